# Optimizing an MI355X kernel written in HIP

```python
import jax, jax.numpy as jnp
from jax import lax
import numpy as np

D_MODEL = 1024
BATCH = 1
SEQ = 16384
DEPTH = 4

CTX_LEN = 256
GRID_W = 64
N_MIXERS = 2
CONV_KERNEL = 31
CONV_PAD = CONV_KERNEL // 2
RET_HEADS = 4
RET_DK = D_MODEL // RET_HEADS
RET_DV = 2 * RET_DK
RET_QK_W = RET_HEADS * RET_DK
RET_V_W = RET_HEADS * RET_DV
RET_IN_W = 2 * RET_QK_W + 3 * RET_V_W
RET_CHUNK = 128
ROPE_BASE = 10000.0
D_FF = -(-8 * D_MODEL // (3 * 256)) * 256
NORM_EPS = 1e-6
LN_EPS = 1e-5

kernel_name = "hybrid_conformer_retention_dit_backbone"


def rms_norm(x, g):
    xf = x.astype(jnp.float32)
    y = xf * lax.rsqrt(jnp.mean(jnp.square(xf), axis=-1, keepdims=True) + NORM_EPS)
    return y.astype(x.dtype) * g


def layer_norm(x, g, b):
    xf = x.astype(jnp.float32)
    mu = jnp.mean(xf, axis=-1, keepdims=True)
    var = jnp.mean(jnp.square(xf - mu), axis=-1, keepdims=True)
    return ((xf - mu) * lax.rsqrt(var + LN_EPS)).astype(x.dtype) * g + b


def swiglu(h, w_in, w_out):
    gt, up = jnp.split(h @ w_in, 2, axis=-1)
    return (jax.nn.silu(gt) * up) @ w_out


def conv_module(h, pw1_w, pw1_b, dw_w, dw_b, ln_g, ln_b, pw2_w, pw2_b):
    a, gt = jnp.split(h @ pw1_w + pw1_b, 2, axis=-1)
    u = a * jax.nn.sigmoid(gt)
    u = lax.conv_general_dilated(
        u, dw_w[:, None, :].astype(u.dtype), window_strides=(1,),
        padding=[(CONV_PAD, CONV_PAD)], dimension_numbers=("NWC", "WIO", "NWC"),
        feature_group_count=D_MODEL) + dw_b
    u = jax.nn.silu(layer_norm(u, ln_g, ln_b))
    return u @ pw2_w + pw2_b


def axial_rope(n_rows):
    row = jnp.repeat(jnp.arange(n_rows, dtype=jnp.float32), GRID_W)
    col = jnp.tile(jnp.arange(GRID_W, dtype=jnp.float32), n_rows)
    quarter = RET_DK // 4
    inv = ROPE_BASE ** (-jnp.arange(quarter, dtype=jnp.float32) / quarter)
    ar = row[:, None] * inv
    ac = col[:, None] * inv
    ang = jnp.concatenate([ar, ar, ac, ac], axis=-1)
    return jnp.cos(ang), jnp.sin(ang)


def apply_rope(t, cos, sin):
    r1, r2, c1, c2 = jnp.split(t, 4, axis=-1)
    rot = jnp.concatenate([-r2, r1, -c2, c1], axis=-1)
    return t * cos[None, :, None, :].astype(t.dtype) + rot * sin[None, :, None, :].astype(t.dtype)


def retention_scan(q, k, v, gamma, state0):
    b, h, t, _ = q.shape
    n = t // RET_CHUNK

    def chunks(a):
        return jnp.moveaxis(a.astype(jnp.float32).reshape(b, h, n, RET_CHUNK, a.shape[-1]), 2, 0)

    log_g = jnp.log(gamma.astype(jnp.float32))
    idx = jnp.arange(RET_CHUNK, dtype=jnp.float32)
    rel = idx[:, None] - idx[None, :]
    decay_intra = jnp.where(rel >= 0, jnp.exp(jnp.maximum(rel, 0.0)[None] * log_g[:, None, None]), 0.0)
    q_decay = jnp.exp((idx + 1.0)[None, :] * log_g[:, None])
    k_decay = jnp.exp((RET_CHUNK - 1.0 - idx)[None, :] * log_g[:, None])
    chunk_decay = jnp.exp(RET_CHUNK * log_g)[:, None, None]

    def step(state, qkv):
        qc, kc, vc = qkv
        scores = jnp.einsum('bhid,bhjd->bhij', qc, kc) * decay_intra
        out = (jnp.einsum('bhij,bhjv->bhiv', scores, vc)
               + jnp.einsum('bhid,bhdv->bhiv', qc, state) * q_decay[None, :, :, None])
        state = state * chunk_decay + jnp.einsum('bhjd,bhjv->bhdv', kc * k_decay[None, :, :, None], vc)
        return state, out

    state, out = lax.scan(step, state0, (chunks(q), chunks(k), chunks(v)))
    out = jnp.moveaxis(out, 0, 2).reshape(b, h, t, -1)
    return out, state


def head_norm(y):
    y = y * lax.rsqrt(jnp.mean(jnp.square(y), axis=-1, keepdims=True) + NORM_EPS)
    b, h, t, dv = y.shape
    return y.transpose(0, 2, 1, 3).reshape(b, t, h * dv)


def retention_mixer(h_lat, h_ctx, w_in, log2_eps, w_out, cos, sin, need_ctx_out):
    gamma = 1.0 - jnp.exp2(log2_eps.astype(jnp.float32))

    def project(h, rope):
        b, t, _ = h.shape
        q, k, v, gf, gb = jnp.split(
            h @ w_in, [RET_QK_W, 2 * RET_QK_W, 2 * RET_QK_W + RET_V_W, 2 * RET_QK_W + 2 * RET_V_W], axis=-1)
        q = q.reshape(b, t, RET_HEADS, RET_DK)
        k = k.reshape(b, t, RET_HEADS, RET_DK)
        if rope:
            q = apply_rope(q, cos, sin)
            k = apply_rope(k, cos, sin)
        k = k * (RET_DK ** -0.5)
        v = v.reshape(b, t, RET_HEADS, RET_DV)
        heads = lambda a: a.transpose(0, 2, 1, 3)
        return heads(q), heads(k), heads(v), gf, gb

    flip = lambda a: jnp.flip(a, axis=2)
    q_c, k_c, v_c, gf_c, gb_c = project(h_ctx, False)
    q_l, k_l, v_l, gf_l, gb_l = project(h_lat, True)
    zero = jnp.zeros((h_lat.shape[0], RET_HEADS, RET_DK, RET_DV), jnp.float32)

    yf_c, s_f = retention_scan(q_c, k_c, v_c, gamma[0], zero)
    yb_c, s_b = retention_scan(flip(q_c), flip(k_c), flip(v_c), gamma[1], zero)
    yf_l, _ = retention_scan(q_l, k_l, v_l, gamma[0], s_f)
    yb_l, _ = retention_scan(flip(q_l), flip(k_l), flip(v_l), gamma[1], s_b)

    def merge(yf, yb, gf, gb):
        y = jax.nn.silu(gf) * head_norm(yf).astype(gf.dtype) + jax.nn.silu(gb) * head_norm(yb).astype(gb.dtype)
        return y @ w_out

    out_lat = merge(yf_l, flip(yb_l), gf_l, gb_l)
    out_ctx = merge(yf_c, flip(yb_c), gf_c, gb_c) if need_ctx_out else None
    return out_lat, out_ctx


def setup_inputs(seed: int = 0) -> dict:
    key = jax.random.key(seed)
    ks = jax.random.split(key, 24)
    n_conv = (DEPTH + N_MIXERS - 1) // N_MIXERS
    n_ret = DEPTH // N_MIXERS
    nrm = lambda k, shape, fan_in, s=1.0: jax.random.normal(k, shape, jnp.float32) * (s * fan_in ** -0.5)
    gain = lambda k, shape: 1.0 + 0.02 * jax.random.normal(k, shape, jnp.float32)
    bias = lambda k, shape: 0.02 * jax.random.normal(k, shape, jnp.float32)
    log2_eps = (-5.0 - jnp.arange(RET_HEADS, dtype=jnp.float32))[None, None, :] \
        + 0.1 * jax.random.normal(ks[17], (n_ret, 2, RET_HEADS), jnp.float32)
    return {
        "x": jax.random.normal(ks[0], (BATCH, SEQ, D_MODEL), jnp.float32),
        "c": jax.random.normal(ks[1], (BATCH, D_MODEL), jnp.float32),
        "ctx": jax.random.normal(ks[2], (BATCH, CTX_LEN, D_MODEL), jnp.float32),
        "c_ctx": jax.random.normal(ks[3], (D_MODEL,), jnp.float32),
        "mod_w": nrm(ks[4], (DEPTH, D_MODEL, 6 * D_MODEL), D_MODEL, 0.5),
        "mod_b": bias(ks[5], (DEPTH, 6 * D_MODEL)),
        "norm1_g": gain(ks[6], (DEPTH, D_MODEL)),
        "norm2_g": gain(ks[7], (DEPTH, D_MODEL)),
        "conv_pw1_w": nrm(ks[8], (n_conv, D_MODEL, 2 * D_MODEL), D_MODEL),
        "conv_pw1_b": bias(ks[9], (n_conv, 2 * D_MODEL)),
        "conv_dw_w": nrm(ks[10], (n_conv, CONV_KERNEL, D_MODEL), CONV_KERNEL),
        "conv_dw_b": bias(ks[11], (n_conv, D_MODEL)),
        "conv_ln_g": gain(ks[12], (n_conv, D_MODEL)),
        "conv_ln_b": bias(ks[13], (n_conv, D_MODEL)),
        "conv_pw2_w": nrm(ks[14], (n_conv, D_MODEL, D_MODEL), D_MODEL),
        "conv_pw2_b": bias(ks[15], (n_conv, D_MODEL)),
        "ret_w_in": nrm(ks[16], (n_ret, D_MODEL, RET_IN_W), D_MODEL),
        "ret_log2_eps": log2_eps,
        "ret_w_out": nrm(ks[18], (n_ret, RET_V_W, D_MODEL), RET_V_W),
        "ffn_w_in": nrm(ks[19], (DEPTH, D_MODEL, 2 * D_FF), D_MODEL),
        "ffn_w_out": nrm(ks[20], (DEPTH, D_FF, D_MODEL), D_FF),
        "final_norm_g": gain(ks[21], (D_MODEL,)),
    }


def reference(x, c, ctx, c_ctx, mod_w, mod_b, norm1_g, norm2_g,
              conv_pw1_w, conv_pw1_b, conv_dw_w, conv_dw_b, conv_ln_g, conv_ln_b, conv_pw2_w, conv_pw2_b,
              ret_w_in, ret_log2_eps, ret_w_out, ffn_w_in, ffn_w_out, final_norm_g):
    n_tok = x.shape[1]
    ROWS = n_tok // GRID_W
    cos, sin = axial_rope(ROWS)
    silu_c = jax.nn.silu(c)[:, None, :]
    silu_cc = jax.nn.silu(c_ctx)
    ctx_s = ctx

    for i in range(DEPTH):
        last = i == DEPTH - 1
        j = i // N_MIXERS
        m_lat = jnp.split(silu_c @ mod_w[i] + mod_b[i], 6, axis=-1)
        m_ctx = jnp.split(silu_cc @ mod_w[i] + mod_b[i], 6, axis=-1)
        h_lat = rms_norm(x, norm1_g[i]) * (1 + m_lat[1]) + m_lat[0]

        if i % N_MIXERS == 0:
            conv_args = (conv_pw1_w[j], conv_pw1_b[j], conv_dw_w[j], conv_dw_b[j],
                         conv_ln_g[j], conv_ln_b[j], conv_pw2_w[j], conv_pw2_b[j])
            y_lat = conv_module(h_lat, *conv_args)
            if not last:
                h_ctx = rms_norm(ctx_s, norm1_g[i]) * (1 + m_ctx[1]) + m_ctx[0]
                y_ctx = conv_module(h_ctx, *conv_args)
        else:
            h_ctx = rms_norm(ctx_s, norm1_g[i]) * (1 + m_ctx[1]) + m_ctx[0]
            y_lat, y_ctx = retention_mixer(h_lat, h_ctx, ret_w_in[j], ret_log2_eps[j], ret_w_out[j],
                                           cos, sin, not last)

        x = x + m_lat[2] * y_lat
        x = x + m_lat[5] * swiglu(rms_norm(x, norm2_g[i]) * (1 + m_lat[4]) + m_lat[3], ffn_w_in[i], ffn_w_out[i])
        if not last:
            ctx_s = ctx_s + m_ctx[2] * y_ctx
            ctx_s = ctx_s + m_ctx[5] * swiglu(rms_norm(ctx_s, norm2_g[i]) * (1 + m_ctx[4]) + m_ctx[3],
                                              ffn_w_in[i], ffn_w_out[i])

    return rms_norm(x, final_norm_g)
```

```cpp
#include <hip/hip_runtime.h>
#include <cstdio>
#include <cstdint>

#ifndef ONE_LAUNCH
#define ONE_LAUNCH 0
#endif

typedef unsigned short bf16_t;
typedef short bf16x8 __attribute__((ext_vector_type(8)));
typedef float f32x4 __attribute__((ext_vector_type(4)));
typedef float f32x2 __attribute__((ext_vector_type(2)));
typedef unsigned u32x2 __attribute__((ext_vector_type(2)));
typedef unsigned u32x4 __attribute__((ext_vector_type(4)));
typedef __bf16 bf16x2_t __attribute__((ext_vector_type(2)));
#define LAS __attribute__((address_space(3)))

constexpr int D = 1024, T = 16384, TC = 256, R = T + TC, NH = 4, DK = 256, DV = 512, QKW = 1024, VW = 2048, INW = 8192, DFF = 2816, FF2 = 5632, CK = 31, DEPTH = 4;
constexpr int NSLOT = 33;
constexpr float NORM_EPS = 1e-6f, LN_EPS = 1e-5f;

constexpr size_t MiB = 1u << 20, KiB = 1u << 10;
constexpr size_t WS_CTL = 0, CTL_ZERO_BYTES = 1 * MiB;
constexpr size_t WS_MODV = 1 * MiB;
constexpr size_t WS_S1 = 1 * MiB + 256 * KiB;
constexpr size_t WS_S2 = 1 * MiB + 320 * KiB;
constexpr size_t WS_CVA = 1 * MiB + 384 * KiB;
constexpr size_t WS_CVF = 1 * MiB + 640 * KiB;
constexpr size_t WS_TABC = 1 * MiB + 832 * KiB;
constexpr size_t WS_TABS = 1 * MiB + 912 * KiB;
constexpr size_t WS_STATS = 2 * MiB;
constexpr size_t WS_XCTX = 4 * MiB;
constexpr size_t WS_WA = 8 * MiB;
constexpr size_t WS_WA2 = 24 * MiB;
constexpr size_t WS_WF1 = 28 * MiB;
constexpr size_t WS_WF2 = 40 * MiB;
constexpr size_t WS_XS = 48 * MiB;
constexpr size_t WS_SCP = 48 * MiB;
constexpr size_t WS_BIG = 114 * MiB;
constexpr size_t WS_Q = WS_BIG, WS_K = WS_BIG + 33 * MiB, WS_VT = WS_BIG + 66 * MiB, WS_GF = WS_BIG + 131 * MiB, WS_GB = WS_BIG + 196 * MiB;
constexpr size_t WS_U = WS_BIG, WS_A2 = WS_BIG + 33 * MiB, WS_H = WS_BIG;
constexpr size_t WS_END = WS_BIG + 261 * MiB;
static_assert((size_t)R * 1024 * 2 <= 33 * MiB && (size_t)R * 2048 * 2 <= 65 * MiB && (size_t)R * DFF * 2 <= 131 * MiB, "map");
static_assert((size_t)NSLOT * 8 * 512 * 256 * 2 <= 66 * MiB, "scp");

constexpr int LDS_BYTES = 147456;

__device__ __forceinline__ unsigned pk2(float lo, float hi) { f32x2 v = {lo, hi}; bf16x2_t b = __builtin_convertvector(v, bf16x2_t); return __builtin_bit_cast(unsigned, b); }
__device__ __forceinline__ float bflo(unsigned u) { return __uint_as_float(u << 16); }
__device__ __forceinline__ float bfhi(unsigned u) { return __uint_as_float(u & 0xffff0000u); }
__device__ __forceinline__ float siluf(float x) { return x / (1.f + __expf(-x)); }
__device__ __forceinline__ float sigmf(float x) { return 1.f / (1.f + __expf(-x)); }
__device__ __forceinline__ int perm_glu(int n, int H) { if (n < H) return 32 * (n >> 4) + (n & 15); const int n2 = n - H; return 32 * (n2 >> 4) + 16 + (n2 & 15); }
__device__ __forceinline__ int perm_win(int n) {
    if (n >= 2 * QKW) return n;
    const int part = n >> 10, hn = n & 1023, h = hn >> 8, d = hn & 255, quarter = d >> 6, idx = d & 63;
    const int Gp = (quarter >> 1) * 4 + (idx >> 4), i = (quarter & 1) * 16 + (idx & 15);
    return part * 1024 + h * 256 + 32 * Gp + i;
}
__device__ __forceinline__ int perm_any(int mode, int n, int H) { return mode == 0 ? n : (mode == 1 ? perm_glu(n, H) : perm_win(n)); }

struct Args { const float* in[22]; float* out; unsigned char* ws; int ph_lo, ph_hi; };

struct Ctx {
    LAS unsigned char* lds;
    int tid, lane, wave, G, bid;
    const float* const* in; float* out; unsigned char* ws;
};

template <int VSILU>
__device__ __forceinline__ void gemv2_unit(Ctx& C, const float* W, int N, int n0, const float* v0, const float* v1, const float* bias, float* o0, float* o1, int pmode, int H) {
    LAS float* red = (LAS float*)C.lds;
    const int c4 = C.tid & 15, ks = C.tid >> 4;
    f32x4 a0 = {0.f, 0.f, 0.f, 0.f}, a1 = {0.f, 0.f, 0.f, 0.f};
#pragma unroll 8
    for (int i = 0; i < 32; ++i) {
        const int k = ks * 32 + i;
        const f32x4 w = *(const f32x4*)(W + (size_t)k * N + n0 + 4 * c4);
        float x0 = v0[k], x1 = v1[k];
        if (VSILU) { x0 = siluf(x0); x1 = siluf(x1); }
        a0 += w * x0; a1 += w * x1;
    }
#pragma unroll
    for (int e = 0; e < 4; ++e) { red[(ks * 2 + 0) * 64 + 4 * c4 + e] = a0[e]; red[(ks * 2 + 1) * 64 + 4 * c4 + e] = a1[e]; }
    __syncthreads();
    if (C.tid < 128) {
        const int s = C.tid >> 6, col = C.tid & 63; float sum = 0.f;
#pragma unroll 8
        for (int k2 = 0; k2 < 32; ++k2) sum += red[(k2 * 2 + s) * 64 + col];
        const int n = n0 + col; if (bias) sum += bias[n];
        (s ? o1 : o0)[perm_any(pmode, n, H)] = sum;
    }
    __syncthreads();
}

__device__ __forceinline__ void transpose_item(const float* W, int K, int N, bf16_t* WT, int pmode, int H, LAS float* scr, int item, int lane) {
    const int nblk = N / 32, kb = item / nblk, nb = item % nblk, k0 = 64 * kb, n0 = 32 * nb;
#pragma unroll 8
    for (int i = 0; i < 32; ++i) { const int kk = 2 * i + (lane >> 5); scr[kk * 33 + (lane & 31)] = W[(size_t)(k0 + kk) * N + n0 + (lane & 31)]; }
    asm volatile("s_waitcnt lgkmcnt(0)" ::: "memory");
    const int c = lane & 7;
#pragma unroll
    for (int j = 0; j < 4; ++j) { const int n = (lane >> 3) + 8 * j; const LAS float* s = scr + (8 * c) * 33 + n;
        u32x4 o; o.x = pk2(s[0 * 33], s[1 * 33]); o.y = pk2(s[2 * 33], s[3 * 33]); o.z = pk2(s[4 * 33], s[5 * 33]); o.w = pk2(s[6 * 33], s[7 * 33]);
        *(u32x4*)(WT + (size_t)perm_any(pmode, n0 + n, H) * K + k0 + 8 * c) = o; }
    asm volatile("s_waitcnt lgkmcnt(0)" ::: "memory");
}
__device__ __forceinline__ void prep_layer(Ctx& C, int i) {
    LAS float* scr = (LAS float*)(C.lds + C.wave * 16384);
    const int gw = C.bid * 8 + C.wave, NGW = C.G * 8, j = i >> 1;
    bf16_t* WA = (bf16_t*)(C.ws + WS_WA); bf16_t* WA2 = (bf16_t*)(C.ws + WS_WA2); bf16_t* WF1 = (bf16_t*)(C.ws + WS_WF1); bf16_t* WF2 = (bf16_t*)(C.ws + WS_WF2);
    const bool conv = (i & 1) == 0;
    const int I_A = conv ? 16 * 64 : 16 * 256, I_A2 = conv ? 16 * 32 : 32 * 32, I_F1 = 16 * 176, I_F2 = 44 * 32;
    const int NIT = I_A + I_A2 + I_F1 + I_F2;
    for (int it = gw; it < NIT; it += NGW) {
        int r = it;
        if (r < I_A) { if (conv) transpose_item(C.in[8] + (size_t)j * 1024 * 2048, 1024, 2048, WA, 1, 1024, scr, r, C.lane);
                       else transpose_item(C.in[16] + (size_t)j * 1024 * 8192, 1024, 8192, WA, 2, 0, scr, r, C.lane); continue; } r -= I_A;
        if (r < I_A2) { if (conv) transpose_item(C.in[14] + (size_t)j * 1024 * 1024, 1024, 1024, WA2, 0, 0, scr, r, C.lane);
                        else transpose_item(C.in[18] + (size_t)j * 2048 * 1024, 2048, 1024, WA2, 0, 0, scr, r, C.lane); continue; } r -= I_A2;
        if (r < I_F1) { transpose_item(C.in[19] + (size_t)i * 1024 * FF2, 1024, FF2, WF1, 1, DFF, scr, r, C.lane); continue; } r -= I_F1;
        transpose_item(C.in[20] + (size_t)i * DFF * 1024, DFF, 1024, WF2, 0, 0, scr, r, C.lane);
    }
}

__device__ __forceinline__ float row_rs(const float* stats, int row, int fq) {
    const f32x4 p = *(const f32x4*)(stats + (size_t)row * 16 + 4 * fq);
    float s = (p[0] + p[1]) + (p[2] + p[3]);
    s += __shfl_xor(s, 16); s += __shfl_xor(s, 32);
    return 1.0f / sqrtf(s * (1.0f / 1024.0f) + NORM_EPS);
}
struct EpiGLU {
    static constexpr bool STATS = false, NEEDRS = true;
    const float* cvl; const float* cvc; const float* stats; bf16_t* out; int ldo; int act;
    __device__ __forceinline__ float row_begin(int row, int fq) const { return row_rs(stats, row, fq); }
    __device__ __forceinline__ float item(int row, int colp, f32x4 v0, f32x4 v1, float rs) const {
        const float* cv = row < T ? cvl : cvc;
        const f32x4 ca = *(const f32x4*)(cv + colp), cg = *(const f32x4*)(cv + colp + 16);
        float o[4];
#pragma unroll
        for (int e = 0; e < 4; ++e) { const float a = rs * v0[e] + ca[e], g = rs * v1[e] + cg[e]; o[e] = act == 0 ? a * sigmf(g) : siluf(a) * g; }
        const int oc = (colp >> 5) * 16 + (colp & 15);
        u32x2 w; w.x = pk2(o[0], o[1]); w.y = pk2(o[2], o[3]);
        *(u32x2*)(out + (size_t)row * ldo + oc) = w;
        return 0.f;
    }
};
struct EpiRes {
    static constexpr bool STATS = true, NEEDRS = false;
    float* xl; float* xc; const float* mgl; const float* mgc; const float* bias; const float* snl; const float* snc; bf16_t* xs; float* stats;
    __device__ __forceinline__ float row_begin(int, int) const { return 1.f; }
    __device__ __forceinline__ float item(int row, int colp, f32x4 v0, f32x4 v1, float) const {
        const bool lat = row < T;
        float* xr = lat ? xl + (size_t)row * 1024 : xc + (size_t)(row - T) * 1024;
        const float* mg = lat ? mgl : mgc; const float* sn = lat ? snl : snc;
        float ss = 0.f;
#pragma unroll
        for (int hlf = 0; hlf < 2; ++hlf) {
            const int c = colp + 16 * hlf; const f32x4 v = hlf ? v1 : v0;
            const f32x4 xo = *(const f32x4*)(xr + c), m4 = *(const f32x4*)(mg + c);
            f32x4 b4 = {0.f, 0.f, 0.f, 0.f}; if (bias) b4 = *(const f32x4*)(bias + c);
            const f32x4 xn = xo + m4 * (v + b4);
            *(f32x4*)(xr + c) = xn;
            ss += (xn[0] * xn[0] + xn[1] * xn[1]) + (xn[2] * xn[2] + xn[3] * xn[3]);
            if (sn) { const f32x4 s4 = *(const f32x4*)(sn + c); u32x2 w; w.x = pk2(xn[0] * s4[0], xn[1] * s4[1]); w.y = pk2(xn[2] * s4[2], xn[3] * s4[3]);
                *(u32x2*)(xs + (size_t)row * 1024 + c) = w; }
        }
        return ss;
    }
};
struct EpiWin {
    static constexpr bool STATS = false, NEEDRS = true;
    const float* cvl; const float* cvc; const float* stats; const float* tabc; const float* tabs;
    bf16_t* q; bf16_t* k; bf16_t* vt; bf16_t* gf; bf16_t* gb;
    __device__ __forceinline__ float row_begin(int row, int fq) const { return row_rs(stats, row, fq); }
    __device__ __forceinline__ float item(int row, int colp, f32x4 v0, f32x4 v1, float rs) const {
        const float* cv = row < T ? cvl : cvc;
        const f32x4 c0 = *(const f32x4*)(cv + colp), c1 = *(const f32x4*)(cv + colp + 16);
        f32x4 a = v0 * rs + c0, b = v1 * rs + c1;
        if (colp < 2048) {
            if (row < T) {
                const int Gp = (colp >> 5) & 7, idx0 = 16 * (Gp & 3) + (colp & 15);
                const int ti = (Gp >> 2) ? 256 + (row & 63) : (row >> 6);
                const f32x4 cs = *(const f32x4*)(tabc + ti * 64 + idx0), sn = *(const f32x4*)(tabs + ti * 64 + idx0);
                const f32x4 o1 = a * cs - b * sn, o2 = b * cs + a * sn; a = o1; b = o2;
            }
            bf16_t* dst = q;
            if (colp >= 1024) { dst = k; a = a * 0.0625f; b = b * 0.0625f; }
            const int c = colp & 1023;
            u32x2 w; w.x = pk2(a[0], a[1]); w.y = pk2(a[2], a[3]); *(u32x2*)(dst + (size_t)row * 1024 + c) = w;
            w.x = pk2(b[0], b[1]); w.y = pk2(b[2], b[3]); *(u32x2*)(dst + (size_t)row * 1024 + c + 16) = w;
        } else if (colp < 4096) {
            const int c = colp - 2048;
#pragma unroll
            for (int e = 0; e < 4; ++e) { vt[(size_t)(c + e) * R + row] = (bf16_t)(pk2(a[e], 0.f) & 0xffffu); vt[(size_t)(c + 16 + e) * R + row] = (bf16_t)(pk2(b[e], 0.f) & 0xffffu); }
        } else {
            bf16_t* dst = colp < 6144 ? gf : gb; const int c = (colp - 4096) & 2047;
            u32x2 w; w.x = pk2(a[0], a[1]); w.y = pk2(a[2], a[3]); *(u32x2*)(dst + (size_t)row * 2048 + c) = w;
            w.x = pk2(b[0], b[1]); w.y = pk2(b[2], b[3]); *(u32x2*)(dst + (size_t)row * 2048 + c + 16) = w;
        }
        return 0.f;
    }
};

template <class Epi>
__device__ __forceinline__ void sgemm_phase(Ctx& C, const bf16_t* A, const bf16_t* Bt, int Mrows, int N, int K, const Epi& E) {
    const int wr = C.wave >> 2, wc = C.wave & 3, fr = C.lane & 15, fq = C.lane >> 4;
    const int nM = Mrows / 64, nN = N / 256, nU = nM * nN;
    for (int u = C.bid; u < nU; u += C.G) {
        const int un = u / nM, um = u % nM;
        const int row0 = 64 * um + 32 * wr, col0 = 256 * un;
        f32x4 acc[2][2][2];
#pragma unroll
        for (int a = 0; a < 2; ++a)
#pragma unroll
            for (int b = 0; b < 2; ++b)
#pragma unroll
                for (int n = 0; n < 2; ++n) acc[a][b][n] = (f32x4){0.f, 0.f, 0.f, 0.f};
        const bf16_t* ap = A + (size_t)(row0 + fr) * K + 8 * fq;
        const bf16_t* bp = Bt + (size_t)(col0 + 32 * wc + fr) * K + 8 * fq;
#pragma unroll 2
        for (int k0 = 0; k0 < K; k0 += 32) {
            bf16x8 af[2], bf[2][2];
#pragma unroll
            for (int mi = 0; mi < 2; ++mi) af[mi] = *(const bf16x8*)(ap + (size_t)(16 * mi) * K + k0);
#pragma unroll
            for (int bj = 0; bj < 2; ++bj)
#pragma unroll
                for (int n = 0; n < 2; ++n) bf[bj][n] = *(const bf16x8*)(bp + (size_t)(128 * bj + 16 * n) * K + k0);
#pragma unroll
            for (int mi = 0; mi < 2; ++mi)
#pragma unroll
                for (int bj = 0; bj < 2; ++bj)
#pragma unroll
                    for (int n = 0; n < 2; ++n) acc[mi][bj][n] = __builtin_amdgcn_mfma_f32_16x16x32_bf16(bf[bj][n], af[mi], acc[mi][bj][n], 0, 0, 0);
        }
#pragma unroll
        for (int mi = 0; mi < 2; ++mi) {
            const int row = row0 + 16 * mi + fr;
            const float rs = E.row_begin(row, fq);
            float ss = 0.f;
#pragma unroll
            for (int bj = 0; bj < 2; ++bj) ss += E.item(row, col0 + 128 * bj + 32 * wc + 4 * fq, acc[mi][bj][0], acc[mi][bj][1], rs);
            if constexpr (Epi::STATS) { ss += __shfl_xor(ss, 16); ss += __shfl_xor(ss, 32); if (fq == 0) E.stats[(size_t)row * 16 + un * 4 + wc] = ss; }
        }
    }
}

__device__ __forceinline__ void dwconv_phase(Ctx& C, int j) {
    const bf16_t* U = (const bf16_t*)(C.ws + WS_U); bf16_t* A2 = (bf16_t*)(C.ws + WS_A2);
    const float* dww = C.in[10] + (size_t)j * CK * 1024; const float* dwb = C.in[11] + j * 1024; const float* lng = C.in[12] + j * 1024; const float* lnb = C.in[13] + j * 1024;
    LAS unsigned char* tile = C.lds; LAS float* part = (LAS float*)(C.lds + 62 * 2048);
    const int tid = C.tid;
    for (int u = C.bid; u < 520; u += C.G) {
        const int base = u < 512 ? 0 : T, n = u < 512 ? T : TC, t0 = 32 * (u < 512 ? u : u - 512);
        for (int idx = tid; idx < 62 * 128; idx += 512) {
            const int rr = idx >> 7, ch = idx & 127, tt = t0 - 15 + rr;
            u32x4 v = {0u, 0u, 0u, 0u};
            if (tt >= 0 && tt < n) v = *(const u32x4*)(U + (size_t)(base + tt) * 1024 + ch * 8);
            *(LAS u32x4*)(tile + rr * 2048 + ch * 16) = v;
        }
        __syncthreads();
        float o0[32], o1[32];
        { const f32x2 b2 = *(const f32x2*)(dwb + 2 * tid);
#pragma unroll
          for (int t = 0; t < 32; ++t) { o0[t] = b2.x; o1[t] = b2.y; } }
        for (int jt = 0; jt < CK; ++jt) {
            const f32x2 w = *(const f32x2*)(dww + jt * 1024 + 2 * tid);
            const LAS unsigned char* p = tile + jt * 2048 + tid * 4;
#pragma unroll
            for (int t = 0; t < 32; ++t) { const unsigned uu = *(const LAS unsigned*)(p + t * 2048); o0[t] += w.x * bflo(uu); o1[t] += w.y * bfhi(uu); }
        }
#pragma unroll
        for (int t = 0; t < 32; ++t) {
            float s = o0[t] + o1[t], q = o0[t] * o0[t] + o1[t] * o1[t];
#pragma unroll
            for (int off = 1; off < 64; off <<= 1) { s += __shfl_xor(s, off); q += __shfl_xor(q, off); }
            if (C.lane == 0) { part[(t * 8 + C.wave) * 2] = s; part[(t * 8 + C.wave) * 2 + 1] = q; }
        }
        __syncthreads();
        const f32x2 g2 = *(const f32x2*)(lng + 2 * tid), bb2 = *(const f32x2*)(lnb + 2 * tid);
#pragma unroll
        for (int t = 0; t < 32; ++t) {
            float s = 0.f, q = 0.f;
#pragma unroll
            for (int w = 0; w < 8; ++w) { s += part[(t * 8 + w) * 2]; q += part[(t * 8 + w) * 2 + 1]; }
            const float mean = s * (1.f / 1024.f), var = q * (1.f / 1024.f) - mean * mean, rstd = 1.0f / sqrtf(var + LN_EPS);
            const float y0 = (o0[t] - mean) * rstd * g2.x + bb2.x, y1 = (o1[t] - mean) * rstd * g2.y + bb2.y;
            *(unsigned*)(A2 + (size_t)(base + t0 + t) * 1024 + 2 * tid) = pk2(siluf(y0), siluf(y1));
        }
        __syncthreads();
    }
}

__device__ __forceinline__ void scan_phase(Ctx& C, int j) {
    const bf16_t* Kb = (const bf16_t*)(C.ws + WS_K); const bf16_t* Vt = (const bf16_t*)(C.ws + WS_VT); bf16_t* Scp = (bf16_t*)(C.ws + WS_SCP);
    const int fr = C.lane & 15, fq = C.lane >> 4;
    for (int wt = C.bid * 8 + C.wave; wt < 2048; wt += C.G * 8) {
        const int hd = wt >> 8, h = hd >> 1, dir = hd & 1, tile = wt & 255, dk0 = 16 * (tile >> 4), dv0 = 32 * (tile & 15);
        const float gam = 1.0f - exp2f(C.in[17][(j * 2 + dir) * 4 + h]); const float L = log2f(gam);
        float kd[4][8];
#pragma unroll
        for (int ks = 0; ks < 4; ++ks)
#pragma unroll
            for (int e = 0; e < 8; ++e) { const int tl = 32 * ks + 8 * fq + e; kd[ks][e] = exp2f(L * (float)(dir == 0 ? 127 - tl : tl)); }
        const float cdec = exp2f(L * 128.f);
        f32x4 acc[2]; acc[0] = (f32x4){0.f, 0.f, 0.f, 0.f}; acc[1] = acc[0];
        for (int step = 0; step < 130; ++step) {
            int bl, tok0; bool isctx = step < 2;
            if (dir == 0) { bl = isctx ? step : step - 2; } else { bl = isctx ? 1 - step : 127 - (step - 2); }
            tok0 = (isctx ? T : 0) + 128 * bl;
            const bool cp = dir == 0 ? ((bl & 3) == 0) : (isctx ? bl == 1 : (bl & 3) == 3);
            if (cp) {
                const int slot = isctx ? 32 : (bl >> 2);
                bf16_t* sp = Scp + ((size_t)((slot * 4 + h) * 2 + dir) * 512) * 256;
#pragma unroll
                for (int nt = 0; nt < 2; ++nt) { u32x2 w; w.x = pk2(acc[nt][0], acc[nt][1]); w.y = pk2(acc[nt][2], acc[nt][3]);
                    *(u32x2*)(sp + (size_t)(dv0 + 16 * nt + fr) * 256 + dk0 + 4 * fq) = w; }
            }
            bf16x8 af[4], bfr[2][4];
#pragma unroll
            for (int ks = 0; ks < 4; ++ks) {
                const bf16_t* kp = Kb + (size_t)(tok0 + 32 * ks + 8 * fq) * 1024 + h * 256 + dk0 + fr;
                float kv[8];
#pragma unroll
                for (int e = 0; e < 8; ++e) kv[e] = bflo((unsigned)kp[(size_t)e * 1024]) * kd[ks][e];
                u32x4 pk; pk.x = pk2(kv[0], kv[1]); pk.y = pk2(kv[2], kv[3]); pk.z = pk2(kv[4], kv[5]); pk.w = pk2(kv[6], kv[7]);
                af[ks] = __builtin_bit_cast(bf16x8, pk);
#pragma unroll
                for (int nt = 0; nt < 2; ++nt) bfr[nt][ks] = *(const bf16x8*)(Vt + (size_t)(h * 512 + dv0 + 16 * nt + fr) * R + tok0 + 32 * ks + 8 * fq);
            }
            acc[0] = acc[0] * cdec; acc[1] = acc[1] * cdec;
#pragma unroll
            for (int ks = 0; ks < 4; ++ks)
#pragma unroll
                for (int nt = 0; nt < 2; ++nt) acc[nt] = __builtin_amdgcn_mfma_f32_16x16x32_bf16(af[ks], bfr[nt][ks], acc[nt], 0, 0, 0);
        }
    }
}

__device__ __forceinline__ void readout_phase(Ctx& C, int j) {
    const bf16_t* Q = (const bf16_t*)(C.ws + WS_Q); const bf16_t* Kb = (const bf16_t*)(C.ws + WS_K); const bf16_t* Vt = (const bf16_t*)(C.ws + WS_VT);
    const bf16_t* Scp = (const bf16_t*)(C.ws + WS_SCP); bf16_t* GF = (bf16_t*)(C.ws + WS_GF); const bf16_t* GB = (const bf16_t*)(C.ws + WS_GB);
    constexpr int PP = 136;
    LAS bf16_t* P = (LAS bf16_t*)C.lds; LAS float* red = (LAS float*)(C.lds + 128 * PP * 2);
    const int fr = C.lane & 15, fq = C.lane >> 4, w = C.wave;
    for (int u = C.bid; u < 520; u += C.G) {
        const int h = u & 3, b = u >> 2;
        const bool lat = b < 128; const int base = lat ? 0 : T, nb = lat ? 128 : 2, bl = lat ? b : b - 128;
        const int g = bl >> 2, slot = lat ? g : 32, i0 = base + 128 * bl;
#pragma unroll 1
        for (int dir = 0; dir < 2; ++dir) {
            const float gam = 1.0f - exp2f(C.in[17][(j * 2 + dir) * 4 + h]); const float L = log2f(gam);
            f32x4 acc[8][4];
#pragma unroll
            for (int mt = 0; mt < 8; ++mt)
#pragma unroll
                for (int nt = 0; nt < 4; ++nt) acc[mt][nt] = (f32x4){0.f, 0.f, 0.f, 0.f};
            const bf16_t* sb = Scp + ((size_t)((slot * 4 + h) * 2 + dir) * 512) * 256;
            const bf16_t* qb = Q + (size_t)(i0 + fr) * 1024 + h * 256 + 8 * fq;
#pragma unroll 1
            for (int ks = 0; ks < 8; ++ks) {
                bf16x8 sf[4];
#pragma unroll
                for (int nt = 0; nt < 4; ++nt) sf[nt] = *(const bf16x8*)(sb + (size_t)(64 * w + 16 * nt + fr) * 256 + 32 * ks + 8 * fq);
#pragma unroll
                for (int mt = 0; mt < 8; ++mt) { const bf16x8 qf = *(const bf16x8*)(qb + (size_t)(16 * mt) * 1024 + 32 * ks);
#pragma unroll
                    for (int nt = 0; nt < 4; ++nt) acc[mt][nt] = __builtin_amdgcn_mfma_f32_16x16x32_bf16(sf[nt], qf, acc[mt][nt], 0, 0, 0); }
            }
            const int gend = (4 * (g + 1) < nb ? 4 * (g + 1) : nb);
#pragma unroll
            for (int mt = 0; mt < 8; ++mt) {
                const int il = 128 * bl + 16 * mt + fr;
                const int ex = dir == 0 ? il - 512 * g + 1 : (gend * 128 - 1) - il + 1;
                const float qd = exp2f(L * (float)ex);
#pragma unroll
                for (int nt = 0; nt < 4; ++nt) acc[mt][nt] = acc[mt][nt] * qd;
            }
            const int kb_lo = dir == 0 ? 4 * g : bl, kb_hi = dir == 0 ? bl : gend - 1;
#pragma unroll 1
            for (int kb = kb_lo; kb <= kb_hi; ++kb) {
                const int j0 = base + 128 * kb;
                const bf16_t* q1 = Q + (size_t)(i0 + 16 * w + fr) * 1024 + h * 256 + 8 * fq;
                const int il = 128 * bl + 16 * w + fr;
#pragma unroll 1
                for (int nh = 0; nh < 2; ++nh) {
                    f32x4 sc[4];
#pragma unroll
                    for (int nt = 0; nt < 4; ++nt) sc[nt] = (f32x4){0.f, 0.f, 0.f, 0.f};
                    const bf16_t* k1 = Kb + (size_t)(j0 + 64 * nh + fr) * 1024 + h * 256 + 8 * fq;
#pragma unroll 1
                    for (int ks = 0; ks < 8; ++ks) {
                        const bf16x8 qf = *(const bf16x8*)(q1 + 32 * ks);
#pragma unroll
                        for (int nt = 0; nt < 4; ++nt) { const bf16x8 kf = *(const bf16x8*)(k1 + (size_t)(16 * nt) * 1024 + 32 * ks);
                            sc[nt] = __builtin_amdgcn_mfma_f32_16x16x32_bf16(kf, qf, sc[nt], 0, 0, 0); }
                    }
#pragma unroll
                    for (int nt = 0; nt < 4; ++nt) {
                        float p[4];
#pragma unroll
                        for (int e = 0; e < 4; ++e) { const int jl = 128 * kb + 64 * nh + 16 * nt + 4 * fq + e; const int rel = dir == 0 ? il - jl : jl - il;
                            p[e] = rel >= 0 ? sc[nt][e] * exp2f(L * (float)rel) : 0.f; }
                        u32x2 wv; wv.x = pk2(p[0], p[1]); wv.y = pk2(p[2], p[3]);
                        *(LAS u32x2*)(P + (16 * w + fr) * PP + 64 * nh + 16 * nt + 4 * fq) = wv;
                    }
                }
                __syncthreads();
                const bf16_t* vb = Vt + (size_t)(h * 512 + 64 * w + fr) * R + j0 + 8 * fq;
#pragma unroll 1
                for (int ks = 0; ks < 4; ++ks) {
                    bf16x8 vf[4];
#pragma unroll
                    for (int nt = 0; nt < 4; ++nt) vf[nt] = *(const bf16x8*)(vb + (size_t)(16 * nt) * R + 32 * ks);
#pragma unroll
                    for (int mt = 0; mt < 8; ++mt) { const bf16x8 pf = *(const LAS bf16x8*)(P + (16 * mt + fr) * PP + 32 * ks + 8 * fq);
#pragma unroll
                        for (int nt = 0; nt < 4; ++nt) acc[mt][nt] = __builtin_amdgcn_mfma_f32_16x16x32_bf16(vf[nt], pf, acc[mt][nt], 0, 0, 0); }
                }
                __syncthreads();
            }
#pragma unroll
            for (int mt = 0; mt < 8; ++mt) {
                float ss = 0.f;
#pragma unroll
                for (int nt = 0; nt < 4; ++nt) ss += (acc[mt][nt][0] * acc[mt][nt][0] + acc[mt][nt][1] * acc[mt][nt][1]) + (acc[mt][nt][2] * acc[mt][nt][2] + acc[mt][nt][3] * acc[mt][nt][3]);
                ss += __shfl_xor(ss, 16); ss += __shfl_xor(ss, 32);
                if (fq == 0) red[(16 * mt + fr) * 8 + w] = ss;
            }
            __syncthreads();
#pragma unroll
            for (int mt = 0; mt < 8; ++mt) {
                float tot = 0.f;
#pragma unroll
                for (int w2 = 0; w2 < 8; ++w2) tot += red[(16 * mt + fr) * 8 + w2];
                const float rn = 1.0f / sqrtf(tot * (1.f / 512.f) + NORM_EPS);
                const size_t off = (size_t)(i0 + 16 * mt + fr) * 2048 + h * 512 + 64 * w + 4 * fq;
#pragma unroll
                for (int nt = 0; nt < 4; ++nt) {
                    const u32x2 gg = *(const u32x2*)((dir == 0 ? (const bf16_t*)GF : GB) + off + 16 * nt);
                    float y0 = siluf(bflo(gg.x)) * acc[mt][nt][0] * rn, y1 = siluf(bfhi(gg.x)) * acc[mt][nt][1] * rn;
                    float y2 = siluf(bflo(gg.y)) * acc[mt][nt][2] * rn, y3 = siluf(bfhi(gg.y)) * acc[mt][nt][3] * rn;
                    if (dir == 1) { const u32x2 yp = *(const u32x2*)(GF + off + 16 * nt); y0 += bflo(yp.x); y1 += bfhi(yp.x); y2 += bflo(yp.y); y3 += bfhi(yp.y); }
                    u32x2 wv; wv.x = pk2(y0, y1); wv.y = pk2(y2, y3);
                    *(u32x2*)(GF + off + 16 * nt) = wv;
                }
            }
            __syncthreads();
        }
    }
}

__device__ __forceinline__ void phase_p0(Ctx& C) {
    float* modv = (float*)(C.ws + WS_MODV);
    for (int u = C.bid; u < 384; u += C.G) {
        const int i = u / 96, nbk = u % 96;
        gemv2_unit<1>(C, C.in[4] + (size_t)i * 1024 * 6144, 6144, 64 * nbk, C.in[1], C.in[3], C.in[5] + i * 6144, modv + (i * 2 + 0) * 6144, modv + (i * 2 + 1) * 6144, 0, 0);
    }
    float* tabc = (float*)(C.ws + WS_TABC); float* tabs = (float*)(C.ws + WS_TABS);
    for (int idx = C.bid * 512 + C.tid; idx < 320 * 64; idx += C.G * 512) {
        const int ti = idx >> 6, i = idx & 63; const float pos = (float)(ti < 256 ? ti : ti - 256);
        const float inv = exp2f(-(float)i * (13.287712379549449f / 64.0f)); const float ang = pos * inv;
        tabc[idx] = __cosf(ang); tabs[idx] = __sinf(ang);
    }
}
__device__ __forceinline__ void phase_p1(Ctx& C) {
    const float* modv = (const float*)(C.ws + WS_MODV);
    float* s1 = (float*)(C.ws + WS_S1); float* s2 = (float*)(C.ws + WS_S2);
    for (int idx = C.bid * 512 + C.tid; idx < 8192; idx += C.G * 512) {
        const int i = idx >> 11, s = (idx >> 10) & 1, k = idx & 1023;
        s1[idx] = C.in[6][i * 1024 + k] * (1.f + modv[(i * 2 + s) * 6144 + 1024 + k]);
        s2[idx] = C.in[7][i * 1024 + k] * (1.f + modv[(i * 2 + s) * 6144 + 4096 + k]);
    }
    float* cvA = (float*)(C.ws + WS_CVA); float* cvF = (float*)(C.ws + WS_CVF);
    for (int u = C.bid; u < 672; u += C.G) {
        if (u < 320) {
            int i, nbk; if (u < 32) { i = 0; nbk = u; } else if (u < 160) { i = 1; nbk = u - 32; } else if (u < 192) { i = 2; nbk = u - 160; } else { i = 3; nbk = u - 192; }
            const int j = i >> 1; const float* v0 = modv + (i * 2 + 0) * 6144; const float* v1 = modv + (i * 2 + 1) * 6144;
            if ((i & 1) == 0) gemv2_unit<0>(C, C.in[8] + (size_t)j * 1024 * 2048, 2048, 64 * nbk, v0, v1, C.in[9] + j * 2048, cvA + (i * 2) * 8192, cvA + (i * 2 + 1) * 8192, 1, 1024);
            else gemv2_unit<0>(C, C.in[16] + (size_t)j * 1024 * 8192, 8192, 64 * nbk, v0, v1, nullptr, cvA + (i * 2) * 8192, cvA + (i * 2 + 1) * 8192, 2, 0);
        } else {
            const int i = (u - 320) / 88, nbk = (u - 320) % 88;
            const float* v0 = modv + (i * 2 + 0) * 6144 + 3072; const float* v1 = modv + (i * 2 + 1) * 6144 + 3072;
            gemv2_unit<0>(C, C.in[19] + (size_t)i * 1024 * FF2, FF2, 64 * nbk, v0, v1, nullptr, cvF + (i * 2) * FF2, cvF + (i * 2 + 1) * FF2, 1, DFF);
        }
    }
    bf16_t* xs = (bf16_t*)(C.ws + WS_XS); float* stats = (float*)(C.ws + WS_STATS); float* xctx = (float*)(C.ws + WS_XCTX);
    for (int row = C.bid * 8 + C.wave; row < R; row += C.G * 8) {
        const bool lat = row < T; const int s = lat ? 0 : 1;
        const float* src = lat ? C.in[0] + (size_t)row * 1024 : C.in[2] + (size_t)(row - T) * 1024;
        float* dst = lat ? C.out + (size_t)row * 1024 : xctx + (size_t)(row - T) * 1024;
        float ss = 0.f;
#pragma unroll
        for (int jj = 0; jj < 4; ++jj) {
            const int k = 4 * C.lane + 256 * jj;
            const f32x4 v = *(const f32x4*)(src + k); *(f32x4*)(dst + k) = v;
            ss += (v[0] * v[0] + v[1] * v[1]) + (v[2] * v[2] + v[3] * v[3]);
            const f32x4 g = *(const f32x4*)(C.in[6] + k), m = *(const f32x4*)(modv + s * 6144 + 1024 + k);
            u32x2 w; w.x = pk2(v[0] * g[0] * (1.f + m[0]), v[1] * g[1] * (1.f + m[1])); w.y = pk2(v[2] * g[2] * (1.f + m[2]), v[3] * g[3] * (1.f + m[3]));
            *(u32x2*)(xs + (size_t)row * 1024 + k) = w;
        }
#pragma unroll
        for (int off = 1; off < 64; off <<= 1) ss += __shfl_xor(ss, off);
        if (C.lane < 16) stats[(size_t)row * 16 + C.lane] = C.lane == 0 ? ss : 0.f;
    }
    prep_layer(C, 0);
}
__device__ __forceinline__ void phase_final(Ctx& C) {
    const float* stats = (const float*)(C.ws + WS_STATS);
    for (int row = C.bid * 8 + C.wave; row < T; row += C.G * 8) {
        float s = C.lane < 16 ? stats[(size_t)row * 16 + C.lane] : 0.f;
#pragma unroll
        for (int off = 1; off < 64; off <<= 1) s += __shfl_xor(s, off);
        const float r = 1.0f / sqrtf(s * (1.f / 1024.f) + NORM_EPS);
        float* xr = C.out + (size_t)row * 1024;
#pragma unroll
        for (int jj = 0; jj < 4; ++jj) { const int k = 4 * C.lane + 256 * jj; const f32x4 v = *(const f32x4*)(xr + k), g = *(const f32x4*)(C.in[21] + k); *(f32x4*)(xr + k) = v * r * g; }
    }
}

constexpr int NPHASE = 31;
__device__ __forceinline__ void run_phase(Ctx& C, int ph) {
    const int i = (ph - 2) / 7, sub = (ph - 2) % 7, j = i >> 1; const bool conv = (i & 1) == 0;
    const float* modv = (const float*)(C.ws + WS_MODV); const float* ml = modv + (i * 2) * 6144; const float* mc = modv + (i * 2 + 1) * 6144;
    float* stats = (float*)(C.ws + WS_STATS); bf16_t* xs = (bf16_t*)(C.ws + WS_XS); float* xctx = (float*)(C.ws + WS_XCTX);
    const float* s1 = (const float*)(C.ws + WS_S1); const float* s2 = (const float*)(C.ws + WS_S2);
    const float* cvA = (const float*)(C.ws + WS_CVA) + (size_t)(i * 2) * 8192; const float* cvF = (const float*)(C.ws + WS_CVF) + (size_t)(i * 2) * FF2;
    const bf16_t* WA = (const bf16_t*)(C.ws + WS_WA); const bf16_t* WA2 = (const bf16_t*)(C.ws + WS_WA2); const bf16_t* WF1 = (const bf16_t*)(C.ws + WS_WF1); const bf16_t* WF2 = (const bf16_t*)(C.ws + WS_WF2);
    switch (sub) {
    case 1:
        if (conv) { EpiGLU E{cvA, cvA + 8192, stats, (bf16_t*)(C.ws + WS_U), 1024, 0}; sgemm_phase(C, xs, WA, R, 2048, 1024, E); }
        else { EpiWin E{cvA, cvA + 8192, stats, (const float*)(C.ws + WS_TABC), (const float*)(C.ws + WS_TABS), (bf16_t*)(C.ws + WS_Q), (bf16_t*)(C.ws + WS_K), (bf16_t*)(C.ws + WS_VT), (bf16_t*)(C.ws + WS_GF), (bf16_t*)(C.ws + WS_GB)};
               sgemm_phase(C, xs, WA, R, 8192, 1024, E); }
        break;
    case 4:
        if (conv) { EpiRes E{C.out, xctx, ml + 2048, mc + 2048, C.in[15] + j * 1024, s2 + (i * 2) * 1024, s2 + (i * 2 + 1) * 1024, xs, stats}; sgemm_phase(C, (const bf16_t*)(C.ws + WS_A2), WA2, R, 1024, 1024, E); }
        else { EpiRes E{C.out, xctx, ml + 2048, mc + 2048, nullptr, s2 + (i * 2) * 1024, s2 + (i * 2 + 1) * 1024, xs, stats}; sgemm_phase(C, (const bf16_t*)(C.ws + WS_GF), WA2, R, 1024, 2048, E); }
        break;
    case 5: { EpiGLU E{cvF, cvF + FF2, stats, (bf16_t*)(C.ws + WS_H), DFF, 1}; sgemm_phase(C, xs, WF1, R, FF2, 1024, E); } break;
    case 6: { const bool last = i == DEPTH - 1;
              EpiRes E{C.out, xctx, ml + 5120, mc + 5120, nullptr, last ? nullptr : s1 + ((i + 1) * 2) * 1024, last ? nullptr : s1 + ((i + 1) * 2 + 1) * 1024, xs, stats};
              sgemm_phase(C, (const bf16_t*)(C.ws + WS_H), WF2, R, 1024, DFF, E); } break;
    }
}

template <int KIND>
__global__ void __launch_bounds__(512, 2) phase_kernel(Args args) {
    extern __shared__ __attribute__((aligned(16))) unsigned char lds_raw[];
    Ctx C;
    C.lds = (LAS unsigned char*)lds_raw; C.tid = threadIdx.x; C.lane = C.tid & 63; C.wave = __builtin_amdgcn_readfirstlane(C.tid >> 6); C.G = gridDim.x; C.bid = blockIdx.x;
    C.in = args.in; C.out = args.out; C.ws = args.ws;
    const int ph = args.ph_lo;
    if (KIND == 0) phase_p0(C);
    else if (KIND == 1) phase_p1(C);
    else if (KIND == 30) phase_final(C);
    else {
        const int i = (ph - 2) / 7, j = i >> 1; const bool conv = (i & 1) == 0;
        if (KIND == 2) prep_layer(C, i);
        else if (KIND == 4) { if (conv) dwconv_phase(C, j); else scan_phase(C, j); }
        else if (KIND == 5) readout_phase(C, j);
        else run_phase(C, ph);
    }
}

extern "C" void kernel_launch(void* const* d_in, const int* in_sizes, int n_in, void* d_out, int out_size, void* d_ws, size_t ws_size, hipStream_t stream) {
    static int grid = 0;
    if (grid == 0) {
        if (n_in != 22 || out_size != T * D || ws_size < WS_END) { fprintf(stderr, "kernel_launch: unexpected problem (n_in %d out %d ws %zu, need %zu)\n", n_in, out_size, ws_size, (size_t)WS_END); grid = -1; return; }
        int dev = 0, cus = 0;
        if (hipGetDevice(&dev) != hipSuccess || hipDeviceGetAttribute(&cus, hipDeviceAttributeMultiprocessorCount, dev) != hipSuccess) { grid = -1; return; }
        bool ok = true;
        ok &= hipFuncSetAttribute((const void*)phase_kernel<0>, hipFuncAttributeMaxDynamicSharedMemorySize, LDS_BYTES) == hipSuccess;
        ok &= hipFuncSetAttribute((const void*)phase_kernel<1>, hipFuncAttributeMaxDynamicSharedMemorySize, LDS_BYTES) == hipSuccess;
        ok &= hipFuncSetAttribute((const void*)phase_kernel<2>, hipFuncAttributeMaxDynamicSharedMemorySize, LDS_BYTES) == hipSuccess;
        ok &= hipFuncSetAttribute((const void*)phase_kernel<3>, hipFuncAttributeMaxDynamicSharedMemorySize, LDS_BYTES) == hipSuccess;
        ok &= hipFuncSetAttribute((const void*)phase_kernel<4>, hipFuncAttributeMaxDynamicSharedMemorySize, LDS_BYTES) == hipSuccess;
        ok &= hipFuncSetAttribute((const void*)phase_kernel<5>, hipFuncAttributeMaxDynamicSharedMemorySize, LDS_BYTES) == hipSuccess;
        ok &= hipFuncSetAttribute((const void*)phase_kernel<30>, hipFuncAttributeMaxDynamicSharedMemorySize, LDS_BYTES) == hipSuccess;
        if (!ok) { fprintf(stderr, "kernel_launch: hipFuncSetAttribute failed\n"); grid = -1; return; }
        grid = cus > 0 ? cus : 256;
    }
    if (grid < 0) return;
    Args a{};
    for (int i = 0; i < 22; ++i) a.in[i] = (const float*)d_in[i];
    a.out = (float*)d_out; a.ws = (unsigned char*)d_ws;
    for (int ph = 0; ph < NPHASE; ++ph) {
        const int i = (ph - 2) / 7, sub = (ph - 2) % 7;
        if (ph >= 2 && ph < 30) { if (sub == 0 && i == 0) continue; if (sub == 3 && (i & 1) == 0) continue; }
        a.ph_lo = ph; a.ph_hi = ph + 1;
        const dim3 g(grid), b(512);
        if (ph == 0) hipLaunchKernelGGL(phase_kernel<0>, g, b, LDS_BYTES, stream, a);
        else if (ph == 1) hipLaunchKernelGGL(phase_kernel<1>, g, b, LDS_BYTES, stream, a);
        else if (ph == 30) hipLaunchKernelGGL(phase_kernel<30>, g, b, LDS_BYTES, stream, a);
        else if (sub == 0) hipLaunchKernelGGL(phase_kernel<2>, g, b, LDS_BYTES, stream, a);
        else if (sub == 2) hipLaunchKernelGGL(phase_kernel<4>, g, b, LDS_BYTES, stream, a);
        else if (sub == 3) hipLaunchKernelGGL(phase_kernel<5>, g, b, LDS_BYTES, stream, a);
        else hipLaunchKernelGGL(phase_kernel<3>, g, b, LDS_BYTES, stream, a);
    }
}
```

```cpp
#include <hip/hip_runtime.h>
#include <cstdio>
#include <cstdint>

#ifndef ONE_LAUNCH
#define ONE_LAUNCH 1
#endif

typedef unsigned short bf16_t;
typedef short bf16x8 __attribute__((ext_vector_type(8)));
typedef float f32x4 __attribute__((ext_vector_type(4)));
typedef float f32x2 __attribute__((ext_vector_type(2)));
typedef unsigned u32x2 __attribute__((ext_vector_type(2)));
typedef unsigned u32x4 __attribute__((ext_vector_type(4)));
typedef __bf16 bf16x2_t __attribute__((ext_vector_type(2)));
#define LAS __attribute__((address_space(3)))

constexpr int D = 1024, T = 16384, TC = 256, R = T + TC, NH = 4, DK = 256, DV = 512, QKW = 1024, VW = 2048, INW = 8192, DFF = 2816, FF2 = 5632, CK = 31, DEPTH = 4;
constexpr int NSLOT = 33;
constexpr float NORM_EPS = 1e-6f, LN_EPS = 1e-5f;

constexpr size_t MiB = 1u << 20, KiB = 1u << 10;
constexpr size_t WS_CTL = 0, CTL_ZERO_BYTES = 1 * MiB;
constexpr size_t WS_MODV = 1 * MiB;
constexpr size_t WS_S1 = 1 * MiB + 256 * KiB;
constexpr size_t WS_S2 = 1 * MiB + 320 * KiB;
constexpr size_t WS_CVA = 1 * MiB + 384 * KiB;
constexpr size_t WS_CVF = 1 * MiB + 640 * KiB;
constexpr size_t WS_TABC = 1 * MiB + 832 * KiB;
constexpr size_t WS_TABS = 1 * MiB + 912 * KiB;
constexpr size_t WS_STATS = 2 * MiB;
constexpr size_t WS_XCTX = 4 * MiB;
constexpr size_t WS_WA = 8 * MiB;
constexpr size_t WS_WA2 = 24 * MiB;
constexpr size_t WS_WF1 = 28 * MiB;
constexpr size_t WS_WF2 = 40 * MiB;
constexpr size_t WS_XS = 48 * MiB;
constexpr size_t WS_SCP = 48 * MiB;
constexpr size_t WS_BIG = 114 * MiB;
constexpr size_t WS_Q = WS_BIG, WS_K = WS_BIG + 33 * MiB, WS_VT = WS_BIG + 66 * MiB, WS_GF = WS_BIG + 131 * MiB, WS_GB = WS_BIG + 196 * MiB;
constexpr size_t WS_U = WS_BIG, WS_A2 = WS_BIG + 33 * MiB, WS_H = WS_BIG;
constexpr size_t WS_END = WS_BIG + 261 * MiB;
static_assert((size_t)R * 1024 * 2 <= 33 * MiB && (size_t)R * 2048 * 2 <= 65 * MiB && (size_t)R * DFF * 2 <= 131 * MiB, "map");
static_assert((size_t)NSLOT * 8 * 512 * 256 * 2 <= 66 * MiB, "scp");

constexpr int LDS_BYTES = 147456;

__device__ __forceinline__ unsigned pk2(float lo, float hi) { f32x2 v = {lo, hi}; bf16x2_t b = __builtin_convertvector(v, bf16x2_t); return __builtin_bit_cast(unsigned, b); }
__device__ __forceinline__ float bflo(unsigned u) { return __uint_as_float(u << 16); }
__device__ __forceinline__ float bfhi(unsigned u) { return __uint_as_float(u & 0xffff0000u); }
__device__ __forceinline__ float siluf(float x) { return x / (1.f + __expf(-x)); }
__device__ __forceinline__ float sigmf(float x) { return 1.f / (1.f + __expf(-x)); }
__device__ __forceinline__ int perm_glu(int n, int H) { if (n < H) return 32 * (n >> 4) + (n & 15); const int n2 = n - H; return 32 * (n2 >> 4) + 16 + (n2 & 15); }
__device__ __forceinline__ int perm_win(int n) {
    if (n >= 2 * QKW) return n;
    const int part = n >> 10, hn = n & 1023, h = hn >> 8, d = hn & 255, quarter = d >> 6, idx = d & 63;
    const int Gp = (quarter >> 1) * 4 + (idx >> 4), i = (quarter & 1) * 16 + (idx & 15);
    return part * 1024 + h * 256 + 32 * Gp + i;
}
__device__ __forceinline__ int perm_any(int mode, int n, int H) { return mode == 0 ? n : (mode == 1 ? perm_glu(n, H) : perm_win(n)); }

struct Args { const float* in[22]; float* out; unsigned char* ws; int ph_lo, ph_hi; };

struct Ctx {
    LAS unsigned char* lds;
    int tid, lane, wave, G, bid;
    const float* const* in; float* out; unsigned char* ws;
};

template <int VSILU>
__device__ __forceinline__ void gemv2_unit(Ctx& C, const float* W, int N, int n0, const float* v0, const float* v1, const float* bias, float* o0, float* o1, int pmode, int H) {
    LAS float* red = (LAS float*)C.lds;
    const int c4 = C.tid & 15, ks = C.tid >> 4;
    f32x4 a0 = {0.f, 0.f, 0.f, 0.f}, a1 = {0.f, 0.f, 0.f, 0.f};
#pragma unroll 8
    for (int i = 0; i < 32; ++i) {
        const int k = ks * 32 + i;
        const f32x4 w = *(const f32x4*)(W + (size_t)k * N + n0 + 4 * c4);
        float x0 = v0[k], x1 = v1[k];
        if (VSILU) { x0 = siluf(x0); x1 = siluf(x1); }
        a0 += w * x0; a1 += w * x1;
    }
#pragma unroll
    for (int e = 0; e < 4; ++e) { red[(ks * 2 + 0) * 64 + 4 * c4 + e] = a0[e]; red[(ks * 2 + 1) * 64 + 4 * c4 + e] = a1[e]; }
    __syncthreads();
    if (C.tid < 128) {
        const int s = C.tid >> 6, col = C.tid & 63; float sum = 0.f;
#pragma unroll 8
        for (int k2 = 0; k2 < 32; ++k2) sum += red[(k2 * 2 + s) * 64 + col];
        const int n = n0 + col; if (bias) sum += bias[n];
        (s ? o1 : o0)[perm_any(pmode, n, H)] = sum;
    }
    __syncthreads();
}

__device__ __forceinline__ void transpose_item(const float* W, int K, int N, bf16_t* WT, int pmode, int H, LAS float* scr, int item, int lane) {
    const int nblk = N / 32, kb = item / nblk, nb = item % nblk, k0 = 64 * kb, n0 = 32 * nb;
#pragma unroll 8
    for (int i = 0; i < 32; ++i) { const int kk = 2 * i + (lane >> 5); scr[kk * 33 + (lane & 31)] = W[(size_t)(k0 + kk) * N + n0 + (lane & 31)]; }
    asm volatile("s_waitcnt lgkmcnt(0)" ::: "memory");
    const int c = lane & 7;
#pragma unroll
    for (int j = 0; j < 4; ++j) { const int n = (lane >> 3) + 8 * j; const LAS float* s = scr + (8 * c) * 33 + n;
        u32x4 o; o.x = pk2(s[0 * 33], s[1 * 33]); o.y = pk2(s[2 * 33], s[3 * 33]); o.z = pk2(s[4 * 33], s[5 * 33]); o.w = pk2(s[6 * 33], s[7 * 33]);
        *(u32x4*)(WT + (size_t)perm_any(pmode, n0 + n, H) * K + k0 + 8 * c) = o; }
    asm volatile("s_waitcnt lgkmcnt(0)" ::: "memory");
}
__device__ __forceinline__ void prep_layer(Ctx& C, int i) {
    LAS float* scr = (LAS float*)(C.lds + C.wave * 16384);
    const int gw = C.bid * 8 + C.wave, NGW = C.G * 8, j = i >> 1;
    bf16_t* WA = (bf16_t*)(C.ws + WS_WA); bf16_t* WA2 = (bf16_t*)(C.ws + WS_WA2); bf16_t* WF1 = (bf16_t*)(C.ws + WS_WF1); bf16_t* WF2 = (bf16_t*)(C.ws + WS_WF2);
    const bool conv = (i & 1) == 0;
    const int I_A = conv ? 16 * 64 : 16 * 256, I_A2 = conv ? 16 * 32 : 32 * 32, I_F1 = 16 * 176, I_F2 = 44 * 32;
    const int NIT = I_A + I_A2 + I_F1 + I_F2;
    for (int it = gw; it < NIT; it += NGW) {
        int r = it;
        if (r < I_A) { if (conv) transpose_item(C.in[8] + (size_t)j * 1024 * 2048, 1024, 2048, WA, 1, 1024, scr, r, C.lane);
                       else transpose_item(C.in[16] + (size_t)j * 1024 * 8192, 1024, 8192, WA, 2, 0, scr, r, C.lane); continue; } r -= I_A;
        if (r < I_A2) { if (conv) transpose_item(C.in[14] + (size_t)j * 1024 * 1024, 1024, 1024, WA2, 0, 0, scr, r, C.lane);
                        else transpose_item(C.in[18] + (size_t)j * 2048 * 1024, 2048, 1024, WA2, 0, 0, scr, r, C.lane); continue; } r -= I_A2;
        if (r < I_F1) { transpose_item(C.in[19] + (size_t)i * 1024 * FF2, 1024, FF2, WF1, 1, DFF, scr, r, C.lane); continue; } r -= I_F1;
        transpose_item(C.in[20] + (size_t)i * DFF * 1024, DFF, 1024, WF2, 0, 0, scr, r, C.lane);
    }
}

__device__ __forceinline__ float row_rs(const float* stats, int row, int fq) {
    const f32x4 p = *(const f32x4*)(stats + (size_t)row * 16 + 4 * fq);
    float s = (p[0] + p[1]) + (p[2] + p[3]);
    s += __shfl_xor(s, 16); s += __shfl_xor(s, 32);
    return 1.0f / sqrtf(s * (1.0f / 1024.0f) + NORM_EPS);
}
struct EpiGLU {
    static constexpr bool STATS = false, NEEDRS = true;
    const float* cvl; const float* cvc; const float* stats; bf16_t* out; int ldo; int act;
    __device__ __forceinline__ float row_begin(int row, int fq) const { return row_rs(stats, row, fq); }
    __device__ __forceinline__ float item(int row, int colp, f32x4 v0, f32x4 v1, float rs) const {
        const float* cv = row < T ? cvl : cvc;
        const f32x4 ca = *(const f32x4*)(cv + colp), cg = *(const f32x4*)(cv + colp + 16);
        float o[4];
#pragma unroll
        for (int e = 0; e < 4; ++e) { const float a = rs * v0[e] + ca[e], g = rs * v1[e] + cg[e]; o[e] = act == 0 ? a * sigmf(g) : siluf(a) * g; }
        const int oc = (colp >> 5) * 16 + (colp & 15);
        u32x2 w; w.x = pk2(o[0], o[1]); w.y = pk2(o[2], o[3]);
        *(u32x2*)(out + (size_t)row * ldo + oc) = w;
        return 0.f;
    }
};
struct EpiRes {
    static constexpr bool STATS = true, NEEDRS = false;
    float* xl; float* xc; const float* mgl; const float* mgc; const float* bias; const float* snl; const float* snc; bf16_t* xs; float* stats;
    __device__ __forceinline__ float row_begin(int, int) const { return 1.f; }
    __device__ __forceinline__ float item(int row, int colp, f32x4 v0, f32x4 v1, float) const {
        const bool lat = row < T;
        float* xr = lat ? xl + (size_t)row * 1024 : xc + (size_t)(row - T) * 1024;
        const float* mg = lat ? mgl : mgc; const float* sn = lat ? snl : snc;
        float ss = 0.f;
#pragma unroll
        for (int hlf = 0; hlf < 2; ++hlf) {
            const int c = colp + 16 * hlf; const f32x4 v = hlf ? v1 : v0;
            const f32x4 xo = *(const f32x4*)(xr + c), m4 = *(const f32x4*)(mg + c);
            f32x4 b4 = {0.f, 0.f, 0.f, 0.f}; if (bias) b4 = *(const f32x4*)(bias + c);
            const f32x4 xn = xo + m4 * (v + b4);
            *(f32x4*)(xr + c) = xn;
            ss += (xn[0] * xn[0] + xn[1] * xn[1]) + (xn[2] * xn[2] + xn[3] * xn[3]);
            if (sn) { const f32x4 s4 = *(const f32x4*)(sn + c); u32x2 w; w.x = pk2(xn[0] * s4[0], xn[1] * s4[1]); w.y = pk2(xn[2] * s4[2], xn[3] * s4[3]);
                *(u32x2*)(xs + (size_t)row * 1024 + c) = w; }
        }
        return ss;
    }
};
struct EpiWin {
    static constexpr bool STATS = false, NEEDRS = true;
    const float* cvl; const float* cvc; const float* stats; const float* tabc; const float* tabs;
    bf16_t* q; bf16_t* k; bf16_t* vt; bf16_t* gf; bf16_t* gb;
    __device__ __forceinline__ float row_begin(int row, int fq) const { return row_rs(stats, row, fq); }
    __device__ __forceinline__ float item(int row, int colp, f32x4 v0, f32x4 v1, float rs) const {
        const float* cv = row < T ? cvl : cvc;
        const f32x4 c0 = *(const f32x4*)(cv + colp), c1 = *(const f32x4*)(cv + colp + 16);
        f32x4 a = v0 * rs + c0, b = v1 * rs + c1;
        if (colp < 2048) {
            if (row < T) {
                const int Gp = (colp >> 5) & 7, idx0 = 16 * (Gp & 3) + (colp & 15);
                const int ti = (Gp >> 2) ? 256 + (row & 63) : (row >> 6);
                const f32x4 cs = *(const f32x4*)(tabc + ti * 64 + idx0), sn = *(const f32x4*)(tabs + ti * 64 + idx0);
                const f32x4 o1 = a * cs - b * sn, o2 = b * cs + a * sn; a = o1; b = o2;
            }
            bf16_t* dst = q;
            if (colp >= 1024) { dst = k; a = a * 0.0625f; b = b * 0.0625f; }
            const int c = colp & 1023;
            u32x2 w; w.x = pk2(a[0], a[1]); w.y = pk2(a[2], a[3]); *(u32x2*)(dst + (size_t)row * 1024 + c) = w;
            w.x = pk2(b[0], b[1]); w.y = pk2(b[2], b[3]); *(u32x2*)(dst + (size_t)row * 1024 + c + 16) = w;
        } else if (colp < 4096) {
            const int c = colp - 2048;
#pragma unroll
            for (int e = 0; e < 4; ++e) { vt[(size_t)(c + e) * R + row] = (bf16_t)(pk2(a[e], 0.f) & 0xffffu); vt[(size_t)(c + 16 + e) * R + row] = (bf16_t)(pk2(b[e], 0.f) & 0xffffu); }
        } else {
            bf16_t* dst = colp < 6144 ? gf : gb; const int c = (colp - 4096) & 2047;
            u32x2 w; w.x = pk2(a[0], a[1]); w.y = pk2(a[2], a[3]); *(u32x2*)(dst + (size_t)row * 2048 + c) = w;
            w.x = pk2(b[0], b[1]); w.y = pk2(b[2], b[3]); *(u32x2*)(dst + (size_t)row * 2048 + c + 16) = w;
        }
        return 0.f;
    }
};

template <class Epi>
__device__ __forceinline__ void sgemm_phase(Ctx& C, const bf16_t* A, const bf16_t* Bt, int Mrows, int N, int K, const Epi& E) {
    const int wr = C.wave >> 2, wc = C.wave & 3, fr = C.lane & 15, fq = C.lane >> 4;
    const int nM = Mrows / 64, nN = N / 256, nU = nM * nN;
    for (int u = C.bid; u < nU; u += C.G) {
        const int un = u / nM, um = u % nM;
        const int row0 = 64 * um + 32 * wr, col0 = 256 * un;
        f32x4 acc[2][2][2];
#pragma unroll
        for (int a = 0; a < 2; ++a)
#pragma unroll
            for (int b = 0; b < 2; ++b)
#pragma unroll
                for (int n = 0; n < 2; ++n) acc[a][b][n] = (f32x4){0.f, 0.f, 0.f, 0.f};
        const bf16_t* ap = A + (size_t)(row0 + fr) * K + 8 * fq;
        const bf16_t* bp = Bt + (size_t)(col0 + 32 * wc + fr) * K + 8 * fq;
#pragma unroll 2
        for (int k0 = 0; k0 < K; k0 += 32) {
            bf16x8 af[2], bf[2][2];
#pragma unroll
            for (int mi = 0; mi < 2; ++mi) af[mi] = *(const bf16x8*)(ap + (size_t)(16 * mi) * K + k0);
#pragma unroll
            for (int bj = 0; bj < 2; ++bj)
#pragma unroll
                for (int n = 0; n < 2; ++n) bf[bj][n] = *(const bf16x8*)(bp + (size_t)(128 * bj + 16 * n) * K + k0);
#pragma unroll
            for (int mi = 0; mi < 2; ++mi)
#pragma unroll
                for (int bj = 0; bj < 2; ++bj)
#pragma unroll
                    for (int n = 0; n < 2; ++n) acc[mi][bj][n] = __builtin_amdgcn_mfma_f32_16x16x32_bf16(bf[bj][n], af[mi], acc[mi][bj][n], 0, 0, 0);
        }
#pragma unroll
        for (int mi = 0; mi < 2; ++mi) {
            const int row = row0 + 16 * mi + fr;
            const float rs = E.row_begin(row, fq);
            float ss = 0.f;
#pragma unroll
            for (int bj = 0; bj < 2; ++bj) ss += E.item(row, col0 + 128 * bj + 32 * wc + 4 * fq, acc[mi][bj][0], acc[mi][bj][1], rs);
            if constexpr (Epi::STATS) { ss += __shfl_xor(ss, 16); ss += __shfl_xor(ss, 32); if (fq == 0) E.stats[(size_t)row * 16 + un * 4 + wc] = ss; }
        }
    }
}

__device__ __forceinline__ void dwconv_phase(Ctx& C, int j) {
    const bf16_t* U = (const bf16_t*)(C.ws + WS_U); bf16_t* A2 = (bf16_t*)(C.ws + WS_A2);
    const float* dww = C.in[10] + (size_t)j * CK * 1024; const float* dwb = C.in[11] + j * 1024; const float* lng = C.in[12] + j * 1024; const float* lnb = C.in[13] + j * 1024;
    LAS unsigned char* tile = C.lds; LAS float* part = (LAS float*)(C.lds + 62 * 2048);
    const int tid = C.tid;
    for (int u = C.bid; u < 520; u += C.G) {
        const int base = u < 512 ? 0 : T, n = u < 512 ? T : TC, t0 = 32 * (u < 512 ? u : u - 512);
        for (int idx = tid; idx < 62 * 128; idx += 512) {
            const int rr = idx >> 7, ch = idx & 127, tt = t0 - 15 + rr;
            u32x4 v = {0u, 0u, 0u, 0u};
            if (tt >= 0 && tt < n) v = *(const u32x4*)(U + (size_t)(base + tt) * 1024 + ch * 8);
            *(LAS u32x4*)(tile + rr * 2048 + ch * 16) = v;
        }
        __syncthreads();
        float o0[32], o1[32];
        { const f32x2 b2 = *(const f32x2*)(dwb + 2 * tid);
#pragma unroll
          for (int t = 0; t < 32; ++t) { o0[t] = b2.x; o1[t] = b2.y; } }
        for (int jt = 0; jt < CK; ++jt) {
            const f32x2 w = *(const f32x2*)(dww + jt * 1024 + 2 * tid);
            const LAS unsigned char* p = tile + jt * 2048 + tid * 4;
#pragma unroll
            for (int t = 0; t < 32; ++t) { const unsigned uu = *(const LAS unsigned*)(p + t * 2048); o0[t] += w.x * bflo(uu); o1[t] += w.y * bfhi(uu); }
        }
#pragma unroll
        for (int t = 0; t < 32; ++t) {
            float s = o0[t] + o1[t], q = o0[t] * o0[t] + o1[t] * o1[t];
#pragma unroll
            for (int off = 1; off < 64; off <<= 1) { s += __shfl_xor(s, off); q += __shfl_xor(q, off); }
            if (C.lane == 0) { part[(t * 8 + C.wave) * 2] = s; part[(t * 8 + C.wave) * 2 + 1] = q; }
        }
        __syncthreads();
        const f32x2 g2 = *(const f32x2*)(lng + 2 * tid), bb2 = *(const f32x2*)(lnb + 2 * tid);
#pragma unroll
        for (int t = 0; t < 32; ++t) {
            float s = 0.f, q = 0.f;
#pragma unroll
            for (int w = 0; w < 8; ++w) { s += part[(t * 8 + w) * 2]; q += part[(t * 8 + w) * 2 + 1]; }
            const float mean = s * (1.f / 1024.f), var = q * (1.f / 1024.f) - mean * mean, rstd = 1.0f / sqrtf(var + LN_EPS);
            const float y0 = (o0[t] - mean) * rstd * g2.x + bb2.x, y1 = (o1[t] - mean) * rstd * g2.y + bb2.y;
            *(unsigned*)(A2 + (size_t)(base + t0 + t) * 1024 + 2 * tid) = pk2(siluf(y0), siluf(y1));
        }
        __syncthreads();
    }
}

__device__ __forceinline__ void scan_phase(Ctx& C, int j) {
    const bf16_t* Kb = (const bf16_t*)(C.ws + WS_K); const bf16_t* Vt = (const bf16_t*)(C.ws + WS_VT); bf16_t* Scp = (bf16_t*)(C.ws + WS_SCP);
    const int fr = C.lane & 15, fq = C.lane >> 4;
    for (int wt = C.bid * 8 + C.wave; wt < 2048; wt += C.G * 8) {
        const int hd = wt >> 8, h = hd >> 1, dir = hd & 1, tile = wt & 255, dk0 = 16 * (tile >> 4), dv0 = 32 * (tile & 15);
        const float gam = 1.0f - exp2f(C.in[17][(j * 2 + dir) * 4 + h]); const float L = log2f(gam);
        float kd[4][8];
#pragma unroll
        for (int ks = 0; ks < 4; ++ks)
#pragma unroll
            for (int e = 0; e < 8; ++e) { const int tl = 32 * ks + 8 * fq + e; kd[ks][e] = exp2f(L * (float)(dir == 0 ? 127 - tl : tl)); }
        const float cdec = exp2f(L * 128.f);
        f32x4 acc[2]; acc[0] = (f32x4){0.f, 0.f, 0.f, 0.f}; acc[1] = acc[0];
        for (int step = 0; step < 130; ++step) {
            int bl, tok0; bool isctx = step < 2;
            if (dir == 0) { bl = isctx ? step : step - 2; } else { bl = isctx ? 1 - step : 127 - (step - 2); }
            tok0 = (isctx ? T : 0) + 128 * bl;
            const bool cp = dir == 0 ? ((bl & 3) == 0) : (isctx ? bl == 1 : (bl & 3) == 3);
            if (cp) {
                const int slot = isctx ? 32 : (bl >> 2);
                bf16_t* sp = Scp + ((size_t)((slot * 4 + h) * 2 + dir) * 512) * 256;
#pragma unroll
                for (int nt = 0; nt < 2; ++nt) { u32x2 w; w.x = pk2(acc[nt][0], acc[nt][1]); w.y = pk2(acc[nt][2], acc[nt][3]);
                    *(u32x2*)(sp + (size_t)(dv0 + 16 * nt + fr) * 256 + dk0 + 4 * fq) = w; }
            }
            bf16x8 af[4], bfr[2][4];
#pragma unroll
            for (int ks = 0; ks < 4; ++ks) {
                const bf16_t* kp = Kb + (size_t)(tok0 + 32 * ks + 8 * fq) * 1024 + h * 256 + dk0 + fr;
                float kv[8];
#pragma unroll
                for (int e = 0; e < 8; ++e) kv[e] = bflo((unsigned)kp[(size_t)e * 1024]) * kd[ks][e];
                u32x4 pk; pk.x = pk2(kv[0], kv[1]); pk.y = pk2(kv[2], kv[3]); pk.z = pk2(kv[4], kv[5]); pk.w = pk2(kv[6], kv[7]);
                af[ks] = __builtin_bit_cast(bf16x8, pk);
#pragma unroll
                for (int nt = 0; nt < 2; ++nt) bfr[nt][ks] = *(const bf16x8*)(Vt + (size_t)(h * 512 + dv0 + 16 * nt + fr) * R + tok0 + 32 * ks + 8 * fq);
            }
            acc[0] = acc[0] * cdec; acc[1] = acc[1] * cdec;
#pragma unroll
            for (int ks = 0; ks < 4; ++ks)
#pragma unroll
                for (int nt = 0; nt < 2; ++nt) acc[nt] = __builtin_amdgcn_mfma_f32_16x16x32_bf16(af[ks], bfr[nt][ks], acc[nt], 0, 0, 0);
        }
    }
}

__device__ __forceinline__ void readout_phase(Ctx& C, int j) {
    const bf16_t* Q = (const bf16_t*)(C.ws + WS_Q); const bf16_t* Kb = (const bf16_t*)(C.ws + WS_K); const bf16_t* Vt = (const bf16_t*)(C.ws + WS_VT);
    const bf16_t* Scp = (const bf16_t*)(C.ws + WS_SCP); bf16_t* GF = (bf16_t*)(C.ws + WS_GF); const bf16_t* GB = (const bf16_t*)(C.ws + WS_GB);
    constexpr int PP = 136;
    LAS bf16_t* P = (LAS bf16_t*)C.lds; LAS float* red = (LAS float*)(C.lds + 64 * PP * 2);
    const int fr = C.lane & 15, fq = C.lane >> 4, w = C.wave;
    for (int u = C.bid; u < 520; u += C.G) {
        const int h = u & 3, b = u >> 2;
        const bool lat = b < 128; const int base = lat ? 0 : T, nb = lat ? 128 : 2, bl = lat ? b : b - 128;
        const int g = bl >> 2, slot = lat ? g : 32;
        const int gend = (4 * (g + 1) < nb ? 4 * (g + 1) : nb);
#pragma unroll 1
        for (int pass = 0; pass < 4; ++pass) {
            const int dir = pass & 1, rh = pass >> 1;
            const int i0 = base + 128 * bl + 64 * rh;
            const int il0 = 128 * bl + 64 * rh;
            const float gam = 1.0f - exp2f(C.in[17][(j * 2 + dir) * 4 + h]); const float L = log2f(gam);
            f32x4 acc[4][4];
#pragma unroll
            for (int mt = 0; mt < 4; ++mt)
#pragma unroll
                for (int nt = 0; nt < 4; ++nt) acc[mt][nt] = (f32x4){0.f, 0.f, 0.f, 0.f};
            const bf16_t* sb = Scp + ((size_t)((slot * 4 + h) * 2 + dir) * 512) * 256;
            const bf16_t* qb = Q + (size_t)(i0 + fr) * 1024 + h * 256 + 8 * fq;
#pragma unroll 1
            for (int ks = 0; ks < 8; ++ks) {
                bf16x8 sf[4];
#pragma unroll
                for (int nt = 0; nt < 4; ++nt) sf[nt] = *(const bf16x8*)(sb + (size_t)(64 * w + 16 * nt + fr) * 256 + 32 * ks + 8 * fq);
#pragma unroll
                for (int mt = 0; mt < 4; ++mt) { const bf16x8 qf = *(const bf16x8*)(qb + (size_t)(16 * mt) * 1024 + 32 * ks);
#pragma unroll
                    for (int nt = 0; nt < 4; ++nt) acc[mt][nt] = __builtin_amdgcn_mfma_f32_16x16x32_bf16(sf[nt], qf, acc[mt][nt], 0, 0, 0); }
            }
#pragma unroll
            for (int mt = 0; mt < 4; ++mt) {
                const int il = il0 + 16 * mt + fr;
                const int ex = dir == 0 ? il - 512 * g + 1 : gend * 128 - il;
                const float qd = exp2f(L * (float)ex);
#pragma unroll
                for (int nt = 0; nt < 4; ++nt) acc[mt][nt] = acc[mt][nt] * qd;
            }
            const int kb_lo = dir == 0 ? 4 * g : bl, kb_hi = dir == 0 ? bl : gend - 1;
#pragma unroll 1
            for (int kb = kb_lo; kb <= kb_hi; ++kb) {
                const int j0 = base + 128 * kb;
                {
                    const int mtw = w >> 1, kh = w & 1;
                    const bf16_t* q1 = Q + (size_t)(i0 + 16 * mtw + fr) * 1024 + h * 256 + 8 * fq;
                    const bf16_t* k1 = Kb + (size_t)(j0 + 64 * kh + fr) * 1024 + h * 256 + 8 * fq;
                    const int il = il0 + 16 * mtw + fr;
                    f32x4 sc[4];
#pragma unroll
                    for (int nt = 0; nt < 4; ++nt) sc[nt] = (f32x4){0.f, 0.f, 0.f, 0.f};
#pragma unroll 1
                    for (int ks = 0; ks < 8; ++ks) {
                        const bf16x8 qf = *(const bf16x8*)(q1 + 32 * ks);
#pragma unroll
                        for (int nt = 0; nt < 4; ++nt) { const bf16x8 kf = *(const bf16x8*)(k1 + (size_t)(16 * nt) * 1024 + 32 * ks);
                            sc[nt] = __builtin_amdgcn_mfma_f32_16x16x32_bf16(kf, qf, sc[nt], 0, 0, 0); }
                    }
#pragma unroll
                    for (int nt = 0; nt < 4; ++nt) {
                        float p[4];
#pragma unroll
                        for (int e = 0; e < 4; ++e) { const int jl = 128 * kb + 64 * kh + 16 * nt + 4 * fq + e; const int rel = dir == 0 ? il - jl : jl - il;
                            p[e] = rel >= 0 ? sc[nt][e] * exp2f(L * (float)rel) : 0.f; }
                        u32x2 wv; wv.x = pk2(p[0], p[1]); wv.y = pk2(p[2], p[3]);
                        *(LAS u32x2*)(P + (16 * mtw + fr) * PP + 64 * kh + 16 * nt + 4 * fq) = wv;
                    }
                }
                __syncthreads();
                const bf16_t* vb = Vt + (size_t)(h * 512 + 64 * w + fr) * R + j0 + 8 * fq;
#pragma unroll 1
                for (int ks = 0; ks < 4; ++ks) {
                    bf16x8 vf[4];
#pragma unroll
                    for (int nt = 0; nt < 4; ++nt) vf[nt] = *(const bf16x8*)(vb + (size_t)(16 * nt) * R + 32 * ks);
#pragma unroll
                    for (int mt = 0; mt < 4; ++mt) { const bf16x8 pf = *(const LAS bf16x8*)(P + (16 * mt + fr) * PP + 32 * ks + 8 * fq);
#pragma unroll
                        for (int nt = 0; nt < 4; ++nt) acc[mt][nt] = __builtin_amdgcn_mfma_f32_16x16x32_bf16(vf[nt], pf, acc[mt][nt], 0, 0, 0); }
                }
                __syncthreads();
            }
#pragma unroll
            for (int mt = 0; mt < 4; ++mt) {
                float ss = 0.f;
#pragma unroll
                for (int nt = 0; nt < 4; ++nt) ss += (acc[mt][nt][0] * acc[mt][nt][0] + acc[mt][nt][1] * acc[mt][nt][1]) + (acc[mt][nt][2] * acc[mt][nt][2] + acc[mt][nt][3] * acc[mt][nt][3]);
                ss += __shfl_xor(ss, 16); ss += __shfl_xor(ss, 32);
                if (fq == 0) red[(16 * mt + fr) * 8 + w] = ss;
            }
            __syncthreads();
#pragma unroll
            for (int mt = 0; mt < 4; ++mt) {
                float tot = 0.f;
#pragma unroll
                for (int w2 = 0; w2 < 8; ++w2) tot += red[(16 * mt + fr) * 8 + w2];
                const float rn = 1.0f / sqrtf(tot * (1.f / 512.f) + NORM_EPS);
                const size_t off = (size_t)(i0 + 16 * mt + fr) * 2048 + h * 512 + 64 * w + 4 * fq;
#pragma unroll
                for (int nt = 0; nt < 4; ++nt) {
                    const u32x2 gg = *(const u32x2*)((dir == 0 ? (const bf16_t*)GF : GB) + off + 16 * nt);
                    float y0 = siluf(bflo(gg.x)) * acc[mt][nt][0] * rn, y1 = siluf(bfhi(gg.x)) * acc[mt][nt][1] * rn;
                    float y2 = siluf(bflo(gg.y)) * acc[mt][nt][2] * rn, y3 = siluf(bfhi(gg.y)) * acc[mt][nt][3] * rn;
                    if (dir == 1) { const u32x2 yp = *(const u32x2*)(GF + off + 16 * nt); y0 += bflo(yp.x); y1 += bfhi(yp.x); y2 += bflo(yp.y); y3 += bfhi(yp.y); }
                    u32x2 wv; wv.x = pk2(y0, y1); wv.y = pk2(y2, y3);
                    *(u32x2*)(GF + off + 16 * nt) = wv;
                }
            }
            __syncthreads();
        }
    }
}

__device__ __forceinline__ void phase_p0(Ctx& C) {
    float* modv = (float*)(C.ws + WS_MODV);
    for (int u = C.bid; u < 384; u += C.G) {
        const int i = u / 96, nbk = u % 96;
        gemv2_unit<1>(C, C.in[4] + (size_t)i * 1024 * 6144, 6144, 64 * nbk, C.in[1], C.in[3], C.in[5] + i * 6144, modv + (i * 2 + 0) * 6144, modv + (i * 2 + 1) * 6144, 0, 0);
    }
    float* tabc = (float*)(C.ws + WS_TABC); float* tabs = (float*)(C.ws + WS_TABS);
    for (int idx = C.bid * 512 + C.tid; idx < 320 * 64; idx += C.G * 512) {
        const int ti = idx >> 6, i = idx & 63; const float pos = (float)(ti < 256 ? ti : ti - 256);
        const float inv = exp2f(-(float)i * (13.287712379549449f / 64.0f)); const float ang = pos * inv;
        tabc[idx] = __cosf(ang); tabs[idx] = __sinf(ang);
    }
}
__device__ __forceinline__ void phase_p1(Ctx& C) {
    const float* modv = (const float*)(C.ws + WS_MODV);
    float* s1 = (float*)(C.ws + WS_S1); float* s2 = (float*)(C.ws + WS_S2);
    for (int idx = C.bid * 512 + C.tid; idx < 8192; idx += C.G * 512) {
        const int i = idx >> 11, s = (idx >> 10) & 1, k = idx & 1023;
        s1[idx] = C.in[6][i * 1024 + k] * (1.f + modv[(i * 2 + s) * 6144 + 1024 + k]);
        s2[idx] = C.in[7][i * 1024 + k] * (1.f + modv[(i * 2 + s) * 6144 + 4096 + k]);
    }
    float* cvA = (float*)(C.ws + WS_CVA); float* cvF = (float*)(C.ws + WS_CVF);
    for (int u = C.bid; u < 672; u += C.G) {
        if (u < 320) {
            int i, nbk; if (u < 32) { i = 0; nbk = u; } else if (u < 160) { i = 1; nbk = u - 32; } else if (u < 192) { i = 2; nbk = u - 160; } else { i = 3; nbk = u - 192; }
            const int j = i >> 1; const float* v0 = modv + (i * 2 + 0) * 6144; const float* v1 = modv + (i * 2 + 1) * 6144;
            if ((i & 1) == 0) gemv2_unit<0>(C, C.in[8] + (size_t)j * 1024 * 2048, 2048, 64 * nbk, v0, v1, C.in[9] + j * 2048, cvA + (i * 2) * 8192, cvA + (i * 2 + 1) * 8192, 1, 1024);
            else gemv2_unit<0>(C, C.in[16] + (size_t)j * 1024 * 8192, 8192, 64 * nbk, v0, v1, nullptr, cvA + (i * 2) * 8192, cvA + (i * 2 + 1) * 8192, 2, 0);
        } else {
            const int i = (u - 320) / 88, nbk = (u - 320) % 88;
            const float* v0 = modv + (i * 2 + 0) * 6144 + 3072; const float* v1 = modv + (i * 2 + 1) * 6144 + 3072;
            gemv2_unit<0>(C, C.in[19] + (size_t)i * 1024 * FF2, FF2, 64 * nbk, v0, v1, nullptr, cvF + (i * 2) * FF2, cvF + (i * 2 + 1) * FF2, 1, DFF);
        }
    }
    bf16_t* xs = (bf16_t*)(C.ws + WS_XS); float* stats = (float*)(C.ws + WS_STATS); float* xctx = (float*)(C.ws + WS_XCTX);
    for (int row = C.bid * 8 + C.wave; row < R; row += C.G * 8) {
        const bool lat = row < T; const int s = lat ? 0 : 1;
        const float* src = lat ? C.in[0] + (size_t)row * 1024 : C.in[2] + (size_t)(row - T) * 1024;
        float* dst = lat ? C.out + (size_t)row * 1024 : xctx + (size_t)(row - T) * 1024;
        float ss = 0.f;
#pragma unroll
        for (int jj = 0; jj < 4; ++jj) {
            const int k = 4 * C.lane + 256 * jj;
            const f32x4 v = *(const f32x4*)(src + k); *(f32x4*)(dst + k) = v;
            ss += (v[0] * v[0] + v[1] * v[1]) + (v[2] * v[2] + v[3] * v[3]);
            const f32x4 g = *(const f32x4*)(C.in[6] + k), m = *(const f32x4*)(modv + s * 6144 + 1024 + k);
            u32x2 w; w.x = pk2(v[0] * g[0] * (1.f + m[0]), v[1] * g[1] * (1.f + m[1])); w.y = pk2(v[2] * g[2] * (1.f + m[2]), v[3] * g[3] * (1.f + m[3]));
            *(u32x2*)(xs + (size_t)row * 1024 + k) = w;
        }
#pragma unroll
        for (int off = 1; off < 64; off <<= 1) ss += __shfl_xor(ss, off);
        if (C.lane < 16) stats[(size_t)row * 16 + C.lane] = C.lane == 0 ? ss : 0.f;
    }
    prep_layer(C, 0);
}
__device__ __forceinline__ void phase_final(Ctx& C) {
    const float* stats = (const float*)(C.ws + WS_STATS);
    for (int row = C.bid * 8 + C.wave; row < T; row += C.G * 8) {
        float s = C.lane < 16 ? stats[(size_t)row * 16 + C.lane] : 0.f;
#pragma unroll
        for (int off = 1; off < 64; off <<= 1) s += __shfl_xor(s, off);
        const float r = 1.0f / sqrtf(s * (1.f / 1024.f) + NORM_EPS);
        float* xr = C.out + (size_t)row * 1024;
#pragma unroll
        for (int jj = 0; jj < 4; ++jj) { const int k = 4 * C.lane + 256 * jj; const f32x4 v = *(const f32x4*)(xr + k), g = *(const f32x4*)(C.in[21] + k); *(f32x4*)(xr + k) = v * r * g; }
    }
}

constexpr int NPHASE = 31;
__device__ __forceinline__ void run_phase(Ctx& C, int ph) {
    const int i = (ph - 2) / 7, sub = (ph - 2) % 7, j = i >> 1; const bool conv = (i & 1) == 0;
    const float* modv = (const float*)(C.ws + WS_MODV); const float* ml = modv + (i * 2) * 6144; const float* mc = modv + (i * 2 + 1) * 6144;
    float* stats = (float*)(C.ws + WS_STATS); bf16_t* xs = (bf16_t*)(C.ws + WS_XS); float* xctx = (float*)(C.ws + WS_XCTX);
    const float* s1 = (const float*)(C.ws + WS_S1); const float* s2 = (const float*)(C.ws + WS_S2);
    const float* cvA = (const float*)(C.ws + WS_CVA) + (size_t)(i * 2) * 8192; const float* cvF = (const float*)(C.ws + WS_CVF) + (size_t)(i * 2) * FF2;
    const bf16_t* WA = (const bf16_t*)(C.ws + WS_WA); const bf16_t* WA2 = (const bf16_t*)(C.ws + WS_WA2); const bf16_t* WF1 = (const bf16_t*)(C.ws + WS_WF1); const bf16_t* WF2 = (const bf16_t*)(C.ws + WS_WF2);
    switch (sub) {
    case 1:
        if (conv) { EpiGLU E{cvA, cvA + 8192, stats, (bf16_t*)(C.ws + WS_U), 1024, 0}; sgemm_phase(C, xs, WA, R, 2048, 1024, E); }
        else { EpiWin E{cvA, cvA + 8192, stats, (const float*)(C.ws + WS_TABC), (const float*)(C.ws + WS_TABS), (bf16_t*)(C.ws + WS_Q), (bf16_t*)(C.ws + WS_K), (bf16_t*)(C.ws + WS_VT), (bf16_t*)(C.ws + WS_GF), (bf16_t*)(C.ws + WS_GB)};
               sgemm_phase(C, xs, WA, R, 8192, 1024, E); }
        break;
    case 4:
        if (conv) { EpiRes E{C.out, xctx, ml + 2048, mc + 2048, C.in[15] + j * 1024, s2 + (i * 2) * 1024, s2 + (i * 2 + 1) * 1024, xs, stats}; sgemm_phase(C, (const bf16_t*)(C.ws + WS_A2), WA2, R, 1024, 1024, E); }
        else { EpiRes E{C.out, xctx, ml + 2048, mc + 2048, nullptr, s2 + (i * 2) * 1024, s2 + (i * 2 + 1) * 1024, xs, stats}; sgemm_phase(C, (const bf16_t*)(C.ws + WS_GF), WA2, R, 1024, 2048, E); }
        break;
    case 5: { EpiGLU E{cvF, cvF + FF2, stats, (bf16_t*)(C.ws + WS_H), DFF, 1}; sgemm_phase(C, xs, WF1, R, FF2, 1024, E); } break;
    case 6: { const bool last = i == DEPTH - 1;
              EpiRes E{C.out, xctx, ml + 5120, mc + 5120, nullptr, last ? nullptr : s1 + ((i + 1) * 2) * 1024, last ? nullptr : s1 + ((i + 1) * 2 + 1) * 1024, xs, stats};
              sgemm_phase(C, (const bf16_t*)(C.ws + WS_H), WF2, R, 1024, DFF, E); } break;
    }
}

#define XB_TMO      128
#define XB_XCNT(j)  (256  + 64 * (j))
#define XB_XSUB(j)  (1280 + 64 * (j))
#define XB_XGEN(j)  (2304 + 64 * (j))
#define XB_TOP      3328
#define XB_TOPGEN   3392
#define XCD_BAR_WORDS 3456
#define XB_SPIN_CAP (1u << 20)
__device__ __forceinline__ unsigned xb_ld(unsigned* p)              { return __hip_atomic_load(p, __ATOMIC_RELAXED, __HIP_MEMORY_SCOPE_AGENT); }
__device__ __forceinline__ unsigned xb_add(unsigned* p, unsigned v) { return __hip_atomic_fetch_add(p, v, __ATOMIC_RELAXED, __HIP_MEMORY_SCOPE_AGENT); }
__device__ __forceinline__ unsigned xb_xcc_id() { return (unsigned)__builtin_amdgcn_s_getreg((3 << 11) | 20) & 0xFu; }
#define XB_SPIN(cond, bar) do { unsigned _sp = 0; while (cond) { __builtin_amdgcn_s_sleep(1); \
    if ((++_sp & 255u) == 0u) { if (xb_ld(&(bar)[XB_TMO])) break; if (_sp > XB_SPIN_CAP) { atomicAdd(&(bar)[XB_TMO], 1u); break; } } } } while (0)
struct XcdBarrier { unsigned* bar; unsigned x; volatile LAS unsigned* st; };
__device__ __forceinline__ XcdBarrier xcd_barrier_post(unsigned* bar, volatile LAS unsigned* st) {
    XcdBarrier b; b.bar = bar; b.x = xb_xcc_id(); b.st = st;
    if (threadIdx.x == 0) (void)xb_add(&bar[XB_XCNT(b.x)], 1u);
    return b;
}
__device__ __forceinline__ void xcd_barrier_complete(unsigned* bar, unsigned x, unsigned& nloc, unsigned& nx) {
    const unsigned G = gridDim.x * gridDim.y * gridDim.z;
    unsigned sum, cnt, mine, sp = 0u;
    for (;;) {
        sum = 0u; cnt = 0u; mine = 0u;
#pragma unroll
        for (unsigned j = 0; j < 16; ++j) { const unsigned c = xb_ld(&bar[XB_XCNT(j)]); sum += c; cnt += (c > 0u) ? 1u : 0u; mine = (j == x) ? c : mine; }
        if (sum == G) break;
        __builtin_amdgcn_s_sleep(1);
        if ((++sp & 255u) == 0u) { if (xb_ld(&bar[XB_TMO])) break; if (sp > XB_SPIN_CAP) { atomicAdd(&bar[XB_TMO], 1u); break; } }
    }
    nloc = mine > 0u ? mine : 1u; nx = cnt > 0u ? cnt : 1u;
}
__device__ __forceinline__ void xcd_barrier(const XcdBarrier& b) {
    asm volatile("s_waitcnt vmcnt(0)" ::: "memory");
    __syncthreads();
    if (threadIdx.x == 0) {
        unsigned* bar = b.bar;
        __builtin_amdgcn_s_waitcnt(0);
        unsigned nloc = b.st[0], nx = b.st[1];
        if (nloc == 0u) { xcd_barrier_complete(bar, b.x, nloc, nx); b.st[0] = nloc; b.st[1] = nx; }
        const unsigned old = xb_add(&bar[XB_XSUB(b.x)], 1u);
        const unsigned gen = old / nloc;
        if (old + 1u == (gen + 1u) * nloc) {
            __builtin_amdgcn_fence(__ATOMIC_RELEASE, "agent");
            asm volatile("s_waitcnt vmcnt(0)" ::: "memory");
            const unsigned og = xb_add(&bar[XB_TOP], 1u);
            const unsigned tg = og / nx;
            if (og + 1u == (tg + 1u) * nx) xb_add(&bar[XB_TOPGEN], 1u);
            else XB_SPIN(xb_ld(&bar[XB_TOPGEN]) == tg, bar);
            __builtin_amdgcn_fence(__ATOMIC_ACQUIRE, "agent");
            xb_add(&bar[XB_XGEN(b.x)], 1u);
            asm volatile("s_waitcnt vmcnt(0)" ::: "memory");
        } else {
            XB_SPIN(xb_ld(&bar[XB_XGEN(b.x)]) == gen, bar);
            __builtin_amdgcn_fence(__ATOMIC_ACQUIRE, "agent");
            asm volatile("s_waitcnt vmcnt(0)" ::: "memory");
        }
    }
    __syncthreads();
}
constexpr int MISC_OFF = 131072 + 320;
constexpr int CW_BAR = 4096;

__device__ __forceinline__ bool phase_exists(int ph) {
    if (ph < 2 || ph == 30) return true;
    const int i = (ph - 2) / 7, sub = (ph - 2) % 7;
    if (sub == 0 && i == 0) return false;
    if (sub == 3 && (i & 1) == 0) return false;
    return true;
}
__global__ void __launch_bounds__(512, 2) mega_kernel(Args args) {
    extern __shared__ __attribute__((aligned(16))) unsigned char lds_raw[];
    Ctx C;
    C.lds = (LAS unsigned char*)lds_raw; C.tid = threadIdx.x; C.lane = C.tid & 63; C.wave = __builtin_amdgcn_readfirstlane(C.tid >> 6); C.G = gridDim.x; C.bid = blockIdx.x;
    C.in = args.in; C.out = args.out; C.ws = args.ws;
    volatile LAS unsigned* MISC = (volatile LAS unsigned*)(C.lds + MISC_OFF);
    if (C.tid < 32) MISC[C.tid] = 0u;
    __syncthreads();
    XcdBarrier bar = xcd_barrier_post((unsigned*)(C.ws + WS_CTL) + CW_BAR, MISC + 8);
    bool first = true;
#pragma unroll 1
    for (int ph = args.ph_lo; ph < args.ph_hi; ++ph) {
        if (!phase_exists(ph)) continue;
        if (!first) xcd_barrier(bar);
        first = false;
        { int t = threadIdx.x; asm volatile("" : "+v"(t)); C.tid = t; C.lane = t & 63; C.wave = __builtin_amdgcn_readfirstlane(t >> 6); }
        { int b = blockIdx.x; asm volatile("" : "+s"(b)); C.bid = b; int g = gridDim.x; asm volatile("" : "+s"(g)); C.G = g; }
        { unsigned long long w = (unsigned long long)args.ws; asm volatile("" : "+s"(w)); C.ws = (unsigned char*)w; unsigned long long o = (unsigned long long)args.out; asm volatile("" : "+s"(o)); C.out = (float*)o; }
        if (ph == 0) phase_p0(C);
        else if (ph == 1) phase_p1(C);
        else if (ph == 30) phase_final(C);
        else {
            const int i = (ph - 2) / 7, sub = (ph - 2) % 7, j = i >> 1; const bool conv = (i & 1) == 0;
            if (sub == 0) prep_layer(C, i);
            else if (sub == 2) {
#ifndef NO_DW
                if (conv) dwconv_phase(C, j);
#endif
#ifndef NO_SCAN
                if (!conv) scan_phase(C, j);
#endif
            }
#ifndef NO_READ
            else if (sub == 3) readout_phase(C, j);
#endif
#ifndef NO_GEMM
            else run_phase(C, ph);
#endif
        }
    }
}

template <int KIND>
__global__ void __launch_bounds__(512, 2) phase_kernel(Args args) {
    extern __shared__ __attribute__((aligned(16))) unsigned char lds_raw[];
    Ctx C;
    C.lds = (LAS unsigned char*)lds_raw; C.tid = threadIdx.x; C.lane = C.tid & 63; C.wave = __builtin_amdgcn_readfirstlane(C.tid >> 6); C.G = gridDim.x; C.bid = blockIdx.x;
    C.in = args.in; C.out = args.out; C.ws = args.ws;
    const int ph = args.ph_lo;
    if (KIND == 0) phase_p0(C);
    else if (KIND == 1) phase_p1(C);
    else if (KIND == 30) phase_final(C);
    else {
        const int i = (ph - 2) / 7, j = i >> 1; const bool conv = (i & 1) == 0;
        if (KIND == 2) prep_layer(C, i);
        else if (KIND == 4) { if (conv) dwconv_phase(C, j); else scan_phase(C, j); }
        else if (KIND == 5) readout_phase(C, j);
        else run_phase(C, ph);
    }
}

extern "C" void kernel_launch(void* const* d_in, const int* in_sizes, int n_in, void* d_out, int out_size, void* d_ws, size_t ws_size, hipStream_t stream) {
    static int grid = 0;
    if (grid == 0) {
        if (n_in != 22 || out_size != T * D || ws_size < WS_END) { fprintf(stderr, "kernel_launch: unexpected problem (n_in %d out %d ws %zu, need %zu)\n", n_in, out_size, ws_size, (size_t)WS_END); grid = -1; return; }
        int dev = 0, cus = 0;
        if (hipGetDevice(&dev) != hipSuccess || hipDeviceGetAttribute(&cus, hipDeviceAttributeMultiprocessorCount, dev) != hipSuccess) { grid = -1; return; }
        bool ok = true;
        ok &= hipFuncSetAttribute((const void*)phase_kernel<0>, hipFuncAttributeMaxDynamicSharedMemorySize, LDS_BYTES) == hipSuccess;
        ok &= hipFuncSetAttribute((const void*)phase_kernel<1>, hipFuncAttributeMaxDynamicSharedMemorySize, LDS_BYTES) == hipSuccess;
        ok &= hipFuncSetAttribute((const void*)phase_kernel<2>, hipFuncAttributeMaxDynamicSharedMemorySize, LDS_BYTES) == hipSuccess;
        ok &= hipFuncSetAttribute((const void*)phase_kernel<3>, hipFuncAttributeMaxDynamicSharedMemorySize, LDS_BYTES) == hipSuccess;
        ok &= hipFuncSetAttribute((const void*)phase_kernel<4>, hipFuncAttributeMaxDynamicSharedMemorySize, LDS_BYTES) == hipSuccess;
        ok &= hipFuncSetAttribute((const void*)phase_kernel<5>, hipFuncAttributeMaxDynamicSharedMemorySize, LDS_BYTES) == hipSuccess;
        ok &= hipFuncSetAttribute((const void*)phase_kernel<30>, hipFuncAttributeMaxDynamicSharedMemorySize, LDS_BYTES) == hipSuccess;
        ok &= hipFuncSetAttribute((const void*)mega_kernel, hipFuncAttributeMaxDynamicSharedMemorySize, LDS_BYTES) == hipSuccess;
        if (!ok) { fprintf(stderr, "kernel_launch: hipFuncSetAttribute failed\n"); grid = -1; return; }
        grid = cus > 0 ? cus : 256;
    }
    if (grid < 0) return;
    Args a{};
    for (int i = 0; i < 22; ++i) a.in[i] = (const float*)d_in[i];
    a.out = (float*)d_out; a.ws = (unsigned char*)d_ws;
#if ONE_LAUNCH
    if (hipMemsetAsync((char*)d_ws + WS_CTL, 0, 65536, stream) != hipSuccess) { fprintf(stderr, "kernel_launch: memset failed\n"); return; }
    a.ph_lo = 0; a.ph_hi = NPHASE;
    hipLaunchKernelGGL(mega_kernel, dim3(grid), dim3(512), LDS_BYTES, stream, a);
    return;
#endif
    for (int ph = 0; ph < NPHASE; ++ph) {
        const int i = (ph - 2) / 7, sub = (ph - 2) % 7;
        if (ph >= 2 && ph < 30) { if (sub == 0 && i == 0) continue; if (sub == 3 && (i & 1) == 0) continue; }
        a.ph_lo = ph; a.ph_hi = ph + 1;
        const dim3 g(grid), b(512);
        if (ph == 0) hipLaunchKernelGGL(phase_kernel<0>, g, b, LDS_BYTES, stream, a);
        else if (ph == 1) hipLaunchKernelGGL(phase_kernel<1>, g, b, LDS_BYTES, stream, a);
        else if (ph == 30) hipLaunchKernelGGL(phase_kernel<30>, g, b, LDS_BYTES, stream, a);
        else if (sub == 0) hipLaunchKernelGGL(phase_kernel<2>, g, b, LDS_BYTES, stream, a);
        else if (sub == 2) hipLaunchKernelGGL(phase_kernel<4>, g, b, LDS_BYTES, stream, a);
        else if (sub == 3) hipLaunchKernelGGL(phase_kernel<5>, g, b, LDS_BYTES, stream, a);
        else hipLaunchKernelGGL(phase_kernel<3>, g, b, LDS_BYTES, stream, a);
    }
}
```

```cpp
#include <hip/hip_runtime.h>
#include <cstdio>
#include <cstdint>
#include <utility>

#ifndef ONE_LAUNCH
#define ONE_LAUNCH 1
#endif

typedef unsigned short bf16_t;
typedef short bf16x8 __attribute__((ext_vector_type(8)));
typedef float f32x4 __attribute__((ext_vector_type(4)));
typedef float f32x2 __attribute__((ext_vector_type(2)));
typedef unsigned u32x2 __attribute__((ext_vector_type(2)));
typedef unsigned u32x4 __attribute__((ext_vector_type(4)));
typedef __bf16 bf16x2_t __attribute__((ext_vector_type(2)));
#define LAS __attribute__((address_space(3)))

constexpr int D = 1024, T = 16384, TC = 256, R = T + TC, NH = 4, DK = 256, DV = 512, QKW = 1024, VW = 2048, INW = 8192, DFF = 2816, FF2 = 5632, CK = 31, DEPTH = 4;
constexpr int NSLOT = 33;
constexpr float NORM_EPS = 1e-6f, LN_EPS = 1e-5f;

constexpr size_t MiB = 1u << 20, KiB = 1u << 10;
constexpr size_t WS_CTL = 0, CTL_ZERO_BYTES = 1 * MiB;
constexpr size_t WS_MODV = 1 * MiB;
constexpr size_t WS_S1 = 1 * MiB + 256 * KiB;
constexpr size_t WS_S2 = 1 * MiB + 320 * KiB;
constexpr size_t WS_CVA = 1 * MiB + 384 * KiB;
constexpr size_t WS_CVF = 1 * MiB + 640 * KiB;
constexpr size_t WS_TABC = 1 * MiB + 832 * KiB;
constexpr size_t WS_TABS = 1 * MiB + 912 * KiB;
constexpr size_t WS_STATS = 2 * MiB;
constexpr size_t WS_XCTX = 4 * MiB;
constexpr size_t WS_WA = 8 * MiB;
constexpr size_t WS_WA2 = 24 * MiB;
constexpr size_t WS_WF1 = 28 * MiB;
constexpr size_t WS_WF2 = 40 * MiB;
constexpr size_t WS_XS = 48 * MiB;
constexpr size_t WS_SCP = 48 * MiB;
constexpr size_t WS_BIG = 114 * MiB;
constexpr size_t WS_Q = WS_BIG, WS_K = WS_BIG + 33 * MiB, WS_VT = WS_BIG + 66 * MiB, WS_GF = WS_BIG + 131 * MiB, WS_GB = WS_BIG + 196 * MiB;
constexpr size_t WS_U = WS_BIG, WS_A2 = WS_BIG + 33 * MiB, WS_H = WS_BIG;
constexpr size_t WS_END = WS_BIG + 261 * MiB;
static_assert((size_t)R * 1024 * 2 <= 33 * MiB && (size_t)R * 2048 * 2 <= 65 * MiB && (size_t)R * DFF * 2 <= 131 * MiB, "map");
static_assert((size_t)NSLOT * 8 * 512 * 256 * 2 <= 66 * MiB, "scp");

constexpr int LDS_BYTES = 147456;

__device__ __forceinline__ unsigned pk2(float lo, float hi) { f32x2 v = {lo, hi}; bf16x2_t b = __builtin_convertvector(v, bf16x2_t); return __builtin_bit_cast(unsigned, b); }
__device__ __forceinline__ float bflo(unsigned u) { return __uint_as_float(u << 16); }
__device__ __forceinline__ float bfhi(unsigned u) { return __uint_as_float(u & 0xffff0000u); }
__device__ __forceinline__ float siluf(float x) { return x / (1.f + __expf(-x)); }
__device__ __forceinline__ float sigmf(float x) { return 1.f / (1.f + __expf(-x)); }
__device__ __forceinline__ int perm_glu(int n, int H) { if (n < H) return 32 * (n >> 4) + (n & 15); const int n2 = n - H; return 32 * (n2 >> 4) + 16 + (n2 & 15); }
__device__ __forceinline__ int perm_win(int n) {
    if (n >= 2 * QKW) return n;
    const int part = n >> 10, hn = n & 1023, h = hn >> 8, d = hn & 255, quarter = d >> 6, idx = d & 63;
    const int Gp = (quarter >> 1) * 4 + (idx >> 4), i = (quarter & 1) * 16 + (idx & 15);
    return part * 1024 + h * 256 + 32 * Gp + i;
}
__device__ __forceinline__ int perm_any(int mode, int n, int H) { return mode == 0 ? n : (mode == 1 ? perm_glu(n, H) : perm_win(n)); }

struct Args { const float* in[22]; float* out; unsigned char* ws; int ph_lo, ph_hi; };

struct Ctx {
    LAS unsigned char* lds;
    int tid, lane, wave, G, bid;
    const float* const* in; float* out; unsigned char* ws;
};

template <int VSILU>
__device__ __forceinline__ void gemv2_unit(Ctx& C, const float* W, int N, int n0, const float* v0, const float* v1, const float* bias, float* o0, float* o1, int pmode, int H) {
    LAS float* red = (LAS float*)C.lds;
    const int c4 = C.tid & 15, ks = C.tid >> 4;
    f32x4 a0 = {0.f, 0.f, 0.f, 0.f}, a1 = {0.f, 0.f, 0.f, 0.f};
#pragma unroll 8
    for (int i = 0; i < 32; ++i) {
        const int k = ks * 32 + i;
        const f32x4 w = *(const f32x4*)(W + (size_t)k * N + n0 + 4 * c4);
        float x0 = v0[k], x1 = v1[k];
        if (VSILU) { x0 = siluf(x0); x1 = siluf(x1); }
        a0 += w * x0; a1 += w * x1;
    }
#pragma unroll
    for (int e = 0; e < 4; ++e) { red[(ks * 2 + 0) * 64 + 4 * c4 + e] = a0[e]; red[(ks * 2 + 1) * 64 + 4 * c4 + e] = a1[e]; }
    __syncthreads();
    if (C.tid < 128) {
        const int s = C.tid >> 6, col = C.tid & 63; float sum = 0.f;
#pragma unroll 8
        for (int k2 = 0; k2 < 32; ++k2) sum += red[(k2 * 2 + s) * 64 + col];
        const int n = n0 + col; if (bias) sum += bias[n];
        (s ? o1 : o0)[perm_any(pmode, n, H)] = sum;
    }
    __syncthreads();
}

__device__ __forceinline__ void transpose_item(const float* W, int K, int N, bf16_t* WT, int pmode, int H, LAS float* scr, int item, int lane) {
    const int nblk = N / 32, kb = item / nblk, nb = item % nblk, k0 = 64 * kb, n0 = 32 * nb;
#pragma unroll 8
    for (int i = 0; i < 32; ++i) { const int kk = 2 * i + (lane >> 5); scr[kk * 33 + (lane & 31)] = W[(size_t)(k0 + kk) * N + n0 + (lane & 31)]; }
    asm volatile("s_waitcnt lgkmcnt(0)" ::: "memory");
    const int c = lane & 7;
#pragma unroll
    for (int j = 0; j < 4; ++j) { const int n = (lane >> 3) + 8 * j; const LAS float* s = scr + (8 * c) * 33 + n;
        u32x4 o; o.x = pk2(s[0 * 33], s[1 * 33]); o.y = pk2(s[2 * 33], s[3 * 33]); o.z = pk2(s[4 * 33], s[5 * 33]); o.w = pk2(s[6 * 33], s[7 * 33]);
        *(u32x4*)(WT + (size_t)perm_any(pmode, n0 + n, H) * K + k0 + 8 * c) = o; }
    asm volatile("s_waitcnt lgkmcnt(0)" ::: "memory");
}
__device__ __forceinline__ void prep_layer(Ctx& C, int i) {
    LAS float* scr = (LAS float*)(C.lds + C.wave * 16384);
    const int gw = C.bid * 8 + C.wave, NGW = C.G * 8, j = i >> 1;
    bf16_t* WA = (bf16_t*)(C.ws + WS_WA); bf16_t* WA2 = (bf16_t*)(C.ws + WS_WA2); bf16_t* WF1 = (bf16_t*)(C.ws + WS_WF1); bf16_t* WF2 = (bf16_t*)(C.ws + WS_WF2);
    const bool conv = (i & 1) == 0;
    const int I_A = conv ? 16 * 64 : 16 * 256, I_A2 = conv ? 16 * 32 : 32 * 32, I_F1 = 16 * 176, I_F2 = 44 * 32;
    const int NIT = I_A + I_A2 + I_F1 + I_F2;
    for (int it = gw; it < NIT; it += NGW) {
        int r = it;
        if (r < I_A) { if (conv) transpose_item(C.in[8] + (size_t)j * 1024 * 2048, 1024, 2048, WA, 1, 1024, scr, r, C.lane);
                       else transpose_item(C.in[16] + (size_t)j * 1024 * 8192, 1024, 8192, WA, 2, 0, scr, r, C.lane); continue; } r -= I_A;
        if (r < I_A2) { if (conv) transpose_item(C.in[14] + (size_t)j * 1024 * 1024, 1024, 1024, WA2, 0, 0, scr, r, C.lane);
                        else transpose_item(C.in[18] + (size_t)j * 2048 * 1024, 2048, 1024, WA2, 0, 0, scr, r, C.lane); continue; } r -= I_A2;
        if (r < I_F1) { transpose_item(C.in[19] + (size_t)i * 1024 * FF2, 1024, FF2, WF1, 1, DFF, scr, r, C.lane); continue; } r -= I_F1;
        transpose_item(C.in[20] + (size_t)i * DFF * 1024, DFF, 1024, WF2, 0, 0, scr, r, C.lane);
    }
}

__device__ __forceinline__ float row_rs(const float* stats, int row, int fq) {
    const f32x4 p = *(const f32x4*)(stats + (size_t)row * 16 + 4 * fq);
    float s = (p[0] + p[1]) + (p[2] + p[3]);
    s += __shfl_xor(s, 16); s += __shfl_xor(s, 32);
    return 1.0f / sqrtf(s * (1.0f / 1024.0f) + NORM_EPS);
}
struct EpiGLU {
    static constexpr bool STATS = false, NEEDRS = true;
    unsigned char* ws; int cvoff  , cvstride  , outoff  , ldo, act;
    float* stats;
    __device__ __forceinline__ float row_begin(int row, int fq) const { return row_rs((const float*)(ws + WS_STATS), row, fq); }
    __device__ __forceinline__ float item(int row, int colp, f32x4 v0, f32x4 v1, float rs) const {
        const float* cv = (const float*)ws + cvoff + (row < T ? 0 : cvstride);
        const f32x4 ca = *(const f32x4*)(cv + colp), cg = *(const f32x4*)(cv + colp + 16);
        float o[4];
#pragma unroll
        for (int e = 0; e < 4; ++e) { const float a = rs * v0[e] + ca[e], g = rs * v1[e] + cg[e]; o[e] = act == 0 ? a * sigmf(g) : siluf(a) * g; }
        const int oc = (colp >> 5) * 16 + (colp & 15);
        u32x2 w; w.x = pk2(o[0], o[1]); w.y = pk2(o[2], o[3]);
        *(u32x2*)((bf16_t*)(ws + outoff) + (size_t)row * ldo + oc) = w;
        return 0.f;
    }
};
struct EpiRes {
    static constexpr bool STATS = true, NEEDRS = false;
    unsigned char* ws; float* xl; const float* bias; int mgoff  , snoff  ;
    float* stats;
    __device__ __forceinline__ float row_begin(int, int) const { return 1.f; }
    __device__ __forceinline__ float item(int row, int colp, f32x4 v0, f32x4 v1, float) const {
        const bool lat = row < T;
        float* xr = lat ? xl + (size_t)row * 1024 : (float*)(ws + WS_XCTX) + (size_t)(row - T) * 1024;
        const float* mg = (const float*)ws + mgoff + (lat ? 0 : 6144); const float* sn = (const float*)ws + snoff + (lat ? 0 : 1024);
        bf16_t* xs = (bf16_t*)(ws + WS_XS);
        float ss = 0.f;
#pragma unroll
        for (int hlf = 0; hlf < 2; ++hlf) {
            const int c = colp + 16 * hlf; const f32x4 v = hlf ? v1 : v0;
            const f32x4 xo = *(const f32x4*)(xr + c), m4 = *(const f32x4*)(mg + c);
            f32x4 b4 = {0.f, 0.f, 0.f, 0.f}; if (bias) b4 = *(const f32x4*)(bias + c);
            const f32x4 xn = xo + m4 * (v + b4);
            *(f32x4*)(xr + c) = xn;
            ss += (xn[0] * xn[0] + xn[1] * xn[1]) + (xn[2] * xn[2] + xn[3] * xn[3]);
            if (snoff >= 0) { const f32x4 s4 = *(const f32x4*)(sn + c); u32x2 w; w.x = pk2(xn[0] * s4[0], xn[1] * s4[1]); w.y = pk2(xn[2] * s4[2], xn[3] * s4[3]);
                *(u32x2*)(xs + (size_t)row * 1024 + c) = w; }
        }
        return ss;
    }
};
struct EpiWin {
    static constexpr bool STATS = false, NEEDRS = true;
    unsigned char* ws; int cvoff;
    float* stats;
    __device__ __forceinline__ float row_begin(int row, int fq) const { return row_rs((const float*)(ws + WS_STATS), row, fq); }
    __device__ __forceinline__ float item(int row, int colp, f32x4 v0, f32x4 v1, float rs) const {
        const float* cv = (const float*)ws + cvoff + (row < T ? 0 : 8192);
        const f32x4 c0 = *(const f32x4*)(cv + colp), c1 = *(const f32x4*)(cv + colp + 16);
        f32x4 a = v0 * rs + c0, b = v1 * rs + c1;
        if (colp < 2048) {
            if (row < T) {
                const int Gp = (colp >> 5) & 7, idx0 = 16 * (Gp & 3) + (colp & 15);
                const int ti = (Gp >> 2) ? 256 + (row & 63) : (row >> 6);
                const f32x4 cs = *(const f32x4*)((const float*)(ws + WS_TABC) + ti * 64 + idx0), sn = *(const f32x4*)((const float*)(ws + WS_TABS) + ti * 64 + idx0);
                const f32x4 o1 = a * cs - b * sn, o2 = b * cs + a * sn; a = o1; b = o2;
            }
            bf16_t* dst = (bf16_t*)(ws + WS_Q);
            if (colp >= 1024) { dst = (bf16_t*)(ws + WS_K); a = a * 0.0625f; b = b * 0.0625f; }
            const int c = colp & 1023;
            u32x2 w; w.x = pk2(a[0], a[1]); w.y = pk2(a[2], a[3]); *(u32x2*)(dst + (size_t)row * 1024 + c) = w;
            w.x = pk2(b[0], b[1]); w.y = pk2(b[2], b[3]); *(u32x2*)(dst + (size_t)row * 1024 + c + 16) = w;
        } else if (colp < 4096) {
            const int c = colp - 2048;
            bf16_t* vt = (bf16_t*)(ws + WS_VT);
#pragma unroll
            for (int e = 0; e < 4; ++e) { vt[(size_t)(c + e) * R + row] = (bf16_t)(pk2(a[e], 0.f) & 0xffffu); vt[(size_t)(c + 16 + e) * R + row] = (bf16_t)(pk2(b[e], 0.f) & 0xffffu); }
        } else {
            bf16_t* dst = (bf16_t*)(ws + (colp < 6144 ? WS_GF : WS_GB)); const int c = (colp - 4096) & 2047;
            u32x2 w; w.x = pk2(a[0], a[1]); w.y = pk2(a[2], a[3]); *(u32x2*)(dst + (size_t)row * 2048 + c) = w;
            w.x = pk2(b[0], b[1]); w.y = pk2(b[2], b[3]); *(u32x2*)(dst + (size_t)row * 2048 + c + 16) = w;
        }
        return 0.f;
    }
};

template <class Epi>
__device__ __forceinline__ void sgemm_small(Ctx& C, const bf16_t* A, const bf16_t* Bt, int row_lo, int Mrows, int N, int K, const Epi& E, int n_lo, int n_hi) {
    const int wr = C.wave >> 2, wc = C.wave & 3, fr = C.lane & 15, fq = C.lane >> 4;
    const int nM = Mrows / 32, nN = n_hi - n_lo, nU = nM * nN;
    for (int u = (C.G - 1 - C.bid); u < nU; u += C.G) {
        const int un = n_lo + u / nM, um = u % nM;
        const int row0 = row_lo + 32 * um + 16 * wr, col0 = 256 * un;
        f32x4 acc[2][2];
#pragma unroll
        for (int b = 0; b < 2; ++b)
#pragma unroll
            for (int n = 0; n < 2; ++n) acc[b][n] = (f32x4){0.f, 0.f, 0.f, 0.f};
        const bf16_t* ap = A + (size_t)(row0 + fr) * K + 8 * fq;
        const bf16_t* bp = Bt + (size_t)(col0 + 32 * wc + fr) * K + 8 * fq;
#pragma unroll 4
        for (int k0 = 0; k0 < K; k0 += 32) {
            bf16x8 bf[2][2];
            const bf16x8 af = *(const bf16x8*)(ap + k0);
#pragma unroll
            for (int bj = 0; bj < 2; ++bj)
#pragma unroll
                for (int n = 0; n < 2; ++n) bf[bj][n] = *(const bf16x8*)(bp + (size_t)(128 * bj + 16 * n) * K + k0);
#pragma unroll
            for (int bj = 0; bj < 2; ++bj)
#pragma unroll
                for (int n = 0; n < 2; ++n) acc[bj][n] = __builtin_amdgcn_mfma_f32_16x16x32_bf16(bf[bj][n], af, acc[bj][n], 0, 0, 0);
        }
        const int row = row0 + fr;
        const float rs = E.row_begin(row, fq);
        float ss = 0.f;
#pragma unroll
        for (int bj = 0; bj < 2; ++bj) ss += E.item(row, col0 + 128 * bj + 32 * wc + 4 * fq, acc[bj][0], acc[bj][1], rs);
        if constexpr (Epi::STATS) { ss += __shfl_xor(ss, 16); ss += __shfl_xor(ss, 32); if (fq == 0) E.stats[(size_t)row * 16 + un * 4 + wc] = ss; }
    }
}

namespace pg8 {
#define PG8_LAS __attribute__((address_space(3)))
typedef unsigned short bf16_t;
typedef short bf16x8 __attribute__((ext_vector_type(8)));
typedef float f32x4 __attribute__((ext_vector_type(4)));
typedef unsigned u32x4 __attribute__((ext_vector_type(4)));
constexpr int BM = 256, BK = 64, HALF = 128, HTB = HALF * BK * 2  , STAGE_BYTES = 8 * HTB, NXCD = 8, WGM = 8;

__host__ __device__ __forceinline__ int lds_byte(int r, int c) { const int st = (r >> 4) * 2 + (c >> 5), rr = r & 15, cc = c & 31, ob = rr * 64 + cc * 2; return st * 1024 + (ob ^ (((ob >> 9) & 1) << 5)); }
__host__ __device__ __forceinline__ void stage_rc(int b, int& R, int& C) { const int st = b / 1024, sb = b % 1024, swz = sb ^ (((sb >> 9) & 1) << 5); R = (st >> 1) * 16 + swz / 64; C = (st & 1) * 32 + (swz % 64) / 2; }
__host__ __device__ __forceinline__ int perm32(int rho) { const int n = rho >> 4, i = rho & 15; return 8 * (i >> 2) + 4 * n + (i & 3); }

struct Unit { int pm, pn; };
struct Gemm { const bf16_t* A; const bf16_t* Bt; int M, N, K; };

struct StaticOrder {
    int nM, nN, nwg, G, c;
    __host__ __device__ void init(int M, int N, int G_, int c_) { nM = M / BM; nN = N / BM; nwg = nM * nN; G = G_; c = c_; }
    __host__ __device__ bool next(int i, Unit& u) const {
        const long L = (long)i * G + c; if (L >= nwg) return false;
        int wgid = (int)L; { const int q = nwg / NXCD, r = nwg % NXCD, xcd = wgid % NXCD, off = wgid / NXCD; wgid = (xcd < r ? xcd * (q + 1) : r * (q + 1) + (xcd - r) * q) + off; }
        const int nig = WGM * nN, gid = wgid / nig, fm = gid * WGM, gsz = (nM - fm) < WGM ? (nM - fm) : WGM;
        u.pm = fm + ((wgid % nig) % gsz); u.pn = (wgid % nig) / gsz; return true;
    }
    __device__ __forceinline__ void a_ready(const Unit&) const {}
    __device__ __forceinline__ void done(const Unit&) const {}
};

template <class Epi, class Sched, bool ALIGN_EPI = false, bool SP2 = false>
__device__ __forceinline__ void gemm_phase(PG8_LAS unsigned char* lds, const Gemm g, const Sched& S, const Epi& E) {
    const int tid = threadIdx.x, wid = __builtin_amdgcn_readfirstlane(tid >> 6), lane = tid & 63, wr = wid >> 2, wc = wid & 3, fr = lane & 15, fq = lane >> 4;
    const int K = g.K, nt = K / BK;
    unsigned voffA[2], voffB[2];
#pragma unroll
    for (int i = 0; i < 2; ++i) { int R, C; stage_rc(tid * 16 + i * 8192, R, C); const int Rb = Epi::PERM ? ((R & ~31) + perm32(R & 31)) : R;
        voffA[i] = (unsigned)(R * K + C) * 2u; voffB[i] = (unsigned)(Rb * K + C) * 2u; }
    const size_t kstep = (size_t)(BK * 2);
    const size_t hstep = (size_t)HALF * K * 2;
    const size_t tstep = 2 * hstep;
    const unsigned ldsw = (unsigned)wid * 1024u;
    const int aoff = lds_byte(wr * 64 + fr, fq * 8), boff = lds_byte(wc * 32 + fr, fq * 8);
#define PG8_SA(b, h) (((b) * 2 + (h)) * HTB)
#define PG8_SB(b, h) ((4 + (b) * 2 + (h)) * HTB)
#define PG8_STAGE(bufoff, gbase, voff) do { _Pragma("unroll") for (int _i = 0; _i < 2; ++_i) \
        __builtin_amdgcn_global_load_lds((const unsigned*)((const char*)(gbase) + (voff)[_i]), (PG8_LAS unsigned*)(lds + (bufoff) + ldsw + _i * 8192), 16, 0, 0); } while (0)
#define PG8_LDA(dst, b, h) do { _Pragma("unroll") for (int m = 0; m < 4; ++m) _Pragma("unroll") for (int k = 0; k < 2; ++k) dst[m][k] = *(const PG8_LAS bf16x8*)(lds + PG8_SA(b, h) + aoff + m * 2048 + k * 1024); } while (0)
#define PG8_LDB(dst, b, h) do { _Pragma("unroll") for (int n = 0; n < 2; ++n) _Pragma("unroll") for (int k = 0; k < 2; ++k) dst[n][k] = *(const PG8_LAS bf16x8*)(lds + PG8_SB(b, h) + boff + n * 2048 + k * 1024); } while (0)
#define PG8_MMA(ai, bj, At, Bt) do { __builtin_amdgcn_s_setprio(1); _Pragma("unroll") for (int m = 0; m < 4; ++m) _Pragma("unroll") for (int n = 0; n < 2; ++n) _Pragma("unroll") for (int k = 0; k < 2; ++k) \
        acc[ai][bj][m][n] = __builtin_amdgcn_mfma_f32_16x16x32_bf16(Bt[n][k], At[m][k], acc[ai][bj][m][n], 0, 0, 0); __builtin_amdgcn_s_setprio(0); } while (0)
#define PG8_WAIT_V(n) asm volatile("s_waitcnt vmcnt(" #n ")" ::: "memory")
#define PG8_WAIT_L(n) asm volatile("s_waitcnt lgkmcnt(" #n ")" ::: "memory")
#define PG8_BAR __builtin_amdgcn_s_barrier()
#define PG8_SCHED __builtin_amdgcn_sched_barrier(0)
    Unit cur, nxt; int ui = 0;
    if (!S.next(0, cur)) return;
    f32x4 acc[2][2][4][2];
#pragma unroll
    for (int a = 0; a < 2; ++a)
#pragma unroll
        for (int b = 0; b < 2; ++b)
#pragma unroll
            for (int m = 0; m < 4; ++m)
#pragma unroll
                for (int n = 0; n < 2; ++n) acc[a][b][m][n] = (f32x4){0.f, 0.f, 0.f, 0.f};
    bf16x8 At[4][2], B0[2][2], B1[2][2];
    const char* cA = (const char*)g.A + (size_t)cur.pm * tstep; const char* cB = (const char*)g.Bt + (size_t)cur.pn * tstep;
    S.a_ready(cur);
    if constexpr (SP2) {
        PG8_STAGE(PG8_SB(0, 0), cB, voffB); PG8_STAGE(PG8_SB(0, 1), cB + hstep, voffB); PG8_STAGE(PG8_SA(0, 0), cA, voffA); PG8_STAGE(PG8_SA(0, 1), cA + hstep, voffA);
        if (wr == 1) PG8_BAR;
        PG8_WAIT_V(2); PG8_BAR;
        PG8_STAGE(PG8_SB(1, 0), cB + kstep, voffB); PG8_STAGE(PG8_SA(1, 0), cA + kstep, voffA); PG8_STAGE(PG8_SB(1, 1), cB + hstep + kstep, voffB);
        PG8_WAIT_V(6); PG8_BAR;
    } else {
        PG8_STAGE(PG8_SB(0, 0), cB, voffB); PG8_STAGE(PG8_SA(0, 0), cA, voffA); PG8_STAGE(PG8_SB(0, 1), cB + hstep, voffB); PG8_STAGE(PG8_SA(0, 1), cA + hstep, voffA);
        if (wr == 1) PG8_BAR;
        PG8_WAIT_V(4); PG8_BAR;
        PG8_STAGE(PG8_SB(1, 0), cB + kstep, voffB); PG8_STAGE(PG8_SA(1, 0), cA + kstep, voffA); PG8_STAGE(PG8_SB(1, 1), cB + hstep + kstep, voffB);
        PG8_WAIT_V(6); PG8_BAR;
    }
    for (;;) {
        const bool has_next = S.next(ui + 1, nxt);
        const char* nA = has_next ? (const char*)g.A + (size_t)nxt.pm * tstep : cA; const char* nB = has_next ? (const char*)g.Bt + (size_t)nxt.pn * tstep : cB;
        for (int t = 0; t < nt; t += 2) {
            const bool last = (t == nt - 2);
            const char* a1 = cA + (size_t)(t + 1) * kstep;
            const char* a2 = last ? nA : cA + (size_t)(t + 2) * kstep; const char* b2 = last ? nB : cB + (size_t)(t + 2) * kstep;
            const char* a3 = a2 + kstep; const char* b3 = b2 + kstep;
            if (last && has_next) S.a_ready(nxt);
            if constexpr (SP2) {
            PG8_LDB(B0, 0, 0); PG8_LDB(B1, 0, 1); PG8_SCHED; PG8_LDA(At, 0, 0); PG8_STAGE(PG8_SA(1, 1), a1 + hstep, voffA);
            PG8_WAIT_V(8); PG8_WAIT_L(0); PG8_BAR; PG8_MMA(0, 0, At, B0); PG8_MMA(0, 1, At, B1); PG8_BAR; PG8_SCHED;
            PG8_LDA(At, 0, 1); PG8_STAGE(PG8_SB(0, 0), b2, voffB); PG8_STAGE(PG8_SB(0, 1), b2 + hstep, voffB); PG8_STAGE(PG8_SA(0, 0), a2, voffA);
            PG8_WAIT_V(8); PG8_WAIT_L(0); PG8_BAR; PG8_MMA(1, 0, At, B0); PG8_MMA(1, 1, At, B1); PG8_BAR; PG8_SCHED;
            PG8_LDB(B0, 1, 0); PG8_LDB(B1, 1, 1); PG8_SCHED; PG8_LDA(At, 1, 0); PG8_STAGE(PG8_SA(0, 1), a2 + hstep, voffA);
            PG8_WAIT_V(8); PG8_WAIT_L(0); PG8_BAR; PG8_MMA(0, 0, At, B0); PG8_MMA(0, 1, At, B1); PG8_BAR; PG8_SCHED;
            PG8_LDA(At, 1, 1); PG8_STAGE(PG8_SB(1, 0), b3, voffB); PG8_STAGE(PG8_SB(1, 1), b3 + hstep, voffB); PG8_STAGE(PG8_SA(1, 0), a3, voffA);
            PG8_WAIT_V(8); PG8_WAIT_L(0); PG8_BAR; PG8_MMA(1, 0, At, B0); PG8_MMA(1, 1, At, B1); PG8_BAR; PG8_SCHED;
            } else {
            PG8_LDB(B0, 0, 0); PG8_SCHED; PG8_LDA(At, 0, 0); PG8_STAGE(PG8_SA(1, 1), a1 + hstep, voffA);
            PG8_WAIT_L(8); PG8_BAR; PG8_WAIT_L(0); PG8_MMA(0, 0, At, B0); PG8_BAR; PG8_SCHED;
            PG8_LDB(B1, 0, 1); PG8_STAGE(PG8_SB(0, 0), b2, voffB);
            PG8_BAR; PG8_WAIT_L(0); PG8_MMA(0, 1, At, B1); PG8_BAR;
            PG8_LDA(At, 0, 1); PG8_STAGE(PG8_SA(0, 0), a2, voffA);
            PG8_BAR; PG8_WAIT_L(0); PG8_MMA(1, 0, At, B0); PG8_BAR; PG8_SCHED;
            PG8_STAGE(PG8_SB(0, 1), b2 + hstep, voffB);
            PG8_WAIT_V(6); PG8_BAR; PG8_MMA(1, 1, At, B1); PG8_BAR;
            PG8_LDB(B0, 1, 0); PG8_SCHED; PG8_LDA(At, 1, 0); PG8_STAGE(PG8_SA(0, 1), a2 + hstep, voffA);
            PG8_WAIT_L(8); PG8_BAR; PG8_WAIT_L(0); PG8_MMA(0, 0, At, B0); PG8_BAR; PG8_SCHED;
            PG8_LDB(B1, 1, 1); PG8_STAGE(PG8_SB(1, 0), b3, voffB);
            PG8_BAR; PG8_WAIT_L(0); PG8_MMA(0, 1, At, B1); PG8_BAR;
            PG8_LDA(At, 1, 1); PG8_STAGE(PG8_SA(1, 0), a3, voffA);
            PG8_BAR; PG8_WAIT_L(0); PG8_MMA(1, 0, At, B0); PG8_BAR; PG8_SCHED;
            PG8_STAGE(PG8_SB(1, 1), b3 + hstep, voffB);
            PG8_WAIT_V(6); PG8_BAR; PG8_MMA(1, 1, At, B1); PG8_BAR;
            }
        }
        if constexpr (ALIGN_EPI) { if (wr == 0) PG8_BAR; }
        if constexpr (!Epi::AFTER_DRAIN) { E(acc, cur, wr, wc, fr, fq); S.done(cur); }
        if (!has_next) break;
#pragma unroll
        for (int a = 0; a < 2; ++a)
#pragma unroll
            for (int b = 0; b < 2; ++b)
#pragma unroll
                for (int m = 0; m < 4; ++m)
#pragma unroll
                    for (int n = 0; n < 2; ++n) acc[a][b][m][n] = (f32x4){0.f, 0.f, 0.f, 0.f};
        cur = nxt; cA = nA; cB = nB; ++ui;
        if constexpr (ALIGN_EPI) { if (wr == 1) PG8_BAR; }
    }
    PG8_WAIT_V(0);
    if constexpr (!ALIGN_EPI) { if (wr == 0) PG8_BAR; }
    PG8_BAR;
    if constexpr (Epi::AFTER_DRAIN) { E.fused(acc, cur, wr, wc, fr, fq, lds, wid, lane); S.done(cur); }
#undef PG8_SA
#undef PG8_SB
#undef PG8_STAGE
#undef PG8_LDA
#undef PG8_LDB
#undef PG8_MMA
#undef PG8_WAIT_V
#undef PG8_WAIT_L
#undef PG8_BAR
#undef PG8_SCHED
}
}

template <class E0> struct EpiAdapt {
    static constexpr bool PERM = false, AFTER_DRAIN = false;
    E0 e;
    __device__ __forceinline__ void operator()(const pg8::f32x4 (&acc)[2][2][4][2], const pg8::Unit& u, int wr, int wc, int fr, int fq) const {
#pragma unroll
        for (int ai = 0; ai < 2; ++ai)
#pragma unroll
            for (int m = 0; m < 4; ++m) {
                const int row = u.pm * 256 + ai * 128 + wr * 64 + m * 16 + fr;
                const float rs = e.row_begin(row, fq);
                float ss = 0.f;
#pragma unroll
                for (int bj = 0; bj < 2; ++bj) ss += e.item(row, u.pn * 256 + bj * 128 + wc * 32 + 4 * fq, acc[ai][bj][m][0], acc[ai][bj][m][1], rs);
                if constexpr (E0::STATS) { ss += __shfl_xor(ss, 16); ss += __shfl_xor(ss, 32); if (fq == 0) e.stats[(size_t)row * 16 + u.pn * 4 + wc] = ss; }
            }
    }
};
template <class E0>
__device__ __forceinline__ void gemm_both(Ctx& C, const bf16_t* A, const bf16_t* Bt, int Mbig, int N, int K, const E0& E, int ctx_n_lo, int ctx_n_hi) {
    { pg8::Gemm g{A, Bt, Mbig, N, K}; pg8::StaticOrder S; S.init(Mbig, N, C.G, C.bid); EpiAdapt<E0> EA{E};
      pg8::gemm_phase<EpiAdapt<E0>, pg8::StaticOrder, true, true>(C.lds, g, S, EA); }
    if (Mbig < R && ctx_n_hi > ctx_n_lo) sgemm_small(C, A, Bt, Mbig, R - Mbig, N, K, E, ctx_n_lo, ctx_n_hi);
}
__device__ __forceinline__ void dwconv_phase(Ctx& C, int j) {
    const bf16_t* U = (const bf16_t*)(C.ws + WS_U); bf16_t* A2 = (bf16_t*)(C.ws + WS_A2);
    const float* dww = C.in[10] + (size_t)j * CK * 1024; const float* dwb = C.in[11] + j * 1024; const float* lng = C.in[12] + j * 1024; const float* lnb = C.in[13] + j * 1024;
    LAS unsigned char* tile = C.lds; LAS float* part = (LAS float*)(C.lds + 62 * 2048);
    const int tid = C.tid;
    for (int u = C.bid; u < 520; u += C.G) {
        const int base = u < 512 ? 0 : T, n = u < 512 ? T : TC, t0 = 32 * (u < 512 ? u : u - 512);
        for (int idx = tid; idx < 62 * 128; idx += 512) {
            const int rr = idx >> 7, ch = idx & 127, tt = t0 - 15 + rr;
            u32x4 v = {0u, 0u, 0u, 0u};
            if (tt >= 0 && tt < n) v = *(const u32x4*)(U + (size_t)(base + tt) * 1024 + ch * 8);
            *(LAS u32x4*)(tile + rr * 2048 + ch * 16) = v;
        }
        __syncthreads();
        float o0[32], o1[32];
        { const f32x2 b2 = *(const f32x2*)(dwb + 2 * tid);
#pragma unroll
          for (int t = 0; t < 32; ++t) { o0[t] = b2.x; o1[t] = b2.y; } }
        for (int jt = 0; jt < CK; ++jt) {
            const f32x2 w = *(const f32x2*)(dww + jt * 1024 + 2 * tid);
            const LAS unsigned char* p = tile + jt * 2048 + tid * 4;
#pragma unroll
            for (int t = 0; t < 32; ++t) { const unsigned uu = *(const LAS unsigned*)(p + t * 2048); o0[t] += w.x * bflo(uu); o1[t] += w.y * bfhi(uu); }
        }
#pragma unroll
        for (int t = 0; t < 32; ++t) {
            float s = o0[t] + o1[t], q = o0[t] * o0[t] + o1[t] * o1[t];
#pragma unroll
            for (int off = 1; off < 64; off <<= 1) { s += __shfl_xor(s, off); q += __shfl_xor(q, off); }
            if (C.lane == 0) { part[(t * 8 + C.wave) * 2] = s; part[(t * 8 + C.wave) * 2 + 1] = q; }
        }
        __syncthreads();
        const f32x2 g2 = *(const f32x2*)(lng + 2 * tid), bb2 = *(const f32x2*)(lnb + 2 * tid);
#pragma unroll
        for (int t = 0; t < 32; ++t) {
            float s = 0.f, q = 0.f;
#pragma unroll
            for (int w = 0; w < 8; ++w) { s += part[(t * 8 + w) * 2]; q += part[(t * 8 + w) * 2 + 1]; }
            const float mean = s * (1.f / 1024.f), var = q * (1.f / 1024.f) - mean * mean, rstd = 1.0f / sqrtf(var + LN_EPS);
            const float y0 = (o0[t] - mean) * rstd * g2.x + bb2.x, y1 = (o1[t] - mean) * rstd * g2.y + bb2.y;
            *(unsigned*)(A2 + (size_t)(base + t0 + t) * 1024 + 2 * tid) = pk2(siluf(y0), siluf(y1));
        }
        __syncthreads();
    }
}

__device__ __forceinline__ void scan_phase(Ctx& C, int j) {
    const bf16_t* Kb = (const bf16_t*)(C.ws + WS_K); const bf16_t* Vt = (const bf16_t*)(C.ws + WS_VT); bf16_t* Scp = (bf16_t*)(C.ws + WS_SCP);
    const int fr = C.lane & 15, fq = C.lane >> 4;
    for (int wt = C.bid * 8 + C.wave; wt < 2048; wt += C.G * 8) {
        const int hd = wt >> 8, h = hd >> 1, dir = hd & 1, tile = wt & 255, dk0 = 16 * (tile >> 4), dv0 = 32 * (tile & 15);
        const float gam = 1.0f - exp2f(C.in[17][(j * 2 + dir) * 4 + h]); const float L = log2f(gam);
        float kd[4][8];
#pragma unroll
        for (int ks = 0; ks < 4; ++ks)
#pragma unroll
            for (int e = 0; e < 8; ++e) { const int tl = 32 * ks + 8 * fq + e; kd[ks][e] = exp2f(L * (float)(dir == 0 ? 127 - tl : tl)); }
        const float cdec = exp2f(L * 128.f);
        f32x4 acc[2]; acc[0] = (f32x4){0.f, 0.f, 0.f, 0.f}; acc[1] = acc[0];
        for (int step = 0; step < 130; ++step) {
            int bl, tok0; bool isctx = step < 2;
            if (dir == 0) { bl = isctx ? step : step - 2; } else { bl = isctx ? 1 - step : 127 - (step - 2); }
            tok0 = (isctx ? T : 0) + 128 * bl;
            const bool cp = dir == 0 ? ((bl & 3) == 0) : (isctx ? bl == 1 : (bl & 3) == 3);
            if (cp) {
                const int slot = isctx ? 32 : (bl >> 2);
                bf16_t* sp = Scp + ((size_t)((slot * 4 + h) * 2 + dir) * 512) * 256;
#pragma unroll
                for (int nt = 0; nt < 2; ++nt) { u32x2 w; w.x = pk2(acc[nt][0], acc[nt][1]); w.y = pk2(acc[nt][2], acc[nt][3]);
                    *(u32x2*)(sp + (size_t)(dv0 + 16 * nt + fr) * 256 + dk0 + 4 * fq) = w; }
            }
            bf16x8 af[4], bfr[2][4];
#pragma unroll
            for (int ks = 0; ks < 4; ++ks) {
                const bf16_t* kp = Kb + (size_t)(tok0 + 32 * ks + 8 * fq) * 1024 + h * 256 + dk0 + fr;
                float kv[8];
#pragma unroll
                for (int e = 0; e < 8; ++e) kv[e] = bflo((unsigned)kp[(size_t)e * 1024]) * kd[ks][e];
                u32x4 pk; pk.x = pk2(kv[0], kv[1]); pk.y = pk2(kv[2], kv[3]); pk.z = pk2(kv[4], kv[5]); pk.w = pk2(kv[6], kv[7]);
                af[ks] = __builtin_bit_cast(bf16x8, pk);
#pragma unroll
                for (int nt = 0; nt < 2; ++nt) bfr[nt][ks] = *(const bf16x8*)(Vt + (size_t)(h * 512 + dv0 + 16 * nt + fr) * R + tok0 + 32 * ks + 8 * fq);
            }
            acc[0] = acc[0] * cdec; acc[1] = acc[1] * cdec;
#pragma unroll
            for (int ks = 0; ks < 4; ++ks)
#pragma unroll
                for (int nt = 0; nt < 2; ++nt) acc[nt] = __builtin_amdgcn_mfma_f32_16x16x32_bf16(af[ks], bfr[nt][ks], acc[nt], 0, 0, 0);
        }
    }
}

__device__ __forceinline__ void readout_phase(Ctx& C, int j, bool skip_ctx) {
    const bf16_t* Q = (const bf16_t*)(C.ws + WS_Q); const bf16_t* Kb = (const bf16_t*)(C.ws + WS_K); const bf16_t* Vt = (const bf16_t*)(C.ws + WS_VT);
    const bf16_t* Scp = (const bf16_t*)(C.ws + WS_SCP); bf16_t* GF = (bf16_t*)(C.ws + WS_GF); const bf16_t* GB = (const bf16_t*)(C.ws + WS_GB);
    constexpr int PP = 136;
    LAS bf16_t* P = (LAS bf16_t*)C.lds; LAS float* red = (LAS float*)(C.lds + 64 * PP * 2);
    const int fr = C.lane & 15, fq = C.lane >> 4, w = C.wave;
    const int nunits = skip_ctx ? 512 : 520;
    for (int u = C.bid; u < nunits; u += C.G) {
        const int h = u & 3, b = u >> 2;
        const bool lat = b < 128; const int base = lat ? 0 : T, nb = lat ? 128 : 2, bl = lat ? b : b - 128;
        const int g = bl >> 2, slot = lat ? g : 32;
        const int gend = (4 * (g + 1) < nb ? 4 * (g + 1) : nb);
#pragma unroll 1
        for (int pass = 0; pass < 4; ++pass) {
            const int dir = pass & 1, rh = pass >> 1;
            const int i0 = base + 128 * bl + 64 * rh;
            const int il0 = 128 * bl + 64 * rh;
            const float gam = 1.0f - exp2f(C.in[17][(j * 2 + dir) * 4 + h]); const float L = log2f(gam);
            f32x4 acc[4][4];
#pragma unroll
            for (int mt = 0; mt < 4; ++mt)
#pragma unroll
                for (int nt = 0; nt < 4; ++nt) acc[mt][nt] = (f32x4){0.f, 0.f, 0.f, 0.f};
            const bf16_t* sb = Scp + ((size_t)((slot * 4 + h) * 2 + dir) * 512) * 256;
            const bf16_t* qb = Q + (size_t)(i0 + fr) * 1024 + h * 256 + 8 * fq;
#pragma unroll 1
            for (int ks = 0; ks < 8; ++ks) {
                bf16x8 sf[4];
#pragma unroll
                for (int nt = 0; nt < 4; ++nt) sf[nt] = *(const bf16x8*)(sb + (size_t)(64 * w + 16 * nt + fr) * 256 + 32 * ks + 8 * fq);
#pragma unroll
                for (int mt = 0; mt < 4; ++mt) { const bf16x8 qf = *(const bf16x8*)(qb + (size_t)(16 * mt) * 1024 + 32 * ks);
#pragma unroll
                    for (int nt = 0; nt < 4; ++nt) acc[mt][nt] = __builtin_amdgcn_mfma_f32_16x16x32_bf16(sf[nt], qf, acc[mt][nt], 0, 0, 0); }
            }
#pragma unroll
            for (int mt = 0; mt < 4; ++mt) {
                const int il = il0 + 16 * mt + fr;
                const int ex = dir == 0 ? il - 512 * g + 1 : gend * 128 - il;
                const float qd = exp2f(L * (float)ex);
#pragma unroll
                for (int nt = 0; nt < 4; ++nt) acc[mt][nt] = acc[mt][nt] * qd;
            }
            const int kb_lo = dir == 0 ? 4 * g : bl, kb_hi = dir == 0 ? bl : gend - 1;
#pragma unroll 1
            for (int kb = kb_lo; kb <= kb_hi; ++kb) {
                const int j0 = base + 128 * kb;
                {
                    const int mtw = w >> 1, kh = w & 1;
                    const bf16_t* q1 = Q + (size_t)(i0 + 16 * mtw + fr) * 1024 + h * 256 + 8 * fq;
                    const bf16_t* k1 = Kb + (size_t)(j0 + 64 * kh + fr) * 1024 + h * 256 + 8 * fq;
                    const int il = il0 + 16 * mtw + fr;
                    f32x4 sc[4];
#pragma unroll
                    for (int nt = 0; nt < 4; ++nt) sc[nt] = (f32x4){0.f, 0.f, 0.f, 0.f};
#pragma unroll 1
                    for (int ks = 0; ks < 8; ++ks) {
                        const bf16x8 qf = *(const bf16x8*)(q1 + 32 * ks);
#pragma unroll
                        for (int nt = 0; nt < 4; ++nt) { const bf16x8 kf = *(const bf16x8*)(k1 + (size_t)(16 * nt) * 1024 + 32 * ks);
                            sc[nt] = __builtin_amdgcn_mfma_f32_16x16x32_bf16(kf, qf, sc[nt], 0, 0, 0); }
                    }
#pragma unroll
                    for (int nt = 0; nt < 4; ++nt) {
                        float p[4];
#pragma unroll
                        for (int e = 0; e < 4; ++e) { const int jl = 128 * kb + 64 * kh + 16 * nt + 4 * fq + e; const int rel = dir == 0 ? il - jl : jl - il;
                            p[e] = rel >= 0 ? sc[nt][e] * exp2f(L * (float)rel) : 0.f; }
                        u32x2 wv; wv.x = pk2(p[0], p[1]); wv.y = pk2(p[2], p[3]);
                        *(LAS u32x2*)(P + (16 * mtw + fr) * PP + 64 * kh + 16 * nt + 4 * fq) = wv;
                    }
                }
                __syncthreads();
                const bf16_t* vb = Vt + (size_t)(h * 512 + 64 * w + fr) * R + j0 + 8 * fq;
#pragma unroll 1
                for (int ks = 0; ks < 4; ++ks) {
                    bf16x8 vf[4];
#pragma unroll
                    for (int nt = 0; nt < 4; ++nt) vf[nt] = *(const bf16x8*)(vb + (size_t)(16 * nt) * R + 32 * ks);
#pragma unroll
                    for (int mt = 0; mt < 4; ++mt) { const bf16x8 pf = *(const LAS bf16x8*)(P + (16 * mt + fr) * PP + 32 * ks + 8 * fq);
#pragma unroll
                        for (int nt = 0; nt < 4; ++nt) acc[mt][nt] = __builtin_amdgcn_mfma_f32_16x16x32_bf16(vf[nt], pf, acc[mt][nt], 0, 0, 0); }
                }
                __syncthreads();
            }
#pragma unroll
            for (int mt = 0; mt < 4; ++mt) {
                float ss = 0.f;
#pragma unroll
                for (int nt = 0; nt < 4; ++nt) ss += (acc[mt][nt][0] * acc[mt][nt][0] + acc[mt][nt][1] * acc[mt][nt][1]) + (acc[mt][nt][2] * acc[mt][nt][2] + acc[mt][nt][3] * acc[mt][nt][3]);
                ss += __shfl_xor(ss, 16); ss += __shfl_xor(ss, 32);
                if (fq == 0) red[(16 * mt + fr) * 8 + w] = ss;
            }
            __syncthreads();
#pragma unroll
            for (int mt = 0; mt < 4; ++mt) {
                float tot = 0.f;
#pragma unroll
                for (int w2 = 0; w2 < 8; ++w2) tot += red[(16 * mt + fr) * 8 + w2];
                const float rn = 1.0f / sqrtf(tot * (1.f / 512.f) + NORM_EPS);
                const size_t off = (size_t)(i0 + 16 * mt + fr) * 2048 + h * 512 + 64 * w + 4 * fq;
#pragma unroll
                for (int nt = 0; nt < 4; ++nt) {
                    const u32x2 gg = *(const u32x2*)((dir == 0 ? (const bf16_t*)GF : GB) + off + 16 * nt);
                    float y0 = siluf(bflo(gg.x)) * acc[mt][nt][0] * rn, y1 = siluf(bfhi(gg.x)) * acc[mt][nt][1] * rn;
                    float y2 = siluf(bflo(gg.y)) * acc[mt][nt][2] * rn, y3 = siluf(bfhi(gg.y)) * acc[mt][nt][3] * rn;
                    if (dir == 1) { const u32x2 yp = *(const u32x2*)(GF + off + 16 * nt); y0 += bflo(yp.x); y1 += bfhi(yp.x); y2 += bflo(yp.y); y3 += bfhi(yp.y); }
                    u32x2 wv; wv.x = pk2(y0, y1); wv.y = pk2(y2, y3);
                    *(u32x2*)(GF + off + 16 * nt) = wv;
                }
            }
            __syncthreads();
        }
    }
}

__device__ __forceinline__ void phase_p0(Ctx& C) {
    float* modv = (float*)(C.ws + WS_MODV);
    for (int u = C.bid; u < 384; u += C.G) {
        const int i = u / 96, nbk = u % 96;
        gemv2_unit<1>(C, C.in[4] + (size_t)i * 1024 * 6144, 6144, 64 * nbk, C.in[1], C.in[3], C.in[5] + i * 6144, modv + (i * 2 + 0) * 6144, modv + (i * 2 + 1) * 6144, 0, 0);
    }
    float* tabc = (float*)(C.ws + WS_TABC); float* tabs = (float*)(C.ws + WS_TABS);
    for (int idx = C.bid * 512 + C.tid; idx < 320 * 64; idx += C.G * 512) {
        const int ti = idx >> 6, i = idx & 63; const float pos = (float)(ti < 256 ? ti : ti - 256);
        const float inv = exp2f(-(float)i * (13.287712379549449f / 64.0f)); const float ang = pos * inv;
        tabc[idx] = __cosf(ang); tabs[idx] = __sinf(ang);
    }
}
__device__ __forceinline__ void phase_p1(Ctx& C) {
    const float* modv = (const float*)(C.ws + WS_MODV);
    float* s1 = (float*)(C.ws + WS_S1); float* s2 = (float*)(C.ws + WS_S2);
    for (int idx = C.bid * 512 + C.tid; idx < 8192; idx += C.G * 512) {
        const int i = idx >> 11, s = (idx >> 10) & 1, k = idx & 1023;
        s1[idx] = C.in[6][i * 1024 + k] * (1.f + modv[(i * 2 + s) * 6144 + 1024 + k]);
        s2[idx] = C.in[7][i * 1024 + k] * (1.f + modv[(i * 2 + s) * 6144 + 4096 + k]);
    }
    float* cvA = (float*)(C.ws + WS_CVA); float* cvF = (float*)(C.ws + WS_CVF);
    for (int u = C.bid; u < 672; u += C.G) {
        if (u < 320) {
            int i, nbk; if (u < 32) { i = 0; nbk = u; } else if (u < 160) { i = 1; nbk = u - 32; } else if (u < 192) { i = 2; nbk = u - 160; } else { i = 3; nbk = u - 192; }
            const int j = i >> 1; const float* v0 = modv + (i * 2 + 0) * 6144; const float* v1 = modv + (i * 2 + 1) * 6144;
            if ((i & 1) == 0) gemv2_unit<0>(C, C.in[8] + (size_t)j * 1024 * 2048, 2048, 64 * nbk, v0, v1, C.in[9] + j * 2048, cvA + (i * 2) * 8192, cvA + (i * 2 + 1) * 8192, 1, 1024);
            else gemv2_unit<0>(C, C.in[16] + (size_t)j * 1024 * 8192, 8192, 64 * nbk, v0, v1, nullptr, cvA + (i * 2) * 8192, cvA + (i * 2 + 1) * 8192, 2, 0);
        } else {
            const int i = (u - 320) / 88, nbk = (u - 320) % 88;
            const float* v0 = modv + (i * 2 + 0) * 6144 + 3072; const float* v1 = modv + (i * 2 + 1) * 6144 + 3072;
            gemv2_unit<0>(C, C.in[19] + (size_t)i * 1024 * FF2, FF2, 64 * nbk, v0, v1, nullptr, cvF + (i * 2) * FF2, cvF + (i * 2 + 1) * FF2, 1, DFF);
        }
    }
    bf16_t* xs = (bf16_t*)(C.ws + WS_XS); float* stats = (float*)(C.ws + WS_STATS); float* xctx = (float*)(C.ws + WS_XCTX);
    for (int row = C.bid * 8 + C.wave; row < R; row += C.G * 8) {
        const bool lat = row < T; const int s = lat ? 0 : 1;
        const float* src = lat ? C.in[0] + (size_t)row * 1024 : C.in[2] + (size_t)(row - T) * 1024;
        float* dst = lat ? C.out + (size_t)row * 1024 : xctx + (size_t)(row - T) * 1024;
        float ss = 0.f;
#pragma unroll
        for (int jj = 0; jj < 4; ++jj) {
            const int k = 4 * C.lane + 256 * jj;
            const f32x4 v = *(const f32x4*)(src + k); *(f32x4*)(dst + k) = v;
            ss += (v[0] * v[0] + v[1] * v[1]) + (v[2] * v[2] + v[3] * v[3]);
            const f32x4 g = *(const f32x4*)(C.in[6] + k), m = *(const f32x4*)(modv + s * 6144 + 1024 + k);
            u32x2 w; w.x = pk2(v[0] * g[0] * (1.f + m[0]), v[1] * g[1] * (1.f + m[1])); w.y = pk2(v[2] * g[2] * (1.f + m[2]), v[3] * g[3] * (1.f + m[3]));
            *(u32x2*)(xs + (size_t)row * 1024 + k) = w;
        }
#pragma unroll
        for (int off = 1; off < 64; off <<= 1) ss += __shfl_xor(ss, off);
        if (C.lane < 16) stats[(size_t)row * 16 + C.lane] = C.lane == 0 ? ss : 0.f;
    }
    prep_layer(C, 0);
}
__device__ __forceinline__ void phase_final(Ctx& C) {
    const float* stats = (const float*)(C.ws + WS_STATS);
    for (int row = C.bid * 8 + C.wave; row < T; row += C.G * 8) {
        float s = C.lane < 16 ? stats[(size_t)row * 16 + C.lane] : 0.f;
#pragma unroll
        for (int off = 1; off < 64; off <<= 1) s += __shfl_xor(s, off);
        const float r = 1.0f / sqrtf(s * (1.f / 1024.f) + NORM_EPS);
        float* xr = C.out + (size_t)row * 1024;
#pragma unroll
        for (int jj = 0; jj < 4; ++jj) { const int k = 4 * C.lane + 256 * jj; const f32x4 v = *(const f32x4*)(xr + k), g = *(const f32x4*)(C.in[21] + k); *(f32x4*)(xr + k) = v * r * g; }
    }
}

constexpr int NPHASE = 31;
__device__ __forceinline__ void run_phase(Ctx& C, int ph) {
    const int i = (ph - 2) / 7, sub = (ph - 2) % 7, j = i >> 1; const bool conv = (i & 1) == 0;
    const bool last = i == DEPTH - 1;
    float* stats = (float*)(C.ws + WS_STATS);
    const bf16_t* xs = (const bf16_t*)(C.ws + WS_XS);
    constexpr int F_MODV = (int)(WS_MODV / 4), F_S1 = (int)(WS_S1 / 4), F_S2 = (int)(WS_S2 / 4), F_CVA = (int)(WS_CVA / 4), F_CVF = (int)(WS_CVF / 4);
    if (sub == 1) {
        if (conv) { EpiGLU E{C.ws, F_CVA + (i * 2) * 8192, 8192, (int)WS_U, 1024, 0, stats}; gemm_both(C, xs, (const bf16_t*)(C.ws + WS_WA), T, 2048, 1024, E, 0, 8); }
        else { EpiWin E{C.ws, F_CVA + (i * 2) * 8192, stats}; gemm_both(C, xs, (const bf16_t*)(C.ws + WS_WA), T, 8192, 1024, E, last ? 4 : 0, last ? 16 : 32); }
    } else if (sub == 5) {
        EpiGLU E{C.ws, F_CVF + (i * 2) * FF2, FF2, (int)WS_H, DFF, 1, stats}; gemm_both(C, xs, (const bf16_t*)(C.ws + WS_WF1), last ? T : R, FF2, 1024, E, 0, 0);
    } else {
        const bool f2 = sub == 6;
        const int mgoff = F_MODV + (i * 2) * 6144 + (f2 ? 5120 : 2048);
        const int snoff = f2 ? (last ? -1 : F_S1 + ((i + 1) * 2) * 1024) : F_S2 + (i * 2) * 1024;
        const float* bias = (!f2 && conv) ? C.in[15] + j * 1024 : nullptr;
        const bf16_t* A = (const bf16_t*)(C.ws + (f2 ? WS_H : (conv ? WS_A2 : WS_GF)));
        const bf16_t* Bt = (const bf16_t*)(C.ws + (f2 ? WS_WF2 : WS_WA2));
        const int K = f2 ? DFF : (conv ? 1024 : 2048);
        EpiRes E{C.ws, C.out, bias, mgoff, snoff, stats};
        gemm_both(C, A, Bt, T, 1024, K, E, 0, last ? 0 : 4);
    }
}

#define XB_TMO      128
#define XB_XCNT(j)  (256  + 64 * (j))
#define XB_XSUB(j)  (1280 + 64 * (j))
#define XB_XGEN(j)  (2304 + 64 * (j))
#define XB_TOP      3328
#define XB_TOPGEN   3392
#define XCD_BAR_WORDS 3456
#define XB_SPIN_CAP (1u << 20)
__device__ __forceinline__ unsigned xb_ld(unsigned* p)              { return __hip_atomic_load(p, __ATOMIC_RELAXED, __HIP_MEMORY_SCOPE_AGENT); }
__device__ __forceinline__ unsigned xb_add(unsigned* p, unsigned v) { return __hip_atomic_fetch_add(p, v, __ATOMIC_RELAXED, __HIP_MEMORY_SCOPE_AGENT); }
__device__ __forceinline__ unsigned xb_xcc_id() { return (unsigned)__builtin_amdgcn_s_getreg((3 << 11) | 20) & 0xFu; }
#define XB_SPIN(cond, bar) do { unsigned _sp = 0; while (cond) { __builtin_amdgcn_s_sleep(1); \
    if ((++_sp & 255u) == 0u) { if (xb_ld(&(bar)[XB_TMO])) break; if (_sp > XB_SPIN_CAP) { atomicAdd(&(bar)[XB_TMO], 1u); break; } } } } while (0)
struct XcdBarrier { unsigned* bar; unsigned x; volatile LAS unsigned* st; };
__device__ __forceinline__ XcdBarrier xcd_barrier_post(unsigned* bar, volatile LAS unsigned* st) {
    XcdBarrier b; b.bar = bar; b.x = xb_xcc_id(); b.st = st;
    if (threadIdx.x == 0) (void)xb_add(&bar[XB_XCNT(b.x)], 1u);
    return b;
}
__device__ __forceinline__ void xcd_barrier_complete(unsigned* bar, unsigned x, unsigned& nloc, unsigned& nx) {
    const unsigned G = gridDim.x * gridDim.y * gridDim.z;
    unsigned sum, cnt, mine, sp = 0u;
    for (;;) {
        sum = 0u; cnt = 0u; mine = 0u;
#pragma unroll
        for (unsigned j = 0; j < 16; ++j) { const unsigned c = xb_ld(&bar[XB_XCNT(j)]); sum += c; cnt += (c > 0u) ? 1u : 0u; mine = (j == x) ? c : mine; }
        if (sum == G) break;
        __builtin_amdgcn_s_sleep(1);
        if ((++sp & 255u) == 0u) { if (xb_ld(&bar[XB_TMO])) break; if (sp > XB_SPIN_CAP) { atomicAdd(&bar[XB_TMO], 1u); break; } }
    }
    nloc = mine > 0u ? mine : 1u; nx = cnt > 0u ? cnt : 1u;
}
__device__ __forceinline__ void xcd_barrier(const XcdBarrier& b) {
    asm volatile("s_waitcnt vmcnt(0)" ::: "memory");
    __syncthreads();
    if (threadIdx.x == 0) {
        unsigned* bar = b.bar;
        __builtin_amdgcn_s_waitcnt(0);
        unsigned nloc = b.st[0], nx = b.st[1];
        if (nloc == 0u) { xcd_barrier_complete(bar, b.x, nloc, nx); b.st[0] = nloc; b.st[1] = nx; }
        const unsigned old = xb_add(&bar[XB_XSUB(b.x)], 1u);
        const unsigned gen = old / nloc;
        if (old + 1u == (gen + 1u) * nloc) {
            __builtin_amdgcn_fence(__ATOMIC_RELEASE, "agent");
            asm volatile("s_waitcnt vmcnt(0)" ::: "memory");
            const unsigned og = xb_add(&bar[XB_TOP], 1u);
            const unsigned tg = og / nx;
            if (og + 1u == (tg + 1u) * nx) xb_add(&bar[XB_TOPGEN], 1u);
            else XB_SPIN(xb_ld(&bar[XB_TOPGEN]) == tg, bar);
            __builtin_amdgcn_fence(__ATOMIC_ACQUIRE, "agent");
            xb_add(&bar[XB_XGEN(b.x)], 1u);
            asm volatile("s_waitcnt vmcnt(0)" ::: "memory");
        } else {
            XB_SPIN(xb_ld(&bar[XB_XGEN(b.x)]) == gen, bar);
            __builtin_amdgcn_fence(__ATOMIC_ACQUIRE, "agent");
            asm volatile("s_waitcnt vmcnt(0)" ::: "memory");
        }
    }
    __syncthreads();
}
constexpr int MISC_OFF = 131072 + 320;
constexpr int CW_BAR = 4096;

template <int PH> __device__ __forceinline__ void one_phase(Ctx& C, const Args& args, const XcdBarrier& bar) {
    if (PH < args.ph_lo || PH >= args.ph_hi) return;
    constexpr int i = (PH - 2) / 7, sub = (PH - 2) % 7, j = i >> 1; constexpr bool conv = (i & 1) == 0;
    if (PH >= 2 && PH < 30) { if (sub == 0 && i == 0) return; if (sub == 3 && conv) return; }
    if (PH > args.ph_lo) xcd_barrier(bar);
    if (PH == 0) phase_p0(C);
    else if (PH == 1) phase_p1(C);
    else if (PH == 30) phase_final(C);
    else if (sub == 0) prep_layer(C, i);
    else if (sub == 2) { if (conv) dwconv_phase(C, j); else scan_phase(C, j); }
    else if (sub == 3) readout_phase(C, j, i == DEPTH - 1);
    else run_phase(C, PH);
}
template <int... PHS> __device__ __forceinline__ void all_phases(Ctx& C, const Args& args, const XcdBarrier& bar, std::integer_sequence<int, PHS...>) { (one_phase<PHS>(C, args, bar), ...); }
__global__ void __launch_bounds__(512, 2) mega_kernel(Args args) {
    extern __shared__ __attribute__((aligned(16))) unsigned char lds_raw[];
    Ctx C;
    C.lds = (LAS unsigned char*)lds_raw; C.tid = threadIdx.x; C.lane = C.tid & 63; C.wave = __builtin_amdgcn_readfirstlane(C.tid >> 6); C.G = gridDim.x; C.bid = blockIdx.x;
    C.in = args.in; C.out = args.out; C.ws = args.ws;
    volatile LAS unsigned* MISC = (volatile LAS unsigned*)(C.lds + MISC_OFF);
    if (C.tid < 32) MISC[C.tid] = 0u;
    __syncthreads();
    XcdBarrier bar = xcd_barrier_post((unsigned*)(C.ws + WS_CTL) + CW_BAR, MISC + 8);
    all_phases(C, args, bar, std::make_integer_sequence<int, NPHASE>{});
}

template <int KIND>
__global__ void __launch_bounds__(512, 2) phase_kernel(Args args) {
    extern __shared__ __attribute__((aligned(16))) unsigned char lds_raw[];
    Ctx C;
    C.lds = (LAS unsigned char*)lds_raw; C.tid = threadIdx.x; C.lane = C.tid & 63; C.wave = __builtin_amdgcn_readfirstlane(C.tid >> 6); C.G = gridDim.x; C.bid = blockIdx.x;
    C.in = args.in; C.out = args.out; C.ws = args.ws;
    const int ph = args.ph_lo;
    if (KIND == 0) phase_p0(C);
    else if (KIND == 1) phase_p1(C);
    else if (KIND == 30) phase_final(C);
    else {
        const int i = (ph - 2) / 7, j = i >> 1; const bool conv = (i & 1) == 0;
        if (KIND == 2) prep_layer(C, i);
        else if (KIND == 4) { if (conv) dwconv_phase(C, j); else scan_phase(C, j); }
        else if (KIND == 5) readout_phase(C, j, i == DEPTH - 1);
        else run_phase(C, ph);
    }
}

extern "C" void kernel_launch(void* const* d_in, const int* in_sizes, int n_in, void* d_out, int out_size, void* d_ws, size_t ws_size, hipStream_t stream) {
    static int grid = 0;
    if (grid == 0) {
        if (n_in != 22 || out_size != T * D || ws_size < WS_END) { fprintf(stderr, "kernel_launch: unexpected problem (n_in %d out %d ws %zu, need %zu)\n", n_in, out_size, ws_size, (size_t)WS_END); grid = -1; return; }
        int dev = 0, cus = 0;
        if (hipGetDevice(&dev) != hipSuccess || hipDeviceGetAttribute(&cus, hipDeviceAttributeMultiprocessorCount, dev) != hipSuccess) { grid = -1; return; }
        bool ok = true;
        ok &= hipFuncSetAttribute((const void*)phase_kernel<0>, hipFuncAttributeMaxDynamicSharedMemorySize, LDS_BYTES) == hipSuccess;
        ok &= hipFuncSetAttribute((const void*)phase_kernel<1>, hipFuncAttributeMaxDynamicSharedMemorySize, LDS_BYTES) == hipSuccess;
        ok &= hipFuncSetAttribute((const void*)phase_kernel<2>, hipFuncAttributeMaxDynamicSharedMemorySize, LDS_BYTES) == hipSuccess;
        ok &= hipFuncSetAttribute((const void*)phase_kernel<3>, hipFuncAttributeMaxDynamicSharedMemorySize, LDS_BYTES) == hipSuccess;
        ok &= hipFuncSetAttribute((const void*)phase_kernel<4>, hipFuncAttributeMaxDynamicSharedMemorySize, LDS_BYTES) == hipSuccess;
        ok &= hipFuncSetAttribute((const void*)phase_kernel<5>, hipFuncAttributeMaxDynamicSharedMemorySize, LDS_BYTES) == hipSuccess;
        ok &= hipFuncSetAttribute((const void*)phase_kernel<30>, hipFuncAttributeMaxDynamicSharedMemorySize, LDS_BYTES) == hipSuccess;
        ok &= hipFuncSetAttribute((const void*)mega_kernel, hipFuncAttributeMaxDynamicSharedMemorySize, LDS_BYTES) == hipSuccess;
        if (!ok) { fprintf(stderr, "kernel_launch: hipFuncSetAttribute failed\n"); grid = -1; return; }
        grid = cus > 0 ? cus : 256;
    }
    if (grid < 0) return;
    Args a{};
    for (int i = 0; i < 22; ++i) a.in[i] = (const float*)d_in[i];
    a.out = (float*)d_out; a.ws = (unsigned char*)d_ws;
#if ONE_LAUNCH
    if (hipMemsetAsync((char*)d_ws + WS_CTL, 0, 65536, stream) != hipSuccess) { fprintf(stderr, "kernel_launch: memset failed\n"); return; }
    a.ph_lo = 0; a.ph_hi = NPHASE;
    hipLaunchKernelGGL(mega_kernel, dim3(grid), dim3(512), LDS_BYTES, stream, a);
    return;
#endif
    for (int ph = 0; ph < NPHASE; ++ph) {
        const int i = (ph - 2) / 7, sub = (ph - 2) % 7;
        if (ph >= 2 && ph < 30) { if (sub == 0 && i == 0) continue; if (sub == 3 && (i & 1) == 0) continue; }
        a.ph_lo = ph; a.ph_hi = ph + 1;
        const dim3 g(grid), b(512);
        if (ph == 0) hipLaunchKernelGGL(phase_kernel<0>, g, b, LDS_BYTES, stream, a);
        else if (ph == 1) hipLaunchKernelGGL(phase_kernel<1>, g, b, LDS_BYTES, stream, a);
        else if (ph == 30) hipLaunchKernelGGL(phase_kernel<30>, g, b, LDS_BYTES, stream, a);
        else if (sub == 0) hipLaunchKernelGGL(phase_kernel<2>, g, b, LDS_BYTES, stream, a);
        else if (sub == 2) hipLaunchKernelGGL(phase_kernel<4>, g, b, LDS_BYTES, stream, a);
        else if (sub == 3) hipLaunchKernelGGL(phase_kernel<5>, g, b, LDS_BYTES, stream, a);
        else hipLaunchKernelGGL(phase_kernel<3>, g, b, LDS_BYTES, stream, a);
    }
}
```

```cpp
#include <hip/hip_runtime.h>
#include <cstdio>
#include <cstdint>
#include <utility>

#ifndef ONE_LAUNCH
#define ONE_LAUNCH 1
#endif

typedef unsigned short bf16_t;
typedef short bf16x8 __attribute__((ext_vector_type(8)));
typedef float f32x4 __attribute__((ext_vector_type(4)));
typedef float f32x2 __attribute__((ext_vector_type(2)));
typedef unsigned u32x2 __attribute__((ext_vector_type(2)));
typedef unsigned u32x4 __attribute__((ext_vector_type(4)));
typedef __bf16 bf16x2_t __attribute__((ext_vector_type(2)));
#define LAS __attribute__((address_space(3)))

constexpr int D = 1024, T = 16384, TC = 256, R = T + TC, NH = 4, DK = 256, DV = 512, QKW = 1024, VW = 2048, INW = 8192, DFF = 2816, FF2 = 5632, CK = 31, DEPTH = 4;
constexpr int NSLOT = 33;
constexpr float NORM_EPS = 1e-6f, LN_EPS = 1e-5f;

constexpr size_t MiB = 1u << 20, KiB = 1u << 10;
constexpr size_t WS_CTL = 0, CTL_ZERO_BYTES = 1 * MiB;
constexpr size_t WS_MODV = 1 * MiB;
constexpr size_t WS_S1 = 1 * MiB + 256 * KiB;
constexpr size_t WS_S2 = 1 * MiB + 320 * KiB;
constexpr size_t WS_CVA = 1 * MiB + 384 * KiB;
constexpr size_t WS_CVF = 1 * MiB + 640 * KiB;
constexpr size_t WS_TABC = 1 * MiB + 832 * KiB;
constexpr size_t WS_TABS = 1 * MiB + 912 * KiB;
constexpr size_t WS_STATS = 2 * MiB;
constexpr size_t WS_XCTX = 4 * MiB;
constexpr size_t WS_WA = 8 * MiB;
constexpr size_t WS_WA2 = 24 * MiB;
constexpr size_t WS_WF1 = 28 * MiB;
constexpr size_t WS_WF2 = 40 * MiB;
constexpr size_t WS_XS = 48 * MiB;
constexpr size_t WS_SCP = 48 * MiB;
constexpr size_t WS_BIG = 114 * MiB;
constexpr size_t WS_Q = WS_BIG, WS_K = WS_BIG + 33 * MiB, WS_VT = WS_BIG + 66 * MiB, WS_GF = WS_BIG + 131 * MiB, WS_GB = WS_BIG + 196 * MiB;
constexpr size_t WS_U = WS_BIG, WS_A2 = WS_BIG + 33 * MiB, WS_H = WS_BIG;
constexpr size_t WS_END = WS_BIG + 261 * MiB;
static_assert((size_t)R * 1024 * 2 <= 33 * MiB && (size_t)R * 2048 * 2 <= 65 * MiB && (size_t)R * DFF * 2 <= 131 * MiB, "map");
static_assert((size_t)NSLOT * 8 * 512 * 256 * 2 <= 66 * MiB, "scp");

constexpr int LDS_BYTES = 147456;

__device__ __forceinline__ unsigned pk2(float lo, float hi) { f32x2 v = {lo, hi}; bf16x2_t b = __builtin_convertvector(v, bf16x2_t); return __builtin_bit_cast(unsigned, b); }
__device__ __forceinline__ float bflo(unsigned u) { return __uint_as_float(u << 16); }
__device__ __forceinline__ float bfhi(unsigned u) { return __uint_as_float(u & 0xffff0000u); }
__device__ __forceinline__ float siluf(float x) { return x / (1.f + __expf(-x)); }
__device__ __forceinline__ float sigmf(float x) { return 1.f / (1.f + __expf(-x)); }
__device__ __forceinline__ int perm_glu(int n, int H) { if (n < H) return 32 * (n >> 4) + (n & 15); const int n2 = n - H; return 32 * (n2 >> 4) + 16 + (n2 & 15); }
__device__ __forceinline__ int perm_win(int n) {
    if (n >= 2 * QKW) return n;
    const int part = n >> 10, hn = n & 1023, h = hn >> 8, d = hn & 255, quarter = d >> 6, idx = d & 63;
    const int Gp = (quarter >> 1) * 4 + (idx >> 4), i = (quarter & 1) * 16 + (idx & 15);
    return part * 1024 + h * 256 + 32 * Gp + i;
}
__device__ __forceinline__ int perm_any(int mode, int n, int H) { return mode == 0 ? n : (mode == 1 ? perm_glu(n, H) : perm_win(n)); }

struct Args { const float* in[22]; float* out; unsigned char* ws; int ph_lo, ph_hi; };

struct Ctx {
    LAS unsigned char* lds;
    int tid, lane, wave, G, bid;
    const float* const* in; float* out; unsigned char* ws;
};

template <int VSILU>
__device__ __forceinline__ void gemv2_unit(Ctx& C, const float* W, int N, int n0, const float* v0, const float* v1, const float* bias, float* o0, float* o1, int pmode, int H) {
    LAS float* red = (LAS float*)C.lds;
    const int c4 = C.tid & 15, ks = C.tid >> 4;
    f32x4 a0 = {0.f, 0.f, 0.f, 0.f}, a1 = {0.f, 0.f, 0.f, 0.f};
#pragma unroll 8
    for (int i = 0; i < 32; ++i) {
        const int k = ks * 32 + i;
        const f32x4 w = *(const f32x4*)(W + (size_t)k * N + n0 + 4 * c4);
        float x0 = v0[k], x1 = v1[k];
        if (VSILU) { x0 = siluf(x0); x1 = siluf(x1); }
        a0 += w * x0; a1 += w * x1;
    }
#pragma unroll
    for (int e = 0; e < 4; ++e) { red[(ks * 2 + 0) * 64 + 4 * c4 + e] = a0[e]; red[(ks * 2 + 1) * 64 + 4 * c4 + e] = a1[e]; }
    __syncthreads();
    if (C.tid < 128) {
        const int s = C.tid >> 6, col = C.tid & 63; float sum = 0.f;
#pragma unroll 8
        for (int k2 = 0; k2 < 32; ++k2) sum += red[(k2 * 2 + s) * 64 + col];
        const int n = n0 + col; if (bias) sum += bias[n];
        (s ? o1 : o0)[perm_any(pmode, n, H)] = sum;
    }
    __syncthreads();
}

__device__ __forceinline__ void transpose_item(const float* W, int K, int N, bf16_t* WT, int pmode, int H, LAS float* scr, int item, int lane) {
    const int nblk = N / 32, kb = item / nblk, nb = item % nblk, k0 = 64 * kb, n0 = 32 * nb;
#pragma unroll 8
    for (int i = 0; i < 32; ++i) { const int kk = 2 * i + (lane >> 5); scr[kk * 33 + (lane & 31)] = W[(size_t)(k0 + kk) * N + n0 + (lane & 31)]; }
    asm volatile("s_waitcnt lgkmcnt(0)" ::: "memory");
    const int c = lane & 7;
#pragma unroll
    for (int j = 0; j < 4; ++j) { const int n = (lane >> 3) + 8 * j; const LAS float* s = scr + (8 * c) * 33 + n;
        u32x4 o; o.x = pk2(s[0 * 33], s[1 * 33]); o.y = pk2(s[2 * 33], s[3 * 33]); o.z = pk2(s[4 * 33], s[5 * 33]); o.w = pk2(s[6 * 33], s[7 * 33]);
        *(u32x4*)(WT + (size_t)perm_any(pmode, n0 + n, H) * K + k0 + 8 * c) = o; }
    asm volatile("s_waitcnt lgkmcnt(0)" ::: "memory");
}
__device__ __forceinline__ void prep_layer(Ctx& C, int i) {
    LAS float* scr = (LAS float*)(C.lds + C.wave * 16384);
    const int gw = C.bid * 8 + C.wave, NGW = C.G * 8, j = i >> 1;
    bf16_t* WA = (bf16_t*)(C.ws + WS_WA); bf16_t* WA2 = (bf16_t*)(C.ws + WS_WA2); bf16_t* WF1 = (bf16_t*)(C.ws + WS_WF1); bf16_t* WF2 = (bf16_t*)(C.ws + WS_WF2);
    const bool conv = (i & 1) == 0;
    const int I_A = conv ? 16 * 64 : 16 * 256, I_A2 = conv ? 16 * 32 : 32 * 32, I_F1 = 16 * 176, I_F2 = 44 * 32;
    const int NIT = I_A + I_A2 + I_F1 + I_F2;
    for (int it = gw; it < NIT; it += NGW) {
        int r = it;
        if (r < I_A) { if (conv) transpose_item(C.in[8] + (size_t)j * 1024 * 2048, 1024, 2048, WA, 1, 1024, scr, r, C.lane);
                       else transpose_item(C.in[16] + (size_t)j * 1024 * 8192, 1024, 8192, WA, 2, 0, scr, r, C.lane); continue; } r -= I_A;
        if (r < I_A2) { if (conv) transpose_item(C.in[14] + (size_t)j * 1024 * 1024, 1024, 1024, WA2, 0, 0, scr, r, C.lane);
                        else transpose_item(C.in[18] + (size_t)j * 2048 * 1024, 2048, 1024, WA2, 0, 0, scr, r, C.lane); continue; } r -= I_A2;
        if (r < I_F1) { transpose_item(C.in[19] + (size_t)i * 1024 * FF2, 1024, FF2, WF1, 1, DFF, scr, r, C.lane); continue; } r -= I_F1;
        transpose_item(C.in[20] + (size_t)i * DFF * 1024, DFF, 1024, WF2, 0, 0, scr, r, C.lane);
    }
}

__device__ __forceinline__ float row_rs(const float* stats, int row, int fq) {
    const f32x4 p = *(const f32x4*)(stats + (size_t)row * 16 + 4 * fq);
    float s = (p[0] + p[1]) + (p[2] + p[3]);
    s += __shfl_xor(s, 16); s += __shfl_xor(s, 32);
    return 1.0f / sqrtf(s * (1.0f / 1024.0f) + NORM_EPS);
}
struct EpiGLU {
    static constexpr bool STATS = false, NEEDRS = true;
    unsigned char* ws; int cvoff  , cvstride  , outoff  , ldo, act;
    float* stats;
    __device__ __forceinline__ float row_begin(int row, int fq) const { return row_rs((const float*)(ws + WS_STATS), row, fq); }
    __device__ __forceinline__ float item(int row, int colp, f32x4 v0, f32x4 v1, float rs) const {
        const float* cv = (const float*)ws + cvoff + (row < T ? 0 : cvstride);
        const f32x4 ca = *(const f32x4*)(cv + colp), cg = *(const f32x4*)(cv + colp + 16);
        float o[4];
#pragma unroll
        for (int e = 0; e < 4; ++e) { const float a = rs * v0[e] + ca[e], g = rs * v1[e] + cg[e]; o[e] = act == 0 ? a * sigmf(g) : siluf(a) * g; }
        const int oc = (colp >> 5) * 16 + (colp & 15);
        u32x2 w; w.x = pk2(o[0], o[1]); w.y = pk2(o[2], o[3]);
        *(u32x2*)((bf16_t*)(ws + outoff) + (size_t)row * ldo + oc) = w;
        return 0.f;
    }
};
struct EpiRes {
    static constexpr bool STATS = true, NEEDRS = false;
    unsigned char* ws; float* xl; const float* bias; int mgoff  , snoff  ;
    float* stats;
    __device__ __forceinline__ float row_begin(int, int) const { return 1.f; }
    __device__ __forceinline__ float item(int row, int colp, f32x4 v0, f32x4 v1, float) const {
        const bool lat = row < T;
        float* xr = lat ? xl + (size_t)row * 1024 : (float*)(ws + WS_XCTX) + (size_t)(row - T) * 1024;
        const float* mg = (const float*)ws + mgoff + (lat ? 0 : 6144); const float* sn = (const float*)ws + snoff + (lat ? 0 : 1024);
        bf16_t* xs = (bf16_t*)(ws + WS_XS);
        float ss = 0.f;
#pragma unroll
        for (int hlf = 0; hlf < 2; ++hlf) {
            const int c = colp + 16 * hlf; const f32x4 v = hlf ? v1 : v0;
            const f32x4 xo = *(const f32x4*)(xr + c), m4 = *(const f32x4*)(mg + c);
            f32x4 b4 = {0.f, 0.f, 0.f, 0.f}; if (bias) b4 = *(const f32x4*)(bias + c);
            const f32x4 xn = xo + m4 * (v + b4);
            *(f32x4*)(xr + c) = xn;
            ss += (xn[0] * xn[0] + xn[1] * xn[1]) + (xn[2] * xn[2] + xn[3] * xn[3]);
            if (snoff >= 0) { const f32x4 s4 = *(const f32x4*)(sn + c); u32x2 w; w.x = pk2(xn[0] * s4[0], xn[1] * s4[1]); w.y = pk2(xn[2] * s4[2], xn[3] * s4[3]);
                *(u32x2*)(xs + (size_t)row * 1024 + c) = w; }
        }
        return ss;
    }
};
struct EpiWin {
    static constexpr bool STATS = false, NEEDRS = true;
    unsigned char* ws; int cvoff;
    float* stats;
    __device__ __forceinline__ float row_begin(int row, int fq) const { return row_rs((const float*)(ws + WS_STATS), row, fq); }
    __device__ __forceinline__ float item(int row, int colp, f32x4 v0, f32x4 v1, float rs) const {
        const float* cv = (const float*)ws + cvoff + (row < T ? 0 : 8192);
        const f32x4 c0 = *(const f32x4*)(cv + colp), c1 = *(const f32x4*)(cv + colp + 16);
        f32x4 a = v0 * rs + c0, b = v1 * rs + c1;
        if (colp < 2048) {
            if (row < T) {
                const int Gp = (colp >> 5) & 7, idx0 = 16 * (Gp & 3) + (colp & 15);
                const int ti = (Gp >> 2) ? 256 + (row & 63) : (row >> 6);
                const f32x4 cs = *(const f32x4*)((const float*)(ws + WS_TABC) + ti * 64 + idx0), sn = *(const f32x4*)((const float*)(ws + WS_TABS) + ti * 64 + idx0);
                const f32x4 o1 = a * cs - b * sn, o2 = b * cs + a * sn; a = o1; b = o2;
            }
            bf16_t* dst = (bf16_t*)(ws + WS_Q);
            if (colp >= 1024) { dst = (bf16_t*)(ws + WS_K); a = a * 0.0625f; b = b * 0.0625f; }
            const int c = colp & 1023;
            u32x2 w; w.x = pk2(a[0], a[1]); w.y = pk2(a[2], a[3]); *(u32x2*)(dst + (size_t)row * 1024 + c) = w;
            w.x = pk2(b[0], b[1]); w.y = pk2(b[2], b[3]); *(u32x2*)(dst + (size_t)row * 1024 + c + 16) = w;
        } else if (colp < 4096) {
            const int c = colp - 2048;
            bf16_t* vt = (bf16_t*)(ws + WS_VT);
#pragma unroll
            for (int e = 0; e < 4; ++e) { vt[(size_t)(c + e) * R + row] = (bf16_t)(pk2(a[e], 0.f) & 0xffffu); vt[(size_t)(c + 16 + e) * R + row] = (bf16_t)(pk2(b[e], 0.f) & 0xffffu); }
        } else {
            bf16_t* dst = (bf16_t*)(ws + (colp < 6144 ? WS_GF : WS_GB)); const int c = (colp - 4096) & 2047;
            u32x2 w; w.x = pk2(a[0], a[1]); w.y = pk2(a[2], a[3]); *(u32x2*)(dst + (size_t)row * 2048 + c) = w;
            w.x = pk2(b[0], b[1]); w.y = pk2(b[2], b[3]); *(u32x2*)(dst + (size_t)row * 2048 + c + 16) = w;
        }
        return 0.f;
    }
};

template <class Epi>
__device__ __forceinline__ void sgemm_small(Ctx& C, const bf16_t* A, const bf16_t* Bt, int row_lo, int Mrows, int N, int K, const Epi& E, int n_lo, int n_hi) {
    const int wr = C.wave >> 2, wc = C.wave & 3, fr = C.lane & 15, fq = C.lane >> 4;
    const int nM = Mrows / 32, nN = n_hi - n_lo, nU = nM * nN;
    for (int u = (C.G - 1 - C.bid); u < nU; u += C.G) {
        const int un = n_lo + u / nM, um = u % nM;
        const int row0 = row_lo + 32 * um + 16 * wr, col0 = 256 * un;
        f32x4 acc[2][2];
#pragma unroll
        for (int b = 0; b < 2; ++b)
#pragma unroll
            for (int n = 0; n < 2; ++n) acc[b][n] = (f32x4){0.f, 0.f, 0.f, 0.f};
        const bf16_t* ap = A + (size_t)(row0 + fr) * K + 8 * fq;
        const bf16_t* bp = Bt + (size_t)(col0 + 32 * wc + fr) * K + 8 * fq;
#pragma unroll 4
        for (int k0 = 0; k0 < K; k0 += 32) {
            bf16x8 bf[2][2];
            const bf16x8 af = *(const bf16x8*)(ap + k0);
#pragma unroll
            for (int bj = 0; bj < 2; ++bj)
#pragma unroll
                for (int n = 0; n < 2; ++n) bf[bj][n] = *(const bf16x8*)(bp + (size_t)(128 * bj + 16 * n) * K + k0);
#pragma unroll
            for (int bj = 0; bj < 2; ++bj)
#pragma unroll
                for (int n = 0; n < 2; ++n) acc[bj][n] = __builtin_amdgcn_mfma_f32_16x16x32_bf16(bf[bj][n], af, acc[bj][n], 0, 0, 0);
        }
        const int row = row0 + fr;
        const float rs = E.row_begin(row, fq);
        float ss = 0.f;
#pragma unroll
        for (int bj = 0; bj < 2; ++bj) ss += E.item(row, col0 + 128 * bj + 32 * wc + 4 * fq, acc[bj][0], acc[bj][1], rs);
        if constexpr (Epi::STATS) { ss += __shfl_xor(ss, 16); ss += __shfl_xor(ss, 32); if (fq == 0) E.stats[(size_t)row * 16 + un * 4 + wc] = ss; }
    }
}

namespace pg8 {
#define PG8_LAS __attribute__((address_space(3)))
typedef unsigned short bf16_t;
typedef short bf16x8 __attribute__((ext_vector_type(8)));
typedef float f32x4 __attribute__((ext_vector_type(4)));
typedef unsigned u32x4 __attribute__((ext_vector_type(4)));
constexpr int BM = 256, BK = 64, HALF = 128, HTB = HALF * BK * 2  , STAGE_BYTES = 8 * HTB, NXCD = 8, WGM = 8;

__host__ __device__ __forceinline__ int lds_byte(int r, int c) { const int st = (r >> 4) * 2 + (c >> 5), rr = r & 15, cc = c & 31, ob = rr * 64 + cc * 2; return st * 1024 + (ob ^ (((ob >> 9) & 1) << 5)); }
__host__ __device__ __forceinline__ void stage_rc(int b, int& R, int& C) { const int st = b / 1024, sb = b % 1024, swz = sb ^ (((sb >> 9) & 1) << 5); R = (st >> 1) * 16 + swz / 64; C = (st & 1) * 32 + (swz % 64) / 2; }
__host__ __device__ __forceinline__ int perm32(int rho) { const int n = rho >> 4, i = rho & 15; return 8 * (i >> 2) + 4 * n + (i & 3); }

struct Unit { int pm, pn; };
struct Gemm { const bf16_t* A; const bf16_t* Bt; int M, N, K; };

struct StaticOrder {
    int nM, nN, nwg, G, c;
    __host__ __device__ void init(int M, int N, int G_, int c_) { nM = M / BM; nN = N / BM; nwg = nM * nN; G = G_; c = c_; }
    __host__ __device__ bool next(int i, Unit& u) const {
        const long L = (long)i * G + c; if (L >= nwg) return false;
        int wgid = (int)L; { const int q = nwg / NXCD, r = nwg % NXCD, xcd = wgid % NXCD, off = wgid / NXCD; wgid = (xcd < r ? xcd * (q + 1) : r * (q + 1) + (xcd - r) * q) + off; }
        const int nig = WGM * nN, gid = wgid / nig, fm = gid * WGM, gsz = (nM - fm) < WGM ? (nM - fm) : WGM;
        u.pm = fm + ((wgid % nig) % gsz); u.pn = (wgid % nig) / gsz; return true;
    }
    __device__ __forceinline__ void a_ready(const Unit&) const {}
    __device__ __forceinline__ void done(const Unit&) const {}
};

template <class Epi, class Sched, bool ALIGN_EPI = false, bool SP2 = false>
__device__ __forceinline__ void gemm_phase(PG8_LAS unsigned char* lds, const Gemm g, const Sched& S, const Epi& E) {
    const int tid = threadIdx.x, wid = __builtin_amdgcn_readfirstlane(tid >> 6), lane = tid & 63, wr = wid >> 2, wc = wid & 3, fr = lane & 15, fq = lane >> 4;
    const int K = g.K, nt = K / BK;
    unsigned voffA[2], voffB[2];
#pragma unroll
    for (int i = 0; i < 2; ++i) { int R, C; stage_rc(tid * 16 + i * 8192, R, C); const int Rb = Epi::PERM ? ((R & ~31) + perm32(R & 31)) : R;
        voffA[i] = (unsigned)(R * K + C) * 2u; voffB[i] = (unsigned)(Rb * K + C) * 2u; }
    const size_t kstep = (size_t)(BK * 2);
    const size_t hstep = (size_t)HALF * K * 2;
    const size_t tstep = 2 * hstep;
    const unsigned ldsw = (unsigned)wid * 1024u;
    const int aoff = lds_byte(wr * 64 + fr, fq * 8), boff = lds_byte(wc * 32 + fr, fq * 8);
#define PG8_SA(b, h) (((b) * 2 + (h)) * HTB)
#define PG8_SB(b, h) ((4 + (b) * 2 + (h)) * HTB)
#define PG8_STAGE(bufoff, gbase, voff) do { _Pragma("unroll") for (int _i = 0; _i < 2; ++_i) \
        __builtin_amdgcn_global_load_lds((const unsigned*)((const char*)(gbase) + (voff)[_i]), (PG8_LAS unsigned*)(lds + (bufoff) + ldsw + _i * 8192), 16, 0, 0); } while (0)
#define PG8_LDA(dst, b, h) do { _Pragma("unroll") for (int m = 0; m < 4; ++m) _Pragma("unroll") for (int k = 0; k < 2; ++k) dst[m][k] = *(const PG8_LAS bf16x8*)(lds + PG8_SA(b, h) + aoff + m * 2048 + k * 1024); } while (0)
#define PG8_LDB(dst, b, h) do { _Pragma("unroll") for (int n = 0; n < 2; ++n) _Pragma("unroll") for (int k = 0; k < 2; ++k) dst[n][k] = *(const PG8_LAS bf16x8*)(lds + PG8_SB(b, h) + boff + n * 2048 + k * 1024); } while (0)
#define PG8_MMA(ai, bj, At, Bt) do { __builtin_amdgcn_s_setprio(1); _Pragma("unroll") for (int m = 0; m < 4; ++m) _Pragma("unroll") for (int n = 0; n < 2; ++n) _Pragma("unroll") for (int k = 0; k < 2; ++k) \
        acc[ai][bj][m][n] = __builtin_amdgcn_mfma_f32_16x16x32_bf16(Bt[n][k], At[m][k], acc[ai][bj][m][n], 0, 0, 0); __builtin_amdgcn_s_setprio(0); } while (0)
#define PG8_WAIT_V(n) asm volatile("s_waitcnt vmcnt(" #n ")" ::: "memory")
#define PG8_WAIT_L(n) asm volatile("s_waitcnt lgkmcnt(" #n ")" ::: "memory")
#define PG8_BAR __builtin_amdgcn_s_barrier()
#define PG8_SCHED __builtin_amdgcn_sched_barrier(0)
    Unit cur, nxt; int ui = 0;
    if (!S.next(0, cur)) return;
    f32x4 acc[2][2][4][2];
#pragma unroll
    for (int a = 0; a < 2; ++a)
#pragma unroll
        for (int b = 0; b < 2; ++b)
#pragma unroll
            for (int m = 0; m < 4; ++m)
#pragma unroll
                for (int n = 0; n < 2; ++n) acc[a][b][m][n] = (f32x4){0.f, 0.f, 0.f, 0.f};
    bf16x8 At[4][2], B0[2][2], B1[2][2];
    const char* cA = (const char*)g.A + (size_t)cur.pm * tstep; const char* cB = (const char*)g.Bt + (size_t)cur.pn * tstep;
    S.a_ready(cur);
    if constexpr (SP2) {
        PG8_STAGE(PG8_SB(0, 0), cB, voffB); PG8_STAGE(PG8_SB(0, 1), cB + hstep, voffB); PG8_STAGE(PG8_SA(0, 0), cA, voffA); PG8_STAGE(PG8_SA(0, 1), cA + hstep, voffA);
        if (wr == 1) PG8_BAR;
        PG8_WAIT_V(2); PG8_BAR;
        PG8_STAGE(PG8_SB(1, 0), cB + kstep, voffB); PG8_STAGE(PG8_SA(1, 0), cA + kstep, voffA); PG8_STAGE(PG8_SB(1, 1), cB + hstep + kstep, voffB);
        PG8_WAIT_V(6); PG8_BAR;
    } else {
        PG8_STAGE(PG8_SB(0, 0), cB, voffB); PG8_STAGE(PG8_SA(0, 0), cA, voffA); PG8_STAGE(PG8_SB(0, 1), cB + hstep, voffB); PG8_STAGE(PG8_SA(0, 1), cA + hstep, voffA);
        if (wr == 1) PG8_BAR;
        PG8_WAIT_V(4); PG8_BAR;
        PG8_STAGE(PG8_SB(1, 0), cB + kstep, voffB); PG8_STAGE(PG8_SA(1, 0), cA + kstep, voffA); PG8_STAGE(PG8_SB(1, 1), cB + hstep + kstep, voffB);
        PG8_WAIT_V(6); PG8_BAR;
    }
    for (;;) {
        const bool has_next = S.next(ui + 1, nxt);
        const char* nA = has_next ? (const char*)g.A + (size_t)nxt.pm * tstep : cA; const char* nB = has_next ? (const char*)g.Bt + (size_t)nxt.pn * tstep : cB;
        for (int t = 0; t < nt; t += 2) {
            const bool last = (t == nt - 2);
            const char* a1 = cA + (size_t)(t + 1) * kstep;
            const char* a2 = last ? nA : cA + (size_t)(t + 2) * kstep; const char* b2 = last ? nB : cB + (size_t)(t + 2) * kstep;
            const char* a3 = a2 + kstep; const char* b3 = b2 + kstep;
            if (last && has_next) S.a_ready(nxt);
            if constexpr (SP2) {
            PG8_LDB(B0, 0, 0); PG8_LDB(B1, 0, 1); PG8_SCHED; PG8_LDA(At, 0, 0); PG8_STAGE(PG8_SA(1, 1), a1 + hstep, voffA);
            PG8_WAIT_V(8); PG8_WAIT_L(0); PG8_BAR; PG8_MMA(0, 0, At, B0); PG8_MMA(0, 1, At, B1); PG8_BAR; PG8_SCHED;
            PG8_LDA(At, 0, 1); PG8_STAGE(PG8_SB(0, 0), b2, voffB); PG8_STAGE(PG8_SB(0, 1), b2 + hstep, voffB); PG8_STAGE(PG8_SA(0, 0), a2, voffA);
            PG8_WAIT_V(8); PG8_WAIT_L(0); PG8_BAR; PG8_MMA(1, 0, At, B0); PG8_MMA(1, 1, At, B1); PG8_BAR; PG8_SCHED;
            PG8_LDB(B0, 1, 0); PG8_LDB(B1, 1, 1); PG8_SCHED; PG8_LDA(At, 1, 0); PG8_STAGE(PG8_SA(0, 1), a2 + hstep, voffA);
            PG8_WAIT_V(8); PG8_WAIT_L(0); PG8_BAR; PG8_MMA(0, 0, At, B0); PG8_MMA(0, 1, At, B1); PG8_BAR; PG8_SCHED;
            PG8_LDA(At, 1, 1); PG8_STAGE(PG8_SB(1, 0), b3, voffB); PG8_STAGE(PG8_SB(1, 1), b3 + hstep, voffB); PG8_STAGE(PG8_SA(1, 0), a3, voffA);
            PG8_WAIT_V(8); PG8_WAIT_L(0); PG8_BAR; PG8_MMA(1, 0, At, B0); PG8_MMA(1, 1, At, B1); PG8_BAR; PG8_SCHED;
            } else {
            PG8_LDB(B0, 0, 0); PG8_SCHED; PG8_LDA(At, 0, 0); PG8_STAGE(PG8_SA(1, 1), a1 + hstep, voffA);
            PG8_WAIT_L(8); PG8_BAR; PG8_WAIT_L(0); PG8_MMA(0, 0, At, B0); PG8_BAR; PG8_SCHED;
            PG8_LDB(B1, 0, 1); PG8_STAGE(PG8_SB(0, 0), b2, voffB);
            PG8_BAR; PG8_WAIT_L(0); PG8_MMA(0, 1, At, B1); PG8_BAR;
            PG8_LDA(At, 0, 1); PG8_STAGE(PG8_SA(0, 0), a2, voffA);
            PG8_BAR; PG8_WAIT_L(0); PG8_MMA(1, 0, At, B0); PG8_BAR; PG8_SCHED;
            PG8_STAGE(PG8_SB(0, 1), b2 + hstep, voffB);
            PG8_WAIT_V(6); PG8_BAR; PG8_MMA(1, 1, At, B1); PG8_BAR;
            PG8_LDB(B0, 1, 0); PG8_SCHED; PG8_LDA(At, 1, 0); PG8_STAGE(PG8_SA(0, 1), a2 + hstep, voffA);
            PG8_WAIT_L(8); PG8_BAR; PG8_WAIT_L(0); PG8_MMA(0, 0, At, B0); PG8_BAR; PG8_SCHED;
            PG8_LDB(B1, 1, 1); PG8_STAGE(PG8_SB(1, 0), b3, voffB);
            PG8_BAR; PG8_WAIT_L(0); PG8_MMA(0, 1, At, B1); PG8_BAR;
            PG8_LDA(At, 1, 1); PG8_STAGE(PG8_SA(1, 0), a3, voffA);
            PG8_BAR; PG8_WAIT_L(0); PG8_MMA(1, 0, At, B0); PG8_BAR; PG8_SCHED;
            PG8_STAGE(PG8_SB(1, 1), b3 + hstep, voffB);
            PG8_WAIT_V(6); PG8_BAR; PG8_MMA(1, 1, At, B1); PG8_BAR;
            }
        }
        if constexpr (ALIGN_EPI) { if (wr == 0) PG8_BAR; }
        if constexpr (!Epi::AFTER_DRAIN) { E(acc, cur, wr, wc, fr, fq); S.done(cur); }
        if (!has_next) break;
#pragma unroll
        for (int a = 0; a < 2; ++a)
#pragma unroll
            for (int b = 0; b < 2; ++b)
#pragma unroll
                for (int m = 0; m < 4; ++m)
#pragma unroll
                    for (int n = 0; n < 2; ++n) acc[a][b][m][n] = (f32x4){0.f, 0.f, 0.f, 0.f};
        cur = nxt; cA = nA; cB = nB; ++ui;
        if constexpr (ALIGN_EPI) { if (wr == 1) PG8_BAR; }
    }
    PG8_WAIT_V(0);
    if constexpr (!ALIGN_EPI) { if (wr == 0) PG8_BAR; }
    PG8_BAR;
    if constexpr (Epi::AFTER_DRAIN) { E.fused(acc, cur, wr, wc, fr, fq, lds, wid, lane); S.done(cur); }
#undef PG8_SA
#undef PG8_SB
#undef PG8_STAGE
#undef PG8_LDA
#undef PG8_LDB
#undef PG8_MMA
#undef PG8_WAIT_V
#undef PG8_WAIT_L
#undef PG8_BAR
#undef PG8_SCHED
}
}

template <class E0> struct EpiAdapt {
    static constexpr bool PERM = false, AFTER_DRAIN = false;
    E0 e;
    __device__ __forceinline__ void operator()(const pg8::f32x4 (&acc)[2][2][4][2], const pg8::Unit& u, int wr, int wc, int fr, int fq) const {
#pragma unroll
        for (int ai = 0; ai < 2; ++ai)
#pragma unroll
            for (int m = 0; m < 4; ++m) {
                const int row = u.pm * 256 + ai * 128 + wr * 64 + m * 16 + fr;
                const float rs = e.row_begin(row, fq);
                float ss = 0.f;
#pragma unroll
                for (int bj = 0; bj < 2; ++bj) ss += e.item(row, u.pn * 256 + bj * 128 + wc * 32 + 4 * fq, acc[ai][bj][m][0], acc[ai][bj][m][1], rs);
                if constexpr (E0::STATS) { ss += __shfl_xor(ss, 16); ss += __shfl_xor(ss, 32); if (fq == 0) e.stats[(size_t)row * 16 + u.pn * 4 + wc] = ss; }
            }
    }
};
template <class E0>
__device__ __forceinline__ void gemm_both(Ctx& C, const bf16_t* A, const bf16_t* Bt, int Mbig, int N, int K, const E0& E, int ctx_n_lo, int ctx_n_hi) {
    { pg8::Gemm g{A, Bt, Mbig, N, K}; pg8::StaticOrder S; S.init(Mbig, N, C.G, C.bid); EpiAdapt<E0> EA{E};
      pg8::gemm_phase<EpiAdapt<E0>, pg8::StaticOrder, true, true>(C.lds, g, S, EA); }
    if (Mbig < R && ctx_n_hi > ctx_n_lo) sgemm_small(C, A, Bt, Mbig, R - Mbig, N, K, E, ctx_n_lo, ctx_n_hi);
}
__device__ __forceinline__ void dwconv_phase(Ctx& C, int j) {
    const bf16_t* U = (const bf16_t*)(C.ws + WS_U); bf16_t* A2 = (bf16_t*)(C.ws + WS_A2);
    const float* dww = C.in[10] + (size_t)j * CK * 1024; const float* dwb = C.in[11] + j * 1024; const float* lng = C.in[12] + j * 1024; const float* lnb = C.in[13] + j * 1024;
    LAS unsigned char* tile = C.lds; LAS float* part = (LAS float*)(C.lds + 62 * 2048);
    const int tid = C.tid;
    for (int u = C.bid; u < 520; u += C.G) {
        const int base = u < 512 ? 0 : T, n = u < 512 ? T : TC, t0 = 32 * (u < 512 ? u : u - 512);
        for (int idx = tid; idx < 62 * 128; idx += 512) {
            const int rr = idx >> 7, ch = idx & 127, tt = t0 - 15 + rr;
            u32x4 v = {0u, 0u, 0u, 0u};
            if (tt >= 0 && tt < n) v = *(const u32x4*)(U + (size_t)(base + tt) * 1024 + ch * 8);
            *(LAS u32x4*)(tile + rr * 2048 + ch * 16) = v;
        }
        __syncthreads();
        float o0[32], o1[32];
        { const f32x2 b2 = *(const f32x2*)(dwb + 2 * tid);
#pragma unroll
          for (int t = 0; t < 32; ++t) { o0[t] = b2.x; o1[t] = b2.y; } }
        for (int jt = 0; jt < CK; ++jt) {
            const f32x2 w = *(const f32x2*)(dww + jt * 1024 + 2 * tid);
            const LAS unsigned char* p = tile + jt * 2048 + tid * 4;
#pragma unroll
            for (int t = 0; t < 32; ++t) { const unsigned uu = *(const LAS unsigned*)(p + t * 2048); o0[t] += w.x * bflo(uu); o1[t] += w.y * bfhi(uu); }
        }
#pragma unroll
        for (int t = 0; t < 32; ++t) {
            float s = o0[t] + o1[t], q = o0[t] * o0[t] + o1[t] * o1[t];
#pragma unroll
            for (int off = 1; off < 64; off <<= 1) { s += __shfl_xor(s, off); q += __shfl_xor(q, off); }
            if (C.lane == 0) { part[(t * 8 + C.wave) * 2] = s; part[(t * 8 + C.wave) * 2 + 1] = q; }
        }
        __syncthreads();
        const f32x2 g2 = *(const f32x2*)(lng + 2 * tid), bb2 = *(const f32x2*)(lnb + 2 * tid);
#pragma unroll
        for (int t = 0; t < 32; ++t) {
            float s = 0.f, q = 0.f;
#pragma unroll
            for (int w = 0; w < 8; ++w) { s += part[(t * 8 + w) * 2]; q += part[(t * 8 + w) * 2 + 1]; }
            const float mean = s * (1.f / 1024.f), var = q * (1.f / 1024.f) - mean * mean, rstd = 1.0f / sqrtf(var + LN_EPS);
            const float y0 = (o0[t] - mean) * rstd * g2.x + bb2.x, y1 = (o1[t] - mean) * rstd * g2.y + bb2.y;
            *(unsigned*)(A2 + (size_t)(base + t0 + t) * 1024 + 2 * tid) = pk2(siluf(y0), siluf(y1));
        }
        __syncthreads();
    }
}

__device__ __forceinline__ void scan_phase(Ctx& C, int j) {
    const bf16_t* Kb = (const bf16_t*)(C.ws + WS_K); const bf16_t* Vt = (const bf16_t*)(C.ws + WS_VT); bf16_t* Scp = (bf16_t*)(C.ws + WS_SCP);
    constexpr int KP = 80;
    LAS bf16_t* kbuf = (LAS bf16_t*)C.lds;
    const int fr = C.lane & 15, fq = C.lane >> 4, w = C.wave, tid = C.tid;
    for (int cu = C.bid; cu < 256; cu += C.G) {
        const int hd = cu >> 5, h = hd >> 1, dir = hd & 1, dk_s = 64 * ((cu >> 3) & 3), dv_s = 64 * (cu & 7);
        const int mt = w >> 1, nh = w & 1, dkl = 16 * mt, dv0 = dv_s + 32 * nh;
        const float gam = 1.0f - exp2f(C.in[17][(j * 2 + dir) * 4 + h]); const float L = log2f(gam);
        const float cdec = exp2f(L * 256.f);
        float kdr[4];
#pragma unroll
        for (int i = 0; i < 4; ++i) { const int row = (tid >> 3) + 64 * i; kdr[i] = exp2f(L * (float)(dir == 0 ? 255 - row : row)); }
        const int srow = tid >> 3, sch = tid & 7;
        f32x4 acc[2]; acc[0] = (f32x4){0.f, 0.f, 0.f, 0.f}; acc[1] = acc[0];
        u32x4 kreg[4]; bf16x8 vnext[2][8];
        auto tok_of = [&](int st) { return st == 0 ? T : 256 * (dir == 0 ? st - 1 : 64 - st); };
        {   const int tok0 = tok_of(0);
#pragma unroll
            for (int i = 0; i < 4; ++i) kreg[i] = *(const u32x4*)(Kb + (size_t)(tok0 + srow + 64 * i) * 1024 + h * 256 + dk_s + 8 * sch);
#pragma unroll
            for (int nt = 0; nt < 2; ++nt)
#pragma unroll
                for (int ks = 0; ks < 8; ++ks) vnext[nt][ks] = *(const bf16x8*)(Vt + (size_t)(h * 512 + dv0 + 16 * nt + fr) * R + tok0 + 32 * ks + 8 * fq);
        }
#pragma unroll 1
        for (int st = 0; st < 65; ++st) {
            LAS bf16_t* kb = kbuf + (st & 1) * 256 * KP;
#pragma unroll
            for (int i = 0; i < 4; ++i) {
                const u32x4 r = kreg[i]; const float d = kdr[i]; u32x4 o;
                o.x = pk2(bflo(r.x) * d, bfhi(r.x) * d); o.y = pk2(bflo(r.y) * d, bfhi(r.y) * d); o.z = pk2(bflo(r.z) * d, bfhi(r.z) * d); o.w = pk2(bflo(r.w) * d, bfhi(r.w) * d);
                *(LAS u32x4*)(kb + (srow + 64 * i) * KP + 8 * sch) = o;
            }
            bf16x8 vcur[2][8];
#pragma unroll
            for (int nt = 0; nt < 2; ++nt)
#pragma unroll
                for (int ks = 0; ks < 8; ++ks) vcur[nt][ks] = vnext[nt][ks];
            __syncthreads();
            if (st + 1 < 65) {
                const int tok1 = tok_of(st + 1);
#pragma unroll
                for (int i = 0; i < 4; ++i) kreg[i] = *(const u32x4*)(Kb + (size_t)(tok1 + srow + 64 * i) * 1024 + h * 256 + dk_s + 8 * sch);
#pragma unroll
                for (int nt = 0; nt < 2; ++nt)
#pragma unroll
                    for (int ks = 0; ks < 8; ++ks) vnext[nt][ks] = *(const bf16x8*)(Vt + (size_t)(h * 512 + dv0 + 16 * nt + fr) * R + tok1 + 32 * ks + 8 * fq);
            }
            const int sl = dir == 0 ? st - 1 : 64 - st;
            const bool cp = st == 0 || (dir == 0 ? (sl & 1) == 0 : (sl & 1) == 1);
            if (cp) {
                const int slot = st == 0 ? 32 : (sl >> 1);
                bf16_t* sp = Scp + ((size_t)((slot * 4 + h) * 2 + dir) * 512) * 256;
#pragma unroll
                for (int nt = 0; nt < 2; ++nt) { u32x2 wv; wv.x = pk2(acc[nt][0], acc[nt][1]); wv.y = pk2(acc[nt][2], acc[nt][3]);
                    *(u32x2*)(sp + (size_t)(dv0 + 16 * nt + fr) * 256 + dk_s + dkl + 4 * fq) = wv; }
            }
            acc[0] = acc[0] * cdec; acc[1] = acc[1] * cdec;
#pragma unroll
            for (int ks = 0; ks < 8; ++ks) {
                const LAS bf16_t* kp = kb + (32 * ks + 8 * fq) * KP + dkl + fr;
                u32x4 pk;
                pk.x = (unsigned)kp[0 * KP] | ((unsigned)kp[1 * KP] << 16); pk.y = (unsigned)kp[2 * KP] | ((unsigned)kp[3 * KP] << 16);
                pk.z = (unsigned)kp[4 * KP] | ((unsigned)kp[5 * KP] << 16); pk.w = (unsigned)kp[6 * KP] | ((unsigned)kp[7 * KP] << 16);
                const bf16x8 af = __builtin_bit_cast(bf16x8, pk);
#pragma unroll
                for (int nt = 0; nt < 2; ++nt) acc[nt] = __builtin_amdgcn_mfma_f32_16x16x32_bf16(af, vcur[nt][ks], acc[nt], 0, 0, 0);
            }
        }
        __syncthreads();
    }
}

__device__ __forceinline__ void readout_phase(Ctx& C, int j, bool skip_ctx) {
    const bf16_t* Q = (const bf16_t*)(C.ws + WS_Q); const bf16_t* Kb = (const bf16_t*)(C.ws + WS_K); const bf16_t* Vt = (const bf16_t*)(C.ws + WS_VT);
    const bf16_t* Scp = (const bf16_t*)(C.ws + WS_SCP); bf16_t* GF = (bf16_t*)(C.ws + WS_GF); const bf16_t* GB = (const bf16_t*)(C.ws + WS_GB);
    constexpr int QP = 264, PP = 136;
    LAS bf16_t* Qs = (LAS bf16_t*)C.lds;
    LAS bf16_t* Pb = (LAS bf16_t*)(C.lds + 64 * QP * 2);
    LAS float* red = (LAS float*)(C.lds + 64 * QP * 2 + 2 * 64 * PP * 2);
    const int fr = C.lane & 15, fq = C.lane >> 4, w = C.wave, tid = C.tid;
    const int nunits = skip_ctx ? 512 : 520;
    for (int u = C.bid; u < nunits; u += C.G) {
        const int h = u & 3, b = u >> 2;
        const bool lat = b < 128; const int base = lat ? 0 : T, nb = lat ? 128 : 2, bl = lat ? b : b - 128;
        const int g = bl >> 2, slot = lat ? g : 32;
        const int gend = (4 * (g + 1) < nb ? 4 * (g + 1) : nb);
#pragma unroll 1
        for (int rh = 0; rh < 2; ++rh) {
            const int i0 = base + 128 * bl + 64 * rh, il0 = 128 * bl + 64 * rh;
            __syncthreads();
#pragma unroll
            for (int i = 0; i < 4; ++i) { const int c = tid + 512 * i, row = c >> 5, ch = c & 31;
                *(LAS u32x4*)(Qs + row * QP + 8 * ch) = *(const u32x4*)(Q + (size_t)(i0 + row) * 1024 + h * 256 + 8 * ch); }
            __syncthreads();
#pragma unroll 1
            for (int dir = 0; dir < 2; ++dir) {
                const float gam = 1.0f - exp2f(C.in[17][(j * 2 + dir) * 4 + h]); const float L = log2f(gam);
                f32x4 acc[4][4];
#pragma unroll
                for (int mt = 0; mt < 4; ++mt)
#pragma unroll
                    for (int nt = 0; nt < 4; ++nt) acc[mt][nt] = (f32x4){0.f, 0.f, 0.f, 0.f};
                const bf16_t* sb = Scp + ((size_t)((slot * 4 + h) * 2 + dir) * 512) * 256 + (size_t)(64 * w + fr) * 256 + 8 * fq;
#pragma unroll
                for (int half = 0; half < 2; ++half) {
                    bf16x8 sf[4][4];
#pragma unroll
                    for (int k4 = 0; k4 < 4; ++k4)
#pragma unroll
                        for (int nt = 0; nt < 4; ++nt) sf[k4][nt] = *(const bf16x8*)(sb + (size_t)(16 * nt) * 256 + 32 * (4 * half + k4));
#pragma unroll
                    for (int k4 = 0; k4 < 4; ++k4)
#pragma unroll
                        for (int mt = 0; mt < 4; ++mt) { const bf16x8 qf = *(const LAS bf16x8*)(Qs + (16 * mt + fr) * QP + 32 * (4 * half + k4) + 8 * fq);
#pragma unroll
                            for (int nt = 0; nt < 4; ++nt) acc[mt][nt] = __builtin_amdgcn_mfma_f32_16x16x32_bf16(sf[k4][nt], qf, acc[mt][nt], 0, 0, 0); }
                }
#pragma unroll
                for (int mt = 0; mt < 4; ++mt) {
                    const int il = il0 + 16 * mt + fr;
                    const int ex = dir == 0 ? il - 512 * g + 1 : gend * 128 - il;
                    const float qd = exp2f(L * (float)ex);
#pragma unroll
                    for (int nt = 0; nt < 4; ++nt) acc[mt][nt] = acc[mt][nt] * qd;
                }
                const int kb_lo = dir == 0 ? 4 * g : bl, kb_hi = dir == 0 ? bl : gend - 1;
                int pbuf = 0;
#pragma unroll 1
                for (int kb = kb_lo; kb <= kb_hi; ++kb) {
                    const int j0 = base + 128 * kb;
                    bf16x8 kf[8], vf[4][4];
                    { const bf16_t* k1 = Kb + (size_t)(j0 + 16 * w + fr) * 1024 + h * 256 + 8 * fq;
#pragma unroll
                      for (int ks = 0; ks < 8; ++ks) kf[ks] = *(const bf16x8*)(k1 + 32 * ks);
                      const bf16_t* vb = Vt + (size_t)(h * 512 + 64 * w + fr) * R + j0 + 8 * fq;
#pragma unroll
                      for (int ks = 0; ks < 4; ++ks)
#pragma unroll
                          for (int nt = 0; nt < 4; ++nt) vf[ks][nt] = *(const bf16x8*)(vb + (size_t)(16 * nt) * R + 32 * ks); }
                    f32x4 sc[4];
#pragma unroll
                    for (int mt = 0; mt < 4; ++mt) sc[mt] = (f32x4){0.f, 0.f, 0.f, 0.f};
#pragma unroll
                    for (int ks = 0; ks < 8; ++ks)
#pragma unroll
                        for (int mt = 0; mt < 4; ++mt) { const bf16x8 qf = *(const LAS bf16x8*)(Qs + (16 * mt + fr) * QP + 32 * ks + 8 * fq);
                            sc[mt] = __builtin_amdgcn_mfma_f32_16x16x32_bf16(kf[ks], qf, sc[mt], 0, 0, 0); }
                    LAS bf16_t* P = Pb + pbuf * 64 * PP;
#pragma unroll
                    for (int mt = 0; mt < 4; ++mt) {
                        const int il = il0 + 16 * mt + fr;
                        float p[4];
#pragma unroll
                        for (int e = 0; e < 4; ++e) { const int jl = 128 * kb + 16 * w + 4 * fq + e; const int rel = dir == 0 ? il - jl : jl - il;
                            p[e] = rel >= 0 ? sc[mt][e] * exp2f(L * (float)rel) : 0.f; }
                        u32x2 wv; wv.x = pk2(p[0], p[1]); wv.y = pk2(p[2], p[3]);
                        *(LAS u32x2*)(P + (16 * mt + fr) * PP + 16 * w + 4 * fq) = wv;
                    }
                    __syncthreads();
#pragma unroll
                    for (int ks = 0; ks < 4; ++ks)
#pragma unroll
                        for (int mt = 0; mt < 4; ++mt) { const bf16x8 pf = *(const LAS bf16x8*)(P + (16 * mt + fr) * PP + 32 * ks + 8 * fq);
#pragma unroll
                            for (int nt = 0; nt < 4; ++nt) acc[mt][nt] = __builtin_amdgcn_mfma_f32_16x16x32_bf16(vf[ks][nt], pf, acc[mt][nt], 0, 0, 0); }
                    pbuf ^= 1;
                }
#pragma unroll
                for (int mt = 0; mt < 4; ++mt) {
                    float ss = 0.f;
#pragma unroll
                    for (int nt = 0; nt < 4; ++nt) ss += (acc[mt][nt][0] * acc[mt][nt][0] + acc[mt][nt][1] * acc[mt][nt][1]) + (acc[mt][nt][2] * acc[mt][nt][2] + acc[mt][nt][3] * acc[mt][nt][3]);
                    ss += __shfl_xor(ss, 16); ss += __shfl_xor(ss, 32);
                    if (fq == 0) red[(16 * mt + fr) * 8 + w] = ss;
                }
                __syncthreads();
#pragma unroll
                for (int mt = 0; mt < 4; ++mt) {
                    float tot = 0.f;
#pragma unroll
                    for (int w2 = 0; w2 < 8; ++w2) tot += red[(16 * mt + fr) * 8 + w2];
                    const float rn = 1.0f / sqrtf(tot * (1.f / 512.f) + NORM_EPS);
                    const size_t off = (size_t)(i0 + 16 * mt + fr) * 2048 + h * 512 + 64 * w + 4 * fq;
#pragma unroll
                    for (int nt = 0; nt < 4; ++nt) {
                        const u32x2 gg = *(const u32x2*)((dir == 0 ? (const bf16_t*)GF : GB) + off + 16 * nt);
                        float y0 = siluf(bflo(gg.x)) * acc[mt][nt][0] * rn, y1 = siluf(bfhi(gg.x)) * acc[mt][nt][1] * rn;
                        float y2 = siluf(bflo(gg.y)) * acc[mt][nt][2] * rn, y3 = siluf(bfhi(gg.y)) * acc[mt][nt][3] * rn;
                        if (dir == 1) { const u32x2 yp = *(const u32x2*)(GF + off + 16 * nt); y0 += bflo(yp.x); y1 += bfhi(yp.x); y2 += bflo(yp.y); y3 += bfhi(yp.y); }
                        u32x2 wv; wv.x = pk2(y0, y1); wv.y = pk2(y2, y3);
                        *(u32x2*)(GF + off + 16 * nt) = wv;
                    }
                }
            }
        }
    }
}

__device__ __forceinline__ void phase_p0(Ctx& C) {
    float* modv = (float*)(C.ws + WS_MODV);
    for (int u = C.bid; u < 384; u += C.G) {
        const int i = u / 96, nbk = u % 96;
        gemv2_unit<1>(C, C.in[4] + (size_t)i * 1024 * 6144, 6144, 64 * nbk, C.in[1], C.in[3], C.in[5] + i * 6144, modv + (i * 2 + 0) * 6144, modv + (i * 2 + 1) * 6144, 0, 0);
    }
    float* tabc = (float*)(C.ws + WS_TABC); float* tabs = (float*)(C.ws + WS_TABS);
    for (int idx = C.bid * 512 + C.tid; idx < 320 * 64; idx += C.G * 512) {
        const int ti = idx >> 6, i = idx & 63; const float pos = (float)(ti < 256 ? ti : ti - 256);
        const float inv = exp2f(-(float)i * (13.287712379549449f / 64.0f)); const float ang = pos * inv;
        tabc[idx] = __cosf(ang); tabs[idx] = __sinf(ang);
    }
}
__device__ __forceinline__ void phase_p1(Ctx& C) {
    const float* modv = (const float*)(C.ws + WS_MODV);
    float* s1 = (float*)(C.ws + WS_S1); float* s2 = (float*)(C.ws + WS_S2);
    for (int idx = C.bid * 512 + C.tid; idx < 8192; idx += C.G * 512) {
        const int i = idx >> 11, s = (idx >> 10) & 1, k = idx & 1023;
        s1[idx] = C.in[6][i * 1024 + k] * (1.f + modv[(i * 2 + s) * 6144 + 1024 + k]);
        s2[idx] = C.in[7][i * 1024 + k] * (1.f + modv[(i * 2 + s) * 6144 + 4096 + k]);
    }
    float* cvA = (float*)(C.ws + WS_CVA); float* cvF = (float*)(C.ws + WS_CVF);
    for (int u = C.bid; u < 672; u += C.G) {
        if (u < 320) {
            int i, nbk; if (u < 32) { i = 0; nbk = u; } else if (u < 160) { i = 1; nbk = u - 32; } else if (u < 192) { i = 2; nbk = u - 160; } else { i = 3; nbk = u - 192; }
            const int j = i >> 1; const float* v0 = modv + (i * 2 + 0) * 6144; const float* v1 = modv + (i * 2 + 1) * 6144;
            if ((i & 1) == 0) gemv2_unit<0>(C, C.in[8] + (size_t)j * 1024 * 2048, 2048, 64 * nbk, v0, v1, C.in[9] + j * 2048, cvA + (i * 2) * 8192, cvA + (i * 2 + 1) * 8192, 1, 1024);
            else gemv2_unit<0>(C, C.in[16] + (size_t)j * 1024 * 8192, 8192, 64 * nbk, v0, v1, nullptr, cvA + (i * 2) * 8192, cvA + (i * 2 + 1) * 8192, 2, 0);
        } else {
            const int i = (u - 320) / 88, nbk = (u - 320) % 88;
            const float* v0 = modv + (i * 2 + 0) * 6144 + 3072; const float* v1 = modv + (i * 2 + 1) * 6144 + 3072;
            gemv2_unit<0>(C, C.in[19] + (size_t)i * 1024 * FF2, FF2, 64 * nbk, v0, v1, nullptr, cvF + (i * 2) * FF2, cvF + (i * 2 + 1) * FF2, 1, DFF);
        }
    }
    bf16_t* xs = (bf16_t*)(C.ws + WS_XS); float* stats = (float*)(C.ws + WS_STATS); float* xctx = (float*)(C.ws + WS_XCTX);
    for (int row = C.bid * 8 + C.wave; row < R; row += C.G * 8) {
        const bool lat = row < T; const int s = lat ? 0 : 1;
        const float* src = lat ? C.in[0] + (size_t)row * 1024 : C.in[2] + (size_t)(row - T) * 1024;
        float* dst = lat ? C.out + (size_t)row * 1024 : xctx + (size_t)(row - T) * 1024;
        float ss = 0.f;
#pragma unroll
        for (int jj = 0; jj < 4; ++jj) {
            const int k = 4 * C.lane + 256 * jj;
            const f32x4 v = *(const f32x4*)(src + k); *(f32x4*)(dst + k) = v;
            ss += (v[0] * v[0] + v[1] * v[1]) + (v[2] * v[2] + v[3] * v[3]);
            const f32x4 g = *(const f32x4*)(C.in[6] + k), m = *(const f32x4*)(modv + s * 6144 + 1024 + k);
            u32x2 w; w.x = pk2(v[0] * g[0] * (1.f + m[0]), v[1] * g[1] * (1.f + m[1])); w.y = pk2(v[2] * g[2] * (1.f + m[2]), v[3] * g[3] * (1.f + m[3]));
            *(u32x2*)(xs + (size_t)row * 1024 + k) = w;
        }
#pragma unroll
        for (int off = 1; off < 64; off <<= 1) ss += __shfl_xor(ss, off);
        if (C.lane < 16) stats[(size_t)row * 16 + C.lane] = C.lane == 0 ? ss : 0.f;
    }
    prep_layer(C, 0);
}
__device__ __forceinline__ void phase_final(Ctx& C) {
    const float* stats = (const float*)(C.ws + WS_STATS);
    for (int row = C.bid * 8 + C.wave; row < T; row += C.G * 8) {
        float s = C.lane < 16 ? stats[(size_t)row * 16 + C.lane] : 0.f;
#pragma unroll
        for (int off = 1; off < 64; off <<= 1) s += __shfl_xor(s, off);
        const float r = 1.0f / sqrtf(s * (1.f / 1024.f) + NORM_EPS);
        float* xr = C.out + (size_t)row * 1024;
#pragma unroll
        for (int jj = 0; jj < 4; ++jj) { const int k = 4 * C.lane + 256 * jj; const f32x4 v = *(const f32x4*)(xr + k), g = *(const f32x4*)(C.in[21] + k); *(f32x4*)(xr + k) = v * r * g; }
    }
}

constexpr int NPHASE = 31;
__device__ __forceinline__ void run_phase(Ctx& C, int ph) {
    const int i = (ph - 2) / 7, sub = (ph - 2) % 7, j = i >> 1; const bool conv = (i & 1) == 0;
    const bool last = i == DEPTH - 1;
    float* stats = (float*)(C.ws + WS_STATS);
    const bf16_t* xs = (const bf16_t*)(C.ws + WS_XS);
    constexpr int F_MODV = (int)(WS_MODV / 4), F_S1 = (int)(WS_S1 / 4), F_S2 = (int)(WS_S2 / 4), F_CVA = (int)(WS_CVA / 4), F_CVF = (int)(WS_CVF / 4);
    if (sub == 1) {
        if (conv) { EpiGLU E{C.ws, F_CVA + (i * 2) * 8192, 8192, (int)WS_U, 1024, 0, stats}; gemm_both(C, xs, (const bf16_t*)(C.ws + WS_WA), T, 2048, 1024, E, 0, 8); }
        else { EpiWin E{C.ws, F_CVA + (i * 2) * 8192, stats}; gemm_both(C, xs, (const bf16_t*)(C.ws + WS_WA), T, 8192, 1024, E, last ? 4 : 0, last ? 16 : 32); }
    } else if (sub == 5) {
        EpiGLU E{C.ws, F_CVF + (i * 2) * FF2, FF2, (int)WS_H, DFF, 1, stats}; gemm_both(C, xs, (const bf16_t*)(C.ws + WS_WF1), last ? T : R, FF2, 1024, E, 0, 0);
    } else {
        const bool f2 = sub == 6;
        const int mgoff = F_MODV + (i * 2) * 6144 + (f2 ? 5120 : 2048);
        const int snoff = f2 ? (last ? -1 : F_S1 + ((i + 1) * 2) * 1024) : F_S2 + (i * 2) * 1024;
        const float* bias = (!f2 && conv) ? C.in[15] + j * 1024 : nullptr;
        const bf16_t* A = (const bf16_t*)(C.ws + (f2 ? WS_H : (conv ? WS_A2 : WS_GF)));
        const bf16_t* Bt = (const bf16_t*)(C.ws + (f2 ? WS_WF2 : WS_WA2));
        const int K = f2 ? DFF : (conv ? 1024 : 2048);
        EpiRes E{C.ws, C.out, bias, mgoff, snoff, stats};
        gemm_both(C, A, Bt, T, 1024, K, E, 0, last ? 0 : 4);
    }
}

#define XB_TMO      128
#define XB_XCNT(j)  (256  + 64 * (j))
#define XB_XSUB(j)  (1280 + 64 * (j))
#define XB_XGEN(j)  (2304 + 64 * (j))
#define XB_TOP      3328
#define XB_TOPGEN   3392
#define XCD_BAR_WORDS 3456
#define XB_SPIN_CAP (1u << 20)
__device__ __forceinline__ unsigned xb_ld(unsigned* p)              { return __hip_atomic_load(p, __ATOMIC_RELAXED, __HIP_MEMORY_SCOPE_AGENT); }
__device__ __forceinline__ unsigned xb_add(unsigned* p, unsigned v) { return __hip_atomic_fetch_add(p, v, __ATOMIC_RELAXED, __HIP_MEMORY_SCOPE_AGENT); }
__device__ __forceinline__ unsigned xb_xcc_id() { return (unsigned)__builtin_amdgcn_s_getreg((3 << 11) | 20) & 0xFu; }
#define XB_SPIN(cond, bar) do { unsigned _sp = 0; while (cond) { __builtin_amdgcn_s_sleep(1); \
    if ((++_sp & 255u) == 0u) { if (xb_ld(&(bar)[XB_TMO])) break; if (_sp > XB_SPIN_CAP) { atomicAdd(&(bar)[XB_TMO], 1u); break; } } } } while (0)
struct XcdBarrier { unsigned* bar; unsigned x; volatile LAS unsigned* st; };
__device__ __forceinline__ XcdBarrier xcd_barrier_post(unsigned* bar, volatile LAS unsigned* st) {
    XcdBarrier b; b.bar = bar; b.x = xb_xcc_id(); b.st = st;
    if (threadIdx.x == 0) (void)xb_add(&bar[XB_XCNT(b.x)], 1u);
    return b;
}
__device__ __forceinline__ void xcd_barrier_complete(unsigned* bar, unsigned x, unsigned& nloc, unsigned& nx) {
    const unsigned G = gridDim.x * gridDim.y * gridDim.z;
    unsigned sum, cnt, mine, sp = 0u;
    for (;;) {
        sum = 0u; cnt = 0u; mine = 0u;
#pragma unroll
        for (unsigned j = 0; j < 16; ++j) { const unsigned c = xb_ld(&bar[XB_XCNT(j)]); sum += c; cnt += (c > 0u) ? 1u : 0u; mine = (j == x) ? c : mine; }
        if (sum == G) break;
        __builtin_amdgcn_s_sleep(1);
        if ((++sp & 255u) == 0u) { if (xb_ld(&bar[XB_TMO])) break; if (sp > XB_SPIN_CAP) { atomicAdd(&bar[XB_TMO], 1u); break; } }
    }
    nloc = mine > 0u ? mine : 1u; nx = cnt > 0u ? cnt : 1u;
}
__device__ __forceinline__ void xcd_barrier(const XcdBarrier& b) {
    asm volatile("s_waitcnt vmcnt(0)" ::: "memory");
    __syncthreads();
    if (threadIdx.x == 0) {
        unsigned* bar = b.bar;
        __builtin_amdgcn_s_waitcnt(0);
        unsigned nloc = b.st[0], nx = b.st[1];
        if (nloc == 0u) { xcd_barrier_complete(bar, b.x, nloc, nx); b.st[0] = nloc; b.st[1] = nx; }
        const unsigned old = xb_add(&bar[XB_XSUB(b.x)], 1u);
        const unsigned gen = old / nloc;
        if (old + 1u == (gen + 1u) * nloc) {
            __builtin_amdgcn_fence(__ATOMIC_RELEASE, "agent");
            asm volatile("s_waitcnt vmcnt(0)" ::: "memory");
            const unsigned og = xb_add(&bar[XB_TOP], 1u);
            const unsigned tg = og / nx;
            if (og + 1u == (tg + 1u) * nx) xb_add(&bar[XB_TOPGEN], 1u);
            else XB_SPIN(xb_ld(&bar[XB_TOPGEN]) == tg, bar);
            __builtin_amdgcn_fence(__ATOMIC_ACQUIRE, "agent");
            xb_add(&bar[XB_XGEN(b.x)], 1u);
            asm volatile("s_waitcnt vmcnt(0)" ::: "memory");
        } else {
            XB_SPIN(xb_ld(&bar[XB_XGEN(b.x)]) == gen, bar);
            __builtin_amdgcn_fence(__ATOMIC_ACQUIRE, "agent");
            asm volatile("s_waitcnt vmcnt(0)" ::: "memory");
        }
    }
    __syncthreads();
}
constexpr int MISC_OFF = 131072 + 320;
constexpr int CW_BAR = 4096;

template <int PH> __device__ __forceinline__ void one_phase(Ctx& C, const Args& args, const XcdBarrier& bar) {
    if (PH < args.ph_lo || PH >= args.ph_hi) return;
    constexpr int i = (PH - 2) / 7, sub = (PH - 2) % 7, j = i >> 1; constexpr bool conv = (i & 1) == 0;
    if (PH >= 2 && PH < 30) { if (sub == 0 && i == 0) return; if (sub == 3 && conv) return; }
    if (PH > args.ph_lo) xcd_barrier(bar);
    if (PH == 0) phase_p0(C);
    else if (PH == 1) phase_p1(C);
    else if (PH == 30) phase_final(C);
    else if (sub == 0) prep_layer(C, i);
    else if (sub == 2) { if (conv) dwconv_phase(C, j); else scan_phase(C, j); }
    else if (sub == 3) readout_phase(C, j, i == DEPTH - 1);
    else run_phase(C, PH);
}
template <int... PHS> __device__ __forceinline__ void all_phases(Ctx& C, const Args& args, const XcdBarrier& bar, std::integer_sequence<int, PHS...>) { (one_phase<PHS>(C, args, bar), ...); }
__global__ void __launch_bounds__(512, 2) mega_kernel(Args args) {
    extern __shared__ __attribute__((aligned(16))) unsigned char lds_raw[];
    Ctx C;
    C.lds = (LAS unsigned char*)lds_raw; C.tid = threadIdx.x; C.lane = C.tid & 63; C.wave = __builtin_amdgcn_readfirstlane(C.tid >> 6); C.G = gridDim.x; C.bid = blockIdx.x;
    C.in = args.in; C.out = args.out; C.ws = args.ws;
    volatile LAS unsigned* MISC = (volatile LAS unsigned*)(C.lds + MISC_OFF);
    if (C.tid < 32) MISC[C.tid] = 0u;
    __syncthreads();
    XcdBarrier bar = xcd_barrier_post((unsigned*)(C.ws + WS_CTL) + CW_BAR, MISC + 8);
    all_phases(C, args, bar, std::make_integer_sequence<int, NPHASE>{});
}

template <int KIND>
__global__ void __launch_bounds__(512, 2) phase_kernel(Args args) {
    extern __shared__ __attribute__((aligned(16))) unsigned char lds_raw[];
    Ctx C;
    C.lds = (LAS unsigned char*)lds_raw; C.tid = threadIdx.x; C.lane = C.tid & 63; C.wave = __builtin_amdgcn_readfirstlane(C.tid >> 6); C.G = gridDim.x; C.bid = blockIdx.x;
    C.in = args.in; C.out = args.out; C.ws = args.ws;
    const int ph = args.ph_lo;
    if (KIND == 0) phase_p0(C);
    else if (KIND == 1) phase_p1(C);
    else if (KIND == 30) phase_final(C);
    else {
        const int i = (ph - 2) / 7, j = i >> 1; const bool conv = (i & 1) == 0;
        if (KIND == 2) prep_layer(C, i);
        else if (KIND == 4) { if (conv) dwconv_phase(C, j); else scan_phase(C, j); }
        else if (KIND == 5) readout_phase(C, j, i == DEPTH - 1);
        else run_phase(C, ph);
    }
}

extern "C" void kernel_launch(void* const* d_in, const int* in_sizes, int n_in, void* d_out, int out_size, void* d_ws, size_t ws_size, hipStream_t stream) {
    static int grid = 0;
    if (grid == 0) {
        if (n_in != 22 || out_size != T * D || ws_size < WS_END) { fprintf(stderr, "kernel_launch: unexpected problem (n_in %d out %d ws %zu, need %zu)\n", n_in, out_size, ws_size, (size_t)WS_END); grid = -1; return; }
        int dev = 0, cus = 0;
        if (hipGetDevice(&dev) != hipSuccess || hipDeviceGetAttribute(&cus, hipDeviceAttributeMultiprocessorCount, dev) != hipSuccess) { grid = -1; return; }
        bool ok = true;
        ok &= hipFuncSetAttribute((const void*)phase_kernel<0>, hipFuncAttributeMaxDynamicSharedMemorySize, LDS_BYTES) == hipSuccess;
        ok &= hipFuncSetAttribute((const void*)phase_kernel<1>, hipFuncAttributeMaxDynamicSharedMemorySize, LDS_BYTES) == hipSuccess;
        ok &= hipFuncSetAttribute((const void*)phase_kernel<2>, hipFuncAttributeMaxDynamicSharedMemorySize, LDS_BYTES) == hipSuccess;
        ok &= hipFuncSetAttribute((const void*)phase_kernel<3>, hipFuncAttributeMaxDynamicSharedMemorySize, LDS_BYTES) == hipSuccess;
        ok &= hipFuncSetAttribute((const void*)phase_kernel<4>, hipFuncAttributeMaxDynamicSharedMemorySize, LDS_BYTES) == hipSuccess;
        ok &= hipFuncSetAttribute((const void*)phase_kernel<5>, hipFuncAttributeMaxDynamicSharedMemorySize, LDS_BYTES) == hipSuccess;
        ok &= hipFuncSetAttribute((const void*)phase_kernel<30>, hipFuncAttributeMaxDynamicSharedMemorySize, LDS_BYTES) == hipSuccess;
        ok &= hipFuncSetAttribute((const void*)mega_kernel, hipFuncAttributeMaxDynamicSharedMemorySize, LDS_BYTES) == hipSuccess;
        if (!ok) { fprintf(stderr, "kernel_launch: hipFuncSetAttribute failed\n"); grid = -1; return; }
        grid = cus > 0 ? cus : 256;
    }
    if (grid < 0) return;
    Args a{};
    for (int i = 0; i < 22; ++i) a.in[i] = (const float*)d_in[i];
    a.out = (float*)d_out; a.ws = (unsigned char*)d_ws;
#if ONE_LAUNCH
    if (hipMemsetAsync((char*)d_ws + WS_CTL, 0, 65536, stream) != hipSuccess) { fprintf(stderr, "kernel_launch: memset failed\n"); return; }
    a.ph_lo = 0; a.ph_hi = NPHASE;
    hipLaunchKernelGGL(mega_kernel, dim3(grid), dim3(512), LDS_BYTES, stream, a);
    return;
#endif
    for (int ph = 0; ph < NPHASE; ++ph) {
        const int i = (ph - 2) / 7, sub = (ph - 2) % 7;
        if (ph >= 2 && ph < 30) { if (sub == 0 && i == 0) continue; if (sub == 3 && (i & 1) == 0) continue; }
        a.ph_lo = ph; a.ph_hi = ph + 1;
        const dim3 g(grid), b(512);
        if (ph == 0) hipLaunchKernelGGL(phase_kernel<0>, g, b, LDS_BYTES, stream, a);
        else if (ph == 1) hipLaunchKernelGGL(phase_kernel<1>, g, b, LDS_BYTES, stream, a);
        else if (ph == 30) hipLaunchKernelGGL(phase_kernel<30>, g, b, LDS_BYTES, stream, a);
        else if (sub == 0) hipLaunchKernelGGL(phase_kernel<2>, g, b, LDS_BYTES, stream, a);
        else if (sub == 2) hipLaunchKernelGGL(phase_kernel<4>, g, b, LDS_BYTES, stream, a);
        else if (sub == 3) hipLaunchKernelGGL(phase_kernel<5>, g, b, LDS_BYTES, stream, a);
        else hipLaunchKernelGGL(phase_kernel<3>, g, b, LDS_BYTES, stream, a);
    }
}
```

```cpp
#include <hip/hip_runtime.h>
#include <cstdio>
#include <cstdint>
#include <utility>

#ifndef ONE_LAUNCH
#define ONE_LAUNCH 1
#endif

typedef unsigned short bf16_t;
typedef short bf16x8 __attribute__((ext_vector_type(8)));
typedef float f32x4 __attribute__((ext_vector_type(4)));
typedef float f32x2 __attribute__((ext_vector_type(2)));
typedef unsigned u32x2 __attribute__((ext_vector_type(2)));
typedef unsigned u32x4 __attribute__((ext_vector_type(4)));
typedef __bf16 bf16x2_t __attribute__((ext_vector_type(2)));
#define LAS __attribute__((address_space(3)))

constexpr int D = 1024, T = 16384, TC = 256, R = T + TC, NH = 4, DK = 256, DV = 512, QKW = 1024, VW = 2048, INW = 8192, DFF = 2816, FF2 = 5632, CK = 31, DEPTH = 4;
constexpr int NSLOT = 33;
constexpr float NORM_EPS = 1e-6f, LN_EPS = 1e-5f;

constexpr size_t MiB = 1u << 20, KiB = 1u << 10;
constexpr size_t WS_CTL = 0, CTL_ZERO_BYTES = 1 * MiB;
constexpr size_t WS_MODV = 1 * MiB;
constexpr size_t WS_S1 = 1 * MiB + 256 * KiB;
constexpr size_t WS_S2 = 1 * MiB + 320 * KiB;
constexpr size_t WS_CVA = 1 * MiB + 384 * KiB;
constexpr size_t WS_CVF = 1 * MiB + 640 * KiB;
constexpr size_t WS_TABC = 1 * MiB + 832 * KiB;
constexpr size_t WS_TABS = 1 * MiB + 912 * KiB;
constexpr size_t WS_STATS = 2 * MiB;
constexpr size_t WS_XCTX = 4 * MiB;
constexpr size_t WS_WA = 8 * MiB;
constexpr size_t WS_WA2 = 24 * MiB;
constexpr size_t WS_WF1 = 28 * MiB;
constexpr size_t WS_WF2 = 40 * MiB;
constexpr size_t WS_XS = 48 * MiB;
constexpr size_t WS_SCP = 48 * MiB;
constexpr size_t WS_BIG = 114 * MiB;
constexpr size_t WS_Q = WS_BIG, WS_K = WS_BIG + 33 * MiB, WS_VT = WS_BIG + 66 * MiB, WS_GF = WS_BIG + 131 * MiB, WS_GB = WS_BIG + 196 * MiB;
constexpr size_t WS_U = WS_BIG, WS_A2 = WS_BIG + 33 * MiB, WS_H = WS_BIG;
constexpr size_t WS_END = WS_BIG + 261 * MiB;
static_assert((size_t)R * 1024 * 2 <= 33 * MiB && (size_t)R * 2048 * 2 <= 65 * MiB && (size_t)R * DFF * 2 <= 131 * MiB, "map");
static_assert((size_t)NSLOT * 8 * 512 * 256 * 2 <= 66 * MiB, "scp");

constexpr int LDS_BYTES = 147456;

__device__ __forceinline__ unsigned pk2(float lo, float hi) { f32x2 v = {lo, hi}; bf16x2_t b = __builtin_convertvector(v, bf16x2_t); return __builtin_bit_cast(unsigned, b); }
__device__ __forceinline__ float bflo(unsigned u) { return __uint_as_float(u << 16); }
__device__ __forceinline__ float bfhi(unsigned u) { return __uint_as_float(u & 0xffff0000u); }
__device__ __forceinline__ float siluf(float x) { return x / (1.f + __expf(-x)); }
__device__ __forceinline__ float sigmf(float x) { return 1.f / (1.f + __expf(-x)); }
__device__ __forceinline__ float wave_sum63(float v) {
    v += __builtin_bit_cast(float, __builtin_amdgcn_update_dpp(0, __builtin_bit_cast(int, v), 0xB1, 0xF, 0xF, false));
    v += __builtin_bit_cast(float, __builtin_amdgcn_update_dpp(0, __builtin_bit_cast(int, v), 0x4E, 0xF, 0xF, false));
    v += __builtin_bit_cast(float, __builtin_amdgcn_update_dpp(0, __builtin_bit_cast(int, v), 0x141, 0xF, 0xF, false));
    v += __builtin_bit_cast(float, __builtin_amdgcn_update_dpp(0, __builtin_bit_cast(int, v), 0x140, 0xF, 0xF, false));
    v += __builtin_bit_cast(float, __builtin_amdgcn_update_dpp(0, __builtin_bit_cast(int, v), 0x142, 0xA, 0xF, false));
    v += __builtin_bit_cast(float, __builtin_amdgcn_update_dpp(0, __builtin_bit_cast(int, v), 0x143, 0xC, 0xF, false));
    return v;
}
__device__ __forceinline__ int perm_glu(int n, int H) { if (n < H) return 32 * (n >> 4) + (n & 15); const int n2 = n - H; return 32 * (n2 >> 4) + 16 + (n2 & 15); }
__device__ __forceinline__ int perm_win(int n) {
    if (n >= 2 * QKW) return n;
    const int part = n >> 10, hn = n & 1023, h = hn >> 8, d = hn & 255, quarter = d >> 6, idx = d & 63;
    const int Gp = (quarter >> 1) * 4 + (idx >> 4), i = (quarter & 1) * 16 + (idx & 15);
    return part * 1024 + h * 256 + 32 * Gp + i;
}
__device__ __forceinline__ int perm_any(int mode, int n, int H) { return mode == 0 ? n : (mode == 1 ? perm_glu(n, H) : perm_win(n)); }

struct Args { const float* in[22]; float* out; unsigned char* ws; int ph_lo, ph_hi; };

struct Ctx {
    LAS unsigned char* lds;
    int tid, lane, wave, G, bid;
    const float* const* in; float* out; unsigned char* ws;
};

template <int VSILU>
__device__ __forceinline__ void gemv2_unit(Ctx& C, const float* W, int N, int n0, const float* v0, const float* v1, const float* bias, float* o0, float* o1, int pmode, int H) {
    LAS float* red = (LAS float*)C.lds;
    const int c4 = C.tid & 15, ks = C.tid >> 4;
    f32x4 a0 = {0.f, 0.f, 0.f, 0.f}, a1 = {0.f, 0.f, 0.f, 0.f};
#pragma unroll 8
    for (int i = 0; i < 32; ++i) {
        const int k = ks * 32 + i;
        const f32x4 w = *(const f32x4*)(W + (size_t)k * N + n0 + 4 * c4);
        float x0 = v0[k], x1 = v1[k];
        if (VSILU) { x0 = siluf(x0); x1 = siluf(x1); }
        a0 += w * x0; a1 += w * x1;
    }
#pragma unroll
    for (int e = 0; e < 4; ++e) { red[(ks * 2 + 0) * 64 + 4 * c4 + e] = a0[e]; red[(ks * 2 + 1) * 64 + 4 * c4 + e] = a1[e]; }
    __syncthreads();
    if (C.tid < 128) {
        const int s = C.tid >> 6, col = C.tid & 63; float sum = 0.f;
#pragma unroll 8
        for (int k2 = 0; k2 < 32; ++k2) sum += red[(k2 * 2 + s) * 64 + col];
        const int n = n0 + col; if (bias) sum += bias[n];
        (s ? o1 : o0)[perm_any(pmode, n, H)] = sum;
    }
    __syncthreads();
}

__device__ __forceinline__ void transpose_item(const float* W, int K, int N, bf16_t* WT, int pmode, int H, LAS float* scr, int item, int lane) {
    const int nblk = N / 32, kb = item / nblk, nb = item % nblk, k0 = 64 * kb, n0 = 32 * nb;
#pragma unroll 8
    for (int i = 0; i < 32; ++i) { const int kk = 2 * i + (lane >> 5); scr[kk * 33 + (lane & 31)] = W[(size_t)(k0 + kk) * N + n0 + (lane & 31)]; }
    asm volatile("s_waitcnt lgkmcnt(0)" ::: "memory");
    const int c = lane & 7;
#pragma unroll
    for (int j = 0; j < 4; ++j) { const int n = (lane >> 3) + 8 * j; const LAS float* s = scr + (8 * c) * 33 + n;
        u32x4 o; o.x = pk2(s[0 * 33], s[1 * 33]); o.y = pk2(s[2 * 33], s[3 * 33]); o.z = pk2(s[4 * 33], s[5 * 33]); o.w = pk2(s[6 * 33], s[7 * 33]);
        *(u32x4*)(WT + (size_t)perm_any(pmode, n0 + n, H) * K + k0 + 8 * c) = o; }
    asm volatile("s_waitcnt lgkmcnt(0)" ::: "memory");
}
__device__ __forceinline__ void prep_layer(Ctx& C, int i) {
    LAS float* scr = (LAS float*)(C.lds + C.wave * 16384);
    const int gw = C.bid * 8 + C.wave, NGW = C.G * 8, j = i >> 1;
    bf16_t* WA = (bf16_t*)(C.ws + WS_WA); bf16_t* WA2 = (bf16_t*)(C.ws + WS_WA2); bf16_t* WF1 = (bf16_t*)(C.ws + WS_WF1); bf16_t* WF2 = (bf16_t*)(C.ws + WS_WF2);
    const bool conv = (i & 1) == 0;
    const int I_A = conv ? 16 * 64 : 16 * 256, I_A2 = conv ? 16 * 32 : 32 * 32, I_F1 = 16 * 176, I_F2 = 44 * 32;
    const int NIT = I_A + I_A2 + I_F1 + I_F2;
    for (int it = gw; it < NIT; it += NGW) {
        int r = it;
        if (r < I_A) { if (conv) transpose_item(C.in[8] + (size_t)j * 1024 * 2048, 1024, 2048, WA, 1, 1024, scr, r, C.lane);
                       else transpose_item(C.in[16] + (size_t)j * 1024 * 8192, 1024, 8192, WA, 2, 0, scr, r, C.lane); continue; } r -= I_A;
        if (r < I_A2) { if (conv) transpose_item(C.in[14] + (size_t)j * 1024 * 1024, 1024, 1024, WA2, 0, 0, scr, r, C.lane);
                        else transpose_item(C.in[18] + (size_t)j * 2048 * 1024, 2048, 1024, WA2, 0, 0, scr, r, C.lane); continue; } r -= I_A2;
        if (r < I_F1) { transpose_item(C.in[19] + (size_t)i * 1024 * FF2, 1024, FF2, WF1, 1, DFF, scr, r, C.lane); continue; } r -= I_F1;
        transpose_item(C.in[20] + (size_t)i * DFF * 1024, DFF, 1024, WF2, 0, 0, scr, r, C.lane);
    }
}

__device__ __forceinline__ float row_rs(const float* stats, int row, int fq) {
    const f32x4 p = *(const f32x4*)(stats + (size_t)row * 16 + 4 * fq);
    float s = (p[0] + p[1]) + (p[2] + p[3]);
    s += __shfl_xor(s, 16); s += __shfl_xor(s, 32);
    return 1.0f / sqrtf(s * (1.0f / 1024.0f) + NORM_EPS);
}
struct EpiGLU {
    static constexpr bool STATS = false, NEEDRS = true;
    unsigned char* ws; int cvoff  , cvstride  , outoff  , ldo, act;
    float* stats;
    __device__ __forceinline__ float row_begin(int row, int fq) const { return row_rs((const float*)(ws + WS_STATS), row, fq); }
    __device__ __forceinline__ float item(int row, int colp, f32x4 v0, f32x4 v1, float rs) const {
        const float* cv = (const float*)ws + cvoff + (row < T ? 0 : cvstride);
        const f32x4 ca = *(const f32x4*)(cv + colp), cg = *(const f32x4*)(cv + colp + 16);
        float o[4];
#pragma unroll
        for (int e = 0; e < 4; ++e) { const float a = rs * v0[e] + ca[e], g = rs * v1[e] + cg[e]; o[e] = act == 0 ? a * sigmf(g) : siluf(a) * g; }
        const int oc = (colp >> 5) * 16 + (colp & 15);
        u32x2 w; w.x = pk2(o[0], o[1]); w.y = pk2(o[2], o[3]);
        *(u32x2*)((bf16_t*)(ws + outoff) + (size_t)row * ldo + oc) = w;
        return 0.f;
    }
};
struct EpiRes {
    static constexpr bool STATS = true, NEEDRS = false;
    unsigned char* ws; float* xl; const float* bias; int mgoff  , snoff  ;
    float* stats;
    __device__ __forceinline__ float row_begin(int, int) const { return 1.f; }
    __device__ __forceinline__ float item(int row, int colp, f32x4 v0, f32x4 v1, float) const {
        const bool lat = row < T;
        float* xr = lat ? xl + (size_t)row * 1024 : (float*)(ws + WS_XCTX) + (size_t)(row - T) * 1024;
        const float* mg = (const float*)ws + mgoff + (lat ? 0 : 6144); const float* sn = (const float*)ws + snoff + (lat ? 0 : 1024);
        bf16_t* xs = (bf16_t*)(ws + WS_XS);
        float ss = 0.f;
#pragma unroll
        for (int hlf = 0; hlf < 2; ++hlf) {
            const int c = colp + 16 * hlf; const f32x4 v = hlf ? v1 : v0;
            const f32x4 xo = *(const f32x4*)(xr + c), m4 = *(const f32x4*)(mg + c);
            f32x4 b4 = {0.f, 0.f, 0.f, 0.f}; if (bias) b4 = *(const f32x4*)(bias + c);
            const f32x4 xn = xo + m4 * (v + b4);
            *(f32x4*)(xr + c) = xn;
            ss += (xn[0] * xn[0] + xn[1] * xn[1]) + (xn[2] * xn[2] + xn[3] * xn[3]);
            if (snoff >= 0) { const f32x4 s4 = *(const f32x4*)(sn + c); u32x2 w; w.x = pk2(xn[0] * s4[0], xn[1] * s4[1]); w.y = pk2(xn[2] * s4[2], xn[3] * s4[3]);
                *(u32x2*)(xs + (size_t)row * 1024 + c) = w; }
        }
        return ss;
    }
};
struct EpiWin {
    static constexpr bool STATS = false, NEEDRS = true;
    unsigned char* ws; int cvoff;
    float* stats;
    __device__ __forceinline__ float row_begin(int row, int fq) const { return row_rs((const float*)(ws + WS_STATS), row, fq); }
    __device__ __forceinline__ float item(int row, int colp, f32x4 v0, f32x4 v1, float rs) const {
        const float* cv = (const float*)ws + cvoff + (row < T ? 0 : 8192);
        const f32x4 c0 = *(const f32x4*)(cv + colp), c1 = *(const f32x4*)(cv + colp + 16);
        f32x4 a = v0 * rs + c0, b = v1 * rs + c1;
        if (colp < 2048) {
            if (row < T) {
                const int Gp = (colp >> 5) & 7, idx0 = 16 * (Gp & 3) + (colp & 15);
                const int ti = (Gp >> 2) ? 256 + (row & 63) : (row >> 6);
                const f32x4 cs = *(const f32x4*)((const float*)(ws + WS_TABC) + ti * 64 + idx0), sn = *(const f32x4*)((const float*)(ws + WS_TABS) + ti * 64 + idx0);
                const f32x4 o1 = a * cs - b * sn, o2 = b * cs + a * sn; a = o1; b = o2;
            }
            bf16_t* dst = (bf16_t*)(ws + WS_Q);
            if (colp >= 1024) { dst = (bf16_t*)(ws + WS_K); a = a * 0.0625f; b = b * 0.0625f; }
            const int c = colp & 1023;
            u32x2 w; w.x = pk2(a[0], a[1]); w.y = pk2(a[2], a[3]); *(u32x2*)(dst + (size_t)row * 1024 + c) = w;
            w.x = pk2(b[0], b[1]); w.y = pk2(b[2], b[3]); *(u32x2*)(dst + (size_t)row * 1024 + c + 16) = w;
        } else if (colp < 4096) {
            const int c = colp - 2048;
            bf16_t* vt = (bf16_t*)(ws + WS_VT);
#pragma unroll
            for (int e = 0; e < 4; ++e) { vt[(size_t)(c + e) * R + row] = (bf16_t)(pk2(a[e], 0.f) & 0xffffu); vt[(size_t)(c + 16 + e) * R + row] = (bf16_t)(pk2(b[e], 0.f) & 0xffffu); }
        } else {
            bf16_t* dst = (bf16_t*)(ws + (colp < 6144 ? WS_GF : WS_GB)); const int c = (colp - 4096) & 2047;
            u32x2 w; w.x = pk2(a[0], a[1]); w.y = pk2(a[2], a[3]); *(u32x2*)(dst + (size_t)row * 2048 + c) = w;
            w.x = pk2(b[0], b[1]); w.y = pk2(b[2], b[3]); *(u32x2*)(dst + (size_t)row * 2048 + c + 16) = w;
        }
        return 0.f;
    }
};

template <class Epi>
__device__ __forceinline__ void sgemm_small(Ctx& C, const bf16_t* A, const bf16_t* Bt, int row_lo, int Mrows, int N, int K, const Epi& E, int n_lo, int n_hi) {
    const int wr = C.wave >> 2, wc = C.wave & 3, fr = C.lane & 15, fq = C.lane >> 4;
    const int nM = Mrows / 32, nN = n_hi - n_lo, nU = nM * nN;
    for (int u = (C.G - 1 - C.bid); u < nU; u += C.G) {
        const int un = n_lo + u / nM, um = u % nM;
        const int row0 = row_lo + 32 * um + 16 * wr, col0 = 256 * un;
        f32x4 acc[2][2];
#pragma unroll
        for (int b = 0; b < 2; ++b)
#pragma unroll
            for (int n = 0; n < 2; ++n) acc[b][n] = (f32x4){0.f, 0.f, 0.f, 0.f};
        const bf16_t* ap = A + (size_t)(row0 + fr) * K + 8 * fq;
        const bf16_t* bp = Bt + (size_t)(col0 + 32 * wc + fr) * K + 8 * fq;
#pragma unroll 4
        for (int k0 = 0; k0 < K; k0 += 32) {
            bf16x8 bf[2][2];
            const bf16x8 af = *(const bf16x8*)(ap + k0);
#pragma unroll
            for (int bj = 0; bj < 2; ++bj)
#pragma unroll
                for (int n = 0; n < 2; ++n) bf[bj][n] = *(const bf16x8*)(bp + (size_t)(128 * bj + 16 * n) * K + k0);
#pragma unroll
            for (int bj = 0; bj < 2; ++bj)
#pragma unroll
                for (int n = 0; n < 2; ++n) acc[bj][n] = __builtin_amdgcn_mfma_f32_16x16x32_bf16(bf[bj][n], af, acc[bj][n], 0, 0, 0);
        }
        const int row = row0 + fr;
        const float rs = E.row_begin(row, fq);
        float ss = 0.f;
#pragma unroll
        for (int bj = 0; bj < 2; ++bj) ss += E.item(row, col0 + 128 * bj + 32 * wc + 4 * fq, acc[bj][0], acc[bj][1], rs);
        if constexpr (Epi::STATS) { ss += __shfl_xor(ss, 16); ss += __shfl_xor(ss, 32); if (fq == 0) E.stats[(size_t)row * 16 + un * 4 + wc] = ss; }
    }
}

namespace pg8 {
#define PG8_LAS __attribute__((address_space(3)))
typedef unsigned short bf16_t;
typedef short bf16x8 __attribute__((ext_vector_type(8)));
typedef float f32x4 __attribute__((ext_vector_type(4)));
typedef unsigned u32x4 __attribute__((ext_vector_type(4)));
constexpr int BM = 256, BK = 64, HALF = 128, HTB = HALF * BK * 2  , STAGE_BYTES = 8 * HTB, NXCD = 8, WGM = 8;

__host__ __device__ __forceinline__ int lds_byte(int r, int c) { const int st = (r >> 4) * 2 + (c >> 5), rr = r & 15, cc = c & 31, ob = rr * 64 + cc * 2; return st * 1024 + (ob ^ (((ob >> 9) & 1) << 5)); }
__host__ __device__ __forceinline__ void stage_rc(int b, int& R, int& C) { const int st = b / 1024, sb = b % 1024, swz = sb ^ (((sb >> 9) & 1) << 5); R = (st >> 1) * 16 + swz / 64; C = (st & 1) * 32 + (swz % 64) / 2; }
__host__ __device__ __forceinline__ int perm32(int rho) { const int n = rho >> 4, i = rho & 15; return 8 * (i >> 2) + 4 * n + (i & 3); }

struct Unit { int pm, pn; };
struct Gemm { const bf16_t* A; const bf16_t* Bt; int M, N, K; };

struct StaticOrder {
    int nM, nN, nwg, G, c;
    __host__ __device__ void init(int M, int N, int G_, int c_) { nM = M / BM; nN = N / BM; nwg = nM * nN; G = G_; c = c_; }
    __host__ __device__ bool next(int i, Unit& u) const {
        const long L = (long)i * G + c; if (L >= nwg) return false;
        int wgid = (int)L; { const int q = nwg / NXCD, r = nwg % NXCD, xcd = wgid % NXCD, off = wgid / NXCD; wgid = (xcd < r ? xcd * (q + 1) : r * (q + 1) + (xcd - r) * q) + off; }
        const int nig = WGM * nN, gid = wgid / nig, fm = gid * WGM, gsz = (nM - fm) < WGM ? (nM - fm) : WGM;
        u.pm = fm + ((wgid % nig) % gsz); u.pn = (wgid % nig) / gsz; return true;
    }
    __device__ __forceinline__ void a_ready(const Unit&) const {}
    __device__ __forceinline__ void done(const Unit&) const {}
};

template <class Epi, class Sched, bool ALIGN_EPI = false, bool SP2 = false>
__device__ __forceinline__ void gemm_phase(PG8_LAS unsigned char* lds, const Gemm g, const Sched& S, const Epi& E) {
    const int tid = threadIdx.x, wid = __builtin_amdgcn_readfirstlane(tid >> 6), lane = tid & 63, wr = wid >> 2, wc = wid & 3, fr = lane & 15, fq = lane >> 4;
    const int K = g.K, nt = K / BK;
    unsigned voffA[2], voffB[2];
#pragma unroll
    for (int i = 0; i < 2; ++i) { int R, C; stage_rc(tid * 16 + i * 8192, R, C); const int Rb = Epi::PERM ? ((R & ~31) + perm32(R & 31)) : R;
        voffA[i] = (unsigned)(R * K + C) * 2u; voffB[i] = (unsigned)(Rb * K + C) * 2u; }
    const size_t kstep = (size_t)(BK * 2);
    const size_t hstep = (size_t)HALF * K * 2;
    const size_t tstep = 2 * hstep;
    const unsigned ldsw = (unsigned)wid * 1024u;
    const int aoff = lds_byte(wr * 64 + fr, fq * 8), boff = lds_byte(wc * 32 + fr, fq * 8);
#define PG8_SA(b, h) (((b) * 2 + (h)) * HTB)
#define PG8_SB(b, h) ((4 + (b) * 2 + (h)) * HTB)
#define PG8_STAGE(bufoff, gbase, voff) do { _Pragma("unroll") for (int _i = 0; _i < 2; ++_i) \
        __builtin_amdgcn_global_load_lds((const unsigned*)((const char*)(gbase) + (voff)[_i]), (PG8_LAS unsigned*)(lds + (bufoff) + ldsw + _i * 8192), 16, 0, 0); } while (0)
#define PG8_LDA(dst, b, h) do { _Pragma("unroll") for (int m = 0; m < 4; ++m) _Pragma("unroll") for (int k = 0; k < 2; ++k) dst[m][k] = *(const PG8_LAS bf16x8*)(lds + PG8_SA(b, h) + aoff + m * 2048 + k * 1024); } while (0)
#define PG8_LDB(dst, b, h) do { _Pragma("unroll") for (int n = 0; n < 2; ++n) _Pragma("unroll") for (int k = 0; k < 2; ++k) dst[n][k] = *(const PG8_LAS bf16x8*)(lds + PG8_SB(b, h) + boff + n * 2048 + k * 1024); } while (0)
#define PG8_MMA(ai, bj, At, Bt) do { __builtin_amdgcn_s_setprio(1); _Pragma("unroll") for (int m = 0; m < 4; ++m) _Pragma("unroll") for (int n = 0; n < 2; ++n) _Pragma("unroll") for (int k = 0; k < 2; ++k) \
        acc[ai][bj][m][n] = __builtin_amdgcn_mfma_f32_16x16x32_bf16(Bt[n][k], At[m][k], acc[ai][bj][m][n], 0, 0, 0); __builtin_amdgcn_s_setprio(0); } while (0)
#define PG8_WAIT_V(n) asm volatile("s_waitcnt vmcnt(" #n ")" ::: "memory")
#define PG8_WAIT_L(n) asm volatile("s_waitcnt lgkmcnt(" #n ")" ::: "memory")
#define PG8_BAR __builtin_amdgcn_s_barrier()
#define PG8_SCHED __builtin_amdgcn_sched_barrier(0)
    Unit cur, nxt; int ui = 0;
    if (!S.next(0, cur)) return;
    f32x4 acc[2][2][4][2];
#pragma unroll
    for (int a = 0; a < 2; ++a)
#pragma unroll
        for (int b = 0; b < 2; ++b)
#pragma unroll
            for (int m = 0; m < 4; ++m)
#pragma unroll
                for (int n = 0; n < 2; ++n) acc[a][b][m][n] = (f32x4){0.f, 0.f, 0.f, 0.f};
    bf16x8 At[4][2], B0[2][2], B1[2][2];
    const char* cA = (const char*)g.A + (size_t)cur.pm * tstep; const char* cB = (const char*)g.Bt + (size_t)cur.pn * tstep;
    S.a_ready(cur);
    if constexpr (SP2) {
        PG8_STAGE(PG8_SB(0, 0), cB, voffB); PG8_STAGE(PG8_SB(0, 1), cB + hstep, voffB); PG8_STAGE(PG8_SA(0, 0), cA, voffA); PG8_STAGE(PG8_SA(0, 1), cA + hstep, voffA);
        if (wr == 1) PG8_BAR;
        PG8_WAIT_V(2); PG8_BAR;
        PG8_STAGE(PG8_SB(1, 0), cB + kstep, voffB); PG8_STAGE(PG8_SA(1, 0), cA + kstep, voffA); PG8_STAGE(PG8_SB(1, 1), cB + hstep + kstep, voffB);
        PG8_WAIT_V(6); PG8_BAR;
    } else {
        PG8_STAGE(PG8_SB(0, 0), cB, voffB); PG8_STAGE(PG8_SA(0, 0), cA, voffA); PG8_STAGE(PG8_SB(0, 1), cB + hstep, voffB); PG8_STAGE(PG8_SA(0, 1), cA + hstep, voffA);
        if (wr == 1) PG8_BAR;
        PG8_WAIT_V(4); PG8_BAR;
        PG8_STAGE(PG8_SB(1, 0), cB + kstep, voffB); PG8_STAGE(PG8_SA(1, 0), cA + kstep, voffA); PG8_STAGE(PG8_SB(1, 1), cB + hstep + kstep, voffB);
        PG8_WAIT_V(6); PG8_BAR;
    }
    for (;;) {
        const bool has_next = S.next(ui + 1, nxt);
        const char* nA = has_next ? (const char*)g.A + (size_t)nxt.pm * tstep : cA; const char* nB = has_next ? (const char*)g.Bt + (size_t)nxt.pn * tstep : cB;
        for (int t = 0; t < nt; t += 2) {
            const bool last = (t == nt - 2);
            const char* a1 = cA + (size_t)(t + 1) * kstep;
            const char* a2 = last ? nA : cA + (size_t)(t + 2) * kstep; const char* b2 = last ? nB : cB + (size_t)(t + 2) * kstep;
            const char* a3 = a2 + kstep; const char* b3 = b2 + kstep;
            if (last && has_next) S.a_ready(nxt);
            if constexpr (SP2) {
            PG8_LDB(B0, 0, 0); PG8_LDB(B1, 0, 1); PG8_SCHED; PG8_LDA(At, 0, 0); PG8_STAGE(PG8_SA(1, 1), a1 + hstep, voffA);
            PG8_WAIT_V(8); PG8_WAIT_L(0); PG8_BAR; PG8_MMA(0, 0, At, B0); PG8_MMA(0, 1, At, B1); PG8_BAR; PG8_SCHED;
            PG8_LDA(At, 0, 1); PG8_STAGE(PG8_SB(0, 0), b2, voffB); PG8_STAGE(PG8_SB(0, 1), b2 + hstep, voffB); PG8_STAGE(PG8_SA(0, 0), a2, voffA);
            PG8_WAIT_V(8); PG8_WAIT_L(0); PG8_BAR; PG8_MMA(1, 0, At, B0); PG8_MMA(1, 1, At, B1); PG8_BAR; PG8_SCHED;
            PG8_LDB(B0, 1, 0); PG8_LDB(B1, 1, 1); PG8_SCHED; PG8_LDA(At, 1, 0); PG8_STAGE(PG8_SA(0, 1), a2 + hstep, voffA);
            PG8_WAIT_V(8); PG8_WAIT_L(0); PG8_BAR; PG8_MMA(0, 0, At, B0); PG8_MMA(0, 1, At, B1); PG8_BAR; PG8_SCHED;
            PG8_LDA(At, 1, 1); PG8_STAGE(PG8_SB(1, 0), b3, voffB); PG8_STAGE(PG8_SB(1, 1), b3 + hstep, voffB); PG8_STAGE(PG8_SA(1, 0), a3, voffA);
            PG8_WAIT_V(8); PG8_WAIT_L(0); PG8_BAR; PG8_MMA(1, 0, At, B0); PG8_MMA(1, 1, At, B1); PG8_BAR; PG8_SCHED;
            } else {
            PG8_LDB(B0, 0, 0); PG8_SCHED; PG8_LDA(At, 0, 0); PG8_STAGE(PG8_SA(1, 1), a1 + hstep, voffA);
            PG8_WAIT_L(8); PG8_BAR; PG8_WAIT_L(0); PG8_MMA(0, 0, At, B0); PG8_BAR; PG8_SCHED;
            PG8_LDB(B1, 0, 1); PG8_STAGE(PG8_SB(0, 0), b2, voffB);
            PG8_BAR; PG8_WAIT_L(0); PG8_MMA(0, 1, At, B1); PG8_BAR;
            PG8_LDA(At, 0, 1); PG8_STAGE(PG8_SA(0, 0), a2, voffA);
            PG8_BAR; PG8_WAIT_L(0); PG8_MMA(1, 0, At, B0); PG8_BAR; PG8_SCHED;
            PG8_STAGE(PG8_SB(0, 1), b2 + hstep, voffB);
            PG8_WAIT_V(6); PG8_BAR; PG8_MMA(1, 1, At, B1); PG8_BAR;
            PG8_LDB(B0, 1, 0); PG8_SCHED; PG8_LDA(At, 1, 0); PG8_STAGE(PG8_SA(0, 1), a2 + hstep, voffA);
            PG8_WAIT_L(8); PG8_BAR; PG8_WAIT_L(0); PG8_MMA(0, 0, At, B0); PG8_BAR; PG8_SCHED;
            PG8_LDB(B1, 1, 1); PG8_STAGE(PG8_SB(1, 0), b3, voffB);
            PG8_BAR; PG8_WAIT_L(0); PG8_MMA(0, 1, At, B1); PG8_BAR;
            PG8_LDA(At, 1, 1); PG8_STAGE(PG8_SA(1, 0), a3, voffA);
            PG8_BAR; PG8_WAIT_L(0); PG8_MMA(1, 0, At, B0); PG8_BAR; PG8_SCHED;
            PG8_STAGE(PG8_SB(1, 1), b3 + hstep, voffB);
            PG8_WAIT_V(6); PG8_BAR; PG8_MMA(1, 1, At, B1); PG8_BAR;
            }
        }
        if constexpr (ALIGN_EPI) { if (wr == 0) PG8_BAR; }
        if constexpr (!Epi::AFTER_DRAIN) { E(acc, cur, wr, wc, fr, fq); S.done(cur); }
        if (!has_next) break;
#pragma unroll
        for (int a = 0; a < 2; ++a)
#pragma unroll
            for (int b = 0; b < 2; ++b)
#pragma unroll
                for (int m = 0; m < 4; ++m)
#pragma unroll
                    for (int n = 0; n < 2; ++n) acc[a][b][m][n] = (f32x4){0.f, 0.f, 0.f, 0.f};
        cur = nxt; cA = nA; cB = nB; ++ui;
        if constexpr (ALIGN_EPI) { if (wr == 1) PG8_BAR; }
    }
    PG8_WAIT_V(0);
    if constexpr (!ALIGN_EPI) { if (wr == 0) PG8_BAR; }
    PG8_BAR;
    if constexpr (Epi::AFTER_DRAIN) { E.fused(acc, cur, wr, wc, fr, fq, lds, wid, lane); S.done(cur); }
#undef PG8_SA
#undef PG8_SB
#undef PG8_STAGE
#undef PG8_LDA
#undef PG8_LDB
#undef PG8_MMA
#undef PG8_WAIT_V
#undef PG8_WAIT_L
#undef PG8_BAR
#undef PG8_SCHED
}
}

template <class E0> struct EpiAdapt {
    static constexpr bool PERM = false, AFTER_DRAIN = false;
    E0 e;
    __device__ __forceinline__ void operator()(const pg8::f32x4 (&acc)[2][2][4][2], const pg8::Unit& u, int wr, int wc, int fr, int fq) const {
#pragma unroll
        for (int ai = 0; ai < 2; ++ai)
#pragma unroll
            for (int m = 0; m < 4; ++m) {
                const int row = u.pm * 256 + ai * 128 + wr * 64 + m * 16 + fr;
                const float rs = e.row_begin(row, fq);
                float ss = 0.f;
#pragma unroll
                for (int bj = 0; bj < 2; ++bj) ss += e.item(row, u.pn * 256 + bj * 128 + wc * 32 + 4 * fq, acc[ai][bj][m][0], acc[ai][bj][m][1], rs);
                if constexpr (E0::STATS) { ss += __shfl_xor(ss, 16); ss += __shfl_xor(ss, 32); if (fq == 0) e.stats[(size_t)row * 16 + u.pn * 4 + wc] = ss; }
            }
    }
};
template <class E0>
__device__ __forceinline__ void gemm_both(Ctx& C, const bf16_t* A, const bf16_t* Bt, int Mbig, int N, int K, const E0& E, int ctx_n_lo, int ctx_n_hi) {
    { pg8::Gemm g{A, Bt, Mbig, N, K}; pg8::StaticOrder S; S.init(Mbig, N, C.G, C.bid); EpiAdapt<E0> EA{E};
      pg8::gemm_phase<EpiAdapt<E0>, pg8::StaticOrder, true, true>(C.lds, g, S, EA); }
    if (Mbig < R && ctx_n_hi > ctx_n_lo) sgemm_small(C, A, Bt, Mbig, R - Mbig, N, K, E, ctx_n_lo, ctx_n_hi);
}
__device__ __forceinline__ void dwconv_phase(Ctx& C, int j) {
    const bf16_t* U = (const bf16_t*)(C.ws + WS_U); bf16_t* A2 = (bf16_t*)(C.ws + WS_A2);
    const float* dww = C.in[10] + (size_t)j * CK * 1024; const float* dwb = C.in[11] + j * 1024; const float* lng = C.in[12] + j * 1024; const float* lnb = C.in[13] + j * 1024;
    LAS unsigned char* tile = C.lds; LAS float* part = (LAS float*)(C.lds + 62 * 2048);
    const int tid = C.tid;
    for (int u = C.bid; u < 520; u += C.G) {
        const int base = u < 512 ? 0 : T, n = u < 512 ? T : TC, t0 = 32 * (u < 512 ? u : u - 512);
        for (int idx = tid; idx < 62 * 128; idx += 512) {
            const int rr = idx >> 7, ch = idx & 127, tt = t0 - 15 + rr;
            u32x4 v = {0u, 0u, 0u, 0u};
            if (tt >= 0 && tt < n) v = *(const u32x4*)(U + (size_t)(base + tt) * 1024 + ch * 8);
            *(LAS u32x4*)(tile + rr * 2048 + ch * 16) = v;
        }
        __syncthreads();
        float o0[32], o1[32];
        { const f32x2 b2 = *(const f32x2*)(dwb + 2 * tid);
#pragma unroll
          for (int t = 0; t < 32; ++t) { o0[t] = b2.x; o1[t] = b2.y; } }
        for (int jt = 0; jt < CK; ++jt) {
            const f32x2 w = *(const f32x2*)(dww + jt * 1024 + 2 * tid);
            const LAS unsigned char* p = tile + jt * 2048 + tid * 4;
#pragma unroll
            for (int t = 0; t < 32; ++t) { const unsigned uu = *(const LAS unsigned*)(p + t * 2048); o0[t] += w.x * bflo(uu); o1[t] += w.y * bfhi(uu); }
        }
#pragma unroll
        for (int t = 0; t < 32; ++t) {
            const float s = wave_sum63(o0[t] + o1[t]), q = wave_sum63(o0[t] * o0[t] + o1[t] * o1[t]);
            if (C.lane == 63) { part[(t * 8 + C.wave) * 2] = s; part[(t * 8 + C.wave) * 2 + 1] = q; }
        }
        __syncthreads();
        const f32x2 g2 = *(const f32x2*)(lng + 2 * tid), bb2 = *(const f32x2*)(lnb + 2 * tid);
#pragma unroll
        for (int t = 0; t < 32; ++t) {
            float s = 0.f, q = 0.f;
#pragma unroll
            for (int w = 0; w < 8; ++w) { s += part[(t * 8 + w) * 2]; q += part[(t * 8 + w) * 2 + 1]; }
            const float mean = s * (1.f / 1024.f), var = q * (1.f / 1024.f) - mean * mean, rstd = 1.0f / sqrtf(var + LN_EPS);
            const float y0 = (o0[t] - mean) * rstd * g2.x + bb2.x, y1 = (o1[t] - mean) * rstd * g2.y + bb2.y;
            *(unsigned*)(A2 + (size_t)(base + t0 + t) * 1024 + 2 * tid) = pk2(siluf(y0), siluf(y1));
        }
        __syncthreads();
    }
}

__device__ __forceinline__ void scan_phase(Ctx& C, int j) {
    const bf16_t* Kb = (const bf16_t*)(C.ws + WS_K); const bf16_t* Vt = (const bf16_t*)(C.ws + WS_VT); bf16_t* Scp = (bf16_t*)(C.ws + WS_SCP);
    constexpr int KP = 80;
    LAS bf16_t* kbuf = (LAS bf16_t*)C.lds;
    const int fr = C.lane & 15, fq = C.lane >> 4, w = C.wave, tid = C.tid;
    for (int cu = C.bid; cu < 256; cu += C.G) {
        const int hd = cu & 7, sidx = cu >> 3, h = hd >> 1, dir = hd & 1, dk_s = 64 * ((sidx >> 3) & 3), dv_s = 64 * (sidx & 7);
        const int mt = w >> 1, nh = w & 1, dkl = 16 * mt, dv0 = dv_s + 32 * nh;
        const float gam = 1.0f - exp2f(C.in[17][(j * 2 + dir) * 4 + h]); const float L = log2f(gam);
        const float cdec = exp2f(L * 256.f);
        float kdr[4];
#pragma unroll
        for (int i = 0; i < 4; ++i) { const int row = (tid >> 3) + 64 * i; kdr[i] = exp2f(L * (float)(dir == 0 ? 255 - row : row)); }
        const int srow = tid >> 3, sch = tid & 7;
        f32x4 acc[2]; acc[0] = (f32x4){0.f, 0.f, 0.f, 0.f}; acc[1] = acc[0];
        u32x4 kreg[4]; bf16x8 vnext[2][8];
        auto tok_of = [&](int st) { return st == 0 ? T : 256 * (dir == 0 ? st - 1 : 64 - st); };
        {   const int tok0 = tok_of(0);
#pragma unroll
            for (int i = 0; i < 4; ++i) kreg[i] = *(const u32x4*)(Kb + (size_t)(tok0 + srow + 64 * i) * 1024 + h * 256 + dk_s + 8 * sch);
#pragma unroll
            for (int nt = 0; nt < 2; ++nt)
#pragma unroll
                for (int ks = 0; ks < 8; ++ks) vnext[nt][ks] = *(const bf16x8*)(Vt + (size_t)(h * 512 + dv0 + 16 * nt + fr) * R + tok0 + 32 * ks + 8 * fq);
        }
#pragma unroll 1
        for (int st = 0; st < 65; ++st) {
            LAS bf16_t* kb = kbuf + (st & 1) * 256 * KP;
#pragma unroll
            for (int i = 0; i < 4; ++i) {
                const u32x4 r = kreg[i]; const float d = kdr[i]; u32x4 o;
                o.x = pk2(bflo(r.x) * d, bfhi(r.x) * d); o.y = pk2(bflo(r.y) * d, bfhi(r.y) * d); o.z = pk2(bflo(r.z) * d, bfhi(r.z) * d); o.w = pk2(bflo(r.w) * d, bfhi(r.w) * d);
                *(LAS u32x4*)(kb + (srow + 64 * i) * KP + 8 * sch) = o;
            }
            bf16x8 vcur[2][8];
#pragma unroll
            for (int nt = 0; nt < 2; ++nt)
#pragma unroll
                for (int ks = 0; ks < 8; ++ks) vcur[nt][ks] = vnext[nt][ks];
            __syncthreads();
            if (st + 1 < 65) {
                const int tok1 = tok_of(st + 1);
#pragma unroll
                for (int i = 0; i < 4; ++i) kreg[i] = *(const u32x4*)(Kb + (size_t)(tok1 + srow + 64 * i) * 1024 + h * 256 + dk_s + 8 * sch);
#pragma unroll
                for (int nt = 0; nt < 2; ++nt)
#pragma unroll
                    for (int ks = 0; ks < 8; ++ks) vnext[nt][ks] = *(const bf16x8*)(Vt + (size_t)(h * 512 + dv0 + 16 * nt + fr) * R + tok1 + 32 * ks + 8 * fq);
            }
            const int sl = dir == 0 ? st - 1 : 64 - st;
            const bool cp = st == 0 || (dir == 0 ? (sl & 1) == 0 : (sl & 1) == 1);
            if (cp) {
                const int slot = st == 0 ? 32 : (sl >> 1);
                bf16_t* sp = Scp + ((size_t)((slot * 4 + h) * 2 + dir) * 512) * 256;
#pragma unroll
                for (int nt = 0; nt < 2; ++nt) { u32x2 wv; wv.x = pk2(acc[nt][0], acc[nt][1]); wv.y = pk2(acc[nt][2], acc[nt][3]);
                    *(u32x2*)(sp + (size_t)(dv0 + 16 * nt + fr) * 256 + dk_s + dkl + 4 * fq) = wv; }
            }
            acc[0] = acc[0] * cdec; acc[1] = acc[1] * cdec;
#pragma unroll
            for (int ks = 0; ks < 8; ++ks) {
                const LAS bf16_t* kp = kb + (32 * ks + 8 * fq) * KP + dkl + fr;
                u32x4 pk;
                pk.x = (unsigned)kp[0 * KP] | ((unsigned)kp[1 * KP] << 16); pk.y = (unsigned)kp[2 * KP] | ((unsigned)kp[3 * KP] << 16);
                pk.z = (unsigned)kp[4 * KP] | ((unsigned)kp[5 * KP] << 16); pk.w = (unsigned)kp[6 * KP] | ((unsigned)kp[7 * KP] << 16);
                const bf16x8 af = __builtin_bit_cast(bf16x8, pk);
#pragma unroll
                for (int nt = 0; nt < 2; ++nt) acc[nt] = __builtin_amdgcn_mfma_f32_16x16x32_bf16(af, vcur[nt][ks], acc[nt], 0, 0, 0);
            }
        }
        __syncthreads();
    }
}

__device__ __forceinline__ void readout_phase(Ctx& C, int j, bool skip_ctx) {
    const bf16_t* Q = (const bf16_t*)(C.ws + WS_Q); const bf16_t* Kb = (const bf16_t*)(C.ws + WS_K); const bf16_t* Vt = (const bf16_t*)(C.ws + WS_VT);
    const bf16_t* Scp = (const bf16_t*)(C.ws + WS_SCP); bf16_t* GF = (bf16_t*)(C.ws + WS_GF); const bf16_t* GB = (const bf16_t*)(C.ws + WS_GB);
    constexpr int QP = 264, PP = 136;
    LAS bf16_t* Qs = (LAS bf16_t*)C.lds;
    LAS bf16_t* Pb = (LAS bf16_t*)(C.lds + 64 * QP * 2);
    LAS float* red = (LAS float*)(C.lds + 64 * QP * 2 + 2 * 64 * PP * 2);
    const int fr = C.lane & 15, fq = C.lane >> 4, w = C.wave, tid = C.tid;
    const int nunits = skip_ctx ? 512 : 520;
    for (int u0 = C.bid; u0 < nunits; u0 += C.G) {
        int h, b;
        if (C.G == 256 && u0 < 512) { const int r = u0 >> 8, x = u0 & 7, idx = (u0 & 255) >> 3, grp = r * 64 + x * 8 + (idx >> 2); h = grp & 3; b = (grp >> 2) * 4 + (idx & 3); }
        else { h = u0 & 3; b = u0 >> 2; }
        const bool lat = b < 128; const int base = lat ? 0 : T, nb = lat ? 128 : 2, bl = lat ? b : b - 128;
        const int g = bl >> 2, slot = lat ? g : 32;
        const int gend = (4 * (g + 1) < nb ? 4 * (g + 1) : nb);
#pragma unroll 1
        for (int rh = 0; rh < 2; ++rh) {
            const int i0 = base + 128 * bl + 64 * rh, il0 = 128 * bl + 64 * rh;
            __syncthreads();
#pragma unroll
            for (int i = 0; i < 4; ++i) { const int c = tid + 512 * i, row = c >> 5, ch = c & 31;
                *(LAS u32x4*)(Qs + row * QP + 8 * ch) = *(const u32x4*)(Q + (size_t)(i0 + row) * 1024 + h * 256 + 8 * ch); }
            __syncthreads();
#pragma unroll 1
            for (int dir = 0; dir < 2; ++dir) {
                const float gam = 1.0f - exp2f(C.in[17][(j * 2 + dir) * 4 + h]); const float L = log2f(gam);
                f32x4 acc[4][4];
#pragma unroll
                for (int mt = 0; mt < 4; ++mt)
#pragma unroll
                    for (int nt = 0; nt < 4; ++nt) acc[mt][nt] = (f32x4){0.f, 0.f, 0.f, 0.f};
                const bf16_t* sb = Scp + ((size_t)((slot * 4 + h) * 2 + dir) * 512) * 256 + (size_t)(64 * w + fr) * 256 + 8 * fq;
#pragma unroll
                for (int half = 0; half < 2; ++half) {
                    bf16x8 sf[4][4];
#pragma unroll
                    for (int k4 = 0; k4 < 4; ++k4)
#pragma unroll
                        for (int nt = 0; nt < 4; ++nt) sf[k4][nt] = *(const bf16x8*)(sb + (size_t)(16 * nt) * 256 + 32 * (4 * half + k4));
#pragma unroll
                    for (int k4 = 0; k4 < 4; ++k4)
#pragma unroll
                        for (int mt = 0; mt < 4; ++mt) { const bf16x8 qf = *(const LAS bf16x8*)(Qs + (16 * mt + fr) * QP + 32 * (4 * half + k4) + 8 * fq);
#pragma unroll
                            for (int nt = 0; nt < 4; ++nt) acc[mt][nt] = __builtin_amdgcn_mfma_f32_16x16x32_bf16(sf[k4][nt], qf, acc[mt][nt], 0, 0, 0); }
                }
#pragma unroll
                for (int mt = 0; mt < 4; ++mt) {
                    const int il = il0 + 16 * mt + fr;
                    const int ex = dir == 0 ? il - 512 * g + 1 : gend * 128 - il;
                    const float qd = exp2f(L * (float)ex);
#pragma unroll
                    for (int nt = 0; nt < 4; ++nt) acc[mt][nt] = acc[mt][nt] * qd;
                }
                const int kb_lo = dir == 0 ? 4 * g : bl, kb_hi = dir == 0 ? bl : gend - 1;
                int pbuf = 0;
#pragma unroll 1
                for (int kb = kb_lo; kb <= kb_hi; ++kb) {
                    const int j0 = base + 128 * kb;
                    bf16x8 kf[8], vf[4][4];
                    { const bf16_t* k1 = Kb + (size_t)(j0 + 16 * w + fr) * 1024 + h * 256 + 8 * fq;
#pragma unroll
                      for (int ks = 0; ks < 8; ++ks) kf[ks] = *(const bf16x8*)(k1 + 32 * ks);
                      const bf16_t* vb = Vt + (size_t)(h * 512 + 64 * w + fr) * R + j0 + 8 * fq;
#pragma unroll
                      for (int ks = 0; ks < 4; ++ks)
#pragma unroll
                          for (int nt = 0; nt < 4; ++nt) vf[ks][nt] = *(const bf16x8*)(vb + (size_t)(16 * nt) * R + 32 * ks); }
                    f32x4 sc[4];
#pragma unroll
                    for (int mt = 0; mt < 4; ++mt) sc[mt] = (f32x4){0.f, 0.f, 0.f, 0.f};
#pragma unroll
                    for (int ks = 0; ks < 8; ++ks)
#pragma unroll
                        for (int mt = 0; mt < 4; ++mt) { const bf16x8 qf = *(const LAS bf16x8*)(Qs + (16 * mt + fr) * QP + 32 * ks + 8 * fq);
                            sc[mt] = __builtin_amdgcn_mfma_f32_16x16x32_bf16(kf[ks], qf, sc[mt], 0, 0, 0); }
                    LAS bf16_t* P = Pb + pbuf * 64 * PP;
#pragma unroll
                    for (int mt = 0; mt < 4; ++mt) {
                        const int il = il0 + 16 * mt + fr;
                        float p[4];
#pragma unroll
                        for (int e = 0; e < 4; ++e) { const int jl = 128 * kb + 16 * w + 4 * fq + e; const int rel = dir == 0 ? il - jl : jl - il;
                            p[e] = rel >= 0 ? sc[mt][e] * exp2f(L * (float)rel) : 0.f; }
                        u32x2 wv; wv.x = pk2(p[0], p[1]); wv.y = pk2(p[2], p[3]);
                        *(LAS u32x2*)(P + (16 * mt + fr) * PP + 16 * w + 4 * fq) = wv;
                    }
                    __syncthreads();
#pragma unroll
                    for (int ks = 0; ks < 4; ++ks)
#pragma unroll
                        for (int mt = 0; mt < 4; ++mt) { const bf16x8 pf = *(const LAS bf16x8*)(P + (16 * mt + fr) * PP + 32 * ks + 8 * fq);
#pragma unroll
                            for (int nt = 0; nt < 4; ++nt) acc[mt][nt] = __builtin_amdgcn_mfma_f32_16x16x32_bf16(vf[ks][nt], pf, acc[mt][nt], 0, 0, 0); }
                    pbuf ^= 1;
                }
#pragma unroll
                for (int mt = 0; mt < 4; ++mt) {
                    float ss = 0.f;
#pragma unroll
                    for (int nt = 0; nt < 4; ++nt) ss += (acc[mt][nt][0] * acc[mt][nt][0] + acc[mt][nt][1] * acc[mt][nt][1]) + (acc[mt][nt][2] * acc[mt][nt][2] + acc[mt][nt][3] * acc[mt][nt][3]);
                    ss += __shfl_xor(ss, 16); ss += __shfl_xor(ss, 32);
                    if (fq == 0) red[(16 * mt + fr) * 8 + w] = ss;
                }
                __syncthreads();
#pragma unroll
                for (int mt = 0; mt < 4; ++mt) {
                    float tot = 0.f;
#pragma unroll
                    for (int w2 = 0; w2 < 8; ++w2) tot += red[(16 * mt + fr) * 8 + w2];
                    const float rn = 1.0f / sqrtf(tot * (1.f / 512.f) + NORM_EPS);
                    const size_t off = (size_t)(i0 + 16 * mt + fr) * 2048 + h * 512 + 64 * w + 4 * fq;
#pragma unroll
                    for (int nt = 0; nt < 4; ++nt) {
                        const u32x2 gg = *(const u32x2*)((dir == 0 ? (const bf16_t*)GF : GB) + off + 16 * nt);
                        float y0 = siluf(bflo(gg.x)) * acc[mt][nt][0] * rn, y1 = siluf(bfhi(gg.x)) * acc[mt][nt][1] * rn;
                        float y2 = siluf(bflo(gg.y)) * acc[mt][nt][2] * rn, y3 = siluf(bfhi(gg.y)) * acc[mt][nt][3] * rn;
                        if (dir == 1) { const u32x2 yp = *(const u32x2*)(GF + off + 16 * nt); y0 += bflo(yp.x); y1 += bfhi(yp.x); y2 += bflo(yp.y); y3 += bfhi(yp.y); }
                        u32x2 wv; wv.x = pk2(y0, y1); wv.y = pk2(y2, y3);
                        *(u32x2*)(GF + off + 16 * nt) = wv;
                    }
                }
            }
        }
    }
}

__device__ __forceinline__ void phase_p0(Ctx& C) {
    float* modv = (float*)(C.ws + WS_MODV);
    for (int u = C.bid; u < 384; u += C.G) {
        const int i = u / 96, nbk = u % 96;
        gemv2_unit<1>(C, C.in[4] + (size_t)i * 1024 * 6144, 6144, 64 * nbk, C.in[1], C.in[3], C.in[5] + i * 6144, modv + (i * 2 + 0) * 6144, modv + (i * 2 + 1) * 6144, 0, 0);
    }
    float* tabc = (float*)(C.ws + WS_TABC); float* tabs = (float*)(C.ws + WS_TABS);
    for (int idx = C.bid * 512 + C.tid; idx < 320 * 64; idx += C.G * 512) {
        const int ti = idx >> 6, i = idx & 63; const float pos = (float)(ti < 256 ? ti : ti - 256);
        const float inv = exp2f(-(float)i * (13.287712379549449f / 64.0f)); const float ang = pos * inv;
        tabc[idx] = __cosf(ang); tabs[idx] = __sinf(ang);
    }
}
__device__ __forceinline__ void phase_p1(Ctx& C) {
    const float* modv = (const float*)(C.ws + WS_MODV);
    float* s1 = (float*)(C.ws + WS_S1); float* s2 = (float*)(C.ws + WS_S2);
    for (int idx = C.bid * 512 + C.tid; idx < 8192; idx += C.G * 512) {
        const int i = idx >> 11, s = (idx >> 10) & 1, k = idx & 1023;
        s1[idx] = C.in[6][i * 1024 + k] * (1.f + modv[(i * 2 + s) * 6144 + 1024 + k]);
        s2[idx] = C.in[7][i * 1024 + k] * (1.f + modv[(i * 2 + s) * 6144 + 4096 + k]);
    }
    float* cvA = (float*)(C.ws + WS_CVA); float* cvF = (float*)(C.ws + WS_CVF);
    for (int u = C.bid; u < 672; u += C.G) {
        if (u < 320) {
            int i, nbk; if (u < 32) { i = 0; nbk = u; } else if (u < 160) { i = 1; nbk = u - 32; } else if (u < 192) { i = 2; nbk = u - 160; } else { i = 3; nbk = u - 192; }
            const int j = i >> 1; const float* v0 = modv + (i * 2 + 0) * 6144; const float* v1 = modv + (i * 2 + 1) * 6144;
            if ((i & 1) == 0) gemv2_unit<0>(C, C.in[8] + (size_t)j * 1024 * 2048, 2048, 64 * nbk, v0, v1, C.in[9] + j * 2048, cvA + (i * 2) * 8192, cvA + (i * 2 + 1) * 8192, 1, 1024);
            else gemv2_unit<0>(C, C.in[16] + (size_t)j * 1024 * 8192, 8192, 64 * nbk, v0, v1, nullptr, cvA + (i * 2) * 8192, cvA + (i * 2 + 1) * 8192, 2, 0);
        } else {
            const int i = (u - 320) / 88, nbk = (u - 320) % 88;
            const float* v0 = modv + (i * 2 + 0) * 6144 + 3072; const float* v1 = modv + (i * 2 + 1) * 6144 + 3072;
            gemv2_unit<0>(C, C.in[19] + (size_t)i * 1024 * FF2, FF2, 64 * nbk, v0, v1, nullptr, cvF + (i * 2) * FF2, cvF + (i * 2 + 1) * FF2, 1, DFF);
        }
    }
    bf16_t* xs = (bf16_t*)(C.ws + WS_XS); float* stats = (float*)(C.ws + WS_STATS); float* xctx = (float*)(C.ws + WS_XCTX);
    for (int row = C.bid * 8 + C.wave; row < R; row += C.G * 8) {
        const bool lat = row < T; const int s = lat ? 0 : 1;
        const float* src = lat ? C.in[0] + (size_t)row * 1024 : C.in[2] + (size_t)(row - T) * 1024;
        float* dst = lat ? C.out + (size_t)row * 1024 : xctx + (size_t)(row - T) * 1024;
        float ss = 0.f;
#pragma unroll
        for (int jj = 0; jj < 4; ++jj) {
            const int k = 4 * C.lane + 256 * jj;
            const f32x4 v = *(const f32x4*)(src + k); *(f32x4*)(dst + k) = v;
            ss += (v[0] * v[0] + v[1] * v[1]) + (v[2] * v[2] + v[3] * v[3]);
            const f32x4 g = *(const f32x4*)(C.in[6] + k), m = *(const f32x4*)(modv + s * 6144 + 1024 + k);
            u32x2 w; w.x = pk2(v[0] * g[0] * (1.f + m[0]), v[1] * g[1] * (1.f + m[1])); w.y = pk2(v[2] * g[2] * (1.f + m[2]), v[3] * g[3] * (1.f + m[3]));
            *(u32x2*)(xs + (size_t)row * 1024 + k) = w;
        }
#pragma unroll
        for (int off = 1; off < 64; off <<= 1) ss += __shfl_xor(ss, off);
        if (C.lane < 16) stats[(size_t)row * 16 + C.lane] = C.lane == 0 ? ss : 0.f;
    }
    prep_layer(C, 0);
}
__device__ __forceinline__ void phase_final(Ctx& C) {
    const float* stats = (const float*)(C.ws + WS_STATS);
    for (int row = C.bid * 8 + C.wave; row < T; row += C.G * 8) {
        float s = C.lane < 16 ? stats[(size_t)row * 16 + C.lane] : 0.f;
#pragma unroll
        for (int off = 1; off < 64; off <<= 1) s += __shfl_xor(s, off);
        const float r = 1.0f / sqrtf(s * (1.f / 1024.f) + NORM_EPS);
        float* xr = C.out + (size_t)row * 1024;
#pragma unroll
        for (int jj = 0; jj < 4; ++jj) { const int k = 4 * C.lane + 256 * jj; const f32x4 v = *(const f32x4*)(xr + k), g = *(const f32x4*)(C.in[21] + k); *(f32x4*)(xr + k) = v * r * g; }
    }
}

constexpr int NPHASE = 31;
__device__ __forceinline__ void run_phase(Ctx& C, int ph) {
    const int i = (ph - 2) / 7, sub = (ph - 2) % 7, j = i >> 1; const bool conv = (i & 1) == 0;
    const bool last = i == DEPTH - 1;
    float* stats = (float*)(C.ws + WS_STATS);
    const bf16_t* xs = (const bf16_t*)(C.ws + WS_XS);
    constexpr int F_MODV = (int)(WS_MODV / 4), F_S1 = (int)(WS_S1 / 4), F_S2 = (int)(WS_S2 / 4), F_CVA = (int)(WS_CVA / 4), F_CVF = (int)(WS_CVF / 4);
    if (sub == 1) {
        if (conv) { EpiGLU E{C.ws, F_CVA + (i * 2) * 8192, 8192, (int)WS_U, 1024, 0, stats}; gemm_both(C, xs, (const bf16_t*)(C.ws + WS_WA), T, 2048, 1024, E, 0, 8); }
        else { EpiWin E{C.ws, F_CVA + (i * 2) * 8192, stats}; gemm_both(C, xs, (const bf16_t*)(C.ws + WS_WA), T, 8192, 1024, E, last ? 4 : 0, last ? 16 : 32); }
    } else if (sub == 5) {
        EpiGLU E{C.ws, F_CVF + (i * 2) * FF2, FF2, (int)WS_H, DFF, 1, stats}; gemm_both(C, xs, (const bf16_t*)(C.ws + WS_WF1), last ? T : R, FF2, 1024, E, 0, 0);
    } else {
        const bool f2 = sub == 6;
        const int mgoff = F_MODV + (i * 2) * 6144 + (f2 ? 5120 : 2048);
        const int snoff = f2 ? (last ? -1 : F_S1 + ((i + 1) * 2) * 1024) : F_S2 + (i * 2) * 1024;
        const float* bias = (!f2 && conv) ? C.in[15] + j * 1024 : nullptr;
        const bf16_t* A = (const bf16_t*)(C.ws + (f2 ? WS_H : (conv ? WS_A2 : WS_GF)));
        const bf16_t* Bt = (const bf16_t*)(C.ws + (f2 ? WS_WF2 : WS_WA2));
        const int K = f2 ? DFF : (conv ? 1024 : 2048);
        EpiRes E{C.ws, C.out, bias, mgoff, snoff, stats};
        gemm_both(C, A, Bt, T, 1024, K, E, 0, last ? 0 : 4);
    }
}

#define XB_TMO      128
#define XB_XCNT(j)  (256  + 64 * (j))
#define XB_XSUB(j)  (1280 + 64 * (j))
#define XB_XGEN(j)  (2304 + 64 * (j))
#define XB_TOP      3328
#define XB_TOPGEN   3392
#define XCD_BAR_WORDS 3456
#define XB_SPIN_CAP (1u << 20)
__device__ __forceinline__ unsigned xb_ld(unsigned* p)              { return __hip_atomic_load(p, __ATOMIC_RELAXED, __HIP_MEMORY_SCOPE_AGENT); }
__device__ __forceinline__ unsigned xb_add(unsigned* p, unsigned v) { return __hip_atomic_fetch_add(p, v, __ATOMIC_RELAXED, __HIP_MEMORY_SCOPE_AGENT); }
__device__ __forceinline__ unsigned xb_xcc_id() { return (unsigned)__builtin_amdgcn_s_getreg((3 << 11) | 20) & 0xFu; }
#define XB_SPIN(cond, bar) do { unsigned _sp = 0; while (cond) { __builtin_amdgcn_s_sleep(1); \
    if ((++_sp & 255u) == 0u) { if (xb_ld(&(bar)[XB_TMO])) break; if (_sp > XB_SPIN_CAP) { atomicAdd(&(bar)[XB_TMO], 1u); break; } } } } while (0)
struct XcdBarrier { unsigned* bar; unsigned x; volatile LAS unsigned* st; };
__device__ __forceinline__ XcdBarrier xcd_barrier_post(unsigned* bar, volatile LAS unsigned* st) {
    XcdBarrier b; b.bar = bar; b.x = xb_xcc_id(); b.st = st;
    if (threadIdx.x == 0) (void)xb_add(&bar[XB_XCNT(b.x)], 1u);
    return b;
}
__device__ __forceinline__ void xcd_barrier_complete(unsigned* bar, unsigned x, unsigned& nloc, unsigned& nx) {
    const unsigned G = gridDim.x * gridDim.y * gridDim.z;
    unsigned sum, cnt, mine, sp = 0u;
    for (;;) {
        sum = 0u; cnt = 0u; mine = 0u;
#pragma unroll
        for (unsigned j = 0; j < 16; ++j) { const unsigned c = xb_ld(&bar[XB_XCNT(j)]); sum += c; cnt += (c > 0u) ? 1u : 0u; mine = (j == x) ? c : mine; }
        if (sum == G) break;
        __builtin_amdgcn_s_sleep(1);
        if ((++sp & 255u) == 0u) { if (xb_ld(&bar[XB_TMO])) break; if (sp > XB_SPIN_CAP) { atomicAdd(&bar[XB_TMO], 1u); break; } }
    }
    nloc = mine > 0u ? mine : 1u; nx = cnt > 0u ? cnt : 1u;
}
__device__ __forceinline__ void xcd_barrier(const XcdBarrier& b) {
    asm volatile("s_waitcnt vmcnt(0)" ::: "memory");
    __syncthreads();
    if (threadIdx.x == 0) {
        unsigned* bar = b.bar;
        __builtin_amdgcn_s_waitcnt(0);
        unsigned nloc = b.st[0], nx = b.st[1];
        if (nloc == 0u) { xcd_barrier_complete(bar, b.x, nloc, nx); b.st[0] = nloc; b.st[1] = nx; }
        const unsigned old = xb_add(&bar[XB_XSUB(b.x)], 1u);
        const unsigned gen = old / nloc;
        if (old + 1u == (gen + 1u) * nloc) {
            __builtin_amdgcn_fence(__ATOMIC_RELEASE, "agent");
            asm volatile("s_waitcnt vmcnt(0)" ::: "memory");
            const unsigned og = xb_add(&bar[XB_TOP], 1u);
            const unsigned tg = og / nx;
            if (og + 1u == (tg + 1u) * nx) xb_add(&bar[XB_TOPGEN], 1u);
            else XB_SPIN(xb_ld(&bar[XB_TOPGEN]) == tg, bar);
            __builtin_amdgcn_fence(__ATOMIC_ACQUIRE, "agent");
            xb_add(&bar[XB_XGEN(b.x)], 1u);
            asm volatile("s_waitcnt vmcnt(0)" ::: "memory");
        } else {
            XB_SPIN(xb_ld(&bar[XB_XGEN(b.x)]) == gen, bar);
            __builtin_amdgcn_fence(__ATOMIC_ACQUIRE, "agent");
            asm volatile("s_waitcnt vmcnt(0)" ::: "memory");
        }
    }
    __syncthreads();
}
constexpr int MISC_OFF = 131072 + 320;
constexpr int CW_BAR = 4096;

#ifndef PROBE_DUP
#define PROBE_DUP 0
#endif
#if ONE_LAUNCH
template <int PH> __device__ __forceinline__ void phase_body(Ctx& C) {
    constexpr int i = (PH - 2) / 7, sub = (PH - 2) % 7, j = i >> 1; constexpr bool conv = (i & 1) == 0;
    if (PH == 0) phase_p0(C);
    else if (PH == 1) phase_p1(C);
    else if (PH == 30) phase_final(C);
    else if (sub == 0) prep_layer(C, i);
    else if (sub == 2) { if (conv) dwconv_phase(C, j); else scan_phase(C, j); }
    else if (sub == 3) readout_phase(C, j, i == DEPTH - 1);
    else run_phase(C, PH);
}
template <int PH> __device__ __forceinline__ void one_phase(Ctx& C, const Args& args, const XcdBarrier& bar) {
    if (PH < args.ph_lo || PH >= args.ph_hi) return;
    constexpr int i = (PH - 2) / 7, sub = (PH - 2) % 7; constexpr bool conv = (i & 1) == 0;
    if (PH >= 2 && PH < 30) { if (sub == 0 && i == 0) return; if (sub == 3 && conv) return; }
    if (PH > args.ph_lo) xcd_barrier(bar);
    phase_body<PH>(C);
    constexpr bool dup = ((PH >= 2 && PH < 30) && (((PROBE_DUP & 1) && (sub == 1 || sub == 5)) || ((PROBE_DUP & 2) && sub == 2 && !conv) || ((PROBE_DUP & 4) && sub == 2 && conv) || ((PROBE_DUP & 8) && sub == 0))) || ((PROBE_DUP & 16) && PH < 2);
    if constexpr (dup) { xcd_barrier(bar); phase_body<PH>(C); }
}
template <int... PHS> __device__ __forceinline__ void all_phases(Ctx& C, const Args& args, const XcdBarrier& bar, std::integer_sequence<int, PHS...>) { (one_phase<PHS>(C, args, bar), ...); }
__global__ void __launch_bounds__(512, 2) mega_kernel(Args args) {
    extern __shared__ __attribute__((aligned(16))) unsigned char lds_raw[];
    Ctx C;
    C.lds = (LAS unsigned char*)lds_raw; C.tid = threadIdx.x; C.lane = C.tid & 63; C.wave = __builtin_amdgcn_readfirstlane(C.tid >> 6); C.G = gridDim.x; C.bid = blockIdx.x;
    C.in = args.in; C.out = args.out; C.ws = args.ws;
    volatile LAS unsigned* MISC = (volatile LAS unsigned*)(C.lds + MISC_OFF);
    if (C.tid < 32) MISC[C.tid] = 0u;
    __syncthreads();
    XcdBarrier bar = xcd_barrier_post((unsigned*)(C.ws + WS_CTL) + CW_BAR, MISC + 8);
    all_phases(C, args, bar, std::make_integer_sequence<int, NPHASE>{});
}

#endif
template <int KIND>
__global__ void __launch_bounds__(512, 2) phase_kernel(Args args) {
    extern __shared__ __attribute__((aligned(16))) unsigned char lds_raw[];
    Ctx C;
    C.lds = (LAS unsigned char*)lds_raw; C.tid = threadIdx.x; C.lane = C.tid & 63; C.wave = __builtin_amdgcn_readfirstlane(C.tid >> 6); C.G = gridDim.x; C.bid = blockIdx.x;
    C.in = args.in; C.out = args.out; C.ws = args.ws;
    const int ph = args.ph_lo;
    if (KIND == 0) phase_p0(C);
    else if (KIND == 1) phase_p1(C);
    else if (KIND == 30) phase_final(C);
    else {
        const int i = (ph - 2) / 7, j = i >> 1; const bool conv = (i & 1) == 0;
        if (KIND == 2) prep_layer(C, i);
        else if (KIND == 4) { if (conv) dwconv_phase(C, j); else scan_phase(C, j); }
        else if (KIND == 5) readout_phase(C, j, i == DEPTH - 1);
        else run_phase(C, ph);
    }
}

extern "C" void kernel_launch(void* const* d_in, const int* in_sizes, int n_in, void* d_out, int out_size, void* d_ws, size_t ws_size, hipStream_t stream) {
    static int grid = 0;
    if (grid == 0) {
        if (n_in != 22 || out_size != T * D || ws_size < WS_END) { fprintf(stderr, "kernel_launch: unexpected problem (n_in %d out %d ws %zu, need %zu)\n", n_in, out_size, ws_size, (size_t)WS_END); grid = -1; return; }
        int dev = 0, cus = 0;
        if (hipGetDevice(&dev) != hipSuccess || hipDeviceGetAttribute(&cus, hipDeviceAttributeMultiprocessorCount, dev) != hipSuccess) { grid = -1; return; }
        bool ok = true;
        ok &= hipFuncSetAttribute((const void*)phase_kernel<0>, hipFuncAttributeMaxDynamicSharedMemorySize, LDS_BYTES) == hipSuccess;
        ok &= hipFuncSetAttribute((const void*)phase_kernel<1>, hipFuncAttributeMaxDynamicSharedMemorySize, LDS_BYTES) == hipSuccess;
        ok &= hipFuncSetAttribute((const void*)phase_kernel<2>, hipFuncAttributeMaxDynamicSharedMemorySize, LDS_BYTES) == hipSuccess;
        ok &= hipFuncSetAttribute((const void*)phase_kernel<3>, hipFuncAttributeMaxDynamicSharedMemorySize, LDS_BYTES) == hipSuccess;
        ok &= hipFuncSetAttribute((const void*)phase_kernel<4>, hipFuncAttributeMaxDynamicSharedMemorySize, LDS_BYTES) == hipSuccess;
        ok &= hipFuncSetAttribute((const void*)phase_kernel<5>, hipFuncAttributeMaxDynamicSharedMemorySize, LDS_BYTES) == hipSuccess;
        ok &= hipFuncSetAttribute((const void*)phase_kernel<30>, hipFuncAttributeMaxDynamicSharedMemorySize, LDS_BYTES) == hipSuccess;
#if ONE_LAUNCH
        ok &= hipFuncSetAttribute((const void*)mega_kernel, hipFuncAttributeMaxDynamicSharedMemorySize, LDS_BYTES) == hipSuccess;
#endif
        if (!ok) { fprintf(stderr, "kernel_launch: hipFuncSetAttribute failed\n"); grid = -1; return; }
        grid = cus > 0 ? cus : 256;
    }
    if (grid < 0) return;
    Args a{};
    for (int i = 0; i < 22; ++i) a.in[i] = (const float*)d_in[i];
    a.out = (float*)d_out; a.ws = (unsigned char*)d_ws;
#if ONE_LAUNCH
    if (hipMemsetAsync((char*)d_ws + WS_CTL, 0, 65536, stream) != hipSuccess) { fprintf(stderr, "kernel_launch: memset failed\n"); return; }
    a.ph_lo = 0; a.ph_hi = NPHASE;
    hipLaunchKernelGGL(mega_kernel, dim3(grid), dim3(512), LDS_BYTES, stream, a);
    return;
#endif
    for (int ph = 0; ph < NPHASE; ++ph) {
        const int i = (ph - 2) / 7, sub = (ph - 2) % 7;
        if (ph >= 2 && ph < 30) { if (sub == 0 && i == 0) continue; if (sub == 3 && (i & 1) == 0) continue; }
        a.ph_lo = ph; a.ph_hi = ph + 1;
        const dim3 g(grid), b(512);
        if (ph == 0) hipLaunchKernelGGL(phase_kernel<0>, g, b, LDS_BYTES, stream, a);
        else if (ph == 1) hipLaunchKernelGGL(phase_kernel<1>, g, b, LDS_BYTES, stream, a);
        else if (ph == 30) hipLaunchKernelGGL(phase_kernel<30>, g, b, LDS_BYTES, stream, a);
        else if (sub == 0) hipLaunchKernelGGL(phase_kernel<2>, g, b, LDS_BYTES, stream, a);
        else if (sub == 2) hipLaunchKernelGGL(phase_kernel<4>, g, b, LDS_BYTES, stream, a);
        else if (sub == 3) hipLaunchKernelGGL(phase_kernel<5>, g, b, LDS_BYTES, stream, a);
        else hipLaunchKernelGGL(phase_kernel<3>, g, b, LDS_BYTES, stream, a);
        {   const bool conv = (i & 1) == 0;
            const bool dup = ((ph >= 2 && ph < 30) && (((PROBE_DUP & 1) && (sub == 1 || sub == 5)) || ((PROBE_DUP & 2) && sub == 2 && !conv) || ((PROBE_DUP & 4) && sub == 2 && conv) || ((PROBE_DUP & 8) && sub == 0))) || ((PROBE_DUP & 16) && ph < 2);
            if (dup) {
                if (ph == 0) hipLaunchKernelGGL(phase_kernel<0>, g, b, LDS_BYTES, stream, a);
                else if (ph == 1) hipLaunchKernelGGL(phase_kernel<1>, g, b, LDS_BYTES, stream, a);
                else if (sub == 0) hipLaunchKernelGGL(phase_kernel<2>, g, b, LDS_BYTES, stream, a);
                else if (sub == 2) hipLaunchKernelGGL(phase_kernel<4>, g, b, LDS_BYTES, stream, a);
                else hipLaunchKernelGGL(phase_kernel<3>, g, b, LDS_BYTES, stream, a);
            } }
    }
}
```

```cpp
#include <hip/hip_runtime.h>
#include <cstdio>
#include <cstdint>
#include <utility>

#ifndef ONE_LAUNCH
#define ONE_LAUNCH 1
#endif

typedef unsigned short bf16_t;
typedef short bf16x8 __attribute__((ext_vector_type(8)));
typedef float f32x4 __attribute__((ext_vector_type(4)));
typedef float f32x2 __attribute__((ext_vector_type(2)));
typedef unsigned u32x2 __attribute__((ext_vector_type(2)));
typedef unsigned u32x4 __attribute__((ext_vector_type(4)));
typedef __bf16 bf16x2_t __attribute__((ext_vector_type(2)));
typedef short s16x4 __attribute__((ext_vector_type(4)));
#define LAS __attribute__((address_space(3)))

constexpr int D = 1024, T = 16384, TC = 256, R = T + TC, NH = 4, DK = 256, DV = 512, QKW = 1024, VW = 2048, INW = 8192, DFF = 2816, FF2 = 5632, CK = 31, DEPTH = 4;
constexpr int NSLOT = 33;
constexpr float NORM_EPS = 1e-6f, LN_EPS = 1e-5f;

constexpr size_t MiB = 1u << 20, KiB = 1u << 10;
constexpr size_t WS_CTL = 0, CTL_ZERO_BYTES = 1 * MiB;
constexpr size_t WS_MODV = 1 * MiB;
constexpr size_t WS_S1 = 1 * MiB + 256 * KiB;
constexpr size_t WS_S2 = 1 * MiB + 320 * KiB;
constexpr size_t WS_CVA = 1 * MiB + 384 * KiB;
constexpr size_t WS_CVF = 1 * MiB + 640 * KiB;
constexpr size_t WS_TABC = 1 * MiB + 832 * KiB;
constexpr size_t WS_TABS = 1 * MiB + 912 * KiB;
constexpr size_t WS_STATS = 2 * MiB;
constexpr size_t WS_XCTX = 4 * MiB;
constexpr size_t WS_WA = 8 * MiB;
constexpr size_t WS_WA2 = 24 * MiB;
constexpr size_t WS_WF1 = 28 * MiB;
constexpr size_t WS_WF2 = 40 * MiB;
constexpr size_t WS_XS = 48 * MiB;
constexpr size_t WS_SCP = 48 * MiB;
constexpr size_t WS_BIG = 114 * MiB;
constexpr size_t WS_Q = WS_BIG, WS_K = WS_BIG + 33 * MiB, WS_VT = WS_BIG + 66 * MiB, WS_GF = WS_BIG + 131 * MiB, WS_GB = WS_BIG + 196 * MiB;
constexpr size_t WS_U = WS_BIG, WS_A2 = WS_BIG + 33 * MiB, WS_H = WS_BIG;
constexpr size_t WS_END = WS_BIG + 261 * MiB;
static_assert((size_t)R * 1024 * 2 <= 33 * MiB && (size_t)R * 2048 * 2 <= 65 * MiB && (size_t)R * DFF * 2 <= 131 * MiB, "map");
static_assert((size_t)NSLOT * 8 * 512 * 256 * 2 <= 66 * MiB, "scp");

constexpr int LDS_BYTES = 147456;

__device__ __forceinline__ unsigned pk2(float lo, float hi) { f32x2 v = {lo, hi}; bf16x2_t b = __builtin_convertvector(v, bf16x2_t); return __builtin_bit_cast(unsigned, b); }
__device__ __forceinline__ float bflo(unsigned u) { return __uint_as_float(u << 16); }
__device__ __forceinline__ float bfhi(unsigned u) { return __uint_as_float(u & 0xffff0000u); }
__device__ __forceinline__ float siluf(float x) { return x / (1.f + __expf(-x)); }
__device__ __forceinline__ float sigmf(float x) { return 1.f / (1.f + __expf(-x)); }
__device__ __forceinline__ float wave_sum63(float v) {
    v += __builtin_bit_cast(float, __builtin_amdgcn_update_dpp(0, __builtin_bit_cast(int, v), 0xB1, 0xF, 0xF, false));
    v += __builtin_bit_cast(float, __builtin_amdgcn_update_dpp(0, __builtin_bit_cast(int, v), 0x4E, 0xF, 0xF, false));
    v += __builtin_bit_cast(float, __builtin_amdgcn_update_dpp(0, __builtin_bit_cast(int, v), 0x141, 0xF, 0xF, false));
    v += __builtin_bit_cast(float, __builtin_amdgcn_update_dpp(0, __builtin_bit_cast(int, v), 0x140, 0xF, 0xF, false));
    v += __builtin_bit_cast(float, __builtin_amdgcn_update_dpp(0, __builtin_bit_cast(int, v), 0x142, 0xA, 0xF, false));
    v += __builtin_bit_cast(float, __builtin_amdgcn_update_dpp(0, __builtin_bit_cast(int, v), 0x143, 0xC, 0xF, false));
    return v;
}
__device__ __forceinline__ int perm_glu(int n, int H) { if (n < H) return 32 * (n >> 4) + (n & 15); const int n2 = n - H; return 32 * (n2 >> 4) + 16 + (n2 & 15); }
__device__ __forceinline__ int perm_win(int n) {
    if (n >= 2 * QKW) return n;
    const int part = n >> 10, hn = n & 1023, h = hn >> 8, d = hn & 255, quarter = d >> 6, idx = d & 63;
    const int Gp = (quarter >> 1) * 4 + (idx >> 4), i = (quarter & 1) * 16 + (idx & 15);
    return part * 1024 + h * 256 + 32 * Gp + i;
}
__device__ __forceinline__ int perm_any(int mode, int n, int H) { return mode == 0 ? n : (mode == 1 ? perm_glu(n, H) : perm_win(n)); }

struct Args { const float* in[22]; float* out; unsigned char* ws; int ph_lo, ph_hi; };

struct Ctx {
    LAS unsigned char* lds;
    int tid, lane, wave, G, bid;
    const float* const* in; float* out; unsigned char* ws;
};

template <int VSILU>
__device__ __forceinline__ void gemv2_unit(Ctx& C, const float* W, int N, int n0, const float* v0, const float* v1, const float* bias, float* o0, float* o1, int pmode, int H) {
    LAS float* red = (LAS float*)C.lds;
    const int c4 = C.tid & 15, ks = C.tid >> 4;
    f32x4 a0 = {0.f, 0.f, 0.f, 0.f}, a1 = {0.f, 0.f, 0.f, 0.f};
#pragma unroll 8
    for (int i = 0; i < 32; ++i) {
        const int k = ks * 32 + i;
        const f32x4 w = *(const f32x4*)(W + (size_t)k * N + n0 + 4 * c4);
        float x0 = v0[k], x1 = v1[k];
        if (VSILU) { x0 = siluf(x0); x1 = siluf(x1); }
        a0 += w * x0; a1 += w * x1;
    }
#pragma unroll
    for (int e = 0; e < 4; ++e) { red[(ks * 2 + 0) * 64 + 4 * c4 + e] = a0[e]; red[(ks * 2 + 1) * 64 + 4 * c4 + e] = a1[e]; }
    __syncthreads();
    if (C.tid < 128) {
        const int s = C.tid >> 6, col = C.tid & 63; float sum = 0.f;
#pragma unroll 8
        for (int k2 = 0; k2 < 32; ++k2) sum += red[(k2 * 2 + s) * 64 + col];
        const int n = n0 + col; if (bias) sum += bias[n];
        (s ? o1 : o0)[perm_any(pmode, n, H)] = sum;
    }
    __syncthreads();
}

__device__ __forceinline__ void transpose_item(const float* W, int K, int N, bf16_t* WT, int pmode, int H, LAS float* scr, int item, int lane) {
    const int nblk = N / 32, kb = item / nblk, nb = item % nblk, k0 = 64 * kb, n0 = 32 * nb;
#pragma unroll 8
    for (int i = 0; i < 32; ++i) { const int kk = 2 * i + (lane >> 5); scr[kk * 33 + (lane & 31)] = W[(size_t)(k0 + kk) * N + n0 + (lane & 31)]; }
    asm volatile("s_waitcnt lgkmcnt(0)" ::: "memory");
    const int c = lane & 7;
#pragma unroll
    for (int j = 0; j < 4; ++j) { const int n = (lane >> 3) + 8 * j; const LAS float* s = scr + (8 * c) * 33 + n;
        u32x4 o; o.x = pk2(s[0 * 33], s[1 * 33]); o.y = pk2(s[2 * 33], s[3 * 33]); o.z = pk2(s[4 * 33], s[5 * 33]); o.w = pk2(s[6 * 33], s[7 * 33]);
        *(u32x4*)(WT + (size_t)perm_any(pmode, n0 + n, H) * K + k0 + 8 * c) = o; }
    asm volatile("s_waitcnt lgkmcnt(0)" ::: "memory");
}
__device__ __forceinline__ void prep_layer(Ctx& C, int i) {
    LAS float* scr = (LAS float*)(C.lds + C.wave * 16384);
    const int gw = C.bid * 8 + C.wave, NGW = C.G * 8, j = i >> 1;
    bf16_t* WA = (bf16_t*)(C.ws + WS_WA); bf16_t* WA2 = (bf16_t*)(C.ws + WS_WA2); bf16_t* WF1 = (bf16_t*)(C.ws + WS_WF1); bf16_t* WF2 = (bf16_t*)(C.ws + WS_WF2);
    const bool conv = (i & 1) == 0;
    const int I_A = conv ? 16 * 64 : 16 * 256, I_A2 = conv ? 16 * 32 : 32 * 32, I_F1 = 16 * 176, I_F2 = 44 * 32;
    const int NIT = I_A + I_A2 + I_F1 + I_F2;
    for (int it = gw; it < NIT; it += NGW) {
        int r = it;
        if (r < I_A) { if (conv) transpose_item(C.in[8] + (size_t)j * 1024 * 2048, 1024, 2048, WA, 1, 1024, scr, r, C.lane);
                       else transpose_item(C.in[16] + (size_t)j * 1024 * 8192, 1024, 8192, WA, 2, 0, scr, r, C.lane); continue; } r -= I_A;
        if (r < I_A2) { if (conv) transpose_item(C.in[14] + (size_t)j * 1024 * 1024, 1024, 1024, WA2, 0, 0, scr, r, C.lane);
                        else transpose_item(C.in[18] + (size_t)j * 2048 * 1024, 2048, 1024, WA2, 0, 0, scr, r, C.lane); continue; } r -= I_A2;
        if (r < I_F1) { transpose_item(C.in[19] + (size_t)i * 1024 * FF2, 1024, FF2, WF1, 1, DFF, scr, r, C.lane); continue; } r -= I_F1;
        transpose_item(C.in[20] + (size_t)i * DFF * 1024, DFF, 1024, WF2, 0, 0, scr, r, C.lane);
    }
}

__device__ __forceinline__ float row_rs(const float* stats, int row, int fq) {
    const f32x4 p = *(const f32x4*)(stats + (size_t)row * 16 + 4 * fq);
    float s = (p[0] + p[1]) + (p[2] + p[3]);
    s += __shfl_xor(s, 16); s += __shfl_xor(s, 32);
    return 1.0f / sqrtf(s * (1.0f / 1024.0f) + NORM_EPS);
}
struct EpiGLU {
    static constexpr bool STATS = false, NEEDRS = true;
    unsigned char* ws; int cvoff  , cvstride  , outoff  , ldo, act;
    float* stats;
    __device__ __forceinline__ float row_begin(int row, int fq) const { return row_rs((const float*)(ws + WS_STATS), row, fq); }
    __device__ __forceinline__ float item(int row, int colp, f32x4 v0, f32x4 v1, float rs) const {
        const float* cv = (const float*)ws + cvoff + (row < T ? 0 : cvstride);
        const f32x4 ca = *(const f32x4*)(cv + colp), cg = *(const f32x4*)(cv + colp + 16);
        float o[4];
#pragma unroll
        for (int e = 0; e < 4; ++e) { const float a = rs * v0[e] + ca[e], g = rs * v1[e] + cg[e]; o[e] = act == 0 ? a * sigmf(g) : siluf(a) * g; }
        const int oc = (colp >> 5) * 16 + (colp & 15);
        u32x2 w; w.x = pk2(o[0], o[1]); w.y = pk2(o[2], o[3]);
        *(u32x2*)((bf16_t*)(ws + outoff) + (size_t)row * ldo + oc) = w;
        return 0.f;
    }
};
struct EpiRes {
    static constexpr bool STATS = true, NEEDRS = false;
    unsigned char* ws; float* xl; const float* bias; int mgoff  , snoff  ;
    float* stats;
    __device__ __forceinline__ float row_begin(int, int) const { return 1.f; }
    __device__ __forceinline__ float item(int row, int colp, f32x4 v0, f32x4 v1, float) const {
        const bool lat = row < T;
        float* xr = lat ? xl + (size_t)row * 1024 : (float*)(ws + WS_XCTX) + (size_t)(row - T) * 1024;
        const float* mg = (const float*)ws + mgoff + (lat ? 0 : 6144); const float* sn = (const float*)ws + snoff + (lat ? 0 : 1024);
        bf16_t* xs = (bf16_t*)(ws + WS_XS);
        float ss = 0.f;
#pragma unroll
        for (int hlf = 0; hlf < 2; ++hlf) {
            const int c = colp + 16 * hlf; const f32x4 v = hlf ? v1 : v0;
            const f32x4 xo = *(const f32x4*)(xr + c), m4 = *(const f32x4*)(mg + c);
            f32x4 b4 = {0.f, 0.f, 0.f, 0.f}; if (bias) b4 = *(const f32x4*)(bias + c);
            const f32x4 xn = xo + m4 * (v + b4);
            *(f32x4*)(xr + c) = xn;
            ss += (xn[0] * xn[0] + xn[1] * xn[1]) + (xn[2] * xn[2] + xn[3] * xn[3]);
            if (snoff >= 0) { const f32x4 s4 = *(const f32x4*)(sn + c); u32x2 w; w.x = pk2(xn[0] * s4[0], xn[1] * s4[1]); w.y = pk2(xn[2] * s4[2], xn[3] * s4[3]);
                *(u32x2*)(xs + (size_t)row * 1024 + c) = w; }
        }
        return ss;
    }
};
struct EpiWin {
    static constexpr bool STATS = false, NEEDRS = true;
    unsigned char* ws; int cvoff;
    float* stats;
    __device__ __forceinline__ float row_begin(int row, int fq) const { return row_rs((const float*)(ws + WS_STATS), row, fq); }
    __device__ __forceinline__ float item(int row, int colp, f32x4 v0, f32x4 v1, float rs) const {
        const float* cv = (const float*)ws + cvoff + (row < T ? 0 : 8192);
        const f32x4 c0 = *(const f32x4*)(cv + colp), c1 = *(const f32x4*)(cv + colp + 16);
        f32x4 a = v0 * rs + c0, b = v1 * rs + c1;
        if (colp < 2048) {
            if (row < T) {
                const int Gp = (colp >> 5) & 7, idx0 = 16 * (Gp & 3) + (colp & 15);
                const int ti = (Gp >> 2) ? 256 + (row & 63) : (row >> 6);
                const f32x4 cs = *(const f32x4*)((const float*)(ws + WS_TABC) + ti * 64 + idx0), sn = *(const f32x4*)((const float*)(ws + WS_TABS) + ti * 64 + idx0);
                const f32x4 o1 = a * cs - b * sn, o2 = b * cs + a * sn; a = o1; b = o2;
            }
            bf16_t* dst = (bf16_t*)(ws + WS_Q);
            if (colp >= 1024) { dst = (bf16_t*)(ws + WS_K); a = a * 0.0625f; b = b * 0.0625f; }
            const int c = colp & 1023;
            u32x2 w; w.x = pk2(a[0], a[1]); w.y = pk2(a[2], a[3]); *(u32x2*)(dst + (size_t)row * 1024 + c) = w;
            w.x = pk2(b[0], b[1]); w.y = pk2(b[2], b[3]); *(u32x2*)(dst + (size_t)row * 1024 + c + 16) = w;
        } else if (colp < 4096) {
            const int c = colp - 2048;
            bf16_t* vt = (bf16_t*)(ws + WS_VT);
#pragma unroll
            for (int e = 0; e < 4; ++e) { vt[(size_t)(c + e) * R + row] = (bf16_t)(pk2(a[e], 0.f) & 0xffffu); vt[(size_t)(c + 16 + e) * R + row] = (bf16_t)(pk2(b[e], 0.f) & 0xffffu); }
        } else {
            bf16_t* dst = (bf16_t*)(ws + (colp < 6144 ? WS_GF : WS_GB)); const int c = (colp - 4096) & 2047;
            u32x2 w; w.x = pk2(a[0], a[1]); w.y = pk2(a[2], a[3]); *(u32x2*)(dst + (size_t)row * 2048 + c) = w;
            w.x = pk2(b[0], b[1]); w.y = pk2(b[2], b[3]); *(u32x2*)(dst + (size_t)row * 2048 + c + 16) = w;
        }
        return 0.f;
    }
};

template <class Epi>
__device__ __forceinline__ void sgemm_small(Ctx& C, const bf16_t* A, const bf16_t* Bt, int row_lo, int Mrows, int N, int K, const Epi& E, int n_lo, int n_hi) {
    const int wr = C.wave >> 2, wc = C.wave & 3, fr = C.lane & 15, fq = C.lane >> 4;
    const int nM = Mrows / 32, nN = n_hi - n_lo, nU = nM * nN;
    for (int u = (C.G - 1 - C.bid); u < nU; u += C.G) {
        const int un = n_lo + u / nM, um = u % nM;
        const int row0 = row_lo + 32 * um + 16 * wr, col0 = 256 * un;
        f32x4 acc[2][2];
#pragma unroll
        for (int b = 0; b < 2; ++b)
#pragma unroll
            for (int n = 0; n < 2; ++n) acc[b][n] = (f32x4){0.f, 0.f, 0.f, 0.f};
        const bf16_t* ap = A + (size_t)(row0 + fr) * K + 8 * fq;
        const bf16_t* bp = Bt + (size_t)(col0 + 32 * wc + fr) * K + 8 * fq;
#pragma unroll 4
        for (int k0 = 0; k0 < K; k0 += 32) {
            bf16x8 bf[2][2];
            const bf16x8 af = *(const bf16x8*)(ap + k0);
#pragma unroll
            for (int bj = 0; bj < 2; ++bj)
#pragma unroll
                for (int n = 0; n < 2; ++n) bf[bj][n] = *(const bf16x8*)(bp + (size_t)(128 * bj + 16 * n) * K + k0);
#pragma unroll
            for (int bj = 0; bj < 2; ++bj)
#pragma unroll
                for (int n = 0; n < 2; ++n) acc[bj][n] = __builtin_amdgcn_mfma_f32_16x16x32_bf16(bf[bj][n], af, acc[bj][n], 0, 0, 0);
        }
        const int row = row0 + fr;
        const float rs = E.row_begin(row, fq);
        float ss = 0.f;
#pragma unroll
        for (int bj = 0; bj < 2; ++bj) ss += E.item(row, col0 + 128 * bj + 32 * wc + 4 * fq, acc[bj][0], acc[bj][1], rs);
        if constexpr (Epi::STATS) { ss += __shfl_xor(ss, 16); ss += __shfl_xor(ss, 32); if (fq == 0) E.stats[(size_t)row * 16 + un * 4 + wc] = ss; }
    }
}

namespace pg8 {
#define PG8_LAS __attribute__((address_space(3)))
typedef unsigned short bf16_t;
typedef short bf16x8 __attribute__((ext_vector_type(8)));
typedef float f32x4 __attribute__((ext_vector_type(4)));
typedef unsigned u32x4 __attribute__((ext_vector_type(4)));
constexpr int BM = 256, BK = 64, HALF = 128, HTB = HALF * BK * 2  , STAGE_BYTES = 8 * HTB, NXCD = 8, WGM = 8;

__host__ __device__ __forceinline__ int lds_byte(int r, int c) { const int st = (r >> 4) * 2 + (c >> 5), rr = r & 15, cc = c & 31, ob = rr * 64 + cc * 2; return st * 1024 + (ob ^ (((ob >> 9) & 1) << 5)); }
__host__ __device__ __forceinline__ void stage_rc(int b, int& R, int& C) { const int st = b / 1024, sb = b % 1024, swz = sb ^ (((sb >> 9) & 1) << 5); R = (st >> 1) * 16 + swz / 64; C = (st & 1) * 32 + (swz % 64) / 2; }
__host__ __device__ __forceinline__ int perm32(int rho) { const int n = rho >> 4, i = rho & 15; return 8 * (i >> 2) + 4 * n + (i & 3); }

struct Unit { int pm, pn; };
struct Gemm { const bf16_t* A; const bf16_t* Bt; int M, N, K; };

struct StaticOrder {
    int nM, nN, nwg, G, c;
    __host__ __device__ void init(int M, int N, int G_, int c_) { nM = M / BM; nN = N / BM; nwg = nM * nN; G = G_; c = c_; }
    __host__ __device__ bool next(int i, Unit& u) const {
        const long L = (long)i * G + c; if (L >= nwg) return false;
        int wgid = (int)L; { const int q = nwg / NXCD, r = nwg % NXCD, xcd = wgid % NXCD, off = wgid / NXCD; wgid = (xcd < r ? xcd * (q + 1) : r * (q + 1) + (xcd - r) * q) + off; }
        const int nig = WGM * nN, gid = wgid / nig, fm = gid * WGM, gsz = (nM - fm) < WGM ? (nM - fm) : WGM;
        u.pm = fm + ((wgid % nig) % gsz); u.pn = (wgid % nig) / gsz; return true;
    }
    __device__ __forceinline__ void a_ready(const Unit&) const {}
    __device__ __forceinline__ void done(const Unit&) const {}
};

template <class Epi, class Sched, bool ALIGN_EPI = false, bool SP2 = false>
__device__ __forceinline__ void gemm_phase(PG8_LAS unsigned char* lds, const Gemm g, const Sched& S, const Epi& E) {
    const int tid = threadIdx.x, wid = __builtin_amdgcn_readfirstlane(tid >> 6), lane = tid & 63, wr = wid >> 2, wc = wid & 3, fr = lane & 15, fq = lane >> 4;
    const int K = g.K, nt = K / BK;
    unsigned voffA[2], voffB[2];
#pragma unroll
    for (int i = 0; i < 2; ++i) { int R, C; stage_rc(tid * 16 + i * 8192, R, C); const int Rb = Epi::PERM ? ((R & ~31) + perm32(R & 31)) : R;
        voffA[i] = (unsigned)(R * K + C) * 2u; voffB[i] = (unsigned)(Rb * K + C) * 2u; }
    const size_t kstep = (size_t)(BK * 2);
    const size_t hstep = (size_t)HALF * K * 2;
    const size_t tstep = 2 * hstep;
    const unsigned ldsw = (unsigned)wid * 1024u;
    const int aoff = lds_byte(wr * 64 + fr, fq * 8), boff = lds_byte(wc * 32 + fr, fq * 8);
#define PG8_SA(b, h) (((b) * 2 + (h)) * HTB)
#define PG8_SB(b, h) ((4 + (b) * 2 + (h)) * HTB)
#define PG8_STAGE(bufoff, gbase, voff) do { _Pragma("unroll") for (int _i = 0; _i < 2; ++_i) \
        __builtin_amdgcn_global_load_lds((const unsigned*)((const char*)(gbase) + (voff)[_i]), (PG8_LAS unsigned*)(lds + (bufoff) + ldsw + _i * 8192), 16, 0, 0); } while (0)
#define PG8_LDA(dst, b, h) do { _Pragma("unroll") for (int m = 0; m < 4; ++m) _Pragma("unroll") for (int k = 0; k < 2; ++k) dst[m][k] = *(const PG8_LAS bf16x8*)(lds + PG8_SA(b, h) + aoff + m * 2048 + k * 1024); } while (0)
#define PG8_LDB(dst, b, h) do { _Pragma("unroll") for (int n = 0; n < 2; ++n) _Pragma("unroll") for (int k = 0; k < 2; ++k) dst[n][k] = *(const PG8_LAS bf16x8*)(lds + PG8_SB(b, h) + boff + n * 2048 + k * 1024); } while (0)
#define PG8_MMA(ai, bj, At, Bt) do { __builtin_amdgcn_s_setprio(1); _Pragma("unroll") for (int m = 0; m < 4; ++m) _Pragma("unroll") for (int n = 0; n < 2; ++n) _Pragma("unroll") for (int k = 0; k < 2; ++k) \
        acc[ai][bj][m][n] = __builtin_amdgcn_mfma_f32_16x16x32_bf16(Bt[n][k], At[m][k], acc[ai][bj][m][n], 0, 0, 0); __builtin_amdgcn_s_setprio(0); } while (0)
#define PG8_WAIT_V(n) asm volatile("s_waitcnt vmcnt(" #n ")" ::: "memory")
#define PG8_WAIT_L(n) asm volatile("s_waitcnt lgkmcnt(" #n ")" ::: "memory")
#define PG8_BAR __builtin_amdgcn_s_barrier()
#define PG8_SCHED __builtin_amdgcn_sched_barrier(0)
    Unit cur, nxt; int ui = 0;
    if (!S.next(0, cur)) return;
    f32x4 acc[2][2][4][2];
#pragma unroll
    for (int a = 0; a < 2; ++a)
#pragma unroll
        for (int b = 0; b < 2; ++b)
#pragma unroll
            for (int m = 0; m < 4; ++m)
#pragma unroll
                for (int n = 0; n < 2; ++n) acc[a][b][m][n] = (f32x4){0.f, 0.f, 0.f, 0.f};
    bf16x8 At[4][2], B0[2][2], B1[2][2];
    const char* cA = (const char*)g.A + (size_t)cur.pm * tstep; const char* cB = (const char*)g.Bt + (size_t)cur.pn * tstep;
    S.a_ready(cur);
    if constexpr (SP2) {
        PG8_STAGE(PG8_SB(0, 0), cB, voffB); PG8_STAGE(PG8_SB(0, 1), cB + hstep, voffB); PG8_STAGE(PG8_SA(0, 0), cA, voffA); PG8_STAGE(PG8_SA(0, 1), cA + hstep, voffA);
        if (wr == 1) PG8_BAR;
        PG8_WAIT_V(2); PG8_BAR;
        PG8_STAGE(PG8_SB(1, 0), cB + kstep, voffB); PG8_STAGE(PG8_SA(1, 0), cA + kstep, voffA); PG8_STAGE(PG8_SB(1, 1), cB + hstep + kstep, voffB);
        PG8_WAIT_V(6); PG8_BAR;
    } else {
        PG8_STAGE(PG8_SB(0, 0), cB, voffB); PG8_STAGE(PG8_SA(0, 0), cA, voffA); PG8_STAGE(PG8_SB(0, 1), cB + hstep, voffB); PG8_STAGE(PG8_SA(0, 1), cA + hstep, voffA);
        if (wr == 1) PG8_BAR;
        PG8_WAIT_V(4); PG8_BAR;
        PG8_STAGE(PG8_SB(1, 0), cB + kstep, voffB); PG8_STAGE(PG8_SA(1, 0), cA + kstep, voffA); PG8_STAGE(PG8_SB(1, 1), cB + hstep + kstep, voffB);
        PG8_WAIT_V(6); PG8_BAR;
    }
    for (;;) {
        const bool has_next = S.next(ui + 1, nxt);
        const char* nA = has_next ? (const char*)g.A + (size_t)nxt.pm * tstep : cA; const char* nB = has_next ? (const char*)g.Bt + (size_t)nxt.pn * tstep : cB;
        for (int t = 0; t < nt; t += 2) {
            const bool last = (t == nt - 2);
            const char* a1 = cA + (size_t)(t + 1) * kstep;
            const char* a2 = last ? nA : cA + (size_t)(t + 2) * kstep; const char* b2 = last ? nB : cB + (size_t)(t + 2) * kstep;
            const char* a3 = a2 + kstep; const char* b3 = b2 + kstep;
            if (last && has_next) S.a_ready(nxt);
            if constexpr (SP2) {
            PG8_LDB(B0, 0, 0); PG8_LDB(B1, 0, 1); PG8_SCHED; PG8_LDA(At, 0, 0); PG8_STAGE(PG8_SA(1, 1), a1 + hstep, voffA);
            PG8_WAIT_V(8); PG8_WAIT_L(0); PG8_BAR; PG8_MMA(0, 0, At, B0); PG8_MMA(0, 1, At, B1); PG8_BAR; PG8_SCHED;
            PG8_LDA(At, 0, 1); PG8_STAGE(PG8_SB(0, 0), b2, voffB); PG8_STAGE(PG8_SB(0, 1), b2 + hstep, voffB); PG8_STAGE(PG8_SA(0, 0), a2, voffA);
            PG8_WAIT_V(8); PG8_WAIT_L(0); PG8_BAR; PG8_MMA(1, 0, At, B0); PG8_MMA(1, 1, At, B1); PG8_BAR; PG8_SCHED;
            PG8_LDB(B0, 1, 0); PG8_LDB(B1, 1, 1); PG8_SCHED; PG8_LDA(At, 1, 0); PG8_STAGE(PG8_SA(0, 1), a2 + hstep, voffA);
            PG8_WAIT_V(8); PG8_WAIT_L(0); PG8_BAR; PG8_MMA(0, 0, At, B0); PG8_MMA(0, 1, At, B1); PG8_BAR; PG8_SCHED;
            PG8_LDA(At, 1, 1); PG8_STAGE(PG8_SB(1, 0), b3, voffB); PG8_STAGE(PG8_SB(1, 1), b3 + hstep, voffB); PG8_STAGE(PG8_SA(1, 0), a3, voffA);
            PG8_WAIT_V(8); PG8_WAIT_L(0); PG8_BAR; PG8_MMA(1, 0, At, B0); PG8_MMA(1, 1, At, B1); PG8_BAR; PG8_SCHED;
            } else {
            PG8_LDB(B0, 0, 0); PG8_SCHED; PG8_LDA(At, 0, 0); PG8_STAGE(PG8_SA(1, 1), a1 + hstep, voffA);
            PG8_WAIT_L(8); PG8_BAR; PG8_WAIT_L(0); PG8_MMA(0, 0, At, B0); PG8_BAR; PG8_SCHED;
            PG8_LDB(B1, 0, 1); PG8_STAGE(PG8_SB(0, 0), b2, voffB);
            PG8_BAR; PG8_WAIT_L(0); PG8_MMA(0, 1, At, B1); PG8_BAR;
            PG8_LDA(At, 0, 1); PG8_STAGE(PG8_SA(0, 0), a2, voffA);
            PG8_BAR; PG8_WAIT_L(0); PG8_MMA(1, 0, At, B0); PG8_BAR; PG8_SCHED;
            PG8_STAGE(PG8_SB(0, 1), b2 + hstep, voffB);
            PG8_WAIT_V(6); PG8_BAR; PG8_MMA(1, 1, At, B1); PG8_BAR;
            PG8_LDB(B0, 1, 0); PG8_SCHED; PG8_LDA(At, 1, 0); PG8_STAGE(PG8_SA(0, 1), a2 + hstep, voffA);
            PG8_WAIT_L(8); PG8_BAR; PG8_WAIT_L(0); PG8_MMA(0, 0, At, B0); PG8_BAR; PG8_SCHED;
            PG8_LDB(B1, 1, 1); PG8_STAGE(PG8_SB(1, 0), b3, voffB);
            PG8_BAR; PG8_WAIT_L(0); PG8_MMA(0, 1, At, B1); PG8_BAR;
            PG8_LDA(At, 1, 1); PG8_STAGE(PG8_SA(1, 0), a3, voffA);
            PG8_BAR; PG8_WAIT_L(0); PG8_MMA(1, 0, At, B0); PG8_BAR; PG8_SCHED;
            PG8_STAGE(PG8_SB(1, 1), b3 + hstep, voffB);
            PG8_WAIT_V(6); PG8_BAR; PG8_MMA(1, 1, At, B1); PG8_BAR;
            }
        }
        if constexpr (ALIGN_EPI) { if (wr == 0) PG8_BAR; }
        if constexpr (!Epi::AFTER_DRAIN) { E(acc, cur, wr, wc, fr, fq); S.done(cur); }
        if (!has_next) break;
#pragma unroll
        for (int a = 0; a < 2; ++a)
#pragma unroll
            for (int b = 0; b < 2; ++b)
#pragma unroll
                for (int m = 0; m < 4; ++m)
#pragma unroll
                    for (int n = 0; n < 2; ++n) acc[a][b][m][n] = (f32x4){0.f, 0.f, 0.f, 0.f};
        cur = nxt; cA = nA; cB = nB; ++ui;
        if constexpr (ALIGN_EPI) { if (wr == 1) PG8_BAR; }
    }
    PG8_WAIT_V(0);
    if constexpr (!ALIGN_EPI) { if (wr == 0) PG8_BAR; }
    PG8_BAR;
    if constexpr (Epi::AFTER_DRAIN) { E.fused(acc, cur, wr, wc, fr, fq, lds, wid, lane); S.done(cur); }
#undef PG8_SA
#undef PG8_SB
#undef PG8_STAGE
#undef PG8_LDA
#undef PG8_LDB
#undef PG8_MMA
#undef PG8_WAIT_V
#undef PG8_WAIT_L
#undef PG8_BAR
#undef PG8_SCHED
}
}

template <class E0> struct EpiAdapt {
    static constexpr bool PERM = false, AFTER_DRAIN = false;
    E0 e;
    __device__ __forceinline__ void operator()(const pg8::f32x4 (&acc)[2][2][4][2], const pg8::Unit& u, int wr, int wc, int fr, int fq) const {
#pragma unroll
        for (int ai = 0; ai < 2; ++ai)
#pragma unroll
            for (int m = 0; m < 4; ++m) {
                const int row = u.pm * 256 + ai * 128 + wr * 64 + m * 16 + fr;
                const float rs = e.row_begin(row, fq);
                float ss = 0.f;
#pragma unroll
                for (int bj = 0; bj < 2; ++bj) ss += e.item(row, u.pn * 256 + bj * 128 + wc * 32 + 4 * fq, acc[ai][bj][m][0], acc[ai][bj][m][1], rs);
                if constexpr (E0::STATS) { ss += __shfl_xor(ss, 16); ss += __shfl_xor(ss, 32); if (fq == 0) e.stats[(size_t)row * 16 + u.pn * 4 + wc] = ss; }
            }
    }
};
template <class E0>
__device__ __forceinline__ void gemm_both(Ctx& C, const bf16_t* A, const bf16_t* Bt, int Mbig, int N, int K, const E0& E, int ctx_n_lo, int ctx_n_hi) {
    { pg8::Gemm g{A, Bt, Mbig, N, K}; pg8::StaticOrder S; S.init(Mbig, N, C.G, C.bid); EpiAdapt<E0> EA{E};
      pg8::gemm_phase<EpiAdapt<E0>, pg8::StaticOrder, true, true>(C.lds, g, S, EA); }
    if (Mbig < R && ctx_n_hi > ctx_n_lo) sgemm_small(C, A, Bt, Mbig, R - Mbig, N, K, E, ctx_n_lo, ctx_n_hi);
}
__device__ __forceinline__ void dwconv_phase(Ctx& C, int j) {
    const bf16_t* U = (const bf16_t*)(C.ws + WS_U); bf16_t* A2 = (bf16_t*)(C.ws + WS_A2);
    const float* dww = C.in[10] + (size_t)j * CK * 1024; const float* dwb = C.in[11] + j * 1024; const float* lng = C.in[12] + j * 1024; const float* lnb = C.in[13] + j * 1024;
    LAS unsigned char* tile = C.lds; LAS float* part = (LAS float*)(C.lds + 62 * 2048);
    const int tid = C.tid;
    for (int u = C.bid; u < 520; u += C.G) {
        const int base = u < 512 ? 0 : T, n = u < 512 ? T : TC, t0 = 32 * (u < 512 ? u : u - 512);
        for (int idx = tid; idx < 62 * 128; idx += 512) {
            const int rr = idx >> 7, ch = idx & 127, tt = t0 - 15 + rr;
            u32x4 v = {0u, 0u, 0u, 0u};
            if (tt >= 0 && tt < n) v = *(const u32x4*)(U + (size_t)(base + tt) * 1024 + ch * 8);
            *(LAS u32x4*)(tile + rr * 2048 + ch * 16) = v;
        }
        __syncthreads();
        float o0[32], o1[32];
        { const f32x2 b2 = *(const f32x2*)(dwb + 2 * tid);
#pragma unroll
          for (int t = 0; t < 32; ++t) { o0[t] = b2.x; o1[t] = b2.y; } }
        for (int jt = 0; jt < CK; ++jt) {
            const f32x2 w = *(const f32x2*)(dww + jt * 1024 + 2 * tid);
            const LAS unsigned char* p = tile + jt * 2048 + tid * 4;
#pragma unroll
            for (int t = 0; t < 32; ++t) { const unsigned uu = *(const LAS unsigned*)(p + t * 2048); o0[t] += w.x * bflo(uu); o1[t] += w.y * bfhi(uu); }
        }
#pragma unroll
        for (int t = 0; t < 32; ++t) {
            const float s = wave_sum63(o0[t] + o1[t]), q = wave_sum63(o0[t] * o0[t] + o1[t] * o1[t]);
            if (C.lane == 63) { part[(t * 8 + C.wave) * 2] = s; part[(t * 8 + C.wave) * 2 + 1] = q; }
        }
        __syncthreads();
        const f32x2 g2 = *(const f32x2*)(lng + 2 * tid), bb2 = *(const f32x2*)(lnb + 2 * tid);
#pragma unroll
        for (int t = 0; t < 32; ++t) {
            float s = 0.f, q = 0.f;
#pragma unroll
            for (int w = 0; w < 8; ++w) { s += part[(t * 8 + w) * 2]; q += part[(t * 8 + w) * 2 + 1]; }
            const float mean = s * (1.f / 1024.f), var = q * (1.f / 1024.f) - mean * mean, rstd = 1.0f / sqrtf(var + LN_EPS);
            const float y0 = (o0[t] - mean) * rstd * g2.x + bb2.x, y1 = (o1[t] - mean) * rstd * g2.y + bb2.y;
            *(unsigned*)(A2 + (size_t)(base + t0 + t) * 1024 + 2 * tid) = pk2(siluf(y0), siluf(y1));
        }
        __syncthreads();
    }
}

__device__ __forceinline__ void scan_phase(Ctx& C, int j) {
    const bf16_t* Kb = (const bf16_t*)(C.ws + WS_K); const bf16_t* Vt = (const bf16_t*)(C.ws + WS_VT); bf16_t* Scp = (bf16_t*)(C.ws + WS_SCP);
    constexpr int KP = 64, VP = 136;
    constexpr int KBYTES = 128 * KP * 2, VBYTES = 64 * VP * 2;
    LAS bf16_t* kbuf = (LAS bf16_t*)C.lds;
    LAS bf16_t* vbuf = (LAS bf16_t*)(C.lds + 2 * KBYTES);
    const int fr = C.lane & 15, fq = C.lane >> 4, w = C.wave, tid = C.tid;
    for (int cu = C.bid; cu < 256; cu += C.G) {
        const int hd = cu & 7, sidx = cu >> 3, h = hd >> 1, dir = hd & 1, dk_s = 64 * ((sidx >> 3) & 3), dv_s = 64 * (sidx & 7);
        const int mt = w >> 1, nh = w & 1, dkl = 16 * mt, dvl = 32 * nh;
        const float gam = 1.0f - exp2f(C.in[17][(j * 2 + dir) * 4 + h]); const float L = log2f(gam);
        const float cdec = exp2f(L * 128.f);
        const int krow = tid >> 3, kch = tid & 7, vrow = tid >> 4, vch = tid & 15;
        const int kchs = kch ^ (((krow >> 3) & 1) << 1) ^ (((krow >> 1) & 1) << 2);
        const int trq = (fr >> 2), trp = fr & 3;
        const int trrow0 = 8 * fq + trq;
        const int trcol0 = (((2 * mt + (trp >> 1)) ^ ((fq & 1) << 1) ^ (((trq >> 1) & 1) << 2)) << 3) + 4 * (trp & 1);
        const float kd0 = exp2f(L * (float)(dir == 0 ? 127 - krow : krow)), kd1 = exp2f(L * (float)(dir == 0 ? 63 - krow : krow + 64));
        const bf16_t* kg = Kb + (size_t)krow * 1024 + h * 256 + dk_s + 8 * kch;
        const bf16_t* vg = Vt + (size_t)(h * 512 + dv_s + vrow) * R + 8 * vch;
        auto tok_of = [&](int st) { const int bl = st < 2 ? (dir == 0 ? st : 1 - st) : (dir == 0 ? st - 2 : 129 - st); return (st < 2 ? T : 0) + 128 * bl; };
        f32x4 acc[2]; acc[0] = (f32x4){0.f, 0.f, 0.f, 0.f}; acc[1] = acc[0];
        u32x4 ra[4], rb[4];
#define SCAN_LOAD(dst, tok) do { dst[0] = *(const u32x4*)(kg + (size_t)(tok) * 1024); dst[1] = *(const u32x4*)(kg + (size_t)((tok) + 64) * 1024); \
        dst[2] = *(const u32x4*)(vg + (tok)); dst[3] = *(const u32x4*)(vg + (size_t)32 * R + (tok)); } while (0)
#define SCAN_STORE(src, buf) do { LAS bf16_t* kb_ = kbuf + (buf) * 128 * KP; LAS bf16_t* vb_ = vbuf + (buf) * 64 * VP; u32x4 o_; \
        o_.x = pk2(bflo(src[0].x) * kd0, bfhi(src[0].x) * kd0); o_.y = pk2(bflo(src[0].y) * kd0, bfhi(src[0].y) * kd0); o_.z = pk2(bflo(src[0].z) * kd0, bfhi(src[0].z) * kd0); o_.w = pk2(bflo(src[0].w) * kd0, bfhi(src[0].w) * kd0); \
        *(LAS u32x4*)(kb_ + krow * KP + 8 * kchs) = o_; \
        o_.x = pk2(bflo(src[1].x) * kd1, bfhi(src[1].x) * kd1); o_.y = pk2(bflo(src[1].y) * kd1, bfhi(src[1].y) * kd1); o_.z = pk2(bflo(src[1].z) * kd1, bfhi(src[1].z) * kd1); o_.w = pk2(bflo(src[1].w) * kd1, bfhi(src[1].w) * kd1); \
        *(LAS u32x4*)(kb_ + (krow + 64) * KP + 8 * kchs) = o_; \
        *(LAS u32x4*)(vb_ + vrow * VP + 8 * vch) = src[2]; *(LAS u32x4*)(vb_ + (vrow + 32) * VP + 8 * vch) = src[3]; } while (0)
        __syncthreads();
        SCAN_LOAD(ra, tok_of(0));
        SCAN_STORE(ra, 0);
        SCAN_LOAD(ra, tok_of(1));
        __syncthreads();
#define SCAN_STEP(st, RA, RB) do { \
            const int cur = (st) & 1; \
            if ((st) + 2 < 130) SCAN_LOAD(RB, tok_of((st) + 2)); \
            {   const bool isctx = (st) < 2; const int bl = isctx ? (dir == 0 ? (st) : 1 - (st)) : (dir == 0 ? (st) - 2 : 129 - (st)); \
                const bool cp = dir == 0 ? ((bl & 3) == 0) : (isctx ? bl == 1 : (bl & 3) == 3); \
                if (cp) { \
                    const int slot = isctx ? 32 : (bl >> 2); \
                    bf16_t* sp = Scp + ((size_t)((slot * 4 + h) * 2 + dir) * 512) * 256; \
                    _Pragma("unroll") for (int nt = 0; nt < 2; ++nt) { u32x2 wv; wv.x = pk2(acc[nt][0], acc[nt][1]); wv.y = pk2(acc[nt][2], acc[nt][3]); \
                        *(u32x2*)(sp + (size_t)(dv_s + dvl + 16 * nt + fr) * 256 + dk_s + dkl + 4 * fq) = wv; } \
                } } \
            acc[0] = acc[0] * cdec; acc[1] = acc[1] * cdec; \
            const LAS bf16_t* kb = kbuf + cur * 128 * KP; const LAS bf16_t* vb = vbuf + cur * 64 * VP; \
            _Pragma("unroll") for (int ks = 0; ks < 4; ++ks) { \
                const LAS bf16_t* kp = kb + (32 * ks + trrow0) * KP + trcol0; \
                const s16x4 lo4 = __builtin_amdgcn_ds_read_tr16_b64_v4i16((LAS s16x4*)kp); \
                const s16x4 hi4 = __builtin_amdgcn_ds_read_tr16_b64_v4i16((LAS s16x4*)(kp + 4 * KP)); \
                const bf16x8 af = (bf16x8){lo4[0], lo4[1], lo4[2], lo4[3], hi4[0], hi4[1], hi4[2], hi4[3]}; \
                _Pragma("unroll") for (int nt = 0; nt < 2; ++nt) { const bf16x8 vf = *(const LAS bf16x8*)(vb + (dvl + 16 * nt + fr) * VP + 32 * ks + 8 * fq); \
                    acc[nt] = __builtin_amdgcn_mfma_f32_16x16x32_bf16(af, vf, acc[nt], 0, 0, 0); } \
            } \
            if ((st) + 1 < 130) SCAN_STORE(RA, cur ^ 1); \
            __syncthreads(); \
        } while (0)
#pragma unroll 1
        for (int st2 = 0; st2 < 130; st2 += 2) { SCAN_STEP(st2, ra, rb); SCAN_STEP(st2 + 1, rb, ra); }
#undef SCAN_STEP
#undef SCAN_LOAD
#undef SCAN_STORE
    }
}

__device__ __forceinline__ void readout_phase(Ctx& C, int j, bool skip_ctx) {
    const bf16_t* Q = (const bf16_t*)(C.ws + WS_Q); const bf16_t* Kb = (const bf16_t*)(C.ws + WS_K); const bf16_t* Vt = (const bf16_t*)(C.ws + WS_VT);
    const bf16_t* Scp = (const bf16_t*)(C.ws + WS_SCP); bf16_t* GF = (bf16_t*)(C.ws + WS_GF); const bf16_t* GB = (const bf16_t*)(C.ws + WS_GB);
    constexpr int QP = 264, PP = 136;
    LAS bf16_t* Qs = (LAS bf16_t*)C.lds;
    LAS bf16_t* Pb = (LAS bf16_t*)(C.lds + 64 * QP * 2);
    LAS float* red = (LAS float*)(C.lds + 64 * QP * 2 + 2 * 64 * PP * 2);
    const int fr = C.lane & 15, fq = C.lane >> 4, w = C.wave, tid = C.tid;
    const int nunits = skip_ctx ? 512 : 520;
    for (int u0 = C.bid; u0 < nunits; u0 += C.G) {
        int h, b;
        if (C.G == 256 && u0 < 512) { const int r = u0 >> 8, x = u0 & 7, idx = (u0 & 255) >> 3, grp = r * 64 + x * 8 + (idx >> 2); h = grp & 3; b = (grp >> 2) * 4 + (idx & 3); }
        else { h = u0 & 3; b = u0 >> 2; }
        const bool lat = b < 128; const int base = lat ? 0 : T, nb = lat ? 128 : 2, bl = lat ? b : b - 128;
        const int g = bl >> 2, slot = lat ? g : 32;
        const int gend = (4 * (g + 1) < nb ? 4 * (g + 1) : nb);
#pragma unroll 1
        for (int rh = 0; rh < 2; ++rh) {
            const int i0 = base + 128 * bl + 64 * rh, il0 = 128 * bl + 64 * rh;
            __syncthreads();
#pragma unroll
            for (int i = 0; i < 4; ++i) { const int c = tid + 512 * i, row = c >> 5, ch = c & 31;
                *(LAS u32x4*)(Qs + row * QP + 8 * ch) = *(const u32x4*)(Q + (size_t)(i0 + row) * 1024 + h * 256 + 8 * ch); }
            __syncthreads();
#pragma unroll 1
            for (int dir = 0; dir < 2; ++dir) {
                const float gam = 1.0f - exp2f(C.in[17][(j * 2 + dir) * 4 + h]); const float L = log2f(gam);
                f32x4 acc[4][4];
#pragma unroll
                for (int mt = 0; mt < 4; ++mt)
#pragma unroll
                    for (int nt = 0; nt < 4; ++nt) acc[mt][nt] = (f32x4){0.f, 0.f, 0.f, 0.f};
                const bf16_t* sb = Scp + ((size_t)((slot * 4 + h) * 2 + dir) * 512) * 256 + (size_t)(64 * w + fr) * 256 + 8 * fq;
#pragma unroll
                for (int half = 0; half < 2; ++half) {
                    bf16x8 sf[4][4];
#pragma unroll
                    for (int k4 = 0; k4 < 4; ++k4)
#pragma unroll
                        for (int nt = 0; nt < 4; ++nt) sf[k4][nt] = *(const bf16x8*)(sb + (size_t)(16 * nt) * 256 + 32 * (4 * half + k4));
#pragma unroll
                    for (int k4 = 0; k4 < 4; ++k4)
#pragma unroll
                        for (int mt = 0; mt < 4; ++mt) { const bf16x8 qf = *(const LAS bf16x8*)(Qs + (16 * mt + fr) * QP + 32 * (4 * half + k4) + 8 * fq);
#pragma unroll
                            for (int nt = 0; nt < 4; ++nt) acc[mt][nt] = __builtin_amdgcn_mfma_f32_16x16x32_bf16(sf[k4][nt], qf, acc[mt][nt], 0, 0, 0); }
                }
#pragma unroll
                for (int mt = 0; mt < 4; ++mt) {
                    const int il = il0 + 16 * mt + fr;
                    const int ex = dir == 0 ? il - 512 * g + 1 : gend * 128 - il;
                    const float qd = exp2f(L * (float)ex);
#pragma unroll
                    for (int nt = 0; nt < 4; ++nt) acc[mt][nt] = acc[mt][nt] * qd;
                }
                const int kb_lo = dir == 0 ? 4 * g : bl, kb_hi = dir == 0 ? bl : gend - 1;
                int pbuf = 0;
#pragma unroll 1
                for (int kb = kb_lo; kb <= kb_hi; ++kb) {
                    const int j0 = base + 128 * kb;
                    bf16x8 kf[8], vf[4][4];
                    { const bf16_t* k1 = Kb + (size_t)(j0 + 16 * w + fr) * 1024 + h * 256 + 8 * fq;
#pragma unroll
                      for (int ks = 0; ks < 8; ++ks) kf[ks] = *(const bf16x8*)(k1 + 32 * ks);
                      const bf16_t* vb = Vt + (size_t)(h * 512 + 64 * w + fr) * R + j0 + 8 * fq;
#pragma unroll
                      for (int ks = 0; ks < 4; ++ks)
#pragma unroll
                          for (int nt = 0; nt < 4; ++nt) vf[ks][nt] = *(const bf16x8*)(vb + (size_t)(16 * nt) * R + 32 * ks); }
                    f32x4 sc[4];
#pragma unroll
                    for (int mt = 0; mt < 4; ++mt) sc[mt] = (f32x4){0.f, 0.f, 0.f, 0.f};
#pragma unroll
                    for (int ks = 0; ks < 8; ++ks)
#pragma unroll
                        for (int mt = 0; mt < 4; ++mt) { const bf16x8 qf = *(const LAS bf16x8*)(Qs + (16 * mt + fr) * QP + 32 * ks + 8 * fq);
                            sc[mt] = __builtin_amdgcn_mfma_f32_16x16x32_bf16(kf[ks], qf, sc[mt], 0, 0, 0); }
                    LAS bf16_t* P = Pb + pbuf * 64 * PP;
#pragma unroll
                    for (int mt = 0; mt < 4; ++mt) {
                        const int il = il0 + 16 * mt + fr;
                        float p[4];
#pragma unroll
                        for (int e = 0; e < 4; ++e) { const int jl = 128 * kb + 16 * w + 4 * fq + e; const int rel = dir == 0 ? il - jl : jl - il;
                            p[e] = rel >= 0 ? sc[mt][e] * exp2f(L * (float)rel) : 0.f; }
                        u32x2 wv; wv.x = pk2(p[0], p[1]); wv.y = pk2(p[2], p[3]);
                        *(LAS u32x2*)(P + (16 * mt + fr) * PP + 16 * w + 4 * fq) = wv;
                    }
                    __syncthreads();
#pragma unroll
                    for (int ks = 0; ks < 4; ++ks)
#pragma unroll
                        for (int mt = 0; mt < 4; ++mt) { const bf16x8 pf = *(const LAS bf16x8*)(P + (16 * mt + fr) * PP + 32 * ks + 8 * fq);
#pragma unroll
                            for (int nt = 0; nt < 4; ++nt) acc[mt][nt] = __builtin_amdgcn_mfma_f32_16x16x32_bf16(vf[ks][nt], pf, acc[mt][nt], 0, 0, 0); }
                    pbuf ^= 1;
                }
#pragma unroll
                for (int mt = 0; mt < 4; ++mt) {
                    float ss = 0.f;
#pragma unroll
                    for (int nt = 0; nt < 4; ++nt) ss += (acc[mt][nt][0] * acc[mt][nt][0] + acc[mt][nt][1] * acc[mt][nt][1]) + (acc[mt][nt][2] * acc[mt][nt][2] + acc[mt][nt][3] * acc[mt][nt][3]);
                    ss += __shfl_xor(ss, 16); ss += __shfl_xor(ss, 32);
                    if (fq == 0) red[(16 * mt + fr) * 8 + w] = ss;
                }
                __syncthreads();
#pragma unroll
                for (int mt = 0; mt < 4; ++mt) {
                    float tot = 0.f;
#pragma unroll
                    for (int w2 = 0; w2 < 8; ++w2) tot += red[(16 * mt + fr) * 8 + w2];
                    const float rn = 1.0f / sqrtf(tot * (1.f / 512.f) + NORM_EPS);
                    const size_t off = (size_t)(i0 + 16 * mt + fr) * 2048 + h * 512 + 64 * w + 4 * fq;
#pragma unroll
                    for (int nt = 0; nt < 4; ++nt) {
                        const u32x2 gg = *(const u32x2*)((dir == 0 ? (const bf16_t*)GF : GB) + off + 16 * nt);
                        float y0 = siluf(bflo(gg.x)) * acc[mt][nt][0] * rn, y1 = siluf(bfhi(gg.x)) * acc[mt][nt][1] * rn;
                        float y2 = siluf(bflo(gg.y)) * acc[mt][nt][2] * rn, y3 = siluf(bfhi(gg.y)) * acc[mt][nt][3] * rn;
                        if (dir == 1) { const u32x2 yp = *(const u32x2*)(GF + off + 16 * nt); y0 += bflo(yp.x); y1 += bfhi(yp.x); y2 += bflo(yp.y); y3 += bfhi(yp.y); }
                        u32x2 wv; wv.x = pk2(y0, y1); wv.y = pk2(y2, y3);
                        *(u32x2*)(GF + off + 16 * nt) = wv;
                    }
                }
            }
        }
    }
}

__device__ __forceinline__ void phase_p0(Ctx& C) {
    float* modv = (float*)(C.ws + WS_MODV);
    for (int u = C.bid; u < 384; u += C.G) {
        const int i = u / 96, nbk = u % 96;
        gemv2_unit<1>(C, C.in[4] + (size_t)i * 1024 * 6144, 6144, 64 * nbk, C.in[1], C.in[3], C.in[5] + i * 6144, modv + (i * 2 + 0) * 6144, modv + (i * 2 + 1) * 6144, 0, 0);
    }
    float* tabc = (float*)(C.ws + WS_TABC); float* tabs = (float*)(C.ws + WS_TABS);
    for (int idx = C.bid * 512 + C.tid; idx < 320 * 64; idx += C.G * 512) {
        const int ti = idx >> 6, i = idx & 63; const float pos = (float)(ti < 256 ? ti : ti - 256);
        const float inv = exp2f(-(float)i * (13.287712379549449f / 64.0f)); const float ang = pos * inv;
        tabc[idx] = __cosf(ang); tabs[idx] = __sinf(ang);
    }
}
__device__ __forceinline__ void phase_p1(Ctx& C) {
    const float* modv = (const float*)(C.ws + WS_MODV);
    float* s1 = (float*)(C.ws + WS_S1); float* s2 = (float*)(C.ws + WS_S2);
    for (int idx = C.bid * 512 + C.tid; idx < 8192; idx += C.G * 512) {
        const int i = idx >> 11, s = (idx >> 10) & 1, k = idx & 1023;
        s1[idx] = C.in[6][i * 1024 + k] * (1.f + modv[(i * 2 + s) * 6144 + 1024 + k]);
        s2[idx] = C.in[7][i * 1024 + k] * (1.f + modv[(i * 2 + s) * 6144 + 4096 + k]);
    }
    float* cvA = (float*)(C.ws + WS_CVA); float* cvF = (float*)(C.ws + WS_CVF);
    for (int u = C.bid; u < 672; u += C.G) {
        if (u < 320) {
            int i, nbk; if (u < 32) { i = 0; nbk = u; } else if (u < 160) { i = 1; nbk = u - 32; } else if (u < 192) { i = 2; nbk = u - 160; } else { i = 3; nbk = u - 192; }
            const int j = i >> 1; const float* v0 = modv + (i * 2 + 0) * 6144; const float* v1 = modv + (i * 2 + 1) * 6144;
            if ((i & 1) == 0) gemv2_unit<0>(C, C.in[8] + (size_t)j * 1024 * 2048, 2048, 64 * nbk, v0, v1, C.in[9] + j * 2048, cvA + (i * 2) * 8192, cvA + (i * 2 + 1) * 8192, 1, 1024);
            else gemv2_unit<0>(C, C.in[16] + (size_t)j * 1024 * 8192, 8192, 64 * nbk, v0, v1, nullptr, cvA + (i * 2) * 8192, cvA + (i * 2 + 1) * 8192, 2, 0);
        } else {
            const int i = (u - 320) / 88, nbk = (u - 320) % 88;
            const float* v0 = modv + (i * 2 + 0) * 6144 + 3072; const float* v1 = modv + (i * 2 + 1) * 6144 + 3072;
            gemv2_unit<0>(C, C.in[19] + (size_t)i * 1024 * FF2, FF2, 64 * nbk, v0, v1, nullptr, cvF + (i * 2) * FF2, cvF + (i * 2 + 1) * FF2, 1, DFF);
        }
    }
    bf16_t* xs = (bf16_t*)(C.ws + WS_XS); float* stats = (float*)(C.ws + WS_STATS); float* xctx = (float*)(C.ws + WS_XCTX);
    for (int row = C.bid * 8 + C.wave; row < R; row += C.G * 8) {
        const bool lat = row < T; const int s = lat ? 0 : 1;
        const float* src = lat ? C.in[0] + (size_t)row * 1024 : C.in[2] + (size_t)(row - T) * 1024;
        float* dst = lat ? C.out + (size_t)row * 1024 : xctx + (size_t)(row - T) * 1024;
        float ss = 0.f;
#pragma unroll
        for (int jj = 0; jj < 4; ++jj) {
            const int k = 4 * C.lane + 256 * jj;
            const f32x4 v = *(const f32x4*)(src + k); *(f32x4*)(dst + k) = v;
            ss += (v[0] * v[0] + v[1] * v[1]) + (v[2] * v[2] + v[3] * v[3]);
            const f32x4 g = *(const f32x4*)(C.in[6] + k), m = *(const f32x4*)(modv + s * 6144 + 1024 + k);
            u32x2 w; w.x = pk2(v[0] * g[0] * (1.f + m[0]), v[1] * g[1] * (1.f + m[1])); w.y = pk2(v[2] * g[2] * (1.f + m[2]), v[3] * g[3] * (1.f + m[3]));
            *(u32x2*)(xs + (size_t)row * 1024 + k) = w;
        }
#pragma unroll
        for (int off = 1; off < 64; off <<= 1) ss += __shfl_xor(ss, off);
        if (C.lane < 16) stats[(size_t)row * 16 + C.lane] = C.lane == 0 ? ss : 0.f;
    }
    prep_layer(C, 0);
}
__device__ __forceinline__ void phase_final(Ctx& C) {
    const float* stats = (const float*)(C.ws + WS_STATS);
    for (int row = C.bid * 8 + C.wave; row < T; row += C.G * 8) {
        float s = C.lane < 16 ? stats[(size_t)row * 16 + C.lane] : 0.f;
#pragma unroll
        for (int off = 1; off < 64; off <<= 1) s += __shfl_xor(s, off);
        const float r = 1.0f / sqrtf(s * (1.f / 1024.f) + NORM_EPS);
        float* xr = C.out + (size_t)row * 1024;
#pragma unroll
        for (int jj = 0; jj < 4; ++jj) { const int k = 4 * C.lane + 256 * jj; const f32x4 v = *(const f32x4*)(xr + k), g = *(const f32x4*)(C.in[21] + k); *(f32x4*)(xr + k) = v * r * g; }
    }
}

constexpr int NPHASE = 31;
__device__ __forceinline__ void run_phase(Ctx& C, int ph) {
    const int i = (ph - 2) / 7, sub = (ph - 2) % 7, j = i >> 1; const bool conv = (i & 1) == 0;
    const bool last = i == DEPTH - 1;
    float* stats = (float*)(C.ws + WS_STATS);
    const bf16_t* xs = (const bf16_t*)(C.ws + WS_XS);
    constexpr int F_MODV = (int)(WS_MODV / 4), F_S1 = (int)(WS_S1 / 4), F_S2 = (int)(WS_S2 / 4), F_CVA = (int)(WS_CVA / 4), F_CVF = (int)(WS_CVF / 4);
    if (sub == 1) {
        if (conv) { EpiGLU E{C.ws, F_CVA + (i * 2) * 8192, 8192, (int)WS_U, 1024, 0, stats}; gemm_both(C, xs, (const bf16_t*)(C.ws + WS_WA), T, 2048, 1024, E, 0, 8); }
        else { EpiWin E{C.ws, F_CVA + (i * 2) * 8192, stats}; gemm_both(C, xs, (const bf16_t*)(C.ws + WS_WA), T, 8192, 1024, E, last ? 4 : 0, last ? 16 : 32); }
    } else if (sub == 5) {
        EpiGLU E{C.ws, F_CVF + (i * 2) * FF2, FF2, (int)WS_H, DFF, 1, stats}; gemm_both(C, xs, (const bf16_t*)(C.ws + WS_WF1), last ? T : R, FF2, 1024, E, 0, 0);
    } else {
        const bool f2 = sub == 6;
        const int mgoff = F_MODV + (i * 2) * 6144 + (f2 ? 5120 : 2048);
        const int snoff = f2 ? (last ? -1 : F_S1 + ((i + 1) * 2) * 1024) : F_S2 + (i * 2) * 1024;
        const float* bias = (!f2 && conv) ? C.in[15] + j * 1024 : nullptr;
        const bf16_t* A = (const bf16_t*)(C.ws + (f2 ? WS_H : (conv ? WS_A2 : WS_GF)));
        const bf16_t* Bt = (const bf16_t*)(C.ws + (f2 ? WS_WF2 : WS_WA2));
        const int K = f2 ? DFF : (conv ? 1024 : 2048);
        EpiRes E{C.ws, C.out, bias, mgoff, snoff, stats};
        gemm_both(C, A, Bt, T, 1024, K, E, 0, last ? 0 : 4);
    }
}

#define XB_TMO      128
#define XB_XCNT(j)  (256  + 64 * (j))
#define XB_XSUB(j)  (1280 + 64 * (j))
#define XB_XGEN(j)  (2304 + 64 * (j))
#define XB_TOP      3328
#define XB_TOPGEN   3392
#define XCD_BAR_WORDS 3456
#define XB_SPIN_CAP (1u << 20)
__device__ __forceinline__ unsigned xb_ld(unsigned* p)              { return __hip_atomic_load(p, __ATOMIC_RELAXED, __HIP_MEMORY_SCOPE_AGENT); }
__device__ __forceinline__ unsigned xb_add(unsigned* p, unsigned v) { return __hip_atomic_fetch_add(p, v, __ATOMIC_RELAXED, __HIP_MEMORY_SCOPE_AGENT); }
__device__ __forceinline__ unsigned xb_xcc_id() { return (unsigned)__builtin_amdgcn_s_getreg((3 << 11) | 20) & 0xFu; }
#define XB_SPIN(cond, bar) do { unsigned _sp = 0; while (cond) { __builtin_amdgcn_s_sleep(1); \
    if ((++_sp & 255u) == 0u) { if (xb_ld(&(bar)[XB_TMO])) break; if (_sp > XB_SPIN_CAP) { atomicAdd(&(bar)[XB_TMO], 1u); break; } } } } while (0)
struct XcdBarrier { unsigned* bar; unsigned x; volatile LAS unsigned* st; };
__device__ __forceinline__ XcdBarrier xcd_barrier_post(unsigned* bar, volatile LAS unsigned* st) {
    XcdBarrier b; b.bar = bar; b.x = xb_xcc_id(); b.st = st;
    if (threadIdx.x == 0) (void)xb_add(&bar[XB_XCNT(b.x)], 1u);
    return b;
}
__device__ __forceinline__ void xcd_barrier_complete(unsigned* bar, unsigned x, unsigned& nloc, unsigned& nx) {
    const unsigned G = gridDim.x * gridDim.y * gridDim.z;
    unsigned sum, cnt, mine, sp = 0u;
    for (;;) {
        sum = 0u; cnt = 0u; mine = 0u;
#pragma unroll
        for (unsigned j = 0; j < 16; ++j) { const unsigned c = xb_ld(&bar[XB_XCNT(j)]); sum += c; cnt += (c > 0u) ? 1u : 0u; mine = (j == x) ? c : mine; }
        if (sum == G) break;
        __builtin_amdgcn_s_sleep(1);
        if ((++sp & 255u) == 0u) { if (xb_ld(&bar[XB_TMO])) break; if (sp > XB_SPIN_CAP) { atomicAdd(&bar[XB_TMO], 1u); break; } }
    }
    nloc = mine > 0u ? mine : 1u; nx = cnt > 0u ? cnt : 1u;
}
__device__ __forceinline__ void xcd_barrier(const XcdBarrier& b) {
    asm volatile("s_waitcnt vmcnt(0)" ::: "memory");
    __syncthreads();
    if (threadIdx.x == 0) {
        unsigned* bar = b.bar;
        __builtin_amdgcn_s_waitcnt(0);
        unsigned nloc = b.st[0], nx = b.st[1];
        if (nloc == 0u) { xcd_barrier_complete(bar, b.x, nloc, nx); b.st[0] = nloc; b.st[1] = nx; }
        const unsigned old = xb_add(&bar[XB_XSUB(b.x)], 1u);
        const unsigned gen = old / nloc;
        if (old + 1u == (gen + 1u) * nloc) {
            __builtin_amdgcn_fence(__ATOMIC_RELEASE, "agent");
            asm volatile("s_waitcnt vmcnt(0)" ::: "memory");
            const unsigned og = xb_add(&bar[XB_TOP], 1u);
            const unsigned tg = og / nx;
            if (og + 1u == (tg + 1u) * nx) xb_add(&bar[XB_TOPGEN], 1u);
            else XB_SPIN(xb_ld(&bar[XB_TOPGEN]) == tg, bar);
            __builtin_amdgcn_fence(__ATOMIC_ACQUIRE, "agent");
            xb_add(&bar[XB_XGEN(b.x)], 1u);
            asm volatile("s_waitcnt vmcnt(0)" ::: "memory");
        } else {
            XB_SPIN(xb_ld(&bar[XB_XGEN(b.x)]) == gen, bar);
            __builtin_amdgcn_fence(__ATOMIC_ACQUIRE, "agent");
            asm volatile("s_waitcnt vmcnt(0)" ::: "memory");
        }
    }
    __syncthreads();
}
constexpr int MISC_OFF = 131072 + 320;
constexpr int CW_BAR = 4096;

#ifndef PROBE_DUP
#define PROBE_DUP 0
#endif
#if ONE_LAUNCH
template <int PH> __device__ __forceinline__ void phase_body(Ctx& C) {
    constexpr int i = (PH - 2) / 7, sub = (PH - 2) % 7, j = i >> 1; constexpr bool conv = (i & 1) == 0;
    if (PH == 0) phase_p0(C);
    else if (PH == 1) phase_p1(C);
    else if (PH == 30) phase_final(C);
    else if (sub == 0) prep_layer(C, i);
    else if (sub == 2) { if (conv) dwconv_phase(C, j); else scan_phase(C, j); }
    else if (sub == 3) readout_phase(C, j, i == DEPTH - 1);
    else run_phase(C, PH);
}
template <int PH> __device__ __forceinline__ void one_phase(Ctx& C, const Args& args, const XcdBarrier& bar) {
    if (PH < args.ph_lo || PH >= args.ph_hi) return;
    constexpr int i = (PH - 2) / 7, sub = (PH - 2) % 7; constexpr bool conv = (i & 1) == 0;
    if (PH >= 2 && PH < 30) { if (sub == 0 && i == 0) return; if (sub == 3 && conv) return; }
    if (PH > args.ph_lo) xcd_barrier(bar);
    phase_body<PH>(C);
    constexpr bool dup = ((PH >= 2 && PH < 30) && (((PROBE_DUP & 1) && (sub == 1 || sub == 5)) || ((PROBE_DUP & 2) && sub == 2 && !conv) || ((PROBE_DUP & 4) && sub == 2 && conv) || ((PROBE_DUP & 8) && sub == 0))) || ((PROBE_DUP & 16) && PH < 2);
    if constexpr (dup) { xcd_barrier(bar); phase_body<PH>(C); }
}
template <int... PHS> __device__ __forceinline__ void all_phases(Ctx& C, const Args& args, const XcdBarrier& bar, std::integer_sequence<int, PHS...>) { (one_phase<PHS>(C, args, bar), ...); }
__global__ void __launch_bounds__(512, 2) mega_kernel(Args args) {
    extern __shared__ __attribute__((aligned(16))) unsigned char lds_raw[];
    Ctx C;
    C.lds = (LAS unsigned char*)lds_raw; C.tid = threadIdx.x; C.lane = C.tid & 63; C.wave = __builtin_amdgcn_readfirstlane(C.tid >> 6); C.G = gridDim.x; C.bid = blockIdx.x;
    C.in = args.in; C.out = args.out; C.ws = args.ws;
    volatile LAS unsigned* MISC = (volatile LAS unsigned*)(C.lds + MISC_OFF);
    if (C.tid < 32) MISC[C.tid] = 0u;
    __syncthreads();
    XcdBarrier bar = xcd_barrier_post((unsigned*)(C.ws + WS_CTL) + CW_BAR, MISC + 8);
    all_phases(C, args, bar, std::make_integer_sequence<int, NPHASE>{});
}

#endif
template <int KIND>
__global__ void __launch_bounds__(512, 2) phase_kernel(Args args) {
    extern __shared__ __attribute__((aligned(16))) unsigned char lds_raw[];
    Ctx C;
    C.lds = (LAS unsigned char*)lds_raw; C.tid = threadIdx.x; C.lane = C.tid & 63; C.wave = __builtin_amdgcn_readfirstlane(C.tid >> 6); C.G = gridDim.x; C.bid = blockIdx.x;
    C.in = args.in; C.out = args.out; C.ws = args.ws;
    const int ph = args.ph_lo;
    if (KIND == 0) phase_p0(C);
    else if (KIND == 1) phase_p1(C);
    else if (KIND == 30) phase_final(C);
    else {
        const int i = (ph - 2) / 7, j = i >> 1; const bool conv = (i & 1) == 0;
        if (KIND == 2) prep_layer(C, i);
        else if (KIND == 4) { if (conv) dwconv_phase(C, j); else scan_phase(C, j); }
        else if (KIND == 5) readout_phase(C, j, i == DEPTH - 1);
        else run_phase(C, ph);
    }
}

extern "C" void kernel_launch(void* const* d_in, const int* in_sizes, int n_in, void* d_out, int out_size, void* d_ws, size_t ws_size, hipStream_t stream) {
    static int grid = 0;
    if (grid == 0) {
        if (n_in != 22 || out_size != T * D || ws_size < WS_END) { fprintf(stderr, "kernel_launch: unexpected problem (n_in %d out %d ws %zu, need %zu)\n", n_in, out_size, ws_size, (size_t)WS_END); grid = -1; return; }
        int dev = 0, cus = 0;
        if (hipGetDevice(&dev) != hipSuccess || hipDeviceGetAttribute(&cus, hipDeviceAttributeMultiprocessorCount, dev) != hipSuccess) { grid = -1; return; }
        bool ok = true;
        ok &= hipFuncSetAttribute((const void*)phase_kernel<0>, hipFuncAttributeMaxDynamicSharedMemorySize, LDS_BYTES) == hipSuccess;
        ok &= hipFuncSetAttribute((const void*)phase_kernel<1>, hipFuncAttributeMaxDynamicSharedMemorySize, LDS_BYTES) == hipSuccess;
        ok &= hipFuncSetAttribute((const void*)phase_kernel<2>, hipFuncAttributeMaxDynamicSharedMemorySize, LDS_BYTES) == hipSuccess;
        ok &= hipFuncSetAttribute((const void*)phase_kernel<3>, hipFuncAttributeMaxDynamicSharedMemorySize, LDS_BYTES) == hipSuccess;
        ok &= hipFuncSetAttribute((const void*)phase_kernel<4>, hipFuncAttributeMaxDynamicSharedMemorySize, LDS_BYTES) == hipSuccess;
        ok &= hipFuncSetAttribute((const void*)phase_kernel<5>, hipFuncAttributeMaxDynamicSharedMemorySize, LDS_BYTES) == hipSuccess;
        ok &= hipFuncSetAttribute((const void*)phase_kernel<30>, hipFuncAttributeMaxDynamicSharedMemorySize, LDS_BYTES) == hipSuccess;
#if ONE_LAUNCH
        ok &= hipFuncSetAttribute((const void*)mega_kernel, hipFuncAttributeMaxDynamicSharedMemorySize, LDS_BYTES) == hipSuccess;
#endif
        if (!ok) { fprintf(stderr, "kernel_launch: hipFuncSetAttribute failed\n"); grid = -1; return; }
        grid = cus > 0 ? cus : 256;
    }
    if (grid < 0) return;
    Args a{};
    for (int i = 0; i < 22; ++i) a.in[i] = (const float*)d_in[i];
    a.out = (float*)d_out; a.ws = (unsigned char*)d_ws;
#if ONE_LAUNCH
    if (hipMemsetAsync((char*)d_ws + WS_CTL, 0, 65536, stream) != hipSuccess) { fprintf(stderr, "kernel_launch: memset failed\n"); return; }
    a.ph_lo = 0; a.ph_hi = NPHASE;
    hipLaunchKernelGGL(mega_kernel, dim3(grid), dim3(512), LDS_BYTES, stream, a);
    return;
#endif
    for (int ph = 0; ph < NPHASE; ++ph) {
        const int i = (ph - 2) / 7, sub = (ph - 2) % 7;
        if (ph >= 2 && ph < 30) { if (sub == 0 && i == 0) continue; if (sub == 3 && (i & 1) == 0) continue; }
        a.ph_lo = ph; a.ph_hi = ph + 1;
        const dim3 g(grid), b(512);
        if (ph == 0) hipLaunchKernelGGL(phase_kernel<0>, g, b, LDS_BYTES, stream, a);
        else if (ph == 1) hipLaunchKernelGGL(phase_kernel<1>, g, b, LDS_BYTES, stream, a);
        else if (ph == 30) hipLaunchKernelGGL(phase_kernel<30>, g, b, LDS_BYTES, stream, a);
        else if (sub == 0) hipLaunchKernelGGL(phase_kernel<2>, g, b, LDS_BYTES, stream, a);
        else if (sub == 2) hipLaunchKernelGGL(phase_kernel<4>, g, b, LDS_BYTES, stream, a);
        else if (sub == 3) hipLaunchKernelGGL(phase_kernel<5>, g, b, LDS_BYTES, stream, a);
        else hipLaunchKernelGGL(phase_kernel<3>, g, b, LDS_BYTES, stream, a);
        {   const bool conv = (i & 1) == 0;
            const bool dup = ((ph >= 2 && ph < 30) && (((PROBE_DUP & 1) && (sub == 1 || sub == 5)) || ((PROBE_DUP & 2) && sub == 2 && !conv) || ((PROBE_DUP & 4) && sub == 2 && conv) || ((PROBE_DUP & 8) && sub == 0))) || ((PROBE_DUP & 16) && ph < 2);
            if (dup) {
                if (ph == 0) hipLaunchKernelGGL(phase_kernel<0>, g, b, LDS_BYTES, stream, a);
                else if (ph == 1) hipLaunchKernelGGL(phase_kernel<1>, g, b, LDS_BYTES, stream, a);
                else if (sub == 0) hipLaunchKernelGGL(phase_kernel<2>, g, b, LDS_BYTES, stream, a);
                else if (sub == 2) hipLaunchKernelGGL(phase_kernel<4>, g, b, LDS_BYTES, stream, a);
                else hipLaunchKernelGGL(phase_kernel<3>, g, b, LDS_BYTES, stream, a);
            } }
    }
}
```

```cpp
#include <hip/hip_runtime.h>
#include <cstdio>
#include <cstdint>
#include <utility>

#ifndef ONE_LAUNCH
#define ONE_LAUNCH 1
#endif

typedef unsigned short bf16_t;
typedef short bf16x8 __attribute__((ext_vector_type(8)));
typedef float f32x4 __attribute__((ext_vector_type(4)));
typedef float f32x2 __attribute__((ext_vector_type(2)));
typedef unsigned u32x2 __attribute__((ext_vector_type(2)));
typedef unsigned u32x4 __attribute__((ext_vector_type(4)));
typedef __bf16 bf16x2_t __attribute__((ext_vector_type(2)));
typedef short s16x4 __attribute__((ext_vector_type(4)));
#define LAS __attribute__((address_space(3)))

constexpr int D = 1024, T = 16384, TC = 256, R = T + TC, NH = 4, DK = 256, DV = 512, QKW = 1024, VW = 2048, INW = 8192, DFF = 2816, FF2 = 5632, CK = 31, DEPTH = 4;
constexpr int NSLOT = 33;
constexpr float NORM_EPS = 1e-6f, LN_EPS = 1e-5f;

constexpr size_t MiB = 1u << 20, KiB = 1u << 10;
constexpr size_t WS_CTL = 0, CTL_ZERO_BYTES = 1 * MiB;
constexpr size_t WS_MODV = 1 * MiB;
constexpr size_t WS_S1 = 1 * MiB + 256 * KiB;
constexpr size_t WS_S2 = 1 * MiB + 320 * KiB;
constexpr size_t WS_CVA = 1 * MiB + 384 * KiB;
constexpr size_t WS_CVF = 1 * MiB + 640 * KiB;
constexpr size_t WS_TABC = 1 * MiB + 832 * KiB;
constexpr size_t WS_TABS = 1 * MiB + 912 * KiB;
constexpr size_t WS_STATS = 2 * MiB;
constexpr size_t WS_XCTX = 4 * MiB;
constexpr size_t WS_WA = 8 * MiB;
constexpr size_t WS_WA2 = 24 * MiB;
constexpr size_t WS_WF1 = 28 * MiB;
constexpr size_t WS_WF2 = 40 * MiB;
constexpr size_t WS_XS = 48 * MiB;
constexpr size_t WS_SCP = 48 * MiB;
constexpr size_t WS_BIG = 114 * MiB;
constexpr size_t WS_Q = WS_BIG, WS_K = WS_BIG + 33 * MiB, WS_VT = WS_BIG + 66 * MiB, WS_GF = WS_BIG + 131 * MiB, WS_GB = WS_BIG + 196 * MiB;
constexpr size_t WS_U = WS_BIG, WS_A2 = WS_BIG + 33 * MiB, WS_H = WS_BIG;
constexpr size_t WS_END = WS_BIG + 261 * MiB;
static_assert((size_t)R * 1024 * 2 <= 33 * MiB && (size_t)R * 2048 * 2 <= 65 * MiB && (size_t)R * DFF * 2 <= 131 * MiB, "map");
static_assert((size_t)NSLOT * 8 * 512 * 256 * 2 <= 66 * MiB, "scp");

constexpr int LDS_BYTES = 147456;

__device__ __forceinline__ unsigned pk2(float lo, float hi) { f32x2 v = {lo, hi}; bf16x2_t b = __builtin_convertvector(v, bf16x2_t); return __builtin_bit_cast(unsigned, b); }
__device__ __forceinline__ float bflo(unsigned u) { return __uint_as_float(u << 16); }
__device__ __forceinline__ float bfhi(unsigned u) { return __uint_as_float(u & 0xffff0000u); }
__device__ __forceinline__ float siluf(float x) { return x / (1.f + __expf(-x)); }
__device__ __forceinline__ float sigmf(float x) { return 1.f / (1.f + __expf(-x)); }
__device__ __forceinline__ float wave_sum63(float v) {
    v += __builtin_bit_cast(float, __builtin_amdgcn_update_dpp(0, __builtin_bit_cast(int, v), 0xB1, 0xF, 0xF, false));
    v += __builtin_bit_cast(float, __builtin_amdgcn_update_dpp(0, __builtin_bit_cast(int, v), 0x4E, 0xF, 0xF, false));
    v += __builtin_bit_cast(float, __builtin_amdgcn_update_dpp(0, __builtin_bit_cast(int, v), 0x141, 0xF, 0xF, false));
    v += __builtin_bit_cast(float, __builtin_amdgcn_update_dpp(0, __builtin_bit_cast(int, v), 0x140, 0xF, 0xF, false));
    v += __builtin_bit_cast(float, __builtin_amdgcn_update_dpp(0, __builtin_bit_cast(int, v), 0x142, 0xA, 0xF, false));
    v += __builtin_bit_cast(float, __builtin_amdgcn_update_dpp(0, __builtin_bit_cast(int, v), 0x143, 0xC, 0xF, false));
    return v;
}
__device__ __forceinline__ int perm_glu(int n, int H) { if (n < H) return 32 * (n >> 4) + (n & 15); const int n2 = n - H; return 32 * (n2 >> 4) + 16 + (n2 & 15); }
__device__ __forceinline__ int perm_win(int n) {
    if (n >= 2 * QKW) return n;
    const int part = n >> 10, hn = n & 1023, h = hn >> 8, d = hn & 255, quarter = d >> 6, idx = d & 63;
    const int Gp = (quarter >> 1) * 4 + (idx >> 4), i = (quarter & 1) * 16 + (idx & 15);
    return part * 1024 + h * 256 + 32 * Gp + i;
}
__device__ __forceinline__ int perm_any(int mode, int n, int H) { return mode == 0 ? n : (mode == 1 ? perm_glu(n, H) : perm_win(n)); }

struct Args { const float* in[22]; float* out; unsigned char* ws; int ph_lo, ph_hi; };

struct Ctx {
    LAS unsigned char* lds;
    int tid, lane, wave, G, bid;
    const float* const* in; float* out; unsigned char* ws;
};

template <int VSILU>
__device__ __forceinline__ void gemv2_unit(Ctx& C, const float* W, int N, int n0, const float* v0, const float* v1, const float* bias, float* o0, float* o1, int pmode, int H) {
    LAS float* red = (LAS float*)C.lds;
    const int c4 = C.tid & 15, ks = C.tid >> 4;
    f32x4 a0 = {0.f, 0.f, 0.f, 0.f}, a1 = {0.f, 0.f, 0.f, 0.f};
#pragma unroll 8
    for (int i = 0; i < 32; ++i) {
        const int k = ks * 32 + i;
        const f32x4 w = *(const f32x4*)(W + (size_t)k * N + n0 + 4 * c4);
        float x0 = v0[k], x1 = v1[k];
        if (VSILU) { x0 = siluf(x0); x1 = siluf(x1); }
        a0 += w * x0; a1 += w * x1;
    }
#pragma unroll
    for (int e = 0; e < 4; ++e) { red[(ks * 2 + 0) * 64 + 4 * c4 + e] = a0[e]; red[(ks * 2 + 1) * 64 + 4 * c4 + e] = a1[e]; }
    __syncthreads();
    if (C.tid < 128) {
        const int s = C.tid >> 6, col = C.tid & 63; float sum = 0.f;
#pragma unroll 8
        for (int k2 = 0; k2 < 32; ++k2) sum += red[(k2 * 2 + s) * 64 + col];
        const int n = n0 + col; if (bias) sum += bias[n];
        (s ? o1 : o0)[perm_any(pmode, n, H)] = sum;
    }
    __syncthreads();
}

__device__ __forceinline__ void transpose_item(const float* W, int K, int N, bf16_t* WT, int pmode, int H, LAS float* scr, int item, int lane) {
    const int nblk = N / 32, kb = item / nblk, nb = item % nblk, k0 = 64 * kb, n0 = 32 * nb;
#pragma unroll 8
    for (int i = 0; i < 32; ++i) { const int kk = 2 * i + (lane >> 5); scr[kk * 33 + (lane & 31)] = W[(size_t)(k0 + kk) * N + n0 + (lane & 31)]; }
    asm volatile("s_waitcnt lgkmcnt(0)" ::: "memory");
    const int c = lane & 7;
#pragma unroll
    for (int j = 0; j < 4; ++j) { const int n = (lane >> 3) + 8 * j; const LAS float* s = scr + (8 * c) * 33 + n;
        u32x4 o; o.x = pk2(s[0 * 33], s[1 * 33]); o.y = pk2(s[2 * 33], s[3 * 33]); o.z = pk2(s[4 * 33], s[5 * 33]); o.w = pk2(s[6 * 33], s[7 * 33]);
        *(u32x4*)(WT + (size_t)perm_any(pmode, n0 + n, H) * K + k0 + 8 * c) = o; }
    asm volatile("s_waitcnt lgkmcnt(0)" ::: "memory");
}
__device__ __forceinline__ void prep_layer(Ctx& C, int i) {
    LAS float* scr = (LAS float*)(C.lds + C.wave * 16384);
    const int gw = C.bid * 8 + C.wave, NGW = C.G * 8, j = i >> 1;
    bf16_t* WA = (bf16_t*)(C.ws + WS_WA); bf16_t* WA2 = (bf16_t*)(C.ws + WS_WA2); bf16_t* WF1 = (bf16_t*)(C.ws + WS_WF1); bf16_t* WF2 = (bf16_t*)(C.ws + WS_WF2);
    const bool conv = (i & 1) == 0;
    const int I_A = conv ? 16 * 64 : 16 * 256, I_A2 = conv ? 16 * 32 : 32 * 32, I_F1 = 16 * 176, I_F2 = 44 * 32;
    const int NIT = I_A + I_A2 + I_F1 + I_F2;
    for (int it = gw; it < NIT; it += NGW) {
        int r = it;
        if (r < I_A) { if (conv) transpose_item(C.in[8] + (size_t)j * 1024 * 2048, 1024, 2048, WA, 1, 1024, scr, r, C.lane);
                       else transpose_item(C.in[16] + (size_t)j * 1024 * 8192, 1024, 8192, WA, 2, 0, scr, r, C.lane); continue; } r -= I_A;
        if (r < I_A2) { if (conv) transpose_item(C.in[14] + (size_t)j * 1024 * 1024, 1024, 1024, WA2, 0, 0, scr, r, C.lane);
                        else transpose_item(C.in[18] + (size_t)j * 2048 * 1024, 2048, 1024, WA2, 0, 0, scr, r, C.lane); continue; } r -= I_A2;
        if (r < I_F1) { transpose_item(C.in[19] + (size_t)i * 1024 * FF2, 1024, FF2, WF1, 1, DFF, scr, r, C.lane); continue; } r -= I_F1;
        transpose_item(C.in[20] + (size_t)i * DFF * 1024, DFF, 1024, WF2, 0, 0, scr, r, C.lane);
    }
}

__device__ __forceinline__ float row_rs(const float* stats, int row, int fq) {
    const f32x4 p = *(const f32x4*)(stats + (size_t)row * 16 + 4 * fq);
    float s = (p[0] + p[1]) + (p[2] + p[3]);
    s += __shfl_xor(s, 16); s += __shfl_xor(s, 32);
    return 1.0f / sqrtf(s * (1.0f / 1024.0f) + NORM_EPS);
}
struct EpiGLU {
    static constexpr bool STATS = false, NEEDRS = true;
    unsigned char* ws; int cvoff  , cvstride  , outoff  , ldo, act;
    float* stats;
    __device__ __forceinline__ float row_begin(int row, int fq) const { return row_rs((const float*)(ws + WS_STATS), row, fq); }
    __device__ __forceinline__ float item(int row, int colp, f32x4 v0, f32x4 v1, float rs) const {
        const float* cv = (const float*)ws + cvoff + (row < T ? 0 : cvstride);
        const f32x4 ca = *(const f32x4*)(cv + colp), cg = *(const f32x4*)(cv + colp + 16);
        float o[4];
#pragma unroll
        for (int e = 0; e < 4; ++e) { const float a = rs * v0[e] + ca[e], g = rs * v1[e] + cg[e]; o[e] = act == 0 ? a * sigmf(g) : siluf(a) * g; }
        const int oc = (colp >> 5) * 16 + (colp & 15);
        u32x2 w; w.x = pk2(o[0], o[1]); w.y = pk2(o[2], o[3]);
        *(u32x2*)((bf16_t*)(ws + outoff) + (size_t)row * ldo + oc) = w;
        return 0.f;
    }
};
struct EpiRes {
    static constexpr bool STATS = true, NEEDRS = false;
    unsigned char* ws; float* xl; const float* bias; int mgoff  , snoff  ;
    float* stats;
    __device__ __forceinline__ float row_begin(int, int) const { return 1.f; }
    __device__ __forceinline__ float item(int row, int colp, f32x4 v0, f32x4 v1, float) const {
        const bool lat = row < T;
        float* xr = lat ? xl + (size_t)row * 1024 : (float*)(ws + WS_XCTX) + (size_t)(row - T) * 1024;
        const float* mg = (const float*)ws + mgoff + (lat ? 0 : 6144); const float* sn = (const float*)ws + snoff + (lat ? 0 : 1024);
        bf16_t* xs = (bf16_t*)(ws + WS_XS);
        float ss = 0.f;
#pragma unroll
        for (int hlf = 0; hlf < 2; ++hlf) {
            const int c = colp + 16 * hlf; const f32x4 v = hlf ? v1 : v0;
            const f32x4 xo = *(const f32x4*)(xr + c), m4 = *(const f32x4*)(mg + c);
            f32x4 b4 = {0.f, 0.f, 0.f, 0.f}; if (bias) b4 = *(const f32x4*)(bias + c);
            const f32x4 xn = xo + m4 * (v + b4);
            *(f32x4*)(xr + c) = xn;
            ss += (xn[0] * xn[0] + xn[1] * xn[1]) + (xn[2] * xn[2] + xn[3] * xn[3]);
            if (snoff >= 0) { const f32x4 s4 = *(const f32x4*)(sn + c); u32x2 w; w.x = pk2(xn[0] * s4[0], xn[1] * s4[1]); w.y = pk2(xn[2] * s4[2], xn[3] * s4[3]);
                *(u32x2*)(xs + (size_t)row * 1024 + c) = w; }
        }
        return ss;
    }
};
struct EpiWin {
    static constexpr bool STATS = false, NEEDRS = true;
    unsigned char* ws; int cvoff;
    float* stats;
    __device__ __forceinline__ float row_begin(int row, int fq) const { return row_rs((const float*)(ws + WS_STATS), row, fq); }
    __device__ __forceinline__ float item(int row, int colp, f32x4 v0, f32x4 v1, float rs) const {
        const float* cv = (const float*)ws + cvoff + (row < T ? 0 : 8192);
        const f32x4 c0 = *(const f32x4*)(cv + colp), c1 = *(const f32x4*)(cv + colp + 16);
        f32x4 a = v0 * rs + c0, b = v1 * rs + c1;
        if (colp < 2048) {
            if (row < T) {
                const int Gp = (colp >> 5) & 7, idx0 = 16 * (Gp & 3) + (colp & 15);
                const int ti = (Gp >> 2) ? 256 + (row & 63) : (row >> 6);
                const f32x4 cs = *(const f32x4*)((const float*)(ws + WS_TABC) + ti * 64 + idx0), sn = *(const f32x4*)((const float*)(ws + WS_TABS) + ti * 64 + idx0);
                const f32x4 o1 = a * cs - b * sn, o2 = b * cs + a * sn; a = o1; b = o2;
            }
            bf16_t* dst = (bf16_t*)(ws + WS_Q);
            if (colp >= 1024) { dst = (bf16_t*)(ws + WS_K); a = a * 0.0625f; b = b * 0.0625f; }
            const int c = colp & 1023;
            u32x2 w; w.x = pk2(a[0], a[1]); w.y = pk2(a[2], a[3]); *(u32x2*)(dst + (size_t)row * 1024 + c) = w;
            w.x = pk2(b[0], b[1]); w.y = pk2(b[2], b[3]); *(u32x2*)(dst + (size_t)row * 1024 + c + 16) = w;
        } else if (colp < 4096) {
            const int c = colp - 2048;
            bf16_t* vt = (bf16_t*)(ws + WS_VT);
#pragma unroll
            for (int e = 0; e < 4; ++e) { vt[(size_t)(c + e) * R + row] = (bf16_t)(pk2(a[e], 0.f) & 0xffffu); vt[(size_t)(c + 16 + e) * R + row] = (bf16_t)(pk2(b[e], 0.f) & 0xffffu); }
        } else {
            bf16_t* dst = (bf16_t*)(ws + (colp < 6144 ? WS_GF : WS_GB)); const int c = (colp - 4096) & 2047;
            u32x2 w; w.x = pk2(a[0], a[1]); w.y = pk2(a[2], a[3]); *(u32x2*)(dst + (size_t)row * 2048 + c) = w;
            w.x = pk2(b[0], b[1]); w.y = pk2(b[2], b[3]); *(u32x2*)(dst + (size_t)row * 2048 + c + 16) = w;
        }
        return 0.f;
    }
};

template <class Epi>
__device__ __forceinline__ void sgemm_small(Ctx& C, const bf16_t* A, const bf16_t* Bt, int row_lo, int Mrows, int N, int K, const Epi& E, int n_lo, int n_hi) {
    const int wr = C.wave >> 2, wc = C.wave & 3, fr = C.lane & 15, fq = C.lane >> 4;
    const int nM = Mrows / 32, nN = n_hi - n_lo, nU = nM * nN;
    for (int u = (C.G - 1 - C.bid); u < nU; u += C.G) {
        const int un = n_lo + u / nM, um = u % nM;
        const int row0 = row_lo + 32 * um + 16 * wr, col0 = 256 * un;
        f32x4 acc[2][2];
#pragma unroll
        for (int b = 0; b < 2; ++b)
#pragma unroll
            for (int n = 0; n < 2; ++n) acc[b][n] = (f32x4){0.f, 0.f, 0.f, 0.f};
        const bf16_t* ap = A + (size_t)(row0 + fr) * K + 8 * fq;
        const bf16_t* bp = Bt + (size_t)(col0 + 32 * wc + fr) * K + 8 * fq;
#pragma unroll 4
        for (int k0 = 0; k0 < K; k0 += 32) {
            bf16x8 bf[2][2];
            const bf16x8 af = *(const bf16x8*)(ap + k0);
#pragma unroll
            for (int bj = 0; bj < 2; ++bj)
#pragma unroll
                for (int n = 0; n < 2; ++n) bf[bj][n] = *(const bf16x8*)(bp + (size_t)(128 * bj + 16 * n) * K + k0);
#pragma unroll
            for (int bj = 0; bj < 2; ++bj)
#pragma unroll
                for (int n = 0; n < 2; ++n) acc[bj][n] = __builtin_amdgcn_mfma_f32_16x16x32_bf16(bf[bj][n], af, acc[bj][n], 0, 0, 0);
        }
        const int row = row0 + fr;
        const float rs = E.row_begin(row, fq);
        float ss = 0.f;
#pragma unroll
        for (int bj = 0; bj < 2; ++bj) ss += E.item(row, col0 + 128 * bj + 32 * wc + 4 * fq, acc[bj][0], acc[bj][1], rs);
        if constexpr (Epi::STATS) { ss += __shfl_xor(ss, 16); ss += __shfl_xor(ss, 32); if (fq == 0) E.stats[(size_t)row * 16 + un * 4 + wc] = ss; }
    }
}

namespace pg8 {
#define PG8_LAS __attribute__((address_space(3)))
typedef unsigned short bf16_t;
typedef short bf16x8 __attribute__((ext_vector_type(8)));
typedef float f32x4 __attribute__((ext_vector_type(4)));
typedef unsigned u32x4 __attribute__((ext_vector_type(4)));
constexpr int BM = 256, BK = 64, HALF = 128, HTB = HALF * BK * 2  , STAGE_BYTES = 8 * HTB, NXCD = 8, WGM = 8;

__host__ __device__ __forceinline__ int lds_byte(int r, int c) { const int st = (r >> 4) * 2 + (c >> 5), rr = r & 15, cc = c & 31, ob = rr * 64 + cc * 2; return st * 1024 + (ob ^ (((ob >> 9) & 1) << 5)); }
__host__ __device__ __forceinline__ void stage_rc(int b, int& R, int& C) { const int st = b / 1024, sb = b % 1024, swz = sb ^ (((sb >> 9) & 1) << 5); R = (st >> 1) * 16 + swz / 64; C = (st & 1) * 32 + (swz % 64) / 2; }
__host__ __device__ __forceinline__ int perm32(int rho) { const int n = rho >> 4, i = rho & 15; return 8 * (i >> 2) + 4 * n + (i & 3); }

struct Unit { int pm, pn; };
struct Gemm { const bf16_t* A; const bf16_t* Bt; int M, N, K; };

struct StaticOrder {
    int nM, nN, nwg, G, c;
    __host__ __device__ void init(int M, int N, int G_, int c_) { nM = M / BM; nN = N / BM; nwg = nM * nN; G = G_; c = c_; }
    __host__ __device__ bool next(int i, Unit& u) const {
        const long L = (long)i * G + c; if (L >= nwg) return false;
        int wgid = (int)L; { const int q = nwg / NXCD, r = nwg % NXCD, xcd = wgid % NXCD, off = wgid / NXCD; wgid = (xcd < r ? xcd * (q + 1) : r * (q + 1) + (xcd - r) * q) + off; }
        const int nig = WGM * nN, gid = wgid / nig, fm = gid * WGM, gsz = (nM - fm) < WGM ? (nM - fm) : WGM;
        u.pm = fm + ((wgid % nig) % gsz); u.pn = (wgid % nig) / gsz; return true;
    }
    __device__ __forceinline__ void a_ready(const Unit&) const {}
    __device__ __forceinline__ void done(const Unit&) const {}
};

template <class Epi, class Sched, bool ALIGN_EPI = false, bool SP2 = false>
__device__ __forceinline__ void gemm_phase(PG8_LAS unsigned char* lds, const Gemm g, const Sched& S, const Epi& E) {
    const int tid = threadIdx.x, wid = __builtin_amdgcn_readfirstlane(tid >> 6), lane = tid & 63, wr = wid >> 2, wc = wid & 3, fr = lane & 15, fq = lane >> 4;
    const int K = g.K, nt = K / BK;
    unsigned voffA[2], voffB[2];
#pragma unroll
    for (int i = 0; i < 2; ++i) { int R, C; stage_rc(tid * 16 + i * 8192, R, C); const int Rb = Epi::PERM ? ((R & ~31) + perm32(R & 31)) : R;
        voffA[i] = (unsigned)(R * K + C) * 2u; voffB[i] = (unsigned)(Rb * K + C) * 2u; }
    const size_t kstep = (size_t)(BK * 2);
    const size_t hstep = (size_t)HALF * K * 2;
    const size_t tstep = 2 * hstep;
    const unsigned ldsw = (unsigned)wid * 1024u;
    const int aoff = lds_byte(wr * 64 + fr, fq * 8), boff = lds_byte(wc * 32 + fr, fq * 8);
#define PG8_SA(b, h) (((b) * 2 + (h)) * HTB)
#define PG8_SB(b, h) ((4 + (b) * 2 + (h)) * HTB)
#define PG8_STAGE(bufoff, gbase, voff) do { _Pragma("unroll") for (int _i = 0; _i < 2; ++_i) \
        __builtin_amdgcn_global_load_lds((const unsigned*)((const char*)(gbase) + (voff)[_i]), (PG8_LAS unsigned*)(lds + (bufoff) + ldsw + _i * 8192), 16, 0, 0); } while (0)
#define PG8_LDA(dst, b, h) do { _Pragma("unroll") for (int m = 0; m < 4; ++m) _Pragma("unroll") for (int k = 0; k < 2; ++k) dst[m][k] = *(const PG8_LAS bf16x8*)(lds + PG8_SA(b, h) + aoff + m * 2048 + k * 1024); } while (0)
#define PG8_LDB(dst, b, h) do { _Pragma("unroll") for (int n = 0; n < 2; ++n) _Pragma("unroll") for (int k = 0; k < 2; ++k) dst[n][k] = *(const PG8_LAS bf16x8*)(lds + PG8_SB(b, h) + boff + n * 2048 + k * 1024); } while (0)
#define PG8_MMA(ai, bj, At, Bt) do { __builtin_amdgcn_s_setprio(1); _Pragma("unroll") for (int m = 0; m < 4; ++m) _Pragma("unroll") for (int n = 0; n < 2; ++n) _Pragma("unroll") for (int k = 0; k < 2; ++k) \
        acc[ai][bj][m][n] = __builtin_amdgcn_mfma_f32_16x16x32_bf16(Bt[n][k], At[m][k], acc[ai][bj][m][n], 0, 0, 0); __builtin_amdgcn_s_setprio(0); } while (0)
#define PG8_WAIT_V(n) asm volatile("s_waitcnt vmcnt(" #n ")" ::: "memory")
#define PG8_WAIT_L(n) asm volatile("s_waitcnt lgkmcnt(" #n ")" ::: "memory")
#define PG8_BAR __builtin_amdgcn_s_barrier()
#define PG8_SCHED __builtin_amdgcn_sched_barrier(0)
    Unit cur, nxt; int ui = 0;
    if (!S.next(0, cur)) return;
    f32x4 acc[2][2][4][2];
#pragma unroll
    for (int a = 0; a < 2; ++a)
#pragma unroll
        for (int b = 0; b < 2; ++b)
#pragma unroll
            for (int m = 0; m < 4; ++m)
#pragma unroll
                for (int n = 0; n < 2; ++n) acc[a][b][m][n] = (f32x4){0.f, 0.f, 0.f, 0.f};
    bf16x8 At[4][2], B0[2][2], B1[2][2];
    const char* cA = (const char*)g.A + (size_t)cur.pm * tstep; const char* cB = (const char*)g.Bt + (size_t)cur.pn * tstep;
    S.a_ready(cur);
    if constexpr (SP2) {
        PG8_STAGE(PG8_SB(0, 0), cB, voffB); PG8_STAGE(PG8_SB(0, 1), cB + hstep, voffB); PG8_STAGE(PG8_SA(0, 0), cA, voffA); PG8_STAGE(PG8_SA(0, 1), cA + hstep, voffA);
        if (wr == 1) PG8_BAR;
        PG8_WAIT_V(2); PG8_BAR;
        PG8_STAGE(PG8_SB(1, 0), cB + kstep, voffB); PG8_STAGE(PG8_SA(1, 0), cA + kstep, voffA); PG8_STAGE(PG8_SB(1, 1), cB + hstep + kstep, voffB);
        PG8_WAIT_V(6); PG8_BAR;
    } else {
        PG8_STAGE(PG8_SB(0, 0), cB, voffB); PG8_STAGE(PG8_SA(0, 0), cA, voffA); PG8_STAGE(PG8_SB(0, 1), cB + hstep, voffB); PG8_STAGE(PG8_SA(0, 1), cA + hstep, voffA);
        if (wr == 1) PG8_BAR;
        PG8_WAIT_V(4); PG8_BAR;
        PG8_STAGE(PG8_SB(1, 0), cB + kstep, voffB); PG8_STAGE(PG8_SA(1, 0), cA + kstep, voffA); PG8_STAGE(PG8_SB(1, 1), cB + hstep + kstep, voffB);
        PG8_WAIT_V(6); PG8_BAR;
    }
    for (;;) {
        const bool has_next = S.next(ui + 1, nxt);
        const char* nA = has_next ? (const char*)g.A + (size_t)nxt.pm * tstep : cA; const char* nB = has_next ? (const char*)g.Bt + (size_t)nxt.pn * tstep : cB;
        for (int t = 0; t < nt; t += 2) {
            const bool last = (t == nt - 2);
            const char* a1 = cA + (size_t)(t + 1) * kstep;
            const char* a2 = last ? nA : cA + (size_t)(t + 2) * kstep; const char* b2 = last ? nB : cB + (size_t)(t + 2) * kstep;
            const char* a3 = a2 + kstep; const char* b3 = b2 + kstep;
            if (last && has_next) S.a_ready(nxt);
            if constexpr (SP2) {
            PG8_LDB(B0, 0, 0); PG8_LDB(B1, 0, 1); PG8_SCHED; PG8_LDA(At, 0, 0); PG8_STAGE(PG8_SA(1, 1), a1 + hstep, voffA);
            PG8_WAIT_V(8); PG8_WAIT_L(0); PG8_BAR; PG8_MMA(0, 0, At, B0); PG8_MMA(0, 1, At, B1); PG8_BAR; PG8_SCHED;
            PG8_LDA(At, 0, 1); PG8_STAGE(PG8_SB(0, 0), b2, voffB); PG8_STAGE(PG8_SB(0, 1), b2 + hstep, voffB); PG8_STAGE(PG8_SA(0, 0), a2, voffA);
            PG8_WAIT_V(8); PG8_WAIT_L(0); PG8_BAR; PG8_MMA(1, 0, At, B0); PG8_MMA(1, 1, At, B1); PG8_BAR; PG8_SCHED;
            PG8_LDB(B0, 1, 0); PG8_LDB(B1, 1, 1); PG8_SCHED; PG8_LDA(At, 1, 0); PG8_STAGE(PG8_SA(0, 1), a2 + hstep, voffA);
            PG8_WAIT_V(8); PG8_WAIT_L(0); PG8_BAR; PG8_MMA(0, 0, At, B0); PG8_MMA(0, 1, At, B1); PG8_BAR; PG8_SCHED;
            PG8_LDA(At, 1, 1); PG8_STAGE(PG8_SB(1, 0), b3, voffB); PG8_STAGE(PG8_SB(1, 1), b3 + hstep, voffB); PG8_STAGE(PG8_SA(1, 0), a3, voffA);
            PG8_WAIT_V(8); PG8_WAIT_L(0); PG8_BAR; PG8_MMA(1, 0, At, B0); PG8_MMA(1, 1, At, B1); PG8_BAR; PG8_SCHED;
            } else {
            PG8_LDB(B0, 0, 0); PG8_SCHED; PG8_LDA(At, 0, 0); PG8_STAGE(PG8_SA(1, 1), a1 + hstep, voffA);
            PG8_WAIT_L(8); PG8_BAR; PG8_WAIT_L(0); PG8_MMA(0, 0, At, B0); PG8_BAR; PG8_SCHED;
            PG8_LDB(B1, 0, 1); PG8_STAGE(PG8_SB(0, 0), b2, voffB);
            PG8_BAR; PG8_WAIT_L(0); PG8_MMA(0, 1, At, B1); PG8_BAR;
            PG8_LDA(At, 0, 1); PG8_STAGE(PG8_SA(0, 0), a2, voffA);
            PG8_BAR; PG8_WAIT_L(0); PG8_MMA(1, 0, At, B0); PG8_BAR; PG8_SCHED;
            PG8_STAGE(PG8_SB(0, 1), b2 + hstep, voffB);
            PG8_WAIT_V(6); PG8_BAR; PG8_MMA(1, 1, At, B1); PG8_BAR;
            PG8_LDB(B0, 1, 0); PG8_SCHED; PG8_LDA(At, 1, 0); PG8_STAGE(PG8_SA(0, 1), a2 + hstep, voffA);
            PG8_WAIT_L(8); PG8_BAR; PG8_WAIT_L(0); PG8_MMA(0, 0, At, B0); PG8_BAR; PG8_SCHED;
            PG8_LDB(B1, 1, 1); PG8_STAGE(PG8_SB(1, 0), b3, voffB);
            PG8_BAR; PG8_WAIT_L(0); PG8_MMA(0, 1, At, B1); PG8_BAR;
            PG8_LDA(At, 1, 1); PG8_STAGE(PG8_SA(1, 0), a3, voffA);
            PG8_BAR; PG8_WAIT_L(0); PG8_MMA(1, 0, At, B0); PG8_BAR; PG8_SCHED;
            PG8_STAGE(PG8_SB(1, 1), b3 + hstep, voffB);
            PG8_WAIT_V(6); PG8_BAR; PG8_MMA(1, 1, At, B1); PG8_BAR;
            }
        }
        if constexpr (ALIGN_EPI) { if (wr == 0) PG8_BAR; }
        if constexpr (!Epi::AFTER_DRAIN) { E(acc, cur, wr, wc, fr, fq); S.done(cur); }
        if (!has_next) break;
#pragma unroll
        for (int a = 0; a < 2; ++a)
#pragma unroll
            for (int b = 0; b < 2; ++b)
#pragma unroll
                for (int m = 0; m < 4; ++m)
#pragma unroll
                    for (int n = 0; n < 2; ++n) acc[a][b][m][n] = (f32x4){0.f, 0.f, 0.f, 0.f};
        cur = nxt; cA = nA; cB = nB; ++ui;
        if constexpr (ALIGN_EPI) { if (wr == 1) PG8_BAR; }
    }
    PG8_WAIT_V(0);
    if constexpr (!ALIGN_EPI) { if (wr == 0) PG8_BAR; }
    PG8_BAR;
    if constexpr (Epi::AFTER_DRAIN) { E.fused(acc, cur, wr, wc, fr, fq, lds, wid, lane); S.done(cur); }
#undef PG8_SA
#undef PG8_SB
#undef PG8_STAGE
#undef PG8_LDA
#undef PG8_LDB
#undef PG8_MMA
#undef PG8_WAIT_V
#undef PG8_WAIT_L
#undef PG8_BAR
#undef PG8_SCHED
}
}

template <class E0> struct EpiAdapt {
    static constexpr bool PERM = false, AFTER_DRAIN = false;
    E0 e;
    __device__ __forceinline__ void operator()(const pg8::f32x4 (&acc)[2][2][4][2], const pg8::Unit& u, int wr, int wc, int fr, int fq) const {
#pragma unroll
        for (int ai = 0; ai < 2; ++ai)
#pragma unroll
            for (int m = 0; m < 4; ++m) {
                const int row = u.pm * 256 + ai * 128 + wr * 64 + m * 16 + fr;
                const float rs = e.row_begin(row, fq);
                float ss = 0.f;
#pragma unroll
                for (int bj = 0; bj < 2; ++bj) ss += e.item(row, u.pn * 256 + bj * 128 + wc * 32 + 4 * fq, acc[ai][bj][m][0], acc[ai][bj][m][1], rs);
                if constexpr (E0::STATS) { ss += __shfl_xor(ss, 16); ss += __shfl_xor(ss, 32); if (fq == 0) e.stats[(size_t)row * 16 + u.pn * 4 + wc] = ss; }
            }
    }
};
template <class E0>
__device__ __forceinline__ void gemm_both(Ctx& C, const bf16_t* A, const bf16_t* Bt, int Mbig, int N, int K, const E0& E, int ctx_n_lo, int ctx_n_hi) {
    { pg8::Gemm g{A, Bt, Mbig, N, K}; pg8::StaticOrder S; S.init(Mbig, N, C.G, C.bid); EpiAdapt<E0> EA{E};
      pg8::gemm_phase<EpiAdapt<E0>, pg8::StaticOrder, true, true>(C.lds, g, S, EA); }
    if (Mbig < R && ctx_n_hi > ctx_n_lo) sgemm_small(C, A, Bt, Mbig, R - Mbig, N, K, E, ctx_n_lo, ctx_n_hi);
}
__device__ __forceinline__ void dwconv_phase(Ctx& C, int j) {
    const bf16_t* U = (const bf16_t*)(C.ws + WS_U); bf16_t* A2 = (bf16_t*)(C.ws + WS_A2);
    const float* dww = C.in[10] + (size_t)j * CK * 1024; const float* dwb = C.in[11] + j * 1024; const float* lng = C.in[12] + j * 1024; const float* lnb = C.in[13] + j * 1024;
    LAS unsigned char* tile = C.lds; LAS float* part = (LAS float*)(C.lds + 62 * 2048);
    const int tid = C.tid;
    for (int u = C.bid; u < 520; u += C.G) {
        const int base = u < 512 ? 0 : T, n = u < 512 ? T : TC, t0 = 32 * (u < 512 ? u : u - 512);
        for (int idx = tid; idx < 62 * 128; idx += 512) {
            const int rr = idx >> 7, ch = idx & 127, tt = t0 - 15 + rr;
            u32x4 v = {0u, 0u, 0u, 0u};
            if (tt >= 0 && tt < n) v = *(const u32x4*)(U + (size_t)(base + tt) * 1024 + ch * 8);
            *(LAS u32x4*)(tile + rr * 2048 + ch * 16) = v;
        }
        __syncthreads();
        float o0[32], o1[32];
        { const f32x2 b2 = *(const f32x2*)(dwb + 2 * tid);
#pragma unroll
          for (int t = 0; t < 32; ++t) { o0[t] = b2.x; o1[t] = b2.y; } }
        for (int jt = 0; jt < CK; ++jt) {
            const f32x2 w = *(const f32x2*)(dww + jt * 1024 + 2 * tid);
            const LAS unsigned char* p = tile + jt * 2048 + tid * 4;
#pragma unroll
            for (int t = 0; t < 32; ++t) { const unsigned uu = *(const LAS unsigned*)(p + t * 2048); o0[t] += w.x * bflo(uu); o1[t] += w.y * bfhi(uu); }
        }
#pragma unroll
        for (int t = 0; t < 32; ++t) {
            const float s = wave_sum63(o0[t] + o1[t]), q = wave_sum63(o0[t] * o0[t] + o1[t] * o1[t]);
            if (C.lane == 63) { part[(t * 8 + C.wave) * 2] = s; part[(t * 8 + C.wave) * 2 + 1] = q; }
        }
        __syncthreads();
        const f32x2 g2 = *(const f32x2*)(lng + 2 * tid), bb2 = *(const f32x2*)(lnb + 2 * tid);
#pragma unroll
        for (int t = 0; t < 32; ++t) {
            float s = 0.f, q = 0.f;
#pragma unroll
            for (int w = 0; w < 8; ++w) { s += part[(t * 8 + w) * 2]; q += part[(t * 8 + w) * 2 + 1]; }
            const float mean = s * (1.f / 1024.f), var = q * (1.f / 1024.f) - mean * mean, rstd = 1.0f / sqrtf(var + LN_EPS);
            const float y0 = (o0[t] - mean) * rstd * g2.x + bb2.x, y1 = (o1[t] - mean) * rstd * g2.y + bb2.y;
            *(unsigned*)(A2 + (size_t)(base + t0 + t) * 1024 + 2 * tid) = pk2(siluf(y0), siluf(y1));
        }
        __syncthreads();
    }
}

__device__ __forceinline__ void scan_phase(Ctx& C, int j) {
    const bf16_t* Kb = (const bf16_t*)(C.ws + WS_K); const bf16_t* Vt = (const bf16_t*)(C.ws + WS_VT); bf16_t* Scp = (bf16_t*)(C.ws + WS_SCP);
    constexpr int KP = 64, VP = 136;
    constexpr int KBYTES = 128 * KP * 2, VBYTES = 64 * VP * 2;
    LAS bf16_t* kbuf = (LAS bf16_t*)C.lds;
    LAS bf16_t* vbuf = (LAS bf16_t*)(C.lds + 2 * KBYTES);
    const int fr = C.lane & 15, fq = C.lane >> 4, w = C.wave, tid = C.tid;
    for (int cu = C.bid; cu < 256; cu += C.G) {
        const int hd = cu & 7, sidx = cu >> 3, h = hd >> 1, dir = hd & 1, dk_s = 64 * ((sidx >> 3) & 3), dv_s = 64 * (sidx & 7);
        const int mt = w >> 1, nh = w & 1, dkl = 16 * mt, dvl = 32 * nh;
        const float gam = 1.0f - exp2f(C.in[17][(j * 2 + dir) * 4 + h]); const float L = log2f(gam);
        const float cdec = exp2f(L * 128.f);
        const int krow = tid >> 3, kch = tid & 7, vrow = tid >> 4, vch = tid & 15;
        const int kchs = kch ^ (((krow >> 3) & 1) << 1) ^ (((krow >> 1) & 1) << 2);
        const int trq = (fr >> 2), trp = fr & 3;
        const int trrow0 = 8 * fq + trq;
        const int trcol0 = (((2 * mt + (trp >> 1)) ^ ((fq & 1) << 1) ^ (((trq >> 1) & 1) << 2)) << 3) + 4 * (trp & 1);
        const float kd0 = exp2f(L * (float)(dir == 0 ? 127 - krow : krow)), kd1 = exp2f(L * (float)(dir == 0 ? 63 - krow : krow + 64));
        const bf16_t* kg = Kb + (size_t)krow * 1024 + h * 256 + dk_s + 8 * kch;
        const bf16_t* vg = Vt + (size_t)(h * 512 + dv_s + vrow) * R + 8 * vch;
        auto tok_of = [&](int st) { const int bl = st < 2 ? (dir == 0 ? st : 1 - st) : (dir == 0 ? st - 2 : 129 - st); return (st < 2 ? T : 0) + 128 * bl; };
        f32x4 acc[2]; acc[0] = (f32x4){0.f, 0.f, 0.f, 0.f}; acc[1] = acc[0];
        u32x4 ra[4], rb[4];
#define SCAN_LOAD(dst, tok) do { dst[0] = *(const u32x4*)(kg + (size_t)(tok) * 1024); dst[1] = *(const u32x4*)(kg + (size_t)((tok) + 64) * 1024); \
        dst[2] = *(const u32x4*)(vg + (tok)); dst[3] = *(const u32x4*)(vg + (size_t)32 * R + (tok)); } while (0)
#define SCAN_STORE(src, buf) do { LAS bf16_t* kb_ = kbuf + (buf) * 128 * KP; LAS bf16_t* vb_ = vbuf + (buf) * 64 * VP; u32x4 o_; \
        o_.x = pk2(bflo(src[0].x) * kd0, bfhi(src[0].x) * kd0); o_.y = pk2(bflo(src[0].y) * kd0, bfhi(src[0].y) * kd0); o_.z = pk2(bflo(src[0].z) * kd0, bfhi(src[0].z) * kd0); o_.w = pk2(bflo(src[0].w) * kd0, bfhi(src[0].w) * kd0); \
        *(LAS u32x4*)(kb_ + krow * KP + 8 * kchs) = o_; \
        o_.x = pk2(bflo(src[1].x) * kd1, bfhi(src[1].x) * kd1); o_.y = pk2(bflo(src[1].y) * kd1, bfhi(src[1].y) * kd1); o_.z = pk2(bflo(src[1].z) * kd1, bfhi(src[1].z) * kd1); o_.w = pk2(bflo(src[1].w) * kd1, bfhi(src[1].w) * kd1); \
        *(LAS u32x4*)(kb_ + (krow + 64) * KP + 8 * kchs) = o_; \
        *(LAS u32x4*)(vb_ + vrow * VP + 8 * vch) = src[2]; *(LAS u32x4*)(vb_ + (vrow + 32) * VP + 8 * vch) = src[3]; } while (0)
        __syncthreads();
        SCAN_LOAD(ra, tok_of(0));
        SCAN_STORE(ra, 0);
        SCAN_LOAD(ra, tok_of(1));
        __syncthreads();
#define SCAN_STEP(st, RA, RB) do { \
            const int cur = (st) & 1; \
            if ((st) + 2 < 130) SCAN_LOAD(RB, tok_of((st) + 2)); \
            {   const bool isctx = (st) < 2; const int bl = isctx ? (dir == 0 ? (st) : 1 - (st)) : (dir == 0 ? (st) - 2 : 129 - (st)); \
                const bool cp = dir == 0 ? ((bl & 3) == 0) : (isctx ? bl == 1 : (bl & 3) == 3); \
                if (cp) { \
                    const int slot = isctx ? 32 : (bl >> 2); \
                    bf16_t* sp = Scp + ((size_t)((slot * 4 + h) * 2 + dir) * 512) * 256; \
                    _Pragma("unroll") for (int nt = 0; nt < 2; ++nt) { u32x2 wv; wv.x = pk2(acc[nt][0], acc[nt][1]); wv.y = pk2(acc[nt][2], acc[nt][3]); \
                        *(u32x2*)(sp + (size_t)(dv_s + dvl + 16 * nt + fr) * 256 + dk_s + dkl + 4 * fq) = wv; } \
                } } \
            acc[0] = acc[0] * cdec; acc[1] = acc[1] * cdec; \
            const LAS bf16_t* kb = kbuf + cur * 128 * KP; const LAS bf16_t* vb = vbuf + cur * 64 * VP; \
            _Pragma("unroll") for (int ks = 0; ks < 4; ++ks) { \
                const LAS bf16_t* kp = kb + (32 * ks + trrow0) * KP + trcol0; \
                const s16x4 lo4 = __builtin_amdgcn_ds_read_tr16_b64_v4i16((LAS s16x4*)kp); \
                const s16x4 hi4 = __builtin_amdgcn_ds_read_tr16_b64_v4i16((LAS s16x4*)(kp + 4 * KP)); \
                const bf16x8 af = (bf16x8){lo4[0], lo4[1], lo4[2], lo4[3], hi4[0], hi4[1], hi4[2], hi4[3]}; \
                _Pragma("unroll") for (int nt = 0; nt < 2; ++nt) { const bf16x8 vf = *(const LAS bf16x8*)(vb + (dvl + 16 * nt + fr) * VP + 32 * ks + 8 * fq); \
                    acc[nt] = __builtin_amdgcn_mfma_f32_16x16x32_bf16(af, vf, acc[nt], 0, 0, 0); } \
            } \
            if ((st) + 1 < 130) SCAN_STORE(RA, cur ^ 1); \
            __syncthreads(); \
        } while (0)
#pragma unroll 1
        for (int st2 = 0; st2 < 130; st2 += 2) { SCAN_STEP(st2, ra, rb); SCAN_STEP(st2 + 1, rb, ra); }
#undef SCAN_STEP
#undef SCAN_LOAD
#undef SCAN_STORE
    }
}

__device__ __forceinline__ void readout_phase(Ctx& C, int j, bool skip_ctx) {
    const bf16_t* Q = (const bf16_t*)(C.ws + WS_Q); const bf16_t* Kb = (const bf16_t*)(C.ws + WS_K); const bf16_t* Vt = (const bf16_t*)(C.ws + WS_VT);
    const bf16_t* Scp = (const bf16_t*)(C.ws + WS_SCP); bf16_t* GF = (bf16_t*)(C.ws + WS_GF); const bf16_t* GB = (const bf16_t*)(C.ws + WS_GB);
    constexpr int QP = 264, PP = 136;
    LAS bf16_t* Qs = (LAS bf16_t*)C.lds;
    LAS bf16_t* Pb = (LAS bf16_t*)(C.lds + 64 * QP * 2);
    LAS float* red = (LAS float*)(C.lds + 64 * QP * 2 + 2 * 64 * PP * 2);
    const int w = C.wave, tid = C.tid;
    const int nunits = skip_ctx ? 1024 : 1040;
    for (int u0 = C.bid; u0 < nunits; u0 += C.G) {
        int h, b, rh;
        if (C.G == 256 && u0 < 1024) { const int r = u0 >> 8, x = u0 & 7, idx = (u0 & 255) >> 3, grp = r * 32 + x * 4 + (idx >> 3); h = grp & 3; b = (grp >> 2) * 4 + ((idx >> 1) & 3); rh = idx & 1; }
        else { rh = u0 & 1; h = (u0 >> 1) & 3; b = u0 >> 3; }
        const bool lat = b < 128; const int base = lat ? 0 : T, nb = lat ? 128 : 2, bl = lat ? b : b - 128;
        const int g = bl >> 2, slot = lat ? g : 32;
        const int gend = (4 * (g + 1) < nb ? 4 * (g + 1) : nb);
        {
            const int i0 = base + 128 * bl + 64 * rh, il0 = 128 * bl + 64 * rh;
#pragma unroll
            for (int i = 0; i < 4; ++i) { const int c = tid + 512 * i, row = c >> 5, ch = c & 31;
                *(LAS u32x4*)(Qs + row * QP + 8 * ch) = *(const u32x4*)(Q + (size_t)(i0 + row) * 1024 + h * 256 + 8 * ch); }
            __syncthreads();
#pragma unroll 1
            for (int dir = 0; dir < 2; ++dir) {
                int lane_o = C.lane; asm volatile("" : "+v"(lane_o));
                const int fr = lane_o & 15, fq = lane_o >> 4;
                const float gam = 1.0f - exp2f(C.in[17][(j * 2 + dir) * 4 + h]); const float L = log2f(gam);
                f32x4 acc[4][4];
#pragma unroll
                for (int mt = 0; mt < 4; ++mt)
#pragma unroll
                    for (int nt = 0; nt < 4; ++nt) acc[mt][nt] = (f32x4){0.f, 0.f, 0.f, 0.f};
                const int kb_lo = dir == 0 ? 4 * g : bl, kb_hi = dir == 0 ? bl : gend - 1;
                bf16x8 kf[8];
                { const bf16_t* k1 = Kb + (size_t)(base + 128 * kb_lo + 16 * w + fr) * 1024 + h * 256 + 8 * fq;
#pragma unroll
                  for (int ks = 0; ks < 8; ++ks) kf[ks] = *(const bf16x8*)(k1 + 32 * ks); }
                const bf16_t* sb = Scp + ((size_t)((slot * 4 + h) * 2 + dir) * 512) * 256 + (size_t)(64 * w + fr) * 256 + 8 * fq;
#pragma unroll
                for (int half = 0; half < 4; ++half) {
                    bf16x8 sf[2][4];
#pragma unroll
                    for (int k4 = 0; k4 < 2; ++k4)
#pragma unroll
                        for (int nt = 0; nt < 4; ++nt) sf[k4][nt] = *(const bf16x8*)(sb + (size_t)(16 * nt) * 256 + 32 * (2 * half + k4));
#pragma unroll
                    for (int k4 = 0; k4 < 2; ++k4)
#pragma unroll
                        for (int mt = 0; mt < 4; ++mt) { const bf16x8 qf = *(const LAS bf16x8*)(Qs + (16 * mt + fr) * QP + 32 * (2 * half + k4) + 8 * fq);
#pragma unroll
                            for (int nt = 0; nt < 4; ++nt) acc[mt][nt] = __builtin_amdgcn_mfma_f32_16x16x32_bf16(sf[k4][nt], qf, acc[mt][nt], 0, 0, 0); }
                }
#pragma unroll
                for (int mt = 0; mt < 4; ++mt) {
                    const int il = il0 + 16 * mt + fr;
                    const int ex = dir == 0 ? il - 512 * g + 1 : gend * 128 - il;
                    const float qd = __builtin_amdgcn_exp2f(L * (float)ex);
#pragma unroll
                    for (int nt = 0; nt < 4; ++nt) acc[mt][nt] = acc[mt][nt] * qd;
                }
                int pbuf = 0;
                __builtin_amdgcn_sched_barrier(0);
#pragma unroll 1
                for (int kb = kb_lo; kb <= kb_hi; ++kb) {
                    const int j0 = base + 128 * kb;
                    bf16x8 vf[4][4];
                    const bf16_t* vb = Vt + (size_t)(h * 512 + 64 * w + fr) * R + j0 + 8 * fq;
#pragma unroll
                    for (int ks = 0; ks < 2; ++ks)
#pragma unroll
                        for (int nt = 0; nt < 4; ++nt) vf[ks][nt] = *(const bf16x8*)(vb + (size_t)(16 * nt) * R + 32 * ks);
                    f32x4 sc[4];
#pragma unroll
                    for (int mt = 0; mt < 4; ++mt) sc[mt] = (f32x4){0.f, 0.f, 0.f, 0.f};
#pragma unroll
                    for (int ks = 0; ks < 8; ++ks) {
#pragma unroll
                        for (int mt = 0; mt < 4; ++mt) { const bf16x8 qf = *(const LAS bf16x8*)(Qs + (16 * mt + fr) * QP + 32 * ks + 8 * fq);
                            sc[mt] = __builtin_amdgcn_mfma_f32_16x16x32_bf16(kf[ks], qf, sc[mt], 0, 0, 0); }
                        if (ks & 1) __builtin_amdgcn_sched_barrier(0);
                    }
                    if (kb < kb_hi) { const bf16_t* k1 = Kb + (size_t)(j0 + 128 + 16 * w + fr) * 1024 + h * 256 + 8 * fq;
#pragma unroll
                        for (int ks = 0; ks < 8; ++ks) kf[ks] = *(const bf16x8*)(k1 + 32 * ks); }
#pragma unroll
                    for (int ks = 2; ks < 4; ++ks)
#pragma unroll
                        for (int nt = 0; nt < 4; ++nt) vf[ks][nt] = *(const bf16x8*)(vb + (size_t)(16 * nt) * R + 32 * ks);
                    LAS bf16_t* P = Pb + pbuf * 64 * PP;
#pragma unroll
                    for (int mt = 0; mt < 4; ++mt) {
                        const int il = il0 + 16 * mt + fr;
                        float p[4];
#pragma unroll
                        for (int e = 0; e < 4; ++e) { const int jl = 128 * kb + 16 * w + 4 * fq + e; const int rel = dir == 0 ? il - jl : jl - il;
                            p[e] = rel >= 0 ? sc[mt][e] * __builtin_amdgcn_exp2f(L * (float)rel) : 0.f; }
                        u32x2 wv; wv.x = pk2(p[0], p[1]); wv.y = pk2(p[2], p[3]);
                        *(LAS u32x2*)(P + (16 * mt + fr) * PP + 16 * w + 4 * fq) = wv;
                    }
                    __syncthreads();
#pragma unroll
                    for (int ks = 0; ks < 4; ++ks)
#pragma unroll
                        for (int mt = 0; mt < 4; ++mt) { const bf16x8 pf = *(const LAS bf16x8*)(P + (16 * mt + fr) * PP + 32 * ks + 8 * fq);
#pragma unroll
                            for (int nt = 0; nt < 4; ++nt) acc[mt][nt] = __builtin_amdgcn_mfma_f32_16x16x32_bf16(vf[ks][nt], pf, acc[mt][nt], 0, 0, 0); }
                    pbuf ^= 1;
                    __builtin_amdgcn_sched_barrier(0);
                }
                __builtin_amdgcn_sched_barrier(0);
#pragma unroll
                for (int mt = 0; mt < 4; ++mt) {
                    float ss = 0.f;
#pragma unroll
                    for (int nt = 0; nt < 4; ++nt) ss += (acc[mt][nt][0] * acc[mt][nt][0] + acc[mt][nt][1] * acc[mt][nt][1]) + (acc[mt][nt][2] * acc[mt][nt][2] + acc[mt][nt][3] * acc[mt][nt][3]);
                    ss += __shfl_xor(ss, 16); ss += __shfl_xor(ss, 32);
                    if (fq == 0) red[(16 * mt + fr) * 8 + w] = ss;
                }
                __syncthreads();
#pragma unroll
                for (int mt = 0; mt < 4; ++mt) {
                    float tot = 0.f;
#pragma unroll
                    for (int w2 = 0; w2 < 8; ++w2) tot += red[(16 * mt + fr) * 8 + w2];
                    const float rn = 1.0f / sqrtf(tot * (1.f / 512.f) + NORM_EPS);
                    const size_t off = (size_t)(i0 + 16 * mt + fr) * 2048 + h * 512 + 64 * w + 4 * fq;
#pragma unroll
                    for (int nt = 0; nt < 4; ++nt) {
                        const u32x2 g1 = *(const u32x2*)((dir == 0 ? (const bf16_t*)GF : GB) + off + 16 * nt);
                        float y0 = siluf(bflo(g1.x)) * acc[mt][nt][0] * rn, y1 = siluf(bfhi(g1.x)) * acc[mt][nt][1] * rn;
                        float y2 = siluf(bflo(g1.y)) * acc[mt][nt][2] * rn, y3 = siluf(bfhi(g1.y)) * acc[mt][nt][3] * rn;
                        if (dir == 1) { const u32x2 yp = *(const u32x2*)(GF + off + 16 * nt); y0 += bflo(yp.x); y1 += bfhi(yp.x); y2 += bflo(yp.y); y3 += bfhi(yp.y); }
                        u32x2 wv; wv.x = pk2(y0, y1); wv.y = pk2(y2, y3);
                        *(u32x2*)(GF + off + 16 * nt) = wv;
                    }
                }
            }
        }
    }
}

__device__ __forceinline__ void phase_p0(Ctx& C) {
    float* modv = (float*)(C.ws + WS_MODV);
    for (int u = C.bid; u < 384; u += C.G) {
        const int i = u / 96, nbk = u % 96;
        gemv2_unit<1>(C, C.in[4] + (size_t)i * 1024 * 6144, 6144, 64 * nbk, C.in[1], C.in[3], C.in[5] + i * 6144, modv + (i * 2 + 0) * 6144, modv + (i * 2 + 1) * 6144, 0, 0);
    }
    float* tabc = (float*)(C.ws + WS_TABC); float* tabs = (float*)(C.ws + WS_TABS);
    for (int idx = C.bid * 512 + C.tid; idx < 320 * 64; idx += C.G * 512) {
        const int ti = idx >> 6, i = idx & 63; const float pos = (float)(ti < 256 ? ti : ti - 256);
        const float inv = exp2f(-(float)i * (13.287712379549449f / 64.0f)); const float ang = pos * inv;
        tabc[idx] = __cosf(ang); tabs[idx] = __sinf(ang);
    }
}
__device__ __forceinline__ void phase_p1(Ctx& C) {
    const float* modv = (const float*)(C.ws + WS_MODV);
    float* s1 = (float*)(C.ws + WS_S1); float* s2 = (float*)(C.ws + WS_S2);
    for (int idx = C.bid * 512 + C.tid; idx < 8192; idx += C.G * 512) {
        const int i = idx >> 11, s = (idx >> 10) & 1, k = idx & 1023;
        s1[idx] = C.in[6][i * 1024 + k] * (1.f + modv[(i * 2 + s) * 6144 + 1024 + k]);
        s2[idx] = C.in[7][i * 1024 + k] * (1.f + modv[(i * 2 + s) * 6144 + 4096 + k]);
    }
    float* cvA = (float*)(C.ws + WS_CVA); float* cvF = (float*)(C.ws + WS_CVF);
    for (int u = C.bid; u < 672; u += C.G) {
        if (u < 320) {
            int i, nbk; if (u < 32) { i = 0; nbk = u; } else if (u < 160) { i = 1; nbk = u - 32; } else if (u < 192) { i = 2; nbk = u - 160; } else { i = 3; nbk = u - 192; }
            const int j = i >> 1; const float* v0 = modv + (i * 2 + 0) * 6144; const float* v1 = modv + (i * 2 + 1) * 6144;
            if ((i & 1) == 0) gemv2_unit<0>(C, C.in[8] + (size_t)j * 1024 * 2048, 2048, 64 * nbk, v0, v1, C.in[9] + j * 2048, cvA + (i * 2) * 8192, cvA + (i * 2 + 1) * 8192, 1, 1024);
            else gemv2_unit<0>(C, C.in[16] + (size_t)j * 1024 * 8192, 8192, 64 * nbk, v0, v1, nullptr, cvA + (i * 2) * 8192, cvA + (i * 2 + 1) * 8192, 2, 0);
        } else {
            const int i = (u - 320) / 88, nbk = (u - 320) % 88;
            const float* v0 = modv + (i * 2 + 0) * 6144 + 3072; const float* v1 = modv + (i * 2 + 1) * 6144 + 3072;
            gemv2_unit<0>(C, C.in[19] + (size_t)i * 1024 * FF2, FF2, 64 * nbk, v0, v1, nullptr, cvF + (i * 2) * FF2, cvF + (i * 2 + 1) * FF2, 1, DFF);
        }
    }
    bf16_t* xs = (bf16_t*)(C.ws + WS_XS); float* stats = (float*)(C.ws + WS_STATS); float* xctx = (float*)(C.ws + WS_XCTX);
    for (int row = C.bid * 8 + C.wave; row < R; row += C.G * 8) {
        const bool lat = row < T; const int s = lat ? 0 : 1;
        const float* src = lat ? C.in[0] + (size_t)row * 1024 : C.in[2] + (size_t)(row - T) * 1024;
        float* dst = lat ? C.out + (size_t)row * 1024 : xctx + (size_t)(row - T) * 1024;
        float ss = 0.f;
#pragma unroll
        for (int jj = 0; jj < 4; ++jj) {
            const int k = 4 * C.lane + 256 * jj;
            const f32x4 v = *(const f32x4*)(src + k); *(f32x4*)(dst + k) = v;
            ss += (v[0] * v[0] + v[1] * v[1]) + (v[2] * v[2] + v[3] * v[3]);
            const f32x4 g = *(const f32x4*)(C.in[6] + k), m = *(const f32x4*)(modv + s * 6144 + 1024 + k);
            u32x2 w; w.x = pk2(v[0] * g[0] * (1.f + m[0]), v[1] * g[1] * (1.f + m[1])); w.y = pk2(v[2] * g[2] * (1.f + m[2]), v[3] * g[3] * (1.f + m[3]));
            *(u32x2*)(xs + (size_t)row * 1024 + k) = w;
        }
#pragma unroll
        for (int off = 1; off < 64; off <<= 1) ss += __shfl_xor(ss, off);
        if (C.lane < 16) stats[(size_t)row * 16 + C.lane] = C.lane == 0 ? ss : 0.f;
    }
    prep_layer(C, 0);
}
__device__ __forceinline__ void phase_final(Ctx& C) {
    const float* stats = (const float*)(C.ws + WS_STATS);
    for (int row = C.bid * 8 + C.wave; row < T; row += C.G * 8) {
        float s = C.lane < 16 ? stats[(size_t)row * 16 + C.lane] : 0.f;
#pragma unroll
        for (int off = 1; off < 64; off <<= 1) s += __shfl_xor(s, off);
        const float r = 1.0f / sqrtf(s * (1.f / 1024.f) + NORM_EPS);
        float* xr = C.out + (size_t)row * 1024;
#pragma unroll
        for (int jj = 0; jj < 4; ++jj) { const int k = 4 * C.lane + 256 * jj; const f32x4 v = *(const f32x4*)(xr + k), g = *(const f32x4*)(C.in[21] + k); *(f32x4*)(xr + k) = v * r * g; }
    }
}

constexpr int NPHASE = 31;
__device__ __forceinline__ void run_phase(Ctx& C, int ph) {
    const int i = (ph - 2) / 7, sub = (ph - 2) % 7, j = i >> 1; const bool conv = (i & 1) == 0;
    const bool last = i == DEPTH - 1;
    float* stats = (float*)(C.ws + WS_STATS);
    const bf16_t* xs = (const bf16_t*)(C.ws + WS_XS);
    constexpr int F_MODV = (int)(WS_MODV / 4), F_S1 = (int)(WS_S1 / 4), F_S2 = (int)(WS_S2 / 4), F_CVA = (int)(WS_CVA / 4), F_CVF = (int)(WS_CVF / 4);
    if (sub == 1) {
        if (conv) { EpiGLU E{C.ws, F_CVA + (i * 2) * 8192, 8192, (int)WS_U, 1024, 0, stats}; gemm_both(C, xs, (const bf16_t*)(C.ws + WS_WA), T, 2048, 1024, E, 0, 8); }
        else { EpiWin E{C.ws, F_CVA + (i * 2) * 8192, stats}; gemm_both(C, xs, (const bf16_t*)(C.ws + WS_WA), T, 8192, 1024, E, last ? 4 : 0, last ? 16 : 32); }
    } else if (sub == 5) {
        EpiGLU E{C.ws, F_CVF + (i * 2) * FF2, FF2, (int)WS_H, DFF, 1, stats}; gemm_both(C, xs, (const bf16_t*)(C.ws + WS_WF1), last ? T : R, FF2, 1024, E, 0, 0);
    } else {
        const bool f2 = sub == 6;
        const int mgoff = F_MODV + (i * 2) * 6144 + (f2 ? 5120 : 2048);
        const int snoff = f2 ? (last ? -1 : F_S1 + ((i + 1) * 2) * 1024) : F_S2 + (i * 2) * 1024;
        const float* bias = (!f2 && conv) ? C.in[15] + j * 1024 : nullptr;
        const bf16_t* A = (const bf16_t*)(C.ws + (f2 ? WS_H : (conv ? WS_A2 : WS_GF)));
        const bf16_t* Bt = (const bf16_t*)(C.ws + (f2 ? WS_WF2 : WS_WA2));
        const int K = f2 ? DFF : (conv ? 1024 : 2048);
        EpiRes E{C.ws, C.out, bias, mgoff, snoff, stats};
        gemm_both(C, A, Bt, T, 1024, K, E, 0, last ? 0 : 4);
    }
}

#define XB_TMO      128
#define XB_XCNT(j)  (256  + 64 * (j))
#define XB_XSUB(j)  (1280 + 64 * (j))
#define XB_XGEN(j)  (2304 + 64 * (j))
#define XB_TOP      3328
#define XB_TOPGEN   3392
#define XCD_BAR_WORDS 3456
#define XB_SPIN_CAP (1u << 20)
__device__ __forceinline__ unsigned xb_ld(unsigned* p)              { return __hip_atomic_load(p, __ATOMIC_RELAXED, __HIP_MEMORY_SCOPE_AGENT); }
__device__ __forceinline__ unsigned xb_add(unsigned* p, unsigned v) { return __hip_atomic_fetch_add(p, v, __ATOMIC_RELAXED, __HIP_MEMORY_SCOPE_AGENT); }
__device__ __forceinline__ unsigned xb_xcc_id() { return (unsigned)__builtin_amdgcn_s_getreg((3 << 11) | 20) & 0xFu; }
#define XB_SPIN(cond, bar) do { unsigned _sp = 0; while (cond) { __builtin_amdgcn_s_sleep(1); \
    if ((++_sp & 255u) == 0u) { if (xb_ld(&(bar)[XB_TMO])) break; if (_sp > XB_SPIN_CAP) { atomicAdd(&(bar)[XB_TMO], 1u); break; } } } } while (0)
struct XcdBarrier { unsigned* bar; unsigned x; volatile LAS unsigned* st; };
__device__ __forceinline__ XcdBarrier xcd_barrier_post(unsigned* bar, volatile LAS unsigned* st) {
    XcdBarrier b; b.bar = bar; b.x = xb_xcc_id(); b.st = st;
    if (threadIdx.x == 0) (void)xb_add(&bar[XB_XCNT(b.x)], 1u);
    return b;
}
__device__ __forceinline__ void xcd_barrier_complete(unsigned* bar, unsigned x, unsigned& nloc, unsigned& nx) {
    const unsigned G = gridDim.x * gridDim.y * gridDim.z;
    unsigned sum, cnt, mine, sp = 0u;
    for (;;) {
        sum = 0u; cnt = 0u; mine = 0u;
#pragma unroll
        for (unsigned j = 0; j < 16; ++j) { const unsigned c = xb_ld(&bar[XB_XCNT(j)]); sum += c; cnt += (c > 0u) ? 1u : 0u; mine = (j == x) ? c : mine; }
        if (sum == G) break;
        __builtin_amdgcn_s_sleep(1);
        if ((++sp & 255u) == 0u) { if (xb_ld(&bar[XB_TMO])) break; if (sp > XB_SPIN_CAP) { atomicAdd(&bar[XB_TMO], 1u); break; } }
    }
    nloc = mine > 0u ? mine : 1u; nx = cnt > 0u ? cnt : 1u;
}
__device__ __forceinline__ void xcd_barrier(const XcdBarrier& b) {
    asm volatile("s_waitcnt vmcnt(0)" ::: "memory");
    __syncthreads();
    if (threadIdx.x == 0) {
        unsigned* bar = b.bar;
        __builtin_amdgcn_s_waitcnt(0);
        unsigned nloc = b.st[0], nx = b.st[1];
        if (nloc == 0u) { xcd_barrier_complete(bar, b.x, nloc, nx); b.st[0] = nloc; b.st[1] = nx; }
        const unsigned old = xb_add(&bar[XB_XSUB(b.x)], 1u);
        const unsigned gen = old / nloc;
        if (old + 1u == (gen + 1u) * nloc) {
            __builtin_amdgcn_fence(__ATOMIC_RELEASE, "agent");
            asm volatile("s_waitcnt vmcnt(0)" ::: "memory");
            const unsigned og = xb_add(&bar[XB_TOP], 1u);
            const unsigned tg = og / nx;
            if (og + 1u == (tg + 1u) * nx) xb_add(&bar[XB_TOPGEN], 1u);
            else XB_SPIN(xb_ld(&bar[XB_TOPGEN]) == tg, bar);
            __builtin_amdgcn_fence(__ATOMIC_ACQUIRE, "agent");
            xb_add(&bar[XB_XGEN(b.x)], 1u);
            asm volatile("s_waitcnt vmcnt(0)" ::: "memory");
        } else {
            XB_SPIN(xb_ld(&bar[XB_XGEN(b.x)]) == gen, bar);
            __builtin_amdgcn_fence(__ATOMIC_ACQUIRE, "agent");
            asm volatile("s_waitcnt vmcnt(0)" ::: "memory");
        }
    }
    __syncthreads();
}
constexpr int MISC_OFF = 131072 + 320;
constexpr int CW_BAR = 4096;

#ifndef PROBE_DUP
#define PROBE_DUP 0
#endif
#if ONE_LAUNCH
template <int PH> __device__ __forceinline__ void phase_body(Ctx& C) {
    constexpr int i = (PH - 2) / 7, sub = (PH - 2) % 7, j = i >> 1; constexpr bool conv = (i & 1) == 0;
    if (PH == 0) phase_p0(C);
    else if (PH == 1) phase_p1(C);
    else if (PH == 30) phase_final(C);
    else if (sub == 0) prep_layer(C, i);
    else if (sub == 2) { if (conv) dwconv_phase(C, j); else scan_phase(C, j); }
    else if (sub == 3) readout_phase(C, j, i == DEPTH - 1);
    else run_phase(C, PH);
}
template <int PH> __device__ __forceinline__ void one_phase(Ctx& C, const Args& args, const XcdBarrier& bar) {
    if (PH < args.ph_lo || PH >= args.ph_hi) return;
    constexpr int i = (PH - 2) / 7, sub = (PH - 2) % 7; constexpr bool conv = (i & 1) == 0;
    if (PH >= 2 && PH < 30) { if (sub == 0 && i == 0) return; if (sub == 3 && conv) return; }
    if (PH > args.ph_lo) xcd_barrier(bar);
    phase_body<PH>(C);
    constexpr bool dup = ((PH >= 2 && PH < 30) && (((PROBE_DUP & 1) && (sub == 1 || sub == 5)) || ((PROBE_DUP & 2) && sub == 2 && !conv) || ((PROBE_DUP & 4) && sub == 2 && conv) || ((PROBE_DUP & 8) && sub == 0))) || ((PROBE_DUP & 16) && PH < 2);
    if constexpr (dup) { xcd_barrier(bar); phase_body<PH>(C); }
}
template <int... PHS> __device__ __forceinline__ void all_phases(Ctx& C, const Args& args, const XcdBarrier& bar, std::integer_sequence<int, PHS...>) { (one_phase<PHS>(C, args, bar), ...); }
__global__ void __launch_bounds__(512, 2) mega_kernel(Args args) {
    extern __shared__ __attribute__((aligned(16))) unsigned char lds_raw[];
    Ctx C;
    C.lds = (LAS unsigned char*)lds_raw; C.tid = threadIdx.x; C.lane = C.tid & 63; C.wave = __builtin_amdgcn_readfirstlane(C.tid >> 6); C.G = gridDim.x; C.bid = blockIdx.x;
    C.in = args.in; C.out = args.out; C.ws = args.ws;
    volatile LAS unsigned* MISC = (volatile LAS unsigned*)(C.lds + MISC_OFF);
    if (C.tid < 32) MISC[C.tid] = 0u;
    __syncthreads();
    XcdBarrier bar = xcd_barrier_post((unsigned*)(C.ws + WS_CTL) + CW_BAR, MISC + 8);
    all_phases(C, args, bar, std::make_integer_sequence<int, NPHASE>{});
}

#endif
template <int KIND>
__global__ void __launch_bounds__(512, 2) phase_kernel(Args args) {
    extern __shared__ __attribute__((aligned(16))) unsigned char lds_raw[];
    Ctx C;
    C.lds = (LAS unsigned char*)lds_raw; C.tid = threadIdx.x; C.lane = C.tid & 63; C.wave = __builtin_amdgcn_readfirstlane(C.tid >> 6); C.G = gridDim.x; C.bid = blockIdx.x;
    C.in = args.in; C.out = args.out; C.ws = args.ws;
    const int ph = args.ph_lo;
    if (KIND == 0) phase_p0(C);
    else if (KIND == 1) phase_p1(C);
    else if (KIND == 30) phase_final(C);
    else {
        const int i = (ph - 2) / 7, j = i >> 1; const bool conv = (i & 1) == 0;
        if (KIND == 2) prep_layer(C, i);
        else if (KIND == 4) { if (conv) dwconv_phase(C, j); else scan_phase(C, j); }
        else if (KIND == 5) readout_phase(C, j, i == DEPTH - 1);
        else run_phase(C, ph);
    }
}

extern "C" void kernel_launch(void* const* d_in, const int* in_sizes, int n_in, void* d_out, int out_size, void* d_ws, size_t ws_size, hipStream_t stream) {
    static int grid = 0;
    if (grid == 0) {
        if (n_in != 22 || out_size != T * D || ws_size < WS_END) { fprintf(stderr, "kernel_launch: unexpected problem (n_in %d out %d ws %zu, need %zu)\n", n_in, out_size, ws_size, (size_t)WS_END); grid = -1; return; }
        int dev = 0, cus = 0;
        if (hipGetDevice(&dev) != hipSuccess || hipDeviceGetAttribute(&cus, hipDeviceAttributeMultiprocessorCount, dev) != hipSuccess) { grid = -1; return; }
        bool ok = true;
        ok &= hipFuncSetAttribute((const void*)phase_kernel<0>, hipFuncAttributeMaxDynamicSharedMemorySize, LDS_BYTES) == hipSuccess;
        ok &= hipFuncSetAttribute((const void*)phase_kernel<1>, hipFuncAttributeMaxDynamicSharedMemorySize, LDS_BYTES) == hipSuccess;
        ok &= hipFuncSetAttribute((const void*)phase_kernel<2>, hipFuncAttributeMaxDynamicSharedMemorySize, LDS_BYTES) == hipSuccess;
        ok &= hipFuncSetAttribute((const void*)phase_kernel<3>, hipFuncAttributeMaxDynamicSharedMemorySize, LDS_BYTES) == hipSuccess;
        ok &= hipFuncSetAttribute((const void*)phase_kernel<4>, hipFuncAttributeMaxDynamicSharedMemorySize, LDS_BYTES) == hipSuccess;
        ok &= hipFuncSetAttribute((const void*)phase_kernel<5>, hipFuncAttributeMaxDynamicSharedMemorySize, LDS_BYTES) == hipSuccess;
        ok &= hipFuncSetAttribute((const void*)phase_kernel<30>, hipFuncAttributeMaxDynamicSharedMemorySize, LDS_BYTES) == hipSuccess;
#if ONE_LAUNCH
        ok &= hipFuncSetAttribute((const void*)mega_kernel, hipFuncAttributeMaxDynamicSharedMemorySize, LDS_BYTES) == hipSuccess;
#endif
        if (!ok) { fprintf(stderr, "kernel_launch: hipFuncSetAttribute failed\n"); grid = -1; return; }
        grid = cus > 0 ? cus : 256;
    }
    if (grid < 0) return;
    Args a{};
    for (int i = 0; i < 22; ++i) a.in[i] = (const float*)d_in[i];
    a.out = (float*)d_out; a.ws = (unsigned char*)d_ws;
#if ONE_LAUNCH
    if (hipMemsetAsync((char*)d_ws + WS_CTL, 0, 65536, stream) != hipSuccess) { fprintf(stderr, "kernel_launch: memset failed\n"); return; }
    a.ph_lo = 0; a.ph_hi = NPHASE;
    hipLaunchKernelGGL(mega_kernel, dim3(grid), dim3(512), LDS_BYTES, stream, a);
    return;
#endif
    for (int ph = 0; ph < NPHASE; ++ph) {
        const int i = (ph - 2) / 7, sub = (ph - 2) % 7;
        if (ph >= 2 && ph < 30) { if (sub == 0 && i == 0) continue; if (sub == 3 && (i & 1) == 0) continue; }
        a.ph_lo = ph; a.ph_hi = ph + 1;
        const dim3 g(grid), b(512);
        if (ph == 0) hipLaunchKernelGGL(phase_kernel<0>, g, b, LDS_BYTES, stream, a);
        else if (ph == 1) hipLaunchKernelGGL(phase_kernel<1>, g, b, LDS_BYTES, stream, a);
        else if (ph == 30) hipLaunchKernelGGL(phase_kernel<30>, g, b, LDS_BYTES, stream, a);
        else if (sub == 0) hipLaunchKernelGGL(phase_kernel<2>, g, b, LDS_BYTES, stream, a);
        else if (sub == 2) hipLaunchKernelGGL(phase_kernel<4>, g, b, LDS_BYTES, stream, a);
        else if (sub == 3) hipLaunchKernelGGL(phase_kernel<5>, g, b, LDS_BYTES, stream, a);
        else hipLaunchKernelGGL(phase_kernel<3>, g, b, LDS_BYTES, stream, a);
        {   const bool conv = (i & 1) == 0;
            const bool dup = ((ph >= 2 && ph < 30) && (((PROBE_DUP & 1) && (sub == 1 || sub == 5)) || ((PROBE_DUP & 2) && sub == 2 && !conv) || ((PROBE_DUP & 4) && sub == 2 && conv) || ((PROBE_DUP & 8) && sub == 0))) || ((PROBE_DUP & 16) && ph < 2);
            if (dup) {
                if (ph == 0) hipLaunchKernelGGL(phase_kernel<0>, g, b, LDS_BYTES, stream, a);
                else if (ph == 1) hipLaunchKernelGGL(phase_kernel<1>, g, b, LDS_BYTES, stream, a);
                else if (sub == 0) hipLaunchKernelGGL(phase_kernel<2>, g, b, LDS_BYTES, stream, a);
                else if (sub == 2) hipLaunchKernelGGL(phase_kernel<4>, g, b, LDS_BYTES, stream, a);
                else hipLaunchKernelGGL(phase_kernel<3>, g, b, LDS_BYTES, stream, a);
            } }
    }
}
```

```cpp
#include <hip/hip_runtime.h>
#include <cstdio>
#include <cstdint>
#include <utility>

#ifndef ONE_LAUNCH
#define ONE_LAUNCH 1
#endif

typedef unsigned short bf16_t;
typedef short bf16x8 __attribute__((ext_vector_type(8)));
typedef float f32x4 __attribute__((ext_vector_type(4)));
typedef float f32x2 __attribute__((ext_vector_type(2)));
typedef unsigned u32x2 __attribute__((ext_vector_type(2)));
typedef unsigned u32x4 __attribute__((ext_vector_type(4)));
typedef __bf16 bf16x2_t __attribute__((ext_vector_type(2)));
typedef short s16x4 __attribute__((ext_vector_type(4)));
#define LAS __attribute__((address_space(3)))

constexpr int D = 1024, T = 16384, TC = 256, R = T + TC, NH = 4, DK = 256, DV = 512, QKW = 1024, VW = 2048, INW = 8192, DFF = 2816, FF2 = 5632, CK = 31, DEPTH = 4;
constexpr int NSLOT = 33;
constexpr float NORM_EPS = 1e-6f, LN_EPS = 1e-5f;

constexpr size_t MiB = 1u << 20, KiB = 1u << 10;
constexpr size_t WS_CTL = 0, CTL_ZERO_BYTES = 1 * MiB;
constexpr size_t WS_MODV = 1 * MiB;
constexpr size_t WS_S1 = 1 * MiB + 256 * KiB;
constexpr size_t WS_S2 = 1 * MiB + 320 * KiB;
constexpr size_t WS_CVA = 1 * MiB + 384 * KiB;
constexpr size_t WS_CVF = 1 * MiB + 640 * KiB;
constexpr size_t WS_TABC = 1 * MiB + 832 * KiB;
constexpr size_t WS_TABS = 1 * MiB + 912 * KiB;
constexpr size_t WS_STATS = 2 * MiB;
constexpr size_t WS_XCTX = 4 * MiB;
constexpr size_t WS_WA = 8 * MiB;
constexpr size_t WS_WA2 = 24 * MiB;
constexpr size_t WS_WF1 = 28 * MiB;
constexpr size_t WS_WF2 = 40 * MiB;
constexpr size_t WS_XS = 48 * MiB;
constexpr size_t WS_SCP = 48 * MiB;
constexpr size_t WS_BIG = 114 * MiB;
constexpr size_t WS_Q = WS_BIG, WS_K = WS_BIG + 33 * MiB, WS_VT = WS_BIG + 66 * MiB, WS_GF = WS_BIG + 131 * MiB, WS_GB = WS_BIG + 196 * MiB;
constexpr size_t WS_U = WS_BIG, WS_A2 = WS_BIG + 33 * MiB, WS_H = WS_BIG;
constexpr size_t WS_END = WS_BIG + 261 * MiB;
static_assert((size_t)R * 1024 * 2 <= 33 * MiB && (size_t)R * 2048 * 2 <= 65 * MiB && (size_t)R * DFF * 2 <= 131 * MiB, "map");
static_assert((size_t)NSLOT * 8 * 512 * 256 * 2 <= 66 * MiB, "scp");

constexpr int LDS_BYTES = 147456;

__device__ __forceinline__ unsigned pk2(float lo, float hi) { f32x2 v = {lo, hi}; bf16x2_t b = __builtin_convertvector(v, bf16x2_t); return __builtin_bit_cast(unsigned, b); }
__device__ __forceinline__ float bflo(unsigned u) { return __uint_as_float(u << 16); }
__device__ __forceinline__ float bfhi(unsigned u) { return __uint_as_float(u & 0xffff0000u); }
__device__ __forceinline__ float sigmf(float x) { return __builtin_amdgcn_rcpf(1.f + __builtin_amdgcn_exp2f(-1.4426950408889634f * x)); }
__device__ __forceinline__ float siluf(float x) { return x * sigmf(x); }
__device__ __forceinline__ float wave_sum63(float v) {
    v += __builtin_bit_cast(float, __builtin_amdgcn_update_dpp(0, __builtin_bit_cast(int, v), 0xB1, 0xF, 0xF, false));
    v += __builtin_bit_cast(float, __builtin_amdgcn_update_dpp(0, __builtin_bit_cast(int, v), 0x4E, 0xF, 0xF, false));
    v += __builtin_bit_cast(float, __builtin_amdgcn_update_dpp(0, __builtin_bit_cast(int, v), 0x141, 0xF, 0xF, false));
    v += __builtin_bit_cast(float, __builtin_amdgcn_update_dpp(0, __builtin_bit_cast(int, v), 0x140, 0xF, 0xF, false));
    v += __builtin_bit_cast(float, __builtin_amdgcn_update_dpp(0, __builtin_bit_cast(int, v), 0x142, 0xA, 0xF, false));
    v += __builtin_bit_cast(float, __builtin_amdgcn_update_dpp(0, __builtin_bit_cast(int, v), 0x143, 0xC, 0xF, false));
    return v;
}
__device__ __forceinline__ int perm_glu(int n, int H) { if (n < H) return 32 * (n >> 4) + (n & 15); const int n2 = n - H; return 32 * (n2 >> 4) + 16 + (n2 & 15); }
__device__ __forceinline__ int perm_win(int n) {
    if (n >= 2 * QKW) return n;
    const int part = n >> 10, hn = n & 1023, h = hn >> 8, d = hn & 255, quarter = d >> 6, idx = d & 63;
    const int Gp = (quarter >> 1) * 4 + (idx >> 4), i = (quarter & 1) * 16 + (idx & 15);
    return part * 1024 + h * 256 + 32 * Gp + i;
}
__device__ __forceinline__ int perm_any(int mode, int n, int H) { return mode == 0 ? n : (mode == 1 ? perm_glu(n, H) : perm_win(n)); }

struct Args { const float* in[22]; float* out; unsigned char* ws; int ph_lo, ph_hi; };

struct Ctx {
    LAS unsigned char* lds;
    int tid, lane, wave, G, bid;
    const float* const* in; float* out; unsigned char* ws;
};

template <int VSILU>
__device__ __forceinline__ void gemv2_unit(Ctx& C, const float* W, int N, int n0, const float* v0, const float* v1, const float* bias, float* o0, float* o1, int pmode, int H) {
    LAS float* red = (LAS float*)C.lds;
    const int c4 = C.tid & 15, ks = C.tid >> 4;
    f32x4 a0 = {0.f, 0.f, 0.f, 0.f}, a1 = {0.f, 0.f, 0.f, 0.f};
#pragma unroll 8
    for (int i = 0; i < 32; ++i) {
        const int k = ks * 32 + i;
        const f32x4 w = *(const f32x4*)(W + (size_t)k * N + n0 + 4 * c4);
        float x0 = v0[k], x1 = v1[k];
        if (VSILU) { x0 = siluf(x0); x1 = siluf(x1); }
        a0 += w * x0; a1 += w * x1;
    }
#pragma unroll
    for (int e = 0; e < 4; ++e) { red[(ks * 2 + 0) * 64 + 4 * c4 + e] = a0[e]; red[(ks * 2 + 1) * 64 + 4 * c4 + e] = a1[e]; }
    __syncthreads();
    if (C.tid < 128) {
        const int s = C.tid >> 6, col = C.tid & 63; float sum = 0.f;
#pragma unroll 8
        for (int k2 = 0; k2 < 32; ++k2) sum += red[(k2 * 2 + s) * 64 + col];
        const int n = n0 + col; if (bias) sum += bias[n];
        (s ? o1 : o0)[perm_any(pmode, n, H)] = sum;
    }
    __syncthreads();
}

__device__ __forceinline__ void transpose_item(const float* W, int K, int N, bf16_t* WT, int pmode, int H, LAS float* scr, int item, int lane) {
    const int nblk = N / 32, kb = item / nblk, nb = item % nblk, k0 = 64 * kb, n0 = 32 * nb;
#pragma unroll 8
    for (int i = 0; i < 32; ++i) { const int kk = 2 * i + (lane >> 5); scr[kk * 33 + (lane & 31)] = W[(size_t)(k0 + kk) * N + n0 + (lane & 31)]; }
    asm volatile("s_waitcnt lgkmcnt(0)" ::: "memory");
    const int c = lane & 7;
#pragma unroll
    for (int j = 0; j < 4; ++j) { const int n = (lane >> 3) + 8 * j; const LAS float* s = scr + (8 * c) * 33 + n;
        u32x4 o; o.x = pk2(s[0 * 33], s[1 * 33]); o.y = pk2(s[2 * 33], s[3 * 33]); o.z = pk2(s[4 * 33], s[5 * 33]); o.w = pk2(s[6 * 33], s[7 * 33]);
        *(u32x4*)(WT + (size_t)perm_any(pmode, n0 + n, H) * K + k0 + 8 * c) = o; }
    asm volatile("s_waitcnt lgkmcnt(0)" ::: "memory");
}
__device__ __forceinline__ void prep_layer(Ctx& C, int i) {
    LAS float* scr = (LAS float*)(C.lds + C.wave * 16384);
    const int gw = C.bid * 8 + C.wave, NGW = C.G * 8, j = i >> 1;
    bf16_t* WA = (bf16_t*)(C.ws + WS_WA); bf16_t* WA2 = (bf16_t*)(C.ws + WS_WA2); bf16_t* WF1 = (bf16_t*)(C.ws + WS_WF1); bf16_t* WF2 = (bf16_t*)(C.ws + WS_WF2);
    const bool conv = (i & 1) == 0;
    const int I_A = conv ? 16 * 64 : 16 * 256, I_A2 = conv ? 16 * 32 : 32 * 32, I_F1 = 16 * 176, I_F2 = 44 * 32;
    const int NIT = I_A + I_A2 + I_F1 + I_F2;
    for (int it = gw; it < NIT; it += NGW) {
        int r = it;
        if (r < I_A) { if (conv) transpose_item(C.in[8] + (size_t)j * 1024 * 2048, 1024, 2048, WA, 1, 1024, scr, r, C.lane);
                       else transpose_item(C.in[16] + (size_t)j * 1024 * 8192, 1024, 8192, WA, 2, 0, scr, r, C.lane); continue; } r -= I_A;
        if (r < I_A2) { if (conv) transpose_item(C.in[14] + (size_t)j * 1024 * 1024, 1024, 1024, WA2, 0, 0, scr, r, C.lane);
                        else transpose_item(C.in[18] + (size_t)j * 2048 * 1024, 2048, 1024, WA2, 0, 0, scr, r, C.lane); continue; } r -= I_A2;
        if (r < I_F1) { transpose_item(C.in[19] + (size_t)i * 1024 * FF2, 1024, FF2, WF1, 1, DFF, scr, r, C.lane); continue; } r -= I_F1;
        transpose_item(C.in[20] + (size_t)i * DFF * 1024, DFF, 1024, WF2, 0, 0, scr, r, C.lane);
    }
}

__device__ __forceinline__ float row_rs(const float* stats, int row, int fq) {
    const f32x4 p = *(const f32x4*)(stats + (size_t)row * 16 + 4 * fq);
    float s = (p[0] + p[1]) + (p[2] + p[3]);
    s += __shfl_xor(s, 16); s += __shfl_xor(s, 32);
    return 1.0f / sqrtf(s * (1.0f / 1024.0f) + NORM_EPS);
}
struct EpiGLU {
    static constexpr bool STATS = false, NEEDRS = true;
    unsigned char* ws; int cvoff  , cvstride  , outoff  , ldo, act;
    float* stats;
    __device__ __forceinline__ float row_begin(int row, int fq) const { return row_rs((const float*)(ws + WS_STATS), row, fq); }
    __device__ __forceinline__ float item(int row, int colp, f32x4 v0, f32x4 v1, float rs) const {
        const float* cv = (const float*)ws + cvoff + (row < T ? 0 : cvstride);
        const f32x4 ca = *(const f32x4*)(cv + colp), cg = *(const f32x4*)(cv + colp + 16);
        float o[4];
#pragma unroll
        for (int e = 0; e < 4; ++e) { const float a = rs * v0[e] + ca[e], g = rs * v1[e] + cg[e]; o[e] = act == 0 ? a * sigmf(g) : siluf(a) * g; }
        const int oc = (colp >> 5) * 16 + (colp & 15);
        u32x2 w; w.x = pk2(o[0], o[1]); w.y = pk2(o[2], o[3]);
        *(u32x2*)((bf16_t*)(ws + outoff) + (size_t)row * ldo + oc) = w;
        return 0.f;
    }
};
struct EpiRes {
    static constexpr bool STATS = true, NEEDRS = false;
    unsigned char* ws; float* xl; const float* bias; int mgoff  , snoff  ;
    float* stats;
    __device__ __forceinline__ float row_begin(int, int) const { return 1.f; }
    __device__ __forceinline__ float item(int row, int colp, f32x4 v0, f32x4 v1, float) const {
        const bool lat = row < T;
        float* xr = lat ? xl + (size_t)row * 1024 : (float*)(ws + WS_XCTX) + (size_t)(row - T) * 1024;
        const float* mg = (const float*)ws + mgoff + (lat ? 0 : 6144); const float* sn = (const float*)ws + snoff + (lat ? 0 : 1024);
        bf16_t* xs = (bf16_t*)(ws + WS_XS);
        float ss = 0.f;
#pragma unroll
        for (int hlf = 0; hlf < 2; ++hlf) {
            const int c = colp + 16 * hlf; const f32x4 v = hlf ? v1 : v0;
            const f32x4 xo = *(const f32x4*)(xr + c), m4 = *(const f32x4*)(mg + c);
            f32x4 b4 = {0.f, 0.f, 0.f, 0.f}; if (bias) b4 = *(const f32x4*)(bias + c);
            const f32x4 xn = xo + m4 * (v + b4);
            *(f32x4*)(xr + c) = xn;
            ss += (xn[0] * xn[0] + xn[1] * xn[1]) + (xn[2] * xn[2] + xn[3] * xn[3]);
            if (snoff >= 0) { const f32x4 s4 = *(const f32x4*)(sn + c); u32x2 w; w.x = pk2(xn[0] * s4[0], xn[1] * s4[1]); w.y = pk2(xn[2] * s4[2], xn[3] * s4[3]);
                *(u32x2*)(xs + (size_t)row * 1024 + c) = w; }
        }
        return ss;
    }
};
struct EpiWin {
    static constexpr bool STATS = false, NEEDRS = true;
    unsigned char* ws; int cvoff;
    float* stats;
    __device__ __forceinline__ float row_begin(int row, int fq) const { return row_rs((const float*)(ws + WS_STATS), row, fq); }
    __device__ __forceinline__ float item(int row, int colp, f32x4 v0, f32x4 v1, float rs) const {
        const float* cv = (const float*)ws + cvoff + (row < T ? 0 : 8192);
        const f32x4 c0 = *(const f32x4*)(cv + colp), c1 = *(const f32x4*)(cv + colp + 16);
        f32x4 a = v0 * rs + c0, b = v1 * rs + c1;
        if (colp < 2048) {
            if (row < T) {
                const int Gp = (colp >> 5) & 7, idx0 = 16 * (Gp & 3) + (colp & 15);
                const int ti = (Gp >> 2) ? 256 + (row & 63) : (row >> 6);
                const f32x4 cs = *(const f32x4*)((const float*)(ws + WS_TABC) + ti * 64 + idx0), sn = *(const f32x4*)((const float*)(ws + WS_TABS) + ti * 64 + idx0);
                const f32x4 o1 = a * cs - b * sn, o2 = b * cs + a * sn; a = o1; b = o2;
            }
            bf16_t* dst = (bf16_t*)(ws + WS_Q);
            if (colp >= 1024) { dst = (bf16_t*)(ws + WS_K); a = a * 0.0625f; b = b * 0.0625f; }
            const int c = colp & 1023;
            u32x2 w; w.x = pk2(a[0], a[1]); w.y = pk2(a[2], a[3]); *(u32x2*)(dst + (size_t)row * 1024 + c) = w;
            w.x = pk2(b[0], b[1]); w.y = pk2(b[2], b[3]); *(u32x2*)(dst + (size_t)row * 1024 + c + 16) = w;
        } else if (colp < 4096) {
            const int c = colp - 2048;
            bf16_t* vt = (bf16_t*)(ws + WS_VT);
#pragma unroll
            for (int e = 0; e < 4; ++e) { vt[(size_t)(c + e) * R + row] = (bf16_t)(pk2(a[e], 0.f) & 0xffffu); vt[(size_t)(c + 16 + e) * R + row] = (bf16_t)(pk2(b[e], 0.f) & 0xffffu); }
        } else {
            bf16_t* dst = (bf16_t*)(ws + (colp < 6144 ? WS_GF : WS_GB)); const int c = (colp - 4096) & 2047;
            u32x2 w; w.x = pk2(a[0], a[1]); w.y = pk2(a[2], a[3]); *(u32x2*)(dst + (size_t)row * 2048 + c) = w;
            w.x = pk2(b[0], b[1]); w.y = pk2(b[2], b[3]); *(u32x2*)(dst + (size_t)row * 2048 + c + 16) = w;
        }
        return 0.f;
    }
};

template <class Epi>
__device__ __forceinline__ void sgemm_small(Ctx& C, const bf16_t* A, const bf16_t* Bt, int row_lo, int Mrows, int N, int K, const Epi& E, int n_lo, int n_hi) {
    const int wr = C.wave >> 2, wc = C.wave & 3, fr = C.lane & 15, fq = C.lane >> 4;
    const int nM = Mrows / 32, nN = n_hi - n_lo, nU = nM * nN;
    for (int u = (C.G - 1 - C.bid); u < nU; u += C.G) {
        const int un = n_lo + u / nM, um = u % nM;
        const int row0 = row_lo + 32 * um + 16 * wr, col0 = 256 * un;
        f32x4 acc[2][2];
#pragma unroll
        for (int b = 0; b < 2; ++b)
#pragma unroll
            for (int n = 0; n < 2; ++n) acc[b][n] = (f32x4){0.f, 0.f, 0.f, 0.f};
        const bf16_t* ap = A + (size_t)(row0 + fr) * K + 8 * fq;
        const bf16_t* bp = Bt + (size_t)(col0 + 32 * wc + fr) * K + 8 * fq;
#pragma unroll 4
        for (int k0 = 0; k0 < K; k0 += 32) {
            bf16x8 bf[2][2];
            const bf16x8 af = *(const bf16x8*)(ap + k0);
#pragma unroll
            for (int bj = 0; bj < 2; ++bj)
#pragma unroll
                for (int n = 0; n < 2; ++n) bf[bj][n] = *(const bf16x8*)(bp + (size_t)(128 * bj + 16 * n) * K + k0);
#pragma unroll
            for (int bj = 0; bj < 2; ++bj)
#pragma unroll
                for (int n = 0; n < 2; ++n) acc[bj][n] = __builtin_amdgcn_mfma_f32_16x16x32_bf16(bf[bj][n], af, acc[bj][n], 0, 0, 0);
        }
        const int row = row0 + fr;
        const float rs = E.row_begin(row, fq);
        float ss = 0.f;
#pragma unroll
        for (int bj = 0; bj < 2; ++bj) ss += E.item(row, col0 + 128 * bj + 32 * wc + 4 * fq, acc[bj][0], acc[bj][1], rs);
        if constexpr (Epi::STATS) { ss += __shfl_xor(ss, 16); ss += __shfl_xor(ss, 32); if (fq == 0) E.stats[(size_t)row * 16 + un * 4 + wc] = ss; }
    }
}

namespace pg8 {
#define PG8_LAS __attribute__((address_space(3)))
typedef unsigned short bf16_t;
typedef short bf16x8 __attribute__((ext_vector_type(8)));
typedef float f32x4 __attribute__((ext_vector_type(4)));
typedef unsigned u32x4 __attribute__((ext_vector_type(4)));
constexpr int BM = 256, BK = 64, HALF = 128, HTB = HALF * BK * 2  , STAGE_BYTES = 8 * HTB, NXCD = 8, WGM = 8;

__host__ __device__ __forceinline__ int lds_byte(int r, int c) { const int st = (r >> 4) * 2 + (c >> 5), rr = r & 15, cc = c & 31, ob = rr * 64 + cc * 2; return st * 1024 + (ob ^ (((ob >> 9) & 1) << 5)); }
__host__ __device__ __forceinline__ void stage_rc(int b, int& R, int& C) { const int st = b / 1024, sb = b % 1024, swz = sb ^ (((sb >> 9) & 1) << 5); R = (st >> 1) * 16 + swz / 64; C = (st & 1) * 32 + (swz % 64) / 2; }
__host__ __device__ __forceinline__ int perm32(int rho) { const int n = rho >> 4, i = rho & 15; return 8 * (i >> 2) + 4 * n + (i & 3); }

struct Unit { int pm, pn; };
struct Gemm { const bf16_t* A; const bf16_t* Bt; int M, N, K; };

struct StaticOrder {
    int nM, nN, nwg, G, c;
    __host__ __device__ void init(int M, int N, int G_, int c_) { nM = M / BM; nN = N / BM; nwg = nM * nN; G = G_; c = c_; }
    __host__ __device__ bool next(int i, Unit& u) const {
        const long L = (long)i * G + c; if (L >= nwg) return false;
        int wgid = (int)L; { const int q = nwg / NXCD, r = nwg % NXCD, xcd = wgid % NXCD, off = wgid / NXCD; wgid = (xcd < r ? xcd * (q + 1) : r * (q + 1) + (xcd - r) * q) + off; }
        const int nig = WGM * nN, gid = wgid / nig, fm = gid * WGM, gsz = (nM - fm) < WGM ? (nM - fm) : WGM;
        u.pm = fm + ((wgid % nig) % gsz); u.pn = (wgid % nig) / gsz; return true;
    }
    __device__ __forceinline__ void a_ready(const Unit&) const {}
    __device__ __forceinline__ void done(const Unit&) const {}
};

template <class Epi, class Sched, bool ALIGN_EPI = false, bool SP2 = false>
__device__ __forceinline__ void gemm_phase(PG8_LAS unsigned char* lds, const Gemm g, const Sched& S, const Epi& E) {
    const int tid = threadIdx.x, wid = __builtin_amdgcn_readfirstlane(tid >> 6), lane = tid & 63, wr = wid >> 2, wc = wid & 3, fr = lane & 15, fq = lane >> 4;
    const int K = g.K, nt = K / BK;
    unsigned voffA[2], voffB[2];
#pragma unroll
    for (int i = 0; i < 2; ++i) { int R, C; stage_rc(tid * 16 + i * 8192, R, C); const int Rb = Epi::PERM ? ((R & ~31) + perm32(R & 31)) : R;
        voffA[i] = (unsigned)(R * K + C) * 2u; voffB[i] = (unsigned)(Rb * K + C) * 2u; }
    const size_t kstep = (size_t)(BK * 2);
    const size_t hstep = (size_t)HALF * K * 2;
    const size_t tstep = 2 * hstep;
    const unsigned ldsw = (unsigned)wid * 1024u;
    const int aoff = lds_byte(wr * 64 + fr, fq * 8), boff = lds_byte(wc * 32 + fr, fq * 8);
#define PG8_SA(b, h) (((b) * 2 + (h)) * HTB)
#define PG8_SB(b, h) ((4 + (b) * 2 + (h)) * HTB)
#define PG8_STAGE(bufoff, gbase, voff) do { _Pragma("unroll") for (int _i = 0; _i < 2; ++_i) \
        __builtin_amdgcn_global_load_lds((const unsigned*)((const char*)(gbase) + (voff)[_i]), (PG8_LAS unsigned*)(lds + (bufoff) + ldsw + _i * 8192), 16, 0, 0); } while (0)
#define PG8_LDA(dst, b, h) do { _Pragma("unroll") for (int m = 0; m < 4; ++m) _Pragma("unroll") for (int k = 0; k < 2; ++k) dst[m][k] = *(const PG8_LAS bf16x8*)(lds + PG8_SA(b, h) + aoff + m * 2048 + k * 1024); } while (0)
#define PG8_LDB(dst, b, h) do { _Pragma("unroll") for (int n = 0; n < 2; ++n) _Pragma("unroll") for (int k = 0; k < 2; ++k) dst[n][k] = *(const PG8_LAS bf16x8*)(lds + PG8_SB(b, h) + boff + n * 2048 + k * 1024); } while (0)
#define PG8_MMA(ai, bj, At, Bt) do { __builtin_amdgcn_s_setprio(1); _Pragma("unroll") for (int m = 0; m < 4; ++m) _Pragma("unroll") for (int n = 0; n < 2; ++n) _Pragma("unroll") for (int k = 0; k < 2; ++k) \
        acc[ai][bj][m][n] = __builtin_amdgcn_mfma_f32_16x16x32_bf16(Bt[n][k], At[m][k], acc[ai][bj][m][n], 0, 0, 0); __builtin_amdgcn_s_setprio(0); } while (0)
#define PG8_WAIT_V(n) asm volatile("s_waitcnt vmcnt(" #n ")" ::: "memory")
#define PG8_WAIT_L(n) asm volatile("s_waitcnt lgkmcnt(" #n ")" ::: "memory")
#define PG8_BAR __builtin_amdgcn_s_barrier()
#define PG8_SCHED __builtin_amdgcn_sched_barrier(0)
    Unit cur, nxt; int ui = 0;
    if (!S.next(0, cur)) return;
    f32x4 acc[2][2][4][2];
#pragma unroll
    for (int a = 0; a < 2; ++a)
#pragma unroll
        for (int b = 0; b < 2; ++b)
#pragma unroll
            for (int m = 0; m < 4; ++m)
#pragma unroll
                for (int n = 0; n < 2; ++n) acc[a][b][m][n] = (f32x4){0.f, 0.f, 0.f, 0.f};
    bf16x8 At[4][2], B0[2][2], B1[2][2];
    const char* cA = (const char*)g.A + (size_t)cur.pm * tstep; const char* cB = (const char*)g.Bt + (size_t)cur.pn * tstep;
    S.a_ready(cur);
    if constexpr (SP2) {
        PG8_STAGE(PG8_SB(0, 0), cB, voffB); PG8_STAGE(PG8_SB(0, 1), cB + hstep, voffB); PG8_STAGE(PG8_SA(0, 0), cA, voffA); PG8_STAGE(PG8_SA(0, 1), cA + hstep, voffA);
        if (wr == 1) PG8_BAR;
        PG8_WAIT_V(2); PG8_BAR;
        PG8_STAGE(PG8_SB(1, 0), cB + kstep, voffB); PG8_STAGE(PG8_SA(1, 0), cA + kstep, voffA); PG8_STAGE(PG8_SB(1, 1), cB + hstep + kstep, voffB);
        PG8_WAIT_V(6); PG8_BAR;
    } else {
        PG8_STAGE(PG8_SB(0, 0), cB, voffB); PG8_STAGE(PG8_SA(0, 0), cA, voffA); PG8_STAGE(PG8_SB(0, 1), cB + hstep, voffB); PG8_STAGE(PG8_SA(0, 1), cA + hstep, voffA);
        if (wr == 1) PG8_BAR;
        PG8_WAIT_V(4); PG8_BAR;
        PG8_STAGE(PG8_SB(1, 0), cB + kstep, voffB); PG8_STAGE(PG8_SA(1, 0), cA + kstep, voffA); PG8_STAGE(PG8_SB(1, 1), cB + hstep + kstep, voffB);
        PG8_WAIT_V(6); PG8_BAR;
    }
    for (;;) {
        const bool has_next = S.next(ui + 1, nxt);
        const char* nA = has_next ? (const char*)g.A + (size_t)nxt.pm * tstep : cA; const char* nB = has_next ? (const char*)g.Bt + (size_t)nxt.pn * tstep : cB;
        for (int t = 0; t < nt; t += 2) {
            const bool last = (t == nt - 2);
            const char* a1 = cA + (size_t)(t + 1) * kstep;
            const char* a2 = last ? nA : cA + (size_t)(t + 2) * kstep; const char* b2 = last ? nB : cB + (size_t)(t + 2) * kstep;
            const char* a3 = a2 + kstep; const char* b3 = b2 + kstep;
            if (last && has_next) S.a_ready(nxt);
            if constexpr (SP2) {
            PG8_LDB(B0, 0, 0); PG8_LDB(B1, 0, 1); PG8_SCHED; PG8_LDA(At, 0, 0); PG8_STAGE(PG8_SA(1, 1), a1 + hstep, voffA);
            PG8_WAIT_V(8); PG8_WAIT_L(0); PG8_BAR; PG8_MMA(0, 0, At, B0); PG8_MMA(0, 1, At, B1); PG8_BAR; PG8_SCHED;
            PG8_LDA(At, 0, 1); PG8_STAGE(PG8_SB(0, 0), b2, voffB); PG8_STAGE(PG8_SB(0, 1), b2 + hstep, voffB); PG8_STAGE(PG8_SA(0, 0), a2, voffA);
            PG8_WAIT_V(8); PG8_WAIT_L(0); PG8_BAR; PG8_MMA(1, 0, At, B0); PG8_MMA(1, 1, At, B1); PG8_BAR; PG8_SCHED;
            PG8_LDB(B0, 1, 0); PG8_LDB(B1, 1, 1); PG8_SCHED; PG8_LDA(At, 1, 0); PG8_STAGE(PG8_SA(0, 1), a2 + hstep, voffA);
            PG8_WAIT_V(8); PG8_WAIT_L(0); PG8_BAR; PG8_MMA(0, 0, At, B0); PG8_MMA(0, 1, At, B1); PG8_BAR; PG8_SCHED;
            PG8_LDA(At, 1, 1); PG8_STAGE(PG8_SB(1, 0), b3, voffB); PG8_STAGE(PG8_SB(1, 1), b3 + hstep, voffB); PG8_STAGE(PG8_SA(1, 0), a3, voffA);
            PG8_WAIT_V(8); PG8_WAIT_L(0); PG8_BAR; PG8_MMA(1, 0, At, B0); PG8_MMA(1, 1, At, B1); PG8_BAR; PG8_SCHED;
            } else {
            PG8_LDB(B0, 0, 0); PG8_SCHED; PG8_LDA(At, 0, 0); PG8_STAGE(PG8_SA(1, 1), a1 + hstep, voffA);
            PG8_WAIT_L(8); PG8_BAR; PG8_WAIT_L(0); PG8_MMA(0, 0, At, B0); PG8_BAR; PG8_SCHED;
            PG8_LDB(B1, 0, 1); PG8_STAGE(PG8_SB(0, 0), b2, voffB);
            PG8_BAR; PG8_WAIT_L(0); PG8_MMA(0, 1, At, B1); PG8_BAR;
            PG8_LDA(At, 0, 1); PG8_STAGE(PG8_SA(0, 0), a2, voffA);
            PG8_BAR; PG8_WAIT_L(0); PG8_MMA(1, 0, At, B0); PG8_BAR; PG8_SCHED;
            PG8_STAGE(PG8_SB(0, 1), b2 + hstep, voffB);
            PG8_WAIT_V(6); PG8_BAR; PG8_MMA(1, 1, At, B1); PG8_BAR;
            PG8_LDB(B0, 1, 0); PG8_SCHED; PG8_LDA(At, 1, 0); PG8_STAGE(PG8_SA(0, 1), a2 + hstep, voffA);
            PG8_WAIT_L(8); PG8_BAR; PG8_WAIT_L(0); PG8_MMA(0, 0, At, B0); PG8_BAR; PG8_SCHED;
            PG8_LDB(B1, 1, 1); PG8_STAGE(PG8_SB(1, 0), b3, voffB);
            PG8_BAR; PG8_WAIT_L(0); PG8_MMA(0, 1, At, B1); PG8_BAR;
            PG8_LDA(At, 1, 1); PG8_STAGE(PG8_SA(1, 0), a3, voffA);
            PG8_BAR; PG8_WAIT_L(0); PG8_MMA(1, 0, At, B0); PG8_BAR; PG8_SCHED;
            PG8_STAGE(PG8_SB(1, 1), b3 + hstep, voffB);
            PG8_WAIT_V(6); PG8_BAR; PG8_MMA(1, 1, At, B1); PG8_BAR;
            }
        }
        if constexpr (ALIGN_EPI) { if (wr == 0) PG8_BAR; }
        if constexpr (!Epi::AFTER_DRAIN) { E(acc, cur, wr, wc, fr, fq); S.done(cur); }
        if (!has_next) break;
#pragma unroll
        for (int a = 0; a < 2; ++a)
#pragma unroll
            for (int b = 0; b < 2; ++b)
#pragma unroll
                for (int m = 0; m < 4; ++m)
#pragma unroll
                    for (int n = 0; n < 2; ++n) acc[a][b][m][n] = (f32x4){0.f, 0.f, 0.f, 0.f};
        cur = nxt; cA = nA; cB = nB; ++ui;
        if constexpr (ALIGN_EPI) { if (wr == 1) PG8_BAR; }
    }
    PG8_WAIT_V(0);
    if constexpr (!ALIGN_EPI) { if (wr == 0) PG8_BAR; }
    PG8_BAR;
    if constexpr (Epi::AFTER_DRAIN) { E.fused(acc, cur, wr, wc, fr, fq, lds, wid, lane); S.done(cur); }
#undef PG8_SA
#undef PG8_SB
#undef PG8_STAGE
#undef PG8_LDA
#undef PG8_LDB
#undef PG8_MMA
#undef PG8_WAIT_V
#undef PG8_WAIT_L
#undef PG8_BAR
#undef PG8_SCHED
}
}

template <class E0> struct EpiAdapt {
    static constexpr bool PERM = false, AFTER_DRAIN = false;
    E0 e;
    __device__ __forceinline__ void operator()(const pg8::f32x4 (&acc)[2][2][4][2], const pg8::Unit& u, int wr, int wc, int fr, int fq) const {
#pragma unroll
        for (int ai = 0; ai < 2; ++ai)
#pragma unroll
            for (int m = 0; m < 4; ++m) {
                const int row = u.pm * 256 + ai * 128 + wr * 64 + m * 16 + fr;
                const float rs = e.row_begin(row, fq);
                float ss = 0.f;
#pragma unroll
                for (int bj = 0; bj < 2; ++bj) ss += e.item(row, u.pn * 256 + bj * 128 + wc * 32 + 4 * fq, acc[ai][bj][m][0], acc[ai][bj][m][1], rs);
                if constexpr (E0::STATS) { ss += __shfl_xor(ss, 16); ss += __shfl_xor(ss, 32); if (fq == 0) e.stats[(size_t)row * 16 + u.pn * 4 + wc] = ss; }
            }
    }
};
template <class E0>
__device__ __forceinline__ void gemm_both(Ctx& C, const bf16_t* A, const bf16_t* Bt, int Mbig, int N, int K, const E0& E, int ctx_n_lo, int ctx_n_hi) {
    { pg8::Gemm g{A, Bt, Mbig, N, K}; pg8::StaticOrder S; S.init(Mbig, N, C.G, C.bid); EpiAdapt<E0> EA{E};
      pg8::gemm_phase<EpiAdapt<E0>, pg8::StaticOrder, true, true>(C.lds, g, S, EA); }
    if (Mbig < R && ctx_n_hi > ctx_n_lo) sgemm_small(C, A, Bt, Mbig, R - Mbig, N, K, E, ctx_n_lo, ctx_n_hi);
}
__device__ __forceinline__ void dwconv_phase(Ctx& C, int j) {
    const bf16_t* U = (const bf16_t*)(C.ws + WS_U); bf16_t* A2 = (bf16_t*)(C.ws + WS_A2);
    const float* dww = C.in[10] + (size_t)j * CK * 1024; const float* dwb = C.in[11] + j * 1024; const float* lng = C.in[12] + j * 1024; const float* lnb = C.in[13] + j * 1024;
    LAS unsigned char* tile = C.lds; LAS float* part = (LAS float*)(C.lds + 62 * 2048);
    const int tid = C.tid;
    for (int u = C.bid; u < 520; u += C.G) {
        const int base = u < 512 ? 0 : T, n = u < 512 ? T : TC, t0 = 32 * (u < 512 ? u : u - 512);
        for (int idx = tid; idx < 62 * 128; idx += 512) {
            const int rr = idx >> 7, ch = idx & 127, tt = t0 - 15 + rr;
            u32x4 v = {0u, 0u, 0u, 0u};
            if (tt >= 0 && tt < n) v = *(const u32x4*)(U + (size_t)(base + tt) * 1024 + ch * 8);
            *(LAS u32x4*)(tile + rr * 2048 + ch * 16) = v;
        }
        __syncthreads();
        float o0[32], o1[32];
        { const f32x2 b2 = *(const f32x2*)(dwb + 2 * tid);
#pragma unroll
          for (int t = 0; t < 32; ++t) { o0[t] = b2.x; o1[t] = b2.y; } }
        for (int jt = 0; jt < CK; ++jt) {
            const f32x2 w = *(const f32x2*)(dww + jt * 1024 + 2 * tid);
            const LAS unsigned char* p = tile + jt * 2048 + tid * 4;
#pragma unroll
            for (int t = 0; t < 32; ++t) { const unsigned uu = *(const LAS unsigned*)(p + t * 2048); o0[t] += w.x * bflo(uu); o1[t] += w.y * bfhi(uu); }
        }
#pragma unroll
        for (int t = 0; t < 32; ++t) {
            const float s = wave_sum63(o0[t] + o1[t]), q = wave_sum63(o0[t] * o0[t] + o1[t] * o1[t]);
            if (C.lane == 63) { part[(t * 8 + C.wave) * 2] = s; part[(t * 8 + C.wave) * 2 + 1] = q; }
        }
        __syncthreads();
        const f32x2 g2 = *(const f32x2*)(lng + 2 * tid), bb2 = *(const f32x2*)(lnb + 2 * tid);
#pragma unroll
        for (int t = 0; t < 32; ++t) {
            float s = 0.f, q = 0.f;
#pragma unroll
            for (int w = 0; w < 8; ++w) { s += part[(t * 8 + w) * 2]; q += part[(t * 8 + w) * 2 + 1]; }
            const float mean = s * (1.f / 1024.f), var = q * (1.f / 1024.f) - mean * mean, rstd = 1.0f / sqrtf(var + LN_EPS);
            const float y0 = (o0[t] - mean) * rstd * g2.x + bb2.x, y1 = (o1[t] - mean) * rstd * g2.y + bb2.y;
            *(unsigned*)(A2 + (size_t)(base + t0 + t) * 1024 + 2 * tid) = pk2(siluf(y0), siluf(y1));
        }
        __syncthreads();
    }
}

__device__ __forceinline__ void scan_phase(Ctx& C, int j) {
    const bf16_t* Kb = (const bf16_t*)(C.ws + WS_K); const bf16_t* Vt = (const bf16_t*)(C.ws + WS_VT); bf16_t* Scp = (bf16_t*)(C.ws + WS_SCP);
    constexpr int KP = 64, VP = 136;
    constexpr int KBYTES = 128 * KP * 2, VBYTES = 64 * VP * 2;
    LAS bf16_t* kbuf = (LAS bf16_t*)C.lds;
    LAS bf16_t* vbuf = (LAS bf16_t*)(C.lds + 2 * KBYTES);
    const int fr = C.lane & 15, fq = C.lane >> 4, w = C.wave, tid = C.tid;
    for (int cu = C.bid; cu < 256; cu += C.G) {
        const int hd = cu & 7, sidx = cu >> 3, h = hd >> 1, dir = hd & 1, dk_s = 64 * ((sidx >> 3) & 3), dv_s = 64 * (sidx & 7);
        const int mt = w >> 1, nh = w & 1, dkl = 16 * mt, dvl = 32 * nh;
        const float gam = 1.0f - exp2f(C.in[17][(j * 2 + dir) * 4 + h]); const float L = log2f(gam);
        const float cdec = exp2f(L * 128.f);
        const int krow = tid >> 3, kch = tid & 7, vrow = tid >> 4, vch = tid & 15;
        const int kchs = kch ^ (((krow >> 3) & 1) << 1) ^ (((krow >> 1) & 1) << 2);
        const int trq = (fr >> 2), trp = fr & 3;
        const int trrow0 = 8 * fq + trq;
        const int trcol0 = (((2 * mt + (trp >> 1)) ^ ((fq & 1) << 1) ^ (((trq >> 1) & 1) << 2)) << 3) + 4 * (trp & 1);
        const float kd0 = exp2f(L * (float)(dir == 0 ? 127 - krow : krow)), kd1 = exp2f(L * (float)(dir == 0 ? 63 - krow : krow + 64));
        const bf16_t* kg = Kb + (size_t)krow * 1024 + h * 256 + dk_s + 8 * kch;
        const bf16_t* vg = Vt + (size_t)(h * 512 + dv_s + vrow) * R + 8 * vch;
        auto tok_of = [&](int st) { const int bl = st < 2 ? (dir == 0 ? st : 1 - st) : (dir == 0 ? st - 2 : 129 - st); return (st < 2 ? T : 0) + 128 * bl; };
        f32x4 acc[2]; acc[0] = (f32x4){0.f, 0.f, 0.f, 0.f}; acc[1] = acc[0];
        u32x4 ra[4], rb[4];
#define SCAN_LOAD(dst, tok) do { dst[0] = *(const u32x4*)(kg + (size_t)(tok) * 1024); dst[1] = *(const u32x4*)(kg + (size_t)((tok) + 64) * 1024); \
        dst[2] = *(const u32x4*)(vg + (tok)); dst[3] = *(const u32x4*)(vg + (size_t)32 * R + (tok)); } while (0)
#define SCAN_STORE(src, buf) do { LAS bf16_t* kb_ = kbuf + (buf) * 128 * KP; LAS bf16_t* vb_ = vbuf + (buf) * 64 * VP; u32x4 o_; \
        o_.x = pk2(bflo(src[0].x) * kd0, bfhi(src[0].x) * kd0); o_.y = pk2(bflo(src[0].y) * kd0, bfhi(src[0].y) * kd0); o_.z = pk2(bflo(src[0].z) * kd0, bfhi(src[0].z) * kd0); o_.w = pk2(bflo(src[0].w) * kd0, bfhi(src[0].w) * kd0); \
        *(LAS u32x4*)(kb_ + krow * KP + 8 * kchs) = o_; \
        o_.x = pk2(bflo(src[1].x) * kd1, bfhi(src[1].x) * kd1); o_.y = pk2(bflo(src[1].y) * kd1, bfhi(src[1].y) * kd1); o_.z = pk2(bflo(src[1].z) * kd1, bfhi(src[1].z) * kd1); o_.w = pk2(bflo(src[1].w) * kd1, bfhi(src[1].w) * kd1); \
        *(LAS u32x4*)(kb_ + (krow + 64) * KP + 8 * kchs) = o_; \
        *(LAS u32x4*)(vb_ + vrow * VP + 8 * vch) = src[2]; *(LAS u32x4*)(vb_ + (vrow + 32) * VP + 8 * vch) = src[3]; } while (0)
        __syncthreads();
        SCAN_LOAD(ra, tok_of(0));
        SCAN_STORE(ra, 0);
        SCAN_LOAD(ra, tok_of(1));
        __syncthreads();
#define SCAN_STEP(st, RA, RB) do { \
            const int cur = (st) & 1; \
            if ((st) + 2 < 130) SCAN_LOAD(RB, tok_of((st) + 2)); \
            {   const bool isctx = (st) < 2; const int bl = isctx ? (dir == 0 ? (st) : 1 - (st)) : (dir == 0 ? (st) - 2 : 129 - (st)); \
                const bool cp = dir == 0 ? ((bl & 3) == 0) : (isctx ? bl == 1 : (bl & 3) == 3); \
                if (cp) { \
                    const int slot = isctx ? 32 : (bl >> 2); \
                    bf16_t* sp = Scp + ((size_t)((slot * 4 + h) * 2 + dir) * 512) * 256; \
                    _Pragma("unroll") for (int nt = 0; nt < 2; ++nt) { u32x2 wv; wv.x = pk2(acc[nt][0], acc[nt][1]); wv.y = pk2(acc[nt][2], acc[nt][3]); \
                        *(u32x2*)(sp + (size_t)(dv_s + dvl + 16 * nt + fr) * 256 + dk_s + dkl + 4 * fq) = wv; } \
                } } \
            acc[0] = acc[0] * cdec; acc[1] = acc[1] * cdec; \
            const LAS bf16_t* kb = kbuf + cur * 128 * KP; const LAS bf16_t* vb = vbuf + cur * 64 * VP; \
            _Pragma("unroll") for (int ks = 0; ks < 4; ++ks) { \
                const LAS bf16_t* kp = kb + (32 * ks + trrow0) * KP + trcol0; \
                const s16x4 lo4 = __builtin_amdgcn_ds_read_tr16_b64_v4i16((LAS s16x4*)kp); \
                const s16x4 hi4 = __builtin_amdgcn_ds_read_tr16_b64_v4i16((LAS s16x4*)(kp + 4 * KP)); \
                const bf16x8 af = (bf16x8){lo4[0], lo4[1], lo4[2], lo4[3], hi4[0], hi4[1], hi4[2], hi4[3]}; \
                _Pragma("unroll") for (int nt = 0; nt < 2; ++nt) { const bf16x8 vf = *(const LAS bf16x8*)(vb + (dvl + 16 * nt + fr) * VP + 32 * ks + 8 * fq); \
                    acc[nt] = __builtin_amdgcn_mfma_f32_16x16x32_bf16(af, vf, acc[nt], 0, 0, 0); } \
            } \
            if ((st) + 1 < 130) SCAN_STORE(RA, cur ^ 1); \
            __syncthreads(); \
        } while (0)
#pragma unroll 1
        for (int st2 = 0; st2 < 130; st2 += 2) { SCAN_STEP(st2, ra, rb); SCAN_STEP(st2 + 1, rb, ra); }
#undef SCAN_STEP
#undef SCAN_LOAD
#undef SCAN_STORE
    }
}

template <int PV = 0>
__device__ __forceinline__ void readout_phase(Ctx& C, int j, bool skip_ctx) {
    const bf16_t* Q = (const bf16_t*)(C.ws + WS_Q); const bf16_t* Kb = (const bf16_t*)(C.ws + WS_K); const bf16_t* Vt = (const bf16_t*)(C.ws + WS_VT);
    const bf16_t* Scp = (const bf16_t*)(C.ws + WS_SCP); bf16_t* GF = (bf16_t*)(C.ws + WS_GF); const bf16_t* GB = (const bf16_t*)(C.ws + WS_GB);
    constexpr int QP = 264, PP = 136;
    LAS bf16_t* Qs = (LAS bf16_t*)C.lds;
    LAS bf16_t* Pb = (LAS bf16_t*)(C.lds + 64 * QP * 2);
    LAS float* red = (LAS float*)(C.lds + 64 * QP * 2 + 2 * 64 * PP * 2);
    const int w = C.wave, tid = C.tid;
    const int nunits = skip_ctx ? 1024 : 1040;
    for (int u0 = C.bid; u0 < nunits; u0 += C.G) {
        int h, b, rh;
        if (C.G == 256 && u0 < 1024) { const int r = u0 >> 8, x = u0 & 7, idx = (u0 & 255) >> 3, grp = r * 32 + x * 4 + (idx >> 3); h = grp & 3; b = (grp >> 2) * 4 + ((idx >> 1) & 3); rh = idx & 1; }
        else { rh = u0 & 1; h = (u0 >> 1) & 3; b = u0 >> 3; }
        const bool lat = b < 128; const int base = lat ? 0 : T, nb = lat ? 128 : 2, bl = lat ? b : b - 128;
        const int g = bl >> 2, slot = lat ? g : 32;
        const int gend = (4 * (g + 1) < nb ? 4 * (g + 1) : nb);
        {
            const int i0 = base + 128 * bl + 64 * rh, il0 = 128 * bl + 64 * rh;
#pragma unroll
            for (int i = 0; i < 4; ++i) { const int c = tid + 512 * i, row = c >> 5, ch = c & 31;
                *(LAS u32x4*)(Qs + row * QP + 8 * ch) = *(const u32x4*)(Q + (size_t)(i0 + row) * 1024 + h * 256 + 8 * ch); }
            __syncthreads();
#pragma unroll 1
            for (int dir = 0; dir < 2; ++dir) {
                int lane_o = C.lane; asm volatile("" : "+v"(lane_o));
                const int fr = lane_o & 15, fq = lane_o >> 4;
                const float gam = 1.0f - exp2f(C.in[17][(j * 2 + dir) * 4 + h]); const float L = log2f(gam);
                f32x4 acc[4][4];
#pragma unroll
                for (int mt = 0; mt < 4; ++mt)
#pragma unroll
                    for (int nt = 0; nt < 4; ++nt) acc[mt][nt] = (f32x4){0.f, 0.f, 0.f, 0.f};
                const int kb_lo = dir == 0 ? 4 * g : bl, kb_hi = dir == 0 ? bl : gend - 1;
                bf16x8 kf[8];
                { const bf16_t* k1 = Kb + (size_t)(base + 128 * kb_lo + 16 * w + fr) * 1024 + h * 256 + 8 * fq;
#pragma unroll
                  for (int ks = 0; ks < 8; ++ks) kf[ks] = *(const bf16x8*)(k1 + 32 * ks); }
                const bf16_t* sb = Scp + ((size_t)((slot * 4 + h) * 2 + dir) * 512) * 256 + (size_t)(64 * w + 16 * (fr >> 2) + (fr & 3)) * 256 + 8 * fq;
#pragma unroll
                for (int half = 0; half < (PV == 3 ? 0 : 4); ++half) {
                    bf16x8 sf[2][4];
#pragma unroll
                    for (int k4 = 0; k4 < 2; ++k4)
#pragma unroll
                        for (int nt = 0; nt < 4; ++nt) sf[k4][nt] = *(const bf16x8*)(sb + (size_t)(4 * nt) * 256 + 32 * (2 * half + k4));
#pragma unroll
                    for (int k4 = 0; k4 < 2; ++k4)
#pragma unroll
                        for (int mt = 0; mt < 4; ++mt) { const bf16x8 qf = *(const LAS bf16x8*)(Qs + (16 * mt + fr) * QP + 32 * (2 * half + k4) + 8 * fq);
#pragma unroll
                            for (int nt = 0; nt < 4; ++nt) acc[mt][nt] = __builtin_amdgcn_mfma_f32_16x16x32_bf16(sf[k4][nt], qf, acc[mt][nt], 0, 0, 0); }
                }
#pragma unroll
                for (int mt = 0; mt < 4; ++mt) {
                    const int il = il0 + 16 * mt + fr;
                    const int ex = dir == 0 ? il - 512 * g + 1 : gend * 128 - il;
                    const float qd = __builtin_amdgcn_exp2f(L * (float)ex);
#pragma unroll
                    for (int nt = 0; nt < 4; ++nt) acc[mt][nt] = acc[mt][nt] * qd;
                }
                int pbuf = 0;
                __builtin_amdgcn_sched_barrier(0);
#pragma unroll 1
                for (int kb = kb_lo; kb <= (PV == 2 ? kb_lo - 1 : kb_hi); ++kb) {
                    const int j0 = base + 128 * kb;
                    bf16x8 vf[4][4];
                    const bf16_t* vb = Vt + (size_t)(h * 512 + 64 * w + 16 * (fr >> 2) + (fr & 3)) * R + j0 + 8 * fq;
#pragma unroll
                    for (int ks = 0; ks < 2; ++ks)
#pragma unroll
                        for (int nt = 0; nt < 4; ++nt) vf[ks][nt] = *(const bf16x8*)(vb + (size_t)(4 * nt) * R + 32 * ks);
                    f32x4 sc[4];
#pragma unroll
                    for (int mt = 0; mt < 4; ++mt) sc[mt] = (f32x4){0.f, 0.f, 0.f, 0.f};
#pragma unroll
                    for (int ks = 0; ks < 8; ++ks) {
#pragma unroll
                        for (int mt = 0; mt < 4; ++mt) { const bf16x8 qf = *(const LAS bf16x8*)(Qs + (16 * mt + fr) * QP + 32 * ks + 8 * fq);
                            sc[mt] = __builtin_amdgcn_mfma_f32_16x16x32_bf16(kf[ks], qf, sc[mt], 0, 0, 0); }
                        if (ks & 1) __builtin_amdgcn_sched_barrier(0);
                    }
                    if (kb < kb_hi) { const bf16_t* k1 = Kb + (size_t)(j0 + 128 + 16 * w + fr) * 1024 + h * 256 + 8 * fq;
#pragma unroll
                        for (int ks = 0; ks < 8; ++ks) kf[ks] = *(const bf16x8*)(k1 + 32 * ks); }
#pragma unroll
                    for (int ks = 2; ks < 4; ++ks)
#pragma unroll
                        for (int nt = 0; nt < 4; ++nt) vf[ks][nt] = *(const bf16x8*)(vb + (size_t)(4 * nt) * R + 32 * ks);
                    LAS bf16_t* P = Pb + pbuf * 64 * PP;
#pragma unroll
                    for (int mt = 0; mt < 4; ++mt) {
                        const int il = il0 + 16 * mt + fr;
                        float p[4];
#pragma unroll
                        for (int e = 0; e < 4; ++e) { const int jl = 128 * kb + 16 * w + 4 * fq + e; const int rel = dir == 0 ? il - jl : jl - il;
                            p[e] = rel >= 0 ? sc[mt][e] * __builtin_amdgcn_exp2f(L * (float)rel) : 0.f; }
                        u32x2 wv; wv.x = pk2(p[0], p[1]); wv.y = pk2(p[2], p[3]);
                        *(LAS u32x2*)(P + (16 * mt + fr) * PP + 16 * w + 4 * fq) = wv;
                    }
                    __syncthreads();
#pragma unroll
                    for (int ks = 0; ks < 4; ++ks)
#pragma unroll
                        for (int mt = 0; mt < 4; ++mt) { const bf16x8 pf = *(const LAS bf16x8*)(P + (16 * mt + fr) * PP + 32 * ks + 8 * fq);
#pragma unroll
                            for (int nt = 0; nt < 4; ++nt) acc[mt][nt] = __builtin_amdgcn_mfma_f32_16x16x32_bf16(vf[ks][nt], pf, acc[mt][nt], 0, 0, 0); }
                    pbuf ^= 1;
                    __builtin_amdgcn_sched_barrier(0);
                }
                __builtin_amdgcn_sched_barrier(0);
#pragma unroll
                for (int mt = 0; mt < 4; ++mt) {
                    float ss = 0.f;
#pragma unroll
                    for (int nt = 0; nt < 4; ++nt) ss += (acc[mt][nt][0] * acc[mt][nt][0] + acc[mt][nt][1] * acc[mt][nt][1]) + (acc[mt][nt][2] * acc[mt][nt][2] + acc[mt][nt][3] * acc[mt][nt][3]);
                    ss += __shfl_xor(ss, 16); ss += __shfl_xor(ss, 32);
                    if (fq == 0) red[(16 * mt + fr) * 8 + w] = ss;
                }
                __syncthreads();
#pragma unroll
                for (int mt = 0; mt < 4; ++mt) {
                    float tot = 0.f;
#pragma unroll
                    for (int w2 = 0; w2 < 8; ++w2) tot += red[(16 * mt + fr) * 8 + w2];
                    const float rn = 1.0f / sqrtf(tot * (1.f / 512.f) + NORM_EPS);
                    const size_t off = (size_t)(i0 + 16 * mt + fr) * 2048 + h * 512 + 64 * w + 16 * fq;
#pragma unroll
                    for (int np = 0; np < (PV == 4 ? 0 : 2); ++np) {
                        const u32x4 g4 = *(const u32x4*)((dir == 0 ? (const bf16_t*)GF : GB) + off + 8 * np);
                        float y[8];
                        y[0] = siluf(bflo(g4.x)) * acc[mt][2 * np][0] * rn; y[1] = siluf(bfhi(g4.x)) * acc[mt][2 * np][1] * rn;
                        y[2] = siluf(bflo(g4.y)) * acc[mt][2 * np][2] * rn; y[3] = siluf(bfhi(g4.y)) * acc[mt][2 * np][3] * rn;
                        y[4] = siluf(bflo(g4.z)) * acc[mt][2 * np + 1][0] * rn; y[5] = siluf(bfhi(g4.z)) * acc[mt][2 * np + 1][1] * rn;
                        y[6] = siluf(bflo(g4.w)) * acc[mt][2 * np + 1][2] * rn; y[7] = siluf(bfhi(g4.w)) * acc[mt][2 * np + 1][3] * rn;
                        if (dir == 1) { const u32x4 yp = *(const u32x4*)(GF + off + 8 * np);
                            y[0] += bflo(yp.x); y[1] += bfhi(yp.x); y[2] += bflo(yp.y); y[3] += bfhi(yp.y); y[4] += bflo(yp.z); y[5] += bfhi(yp.z); y[6] += bflo(yp.w); y[7] += bfhi(yp.w); }
                        u32x4 wv; wv.x = pk2(y[0], y[1]); wv.y = pk2(y[2], y[3]); wv.z = pk2(y[4], y[5]); wv.w = pk2(y[6], y[7]);
                        *(u32x4*)(GF + off + 8 * np) = wv;
                    }
                }
            }
        }
    }
}

__device__ __forceinline__ void phase_p0(Ctx& C) {
    float* modv = (float*)(C.ws + WS_MODV);
    for (int u = C.bid; u < 384; u += C.G) {
        const int i = u / 96, nbk = u % 96;
        gemv2_unit<1>(C, C.in[4] + (size_t)i * 1024 * 6144, 6144, 64 * nbk, C.in[1], C.in[3], C.in[5] + i * 6144, modv + (i * 2 + 0) * 6144, modv + (i * 2 + 1) * 6144, 0, 0);
    }
    float* tabc = (float*)(C.ws + WS_TABC); float* tabs = (float*)(C.ws + WS_TABS);
    for (int idx = C.bid * 512 + C.tid; idx < 320 * 64; idx += C.G * 512) {
        const int ti = idx >> 6, i = idx & 63; const float pos = (float)(ti < 256 ? ti : ti - 256);
        const float inv = exp2f(-(float)i * (13.287712379549449f / 64.0f)); const float ang = pos * inv;
        tabc[idx] = __cosf(ang); tabs[idx] = __sinf(ang);
    }
}
__device__ __forceinline__ void phase_p1(Ctx& C) {
    const float* modv = (const float*)(C.ws + WS_MODV);
    float* s1 = (float*)(C.ws + WS_S1); float* s2 = (float*)(C.ws + WS_S2);
    for (int idx = C.bid * 512 + C.tid; idx < 8192; idx += C.G * 512) {
        const int i = idx >> 11, s = (idx >> 10) & 1, k = idx & 1023;
        s1[idx] = C.in[6][i * 1024 + k] * (1.f + modv[(i * 2 + s) * 6144 + 1024 + k]);
        s2[idx] = C.in[7][i * 1024 + k] * (1.f + modv[(i * 2 + s) * 6144 + 4096 + k]);
    }
    float* cvA = (float*)(C.ws + WS_CVA); float* cvF = (float*)(C.ws + WS_CVF);
    for (int u = C.bid; u < 672; u += C.G) {
        if (u < 320) {
            int i, nbk; if (u < 32) { i = 0; nbk = u; } else if (u < 160) { i = 1; nbk = u - 32; } else if (u < 192) { i = 2; nbk = u - 160; } else { i = 3; nbk = u - 192; }
            const int j = i >> 1; const float* v0 = modv + (i * 2 + 0) * 6144; const float* v1 = modv + (i * 2 + 1) * 6144;
            if ((i & 1) == 0) gemv2_unit<0>(C, C.in[8] + (size_t)j * 1024 * 2048, 2048, 64 * nbk, v0, v1, C.in[9] + j * 2048, cvA + (i * 2) * 8192, cvA + (i * 2 + 1) * 8192, 1, 1024);
            else gemv2_unit<0>(C, C.in[16] + (size_t)j * 1024 * 8192, 8192, 64 * nbk, v0, v1, nullptr, cvA + (i * 2) * 8192, cvA + (i * 2 + 1) * 8192, 2, 0);
        } else {
            const int i = (u - 320) / 88, nbk = (u - 320) % 88;
            const float* v0 = modv + (i * 2 + 0) * 6144 + 3072; const float* v1 = modv + (i * 2 + 1) * 6144 + 3072;
            gemv2_unit<0>(C, C.in[19] + (size_t)i * 1024 * FF2, FF2, 64 * nbk, v0, v1, nullptr, cvF + (i * 2) * FF2, cvF + (i * 2 + 1) * FF2, 1, DFF);
        }
    }
    bf16_t* xs = (bf16_t*)(C.ws + WS_XS); float* stats = (float*)(C.ws + WS_STATS); float* xctx = (float*)(C.ws + WS_XCTX);
    for (int row = C.bid * 8 + C.wave; row < R; row += C.G * 8) {
        const bool lat = row < T; const int s = lat ? 0 : 1;
        const float* src = lat ? C.in[0] + (size_t)row * 1024 : C.in[2] + (size_t)(row - T) * 1024;
        float* dst = lat ? C.out + (size_t)row * 1024 : xctx + (size_t)(row - T) * 1024;
        float ss = 0.f;
#pragma unroll
        for (int jj = 0; jj < 4; ++jj) {
            const int k = 4 * C.lane + 256 * jj;
            const f32x4 v = *(const f32x4*)(src + k); *(f32x4*)(dst + k) = v;
            ss += (v[0] * v[0] + v[1] * v[1]) + (v[2] * v[2] + v[3] * v[3]);
            const f32x4 g = *(const f32x4*)(C.in[6] + k), m = *(const f32x4*)(modv + s * 6144 + 1024 + k);
            u32x2 w; w.x = pk2(v[0] * g[0] * (1.f + m[0]), v[1] * g[1] * (1.f + m[1])); w.y = pk2(v[2] * g[2] * (1.f + m[2]), v[3] * g[3] * (1.f + m[3]));
            *(u32x2*)(xs + (size_t)row * 1024 + k) = w;
        }
#pragma unroll
        for (int off = 1; off < 64; off <<= 1) ss += __shfl_xor(ss, off);
        if (C.lane < 16) stats[(size_t)row * 16 + C.lane] = C.lane == 0 ? ss : 0.f;
    }
    prep_layer(C, 0);
}
__device__ __forceinline__ void phase_final(Ctx& C) {
    const float* stats = (const float*)(C.ws + WS_STATS);
    for (int row = C.bid * 8 + C.wave; row < T; row += C.G * 8) {
        float s = C.lane < 16 ? stats[(size_t)row * 16 + C.lane] : 0.f;
#pragma unroll
        for (int off = 1; off < 64; off <<= 1) s += __shfl_xor(s, off);
        const float r = 1.0f / sqrtf(s * (1.f / 1024.f) + NORM_EPS);
        float* xr = C.out + (size_t)row * 1024;
#pragma unroll
        for (int jj = 0; jj < 4; ++jj) { const int k = 4 * C.lane + 256 * jj; const f32x4 v = *(const f32x4*)(xr + k), g = *(const f32x4*)(C.in[21] + k); *(f32x4*)(xr + k) = v * r * g; }
    }
}

constexpr int NPHASE = 31;
__device__ __forceinline__ void run_phase(Ctx& C, int ph) {
    const int i = (ph - 2) / 7, sub = (ph - 2) % 7, j = i >> 1; const bool conv = (i & 1) == 0;
    const bool last = i == DEPTH - 1;
    float* stats = (float*)(C.ws + WS_STATS);
    const bf16_t* xs = (const bf16_t*)(C.ws + WS_XS);
    constexpr int F_MODV = (int)(WS_MODV / 4), F_S1 = (int)(WS_S1 / 4), F_S2 = (int)(WS_S2 / 4), F_CVA = (int)(WS_CVA / 4), F_CVF = (int)(WS_CVF / 4);
    if (sub == 1) {
        if (conv) { EpiGLU E{C.ws, F_CVA + (i * 2) * 8192, 8192, (int)WS_U, 1024, 0, stats}; gemm_both(C, xs, (const bf16_t*)(C.ws + WS_WA), T, 2048, 1024, E, 0, 8); }
        else { EpiWin E{C.ws, F_CVA + (i * 2) * 8192, stats}; gemm_both(C, xs, (const bf16_t*)(C.ws + WS_WA), T, 8192, 1024, E, last ? 4 : 0, last ? 16 : 32); }
    } else if (sub == 5) {
        EpiGLU E{C.ws, F_CVF + (i * 2) * FF2, FF2, (int)WS_H, DFF, 1, stats}; gemm_both(C, xs, (const bf16_t*)(C.ws + WS_WF1), last ? T : R, FF2, 1024, E, 0, 0);
    } else {
        const bool f2 = sub == 6;
        const int mgoff = F_MODV + (i * 2) * 6144 + (f2 ? 5120 : 2048);
        const int snoff = f2 ? (last ? -1 : F_S1 + ((i + 1) * 2) * 1024) : F_S2 + (i * 2) * 1024;
        const float* bias = (!f2 && conv) ? C.in[15] + j * 1024 : nullptr;
        const bf16_t* A = (const bf16_t*)(C.ws + (f2 ? WS_H : (conv ? WS_A2 : WS_GF)));
        const bf16_t* Bt = (const bf16_t*)(C.ws + (f2 ? WS_WF2 : WS_WA2));
        const int K = f2 ? DFF : (conv ? 1024 : 2048);
        EpiRes E{C.ws, C.out, bias, mgoff, snoff, stats};
        gemm_both(C, A, Bt, T, 1024, K, E, 0, last ? 0 : 4);
    }
}

#define XB_TMO      128
#define XB_XCNT(j)  (256  + 64 * (j))
#define XB_XSUB(j)  (1280 + 64 * (j))
#define XB_XGEN(j)  (2304 + 64 * (j))
#define XB_TOP      3328
#define XB_TOPGEN   3392
#define XCD_BAR_WORDS 3456
#define XB_SPIN_CAP (1u << 20)
__device__ __forceinline__ unsigned xb_ld(unsigned* p)              { return __hip_atomic_load(p, __ATOMIC_RELAXED, __HIP_MEMORY_SCOPE_AGENT); }
__device__ __forceinline__ unsigned xb_add(unsigned* p, unsigned v) { return __hip_atomic_fetch_add(p, v, __ATOMIC_RELAXED, __HIP_MEMORY_SCOPE_AGENT); }
__device__ __forceinline__ unsigned xb_xcc_id() { return (unsigned)__builtin_amdgcn_s_getreg((3 << 11) | 20) & 0xFu; }
#define XB_SPIN(cond, bar) do { unsigned _sp = 0; while (cond) { __builtin_amdgcn_s_sleep(1); \
    if ((++_sp & 255u) == 0u) { if (xb_ld(&(bar)[XB_TMO])) break; if (_sp > XB_SPIN_CAP) { atomicAdd(&(bar)[XB_TMO], 1u); break; } } } } while (0)
struct XcdBarrier { unsigned* bar; unsigned x; volatile LAS unsigned* st; };
__device__ __forceinline__ XcdBarrier xcd_barrier_post(unsigned* bar, volatile LAS unsigned* st) {
    XcdBarrier b; b.bar = bar; b.x = xb_xcc_id(); b.st = st;
    if (threadIdx.x == 0) (void)xb_add(&bar[XB_XCNT(b.x)], 1u);
    return b;
}
__device__ __forceinline__ void xcd_barrier_complete(unsigned* bar, unsigned x, unsigned& nloc, unsigned& nx) {
    const unsigned G = gridDim.x * gridDim.y * gridDim.z;
    unsigned sum, cnt, mine, sp = 0u;
    for (;;) {
        sum = 0u; cnt = 0u; mine = 0u;
#pragma unroll
        for (unsigned j = 0; j < 16; ++j) { const unsigned c = xb_ld(&bar[XB_XCNT(j)]); sum += c; cnt += (c > 0u) ? 1u : 0u; mine = (j == x) ? c : mine; }
        if (sum == G) break;
        __builtin_amdgcn_s_sleep(1);
        if ((++sp & 255u) == 0u) { if (xb_ld(&bar[XB_TMO])) break; if (sp > XB_SPIN_CAP) { atomicAdd(&bar[XB_TMO], 1u); break; } }
    }
    nloc = mine > 0u ? mine : 1u; nx = cnt > 0u ? cnt : 1u;
}
__device__ __forceinline__ void xcd_barrier(const XcdBarrier& b) {
    asm volatile("s_waitcnt vmcnt(0)" ::: "memory");
    __syncthreads();
    if (threadIdx.x == 0) {
        unsigned* bar = b.bar;
        __builtin_amdgcn_s_waitcnt(0);
        unsigned nloc = b.st[0], nx = b.st[1];
        if (nloc == 0u) { xcd_barrier_complete(bar, b.x, nloc, nx); b.st[0] = nloc; b.st[1] = nx; }
        const unsigned old = xb_add(&bar[XB_XSUB(b.x)], 1u);
        const unsigned gen = old / nloc;
        if (old + 1u == (gen + 1u) * nloc) {
            __builtin_amdgcn_fence(__ATOMIC_RELEASE, "agent");
            asm volatile("s_waitcnt vmcnt(0)" ::: "memory");
            const unsigned og = xb_add(&bar[XB_TOP], 1u);
            const unsigned tg = og / nx;
            if (og + 1u == (tg + 1u) * nx) xb_add(&bar[XB_TOPGEN], 1u);
            else XB_SPIN(xb_ld(&bar[XB_TOPGEN]) == tg, bar);
            __builtin_amdgcn_fence(__ATOMIC_ACQUIRE, "agent");
            xb_add(&bar[XB_XGEN(b.x)], 1u);
            asm volatile("s_waitcnt vmcnt(0)" ::: "memory");
        } else {
            XB_SPIN(xb_ld(&bar[XB_XGEN(b.x)]) == gen, bar);
            __builtin_amdgcn_fence(__ATOMIC_ACQUIRE, "agent");
            asm volatile("s_waitcnt vmcnt(0)" ::: "memory");
        }
    }
    __syncthreads();
}
constexpr int MISC_OFF = 131072 + 320;
constexpr int CW_BAR = 4096;

#ifndef PROBE_DUP
#define PROBE_DUP 0
#endif
#if ONE_LAUNCH
template <int PH> __device__ __forceinline__ void phase_body(Ctx& C) {
    constexpr int i = (PH - 2) / 7, sub = (PH - 2) % 7, j = i >> 1; constexpr bool conv = (i & 1) == 0;
    if (PH == 0) phase_p0(C);
    else if (PH == 1) phase_p1(C);
    else if (PH == 30) phase_final(C);
    else if (sub == 0) prep_layer(C, i);
    else if (sub == 2) { if (conv) dwconv_phase(C, j); else scan_phase(C, j); }
    else if (sub == 3) readout_phase(C, j, i == DEPTH - 1);
    else run_phase(C, PH);
}
template <int PH> __device__ __forceinline__ void one_phase(Ctx& C, const Args& args, const XcdBarrier& bar) {
    if (PH < args.ph_lo || PH >= args.ph_hi) return;
    constexpr int i = (PH - 2) / 7, sub = (PH - 2) % 7; constexpr bool conv = (i & 1) == 0;
    if (PH >= 2 && PH < 30) { if (sub == 0 && i == 0) return; if (sub == 3 && conv) return; }
    if (PH > args.ph_lo) xcd_barrier(bar);
    phase_body<PH>(C);
    constexpr bool dup = ((PH >= 2 && PH < 30) && (((PROBE_DUP & 1) && (sub == 1 || sub == 5)) || ((PROBE_DUP & 2) && sub == 2 && !conv) || ((PROBE_DUP & 4) && sub == 2 && conv) || ((PROBE_DUP & 8) && sub == 0))) || ((PROBE_DUP & 16) && PH < 2);
    if constexpr (dup) { xcd_barrier(bar); phase_body<PH>(C); }
}
template <int... PHS> __device__ __forceinline__ void all_phases(Ctx& C, const Args& args, const XcdBarrier& bar, std::integer_sequence<int, PHS...>) { (one_phase<PHS>(C, args, bar), ...); }
__global__ void __launch_bounds__(512, 2) mega_kernel(Args args) {
    extern __shared__ __attribute__((aligned(16))) unsigned char lds_raw[];
    Ctx C;
    C.lds = (LAS unsigned char*)lds_raw; C.tid = threadIdx.x; C.lane = C.tid & 63; C.wave = __builtin_amdgcn_readfirstlane(C.tid >> 6); C.G = gridDim.x; C.bid = blockIdx.x;
    C.in = args.in; C.out = args.out; C.ws = args.ws;
    volatile LAS unsigned* MISC = (volatile LAS unsigned*)(C.lds + MISC_OFF);
    if (C.tid < 32) MISC[C.tid] = 0u;
    __syncthreads();
    XcdBarrier bar = xcd_barrier_post((unsigned*)(C.ws + WS_CTL) + CW_BAR, MISC + 8);
    all_phases(C, args, bar, std::make_integer_sequence<int, NPHASE>{});
}

#endif
template <int KIND>
__global__ void __launch_bounds__(512, 2) phase_kernel(Args args) {
    extern __shared__ __attribute__((aligned(16))) unsigned char lds_raw[];
    Ctx C;
    C.lds = (LAS unsigned char*)lds_raw; C.tid = threadIdx.x; C.lane = C.tid & 63; C.wave = __builtin_amdgcn_readfirstlane(C.tid >> 6); C.G = gridDim.x; C.bid = blockIdx.x;
    C.in = args.in; C.out = args.out; C.ws = args.ws;
    const int ph = args.ph_lo;
    if (KIND == 0) phase_p0(C);
    else if (KIND == 1) phase_p1(C);
    else if (KIND == 30) phase_final(C);
    else {
        const int i = (ph - 2) / 7, j = i >> 1; const bool conv = (i & 1) == 0;
        if (KIND == 2) prep_layer(C, i);
        else if (KIND == 4) { if (conv) dwconv_phase(C, j); else scan_phase(C, j); }
        else if (KIND == 5) readout_phase(C, j, i == DEPTH - 1);
        else run_phase(C, ph);
    }
}

#ifndef PROBE_RD
#define PROBE_RD 0
#endif
#if PROBE_RD
__global__ void __launch_bounds__(512, 2) probe_read_kernel(Args args) {
    extern __shared__ __attribute__((aligned(16))) unsigned char lds_raw[];
    Ctx C;
    C.lds = (LAS unsigned char*)lds_raw; C.tid = threadIdx.x; C.lane = C.tid & 63; C.wave = __builtin_amdgcn_readfirstlane(C.tid >> 6); C.G = gridDim.x; C.bid = blockIdx.x;
    C.in = args.in; C.out = args.out; C.ws = args.ws;
    readout_phase<PROBE_RD>(C, 1, true);
}
#endif
extern "C" void kernel_launch(void* const* d_in, const int* in_sizes, int n_in, void* d_out, int out_size, void* d_ws, size_t ws_size, hipStream_t stream) {
    static int grid = 0;
    if (grid == 0) {
        if (n_in != 22 || out_size != T * D || ws_size < WS_END + (PROBE_RD ? 20 * MiB : 0)) { fprintf(stderr, "kernel_launch: unexpected problem (n_in %d out %d ws %zu, need %zu)\n", n_in, out_size, ws_size, (size_t)WS_END); grid = -1; return; }
        int dev = 0, cus = 0;
        if (hipGetDevice(&dev) != hipSuccess || hipDeviceGetAttribute(&cus, hipDeviceAttributeMultiprocessorCount, dev) != hipSuccess) { grid = -1; return; }
        bool ok = true;
        ok &= hipFuncSetAttribute((const void*)phase_kernel<0>, hipFuncAttributeMaxDynamicSharedMemorySize, LDS_BYTES) == hipSuccess;
        ok &= hipFuncSetAttribute((const void*)phase_kernel<1>, hipFuncAttributeMaxDynamicSharedMemorySize, LDS_BYTES) == hipSuccess;
        ok &= hipFuncSetAttribute((const void*)phase_kernel<2>, hipFuncAttributeMaxDynamicSharedMemorySize, LDS_BYTES) == hipSuccess;
        ok &= hipFuncSetAttribute((const void*)phase_kernel<3>, hipFuncAttributeMaxDynamicSharedMemorySize, LDS_BYTES) == hipSuccess;
        ok &= hipFuncSetAttribute((const void*)phase_kernel<4>, hipFuncAttributeMaxDynamicSharedMemorySize, LDS_BYTES) == hipSuccess;
        ok &= hipFuncSetAttribute((const void*)phase_kernel<5>, hipFuncAttributeMaxDynamicSharedMemorySize, LDS_BYTES) == hipSuccess;
        ok &= hipFuncSetAttribute((const void*)phase_kernel<30>, hipFuncAttributeMaxDynamicSharedMemorySize, LDS_BYTES) == hipSuccess;
#if ONE_LAUNCH
        ok &= hipFuncSetAttribute((const void*)mega_kernel, hipFuncAttributeMaxDynamicSharedMemorySize, LDS_BYTES) == hipSuccess;
#endif
        if (!ok) { fprintf(stderr, "kernel_launch: hipFuncSetAttribute failed\n"); grid = -1; return; }
        grid = cus > 0 ? cus : 256;
    }
    if (grid < 0) return;
    Args a{};
    for (int i = 0; i < 22; ++i) a.in[i] = (const float*)d_in[i];
    a.out = (float*)d_out; a.ws = (unsigned char*)d_ws;
#if ONE_LAUNCH
    if (hipMemsetAsync((char*)d_ws + WS_CTL, 0, 65536, stream) != hipSuccess) { fprintf(stderr, "kernel_launch: memset failed\n"); return; }
    a.ph_lo = 0; a.ph_hi = NPHASE;
    hipLaunchKernelGGL(mega_kernel, dim3(grid), dim3(512), LDS_BYTES, stream, a);
    return;
#endif
    for (int ph = 0; ph < NPHASE; ++ph) {
        const int i = (ph - 2) / 7, sub = (ph - 2) % 7;
        if (ph >= 2 && ph < 30) { if (sub == 0 && i == 0) continue; if (sub == 3 && (i & 1) == 0) continue; }
        a.ph_lo = ph; a.ph_hi = ph + 1;
        const dim3 g(grid), b(512);
        if (ph == 0) hipLaunchKernelGGL(phase_kernel<0>, g, b, LDS_BYTES, stream, a);
        else if (ph == 1) hipLaunchKernelGGL(phase_kernel<1>, g, b, LDS_BYTES, stream, a);
        else if (ph == 30) hipLaunchKernelGGL(phase_kernel<30>, g, b, LDS_BYTES, stream, a);
        else if (sub == 0) hipLaunchKernelGGL(phase_kernel<2>, g, b, LDS_BYTES, stream, a);
        else if (sub == 2) hipLaunchKernelGGL(phase_kernel<4>, g, b, LDS_BYTES, stream, a);
        else if (sub == 3) hipLaunchKernelGGL(phase_kernel<5>, g, b, LDS_BYTES, stream, a);
        else hipLaunchKernelGGL(phase_kernel<3>, g, b, LDS_BYTES, stream, a);
#if PROBE_RD
        if (ph == 30) { hipFuncSetAttribute((const void*)probe_read_kernel, hipFuncAttributeMaxDynamicSharedMemorySize, LDS_BYTES); hipLaunchKernelGGL(probe_read_kernel, g, b, LDS_BYTES, stream, a); }
#endif
        {   const bool conv = (i & 1) == 0;
            const bool dup = ((ph >= 2 && ph < 30) && (((PROBE_DUP & 1) && (sub == 1 || sub == 5)) || ((PROBE_DUP & 2) && sub == 2 && !conv) || ((PROBE_DUP & 4) && sub == 2 && conv) || ((PROBE_DUP & 8) && sub == 0))) || ((PROBE_DUP & 16) && ph < 2);
            if (dup) {
                if (ph == 0) hipLaunchKernelGGL(phase_kernel<0>, g, b, LDS_BYTES, stream, a);
                else if (ph == 1) hipLaunchKernelGGL(phase_kernel<1>, g, b, LDS_BYTES, stream, a);
                else if (sub == 0) hipLaunchKernelGGL(phase_kernel<2>, g, b, LDS_BYTES, stream, a);
                else if (sub == 2) hipLaunchKernelGGL(phase_kernel<4>, g, b, LDS_BYTES, stream, a);
                else hipLaunchKernelGGL(phase_kernel<3>, g, b, LDS_BYTES, stream, a);
            } }
    }
}
```

```cpp
#include <hip/hip_runtime.h>
#include <cstdio>
#include <cstdint>
#include <utility>

#ifndef ONE_LAUNCH
#define ONE_LAUNCH 1
#endif

typedef unsigned short bf16_t;
typedef short bf16x8 __attribute__((ext_vector_type(8)));
typedef float f32x4 __attribute__((ext_vector_type(4)));
typedef float f32x2 __attribute__((ext_vector_type(2)));
typedef unsigned u32x2 __attribute__((ext_vector_type(2)));
typedef unsigned u32x4 __attribute__((ext_vector_type(4)));
typedef __bf16 bf16x2_t __attribute__((ext_vector_type(2)));
typedef short s16x4 __attribute__((ext_vector_type(4)));
#define LAS __attribute__((address_space(3)))

constexpr int D = 1024, T = 16384, TC = 256, R = T + TC, NH = 4, DK = 256, DV = 512, QKW = 1024, VW = 2048, INW = 8192, DFF = 2816, FF2 = 5632, CK = 31, DEPTH = 4;
constexpr int NSLOT = 33;
constexpr float NORM_EPS = 1e-6f, LN_EPS = 1e-5f;

constexpr size_t MiB = 1u << 20, KiB = 1u << 10;
constexpr size_t WS_CTL = 0, CTL_ZERO_BYTES = 1 * MiB;
constexpr size_t WS_MODV = 1 * MiB;
constexpr size_t WS_S1 = 1 * MiB + 256 * KiB;
constexpr size_t WS_S2 = 1 * MiB + 320 * KiB;
constexpr size_t WS_CVA = 1 * MiB + 384 * KiB;
constexpr size_t WS_CVF = 1 * MiB + 640 * KiB;
constexpr size_t WS_TABC = 1 * MiB + 832 * KiB;
constexpr size_t WS_TABS = 1 * MiB + 912 * KiB;
constexpr size_t WS_STATS = 2 * MiB;
constexpr size_t WS_XCTX = 4 * MiB;
constexpr size_t WS_WA = 8 * MiB;
constexpr size_t WS_WA2 = 24 * MiB;
constexpr size_t WS_WF1 = 28 * MiB;
constexpr size_t WS_WF2 = 40 * MiB;
constexpr size_t WS_XS = 48 * MiB;
constexpr size_t WS_SCP = 48 * MiB;
constexpr size_t WS_BIG = 114 * MiB;
constexpr size_t WS_Q = WS_BIG, WS_K = WS_BIG + 33 * MiB, WS_VT = WS_BIG + 66 * MiB, WS_GF = WS_BIG + 131 * MiB, WS_GB = WS_BIG + 196 * MiB;
constexpr size_t WS_U = WS_BIG, WS_A2 = WS_BIG + 33 * MiB, WS_H = WS_BIG;
constexpr size_t WS_END = WS_BIG + 261 * MiB;
static_assert((size_t)R * 1024 * 2 <= 33 * MiB && (size_t)R * 2048 * 2 <= 65 * MiB && (size_t)R * DFF * 2 <= 131 * MiB, "map");
static_assert((size_t)NSLOT * 8 * 512 * 256 * 2 <= 66 * MiB, "scp");

constexpr int LDS_BYTES = 147456;

__device__ __forceinline__ unsigned pk2(float lo, float hi) { f32x2 v = {lo, hi}; bf16x2_t b = __builtin_convertvector(v, bf16x2_t); return __builtin_bit_cast(unsigned, b); }
__device__ __forceinline__ float bflo(unsigned u) { return __uint_as_float(u << 16); }
__device__ __forceinline__ float bfhi(unsigned u) { return __uint_as_float(u & 0xffff0000u); }
__device__ __forceinline__ float sigmf(float x) { return __builtin_amdgcn_rcpf(1.f + __builtin_amdgcn_exp2f(-1.4426950408889634f * x)); }
__device__ __forceinline__ float siluf(float x) { return x * sigmf(x); }
__device__ __forceinline__ float wave_sum63(float v) {
    v += __builtin_bit_cast(float, __builtin_amdgcn_update_dpp(0, __builtin_bit_cast(int, v), 0xB1, 0xF, 0xF, false));
    v += __builtin_bit_cast(float, __builtin_amdgcn_update_dpp(0, __builtin_bit_cast(int, v), 0x4E, 0xF, 0xF, false));
    v += __builtin_bit_cast(float, __builtin_amdgcn_update_dpp(0, __builtin_bit_cast(int, v), 0x141, 0xF, 0xF, false));
    v += __builtin_bit_cast(float, __builtin_amdgcn_update_dpp(0, __builtin_bit_cast(int, v), 0x140, 0xF, 0xF, false));
    v += __builtin_bit_cast(float, __builtin_amdgcn_update_dpp(0, __builtin_bit_cast(int, v), 0x142, 0xA, 0xF, false));
    v += __builtin_bit_cast(float, __builtin_amdgcn_update_dpp(0, __builtin_bit_cast(int, v), 0x143, 0xC, 0xF, false));
    return v;
}
__device__ __forceinline__ int perm_glu(int n, int H) { if (n < H) return 32 * (n >> 4) + (n & 15); const int n2 = n - H; return 32 * (n2 >> 4) + 16 + (n2 & 15); }
__device__ __forceinline__ int perm_win(int n) {
    if (n >= 2 * QKW) return n;
    const int part = n >> 10, hn = n & 1023, h = hn >> 8, d = hn & 255, quarter = d >> 6, idx = d & 63;
    const int Gp = (quarter >> 1) * 4 + (idx >> 4), i = (quarter & 1) * 16 + (idx & 15);
    return part * 1024 + h * 256 + 32 * Gp + i;
}
__device__ __forceinline__ int perm_any(int mode, int n, int H) { return mode == 0 ? n : (mode == 1 ? perm_glu(n, H) : perm_win(n)); }

struct Args { const float* in[22]; float* out; unsigned char* ws; int ph_lo, ph_hi; };

struct Ctx {
    LAS unsigned char* lds;
    int tid, lane, wave, G, bid;
    const float* const* in; float* out; unsigned char* ws;
};

template <int VSILU>
__device__ __forceinline__ void gemv2_unit(Ctx& C, const float* W, int N, int n0, const float* v0, const float* v1, const float* bias, float* o0, float* o1, int pmode, int H) {
    LAS float* red = (LAS float*)C.lds;
    const int c4 = C.tid & 15, ks = C.tid >> 4;
    f32x4 a0 = {0.f, 0.f, 0.f, 0.f}, a1 = {0.f, 0.f, 0.f, 0.f};
#pragma unroll 8
    for (int i = 0; i < 32; ++i) {
        const int k = ks * 32 + i;
        const f32x4 w = *(const f32x4*)(W + (size_t)k * N + n0 + 4 * c4);
        float x0 = v0[k], x1 = v1[k];
        if (VSILU) { x0 = siluf(x0); x1 = siluf(x1); }
        a0 += w * x0; a1 += w * x1;
    }
#pragma unroll
    for (int e = 0; e < 4; ++e) { red[(ks * 2 + 0) * 64 + 4 * c4 + e] = a0[e]; red[(ks * 2 + 1) * 64 + 4 * c4 + e] = a1[e]; }
    __syncthreads();
    if (C.tid < 128) {
        const int s = C.tid >> 6, col = C.tid & 63; float sum = 0.f;
#pragma unroll 8
        for (int k2 = 0; k2 < 32; ++k2) sum += red[(k2 * 2 + s) * 64 + col];
        const int n = n0 + col; if (bias) sum += bias[n];
        (s ? o1 : o0)[perm_any(pmode, n, H)] = sum;
    }
    __syncthreads();
}

__device__ __forceinline__ void transpose_item(const float* W, int K, int N, bf16_t* WT, int pmode, int H, LAS float* scr, int item, int lane) {
    const int nblk = N / 32, kb = item / nblk, nb = item % nblk, k0 = 64 * kb, n0 = 32 * nb;
    {   f32x4 v[8];
#pragma unroll
        for (int i = 0; i < 8; ++i) v[i] = *(const f32x4*)(W + (size_t)(k0 + 8 * i + (lane >> 3)) * N + n0 + 4 * (lane & 7));
#pragma unroll
        for (int i = 0; i < 8; ++i) { LAS float* d = scr + (8 * i + (lane >> 3)) * 33 + 4 * (lane & 7); d[0] = v[i][0]; d[1] = v[i][1]; d[2] = v[i][2]; d[3] = v[i][3]; } }
    asm volatile("s_waitcnt lgkmcnt(0)" ::: "memory");
    const int c = lane & 7;
#pragma unroll
    for (int j = 0; j < 4; ++j) { const int n = (lane >> 3) + 8 * j; const LAS float* s = scr + (8 * c) * 33 + n;
        u32x4 o; o.x = pk2(s[0 * 33], s[1 * 33]); o.y = pk2(s[2 * 33], s[3 * 33]); o.z = pk2(s[4 * 33], s[5 * 33]); o.w = pk2(s[6 * 33], s[7 * 33]);
        *(u32x4*)(WT + (size_t)perm_any(pmode, n0 + n, H) * K + k0 + 8 * c) = o; }
    asm volatile("s_waitcnt lgkmcnt(0)" ::: "memory");
}
__device__ __forceinline__ void prep_layer(Ctx& C, int i, int part, int cu_lo) {
    if (C.bid < cu_lo) return;
    LAS float* scr = (LAS float*)(C.lds + C.wave * 16384);
    const int gw = (C.bid - cu_lo) * 8 + C.wave, NGW = (C.G - cu_lo) * 8, j = i >> 1;
    bf16_t* WA = (bf16_t*)(C.ws + WS_WA); bf16_t* WA2 = (bf16_t*)(C.ws + WS_WA2); bf16_t* WF1 = (bf16_t*)(C.ws + WS_WF1); bf16_t* WF2 = (bf16_t*)(C.ws + WS_WF2);
    const bool conv = (i & 1) == 0;
    const int I_A = (part & 1) ? (conv ? 16 * 64 : 16 * 256) : 0, I_A2 = (part & 1) ? (conv ? 16 * 32 : 32 * 32) : 0, I_F1 = (part & 2) ? 16 * 176 : 0, I_F2 = (part & 2) ? 44 * 32 : 0;
    const int NIT = I_A + I_A2 + I_F1 + I_F2;
    for (int it = gw; it < NIT; it += NGW) {
        int r = it;
        if (r < I_A) { if (conv) transpose_item(C.in[8] + (size_t)j * 1024 * 2048, 1024, 2048, WA, 1, 1024, scr, r, C.lane);
                       else transpose_item(C.in[16] + (size_t)j * 1024 * 8192, 1024, 8192, WA, 2, 0, scr, r, C.lane); continue; } r -= I_A;
        if (r < I_A2) { if (conv) transpose_item(C.in[14] + (size_t)j * 1024 * 1024, 1024, 1024, WA2, 0, 0, scr, r, C.lane);
                        else transpose_item(C.in[18] + (size_t)j * 2048 * 1024, 2048, 1024, WA2, 0, 0, scr, r, C.lane); continue; } r -= I_A2;
        if (r < I_F1) { transpose_item(C.in[19] + (size_t)i * 1024 * FF2, 1024, FF2, WF1, 1, DFF, scr, r, C.lane); continue; } r -= I_F1;
        transpose_item(C.in[20] + (size_t)i * DFF * 1024, DFF, 1024, WF2, 0, 0, scr, r, C.lane);
    }
}

__device__ __forceinline__ float row_rs(const float* stats, int row, int fq) {
    const f32x4 p = *(const f32x4*)(stats + (size_t)row * 16 + 4 * fq);
    float s = (p[0] + p[1]) + (p[2] + p[3]);
    s += __shfl_xor(s, 16); s += __shfl_xor(s, 32);
    return 1.0f / sqrtf(s * (1.0f / 1024.0f) + NORM_EPS);
}
struct EpiGLU {
    static constexpr bool STATS = false, NEEDRS = true;
    unsigned char* ws; int cvoff  , cvstride  , outoff  , ldo, act;
    float* stats;
    __device__ __forceinline__ float row_begin(int row, int fq) const { return row_rs((const float*)(ws + WS_STATS), row, fq); }
    __device__ __forceinline__ float item(int row, int colp, f32x4 v0, f32x4 v1, float rs) const {
        const float* cv = (const float*)ws + cvoff + (row < T ? 0 : cvstride);
        const f32x4 ca = *(const f32x4*)(cv + colp), cg = *(const f32x4*)(cv + colp + 16);
        float o[4];
#pragma unroll
        for (int e = 0; e < 4; ++e) { const float a = rs * v0[e] + ca[e], g = rs * v1[e] + cg[e]; o[e] = act == 0 ? a * sigmf(g) : siluf(a) * g; }
        const int oc = (colp >> 5) * 16 + (colp & 15);
        u32x2 w; w.x = pk2(o[0], o[1]); w.y = pk2(o[2], o[3]);
        *(u32x2*)((bf16_t*)(ws + outoff) + (size_t)row * ldo + oc) = w;
        return 0.f;
    }
};
struct EpiRes {
    static constexpr bool STATS = true, NEEDRS = false;
    unsigned char* ws; float* xl; const float* bias; int mgoff  , snoff  ;
    float* stats;
    __device__ __forceinline__ float row_begin(int, int) const { return 1.f; }
    __device__ __forceinline__ float item(int row, int colp, f32x4 v0, f32x4 v1, float) const {
        const bool lat = row < T;
        float* xr = lat ? xl + (size_t)row * 1024 : (float*)(ws + WS_XCTX) + (size_t)(row - T) * 1024;
        const float* mg = (const float*)ws + mgoff + (lat ? 0 : 6144); const float* sn = (const float*)ws + snoff + (lat ? 0 : 1024);
        bf16_t* xs = (bf16_t*)(ws + WS_XS);
        float ss = 0.f;
#pragma unroll
        for (int hlf = 0; hlf < 2; ++hlf) {
            const int c = colp + 16 * hlf; const f32x4 v = hlf ? v1 : v0;
            const f32x4 xo = *(const f32x4*)(xr + c), m4 = *(const f32x4*)(mg + c);
            f32x4 b4 = {0.f, 0.f, 0.f, 0.f}; if (bias) b4 = *(const f32x4*)(bias + c);
            const f32x4 xn = xo + m4 * (v + b4);
            *(f32x4*)(xr + c) = xn;
            ss += (xn[0] * xn[0] + xn[1] * xn[1]) + (xn[2] * xn[2] + xn[3] * xn[3]);
            if (snoff >= 0) { const f32x4 s4 = *(const f32x4*)(sn + c); u32x2 w; w.x = pk2(xn[0] * s4[0], xn[1] * s4[1]); w.y = pk2(xn[2] * s4[2], xn[3] * s4[3]);
                *(u32x2*)(xs + (size_t)row * 1024 + c) = w; }
        }
        return ss;
    }
};
struct EpiWin {
    static constexpr bool STATS = false, NEEDRS = true;
    unsigned char* ws; int cvoff;
    float* stats;
    __device__ __forceinline__ float row_begin(int row, int fq) const { return row_rs((const float*)(ws + WS_STATS), row, fq); }
    __device__ __forceinline__ float item(int row, int colp, f32x4 v0, f32x4 v1, float rs) const {
        const float* cv = (const float*)ws + cvoff + (row < T ? 0 : 8192);
        const f32x4 c0 = *(const f32x4*)(cv + colp), c1 = *(const f32x4*)(cv + colp + 16);
        f32x4 a = v0 * rs + c0, b = v1 * rs + c1;
        if (colp < 2048) {
            if (row < T) {
                const int Gp = (colp >> 5) & 7, idx0 = 16 * (Gp & 3) + (colp & 15);
                const int ti = (Gp >> 2) ? 256 + (row & 63) : (row >> 6);
                const f32x4 cs = *(const f32x4*)((const float*)(ws + WS_TABC) + ti * 64 + idx0), sn = *(const f32x4*)((const float*)(ws + WS_TABS) + ti * 64 + idx0);
                const f32x4 o1 = a * cs - b * sn, o2 = b * cs + a * sn; a = o1; b = o2;
            }
            bf16_t* dst = (bf16_t*)(ws + WS_Q);
            if (colp >= 1024) { dst = (bf16_t*)(ws + WS_K); a = a * 0.0625f; b = b * 0.0625f; }
            const int c = colp & 1023;
            u32x2 w; w.x = pk2(a[0], a[1]); w.y = pk2(a[2], a[3]); *(u32x2*)(dst + (size_t)row * 1024 + c) = w;
            w.x = pk2(b[0], b[1]); w.y = pk2(b[2], b[3]); *(u32x2*)(dst + (size_t)row * 1024 + c + 16) = w;
        } else if (colp < 4096) {
            const int c = colp - 2048;
            bf16_t* vt = (bf16_t*)(ws + WS_VT);
#pragma unroll
            for (int e = 0; e < 4; ++e) { vt[(size_t)(c + e) * R + row] = (bf16_t)(pk2(a[e], 0.f) & 0xffffu); vt[(size_t)(c + 16 + e) * R + row] = (bf16_t)(pk2(b[e], 0.f) & 0xffffu); }
        } else {
            bf16_t* dst = (bf16_t*)(ws + (colp < 6144 ? WS_GF : WS_GB)); const int c = (colp - 4096) & 2047;
            u32x2 w; w.x = pk2(a[0], a[1]); w.y = pk2(a[2], a[3]); *(u32x2*)(dst + (size_t)row * 2048 + c) = w;
            w.x = pk2(b[0], b[1]); w.y = pk2(b[2], b[3]); *(u32x2*)(dst + (size_t)row * 2048 + c + 16) = w;
        }
        return 0.f;
    }
};

namespace pg8 {
#define PG8_LAS __attribute__((address_space(3)))
typedef unsigned short bf16_t;
typedef short bf16x8 __attribute__((ext_vector_type(8)));
typedef float f32x4 __attribute__((ext_vector_type(4)));
typedef unsigned u32x4 __attribute__((ext_vector_type(4)));
constexpr int BM = 256, BK = 64, HALF = 128, HTB = HALF * BK * 2  , STAGE_BYTES = 8 * HTB, NXCD = 8, WGM = 8;

__host__ __device__ __forceinline__ int lds_byte(int r, int c) { const int st = (r >> 4) * 2 + (c >> 5), rr = r & 15, cc = c & 31, ob = rr * 64 + cc * 2; return st * 1024 + (ob ^ (((ob >> 9) & 1) << 5)); }
__host__ __device__ __forceinline__ void stage_rc(int b, int& R, int& C) { const int st = b / 1024, sb = b % 1024, swz = sb ^ (((sb >> 9) & 1) << 5); R = (st >> 1) * 16 + swz / 64; C = (st & 1) * 32 + (swz % 64) / 2; }
__host__ __device__ __forceinline__ int perm32(int rho) { const int n = rho >> 4, i = rho & 15; return 8 * (i >> 2) + 4 * n + (i & 3); }

struct Unit { int pm, pn; };
struct Gemm { const bf16_t* A; const bf16_t* Bt; int M, N, K; };

struct StaticOrder {
    int nM, nN, nwg, G, c;
    __host__ __device__ void init(int M, int N, int G_, int c_) { nM = M / BM; nN = N / BM; nwg = nM * nN; G = G_; c = c_; }
    __host__ __device__ bool next(int i, Unit& u) const {
        const long L = (long)i * G + c; if (L >= nwg) return false;
        int wgid = (int)L; { const int q = nwg / NXCD, r = nwg % NXCD, xcd = wgid % NXCD, off = wgid / NXCD; wgid = (xcd < r ? xcd * (q + 1) : r * (q + 1) + (xcd - r) * q) + off; }
        const int nig = WGM * nN, gid = wgid / nig, fm = gid * WGM, gsz = (nM - fm) < WGM ? (nM - fm) : WGM;
        u.pm = fm + ((wgid % nig) % gsz); u.pn = (wgid % nig) / gsz; return true;
    }
    __device__ __forceinline__ void a_ready(const Unit&) const {}
    __device__ __forceinline__ void done(const Unit&) const {}
};

template <class Epi, class Sched, bool ALIGN_EPI = false, bool SP2 = false, bool SWAPMMA = false>
__device__ __forceinline__ void gemm_phase(PG8_LAS unsigned char* lds, const Gemm g, const Sched& S, const Epi& E) {
    const int tid = threadIdx.x, wid = __builtin_amdgcn_readfirstlane(tid >> 6), lane = tid & 63, wr = wid >> 2, wc = wid & 3, fr = lane & 15, fq = lane >> 4;
    const int K = g.K, nt = K / BK;
    unsigned voffA[2], voffB[2];
#pragma unroll
    for (int i = 0; i < 2; ++i) { int R, C; stage_rc(tid * 16 + i * 8192, R, C); const int Rb = Epi::PERM ? ((R & ~31) + perm32(R & 31)) : R;
        voffA[i] = (unsigned)(R * K + C) * 2u; voffB[i] = (unsigned)(Rb * K + C) * 2u; }
    const size_t kstep = (size_t)(BK * 2);
    const size_t hstep = (size_t)HALF * K * 2;
    const size_t tstep = 2 * hstep;
    const unsigned ldsw = (unsigned)wid * 1024u;
    const int aoff = lds_byte(wr * 64 + fr, fq * 8), boff = lds_byte(wc * 32 + fr, fq * 8);
#define PG8_SA(b, h) (((b) * 2 + (h)) * HTB)
#define PG8_SB(b, h) ((4 + (b) * 2 + (h)) * HTB)
#define PG8_STAGE(bufoff, gbase, voff) do { _Pragma("unroll") for (int _i = 0; _i < 2; ++_i) \
        __builtin_amdgcn_global_load_lds((const unsigned*)((const char*)(gbase) + (voff)[_i]), (PG8_LAS unsigned*)(lds + (bufoff) + ldsw + _i * 8192), 16, 0, 0); } while (0)
#define PG8_LDA(dst, b, h) do { _Pragma("unroll") for (int m = 0; m < 4; ++m) _Pragma("unroll") for (int k = 0; k < 2; ++k) dst[m][k] = *(const PG8_LAS bf16x8*)(lds + PG8_SA(b, h) + aoff + m * 2048 + k * 1024); } while (0)
#define PG8_LDB(dst, b, h) do { _Pragma("unroll") for (int n = 0; n < 2; ++n) _Pragma("unroll") for (int k = 0; k < 2; ++k) dst[n][k] = *(const PG8_LAS bf16x8*)(lds + PG8_SB(b, h) + boff + n * 2048 + k * 1024); } while (0)
#define PG8_MMA(ai, bj, At, Bt) do { __builtin_amdgcn_s_setprio(1); _Pragma("unroll") for (int m = 0; m < 4; ++m) _Pragma("unroll") for (int n = 0; n < 2; ++n) _Pragma("unroll") for (int k = 0; k < 2; ++k) \
        acc[ai][bj][m][n] = SWAPMMA ? __builtin_amdgcn_mfma_f32_16x16x32_bf16(At[m][k], Bt[n][k], acc[ai][bj][m][n], 0, 0, 0) : __builtin_amdgcn_mfma_f32_16x16x32_bf16(Bt[n][k], At[m][k], acc[ai][bj][m][n], 0, 0, 0); __builtin_amdgcn_s_setprio(0); } while (0)
#define PG8_WAIT_V(n) asm volatile("s_waitcnt vmcnt(" #n ")" ::: "memory")
#define PG8_WAIT_L(n) asm volatile("s_waitcnt lgkmcnt(" #n ")" ::: "memory")
#define PG8_BAR __builtin_amdgcn_s_barrier()
#define PG8_SCHED __builtin_amdgcn_sched_barrier(0)
    Unit cur, nxt; int ui = 0;
    if (!S.next(0, cur)) return;
    f32x4 acc[2][2][4][2];
#pragma unroll
    for (int a = 0; a < 2; ++a)
#pragma unroll
        for (int b = 0; b < 2; ++b)
#pragma unroll
            for (int m = 0; m < 4; ++m)
#pragma unroll
                for (int n = 0; n < 2; ++n) acc[a][b][m][n] = (f32x4){0.f, 0.f, 0.f, 0.f};
    bf16x8 At[4][2], B0[2][2], B1[2][2];
    const char* cA = (const char*)g.A + (size_t)cur.pm * tstep; const char* cB = (const char*)g.Bt + (size_t)cur.pn * tstep;
    S.a_ready(cur);
    if constexpr (SP2) {
        PG8_STAGE(PG8_SB(0, 0), cB, voffB); PG8_STAGE(PG8_SB(0, 1), cB + hstep, voffB); PG8_STAGE(PG8_SA(0, 0), cA, voffA); PG8_STAGE(PG8_SA(0, 1), cA + hstep, voffA);
        if (wr == 1) PG8_BAR;
        PG8_WAIT_V(2); PG8_BAR;
        PG8_STAGE(PG8_SB(1, 0), cB + kstep, voffB); PG8_STAGE(PG8_SA(1, 0), cA + kstep, voffA); PG8_STAGE(PG8_SB(1, 1), cB + hstep + kstep, voffB);
        PG8_WAIT_V(6); PG8_BAR;
    } else {
        PG8_STAGE(PG8_SB(0, 0), cB, voffB); PG8_STAGE(PG8_SA(0, 0), cA, voffA); PG8_STAGE(PG8_SB(0, 1), cB + hstep, voffB); PG8_STAGE(PG8_SA(0, 1), cA + hstep, voffA);
        if (wr == 1) PG8_BAR;
        PG8_WAIT_V(4); PG8_BAR;
        PG8_STAGE(PG8_SB(1, 0), cB + kstep, voffB); PG8_STAGE(PG8_SA(1, 0), cA + kstep, voffA); PG8_STAGE(PG8_SB(1, 1), cB + hstep + kstep, voffB);
        PG8_WAIT_V(6); PG8_BAR;
    }
    for (;;) {
        const bool has_next = S.next(ui + 1, nxt);
        const char* nA = has_next ? (const char*)g.A + (size_t)nxt.pm * tstep : cA; const char* nB = has_next ? (const char*)g.Bt + (size_t)nxt.pn * tstep : cB;
        for (int t = 0; t < nt; t += 2) {
            const bool last = (t == nt - 2);
            const char* a1 = cA + (size_t)(t + 1) * kstep;
            const char* a2 = last ? nA : cA + (size_t)(t + 2) * kstep; const char* b2 = last ? nB : cB + (size_t)(t + 2) * kstep;
            const char* a3 = a2 + kstep; const char* b3 = b2 + kstep;
            if (last && has_next) S.a_ready(nxt);
            if constexpr (SP2) {
            PG8_LDB(B0, 0, 0); PG8_LDB(B1, 0, 1); PG8_SCHED; PG8_LDA(At, 0, 0); PG8_STAGE(PG8_SA(1, 1), a1 + hstep, voffA);
            PG8_WAIT_V(8); PG8_WAIT_L(0); PG8_BAR; PG8_MMA(0, 0, At, B0); PG8_MMA(0, 1, At, B1); PG8_BAR; PG8_SCHED;
            PG8_LDA(At, 0, 1); PG8_STAGE(PG8_SB(0, 0), b2, voffB); PG8_STAGE(PG8_SB(0, 1), b2 + hstep, voffB); PG8_STAGE(PG8_SA(0, 0), a2, voffA);
            PG8_WAIT_V(8); PG8_WAIT_L(0); PG8_BAR; PG8_MMA(1, 0, At, B0); PG8_MMA(1, 1, At, B1); PG8_BAR; PG8_SCHED;
            PG8_LDB(B0, 1, 0); PG8_LDB(B1, 1, 1); PG8_SCHED; PG8_LDA(At, 1, 0); PG8_STAGE(PG8_SA(0, 1), a2 + hstep, voffA);
            PG8_WAIT_V(8); PG8_WAIT_L(0); PG8_BAR; PG8_MMA(0, 0, At, B0); PG8_MMA(0, 1, At, B1); PG8_BAR; PG8_SCHED;
            PG8_LDA(At, 1, 1); PG8_STAGE(PG8_SB(1, 0), b3, voffB); PG8_STAGE(PG8_SB(1, 1), b3 + hstep, voffB); PG8_STAGE(PG8_SA(1, 0), a3, voffA);
            PG8_WAIT_V(8); PG8_WAIT_L(0); PG8_BAR; PG8_MMA(1, 0, At, B0); PG8_MMA(1, 1, At, B1); PG8_BAR; PG8_SCHED;
            } else {
            PG8_LDB(B0, 0, 0); PG8_SCHED; PG8_LDA(At, 0, 0); PG8_STAGE(PG8_SA(1, 1), a1 + hstep, voffA);
            PG8_WAIT_L(8); PG8_BAR; PG8_WAIT_L(0); PG8_MMA(0, 0, At, B0); PG8_BAR; PG8_SCHED;
            PG8_LDB(B1, 0, 1); PG8_STAGE(PG8_SB(0, 0), b2, voffB);
            PG8_BAR; PG8_WAIT_L(0); PG8_MMA(0, 1, At, B1); PG8_BAR;
            PG8_LDA(At, 0, 1); PG8_STAGE(PG8_SA(0, 0), a2, voffA);
            PG8_BAR; PG8_WAIT_L(0); PG8_MMA(1, 0, At, B0); PG8_BAR; PG8_SCHED;
            PG8_STAGE(PG8_SB(0, 1), b2 + hstep, voffB);
            PG8_WAIT_V(6); PG8_BAR; PG8_MMA(1, 1, At, B1); PG8_BAR;
            PG8_LDB(B0, 1, 0); PG8_SCHED; PG8_LDA(At, 1, 0); PG8_STAGE(PG8_SA(0, 1), a2 + hstep, voffA);
            PG8_WAIT_L(8); PG8_BAR; PG8_WAIT_L(0); PG8_MMA(0, 0, At, B0); PG8_BAR; PG8_SCHED;
            PG8_LDB(B1, 1, 1); PG8_STAGE(PG8_SB(1, 0), b3, voffB);
            PG8_BAR; PG8_WAIT_L(0); PG8_MMA(0, 1, At, B1); PG8_BAR;
            PG8_LDA(At, 1, 1); PG8_STAGE(PG8_SA(1, 0), a3, voffA);
            PG8_BAR; PG8_WAIT_L(0); PG8_MMA(1, 0, At, B0); PG8_BAR; PG8_SCHED;
            PG8_STAGE(PG8_SB(1, 1), b3 + hstep, voffB);
            PG8_WAIT_V(6); PG8_BAR; PG8_MMA(1, 1, At, B1); PG8_BAR;
            }
        }
        if constexpr (ALIGN_EPI) { if (wr == 0) PG8_BAR; }
        if constexpr (!Epi::AFTER_DRAIN) { E(acc, cur, wr, wc, fr, fq); S.done(cur); }
        if (!has_next) break;
#pragma unroll
        for (int a = 0; a < 2; ++a)
#pragma unroll
            for (int b = 0; b < 2; ++b)
#pragma unroll
                for (int m = 0; m < 4; ++m)
#pragma unroll
                    for (int n = 0; n < 2; ++n) acc[a][b][m][n] = (f32x4){0.f, 0.f, 0.f, 0.f};
        cur = nxt; cA = nA; cB = nB; ++ui;
        if constexpr (ALIGN_EPI) { if (wr == 1) PG8_BAR; }
    }
    PG8_WAIT_V(0);
    if constexpr (!ALIGN_EPI) { if (wr == 0) PG8_BAR; }
    PG8_BAR;
    if constexpr (Epi::AFTER_DRAIN) { E.fused(acc, cur, wr, wc, fr, fq, lds, wid, lane); S.done(cur); }
#undef PG8_SA
#undef PG8_SB
#undef PG8_STAGE
#undef PG8_LDA
#undef PG8_LDB
#undef PG8_MMA
#undef PG8_WAIT_V
#undef PG8_WAIT_L
#undef PG8_BAR
#undef PG8_SCHED
}
}

template <class E0> struct EpiAdapt {
    static constexpr bool PERM = false, AFTER_DRAIN = false;
    E0 e; int col_base;
    __device__ __forceinline__ void operator()(const pg8::f32x4 (&acc)[2][2][4][2], const pg8::Unit& u, int wr, int wc, int fr, int fq) const {
#pragma unroll
        for (int ai = 0; ai < 2; ++ai)
#pragma unroll
            for (int m = 0; m < 4; ++m) {
                const int row = u.pm * 256 + ai * 128 + wr * 64 + m * 16 + fr;
                const float rs = e.row_begin(row, fq);
                float ss = 0.f;
#pragma unroll
                for (int bj = 0; bj < 2; ++bj) ss += e.item(row, col_base + u.pn * 256 + bj * 128 + wc * 32 + 4 * fq, acc[ai][bj][m][0], acc[ai][bj][m][1], rs);
                if constexpr (E0::STATS) { ss += __shfl_xor(ss, 16); ss += __shfl_xor(ss, 32); if (fq == 0) e.stats[(size_t)row * 16 + (col_base >> 6) + u.pn * 4 + wc] = ss; }
            }
    }
};
struct EpiVt {
    static constexpr bool PERM = false, AFTER_DRAIN = false;
    unsigned char* ws; int cvoff;
    __device__ __forceinline__ void operator()(const pg8::f32x4 (&acc)[2][2][4][2], const pg8::Unit& u, int wr, int wc, int fr, int fq) const {
        bf16_t* vt = (bf16_t*)(ws + WS_VT);
#pragma unroll
        for (int ai = 0; ai < 2; ++ai)
#pragma unroll
            for (int m = 0; m < 4; ++m) {
                const int rowb = u.pm * 256 + ai * 128 + wr * 64 + m * 16;
                const float rsl = row_rs((const float*)(ws + WS_STATS), rowb + fr, fq);
                float rsv[4];
#pragma unroll
                for (int e = 0; e < 4; ++e) rsv[e] = __shfl(rsl, 4 * fq + e);
                const float* cv = (const float*)ws + cvoff + (rowb < T ? 0 : 8192);
#pragma unroll
                for (int bj = 0; bj < 2; ++bj)
#pragma unroll
                    for (int n = 0; n < 2; ++n) {
                        const int col = 2048 + u.pn * 256 + bj * 128 + wc * 32 + 16 * n + fr;
                        const float c0 = cv[col]; const pg8::f32x4 a = acc[ai][bj][m][n];
                        u32x2 w; w.x = pk2(a[0] * rsv[0] + c0, a[1] * rsv[1] + c0); w.y = pk2(a[2] * rsv[2] + c0, a[3] * rsv[3] + c0);
                        *(u32x2*)(vt + (size_t)(col - 2048) * R + rowb + 4 * fq) = w;
                    }
            }
    }
};
template <class Epi>
__device__ __forceinline__ void sgemm_small(Ctx& C, const bf16_t* A, const bf16_t* Bt, int row_lo, int Mrows, int N, int K, const Epi& E, int n_lo, int n_hi) {
    const int kh = C.wave >> 2, wc = C.wave & 3, fr = C.lane & 15, fq = C.lane >> 4;
    const int nM = Mrows / 16, nN = n_hi - n_lo, nU = nM * nN, Kh = K >> 1;
    LAS f32x4* xch = (LAS f32x4*)C.lds;
    for (int u = (C.G - 1 - C.bid); u < nU; u += C.G) {
        const int un = n_lo + u / nM, um = u % nM;
        const int row0 = row_lo + 16 * um, col0 = 256 * un;
        f32x4 acc[2][2];
#pragma unroll
        for (int b = 0; b < 2; ++b)
#pragma unroll
            for (int n = 0; n < 2; ++n) acc[b][n] = (f32x4){0.f, 0.f, 0.f, 0.f};
        const bf16_t* ap = A + (size_t)(row0 + fr) * K + kh * Kh + 8 * fq;
        const bf16_t* bp = Bt + (size_t)(col0 + 32 * wc + fr) * K + kh * Kh + 8 * fq;
#pragma unroll 4
        for (int k0 = 0; k0 < Kh; k0 += 32) {
            bf16x8 bf[2][2];
            const bf16x8 af = *(const bf16x8*)(ap + k0);
#pragma unroll
            for (int bj = 0; bj < 2; ++bj)
#pragma unroll
                for (int n = 0; n < 2; ++n) bf[bj][n] = *(const bf16x8*)(bp + (size_t)(128 * bj + 16 * n) * K + k0);
#pragma unroll
            for (int bj = 0; bj < 2; ++bj)
#pragma unroll
                for (int n = 0; n < 2; ++n) acc[bj][n] = __builtin_amdgcn_mfma_f32_16x16x32_bf16(bf[bj][n], af, acc[bj][n], 0, 0, 0);
        }
        if (kh == 1) {
#pragma unroll
            for (int bj = 0; bj < 2; ++bj)
#pragma unroll
                for (int n = 0; n < 2; ++n) xch[(wc * 4 + bj * 2 + n) * 64 + C.lane] = acc[bj][n];
        }
        __syncthreads();
        if (kh == 0) {
#pragma unroll
            for (int bj = 0; bj < 2; ++bj)
#pragma unroll
                for (int n = 0; n < 2; ++n) acc[bj][n] += xch[(wc * 4 + bj * 2 + n) * 64 + C.lane];
            const int row = row0 + fr;
            const float rs = E.row_begin(row, fq);
            float ss = 0.f;
#pragma unroll
            for (int bj = 0; bj < 2; ++bj) ss += E.item(row, col0 + 128 * bj + 32 * wc + 4 * fq, acc[bj][0], acc[bj][1], rs);
            if constexpr (Epi::STATS) { ss += __shfl_xor(ss, 16); ss += __shfl_xor(ss, 32); if (fq == 0) E.stats[(size_t)row * 16 + un * 4 + wc] = ss; }
        }
        __syncthreads();
    }
}
template <class E0>
__device__ __forceinline__ void gemm_both(Ctx& C, const bf16_t* A, const bf16_t* Bt, int Mbig, int N, int K, const E0& E, int ctx_n_lo, int ctx_n_hi, int nb_lo = 0, int nb_hi = -1) {
    if (nb_hi < 0) nb_hi = N / 256;
    { pg8::Gemm g{A, Bt + (size_t)nb_lo * 256 * K, Mbig, (nb_hi - nb_lo) * 256, K}; pg8::StaticOrder S; S.init(Mbig, (nb_hi - nb_lo) * 256, C.G, C.bid); EpiAdapt<E0> EA{E, nb_lo * 256};
      pg8::gemm_phase<EpiAdapt<E0>, pg8::StaticOrder, true, true>(C.lds, g, S, EA); }
    if (Mbig < R && ctx_n_hi > ctx_n_lo) { __syncthreads(); sgemm_small(C, A, Bt, T, R - T, N, K, E, ctx_n_lo, ctx_n_hi); }
}
__device__ __forceinline__ void dwconv_phase(Ctx& C, int j) {
    const bf16_t* U = (const bf16_t*)(C.ws + WS_U); bf16_t* A2 = (bf16_t*)(C.ws + WS_A2);
    const float* dww = C.in[10] + (size_t)j * CK * 1024; const float* dwb = C.in[11] + j * 1024; const float* lng = C.in[12] + j * 1024; const float* lnb = C.in[13] + j * 1024;
    LAS unsigned char* tile = C.lds; LAS float* part = (LAS float*)(C.lds + 62 * 2048);
    const int tid = C.tid;
    for (int u = C.bid; u < 520; u += C.G) {
        const int base = u < 512 ? 0 : T, n = u < 512 ? T : TC, t0 = 32 * (u < 512 ? u : u - 512);
        for (int idx = tid; idx < 62 * 128; idx += 512) {
            const int rr = idx >> 7, ch = idx & 127, tt = t0 - 15 + rr;
            u32x4 v = {0u, 0u, 0u, 0u};
            if (tt >= 0 && tt < n) v = *(const u32x4*)(U + (size_t)(base + tt) * 1024 + ch * 8);
            *(LAS u32x4*)(tile + rr * 2048 + ch * 16) = v;
        }
        __syncthreads();
        float o0[32], o1[32];
        { const f32x2 b2 = *(const f32x2*)(dwb + 2 * tid);
#pragma unroll
          for (int t = 0; t < 32; ++t) { o0[t] = b2.x; o1[t] = b2.y; } }
        for (int jt = 0; jt < CK; ++jt) {
            const f32x2 w = *(const f32x2*)(dww + jt * 1024 + 2 * tid);
            const LAS unsigned char* p = tile + jt * 2048 + tid * 4;
#pragma unroll
            for (int t = 0; t < 32; ++t) { const unsigned uu = *(const LAS unsigned*)(p + t * 2048); o0[t] += w.x * bflo(uu); o1[t] += w.y * bfhi(uu); }
        }
#pragma unroll
        for (int t = 0; t < 32; ++t) {
            const float s = wave_sum63(o0[t] + o1[t]), q = wave_sum63(o0[t] * o0[t] + o1[t] * o1[t]);
            if (C.lane == 63) { part[(t * 8 + C.wave) * 2] = s; part[(t * 8 + C.wave) * 2 + 1] = q; }
        }
        __syncthreads();
        const f32x2 g2 = *(const f32x2*)(lng + 2 * tid), bb2 = *(const f32x2*)(lnb + 2 * tid);
#pragma unroll
        for (int t = 0; t < 32; ++t) {
            float s = 0.f, q = 0.f;
#pragma unroll
            for (int w = 0; w < 8; ++w) { s += part[(t * 8 + w) * 2]; q += part[(t * 8 + w) * 2 + 1]; }
            const float mean = s * (1.f / 1024.f), var = q * (1.f / 1024.f) - mean * mean, rstd = 1.0f / sqrtf(var + LN_EPS);
            const float y0 = (o0[t] - mean) * rstd * g2.x + bb2.x, y1 = (o1[t] - mean) * rstd * g2.y + bb2.y;
            *(unsigned*)(A2 + (size_t)(base + t0 + t) * 1024 + 2 * tid) = pk2(siluf(y0), siluf(y1));
        }
        __syncthreads();
    }
}

__device__ __forceinline__ void scan_phase(Ctx& C, int j) {
    const bf16_t* Kb = (const bf16_t*)(C.ws + WS_K); const bf16_t* Vt = (const bf16_t*)(C.ws + WS_VT); bf16_t* Scp = (bf16_t*)(C.ws + WS_SCP);
    constexpr int KP = 64, VP = 136;
    constexpr int KBYTES = 128 * KP * 2, VBYTES = 64 * VP * 2;
    LAS bf16_t* kbuf = (LAS bf16_t*)C.lds;
    LAS bf16_t* vbuf = (LAS bf16_t*)(C.lds + 2 * KBYTES);
    const int fr = C.lane & 15, fq = C.lane >> 4, w = C.wave, tid = C.tid;
    for (int cu = C.bid; cu < 256; cu += C.G) {
        const int hd = cu & 7, sidx = cu >> 3, h = hd >> 1, dir = hd & 1, dk_s = 64 * ((sidx >> 3) & 3), dv_s = 64 * (sidx & 7);
        const int mt = w >> 1, nh = w & 1, dkl = 16 * mt, dvl = 32 * nh;
        const float gam = 1.0f - exp2f(C.in[17][(j * 2 + dir) * 4 + h]); const float L = log2f(gam);
        const float cdec = exp2f(L * 128.f);
        const int krow = tid >> 3, kch = tid & 7, vrow = tid >> 4, vch = tid & 15;
        const int kchs = kch ^ (((krow >> 3) & 1) << 1) ^ (((krow >> 1) & 1) << 2);
        const int trq = (fr >> 2), trp = fr & 3;
        const int trrow0 = 8 * fq + trq;
        const int trcol0 = (((2 * mt + (trp >> 1)) ^ ((fq & 1) << 1) ^ (((trq >> 1) & 1) << 2)) << 3) + 4 * (trp & 1);
        const float kd0 = exp2f(L * (float)(dir == 0 ? 127 - krow : krow)), kd1 = exp2f(L * (float)(dir == 0 ? 63 - krow : krow + 64));
        const bf16_t* kg = Kb + (size_t)krow * 1024 + h * 256 + dk_s + 8 * kch;
        const bf16_t* vg = Vt + (size_t)(h * 512 + dv_s + vrow) * R + 8 * vch;
        auto tok_of = [&](int st) { const int bl = st < 2 ? (dir == 0 ? st : 1 - st) : (dir == 0 ? st - 2 : 129 - st); return (st < 2 ? T : 0) + 128 * bl; };
        f32x4 acc[2]; acc[0] = (f32x4){0.f, 0.f, 0.f, 0.f}; acc[1] = acc[0];
        u32x4 ra[4], rb[4];
#define SCAN_LOAD(dst, tok) do { dst[0] = *(const u32x4*)(kg + (size_t)(tok) * 1024); dst[1] = *(const u32x4*)(kg + (size_t)((tok) + 64) * 1024); \
        dst[2] = *(const u32x4*)(vg + (tok)); dst[3] = *(const u32x4*)(vg + (size_t)32 * R + (tok)); } while (0)
#define SCAN_STORE(src, buf) do { LAS bf16_t* kb_ = kbuf + (buf) * 128 * KP; LAS bf16_t* vb_ = vbuf + (buf) * 64 * VP; u32x4 o_; \
        o_.x = pk2(bflo(src[0].x) * kd0, bfhi(src[0].x) * kd0); o_.y = pk2(bflo(src[0].y) * kd0, bfhi(src[0].y) * kd0); o_.z = pk2(bflo(src[0].z) * kd0, bfhi(src[0].z) * kd0); o_.w = pk2(bflo(src[0].w) * kd0, bfhi(src[0].w) * kd0); \
        *(LAS u32x4*)(kb_ + krow * KP + 8 * kchs) = o_; \
        o_.x = pk2(bflo(src[1].x) * kd1, bfhi(src[1].x) * kd1); o_.y = pk2(bflo(src[1].y) * kd1, bfhi(src[1].y) * kd1); o_.z = pk2(bflo(src[1].z) * kd1, bfhi(src[1].z) * kd1); o_.w = pk2(bflo(src[1].w) * kd1, bfhi(src[1].w) * kd1); \
        *(LAS u32x4*)(kb_ + (krow + 64) * KP + 8 * kchs) = o_; \
        *(LAS u32x4*)(vb_ + vrow * VP + 8 * vch) = src[2]; *(LAS u32x4*)(vb_ + (vrow + 32) * VP + 8 * vch) = src[3]; } while (0)
        __syncthreads();
        SCAN_LOAD(ra, tok_of(0));
        SCAN_STORE(ra, 0);
        SCAN_LOAD(ra, tok_of(1));
        __syncthreads();
#define SCAN_STEP(st, RA, RB) do { \
            const int cur = (st) & 1; \
            if ((st) + 2 < 130) SCAN_LOAD(RB, tok_of((st) + 2)); \
            {   const bool isctx = (st) < 2; const int bl = isctx ? (dir == 0 ? (st) : 1 - (st)) : (dir == 0 ? (st) - 2 : 129 - (st)); \
                const bool cp = dir == 0 ? ((bl & 3) == 0) : (isctx ? bl == 1 : (bl & 3) == 3); \
                if (cp) { \
                    const int slot = isctx ? 32 : (bl >> 2); \
                    bf16_t* sp = Scp + ((size_t)((slot * 4 + h) * 2 + dir) * 512) * 256; \
                    _Pragma("unroll") for (int nt = 0; nt < 2; ++nt) { u32x2 wv; wv.x = pk2(acc[nt][0], acc[nt][1]); wv.y = pk2(acc[nt][2], acc[nt][3]); \
                        *(u32x2*)(sp + (size_t)(dv_s + dvl + 16 * nt + fr) * 256 + dk_s + dkl + 4 * fq) = wv; } \
                } } \
            acc[0] = acc[0] * cdec; acc[1] = acc[1] * cdec; \
            const LAS bf16_t* kb = kbuf + cur * 128 * KP; const LAS bf16_t* vb = vbuf + cur * 64 * VP; \
            _Pragma("unroll") for (int ks = 0; ks < 4; ++ks) { \
                const LAS bf16_t* kp = kb + (32 * ks + trrow0) * KP + trcol0; \
                const s16x4 lo4 = __builtin_amdgcn_ds_read_tr16_b64_v4i16((LAS s16x4*)kp); \
                const s16x4 hi4 = __builtin_amdgcn_ds_read_tr16_b64_v4i16((LAS s16x4*)(kp + 4 * KP)); \
                const bf16x8 af = (bf16x8){lo4[0], lo4[1], lo4[2], lo4[3], hi4[0], hi4[1], hi4[2], hi4[3]}; \
                _Pragma("unroll") for (int nt = 0; nt < 2; ++nt) { const bf16x8 vf = *(const LAS bf16x8*)(vb + (dvl + 16 * nt + fr) * VP + 32 * ks + 8 * fq); \
                    acc[nt] = __builtin_amdgcn_mfma_f32_16x16x32_bf16(af, vf, acc[nt], 0, 0, 0); } \
            } \
            if ((st) + 1 < 130) SCAN_STORE(RA, cur ^ 1); \
            __syncthreads(); \
        } while (0)
#pragma unroll 1
        for (int st2 = 0; st2 < 130; st2 += 2) { SCAN_STEP(st2, ra, rb); SCAN_STEP(st2 + 1, rb, ra); }
#undef SCAN_STEP
#undef SCAN_LOAD
#undef SCAN_STORE
    }
}

template <int PV = 0>
__device__ __forceinline__ void readout_phase(Ctx& C, int j, bool skip_ctx) {
    const bf16_t* Q = (const bf16_t*)(C.ws + WS_Q); const bf16_t* Kb = (const bf16_t*)(C.ws + WS_K); const bf16_t* Vt = (const bf16_t*)(C.ws + WS_VT);
    const bf16_t* Scp = (const bf16_t*)(C.ws + WS_SCP); bf16_t* GF = (bf16_t*)(C.ws + WS_GF); const bf16_t* GB = (const bf16_t*)(C.ws + WS_GB);
    constexpr int QP = 264, PP = 136;
    LAS bf16_t* Qs = (LAS bf16_t*)C.lds;
    LAS bf16_t* Pb = (LAS bf16_t*)(C.lds + 64 * QP * 2);
    LAS float* red = (LAS float*)(C.lds + 64 * QP * 2 + 2 * 64 * PP * 2);
    const int w = C.wave, tid = C.tid;
    const int nunits = skip_ctx ? 1024 : 1040;
    for (int u0 = C.bid; u0 < nunits; u0 += C.G) {
        int h, b, rh;
        if (C.G == 256 && u0 < 1024) { const int r = u0 >> 8, x = u0 & 7, idx = (u0 & 255) >> 3, grp = r * 32 + x * 4 + (idx >> 3); h = grp & 3; b = (grp >> 2) * 4 + ((idx >> 1) & 3); rh = idx & 1; }
        else { rh = u0 & 1; h = (u0 >> 1) & 3; b = u0 >> 3; }
        const bool lat = b < 128; const int base = lat ? 0 : T, nb = lat ? 128 : 2, bl = lat ? b : b - 128;
        const int g = bl >> 2, slot = lat ? g : 32;
        const int gend = (4 * (g + 1) < nb ? 4 * (g + 1) : nb);
        {
            const int i0 = base + 128 * bl + 64 * rh, il0 = 128 * bl + 64 * rh;
#pragma unroll
            for (int i = 0; i < 4; ++i) { const int c = tid + 512 * i, row = c >> 5, ch = c & 31;
                *(LAS u32x4*)(Qs + row * QP + 8 * ch) = *(const u32x4*)(Q + (size_t)(i0 + row) * 1024 + h * 256 + 8 * ch); }
            __syncthreads();
#pragma unroll 1
            for (int dir = 0; dir < 2; ++dir) {
                int lane_o = C.lane; asm volatile("" : "+v"(lane_o));
                const int fr = lane_o & 15, fq = lane_o >> 4;
                const float gam = 1.0f - exp2f(C.in[17][(j * 2 + dir) * 4 + h]); const float L = log2f(gam);
                f32x4 acc[4][4];
#pragma unroll
                for (int mt = 0; mt < 4; ++mt)
#pragma unroll
                    for (int nt = 0; nt < 4; ++nt) acc[mt][nt] = (f32x4){0.f, 0.f, 0.f, 0.f};
                const int kb_lo = dir == 0 ? 4 * g : bl, kb_hi = dir == 0 ? bl : gend - 1;
                bf16x8 kf[8];
                { const bf16_t* k1 = Kb + (size_t)(base + 128 * kb_lo + 16 * w + fr) * 1024 + h * 256 + 8 * fq;
#pragma unroll
                  for (int ks = 0; ks < 8; ++ks) kf[ks] = *(const bf16x8*)(k1 + 32 * ks); }
                const bf16_t* sb = Scp + ((size_t)((slot * 4 + h) * 2 + dir) * 512) * 256 + (size_t)(64 * w + 16 * (fr >> 2) + (fr & 3)) * 256 + 8 * fq;
#pragma unroll
                for (int half = 0; half < (PV == 3 ? 0 : 4); ++half) {
                    bf16x8 sf[2][4];
#pragma unroll
                    for (int k4 = 0; k4 < 2; ++k4)
#pragma unroll
                        for (int nt = 0; nt < 4; ++nt) sf[k4][nt] = *(const bf16x8*)(sb + (size_t)(4 * nt) * 256 + 32 * (2 * half + k4));
#pragma unroll
                    for (int k4 = 0; k4 < 2; ++k4)
#pragma unroll
                        for (int mt = 0; mt < 4; ++mt) { const bf16x8 qf = *(const LAS bf16x8*)(Qs + (16 * mt + fr) * QP + 32 * (2 * half + k4) + 8 * fq);
#pragma unroll
                            for (int nt = 0; nt < 4; ++nt) acc[mt][nt] = __builtin_amdgcn_mfma_f32_16x16x32_bf16(sf[k4][nt], qf, acc[mt][nt], 0, 0, 0); }
                }
#pragma unroll
                for (int mt = 0; mt < 4; ++mt) {
                    const int il = il0 + 16 * mt + fr;
                    const int ex = dir == 0 ? il - 512 * g + 1 : gend * 128 - il;
                    const float qd = __builtin_amdgcn_exp2f(L * (float)ex);
#pragma unroll
                    for (int nt = 0; nt < 4; ++nt) acc[mt][nt] = acc[mt][nt] * qd;
                }
                int pbuf = 0;
                __builtin_amdgcn_sched_barrier(0);
#pragma unroll 1
                for (int kb = kb_lo; kb <= (PV == 2 ? kb_lo - 1 : kb_hi); ++kb) {
                    const int j0 = base + 128 * kb;
                    bf16x8 vf[4][4];
                    const bf16_t* vb = Vt + (size_t)(h * 512 + 64 * w + 16 * (fr >> 2) + (fr & 3)) * R + j0 + 8 * fq;
#pragma unroll
                    for (int ks = 0; ks < 2; ++ks)
#pragma unroll
                        for (int nt = 0; nt < 4; ++nt) vf[ks][nt] = *(const bf16x8*)(vb + (size_t)(4 * nt) * R + 32 * ks);
                    f32x4 sc[4];
#pragma unroll
                    for (int mt = 0; mt < 4; ++mt) sc[mt] = (f32x4){0.f, 0.f, 0.f, 0.f};
#pragma unroll
                    for (int ks = 0; ks < 8; ++ks) {
#pragma unroll
                        for (int mt = 0; mt < 4; ++mt) { const bf16x8 qf = *(const LAS bf16x8*)(Qs + (16 * mt + fr) * QP + 32 * ks + 8 * fq);
                            sc[mt] = __builtin_amdgcn_mfma_f32_16x16x32_bf16(kf[ks], qf, sc[mt], 0, 0, 0); }
                        if (ks & 1) __builtin_amdgcn_sched_barrier(0);
                    }
                    if (kb < kb_hi) { const bf16_t* k1 = Kb + (size_t)(j0 + 128 + 16 * w + fr) * 1024 + h * 256 + 8 * fq;
#pragma unroll
                        for (int ks = 0; ks < 8; ++ks) kf[ks] = *(const bf16x8*)(k1 + 32 * ks); }
#pragma unroll
                    for (int ks = 2; ks < 4; ++ks)
#pragma unroll
                        for (int nt = 0; nt < 4; ++nt) vf[ks][nt] = *(const bf16x8*)(vb + (size_t)(4 * nt) * R + 32 * ks);
                    LAS bf16_t* P = Pb + pbuf * 64 * PP;
#pragma unroll
                    for (int mt = 0; mt < 4; ++mt) {
                        const int il = il0 + 16 * mt + fr;
                        float p[4];
#pragma unroll
                        for (int e = 0; e < 4; ++e) { const int jl = 128 * kb + 16 * w + 4 * fq + e; const int rel = dir == 0 ? il - jl : jl - il;
                            p[e] = rel >= 0 ? sc[mt][e] * __builtin_amdgcn_exp2f(L * (float)rel) : 0.f; }
                        u32x2 wv; wv.x = pk2(p[0], p[1]); wv.y = pk2(p[2], p[3]);
                        *(LAS u32x2*)(P + (16 * mt + fr) * PP + 16 * w + 4 * fq) = wv;
                    }
                    __syncthreads();
#pragma unroll
                    for (int ks = 0; ks < 4; ++ks)
#pragma unroll
                        for (int mt = 0; mt < 4; ++mt) { const bf16x8 pf = *(const LAS bf16x8*)(P + (16 * mt + fr) * PP + 32 * ks + 8 * fq);
#pragma unroll
                            for (int nt = 0; nt < 4; ++nt) acc[mt][nt] = __builtin_amdgcn_mfma_f32_16x16x32_bf16(vf[ks][nt], pf, acc[mt][nt], 0, 0, 0); }
                    pbuf ^= 1;
                    __builtin_amdgcn_sched_barrier(0);
                }
                __builtin_amdgcn_sched_barrier(0);
#pragma unroll
                for (int mt = 0; mt < 4; ++mt) {
                    float ss = 0.f;
#pragma unroll
                    for (int nt = 0; nt < 4; ++nt) ss += (acc[mt][nt][0] * acc[mt][nt][0] + acc[mt][nt][1] * acc[mt][nt][1]) + (acc[mt][nt][2] * acc[mt][nt][2] + acc[mt][nt][3] * acc[mt][nt][3]);
                    ss += __shfl_xor(ss, 16); ss += __shfl_xor(ss, 32);
                    if (fq == 0) red[(16 * mt + fr) * 8 + w] = ss;
                }
                __syncthreads();
#pragma unroll
                for (int mt = 0; mt < 4; ++mt) {
                    float tot = 0.f;
#pragma unroll
                    for (int w2 = 0; w2 < 8; ++w2) tot += red[(16 * mt + fr) * 8 + w2];
                    const float rn = 1.0f / sqrtf(tot * (1.f / 512.f) + NORM_EPS);
                    const size_t off = (size_t)(i0 + 16 * mt + fr) * 2048 + h * 512 + 64 * w + 16 * fq;
#pragma unroll
                    for (int np = 0; np < (PV == 4 ? 0 : 2); ++np) {
                        const u32x4 g4 = *(const u32x4*)((dir == 0 ? (const bf16_t*)GF : GB) + off + 8 * np);
                        float y[8];
                        y[0] = siluf(bflo(g4.x)) * acc[mt][2 * np][0] * rn; y[1] = siluf(bfhi(g4.x)) * acc[mt][2 * np][1] * rn;
                        y[2] = siluf(bflo(g4.y)) * acc[mt][2 * np][2] * rn; y[3] = siluf(bfhi(g4.y)) * acc[mt][2 * np][3] * rn;
                        y[4] = siluf(bflo(g4.z)) * acc[mt][2 * np + 1][0] * rn; y[5] = siluf(bfhi(g4.z)) * acc[mt][2 * np + 1][1] * rn;
                        y[6] = siluf(bflo(g4.w)) * acc[mt][2 * np + 1][2] * rn; y[7] = siluf(bfhi(g4.w)) * acc[mt][2 * np + 1][3] * rn;
                        if (dir == 1) { const u32x4 yp = *(const u32x4*)(GF + off + 8 * np);
                            y[0] += bflo(yp.x); y[1] += bfhi(yp.x); y[2] += bflo(yp.y); y[3] += bfhi(yp.y); y[4] += bflo(yp.z); y[5] += bfhi(yp.z); y[6] += bflo(yp.w); y[7] += bfhi(yp.w); }
                        u32x4 wv; wv.x = pk2(y[0], y[1]); wv.y = pk2(y[2], y[3]); wv.z = pk2(y[4], y[5]); wv.w = pk2(y[6], y[7]);
                        *(u32x4*)(GF + off + 8 * np) = wv;
                    }
                }
            }
        }
    }
}

__device__ __forceinline__ void phase_p0(Ctx& C) {
    float* modv = (float*)(C.ws + WS_MODV);
    for (int u = C.bid; u < 384; u += C.G) {
        const int i = u / 96, nbk = u % 96;
        gemv2_unit<1>(C, C.in[4] + (size_t)i * 1024 * 6144, 6144, 64 * nbk, C.in[1], C.in[3], C.in[5] + i * 6144, modv + (i * 2 + 0) * 6144, modv + (i * 2 + 1) * 6144, 0, 0);
    }
    float* tabc = (float*)(C.ws + WS_TABC); float* tabs = (float*)(C.ws + WS_TABS);
    for (int idx = C.bid * 512 + C.tid; idx < 320 * 64; idx += C.G * 512) {
        const int ti = idx >> 6, i = idx & 63; const float pos = (float)(ti < 256 ? ti : ti - 256);
        const float inv = exp2f(-(float)i * (13.287712379549449f / 64.0f)); const float ang = pos * inv;
        tabc[idx] = __cosf(ang); tabs[idx] = __sinf(ang);
    }
}
__device__ __forceinline__ void phase_p1(Ctx& C) {
    const float* modv = (const float*)(C.ws + WS_MODV);
    float* s1 = (float*)(C.ws + WS_S1); float* s2 = (float*)(C.ws + WS_S2);
    for (int idx = C.bid * 512 + C.tid; idx < 8192; idx += C.G * 512) {
        const int i = idx >> 11, s = (idx >> 10) & 1, k = idx & 1023;
        s1[idx] = C.in[6][i * 1024 + k] * (1.f + modv[(i * 2 + s) * 6144 + 1024 + k]);
        s2[idx] = C.in[7][i * 1024 + k] * (1.f + modv[(i * 2 + s) * 6144 + 4096 + k]);
    }
    float* cvA = (float*)(C.ws + WS_CVA); float* cvF = (float*)(C.ws + WS_CVF);
    for (int u = C.bid; u < 672; u += C.G) {
        if (u < 320) {
            int i, nbk; if (u < 32) { i = 0; nbk = u; } else if (u < 160) { i = 1; nbk = u - 32; } else if (u < 192) { i = 2; nbk = u - 160; } else { i = 3; nbk = u - 192; }
            const int j = i >> 1; const float* v0 = modv + (i * 2 + 0) * 6144; const float* v1 = modv + (i * 2 + 1) * 6144;
            if ((i & 1) == 0) gemv2_unit<0>(C, C.in[8] + (size_t)j * 1024 * 2048, 2048, 64 * nbk, v0, v1, C.in[9] + j * 2048, cvA + (i * 2) * 8192, cvA + (i * 2 + 1) * 8192, 1, 1024);
            else gemv2_unit<0>(C, C.in[16] + (size_t)j * 1024 * 8192, 8192, 64 * nbk, v0, v1, nullptr, cvA + (i * 2) * 8192, cvA + (i * 2 + 1) * 8192, 2, 0);
        } else {
            const int i = (u - 320) / 88, nbk = (u - 320) % 88;
            const float* v0 = modv + (i * 2 + 0) * 6144 + 3072; const float* v1 = modv + (i * 2 + 1) * 6144 + 3072;
            gemv2_unit<0>(C, C.in[19] + (size_t)i * 1024 * FF2, FF2, 64 * nbk, v0, v1, nullptr, cvF + (i * 2) * FF2, cvF + (i * 2 + 1) * FF2, 1, DFF);
        }
    }
    bf16_t* xs = (bf16_t*)(C.ws + WS_XS); float* stats = (float*)(C.ws + WS_STATS); float* xctx = (float*)(C.ws + WS_XCTX);
    for (int row = C.bid * 8 + C.wave; row < R; row += C.G * 8) {
        const bool lat = row < T; const int s = lat ? 0 : 1;
        const float* src = lat ? C.in[0] + (size_t)row * 1024 : C.in[2] + (size_t)(row - T) * 1024;
        float* dst = lat ? C.out + (size_t)row * 1024 : xctx + (size_t)(row - T) * 1024;
        float ss = 0.f;
#pragma unroll
        for (int jj = 0; jj < 4; ++jj) {
            const int k = 4 * C.lane + 256 * jj;
            const f32x4 v = *(const f32x4*)(src + k); *(f32x4*)(dst + k) = v;
            ss += (v[0] * v[0] + v[1] * v[1]) + (v[2] * v[2] + v[3] * v[3]);
            const f32x4 g = *(const f32x4*)(C.in[6] + k), m = *(const f32x4*)(modv + s * 6144 + 1024 + k);
            u32x2 w; w.x = pk2(v[0] * g[0] * (1.f + m[0]), v[1] * g[1] * (1.f + m[1])); w.y = pk2(v[2] * g[2] * (1.f + m[2]), v[3] * g[3] * (1.f + m[3]));
            *(u32x2*)(xs + (size_t)row * 1024 + k) = w;
        }
#pragma unroll
        for (int off = 1; off < 64; off <<= 1) ss += __shfl_xor(ss, off);
        if (C.lane < 16) stats[(size_t)row * 16 + C.lane] = C.lane == 0 ? ss : 0.f;
    }
    prep_layer(C, 0, 3, 0);
}
__device__ __forceinline__ void phase_final(Ctx& C) {
    const float* stats = (const float*)(C.ws + WS_STATS);
    for (int row = C.bid * 8 + C.wave; row < T; row += C.G * 8) {
        float s = C.lane < 16 ? stats[(size_t)row * 16 + C.lane] : 0.f;
#pragma unroll
        for (int off = 1; off < 64; off <<= 1) s += __shfl_xor(s, off);
        const float r = 1.0f / sqrtf(s * (1.f / 1024.f) + NORM_EPS);
        float* xr = C.out + (size_t)row * 1024;
#pragma unroll
        for (int jj = 0; jj < 4; ++jj) { const int k = 4 * C.lane + 256 * jj; const f32x4 v = *(const f32x4*)(xr + k), g = *(const f32x4*)(C.in[21] + k); *(f32x4*)(xr + k) = v * r * g; }
    }
}

constexpr int NPHASE = 31;
__device__ __forceinline__ void run_phase(Ctx& C, int ph) {
    const int i = (ph - 2) / 7, sub = (ph - 2) % 7, j = i >> 1; const bool conv = (i & 1) == 0;
    const bool last = i == DEPTH - 1;
    float* stats = (float*)(C.ws + WS_STATS);
    const bf16_t* xs = (const bf16_t*)(C.ws + WS_XS);
    constexpr int F_MODV = (int)(WS_MODV / 4), F_S1 = (int)(WS_S1 / 4), F_S2 = (int)(WS_S2 / 4), F_CVA = (int)(WS_CVA / 4), F_CVF = (int)(WS_CVF / 4);
    if (sub == 1) {
        if (conv) { EpiGLU E{C.ws, F_CVA + (i * 2) * 8192, 8192, (int)WS_U, 1024, 0, stats}; gemm_both(C, xs, (const bf16_t*)(C.ws + WS_WA), T, 2048, 1024, E, 0, 8); }
        else {
            EpiWin E{C.ws, F_CVA + (i * 2) * 8192, stats};
            const bf16_t* WA = (const bf16_t*)(C.ws + WS_WA);
            gemm_both(C, xs, WA, T, 8192, 1024, E, 0, 0, 0, 8);
            { pg8::Gemm g{xs, WA + (size_t)2048 * 1024, T, 2048, 1024}; pg8::StaticOrder S; S.init(T, 2048, C.G, C.bid); EpiVt EV{C.ws, F_CVA + (i * 2) * 8192};
              pg8::gemm_phase<EpiVt, pg8::StaticOrder, true, true, true>(C.lds, g, S, EV); }
            gemm_both(C, xs, WA, T, 8192, 1024, E, last ? 4 : 0, last ? 16 : 32, 16, 32);
        }
    } else if (sub == 5) {
        EpiGLU E{C.ws, F_CVF + (i * 2) * FF2, FF2, (int)WS_H, DFF, 1, stats}; gemm_both(C, xs, (const bf16_t*)(C.ws + WS_WF1), last ? T : R, FF2, 1024, E, 0, 0);
        if (!last) { __syncthreads(); prep_layer(C, i + 1, 1, C.G == 256 ? 128 : 0); }
    } else {
        const bool f2 = sub == 6;
        const int mgoff = F_MODV + (i * 2) * 6144 + (f2 ? 5120 : 2048);
        const int snoff = f2 ? (last ? -1 : F_S1 + ((i + 1) * 2) * 1024) : F_S2 + (i * 2) * 1024;
        const float* bias = (!f2 && conv) ? C.in[15] + j * 1024 : nullptr;
        const bf16_t* A = (const bf16_t*)(C.ws + (f2 ? WS_H : (conv ? WS_A2 : WS_GF)));
        const bf16_t* Bt = (const bf16_t*)(C.ws + (f2 ? WS_WF2 : WS_WA2));
        const int K = f2 ? DFF : (conv ? 1024 : 2048);
        EpiRes E{C.ws, C.out, bias, mgoff, snoff, stats};
        gemm_both(C, A, Bt, T, 1024, K, E, 0, last ? 0 : 4);
    }
}

#define XB_TMO      128
#define XB_XCNT(j)  (256  + 64 * (j))
#define XB_XSUB(j)  (1280 + 64 * (j))
#define XB_XGEN(j)  (2304 + 64 * (j))
#define XB_TOP      3328
#define XB_TOPGEN   3392
#define XCD_BAR_WORDS 3456
#define XB_SPIN_CAP (1u << 20)
__device__ __forceinline__ unsigned xb_ld(unsigned* p)              { return __hip_atomic_load(p, __ATOMIC_RELAXED, __HIP_MEMORY_SCOPE_AGENT); }
__device__ __forceinline__ unsigned xb_add(unsigned* p, unsigned v) { return __hip_atomic_fetch_add(p, v, __ATOMIC_RELAXED, __HIP_MEMORY_SCOPE_AGENT); }
__device__ __forceinline__ unsigned xb_xcc_id() { return (unsigned)__builtin_amdgcn_s_getreg((3 << 11) | 20) & 0xFu; }
#define XB_SPIN(cond, bar) do { unsigned _sp = 0; while (cond) { __builtin_amdgcn_s_sleep(1); \
    if ((++_sp & 255u) == 0u) { if (xb_ld(&(bar)[XB_TMO])) break; if (_sp > XB_SPIN_CAP) { atomicAdd(&(bar)[XB_TMO], 1u); break; } } } } while (0)
struct XcdBarrier { unsigned* bar; unsigned x; volatile LAS unsigned* st; };
__device__ __forceinline__ XcdBarrier xcd_barrier_post(unsigned* bar, volatile LAS unsigned* st) {
    XcdBarrier b; b.bar = bar; b.x = xb_xcc_id(); b.st = st;
    if (threadIdx.x == 0) (void)xb_add(&bar[XB_XCNT(b.x)], 1u);
    return b;
}
__device__ __forceinline__ void xcd_barrier_complete(unsigned* bar, unsigned x, unsigned& nloc, unsigned& nx) {
    const unsigned G = gridDim.x * gridDim.y * gridDim.z;
    unsigned sum, cnt, mine, sp = 0u;
    for (;;) {
        sum = 0u; cnt = 0u; mine = 0u;
#pragma unroll
        for (unsigned j = 0; j < 16; ++j) { const unsigned c = xb_ld(&bar[XB_XCNT(j)]); sum += c; cnt += (c > 0u) ? 1u : 0u; mine = (j == x) ? c : mine; }
        if (sum == G) break;
        __builtin_amdgcn_s_sleep(1);
        if ((++sp & 255u) == 0u) { if (xb_ld(&bar[XB_TMO])) break; if (sp > XB_SPIN_CAP) { atomicAdd(&bar[XB_TMO], 1u); break; } }
    }
    nloc = mine > 0u ? mine : 1u; nx = cnt > 0u ? cnt : 1u;
}
__device__ __forceinline__ void xcd_barrier(const XcdBarrier& b) {
    asm volatile("s_waitcnt vmcnt(0)" ::: "memory");
    __syncthreads();
    if (threadIdx.x == 0) {
        unsigned* bar = b.bar;
        __builtin_amdgcn_s_waitcnt(0);
        unsigned nloc = b.st[0], nx = b.st[1];
        if (nloc == 0u) { xcd_barrier_complete(bar, b.x, nloc, nx); b.st[0] = nloc; b.st[1] = nx; }
        const unsigned old = xb_add(&bar[XB_XSUB(b.x)], 1u);
        const unsigned gen = old / nloc;
        if (old + 1u == (gen + 1u) * nloc) {
            __builtin_amdgcn_fence(__ATOMIC_RELEASE, "agent");
            asm volatile("s_waitcnt vmcnt(0)" ::: "memory");
            const unsigned og = xb_add(&bar[XB_TOP], 1u);
            const unsigned tg = og / nx;
            if (og + 1u == (tg + 1u) * nx) xb_add(&bar[XB_TOPGEN], 1u);
            else XB_SPIN(xb_ld(&bar[XB_TOPGEN]) == tg, bar);
            __builtin_amdgcn_fence(__ATOMIC_ACQUIRE, "agent");
            xb_add(&bar[XB_XGEN(b.x)], 1u);
            asm volatile("s_waitcnt vmcnt(0)" ::: "memory");
        } else {
            XB_SPIN(xb_ld(&bar[XB_XGEN(b.x)]) == gen, bar);
            __builtin_amdgcn_fence(__ATOMIC_ACQUIRE, "agent");
            asm volatile("s_waitcnt vmcnt(0)" ::: "memory");
        }
    }
    __syncthreads();
}
constexpr int MISC_OFF = 131072 + 320;
constexpr int CW_BAR = 4096;

#ifndef PROBE_DUP
#define PROBE_DUP 0
#endif
#if ONE_LAUNCH
template <int PH> __device__ __forceinline__ void phase_body(Ctx& C) {
    constexpr int i = (PH - 2) / 7, sub = (PH - 2) % 7, j = i >> 1; constexpr bool conv = (i & 1) == 0;
    if (PH == 0) phase_p0(C);
    else if (PH == 1) phase_p1(C);
    else if (PH == 30) phase_final(C);
    else if (sub == 0) { }
    else if (sub == 2) { if (i > 0) { prep_layer(C, i, 2, 0); __syncthreads(); } if (conv) dwconv_phase(C, j); else scan_phase(C, j); }
    else if (sub == 3) readout_phase(C, j, i == DEPTH - 1);
    else run_phase(C, PH);
}
template <int PH> __device__ __forceinline__ void one_phase(Ctx& C, const Args& args, const XcdBarrier& bar) {
    if (PH < args.ph_lo || PH >= args.ph_hi) return;
    constexpr int i = (PH - 2) / 7, sub = (PH - 2) % 7; constexpr bool conv = (i & 1) == 0;
    if (PH >= 2 && PH < 30) { if (sub == 0) return; if (sub == 3 && conv) return; }
    if (PH > args.ph_lo) xcd_barrier(bar);
    phase_body<PH>(C);
    constexpr bool dup = ((PH >= 2 && PH < 30) && (((PROBE_DUP & 1) && (sub == 1 || sub == 5)) || ((PROBE_DUP & 2) && sub == 2 && !conv) || ((PROBE_DUP & 4) && sub == 2 && conv) || ((PROBE_DUP & 8) && sub == 0))) || ((PROBE_DUP & 16) && PH < 2);
    if constexpr (dup) { xcd_barrier(bar); phase_body<PH>(C); }
}
template <int... PHS> __device__ __forceinline__ void all_phases(Ctx& C, const Args& args, const XcdBarrier& bar, std::integer_sequence<int, PHS...>) { (one_phase<PHS>(C, args, bar), ...); }
__global__ void __launch_bounds__(512, 2) mega_kernel(Args args) {
    extern __shared__ __attribute__((aligned(16))) unsigned char lds_raw[];
    Ctx C;
    C.lds = (LAS unsigned char*)lds_raw; C.tid = threadIdx.x; C.lane = C.tid & 63; C.wave = __builtin_amdgcn_readfirstlane(C.tid >> 6); C.G = gridDim.x; C.bid = blockIdx.x;
    C.in = args.in; C.out = args.out; C.ws = args.ws;
    volatile LAS unsigned* MISC = (volatile LAS unsigned*)(C.lds + MISC_OFF);
    if (C.tid < 32) MISC[C.tid] = 0u;
    __syncthreads();
    XcdBarrier bar = xcd_barrier_post((unsigned*)(C.ws + WS_CTL) + CW_BAR, MISC + 8);
    all_phases(C, args, bar, std::make_integer_sequence<int, NPHASE>{});
}

#endif
template <int KIND>
__global__ void __launch_bounds__(512, 2) phase_kernel(Args args) {
    extern __shared__ __attribute__((aligned(16))) unsigned char lds_raw[];
    Ctx C;
    C.lds = (LAS unsigned char*)lds_raw; C.tid = threadIdx.x; C.lane = C.tid & 63; C.wave = __builtin_amdgcn_readfirstlane(C.tid >> 6); C.G = gridDim.x; C.bid = blockIdx.x;
    C.in = args.in; C.out = args.out; C.ws = args.ws;
    const int ph = args.ph_lo;
    if (KIND == 0) phase_p0(C);
    else if (KIND == 1) phase_p1(C);
    else if (KIND == 30) phase_final(C);
    else {
        const int i = (ph - 2) / 7, j = i >> 1; const bool conv = (i & 1) == 0;
        if (KIND == 2) { }
        else if (KIND == 4) { if (i > 0) { prep_layer(C, i, 2, 0); __syncthreads(); } if (conv) dwconv_phase(C, j); else scan_phase(C, j); }
        else if (KIND == 5) readout_phase(C, j, i == DEPTH - 1);
        else run_phase(C, ph);
    }
}

#ifndef PROBE_RD
#define PROBE_RD 0
#endif
#if PROBE_RD
__global__ void __launch_bounds__(512, 2) probe_read_kernel(Args args) {
    extern __shared__ __attribute__((aligned(16))) unsigned char lds_raw[];
    Ctx C;
    C.lds = (LAS unsigned char*)lds_raw; C.tid = threadIdx.x; C.lane = C.tid & 63; C.wave = __builtin_amdgcn_readfirstlane(C.tid >> 6); C.G = gridDim.x; C.bid = blockIdx.x;
    C.in = args.in; C.out = args.out; C.ws = args.ws;
    readout_phase<PROBE_RD>(C, 1, true);
}
#endif
extern "C" void kernel_launch(void* const* d_in, const int* in_sizes, int n_in, void* d_out, int out_size, void* d_ws, size_t ws_size, hipStream_t stream) {
    static int grid = 0;
    if (grid == 0) {
        if (n_in != 22 || out_size != T * D || ws_size < WS_END + (PROBE_RD ? 20 * MiB : 0)) { fprintf(stderr, "kernel_launch: unexpected problem (n_in %d out %d ws %zu, need %zu)\n", n_in, out_size, ws_size, (size_t)WS_END); grid = -1; return; }
        int dev = 0, cus = 0;
        if (hipGetDevice(&dev) != hipSuccess || hipDeviceGetAttribute(&cus, hipDeviceAttributeMultiprocessorCount, dev) != hipSuccess) { grid = -1; return; }
        bool ok = true;
        ok &= hipFuncSetAttribute((const void*)phase_kernel<0>, hipFuncAttributeMaxDynamicSharedMemorySize, LDS_BYTES) == hipSuccess;
        ok &= hipFuncSetAttribute((const void*)phase_kernel<1>, hipFuncAttributeMaxDynamicSharedMemorySize, LDS_BYTES) == hipSuccess;
        ok &= hipFuncSetAttribute((const void*)phase_kernel<2>, hipFuncAttributeMaxDynamicSharedMemorySize, LDS_BYTES) == hipSuccess;
        ok &= hipFuncSetAttribute((const void*)phase_kernel<3>, hipFuncAttributeMaxDynamicSharedMemorySize, LDS_BYTES) == hipSuccess;
        ok &= hipFuncSetAttribute((const void*)phase_kernel<4>, hipFuncAttributeMaxDynamicSharedMemorySize, LDS_BYTES) == hipSuccess;
        ok &= hipFuncSetAttribute((const void*)phase_kernel<5>, hipFuncAttributeMaxDynamicSharedMemorySize, LDS_BYTES) == hipSuccess;
        ok &= hipFuncSetAttribute((const void*)phase_kernel<30>, hipFuncAttributeMaxDynamicSharedMemorySize, LDS_BYTES) == hipSuccess;
#if ONE_LAUNCH
        ok &= hipFuncSetAttribute((const void*)mega_kernel, hipFuncAttributeMaxDynamicSharedMemorySize, LDS_BYTES) == hipSuccess;
#endif
        if (!ok) { fprintf(stderr, "kernel_launch: hipFuncSetAttribute failed\n"); grid = -1; return; }
        grid = cus > 0 ? cus : 256;
    }
    if (grid < 0) return;
    Args a{};
    for (int i = 0; i < 22; ++i) a.in[i] = (const float*)d_in[i];
    a.out = (float*)d_out; a.ws = (unsigned char*)d_ws;
#if ONE_LAUNCH
    if (hipMemsetAsync((char*)d_ws + WS_CTL, 0, 65536, stream) != hipSuccess) { fprintf(stderr, "kernel_launch: memset failed\n"); return; }
    a.ph_lo = 0; a.ph_hi = NPHASE;
    hipLaunchKernelGGL(mega_kernel, dim3(grid), dim3(512), LDS_BYTES, stream, a);
    return;
#endif
    for (int ph = 0; ph < NPHASE; ++ph) {
        const int i = (ph - 2) / 7, sub = (ph - 2) % 7;
        if (ph >= 2 && ph < 30) { if (sub == 0) continue; if (sub == 3 && (i & 1) == 0) continue; }
        a.ph_lo = ph; a.ph_hi = ph + 1;
        const dim3 g(grid), b(512);
        if (ph == 0) hipLaunchKernelGGL(phase_kernel<0>, g, b, LDS_BYTES, stream, a);
        else if (ph == 1) hipLaunchKernelGGL(phase_kernel<1>, g, b, LDS_BYTES, stream, a);
        else if (ph == 30) hipLaunchKernelGGL(phase_kernel<30>, g, b, LDS_BYTES, stream, a);
        else if (sub == 0) hipLaunchKernelGGL(phase_kernel<2>, g, b, LDS_BYTES, stream, a);
        else if (sub == 2) hipLaunchKernelGGL(phase_kernel<4>, g, b, LDS_BYTES, stream, a);
        else if (sub == 3) hipLaunchKernelGGL(phase_kernel<5>, g, b, LDS_BYTES, stream, a);
        else hipLaunchKernelGGL(phase_kernel<3>, g, b, LDS_BYTES, stream, a);
#ifdef PROBE_G
        if (ph == 30) { Args a2 = a; a2.ph_lo = PROBE_G; a2.ph_hi = PROBE_G + 1; hipLaunchKernelGGL(phase_kernel<3>, g, b, LDS_BYTES, stream, a2); }
#endif
#if PROBE_RD
        if (ph == 30) { hipFuncSetAttribute((const void*)probe_read_kernel, hipFuncAttributeMaxDynamicSharedMemorySize, LDS_BYTES); hipLaunchKernelGGL(probe_read_kernel, g, b, LDS_BYTES, stream, a); }
#endif
        {   const bool conv = (i & 1) == 0;
            const bool dup = ((ph >= 2 && ph < 30) && (((PROBE_DUP & 1) && (sub == 1 || sub == 5)) || ((PROBE_DUP & 2) && sub == 2 && !conv) || ((PROBE_DUP & 4) && sub == 2 && conv) || ((PROBE_DUP & 8) && sub == 0))) || ((PROBE_DUP & 16) && ph < 2);
            if (dup) {
                if (ph == 0) hipLaunchKernelGGL(phase_kernel<0>, g, b, LDS_BYTES, stream, a);
                else if (ph == 1) hipLaunchKernelGGL(phase_kernel<1>, g, b, LDS_BYTES, stream, a);
                else if (sub == 0) hipLaunchKernelGGL(phase_kernel<2>, g, b, LDS_BYTES, stream, a);
                else if (sub == 2) hipLaunchKernelGGL(phase_kernel<4>, g, b, LDS_BYTES, stream, a);
                else hipLaunchKernelGGL(phase_kernel<3>, g, b, LDS_BYTES, stream, a);
            } }
    }
}
```

```cpp
#include <hip/hip_runtime.h>
#include <cstdio>
#include <cstdint>
#include <utility>

#ifndef ONE_LAUNCH
#define ONE_LAUNCH 1
#endif

typedef unsigned short bf16_t;
typedef short bf16x8 __attribute__((ext_vector_type(8)));
typedef float f32x4 __attribute__((ext_vector_type(4)));
typedef float f32x2 __attribute__((ext_vector_type(2)));
typedef unsigned u32x2 __attribute__((ext_vector_type(2)));
typedef unsigned u32x4 __attribute__((ext_vector_type(4)));
typedef __bf16 bf16x2_t __attribute__((ext_vector_type(2)));
typedef short s16x4 __attribute__((ext_vector_type(4)));
#define LAS __attribute__((address_space(3)))

constexpr int D = 1024, T = 16384, TC = 256, R = T + TC, NH = 4, DK = 256, DV = 512, QKW = 1024, VW = 2048, INW = 8192, DFF = 2816, FF2 = 5632, CK = 31, DEPTH = 4;
constexpr int NSLOT = 33;
constexpr float NORM_EPS = 1e-6f, LN_EPS = 1e-5f;

constexpr size_t MiB = 1u << 20, KiB = 1u << 10;
constexpr size_t WS_CTL = 0, CTL_ZERO_BYTES = 1 * MiB;
constexpr size_t WS_MODV = 1 * MiB;
constexpr size_t WS_S1 = 1 * MiB + 256 * KiB;
constexpr size_t WS_S2 = 1 * MiB + 320 * KiB;
constexpr size_t WS_CVA = 1 * MiB + 384 * KiB;
constexpr size_t WS_CVF = 1 * MiB + 640 * KiB;
constexpr size_t WS_TABC = 1 * MiB + 832 * KiB;
constexpr size_t WS_TABS = 1 * MiB + 912 * KiB;
constexpr size_t WS_STATS = 2 * MiB;
constexpr size_t WS_XCTX = 4 * MiB;
constexpr size_t WS_WA = 8 * MiB;
constexpr size_t WS_WA2 = 24 * MiB;
constexpr size_t WS_WF1 = 28 * MiB;
constexpr size_t WS_WF2 = 40 * MiB;
constexpr size_t WS_XS = 48 * MiB;
constexpr size_t WS_SCP = 48 * MiB;
constexpr size_t WS_BIG = 114 * MiB;
constexpr size_t WS_Q = WS_BIG, WS_K = WS_BIG + 33 * MiB, WS_VT = WS_BIG + 66 * MiB, WS_GF = WS_BIG + 131 * MiB, WS_GB = WS_BIG + 196 * MiB;
constexpr size_t WS_U = WS_BIG, WS_A2 = WS_BIG + 33 * MiB, WS_H = WS_BIG;
constexpr size_t WS_END = WS_BIG + 261 * MiB;
static_assert((size_t)R * 1024 * 2 <= 33 * MiB && (size_t)R * 2048 * 2 <= 65 * MiB && (size_t)R * DFF * 2 <= 131 * MiB, "map");
static_assert((size_t)NSLOT * 8 * 512 * 256 * 2 <= 66 * MiB, "scp");

constexpr int LDS_BYTES = 147456;

__device__ __forceinline__ unsigned pk2(float lo, float hi) { f32x2 v = {lo, hi}; bf16x2_t b = __builtin_convertvector(v, bf16x2_t); return __builtin_bit_cast(unsigned, b); }
__device__ __forceinline__ float bflo(unsigned u) { return __uint_as_float(u << 16); }
__device__ __forceinline__ float bfhi(unsigned u) { return __uint_as_float(u & 0xffff0000u); }
__device__ __forceinline__ float sigmf(float x) { return __builtin_amdgcn_rcpf(1.f + __builtin_amdgcn_exp2f(-1.4426950408889634f * x)); }
__device__ __forceinline__ float siluf(float x) { return x * sigmf(x); }
__device__ __forceinline__ float wave_sum63(float v) {
    v += __builtin_bit_cast(float, __builtin_amdgcn_update_dpp(0, __builtin_bit_cast(int, v), 0xB1, 0xF, 0xF, false));
    v += __builtin_bit_cast(float, __builtin_amdgcn_update_dpp(0, __builtin_bit_cast(int, v), 0x4E, 0xF, 0xF, false));
    v += __builtin_bit_cast(float, __builtin_amdgcn_update_dpp(0, __builtin_bit_cast(int, v), 0x141, 0xF, 0xF, false));
    v += __builtin_bit_cast(float, __builtin_amdgcn_update_dpp(0, __builtin_bit_cast(int, v), 0x140, 0xF, 0xF, false));
    v += __builtin_bit_cast(float, __builtin_amdgcn_update_dpp(0, __builtin_bit_cast(int, v), 0x142, 0xA, 0xF, false));
    v += __builtin_bit_cast(float, __builtin_amdgcn_update_dpp(0, __builtin_bit_cast(int, v), 0x143, 0xC, 0xF, false));
    return v;
}
__device__ __forceinline__ int perm_glu(int n, int H) { if (n < H) return 32 * (n >> 4) + (n & 15); const int n2 = n - H; return 32 * (n2 >> 4) + 16 + (n2 & 15); }
__device__ __forceinline__ int perm_win(int n) {
    if (n >= 2 * QKW) return n;
    const int part = n >> 10, hn = n & 1023, h = hn >> 8, d = hn & 255, quarter = d >> 6, idx = d & 63;
    const int Gp = (quarter >> 1) * 4 + (idx >> 4), i = (quarter & 1) * 16 + (idx & 15);
    return part * 1024 + h * 256 + 32 * Gp + i;
}
__device__ __forceinline__ int perm_any(int mode, int n, int H) { return mode == 0 ? n : (mode == 1 ? perm_glu(n, H) : perm_win(n)); }

struct Args { const float* in[22]; float* out; unsigned char* ws; int ph_lo, ph_hi; };

struct Ctx {
    LAS unsigned char* lds;
    int tid, lane, wave, G, bid;
    const float* const* in; float* out; unsigned char* ws;
};

template <int VSILU>
__device__ __forceinline__ void gemv2_unit(Ctx& C, const float* W, int N, int n0, const float* v0, const float* v1, const float* bias, float* o0, float* o1, int pmode, int H) {
    LAS float* red = (LAS float*)C.lds;
    const int c4 = C.tid & 15, ks = C.tid >> 4;
    f32x4 a0 = {0.f, 0.f, 0.f, 0.f}, a1 = {0.f, 0.f, 0.f, 0.f};
#pragma unroll 8
    for (int i = 0; i < 32; ++i) {
        const int k = ks * 32 + i;
        const f32x4 w = *(const f32x4*)(W + (size_t)k * N + n0 + 4 * c4);
        float x0 = v0[k], x1 = v1[k];
        if (VSILU) { x0 = siluf(x0); x1 = siluf(x1); }
        a0 += w * x0; a1 += w * x1;
    }
#pragma unroll
    for (int e = 0; e < 4; ++e) { red[(ks * 2 + 0) * 64 + 4 * c4 + e] = a0[e]; red[(ks * 2 + 1) * 64 + 4 * c4 + e] = a1[e]; }
    __syncthreads();
    if (C.tid < 128) {
        const int s = C.tid >> 6, col = C.tid & 63; float sum = 0.f;
#pragma unroll 8
        for (int k2 = 0; k2 < 32; ++k2) sum += red[(k2 * 2 + s) * 64 + col];
        const int n = n0 + col; if (bias) sum += bias[n];
        (s ? o1 : o0)[perm_any(pmode, n, H)] = sum;
    }
    __syncthreads();
}

__device__ __forceinline__ void transpose_item(const float* W, int K, int N, bf16_t* WT, int pmode, int H, LAS float* scr, int item, int lane) {
    const int nblk = N / 32, kb = item / nblk, nb = item % nblk, k0 = 64 * kb, n0 = 32 * nb;
    {   f32x4 v[8];
#pragma unroll
        for (int i = 0; i < 8; ++i) v[i] = *(const f32x4*)(W + (size_t)(k0 + 8 * i + (lane >> 3)) * N + n0 + 4 * (lane & 7));
#pragma unroll
        for (int i = 0; i < 8; ++i) { LAS float* d = scr + (8 * i + (lane >> 3)) * 33 + 4 * (lane & 7); d[0] = v[i][0]; d[1] = v[i][1]; d[2] = v[i][2]; d[3] = v[i][3]; } }
    asm volatile("s_waitcnt lgkmcnt(0)" ::: "memory");
    const int c = lane & 7;
#pragma unroll
    for (int j = 0; j < 4; ++j) { const int n = (lane >> 3) + 8 * j; const LAS float* s = scr + (8 * c) * 33 + n;
        u32x4 o; o.x = pk2(s[0 * 33], s[1 * 33]); o.y = pk2(s[2 * 33], s[3 * 33]); o.z = pk2(s[4 * 33], s[5 * 33]); o.w = pk2(s[6 * 33], s[7 * 33]);
        *(u32x4*)(WT + (size_t)perm_any(pmode, n0 + n, H) * K + k0 + 8 * c) = o; }
    asm volatile("s_waitcnt lgkmcnt(0)" ::: "memory");
}
__device__ __forceinline__ void prep_layer(Ctx& C, int i, int part, int cu_lo) {
    if (C.bid < cu_lo) return;
    LAS float* scr = (LAS float*)(C.lds + C.wave * 16384);
    const int gw = (C.bid - cu_lo) * 8 + C.wave, NGW = (C.G - cu_lo) * 8, j = i >> 1;
    bf16_t* WA = (bf16_t*)(C.ws + WS_WA); bf16_t* WA2 = (bf16_t*)(C.ws + WS_WA2); bf16_t* WF1 = (bf16_t*)(C.ws + WS_WF1); bf16_t* WF2 = (bf16_t*)(C.ws + WS_WF2);
    const bool conv = (i & 1) == 0;
    const int I_A = (part & 1) ? (conv ? 16 * 64 : 16 * 256) : 0, I_A2 = (part & 1) ? (conv ? 16 * 32 : 32 * 32) : 0, I_F1 = (part & 2) ? 16 * 176 : 0, I_F2 = (part & 2) ? 44 * 32 : 0;
    const int NIT = I_A + I_A2 + I_F1 + I_F2;
    for (int it = gw; it < NIT; it += NGW) {
        int r = it;
        if (r < I_A) { if (conv) transpose_item(C.in[8] + (size_t)j * 1024 * 2048, 1024, 2048, WA, 1, 1024, scr, r, C.lane);
                       else transpose_item(C.in[16] + (size_t)j * 1024 * 8192, 1024, 8192, WA, 2, 0, scr, r, C.lane); continue; } r -= I_A;
        if (r < I_A2) { if (conv) transpose_item(C.in[14] + (size_t)j * 1024 * 1024, 1024, 1024, WA2, 0, 0, scr, r, C.lane);
                        else transpose_item(C.in[18] + (size_t)j * 2048 * 1024, 2048, 1024, WA2, 0, 0, scr, r, C.lane); continue; } r -= I_A2;
        if (r < I_F1) { transpose_item(C.in[19] + (size_t)i * 1024 * FF2, 1024, FF2, WF1, 1, DFF, scr, r, C.lane); continue; } r -= I_F1;
        transpose_item(C.in[20] + (size_t)i * DFF * 1024, DFF, 1024, WF2, 0, 0, scr, r, C.lane);
    }
}

__device__ __forceinline__ float row_rs(const float* stats, int row, int fq) {
    const f32x4 p = *(const f32x4*)(stats + (size_t)row * 16 + 4 * fq);
    float s = (p[0] + p[1]) + (p[2] + p[3]);
    s += __shfl_xor(s, 16); s += __shfl_xor(s, 32);
    return 1.0f / sqrtf(s * (1.0f / 1024.0f) + NORM_EPS);
}
struct EpiGLU {
    static constexpr bool STATS = false, NEEDRS = true;
    unsigned char* ws; int cvoff  , cvstride  , outoff  , ldo, act;
    float* stats;
    __device__ __forceinline__ float row_begin(int row, int fq) const { return row_rs((const float*)(ws + WS_STATS), row, fq); }
    __device__ __forceinline__ float item(int row, int colp, f32x4 v0, f32x4 v1, float rs) const {
        const float* cv = (const float*)ws + cvoff + (row < T ? 0 : cvstride);
        const f32x4 ca = *(const f32x4*)(cv + colp), cg = *(const f32x4*)(cv + colp + 16);
        float o[4];
#pragma unroll
        for (int e = 0; e < 4; ++e) { const float a = rs * v0[e] + ca[e], g = rs * v1[e] + cg[e]; o[e] = act == 0 ? a * sigmf(g) : siluf(a) * g; }
        const int oc = (colp >> 5) * 16 + (colp & 15);
        u32x2 w; w.x = pk2(o[0], o[1]); w.y = pk2(o[2], o[3]);
        *(u32x2*)((bf16_t*)(ws + outoff) + (size_t)row * ldo + oc) = w;
        return 0.f;
    }
};
struct EpiRes {
    static constexpr bool STATS = true, NEEDRS = false;
    unsigned char* ws; float* xl; const float* bias; int mgoff  , snoff  ;
    float* stats;
    __device__ __forceinline__ float row_begin(int, int) const { return 1.f; }
    __device__ __forceinline__ float item(int row, int colp, f32x4 v0, f32x4 v1, float) const {
        const bool lat = row < T;
        float* xr = lat ? xl + (size_t)row * 1024 : (float*)(ws + WS_XCTX) + (size_t)(row - T) * 1024;
        const float* mg = (const float*)ws + mgoff + (lat ? 0 : 6144); const float* sn = (const float*)ws + snoff + (lat ? 0 : 1024);
        bf16_t* xs = (bf16_t*)(ws + WS_XS);
        float ss = 0.f;
#pragma unroll
        for (int hlf = 0; hlf < 2; ++hlf) {
            const int c = colp + 16 * hlf; const f32x4 v = hlf ? v1 : v0;
            const f32x4 xo = *(const f32x4*)(xr + c), m4 = *(const f32x4*)(mg + c);
            f32x4 b4 = {0.f, 0.f, 0.f, 0.f}; if (bias) b4 = *(const f32x4*)(bias + c);
            const f32x4 xn = xo + m4 * (v + b4);
            *(f32x4*)(xr + c) = xn;
            ss += (xn[0] * xn[0] + xn[1] * xn[1]) + (xn[2] * xn[2] + xn[3] * xn[3]);
            if (snoff >= 0) { const f32x4 s4 = *(const f32x4*)(sn + c); u32x2 w; w.x = pk2(xn[0] * s4[0], xn[1] * s4[1]); w.y = pk2(xn[2] * s4[2], xn[3] * s4[3]);
                *(u32x2*)(xs + (size_t)row * 1024 + c) = w; }
        }
        return ss;
    }
};
struct EpiWin {
    static constexpr bool STATS = false, NEEDRS = true;
    unsigned char* ws; int cvoff;
    float* stats;
    __device__ __forceinline__ float row_begin(int row, int fq) const { return row_rs((const float*)(ws + WS_STATS), row, fq); }
    __device__ __forceinline__ float item(int row, int colp, f32x4 v0, f32x4 v1, float rs) const {
        const float* cv = (const float*)ws + cvoff + (row < T ? 0 : 8192);
        const f32x4 c0 = *(const f32x4*)(cv + colp), c1 = *(const f32x4*)(cv + colp + 16);
        f32x4 a = v0 * rs + c0, b = v1 * rs + c1;
        if (colp < 2048) {
            if (row < T) {
                const int Gp = (colp >> 5) & 7, idx0 = 16 * (Gp & 3) + (colp & 15);
                const int ti = (Gp >> 2) ? 256 + (row & 63) : (row >> 6);
                const f32x4 cs = *(const f32x4*)((const float*)(ws + WS_TABC) + ti * 64 + idx0), sn = *(const f32x4*)((const float*)(ws + WS_TABS) + ti * 64 + idx0);
                const f32x4 o1 = a * cs - b * sn, o2 = b * cs + a * sn; a = o1; b = o2;
            }
            bf16_t* dst = (bf16_t*)(ws + WS_Q);
            if (colp >= 1024) { dst = (bf16_t*)(ws + WS_K); a = a * 0.0625f; b = b * 0.0625f; }
            const int c = colp & 1023;
            u32x2 w; w.x = pk2(a[0], a[1]); w.y = pk2(a[2], a[3]); *(u32x2*)(dst + (size_t)row * 1024 + c) = w;
            w.x = pk2(b[0], b[1]); w.y = pk2(b[2], b[3]); *(u32x2*)(dst + (size_t)row * 1024 + c + 16) = w;
        } else if (colp < 4096) {
            const int c = colp - 2048;
            bf16_t* vt = (bf16_t*)(ws + WS_VT);
#pragma unroll
            for (int e = 0; e < 4; ++e) { vt[(size_t)(c + e) * R + row] = (bf16_t)(pk2(a[e], 0.f) & 0xffffu); vt[(size_t)(c + 16 + e) * R + row] = (bf16_t)(pk2(b[e], 0.f) & 0xffffu); }
        } else {
            bf16_t* dst = (bf16_t*)(ws + (colp < 6144 ? WS_GF : WS_GB)); const int c = (colp - 4096) & 2047;
            u32x2 w; w.x = pk2(a[0], a[1]); w.y = pk2(a[2], a[3]); *(u32x2*)(dst + (size_t)row * 2048 + c) = w;
            w.x = pk2(b[0], b[1]); w.y = pk2(b[2], b[3]); *(u32x2*)(dst + (size_t)row * 2048 + c + 16) = w;
        }
        return 0.f;
    }
};

namespace pg8 {
#define PG8_LAS __attribute__((address_space(3)))
typedef unsigned short bf16_t;
typedef short bf16x8 __attribute__((ext_vector_type(8)));
typedef float f32x4 __attribute__((ext_vector_type(4)));
typedef unsigned u32x4 __attribute__((ext_vector_type(4)));
constexpr int BM = 256, BK = 64, HALF = 128, HTB = HALF * BK * 2  , STAGE_BYTES = 8 * HTB, NXCD = 8, WGM = 8;

__host__ __device__ __forceinline__ int lds_byte(int r, int c) { const int st = (r >> 4) * 2 + (c >> 5), rr = r & 15, cc = c & 31, ob = rr * 64 + cc * 2; return st * 1024 + (ob ^ (((ob >> 9) & 1) << 5)); }
__host__ __device__ __forceinline__ void stage_rc(int b, int& R, int& C) { const int st = b / 1024, sb = b % 1024, swz = sb ^ (((sb >> 9) & 1) << 5); R = (st >> 1) * 16 + swz / 64; C = (st & 1) * 32 + (swz % 64) / 2; }
__host__ __device__ __forceinline__ int perm32(int rho) { const int n = rho >> 4, i = rho & 15; return 8 * (i >> 2) + 4 * n + (i & 3); }

struct Unit { int pm, pn; };
struct Gemm { const bf16_t* A; const bf16_t* Bt; int M, N, K; };

struct StaticOrder {
    int nM, nN, nwg, G, c;
    __host__ __device__ void init(int M, int N, int G_, int c_) { nM = M / BM; nN = N / BM; nwg = nM * nN; G = G_; c = c_; }
    __host__ __device__ bool next(int i, Unit& u) const {
        const long L = (long)i * G + c; if (L >= nwg) return false;
        int wgid = (int)L; { const int q = nwg / NXCD, r = nwg % NXCD, xcd = wgid % NXCD, off = wgid / NXCD; wgid = (xcd < r ? xcd * (q + 1) : r * (q + 1) + (xcd - r) * q) + off; }
        const int nig = WGM * nN, gid = wgid / nig, fm = gid * WGM, gsz = (nM - fm) < WGM ? (nM - fm) : WGM;
        u.pm = fm + ((wgid % nig) % gsz); u.pn = (wgid % nig) / gsz; return true;
    }
    __device__ __forceinline__ void a_ready(const Unit&) const {}
    __device__ __forceinline__ void done(const Unit&) const {}
};

template <class Epi, class Sched, bool ALIGN_EPI = false, bool SP2 = false, bool SWAPMMA = false>
__device__ __forceinline__ void gemm_phase(PG8_LAS unsigned char* lds, const Gemm g, const Sched& S, const Epi& E) {
    const int tid = threadIdx.x, wid = __builtin_amdgcn_readfirstlane(tid >> 6), lane = tid & 63, wr = wid >> 2, wc = wid & 3, fr = lane & 15, fq = lane >> 4;
    const int K = g.K, nt = K / BK;
    unsigned voffA[2], voffB[2];
#pragma unroll
    for (int i = 0; i < 2; ++i) { int R, C; stage_rc(tid * 16 + i * 8192, R, C); const int Rb = Epi::PERM ? ((R & ~31) + perm32(R & 31)) : R;
        voffA[i] = (unsigned)(R * K + C) * 2u; voffB[i] = (unsigned)(Rb * K + C) * 2u; }
    const size_t kstep = (size_t)(BK * 2);
    const size_t hstep = (size_t)HALF * K * 2;
    const size_t tstep = 2 * hstep;
    const unsigned ldsw = (unsigned)wid * 1024u;
    const int aoff = lds_byte(wr * 64 + fr, fq * 8), boff = lds_byte(wc * 32 + fr, fq * 8);
#define PG8_SA(b, h) (((b) * 2 + (h)) * HTB)
#define PG8_SB(b, h) ((4 + (b) * 2 + (h)) * HTB)
#define PG8_STAGE(bufoff, gbase, voff) do { _Pragma("unroll") for (int _i = 0; _i < 2; ++_i) \
        __builtin_amdgcn_global_load_lds((const unsigned*)((const char*)(gbase) + (voff)[_i]), (PG8_LAS unsigned*)(lds + (bufoff) + ldsw + _i * 8192), 16, 0, 0); } while (0)
#define PG8_LDA(dst, b, h) do { _Pragma("unroll") for (int m = 0; m < 4; ++m) _Pragma("unroll") for (int k = 0; k < 2; ++k) dst[m][k] = *(const PG8_LAS bf16x8*)(lds + PG8_SA(b, h) + aoff + m * 2048 + k * 1024); } while (0)
#define PG8_LDB(dst, b, h) do { _Pragma("unroll") for (int n = 0; n < 2; ++n) _Pragma("unroll") for (int k = 0; k < 2; ++k) dst[n][k] = *(const PG8_LAS bf16x8*)(lds + PG8_SB(b, h) + boff + n * 2048 + k * 1024); } while (0)
#define PG8_MMA(ai, bj, At, Bt) do { __builtin_amdgcn_s_setprio(1); _Pragma("unroll") for (int m = 0; m < 4; ++m) _Pragma("unroll") for (int n = 0; n < 2; ++n) _Pragma("unroll") for (int k = 0; k < 2; ++k) \
        acc[ai][bj][m][n] = SWAPMMA ? __builtin_amdgcn_mfma_f32_16x16x32_bf16(At[m][k], Bt[n][k], acc[ai][bj][m][n], 0, 0, 0) : __builtin_amdgcn_mfma_f32_16x16x32_bf16(Bt[n][k], At[m][k], acc[ai][bj][m][n], 0, 0, 0); __builtin_amdgcn_s_setprio(0); } while (0)
#define PG8_WAIT_V(n) asm volatile("s_waitcnt vmcnt(" #n ")" ::: "memory")
#define PG8_WAIT_L(n) asm volatile("s_waitcnt lgkmcnt(" #n ")" ::: "memory")
#define PG8_BAR __builtin_amdgcn_s_barrier()
#define PG8_SCHED __builtin_amdgcn_sched_barrier(0)
    Unit cur, nxt; int ui = 0;
    if (!S.next(0, cur)) return;
    f32x4 acc[2][2][4][2];
#pragma unroll
    for (int a = 0; a < 2; ++a)
#pragma unroll
        for (int b = 0; b < 2; ++b)
#pragma unroll
            for (int m = 0; m < 4; ++m)
#pragma unroll
                for (int n = 0; n < 2; ++n) acc[a][b][m][n] = (f32x4){0.f, 0.f, 0.f, 0.f};
    bf16x8 At[4][2], B0[2][2], B1[2][2];
    const char* cA = (const char*)g.A + (size_t)cur.pm * tstep; const char* cB = (const char*)g.Bt + (size_t)cur.pn * tstep;
    S.a_ready(cur);
    if constexpr (SP2) {
        PG8_STAGE(PG8_SB(0, 0), cB, voffB); PG8_STAGE(PG8_SB(0, 1), cB + hstep, voffB); PG8_STAGE(PG8_SA(0, 0), cA, voffA); PG8_STAGE(PG8_SA(0, 1), cA + hstep, voffA);
        if (wr == 1) PG8_BAR;
        PG8_WAIT_V(2); PG8_BAR;
        PG8_STAGE(PG8_SB(1, 0), cB + kstep, voffB); PG8_STAGE(PG8_SA(1, 0), cA + kstep, voffA); PG8_STAGE(PG8_SB(1, 1), cB + hstep + kstep, voffB);
        PG8_WAIT_V(6); PG8_BAR;
    } else {
        PG8_STAGE(PG8_SB(0, 0), cB, voffB); PG8_STAGE(PG8_SA(0, 0), cA, voffA); PG8_STAGE(PG8_SB(0, 1), cB + hstep, voffB); PG8_STAGE(PG8_SA(0, 1), cA + hstep, voffA);
        if (wr == 1) PG8_BAR;
        PG8_WAIT_V(4); PG8_BAR;
        PG8_STAGE(PG8_SB(1, 0), cB + kstep, voffB); PG8_STAGE(PG8_SA(1, 0), cA + kstep, voffA); PG8_STAGE(PG8_SB(1, 1), cB + hstep + kstep, voffB);
        PG8_WAIT_V(6); PG8_BAR;
    }
    for (;;) {
        const bool has_next = S.next(ui + 1, nxt);
        const char* nA = has_next ? (const char*)g.A + (size_t)nxt.pm * tstep : cA; const char* nB = has_next ? (const char*)g.Bt + (size_t)nxt.pn * tstep : cB;
        for (int t = 0; t < nt; t += 2) {
            const bool last = (t == nt - 2);
            const char* a1 = cA + (size_t)(t + 1) * kstep;
            const char* a2 = last ? nA : cA + (size_t)(t + 2) * kstep; const char* b2 = last ? nB : cB + (size_t)(t + 2) * kstep;
            const char* a3 = a2 + kstep; const char* b3 = b2 + kstep;
            if (last && has_next) S.a_ready(nxt);
            if constexpr (SP2) {
            PG8_LDB(B0, 0, 0); PG8_LDB(B1, 0, 1); PG8_SCHED; PG8_LDA(At, 0, 0); PG8_STAGE(PG8_SA(1, 1), a1 + hstep, voffA);
            PG8_WAIT_V(8); PG8_WAIT_L(0); PG8_BAR; PG8_MMA(0, 0, At, B0); PG8_MMA(0, 1, At, B1); PG8_BAR; PG8_SCHED;
            PG8_LDA(At, 0, 1); PG8_STAGE(PG8_SB(0, 0), b2, voffB); PG8_STAGE(PG8_SB(0, 1), b2 + hstep, voffB); PG8_STAGE(PG8_SA(0, 0), a2, voffA);
            PG8_WAIT_V(8); PG8_WAIT_L(0); PG8_BAR; PG8_MMA(1, 0, At, B0); PG8_MMA(1, 1, At, B1); PG8_BAR; PG8_SCHED;
            PG8_LDB(B0, 1, 0); PG8_LDB(B1, 1, 1); PG8_SCHED; PG8_LDA(At, 1, 0); PG8_STAGE(PG8_SA(0, 1), a2 + hstep, voffA);
            PG8_WAIT_V(8); PG8_WAIT_L(0); PG8_BAR; PG8_MMA(0, 0, At, B0); PG8_MMA(0, 1, At, B1); PG8_BAR; PG8_SCHED;
            PG8_LDA(At, 1, 1); PG8_STAGE(PG8_SB(1, 0), b3, voffB); PG8_STAGE(PG8_SB(1, 1), b3 + hstep, voffB); PG8_STAGE(PG8_SA(1, 0), a3, voffA);
            PG8_WAIT_V(8); PG8_WAIT_L(0); PG8_BAR; PG8_MMA(1, 0, At, B0); PG8_MMA(1, 1, At, B1); PG8_BAR; PG8_SCHED;
            } else {
            PG8_LDB(B0, 0, 0); PG8_SCHED; PG8_LDA(At, 0, 0); PG8_STAGE(PG8_SA(1, 1), a1 + hstep, voffA);
            PG8_WAIT_L(8); PG8_BAR; PG8_WAIT_L(0); PG8_MMA(0, 0, At, B0); PG8_BAR; PG8_SCHED;
            PG8_LDB(B1, 0, 1); PG8_STAGE(PG8_SB(0, 0), b2, voffB);
            PG8_BAR; PG8_WAIT_L(0); PG8_MMA(0, 1, At, B1); PG8_BAR;
            PG8_LDA(At, 0, 1); PG8_STAGE(PG8_SA(0, 0), a2, voffA);
            PG8_BAR; PG8_WAIT_L(0); PG8_MMA(1, 0, At, B0); PG8_BAR; PG8_SCHED;
            PG8_STAGE(PG8_SB(0, 1), b2 + hstep, voffB);
            PG8_WAIT_V(6); PG8_BAR; PG8_MMA(1, 1, At, B1); PG8_BAR;
            PG8_LDB(B0, 1, 0); PG8_SCHED; PG8_LDA(At, 1, 0); PG8_STAGE(PG8_SA(0, 1), a2 + hstep, voffA);
            PG8_WAIT_L(8); PG8_BAR; PG8_WAIT_L(0); PG8_MMA(0, 0, At, B0); PG8_BAR; PG8_SCHED;
            PG8_LDB(B1, 1, 1); PG8_STAGE(PG8_SB(1, 0), b3, voffB);
            PG8_BAR; PG8_WAIT_L(0); PG8_MMA(0, 1, At, B1); PG8_BAR;
            PG8_LDA(At, 1, 1); PG8_STAGE(PG8_SA(1, 0), a3, voffA);
            PG8_BAR; PG8_WAIT_L(0); PG8_MMA(1, 0, At, B0); PG8_BAR; PG8_SCHED;
            PG8_STAGE(PG8_SB(1, 1), b3 + hstep, voffB);
            PG8_WAIT_V(6); PG8_BAR; PG8_MMA(1, 1, At, B1); PG8_BAR;
            }
        }
        if constexpr (ALIGN_EPI) { if (wr == 0) PG8_BAR; }
        if constexpr (!Epi::AFTER_DRAIN) { E(acc, cur, wr, wc, fr, fq); S.done(cur); }
        if (!has_next) break;
#pragma unroll
        for (int a = 0; a < 2; ++a)
#pragma unroll
            for (int b = 0; b < 2; ++b)
#pragma unroll
                for (int m = 0; m < 4; ++m)
#pragma unroll
                    for (int n = 0; n < 2; ++n) acc[a][b][m][n] = (f32x4){0.f, 0.f, 0.f, 0.f};
        cur = nxt; cA = nA; cB = nB; ++ui;
        if constexpr (ALIGN_EPI) { if (wr == 1) PG8_BAR; }
    }
    PG8_WAIT_V(0);
    if constexpr (!ALIGN_EPI) { if (wr == 0) PG8_BAR; }
    PG8_BAR;
    if constexpr (Epi::AFTER_DRAIN) { E.fused(acc, cur, wr, wc, fr, fq, lds, wid, lane); S.done(cur); }
#undef PG8_SA
#undef PG8_SB
#undef PG8_STAGE
#undef PG8_LDA
#undef PG8_LDB
#undef PG8_MMA
#undef PG8_WAIT_V
#undef PG8_WAIT_L
#undef PG8_BAR
#undef PG8_SCHED
}
}

template <class E0> struct EpiAdapt {
    static constexpr bool PERM = false, AFTER_DRAIN = false;
    E0 e; int col_base;
    __device__ __forceinline__ void operator()(const pg8::f32x4 (&acc)[2][2][4][2], const pg8::Unit& u, int wr, int wc, int fr, int fq) const {
#pragma unroll
        for (int ai = 0; ai < 2; ++ai)
#pragma unroll
            for (int m = 0; m < 4; ++m) {
                const int row = u.pm * 256 + ai * 128 + wr * 64 + m * 16 + fr;
                const float rs = e.row_begin(row, fq);
                float ss = 0.f;
#pragma unroll
                for (int bj = 0; bj < 2; ++bj) ss += e.item(row, col_base + u.pn * 256 + bj * 128 + wc * 32 + 4 * fq, acc[ai][bj][m][0], acc[ai][bj][m][1], rs);
                if constexpr (E0::STATS) { ss += __shfl_xor(ss, 16); ss += __shfl_xor(ss, 32); if (fq == 0) e.stats[(size_t)row * 16 + (col_base >> 6) + u.pn * 4 + wc] = ss; }
            }
    }
};
struct EpiVt {
    static constexpr bool PERM = false, AFTER_DRAIN = false;
    unsigned char* ws; int cvoff;
    __device__ __forceinline__ void operator()(const pg8::f32x4 (&acc)[2][2][4][2], const pg8::Unit& u, int wr, int wc, int fr, int fq) const {
        bf16_t* vt = (bf16_t*)(ws + WS_VT);
#pragma unroll
        for (int ai = 0; ai < 2; ++ai)
#pragma unroll
            for (int m = 0; m < 4; ++m) {
                const int rowb = u.pm * 256 + ai * 128 + wr * 64 + m * 16;
                const float rsl = row_rs((const float*)(ws + WS_STATS), rowb + fr, fq);
                float rsv[4];
#pragma unroll
                for (int e = 0; e < 4; ++e) rsv[e] = __shfl(rsl, 4 * fq + e);
                const float* cv = (const float*)ws + cvoff + (rowb < T ? 0 : 8192);
#pragma unroll
                for (int bj = 0; bj < 2; ++bj)
#pragma unroll
                    for (int n = 0; n < 2; ++n) {
                        const int col = 2048 + u.pn * 256 + bj * 128 + wc * 32 + 16 * n + fr;
                        const float c0 = cv[col]; const pg8::f32x4 a = acc[ai][bj][m][n];
                        u32x2 w; w.x = pk2(a[0] * rsv[0] + c0, a[1] * rsv[1] + c0); w.y = pk2(a[2] * rsv[2] + c0, a[3] * rsv[3] + c0);
                        *(u32x2*)(vt + (size_t)(col - 2048) * R + rowb + 4 * fq) = w;
                    }
            }
    }
};
template <class Epi>
__device__ __forceinline__ void sgemm_small(Ctx& C, const bf16_t* A, const bf16_t* Bt, int row_lo, int Mrows, int N, int K, const Epi& E, int n_lo, int n_hi) {
    const int kh = C.wave >> 2, wc = C.wave & 3, fr = C.lane & 15, fq = C.lane >> 4;
    const int nM = Mrows / 16, nN = n_hi - n_lo, nU = nM * nN, Kh = K >> 1;
    LAS f32x4* xch = (LAS f32x4*)C.lds;
    for (int u = (C.G - 1 - C.bid); u < nU; u += C.G) {
        const int un = n_lo + u / nM, um = u % nM;
        const int row0 = row_lo + 16 * um, col0 = 256 * un;
        f32x4 acc[2][2];
#pragma unroll
        for (int b = 0; b < 2; ++b)
#pragma unroll
            for (int n = 0; n < 2; ++n) acc[b][n] = (f32x4){0.f, 0.f, 0.f, 0.f};
        const bf16_t* ap = A + (size_t)(row0 + fr) * K + kh * Kh + 8 * fq;
        const bf16_t* bp = Bt + (size_t)(col0 + 32 * wc + fr) * K + kh * Kh + 8 * fq;
#pragma unroll 4
        for (int k0 = 0; k0 < Kh; k0 += 32) {
            bf16x8 bf[2][2];
            const bf16x8 af = *(const bf16x8*)(ap + k0);
#pragma unroll
            for (int bj = 0; bj < 2; ++bj)
#pragma unroll
                for (int n = 0; n < 2; ++n) bf[bj][n] = *(const bf16x8*)(bp + (size_t)(128 * bj + 16 * n) * K + k0);
#pragma unroll
            for (int bj = 0; bj < 2; ++bj)
#pragma unroll
                for (int n = 0; n < 2; ++n) acc[bj][n] = __builtin_amdgcn_mfma_f32_16x16x32_bf16(bf[bj][n], af, acc[bj][n], 0, 0, 0);
        }
        if (kh == 1) {
#pragma unroll
            for (int bj = 0; bj < 2; ++bj)
#pragma unroll
                for (int n = 0; n < 2; ++n) xch[(wc * 4 + bj * 2 + n) * 64 + C.lane] = acc[bj][n];
        }
        __syncthreads();
        if (kh == 0) {
#pragma unroll
            for (int bj = 0; bj < 2; ++bj)
#pragma unroll
                for (int n = 0; n < 2; ++n) acc[bj][n] += xch[(wc * 4 + bj * 2 + n) * 64 + C.lane];
            const int row = row0 + fr;
            const float rs = E.row_begin(row, fq);
            float ss = 0.f;
#pragma unroll
            for (int bj = 0; bj < 2; ++bj) ss += E.item(row, col0 + 128 * bj + 32 * wc + 4 * fq, acc[bj][0], acc[bj][1], rs);
            if constexpr (Epi::STATS) { ss += __shfl_xor(ss, 16); ss += __shfl_xor(ss, 32); if (fq == 0) E.stats[(size_t)row * 16 + un * 4 + wc] = ss; }
        }
        __syncthreads();
    }
}
template <class E0>
__device__ __forceinline__ void gemm_both(Ctx& C, const bf16_t* A, const bf16_t* Bt, int Mbig, int N, int K, const E0& E, int ctx_n_lo, int ctx_n_hi, int nb_lo = 0, int nb_hi = -1) {
    if (nb_hi < 0) nb_hi = N / 256;
    { pg8::Gemm g{A, Bt + (size_t)nb_lo * 256 * K, Mbig, (nb_hi - nb_lo) * 256, K}; pg8::StaticOrder S; S.init(Mbig, (nb_hi - nb_lo) * 256, C.G, C.bid); EpiAdapt<E0> EA{E, nb_lo * 256};
      pg8::gemm_phase<EpiAdapt<E0>, pg8::StaticOrder, true, true>(C.lds, g, S, EA); }
    if (Mbig < R && ctx_n_hi > ctx_n_lo) { __syncthreads(); sgemm_small(C, A, Bt, T, R - T, N, K, E, ctx_n_lo, ctx_n_hi); }
}
__device__ __forceinline__ void dwconv_phase(Ctx& C, int j) {
    const bf16_t* U = (const bf16_t*)(C.ws + WS_U); bf16_t* A2 = (bf16_t*)(C.ws + WS_A2);
    const float* dww = C.in[10] + (size_t)j * CK * 1024; const float* dwb = C.in[11] + j * 1024; const float* lng = C.in[12] + j * 1024; const float* lnb = C.in[13] + j * 1024;
    LAS unsigned char* tile = C.lds; LAS float* part = (LAS float*)(C.lds + 62 * 2048);
    const int tid = C.tid;
    for (int u = C.bid; u < 520; u += C.G) {
        const int base = u < 512 ? 0 : T, n = u < 512 ? T : TC, t0 = 32 * (u < 512 ? u : u - 512);
        for (int idx = tid; idx < 62 * 128; idx += 512) {
            const int rr = idx >> 7, ch = idx & 127, tt = t0 - 15 + rr;
            u32x4 v = {0u, 0u, 0u, 0u};
            if (tt >= 0 && tt < n) v = *(const u32x4*)(U + (size_t)(base + tt) * 1024 + ch * 8);
            *(LAS u32x4*)(tile + rr * 2048 + ch * 16) = v;
        }
        __syncthreads();
        float o0[32], o1[32];
        { const f32x2 b2 = *(const f32x2*)(dwb + 2 * tid);
#pragma unroll
          for (int t = 0; t < 32; ++t) { o0[t] = b2.x; o1[t] = b2.y; } }
        for (int jt = 0; jt < CK; ++jt) {
            const f32x2 w = *(const f32x2*)(dww + jt * 1024 + 2 * tid);
            const LAS unsigned char* p = tile + jt * 2048 + tid * 4;
#pragma unroll
            for (int t = 0; t < 32; ++t) { const unsigned uu = *(const LAS unsigned*)(p + t * 2048); o0[t] += w.x * bflo(uu); o1[t] += w.y * bfhi(uu); }
        }
#pragma unroll
        for (int t = 0; t < 32; ++t) {
            const float s = wave_sum63(o0[t] + o1[t]), q = wave_sum63(o0[t] * o0[t] + o1[t] * o1[t]);
            if (C.lane == 63) { part[(t * 8 + C.wave) * 2] = s; part[(t * 8 + C.wave) * 2 + 1] = q; }
        }
        __syncthreads();
        const f32x2 g2 = *(const f32x2*)(lng + 2 * tid), bb2 = *(const f32x2*)(lnb + 2 * tid);
#pragma unroll
        for (int t = 0; t < 32; ++t) {
            float s = 0.f, q = 0.f;
#pragma unroll
            for (int w = 0; w < 8; ++w) { s += part[(t * 8 + w) * 2]; q += part[(t * 8 + w) * 2 + 1]; }
            const float mean = s * (1.f / 1024.f), var = q * (1.f / 1024.f) - mean * mean, rstd = 1.0f / sqrtf(var + LN_EPS);
            const float y0 = (o0[t] - mean) * rstd * g2.x + bb2.x, y1 = (o1[t] - mean) * rstd * g2.y + bb2.y;
            *(unsigned*)(A2 + (size_t)(base + t0 + t) * 1024 + 2 * tid) = pk2(siluf(y0), siluf(y1));
        }
        __syncthreads();
    }
}

__device__ __forceinline__ void scan_phase(Ctx& C, int j) {
    const bf16_t* Kb = (const bf16_t*)(C.ws + WS_K); const bf16_t* Vt = (const bf16_t*)(C.ws + WS_VT); bf16_t* Scp = (bf16_t*)(C.ws + WS_SCP);
    constexpr int SLOT = 32768;
    const int fr = C.lane & 15, fq = C.lane >> 4, w = C.wave, lane = C.lane;
    for (int cu = C.bid; cu < 256; cu += C.G) {
        const int hd = cu & 7, sidx = cu >> 3, h = hd >> 1, dir = hd & 1, dk_s = 64 * ((sidx >> 3) & 3), dv_s = 64 * (sidx & 7);
        const float gam = 1.0f - exp2f(C.in[17][(j * 2 + dir) * 4 + h]); const float L = log2f(gam);
        const float cdec = exp2f(L * 128.f);
        const bf16_t* ksrc[2]; const bf16_t* vsrc[2];
#pragma unroll
        for (int p = 0; p < 2; ++p) {
            const int kr = 8 * (2 * w + p) + (lane >> 3), kpos = lane & 7, kc = kpos ^ (((kr >> 3) & 1) << 1) ^ (((kr >> 1) & 1) << 2);
            ksrc[p] = Kb + (size_t)kr * 1024 + h * 256 + dk_s + 8 * kc;
            const int vr = 4 * (2 * w + p) + (lane >> 4), vpos = lane & 15, vc = vpos ^ (vr & 15);
            vsrc[p] = Vt + (size_t)(h * 512 + dv_s + vr) * R + 8 * vc;
        }
        auto tok_of = [&](int st) { const int sc = st < 129 ? st : 129; const int bl = sc < 2 ? (dir == 0 ? sc : 1 - sc) : (dir == 0 ? sc - 2 : 129 - sc); return (sc < 2 ? T : 0) + 128 * bl; };
#define SCAN_DMA(st) do { const int tok_ = tok_of(st); LAS unsigned char* sl_ = C.lds + ((st) & 3) * SLOT + (2 * w) * 1024; \
        __builtin_amdgcn_global_load_lds((const unsigned*)(ksrc[0] + (size_t)tok_ * 1024), (LAS unsigned*)(sl_), 16, 0, 0); \
        __builtin_amdgcn_global_load_lds((const unsigned*)(ksrc[1] + (size_t)tok_ * 1024), (LAS unsigned*)(sl_ + 1024), 16, 0, 0); \
        __builtin_amdgcn_global_load_lds((const unsigned*)(vsrc[0] + tok_), (LAS unsigned*)(sl_ + 16384), 16, 0, 0); \
        __builtin_amdgcn_global_load_lds((const unsigned*)(vsrc[1] + tok_), (LAS unsigned*)(sl_ + 16384 + 1024), 16, 0, 0); } while (0)
        const int mt = w >> 1, nh = w & 1, dkl = 16 * mt;
        const int trq = (fr >> 2), trp = fr & 3, trrow0 = 8 * fq + trq;
        const int trcol0 = (((2 * mt + (trp >> 1)) ^ ((fq & 1) << 1) ^ (((trq >> 1) & 1) << 2)) << 3) + 4 * (trp & 1);
        float kd[4][8];
#pragma unroll
        for (int ks = 0; ks < 4; ++ks)
#pragma unroll
            for (int e = 0; e < 8; ++e) { const int tl = 32 * ks + 8 * fq + e; kd[ks][e] = exp2f(L * (float)(dir == 0 ? 127 - tl : tl)); }
        int voff[2];
#pragma unroll
        for (int nt = 0; nt < 2; ++nt) { const int vr = 32 * nh + 16 * nt + fr; voff[nt] = 16384 + vr * 256; }
        f32x4 acc[2]; acc[0] = (f32x4){0.f, 0.f, 0.f, 0.f}; acc[1] = acc[0];
        const unsigned lds0 = (unsigned)(size_t)C.lds;
        __syncthreads();
        SCAN_DMA(0); SCAN_DMA(1); SCAN_DMA(2);
#pragma unroll 1
        for (int st = 0; st < 130; ++st) {
            asm volatile("s_waitcnt vmcnt(8)" ::: "memory");
            __builtin_amdgcn_s_barrier(); asm volatile("" ::: "memory");
            SCAN_DMA(st + 3);
            {   const bool isctx = st < 2; const int bl = isctx ? (dir == 0 ? st : 1 - st) : (dir == 0 ? st - 2 : 129 - st);
                const bool cp = dir == 0 ? ((bl & 3) == 0) : (isctx ? bl == 1 : (bl & 3) == 3);
                if (cp) {
                    const int slot = isctx ? 32 : (bl >> 2);
                    bf16_t* sp = Scp + ((size_t)((slot * 4 + h) * 2 + dir) * 512) * 256;
#pragma unroll
                    for (int nt = 0; nt < 2; ++nt) { u32x2 wv; wv.x = pk2(acc[nt][0], acc[nt][1]); wv.y = pk2(acc[nt][2], acc[nt][3]);
                        *(u32x2*)(sp + (size_t)(dv_s + 32 * nh + 16 * nt + fr) * 256 + dk_s + dkl + 4 * fq) = wv; }
                } }
            acc[0] = acc[0] * cdec; acc[1] = acc[1] * cdec;
            const unsigned sl = lds0 + (unsigned)((st & 3) * SLOT);
            u32x2 klo[4], khi[4]; u32x4 vfr[4][2];
#pragma unroll
            for (int ks = 0; ks < 4; ++ks) {
                const unsigned ka = sl + (unsigned)(((32 * ks + trrow0) * 64 + trcol0) * 2);
                asm volatile("ds_read_b64_tr_b16 %0, %1" : "=v"(klo[ks]) : "v"(ka));
                asm volatile("ds_read_b64_tr_b16 %0, %1 offset:512" : "=v"(khi[ks]) : "v"(ka));
#pragma unroll
                for (int nt = 0; nt < 2; ++nt) { const int vr = 32 * nh + 16 * nt + fr;
                    const unsigned va = sl + (unsigned)(voff[nt] + (((4 * ks + fq) ^ (vr & 15)) << 4));
                    asm volatile("ds_read_b128 %0, %1" : "=v"(vfr[ks][nt]) : "v"(va)); }
            }
            asm volatile("s_waitcnt lgkmcnt(0)" : "+v"(klo[0]), "+v"(klo[1]), "+v"(klo[2]), "+v"(klo[3]), "+v"(khi[0]), "+v"(khi[1]), "+v"(khi[2]), "+v"(khi[3]) :: "memory");
            asm volatile("" : "+v"(vfr[0][0]), "+v"(vfr[0][1]), "+v"(vfr[1][0]), "+v"(vfr[1][1]), "+v"(vfr[2][0]), "+v"(vfr[2][1]), "+v"(vfr[3][0]), "+v"(vfr[3][1]));
            __builtin_amdgcn_sched_barrier(0);
#pragma unroll
            for (int ks = 0; ks < 4; ++ks) {
                u32x4 pk;
                pk.x = pk2(bflo(klo[ks].x) * kd[ks][0], bfhi(klo[ks].x) * kd[ks][1]);
                pk.y = pk2(bflo(klo[ks].y) * kd[ks][2], bfhi(klo[ks].y) * kd[ks][3]);
                pk.z = pk2(bflo(khi[ks].x) * kd[ks][4], bfhi(khi[ks].x) * kd[ks][5]);
                pk.w = pk2(bflo(khi[ks].y) * kd[ks][6], bfhi(khi[ks].y) * kd[ks][7]);
                const bf16x8 af = __builtin_bit_cast(bf16x8, pk);
#pragma unroll
                for (int nt = 0; nt < 2; ++nt) acc[nt] = __builtin_amdgcn_mfma_f32_16x16x32_bf16(af, __builtin_bit_cast(bf16x8, vfr[ks][nt]), acc[nt], 0, 0, 0);
            }
        }
        asm volatile("s_waitcnt vmcnt(0)" ::: "memory");
        __syncthreads();
#undef SCAN_DMA
    }
}

template <int PV = 0>
__device__ __forceinline__ void readout_phase(Ctx& C, int j, bool skip_ctx) {
    const bf16_t* Q = (const bf16_t*)(C.ws + WS_Q); const bf16_t* Kb = (const bf16_t*)(C.ws + WS_K); const bf16_t* Vt = (const bf16_t*)(C.ws + WS_VT);
    const bf16_t* Scp = (const bf16_t*)(C.ws + WS_SCP); bf16_t* GF = (bf16_t*)(C.ws + WS_GF); const bf16_t* GB = (const bf16_t*)(C.ws + WS_GB);
    constexpr int QP = 264, PP = 136;
    LAS bf16_t* Qs = (LAS bf16_t*)C.lds;
    LAS bf16_t* P = (LAS bf16_t*)(C.lds + 128 * QP * 2);
    LAS float* red = (LAS float*)(C.lds + 128 * QP * 2 + 128 * PP * 2);
    const int w = C.wave, tid = C.tid;
    const int nunits = skip_ctx ? 512 : 520;
    for (int u0 = C.bid; u0 < nunits; u0 += C.G) {
        int h, b;
        if (C.G == 256 && u0 < 512) { const int r = u0 >> 8, x = u0 & 7, idx = (u0 & 255) >> 3, grp = r * 64 + x * 8 + (idx >> 2); h = grp & 3; b = (grp >> 2) * 4 + (idx & 3); }
        else { h = u0 & 3; b = u0 >> 2; }
        const bool lat = b < 128; const int base = lat ? 0 : T, nb = lat ? 128 : 2, bl = lat ? b : b - 128;
        const int g = bl >> 2, slot = lat ? g : 32;
        const int gend = (4 * (g + 1) < nb ? 4 * (g + 1) : nb);
        const int i0 = base + 128 * bl, il0 = 128 * bl;
#pragma unroll
        for (int i = 0; i < 8; ++i) { const int c = tid + 512 * i, row = c >> 5, ch = c & 31;
            *(LAS u32x4*)(Qs + row * QP + 8 * ch) = *(const u32x4*)(Q + (size_t)(i0 + row) * 1024 + h * 256 + 8 * ch); }
        __syncthreads();
#pragma unroll 1
        for (int dir = 0; dir < 2; ++dir) {
            int lane_o = C.lane; asm volatile("" : "+v"(lane_o));
            const int fr = lane_o & 15, fq = lane_o >> 4;
            const float gam = 1.0f - exp2f(C.in[17][(j * 2 + dir) * 4 + h]); const float L = log2f(gam);
            f32x4 acc[8][4];
#pragma unroll
            for (int mt = 0; mt < 8; ++mt)
#pragma unroll
                for (int nt = 0; nt < 4; ++nt) acc[mt][nt] = (f32x4){0.f, 0.f, 0.f, 0.f};
            const int kb_lo = dir == 0 ? 4 * g : bl, kb_hi = dir == 0 ? bl : gend - 1;
            const bf16_t* sb = Scp + ((size_t)((slot * 4 + h) * 2 + dir) * 512) * 256 + (size_t)(64 * w + 16 * (fr >> 2) + (fr & 3)) * 256 + 8 * fq;
#pragma unroll 1
            for (int kq = 0; kq < 4; ++kq) {
                bf16x8 sf[2][4];
#pragma unroll
                for (int k2 = 0; k2 < 2; ++k2)
#pragma unroll
                    for (int nt = 0; nt < 4; ++nt) sf[k2][nt] = *(const bf16x8*)(sb + (size_t)(4 * nt) * 256 + 32 * (2 * kq + k2));
#pragma unroll
                for (int k2 = 0; k2 < 2; ++k2)
#pragma unroll
                    for (int mt = 0; mt < 8; ++mt) { const bf16x8 qf = *(const LAS bf16x8*)(Qs + (16 * mt + fr) * QP + 32 * (2 * kq + k2) + 8 * fq);
#pragma unroll
                        for (int nt = 0; nt < 4; ++nt) acc[mt][nt] = __builtin_amdgcn_mfma_f32_16x16x32_bf16(sf[k2][nt], qf, acc[mt][nt], 0, 0, 0); }
            }
#pragma unroll
            for (int mt = 0; mt < 8; ++mt) {
                const int il = il0 + 16 * mt + fr;
                const int ex = dir == 0 ? il - 512 * g + 1 : gend * 128 - il;
                const float qd = __builtin_amdgcn_exp2f(L * (float)ex);
#pragma unroll
                for (int nt = 0; nt < 4; ++nt) acc[mt][nt] = acc[mt][nt] * qd;
            }
#pragma unroll 1
            for (int kb = kb_lo; kb <= (PV == 2 ? kb_lo - 1 : kb_hi); ++kb) {
                const int j0 = base + 128 * kb;
                {
                    bf16x8 kf[8];
                    const bf16_t* k1 = Kb + (size_t)(j0 + 16 * w + fr) * 1024 + h * 256 + 8 * fq;
#pragma unroll
                    for (int ks = 0; ks < 8; ++ks) kf[ks] = *(const bf16x8*)(k1 + 32 * ks);
                    f32x4 sc[8];
#pragma unroll
                    for (int mt = 0; mt < 8; ++mt) sc[mt] = (f32x4){0.f, 0.f, 0.f, 0.f};
#pragma unroll
                    for (int ks = 0; ks < 8; ++ks) {
#pragma unroll
                        for (int mt = 0; mt < 8; ++mt) { const bf16x8 qf = *(const LAS bf16x8*)(Qs + (16 * mt + fr) * QP + 32 * ks + 8 * fq);
                            sc[mt] = __builtin_amdgcn_mfma_f32_16x16x32_bf16(kf[ks], qf, sc[mt], 0, 0, 0); }
                        __builtin_amdgcn_sched_barrier(0);
                    }
#pragma unroll
                    for (int mt = 0; mt < 8; ++mt) {
                        const int il = il0 + 16 * mt + fr;
                        float p[4];
#pragma unroll
                        for (int e = 0; e < 4; ++e) { const int jl = 128 * kb + 16 * w + 4 * fq + e; const int rel = dir == 0 ? il - jl : jl - il;
                            p[e] = rel >= 0 ? sc[mt][e] * __builtin_amdgcn_exp2f(L * (float)rel) : 0.f; }
                        u32x2 wv; wv.x = pk2(p[0], p[1]); wv.y = pk2(p[2], p[3]);
                        *(LAS u32x2*)(P + (16 * mt + fr) * PP + 16 * w + 4 * fq) = wv;
                    }
                }
                __syncthreads();
                const bf16_t* vb = Vt + (size_t)(h * 512 + 64 * w + 16 * (fr >> 2) + (fr & 3)) * R + j0 + 8 * fq;
#pragma unroll 1
                for (int kh2 = 0; kh2 < 2; ++kh2) {
                    bf16x8 vf[2][4];
#pragma unroll
                    for (int k2 = 0; k2 < 2; ++k2)
#pragma unroll
                        for (int nt = 0; nt < 4; ++nt) vf[k2][nt] = *(const bf16x8*)(vb + (size_t)(4 * nt) * R + 32 * (2 * kh2 + k2));
#pragma unroll
                    for (int k2 = 0; k2 < 2; ++k2)
#pragma unroll
                        for (int mt = 0; mt < 8; ++mt) { const bf16x8 pf = *(const LAS bf16x8*)(P + (16 * mt + fr) * PP + 32 * (2 * kh2 + k2) + 8 * fq);
#pragma unroll
                            for (int nt = 0; nt < 4; ++nt) acc[mt][nt] = __builtin_amdgcn_mfma_f32_16x16x32_bf16(vf[k2][nt], pf, acc[mt][nt], 0, 0, 0); }
                }
                __syncthreads();
            }
#pragma unroll
            for (int mt = 0; mt < 8; ++mt) {
                float ss = 0.f;
#pragma unroll
                for (int nt = 0; nt < 4; ++nt) ss += (acc[mt][nt][0] * acc[mt][nt][0] + acc[mt][nt][1] * acc[mt][nt][1]) + (acc[mt][nt][2] * acc[mt][nt][2] + acc[mt][nt][3] * acc[mt][nt][3]);
                ss += __shfl_xor(ss, 16); ss += __shfl_xor(ss, 32);
                if (fq == 0) red[(16 * mt + fr) * 8 + w] = ss;
            }
            __syncthreads();
#pragma unroll
            for (int mt = 0; mt < 8; ++mt) {
                float tot = 0.f;
#pragma unroll
                for (int w2 = 0; w2 < 8; ++w2) tot += red[(16 * mt + fr) * 8 + w2];
                const float rn = 1.0f / sqrtf(tot * (1.f / 512.f) + NORM_EPS);
                const size_t off = (size_t)(i0 + 16 * mt + fr) * 2048 + h * 512 + 64 * w + 16 * fq;
#pragma unroll
                for (int np = 0; np < (PV == 4 ? 0 : 2); ++np) {
                    const u32x4 g4 = *(const u32x4*)((dir == 0 ? (const bf16_t*)GF : GB) + off + 8 * np);
                    float y[8];
                    y[0] = siluf(bflo(g4.x)) * acc[mt][2 * np][0] * rn; y[1] = siluf(bfhi(g4.x)) * acc[mt][2 * np][1] * rn;
                    y[2] = siluf(bflo(g4.y)) * acc[mt][2 * np][2] * rn; y[3] = siluf(bfhi(g4.y)) * acc[mt][2 * np][3] * rn;
                    y[4] = siluf(bflo(g4.z)) * acc[mt][2 * np + 1][0] * rn; y[5] = siluf(bfhi(g4.z)) * acc[mt][2 * np + 1][1] * rn;
                    y[6] = siluf(bflo(g4.w)) * acc[mt][2 * np + 1][2] * rn; y[7] = siluf(bfhi(g4.w)) * acc[mt][2 * np + 1][3] * rn;
                    if (dir == 1) { const u32x4 yp = *(const u32x4*)(GF + off + 8 * np);
                        y[0] += bflo(yp.x); y[1] += bfhi(yp.x); y[2] += bflo(yp.y); y[3] += bfhi(yp.y); y[4] += bflo(yp.z); y[5] += bfhi(yp.z); y[6] += bflo(yp.w); y[7] += bfhi(yp.w); }
                    u32x4 wv; wv.x = pk2(y[0], y[1]); wv.y = pk2(y[2], y[3]); wv.z = pk2(y[4], y[5]); wv.w = pk2(y[6], y[7]);
                    *(u32x4*)(GF + off + 8 * np) = wv;
                }
            }
        }
        __syncthreads();
    }
}

__device__ __forceinline__ void phase_p0(Ctx& C) {
    float* modv = (float*)(C.ws + WS_MODV);
    for (int u = C.bid; u < 384; u += C.G) {
        const int i = u / 96, nbk = u % 96;
        gemv2_unit<1>(C, C.in[4] + (size_t)i * 1024 * 6144, 6144, 64 * nbk, C.in[1], C.in[3], C.in[5] + i * 6144, modv + (i * 2 + 0) * 6144, modv + (i * 2 + 1) * 6144, 0, 0);
    }
    float* tabc = (float*)(C.ws + WS_TABC); float* tabs = (float*)(C.ws + WS_TABS);
    for (int idx = C.bid * 512 + C.tid; idx < 320 * 64; idx += C.G * 512) {
        const int ti = idx >> 6, i = idx & 63; const float pos = (float)(ti < 256 ? ti : ti - 256);
        const float inv = exp2f(-(float)i * (13.287712379549449f / 64.0f)); const float ang = pos * inv;
        tabc[idx] = __cosf(ang); tabs[idx] = __sinf(ang);
    }
}
__device__ __forceinline__ void phase_p1(Ctx& C) {
    const float* modv = (const float*)(C.ws + WS_MODV);
    float* s1 = (float*)(C.ws + WS_S1); float* s2 = (float*)(C.ws + WS_S2);
    for (int idx = C.bid * 512 + C.tid; idx < 8192; idx += C.G * 512) {
        const int i = idx >> 11, s = (idx >> 10) & 1, k = idx & 1023;
        s1[idx] = C.in[6][i * 1024 + k] * (1.f + modv[(i * 2 + s) * 6144 + 1024 + k]);
        s2[idx] = C.in[7][i * 1024 + k] * (1.f + modv[(i * 2 + s) * 6144 + 4096 + k]);
    }
    float* cvA = (float*)(C.ws + WS_CVA); float* cvF = (float*)(C.ws + WS_CVF);
    for (int u = C.bid; u < 672; u += C.G) {
        if (u < 320) {
            int i, nbk; if (u < 32) { i = 0; nbk = u; } else if (u < 160) { i = 1; nbk = u - 32; } else if (u < 192) { i = 2; nbk = u - 160; } else { i = 3; nbk = u - 192; }
            const int j = i >> 1; const float* v0 = modv + (i * 2 + 0) * 6144; const float* v1 = modv + (i * 2 + 1) * 6144;
            if ((i & 1) == 0) gemv2_unit<0>(C, C.in[8] + (size_t)j * 1024 * 2048, 2048, 64 * nbk, v0, v1, C.in[9] + j * 2048, cvA + (i * 2) * 8192, cvA + (i * 2 + 1) * 8192, 1, 1024);
            else gemv2_unit<0>(C, C.in[16] + (size_t)j * 1024 * 8192, 8192, 64 * nbk, v0, v1, nullptr, cvA + (i * 2) * 8192, cvA + (i * 2 + 1) * 8192, 2, 0);
        } else {
            const int i = (u - 320) / 88, nbk = (u - 320) % 88;
            const float* v0 = modv + (i * 2 + 0) * 6144 + 3072; const float* v1 = modv + (i * 2 + 1) * 6144 + 3072;
            gemv2_unit<0>(C, C.in[19] + (size_t)i * 1024 * FF2, FF2, 64 * nbk, v0, v1, nullptr, cvF + (i * 2) * FF2, cvF + (i * 2 + 1) * FF2, 1, DFF);
        }
    }
    bf16_t* xs = (bf16_t*)(C.ws + WS_XS); float* stats = (float*)(C.ws + WS_STATS); float* xctx = (float*)(C.ws + WS_XCTX);
    for (int row = C.bid * 8 + C.wave; row < R; row += C.G * 8) {
        const bool lat = row < T; const int s = lat ? 0 : 1;
        const float* src = lat ? C.in[0] + (size_t)row * 1024 : C.in[2] + (size_t)(row - T) * 1024;
        float* dst = lat ? C.out + (size_t)row * 1024 : xctx + (size_t)(row - T) * 1024;
        float ss = 0.f;
#pragma unroll
        for (int jj = 0; jj < 4; ++jj) {
            const int k = 4 * C.lane + 256 * jj;
            const f32x4 v = *(const f32x4*)(src + k); *(f32x4*)(dst + k) = v;
            ss += (v[0] * v[0] + v[1] * v[1]) + (v[2] * v[2] + v[3] * v[3]);
            const f32x4 g = *(const f32x4*)(C.in[6] + k), m = *(const f32x4*)(modv + s * 6144 + 1024 + k);
            u32x2 w; w.x = pk2(v[0] * g[0] * (1.f + m[0]), v[1] * g[1] * (1.f + m[1])); w.y = pk2(v[2] * g[2] * (1.f + m[2]), v[3] * g[3] * (1.f + m[3]));
            *(u32x2*)(xs + (size_t)row * 1024 + k) = w;
        }
#pragma unroll
        for (int off = 1; off < 64; off <<= 1) ss += __shfl_xor(ss, off);
        if (C.lane < 16) stats[(size_t)row * 16 + C.lane] = C.lane == 0 ? ss : 0.f;
    }
    prep_layer(C, 0, 3, 0);
}
__device__ __forceinline__ void phase_final(Ctx& C) {
    const float* stats = (const float*)(C.ws + WS_STATS);
    for (int row = C.bid * 8 + C.wave; row < T; row += C.G * 8) {
        float s = C.lane < 16 ? stats[(size_t)row * 16 + C.lane] : 0.f;
#pragma unroll
        for (int off = 1; off < 64; off <<= 1) s += __shfl_xor(s, off);
        const float r = 1.0f / sqrtf(s * (1.f / 1024.f) + NORM_EPS);
        float* xr = C.out + (size_t)row * 1024;
#pragma unroll
        for (int jj = 0; jj < 4; ++jj) { const int k = 4 * C.lane + 256 * jj; const f32x4 v = *(const f32x4*)(xr + k), g = *(const f32x4*)(C.in[21] + k); *(f32x4*)(xr + k) = v * r * g; }
    }
}

constexpr int NPHASE = 31;
__device__ __forceinline__ void run_phase(Ctx& C, int ph) {
    const int i = (ph - 2) / 7, sub = (ph - 2) % 7, j = i >> 1; const bool conv = (i & 1) == 0;
    const bool last = i == DEPTH - 1;
    float* stats = (float*)(C.ws + WS_STATS);
    const bf16_t* xs = (const bf16_t*)(C.ws + WS_XS);
    constexpr int F_MODV = (int)(WS_MODV / 4), F_S1 = (int)(WS_S1 / 4), F_S2 = (int)(WS_S2 / 4), F_CVA = (int)(WS_CVA / 4), F_CVF = (int)(WS_CVF / 4);
    if (sub == 1) {
        if (conv) { EpiGLU E{C.ws, F_CVA + (i * 2) * 8192, 8192, (int)WS_U, 1024, 0, stats}; gemm_both(C, xs, (const bf16_t*)(C.ws + WS_WA), T, 2048, 1024, E, 0, 8); }
        else {
            EpiWin E{C.ws, F_CVA + (i * 2) * 8192, stats};
            const bf16_t* WA = (const bf16_t*)(C.ws + WS_WA);
            gemm_both(C, xs, WA, T, 8192, 1024, E, 0, 0, 0, 8);
            { pg8::Gemm g{xs, WA + (size_t)2048 * 1024, T, 2048, 1024}; pg8::StaticOrder S; S.init(T, 2048, C.G, C.bid); EpiVt EV{C.ws, F_CVA + (i * 2) * 8192};
              pg8::gemm_phase<EpiVt, pg8::StaticOrder, true, true, true>(C.lds, g, S, EV); }
            gemm_both(C, xs, WA, T, 8192, 1024, E, last ? 4 : 0, last ? 16 : 32, 16, 32);
        }
    } else if (sub == 5) {
        EpiGLU E{C.ws, F_CVF + (i * 2) * FF2, FF2, (int)WS_H, DFF, 1, stats}; gemm_both(C, xs, (const bf16_t*)(C.ws + WS_WF1), last ? T : R, FF2, 1024, E, 0, 0);
        if (!last) { __syncthreads(); prep_layer(C, i + 1, 1, C.G == 256 ? 128 : 0); }
    } else {
        const bool f2 = sub == 6;
        const int mgoff = F_MODV + (i * 2) * 6144 + (f2 ? 5120 : 2048);
        const int snoff = f2 ? (last ? -1 : F_S1 + ((i + 1) * 2) * 1024) : F_S2 + (i * 2) * 1024;
        const float* bias = (!f2 && conv) ? C.in[15] + j * 1024 : nullptr;
        const bf16_t* A = (const bf16_t*)(C.ws + (f2 ? WS_H : (conv ? WS_A2 : WS_GF)));
        const bf16_t* Bt = (const bf16_t*)(C.ws + (f2 ? WS_WF2 : WS_WA2));
        const int K = f2 ? DFF : (conv ? 1024 : 2048);
        EpiRes E{C.ws, C.out, bias, mgoff, snoff, stats};
        gemm_both(C, A, Bt, T, 1024, K, E, 0, last ? 0 : 4);
    }
}

#define XB_TMO      128
#define XB_XCNT(j)  (256  + 64 * (j))
#define XB_XSUB(j)  (1280 + 64 * (j))
#define XB_XGEN(j)  (2304 + 64 * (j))
#define XB_TOP      3328
#define XB_TOPGEN   3392
#define XCD_BAR_WORDS 3456
#define XB_SPIN_CAP (1u << 20)
__device__ __forceinline__ unsigned xb_ld(unsigned* p)              { return __hip_atomic_load(p, __ATOMIC_RELAXED, __HIP_MEMORY_SCOPE_AGENT); }
__device__ __forceinline__ unsigned xb_add(unsigned* p, unsigned v) { return __hip_atomic_fetch_add(p, v, __ATOMIC_RELAXED, __HIP_MEMORY_SCOPE_AGENT); }
__device__ __forceinline__ unsigned xb_xcc_id() { return (unsigned)__builtin_amdgcn_s_getreg((3 << 11) | 20) & 0xFu; }
#define XB_SPIN(cond, bar) do { unsigned _sp = 0; while (cond) { __builtin_amdgcn_s_sleep(1); \
    if ((++_sp & 255u) == 0u) { if (xb_ld(&(bar)[XB_TMO])) break; if (_sp > XB_SPIN_CAP) { atomicAdd(&(bar)[XB_TMO], 1u); break; } } } } while (0)
struct XcdBarrier { unsigned* bar; unsigned x; volatile LAS unsigned* st; };
__device__ __forceinline__ XcdBarrier xcd_barrier_post(unsigned* bar, volatile LAS unsigned* st) {
    XcdBarrier b; b.bar = bar; b.x = xb_xcc_id(); b.st = st;
    if (threadIdx.x == 0) (void)xb_add(&bar[XB_XCNT(b.x)], 1u);
    return b;
}
__device__ __forceinline__ void xcd_barrier_complete(unsigned* bar, unsigned x, unsigned& nloc, unsigned& nx) {
    const unsigned G = gridDim.x * gridDim.y * gridDim.z;
    unsigned sum, cnt, mine, sp = 0u;
    for (;;) {
        sum = 0u; cnt = 0u; mine = 0u;
#pragma unroll
        for (unsigned j = 0; j < 16; ++j) { const unsigned c = xb_ld(&bar[XB_XCNT(j)]); sum += c; cnt += (c > 0u) ? 1u : 0u; mine = (j == x) ? c : mine; }
        if (sum == G) break;
        __builtin_amdgcn_s_sleep(1);
        if ((++sp & 255u) == 0u) { if (xb_ld(&bar[XB_TMO])) break; if (sp > XB_SPIN_CAP) { atomicAdd(&bar[XB_TMO], 1u); break; } }
    }
    nloc = mine > 0u ? mine : 1u; nx = cnt > 0u ? cnt : 1u;
}
__device__ __forceinline__ void xcd_barrier(const XcdBarrier& b) {
    asm volatile("s_waitcnt vmcnt(0)" ::: "memory");
    __syncthreads();
    if (threadIdx.x == 0) {
        unsigned* bar = b.bar;
        __builtin_amdgcn_s_waitcnt(0);
        unsigned nloc = b.st[0], nx = b.st[1];
        if (nloc == 0u) { xcd_barrier_complete(bar, b.x, nloc, nx); b.st[0] = nloc; b.st[1] = nx; }
        const unsigned old = xb_add(&bar[XB_XSUB(b.x)], 1u);
        const unsigned gen = old / nloc;
        if (old + 1u == (gen + 1u) * nloc) {
            __builtin_amdgcn_fence(__ATOMIC_RELEASE, "agent");
            asm volatile("s_waitcnt vmcnt(0)" ::: "memory");
            const unsigned og = xb_add(&bar[XB_TOP], 1u);
            const unsigned tg = og / nx;
            if (og + 1u == (tg + 1u) * nx) xb_add(&bar[XB_TOPGEN], 1u);
            else XB_SPIN(xb_ld(&bar[XB_TOPGEN]) == tg, bar);
            __builtin_amdgcn_fence(__ATOMIC_ACQUIRE, "agent");
            xb_add(&bar[XB_XGEN(b.x)], 1u);
            asm volatile("s_waitcnt vmcnt(0)" ::: "memory");
        } else {
            XB_SPIN(xb_ld(&bar[XB_XGEN(b.x)]) == gen, bar);
            __builtin_amdgcn_fence(__ATOMIC_ACQUIRE, "agent");
            asm volatile("s_waitcnt vmcnt(0)" ::: "memory");
        }
    }
    __syncthreads();
}
constexpr int MISC_OFF = 131072 + 320;
constexpr int CW_BAR = 4096;

#ifndef PROBE_DUP
#define PROBE_DUP 0
#endif
#if ONE_LAUNCH
template <int PH> __device__ __forceinline__ void phase_body(Ctx& C) {
    constexpr int i = (PH - 2) / 7, sub = (PH - 2) % 7, j = i >> 1; constexpr bool conv = (i & 1) == 0;
    if (PH == 0) phase_p0(C);
    else if (PH == 1) phase_p1(C);
    else if (PH == 30) phase_final(C);
    else if (sub == 0) { }
    else if (sub == 2) { if (i > 0) { prep_layer(C, i, 2, 0); __syncthreads(); } if (conv) dwconv_phase(C, j); else scan_phase(C, j); }
    else if (sub == 3) readout_phase(C, j, i == DEPTH - 1);
    else run_phase(C, PH);
}
template <int PH> __device__ __forceinline__ void one_phase(Ctx& C, const Args& args, const XcdBarrier& bar) {
    if (PH < args.ph_lo || PH >= args.ph_hi) return;
    constexpr int i = (PH - 2) / 7, sub = (PH - 2) % 7; constexpr bool conv = (i & 1) == 0;
    if (PH >= 2 && PH < 30) { if (sub == 0) return; if (sub == 3 && conv) return; }
    if (PH > args.ph_lo) xcd_barrier(bar);
    phase_body<PH>(C);
    constexpr bool dup = ((PH >= 2 && PH < 30) && (((PROBE_DUP & 1) && (sub == 1 || sub == 5)) || ((PROBE_DUP & 2) && sub == 2 && !conv) || ((PROBE_DUP & 4) && sub == 2 && conv) || ((PROBE_DUP & 8) && sub == 0))) || ((PROBE_DUP & 16) && PH < 2);
    if constexpr (dup) { xcd_barrier(bar); phase_body<PH>(C); }
}
template <int... PHS> __device__ __forceinline__ void all_phases(Ctx& C, const Args& args, const XcdBarrier& bar, std::integer_sequence<int, PHS...>) { (one_phase<PHS>(C, args, bar), ...); }
__global__ void __launch_bounds__(512, 2) mega_kernel(Args args) {
    extern __shared__ __attribute__((aligned(16))) unsigned char lds_raw[];
    Ctx C;
    C.lds = (LAS unsigned char*)lds_raw; C.tid = threadIdx.x; C.lane = C.tid & 63; C.wave = __builtin_amdgcn_readfirstlane(C.tid >> 6); C.G = gridDim.x; C.bid = blockIdx.x;
    C.in = args.in; C.out = args.out; C.ws = args.ws;
    volatile LAS unsigned* MISC = (volatile LAS unsigned*)(C.lds + MISC_OFF);
    if (C.tid < 32) MISC[C.tid] = 0u;
    __syncthreads();
    XcdBarrier bar = xcd_barrier_post((unsigned*)(C.ws + WS_CTL) + CW_BAR, MISC + 8);
    all_phases(C, args, bar, std::make_integer_sequence<int, NPHASE>{});
}

#endif
template <int KIND>
__global__ void __launch_bounds__(512, 2) phase_kernel(Args args) {
    extern __shared__ __attribute__((aligned(16))) unsigned char lds_raw[];
    Ctx C;
    C.lds = (LAS unsigned char*)lds_raw; C.tid = threadIdx.x; C.lane = C.tid & 63; C.wave = __builtin_amdgcn_readfirstlane(C.tid >> 6); C.G = gridDim.x; C.bid = blockIdx.x;
    C.in = args.in; C.out = args.out; C.ws = args.ws;
    const int ph = args.ph_lo;
    if (KIND == 0) phase_p0(C);
    else if (KIND == 1) phase_p1(C);
    else if (KIND == 30) phase_final(C);
    else {
        const int i = (ph - 2) / 7, j = i >> 1; const bool conv = (i & 1) == 0;
        if (KIND == 2) { }
        else if (KIND == 4) { if (i > 0) { prep_layer(C, i, 2, 0); __syncthreads(); } if (conv) dwconv_phase(C, j); else scan_phase(C, j); }
        else if (KIND == 5) readout_phase(C, j, i == DEPTH - 1);
        else run_phase(C, ph);
    }
}

#ifndef PROBE_RD
#define PROBE_RD 0
#endif
#if PROBE_RD
__global__ void __launch_bounds__(512, 2) probe_read_kernel(Args args) {
    extern __shared__ __attribute__((aligned(16))) unsigned char lds_raw[];
    Ctx C;
    C.lds = (LAS unsigned char*)lds_raw; C.tid = threadIdx.x; C.lane = C.tid & 63; C.wave = __builtin_amdgcn_readfirstlane(C.tid >> 6); C.G = gridDim.x; C.bid = blockIdx.x;
    C.in = args.in; C.out = args.out; C.ws = args.ws;
    readout_phase<PROBE_RD>(C, 1, true);
}
#endif
extern "C" void kernel_launch(void* const* d_in, const int* in_sizes, int n_in, void* d_out, int out_size, void* d_ws, size_t ws_size, hipStream_t stream) {
    static int grid = 0;
    if (grid == 0) {
        if (n_in != 22 || out_size != T * D || ws_size < WS_END + (PROBE_RD ? 20 * MiB : 0)) { fprintf(stderr, "kernel_launch: unexpected problem (n_in %d out %d ws %zu, need %zu)\n", n_in, out_size, ws_size, (size_t)WS_END); grid = -1; return; }
        int dev = 0, cus = 0;
        if (hipGetDevice(&dev) != hipSuccess || hipDeviceGetAttribute(&cus, hipDeviceAttributeMultiprocessorCount, dev) != hipSuccess) { grid = -1; return; }
        bool ok = true;
        ok &= hipFuncSetAttribute((const void*)phase_kernel<0>, hipFuncAttributeMaxDynamicSharedMemorySize, LDS_BYTES) == hipSuccess;
        ok &= hipFuncSetAttribute((const void*)phase_kernel<1>, hipFuncAttributeMaxDynamicSharedMemorySize, LDS_BYTES) == hipSuccess;
        ok &= hipFuncSetAttribute((const void*)phase_kernel<2>, hipFuncAttributeMaxDynamicSharedMemorySize, LDS_BYTES) == hipSuccess;
        ok &= hipFuncSetAttribute((const void*)phase_kernel<3>, hipFuncAttributeMaxDynamicSharedMemorySize, LDS_BYTES) == hipSuccess;
        ok &= hipFuncSetAttribute((const void*)phase_kernel<4>, hipFuncAttributeMaxDynamicSharedMemorySize, LDS_BYTES) == hipSuccess;
        ok &= hipFuncSetAttribute((const void*)phase_kernel<5>, hipFuncAttributeMaxDynamicSharedMemorySize, LDS_BYTES) == hipSuccess;
        ok &= hipFuncSetAttribute((const void*)phase_kernel<30>, hipFuncAttributeMaxDynamicSharedMemorySize, LDS_BYTES) == hipSuccess;
#if ONE_LAUNCH
        ok &= hipFuncSetAttribute((const void*)mega_kernel, hipFuncAttributeMaxDynamicSharedMemorySize, LDS_BYTES) == hipSuccess;
#endif
        if (!ok) { fprintf(stderr, "kernel_launch: hipFuncSetAttribute failed\n"); grid = -1; return; }
        grid = cus > 0 ? cus : 256;
    }
    if (grid < 0) return;
    Args a{};
    for (int i = 0; i < 22; ++i) a.in[i] = (const float*)d_in[i];
    a.out = (float*)d_out; a.ws = (unsigned char*)d_ws;
#if ONE_LAUNCH
    if (hipMemsetAsync((char*)d_ws + WS_CTL, 0, 65536, stream) != hipSuccess) { fprintf(stderr, "kernel_launch: memset failed\n"); return; }
    a.ph_lo = 0; a.ph_hi = NPHASE;
    hipLaunchKernelGGL(mega_kernel, dim3(grid), dim3(512), LDS_BYTES, stream, a);
    return;
#endif
    for (int ph = 0; ph < NPHASE; ++ph) {
        const int i = (ph - 2) / 7, sub = (ph - 2) % 7;
        if (ph >= 2 && ph < 30) { if (sub == 0) continue; if (sub == 3 && (i & 1) == 0) continue; }
        a.ph_lo = ph; a.ph_hi = ph + 1;
        const dim3 g(grid), b(512);
        if (ph == 0) hipLaunchKernelGGL(phase_kernel<0>, g, b, LDS_BYTES, stream, a);
        else if (ph == 1) hipLaunchKernelGGL(phase_kernel<1>, g, b, LDS_BYTES, stream, a);
        else if (ph == 30) hipLaunchKernelGGL(phase_kernel<30>, g, b, LDS_BYTES, stream, a);
        else if (sub == 0) hipLaunchKernelGGL(phase_kernel<2>, g, b, LDS_BYTES, stream, a);
        else if (sub == 2) hipLaunchKernelGGL(phase_kernel<4>, g, b, LDS_BYTES, stream, a);
        else if (sub == 3) hipLaunchKernelGGL(phase_kernel<5>, g, b, LDS_BYTES, stream, a);
        else hipLaunchKernelGGL(phase_kernel<3>, g, b, LDS_BYTES, stream, a);
#ifdef PROBE_G
        if (ph == 30) { Args a2 = a; a2.ph_lo = PROBE_G; a2.ph_hi = PROBE_G + 1; hipLaunchKernelGGL(phase_kernel<3>, g, b, LDS_BYTES, stream, a2); }
#endif
#if PROBE_RD
        if (ph == 30) { hipFuncSetAttribute((const void*)probe_read_kernel, hipFuncAttributeMaxDynamicSharedMemorySize, LDS_BYTES); hipLaunchKernelGGL(probe_read_kernel, g, b, LDS_BYTES, stream, a); }
#endif
        {   const bool conv = (i & 1) == 0;
            const bool dup = ((ph >= 2 && ph < 30) && (((PROBE_DUP & 1) && (sub == 1 || sub == 5)) || ((PROBE_DUP & 2) && sub == 2 && !conv) || ((PROBE_DUP & 4) && sub == 2 && conv) || ((PROBE_DUP & 8) && sub == 0))) || ((PROBE_DUP & 16) && ph < 2);
            if (dup) {
                if (ph == 0) hipLaunchKernelGGL(phase_kernel<0>, g, b, LDS_BYTES, stream, a);
                else if (ph == 1) hipLaunchKernelGGL(phase_kernel<1>, g, b, LDS_BYTES, stream, a);
                else if (sub == 0) hipLaunchKernelGGL(phase_kernel<2>, g, b, LDS_BYTES, stream, a);
                else if (sub == 2) hipLaunchKernelGGL(phase_kernel<4>, g, b, LDS_BYTES, stream, a);
                else hipLaunchKernelGGL(phase_kernel<3>, g, b, LDS_BYTES, stream, a);
            } }
    }
}
```

```cpp
#include <hip/hip_runtime.h>
#include <cstdio>
#include <cstdint>
#include <utility>

#ifndef ONE_LAUNCH
#define ONE_LAUNCH 1
#endif

typedef unsigned short bf16_t;
typedef short bf16x8 __attribute__((ext_vector_type(8)));
typedef float f32x4 __attribute__((ext_vector_type(4)));
typedef float f32x2 __attribute__((ext_vector_type(2)));
typedef unsigned u32x2 __attribute__((ext_vector_type(2)));
typedef unsigned u32x4 __attribute__((ext_vector_type(4)));
typedef __bf16 bf16x2_t __attribute__((ext_vector_type(2)));
typedef short s16x4 __attribute__((ext_vector_type(4)));
#define LAS __attribute__((address_space(3)))

constexpr int D = 1024, T = 16384, TC = 256, R = T + TC, NH = 4, DK = 256, DV = 512, QKW = 1024, VW = 2048, INW = 8192, DFF = 2816, FF2 = 5632, CK = 31, DEPTH = 4;
constexpr int NSLOT = 33;
constexpr float NORM_EPS = 1e-6f, LN_EPS = 1e-5f;

constexpr size_t MiB = 1u << 20, KiB = 1u << 10;
constexpr size_t WS_CTL = 0, CTL_ZERO_BYTES = 1 * MiB;
constexpr size_t WS_MODV = 1 * MiB;
constexpr size_t WS_S1 = 1 * MiB + 256 * KiB;
constexpr size_t WS_S2 = 1 * MiB + 320 * KiB;
constexpr size_t WS_CVA = 1 * MiB + 384 * KiB;
constexpr size_t WS_CVF = 1 * MiB + 640 * KiB;
constexpr size_t WS_TABC = 1 * MiB + 832 * KiB;
constexpr size_t WS_TABS = 1 * MiB + 912 * KiB;
constexpr size_t WS_STATS = 2 * MiB;
constexpr size_t WS_XCTX = 4 * MiB;
constexpr size_t WS_WA = 8 * MiB;
constexpr size_t WS_WA2 = 24 * MiB;
constexpr size_t WS_WF1 = 28 * MiB;
constexpr size_t WS_WF2 = 40 * MiB;
constexpr size_t WS_XS = 48 * MiB;
constexpr size_t WS_SCP = 48 * MiB;
constexpr size_t WS_BIG = 114 * MiB;
constexpr size_t WS_Q = WS_BIG, WS_K = WS_BIG + 33 * MiB, WS_VT = WS_BIG + 66 * MiB, WS_GF = WS_BIG + 131 * MiB, WS_GB = WS_BIG + 196 * MiB;
constexpr size_t WS_U = WS_BIG, WS_A2 = WS_BIG + 33 * MiB, WS_H = WS_BIG;
constexpr size_t WS_END = WS_BIG + 261 * MiB;
static_assert((size_t)R * 1024 * 2 <= 33 * MiB && (size_t)R * 2048 * 2 <= 65 * MiB && (size_t)R * DFF * 2 <= 131 * MiB, "map");
static_assert((size_t)NSLOT * 8 * 512 * 256 * 2 <= 66 * MiB, "scp");

constexpr int LDS_BYTES = 147456;

__device__ __forceinline__ unsigned pk2(float lo, float hi) { f32x2 v = {lo, hi}; bf16x2_t b = __builtin_convertvector(v, bf16x2_t); return __builtin_bit_cast(unsigned, b); }
__device__ __forceinline__ float bflo(unsigned u) { return __uint_as_float(u << 16); }
__device__ __forceinline__ float bfhi(unsigned u) { return __uint_as_float(u & 0xffff0000u); }
__device__ __forceinline__ float sigmf(float x) { return __builtin_amdgcn_rcpf(1.f + __builtin_amdgcn_exp2f(-1.4426950408889634f * x)); }
__device__ __forceinline__ float siluf(float x) { return x * sigmf(x); }
__device__ __forceinline__ float wave_sum63(float v) {
    v += __builtin_bit_cast(float, __builtin_amdgcn_update_dpp(0, __builtin_bit_cast(int, v), 0xB1, 0xF, 0xF, false));
    v += __builtin_bit_cast(float, __builtin_amdgcn_update_dpp(0, __builtin_bit_cast(int, v), 0x4E, 0xF, 0xF, false));
    v += __builtin_bit_cast(float, __builtin_amdgcn_update_dpp(0, __builtin_bit_cast(int, v), 0x141, 0xF, 0xF, false));
    v += __builtin_bit_cast(float, __builtin_amdgcn_update_dpp(0, __builtin_bit_cast(int, v), 0x140, 0xF, 0xF, false));
    v += __builtin_bit_cast(float, __builtin_amdgcn_update_dpp(0, __builtin_bit_cast(int, v), 0x142, 0xA, 0xF, false));
    v += __builtin_bit_cast(float, __builtin_amdgcn_update_dpp(0, __builtin_bit_cast(int, v), 0x143, 0xC, 0xF, false));
    return v;
}
__device__ __forceinline__ int perm_glu(int n, int H) { if (n < H) return 32 * (n >> 4) + (n & 15); const int n2 = n - H; return 32 * (n2 >> 4) + 16 + (n2 & 15); }
__device__ __forceinline__ int perm_win(int n) {
    if (n >= 2 * QKW) return n;
    const int part = n >> 10, hn = n & 1023, h = hn >> 8, d = hn & 255, quarter = d >> 6, idx = d & 63;
    const int Gp = (quarter >> 1) * 4 + (idx >> 4), i = (quarter & 1) * 16 + (idx & 15);
    return part * 1024 + h * 256 + 32 * Gp + i;
}
__device__ __forceinline__ int perm_any(int mode, int n, int H) { return mode == 0 ? n : (mode == 1 ? perm_glu(n, H) : perm_win(n)); }

struct Args { const float* in[22]; float* out; unsigned char* ws; int ph_lo, ph_hi; };

struct Ctx {
    LAS unsigned char* lds;
    int tid, lane, wave, G, bid;
    const float* const* in; float* out; unsigned char* ws;
};

template <int VSILU>
__device__ __forceinline__ void gemv2_unit(Ctx& C, const float* W, int N, int n0, const float* v0, const float* v1, const float* bias, float* o0, float* o1, int pmode, int H) {
    LAS float* red = (LAS float*)C.lds;
    const int c4 = C.tid & 15, ks = C.tid >> 4;
    f32x4 a0 = {0.f, 0.f, 0.f, 0.f}, a1 = {0.f, 0.f, 0.f, 0.f};
#pragma unroll 8
    for (int i = 0; i < 32; ++i) {
        const int k = ks * 32 + i;
        const f32x4 w = *(const f32x4*)(W + (size_t)k * N + n0 + 4 * c4);
        float x0 = v0[k], x1 = v1[k];
        if (VSILU) { x0 = siluf(x0); x1 = siluf(x1); }
        a0 += w * x0; a1 += w * x1;
    }
#pragma unroll
    for (int e = 0; e < 4; ++e) { red[(ks * 2 + 0) * 64 + 4 * c4 + e] = a0[e]; red[(ks * 2 + 1) * 64 + 4 * c4 + e] = a1[e]; }
    __syncthreads();
    if (C.tid < 128) {
        const int s = C.tid >> 6, col = C.tid & 63; float sum = 0.f;
#pragma unroll 8
        for (int k2 = 0; k2 < 32; ++k2) sum += red[(k2 * 2 + s) * 64 + col];
        const int n = n0 + col; if (bias) sum += bias[n];
        (s ? o1 : o0)[perm_any(pmode, n, H)] = sum;
    }
    __syncthreads();
}

__device__ __forceinline__ void transpose_item(const float* W, int K, int N, bf16_t* WT, int pmode, int H, LAS float* scr, int item, int lane) {
    const int nblk = N / 32, kb = item / nblk, nb = item % nblk, k0 = 64 * kb, n0 = 32 * nb;
    {   f32x4 v[8];
#pragma unroll
        for (int i = 0; i < 8; ++i) v[i] = *(const f32x4*)(W + (size_t)(k0 + 8 * i + (lane >> 3)) * N + n0 + 4 * (lane & 7));
#pragma unroll
        for (int i = 0; i < 8; ++i) { LAS float* d = scr + (8 * i + (lane >> 3)) * 33 + 4 * (lane & 7); d[0] = v[i][0]; d[1] = v[i][1]; d[2] = v[i][2]; d[3] = v[i][3]; } }
    asm volatile("s_waitcnt lgkmcnt(0)" ::: "memory");
    const int c = lane & 7;
#pragma unroll
    for (int j = 0; j < 4; ++j) { const int n = (lane >> 3) + 8 * j; const LAS float* s = scr + (8 * c) * 33 + n;
        u32x4 o; o.x = pk2(s[0 * 33], s[1 * 33]); o.y = pk2(s[2 * 33], s[3 * 33]); o.z = pk2(s[4 * 33], s[5 * 33]); o.w = pk2(s[6 * 33], s[7 * 33]);
        *(u32x4*)(WT + (size_t)perm_any(pmode, n0 + n, H) * K + k0 + 8 * c) = o; }
    asm volatile("s_waitcnt lgkmcnt(0)" ::: "memory");
}
__device__ __forceinline__ void prep_layer(Ctx& C, int i, int part, int cu_lo) {
    if (C.bid < cu_lo) return;
    LAS float* scr = (LAS float*)(C.lds + C.wave * 16384);
    const int gw = (C.bid - cu_lo) * 8 + C.wave, NGW = (C.G - cu_lo) * 8, j = i >> 1;
    bf16_t* WA = (bf16_t*)(C.ws + WS_WA); bf16_t* WA2 = (bf16_t*)(C.ws + WS_WA2); bf16_t* WF1 = (bf16_t*)(C.ws + WS_WF1); bf16_t* WF2 = (bf16_t*)(C.ws + WS_WF2);
    const bool conv = (i & 1) == 0;
    const int I_A = (part & 1) ? (conv ? 16 * 64 : 16 * 256) : 0, I_A2 = (part & 1) ? (conv ? 16 * 32 : 32 * 32) : 0, I_F1 = (part & 2) ? 16 * 176 : 0, I_F2 = (part & 2) ? 44 * 32 : 0;
    const int NIT = I_A + I_A2 + I_F1 + I_F2;
    for (int it = gw; it < NIT; it += NGW) {
        int r = it;
        if (r < I_A) { if (conv) transpose_item(C.in[8] + (size_t)j * 1024 * 2048, 1024, 2048, WA, 1, 1024, scr, r, C.lane);
                       else transpose_item(C.in[16] + (size_t)j * 1024 * 8192, 1024, 8192, WA, 2, 0, scr, r, C.lane); continue; } r -= I_A;
        if (r < I_A2) { if (conv) transpose_item(C.in[14] + (size_t)j * 1024 * 1024, 1024, 1024, WA2, 0, 0, scr, r, C.lane);
                        else transpose_item(C.in[18] + (size_t)j * 2048 * 1024, 2048, 1024, WA2, 0, 0, scr, r, C.lane); continue; } r -= I_A2;
        if (r < I_F1) { transpose_item(C.in[19] + (size_t)i * 1024 * FF2, 1024, FF2, WF1, 1, DFF, scr, r, C.lane); continue; } r -= I_F1;
        transpose_item(C.in[20] + (size_t)i * DFF * 1024, DFF, 1024, WF2, 0, 0, scr, r, C.lane);
    }
}

__device__ __forceinline__ float row_rs(const float* stats, int row, int fq) {
    const f32x4 p = *(const f32x4*)(stats + (size_t)row * 16 + 4 * fq);
    float s = (p[0] + p[1]) + (p[2] + p[3]);
    s += __shfl_xor(s, 16); s += __shfl_xor(s, 32);
    return 1.0f / sqrtf(s * (1.0f / 1024.0f) + NORM_EPS);
}
struct EpiGLU {
    static constexpr bool STATS = false, NEEDRS = true;
    unsigned char* ws; int cvoff  , cvstride  , outoff  , ldo, act;
    float* stats;
    __device__ __forceinline__ float row_begin(int row, int fq) const { return row_rs((const float*)(ws + WS_STATS), row, fq); }
    __device__ __forceinline__ float item(int row, int colp, f32x4 v0, f32x4 v1, float rs) const {
        const float* cv = (const float*)ws + cvoff + (row < T ? 0 : cvstride);
        const f32x4 ca = *(const f32x4*)(cv + colp), cg = *(const f32x4*)(cv + colp + 16);
        float o[4];
#pragma unroll
        for (int e = 0; e < 4; ++e) { const float a = rs * v0[e] + ca[e], g = rs * v1[e] + cg[e]; o[e] = act == 0 ? a * sigmf(g) : siluf(a) * g; }
        const int oc = (colp >> 5) * 16 + (colp & 15);
        u32x2 w; w.x = pk2(o[0], o[1]); w.y = pk2(o[2], o[3]);
        *(u32x2*)((bf16_t*)(ws + outoff) + (size_t)row * ldo + oc) = w;
        return 0.f;
    }
};
struct EpiRes {
    static constexpr bool STATS = true, NEEDRS = false;
    unsigned char* ws; float* xl; const float* xin  ; const float* cin  ; const float* bias;
    int mgoff  , snoff  ;
    float* stats;
    __device__ __forceinline__ float row_begin(int, int) const { return 1.f; }
    __device__ __forceinline__ float item(int row, int colp, f32x4 v0, f32x4 v1, float) const {
        const bool lat = row < T;
        float* xr = lat ? xl + (size_t)row * 1024 : (float*)(ws + WS_XCTX) + (size_t)(row - T) * 1024;
        const float* xi = lat ? xin + (size_t)row * 1024 : cin + (size_t)(row - T) * 1024;
        const float* mg = (const float*)ws + mgoff + (lat ? 0 : 6144); const float* sn = (const float*)ws + snoff + (lat ? 0 : 1024);
        bf16_t* xs = (bf16_t*)(ws + WS_XS);
        float ss = 0.f;
#pragma unroll
        for (int hlf = 0; hlf < 2; ++hlf) {
            const int c = colp + 16 * hlf; const f32x4 v = hlf ? v1 : v0;
            const f32x4 xo = *(const f32x4*)(xi + c), m4 = *(const f32x4*)(mg + c);
            f32x4 b4 = {0.f, 0.f, 0.f, 0.f}; if (bias) b4 = *(const f32x4*)(bias + c);
            const f32x4 xn = xo + m4 * (v + b4);
            *(f32x4*)(xr + c) = xn;
            ss += (xn[0] * xn[0] + xn[1] * xn[1]) + (xn[2] * xn[2] + xn[3] * xn[3]);
            if (snoff >= 0) { const f32x4 s4 = *(const f32x4*)(sn + c); u32x2 w; w.x = pk2(xn[0] * s4[0], xn[1] * s4[1]); w.y = pk2(xn[2] * s4[2], xn[3] * s4[3]);
                *(u32x2*)(xs + (size_t)row * 1024 + c) = w; }
        }
        return ss;
    }
};
struct EpiWin {
    static constexpr bool STATS = false, NEEDRS = true;
    unsigned char* ws; int cvoff;
    float* stats;
    __device__ __forceinline__ float row_begin(int row, int fq) const { return row_rs((const float*)(ws + WS_STATS), row, fq); }
    __device__ __forceinline__ float item(int row, int colp, f32x4 v0, f32x4 v1, float rs) const {
        const float* cv = (const float*)ws + cvoff + (row < T ? 0 : 8192);
        const f32x4 c0 = *(const f32x4*)(cv + colp), c1 = *(const f32x4*)(cv + colp + 16);
        f32x4 a = v0 * rs + c0, b = v1 * rs + c1;
        if (colp < 2048) {
            if (row < T) {
                const int Gp = (colp >> 5) & 7, idx0 = 16 * (Gp & 3) + (colp & 15);
                const int ti = (Gp >> 2) ? 256 + (row & 63) : (row >> 6);
                const f32x4 cs = *(const f32x4*)((const float*)(ws + WS_TABC) + ti * 64 + idx0), sn = *(const f32x4*)((const float*)(ws + WS_TABS) + ti * 64 + idx0);
                const f32x4 o1 = a * cs - b * sn, o2 = b * cs + a * sn; a = o1; b = o2;
            }
            bf16_t* dst = (bf16_t*)(ws + WS_Q);
            if (colp >= 1024) { dst = (bf16_t*)(ws + WS_K); a = a * 0.0625f; b = b * 0.0625f; }
            const int c = colp & 1023;
            u32x2 w; w.x = pk2(a[0], a[1]); w.y = pk2(a[2], a[3]); *(u32x2*)(dst + (size_t)row * 1024 + c) = w;
            w.x = pk2(b[0], b[1]); w.y = pk2(b[2], b[3]); *(u32x2*)(dst + (size_t)row * 1024 + c + 16) = w;
        } else if (colp < 4096) {
            const int c = colp - 2048;
            bf16_t* vt = (bf16_t*)(ws + WS_VT);
#pragma unroll
            for (int e = 0; e < 4; ++e) { vt[(size_t)(c + e) * R + row] = (bf16_t)(pk2(a[e], 0.f) & 0xffffu); vt[(size_t)(c + 16 + e) * R + row] = (bf16_t)(pk2(b[e], 0.f) & 0xffffu); }
        } else {
            bf16_t* dst = (bf16_t*)(ws + (colp < 6144 ? WS_GF : WS_GB)); const int c = (colp - 4096) & 2047;
            u32x2 w; w.x = pk2(a[0], a[1]); w.y = pk2(a[2], a[3]); *(u32x2*)(dst + (size_t)row * 2048 + c) = w;
            w.x = pk2(b[0], b[1]); w.y = pk2(b[2], b[3]); *(u32x2*)(dst + (size_t)row * 2048 + c + 16) = w;
        }
        return 0.f;
    }
};

namespace pg8 {
#define PG8_LAS __attribute__((address_space(3)))
typedef unsigned short bf16_t;
typedef short bf16x8 __attribute__((ext_vector_type(8)));
typedef float f32x4 __attribute__((ext_vector_type(4)));
typedef unsigned u32x4 __attribute__((ext_vector_type(4)));
constexpr int BM = 256, BK = 64, HALF = 128, HTB = HALF * BK * 2  , STAGE_BYTES = 8 * HTB, NXCD = 8, WGM = 8;

__host__ __device__ __forceinline__ int lds_byte(int r, int c) { const int st = (r >> 4) * 2 + (c >> 5), rr = r & 15, cc = c & 31, ob = rr * 64 + cc * 2; return st * 1024 + (ob ^ (((ob >> 9) & 1) << 5)); }
__host__ __device__ __forceinline__ void stage_rc(int b, int& R, int& C) { const int st = b / 1024, sb = b % 1024, swz = sb ^ (((sb >> 9) & 1) << 5); R = (st >> 1) * 16 + swz / 64; C = (st & 1) * 32 + (swz % 64) / 2; }
__host__ __device__ __forceinline__ int perm32(int rho) { const int n = rho >> 4, i = rho & 15; return 8 * (i >> 2) + 4 * n + (i & 3); }

struct Unit { int pm, pn; };
struct Gemm { const bf16_t* A; const bf16_t* Bt; int M, N, K; };

struct StaticOrder {
    int nM, nN, nwg, G, c;
    __host__ __device__ void init(int M, int N, int G_, int c_) { nM = M / BM; nN = N / BM; nwg = nM * nN; G = G_; c = c_; }
    __host__ __device__ bool next(int i, Unit& u) const {
        const long L = (long)i * G + c; if (L >= nwg) return false;
        int wgid = (int)L; { const int q = nwg / NXCD, r = nwg % NXCD, xcd = wgid % NXCD, off = wgid / NXCD; wgid = (xcd < r ? xcd * (q + 1) : r * (q + 1) + (xcd - r) * q) + off; }
        const int nig = WGM * nN, gid = wgid / nig, fm = gid * WGM, gsz = (nM - fm) < WGM ? (nM - fm) : WGM;
        u.pm = fm + ((wgid % nig) % gsz); u.pn = (wgid % nig) / gsz; return true;
    }
    __device__ __forceinline__ void a_ready(const Unit&) const {}
    __device__ __forceinline__ void done(const Unit&) const {}
};

template <class Epi, class Sched, bool ALIGN_EPI = false, bool SP2 = false, bool SWAPMMA = false>
__device__ __forceinline__ void gemm_phase(PG8_LAS unsigned char* lds, const Gemm g, const Sched& S, const Epi& E) {
    const int tid = threadIdx.x, wid = __builtin_amdgcn_readfirstlane(tid >> 6), lane = tid & 63, wr = wid >> 2, wc = wid & 3, fr = lane & 15, fq = lane >> 4;
    const int K = g.K, nt = K / BK;
    unsigned voffA[2], voffB[2];
#pragma unroll
    for (int i = 0; i < 2; ++i) { int R, C; stage_rc(tid * 16 + i * 8192, R, C); const int Rb = Epi::PERM ? ((R & ~31) + perm32(R & 31)) : R;
        voffA[i] = (unsigned)(R * K + C) * 2u; voffB[i] = (unsigned)(Rb * K + C) * 2u; }
    const size_t kstep = (size_t)(BK * 2);
    const size_t hstep = (size_t)HALF * K * 2;
    const size_t tstep = 2 * hstep;
    const unsigned ldsw = (unsigned)wid * 1024u;
    const int aoff = lds_byte(wr * 64 + fr, fq * 8), boff = lds_byte(wc * 32 + fr, fq * 8);
#define PG8_SA(b, h) (((b) * 2 + (h)) * HTB)
#define PG8_SB(b, h) ((4 + (b) * 2 + (h)) * HTB)
#define PG8_STAGE(bufoff, gbase, voff) do { _Pragma("unroll") for (int _i = 0; _i < 2; ++_i) \
        __builtin_amdgcn_global_load_lds((const unsigned*)((const char*)(gbase) + (voff)[_i]), (PG8_LAS unsigned*)(lds + (bufoff) + ldsw + _i * 8192), 16, 0, 0); } while (0)
#define PG8_LDA(dst, b, h) do { _Pragma("unroll") for (int m = 0; m < 4; ++m) _Pragma("unroll") for (int k = 0; k < 2; ++k) dst[m][k] = *(const PG8_LAS bf16x8*)(lds + PG8_SA(b, h) + aoff + m * 2048 + k * 1024); } while (0)
#define PG8_LDB(dst, b, h) do { _Pragma("unroll") for (int n = 0; n < 2; ++n) _Pragma("unroll") for (int k = 0; k < 2; ++k) dst[n][k] = *(const PG8_LAS bf16x8*)(lds + PG8_SB(b, h) + boff + n * 2048 + k * 1024); } while (0)
#define PG8_MMA(ai, bj, At, Bt) do { __builtin_amdgcn_s_setprio(1); _Pragma("unroll") for (int m = 0; m < 4; ++m) _Pragma("unroll") for (int n = 0; n < 2; ++n) _Pragma("unroll") for (int k = 0; k < 2; ++k) \
        acc[ai][bj][m][n] = SWAPMMA ? __builtin_amdgcn_mfma_f32_16x16x32_bf16(At[m][k], Bt[n][k], acc[ai][bj][m][n], 0, 0, 0) : __builtin_amdgcn_mfma_f32_16x16x32_bf16(Bt[n][k], At[m][k], acc[ai][bj][m][n], 0, 0, 0); __builtin_amdgcn_s_setprio(0); } while (0)
#define PG8_WAIT_V(n) asm volatile("s_waitcnt vmcnt(" #n ")" ::: "memory")
#define PG8_WAIT_L(n) asm volatile("s_waitcnt lgkmcnt(" #n ")" ::: "memory")
#define PG8_BAR __builtin_amdgcn_s_barrier()
#define PG8_SCHED __builtin_amdgcn_sched_barrier(0)
    Unit cur, nxt; int ui = 0;
    if (!S.next(0, cur)) return;
    f32x4 acc[2][2][4][2];
#pragma unroll
    for (int a = 0; a < 2; ++a)
#pragma unroll
        for (int b = 0; b < 2; ++b)
#pragma unroll
            for (int m = 0; m < 4; ++m)
#pragma unroll
                for (int n = 0; n < 2; ++n) acc[a][b][m][n] = (f32x4){0.f, 0.f, 0.f, 0.f};
    bf16x8 At[4][2], B0[2][2], B1[2][2];
    const char* cA = (const char*)g.A + (size_t)cur.pm * tstep; const char* cB = (const char*)g.Bt + (size_t)cur.pn * tstep;
    S.a_ready(cur);
    if constexpr (SP2) {
        PG8_STAGE(PG8_SB(0, 0), cB, voffB); PG8_STAGE(PG8_SB(0, 1), cB + hstep, voffB); PG8_STAGE(PG8_SA(0, 0), cA, voffA); PG8_STAGE(PG8_SA(0, 1), cA + hstep, voffA);
        if (wr == 1) PG8_BAR;
        PG8_WAIT_V(2); PG8_BAR;
        PG8_STAGE(PG8_SB(1, 0), cB + kstep, voffB); PG8_STAGE(PG8_SA(1, 0), cA + kstep, voffA); PG8_STAGE(PG8_SB(1, 1), cB + hstep + kstep, voffB);
        PG8_WAIT_V(6); PG8_BAR;
    } else {
        PG8_STAGE(PG8_SB(0, 0), cB, voffB); PG8_STAGE(PG8_SA(0, 0), cA, voffA); PG8_STAGE(PG8_SB(0, 1), cB + hstep, voffB); PG8_STAGE(PG8_SA(0, 1), cA + hstep, voffA);
        if (wr == 1) PG8_BAR;
        PG8_WAIT_V(4); PG8_BAR;
        PG8_STAGE(PG8_SB(1, 0), cB + kstep, voffB); PG8_STAGE(PG8_SA(1, 0), cA + kstep, voffA); PG8_STAGE(PG8_SB(1, 1), cB + hstep + kstep, voffB);
        PG8_WAIT_V(6); PG8_BAR;
    }
    for (;;) {
        const bool has_next = S.next(ui + 1, nxt);
        const char* nA = has_next ? (const char*)g.A + (size_t)nxt.pm * tstep : cA; const char* nB = has_next ? (const char*)g.Bt + (size_t)nxt.pn * tstep : cB;
        for (int t = 0; t < nt; t += 2) {
            const bool last = (t == nt - 2);
            const char* a1 = cA + (size_t)(t + 1) * kstep;
            const char* a2 = last ? nA : cA + (size_t)(t + 2) * kstep; const char* b2 = last ? nB : cB + (size_t)(t + 2) * kstep;
            const char* a3 = a2 + kstep; const char* b3 = b2 + kstep;
            if (last && has_next) S.a_ready(nxt);
            if constexpr (SP2) {
            PG8_LDB(B0, 0, 0); PG8_LDB(B1, 0, 1); PG8_SCHED; PG8_LDA(At, 0, 0); PG8_STAGE(PG8_SA(1, 1), a1 + hstep, voffA);
            PG8_WAIT_V(8); PG8_WAIT_L(0); PG8_BAR; PG8_MMA(0, 0, At, B0); PG8_MMA(0, 1, At, B1); PG8_BAR; PG8_SCHED;
            PG8_LDA(At, 0, 1); PG8_STAGE(PG8_SB(0, 0), b2, voffB); PG8_STAGE(PG8_SB(0, 1), b2 + hstep, voffB); PG8_STAGE(PG8_SA(0, 0), a2, voffA);
            PG8_WAIT_V(8); PG8_WAIT_L(0); PG8_BAR; PG8_MMA(1, 0, At, B0); PG8_MMA(1, 1, At, B1); PG8_BAR; PG8_SCHED;
            PG8_LDB(B0, 1, 0); PG8_LDB(B1, 1, 1); PG8_SCHED; PG8_LDA(At, 1, 0); PG8_STAGE(PG8_SA(0, 1), a2 + hstep, voffA);
            PG8_WAIT_V(8); PG8_WAIT_L(0); PG8_BAR; PG8_MMA(0, 0, At, B0); PG8_MMA(0, 1, At, B1); PG8_BAR; PG8_SCHED;
            PG8_LDA(At, 1, 1); PG8_STAGE(PG8_SB(1, 0), b3, voffB); PG8_STAGE(PG8_SB(1, 1), b3 + hstep, voffB); PG8_STAGE(PG8_SA(1, 0), a3, voffA);
            PG8_WAIT_V(8); PG8_WAIT_L(0); PG8_BAR; PG8_MMA(1, 0, At, B0); PG8_MMA(1, 1, At, B1); PG8_BAR; PG8_SCHED;
            } else {
            PG8_LDB(B0, 0, 0); PG8_SCHED; PG8_LDA(At, 0, 0); PG8_STAGE(PG8_SA(1, 1), a1 + hstep, voffA);
            PG8_WAIT_L(8); PG8_BAR; PG8_WAIT_L(0); PG8_MMA(0, 0, At, B0); PG8_BAR; PG8_SCHED;
            PG8_LDB(B1, 0, 1); PG8_STAGE(PG8_SB(0, 0), b2, voffB);
            PG8_BAR; PG8_WAIT_L(0); PG8_MMA(0, 1, At, B1); PG8_BAR;
            PG8_LDA(At, 0, 1); PG8_STAGE(PG8_SA(0, 0), a2, voffA);
            PG8_BAR; PG8_WAIT_L(0); PG8_MMA(1, 0, At, B0); PG8_BAR; PG8_SCHED;
            PG8_STAGE(PG8_SB(0, 1), b2 + hstep, voffB);
            PG8_WAIT_V(6); PG8_BAR; PG8_MMA(1, 1, At, B1); PG8_BAR;
            PG8_LDB(B0, 1, 0); PG8_SCHED; PG8_LDA(At, 1, 0); PG8_STAGE(PG8_SA(0, 1), a2 + hstep, voffA);
            PG8_WAIT_L(8); PG8_BAR; PG8_WAIT_L(0); PG8_MMA(0, 0, At, B0); PG8_BAR; PG8_SCHED;
            PG8_LDB(B1, 1, 1); PG8_STAGE(PG8_SB(1, 0), b3, voffB);
            PG8_BAR; PG8_WAIT_L(0); PG8_MMA(0, 1, At, B1); PG8_BAR;
            PG8_LDA(At, 1, 1); PG8_STAGE(PG8_SA(1, 0), a3, voffA);
            PG8_BAR; PG8_WAIT_L(0); PG8_MMA(1, 0, At, B0); PG8_BAR; PG8_SCHED;
            PG8_STAGE(PG8_SB(1, 1), b3 + hstep, voffB);
            PG8_WAIT_V(6); PG8_BAR; PG8_MMA(1, 1, At, B1); PG8_BAR;
            }
        }
        if constexpr (ALIGN_EPI) { if (wr == 0) PG8_BAR; }
        if constexpr (!Epi::AFTER_DRAIN) { E(acc, cur, wr, wc, fr, fq); S.done(cur); }
        if (!has_next) break;
#pragma unroll
        for (int a = 0; a < 2; ++a)
#pragma unroll
            for (int b = 0; b < 2; ++b)
#pragma unroll
                for (int m = 0; m < 4; ++m)
#pragma unroll
                    for (int n = 0; n < 2; ++n) acc[a][b][m][n] = (f32x4){0.f, 0.f, 0.f, 0.f};
        cur = nxt; cA = nA; cB = nB; ++ui;
        if constexpr (ALIGN_EPI) { if (wr == 1) PG8_BAR; }
    }
    PG8_WAIT_V(0);
    if constexpr (!ALIGN_EPI) { if (wr == 0) PG8_BAR; }
    PG8_BAR;
    if constexpr (Epi::AFTER_DRAIN) { E.fused(acc, cur, wr, wc, fr, fq, lds, wid, lane); S.done(cur); }
#undef PG8_SA
#undef PG8_SB
#undef PG8_STAGE
#undef PG8_LDA
#undef PG8_LDB
#undef PG8_MMA
#undef PG8_WAIT_V
#undef PG8_WAIT_L
#undef PG8_BAR
#undef PG8_SCHED
}
}

template <class E0> struct EpiAdapt {
    static constexpr bool PERM = false, AFTER_DRAIN = false;
    E0 e; int col_base;
    __device__ __forceinline__ void operator()(const pg8::f32x4 (&acc)[2][2][4][2], const pg8::Unit& u, int wr, int wc, int fr, int fq) const {
#pragma unroll
        for (int ai = 0; ai < 2; ++ai)
#pragma unroll
            for (int m = 0; m < 4; ++m) {
                const int row = u.pm * 256 + ai * 128 + wr * 64 + m * 16 + fr;
                const float rs = e.row_begin(row, fq);
                float ss = 0.f;
#pragma unroll
                for (int bj = 0; bj < 2; ++bj) ss += e.item(row, col_base + u.pn * 256 + bj * 128 + wc * 32 + 4 * fq, acc[ai][bj][m][0], acc[ai][bj][m][1], rs);
                if constexpr (E0::STATS) { ss += __shfl_xor(ss, 16); ss += __shfl_xor(ss, 32); if (fq == 0) e.stats[(size_t)row * 16 + (col_base >> 6) + u.pn * 4 + wc] = ss; }
            }
    }
};
struct EpiResBig {
    static constexpr bool PERM = false, AFTER_DRAIN = false;
    EpiRes e;
    __device__ __forceinline__ void operator()(const pg8::f32x4 (&acc)[2][2][4][2], const pg8::Unit& u, int wr, int wc, int fr, int fq) const {
        const float* mg = (const float*)e.ws + e.mgoff; const float* sn = (const float*)e.ws + e.snoff;
        bf16_t* xs = (bf16_t*)(e.ws + WS_XS);
        const int colb = u.pn * 256 + wc * 32 + 4 * fq;
#pragma unroll
        for (int ai = 0; ai < 2; ++ai) {
            const int rowb = u.pm * 256 + ai * 128 + wr * 64 + fr;
            f32x4 xo[4][2][2];
#pragma unroll
            for (int m = 0; m < 4; ++m)
#pragma unroll
                for (int bj = 0; bj < 2; ++bj)
#pragma unroll
                    for (int hl = 0; hl < 2; ++hl) xo[m][bj][hl] = *(const f32x4*)(e.xin + (size_t)(rowb + 16 * m) * 1024 + colb + 128 * bj + 16 * hl);
#pragma unroll
            for (int m = 0; m < 4; ++m) {
                const int row = rowb + 16 * m; float ss = 0.f;
#pragma unroll
                for (int bj = 0; bj < 2; ++bj)
#pragma unroll
                    for (int hl = 0; hl < 2; ++hl) {
                        const int c = colb + 128 * bj + 16 * hl;
                        const f32x4 m4 = *(const f32x4*)(mg + c);
                        f32x4 b4 = {0.f, 0.f, 0.f, 0.f}; if (e.bias) b4 = *(const f32x4*)(e.bias + c);
                        const f32x4 xn = xo[m][bj][hl] + m4 * (acc[ai][bj][m][hl] + b4);
                        *(f32x4*)(e.xl + (size_t)row * 1024 + c) = xn;
                        ss += (xn[0] * xn[0] + xn[1] * xn[1]) + (xn[2] * xn[2] + xn[3] * xn[3]);
                        if (e.snoff >= 0) { const f32x4 s4 = *(const f32x4*)(sn + c); u32x2 w; w.x = pk2(xn[0] * s4[0], xn[1] * s4[1]); w.y = pk2(xn[2] * s4[2], xn[3] * s4[3]);
                            *(u32x2*)(xs + (size_t)row * 1024 + c) = w; }
                    }
                ss += __shfl_xor(ss, 16); ss += __shfl_xor(ss, 32); if (fq == 0) e.stats[(size_t)row * 16 + u.pn * 4 + wc] = ss;
            }
        }
    }
};
struct EpiVt {
    static constexpr bool PERM = false, AFTER_DRAIN = false;
    unsigned char* ws; int cvoff;
    __device__ __forceinline__ void operator()(const pg8::f32x4 (&acc)[2][2][4][2], const pg8::Unit& u, int wr, int wc, int fr, int fq) const {
        bf16_t* vt = (bf16_t*)(ws + WS_VT);
#pragma unroll
        for (int ai = 0; ai < 2; ++ai)
#pragma unroll
            for (int m = 0; m < 4; ++m) {
                const int rowb = u.pm * 256 + ai * 128 + wr * 64 + m * 16;
                const float rsl = row_rs((const float*)(ws + WS_STATS), rowb + fr, fq);
                float rsv[4];
#pragma unroll
                for (int e = 0; e < 4; ++e) rsv[e] = __shfl(rsl, 4 * fq + e);
                const float* cv = (const float*)ws + cvoff + (rowb < T ? 0 : 8192);
#pragma unroll
                for (int bj = 0; bj < 2; ++bj)
#pragma unroll
                    for (int n = 0; n < 2; ++n) {
                        const int col = 2048 + u.pn * 256 + bj * 128 + wc * 32 + 16 * n + fr;
                        const float c0 = cv[col]; const pg8::f32x4 a = acc[ai][bj][m][n];
                        u32x2 w; w.x = pk2(a[0] * rsv[0] + c0, a[1] * rsv[1] + c0); w.y = pk2(a[2] * rsv[2] + c0, a[3] * rsv[3] + c0);
                        *(u32x2*)(vt + (size_t)(col - 2048) * R + rowb + 4 * fq) = w;
                    }
            }
    }
};
template <class Epi>
__device__ __forceinline__ void sgemm_small(Ctx& C, const bf16_t* A, const bf16_t* Bt, int row_lo, int Mrows, int N, int K, const Epi& E, int n_lo, int n_hi) {
    const int kh = C.wave >> 2, wc = C.wave & 3, fr = C.lane & 15, fq = C.lane >> 4;
    const int nM = Mrows / 16, nN = n_hi - n_lo, nU = nM * nN, Kh = K >> 1;
    LAS f32x4* xch = (LAS f32x4*)C.lds;
    for (int u = (C.G - 1 - C.bid); u < nU; u += C.G) {
        const int un = n_lo + u / nM, um = u % nM;
        const int row0 = row_lo + 16 * um, col0 = 256 * un;
        f32x4 acc[2][2];
#pragma unroll
        for (int b = 0; b < 2; ++b)
#pragma unroll
            for (int n = 0; n < 2; ++n) acc[b][n] = (f32x4){0.f, 0.f, 0.f, 0.f};
        const bf16_t* ap = A + (size_t)(row0 + fr) * K + kh * Kh + 8 * fq;
        const bf16_t* bp = Bt + (size_t)(col0 + 32 * wc + fr) * K + kh * Kh + 8 * fq;
#pragma unroll 4
        for (int k0 = 0; k0 < Kh; k0 += 32) {
            bf16x8 bf[2][2];
            const bf16x8 af = *(const bf16x8*)(ap + k0);
#pragma unroll
            for (int bj = 0; bj < 2; ++bj)
#pragma unroll
                for (int n = 0; n < 2; ++n) bf[bj][n] = *(const bf16x8*)(bp + (size_t)(128 * bj + 16 * n) * K + k0);
#pragma unroll
            for (int bj = 0; bj < 2; ++bj)
#pragma unroll
                for (int n = 0; n < 2; ++n) acc[bj][n] = __builtin_amdgcn_mfma_f32_16x16x32_bf16(bf[bj][n], af, acc[bj][n], 0, 0, 0);
        }
        if (kh == 1) {
#pragma unroll
            for (int bj = 0; bj < 2; ++bj)
#pragma unroll
                for (int n = 0; n < 2; ++n) xch[(wc * 4 + bj * 2 + n) * 64 + C.lane] = acc[bj][n];
        }
        __syncthreads();
        if (kh == 0) {
#pragma unroll
            for (int bj = 0; bj < 2; ++bj)
#pragma unroll
                for (int n = 0; n < 2; ++n) acc[bj][n] += xch[(wc * 4 + bj * 2 + n) * 64 + C.lane];
            const int row = row0 + fr;
            const float rs = E.row_begin(row, fq);
            float ss = 0.f;
#pragma unroll
            for (int bj = 0; bj < 2; ++bj) ss += E.item(row, col0 + 128 * bj + 32 * wc + 4 * fq, acc[bj][0], acc[bj][1], rs);
            if constexpr (Epi::STATS) { ss += __shfl_xor(ss, 16); ss += __shfl_xor(ss, 32); if (fq == 0) E.stats[(size_t)row * 16 + un * 4 + wc] = ss; }
        }
        __syncthreads();
    }
}
template <class E0>
__device__ __forceinline__ void gemm_both(Ctx& C, const bf16_t* A, const bf16_t* Bt, int Mbig, int N, int K, const E0& E, int ctx_n_lo, int ctx_n_hi, int nb_lo = 0, int nb_hi = -1) {
    if (nb_hi < 0) nb_hi = N / 256;
    { pg8::Gemm g{A, Bt + (size_t)nb_lo * 256 * K, Mbig, (nb_hi - nb_lo) * 256, K}; pg8::StaticOrder S; S.init(Mbig, (nb_hi - nb_lo) * 256, C.G, C.bid); EpiAdapt<E0> EA{E, nb_lo * 256};
      pg8::gemm_phase<EpiAdapt<E0>, pg8::StaticOrder, true, true>(C.lds, g, S, EA); }
    if (Mbig < R && ctx_n_hi > ctx_n_lo) { __syncthreads(); sgemm_small(C, A, Bt, T, R - T, N, K, E, ctx_n_lo, ctx_n_hi); }
}
__device__ __forceinline__ void dwconv_phase(Ctx& C, int j) {
    const bf16_t* U = (const bf16_t*)(C.ws + WS_U); bf16_t* A2 = (bf16_t*)(C.ws + WS_A2);
    const float* dww = C.in[10] + (size_t)j * CK * 1024; const float* dwb = C.in[11] + j * 1024; const float* lng = C.in[12] + j * 1024; const float* lnb = C.in[13] + j * 1024;
    constexpr int TT = 33, NR = TT + 30;
    LAS unsigned char* tile = C.lds; LAS float* part = (LAS float*)(C.lds + NR * 2048);
    const int tid = C.tid;
    constexpr int NUL = (T + TT - 1) / TT, NUC = (TC + TT - 1) / TT;
    f32x2 wt[CK];
#pragma unroll
    for (int jt = 0; jt < CK; ++jt) wt[jt] = *(const f32x2*)(dww + jt * 1024 + 2 * tid);
    const f32x2 b2 = *(const f32x2*)(dwb + 2 * tid), g2 = *(const f32x2*)(lng + 2 * tid), bb2 = *(const f32x2*)(lnb + 2 * tid);
    for (int u = C.bid; u < NUL + NUC; u += C.G) {
        const bool lat = u < NUL; const int base = lat ? 0 : T, n = lat ? T : TC, t0 = TT * (lat ? u : u - NUL);
        const int nv = (n - t0) < TT ? (n - t0) : TT;
        for (int idx = tid; idx < NR * 128; idx += 512) {
            const int rr = idx >> 7, ch = idx & 127, tt = t0 - 15 + rr;
            u32x4 v = {0u, 0u, 0u, 0u};
            if (tt >= 0 && tt < n) v = *(const u32x4*)(U + (size_t)(base + tt) * 1024 + ch * 8);
            *(LAS u32x4*)(tile + rr * 2048 + ch * 16) = v;
        }
        __syncthreads();
        f32x2 o[TT];
#pragma unroll
        for (int t = 0; t < TT; ++t) o[t] = b2;
#pragma unroll
        for (int hb = 0; hb < 3; ++hb) {
            f32x2 xw[41];
#pragma unroll
            for (int r = 0; r < 41; ++r) { const unsigned uu = *(const LAS unsigned*)(tile + (11 * hb + r) * 2048 + tid * 4); xw[r] = (f32x2){bflo(uu), bfhi(uu)}; }
#pragma unroll
            for (int t = 0; t < 11; ++t)
#pragma unroll
                for (int jt = 0; jt < CK; ++jt) o[11 * hb + t] += wt[jt] * xw[t + jt];
        }
#pragma unroll
        for (int t = 0; t < TT; ++t) {
            const float s = wave_sum63(o[t].x + o[t].y), q = wave_sum63(o[t].x * o[t].x + o[t].y * o[t].y);
            if (C.lane == 63) { part[(t * 8 + C.wave) * 2] = s; part[(t * 8 + C.wave) * 2 + 1] = q; }
        }
        __syncthreads();
#pragma unroll
        for (int t = 0; t < TT; ++t) {
            float s = 0.f, q = 0.f;
#pragma unroll
            for (int w = 0; w < 8; ++w) { s += part[(t * 8 + w) * 2]; q += part[(t * 8 + w) * 2 + 1]; }
            const float mean = s * (1.f / 1024.f), var = q * (1.f / 1024.f) - mean * mean, rstd = 1.0f / sqrtf(var + LN_EPS);
            const float y0 = (o[t].x - mean) * rstd * g2.x + bb2.x, y1 = (o[t].y - mean) * rstd * g2.y + bb2.y;
            if (t < nv) *(unsigned*)(A2 + (size_t)(base + t0 + t) * 1024 + 2 * tid) = pk2(siluf(y0), siluf(y1));
        }
        __syncthreads();
    }
}

__device__ __forceinline__ void scan_phase(Ctx& C, int j) {
    const bf16_t* Kb = (const bf16_t*)(C.ws + WS_K); const bf16_t* Vt = (const bf16_t*)(C.ws + WS_VT); bf16_t* Scp = (bf16_t*)(C.ws + WS_SCP);
    constexpr int SLOT = 32768;
    const int fr = C.lane & 15, fq = C.lane >> 4, w = C.wave, lane = C.lane;
    for (int cu = C.bid; cu < 256; cu += C.G) {
        const int hd = cu & 7, sidx = cu >> 3, h = hd >> 1, dir = hd & 1, dk_s = 64 * ((sidx >> 3) & 3), dv_s = 64 * (sidx & 7);
        const float gam = 1.0f - exp2f(C.in[17][(j * 2 + dir) * 4 + h]); const float L = log2f(gam);
        const float cdec = exp2f(L * 128.f);
        const bf16_t* ksrc[2]; const bf16_t* vsrc[2];
#pragma unroll
        for (int p = 0; p < 2; ++p) {
            const int kr = 8 * (2 * w + p) + (lane >> 3), kpos = lane & 7, kc = kpos ^ (((kr >> 3) & 1) << 1) ^ (((kr >> 1) & 1) << 2);
            ksrc[p] = Kb + (size_t)kr * 1024 + h * 256 + dk_s + 8 * kc;
            const int vr = 4 * (2 * w + p) + (lane >> 4), vpos = lane & 15, vc = vpos ^ (vr & 15);
            vsrc[p] = Vt + (size_t)(h * 512 + dv_s + vr) * R + 8 * vc;
        }
        auto tok_of = [&](int st) { const int sc = st < 129 ? st : 129; const int bl = sc < 2 ? (dir == 0 ? sc : 1 - sc) : (dir == 0 ? sc - 2 : 129 - sc); return (sc < 2 ? T : 0) + 128 * bl; };
#define SCAN_DMA(st) do { const int tok_ = tok_of(st); LAS unsigned char* sl_ = C.lds + ((st) & 3) * SLOT + (2 * w) * 1024; \
        __builtin_amdgcn_global_load_lds((const unsigned*)(ksrc[0] + (size_t)tok_ * 1024), (LAS unsigned*)(sl_), 16, 0, 0); \
        __builtin_amdgcn_global_load_lds((const unsigned*)(ksrc[1] + (size_t)tok_ * 1024), (LAS unsigned*)(sl_ + 1024), 16, 0, 0); \
        __builtin_amdgcn_global_load_lds((const unsigned*)(vsrc[0] + tok_), (LAS unsigned*)(sl_ + 16384), 16, 0, 0); \
        __builtin_amdgcn_global_load_lds((const unsigned*)(vsrc[1] + tok_), (LAS unsigned*)(sl_ + 16384 + 1024), 16, 0, 0); } while (0)
        const int mt = w >> 1, nh = w & 1, dkl = 16 * mt;
        const int trq = (fr >> 2), trp = fr & 3, trrow0 = 8 * fq + trq;
        const int trcol0 = (((2 * mt + (trp >> 1)) ^ ((fq & 1) << 1) ^ (((trq >> 1) & 1) << 2)) << 3) + 4 * (trp & 1);
        float kd[4][8];
#pragma unroll
        for (int ks = 0; ks < 4; ++ks)
#pragma unroll
            for (int e = 0; e < 8; ++e) { const int tl = 32 * ks + 8 * fq + e; kd[ks][e] = exp2f(L * (float)(dir == 0 ? 127 - tl : tl)); }
        int voff[2];
#pragma unroll
        for (int nt = 0; nt < 2; ++nt) { const int vr = 32 * nh + 16 * nt + fr; voff[nt] = 16384 + vr * 256; }
        f32x4 acc[2]; acc[0] = (f32x4){0.f, 0.f, 0.f, 0.f}; acc[1] = acc[0];
        const unsigned lds0 = (unsigned)(size_t)C.lds;
        __syncthreads();
        SCAN_DMA(0); SCAN_DMA(1); SCAN_DMA(2);
#pragma unroll 1
        for (int st = 0; st < 130; ++st) {
            asm volatile("s_waitcnt vmcnt(8)" ::: "memory");
            __builtin_amdgcn_s_barrier(); asm volatile("" ::: "memory");
            SCAN_DMA(st + 3);
            {   const bool isctx = st < 2; const int bl = isctx ? (dir == 0 ? st : 1 - st) : (dir == 0 ? st - 2 : 129 - st);
                const bool cp = dir == 0 ? ((bl & 3) == 0) : (isctx ? bl == 1 : (bl & 3) == 3);
                if (cp) {
                    const int slot = isctx ? 32 : (bl >> 2);
                    bf16_t* sp = Scp + ((size_t)((slot * 4 + h) * 2 + dir) * 512) * 256;
#pragma unroll
                    for (int nt = 0; nt < 2; ++nt) { u32x2 wv; wv.x = pk2(acc[nt][0], acc[nt][1]); wv.y = pk2(acc[nt][2], acc[nt][3]);
                        *(u32x2*)(sp + (size_t)(dv_s + 32 * nh + 16 * nt + fr) * 256 + dk_s + dkl + 4 * fq) = wv; }
                } }
            acc[0] = acc[0] * cdec; acc[1] = acc[1] * cdec;
            const unsigned sl = lds0 + (unsigned)((st & 3) * SLOT);
            u32x2 klo[4], khi[4]; u32x4 vfr[4][2];
#pragma unroll
            for (int ks = 0; ks < 4; ++ks) {
                const unsigned ka = sl + (unsigned)(((32 * ks + trrow0) * 64 + trcol0) * 2);
                asm volatile("ds_read_b64_tr_b16 %0, %1" : "=v"(klo[ks]) : "v"(ka));
                asm volatile("ds_read_b64_tr_b16 %0, %1 offset:512" : "=v"(khi[ks]) : "v"(ka));
#pragma unroll
                for (int nt = 0; nt < 2; ++nt) { const int vr = 32 * nh + 16 * nt + fr;
                    const unsigned va = sl + (unsigned)(voff[nt] + (((4 * ks + fq) ^ (vr & 15)) << 4));
                    asm volatile("ds_read_b128 %0, %1" : "=v"(vfr[ks][nt]) : "v"(va)); }
            }
            asm volatile("s_waitcnt lgkmcnt(0)" : "+v"(klo[0]), "+v"(klo[1]), "+v"(klo[2]), "+v"(klo[3]), "+v"(khi[0]), "+v"(khi[1]), "+v"(khi[2]), "+v"(khi[3]) :: "memory");
            asm volatile("" : "+v"(vfr[0][0]), "+v"(vfr[0][1]), "+v"(vfr[1][0]), "+v"(vfr[1][1]), "+v"(vfr[2][0]), "+v"(vfr[2][1]), "+v"(vfr[3][0]), "+v"(vfr[3][1]));
            __builtin_amdgcn_sched_barrier(0);
#pragma unroll
            for (int ks = 0; ks < 4; ++ks) {
                u32x4 pk;
                pk.x = pk2(bflo(klo[ks].x) * kd[ks][0], bfhi(klo[ks].x) * kd[ks][1]);
                pk.y = pk2(bflo(klo[ks].y) * kd[ks][2], bfhi(klo[ks].y) * kd[ks][3]);
                pk.z = pk2(bflo(khi[ks].x) * kd[ks][4], bfhi(khi[ks].x) * kd[ks][5]);
                pk.w = pk2(bflo(khi[ks].y) * kd[ks][6], bfhi(khi[ks].y) * kd[ks][7]);
                const bf16x8 af = __builtin_bit_cast(bf16x8, pk);
#pragma unroll
                for (int nt = 0; nt < 2; ++nt) acc[nt] = __builtin_amdgcn_mfma_f32_16x16x32_bf16(af, __builtin_bit_cast(bf16x8, vfr[ks][nt]), acc[nt], 0, 0, 0);
            }
        }
        asm volatile("s_waitcnt vmcnt(0)" ::: "memory");
        __syncthreads();
#undef SCAN_DMA
    }
}

template <int MT, int PV = 0>
__device__ __forceinline__ void readout_units(Ctx& C, int j) {
    const bf16_t* Q = (const bf16_t*)(C.ws + WS_Q); const bf16_t* Kb = (const bf16_t*)(C.ws + WS_K); const bf16_t* Vt = (const bf16_t*)(C.ws + WS_VT);
    const bf16_t* Scp = (const bf16_t*)(C.ws + WS_SCP); bf16_t* GF = (bf16_t*)(C.ws + WS_GF); const bf16_t* GB = (const bf16_t*)(C.ws + WS_GB);
    constexpr int QP = 264, PP = 136;
    constexpr int NROW = 16 * MT;
    LAS bf16_t* Qs = (LAS bf16_t*)C.lds;
    LAS bf16_t* P = (LAS bf16_t*)(C.lds + NROW * QP * 2);
    LAS float* red = (LAS float*)(C.lds + NROW * QP * 2 + NROW * PP * 2);
    const int w = C.wave, tid = C.tid;
    const int nunits = MT == 8 ? 512 : 32;
    for (int u0 = (MT == 8 ? C.bid : C.G - 1 - C.bid); u0 < nunits; u0 += C.G) {
        int h, b, sb = 0;
        if (MT != 8) { h = u0 & 3; sb = (u0 >> 2) & 3; b = 128 + (u0 >> 4); }
        else if (C.G == 256) { const int r = u0 >> 8, x = u0 & 7, idx = (u0 & 255) >> 3, grp = r * 64 + x * 8 + (idx >> 2); h = grp & 3; b = (grp >> 2) * 4 + (idx & 3); }
        else { h = u0 & 3; b = u0 >> 2; }
        const bool lat = b < 128; const int base = lat ? 0 : T, nb = lat ? 128 : 2, bl = lat ? b : b - 128;
        const int g = bl >> 2, slot = lat ? g : 32;
        const int gend = (4 * (g + 1) < nb ? 4 * (g + 1) : nb);
        const int i0 = base + 128 * bl + NROW * sb, il0 = 128 * bl + NROW * sb;
#pragma unroll
        for (int i = 0; i < MT; ++i) { const int c = tid + 512 * i, row = c >> 5, ch = c & 31;
            *(LAS u32x4*)(Qs + row * QP + 8 * ch) = *(const u32x4*)(Q + (size_t)(i0 + row) * 1024 + h * 256 + 8 * ch); }
        __syncthreads();
#pragma unroll 1
        for (int dir = 0; dir < 2; ++dir) {
            int lane_o = C.lane; asm volatile("" : "+v"(lane_o));
            const int fr = lane_o & 15, fq = lane_o >> 4;
            const float gam = 1.0f - exp2f(C.in[17][(j * 2 + dir) * 4 + h]); const float L = log2f(gam);
            f32x4 acc[MT][4];
#pragma unroll
            for (int mt = 0; mt < MT; ++mt)
#pragma unroll
                for (int nt = 0; nt < 4; ++nt) acc[mt][nt] = (f32x4){0.f, 0.f, 0.f, 0.f};
            const int kb_lo = dir == 0 ? 4 * g : bl, kb_hi = dir == 0 ? bl : gend - 1;
            const bf16_t* sb = Scp + ((size_t)((slot * 4 + h) * 2 + dir) * 512) * 256 + (size_t)(64 * w + 16 * (fr >> 2) + (fr & 3)) * 256 + 8 * fq;
#pragma unroll 1
            for (int kq = 0; kq < 4; ++kq) {
                bf16x8 sf[2][4];
#pragma unroll
                for (int k2 = 0; k2 < 2; ++k2)
#pragma unroll
                    for (int nt = 0; nt < 4; ++nt) sf[k2][nt] = *(const bf16x8*)(sb + (size_t)(4 * nt) * 256 + 32 * (2 * kq + k2));
#pragma unroll
                for (int k2 = 0; k2 < 2; ++k2)
#pragma unroll
                    for (int mt = 0; mt < MT; ++mt) { const bf16x8 qf = *(const LAS bf16x8*)(Qs + (16 * mt + fr) * QP + 32 * (2 * kq + k2) + 8 * fq);
#pragma unroll
                        for (int nt = 0; nt < 4; ++nt) acc[mt][nt] = __builtin_amdgcn_mfma_f32_16x16x32_bf16(sf[k2][nt], qf, acc[mt][nt], 0, 0, 0); }
            }
#pragma unroll
            for (int mt = 0; mt < MT; ++mt) {
                const int il = il0 + 16 * mt + fr;
                const int ex = dir == 0 ? il - 512 * g + 1 : gend * 128 - il;
                const float qd = __builtin_amdgcn_exp2f(L * (float)ex);
#pragma unroll
                for (int nt = 0; nt < 4; ++nt) acc[mt][nt] = acc[mt][nt] * qd;
            }
#pragma unroll 1
            for (int kb = kb_lo; kb <= (PV == 2 ? kb_lo - 1 : kb_hi); ++kb) {
                const int j0 = base + 128 * kb;
                {
                    bf16x8 kf[8];
                    const bf16_t* k1 = Kb + (size_t)(j0 + 16 * w + fr) * 1024 + h * 256 + 8 * fq;
#pragma unroll
                    for (int ks = 0; ks < 8; ++ks) kf[ks] = *(const bf16x8*)(k1 + 32 * ks);
                    f32x4 sc[MT];
#pragma unroll
                    for (int mt = 0; mt < MT; ++mt) sc[mt] = (f32x4){0.f, 0.f, 0.f, 0.f};
#pragma unroll
                    for (int ks = 0; ks < 8; ++ks) {
#pragma unroll
                        for (int mt = 0; mt < MT; ++mt) { const bf16x8 qf = *(const LAS bf16x8*)(Qs + (16 * mt + fr) * QP + 32 * ks + 8 * fq);
                            sc[mt] = __builtin_amdgcn_mfma_f32_16x16x32_bf16(kf[ks], qf, sc[mt], 0, 0, 0); }
                        __builtin_amdgcn_sched_barrier(0);
                    }
#pragma unroll
                    for (int mt = 0; mt < MT; ++mt) {
                        const int il = il0 + 16 * mt + fr;
                        float p[4];
#pragma unroll
                        for (int e = 0; e < 4; ++e) { const int jl = 128 * kb + 16 * w + 4 * fq + e; const int rel = dir == 0 ? il - jl : jl - il;
                            p[e] = rel >= 0 ? sc[mt][e] * __builtin_amdgcn_exp2f(L * (float)rel) : 0.f; }
                        u32x2 wv; wv.x = pk2(p[0], p[1]); wv.y = pk2(p[2], p[3]);
                        *(LAS u32x2*)(P + (16 * mt + fr) * PP + 16 * w + 4 * fq) = wv;
                    }
                }
                __syncthreads();
                const bf16_t* vb = Vt + (size_t)(h * 512 + 64 * w + 16 * (fr >> 2) + (fr & 3)) * R + j0 + 8 * fq;
#pragma unroll 1
                for (int kh2 = 0; kh2 < 2; ++kh2) {
                    bf16x8 vf[2][4];
#pragma unroll
                    for (int k2 = 0; k2 < 2; ++k2)
#pragma unroll
                        for (int nt = 0; nt < 4; ++nt) vf[k2][nt] = *(const bf16x8*)(vb + (size_t)(4 * nt) * R + 32 * (2 * kh2 + k2));
#pragma unroll
                    for (int k2 = 0; k2 < 2; ++k2)
#pragma unroll
                        for (int mt = 0; mt < MT; ++mt) { const bf16x8 pf = *(const LAS bf16x8*)(P + (16 * mt + fr) * PP + 32 * (2 * kh2 + k2) + 8 * fq);
#pragma unroll
                            for (int nt = 0; nt < 4; ++nt) acc[mt][nt] = __builtin_amdgcn_mfma_f32_16x16x32_bf16(vf[k2][nt], pf, acc[mt][nt], 0, 0, 0); }
                }
                __syncthreads();
            }
#pragma unroll
            for (int mt = 0; mt < MT; ++mt) {
                float ss = 0.f;
#pragma unroll
                for (int nt = 0; nt < 4; ++nt) ss += (acc[mt][nt][0] * acc[mt][nt][0] + acc[mt][nt][1] * acc[mt][nt][1]) + (acc[mt][nt][2] * acc[mt][nt][2] + acc[mt][nt][3] * acc[mt][nt][3]);
                ss += __shfl_xor(ss, 16); ss += __shfl_xor(ss, 32);
                if (fq == 0) red[(16 * mt + fr) * 8 + w] = ss;
            }
            __syncthreads();
#pragma unroll
            for (int mt = 0; mt < MT; ++mt) {
                float tot = 0.f;
#pragma unroll
                for (int w2 = 0; w2 < 8; ++w2) tot += red[(16 * mt + fr) * 8 + w2];
                const float rn = 1.0f / sqrtf(tot * (1.f / 512.f) + NORM_EPS);
                const size_t off = (size_t)(i0 + 16 * mt + fr) * 2048 + h * 512 + 64 * w + 16 * fq;
#pragma unroll
                for (int np = 0; np < (PV == 4 ? 0 : 2); ++np) {
                    const u32x4 g4 = *(const u32x4*)((dir == 0 ? (const bf16_t*)GF : GB) + off + 8 * np);
                    float y[8];
                    y[0] = siluf(bflo(g4.x)) * acc[mt][2 * np][0] * rn; y[1] = siluf(bfhi(g4.x)) * acc[mt][2 * np][1] * rn;
                    y[2] = siluf(bflo(g4.y)) * acc[mt][2 * np][2] * rn; y[3] = siluf(bfhi(g4.y)) * acc[mt][2 * np][3] * rn;
                    y[4] = siluf(bflo(g4.z)) * acc[mt][2 * np + 1][0] * rn; y[5] = siluf(bfhi(g4.z)) * acc[mt][2 * np + 1][1] * rn;
                    y[6] = siluf(bflo(g4.w)) * acc[mt][2 * np + 1][2] * rn; y[7] = siluf(bfhi(g4.w)) * acc[mt][2 * np + 1][3] * rn;
                    if (dir == 1) { const u32x4 yp = *(const u32x4*)(GF + off + 8 * np);
                        y[0] += bflo(yp.x); y[1] += bfhi(yp.x); y[2] += bflo(yp.y); y[3] += bfhi(yp.y); y[4] += bflo(yp.z); y[5] += bfhi(yp.z); y[6] += bflo(yp.w); y[7] += bfhi(yp.w); }
                    u32x4 wv; wv.x = pk2(y[0], y[1]); wv.y = pk2(y[2], y[3]); wv.z = pk2(y[4], y[5]); wv.w = pk2(y[6], y[7]);
                    *(u32x4*)(GF + off + 8 * np) = wv;
                }
            }
        }
        __syncthreads();
    }
}

template <int PV = 0>
__device__ __forceinline__ void readout_phase(Ctx& C, int j, bool skip_ctx) {
    readout_units<8, PV>(C, j);
    if (!skip_ctx) { __syncthreads(); readout_units<2, PV>(C, j); }
}

__device__ __forceinline__ void phase_p0(Ctx& C) {
    float* modv = (float*)(C.ws + WS_MODV);
    for (int u = C.bid; u < 384; u += C.G) {
        const int i = u / 96, nbk = u % 96;
        gemv2_unit<1>(C, C.in[4] + (size_t)i * 1024 * 6144, 6144, 64 * nbk, C.in[1], C.in[3], C.in[5] + i * 6144, modv + (i * 2 + 0) * 6144, modv + (i * 2 + 1) * 6144, 0, 0);
    }
    float* tabc = (float*)(C.ws + WS_TABC); float* tabs = (float*)(C.ws + WS_TABS);
    for (int idx = C.bid * 512 + C.tid; idx < 320 * 64; idx += C.G * 512) {
        const int ti = idx >> 6, i = idx & 63; const float pos = (float)(ti < 256 ? ti : ti - 256);
        const float inv = exp2f(-(float)i * (13.287712379549449f / 64.0f)); const float ang = pos * inv;
        tabc[idx] = __cosf(ang); tabs[idx] = __sinf(ang);
    }
}
__device__ __forceinline__ void phase_p1(Ctx& C) {
    const float* modv = (const float*)(C.ws + WS_MODV);
    float* s1 = (float*)(C.ws + WS_S1); float* s2 = (float*)(C.ws + WS_S2);
    for (int idx = C.bid * 512 + C.tid; idx < 8192; idx += C.G * 512) {
        const int i = idx >> 11, s = (idx >> 10) & 1, k = idx & 1023;
        s1[idx] = C.in[6][i * 1024 + k] * (1.f + modv[(i * 2 + s) * 6144 + 1024 + k]);
        s2[idx] = C.in[7][i * 1024 + k] * (1.f + modv[(i * 2 + s) * 6144 + 4096 + k]);
    }
    float* cvA = (float*)(C.ws + WS_CVA); float* cvF = (float*)(C.ws + WS_CVF);
    for (int u = C.bid; u < 672; u += C.G) {
        if (u < 320) {
            int i, nbk; if (u < 32) { i = 0; nbk = u; } else if (u < 160) { i = 1; nbk = u - 32; } else if (u < 192) { i = 2; nbk = u - 160; } else { i = 3; nbk = u - 192; }
            const int j = i >> 1; const float* v0 = modv + (i * 2 + 0) * 6144; const float* v1 = modv + (i * 2 + 1) * 6144;
            if ((i & 1) == 0) gemv2_unit<0>(C, C.in[8] + (size_t)j * 1024 * 2048, 2048, 64 * nbk, v0, v1, C.in[9] + j * 2048, cvA + (i * 2) * 8192, cvA + (i * 2 + 1) * 8192, 1, 1024);
            else gemv2_unit<0>(C, C.in[16] + (size_t)j * 1024 * 8192, 8192, 64 * nbk, v0, v1, nullptr, cvA + (i * 2) * 8192, cvA + (i * 2 + 1) * 8192, 2, 0);
        } else {
            const int i = (u - 320) / 88, nbk = (u - 320) % 88;
            const float* v0 = modv + (i * 2 + 0) * 6144 + 3072; const float* v1 = modv + (i * 2 + 1) * 6144 + 3072;
            gemv2_unit<0>(C, C.in[19] + (size_t)i * 1024 * FF2, FF2, 64 * nbk, v0, v1, nullptr, cvF + (i * 2) * FF2, cvF + (i * 2 + 1) * FF2, 1, DFF);
        }
    }
    bf16_t* xs = (bf16_t*)(C.ws + WS_XS); float* stats = (float*)(C.ws + WS_STATS); float* xctx = (float*)(C.ws + WS_XCTX);
    for (int row = C.bid * 8 + C.wave; row < R; row += C.G * 8) {
        const bool lat = row < T; const int s = lat ? 0 : 1;
        const float* src = lat ? C.in[0] + (size_t)row * 1024 : C.in[2] + (size_t)(row - T) * 1024;
        float ss = 0.f;
#pragma unroll
        for (int jj = 0; jj < 4; ++jj) {
            const int k = 4 * C.lane + 256 * jj;
            const f32x4 v = *(const f32x4*)(src + k);
            ss += (v[0] * v[0] + v[1] * v[1]) + (v[2] * v[2] + v[3] * v[3]);
            const f32x4 g = *(const f32x4*)(C.in[6] + k), m = *(const f32x4*)(modv + s * 6144 + 1024 + k);
            u32x2 w; w.x = pk2(v[0] * g[0] * (1.f + m[0]), v[1] * g[1] * (1.f + m[1])); w.y = pk2(v[2] * g[2] * (1.f + m[2]), v[3] * g[3] * (1.f + m[3]));
            *(u32x2*)(xs + (size_t)row * 1024 + k) = w;
        }
#pragma unroll
        for (int off = 1; off < 64; off <<= 1) ss += __shfl_xor(ss, off);
        if (C.lane < 16) stats[(size_t)row * 16 + C.lane] = C.lane == 0 ? ss : 0.f;
    }
    prep_layer(C, 0, 3, 0);
}
__device__ __forceinline__ void phase_final(Ctx& C) {
    const float* stats = (const float*)(C.ws + WS_STATS);
    for (int row = C.bid * 8 + C.wave; row < T; row += C.G * 8) {
        float s = C.lane < 16 ? stats[(size_t)row * 16 + C.lane] : 0.f;
#pragma unroll
        for (int off = 1; off < 64; off <<= 1) s += __shfl_xor(s, off);
        const float r = 1.0f / sqrtf(s * (1.f / 1024.f) + NORM_EPS);
        float* xr = C.out + (size_t)row * 1024;
#pragma unroll
        for (int jj = 0; jj < 4; ++jj) { const int k = 4 * C.lane + 256 * jj; const f32x4 v = *(const f32x4*)(xr + k), g = *(const f32x4*)(C.in[21] + k); *(f32x4*)(xr + k) = v * r * g; }
    }
}

constexpr int NPHASE = 31;
__device__ __forceinline__ void run_phase(Ctx& C, int ph) {
    const int i = (ph - 2) / 7, sub = (ph - 2) % 7, j = i >> 1; const bool conv = (i & 1) == 0;
    const bool last = i == DEPTH - 1;
    float* stats = (float*)(C.ws + WS_STATS);
    const bf16_t* xs = (const bf16_t*)(C.ws + WS_XS);
    constexpr int F_MODV = (int)(WS_MODV / 4), F_S1 = (int)(WS_S1 / 4), F_S2 = (int)(WS_S2 / 4), F_CVA = (int)(WS_CVA / 4), F_CVF = (int)(WS_CVF / 4);
    if (sub == 1) {
        if (conv) { EpiGLU E{C.ws, F_CVA + (i * 2) * 8192, 8192, (int)WS_U, 1024, 0, stats}; gemm_both(C, xs, (const bf16_t*)(C.ws + WS_WA), T, 2048, 1024, E, 0, 8); }
        else {
            EpiWin E{C.ws, F_CVA + (i * 2) * 8192, stats};
            const bf16_t* WA = (const bf16_t*)(C.ws + WS_WA);
            gemm_both(C, xs, WA, T, 8192, 1024, E, 0, 0, 0, 8);
            { pg8::Gemm g{xs, WA + (size_t)2048 * 1024, T, 2048, 1024}; pg8::StaticOrder S; S.init(T, 2048, C.G, C.bid); EpiVt EV{C.ws, F_CVA + (i * 2) * 8192};
              pg8::gemm_phase<EpiVt, pg8::StaticOrder, true, true, true>(C.lds, g, S, EV); }
            gemm_both(C, xs, WA, T, 8192, 1024, E, last ? 4 : 0, last ? 16 : 32, 16, 32);
        }
    } else if (sub == 5) {
        EpiGLU E{C.ws, F_CVF + (i * 2) * FF2, FF2, (int)WS_H, DFF, 1, stats}; gemm_both(C, xs, (const bf16_t*)(C.ws + WS_WF1), last ? T : R, FF2, 1024, E, 0, 0);
        if (!last) { __syncthreads(); prep_layer(C, i + 1, 1, C.G == 256 ? 128 : 0); }
    } else {
        const bool f2 = sub == 6;
        const int mgoff = F_MODV + (i * 2) * 6144 + (f2 ? 5120 : 2048);
        const int snoff = f2 ? (last ? -1 : F_S1 + ((i + 1) * 2) * 1024) : F_S2 + (i * 2) * 1024;
        const float* bias = (!f2 && conv) ? C.in[15] + j * 1024 : nullptr;
        const bf16_t* A = (const bf16_t*)(C.ws + (f2 ? WS_H : (conv ? WS_A2 : WS_GF)));
        const bf16_t* Bt = (const bf16_t*)(C.ws + (f2 ? WS_WF2 : WS_WA2));
        const int K = f2 ? DFF : (conv ? 1024 : 2048);
        const bool first = (i == 0 && !f2);
        EpiRes E{C.ws, C.out, first ? C.in[0] : (const float*)C.out, first ? C.in[2] : (const float*)(C.ws + WS_XCTX), bias, mgoff, snoff, stats};
        { pg8::Gemm g{A, Bt, T, 1024, K}; pg8::StaticOrder S; S.init(T, 1024, C.G, C.bid); EpiResBig EB{E};
          pg8::gemm_phase<EpiResBig, pg8::StaticOrder, true, true>(C.lds, g, S, EB); }
        if (!last) { __syncthreads(); sgemm_small(C, A, Bt, T, R - T, 1024, K, E, 0, 4); }
    }
}

#define XB_TMO      128
#define XB_XCNT(j)  (256  + 64 * (j))
#define XB_XSUB(j)  (1280 + 64 * (j))
#define XB_XGEN(j)  (2304 + 64 * (j))
#define XB_TOP      3328
#define XB_TOPGEN   3392
#define XCD_BAR_WORDS 3456
#define XB_SPIN_CAP (1u << 20)
__device__ __forceinline__ unsigned xb_ld(unsigned* p)              { return __hip_atomic_load(p, __ATOMIC_RELAXED, __HIP_MEMORY_SCOPE_AGENT); }
__device__ __forceinline__ unsigned xb_add(unsigned* p, unsigned v) { return __hip_atomic_fetch_add(p, v, __ATOMIC_RELAXED, __HIP_MEMORY_SCOPE_AGENT); }
__device__ __forceinline__ unsigned xb_xcc_id() { return (unsigned)__builtin_amdgcn_s_getreg((3 << 11) | 20) & 0xFu; }
#define XB_SPIN(cond, bar) do { unsigned _sp = 0; while (cond) { __builtin_amdgcn_s_sleep(1); \
    if ((++_sp & 255u) == 0u) { if (xb_ld(&(bar)[XB_TMO])) break; if (_sp > XB_SPIN_CAP) { atomicAdd(&(bar)[XB_TMO], 1u); break; } } } } while (0)
struct XcdBarrier { unsigned* bar; unsigned x; volatile LAS unsigned* st; };
__device__ __forceinline__ XcdBarrier xcd_barrier_post(unsigned* bar, volatile LAS unsigned* st) {
    XcdBarrier b; b.bar = bar; b.x = xb_xcc_id(); b.st = st;
    if (threadIdx.x == 0) (void)xb_add(&bar[XB_XCNT(b.x)], 1u);
    return b;
}
__device__ __forceinline__ void xcd_barrier_complete(unsigned* bar, unsigned x, unsigned& nloc, unsigned& nx) {
    const unsigned G = gridDim.x * gridDim.y * gridDim.z;
    unsigned sum, cnt, mine, sp = 0u;
    for (;;) {
        sum = 0u; cnt = 0u; mine = 0u;
#pragma unroll
        for (unsigned j = 0; j < 16; ++j) { const unsigned c = xb_ld(&bar[XB_XCNT(j)]); sum += c; cnt += (c > 0u) ? 1u : 0u; mine = (j == x) ? c : mine; }
        if (sum == G) break;
        __builtin_amdgcn_s_sleep(1);
        if ((++sp & 255u) == 0u) { if (xb_ld(&bar[XB_TMO])) break; if (sp > XB_SPIN_CAP) { atomicAdd(&bar[XB_TMO], 1u); break; } }
    }
    nloc = mine > 0u ? mine : 1u; nx = cnt > 0u ? cnt : 1u;
}
__device__ __forceinline__ void xcd_barrier(const XcdBarrier& b) {
    asm volatile("s_waitcnt vmcnt(0)" ::: "memory");
    __syncthreads();
    if (threadIdx.x == 0) {
        unsigned* bar = b.bar;
        __builtin_amdgcn_s_waitcnt(0);
        unsigned nloc = b.st[0], nx = b.st[1];
        if (nloc == 0u) { xcd_barrier_complete(bar, b.x, nloc, nx); b.st[0] = nloc; b.st[1] = nx; }
        const unsigned old = xb_add(&bar[XB_XSUB(b.x)], 1u);
        const unsigned gen = old / nloc;
        if (old + 1u == (gen + 1u) * nloc) {
            __builtin_amdgcn_fence(__ATOMIC_RELEASE, "agent");
            asm volatile("s_waitcnt vmcnt(0)" ::: "memory");
            const unsigned og = xb_add(&bar[XB_TOP], 1u);
            const unsigned tg = og / nx;
            if (og + 1u == (tg + 1u) * nx) xb_add(&bar[XB_TOPGEN], 1u);
            else XB_SPIN(xb_ld(&bar[XB_TOPGEN]) == tg, bar);
            __builtin_amdgcn_fence(__ATOMIC_ACQUIRE, "agent");
            xb_add(&bar[XB_XGEN(b.x)], 1u);
            asm volatile("s_waitcnt vmcnt(0)" ::: "memory");
        } else {
            XB_SPIN(xb_ld(&bar[XB_XGEN(b.x)]) == gen, bar);
            __builtin_amdgcn_fence(__ATOMIC_ACQUIRE, "agent");
            asm volatile("s_waitcnt vmcnt(0)" ::: "memory");
        }
    }
    __syncthreads();
}
constexpr int MISC_OFF = 131072 + 320;
constexpr int CW_BAR = 4096;

#ifndef PROBE_DUP
#define PROBE_DUP 0
#endif
#if ONE_LAUNCH
template <int PH> __device__ __forceinline__ void phase_body(Ctx& C) {
    constexpr int i = (PH - 2) / 7, sub = (PH - 2) % 7, j = i >> 1; constexpr bool conv = (i & 1) == 0;
    if (PH == 0) phase_p0(C);
    else if (PH == 1) phase_p1(C);
    else if (PH == 30) phase_final(C);
    else if (sub == 0) { }
    else if (sub == 2) { if (i > 0) { prep_layer(C, i, 2, 0); __syncthreads(); } if (conv) dwconv_phase(C, j); else scan_phase(C, j); }
    else if (sub == 3) readout_phase(C, j, i == DEPTH - 1);
    else run_phase(C, PH);
}
template <int PH> __device__ __forceinline__ void one_phase(Ctx& C, const Args& args, const XcdBarrier& bar) {
    if (PH < args.ph_lo || PH >= args.ph_hi) return;
    constexpr int i = (PH - 2) / 7, sub = (PH - 2) % 7; constexpr bool conv = (i & 1) == 0;
    if (PH >= 2 && PH < 30) { if (sub == 0) return; if (sub == 3 && conv) return; }
    if (PH > args.ph_lo) xcd_barrier(bar);
    phase_body<PH>(C);
    constexpr bool dup = ((PH >= 2 && PH < 30) && (((PROBE_DUP & 1) && (sub == 1 || sub == 5)) || ((PROBE_DUP & 2) && sub == 2 && !conv) || ((PROBE_DUP & 4) && sub == 2 && conv) || ((PROBE_DUP & 8) && sub == 0))) || ((PROBE_DUP & 16) && PH < 2);
    if constexpr (dup) { xcd_barrier(bar); phase_body<PH>(C); }
}
template <int... PHS> __device__ __forceinline__ void all_phases(Ctx& C, const Args& args, const XcdBarrier& bar, std::integer_sequence<int, PHS...>) { (one_phase<PHS>(C, args, bar), ...); }
__global__ void __launch_bounds__(512, 2) mega_kernel(Args args) {
    extern __shared__ __attribute__((aligned(16))) unsigned char lds_raw[];
    Ctx C;
    C.lds = (LAS unsigned char*)lds_raw; C.tid = threadIdx.x; C.lane = C.tid & 63; C.wave = __builtin_amdgcn_readfirstlane(C.tid >> 6); C.G = gridDim.x; C.bid = blockIdx.x;
    C.in = args.in; C.out = args.out; C.ws = args.ws;
    volatile LAS unsigned* MISC = (volatile LAS unsigned*)(C.lds + MISC_OFF);
    if (C.tid < 32) MISC[C.tid] = 0u;
    __syncthreads();
    XcdBarrier bar = xcd_barrier_post((unsigned*)(C.ws + WS_CTL) + CW_BAR, MISC + 8);
    all_phases(C, args, bar, std::make_integer_sequence<int, NPHASE>{});
}

#endif
template <int KIND>
__global__ void __launch_bounds__(512, 2) phase_kernel(Args args) {
    extern __shared__ __attribute__((aligned(16))) unsigned char lds_raw[];
    Ctx C;
    C.lds = (LAS unsigned char*)lds_raw; C.tid = threadIdx.x; C.lane = C.tid & 63; C.wave = __builtin_amdgcn_readfirstlane(C.tid >> 6); C.G = gridDim.x; C.bid = blockIdx.x;
    C.in = args.in; C.out = args.out; C.ws = args.ws;
    const int ph = args.ph_lo;
    if (KIND == 0) phase_p0(C);
    else if (KIND == 1) phase_p1(C);
    else if (KIND == 30) phase_final(C);
    else {
        const int i = (ph - 2) / 7, j = i >> 1; const bool conv = (i & 1) == 0;
        if (KIND == 2) { }
        else if (KIND == 4) { if (i > 0) { prep_layer(C, i, 2, 0); __syncthreads(); } if (conv) dwconv_phase(C, j); else scan_phase(C, j); }
        else if (KIND == 5) readout_phase(C, j, i == DEPTH - 1);
        else run_phase(C, ph);
    }
}

#ifndef PROBE_RD
#define PROBE_RD 0
#endif
#if PROBE_RD
__global__ void __launch_bounds__(512, 2) probe_read_kernel(Args args) {
    extern __shared__ __attribute__((aligned(16))) unsigned char lds_raw[];
    Ctx C;
    C.lds = (LAS unsigned char*)lds_raw; C.tid = threadIdx.x; C.lane = C.tid & 63; C.wave = __builtin_amdgcn_readfirstlane(C.tid >> 6); C.G = gridDim.x; C.bid = blockIdx.x;
    C.in = args.in; C.out = args.out; C.ws = args.ws;
    readout_phase<PROBE_RD>(C, 1, true);
}
#endif
extern "C" void kernel_launch(void* const* d_in, const int* in_sizes, int n_in, void* d_out, int out_size, void* d_ws, size_t ws_size, hipStream_t stream) {
    static int grid = 0;
    if (grid == 0) {
        if (n_in != 22 || out_size != T * D || ws_size < WS_END + (PROBE_RD ? 20 * MiB : 0)) { fprintf(stderr, "kernel_launch: unexpected problem (n_in %d out %d ws %zu, need %zu)\n", n_in, out_size, ws_size, (size_t)WS_END); grid = -1; return; }
        int dev = 0, cus = 0;
        if (hipGetDevice(&dev) != hipSuccess || hipDeviceGetAttribute(&cus, hipDeviceAttributeMultiprocessorCount, dev) != hipSuccess) { grid = -1; return; }
        bool ok = true;
        ok &= hipFuncSetAttribute((const void*)phase_kernel<0>, hipFuncAttributeMaxDynamicSharedMemorySize, LDS_BYTES) == hipSuccess;
        ok &= hipFuncSetAttribute((const void*)phase_kernel<1>, hipFuncAttributeMaxDynamicSharedMemorySize, LDS_BYTES) == hipSuccess;
        ok &= hipFuncSetAttribute((const void*)phase_kernel<2>, hipFuncAttributeMaxDynamicSharedMemorySize, LDS_BYTES) == hipSuccess;
        ok &= hipFuncSetAttribute((const void*)phase_kernel<3>, hipFuncAttributeMaxDynamicSharedMemorySize, LDS_BYTES) == hipSuccess;
        ok &= hipFuncSetAttribute((const void*)phase_kernel<4>, hipFuncAttributeMaxDynamicSharedMemorySize, LDS_BYTES) == hipSuccess;
        ok &= hipFuncSetAttribute((const void*)phase_kernel<5>, hipFuncAttributeMaxDynamicSharedMemorySize, LDS_BYTES) == hipSuccess;
        ok &= hipFuncSetAttribute((const void*)phase_kernel<30>, hipFuncAttributeMaxDynamicSharedMemorySize, LDS_BYTES) == hipSuccess;
#if ONE_LAUNCH
        ok &= hipFuncSetAttribute((const void*)mega_kernel, hipFuncAttributeMaxDynamicSharedMemorySize, LDS_BYTES) == hipSuccess;
#endif
        if (!ok) { fprintf(stderr, "kernel_launch: hipFuncSetAttribute failed\n"); grid = -1; return; }
        grid = cus > 0 ? cus : 256;
    }
    if (grid < 0) return;
    Args a{};
    for (int i = 0; i < 22; ++i) a.in[i] = (const float*)d_in[i];
    a.out = (float*)d_out; a.ws = (unsigned char*)d_ws;
#if ONE_LAUNCH
    if (hipMemsetAsync((char*)d_ws + WS_CTL, 0, 65536, stream) != hipSuccess) { fprintf(stderr, "kernel_launch: memset failed\n"); return; }
    a.ph_lo = 0; a.ph_hi = NPHASE;
    hipLaunchKernelGGL(mega_kernel, dim3(grid), dim3(512), LDS_BYTES, stream, a);
    return;
#endif
    for (int ph = 0; ph < NPHASE; ++ph) {
        const int i = (ph - 2) / 7, sub = (ph - 2) % 7;
        if (ph >= 2 && ph < 30) { if (sub == 0) continue; if (sub == 3 && (i & 1) == 0) continue; }
        a.ph_lo = ph; a.ph_hi = ph + 1;
        const dim3 g(grid), b(512);
        if (ph == 0) hipLaunchKernelGGL(phase_kernel<0>, g, b, LDS_BYTES, stream, a);
        else if (ph == 1) hipLaunchKernelGGL(phase_kernel<1>, g, b, LDS_BYTES, stream, a);
        else if (ph == 30) hipLaunchKernelGGL(phase_kernel<30>, g, b, LDS_BYTES, stream, a);
        else if (sub == 0) hipLaunchKernelGGL(phase_kernel<2>, g, b, LDS_BYTES, stream, a);
        else if (sub == 2) hipLaunchKernelGGL(phase_kernel<4>, g, b, LDS_BYTES, stream, a);
        else if (sub == 3) hipLaunchKernelGGL(phase_kernel<5>, g, b, LDS_BYTES, stream, a);
        else hipLaunchKernelGGL(phase_kernel<3>, g, b, LDS_BYTES, stream, a);
#ifdef PROBE_G
        if (ph == 30) { Args a2 = a; a2.ph_lo = PROBE_G; a2.ph_hi = PROBE_G + 1; hipLaunchKernelGGL(phase_kernel<3>, g, b, LDS_BYTES, stream, a2); }
#endif
#if PROBE_RD
        if (ph == 30) { hipFuncSetAttribute((const void*)probe_read_kernel, hipFuncAttributeMaxDynamicSharedMemorySize, LDS_BYTES); hipLaunchKernelGGL(probe_read_kernel, g, b, LDS_BYTES, stream, a); }
#endif
        {   const bool conv = (i & 1) == 0;
            const bool dup = ((ph >= 2 && ph < 30) && (((PROBE_DUP & 1) && (sub == 1 || sub == 5)) || ((PROBE_DUP & 2) && sub == 2 && !conv) || ((PROBE_DUP & 4) && sub == 2 && conv) || ((PROBE_DUP & 8) && sub == 0))) || ((PROBE_DUP & 16) && ph < 2);
            if (dup) {
                if (ph == 0) hipLaunchKernelGGL(phase_kernel<0>, g, b, LDS_BYTES, stream, a);
                else if (ph == 1) hipLaunchKernelGGL(phase_kernel<1>, g, b, LDS_BYTES, stream, a);
                else if (sub == 0) hipLaunchKernelGGL(phase_kernel<2>, g, b, LDS_BYTES, stream, a);
                else if (sub == 2) hipLaunchKernelGGL(phase_kernel<4>, g, b, LDS_BYTES, stream, a);
                else hipLaunchKernelGGL(phase_kernel<3>, g, b, LDS_BYTES, stream, a);
            } }
    }
}
```

```cpp
#include <hip/hip_runtime.h>
#include <cstdio>
#include <cstdint>
#include <utility>

#ifndef ONE_LAUNCH
#define ONE_LAUNCH 1
#endif

typedef unsigned short bf16_t;
typedef short bf16x8 __attribute__((ext_vector_type(8)));
typedef float f32x4 __attribute__((ext_vector_type(4)));
typedef float f32x2 __attribute__((ext_vector_type(2)));
typedef unsigned u32x2 __attribute__((ext_vector_type(2)));
typedef unsigned u32x4 __attribute__((ext_vector_type(4)));
typedef __bf16 bf16x2_t __attribute__((ext_vector_type(2)));
typedef short s16x4 __attribute__((ext_vector_type(4)));
#define LAS __attribute__((address_space(3)))

constexpr int D = 1024, T = 16384, TC = 256, R = T + TC, NH = 4, DK = 256, DV = 512, QKW = 1024, VW = 2048, INW = 8192, DFF = 2816, FF2 = 5632, CK = 31, DEPTH = 4;
constexpr int NSLOT = 33;
constexpr float NORM_EPS = 1e-6f, LN_EPS = 1e-5f;

constexpr size_t MiB = 1u << 20, KiB = 1u << 10;
constexpr size_t WS_CTL = 0, CTL_ZERO_BYTES = 1 * MiB;
constexpr size_t WS_MODV = 1 * MiB;
constexpr size_t WS_S1 = 1 * MiB + 256 * KiB;
constexpr size_t WS_S2 = 1 * MiB + 320 * KiB;
constexpr size_t WS_CVA = 1 * MiB + 384 * KiB;
constexpr size_t WS_CVF = 1 * MiB + 640 * KiB;
constexpr size_t WS_TABC = 1 * MiB + 832 * KiB;
constexpr size_t WS_TABS = 1 * MiB + 912 * KiB;
constexpr size_t WS_STATS = 2 * MiB;
constexpr size_t WS_XCTX = 4 * MiB;
constexpr size_t WS_WA = 8 * MiB;
constexpr size_t WS_WA2 = 24 * MiB;
constexpr size_t WS_WF1 = 28 * MiB;
constexpr size_t WS_WF2 = 40 * MiB;
constexpr size_t WS_XS = 48 * MiB;
constexpr size_t WS_SCP = 48 * MiB;
constexpr size_t WS_BIG = 114 * MiB;
constexpr size_t WS_Q = WS_BIG, WS_K = WS_BIG + 33 * MiB, WS_VT = WS_BIG + 66 * MiB, WS_GF = WS_BIG + 131 * MiB, WS_GB = WS_BIG + 196 * MiB;
constexpr size_t WS_U = WS_BIG, WS_A2 = WS_BIG + 33 * MiB, WS_H = WS_BIG;
constexpr size_t WS_END = WS_BIG + 261 * MiB;
static_assert((size_t)R * 1024 * 2 <= 33 * MiB && (size_t)R * 2048 * 2 <= 65 * MiB && (size_t)R * DFF * 2 <= 131 * MiB, "map");
static_assert((size_t)NSLOT * 8 * 512 * 256 * 2 <= 66 * MiB, "scp");

constexpr int LDS_BYTES = 147456;

__device__ __forceinline__ unsigned pk2(float lo, float hi) { f32x2 v = {lo, hi}; bf16x2_t b = __builtin_convertvector(v, bf16x2_t); return __builtin_bit_cast(unsigned, b); }
__device__ __forceinline__ float bflo(unsigned u) { return __uint_as_float(u << 16); }
__device__ __forceinline__ float bfhi(unsigned u) { return __uint_as_float(u & 0xffff0000u); }
__device__ __forceinline__ float sigmf(float x) { return __builtin_amdgcn_rcpf(1.f + __builtin_amdgcn_exp2f(-1.4426950408889634f * x)); }
__device__ __forceinline__ float siluf(float x) { return x * sigmf(x); }
__device__ __forceinline__ float wave_sum63(float v) {
    v += __builtin_bit_cast(float, __builtin_amdgcn_update_dpp(0, __builtin_bit_cast(int, v), 0xB1, 0xF, 0xF, false));
    v += __builtin_bit_cast(float, __builtin_amdgcn_update_dpp(0, __builtin_bit_cast(int, v), 0x4E, 0xF, 0xF, false));
    v += __builtin_bit_cast(float, __builtin_amdgcn_update_dpp(0, __builtin_bit_cast(int, v), 0x141, 0xF, 0xF, false));
    v += __builtin_bit_cast(float, __builtin_amdgcn_update_dpp(0, __builtin_bit_cast(int, v), 0x140, 0xF, 0xF, false));
    v += __builtin_bit_cast(float, __builtin_amdgcn_update_dpp(0, __builtin_bit_cast(int, v), 0x142, 0xA, 0xF, false));
    v += __builtin_bit_cast(float, __builtin_amdgcn_update_dpp(0, __builtin_bit_cast(int, v), 0x143, 0xC, 0xF, false));
    return v;
}
__device__ __forceinline__ int perm_glu(int n, int H) { if (n < H) return 32 * (n >> 4) + (n & 15); const int n2 = n - H; return 32 * (n2 >> 4) + 16 + (n2 & 15); }
__device__ __forceinline__ int perm_win(int n) {
    if (n >= 2 * QKW) return n;
    const int part = n >> 10, hn = n & 1023, h = hn >> 8, d = hn & 255, quarter = d >> 6, idx = d & 63;
    const int Gp = (quarter >> 1) * 4 + (idx >> 4), i = (quarter & 1) * 16 + (idx & 15);
    return part * 1024 + h * 256 + 32 * Gp + i;
}
__device__ __forceinline__ int perm_any(int mode, int n, int H) { return mode == 0 ? n : (mode == 1 ? perm_glu(n, H) : perm_win(n)); }

struct Args { const float* in[22]; float* out; unsigned char* ws; int ph_lo, ph_hi; };

struct Ctx {
    LAS unsigned char* lds;
    int tid, lane, wave, G, bid;
    const float* const* in; float* out; unsigned char* ws;
};

template <int VSILU>
__device__ __forceinline__ void gemv2_unit(Ctx& C, const float* W, int N, int n0, const float* v0, const float* v1, const float* bias, float* o0, float* o1, int pmode, int H) {
    LAS float* red = (LAS float*)C.lds;
    const int c4 = C.tid & 15, ks = C.tid >> 4;
    f32x4 a0 = {0.f, 0.f, 0.f, 0.f}, a1 = {0.f, 0.f, 0.f, 0.f};
#pragma unroll 8
    for (int i = 0; i < 32; ++i) {
        const int k = ks * 32 + i;
        const f32x4 w = *(const f32x4*)(W + (size_t)k * N + n0 + 4 * c4);
        float x0 = v0[k], x1 = v1[k];
        if (VSILU) { x0 = siluf(x0); x1 = siluf(x1); }
        a0 += w * x0; a1 += w * x1;
    }
#pragma unroll
    for (int e = 0; e < 4; ++e) { red[(ks * 2 + 0) * 64 + 4 * c4 + e] = a0[e]; red[(ks * 2 + 1) * 64 + 4 * c4 + e] = a1[e]; }
    __syncthreads();
    if (C.tid < 128) {
        const int s = C.tid >> 6, col = C.tid & 63; float sum = 0.f;
#pragma unroll 8
        for (int k2 = 0; k2 < 32; ++k2) sum += red[(k2 * 2 + s) * 64 + col];
        const int n = n0 + col; if (bias) sum += bias[n];
        (s ? o1 : o0)[perm_any(pmode, n, H)] = sum;
    }
    __syncthreads();
}

struct PrepItem { const float* W; bf16_t* WT; int K, N, pmode, H, k0, n0; };
__device__ __forceinline__ bool prep_decode(Ctx& C, int i, int part, int it, PrepItem& P) {
    const int j = i >> 1; const bool conv = (i & 1) == 0;
    const int I_A = (part & 1) ? (conv ? 16 * 64 : 16 * 256) : 0, I_A2 = (part & 1) ? (conv ? 16 * 32 : 32 * 32) : 0, I_F1 = (part & 2) ? 16 * 176 : 0, I_F2 = (part & 2) ? 44 * 32 : 0;
    if (it >= I_A + I_A2 + I_F1 + I_F2) return false;
    int r = it;
    if (r < I_A) { if (conv) { P.W = C.in[8] + (size_t)j * 1024 * 2048; P.K = 1024; P.N = 2048; P.pmode = 1; P.H = 1024; } else { P.W = C.in[16] + (size_t)j * 1024 * 8192; P.K = 1024; P.N = 8192; P.pmode = 2; P.H = 0; }
                   P.WT = (bf16_t*)(C.ws + WS_WA); }
    else if ((r -= I_A) < I_A2) { if (conv) { P.W = C.in[14] + (size_t)j * 1024 * 1024; P.K = 1024; } else { P.W = C.in[18] + (size_t)j * 2048 * 1024; P.K = 2048; }
                   P.N = 1024; P.pmode = 0; P.H = 0; P.WT = (bf16_t*)(C.ws + WS_WA2); }
    else if ((r -= I_A2) < I_F1) { P.W = C.in[19] + (size_t)i * 1024 * FF2; P.K = 1024; P.N = FF2; P.pmode = 1; P.H = DFF; P.WT = (bf16_t*)(C.ws + WS_WF1); }
    else { r -= I_F1; P.W = C.in[20] + (size_t)i * DFF * 1024; P.K = DFF; P.N = 1024; P.pmode = 0; P.H = 0; P.WT = (bf16_t*)(C.ws + WS_WF2); }
    const int nblk = P.N / 32; P.k0 = 64 * (r / nblk); P.n0 = 32 * (r % nblk);
    return true;
}
__device__ __forceinline__ void prep_layer(Ctx& C, int i, int part, int cu_lo) {
    if (C.bid < cu_lo) return;
    LAS float* scr = (LAS float*)(C.lds + C.wave * 16384);
    const int gw = (C.bid - cu_lo) * 8 + C.wave, NGW = (C.G - cu_lo) * 8, lane = C.lane;
    PrepItem P, Pn; f32x4 v[8], vn[8];
    bool have = prep_decode(C, i, part, gw, P);
    if (have) {
#pragma unroll
        for (int q = 0; q < 8; ++q) v[q] = *(const f32x4*)(P.W + (size_t)(P.k0 + 8 * q + (lane >> 3)) * P.N + P.n0 + 4 * (lane & 7));
    }
    for (int it = gw; have; it += NGW) {
        const bool havn = prep_decode(C, i, part, it + NGW, Pn);
        if (havn) {
#pragma unroll
            for (int q = 0; q < 8; ++q) vn[q] = *(const f32x4*)(Pn.W + (size_t)(Pn.k0 + 8 * q + (lane >> 3)) * Pn.N + Pn.n0 + 4 * (lane & 7));
        }
#pragma unroll
        for (int q = 0; q < 8; ++q) { LAS float* d = scr + (8 * q + (lane >> 3)) * 33 + 4 * (lane & 7); d[0] = v[q][0]; d[1] = v[q][1]; d[2] = v[q][2]; d[3] = v[q][3]; }
        asm volatile("s_waitcnt lgkmcnt(0)" ::: "memory");
        const int c = lane & 7;
#pragma unroll
        for (int jj = 0; jj < 4; ++jj) { const int n = (lane >> 3) + 8 * jj; const LAS float* sp = scr + (8 * c) * 33 + n;
            u32x4 o; o.x = pk2(sp[0 * 33], sp[1 * 33]); o.y = pk2(sp[2 * 33], sp[3 * 33]); o.z = pk2(sp[4 * 33], sp[5 * 33]); o.w = pk2(sp[6 * 33], sp[7 * 33]);
            *(u32x4*)(P.WT + (size_t)perm_any(P.pmode, P.n0 + n, P.H) * P.K + P.k0 + 8 * c) = o; }
        asm volatile("s_waitcnt lgkmcnt(0)" ::: "memory");
        P = Pn; have = havn;
#pragma unroll
        for (int q = 0; q < 8; ++q) v[q] = vn[q];
    }
}

__device__ __forceinline__ float row_rs(const float* stats, int row, int fq) {
    const f32x4 p = *(const f32x4*)(stats + (size_t)row * 16 + 4 * fq);
    float s = (p[0] + p[1]) + (p[2] + p[3]);
    s += __shfl_xor(s, 16); s += __shfl_xor(s, 32);
    return 1.0f / sqrtf(s * (1.0f / 1024.0f) + NORM_EPS);
}
struct EpiGLU {
    static constexpr bool STATS = false, NEEDRS = true;
    unsigned char* ws; int cvoff  , cvstride  , outoff  , ldo, act;
    float* stats;
    __device__ __forceinline__ float row_begin(int row, int fq) const { return row_rs((const float*)(ws + WS_STATS), row, fq); }
    __device__ __forceinline__ float item(int row, int colp, f32x4 v0, f32x4 v1, float rs) const {
        const float* cv = (const float*)ws + cvoff + (row < T ? 0 : cvstride);
        const f32x4 ca = *(const f32x4*)(cv + colp), cg = *(const f32x4*)(cv + colp + 16);
        float o[4];
#pragma unroll
        for (int e = 0; e < 4; ++e) { const float a = rs * v0[e] + ca[e], g = rs * v1[e] + cg[e]; o[e] = act == 0 ? a * sigmf(g) : siluf(a) * g; }
        const int oc = (colp >> 5) * 16 + (colp & 15);
        u32x2 w; w.x = pk2(o[0], o[1]); w.y = pk2(o[2], o[3]);
        *(u32x2*)((bf16_t*)(ws + outoff) + (size_t)row * ldo + oc) = w;
        return 0.f;
    }
};
struct EpiRes {
    static constexpr bool STATS = true, NEEDRS = false;
    unsigned char* ws; float* xl; const float* xin  ; const float* cin  ; const float* bias;
    int mgoff  , snoff  ;
    float* stats;
    __device__ __forceinline__ float row_begin(int, int) const { return 1.f; }
    __device__ __forceinline__ float item(int row, int colp, f32x4 v0, f32x4 v1, float) const {
        const bool lat = row < T;
        float* xr = lat ? xl + (size_t)row * 1024 : (float*)(ws + WS_XCTX) + (size_t)(row - T) * 1024;
        const float* xi = lat ? xin + (size_t)row * 1024 : cin + (size_t)(row - T) * 1024;
        const float* mg = (const float*)ws + mgoff + (lat ? 0 : 6144); const float* sn = (const float*)ws + snoff + (lat ? 0 : 1024);
        bf16_t* xs = (bf16_t*)(ws + WS_XS);
        float ss = 0.f;
#pragma unroll
        for (int hlf = 0; hlf < 2; ++hlf) {
            const int c = colp + 16 * hlf; const f32x4 v = hlf ? v1 : v0;
            const f32x4 xo = *(const f32x4*)(xi + c), m4 = *(const f32x4*)(mg + c);
            f32x4 b4 = {0.f, 0.f, 0.f, 0.f}; if (bias) b4 = *(const f32x4*)(bias + c);
            const f32x4 xn = xo + m4 * (v + b4);
            *(f32x4*)(xr + c) = xn;
            ss += (xn[0] * xn[0] + xn[1] * xn[1]) + (xn[2] * xn[2] + xn[3] * xn[3]);
            if (snoff >= 0) { const f32x4 s4 = *(const f32x4*)(sn + c); u32x2 w; w.x = pk2(xn[0] * s4[0], xn[1] * s4[1]); w.y = pk2(xn[2] * s4[2], xn[3] * s4[3]);
                *(u32x2*)(xs + (size_t)row * 1024 + c) = w; }
        }
        return ss;
    }
};
struct EpiWin {
    static constexpr bool STATS = false, NEEDRS = true;
    unsigned char* ws; int cvoff;
    float* stats;
    __device__ __forceinline__ float row_begin(int row, int fq) const { return row_rs((const float*)(ws + WS_STATS), row, fq); }
    __device__ __forceinline__ float item(int row, int colp, f32x4 v0, f32x4 v1, float rs) const {
        const float* cv = (const float*)ws + cvoff + (row < T ? 0 : 8192);
        const f32x4 c0 = *(const f32x4*)(cv + colp), c1 = *(const f32x4*)(cv + colp + 16);
        f32x4 a = v0 * rs + c0, b = v1 * rs + c1;
        if (colp < 2048) {
            if (row < T) {
                const int Gp = (colp >> 5) & 7, idx0 = 16 * (Gp & 3) + (colp & 15);
                const int ti = (Gp >> 2) ? 256 + (row & 63) : (row >> 6);
                const f32x4 cs = *(const f32x4*)((const float*)(ws + WS_TABC) + ti * 64 + idx0), sn = *(const f32x4*)((const float*)(ws + WS_TABS) + ti * 64 + idx0);
                const f32x4 o1 = a * cs - b * sn, o2 = b * cs + a * sn; a = o1; b = o2;
            }
            bf16_t* dst = (bf16_t*)(ws + WS_Q);
            if (colp >= 1024) { dst = (bf16_t*)(ws + WS_K); a = a * 0.0625f; b = b * 0.0625f; }
            const int c = colp & 1023;
            u32x2 w; w.x = pk2(a[0], a[1]); w.y = pk2(a[2], a[3]); *(u32x2*)(dst + (size_t)row * 1024 + c) = w;
            w.x = pk2(b[0], b[1]); w.y = pk2(b[2], b[3]); *(u32x2*)(dst + (size_t)row * 1024 + c + 16) = w;
        } else if (colp < 4096) {
            const int c = colp - 2048;
            bf16_t* vt = (bf16_t*)(ws + WS_VT);
#pragma unroll
            for (int e = 0; e < 4; ++e) { vt[(size_t)(c + e) * R + row] = (bf16_t)(pk2(a[e], 0.f) & 0xffffu); vt[(size_t)(c + 16 + e) * R + row] = (bf16_t)(pk2(b[e], 0.f) & 0xffffu); }
        } else {
            bf16_t* dst = (bf16_t*)(ws + (colp < 6144 ? WS_GF : WS_GB)); const int c = (colp - 4096) & 2047;
            u32x2 w; w.x = pk2(a[0], a[1]); w.y = pk2(a[2], a[3]); *(u32x2*)(dst + (size_t)row * 2048 + c) = w;
            w.x = pk2(b[0], b[1]); w.y = pk2(b[2], b[3]); *(u32x2*)(dst + (size_t)row * 2048 + c + 16) = w;
        }
        return 0.f;
    }
};

namespace pg8 {
#define PG8_LAS __attribute__((address_space(3)))
typedef unsigned short bf16_t;
typedef short bf16x8 __attribute__((ext_vector_type(8)));
typedef float f32x4 __attribute__((ext_vector_type(4)));
typedef unsigned u32x4 __attribute__((ext_vector_type(4)));
constexpr int BM = 256, BK = 64, HALF = 128, HTB = HALF * BK * 2  , STAGE_BYTES = 8 * HTB, NXCD = 8, WGM = 8;

__host__ __device__ __forceinline__ int lds_byte(int r, int c) { const int st = (r >> 4) * 2 + (c >> 5), rr = r & 15, cc = c & 31, ob = rr * 64 + cc * 2; return st * 1024 + (ob ^ (((ob >> 9) & 1) << 5)); }
__host__ __device__ __forceinline__ void stage_rc(int b, int& R, int& C) { const int st = b / 1024, sb = b % 1024, swz = sb ^ (((sb >> 9) & 1) << 5); R = (st >> 1) * 16 + swz / 64; C = (st & 1) * 32 + (swz % 64) / 2; }
__host__ __device__ __forceinline__ int perm32(int rho) { const int n = rho >> 4, i = rho & 15; return 8 * (i >> 2) + 4 * n + (i & 3); }

struct Unit { int pm, pn; };
struct Gemm { const bf16_t* A; const bf16_t* Bt; int M, N, K; };

struct StaticOrder {
    int nM, nN, nwg, G, c;
    __host__ __device__ void init(int M, int N, int G_, int c_) { nM = M / BM; nN = N / BM; nwg = nM * nN; G = G_; c = c_; }
    __host__ __device__ bool next(int i, Unit& u) const {
        const long L = (long)i * G + c; if (L >= nwg) return false;
        int wgid = (int)L; { const int q = nwg / NXCD, r = nwg % NXCD, xcd = wgid % NXCD, off = wgid / NXCD; wgid = (xcd < r ? xcd * (q + 1) : r * (q + 1) + (xcd - r) * q) + off; }
        const int nig = WGM * nN, gid = wgid / nig, fm = gid * WGM, gsz = (nM - fm) < WGM ? (nM - fm) : WGM;
        u.pm = fm + ((wgid % nig) % gsz); u.pn = (wgid % nig) / gsz; return true;
    }
    __device__ __forceinline__ void a_ready(const Unit&) const {}
    __device__ __forceinline__ void done(const Unit&) const {}
};

template <class Epi, class Sched, bool ALIGN_EPI = false, bool SP2 = false, bool SWAPMMA = false>
__device__ __forceinline__ void gemm_phase(PG8_LAS unsigned char* lds, const Gemm g, const Sched& S, const Epi& E) {
    const int tid = threadIdx.x, wid = __builtin_amdgcn_readfirstlane(tid >> 6), lane = tid & 63, wr = wid >> 2, wc = wid & 3, fr = lane & 15, fq = lane >> 4;
    const int K = g.K, nt = K / BK;
    unsigned voffA[2], voffB[2];
#pragma unroll
    for (int i = 0; i < 2; ++i) { int R, C; stage_rc(tid * 16 + i * 8192, R, C); const int Rb = Epi::PERM ? ((R & ~31) + perm32(R & 31)) : R;
        voffA[i] = (unsigned)(R * K + C) * 2u; voffB[i] = (unsigned)(Rb * K + C) * 2u; }
    const size_t kstep = (size_t)(BK * 2);
    const size_t hstep = (size_t)HALF * K * 2;
    const size_t tstep = 2 * hstep;
    const unsigned ldsw = (unsigned)wid * 1024u;
    const int aoff = lds_byte(wr * 64 + fr, fq * 8), boff = lds_byte(wc * 32 + fr, fq * 8);
#define PG8_SA(b, h) (((b) * 2 + (h)) * HTB)
#define PG8_SB(b, h) ((4 + (b) * 2 + (h)) * HTB)
#define PG8_STAGE(bufoff, gbase, voff) do { _Pragma("unroll") for (int _i = 0; _i < 2; ++_i) \
        __builtin_amdgcn_global_load_lds((const unsigned*)((const char*)(gbase) + (voff)[_i]), (PG8_LAS unsigned*)(lds + (bufoff) + ldsw + _i * 8192), 16, 0, 0); } while (0)
#define PG8_LDA(dst, b, h) do { _Pragma("unroll") for (int m = 0; m < 4; ++m) _Pragma("unroll") for (int k = 0; k < 2; ++k) dst[m][k] = *(const PG8_LAS bf16x8*)(lds + PG8_SA(b, h) + aoff + m * 2048 + k * 1024); } while (0)
#define PG8_LDB(dst, b, h) do { _Pragma("unroll") for (int n = 0; n < 2; ++n) _Pragma("unroll") for (int k = 0; k < 2; ++k) dst[n][k] = *(const PG8_LAS bf16x8*)(lds + PG8_SB(b, h) + boff + n * 2048 + k * 1024); } while (0)
#define PG8_MMA(ai, bj, At, Bt) do { __builtin_amdgcn_s_setprio(1); _Pragma("unroll") for (int m = 0; m < 4; ++m) _Pragma("unroll") for (int n = 0; n < 2; ++n) _Pragma("unroll") for (int k = 0; k < 2; ++k) \
        acc[ai][bj][m][n] = SWAPMMA ? __builtin_amdgcn_mfma_f32_16x16x32_bf16(At[m][k], Bt[n][k], acc[ai][bj][m][n], 0, 0, 0) : __builtin_amdgcn_mfma_f32_16x16x32_bf16(Bt[n][k], At[m][k], acc[ai][bj][m][n], 0, 0, 0); __builtin_amdgcn_s_setprio(0); } while (0)
#define PG8_WAIT_V(n) asm volatile("s_waitcnt vmcnt(" #n ")" ::: "memory")
#define PG8_WAIT_L(n) asm volatile("s_waitcnt lgkmcnt(" #n ")" ::: "memory")
#define PG8_BAR __builtin_amdgcn_s_barrier()
#define PG8_SCHED __builtin_amdgcn_sched_barrier(0)
    Unit cur, nxt; int ui = 0;
    if (!S.next(0, cur)) return;
    f32x4 acc[2][2][4][2];
#pragma unroll
    for (int a = 0; a < 2; ++a)
#pragma unroll
        for (int b = 0; b < 2; ++b)
#pragma unroll
            for (int m = 0; m < 4; ++m)
#pragma unroll
                for (int n = 0; n < 2; ++n) acc[a][b][m][n] = (f32x4){0.f, 0.f, 0.f, 0.f};
    bf16x8 At[4][2], B0[2][2], B1[2][2];
    const char* cA = (const char*)g.A + (size_t)cur.pm * tstep; const char* cB = (const char*)g.Bt + (size_t)cur.pn * tstep;
    S.a_ready(cur);
    if constexpr (SP2) {
        PG8_STAGE(PG8_SB(0, 0), cB, voffB); PG8_STAGE(PG8_SB(0, 1), cB + hstep, voffB); PG8_STAGE(PG8_SA(0, 0), cA, voffA); PG8_STAGE(PG8_SA(0, 1), cA + hstep, voffA);
        if (wr == 1) PG8_BAR;
        PG8_WAIT_V(2); PG8_BAR;
        PG8_STAGE(PG8_SB(1, 0), cB + kstep, voffB); PG8_STAGE(PG8_SA(1, 0), cA + kstep, voffA); PG8_STAGE(PG8_SB(1, 1), cB + hstep + kstep, voffB);
        PG8_WAIT_V(6); PG8_BAR;
    } else {
        PG8_STAGE(PG8_SB(0, 0), cB, voffB); PG8_STAGE(PG8_SA(0, 0), cA, voffA); PG8_STAGE(PG8_SB(0, 1), cB + hstep, voffB); PG8_STAGE(PG8_SA(0, 1), cA + hstep, voffA);
        if (wr == 1) PG8_BAR;
        PG8_WAIT_V(4); PG8_BAR;
        PG8_STAGE(PG8_SB(1, 0), cB + kstep, voffB); PG8_STAGE(PG8_SA(1, 0), cA + kstep, voffA); PG8_STAGE(PG8_SB(1, 1), cB + hstep + kstep, voffB);
        PG8_WAIT_V(6); PG8_BAR;
    }
    for (;;) {
        const bool has_next = S.next(ui + 1, nxt);
        const char* nA = has_next ? (const char*)g.A + (size_t)nxt.pm * tstep : cA; const char* nB = has_next ? (const char*)g.Bt + (size_t)nxt.pn * tstep : cB;
        for (int t = 0; t < nt; t += 2) {
            const bool last = (t == nt - 2);
            const char* a1 = cA + (size_t)(t + 1) * kstep;
            const char* a2 = last ? nA : cA + (size_t)(t + 2) * kstep; const char* b2 = last ? nB : cB + (size_t)(t + 2) * kstep;
            const char* a3 = a2 + kstep; const char* b3 = b2 + kstep;
            if (last && has_next) S.a_ready(nxt);
            if constexpr (SP2) {
            PG8_LDB(B0, 0, 0); PG8_LDB(B1, 0, 1); PG8_SCHED; PG8_LDA(At, 0, 0); PG8_STAGE(PG8_SA(1, 1), a1 + hstep, voffA);
            PG8_WAIT_V(8); PG8_WAIT_L(0); PG8_BAR; PG8_MMA(0, 0, At, B0); PG8_MMA(0, 1, At, B1); PG8_BAR; PG8_SCHED;
            PG8_LDA(At, 0, 1); PG8_STAGE(PG8_SB(0, 0), b2, voffB); PG8_STAGE(PG8_SB(0, 1), b2 + hstep, voffB); PG8_STAGE(PG8_SA(0, 0), a2, voffA);
            PG8_WAIT_V(8); PG8_WAIT_L(0); PG8_BAR; PG8_MMA(1, 0, At, B0); PG8_MMA(1, 1, At, B1); PG8_BAR; PG8_SCHED;
            PG8_LDB(B0, 1, 0); PG8_LDB(B1, 1, 1); PG8_SCHED; PG8_LDA(At, 1, 0); PG8_STAGE(PG8_SA(0, 1), a2 + hstep, voffA);
            PG8_WAIT_V(8); PG8_WAIT_L(0); PG8_BAR; PG8_MMA(0, 0, At, B0); PG8_MMA(0, 1, At, B1); PG8_BAR; PG8_SCHED;
            PG8_LDA(At, 1, 1); PG8_STAGE(PG8_SB(1, 0), b3, voffB); PG8_STAGE(PG8_SB(1, 1), b3 + hstep, voffB); PG8_STAGE(PG8_SA(1, 0), a3, voffA);
            PG8_WAIT_V(8); PG8_WAIT_L(0); PG8_BAR; PG8_MMA(1, 0, At, B0); PG8_MMA(1, 1, At, B1); PG8_BAR; PG8_SCHED;
            } else {
            PG8_LDB(B0, 0, 0); PG8_SCHED; PG8_LDA(At, 0, 0); PG8_STAGE(PG8_SA(1, 1), a1 + hstep, voffA);
            PG8_WAIT_L(8); PG8_BAR; PG8_WAIT_L(0); PG8_MMA(0, 0, At, B0); PG8_BAR; PG8_SCHED;
            PG8_LDB(B1, 0, 1); PG8_STAGE(PG8_SB(0, 0), b2, voffB);
            PG8_BAR; PG8_WAIT_L(0); PG8_MMA(0, 1, At, B1); PG8_BAR;
            PG8_LDA(At, 0, 1); PG8_STAGE(PG8_SA(0, 0), a2, voffA);
            PG8_BAR; PG8_WAIT_L(0); PG8_MMA(1, 0, At, B0); PG8_BAR; PG8_SCHED;
            PG8_STAGE(PG8_SB(0, 1), b2 + hstep, voffB);
            PG8_WAIT_V(6); PG8_BAR; PG8_MMA(1, 1, At, B1); PG8_BAR;
            PG8_LDB(B0, 1, 0); PG8_SCHED; PG8_LDA(At, 1, 0); PG8_STAGE(PG8_SA(0, 1), a2 + hstep, voffA);
            PG8_WAIT_L(8); PG8_BAR; PG8_WAIT_L(0); PG8_MMA(0, 0, At, B0); PG8_BAR; PG8_SCHED;
            PG8_LDB(B1, 1, 1); PG8_STAGE(PG8_SB(1, 0), b3, voffB);
            PG8_BAR; PG8_WAIT_L(0); PG8_MMA(0, 1, At, B1); PG8_BAR;
            PG8_LDA(At, 1, 1); PG8_STAGE(PG8_SA(1, 0), a3, voffA);
            PG8_BAR; PG8_WAIT_L(0); PG8_MMA(1, 0, At, B0); PG8_BAR; PG8_SCHED;
            PG8_STAGE(PG8_SB(1, 1), b3 + hstep, voffB);
            PG8_WAIT_V(6); PG8_BAR; PG8_MMA(1, 1, At, B1); PG8_BAR;
            }
        }
        if constexpr (ALIGN_EPI) { if (wr == 0) PG8_BAR; }
        if constexpr (!Epi::AFTER_DRAIN) { E(acc, cur, wr, wc, fr, fq); S.done(cur); }
        if (!has_next) break;
#pragma unroll
        for (int a = 0; a < 2; ++a)
#pragma unroll
            for (int b = 0; b < 2; ++b)
#pragma unroll
                for (int m = 0; m < 4; ++m)
#pragma unroll
                    for (int n = 0; n < 2; ++n) acc[a][b][m][n] = (f32x4){0.f, 0.f, 0.f, 0.f};
        cur = nxt; cA = nA; cB = nB; ++ui;
        if constexpr (ALIGN_EPI) { if (wr == 1) PG8_BAR; }
    }
    PG8_WAIT_V(0);
    if constexpr (!ALIGN_EPI) { if (wr == 0) PG8_BAR; }
    PG8_BAR;
    if constexpr (Epi::AFTER_DRAIN) { E.fused(acc, cur, wr, wc, fr, fq, lds, wid, lane); S.done(cur); }
#undef PG8_SA
#undef PG8_SB
#undef PG8_STAGE
#undef PG8_LDA
#undef PG8_LDB
#undef PG8_MMA
#undef PG8_WAIT_V
#undef PG8_WAIT_L
#undef PG8_BAR
#undef PG8_SCHED
}
}

template <class E0> struct EpiAdapt {
    static constexpr bool PERM = false, AFTER_DRAIN = false;
    E0 e; int col_base;
    __device__ __forceinline__ void operator()(const pg8::f32x4 (&acc)[2][2][4][2], const pg8::Unit& u, int wr, int wc, int fr, int fq) const {
#pragma unroll
        for (int ai = 0; ai < 2; ++ai)
#pragma unroll
            for (int m = 0; m < 4; ++m) {
                const int row = u.pm * 256 + ai * 128 + wr * 64 + m * 16 + fr;
                const float rs = e.row_begin(row, fq);
                float ss = 0.f;
#pragma unroll
                for (int bj = 0; bj < 2; ++bj) ss += e.item(row, col_base + u.pn * 256 + bj * 128 + wc * 32 + 4 * fq, acc[ai][bj][m][0], acc[ai][bj][m][1], rs);
                if constexpr (E0::STATS) { ss += __shfl_xor(ss, 16); ss += __shfl_xor(ss, 32); if (fq == 0) e.stats[(size_t)row * 16 + (col_base >> 6) + u.pn * 4 + wc] = ss; }
            }
    }
};
struct EpiResBig {
    static constexpr bool PERM = false, AFTER_DRAIN = false;
    EpiRes e;
    __device__ __forceinline__ void operator()(const pg8::f32x4 (&acc)[2][2][4][2], const pg8::Unit& u, int wr, int wc, int fr, int fq) const {
        const float* mg = (const float*)e.ws + e.mgoff; const float* sn = (const float*)e.ws + e.snoff;
        bf16_t* xs = (bf16_t*)(e.ws + WS_XS);
        const int colb = u.pn * 256 + wc * 32 + 4 * fq;
#pragma unroll
        for (int ai = 0; ai < 2; ++ai) {
            const int rowb = u.pm * 256 + ai * 128 + wr * 64 + fr;
            f32x4 xo[4][2][2];
#pragma unroll
            for (int m = 0; m < 4; ++m)
#pragma unroll
                for (int bj = 0; bj < 2; ++bj)
#pragma unroll
                    for (int hl = 0; hl < 2; ++hl) xo[m][bj][hl] = *(const f32x4*)(e.xin + (size_t)(rowb + 16 * m) * 1024 + colb + 128 * bj + 16 * hl);
#pragma unroll
            for (int m = 0; m < 4; ++m) {
                const int row = rowb + 16 * m; float ss = 0.f;
#pragma unroll
                for (int bj = 0; bj < 2; ++bj)
#pragma unroll
                    for (int hl = 0; hl < 2; ++hl) {
                        const int c = colb + 128 * bj + 16 * hl;
                        const f32x4 m4 = *(const f32x4*)(mg + c);
                        f32x4 b4 = {0.f, 0.f, 0.f, 0.f}; if (e.bias) b4 = *(const f32x4*)(e.bias + c);
                        const f32x4 xn = xo[m][bj][hl] + m4 * (acc[ai][bj][m][hl] + b4);
                        *(f32x4*)(e.xl + (size_t)row * 1024 + c) = xn;
                        ss += (xn[0] * xn[0] + xn[1] * xn[1]) + (xn[2] * xn[2] + xn[3] * xn[3]);
                        if (e.snoff >= 0) { const f32x4 s4 = *(const f32x4*)(sn + c); u32x2 w; w.x = pk2(xn[0] * s4[0], xn[1] * s4[1]); w.y = pk2(xn[2] * s4[2], xn[3] * s4[3]);
                            *(u32x2*)(xs + (size_t)row * 1024 + c) = w; }
                    }
                ss += __shfl_xor(ss, 16); ss += __shfl_xor(ss, 32); if (fq == 0) e.stats[(size_t)row * 16 + u.pn * 4 + wc] = ss;
            }
        }
    }
};
struct EpiVt {
    static constexpr bool PERM = false, AFTER_DRAIN = false;
    unsigned char* ws; int cvoff;
    __device__ __forceinline__ void operator()(const pg8::f32x4 (&acc)[2][2][4][2], const pg8::Unit& u, int wr, int wc, int fr, int fq) const {
        bf16_t* vt = (bf16_t*)(ws + WS_VT);
#pragma unroll
        for (int ai = 0; ai < 2; ++ai)
#pragma unroll
            for (int m = 0; m < 4; ++m) {
                const int rowb = u.pm * 256 + ai * 128 + wr * 64 + m * 16;
                const float rsl = row_rs((const float*)(ws + WS_STATS), rowb + fr, fq);
                float rsv[4];
#pragma unroll
                for (int e = 0; e < 4; ++e) rsv[e] = __shfl(rsl, 4 * fq + e);
                const float* cv = (const float*)ws + cvoff + (rowb < T ? 0 : 8192);
#pragma unroll
                for (int bj = 0; bj < 2; ++bj)
#pragma unroll
                    for (int n = 0; n < 2; ++n) {
                        const int col = 2048 + u.pn * 256 + bj * 128 + wc * 32 + 16 * n + fr;
                        const float c0 = cv[col]; const pg8::f32x4 a = acc[ai][bj][m][n];
                        u32x2 w; w.x = pk2(a[0] * rsv[0] + c0, a[1] * rsv[1] + c0); w.y = pk2(a[2] * rsv[2] + c0, a[3] * rsv[3] + c0);
                        *(u32x2*)(vt + (size_t)(col - 2048) * R + rowb + 4 * fq) = w;
                    }
            }
    }
};
template <class Epi>
__device__ __forceinline__ void sgemm_small(Ctx& C, const bf16_t* A, const bf16_t* Bt, int row_lo, int Mrows, int N, int K, const Epi& E, int n_lo, int n_hi) {
    const int kh = C.wave >> 2, wc = C.wave & 3, fr = C.lane & 15, fq = C.lane >> 4;
    const int nM = Mrows / 16, nN = n_hi - n_lo, nU = nM * nN, Kh = K >> 1;
    LAS f32x4* xch = (LAS f32x4*)C.lds;
    for (int u = (C.G - 1 - C.bid); u < nU; u += C.G) {
        const int un = n_lo + u / nM, um = u % nM;
        const int row0 = row_lo + 16 * um, col0 = 256 * un;
        f32x4 acc[2][2];
#pragma unroll
        for (int b = 0; b < 2; ++b)
#pragma unroll
            for (int n = 0; n < 2; ++n) acc[b][n] = (f32x4){0.f, 0.f, 0.f, 0.f};
        const bf16_t* ap = A + (size_t)(row0 + fr) * K + kh * Kh + 8 * fq;
        const bf16_t* bp = Bt + (size_t)(col0 + 32 * wc + fr) * K + kh * Kh + 8 * fq;
#pragma unroll 4
        for (int k0 = 0; k0 < Kh; k0 += 32) {
            bf16x8 bf[2][2];
            const bf16x8 af = *(const bf16x8*)(ap + k0);
#pragma unroll
            for (int bj = 0; bj < 2; ++bj)
#pragma unroll
                for (int n = 0; n < 2; ++n) bf[bj][n] = *(const bf16x8*)(bp + (size_t)(128 * bj + 16 * n) * K + k0);
#pragma unroll
            for (int bj = 0; bj < 2; ++bj)
#pragma unroll
                for (int n = 0; n < 2; ++n) acc[bj][n] = __builtin_amdgcn_mfma_f32_16x16x32_bf16(bf[bj][n], af, acc[bj][n], 0, 0, 0);
        }
        if (kh == 1) {
#pragma unroll
            for (int bj = 0; bj < 2; ++bj)
#pragma unroll
                for (int n = 0; n < 2; ++n) xch[(wc * 4 + bj * 2 + n) * 64 + C.lane] = acc[bj][n];
        }
        __syncthreads();
        if (kh == 0) {
#pragma unroll
            for (int bj = 0; bj < 2; ++bj)
#pragma unroll
                for (int n = 0; n < 2; ++n) acc[bj][n] += xch[(wc * 4 + bj * 2 + n) * 64 + C.lane];
            const int row = row0 + fr;
            const float rs = E.row_begin(row, fq);
            float ss = 0.f;
#pragma unroll
            for (int bj = 0; bj < 2; ++bj) ss += E.item(row, col0 + 128 * bj + 32 * wc + 4 * fq, acc[bj][0], acc[bj][1], rs);
            if constexpr (Epi::STATS) { ss += __shfl_xor(ss, 16); ss += __shfl_xor(ss, 32); if (fq == 0) E.stats[(size_t)row * 16 + un * 4 + wc] = ss; }
        }
        __syncthreads();
    }
}
template <class E0>
__device__ __forceinline__ void gemm_both(Ctx& C, const bf16_t* A, const bf16_t* Bt, int Mbig, int N, int K, const E0& E, int ctx_n_lo, int ctx_n_hi, int nb_lo = 0, int nb_hi = -1) {
    if (nb_hi < 0) nb_hi = N / 256;
    { pg8::Gemm g{A, Bt + (size_t)nb_lo * 256 * K, Mbig, (nb_hi - nb_lo) * 256, K}; pg8::StaticOrder S; S.init(Mbig, (nb_hi - nb_lo) * 256, C.G, C.bid); EpiAdapt<E0> EA{E, nb_lo * 256};
      pg8::gemm_phase<EpiAdapt<E0>, pg8::StaticOrder, true, true>(C.lds, g, S, EA); }
    if (Mbig < R && ctx_n_hi > ctx_n_lo) { __syncthreads(); sgemm_small(C, A, Bt, T, R - T, N, K, E, ctx_n_lo, ctx_n_hi); }
}
__device__ __forceinline__ void dwconv_phase(Ctx& C, int j) {
    const bf16_t* U = (const bf16_t*)(C.ws + WS_U); bf16_t* A2 = (bf16_t*)(C.ws + WS_A2);
    const float* dww = C.in[10] + (size_t)j * CK * 1024; const float* dwb = C.in[11] + j * 1024; const float* lng = C.in[12] + j * 1024; const float* lnb = C.in[13] + j * 1024;
    constexpr int TT = 33, NR = TT + 30;
    LAS unsigned char* tile = C.lds; LAS float* part = (LAS float*)(C.lds + NR * 2048);
    const int tid = C.tid;
    constexpr int NUL = (T + TT - 1) / TT, NUC = (TC + TT - 1) / TT;
    f32x2 wt[CK];
#pragma unroll
    for (int jt = 0; jt < CK; ++jt) wt[jt] = *(const f32x2*)(dww + jt * 1024 + 2 * tid);
    const f32x2 b2 = *(const f32x2*)(dwb + 2 * tid), g2 = *(const f32x2*)(lng + 2 * tid), bb2 = *(const f32x2*)(lnb + 2 * tid);
    for (int u = C.bid; u < NUL + NUC; u += C.G) {
        const bool lat = u < NUL; const int base = lat ? 0 : T, n = lat ? T : TC, t0 = TT * (lat ? u : u - NUL);
        const int nv = (n - t0) < TT ? (n - t0) : TT;
        for (int idx = tid; idx < NR * 128; idx += 512) {
            const int rr = idx >> 7, ch = idx & 127, tt = t0 - 15 + rr;
            u32x4 v = {0u, 0u, 0u, 0u};
            if (tt >= 0 && tt < n) v = *(const u32x4*)(U + (size_t)(base + tt) * 1024 + ch * 8);
            *(LAS u32x4*)(tile + rr * 2048 + ch * 16) = v;
        }
        __syncthreads();
        f32x2 o[TT];
#pragma unroll
        for (int t = 0; t < TT; ++t) o[t] = b2;
#pragma unroll
        for (int hb = 0; hb < 3; ++hb) {
            f32x2 xw[41];
#pragma unroll
            for (int r = 0; r < 41; ++r) { const unsigned uu = *(const LAS unsigned*)(tile + (11 * hb + r) * 2048 + tid * 4); xw[r] = (f32x2){bflo(uu), bfhi(uu)}; }
#pragma unroll
            for (int t = 0; t < 11; ++t)
#pragma unroll
                for (int jt = 0; jt < CK; ++jt) o[11 * hb + t] += wt[jt] * xw[t + jt];
        }
#pragma unroll
        for (int t = 0; t < TT; ++t) {
            const float s = wave_sum63(o[t].x + o[t].y), q = wave_sum63(o[t].x * o[t].x + o[t].y * o[t].y);
            if (C.lane == 63) { part[(t * 8 + C.wave) * 2] = s; part[(t * 8 + C.wave) * 2 + 1] = q; }
        }
        __syncthreads();
#pragma unroll
        for (int t = 0; t < TT; ++t) {
            float s = 0.f, q = 0.f;
#pragma unroll
            for (int w = 0; w < 8; ++w) { s += part[(t * 8 + w) * 2]; q += part[(t * 8 + w) * 2 + 1]; }
            const float mean = s * (1.f / 1024.f), var = q * (1.f / 1024.f) - mean * mean, rstd = 1.0f / sqrtf(var + LN_EPS);
            const float y0 = (o[t].x - mean) * rstd * g2.x + bb2.x, y1 = (o[t].y - mean) * rstd * g2.y + bb2.y;
            if (t < nv) *(unsigned*)(A2 + (size_t)(base + t0 + t) * 1024 + 2 * tid) = pk2(siluf(y0), siluf(y1));
        }
        __syncthreads();
    }
}

__device__ __forceinline__ void scan_phase(Ctx& C, int j) {
    const bf16_t* Kb = (const bf16_t*)(C.ws + WS_K); const bf16_t* Vt = (const bf16_t*)(C.ws + WS_VT); bf16_t* Scp = (bf16_t*)(C.ws + WS_SCP);
    constexpr int SLOT = 32768;
    const int fr = C.lane & 15, fq = C.lane >> 4, w = C.wave, lane = C.lane;
    for (int cu = C.bid; cu < 256; cu += C.G) {
        const int hd = cu & 7, sidx = cu >> 3, h = hd >> 1, dir = hd & 1, dk_s = 64 * ((sidx >> 3) & 3), dv_s = 64 * (sidx & 7);
        const float gam = 1.0f - exp2f(C.in[17][(j * 2 + dir) * 4 + h]); const float L = log2f(gam);
        const float cdec = exp2f(L * 128.f);
        const bf16_t* ksrc[2]; const bf16_t* vsrc[2];
#pragma unroll
        for (int p = 0; p < 2; ++p) {
            const int kr = 8 * (2 * w + p) + (lane >> 3), kpos = lane & 7, kc = kpos ^ (((kr >> 3) & 1) << 1) ^ (((kr >> 1) & 1) << 2);
            ksrc[p] = Kb + (size_t)kr * 1024 + h * 256 + dk_s + 8 * kc;
            const int vr = 4 * (2 * w + p) + (lane >> 4), vpos = lane & 15, vc = vpos ^ (vr & 15);
            vsrc[p] = Vt + (size_t)(h * 512 + dv_s + vr) * R + 8 * vc;
        }
        auto tok_of = [&](int st) { const int sc = st < 129 ? st : 129; const int bl = sc < 2 ? (dir == 0 ? sc : 1 - sc) : (dir == 0 ? sc - 2 : 129 - sc); return (sc < 2 ? T : 0) + 128 * bl; };
#define SCAN_DMA(st) do { const int tok_ = tok_of(st); LAS unsigned char* sl_ = C.lds + ((st) & 3) * SLOT + (2 * w) * 1024; \
        __builtin_amdgcn_global_load_lds((const unsigned*)(ksrc[0] + (size_t)tok_ * 1024), (LAS unsigned*)(sl_), 16, 0, 0); \
        __builtin_amdgcn_global_load_lds((const unsigned*)(ksrc[1] + (size_t)tok_ * 1024), (LAS unsigned*)(sl_ + 1024), 16, 0, 0); \
        __builtin_amdgcn_global_load_lds((const unsigned*)(vsrc[0] + tok_), (LAS unsigned*)(sl_ + 16384), 16, 0, 0); \
        __builtin_amdgcn_global_load_lds((const unsigned*)(vsrc[1] + tok_), (LAS unsigned*)(sl_ + 16384 + 1024), 16, 0, 0); } while (0)
        const int mt = w >> 1, nh = w & 1, dkl = 16 * mt;
        const int trq = (fr >> 2), trp = fr & 3, trrow0 = 8 * fq + trq;
        const int trcol0 = (((2 * mt + (trp >> 1)) ^ ((fq & 1) << 1) ^ (((trq >> 1) & 1) << 2)) << 3) + 4 * (trp & 1);
        float kd[4][8];
#pragma unroll
        for (int ks = 0; ks < 4; ++ks)
#pragma unroll
            for (int e = 0; e < 8; ++e) { const int tl = 32 * ks + 8 * fq + e; kd[ks][e] = exp2f(L * (float)(dir == 0 ? 127 - tl : tl)); }
        int voff[2];
#pragma unroll
        for (int nt = 0; nt < 2; ++nt) { const int vr = 32 * nh + 16 * nt + fr; voff[nt] = 16384 + vr * 256; }
        f32x4 acc[2]; acc[0] = (f32x4){0.f, 0.f, 0.f, 0.f}; acc[1] = acc[0];
        const unsigned lds0 = (unsigned)(size_t)C.lds;
        __syncthreads();
        SCAN_DMA(0); SCAN_DMA(1); SCAN_DMA(2);
#pragma unroll 1
        for (int st = 0; st < 130; ++st) {
            asm volatile("s_waitcnt vmcnt(8)" ::: "memory");
            __builtin_amdgcn_s_barrier(); asm volatile("" ::: "memory");
            SCAN_DMA(st + 3);
            {   const bool isctx = st < 2; const int bl = isctx ? (dir == 0 ? st : 1 - st) : (dir == 0 ? st - 2 : 129 - st);
                const bool cp = dir == 0 ? ((bl & 3) == 0) : (isctx ? bl == 1 : (bl & 3) == 3);
                if (cp) {
                    const int slot = isctx ? 32 : (bl >> 2);
                    bf16_t* sp = Scp + ((size_t)((slot * 4 + h) * 2 + dir) * 512) * 256;
#pragma unroll
                    for (int nt = 0; nt < 2; ++nt) { u32x2 wv; wv.x = pk2(acc[nt][0], acc[nt][1]); wv.y = pk2(acc[nt][2], acc[nt][3]);
                        *(u32x2*)(sp + (size_t)(dv_s + 32 * nh + 16 * nt + fr) * 256 + dk_s + dkl + 4 * fq) = wv; }
                } }
            acc[0] = acc[0] * cdec; acc[1] = acc[1] * cdec;
            const unsigned sl = lds0 + (unsigned)((st & 3) * SLOT);
            u32x2 klo[4], khi[4]; u32x4 vfr[4][2];
#pragma unroll
            for (int ks = 0; ks < 4; ++ks) {
                const unsigned ka = sl + (unsigned)(((32 * ks + trrow0) * 64 + trcol0) * 2);
                asm volatile("ds_read_b64_tr_b16 %0, %1" : "=v"(klo[ks]) : "v"(ka));
                asm volatile("ds_read_b64_tr_b16 %0, %1 offset:512" : "=v"(khi[ks]) : "v"(ka));
#pragma unroll
                for (int nt = 0; nt < 2; ++nt) { const int vr = 32 * nh + 16 * nt + fr;
                    const unsigned va = sl + (unsigned)(voff[nt] + (((4 * ks + fq) ^ (vr & 15)) << 4));
                    asm volatile("ds_read_b128 %0, %1" : "=v"(vfr[ks][nt]) : "v"(va)); }
            }
            asm volatile("s_waitcnt lgkmcnt(0)" : "+v"(klo[0]), "+v"(klo[1]), "+v"(klo[2]), "+v"(klo[3]), "+v"(khi[0]), "+v"(khi[1]), "+v"(khi[2]), "+v"(khi[3]) :: "memory");
            asm volatile("" : "+v"(vfr[0][0]), "+v"(vfr[0][1]), "+v"(vfr[1][0]), "+v"(vfr[1][1]), "+v"(vfr[2][0]), "+v"(vfr[2][1]), "+v"(vfr[3][0]), "+v"(vfr[3][1]));
            __builtin_amdgcn_sched_barrier(0);
#pragma unroll
            for (int ks = 0; ks < 4; ++ks) {
                u32x4 pk;
                pk.x = pk2(bflo(klo[ks].x) * kd[ks][0], bfhi(klo[ks].x) * kd[ks][1]);
                pk.y = pk2(bflo(klo[ks].y) * kd[ks][2], bfhi(klo[ks].y) * kd[ks][3]);
                pk.z = pk2(bflo(khi[ks].x) * kd[ks][4], bfhi(khi[ks].x) * kd[ks][5]);
                pk.w = pk2(bflo(khi[ks].y) * kd[ks][6], bfhi(khi[ks].y) * kd[ks][7]);
                const bf16x8 af = __builtin_bit_cast(bf16x8, pk);
#pragma unroll
                for (int nt = 0; nt < 2; ++nt) acc[nt] = __builtin_amdgcn_mfma_f32_16x16x32_bf16(af, __builtin_bit_cast(bf16x8, vfr[ks][nt]), acc[nt], 0, 0, 0);
            }
        }
        asm volatile("s_waitcnt vmcnt(0)" ::: "memory");
        __syncthreads();
#undef SCAN_DMA
    }
}

template <int MT, int PV = 0>
__device__ __forceinline__ void readout_units(Ctx& C, int j) {
    const bf16_t* Q = (const bf16_t*)(C.ws + WS_Q); const bf16_t* Kb = (const bf16_t*)(C.ws + WS_K); const bf16_t* Vt = (const bf16_t*)(C.ws + WS_VT);
    const bf16_t* Scp = (const bf16_t*)(C.ws + WS_SCP); bf16_t* GF = (bf16_t*)(C.ws + WS_GF); const bf16_t* GB = (const bf16_t*)(C.ws + WS_GB);
    constexpr int QP = 264, PP = 136;
    constexpr int NROW = 16 * MT;
    LAS bf16_t* Qs = (LAS bf16_t*)C.lds;
    LAS bf16_t* P = (LAS bf16_t*)(C.lds + NROW * QP * 2);
    LAS float* red = (LAS float*)(C.lds + NROW * QP * 2 + NROW * PP * 2);
    const int w = C.wave, tid = C.tid;
    const int nunits = MT == 8 ? 512 : 32;
    for (int u0 = (MT == 8 ? C.bid : C.G - 1 - C.bid); u0 < nunits; u0 += C.G) {
        int h, b, sb = 0;
        if (MT != 8) { h = u0 & 3; sb = (u0 >> 2) & 3; b = 128 + (u0 >> 4); }
        else if (C.G == 256) { const int r = u0 >> 8, x = u0 & 7, idx = (u0 & 255) >> 3, grp = r * 64 + x * 8 + (idx >> 2); h = grp & 3; b = (grp >> 2) * 4 + (idx & 3); }
        else { h = u0 & 3; b = u0 >> 2; }
        const bool lat = b < 128; const int base = lat ? 0 : T, nb = lat ? 128 : 2, bl = lat ? b : b - 128;
        const int g = bl >> 2, slot = lat ? g : 32;
        const int gend = (4 * (g + 1) < nb ? 4 * (g + 1) : nb);
        const int i0 = base + 128 * bl + NROW * sb, il0 = 128 * bl + NROW * sb;
#pragma unroll
        for (int i = 0; i < MT; ++i) { const int c = tid + 512 * i, row = c >> 5, ch = c & 31;
            *(LAS u32x4*)(Qs + row * QP + 8 * ch) = *(const u32x4*)(Q + (size_t)(i0 + row) * 1024 + h * 256 + 8 * ch); }
        __syncthreads();
#pragma unroll 1
        for (int dir = 0; dir < 2; ++dir) {
            int lane_o = C.lane; asm volatile("" : "+v"(lane_o));
            const int fr = lane_o & 15, fq = lane_o >> 4;
            const float gam = 1.0f - exp2f(C.in[17][(j * 2 + dir) * 4 + h]); const float L = log2f(gam);
            f32x4 acc[MT][4];
#pragma unroll
            for (int mt = 0; mt < MT; ++mt)
#pragma unroll
                for (int nt = 0; nt < 4; ++nt) acc[mt][nt] = (f32x4){0.f, 0.f, 0.f, 0.f};
            const int kb_lo = dir == 0 ? 4 * g : bl, kb_hi = dir == 0 ? bl : gend - 1;
            const bf16_t* sb = Scp + ((size_t)((slot * 4 + h) * 2 + dir) * 512) * 256 + (size_t)(64 * w + 16 * (fr >> 2) + (fr & 3)) * 256 + 8 * fq;
#pragma unroll 1
            for (int kq = 0; kq < 4; ++kq) {
                bf16x8 sf[2][4];
#pragma unroll
                for (int k2 = 0; k2 < 2; ++k2)
#pragma unroll
                    for (int nt = 0; nt < 4; ++nt) sf[k2][nt] = *(const bf16x8*)(sb + (size_t)(4 * nt) * 256 + 32 * (2 * kq + k2));
#pragma unroll
                for (int k2 = 0; k2 < 2; ++k2)
#pragma unroll
                    for (int mt = 0; mt < MT; ++mt) { const bf16x8 qf = *(const LAS bf16x8*)(Qs + (16 * mt + fr) * QP + 32 * (2 * kq + k2) + 8 * fq);
#pragma unroll
                        for (int nt = 0; nt < 4; ++nt) acc[mt][nt] = __builtin_amdgcn_mfma_f32_16x16x32_bf16(sf[k2][nt], qf, acc[mt][nt], 0, 0, 0); }
            }
#pragma unroll
            for (int mt = 0; mt < MT; ++mt) {
                const int il = il0 + 16 * mt + fr;
                const int ex = dir == 0 ? il - 512 * g + 1 : gend * 128 - il;
                const float qd = __builtin_amdgcn_exp2f(L * (float)ex);
#pragma unroll
                for (int nt = 0; nt < 4; ++nt) acc[mt][nt] = acc[mt][nt] * qd;
            }
#pragma unroll 1
            for (int kb = kb_lo; kb <= (PV == 2 ? kb_lo - 1 : kb_hi); ++kb) {
                const int j0 = base + 128 * kb;
                {
                    bf16x8 kf[8];
                    const bf16_t* k1 = Kb + (size_t)(j0 + 16 * w + fr) * 1024 + h * 256 + 8 * fq;
#pragma unroll
                    for (int ks = 0; ks < 8; ++ks) kf[ks] = *(const bf16x8*)(k1 + 32 * ks);
                    f32x4 sc[MT];
#pragma unroll
                    for (int mt = 0; mt < MT; ++mt) sc[mt] = (f32x4){0.f, 0.f, 0.f, 0.f};
#pragma unroll
                    for (int ks = 0; ks < 8; ++ks) {
#pragma unroll
                        for (int mt = 0; mt < MT; ++mt) { const bf16x8 qf = *(const LAS bf16x8*)(Qs + (16 * mt + fr) * QP + 32 * ks + 8 * fq);
                            sc[mt] = __builtin_amdgcn_mfma_f32_16x16x32_bf16(kf[ks], qf, sc[mt], 0, 0, 0); }
                        __builtin_amdgcn_sched_barrier(0);
                    }
#pragma unroll
                    for (int mt = 0; mt < MT; ++mt) {
                        const int il = il0 + 16 * mt + fr;
                        float p[4];
#pragma unroll
                        for (int e = 0; e < 4; ++e) { const int jl = 128 * kb + 16 * w + 4 * fq + e; const int rel = dir == 0 ? il - jl : jl - il;
                            p[e] = rel >= 0 ? sc[mt][e] * __builtin_amdgcn_exp2f(L * (float)rel) : 0.f; }
                        u32x2 wv; wv.x = pk2(p[0], p[1]); wv.y = pk2(p[2], p[3]);
                        *(LAS u32x2*)(P + (16 * mt + fr) * PP + 16 * w + 4 * fq) = wv;
                    }
                }
                __syncthreads();
                const bf16_t* vb = Vt + (size_t)(h * 512 + 64 * w + 16 * (fr >> 2) + (fr & 3)) * R + j0 + 8 * fq;
#pragma unroll 1
                for (int kh2 = 0; kh2 < 2; ++kh2) {
                    bf16x8 vf[2][4];
#pragma unroll
                    for (int k2 = 0; k2 < 2; ++k2)
#pragma unroll
                        for (int nt = 0; nt < 4; ++nt) vf[k2][nt] = *(const bf16x8*)(vb + (size_t)(4 * nt) * R + 32 * (2 * kh2 + k2));
#pragma unroll
                    for (int k2 = 0; k2 < 2; ++k2)
#pragma unroll
                        for (int mt = 0; mt < MT; ++mt) { const bf16x8 pf = *(const LAS bf16x8*)(P + (16 * mt + fr) * PP + 32 * (2 * kh2 + k2) + 8 * fq);
#pragma unroll
                            for (int nt = 0; nt < 4; ++nt) acc[mt][nt] = __builtin_amdgcn_mfma_f32_16x16x32_bf16(vf[k2][nt], pf, acc[mt][nt], 0, 0, 0); }
                }
                __syncthreads();
            }
#pragma unroll
            for (int mt = 0; mt < MT; ++mt) {
                float ss = 0.f;
#pragma unroll
                for (int nt = 0; nt < 4; ++nt) ss += (acc[mt][nt][0] * acc[mt][nt][0] + acc[mt][nt][1] * acc[mt][nt][1]) + (acc[mt][nt][2] * acc[mt][nt][2] + acc[mt][nt][3] * acc[mt][nt][3]);
                ss += __shfl_xor(ss, 16); ss += __shfl_xor(ss, 32);
                if (fq == 0) red[(16 * mt + fr) * 8 + w] = ss;
            }
            const size_t off0 = (size_t)(i0 + fr) * 2048 + h * 512 + 64 * w + 16 * fq;
            u32x4 gld[MT][2];
#pragma unroll
            for (int mt = 0; mt < MT; ++mt)
#pragma unroll
                for (int np = 0; np < 2; ++np) gld[mt][np] = *(const u32x4*)((dir == 0 ? (const bf16_t*)GF : GB) + off0 + (size_t)(16 * mt) * 2048 + 8 * np);
            __syncthreads();
#pragma unroll
            for (int mt = 0; mt < MT; ++mt) {
                float tot = 0.f;
#pragma unroll
                for (int w2 = 0; w2 < 8; ++w2) tot += red[(16 * mt + fr) * 8 + w2];
                const float rn = 1.0f / sqrtf(tot * (1.f / 512.f) + NORM_EPS);
#pragma unroll
                for (int np = 0; np < 2; ++np) {
                    const u32x4 g4 = gld[mt][np];
                    acc[mt][2 * np][0] *= siluf(bflo(g4.x)) * rn; acc[mt][2 * np][1] *= siluf(bfhi(g4.x)) * rn;
                    acc[mt][2 * np][2] *= siluf(bflo(g4.y)) * rn; acc[mt][2 * np][3] *= siluf(bfhi(g4.y)) * rn;
                    acc[mt][2 * np + 1][0] *= siluf(bflo(g4.z)) * rn; acc[mt][2 * np + 1][1] *= siluf(bfhi(g4.z)) * rn;
                    acc[mt][2 * np + 1][2] *= siluf(bflo(g4.w)) * rn; acc[mt][2 * np + 1][3] *= siluf(bfhi(g4.w)) * rn;
                }
            }
            if (dir == 1) {
#pragma unroll
                for (int mt = 0; mt < MT; ++mt)
#pragma unroll
                    for (int np = 0; np < 2; ++np) gld[mt][np] = *(const u32x4*)(GF + off0 + (size_t)(16 * mt) * 2048 + 8 * np);
#pragma unroll
                for (int mt = 0; mt < MT; ++mt)
#pragma unroll
                    for (int np = 0; np < 2; ++np) { const u32x4 yp = gld[mt][np];
                        acc[mt][2 * np][0] += bflo(yp.x); acc[mt][2 * np][1] += bfhi(yp.x); acc[mt][2 * np][2] += bflo(yp.y); acc[mt][2 * np][3] += bfhi(yp.y);
                        acc[mt][2 * np + 1][0] += bflo(yp.z); acc[mt][2 * np + 1][1] += bfhi(yp.z); acc[mt][2 * np + 1][2] += bflo(yp.w); acc[mt][2 * np + 1][3] += bfhi(yp.w); }
            }
            if (PV != 4) {
#pragma unroll
                for (int mt = 0; mt < MT; ++mt)
#pragma unroll
                    for (int np = 0; np < 2; ++np) { u32x4 wv; wv.x = pk2(acc[mt][2 * np][0], acc[mt][2 * np][1]); wv.y = pk2(acc[mt][2 * np][2], acc[mt][2 * np][3]);
                        wv.z = pk2(acc[mt][2 * np + 1][0], acc[mt][2 * np + 1][1]); wv.w = pk2(acc[mt][2 * np + 1][2], acc[mt][2 * np + 1][3]);
                        *(u32x4*)(GF + off0 + (size_t)(16 * mt) * 2048 + 8 * np) = wv; }
            }
        }
        __syncthreads();
    }
}

template <int PV = 0>
__device__ __forceinline__ void readout_phase(Ctx& C, int j, bool skip_ctx) {
    readout_units<8, PV>(C, j);
    if (!skip_ctx) { __syncthreads(); readout_units<2, PV>(C, j); }
}

__device__ __forceinline__ void phase_p0(Ctx& C) {
    float* modv = (float*)(C.ws + WS_MODV);
    for (int u = C.bid; u < 384; u += C.G) {
        const int i = u / 96, nbk = u % 96;
        gemv2_unit<1>(C, C.in[4] + (size_t)i * 1024 * 6144, 6144, 64 * nbk, C.in[1], C.in[3], C.in[5] + i * 6144, modv + (i * 2 + 0) * 6144, modv + (i * 2 + 1) * 6144, 0, 0);
    }
    float* tabc = (float*)(C.ws + WS_TABC); float* tabs = (float*)(C.ws + WS_TABS);
    for (int idx = C.bid * 512 + C.tid; idx < 320 * 64; idx += C.G * 512) {
        const int ti = idx >> 6, i = idx & 63; const float pos = (float)(ti < 256 ? ti : ti - 256);
        const float inv = exp2f(-(float)i * (13.287712379549449f / 64.0f)); const float ang = pos * inv;
        tabc[idx] = __cosf(ang); tabs[idx] = __sinf(ang);
    }
}
__device__ __forceinline__ void phase_p1(Ctx& C) {
    const float* modv = (const float*)(C.ws + WS_MODV);
    float* s1 = (float*)(C.ws + WS_S1); float* s2 = (float*)(C.ws + WS_S2);
    for (int idx = C.bid * 512 + C.tid; idx < 8192; idx += C.G * 512) {
        const int i = idx >> 11, s = (idx >> 10) & 1, k = idx & 1023;
        s1[idx] = C.in[6][i * 1024 + k] * (1.f + modv[(i * 2 + s) * 6144 + 1024 + k]);
        s2[idx] = C.in[7][i * 1024 + k] * (1.f + modv[(i * 2 + s) * 6144 + 4096 + k]);
    }
    float* cvA = (float*)(C.ws + WS_CVA); float* cvF = (float*)(C.ws + WS_CVF);
    for (int u = C.bid; u < 672; u += C.G) {
        if (u < 320) {
            int i, nbk; if (u < 32) { i = 0; nbk = u; } else if (u < 160) { i = 1; nbk = u - 32; } else if (u < 192) { i = 2; nbk = u - 160; } else { i = 3; nbk = u - 192; }
            const int j = i >> 1; const float* v0 = modv + (i * 2 + 0) * 6144; const float* v1 = modv + (i * 2 + 1) * 6144;
            if ((i & 1) == 0) gemv2_unit<0>(C, C.in[8] + (size_t)j * 1024 * 2048, 2048, 64 * nbk, v0, v1, C.in[9] + j * 2048, cvA + (i * 2) * 8192, cvA + (i * 2 + 1) * 8192, 1, 1024);
            else gemv2_unit<0>(C, C.in[16] + (size_t)j * 1024 * 8192, 8192, 64 * nbk, v0, v1, nullptr, cvA + (i * 2) * 8192, cvA + (i * 2 + 1) * 8192, 2, 0);
        } else {
            const int i = (u - 320) / 88, nbk = (u - 320) % 88;
            const float* v0 = modv + (i * 2 + 0) * 6144 + 3072; const float* v1 = modv + (i * 2 + 1) * 6144 + 3072;
            gemv2_unit<0>(C, C.in[19] + (size_t)i * 1024 * FF2, FF2, 64 * nbk, v0, v1, nullptr, cvF + (i * 2) * FF2, cvF + (i * 2 + 1) * FF2, 1, DFF);
        }
    }
    bf16_t* xs = (bf16_t*)(C.ws + WS_XS); float* stats = (float*)(C.ws + WS_STATS); float* xctx = (float*)(C.ws + WS_XCTX);
    for (int row = C.bid * 8 + C.wave; row < R; row += C.G * 8) {
        const bool lat = row < T; const int s = lat ? 0 : 1;
        const float* src = lat ? C.in[0] + (size_t)row * 1024 : C.in[2] + (size_t)(row - T) * 1024;
        float ss = 0.f;
#pragma unroll
        for (int jj = 0; jj < 4; ++jj) {
            const int k = 4 * C.lane + 256 * jj;
            const f32x4 v = *(const f32x4*)(src + k);
            ss += (v[0] * v[0] + v[1] * v[1]) + (v[2] * v[2] + v[3] * v[3]);
            const f32x4 g = *(const f32x4*)(C.in[6] + k), m = *(const f32x4*)(modv + s * 6144 + 1024 + k);
            u32x2 w; w.x = pk2(v[0] * g[0] * (1.f + m[0]), v[1] * g[1] * (1.f + m[1])); w.y = pk2(v[2] * g[2] * (1.f + m[2]), v[3] * g[3] * (1.f + m[3]));
            *(u32x2*)(xs + (size_t)row * 1024 + k) = w;
        }
#pragma unroll
        for (int off = 1; off < 64; off <<= 1) ss += __shfl_xor(ss, off);
        if (C.lane < 16) stats[(size_t)row * 16 + C.lane] = C.lane == 0 ? ss : 0.f;
    }
    prep_layer(C, 0, 3, 0);
}
__device__ __forceinline__ void phase_final(Ctx& C) {
    const float* stats = (const float*)(C.ws + WS_STATS);
    for (int row = C.bid * 8 + C.wave; row < T; row += C.G * 8) {
        float s = C.lane < 16 ? stats[(size_t)row * 16 + C.lane] : 0.f;
#pragma unroll
        for (int off = 1; off < 64; off <<= 1) s += __shfl_xor(s, off);
        const float r = 1.0f / sqrtf(s * (1.f / 1024.f) + NORM_EPS);
        float* xr = C.out + (size_t)row * 1024;
#pragma unroll
        for (int jj = 0; jj < 4; ++jj) { const int k = 4 * C.lane + 256 * jj; const f32x4 v = *(const f32x4*)(xr + k), g = *(const f32x4*)(C.in[21] + k); *(f32x4*)(xr + k) = v * r * g; }
    }
}

constexpr int NPHASE = 31;
__device__ __forceinline__ void run_phase(Ctx& C, int ph) {
    const int i = (ph - 2) / 7, sub = (ph - 2) % 7, j = i >> 1; const bool conv = (i & 1) == 0;
    const bool last = i == DEPTH - 1;
    float* stats = (float*)(C.ws + WS_STATS);
    const bf16_t* xs = (const bf16_t*)(C.ws + WS_XS);
    constexpr int F_MODV = (int)(WS_MODV / 4), F_S1 = (int)(WS_S1 / 4), F_S2 = (int)(WS_S2 / 4), F_CVA = (int)(WS_CVA / 4), F_CVF = (int)(WS_CVF / 4);
    if (sub == 1) {
        if (conv) { EpiGLU E{C.ws, F_CVA + (i * 2) * 8192, 8192, (int)WS_U, 1024, 0, stats}; gemm_both(C, xs, (const bf16_t*)(C.ws + WS_WA), T, 2048, 1024, E, 0, 8); }
        else {
            EpiWin E{C.ws, F_CVA + (i * 2) * 8192, stats};
            const bf16_t* WA = (const bf16_t*)(C.ws + WS_WA);
            gemm_both(C, xs, WA, T, 8192, 1024, E, 0, 0, 0, 8);
            { pg8::Gemm g{xs, WA + (size_t)2048 * 1024, T, 2048, 1024}; pg8::StaticOrder S; S.init(T, 2048, C.G, C.bid); EpiVt EV{C.ws, F_CVA + (i * 2) * 8192};
              pg8::gemm_phase<EpiVt, pg8::StaticOrder, true, true, true>(C.lds, g, S, EV); }
            gemm_both(C, xs, WA, T, 8192, 1024, E, last ? 4 : 0, last ? 16 : 32, 16, 32);
        }
    } else if (sub == 5) {
        EpiGLU E{C.ws, F_CVF + (i * 2) * FF2, FF2, (int)WS_H, DFF, 1, stats}; gemm_both(C, xs, (const bf16_t*)(C.ws + WS_WF1), last ? T : R, FF2, 1024, E, 0, 0);
        if (!last) { __syncthreads(); prep_layer(C, i + 1, 1, C.G == 256 ? 150 : 0); }
    } else {
        const bool f2 = sub == 6;
        const int mgoff = F_MODV + (i * 2) * 6144 + (f2 ? 5120 : 2048);
        const int snoff = f2 ? (last ? -1 : F_S1 + ((i + 1) * 2) * 1024) : F_S2 + (i * 2) * 1024;
        const float* bias = (!f2 && conv) ? C.in[15] + j * 1024 : nullptr;
        const bf16_t* A = (const bf16_t*)(C.ws + (f2 ? WS_H : (conv ? WS_A2 : WS_GF)));
        const bf16_t* Bt = (const bf16_t*)(C.ws + (f2 ? WS_WF2 : WS_WA2));
        const int K = f2 ? DFF : (conv ? 1024 : 2048);
        const bool first = (i == 0 && !f2);
        EpiRes E{C.ws, C.out, first ? C.in[0] : (const float*)C.out, first ? C.in[2] : (const float*)(C.ws + WS_XCTX), bias, mgoff, snoff, stats};
        { pg8::Gemm g{A, Bt, T, 1024, K}; pg8::StaticOrder S; S.init(T, 1024, C.G, C.bid); EpiResBig EB{E};
          pg8::gemm_phase<EpiResBig, pg8::StaticOrder, true, true>(C.lds, g, S, EB); }
        if (!last) { __syncthreads(); sgemm_small(C, A, Bt, T, R - T, 1024, K, E, 0, 4); }
    }
}

#define XB_TMO      128
#define XB_XCNT(j)  (256  + 64 * (j))
#define XB_XSUB(j)  (1280 + 64 * (j))
#define XB_XGEN(j)  (2304 + 64 * (j))
#define XB_TOP      3328
#define XB_TOPGEN   3392
#define XCD_BAR_WORDS 3456
#define XB_SPIN_CAP (1u << 20)
__device__ __forceinline__ unsigned xb_ld(unsigned* p)              { return __hip_atomic_load(p, __ATOMIC_RELAXED, __HIP_MEMORY_SCOPE_AGENT); }
__device__ __forceinline__ unsigned xb_add(unsigned* p, unsigned v) { return __hip_atomic_fetch_add(p, v, __ATOMIC_RELAXED, __HIP_MEMORY_SCOPE_AGENT); }
__device__ __forceinline__ unsigned xb_xcc_id() { return (unsigned)__builtin_amdgcn_s_getreg((3 << 11) | 20) & 0xFu; }
#define XB_SPIN(cond, bar) do { unsigned _sp = 0; while (cond) { __builtin_amdgcn_s_sleep(1); \
    if ((++_sp & 255u) == 0u) { if (xb_ld(&(bar)[XB_TMO])) break; if (_sp > XB_SPIN_CAP) { atomicAdd(&(bar)[XB_TMO], 1u); break; } } } } while (0)
struct XcdBarrier { unsigned* bar; unsigned x; volatile LAS unsigned* st; };
__device__ __forceinline__ XcdBarrier xcd_barrier_post(unsigned* bar, volatile LAS unsigned* st) {
    XcdBarrier b; b.bar = bar; b.x = xb_xcc_id(); b.st = st;
    if (threadIdx.x == 0) (void)xb_add(&bar[XB_XCNT(b.x)], 1u);
    return b;
}
__device__ __forceinline__ void xcd_barrier_complete(unsigned* bar, unsigned x, unsigned& nloc, unsigned& nx) {
    const unsigned G = gridDim.x * gridDim.y * gridDim.z;
    unsigned sum, cnt, mine, sp = 0u;
    for (;;) {
        sum = 0u; cnt = 0u; mine = 0u;
#pragma unroll
        for (unsigned j = 0; j < 16; ++j) { const unsigned c = xb_ld(&bar[XB_XCNT(j)]); sum += c; cnt += (c > 0u) ? 1u : 0u; mine = (j == x) ? c : mine; }
        if (sum == G) break;
        __builtin_amdgcn_s_sleep(1);
        if ((++sp & 255u) == 0u) { if (xb_ld(&bar[XB_TMO])) break; if (sp > XB_SPIN_CAP) { atomicAdd(&bar[XB_TMO], 1u); break; } }
    }
    nloc = mine > 0u ? mine : 1u; nx = cnt > 0u ? cnt : 1u;
}
__device__ __forceinline__ void xcd_barrier(const XcdBarrier& b) {
    asm volatile("s_waitcnt vmcnt(0)" ::: "memory");
    __syncthreads();
    if (threadIdx.x == 0) {
        unsigned* bar = b.bar;
        __builtin_amdgcn_s_waitcnt(0);
        unsigned nloc = b.st[0], nx = b.st[1];
        if (nloc == 0u) { xcd_barrier_complete(bar, b.x, nloc, nx); b.st[0] = nloc; b.st[1] = nx; }
        const unsigned old = xb_add(&bar[XB_XSUB(b.x)], 1u);
        const unsigned gen = old / nloc;
        if (old + 1u == (gen + 1u) * nloc) {
            __builtin_amdgcn_fence(__ATOMIC_RELEASE, "agent");
            asm volatile("s_waitcnt vmcnt(0)" ::: "memory");
            const unsigned og = xb_add(&bar[XB_TOP], 1u);
            const unsigned tg = og / nx;
            if (og + 1u == (tg + 1u) * nx) xb_add(&bar[XB_TOPGEN], 1u);
            else XB_SPIN(xb_ld(&bar[XB_TOPGEN]) == tg, bar);
            __builtin_amdgcn_fence(__ATOMIC_ACQUIRE, "agent");
            xb_add(&bar[XB_XGEN(b.x)], 1u);
            asm volatile("s_waitcnt vmcnt(0)" ::: "memory");
        } else {
            XB_SPIN(xb_ld(&bar[XB_XGEN(b.x)]) == gen, bar);
            __builtin_amdgcn_fence(__ATOMIC_ACQUIRE, "agent");
            asm volatile("s_waitcnt vmcnt(0)" ::: "memory");
        }
    }
    __syncthreads();
}
constexpr int MISC_OFF = 131072 + 320;
constexpr int CW_BAR = 4096;

#ifndef PROBE_DUP
#define PROBE_DUP 0
#endif
#if ONE_LAUNCH
template <int PH> __device__ __forceinline__ void phase_body(Ctx& C) {
    constexpr int i = (PH - 2) / 7, sub = (PH - 2) % 7, j = i >> 1; constexpr bool conv = (i & 1) == 0;
    if (PH == 0) phase_p0(C);
    else if (PH == 1) phase_p1(C);
    else if (PH == 30) phase_final(C);
    else if (sub == 0) { }
    else if (sub == 2) { if (i > 0) { prep_layer(C, i, 2, 0); __syncthreads(); } if (conv) dwconv_phase(C, j); else scan_phase(C, j); }
    else if (sub == 3) readout_phase(C, j, i == DEPTH - 1);
    else run_phase(C, PH);
}
template <int PH> __device__ __forceinline__ void one_phase(Ctx& C, const Args& args, const XcdBarrier& bar) {
    if (PH < args.ph_lo || PH >= args.ph_hi) return;
    constexpr int i = (PH - 2) / 7, sub = (PH - 2) % 7; constexpr bool conv = (i & 1) == 0;
    if (PH >= 2 && PH < 30) { if (sub == 0) return; if (sub == 3 && conv) return; }
    if (PH > args.ph_lo) xcd_barrier(bar);
    phase_body<PH>(C);
    constexpr bool dup = ((PH >= 2 && PH < 30) && (((PROBE_DUP & 1) && (sub == 1 || sub == 5)) || ((PROBE_DUP & 2) && sub == 2 && !conv) || ((PROBE_DUP & 4) && sub == 2 && conv) || ((PROBE_DUP & 8) && sub == 0))) || ((PROBE_DUP & 16) && PH < 2);
    if constexpr (dup) { xcd_barrier(bar); phase_body<PH>(C); }
}
template <int... PHS> __device__ __forceinline__ void all_phases(Ctx& C, const Args& args, const XcdBarrier& bar, std::integer_sequence<int, PHS...>) { (one_phase<PHS>(C, args, bar), ...); }
__global__ void __launch_bounds__(512, 2) mega_kernel(Args args) {
    extern __shared__ __attribute__((aligned(16))) unsigned char lds_raw[];
    Ctx C;
    C.lds = (LAS unsigned char*)lds_raw; C.tid = threadIdx.x; C.lane = C.tid & 63; C.wave = __builtin_amdgcn_readfirstlane(C.tid >> 6); C.G = gridDim.x; C.bid = blockIdx.x;
    C.in = args.in; C.out = args.out; C.ws = args.ws;
    volatile LAS unsigned* MISC = (volatile LAS unsigned*)(C.lds + MISC_OFF);
    if (C.tid < 32) MISC[C.tid] = 0u;
    __syncthreads();
    XcdBarrier bar = xcd_barrier_post((unsigned*)(C.ws + WS_CTL) + CW_BAR, MISC + 8);
    all_phases(C, args, bar, std::make_integer_sequence<int, NPHASE>{});
}

#endif
template <int KIND>
__global__ void __launch_bounds__(512, 2) phase_kernel(Args args) {
    extern __shared__ __attribute__((aligned(16))) unsigned char lds_raw[];
    Ctx C;
    C.lds = (LAS unsigned char*)lds_raw; C.tid = threadIdx.x; C.lane = C.tid & 63; C.wave = __builtin_amdgcn_readfirstlane(C.tid >> 6); C.G = gridDim.x; C.bid = blockIdx.x;
    C.in = args.in; C.out = args.out; C.ws = args.ws;
    const int ph = args.ph_lo;
    if (KIND == 0) phase_p0(C);
    else if (KIND == 1) phase_p1(C);
    else if (KIND == 30) phase_final(C);
    else {
        const int i = (ph - 2) / 7, j = i >> 1; const bool conv = (i & 1) == 0;
        if (KIND == 2) { }
        else if (KIND == 4) { if (i > 0) { prep_layer(C, i, 2, 0); __syncthreads(); } if (conv) dwconv_phase(C, j); else scan_phase(C, j); }
        else if (KIND == 5) readout_phase(C, j, i == DEPTH - 1);
        else run_phase(C, ph);
    }
}

#ifndef PROBE_RD
#define PROBE_RD 0
#endif
#if PROBE_RD
__global__ void __launch_bounds__(512, 2) probe_read_kernel(Args args) {
    extern __shared__ __attribute__((aligned(16))) unsigned char lds_raw[];
    Ctx C;
    C.lds = (LAS unsigned char*)lds_raw; C.tid = threadIdx.x; C.lane = C.tid & 63; C.wave = __builtin_amdgcn_readfirstlane(C.tid >> 6); C.G = gridDim.x; C.bid = blockIdx.x;
    C.in = args.in; C.out = args.out; C.ws = args.ws;
    readout_phase<PROBE_RD>(C, 1, true);
}
#endif
extern "C" void kernel_launch(void* const* d_in, const int* in_sizes, int n_in, void* d_out, int out_size, void* d_ws, size_t ws_size, hipStream_t stream) {
    static int grid = 0;
    if (grid == 0) {
        if (n_in != 22 || out_size != T * D || ws_size < WS_END + (PROBE_RD ? 20 * MiB : 0)) { fprintf(stderr, "kernel_launch: unexpected problem (n_in %d out %d ws %zu, need %zu)\n", n_in, out_size, ws_size, (size_t)WS_END); grid = -1; return; }
        int dev = 0, cus = 0;
        if (hipGetDevice(&dev) != hipSuccess || hipDeviceGetAttribute(&cus, hipDeviceAttributeMultiprocessorCount, dev) != hipSuccess) { grid = -1; return; }
        bool ok = true;
        ok &= hipFuncSetAttribute((const void*)phase_kernel<0>, hipFuncAttributeMaxDynamicSharedMemorySize, LDS_BYTES) == hipSuccess;
        ok &= hipFuncSetAttribute((const void*)phase_kernel<1>, hipFuncAttributeMaxDynamicSharedMemorySize, LDS_BYTES) == hipSuccess;
        ok &= hipFuncSetAttribute((const void*)phase_kernel<2>, hipFuncAttributeMaxDynamicSharedMemorySize, LDS_BYTES) == hipSuccess;
        ok &= hipFuncSetAttribute((const void*)phase_kernel<3>, hipFuncAttributeMaxDynamicSharedMemorySize, LDS_BYTES) == hipSuccess;
        ok &= hipFuncSetAttribute((const void*)phase_kernel<4>, hipFuncAttributeMaxDynamicSharedMemorySize, LDS_BYTES) == hipSuccess;
        ok &= hipFuncSetAttribute((const void*)phase_kernel<5>, hipFuncAttributeMaxDynamicSharedMemorySize, LDS_BYTES) == hipSuccess;
        ok &= hipFuncSetAttribute((const void*)phase_kernel<30>, hipFuncAttributeMaxDynamicSharedMemorySize, LDS_BYTES) == hipSuccess;
#if ONE_LAUNCH
        ok &= hipFuncSetAttribute((const void*)mega_kernel, hipFuncAttributeMaxDynamicSharedMemorySize, LDS_BYTES) == hipSuccess;
#endif
        if (!ok) { fprintf(stderr, "kernel_launch: hipFuncSetAttribute failed\n"); grid = -1; return; }
        grid = cus > 0 ? cus : 256;
    }
    if (grid < 0) return;
    Args a{};
    for (int i = 0; i < 22; ++i) a.in[i] = (const float*)d_in[i];
    a.out = (float*)d_out; a.ws = (unsigned char*)d_ws;
#if ONE_LAUNCH
    if (hipMemsetAsync((char*)d_ws + WS_CTL, 0, 65536, stream) != hipSuccess) { fprintf(stderr, "kernel_launch: memset failed\n"); return; }
    a.ph_lo = 0; a.ph_hi = NPHASE;
    hipLaunchKernelGGL(mega_kernel, dim3(grid), dim3(512), LDS_BYTES, stream, a);
    return;
#endif
    for (int ph = 0; ph < NPHASE; ++ph) {
        const int i = (ph - 2) / 7, sub = (ph - 2) % 7;
        if (ph >= 2 && ph < 30) { if (sub == 0) continue; if (sub == 3 && (i & 1) == 0) continue; }
        a.ph_lo = ph; a.ph_hi = ph + 1;
        const dim3 g(grid), b(512);
        if (ph == 0) hipLaunchKernelGGL(phase_kernel<0>, g, b, LDS_BYTES, stream, a);
        else if (ph == 1) hipLaunchKernelGGL(phase_kernel<1>, g, b, LDS_BYTES, stream, a);
        else if (ph == 30) hipLaunchKernelGGL(phase_kernel<30>, g, b, LDS_BYTES, stream, a);
        else if (sub == 0) hipLaunchKernelGGL(phase_kernel<2>, g, b, LDS_BYTES, stream, a);
        else if (sub == 2) hipLaunchKernelGGL(phase_kernel<4>, g, b, LDS_BYTES, stream, a);
        else if (sub == 3) hipLaunchKernelGGL(phase_kernel<5>, g, b, LDS_BYTES, stream, a);
        else hipLaunchKernelGGL(phase_kernel<3>, g, b, LDS_BYTES, stream, a);
#ifdef PROBE_G
        if (ph == 30) { Args a2 = a; a2.ph_lo = PROBE_G; a2.ph_hi = PROBE_G + 1; hipLaunchKernelGGL(phase_kernel<3>, g, b, LDS_BYTES, stream, a2); }
#endif
#if PROBE_RD
        if (ph == 30) { hipFuncSetAttribute((const void*)probe_read_kernel, hipFuncAttributeMaxDynamicSharedMemorySize, LDS_BYTES); hipLaunchKernelGGL(probe_read_kernel, g, b, LDS_BYTES, stream, a); }
#endif
        {   const bool conv = (i & 1) == 0;
            const bool dup = ((ph >= 2 && ph < 30) && (((PROBE_DUP & 1) && (sub == 1 || sub == 5)) || ((PROBE_DUP & 2) && sub == 2 && !conv) || ((PROBE_DUP & 4) && sub == 2 && conv) || ((PROBE_DUP & 8) && sub == 0))) || ((PROBE_DUP & 16) && ph < 2);
            if (dup) {
                if (ph == 0) hipLaunchKernelGGL(phase_kernel<0>, g, b, LDS_BYTES, stream, a);
                else if (ph == 1) hipLaunchKernelGGL(phase_kernel<1>, g, b, LDS_BYTES, stream, a);
                else if (sub == 0) hipLaunchKernelGGL(phase_kernel<2>, g, b, LDS_BYTES, stream, a);
                else if (sub == 2) hipLaunchKernelGGL(phase_kernel<4>, g, b, LDS_BYTES, stream, a);
                else hipLaunchKernelGGL(phase_kernel<3>, g, b, LDS_BYTES, stream, a);
            } }
    }
}
```

```cpp
#include <hip/hip_runtime.h>
#include <cstdio>
#include <cstdint>
#include <utility>

#ifndef ONE_LAUNCH
#define ONE_LAUNCH 1
#endif

typedef unsigned short bf16_t;
typedef short bf16x8 __attribute__((ext_vector_type(8)));
typedef float f32x4 __attribute__((ext_vector_type(4)));
typedef float f32x2 __attribute__((ext_vector_type(2)));
typedef unsigned u32x2 __attribute__((ext_vector_type(2)));
typedef unsigned u32x4 __attribute__((ext_vector_type(4)));
typedef __bf16 bf16x2_t __attribute__((ext_vector_type(2)));
typedef short s16x4 __attribute__((ext_vector_type(4)));
#define LAS __attribute__((address_space(3)))

constexpr int D = 1024, T = 16384, TC = 256, R = T + TC, NH = 4, DK = 256, DV = 512, QKW = 1024, VW = 2048, INW = 8192, DFF = 2816, FF2 = 5632, CK = 31, DEPTH = 4;
constexpr int NSLOT = 33;
constexpr float NORM_EPS = 1e-6f, LN_EPS = 1e-5f;

constexpr size_t MiB = 1u << 20, KiB = 1u << 10;
constexpr size_t WS_CTL = 0, CTL_ZERO_BYTES = 1 * MiB;
constexpr size_t WS_MODV = 1 * MiB;
constexpr size_t WS_S1 = 1 * MiB + 256 * KiB;
constexpr size_t WS_S2 = 1 * MiB + 320 * KiB;
constexpr size_t WS_CVA = 1 * MiB + 384 * KiB;
constexpr size_t WS_CVF = 1 * MiB + 640 * KiB;
constexpr size_t WS_TABC = 1 * MiB + 832 * KiB;
constexpr size_t WS_TABS = 1 * MiB + 912 * KiB;
constexpr size_t WS_STATS = 2 * MiB;
constexpr size_t WS_XCTX = 4 * MiB;
constexpr size_t WS_WA = 8 * MiB;
constexpr size_t WS_WA2 = 24 * MiB;
constexpr size_t WS_WF1 = 28 * MiB;
constexpr size_t WS_WF2 = 40 * MiB;
constexpr size_t WS_XS = 48 * MiB;
constexpr size_t WS_SCP = 48 * MiB;
constexpr size_t WS_BIG = 114 * MiB;
constexpr size_t WS_Q = WS_BIG, WS_K = WS_BIG + 33 * MiB, WS_VT = WS_BIG + 66 * MiB, WS_GF = WS_BIG + 131 * MiB, WS_GB = WS_BIG + 196 * MiB;
constexpr size_t WS_U = WS_BIG, WS_A2 = WS_BIG + 33 * MiB, WS_H = WS_BIG;
constexpr size_t WS_END = WS_BIG + 261 * MiB;
static_assert((size_t)R * 1024 * 2 <= 33 * MiB && (size_t)R * 2048 * 2 <= 65 * MiB && (size_t)R * DFF * 2 <= 131 * MiB, "map");
static_assert((size_t)NSLOT * 8 * 512 * 256 * 2 <= 66 * MiB, "scp");

constexpr int LDS_BYTES = 147456;

__device__ __forceinline__ unsigned pk2(float lo, float hi) { f32x2 v = {lo, hi}; bf16x2_t b = __builtin_convertvector(v, bf16x2_t); return __builtin_bit_cast(unsigned, b); }
__device__ __forceinline__ float bflo(unsigned u) { return __uint_as_float(u << 16); }
__device__ __forceinline__ float bfhi(unsigned u) { return __uint_as_float(u & 0xffff0000u); }
__device__ __forceinline__ float sigmf(float x) { return __builtin_amdgcn_rcpf(1.f + __builtin_amdgcn_exp2f(-1.4426950408889634f * x)); }
__device__ __forceinline__ float siluf(float x) { return x * sigmf(x); }
__device__ __forceinline__ float wave_sum63(float v) {
    v += __builtin_bit_cast(float, __builtin_amdgcn_update_dpp(0, __builtin_bit_cast(int, v), 0xB1, 0xF, 0xF, false));
    v += __builtin_bit_cast(float, __builtin_amdgcn_update_dpp(0, __builtin_bit_cast(int, v), 0x4E, 0xF, 0xF, false));
    v += __builtin_bit_cast(float, __builtin_amdgcn_update_dpp(0, __builtin_bit_cast(int, v), 0x141, 0xF, 0xF, false));
    v += __builtin_bit_cast(float, __builtin_amdgcn_update_dpp(0, __builtin_bit_cast(int, v), 0x140, 0xF, 0xF, false));
    v += __builtin_bit_cast(float, __builtin_amdgcn_update_dpp(0, __builtin_bit_cast(int, v), 0x142, 0xA, 0xF, false));
    v += __builtin_bit_cast(float, __builtin_amdgcn_update_dpp(0, __builtin_bit_cast(int, v), 0x143, 0xC, 0xF, false));
    return v;
}
__device__ __forceinline__ int perm_glu(int n, int H) { if (n < H) return 32 * (n >> 4) + (n & 15); const int n2 = n - H; return 32 * (n2 >> 4) + 16 + (n2 & 15); }
__device__ __forceinline__ int perm_win(int n) {
    if (n >= 2 * QKW) return n;
    const int part = n >> 10, hn = n & 1023, h = hn >> 8, d = hn & 255, quarter = d >> 6, idx = d & 63;
    const int Gp = (quarter >> 1) * 4 + (idx >> 4), i = (quarter & 1) * 16 + (idx & 15);
    return part * 1024 + h * 256 + 32 * Gp + i;
}
__device__ __forceinline__ int perm_any(int mode, int n, int H) { return mode == 0 ? n : (mode == 1 ? perm_glu(n, H) : perm_win(n)); }

struct Args { const float* in[22]; float* out; unsigned char* ws; int ph_lo, ph_hi; };

struct Ctx {
    LAS unsigned char* lds;
    int tid, lane, wave, G, bid;
    const float* const* in; float* out; unsigned char* ws;
};

__device__ __forceinline__ void relane(Ctx& C) {
    int wv = C.wave; asm volatile("" : "+s"(wv)); int ln = (int)__builtin_amdgcn_mbcnt_hi(~0u, __builtin_amdgcn_mbcnt_lo(~0u, 0u)); asm volatile("" : "+v"(ln));
    C.wave = wv; C.lane = ln; C.tid = wv * 64 + ln;
}
template <int VSILU>
__device__ __forceinline__ void gemv2_unit(Ctx& C, const float* W, int N, int n0, const float* v0, const float* v1, const float* bias, float* o0, float* o1, int pmode, int H) {
    LAS float* red = (LAS float*)C.lds;
    const int c4 = C.tid & 15, ks = C.tid >> 4;
    f32x4 a0 = {0.f, 0.f, 0.f, 0.f}, a1 = {0.f, 0.f, 0.f, 0.f};
#pragma unroll 8
    for (int i = 0; i < 32; ++i) {
        const int k = ks * 32 + i;
        const f32x4 w = *(const f32x4*)(W + (size_t)k * N + n0 + 4 * c4);
        float x0 = v0[k], x1 = v1[k];
        if (VSILU) { x0 = siluf(x0); x1 = siluf(x1); }
        a0 += w * x0; a1 += w * x1;
    }
#pragma unroll
    for (int e = 0; e < 4; ++e) { red[(ks * 2 + 0) * 64 + 4 * c4 + e] = a0[e]; red[(ks * 2 + 1) * 64 + 4 * c4 + e] = a1[e]; }
    __syncthreads();
    if (C.tid < 128) {
        const int s = C.tid >> 6, col = C.tid & 63; float sum = 0.f;
#pragma unroll 8
        for (int k2 = 0; k2 < 32; ++k2) sum += red[(k2 * 2 + s) * 64 + col];
        const int n = n0 + col; if (bias) sum += bias[n];
        (s ? o1 : o0)[perm_any(pmode, n, H)] = sum;
    }
    __syncthreads();
}

struct PrepItem { const float* W; bf16_t* WT; int K, N, pmode, H, k0, n0; };
__device__ __forceinline__ bool prep_decode(Ctx& C, int i, int part, int it, PrepItem& P) {
    const int j = i >> 1; const bool conv = (i & 1) == 0;
    const int I_A = (part & 1) ? (conv ? 16 * 64 : 16 * 256) : 0, I_A2 = (part & 1) ? (conv ? 16 * 32 : 32 * 32) : 0, I_F1 = (part & 2) ? 16 * 176 : 0, I_F2 = (part & 2) ? 44 * 32 : 0;
    if (it >= I_A + I_A2 + I_F1 + I_F2) return false;
    int r = it;
    if (r < I_A) { if (conv) { P.W = C.in[8] + (size_t)j * 1024 * 2048; P.K = 1024; P.N = 2048; P.pmode = 1; P.H = 1024; } else { P.W = C.in[16] + (size_t)j * 1024 * 8192; P.K = 1024; P.N = 8192; P.pmode = 2; P.H = 0; }
                   P.WT = (bf16_t*)(C.ws + WS_WA); }
    else if ((r -= I_A) < I_A2) { if (conv) { P.W = C.in[14] + (size_t)j * 1024 * 1024; P.K = 1024; } else { P.W = C.in[18] + (size_t)j * 2048 * 1024; P.K = 2048; }
                   P.N = 1024; P.pmode = 0; P.H = 0; P.WT = (bf16_t*)(C.ws + WS_WA2); }
    else if ((r -= I_A2) < I_F1) { P.W = C.in[19] + (size_t)i * 1024 * FF2; P.K = 1024; P.N = FF2; P.pmode = 1; P.H = DFF; P.WT = (bf16_t*)(C.ws + WS_WF1); }
    else { r -= I_F1; P.W = C.in[20] + (size_t)i * DFF * 1024; P.K = DFF; P.N = 1024; P.pmode = 0; P.H = 0; P.WT = (bf16_t*)(C.ws + WS_WF2); }
    const int nblk = P.N / 32; P.k0 = 64 * (r / nblk); P.n0 = 32 * (r % nblk);
    return true;
}
__device__ __forceinline__ void prep_layer(Ctx& C, int i, int part, int cu_lo) {
    if (C.bid < cu_lo) return;
    LAS float* scr = (LAS float*)(C.lds + C.wave * 16384);
    const int gw = (C.bid - cu_lo) * 8 + C.wave, NGW = (C.G - cu_lo) * 8, lane = C.lane;
    PrepItem P, Pn; f32x4 v[8], vn[8];
    bool have = prep_decode(C, i, part, gw, P);
    if (have) {
#pragma unroll
        for (int q = 0; q < 8; ++q) v[q] = *(const f32x4*)(P.W + (size_t)(P.k0 + 8 * q + (lane >> 3)) * P.N + P.n0 + 4 * (lane & 7));
    }
    for (int it = gw; have; it += NGW) {
        const bool havn = prep_decode(C, i, part, it + NGW, Pn);
        if (havn) {
#pragma unroll
            for (int q = 0; q < 8; ++q) vn[q] = *(const f32x4*)(Pn.W + (size_t)(Pn.k0 + 8 * q + (lane >> 3)) * Pn.N + Pn.n0 + 4 * (lane & 7));
        }
#pragma unroll
        for (int q = 0; q < 8; ++q) { LAS float* d = scr + (8 * q + (lane >> 3)) * 33 + 4 * (lane & 7); d[0] = v[q][0]; d[1] = v[q][1]; d[2] = v[q][2]; d[3] = v[q][3]; }
        asm volatile("s_waitcnt lgkmcnt(0)" ::: "memory");
        const int c = lane & 7;
#pragma unroll
        for (int jj = 0; jj < 4; ++jj) { const int n = (lane >> 3) + 8 * jj; const LAS float* sp = scr + (8 * c) * 33 + n;
            u32x4 o; o.x = pk2(sp[0 * 33], sp[1 * 33]); o.y = pk2(sp[2 * 33], sp[3 * 33]); o.z = pk2(sp[4 * 33], sp[5 * 33]); o.w = pk2(sp[6 * 33], sp[7 * 33]);
            *(u32x4*)(P.WT + (size_t)perm_any(P.pmode, P.n0 + n, P.H) * P.K + P.k0 + 8 * c) = o; }
        asm volatile("s_waitcnt lgkmcnt(0)" ::: "memory");
        P = Pn; have = havn;
#pragma unroll
        for (int q = 0; q < 8; ++q) v[q] = vn[q];
    }
}

__device__ __forceinline__ float row_rs(const float* stats, int row, int fq) {
    const f32x4 p = *(const f32x4*)(stats + (size_t)row * 16 + 4 * fq);
    float s = (p[0] + p[1]) + (p[2] + p[3]);
    s += __shfl_xor(s, 16); s += __shfl_xor(s, 32);
    return 1.0f / sqrtf(s * (1.0f / 1024.0f) + NORM_EPS);
}
struct EpiGLU {
    static constexpr bool STATS = false, NEEDRS = true;
    unsigned char* ws; int cvoff  , cvstride  , outoff  , ldo, act;
    float* stats;
    __device__ __forceinline__ float row_begin(int row, int fq) const { return row_rs((const float*)(ws + WS_STATS), row, fq); }
    __device__ __forceinline__ float item(int row, int colp, f32x4 v0, f32x4 v1, float rs) const {
        const float* cv = (const float*)ws + cvoff + (row < T ? 0 : cvstride);
        const f32x4 ca = *(const f32x4*)(cv + colp), cg = *(const f32x4*)(cv + colp + 16);
        float o[4];
#pragma unroll
        for (int e = 0; e < 4; ++e) { const float a = rs * v0[e] + ca[e], g = rs * v1[e] + cg[e]; o[e] = act == 0 ? a * sigmf(g) : siluf(a) * g; }
        const int oc = (colp >> 5) * 16 + (colp & 15);
        u32x2 w; w.x = pk2(o[0], o[1]); w.y = pk2(o[2], o[3]);
        *(u32x2*)((bf16_t*)(ws + outoff) + (size_t)row * ldo + oc) = w;
        return 0.f;
    }
};
struct EpiRes {
    static constexpr bool STATS = true, NEEDRS = false;
    unsigned char* ws; float* xl; const float* xin  ; const float* cin  ; const float* bias;
    int mgoff  , snoff  ;
    float* stats;
    __device__ __forceinline__ float row_begin(int, int) const { return 1.f; }
    __device__ __forceinline__ float item(int row, int colp, f32x4 v0, f32x4 v1, float) const {
        const bool lat = row < T;
        float* xr = lat ? xl + (size_t)row * 1024 : (float*)(ws + WS_XCTX) + (size_t)(row - T) * 1024;
        const float* xi = lat ? xin + (size_t)row * 1024 : cin + (size_t)(row - T) * 1024;
        const float* mg = (const float*)ws + mgoff + (lat ? 0 : 6144); const float* sn = (const float*)ws + snoff + (lat ? 0 : 1024);
        bf16_t* xs = (bf16_t*)(ws + WS_XS);
        float ss = 0.f;
#pragma unroll
        for (int hlf = 0; hlf < 2; ++hlf) {
            const int c = colp + 16 * hlf; const f32x4 v = hlf ? v1 : v0;
            const f32x4 xo = *(const f32x4*)(xi + c), m4 = *(const f32x4*)(mg + c);
            f32x4 b4 = {0.f, 0.f, 0.f, 0.f}; if (bias) b4 = *(const f32x4*)(bias + c);
            const f32x4 xn = xo + m4 * (v + b4);
            *(f32x4*)(xr + c) = xn;
            ss += (xn[0] * xn[0] + xn[1] * xn[1]) + (xn[2] * xn[2] + xn[3] * xn[3]);
            if (snoff >= 0) { const f32x4 s4 = *(const f32x4*)(sn + c); u32x2 w; w.x = pk2(xn[0] * s4[0], xn[1] * s4[1]); w.y = pk2(xn[2] * s4[2], xn[3] * s4[3]);
                *(u32x2*)(xs + (size_t)row * 1024 + c) = w; }
        }
        return ss;
    }
};
struct EpiWin {
    static constexpr bool STATS = false, NEEDRS = true;
    unsigned char* ws; int cvoff;
    float* stats;
    __device__ __forceinline__ float row_begin(int row, int fq) const { return row_rs((const float*)(ws + WS_STATS), row, fq); }
    __device__ __forceinline__ float item(int row, int colp, f32x4 v0, f32x4 v1, float rs) const {
        const float* cv = (const float*)ws + cvoff + (row < T ? 0 : 8192);
        const f32x4 c0 = *(const f32x4*)(cv + colp), c1 = *(const f32x4*)(cv + colp + 16);
        f32x4 a = v0 * rs + c0, b = v1 * rs + c1;
        if (colp < 2048) {
            if (row < T) {
                const int Gp = (colp >> 5) & 7, idx0 = 16 * (Gp & 3) + (colp & 15);
                const int ti = (Gp >> 2) ? 256 + (row & 63) : (row >> 6);
                const f32x4 cs = *(const f32x4*)((const float*)(ws + WS_TABC) + ti * 64 + idx0), sn = *(const f32x4*)((const float*)(ws + WS_TABS) + ti * 64 + idx0);
                const f32x4 o1 = a * cs - b * sn, o2 = b * cs + a * sn; a = o1; b = o2;
            }
            bf16_t* dst = (bf16_t*)(ws + WS_Q);
            if (colp >= 1024) { dst = (bf16_t*)(ws + WS_K); a = a * 0.0625f; b = b * 0.0625f; }
            const int c = colp & 1023;
            u32x2 w; w.x = pk2(a[0], a[1]); w.y = pk2(a[2], a[3]); *(u32x2*)(dst + (size_t)row * 1024 + c) = w;
            w.x = pk2(b[0], b[1]); w.y = pk2(b[2], b[3]); *(u32x2*)(dst + (size_t)row * 1024 + c + 16) = w;
        } else if (colp < 4096) {
            const int c = colp - 2048;
            bf16_t* vt = (bf16_t*)(ws + WS_VT);
#pragma unroll
            for (int e = 0; e < 4; ++e) { vt[(size_t)(c + e) * R + row] = (bf16_t)(pk2(a[e], 0.f) & 0xffffu); vt[(size_t)(c + 16 + e) * R + row] = (bf16_t)(pk2(b[e], 0.f) & 0xffffu); }
        } else {
            bf16_t* dst = (bf16_t*)(ws + (colp < 6144 ? WS_GF : WS_GB)); const int c = (colp - 4096) & 2047;
            u32x2 w; w.x = pk2(a[0], a[1]); w.y = pk2(a[2], a[3]); *(u32x2*)(dst + (size_t)row * 2048 + c) = w;
            w.x = pk2(b[0], b[1]); w.y = pk2(b[2], b[3]); *(u32x2*)(dst + (size_t)row * 2048 + c + 16) = w;
        }
        return 0.f;
    }
};

namespace pg8 {
#define PG8_LAS __attribute__((address_space(3)))
typedef unsigned short bf16_t;
typedef short bf16x8 __attribute__((ext_vector_type(8)));
typedef float f32x4 __attribute__((ext_vector_type(4)));
typedef unsigned u32x4 __attribute__((ext_vector_type(4)));
constexpr int BM = 256, BK = 64, HALF = 128, HTB = HALF * BK * 2  , STAGE_BYTES = 8 * HTB, NXCD = 8, WGM = 8;

__host__ __device__ __forceinline__ int lds_byte(int r, int c) { const int st = (r >> 4) * 2 + (c >> 5), rr = r & 15, cc = c & 31, ob = rr * 64 + cc * 2; return st * 1024 + (ob ^ (((ob >> 9) & 1) << 5)); }
__host__ __device__ __forceinline__ void stage_rc(int b, int& R, int& C) { const int st = b / 1024, sb = b % 1024, swz = sb ^ (((sb >> 9) & 1) << 5); R = (st >> 1) * 16 + swz / 64; C = (st & 1) * 32 + (swz % 64) / 2; }
__host__ __device__ __forceinline__ int perm32(int rho) { const int n = rho >> 4, i = rho & 15; return 8 * (i >> 2) + 4 * n + (i & 3); }

struct Unit { int pm, pn; };
struct Gemm { const bf16_t* A; const bf16_t* Bt; int M, N, K; };

struct StaticOrder {
    int nM, nN, nwg, G, c;
    __host__ __device__ void init(int M, int N, int G_, int c_) { nM = M / BM; nN = N / BM; nwg = nM * nN; G = G_; c = c_; }
    __host__ __device__ bool next(int i, Unit& u) const {
        const long L = (long)i * G + c; if (L >= nwg) return false;
        int wgid = (int)L; { const int q = nwg / NXCD, r = nwg % NXCD, xcd = wgid % NXCD, off = wgid / NXCD; wgid = (xcd < r ? xcd * (q + 1) : r * (q + 1) + (xcd - r) * q) + off; }
        const int nig = WGM * nN, gid = wgid / nig, fm = gid * WGM, gsz = (nM - fm) < WGM ? (nM - fm) : WGM;
        u.pm = fm + ((wgid % nig) % gsz); u.pn = (wgid % nig) / gsz; return true;
    }
    __device__ __forceinline__ void a_ready(const Unit&) const {}
    __device__ __forceinline__ void done(const Unit&) const {}
};

template <class Epi, class Sched, bool ALIGN_EPI = false, bool SP2 = false, bool SWAPMMA = false>
__device__ __forceinline__ void gemm_phase(PG8_LAS unsigned char* lds, const Gemm g, const Sched& S, const Epi& E) {
    const int tid = threadIdx.x, wid = __builtin_amdgcn_readfirstlane(tid >> 6), lane = tid & 63, wr = wid >> 2, wc = wid & 3, fr = lane & 15, fq = lane >> 4;
    const int K = g.K, nt = K / BK;
    unsigned voffA[2], voffB[2];
#pragma unroll
    for (int i = 0; i < 2; ++i) { int R, C; stage_rc(tid * 16 + i * 8192, R, C); const int Rb = Epi::PERM ? ((R & ~31) + perm32(R & 31)) : R;
        voffA[i] = (unsigned)(R * K + C) * 2u; voffB[i] = (unsigned)(Rb * K + C) * 2u; }
    const size_t kstep = (size_t)(BK * 2);
    const size_t hstep = (size_t)HALF * K * 2;
    const size_t tstep = 2 * hstep;
    const unsigned ldsw = (unsigned)wid * 1024u;
    const int aoff = lds_byte(wr * 64 + fr, fq * 8), boff = lds_byte(wc * 32 + fr, fq * 8);
#define PG8_SA(b, h) (((b) * 2 + (h)) * HTB)
#define PG8_SB(b, h) ((4 + (b) * 2 + (h)) * HTB)
#define PG8_STAGE(bufoff, gbase, voff) do { _Pragma("unroll") for (int _i = 0; _i < 2; ++_i) \
        __builtin_amdgcn_global_load_lds((const unsigned*)((const char*)(gbase) + (voff)[_i]), (PG8_LAS unsigned*)(lds + (bufoff) + ldsw + _i * 8192), 16, 0, 0); } while (0)
#define PG8_LDA(dst, b, h) do { _Pragma("unroll") for (int m = 0; m < 4; ++m) _Pragma("unroll") for (int k = 0; k < 2; ++k) dst[m][k] = *(const PG8_LAS bf16x8*)(lds + PG8_SA(b, h) + aoff + m * 2048 + k * 1024); } while (0)
#define PG8_LDB(dst, b, h) do { _Pragma("unroll") for (int n = 0; n < 2; ++n) _Pragma("unroll") for (int k = 0; k < 2; ++k) dst[n][k] = *(const PG8_LAS bf16x8*)(lds + PG8_SB(b, h) + boff + n * 2048 + k * 1024); } while (0)
#define PG8_MMA(ai, bj, At, Bt) do { __builtin_amdgcn_s_setprio(1); _Pragma("unroll") for (int m = 0; m < 4; ++m) _Pragma("unroll") for (int n = 0; n < 2; ++n) _Pragma("unroll") for (int k = 0; k < 2; ++k) \
        acc[ai][bj][m][n] = SWAPMMA ? __builtin_amdgcn_mfma_f32_16x16x32_bf16(At[m][k], Bt[n][k], acc[ai][bj][m][n], 0, 0, 0) : __builtin_amdgcn_mfma_f32_16x16x32_bf16(Bt[n][k], At[m][k], acc[ai][bj][m][n], 0, 0, 0); __builtin_amdgcn_s_setprio(0); } while (0)
#define PG8_WAIT_V(n) asm volatile("s_waitcnt vmcnt(" #n ")" ::: "memory")
#define PG8_WAIT_L(n) asm volatile("s_waitcnt lgkmcnt(" #n ")" ::: "memory")
#define PG8_BAR __builtin_amdgcn_s_barrier()
#define PG8_SCHED __builtin_amdgcn_sched_barrier(0)
    Unit cur, nxt; int ui = 0;
    if (!S.next(0, cur)) return;
    f32x4 acc[2][2][4][2];
#pragma unroll
    for (int a = 0; a < 2; ++a)
#pragma unroll
        for (int b = 0; b < 2; ++b)
#pragma unroll
            for (int m = 0; m < 4; ++m)
#pragma unroll
                for (int n = 0; n < 2; ++n) acc[a][b][m][n] = (f32x4){0.f, 0.f, 0.f, 0.f};
    bf16x8 At[4][2], B0[2][2], B1[2][2];
    const char* cA = (const char*)g.A + (size_t)cur.pm * tstep; const char* cB = (const char*)g.Bt + (size_t)cur.pn * tstep;
    S.a_ready(cur);
    if constexpr (SP2) {
        PG8_STAGE(PG8_SB(0, 0), cB, voffB); PG8_STAGE(PG8_SB(0, 1), cB + hstep, voffB); PG8_STAGE(PG8_SA(0, 0), cA, voffA); PG8_STAGE(PG8_SA(0, 1), cA + hstep, voffA);
        if (wr == 1) PG8_BAR;
        PG8_WAIT_V(2); PG8_BAR;
        PG8_STAGE(PG8_SB(1, 0), cB + kstep, voffB); PG8_STAGE(PG8_SA(1, 0), cA + kstep, voffA); PG8_STAGE(PG8_SB(1, 1), cB + hstep + kstep, voffB);
        PG8_WAIT_V(6); PG8_BAR;
    } else {
        PG8_STAGE(PG8_SB(0, 0), cB, voffB); PG8_STAGE(PG8_SA(0, 0), cA, voffA); PG8_STAGE(PG8_SB(0, 1), cB + hstep, voffB); PG8_STAGE(PG8_SA(0, 1), cA + hstep, voffA);
        if (wr == 1) PG8_BAR;
        PG8_WAIT_V(4); PG8_BAR;
        PG8_STAGE(PG8_SB(1, 0), cB + kstep, voffB); PG8_STAGE(PG8_SA(1, 0), cA + kstep, voffA); PG8_STAGE(PG8_SB(1, 1), cB + hstep + kstep, voffB);
        PG8_WAIT_V(6); PG8_BAR;
    }
    for (;;) {
        const bool has_next = S.next(ui + 1, nxt);
        const char* nA = has_next ? (const char*)g.A + (size_t)nxt.pm * tstep : cA; const char* nB = has_next ? (const char*)g.Bt + (size_t)nxt.pn * tstep : cB;
        for (int t = 0; t < nt; t += 2) {
            const bool last = (t == nt - 2);
            const char* a1 = cA + (size_t)(t + 1) * kstep;
            const char* a2 = last ? nA : cA + (size_t)(t + 2) * kstep; const char* b2 = last ? nB : cB + (size_t)(t + 2) * kstep;
            const char* a3 = a2 + kstep; const char* b3 = b2 + kstep;
            if (last && has_next) S.a_ready(nxt);
            if constexpr (SP2) {
            PG8_LDB(B0, 0, 0); PG8_LDB(B1, 0, 1); PG8_SCHED; PG8_LDA(At, 0, 0); PG8_STAGE(PG8_SA(1, 1), a1 + hstep, voffA);
            PG8_WAIT_V(8); PG8_WAIT_L(0); PG8_BAR; PG8_MMA(0, 0, At, B0); PG8_MMA(0, 1, At, B1); PG8_BAR; PG8_SCHED;
            PG8_LDA(At, 0, 1); PG8_STAGE(PG8_SB(0, 0), b2, voffB); PG8_STAGE(PG8_SB(0, 1), b2 + hstep, voffB); PG8_STAGE(PG8_SA(0, 0), a2, voffA);
            PG8_WAIT_V(8); PG8_WAIT_L(0); PG8_BAR; PG8_MMA(1, 0, At, B0); PG8_MMA(1, 1, At, B1); PG8_BAR; PG8_SCHED;
            PG8_LDB(B0, 1, 0); PG8_LDB(B1, 1, 1); PG8_SCHED; PG8_LDA(At, 1, 0); PG8_STAGE(PG8_SA(0, 1), a2 + hstep, voffA);
            PG8_WAIT_V(8); PG8_WAIT_L(0); PG8_BAR; PG8_MMA(0, 0, At, B0); PG8_MMA(0, 1, At, B1); PG8_BAR; PG8_SCHED;
            PG8_LDA(At, 1, 1); PG8_STAGE(PG8_SB(1, 0), b3, voffB); PG8_STAGE(PG8_SB(1, 1), b3 + hstep, voffB); PG8_STAGE(PG8_SA(1, 0), a3, voffA);
            PG8_WAIT_V(8); PG8_WAIT_L(0); PG8_BAR; PG8_MMA(1, 0, At, B0); PG8_MMA(1, 1, At, B1); PG8_BAR; PG8_SCHED;
            } else {
            PG8_LDB(B0, 0, 0); PG8_SCHED; PG8_LDA(At, 0, 0); PG8_STAGE(PG8_SA(1, 1), a1 + hstep, voffA);
            PG8_WAIT_L(8); PG8_BAR; PG8_WAIT_L(0); PG8_MMA(0, 0, At, B0); PG8_BAR; PG8_SCHED;
            PG8_LDB(B1, 0, 1); PG8_STAGE(PG8_SB(0, 0), b2, voffB);
            PG8_BAR; PG8_WAIT_L(0); PG8_MMA(0, 1, At, B1); PG8_BAR;
            PG8_LDA(At, 0, 1); PG8_STAGE(PG8_SA(0, 0), a2, voffA);
            PG8_BAR; PG8_WAIT_L(0); PG8_MMA(1, 0, At, B0); PG8_BAR; PG8_SCHED;
            PG8_STAGE(PG8_SB(0, 1), b2 + hstep, voffB);
            PG8_WAIT_V(6); PG8_BAR; PG8_MMA(1, 1, At, B1); PG8_BAR;
            PG8_LDB(B0, 1, 0); PG8_SCHED; PG8_LDA(At, 1, 0); PG8_STAGE(PG8_SA(0, 1), a2 + hstep, voffA);
            PG8_WAIT_L(8); PG8_BAR; PG8_WAIT_L(0); PG8_MMA(0, 0, At, B0); PG8_BAR; PG8_SCHED;
            PG8_LDB(B1, 1, 1); PG8_STAGE(PG8_SB(1, 0), b3, voffB);
            PG8_BAR; PG8_WAIT_L(0); PG8_MMA(0, 1, At, B1); PG8_BAR;
            PG8_LDA(At, 1, 1); PG8_STAGE(PG8_SA(1, 0), a3, voffA);
            PG8_BAR; PG8_WAIT_L(0); PG8_MMA(1, 0, At, B0); PG8_BAR; PG8_SCHED;
            PG8_STAGE(PG8_SB(1, 1), b3 + hstep, voffB);
            PG8_WAIT_V(6); PG8_BAR; PG8_MMA(1, 1, At, B1); PG8_BAR;
            }
        }
        if constexpr (ALIGN_EPI) { if (wr == 0) PG8_BAR; }
        if constexpr (!Epi::AFTER_DRAIN) { E(acc, cur, wr, wc, fr, fq); S.done(cur); }
        if (!has_next) break;
#pragma unroll
        for (int a = 0; a < 2; ++a)
#pragma unroll
            for (int b = 0; b < 2; ++b)
#pragma unroll
                for (int m = 0; m < 4; ++m)
#pragma unroll
                    for (int n = 0; n < 2; ++n) acc[a][b][m][n] = (f32x4){0.f, 0.f, 0.f, 0.f};
        cur = nxt; cA = nA; cB = nB; ++ui;
        if constexpr (ALIGN_EPI) { if (wr == 1) PG8_BAR; }
    }
    PG8_WAIT_V(0);
    if constexpr (!ALIGN_EPI) { if (wr == 0) PG8_BAR; }
    PG8_BAR;
    if constexpr (Epi::AFTER_DRAIN) { E.fused(acc, cur, wr, wc, fr, fq, lds, wid, lane); S.done(cur); }
#undef PG8_SA
#undef PG8_SB
#undef PG8_STAGE
#undef PG8_LDA
#undef PG8_LDB
#undef PG8_MMA
#undef PG8_WAIT_V
#undef PG8_WAIT_L
#undef PG8_BAR
#undef PG8_SCHED
}
}

template <class E0> struct EpiAdapt {
    static constexpr bool PERM = false, AFTER_DRAIN = false;
    E0 e; int col_base;
    __device__ __forceinline__ void operator()(const pg8::f32x4 (&acc)[2][2][4][2], const pg8::Unit& u, int wr, int wc, int fr, int fq) const {
#pragma unroll
        for (int ai = 0; ai < 2; ++ai)
#pragma unroll
            for (int m = 0; m < 4; ++m) {
                const int row = u.pm * 256 + ai * 128 + wr * 64 + m * 16 + fr;
                const float rs = e.row_begin(row, fq);
                float ss = 0.f;
#pragma unroll
                for (int bj = 0; bj < 2; ++bj) ss += e.item(row, col_base + u.pn * 256 + bj * 128 + wc * 32 + 4 * fq, acc[ai][bj][m][0], acc[ai][bj][m][1], rs);
                if constexpr (E0::STATS) { ss += __shfl_xor(ss, 16); ss += __shfl_xor(ss, 32); if (fq == 0) e.stats[(size_t)row * 16 + (col_base >> 6) + u.pn * 4 + wc] = ss; }
            }
    }
};
struct EpiResBig {
    static constexpr bool PERM = false, AFTER_DRAIN = false;
    EpiRes e;
    __device__ __forceinline__ void operator()(const pg8::f32x4 (&acc)[2][2][4][2], const pg8::Unit& u, int wr, int wc, int fr, int fq) const {
        const float* mg = (const float*)e.ws + e.mgoff; const float* sn = (const float*)e.ws + e.snoff;
        bf16_t* xs = (bf16_t*)(e.ws + WS_XS);
        const int colb = u.pn * 256 + wc * 32 + 4 * fq;
#pragma unroll
        for (int aq = 0; aq < 4; ++aq) {
            const int ai = aq >> 1, mh = aq & 1;
            const int rowb = u.pm * 256 + ai * 128 + wr * 64 + fr + 32 * mh;
            f32x4 xo[2][2][2];
#pragma unroll
            for (int m = 0; m < 2; ++m)
#pragma unroll
                for (int bj = 0; bj < 2; ++bj)
#pragma unroll
                    for (int hl = 0; hl < 2; ++hl) xo[m][bj][hl] = *(const f32x4*)(e.xin + (size_t)(rowb + 16 * m) * 1024 + colb + 128 * bj + 16 * hl);
#pragma unroll
            for (int m = 0; m < 2; ++m) {
                const int row = rowb + 16 * m; float ss = 0.f;
#pragma unroll
                for (int bj = 0; bj < 2; ++bj)
#pragma unroll
                    for (int hl = 0; hl < 2; ++hl) {
                        const int c = colb + 128 * bj + 16 * hl;
                        const f32x4 m4 = *(const f32x4*)(mg + c);
                        f32x4 b4 = {0.f, 0.f, 0.f, 0.f}; if (e.bias) b4 = *(const f32x4*)(e.bias + c);
                        const f32x4 xn = xo[m][bj][hl] + m4 * (acc[ai][bj][2 * mh + m][hl] + b4);
                        *(f32x4*)(e.xl + (size_t)row * 1024 + c) = xn;
                        ss += (xn[0] * xn[0] + xn[1] * xn[1]) + (xn[2] * xn[2] + xn[3] * xn[3]);
                        if (e.snoff >= 0) { const f32x4 s4 = *(const f32x4*)(sn + c); u32x2 w; w.x = pk2(xn[0] * s4[0], xn[1] * s4[1]); w.y = pk2(xn[2] * s4[2], xn[3] * s4[3]);
                            *(u32x2*)(xs + (size_t)row * 1024 + c) = w; }
                    }
                ss += __shfl_xor(ss, 16); ss += __shfl_xor(ss, 32); if (fq == 0) e.stats[(size_t)row * 16 + u.pn * 4 + wc] = ss;
            }
        }
    }
};
struct EpiVt {
    static constexpr bool PERM = false, AFTER_DRAIN = false;
    unsigned char* ws; int cvoff;
    __device__ __forceinline__ void operator()(const pg8::f32x4 (&acc)[2][2][4][2], const pg8::Unit& u, int wr, int wc, int fr, int fq) const {
        bf16_t* vt = (bf16_t*)(ws + WS_VT);
#pragma unroll
        for (int ai = 0; ai < 2; ++ai)
#pragma unroll
            for (int m = 0; m < 4; ++m) {
                const int rowb = u.pm * 256 + ai * 128 + wr * 64 + m * 16;
                const float rsl = row_rs((const float*)(ws + WS_STATS), rowb + fr, fq);
                float rsv[4];
#pragma unroll
                for (int e = 0; e < 4; ++e) rsv[e] = __shfl(rsl, 4 * fq + e);
                const float* cv = (const float*)ws + cvoff + (rowb < T ? 0 : 8192);
#pragma unroll
                for (int bj = 0; bj < 2; ++bj)
#pragma unroll
                    for (int n = 0; n < 2; ++n) {
                        const int col = 2048 + u.pn * 256 + bj * 128 + wc * 32 + 16 * n + fr;
                        const float c0 = cv[col]; const pg8::f32x4 a = acc[ai][bj][m][n];
                        u32x2 w; w.x = pk2(a[0] * rsv[0] + c0, a[1] * rsv[1] + c0); w.y = pk2(a[2] * rsv[2] + c0, a[3] * rsv[3] + c0);
                        *(u32x2*)(vt + (size_t)(col - 2048) * R + rowb + 4 * fq) = w;
                    }
            }
    }
};
template <class Epi>
__device__ __forceinline__ void sgemm_small(Ctx& C, const bf16_t* A, const bf16_t* Bt, int row_lo, int Mrows, int N, int K, const Epi& E, int n_lo, int n_hi) {
    const int kh = C.wave >> 2, wc = C.wave & 3, fr = C.lane & 15, fq = C.lane >> 4;
    const int nM = Mrows / 16, nN = n_hi - n_lo, nU = nM * nN, Kh = K >> 1;
    LAS f32x4* xch = (LAS f32x4*)C.lds;
    for (int u = (C.G - 1 - C.bid); u < nU; u += C.G) {
        const int un = n_lo + u / nM, um = u % nM;
        const int row0 = row_lo + 16 * um, col0 = 256 * un;
        f32x4 acc[2][2];
#pragma unroll
        for (int b = 0; b < 2; ++b)
#pragma unroll
            for (int n = 0; n < 2; ++n) acc[b][n] = (f32x4){0.f, 0.f, 0.f, 0.f};
        const bf16_t* ap = A + (size_t)(row0 + fr) * K + kh * Kh + 8 * fq;
        const bf16_t* bp = Bt + (size_t)(col0 + 32 * wc + fr) * K + kh * Kh + 8 * fq;
#pragma unroll 4
        for (int k0 = 0; k0 < Kh; k0 += 32) {
            bf16x8 bf[2][2];
            const bf16x8 af = *(const bf16x8*)(ap + k0);
#pragma unroll
            for (int bj = 0; bj < 2; ++bj)
#pragma unroll
                for (int n = 0; n < 2; ++n) bf[bj][n] = *(const bf16x8*)(bp + (size_t)(128 * bj + 16 * n) * K + k0);
#pragma unroll
            for (int bj = 0; bj < 2; ++bj)
#pragma unroll
                for (int n = 0; n < 2; ++n) acc[bj][n] = __builtin_amdgcn_mfma_f32_16x16x32_bf16(bf[bj][n], af, acc[bj][n], 0, 0, 0);
        }
        if (kh == 1) {
#pragma unroll
            for (int bj = 0; bj < 2; ++bj)
#pragma unroll
                for (int n = 0; n < 2; ++n) xch[(wc * 4 + bj * 2 + n) * 64 + C.lane] = acc[bj][n];
        }
        __syncthreads();
        if (kh == 0) {
#pragma unroll
            for (int bj = 0; bj < 2; ++bj)
#pragma unroll
                for (int n = 0; n < 2; ++n) acc[bj][n] += xch[(wc * 4 + bj * 2 + n) * 64 + C.lane];
            const int row = row0 + fr;
            const float rs = E.row_begin(row, fq);
            float ss = 0.f;
#pragma unroll
            for (int bj = 0; bj < 2; ++bj) ss += E.item(row, col0 + 128 * bj + 32 * wc + 4 * fq, acc[bj][0], acc[bj][1], rs);
            if constexpr (Epi::STATS) { ss += __shfl_xor(ss, 16); ss += __shfl_xor(ss, 32); if (fq == 0) E.stats[(size_t)row * 16 + un * 4 + wc] = ss; }
        }
        __syncthreads();
    }
}
template <class E0>
__device__ __forceinline__ void gemm_both(Ctx& C, const bf16_t* A, const bf16_t* Bt, int Mbig, int N, int K, const E0& E, int ctx_n_lo, int ctx_n_hi, int nb_lo = 0, int nb_hi = -1) {
    if (nb_hi < 0) nb_hi = N / 256;
    { pg8::Gemm g{A, Bt + (size_t)nb_lo * 256 * K, Mbig, (nb_hi - nb_lo) * 256, K}; pg8::StaticOrder S; S.init(Mbig, (nb_hi - nb_lo) * 256, C.G, C.bid); EpiAdapt<E0> EA{E, nb_lo * 256};
      pg8::gemm_phase<EpiAdapt<E0>, pg8::StaticOrder, true, true>(C.lds, g, S, EA); }
    if (Mbig < R && ctx_n_hi > ctx_n_lo) { __syncthreads(); relane(C); sgemm_small(C, A, Bt, T, R - T, N, K, E, ctx_n_lo, ctx_n_hi); }
}
__device__ __forceinline__ void dwconv_phase(Ctx& C, int j) {
    const bf16_t* U = (const bf16_t*)(C.ws + WS_U); bf16_t* A2 = (bf16_t*)(C.ws + WS_A2);
    const float* dww = C.in[10] + (size_t)j * CK * 1024; const float* dwb = C.in[11] + j * 1024; const float* lng = C.in[12] + j * 1024; const float* lnb = C.in[13] + j * 1024;
    constexpr int TT = 33, NR = TT + 30;
    LAS unsigned char* tile = C.lds; LAS float* part = (LAS float*)(C.lds + NR * 2048);
    const int tid = C.tid;
    constexpr int NUL = (T + TT - 1) / TT, NUC = (TC + TT - 1) / TT;
    f32x2 wt[CK];
#pragma unroll
    for (int jt = 0; jt < CK; ++jt) wt[jt] = *(const f32x2*)(dww + jt * 1024 + 2 * tid);
    const f32x2 b2 = *(const f32x2*)(dwb + 2 * tid), g2 = *(const f32x2*)(lng + 2 * tid), bb2 = *(const f32x2*)(lnb + 2 * tid);
    for (int u = C.bid; u < NUL + NUC; u += C.G) {
        const bool lat = u < NUL; const int base = lat ? 0 : T, n = lat ? T : TC, t0 = TT * (lat ? u : u - NUL);
        const int nv = (n - t0) < TT ? (n - t0) : TT;
        for (int idx = tid; idx < NR * 128; idx += 512) {
            const int rr = idx >> 7, ch = idx & 127, tt = t0 - 15 + rr;
            u32x4 v = {0u, 0u, 0u, 0u};
            if (tt >= 0 && tt < n) v = *(const u32x4*)(U + (size_t)(base + tt) * 1024 + ch * 8);
            *(LAS u32x4*)(tile + rr * 2048 + ch * 16) = v;
        }
        __syncthreads();
        f32x2 o[TT];
#pragma unroll
        for (int t = 0; t < TT; ++t) o[t] = b2;
#pragma unroll
        for (int hb = 0; hb < 3; ++hb) {
            f32x2 xw[41];
#pragma unroll
            for (int r = 0; r < 41; ++r) { const unsigned uu = *(const LAS unsigned*)(tile + (11 * hb + r) * 2048 + tid * 4); xw[r] = (f32x2){bflo(uu), bfhi(uu)}; }
#pragma unroll
            for (int t = 0; t < 11; ++t)
#pragma unroll
                for (int jt = 0; jt < CK; ++jt) o[11 * hb + t] += wt[jt] * xw[t + jt];
        }
#pragma unroll
        for (int t = 0; t < TT; ++t) {
            const float s = wave_sum63(o[t].x + o[t].y), q = wave_sum63(o[t].x * o[t].x + o[t].y * o[t].y);
            if (C.lane == 63) { part[(t * 8 + C.wave) * 2] = s; part[(t * 8 + C.wave) * 2 + 1] = q; }
        }
        __syncthreads();
#pragma unroll
        for (int t = 0; t < TT; ++t) {
            float s = 0.f, q = 0.f;
#pragma unroll
            for (int w = 0; w < 8; ++w) { s += part[(t * 8 + w) * 2]; q += part[(t * 8 + w) * 2 + 1]; }
            const float mean = s * (1.f / 1024.f), var = q * (1.f / 1024.f) - mean * mean, rstd = 1.0f / sqrtf(var + LN_EPS);
            const float y0 = (o[t].x - mean) * rstd * g2.x + bb2.x, y1 = (o[t].y - mean) * rstd * g2.y + bb2.y;
            if (t < nv) *(unsigned*)(A2 + (size_t)(base + t0 + t) * 1024 + 2 * tid) = pk2(siluf(y0), siluf(y1));
        }
        __syncthreads();
    }
}

__device__ __forceinline__ void scan_phase(Ctx& C, int j) {
    const bf16_t* Kb = (const bf16_t*)(C.ws + WS_K); const bf16_t* Vt = (const bf16_t*)(C.ws + WS_VT); bf16_t* Scp = (bf16_t*)(C.ws + WS_SCP);
    constexpr int SLOT = 32768;
    const int fr = C.lane & 15, fq = C.lane >> 4, w = C.wave, lane = C.lane;
    for (int cu = C.bid; cu < 256; cu += C.G) {
        const int hd = cu & 7, sidx = cu >> 3, h = hd >> 1, dir = hd & 1, dk_s = 64 * ((sidx >> 3) & 3), dv_s = 64 * (sidx & 7);
        const float gam = 1.0f - exp2f(C.in[17][(j * 2 + dir) * 4 + h]); const float L = log2f(gam);
        const float cdec = exp2f(L * 128.f);
        const bf16_t* ksrc[2]; const bf16_t* vsrc[2];
#pragma unroll
        for (int p = 0; p < 2; ++p) {
            const int kr = 8 * (2 * w + p) + (lane >> 3), kpos = lane & 7, kc = kpos ^ (((kr >> 3) & 1) << 1) ^ (((kr >> 1) & 1) << 2);
            ksrc[p] = Kb + (size_t)kr * 1024 + h * 256 + dk_s + 8 * kc;
            const int vr = 4 * (2 * w + p) + (lane >> 4), vpos = lane & 15, vc = vpos ^ (vr & 15);
            vsrc[p] = Vt + (size_t)(h * 512 + dv_s + vr) * R + 8 * vc;
        }
        auto tok_of = [&](int st) { const int sc = st < 129 ? st : 129; const int bl = sc < 2 ? (dir == 0 ? sc : 1 - sc) : (dir == 0 ? sc - 2 : 129 - sc); return (sc < 2 ? T : 0) + 128 * bl; };
#define SCAN_DMA(st) do { const int tok_ = tok_of(st); LAS unsigned char* sl_ = C.lds + ((st) & 3) * SLOT + (2 * w) * 1024; \
        __builtin_amdgcn_global_load_lds((const unsigned*)(ksrc[0] + (size_t)tok_ * 1024), (LAS unsigned*)(sl_), 16, 0, 0); \
        __builtin_amdgcn_global_load_lds((const unsigned*)(ksrc[1] + (size_t)tok_ * 1024), (LAS unsigned*)(sl_ + 1024), 16, 0, 0); \
        __builtin_amdgcn_global_load_lds((const unsigned*)(vsrc[0] + tok_), (LAS unsigned*)(sl_ + 16384), 16, 0, 0); \
        __builtin_amdgcn_global_load_lds((const unsigned*)(vsrc[1] + tok_), (LAS unsigned*)(sl_ + 16384 + 1024), 16, 0, 0); } while (0)
        const int mt = w >> 1, nh = w & 1, dkl = 16 * mt;
        const int trq = (fr >> 2), trp = fr & 3, trrow0 = 8 * fq + trq;
        const int trcol0 = (((2 * mt + (trp >> 1)) ^ ((fq & 1) << 1) ^ (((trq >> 1) & 1) << 2)) << 3) + 4 * (trp & 1);
        float kd[4][8];
#pragma unroll
        for (int ks = 0; ks < 4; ++ks)
#pragma unroll
            for (int e = 0; e < 8; ++e) { const int tl = 32 * ks + 8 * fq + e; kd[ks][e] = exp2f(L * (float)(dir == 0 ? 127 - tl : tl)); }
        int voff[2];
#pragma unroll
        for (int nt = 0; nt < 2; ++nt) { const int vr = 32 * nh + 16 * nt + fr; voff[nt] = 16384 + vr * 256; }
        f32x4 acc[2]; acc[0] = (f32x4){0.f, 0.f, 0.f, 0.f}; acc[1] = acc[0];
        const unsigned lds0 = (unsigned)(size_t)C.lds;
        __syncthreads();
        SCAN_DMA(0); SCAN_DMA(1); SCAN_DMA(2);
#pragma unroll 1
        for (int st = 0; st < 130; ++st) {
            asm volatile("s_waitcnt vmcnt(8)" ::: "memory");
            __builtin_amdgcn_s_barrier(); asm volatile("" ::: "memory");
            SCAN_DMA(st + 3);
            {   const bool isctx = st < 2; const int bl = isctx ? (dir == 0 ? st : 1 - st) : (dir == 0 ? st - 2 : 129 - st);
                const bool cp = dir == 0 ? ((bl & 3) == 0) : (isctx ? bl == 1 : (bl & 3) == 3);
                if (cp) {
                    const int slot = isctx ? 32 : (bl >> 2);
                    bf16_t* sp = Scp + ((size_t)((slot * 4 + h) * 2 + dir) * 512) * 256;
#pragma unroll
                    for (int nt = 0; nt < 2; ++nt) { u32x2 wv; wv.x = pk2(acc[nt][0], acc[nt][1]); wv.y = pk2(acc[nt][2], acc[nt][3]);
                        *(u32x2*)(sp + (size_t)(dv_s + 32 * nh + 16 * nt + fr) * 256 + dk_s + dkl + 4 * fq) = wv; }
                } }
            acc[0] = acc[0] * cdec; acc[1] = acc[1] * cdec;
            const unsigned sl = lds0 + (unsigned)((st & 3) * SLOT);
            u32x2 klo[4], khi[4]; u32x4 vfr[4][2];
#pragma unroll
            for (int ks = 0; ks < 4; ++ks) {
                const unsigned ka = sl + (unsigned)(((32 * ks + trrow0) * 64 + trcol0) * 2);
                asm volatile("ds_read_b64_tr_b16 %0, %1" : "=v"(klo[ks]) : "v"(ka));
                asm volatile("ds_read_b64_tr_b16 %0, %1 offset:512" : "=v"(khi[ks]) : "v"(ka));
#pragma unroll
                for (int nt = 0; nt < 2; ++nt) { const int vr = 32 * nh + 16 * nt + fr;
                    const unsigned va = sl + (unsigned)(voff[nt] + (((4 * ks + fq) ^ (vr & 15)) << 4));
                    asm volatile("ds_read_b128 %0, %1" : "=v"(vfr[ks][nt]) : "v"(va)); }
            }
            asm volatile("s_waitcnt lgkmcnt(0)" : "+v"(klo[0]), "+v"(klo[1]), "+v"(klo[2]), "+v"(klo[3]), "+v"(khi[0]), "+v"(khi[1]), "+v"(khi[2]), "+v"(khi[3]) :: "memory");
            asm volatile("" : "+v"(vfr[0][0]), "+v"(vfr[0][1]), "+v"(vfr[1][0]), "+v"(vfr[1][1]), "+v"(vfr[2][0]), "+v"(vfr[2][1]), "+v"(vfr[3][0]), "+v"(vfr[3][1]));
            __builtin_amdgcn_sched_barrier(0);
#pragma unroll
            for (int ks = 0; ks < 4; ++ks) {
                u32x4 pk;
                pk.x = pk2(bflo(klo[ks].x) * kd[ks][0], bfhi(klo[ks].x) * kd[ks][1]);
                pk.y = pk2(bflo(klo[ks].y) * kd[ks][2], bfhi(klo[ks].y) * kd[ks][3]);
                pk.z = pk2(bflo(khi[ks].x) * kd[ks][4], bfhi(khi[ks].x) * kd[ks][5]);
                pk.w = pk2(bflo(khi[ks].y) * kd[ks][6], bfhi(khi[ks].y) * kd[ks][7]);
                const bf16x8 af = __builtin_bit_cast(bf16x8, pk);
#pragma unroll
                for (int nt = 0; nt < 2; ++nt) acc[nt] = __builtin_amdgcn_mfma_f32_16x16x32_bf16(af, __builtin_bit_cast(bf16x8, vfr[ks][nt]), acc[nt], 0, 0, 0);
            }
        }
        asm volatile("s_waitcnt vmcnt(0)" ::: "memory");
        __syncthreads();
#undef SCAN_DMA
    }
}

__device__ __forceinline__ void ugemm_phase(Ctx& C, int j) {
    const bf16_t* Kb = (const bf16_t*)(C.ws + WS_K); const bf16_t* Vt = (const bf16_t*)(C.ws + WS_VT); bf16_t* Scp = (bf16_t*)(C.ws + WS_SCP);
    constexpr int SLOT = 65536;
    const int fr = C.lane & 15, fq = C.lane >> 4, w = C.wave, lane = C.lane;
    const int wm = w >> 1, wn = w & 1;
    const unsigned lds0 = (unsigned)(size_t)C.lds;
    for (int it0 = 0; it0 < 3; ++it0) {
        int set, sub;
        if (it0 < 2) { const int x = C.bid & 7, ii = (C.bid & 255) >> 3; if (C.G != 256 && C.bid >= 256) break; set = it0 * 64 + x * 8 + (ii >> 2); sub = ii & 3; if (C.G != 256) { const int itx = it0 * 256 + C.bid; set = itx >> 2; sub = itx & 3; } }
        else { const int k = C.G - 1 - C.bid; if (k >= 16) break; set = 128 + (k >> 2); sub = k & 3; }
        const int slot = set >> 2, h = set & 3, dir = sub >> 1, dvh = sub & 1;
        const int ntok = slot < 32 ? 512 : 256, tokb = slot < 32 ? 512 * slot : T, nst = ntok / 64;
        const float gam = 1.0f - exp2f(C.in[17][(j * 2 + dir) * 4 + h]); const float L = log2f(gam);
        unsigned ksrc[4], vsrc[4];
#pragma unroll
        for (int p = 0; p < 4; ++p) {
            const int kr = 2 * (4 * w + p) + (lane >> 5), kpos = lane & 31, kc = kpos ^ ((((kr & 3) | (((kr >> 3) & 1) << 2))) << 1);
            ksrc[p] = (unsigned)((tokb + kr) * 1024 + h * 256 + 8 * kc);
            const int vr = 8 * (4 * w + p) + (lane >> 3), vpos = lane & 7, vc = vpos ^ ((vr >> 1) & 7);
            vsrc[p] = (unsigned)((h * 512 + 256 * dvh + vr) * R + tokb + 8 * vc);
        }
#define UG_DMA(st) do { const int s_ = (st) < nst ? (st) : nst - 1; LAS unsigned char* sl_ = C.lds + ((st) & 1) * SLOT + (4 * w) * 1024; \
        _Pragma("unroll") for (int p = 0; p < 4; ++p) { \
            __builtin_amdgcn_global_load_lds((const unsigned*)(Kb + (ksrc[p] + (unsigned)(64 * s_ * 1024))), (LAS unsigned*)(sl_ + p * 1024), 16, 0, 0); \
            __builtin_amdgcn_global_load_lds((const unsigned*)(Vt + (vsrc[p] + (unsigned)(64 * s_))), (LAS unsigned*)(sl_ + 32768 + p * 1024), 16, 0, 0); } } while (0)
        const int trq = fr >> 2, trp = fr & 3;
        const int row0 = 8 * fq + trq;
        const unsigned a0 = (unsigned)(row0 * 512 + (((8 * wm + (trp >> 1)) ^ ((((row0 & 3) | (((row0 >> 3) & 1) << 2))) << 1)) << 4) + 8 * (trp & 1));
        const unsigned boff0 = (unsigned)(32768 + (128 * wn + fr) * 128);
        float kd[8];
#pragma unroll
        for (int e = 0; e < 8; ++e) { const int tl = 8 * fq + e; kd[e] = exp2f(L * (float)(dir == 0 ? 31 - tl : tl)); }
        const float kstep = exp2f(L * 32.f);
        f32x4 acc[4][8];
#pragma unroll
        for (int mt = 0; mt < 4; ++mt)
#pragma unroll
            for (int nt = 0; nt < 8; ++nt) acc[mt][nt] = (f32x4){0.f, 0.f, 0.f, 0.f};
        __syncthreads();
        UG_DMA(0);
#pragma unroll 1
        for (int st = 0; st < nst; ++st) {
            asm volatile("s_waitcnt vmcnt(0)" ::: "memory");
            __builtin_amdgcn_s_barrier(); asm volatile("" ::: "memory");
            UG_DMA(st + 1);
            const float sf0 = exp2f(L * (float)(dir == 0 ? ntok - 64 - 64 * st : 64 * st));
            const unsigned sl = lds0 + (unsigned)((st & 1) * SLOT);
#pragma unroll
            for (int ks = 0; ks < 2; ++ks) {
                const float sf = (dir == 0 ? (ks == 0 ? sf0 * kstep : sf0) : (ks == 0 ? sf0 : sf0 * kstep));
                u32x2 alo[4], ahi[4]; u32x4 bfv[4];
#pragma unroll
                for (int mt = 0; mt < 4; ++mt) {
                    const unsigned aa = sl + (a0 ^ (unsigned)(mt << 5)) + (unsigned)(ks * 16384);
                    asm volatile("ds_read_b64_tr_b16 %0, %1" : "=v"(alo[mt]) : "v"(aa));
                    asm volatile("ds_read_b64_tr_b16 %0, %1 offset:2048" : "=v"(ahi[mt]) : "v"(aa));
                }
                const unsigned ba = sl + boff0 + (unsigned)((((4 * ks + fq) ^ ((fr >> 1) & 7))) << 4);
#pragma unroll
                for (int nt = 0; nt < 4; ++nt) asm volatile("ds_read_b128 %0, %1 offset:%c2" : "=v"(bfv[nt]) : "v"(ba), "i"(nt * 2048));
                asm volatile("s_waitcnt lgkmcnt(0)" : "+v"(alo[0]), "+v"(alo[1]), "+v"(alo[2]), "+v"(alo[3]), "+v"(ahi[0]), "+v"(ahi[1]), "+v"(ahi[2]), "+v"(ahi[3]) :: "memory");
                asm volatile("" : "+v"(bfv[0]), "+v"(bfv[1]), "+v"(bfv[2]), "+v"(bfv[3]));
                __builtin_amdgcn_sched_barrier(0);
                bf16x8 af[4];
#pragma unroll
                for (int mt = 0; mt < 4; ++mt) {
                    u32x4 pk;
                    pk.x = pk2(bflo(alo[mt].x) * (kd[0] * sf), bfhi(alo[mt].x) * (kd[1] * sf));
                    pk.y = pk2(bflo(alo[mt].y) * (kd[2] * sf), bfhi(alo[mt].y) * (kd[3] * sf));
                    pk.z = pk2(bflo(ahi[mt].x) * (kd[4] * sf), bfhi(ahi[mt].x) * (kd[5] * sf));
                    pk.w = pk2(bflo(ahi[mt].y) * (kd[6] * sf), bfhi(ahi[mt].y) * (kd[7] * sf));
                    af[mt] = __builtin_bit_cast(bf16x8, pk);
                }
#pragma unroll
                for (int mt = 0; mt < 4; ++mt)
#pragma unroll
                    for (int nt = 0; nt < 4; ++nt) acc[mt][nt] = __builtin_amdgcn_mfma_f32_16x16x32_bf16(af[mt], __builtin_bit_cast(bf16x8, bfv[nt]), acc[mt][nt], 0, 0, 0);
                __builtin_amdgcn_sched_barrier(0);
#pragma unroll
                for (int nt = 0; nt < 4; ++nt) asm volatile("ds_read_b128 %0, %1 offset:%c2" : "=v"(bfv[nt]) : "v"(ba), "i"((nt + 4) * 2048));
                asm volatile("s_waitcnt lgkmcnt(0)" : "+v"(bfv[0]), "+v"(bfv[1]), "+v"(bfv[2]), "+v"(bfv[3]) :: "memory");
                __builtin_amdgcn_sched_barrier(0);
#pragma unroll
                for (int mt = 0; mt < 4; ++mt)
#pragma unroll
                    for (int nt = 0; nt < 4; ++nt) acc[mt][nt + 4] = __builtin_amdgcn_mfma_f32_16x16x32_bf16(af[mt], __builtin_bit_cast(bf16x8, bfv[nt]), acc[mt][nt + 4], 0, 0, 0);
            }
        }
        asm volatile("s_waitcnt vmcnt(0)" ::: "memory");
        bf16_t* sp = Scp + ((size_t)((slot * 4 + h) * 2 + dir) * 512) * 256;
#pragma unroll
        for (int nt = 0; nt < 8; ++nt) {
            bf16_t* rowp = sp + (size_t)(256 * dvh + 128 * wn + 16 * nt + fr) * 256 + 64 * wm + 4 * fq;
#pragma unroll
            for (int mt = 0; mt < 4; ++mt) { u32x2 wv; wv.x = pk2(acc[mt][nt][0], acc[mt][nt][1]); wv.y = pk2(acc[mt][nt][2], acc[mt][nt][3]); *(u32x2*)(rowp + 16 * mt) = wv; }
        }
        __syncthreads();
#undef UG_DMA
    }
}
__device__ __forceinline__ void prefix_phase(Ctx& C, int j) {
    bf16_t* Scp = (bf16_t*)(C.ws + WS_SCP);
    constexpr size_t SSTR = (size_t)8 * 512 * 256;
    for (int idx = C.bid * 512 + C.tid; idx < 8 * 512 * 32; idx += C.G * 512) {
        const int hd = idx >> 14, h = hd >> 1, dir = hd & 1;
        const float gam = 1.0f - exp2f(C.in[17][(j * 2 + dir) * 4 + h]); const float cdec = exp2f(log2f(gam) * 512.f);
        bf16_t* p = Scp + (size_t)idx * 8;
        const u32x4 raw = *(const u32x4*)(p + 32 * SSTR);
        float s[8] = {bflo(raw.x), bfhi(raw.x), bflo(raw.y), bfhi(raw.y), bflo(raw.z), bfhi(raw.z), bflo(raw.w), bfhi(raw.w)};
        *(u32x4*)(p + 32 * SSTR) = (u32x4){0u, 0u, 0u, 0u};
#pragma unroll 1
        for (int qb = 0; qb < 4; ++qb) {
            u32x4 u[8];
#pragma unroll
            for (int q = 0; q < 8; ++q) { const int g = dir == 0 ? 8 * qb + q : 31 - (8 * qb + q); u[q] = *(const u32x4*)(p + (size_t)g * SSTR); }
#pragma unroll
            for (int q = 0; q < 8; ++q) {
                const int g = dir == 0 ? 8 * qb + q : 31 - (8 * qb + q);
                u32x4 o; o.x = pk2(s[0], s[1]); o.y = pk2(s[2], s[3]); o.z = pk2(s[4], s[5]); o.w = pk2(s[6], s[7]);
                *(u32x4*)(p + (size_t)g * SSTR) = o;
                s[0] = s[0] * cdec + bflo(u[q].x); s[1] = s[1] * cdec + bfhi(u[q].x); s[2] = s[2] * cdec + bflo(u[q].y); s[3] = s[3] * cdec + bfhi(u[q].y);
                s[4] = s[4] * cdec + bflo(u[q].z); s[5] = s[5] * cdec + bfhi(u[q].z); s[6] = s[6] * cdec + bflo(u[q].w); s[7] = s[7] * cdec + bfhi(u[q].w);
            }
        }
    }
}

template <int MT, int PV = 0>
__device__ __forceinline__ void readout_units(Ctx& C, int j) {
    const bf16_t* Q = (const bf16_t*)(C.ws + WS_Q); const bf16_t* Kb = (const bf16_t*)(C.ws + WS_K); const bf16_t* Vt = (const bf16_t*)(C.ws + WS_VT);
    const bf16_t* Scp = (const bf16_t*)(C.ws + WS_SCP); bf16_t* GF = (bf16_t*)(C.ws + WS_GF); const bf16_t* GB = (const bf16_t*)(C.ws + WS_GB);
    constexpr int QP = 264, PP = 136;
    constexpr int NROW = 16 * MT;
    LAS bf16_t* Qs = (LAS bf16_t*)C.lds;
    LAS bf16_t* P = (LAS bf16_t*)(C.lds + NROW * QP * 2);
    LAS float* red = (LAS float*)(C.lds + NROW * QP * 2 + NROW * PP * 2);
    const int w = C.wave, tid = C.tid;
    const int nunits = MT == 8 ? 512 : 32;
    for (int u0 = (MT == 8 ? C.bid : C.G - 1 - C.bid); u0 < nunits; u0 += C.G) {
        int h, b, sb = 0;
        if (MT != 8) { h = u0 & 3; sb = (u0 >> 2) & 3; b = 128 + (u0 >> 4); }
        else if (C.G == 256) { const int r = u0 >> 8, x = u0 & 7, idx = (u0 & 255) >> 3, grp = r * 64 + x * 8 + (idx >> 2); h = grp & 3; b = (grp >> 2) * 4 + (idx & 3); }
        else { h = u0 & 3; b = u0 >> 2; }
        const bool lat = b < 128; const int base = lat ? 0 : T, nb = lat ? 128 : 2, bl = lat ? b : b - 128;
        const int g = bl >> 2, slot = lat ? g : 32;
        const int gend = (4 * (g + 1) < nb ? 4 * (g + 1) : nb);
        const int i0 = base + 128 * bl + NROW * sb, il0 = 128 * bl + NROW * sb;
#pragma unroll
        for (int i = 0; i < MT; ++i) { const int c = tid + 512 * i, row = c >> 5, ch = c & 31;
            *(LAS u32x4*)(Qs + row * QP + 8 * ch) = *(const u32x4*)(Q + (size_t)(i0 + row) * 1024 + h * 256 + 8 * ch); }
        __syncthreads();
#pragma unroll 1
        for (int dir = 0; dir < 2; ++dir) {
            int lane_o = C.lane; asm volatile("" : "+v"(lane_o));
            const int fr = lane_o & 15, fq = lane_o >> 4;
            const float gam = 1.0f - exp2f(C.in[17][(j * 2 + dir) * 4 + h]); const float L = log2f(gam);
            f32x4 acc[MT][4];
#pragma unroll
            for (int mt = 0; mt < MT; ++mt)
#pragma unroll
                for (int nt = 0; nt < 4; ++nt) acc[mt][nt] = (f32x4){0.f, 0.f, 0.f, 0.f};
            const int kb_lo = dir == 0 ? 4 * g : bl, kb_hi = dir == 0 ? bl : gend - 1;
            const bf16_t* sb = Scp + ((size_t)((slot * 4 + h) * 2 + dir) * 512) * 256 + (size_t)(64 * w + 16 * (fr >> 2) + (fr & 3)) * 256 + 8 * fq;
#pragma unroll 1
            for (int kq = 0; kq < 4; ++kq) {
                bf16x8 sf[2][4];
#pragma unroll
                for (int k2 = 0; k2 < 2; ++k2)
#pragma unroll
                    for (int nt = 0; nt < 4; ++nt) sf[k2][nt] = *(const bf16x8*)(sb + (size_t)(4 * nt) * 256 + 32 * (2 * kq + k2));
#pragma unroll
                for (int k2 = 0; k2 < 2; ++k2)
#pragma unroll
                    for (int mt = 0; mt < MT; ++mt) { const bf16x8 qf = *(const LAS bf16x8*)(Qs + (16 * mt + fr) * QP + 32 * (2 * kq + k2) + 8 * fq);
#pragma unroll
                        for (int nt = 0; nt < 4; ++nt) acc[mt][nt] = __builtin_amdgcn_mfma_f32_16x16x32_bf16(sf[k2][nt], qf, acc[mt][nt], 0, 0, 0); }
            }
#pragma unroll
            for (int mt = 0; mt < MT; ++mt) {
                const int il = il0 + 16 * mt + fr;
                const int ex = dir == 0 ? il - 512 * g + 1 : gend * 128 - il;
                const float qd = __builtin_amdgcn_exp2f(L * (float)ex);
#pragma unroll
                for (int nt = 0; nt < 4; ++nt) acc[mt][nt] = acc[mt][nt] * qd;
            }
#pragma unroll 1
            for (int kb = kb_lo; kb <= (PV == 2 ? kb_lo - 1 : kb_hi); ++kb) {
                const int j0 = base + 128 * kb;
                {
                    bf16x8 kf[8];
                    const bf16_t* k1 = Kb + (size_t)(j0 + 16 * w + fr) * 1024 + h * 256 + 8 * fq;
#pragma unroll
                    for (int ks = 0; ks < 8; ++ks) kf[ks] = *(const bf16x8*)(k1 + 32 * ks);
                    f32x4 sc[MT];
#pragma unroll
                    for (int mt = 0; mt < MT; ++mt) sc[mt] = (f32x4){0.f, 0.f, 0.f, 0.f};
#pragma unroll
                    for (int ks = 0; ks < 8; ++ks) {
#pragma unroll
                        for (int mt = 0; mt < MT; ++mt) { const bf16x8 qf = *(const LAS bf16x8*)(Qs + (16 * mt + fr) * QP + 32 * ks + 8 * fq);
                            sc[mt] = __builtin_amdgcn_mfma_f32_16x16x32_bf16(kf[ks], qf, sc[mt], 0, 0, 0); }
                        __builtin_amdgcn_sched_barrier(0);
                    }
#pragma unroll
                    for (int mt = 0; mt < MT; ++mt) {
                        const int il = il0 + 16 * mt + fr;
                        float p[4];
#pragma unroll
                        for (int e = 0; e < 4; ++e) { const int jl = 128 * kb + 16 * w + 4 * fq + e; const int rel = dir == 0 ? il - jl : jl - il;
                            p[e] = rel >= 0 ? sc[mt][e] * __builtin_amdgcn_exp2f(L * (float)rel) : 0.f; }
                        u32x2 wv; wv.x = pk2(p[0], p[1]); wv.y = pk2(p[2], p[3]);
                        *(LAS u32x2*)(P + (16 * mt + fr) * PP + 16 * w + 4 * fq) = wv;
                    }
                }
                __syncthreads();
                const bf16_t* vb = Vt + (size_t)(h * 512 + 64 * w + 16 * (fr >> 2) + (fr & 3)) * R + j0 + 8 * fq;
#pragma unroll 1
                for (int kh2 = 0; kh2 < 2; ++kh2) {
                    bf16x8 vf[2][4];
#pragma unroll
                    for (int k2 = 0; k2 < 2; ++k2)
#pragma unroll
                        for (int nt = 0; nt < 4; ++nt) vf[k2][nt] = *(const bf16x8*)(vb + (size_t)(4 * nt) * R + 32 * (2 * kh2 + k2));
#pragma unroll
                    for (int k2 = 0; k2 < 2; ++k2)
#pragma unroll
                        for (int mt = 0; mt < MT; ++mt) { const bf16x8 pf = *(const LAS bf16x8*)(P + (16 * mt + fr) * PP + 32 * (2 * kh2 + k2) + 8 * fq);
#pragma unroll
                            for (int nt = 0; nt < 4; ++nt) acc[mt][nt] = __builtin_amdgcn_mfma_f32_16x16x32_bf16(vf[k2][nt], pf, acc[mt][nt], 0, 0, 0); }
                }
                __syncthreads();
            }
#pragma unroll
            for (int mt = 0; mt < MT; ++mt) {
                float ss = 0.f;
#pragma unroll
                for (int nt = 0; nt < 4; ++nt) ss += (acc[mt][nt][0] * acc[mt][nt][0] + acc[mt][nt][1] * acc[mt][nt][1]) + (acc[mt][nt][2] * acc[mt][nt][2] + acc[mt][nt][3] * acc[mt][nt][3]);
                ss += __shfl_xor(ss, 16); ss += __shfl_xor(ss, 32);
                if (fq == 0) red[(16 * mt + fr) * 8 + w] = ss;
            }
            const size_t off0 = (size_t)(i0 + fr) * 2048 + h * 512 + 64 * w + 16 * fq;
            u32x4 gld[MT][2];
#pragma unroll
            for (int mt = 0; mt < MT; ++mt)
#pragma unroll
                for (int np = 0; np < 2; ++np) gld[mt][np] = *(const u32x4*)((dir == 0 ? (const bf16_t*)GF : GB) + off0 + (size_t)(16 * mt) * 2048 + 8 * np);
            __syncthreads();
#pragma unroll
            for (int mt = 0; mt < MT; ++mt) {
                float tot = 0.f;
#pragma unroll
                for (int w2 = 0; w2 < 8; ++w2) tot += red[(16 * mt + fr) * 8 + w2];
                const float rn = 1.0f / sqrtf(tot * (1.f / 512.f) + NORM_EPS);
#pragma unroll
                for (int np = 0; np < 2; ++np) {
                    const u32x4 g4 = gld[mt][np];
                    acc[mt][2 * np][0] *= siluf(bflo(g4.x)) * rn; acc[mt][2 * np][1] *= siluf(bfhi(g4.x)) * rn;
                    acc[mt][2 * np][2] *= siluf(bflo(g4.y)) * rn; acc[mt][2 * np][3] *= siluf(bfhi(g4.y)) * rn;
                    acc[mt][2 * np + 1][0] *= siluf(bflo(g4.z)) * rn; acc[mt][2 * np + 1][1] *= siluf(bfhi(g4.z)) * rn;
                    acc[mt][2 * np + 1][2] *= siluf(bflo(g4.w)) * rn; acc[mt][2 * np + 1][3] *= siluf(bfhi(g4.w)) * rn;
                }
            }
            if (dir == 1) {
#pragma unroll
                for (int mt = 0; mt < MT; ++mt)
#pragma unroll
                    for (int np = 0; np < 2; ++np) gld[mt][np] = *(const u32x4*)(GF + off0 + (size_t)(16 * mt) * 2048 + 8 * np);
#pragma unroll
                for (int mt = 0; mt < MT; ++mt)
#pragma unroll
                    for (int np = 0; np < 2; ++np) { const u32x4 yp = gld[mt][np];
                        acc[mt][2 * np][0] += bflo(yp.x); acc[mt][2 * np][1] += bfhi(yp.x); acc[mt][2 * np][2] += bflo(yp.y); acc[mt][2 * np][3] += bfhi(yp.y);
                        acc[mt][2 * np + 1][0] += bflo(yp.z); acc[mt][2 * np + 1][1] += bfhi(yp.z); acc[mt][2 * np + 1][2] += bflo(yp.w); acc[mt][2 * np + 1][3] += bfhi(yp.w); }
            }
            if (PV != 4) {
#pragma unroll
                for (int mt = 0; mt < MT; ++mt)
#pragma unroll
                    for (int np = 0; np < 2; ++np) { u32x4 wv; wv.x = pk2(acc[mt][2 * np][0], acc[mt][2 * np][1]); wv.y = pk2(acc[mt][2 * np][2], acc[mt][2 * np][3]);
                        wv.z = pk2(acc[mt][2 * np + 1][0], acc[mt][2 * np + 1][1]); wv.w = pk2(acc[mt][2 * np + 1][2], acc[mt][2 * np + 1][3]);
                        *(u32x4*)(GF + off0 + (size_t)(16 * mt) * 2048 + 8 * np) = wv; }
            }
        }
        __syncthreads();
    }
}

template <int PV = 0>
__device__ __forceinline__ void readout_phase(Ctx& C, int j, bool skip_ctx) {
    readout_units<8, PV>(C, j);
    if (!skip_ctx) { __syncthreads(); readout_units<2, PV>(C, j); }
}

__device__ __forceinline__ void phase_p0(Ctx& C) {
    float* modv = (float*)(C.ws + WS_MODV);
    for (int u = C.bid; u < 384; u += C.G) {
        const int i = u / 96, nbk = u % 96;
        gemv2_unit<1>(C, C.in[4] + (size_t)i * 1024 * 6144, 6144, 64 * nbk, C.in[1], C.in[3], C.in[5] + i * 6144, modv + (i * 2 + 0) * 6144, modv + (i * 2 + 1) * 6144, 0, 0);
    }
    float* tabc = (float*)(C.ws + WS_TABC); float* tabs = (float*)(C.ws + WS_TABS);
    for (int idx = C.bid * 512 + C.tid; idx < 320 * 64; idx += C.G * 512) {
        const int ti = idx >> 6, i = idx & 63; const float pos = (float)(ti < 256 ? ti : ti - 256);
        const float inv = exp2f(-(float)i * (13.287712379549449f / 64.0f)); const float ang = pos * inv;
        tabc[idx] = __cosf(ang); tabs[idx] = __sinf(ang);
    }
}
__device__ __forceinline__ void phase_p1(Ctx& C) {
    const float* modv = (const float*)(C.ws + WS_MODV);
    float* s1 = (float*)(C.ws + WS_S1); float* s2 = (float*)(C.ws + WS_S2);
    for (int idx = C.bid * 512 + C.tid; idx < 8192; idx += C.G * 512) {
        const int i = idx >> 11, s = (idx >> 10) & 1, k = idx & 1023;
        s1[idx] = C.in[6][i * 1024 + k] * (1.f + modv[(i * 2 + s) * 6144 + 1024 + k]);
        s2[idx] = C.in[7][i * 1024 + k] * (1.f + modv[(i * 2 + s) * 6144 + 4096 + k]);
    }
    float* cvA = (float*)(C.ws + WS_CVA); float* cvF = (float*)(C.ws + WS_CVF);
    for (int u = C.bid; u < 672; u += C.G) {
        if (u < 320) {
            int i, nbk; if (u < 32) { i = 0; nbk = u; } else if (u < 160) { i = 1; nbk = u - 32; } else if (u < 192) { i = 2; nbk = u - 160; } else { i = 3; nbk = u - 192; }
            const int j = i >> 1; const float* v0 = modv + (i * 2 + 0) * 6144; const float* v1 = modv + (i * 2 + 1) * 6144;
            if ((i & 1) == 0) gemv2_unit<0>(C, C.in[8] + (size_t)j * 1024 * 2048, 2048, 64 * nbk, v0, v1, C.in[9] + j * 2048, cvA + (i * 2) * 8192, cvA + (i * 2 + 1) * 8192, 1, 1024);
            else gemv2_unit<0>(C, C.in[16] + (size_t)j * 1024 * 8192, 8192, 64 * nbk, v0, v1, nullptr, cvA + (i * 2) * 8192, cvA + (i * 2 + 1) * 8192, 2, 0);
        } else {
            const int i = (u - 320) / 88, nbk = (u - 320) % 88;
            const float* v0 = modv + (i * 2 + 0) * 6144 + 3072; const float* v1 = modv + (i * 2 + 1) * 6144 + 3072;
            gemv2_unit<0>(C, C.in[19] + (size_t)i * 1024 * FF2, FF2, 64 * nbk, v0, v1, nullptr, cvF + (i * 2) * FF2, cvF + (i * 2 + 1) * FF2, 1, DFF);
        }
    }
    bf16_t* xs = (bf16_t*)(C.ws + WS_XS); float* stats = (float*)(C.ws + WS_STATS); float* xctx = (float*)(C.ws + WS_XCTX);
    for (int row = C.bid * 8 + C.wave; row < R; row += C.G * 8) {
        const bool lat = row < T; const int s = lat ? 0 : 1;
        const float* src = lat ? C.in[0] + (size_t)row * 1024 : C.in[2] + (size_t)(row - T) * 1024;
        float ss = 0.f;
#pragma unroll
        for (int jj = 0; jj < 4; ++jj) {
            const int k = 4 * C.lane + 256 * jj;
            const f32x4 v = *(const f32x4*)(src + k);
            ss += (v[0] * v[0] + v[1] * v[1]) + (v[2] * v[2] + v[3] * v[3]);
            const f32x4 g = *(const f32x4*)(C.in[6] + k), m = *(const f32x4*)(modv + s * 6144 + 1024 + k);
            u32x2 w; w.x = pk2(v[0] * g[0] * (1.f + m[0]), v[1] * g[1] * (1.f + m[1])); w.y = pk2(v[2] * g[2] * (1.f + m[2]), v[3] * g[3] * (1.f + m[3]));
            *(u32x2*)(xs + (size_t)row * 1024 + k) = w;
        }
#pragma unroll
        for (int off = 1; off < 64; off <<= 1) ss += __shfl_xor(ss, off);
        if (C.lane < 16) stats[(size_t)row * 16 + C.lane] = C.lane == 0 ? ss : 0.f;
    }
    prep_layer(C, 0, 3, 0);
}
__device__ __forceinline__ void phase_final(Ctx& C) {
    const float* stats = (const float*)(C.ws + WS_STATS);
    for (int row = C.bid * 8 + C.wave; row < T; row += C.G * 8) {
        float s = C.lane < 16 ? stats[(size_t)row * 16 + C.lane] : 0.f;
#pragma unroll
        for (int off = 1; off < 64; off <<= 1) s += __shfl_xor(s, off);
        const float r = 1.0f / sqrtf(s * (1.f / 1024.f) + NORM_EPS);
        float* xr = C.out + (size_t)row * 1024;
#pragma unroll
        for (int jj = 0; jj < 4; ++jj) { const int k = 4 * C.lane + 256 * jj; const f32x4 v = *(const f32x4*)(xr + k), g = *(const f32x4*)(C.in[21] + k); *(f32x4*)(xr + k) = v * r * g; }
    }
}

constexpr int NPHASE = 31;
__device__ __forceinline__ void run_phase(Ctx& C, int ph) {
    const int i = (ph - 2) / 7, sub = (ph - 2) % 7, j = i >> 1; const bool conv = (i & 1) == 0;
    const bool last = i == DEPTH - 1;
    float* stats = (float*)(C.ws + WS_STATS);
    const bf16_t* xs = (const bf16_t*)(C.ws + WS_XS);
    constexpr int F_MODV = (int)(WS_MODV / 4), F_S1 = (int)(WS_S1 / 4), F_S2 = (int)(WS_S2 / 4), F_CVA = (int)(WS_CVA / 4), F_CVF = (int)(WS_CVF / 4);
    if (sub == 0) {
        if (conv) { EpiGLU E{C.ws, F_CVA + (i * 2) * 8192, 8192, (int)WS_U, 1024, 0, stats}; gemm_both(C, xs, (const bf16_t*)(C.ws + WS_WA), T, 2048, 1024, E, 0, 8); }
        else {
            EpiWin E{C.ws, F_CVA + (i * 2) * 8192, stats};
            const bf16_t* WA = (const bf16_t*)(C.ws + WS_WA);
            gemm_both(C, xs, WA, T, 8192, 1024, E, 0, 0, 0, 8);
            { pg8::Gemm g{xs, WA + (size_t)2048 * 1024, T, 2048, 1024}; pg8::StaticOrder S; S.init(T, 2048, C.G, C.bid); EpiVt EV{C.ws, F_CVA + (i * 2) * 8192};
              pg8::gemm_phase<EpiVt, pg8::StaticOrder, true, true, true>(C.lds, g, S, EV); }
            gemm_both(C, xs, WA, T, 8192, 1024, E, last ? 4 : 0, last ? 16 : 32, 16, 32);
        }
    } else if (sub == 5) {
        EpiGLU E{C.ws, F_CVF + (i * 2) * FF2, FF2, (int)WS_H, DFF, 1, stats}; gemm_both(C, xs, (const bf16_t*)(C.ws + WS_WF1), last ? T : R, FF2, 1024, E, 0, 0);
        if (!last) { __syncthreads(); relane(C); prep_layer(C, i + 1, 1, C.G == 256 ? 150 : 0); }
    } else {
        const bool f2 = sub == 6;
        const int mgoff = F_MODV + (i * 2) * 6144 + (f2 ? 5120 : 2048);
        const int snoff = f2 ? (last ? -1 : F_S1 + ((i + 1) * 2) * 1024) : F_S2 + (i * 2) * 1024;
        const float* bias = (!f2 && conv) ? C.in[15] + j * 1024 : nullptr;
        const bf16_t* A = (const bf16_t*)(C.ws + (f2 ? WS_H : (conv ? WS_A2 : WS_GF)));
        const bf16_t* Bt = (const bf16_t*)(C.ws + (f2 ? WS_WF2 : WS_WA2));
        const int K = f2 ? DFF : (conv ? 1024 : 2048);
        const bool first = (i == 0 && !f2);
        EpiRes E{C.ws, C.out, first ? C.in[0] : (const float*)C.out, first ? C.in[2] : (const float*)(C.ws + WS_XCTX), bias, mgoff, snoff, stats};
        { pg8::Gemm g{A, Bt, T, 1024, K}; pg8::StaticOrder S; S.init(T, 1024, C.G, C.bid); EpiResBig EB{E};
          pg8::gemm_phase<EpiResBig, pg8::StaticOrder, true, true>(C.lds, g, S, EB); }
        if (!last) { __syncthreads(); relane(C); sgemm_small(C, A, Bt, T, R - T, 1024, K, E, 0, 4); }
    }
}

#define XB_TMO      128
#define XB_XCNT(j)  (256  + 64 * (j))
#define XB_XSUB(j)  (1280 + 64 * (j))
#define XB_XGEN(j)  (2304 + 64 * (j))
#define XB_TOP      3328
#define XB_TOPGEN   3392
#define XCD_BAR_WORDS 3456
#define XB_SPIN_CAP (1u << 20)
__device__ __forceinline__ unsigned xb_ld(unsigned* p)              { return __hip_atomic_load(p, __ATOMIC_RELAXED, __HIP_MEMORY_SCOPE_AGENT); }
__device__ __forceinline__ unsigned xb_add(unsigned* p, unsigned v) { return __hip_atomic_fetch_add(p, v, __ATOMIC_RELAXED, __HIP_MEMORY_SCOPE_AGENT); }
__device__ __forceinline__ unsigned xb_xcc_id() { return (unsigned)__builtin_amdgcn_s_getreg((3 << 11) | 20) & 0xFu; }
#define XB_SPIN(cond, bar) do { unsigned _sp = 0; while (cond) { __builtin_amdgcn_s_sleep(1); \
    if ((++_sp & 255u) == 0u) { if (xb_ld(&(bar)[XB_TMO])) break; if (_sp > XB_SPIN_CAP) { atomicAdd(&(bar)[XB_TMO], 1u); break; } } } } while (0)
struct XcdBarrier { unsigned* bar; unsigned x; volatile LAS unsigned* st; };
__device__ __forceinline__ XcdBarrier xcd_barrier_post(unsigned* bar, volatile LAS unsigned* st) {
    XcdBarrier b; b.bar = bar; b.x = xb_xcc_id(); b.st = st;
    if (threadIdx.x == 0) (void)xb_add(&bar[XB_XCNT(b.x)], 1u);
    return b;
}
__device__ __forceinline__ void xcd_barrier_complete(unsigned* bar, unsigned x, unsigned& nloc, unsigned& nx) {
    const unsigned G = gridDim.x * gridDim.y * gridDim.z;
    unsigned sum, cnt, mine, sp = 0u;
    for (;;) {
        sum = 0u; cnt = 0u; mine = 0u;
#pragma unroll
        for (unsigned j = 0; j < 16; ++j) { const unsigned c = xb_ld(&bar[XB_XCNT(j)]); sum += c; cnt += (c > 0u) ? 1u : 0u; mine = (j == x) ? c : mine; }
        if (sum == G) break;
        __builtin_amdgcn_s_sleep(1);
        if ((++sp & 255u) == 0u) { if (xb_ld(&bar[XB_TMO])) break; if (sp > XB_SPIN_CAP) { atomicAdd(&bar[XB_TMO], 1u); break; } }
    }
    nloc = mine > 0u ? mine : 1u; nx = cnt > 0u ? cnt : 1u;
}
__device__ __forceinline__ void xcd_barrier(const XcdBarrier& b) {
    asm volatile("s_waitcnt vmcnt(0)" ::: "memory");
    __syncthreads();
    if (threadIdx.x == 0) {
        unsigned* bar = b.bar;
        __builtin_amdgcn_s_waitcnt(0);
        unsigned nloc = b.st[0], nx = b.st[1];
        if (nloc == 0u) { xcd_barrier_complete(bar, b.x, nloc, nx); b.st[0] = nloc; b.st[1] = nx; }
        const unsigned old = xb_add(&bar[XB_XSUB(b.x)], 1u);
        const unsigned gen = old / nloc;
        if (old + 1u == (gen + 1u) * nloc) {
            __builtin_amdgcn_fence(__ATOMIC_RELEASE, "agent");
            asm volatile("s_waitcnt vmcnt(0)" ::: "memory");
            const unsigned og = xb_add(&bar[XB_TOP], 1u);
            const unsigned tg = og / nx;
            if (og + 1u == (tg + 1u) * nx) xb_add(&bar[XB_TOPGEN], 1u);
            else XB_SPIN(xb_ld(&bar[XB_TOPGEN]) == tg, bar);
            __builtin_amdgcn_fence(__ATOMIC_ACQUIRE, "agent");
            xb_add(&bar[XB_XGEN(b.x)], 1u);
            asm volatile("s_waitcnt vmcnt(0)" ::: "memory");
        } else {
            XB_SPIN(xb_ld(&bar[XB_XGEN(b.x)]) == gen, bar);
            __builtin_amdgcn_fence(__ATOMIC_ACQUIRE, "agent");
            asm volatile("s_waitcnt vmcnt(0)" ::: "memory");
        }
    }
    __syncthreads();
}
constexpr int MISC_OFF = 131072 + 320;
constexpr int CW_BAR = 4096;

#ifndef PROBE_DUP
#define PROBE_DUP 0
#endif
#if ONE_LAUNCH
template <int PH> __device__ __forceinline__ void phase_body(Ctx& C) {
    constexpr int i = (PH - 2) / 7, sub = (PH - 2) % 7, j = i >> 1; constexpr bool conv = (i & 1) == 0;
    if (PH == 0) phase_p0(C);
    else if (PH == 1) phase_p1(C);
    else if (PH == 30) phase_final(C);
    else if (sub == 1) { if (i > 0) { prep_layer(C, i, 2, 0); __syncthreads(); } if (conv) dwconv_phase(C, j); else ugemm_phase(C, j); }
    else if (sub == 2) prefix_phase(C, j);
    else if (sub == 3) readout_phase(C, j, i == DEPTH - 1);
    else run_phase(C, PH);
}
template <int PH> __device__ __forceinline__ void one_phase(Ctx& C, const Args& args, const XcdBarrier& bar) {
    if (PH < args.ph_lo || PH >= args.ph_hi) return;
    constexpr int i = (PH - 2) / 7, sub = (PH - 2) % 7; constexpr bool conv = (i & 1) == 0;
    if (PH >= 2 && PH < 30) { if ((sub == 2 || sub == 3) && conv) return; }
    if (PH > args.ph_lo) xcd_barrier(bar);
    relane(C);
    phase_body<PH>(C);
    constexpr bool dup = ((PH >= 2 && PH < 30) && (((PROBE_DUP & 1) && (sub == 0 || sub == 5)) || ((PROBE_DUP & 2) && sub == 1 && !conv) || ((PROBE_DUP & 4) && sub == 1 && conv))) || ((PROBE_DUP & 16) && PH < 2);
    if constexpr (dup) { xcd_barrier(bar); phase_body<PH>(C); }
}
template <int... PHS> __device__ __forceinline__ void all_phases(Ctx& C, const Args& args, const XcdBarrier& bar, std::integer_sequence<int, PHS...>) { (one_phase<PHS>(C, args, bar), ...); }
__global__ void __launch_bounds__(512, 2) mega_kernel(Args args) {
    extern __shared__ __attribute__((aligned(16))) unsigned char lds_raw[];
    Ctx C;
    C.lds = (LAS unsigned char*)lds_raw; C.tid = threadIdx.x; C.lane = C.tid & 63; C.wave = __builtin_amdgcn_readfirstlane(C.tid >> 6); C.G = gridDim.x; C.bid = blockIdx.x;
    C.in = args.in; C.out = args.out; C.ws = args.ws;
    volatile LAS unsigned* MISC = (volatile LAS unsigned*)(C.lds + MISC_OFF);
    if (C.tid < 32) MISC[C.tid] = 0u;
    __syncthreads();
    XcdBarrier bar = xcd_barrier_post((unsigned*)(C.ws + WS_CTL) + CW_BAR, MISC + 8);
    all_phases(C, args, bar, std::make_integer_sequence<int, NPHASE>{});
}

#endif
#if !ONE_LAUNCH
template <int KIND>
__global__ void __launch_bounds__(512, 2) phase_kernel(Args args) {
    extern __shared__ __attribute__((aligned(16))) unsigned char lds_raw[];
    Ctx C;
    C.lds = (LAS unsigned char*)lds_raw; C.tid = threadIdx.x; C.lane = C.tid & 63; C.wave = __builtin_amdgcn_readfirstlane(C.tid >> 6); C.G = gridDim.x; C.bid = blockIdx.x;
    C.in = args.in; C.out = args.out; C.ws = args.ws;
    const int ph = args.ph_lo;
    if (KIND == 0) phase_p0(C);
    else if (KIND == 1) phase_p1(C);
    else if (KIND == 30) phase_final(C);
    else {
        const int i = (ph - 2) / 7, j = i >> 1; const bool conv = (i & 1) == 0;
        if (KIND == 2) prefix_phase(C, j);
        else if (KIND == 4) { if (i > 0) { prep_layer(C, i, 2, 0); __syncthreads(); } if (conv) dwconv_phase(C, j); else ugemm_phase(C, j); }
        else if (KIND == 5) readout_phase(C, j, i == DEPTH - 1);
        else run_phase(C, ph);
    }
}

#endif
#ifndef PROBE_RD
#define PROBE_RD 0
#endif
#if PROBE_RD
__global__ void __launch_bounds__(512, 2) probe_read_kernel(Args args) {
    extern __shared__ __attribute__((aligned(16))) unsigned char lds_raw[];
    Ctx C;
    C.lds = (LAS unsigned char*)lds_raw; C.tid = threadIdx.x; C.lane = C.tid & 63; C.wave = __builtin_amdgcn_readfirstlane(C.tid >> 6); C.G = gridDim.x; C.bid = blockIdx.x;
    C.in = args.in; C.out = args.out; C.ws = args.ws;
    readout_phase<PROBE_RD>(C, 1, true);
}
#endif
extern "C" void kernel_launch(void* const* d_in, const int* in_sizes, int n_in, void* d_out, int out_size, void* d_ws, size_t ws_size, hipStream_t stream) {
    static int grid = 0;
    if (grid == 0) {
        if (n_in != 22 || out_size != T * D || ws_size < WS_END + (PROBE_RD ? 20 * MiB : 0)) { fprintf(stderr, "kernel_launch: unexpected problem (n_in %d out %d ws %zu, need %zu)\n", n_in, out_size, ws_size, (size_t)WS_END); grid = -1; return; }
        int dev = 0, cus = 0;
        if (hipGetDevice(&dev) != hipSuccess || hipDeviceGetAttribute(&cus, hipDeviceAttributeMultiprocessorCount, dev) != hipSuccess) { grid = -1; return; }
        bool ok = true;
#if !ONE_LAUNCH
        ok &= hipFuncSetAttribute((const void*)phase_kernel<0>, hipFuncAttributeMaxDynamicSharedMemorySize, LDS_BYTES) == hipSuccess;
        ok &= hipFuncSetAttribute((const void*)phase_kernel<1>, hipFuncAttributeMaxDynamicSharedMemorySize, LDS_BYTES) == hipSuccess;
        ok &= hipFuncSetAttribute((const void*)phase_kernel<2>, hipFuncAttributeMaxDynamicSharedMemorySize, LDS_BYTES) == hipSuccess;
        ok &= hipFuncSetAttribute((const void*)phase_kernel<3>, hipFuncAttributeMaxDynamicSharedMemorySize, LDS_BYTES) == hipSuccess;
        ok &= hipFuncSetAttribute((const void*)phase_kernel<4>, hipFuncAttributeMaxDynamicSharedMemorySize, LDS_BYTES) == hipSuccess;
        ok &= hipFuncSetAttribute((const void*)phase_kernel<5>, hipFuncAttributeMaxDynamicSharedMemorySize, LDS_BYTES) == hipSuccess;
        ok &= hipFuncSetAttribute((const void*)phase_kernel<30>, hipFuncAttributeMaxDynamicSharedMemorySize, LDS_BYTES) == hipSuccess;
#endif
#if ONE_LAUNCH
        ok &= hipFuncSetAttribute((const void*)mega_kernel, hipFuncAttributeMaxDynamicSharedMemorySize, LDS_BYTES) == hipSuccess;
#endif
        if (!ok) { fprintf(stderr, "kernel_launch: hipFuncSetAttribute failed\n"); grid = -1; return; }
        grid = cus > 0 ? cus : 256;
    }
    if (grid < 0) return;
    Args a{};
    for (int i = 0; i < 22; ++i) a.in[i] = (const float*)d_in[i];
    a.out = (float*)d_out; a.ws = (unsigned char*)d_ws;
#if ONE_LAUNCH
    if (hipMemsetAsync((char*)d_ws + WS_CTL, 0, 65536, stream) != hipSuccess) { fprintf(stderr, "kernel_launch: memset failed\n"); return; }
    a.ph_lo = 0; a.ph_hi = NPHASE;
    hipLaunchKernelGGL(mega_kernel, dim3(grid), dim3(512), LDS_BYTES, stream, a);
    return;
#endif
#if !ONE_LAUNCH
    for (int ph = 0; ph < NPHASE; ++ph) {
        const int i = (ph - 2) / 7, sub = (ph - 2) % 7;
        if (ph >= 2 && ph < 30) { if ((sub == 2 || sub == 3) && (i & 1) == 0) continue; }
        a.ph_lo = ph; a.ph_hi = ph + 1;
        const dim3 g(grid), b(512);
        if (ph == 0) hipLaunchKernelGGL(phase_kernel<0>, g, b, LDS_BYTES, stream, a);
        else if (ph == 1) hipLaunchKernelGGL(phase_kernel<1>, g, b, LDS_BYTES, stream, a);
        else if (ph == 30) hipLaunchKernelGGL(phase_kernel<30>, g, b, LDS_BYTES, stream, a);
        else if (sub == 2) hipLaunchKernelGGL(phase_kernel<2>, g, b, LDS_BYTES, stream, a);
        else if (sub == 1) hipLaunchKernelGGL(phase_kernel<4>, g, b, LDS_BYTES, stream, a);
        else if (sub == 3) hipLaunchKernelGGL(phase_kernel<5>, g, b, LDS_BYTES, stream, a);
        else hipLaunchKernelGGL(phase_kernel<3>, g, b, LDS_BYTES, stream, a);
#ifdef PROBE_G
        if (ph == 30) { Args a2 = a; a2.ph_lo = PROBE_G; a2.ph_hi = PROBE_G + 1; hipLaunchKernelGGL(phase_kernel<3>, g, b, LDS_BYTES, stream, a2); }
#endif
#if PROBE_RD
        if (ph == 30) { hipFuncSetAttribute((const void*)probe_read_kernel, hipFuncAttributeMaxDynamicSharedMemorySize, LDS_BYTES); hipLaunchKernelGGL(probe_read_kernel, g, b, LDS_BYTES, stream, a); }
#endif
        {   const bool conv = (i & 1) == 0;
            const bool dup = ((ph >= 2 && ph < 30) && (((PROBE_DUP & 1) && (sub == 0 || sub == 5)) || ((PROBE_DUP & 2) && sub == 1 && !conv) || ((PROBE_DUP & 4) && sub == 1 && conv))) || ((PROBE_DUP & 16) && ph < 2);
            if (dup) {
                if (ph == 0) hipLaunchKernelGGL(phase_kernel<0>, g, b, LDS_BYTES, stream, a);
                else if (ph == 1) hipLaunchKernelGGL(phase_kernel<1>, g, b, LDS_BYTES, stream, a);
                else if (sub == 2) hipLaunchKernelGGL(phase_kernel<2>, g, b, LDS_BYTES, stream, a);
                else if (sub == 1) hipLaunchKernelGGL(phase_kernel<4>, g, b, LDS_BYTES, stream, a);
                else hipLaunchKernelGGL(phase_kernel<3>, g, b, LDS_BYTES, stream, a);
            } }
    }
#endif
}
```

```cpp
#include <hip/hip_runtime.h>
#include <cstdio>
#include <cstdint>
#include <utility>

#ifndef ONE_LAUNCH
#define ONE_LAUNCH 1
#endif

typedef unsigned short bf16_t;
typedef short bf16x8 __attribute__((ext_vector_type(8)));
typedef float f32x4 __attribute__((ext_vector_type(4)));
typedef float f32x2 __attribute__((ext_vector_type(2)));
typedef unsigned u32x2 __attribute__((ext_vector_type(2)));
typedef unsigned u32x4 __attribute__((ext_vector_type(4)));
typedef __bf16 bf16x2_t __attribute__((ext_vector_type(2)));
typedef short s16x4 __attribute__((ext_vector_type(4)));
#define LAS __attribute__((address_space(3)))

constexpr int D = 1024, T = 16384, TC = 256, R = T + TC, NH = 4, DK = 256, DV = 512, QKW = 1024, VW = 2048, INW = 8192, DFF = 2816, FF2 = 5632, CK = 31, DEPTH = 4;
constexpr int NSLOT = 33;
constexpr float NORM_EPS = 1e-6f, LN_EPS = 1e-5f;

constexpr size_t MiB = 1u << 20, KiB = 1u << 10;
constexpr size_t WS_CTL = 0, CTL_ZERO_BYTES = 1 * MiB;
constexpr size_t WS_MODV = 1 * MiB;
constexpr size_t WS_S1 = 1 * MiB + 256 * KiB;
constexpr size_t WS_S2 = 1 * MiB + 320 * KiB;
constexpr size_t WS_CVA = 1 * MiB + 384 * KiB;
constexpr size_t WS_CVF = 1 * MiB + 640 * KiB;
constexpr size_t WS_TABC = 1 * MiB + 832 * KiB;
constexpr size_t WS_TABS = 1 * MiB + 912 * KiB;
constexpr size_t WS_STATS = 2 * MiB;
constexpr size_t WS_XCTX = 4 * MiB;
constexpr size_t WS_WA = 8 * MiB;
constexpr size_t WS_WA2 = 24 * MiB;
constexpr size_t WS_WF1 = 28 * MiB;
constexpr size_t WS_WF2 = 40 * MiB;
constexpr size_t WS_XS = 48 * MiB;
constexpr size_t WS_SCP = 48 * MiB;
constexpr size_t WS_BIG = 114 * MiB;
constexpr size_t WS_Q = WS_BIG, WS_K = WS_BIG + 33 * MiB, WS_VT = WS_BIG + 66 * MiB, WS_GF = WS_BIG + 131 * MiB, WS_GB = WS_BIG + 196 * MiB;
constexpr size_t WS_U = WS_BIG, WS_A2 = WS_BIG + 33 * MiB, WS_H = WS_BIG;
constexpr size_t WS_END = WS_BIG + 261 * MiB;
static_assert((size_t)R * 1024 * 2 <= 33 * MiB && (size_t)R * 2048 * 2 <= 65 * MiB && (size_t)R * DFF * 2 <= 131 * MiB, "map");
static_assert((size_t)NSLOT * 8 * 512 * 256 * 2 <= 66 * MiB, "scp");

constexpr int LDS_BYTES = 147456;

__device__ __forceinline__ unsigned pk2(float lo, float hi) { f32x2 v = {lo, hi}; bf16x2_t b = __builtin_convertvector(v, bf16x2_t); return __builtin_bit_cast(unsigned, b); }
__device__ __forceinline__ float bflo(unsigned u) { return __uint_as_float(u << 16); }
__device__ __forceinline__ float bfhi(unsigned u) { return __uint_as_float(u & 0xffff0000u); }
__device__ __forceinline__ float sigmf(float x) { return __builtin_amdgcn_rcpf(1.f + __builtin_amdgcn_exp2f(-1.4426950408889634f * x)); }
__device__ __forceinline__ float siluf(float x) { return x * sigmf(x); }
__device__ __forceinline__ float wave_sum63(float v) {
    v += __builtin_bit_cast(float, __builtin_amdgcn_update_dpp(0, __builtin_bit_cast(int, v), 0xB1, 0xF, 0xF, false));
    v += __builtin_bit_cast(float, __builtin_amdgcn_update_dpp(0, __builtin_bit_cast(int, v), 0x4E, 0xF, 0xF, false));
    v += __builtin_bit_cast(float, __builtin_amdgcn_update_dpp(0, __builtin_bit_cast(int, v), 0x141, 0xF, 0xF, false));
    v += __builtin_bit_cast(float, __builtin_amdgcn_update_dpp(0, __builtin_bit_cast(int, v), 0x140, 0xF, 0xF, false));
    v += __builtin_bit_cast(float, __builtin_amdgcn_update_dpp(0, __builtin_bit_cast(int, v), 0x142, 0xA, 0xF, false));
    v += __builtin_bit_cast(float, __builtin_amdgcn_update_dpp(0, __builtin_bit_cast(int, v), 0x143, 0xC, 0xF, false));
    return v;
}
__device__ __forceinline__ int perm_glu(int n, int H) { if (n < H) return 32 * (n >> 4) + (n & 15); const int n2 = n - H; return 32 * (n2 >> 4) + 16 + (n2 & 15); }
__device__ __forceinline__ int perm_win(int n) {
    if (n >= 2 * QKW) return n;
    const int part = n >> 10, hn = n & 1023, h = hn >> 8, d = hn & 255, quarter = d >> 6, idx = d & 63;
    const int Gp = (quarter >> 1) * 4 + (idx >> 4), i = (quarter & 1) * 16 + (idx & 15);
    return part * 1024 + h * 256 + 32 * Gp + i;
}
__device__ __forceinline__ int perm_any(int mode, int n, int H) { return mode == 0 ? n : (mode == 1 ? perm_glu(n, H) : perm_win(n)); }

struct Args { const float* in[22]; float* out; unsigned char* ws; int ph_lo, ph_hi; };

struct Ctx {
    LAS unsigned char* lds;
    int tid, lane, wave, G, bid;
    const float* const* in; float* out; unsigned char* ws;
};

__device__ __forceinline__ void relane(Ctx& C) {
    int wv = C.wave; asm volatile("" : "+s"(wv)); int ln = (int)__builtin_amdgcn_mbcnt_hi(~0u, __builtin_amdgcn_mbcnt_lo(~0u, 0u)); asm volatile("" : "+v"(ln));
    C.wave = wv; C.lane = ln; C.tid = wv * 64 + ln;
}
template <int VSILU>
__device__ __forceinline__ void gemv2_unit(Ctx& C, const float* W, int N, int n0, const float* v0, const float* v1, const float* bias, float* o0, float* o1, int pmode, int H) {
    LAS float* red = (LAS float*)C.lds;
    const int c4 = C.tid & 15, ks = C.tid >> 4;
    f32x4 a0 = {0.f, 0.f, 0.f, 0.f}, a1 = {0.f, 0.f, 0.f, 0.f};
#pragma unroll 8
    for (int i = 0; i < 32; ++i) {
        const int k = ks * 32 + i;
        const f32x4 w = *(const f32x4*)(W + (size_t)k * N + n0 + 4 * c4);
        float x0 = v0[k], x1 = v1[k];
        if (VSILU) { x0 = siluf(x0); x1 = siluf(x1); }
        a0 += w * x0; a1 += w * x1;
    }
#pragma unroll
    for (int e = 0; e < 4; ++e) { red[(ks * 2 + 0) * 64 + 4 * c4 + e] = a0[e]; red[(ks * 2 + 1) * 64 + 4 * c4 + e] = a1[e]; }
    __syncthreads();
    if (C.tid < 128) {
        const int s = C.tid >> 6, col = C.tid & 63; float sum = 0.f;
#pragma unroll 8
        for (int k2 = 0; k2 < 32; ++k2) sum += red[(k2 * 2 + s) * 64 + col];
        const int n = n0 + col; if (bias) sum += bias[n];
        (s ? o1 : o0)[perm_any(pmode, n, H)] = sum;
    }
    __syncthreads();
}

struct PrepItem { const float* W; bf16_t* WT; int K, N, pmode, H, k0, n0; };
__device__ __forceinline__ bool prep_decode(Ctx& C, int i, int part, int it, PrepItem& P) {
    const int j = i >> 1; const bool conv = (i & 1) == 0;
    const int I_A = (part & 1) ? (conv ? 16 * 64 : 16 * 256) : 0, I_A2 = (part & 4) ? (conv ? 16 * 32 : 32 * 32) : 0, I_F1 = (part & 2) ? 16 * 176 : 0, I_F2 = (part & 2) ? 44 * 32 : 0;
    if (it >= I_A + I_A2 + I_F1 + I_F2) return false;
    int r = it;
    if (r < I_A) { if (conv) { P.W = C.in[8] + (size_t)j * 1024 * 2048; P.K = 1024; P.N = 2048; P.pmode = 1; P.H = 1024; } else { P.W = C.in[16] + (size_t)j * 1024 * 8192; P.K = 1024; P.N = 8192; P.pmode = 2; P.H = 0; }
                   P.WT = (bf16_t*)(C.ws + WS_WA); }
    else if ((r -= I_A) < I_A2) { if (conv) { P.W = C.in[14] + (size_t)j * 1024 * 1024; P.K = 1024; } else { P.W = C.in[18] + (size_t)j * 2048 * 1024; P.K = 2048; }
                   P.N = 1024; P.pmode = 0; P.H = 0; P.WT = (bf16_t*)(C.ws + WS_WA2); }
    else if ((r -= I_A2) < I_F1) { P.W = C.in[19] + (size_t)i * 1024 * FF2; P.K = 1024; P.N = FF2; P.pmode = 1; P.H = DFF; P.WT = (bf16_t*)(C.ws + WS_WF1); }
    else { r -= I_F1; P.W = C.in[20] + (size_t)i * DFF * 1024; P.K = DFF; P.N = 1024; P.pmode = 0; P.H = 0; P.WT = (bf16_t*)(C.ws + WS_WF2); }
    const int nblk = P.N / 32; P.k0 = 64 * (r / nblk); P.n0 = 32 * (r % nblk);
    return true;
}
__device__ __forceinline__ void prep_layer(Ctx& C, int i, int part, int cu_lo) {
    if (C.bid < cu_lo) return;
    LAS float* scr = (LAS float*)(C.lds + C.wave * 16384);
    const int gw = (C.bid - cu_lo) * 8 + C.wave, NGW = (C.G - cu_lo) * 8, lane = C.lane;
    PrepItem P, Pn; f32x4 v[8], vn[8];
    bool have = prep_decode(C, i, part, gw, P);
    if (have) {
#pragma unroll
        for (int q = 0; q < 8; ++q) v[q] = *(const f32x4*)(P.W + (size_t)(P.k0 + 8 * q + (lane >> 3)) * P.N + P.n0 + 4 * (lane & 7));
    }
    for (int it = gw; have; it += NGW) {
        const bool havn = prep_decode(C, i, part, it + NGW, Pn);
        if (havn) {
#pragma unroll
            for (int q = 0; q < 8; ++q) vn[q] = *(const f32x4*)(Pn.W + (size_t)(Pn.k0 + 8 * q + (lane >> 3)) * Pn.N + Pn.n0 + 4 * (lane & 7));
        }
#pragma unroll
        for (int q = 0; q < 8; ++q) { LAS float* d = scr + (8 * q + (lane >> 3)) * 33 + 4 * (lane & 7); d[0] = v[q][0]; d[1] = v[q][1]; d[2] = v[q][2]; d[3] = v[q][3]; }
        asm volatile("s_waitcnt lgkmcnt(0)" ::: "memory");
        const int c = lane & 7;
#pragma unroll
        for (int jj = 0; jj < 4; ++jj) { const int n = (lane >> 3) + 8 * jj; const LAS float* sp = scr + (8 * c) * 33 + n;
            u32x4 o; o.x = pk2(sp[0 * 33], sp[1 * 33]); o.y = pk2(sp[2 * 33], sp[3 * 33]); o.z = pk2(sp[4 * 33], sp[5 * 33]); o.w = pk2(sp[6 * 33], sp[7 * 33]);
            *(u32x4*)(P.WT + (size_t)perm_any(P.pmode, P.n0 + n, P.H) * P.K + P.k0 + 8 * c) = o; }
        asm volatile("s_waitcnt lgkmcnt(0)" ::: "memory");
        P = Pn; have = havn;
#pragma unroll
        for (int q = 0; q < 8; ++q) v[q] = vn[q];
    }
}

__device__ __forceinline__ float row_rs(const float* stats, int row, int fq) {
    const f32x4 p = *(const f32x4*)(stats + (size_t)row * 16 + 4 * fq);
    float s = (p[0] + p[1]) + (p[2] + p[3]);
    s += __shfl_xor(s, 16); s += __shfl_xor(s, 32);
    return 1.0f / sqrtf(s * (1.0f / 1024.0f) + NORM_EPS);
}
struct EpiGLU {
    static constexpr bool STATS = false, NEEDRS = true;
    unsigned char* ws; int cvoff  , cvstride  , outoff  , ldo, act;
    float* stats;
    __device__ __forceinline__ float row_begin(int row, int fq) const { return row_rs((const float*)(ws + WS_STATS), row, fq); }
    __device__ __forceinline__ float item(int row, int colp, f32x4 v0, f32x4 v1, float rs) const {
        const float* cv = (const float*)ws + cvoff + (row < T ? 0 : cvstride);
        const f32x4 ca = *(const f32x4*)(cv + colp), cg = *(const f32x4*)(cv + colp + 16);
        float o[4];
#pragma unroll
        for (int e = 0; e < 4; ++e) { const float a = rs * v0[e] + ca[e], g = rs * v1[e] + cg[e]; o[e] = act == 0 ? a * sigmf(g) : siluf(a) * g; }
        const int oc = (colp >> 5) * 16 + (colp & 15);
        u32x2 w; w.x = pk2(o[0], o[1]); w.y = pk2(o[2], o[3]);
        *(u32x2*)((bf16_t*)(ws + outoff) + (size_t)row * ldo + oc) = w;
        return 0.f;
    }
};
struct EpiRes {
    static constexpr bool STATS = true, NEEDRS = false;
    unsigned char* ws; float* xl; const float* xin  ; const float* cin  ; const float* bias;
    int mgoff  , snoff  ;
    float* stats;
    __device__ __forceinline__ float row_begin(int, int) const { return 1.f; }
    __device__ __forceinline__ float item(int row, int colp, f32x4 v0, f32x4 v1, float) const {
        const bool lat = row < T;
        float* xr = lat ? xl + (size_t)row * 1024 : (float*)(ws + WS_XCTX) + (size_t)(row - T) * 1024;
        const float* xi = lat ? xin + (size_t)row * 1024 : cin + (size_t)(row - T) * 1024;
        const float* mg = (const float*)ws + mgoff + (lat ? 0 : 6144); const float* sn = (const float*)ws + snoff + (lat ? 0 : 1024);
        bf16_t* xs = (bf16_t*)(ws + WS_XS);
        float ss = 0.f;
#pragma unroll
        for (int hlf = 0; hlf < 2; ++hlf) {
            const int c = colp + 16 * hlf; const f32x4 v = hlf ? v1 : v0;
            const f32x4 xo = *(const f32x4*)(xi + c), m4 = *(const f32x4*)(mg + c);
            f32x4 b4 = {0.f, 0.f, 0.f, 0.f}; if (bias) b4 = *(const f32x4*)(bias + c);
            const f32x4 xn = xo + m4 * (v + b4);
            *(f32x4*)(xr + c) = xn;
            ss += (xn[0] * xn[0] + xn[1] * xn[1]) + (xn[2] * xn[2] + xn[3] * xn[3]);
            if (snoff >= 0) { const f32x4 s4 = *(const f32x4*)(sn + c); u32x2 w; w.x = pk2(xn[0] * s4[0], xn[1] * s4[1]); w.y = pk2(xn[2] * s4[2], xn[3] * s4[3]);
                *(u32x2*)(xs + (size_t)row * 1024 + c) = w; }
        }
        return ss;
    }
};
struct EpiWin {
    static constexpr bool STATS = false, NEEDRS = true;
    unsigned char* ws; int cvoff;
    float* stats;
    __device__ __forceinline__ float row_begin(int row, int fq) const { return row_rs((const float*)(ws + WS_STATS), row, fq); }
    __device__ __forceinline__ float item(int row, int colp, f32x4 v0, f32x4 v1, float rs) const {
        const float* cv = (const float*)ws + cvoff + (row < T ? 0 : 8192);
        const f32x4 c0 = *(const f32x4*)(cv + colp), c1 = *(const f32x4*)(cv + colp + 16);
        f32x4 a = v0 * rs + c0, b = v1 * rs + c1;
        if (colp < 2048) {
            if (row < T) {
                const int Gp = (colp >> 5) & 7, idx0 = 16 * (Gp & 3) + (colp & 15);
                const int ti = (Gp >> 2) ? 256 + (row & 63) : (row >> 6);
                const f32x4 cs = *(const f32x4*)((const float*)(ws + WS_TABC) + ti * 64 + idx0), sn = *(const f32x4*)((const float*)(ws + WS_TABS) + ti * 64 + idx0);
                const f32x4 o1 = a * cs - b * sn, o2 = b * cs + a * sn; a = o1; b = o2;
            }
            bf16_t* dst = (bf16_t*)(ws + WS_Q);
            if (colp >= 1024) { dst = (bf16_t*)(ws + WS_K); a = a * 0.0625f; b = b * 0.0625f; }
            const int c = colp & 1023;
            u32x2 w; w.x = pk2(a[0], a[1]); w.y = pk2(a[2], a[3]); *(u32x2*)(dst + (size_t)row * 1024 + c) = w;
            w.x = pk2(b[0], b[1]); w.y = pk2(b[2], b[3]); *(u32x2*)(dst + (size_t)row * 1024 + c + 16) = w;
        } else if (colp < 4096) {
            const int c = colp - 2048;
            bf16_t* vt = (bf16_t*)(ws + WS_VT);
#pragma unroll
            for (int e = 0; e < 4; ++e) { vt[(size_t)(c + e) * R + row] = (bf16_t)(pk2(a[e], 0.f) & 0xffffu); vt[(size_t)(c + 16 + e) * R + row] = (bf16_t)(pk2(b[e], 0.f) & 0xffffu); }
        } else {
            bf16_t* dst = (bf16_t*)(ws + (colp < 6144 ? WS_GF : WS_GB)); const int c = (colp - 4096) & 2047;
            u32x2 w; w.x = pk2(a[0], a[1]); w.y = pk2(a[2], a[3]); *(u32x2*)(dst + (size_t)row * 2048 + c) = w;
            w.x = pk2(b[0], b[1]); w.y = pk2(b[2], b[3]); *(u32x2*)(dst + (size_t)row * 2048 + c + 16) = w;
        }
        return 0.f;
    }
};

namespace pg8 {
#define PG8_LAS __attribute__((address_space(3)))
typedef unsigned short bf16_t;
typedef short bf16x8 __attribute__((ext_vector_type(8)));
typedef float f32x4 __attribute__((ext_vector_type(4)));
typedef unsigned u32x4 __attribute__((ext_vector_type(4)));
constexpr int BM = 256, BK = 64, HALF = 128, HTB = HALF * BK * 2  , STAGE_BYTES = 8 * HTB, NXCD = 8, WGM = 8;

__host__ __device__ __forceinline__ int lds_byte(int r, int c) { const int st = (r >> 4) * 2 + (c >> 5), rr = r & 15, cc = c & 31, ob = rr * 64 + cc * 2; return st * 1024 + (ob ^ (((ob >> 9) & 1) << 5)); }
__host__ __device__ __forceinline__ void stage_rc(int b, int& R, int& C) { const int st = b / 1024, sb = b % 1024, swz = sb ^ (((sb >> 9) & 1) << 5); R = (st >> 1) * 16 + swz / 64; C = (st & 1) * 32 + (swz % 64) / 2; }
__host__ __device__ __forceinline__ int perm32(int rho) { const int n = rho >> 4, i = rho & 15; return 8 * (i >> 2) + 4 * n + (i & 3); }

struct Unit { int pm, pn; };
struct Gemm { const bf16_t* A; const bf16_t* Bt; int M, N, K; };

struct StaticOrder {
    int nM, nN, nwg, G, c;
    __host__ __device__ void init(int M, int N, int G_, int c_) { nM = M / BM; nN = N / BM; nwg = nM * nN; G = G_; c = c_; }
    __host__ __device__ bool next(int i, Unit& u) const {
        const long L = (long)i * G + c; if (L >= nwg) return false;
        int wgid = (int)L; { const int q = nwg / NXCD, r = nwg % NXCD, xcd = wgid % NXCD, off = wgid / NXCD; wgid = (xcd < r ? xcd * (q + 1) : r * (q + 1) + (xcd - r) * q) + off; }
        const int nig = WGM * nN, gid = wgid / nig, fm = gid * WGM, gsz = (nM - fm) < WGM ? (nM - fm) : WGM;
        u.pm = fm + ((wgid % nig) % gsz); u.pn = (wgid % nig) / gsz; return true;
    }
    __device__ __forceinline__ void a_ready(const Unit&) const {}
    __device__ __forceinline__ void done(const Unit&) const {}
};

template <class Epi, class Sched, bool ALIGN_EPI = false, bool SP2 = false, bool SWAPMMA = false>
__device__ __forceinline__ void gemm_phase(PG8_LAS unsigned char* lds, const Gemm g, const Sched& S, const Epi& E) {
    const int tid = threadIdx.x, wid = __builtin_amdgcn_readfirstlane(tid >> 6), lane = tid & 63, wr = wid >> 2, wc = wid & 3, fr = lane & 15, fq = lane >> 4;
    const int K = g.K, nt = K / BK;
    unsigned voffA[2], voffB[2];
#pragma unroll
    for (int i = 0; i < 2; ++i) { int R, C; stage_rc(tid * 16 + i * 8192, R, C); const int Rb = Epi::PERM ? ((R & ~31) + perm32(R & 31)) : R;
        voffA[i] = (unsigned)(R * K + C) * 2u; voffB[i] = (unsigned)(Rb * K + C) * 2u; }
    const size_t kstep = (size_t)(BK * 2);
    const size_t hstep = (size_t)HALF * K * 2;
    const size_t tstep = 2 * hstep;
    const unsigned ldsw = (unsigned)wid * 1024u;
    const int aoff = lds_byte(wr * 64 + fr, fq * 8), boff = lds_byte(wc * 32 + fr, fq * 8);
#define PG8_SA(b, h) (((b) * 2 + (h)) * HTB)
#define PG8_SB(b, h) ((4 + (b) * 2 + (h)) * HTB)
#define PG8_STAGE(bufoff, gbase, voff) do { _Pragma("unroll") for (int _i = 0; _i < 2; ++_i) \
        __builtin_amdgcn_global_load_lds((const unsigned*)((const char*)(gbase) + (voff)[_i]), (PG8_LAS unsigned*)(lds + (bufoff) + ldsw + _i * 8192), 16, 0, 0); } while (0)
#define PG8_LDA(dst, b, h) do { _Pragma("unroll") for (int m = 0; m < 4; ++m) _Pragma("unroll") for (int k = 0; k < 2; ++k) dst[m][k] = *(const PG8_LAS bf16x8*)(lds + PG8_SA(b, h) + aoff + m * 2048 + k * 1024); } while (0)
#define PG8_LDB(dst, b, h) do { _Pragma("unroll") for (int n = 0; n < 2; ++n) _Pragma("unroll") for (int k = 0; k < 2; ++k) dst[n][k] = *(const PG8_LAS bf16x8*)(lds + PG8_SB(b, h) + boff + n * 2048 + k * 1024); } while (0)
#define PG8_MMA(ai, bj, At, Bt) do { __builtin_amdgcn_s_setprio(1); _Pragma("unroll") for (int m = 0; m < 4; ++m) _Pragma("unroll") for (int n = 0; n < 2; ++n) _Pragma("unroll") for (int k = 0; k < 2; ++k) \
        acc[ai][bj][m][n] = SWAPMMA ? __builtin_amdgcn_mfma_f32_16x16x32_bf16(At[m][k], Bt[n][k], acc[ai][bj][m][n], 0, 0, 0) : __builtin_amdgcn_mfma_f32_16x16x32_bf16(Bt[n][k], At[m][k], acc[ai][bj][m][n], 0, 0, 0); __builtin_amdgcn_s_setprio(0); } while (0)
#define PG8_WAIT_V(n) asm volatile("s_waitcnt vmcnt(" #n ")" ::: "memory")
#define PG8_WAIT_L(n) asm volatile("s_waitcnt lgkmcnt(" #n ")" ::: "memory")
#define PG8_BAR __builtin_amdgcn_s_barrier()
#define PG8_SCHED __builtin_amdgcn_sched_barrier(0)
    Unit cur, nxt; int ui = 0;
    if (!S.next(0, cur)) return;
    f32x4 acc[2][2][4][2];
#pragma unroll
    for (int a = 0; a < 2; ++a)
#pragma unroll
        for (int b = 0; b < 2; ++b)
#pragma unroll
            for (int m = 0; m < 4; ++m)
#pragma unroll
                for (int n = 0; n < 2; ++n) acc[a][b][m][n] = (f32x4){0.f, 0.f, 0.f, 0.f};
    bf16x8 At[4][2], B0[2][2], B1[2][2];
    const char* cA = (const char*)g.A + (size_t)cur.pm * tstep; const char* cB = (const char*)g.Bt + (size_t)cur.pn * tstep;
    S.a_ready(cur);
    if constexpr (SP2) {
        PG8_STAGE(PG8_SB(0, 0), cB, voffB); PG8_STAGE(PG8_SB(0, 1), cB + hstep, voffB); PG8_STAGE(PG8_SA(0, 0), cA, voffA); PG8_STAGE(PG8_SA(0, 1), cA + hstep, voffA);
        if (wr == 1) PG8_BAR;
        PG8_WAIT_V(2); PG8_BAR;
        PG8_STAGE(PG8_SB(1, 0), cB + kstep, voffB); PG8_STAGE(PG8_SA(1, 0), cA + kstep, voffA); PG8_STAGE(PG8_SB(1, 1), cB + hstep + kstep, voffB);
        PG8_WAIT_V(6); PG8_BAR;
    } else {
        PG8_STAGE(PG8_SB(0, 0), cB, voffB); PG8_STAGE(PG8_SA(0, 0), cA, voffA); PG8_STAGE(PG8_SB(0, 1), cB + hstep, voffB); PG8_STAGE(PG8_SA(0, 1), cA + hstep, voffA);
        if (wr == 1) PG8_BAR;
        PG8_WAIT_V(4); PG8_BAR;
        PG8_STAGE(PG8_SB(1, 0), cB + kstep, voffB); PG8_STAGE(PG8_SA(1, 0), cA + kstep, voffA); PG8_STAGE(PG8_SB(1, 1), cB + hstep + kstep, voffB);
        PG8_WAIT_V(6); PG8_BAR;
    }
    for (;;) {
        const bool has_next = S.next(ui + 1, nxt);
        const char* nA = has_next ? (const char*)g.A + (size_t)nxt.pm * tstep : cA; const char* nB = has_next ? (const char*)g.Bt + (size_t)nxt.pn * tstep : cB;
        for (int t = 0; t < nt; t += 2) {
            const bool last = (t == nt - 2);
            const char* a1 = cA + (size_t)(t + 1) * kstep;
            const char* a2 = last ? nA : cA + (size_t)(t + 2) * kstep; const char* b2 = last ? nB : cB + (size_t)(t + 2) * kstep;
            const char* a3 = a2 + kstep; const char* b3 = b2 + kstep;
            if (last && has_next) S.a_ready(nxt);
            if constexpr (SP2) {
            PG8_LDB(B0, 0, 0); PG8_LDB(B1, 0, 1); PG8_SCHED; PG8_LDA(At, 0, 0); PG8_STAGE(PG8_SA(1, 1), a1 + hstep, voffA);
            PG8_WAIT_V(8); PG8_WAIT_L(0); PG8_BAR; PG8_MMA(0, 0, At, B0); PG8_MMA(0, 1, At, B1); PG8_BAR; PG8_SCHED;
            PG8_LDA(At, 0, 1); PG8_STAGE(PG8_SB(0, 0), b2, voffB); PG8_STAGE(PG8_SB(0, 1), b2 + hstep, voffB); PG8_STAGE(PG8_SA(0, 0), a2, voffA);
            PG8_WAIT_V(8); PG8_WAIT_L(0); PG8_BAR; PG8_MMA(1, 0, At, B0); PG8_MMA(1, 1, At, B1); PG8_BAR; PG8_SCHED;
            PG8_LDB(B0, 1, 0); PG8_LDB(B1, 1, 1); PG8_SCHED; PG8_LDA(At, 1, 0); PG8_STAGE(PG8_SA(0, 1), a2 + hstep, voffA);
            PG8_WAIT_V(8); PG8_WAIT_L(0); PG8_BAR; PG8_MMA(0, 0, At, B0); PG8_MMA(0, 1, At, B1); PG8_BAR; PG8_SCHED;
            PG8_LDA(At, 1, 1); PG8_STAGE(PG8_SB(1, 0), b3, voffB); PG8_STAGE(PG8_SB(1, 1), b3 + hstep, voffB); PG8_STAGE(PG8_SA(1, 0), a3, voffA);
            PG8_WAIT_V(8); PG8_WAIT_L(0); PG8_BAR; PG8_MMA(1, 0, At, B0); PG8_MMA(1, 1, At, B1); PG8_BAR; PG8_SCHED;
            } else {
            PG8_LDB(B0, 0, 0); PG8_SCHED; PG8_LDA(At, 0, 0); PG8_STAGE(PG8_SA(1, 1), a1 + hstep, voffA);
            PG8_WAIT_L(8); PG8_BAR; PG8_WAIT_L(0); PG8_MMA(0, 0, At, B0); PG8_BAR; PG8_SCHED;
            PG8_LDB(B1, 0, 1); PG8_STAGE(PG8_SB(0, 0), b2, voffB);
            PG8_BAR; PG8_WAIT_L(0); PG8_MMA(0, 1, At, B1); PG8_BAR;
            PG8_LDA(At, 0, 1); PG8_STAGE(PG8_SA(0, 0), a2, voffA);
            PG8_BAR; PG8_WAIT_L(0); PG8_MMA(1, 0, At, B0); PG8_BAR; PG8_SCHED;
            PG8_STAGE(PG8_SB(0, 1), b2 + hstep, voffB);
            PG8_WAIT_V(6); PG8_BAR; PG8_MMA(1, 1, At, B1); PG8_BAR;
            PG8_LDB(B0, 1, 0); PG8_SCHED; PG8_LDA(At, 1, 0); PG8_STAGE(PG8_SA(0, 1), a2 + hstep, voffA);
            PG8_WAIT_L(8); PG8_BAR; PG8_WAIT_L(0); PG8_MMA(0, 0, At, B0); PG8_BAR; PG8_SCHED;
            PG8_LDB(B1, 1, 1); PG8_STAGE(PG8_SB(1, 0), b3, voffB);
            PG8_BAR; PG8_WAIT_L(0); PG8_MMA(0, 1, At, B1); PG8_BAR;
            PG8_LDA(At, 1, 1); PG8_STAGE(PG8_SA(1, 0), a3, voffA);
            PG8_BAR; PG8_WAIT_L(0); PG8_MMA(1, 0, At, B0); PG8_BAR; PG8_SCHED;
            PG8_STAGE(PG8_SB(1, 1), b3 + hstep, voffB);
            PG8_WAIT_V(6); PG8_BAR; PG8_MMA(1, 1, At, B1); PG8_BAR;
            }
        }
        if constexpr (ALIGN_EPI) { if (wr == 0) PG8_BAR; }
        if constexpr (!Epi::AFTER_DRAIN) { E(acc, cur, wr, wc, fr, fq); S.done(cur); }
        if (!has_next) break;
#pragma unroll
        for (int a = 0; a < 2; ++a)
#pragma unroll
            for (int b = 0; b < 2; ++b)
#pragma unroll
                for (int m = 0; m < 4; ++m)
#pragma unroll
                    for (int n = 0; n < 2; ++n) acc[a][b][m][n] = (f32x4){0.f, 0.f, 0.f, 0.f};
        cur = nxt; cA = nA; cB = nB; ++ui;
        if constexpr (ALIGN_EPI) { if (wr == 1) PG8_BAR; }
    }
    PG8_WAIT_V(0);
    if constexpr (!ALIGN_EPI) { if (wr == 0) PG8_BAR; }
    PG8_BAR;
    if constexpr (Epi::AFTER_DRAIN) { E.fused(acc, cur, wr, wc, fr, fq, lds, wid, lane); S.done(cur); }
#undef PG8_SA
#undef PG8_SB
#undef PG8_STAGE
#undef PG8_LDA
#undef PG8_LDB
#undef PG8_MMA
#undef PG8_WAIT_V
#undef PG8_WAIT_L
#undef PG8_BAR
#undef PG8_SCHED
}
}

template <class E0> struct EpiAdapt {
    static constexpr bool PERM = false, AFTER_DRAIN = false;
    E0 e; int col_base;
    __device__ __forceinline__ void operator()(const pg8::f32x4 (&acc)[2][2][4][2], const pg8::Unit& u, int wr, int wc, int fr, int fq) const {
#pragma unroll
        for (int ai = 0; ai < 2; ++ai)
#pragma unroll
            for (int m = 0; m < 4; ++m) {
                const int row = u.pm * 256 + ai * 128 + wr * 64 + m * 16 + fr;
                const float rs = e.row_begin(row, fq);
                float ss = 0.f;
#pragma unroll
                for (int bj = 0; bj < 2; ++bj) ss += e.item(row, col_base + u.pn * 256 + bj * 128 + wc * 32 + 4 * fq, acc[ai][bj][m][0], acc[ai][bj][m][1], rs);
                if constexpr (E0::STATS) { ss += __shfl_xor(ss, 16); ss += __shfl_xor(ss, 32); if (fq == 0) e.stats[(size_t)row * 16 + (col_base >> 6) + u.pn * 4 + wc] = ss; }
            }
    }
};
struct EpiResBig {
    static constexpr bool PERM = false, AFTER_DRAIN = false;
    EpiRes e;
    __device__ __forceinline__ void operator()(const pg8::f32x4 (&acc)[2][2][4][2], const pg8::Unit& u, int wr, int wc, int fr, int fq) const {
        const float* mg = (const float*)e.ws + e.mgoff; const float* sn = (const float*)e.ws + e.snoff;
        bf16_t* xs = (bf16_t*)(e.ws + WS_XS);
        const int colb = u.pn * 256 + wc * 32 + 4 * fq;
#pragma unroll
        for (int aq = 0; aq < 4; ++aq) {
            const int ai = aq >> 1, mh = aq & 1;
            const int rowb = u.pm * 256 + ai * 128 + wr * 64 + fr + 32 * mh;
            f32x4 xo[2][2][2];
#pragma unroll
            for (int m = 0; m < 2; ++m)
#pragma unroll
                for (int bj = 0; bj < 2; ++bj)
#pragma unroll
                    for (int hl = 0; hl < 2; ++hl) xo[m][bj][hl] = *(const f32x4*)(e.xin + (size_t)(rowb + 16 * m) * 1024 + colb + 128 * bj + 16 * hl);
#pragma unroll
            for (int m = 0; m < 2; ++m) {
                const int row = rowb + 16 * m; float ss = 0.f;
#pragma unroll
                for (int bj = 0; bj < 2; ++bj)
#pragma unroll
                    for (int hl = 0; hl < 2; ++hl) {
                        const int c = colb + 128 * bj + 16 * hl;
                        const f32x4 m4 = *(const f32x4*)(mg + c);
                        f32x4 b4 = {0.f, 0.f, 0.f, 0.f}; if (e.bias) b4 = *(const f32x4*)(e.bias + c);
                        const f32x4 xn = xo[m][bj][hl] + m4 * (acc[ai][bj][2 * mh + m][hl] + b4);
                        *(f32x4*)(e.xl + (size_t)row * 1024 + c) = xn;
                        ss += (xn[0] * xn[0] + xn[1] * xn[1]) + (xn[2] * xn[2] + xn[3] * xn[3]);
                        if (e.snoff >= 0) { const f32x4 s4 = *(const f32x4*)(sn + c); u32x2 w; w.x = pk2(xn[0] * s4[0], xn[1] * s4[1]); w.y = pk2(xn[2] * s4[2], xn[3] * s4[3]);
                            *(u32x2*)(xs + (size_t)row * 1024 + c) = w; }
                    }
                ss += __shfl_xor(ss, 16); ss += __shfl_xor(ss, 32); if (fq == 0) e.stats[(size_t)row * 16 + u.pn * 4 + wc] = ss;
            }
        }
    }
};
struct EpiVt {
    static constexpr bool PERM = false, AFTER_DRAIN = false;
    unsigned char* ws; int cvoff;
    __device__ __forceinline__ void operator()(const pg8::f32x4 (&acc)[2][2][4][2], const pg8::Unit& u, int wr, int wc, int fr, int fq) const {
        bf16_t* vt = (bf16_t*)(ws + WS_VT);
#pragma unroll
        for (int ai = 0; ai < 2; ++ai)
#pragma unroll
            for (int m = 0; m < 4; ++m) {
                const int rowb = u.pm * 256 + ai * 128 + wr * 64 + m * 16;
                const float rsl = row_rs((const float*)(ws + WS_STATS), rowb + fr, fq);
                float rsv[4];
#pragma unroll
                for (int e = 0; e < 4; ++e) rsv[e] = __shfl(rsl, 4 * fq + e);
                const float* cv = (const float*)ws + cvoff + (rowb < T ? 0 : 8192);
#pragma unroll
                for (int bj = 0; bj < 2; ++bj)
#pragma unroll
                    for (int n = 0; n < 2; ++n) {
                        const int col = 2048 + u.pn * 256 + bj * 128 + wc * 32 + 16 * n + fr;
                        const float c0 = cv[col]; const pg8::f32x4 a = acc[ai][bj][m][n];
                        u32x2 w; w.x = pk2(a[0] * rsv[0] + c0, a[1] * rsv[1] + c0); w.y = pk2(a[2] * rsv[2] + c0, a[3] * rsv[3] + c0);
                        *(u32x2*)(vt + (size_t)(col - 2048) * R + rowb + 4 * fq) = w;
                    }
            }
    }
};
template <class Epi>
__device__ __forceinline__ void sgemm_small(Ctx& C, const bf16_t* A, const bf16_t* Bt, int row_lo, int Mrows, int N, int K, const Epi& E, int n_lo, int n_hi) {
    const int w = C.wave, fr = C.lane & 15, fq = C.lane >> 4;
    const int nM = Mrows / 16, nN = n_hi - n_lo, nU = nM * nN, K8 = K >> 3;
    LAS f32x4* xch = (LAS f32x4*)C.lds;
    LAS float* sx = (LAS float*)(C.lds + 131072 + 1024);
    for (int u = (C.G - 1 - C.bid); u < nU; u += C.G) {
        const int un = n_lo + u / nM, um = u % nM;
        const int row0 = row_lo + 16 * um, col0 = 256 * un;
        f32x4 acc[16];
#pragma unroll
        for (int t = 0; t < 16; ++t) acc[t] = (f32x4){0.f, 0.f, 0.f, 0.f};
        const bf16_t* ap = A + (size_t)(row0 + fr) * K + w * K8 + 8 * fq;
        const bf16_t* bp = Bt + (size_t)(col0 + fr) * K + w * K8 + 8 * fq;
#pragma unroll 1
        for (int k0 = 0; k0 < K8; k0 += 32) {
            const bf16x8 af = *(const bf16x8*)(ap + k0);
            bf16x8 bf[16];
#pragma unroll
            for (int t = 0; t < 16; ++t) bf[t] = *(const bf16x8*)(bp + (size_t)(16 * t) * K + k0);
#pragma unroll
            for (int t = 0; t < 16; ++t) acc[t] = __builtin_amdgcn_mfma_f32_16x16x32_bf16(bf[t], af, acc[t], 0, 0, 0);
        }
#pragma unroll
        for (int t = 0; t < 16; ++t) xch[(w * 16 + t) * 64 + C.lane] = acc[t];
        __syncthreads();
        const int wc = w >> 1, bj = w & 1, t0 = 8 * bj + 2 * wc;
        f32x4 v0 = {0.f, 0.f, 0.f, 0.f}, v1 = v0;
#pragma unroll
        for (int q = 0; q < 8; ++q) { v0 += xch[(q * 16 + t0) * 64 + C.lane]; v1 += xch[(q * 16 + t0 + 1) * 64 + C.lane]; }
        const int row = row0 + fr;
        const float rs = E.row_begin(row, fq);
        float ss = E.item(row, col0 + 128 * bj + 32 * wc + 4 * fq, v0, v1, rs);
        if constexpr (Epi::STATS) {
            ss += __shfl_xor(ss, 16); ss += __shfl_xor(ss, 32);
            if (fq == 0) sx[fr * 8 + w] = ss;
            __syncthreads();
            if (fq == 0 && bj == 0) E.stats[(size_t)row * 16 + un * 4 + wc] = sx[fr * 8 + w] + sx[fr * 8 + w + 1];
        }
        __syncthreads();
    }
}
template <class E0>
__device__ __forceinline__ void gemm_both(Ctx& C, const bf16_t* A, const bf16_t* Bt, int Mbig, int N, int K, const E0& E, int ctx_n_lo, int ctx_n_hi, int nb_lo = 0, int nb_hi = -1) {
    if (nb_hi < 0) nb_hi = N / 256;
    { pg8::Gemm g{A, Bt + (size_t)nb_lo * 256 * K, Mbig, (nb_hi - nb_lo) * 256, K}; pg8::StaticOrder S; S.init(Mbig, (nb_hi - nb_lo) * 256, C.G, C.bid); EpiAdapt<E0> EA{E, nb_lo * 256};
      pg8::gemm_phase<EpiAdapt<E0>, pg8::StaticOrder, true, true>(C.lds, g, S, EA); }
    if (Mbig < R && ctx_n_hi > ctx_n_lo) { __syncthreads(); relane(C); sgemm_small(C, A, Bt, T, R - T, N, K, E, ctx_n_lo, ctx_n_hi); }
}
__device__ __forceinline__ void dwconv_phase(Ctx& C, int j) {
    const bf16_t* U = (const bf16_t*)(C.ws + WS_U); bf16_t* A2 = (bf16_t*)(C.ws + WS_A2);
    const float* dww = C.in[10] + (size_t)j * CK * 1024; const float* dwb = C.in[11] + j * 1024; const float* lng = C.in[12] + j * 1024; const float* lnb = C.in[13] + j * 1024;
    constexpr int TT = 33, NR = TT + 30;
    LAS unsigned char* tile = C.lds; LAS float* part = (LAS float*)(C.lds + NR * 2048);
    const int tid = C.tid;
    constexpr int NUL = (T + TT - 1) / TT, NUC = (TC + TT - 1) / TT;
    f32x2 wt[CK];
#pragma unroll
    for (int jt = 0; jt < CK; ++jt) wt[jt] = *(const f32x2*)(dww + jt * 1024 + 2 * tid);
    const f32x2 b2 = *(const f32x2*)(dwb + 2 * tid), g2 = *(const f32x2*)(lng + 2 * tid), bb2 = *(const f32x2*)(lnb + 2 * tid);
    for (int u = C.bid; u < NUL + NUC; u += C.G) {
        const bool lat = u < NUL; const int base = lat ? 0 : T, n = lat ? T : TC, t0 = TT * (lat ? u : u - NUL);
        const int nv = (n - t0) < TT ? (n - t0) : TT;
        for (int idx = tid; idx < NR * 128; idx += 512) {
            const int rr = idx >> 7, ch = idx & 127, tt = t0 - 15 + rr;
            u32x4 v = {0u, 0u, 0u, 0u};
            if (tt >= 0 && tt < n) v = *(const u32x4*)(U + (size_t)(base + tt) * 1024 + ch * 8);
            *(LAS u32x4*)(tile + rr * 2048 + ch * 16) = v;
        }
        __syncthreads();
        f32x2 o[TT];
#pragma unroll
        for (int t = 0; t < TT; ++t) o[t] = b2;
#pragma unroll
        for (int hb = 0; hb < 3; ++hb) {
            f32x2 xw[41];
#pragma unroll
            for (int r = 0; r < 41; ++r) { const unsigned uu = *(const LAS unsigned*)(tile + (11 * hb + r) * 2048 + tid * 4); xw[r] = (f32x2){bflo(uu), bfhi(uu)}; }
#pragma unroll
            for (int t = 0; t < 11; ++t)
#pragma unroll
                for (int jt = 0; jt < CK; ++jt) o[11 * hb + t] += wt[jt] * xw[t + jt];
        }
#pragma unroll
        for (int t = 0; t < TT; ++t) {
            const float s = wave_sum63(o[t].x + o[t].y), q = wave_sum63(o[t].x * o[t].x + o[t].y * o[t].y);
            if (C.lane == 63) { part[(t * 8 + C.wave) * 2] = s; part[(t * 8 + C.wave) * 2 + 1] = q; }
        }
        __syncthreads();
#pragma unroll
        for (int t = 0; t < TT; ++t) {
            float s = 0.f, q = 0.f;
#pragma unroll
            for (int w = 0; w < 8; ++w) { s += part[(t * 8 + w) * 2]; q += part[(t * 8 + w) * 2 + 1]; }
            const float mean = s * (1.f / 1024.f), var = q * (1.f / 1024.f) - mean * mean, rstd = 1.0f / sqrtf(var + LN_EPS);
            const float y0 = (o[t].x - mean) * rstd * g2.x + bb2.x, y1 = (o[t].y - mean) * rstd * g2.y + bb2.y;
            if (t < nv) *(unsigned*)(A2 + (size_t)(base + t0 + t) * 1024 + 2 * tid) = pk2(siluf(y0), siluf(y1));
        }
        __syncthreads();
    }
}

__device__ __forceinline__ void scan_phase(Ctx& C, int j) {
    const bf16_t* Kb = (const bf16_t*)(C.ws + WS_K); const bf16_t* Vt = (const bf16_t*)(C.ws + WS_VT); bf16_t* Scp = (bf16_t*)(C.ws + WS_SCP);
    constexpr int SLOT = 32768;
    const int fr = C.lane & 15, fq = C.lane >> 4, w = C.wave, lane = C.lane;
    for (int cu = C.bid; cu < 256; cu += C.G) {
        const int hd = cu & 7, sidx = cu >> 3, h = hd >> 1, dir = hd & 1, dk_s = 64 * ((sidx >> 3) & 3), dv_s = 64 * (sidx & 7);
        const float gam = 1.0f - exp2f(C.in[17][(j * 2 + dir) * 4 + h]); const float L = log2f(gam);
        const float cdec = exp2f(L * 128.f);
        const bf16_t* ksrc[2]; const bf16_t* vsrc[2];
#pragma unroll
        for (int p = 0; p < 2; ++p) {
            const int kr = 8 * (2 * w + p) + (lane >> 3), kpos = lane & 7, kc = kpos ^ (((kr >> 3) & 1) << 1) ^ (((kr >> 1) & 1) << 2);
            ksrc[p] = Kb + (size_t)kr * 1024 + h * 256 + dk_s + 8 * kc;
            const int vr = 4 * (2 * w + p) + (lane >> 4), vpos = lane & 15, vc = vpos ^ (vr & 15);
            vsrc[p] = Vt + (size_t)(h * 512 + dv_s + vr) * R + 8 * vc;
        }
        auto tok_of = [&](int st) { const int sc = st < 129 ? st : 129; const int bl = sc < 2 ? (dir == 0 ? sc : 1 - sc) : (dir == 0 ? sc - 2 : 129 - sc); return (sc < 2 ? T : 0) + 128 * bl; };
#define SCAN_DMA(st) do { const int tok_ = tok_of(st); LAS unsigned char* sl_ = C.lds + ((st) & 3) * SLOT + (2 * w) * 1024; \
        __builtin_amdgcn_global_load_lds((const unsigned*)(ksrc[0] + (size_t)tok_ * 1024), (LAS unsigned*)(sl_), 16, 0, 0); \
        __builtin_amdgcn_global_load_lds((const unsigned*)(ksrc[1] + (size_t)tok_ * 1024), (LAS unsigned*)(sl_ + 1024), 16, 0, 0); \
        __builtin_amdgcn_global_load_lds((const unsigned*)(vsrc[0] + tok_), (LAS unsigned*)(sl_ + 16384), 16, 0, 0); \
        __builtin_amdgcn_global_load_lds((const unsigned*)(vsrc[1] + tok_), (LAS unsigned*)(sl_ + 16384 + 1024), 16, 0, 0); } while (0)
        const int mt = w >> 1, nh = w & 1, dkl = 16 * mt;
        const int trq = (fr >> 2), trp = fr & 3, trrow0 = 8 * fq + trq;
        const int trcol0 = (((2 * mt + (trp >> 1)) ^ ((fq & 1) << 1) ^ (((trq >> 1) & 1) << 2)) << 3) + 4 * (trp & 1);
        float kd[4][8];
#pragma unroll
        for (int ks = 0; ks < 4; ++ks)
#pragma unroll
            for (int e = 0; e < 8; ++e) { const int tl = 32 * ks + 8 * fq + e; kd[ks][e] = exp2f(L * (float)(dir == 0 ? 127 - tl : tl)); }
        int voff[2];
#pragma unroll
        for (int nt = 0; nt < 2; ++nt) { const int vr = 32 * nh + 16 * nt + fr; voff[nt] = 16384 + vr * 256; }
        f32x4 acc[2]; acc[0] = (f32x4){0.f, 0.f, 0.f, 0.f}; acc[1] = acc[0];
        const unsigned lds0 = (unsigned)(size_t)C.lds;
        __syncthreads();
        SCAN_DMA(0); SCAN_DMA(1); SCAN_DMA(2);
#pragma unroll 1
        for (int st = 0; st < 130; ++st) {
            asm volatile("s_waitcnt vmcnt(8)" ::: "memory");
            __builtin_amdgcn_s_barrier(); asm volatile("" ::: "memory");
            SCAN_DMA(st + 3);
            {   const bool isctx = st < 2; const int bl = isctx ? (dir == 0 ? st : 1 - st) : (dir == 0 ? st - 2 : 129 - st);
                const bool cp = dir == 0 ? ((bl & 3) == 0) : (isctx ? bl == 1 : (bl & 3) == 3);
                if (cp) {
                    const int slot = isctx ? 32 : (bl >> 2);
                    bf16_t* sp = Scp + ((size_t)((slot * 4 + h) * 2 + dir) * 512) * 256;
#pragma unroll
                    for (int nt = 0; nt < 2; ++nt) { u32x2 wv; wv.x = pk2(acc[nt][0], acc[nt][1]); wv.y = pk2(acc[nt][2], acc[nt][3]);
                        *(u32x2*)(sp + (size_t)(dv_s + 32 * nh + 16 * nt + fr) * 256 + dk_s + dkl + 4 * fq) = wv; }
                } }
            acc[0] = acc[0] * cdec; acc[1] = acc[1] * cdec;
            const unsigned sl = lds0 + (unsigned)((st & 3) * SLOT);
            u32x2 klo[4], khi[4]; u32x4 vfr[4][2];
#pragma unroll
            for (int ks = 0; ks < 4; ++ks) {
                const unsigned ka = sl + (unsigned)(((32 * ks + trrow0) * 64 + trcol0) * 2);
                asm volatile("ds_read_b64_tr_b16 %0, %1" : "=v"(klo[ks]) : "v"(ka));
                asm volatile("ds_read_b64_tr_b16 %0, %1 offset:512" : "=v"(khi[ks]) : "v"(ka));
#pragma unroll
                for (int nt = 0; nt < 2; ++nt) { const int vr = 32 * nh + 16 * nt + fr;
                    const unsigned va = sl + (unsigned)(voff[nt] + (((4 * ks + fq) ^ (vr & 15)) << 4));
                    asm volatile("ds_read_b128 %0, %1" : "=v"(vfr[ks][nt]) : "v"(va)); }
            }
            asm volatile("s_waitcnt lgkmcnt(0)" : "+v"(klo[0]), "+v"(klo[1]), "+v"(klo[2]), "+v"(klo[3]), "+v"(khi[0]), "+v"(khi[1]), "+v"(khi[2]), "+v"(khi[3]) :: "memory");
            asm volatile("" : "+v"(vfr[0][0]), "+v"(vfr[0][1]), "+v"(vfr[1][0]), "+v"(vfr[1][1]), "+v"(vfr[2][0]), "+v"(vfr[2][1]), "+v"(vfr[3][0]), "+v"(vfr[3][1]));
            __builtin_amdgcn_sched_barrier(0);
#pragma unroll
            for (int ks = 0; ks < 4; ++ks) {
                u32x4 pk;
                pk.x = pk2(bflo(klo[ks].x) * kd[ks][0], bfhi(klo[ks].x) * kd[ks][1]);
                pk.y = pk2(bflo(klo[ks].y) * kd[ks][2], bfhi(klo[ks].y) * kd[ks][3]);
                pk.z = pk2(bflo(khi[ks].x) * kd[ks][4], bfhi(khi[ks].x) * kd[ks][5]);
                pk.w = pk2(bflo(khi[ks].y) * kd[ks][6], bfhi(khi[ks].y) * kd[ks][7]);
                const bf16x8 af = __builtin_bit_cast(bf16x8, pk);
#pragma unroll
                for (int nt = 0; nt < 2; ++nt) acc[nt] = __builtin_amdgcn_mfma_f32_16x16x32_bf16(af, __builtin_bit_cast(bf16x8, vfr[ks][nt]), acc[nt], 0, 0, 0);
            }
        }
        asm volatile("s_waitcnt vmcnt(0)" ::: "memory");
        __syncthreads();
#undef SCAN_DMA
    }
}

__device__ __forceinline__ void ugemm_phase(Ctx& C, int j) {
    const bf16_t* Kb = (const bf16_t*)(C.ws + WS_K); const bf16_t* Vt = (const bf16_t*)(C.ws + WS_VT); bf16_t* Scp = (bf16_t*)(C.ws + WS_SCP);
    constexpr int SLOT = 65536;
    const int fr = C.lane & 15, fq = C.lane >> 4, w = C.wave, lane = C.lane;
    const int wm = w >> 1, wn = w & 1;
    const unsigned lds0 = (unsigned)(size_t)C.lds;
    for (int it0 = 0; it0 < 3; ++it0) {
        int set, sub;
        if (it0 < 2) { const int x = C.bid & 7, ii = (C.bid & 255) >> 3; if (C.G != 256 && C.bid >= 256) break; set = it0 * 64 + x * 8 + (ii >> 2); sub = ii & 3; if (C.G != 256) { const int itx = it0 * 256 + C.bid; set = itx >> 2; sub = itx & 3; } }
        else { const int k = C.G - 1 - C.bid; if (k >= 16) break; set = 128 + (k >> 2); sub = k & 3; }
        const int slot = set >> 2, h = set & 3, dir = sub >> 1, dvh = sub & 1;
        const int ntok = slot < 32 ? 512 : 256, tokb = slot < 32 ? 512 * slot : T, nst = ntok / 64;
        const float gam = 1.0f - exp2f(C.in[17][(j * 2 + dir) * 4 + h]); const float L = log2f(gam);
        unsigned ksrc[4], vsrc[4];
#pragma unroll
        for (int p = 0; p < 4; ++p) {
            const int kr = 2 * (4 * w + p) + (lane >> 5), kpos = lane & 31, kc = kpos ^ ((((kr & 3) | (((kr >> 3) & 1) << 2))) << 1);
            ksrc[p] = (unsigned)((tokb + kr) * 1024 + h * 256 + 8 * kc);
            const int vr = 8 * (4 * w + p) + (lane >> 3), vpos = lane & 7, vc = vpos ^ ((vr >> 1) & 7);
            vsrc[p] = (unsigned)((h * 512 + 256 * dvh + vr) * R + tokb + 8 * vc);
        }
#define UG_DMA(st) do { const int s_ = (st) < nst ? (st) : nst - 1; LAS unsigned char* sl_ = C.lds + ((st) & 1) * SLOT + (4 * w) * 1024; \
        _Pragma("unroll") for (int p = 0; p < 4; ++p) { \
            __builtin_amdgcn_global_load_lds((const unsigned*)(Kb + (ksrc[p] + (unsigned)(64 * s_ * 1024))), (LAS unsigned*)(sl_ + p * 1024), 16, 0, 0); \
            __builtin_amdgcn_global_load_lds((const unsigned*)(Vt + (vsrc[p] + (unsigned)(64 * s_))), (LAS unsigned*)(sl_ + 32768 + p * 1024), 16, 0, 0); } } while (0)
        const int trq = fr >> 2, trp = fr & 3;
        const int row0 = 8 * fq + trq;
        const unsigned a0 = (unsigned)(row0 * 512 + (((8 * wm + (trp >> 1)) ^ ((((row0 & 3) | (((row0 >> 3) & 1) << 2))) << 1)) << 4) + 8 * (trp & 1));
        const unsigned boff0 = (unsigned)(32768 + (128 * wn + fr) * 128);
        float kd[8];
#pragma unroll
        for (int e = 0; e < 8; ++e) { const int tl = 8 * fq + e; kd[e] = exp2f(L * (float)(dir == 0 ? 31 - tl : tl)); }
        const float kstep = exp2f(L * 32.f);
        f32x4 acc[4][8];
#pragma unroll
        for (int mt = 0; mt < 4; ++mt)
#pragma unroll
            for (int nt = 0; nt < 8; ++nt) acc[mt][nt] = (f32x4){0.f, 0.f, 0.f, 0.f};
        __syncthreads();
        UG_DMA(0);
#pragma unroll 1
        for (int st = 0; st < nst; ++st) {
            asm volatile("s_waitcnt vmcnt(0)" ::: "memory");
            __builtin_amdgcn_s_barrier(); asm volatile("" ::: "memory");
            UG_DMA(st + 1);
            const float sf0 = exp2f(L * (float)(dir == 0 ? ntok - 64 - 64 * st : 64 * st));
            const unsigned sl = lds0 + (unsigned)((st & 1) * SLOT);
#pragma unroll
            for (int ks = 0; ks < 2; ++ks) {
                const float sf = (dir == 0 ? (ks == 0 ? sf0 * kstep : sf0) : (ks == 0 ? sf0 : sf0 * kstep));
                u32x2 alo[4], ahi[4]; u32x4 bfv[4];
#pragma unroll
                for (int mt = 0; mt < 4; ++mt) {
                    const unsigned aa = sl + (a0 ^ (unsigned)(mt << 5)) + (unsigned)(ks * 16384);
                    asm volatile("ds_read_b64_tr_b16 %0, %1" : "=v"(alo[mt]) : "v"(aa));
                    asm volatile("ds_read_b64_tr_b16 %0, %1 offset:2048" : "=v"(ahi[mt]) : "v"(aa));
                }
                const unsigned ba = sl + boff0 + (unsigned)((((4 * ks + fq) ^ ((fr >> 1) & 7))) << 4);
#pragma unroll
                for (int nt = 0; nt < 4; ++nt) asm volatile("ds_read_b128 %0, %1 offset:%c2" : "=v"(bfv[nt]) : "v"(ba), "i"(nt * 2048));
                asm volatile("s_waitcnt lgkmcnt(0)" : "+v"(alo[0]), "+v"(alo[1]), "+v"(alo[2]), "+v"(alo[3]), "+v"(ahi[0]), "+v"(ahi[1]), "+v"(ahi[2]), "+v"(ahi[3]) :: "memory");
                asm volatile("" : "+v"(bfv[0]), "+v"(bfv[1]), "+v"(bfv[2]), "+v"(bfv[3]));
                __builtin_amdgcn_sched_barrier(0);
                bf16x8 af[4];
#pragma unroll
                for (int mt = 0; mt < 4; ++mt) {
                    u32x4 pk;
                    pk.x = pk2(bflo(alo[mt].x) * (kd[0] * sf), bfhi(alo[mt].x) * (kd[1] * sf));
                    pk.y = pk2(bflo(alo[mt].y) * (kd[2] * sf), bfhi(alo[mt].y) * (kd[3] * sf));
                    pk.z = pk2(bflo(ahi[mt].x) * (kd[4] * sf), bfhi(ahi[mt].x) * (kd[5] * sf));
                    pk.w = pk2(bflo(ahi[mt].y) * (kd[6] * sf), bfhi(ahi[mt].y) * (kd[7] * sf));
                    af[mt] = __builtin_bit_cast(bf16x8, pk);
                }
#pragma unroll
                for (int mt = 0; mt < 4; ++mt)
#pragma unroll
                    for (int nt = 0; nt < 4; ++nt) acc[mt][nt] = __builtin_amdgcn_mfma_f32_16x16x32_bf16(af[mt], __builtin_bit_cast(bf16x8, bfv[nt]), acc[mt][nt], 0, 0, 0);
                __builtin_amdgcn_sched_barrier(0);
#pragma unroll
                for (int nt = 0; nt < 4; ++nt) asm volatile("ds_read_b128 %0, %1 offset:%c2" : "=v"(bfv[nt]) : "v"(ba), "i"((nt + 4) * 2048));
                asm volatile("s_waitcnt lgkmcnt(0)" : "+v"(bfv[0]), "+v"(bfv[1]), "+v"(bfv[2]), "+v"(bfv[3]) :: "memory");
                __builtin_amdgcn_sched_barrier(0);
#pragma unroll
                for (int mt = 0; mt < 4; ++mt)
#pragma unroll
                    for (int nt = 0; nt < 4; ++nt) acc[mt][nt + 4] = __builtin_amdgcn_mfma_f32_16x16x32_bf16(af[mt], __builtin_bit_cast(bf16x8, bfv[nt]), acc[mt][nt + 4], 0, 0, 0);
            }
        }
        asm volatile("s_waitcnt vmcnt(0)" ::: "memory");
        bf16_t* sp = Scp + ((size_t)((slot * 4 + h) * 2 + dir) * 512) * 256;
#pragma unroll
        for (int nt = 0; nt < 8; ++nt) {
            bf16_t* rowp = sp + (size_t)(256 * dvh + 128 * wn + 16 * nt + fr) * 256 + 64 * wm + 4 * fq;
#pragma unroll
            for (int mt = 0; mt < 4; ++mt) { u32x2 wv; wv.x = pk2(acc[mt][nt][0], acc[mt][nt][1]); wv.y = pk2(acc[mt][nt][2], acc[mt][nt][3]); *(u32x2*)(rowp + 16 * mt) = wv; }
        }
        __syncthreads();
#undef UG_DMA
    }
}
__device__ __forceinline__ void prefix_phase(Ctx& C, int j) {
    bf16_t* Scp = (bf16_t*)(C.ws + WS_SCP);
    constexpr size_t SSTR = (size_t)8 * 512 * 256;
    for (int idx = C.bid * 512 + C.tid; idx < 8 * 512 * 32; idx += C.G * 512) {
        const int hd = idx >> 14, h = hd >> 1, dir = hd & 1;
        const float gam = 1.0f - exp2f(C.in[17][(j * 2 + dir) * 4 + h]); const float cdec = exp2f(log2f(gam) * 512.f);
        bf16_t* p = Scp + (size_t)idx * 8;
        const u32x4 raw = *(const u32x4*)(p + 32 * SSTR);
        float s[8] = {bflo(raw.x), bfhi(raw.x), bflo(raw.y), bfhi(raw.y), bflo(raw.z), bfhi(raw.z), bflo(raw.w), bfhi(raw.w)};
        *(u32x4*)(p + 32 * SSTR) = (u32x4){0u, 0u, 0u, 0u};
#pragma unroll 1
        for (int qb = 0; qb < 4; ++qb) {
            u32x4 u[8];
#pragma unroll
            for (int q = 0; q < 8; ++q) { const int g = dir == 0 ? 8 * qb + q : 31 - (8 * qb + q); u[q] = *(const u32x4*)(p + (size_t)g * SSTR); }
#pragma unroll
            for (int q = 0; q < 8; ++q) {
                const int g = dir == 0 ? 8 * qb + q : 31 - (8 * qb + q);
                u32x4 o; o.x = pk2(s[0], s[1]); o.y = pk2(s[2], s[3]); o.z = pk2(s[4], s[5]); o.w = pk2(s[6], s[7]);
                *(u32x4*)(p + (size_t)g * SSTR) = o;
                s[0] = s[0] * cdec + bflo(u[q].x); s[1] = s[1] * cdec + bfhi(u[q].x); s[2] = s[2] * cdec + bflo(u[q].y); s[3] = s[3] * cdec + bfhi(u[q].y);
                s[4] = s[4] * cdec + bflo(u[q].z); s[5] = s[5] * cdec + bfhi(u[q].z); s[6] = s[6] * cdec + bflo(u[q].w); s[7] = s[7] * cdec + bfhi(u[q].w);
            }
        }
    }
}

template <int MT, int PV = 0>
__device__ __forceinline__ void readout_units(Ctx& C, int j) {
    const bf16_t* Q = (const bf16_t*)(C.ws + WS_Q); const bf16_t* Kb = (const bf16_t*)(C.ws + WS_K); const bf16_t* Vt = (const bf16_t*)(C.ws + WS_VT);
    const bf16_t* Scp = (const bf16_t*)(C.ws + WS_SCP); bf16_t* GF = (bf16_t*)(C.ws + WS_GF); const bf16_t* GB = (const bf16_t*)(C.ws + WS_GB);
    constexpr int QP = 264, PP = 136;
    constexpr int NROW = 16 * MT;
    LAS bf16_t* Qs = (LAS bf16_t*)C.lds;
    LAS bf16_t* P = (LAS bf16_t*)(C.lds + NROW * QP * 2);
    LAS float* red = (LAS float*)(C.lds + NROW * QP * 2 + NROW * PP * 2);
    const int w = C.wave, tid = C.tid;
    const int nunits = MT == 8 ? 512 : 32;
    for (int u0 = (MT == 8 ? C.bid : C.G - 1 - C.bid); u0 < nunits; u0 += C.G) {
        int h, b, sb = 0;
        if (MT != 8) { h = u0 & 3; sb = (u0 >> 2) & 3; b = 128 + (u0 >> 4); }
        else if (C.G == 256) { const int r = u0 >> 8, x = u0 & 7, idx = (u0 & 255) >> 3, grp = r * 64 + x * 8 + (idx >> 2); h = grp & 3; b = (grp >> 2) * 4 + (idx & 3); }
        else { h = u0 & 3; b = u0 >> 2; }
        const bool lat = b < 128; const int base = lat ? 0 : T, nb = lat ? 128 : 2, bl = lat ? b : b - 128;
        const int g = bl >> 2, slot = lat ? g : 32;
        const int gend = (4 * (g + 1) < nb ? 4 * (g + 1) : nb);
        const int i0 = base + 128 * bl + NROW * sb, il0 = 128 * bl + NROW * sb;
#pragma unroll
        for (int i = 0; i < MT; ++i) { const int c = tid + 512 * i, row = c >> 5, ch = c & 31;
            *(LAS u32x4*)(Qs + row * QP + 8 * ch) = *(const u32x4*)(Q + (size_t)(i0 + row) * 1024 + h * 256 + 8 * ch); }
        __syncthreads();
#pragma unroll 1
        for (int dir = 0; dir < 2; ++dir) {
            int lane_o = C.lane; asm volatile("" : "+v"(lane_o));
            const int fr = lane_o & 15, fq = lane_o >> 4;
            const float gam = 1.0f - exp2f(C.in[17][(j * 2 + dir) * 4 + h]); const float L = log2f(gam);
            f32x4 acc[MT][4];
#pragma unroll
            for (int mt = 0; mt < MT; ++mt)
#pragma unroll
                for (int nt = 0; nt < 4; ++nt) acc[mt][nt] = (f32x4){0.f, 0.f, 0.f, 0.f};
            const int kb_lo = dir == 0 ? 4 * g : bl, kb_hi = dir == 0 ? bl : gend - 1;
            const bf16_t* sb = Scp + ((size_t)((slot * 4 + h) * 2 + dir) * 512) * 256 + (size_t)(64 * w + 16 * (fr >> 2) + (fr & 3)) * 256 + 8 * fq;
#pragma unroll 1
            for (int kq = 0; kq < 4; ++kq) {
                bf16x8 sf[2][4];
#pragma unroll
                for (int k2 = 0; k2 < 2; ++k2)
#pragma unroll
                    for (int nt = 0; nt < 4; ++nt) sf[k2][nt] = *(const bf16x8*)(sb + (size_t)(4 * nt) * 256 + 32 * (2 * kq + k2));
#pragma unroll
                for (int k2 = 0; k2 < 2; ++k2)
#pragma unroll
                    for (int mt = 0; mt < MT; ++mt) { const bf16x8 qf = *(const LAS bf16x8*)(Qs + (16 * mt + fr) * QP + 32 * (2 * kq + k2) + 8 * fq);
#pragma unroll
                        for (int nt = 0; nt < 4; ++nt) acc[mt][nt] = __builtin_amdgcn_mfma_f32_16x16x32_bf16(sf[k2][nt], qf, acc[mt][nt], 0, 0, 0); }
            }
#pragma unroll
            for (int mt = 0; mt < MT; ++mt) {
                const int il = il0 + 16 * mt + fr;
                const int ex = dir == 0 ? il - 512 * g + 1 : gend * 128 - il;
                const float qd = __builtin_amdgcn_exp2f(L * (float)ex);
#pragma unroll
                for (int nt = 0; nt < 4; ++nt) acc[mt][nt] = acc[mt][nt] * qd;
            }
#pragma unroll 1
            for (int kb = kb_lo; kb <= (PV == 2 ? kb_lo - 1 : kb_hi); ++kb) {
                const int j0 = base + 128 * kb;
                {
                    bf16x8 kf[8];
                    const bf16_t* k1 = Kb + (size_t)(j0 + 16 * w + fr) * 1024 + h * 256 + 8 * fq;
#pragma unroll
                    for (int ks = 0; ks < 8; ++ks) kf[ks] = *(const bf16x8*)(k1 + 32 * ks);
                    f32x4 sc[MT];
#pragma unroll
                    for (int mt = 0; mt < MT; ++mt) sc[mt] = (f32x4){0.f, 0.f, 0.f, 0.f};
#pragma unroll
                    for (int ks = 0; ks < 8; ++ks) {
#pragma unroll
                        for (int mt = 0; mt < MT; ++mt) { const bf16x8 qf = *(const LAS bf16x8*)(Qs + (16 * mt + fr) * QP + 32 * ks + 8 * fq);
                            sc[mt] = __builtin_amdgcn_mfma_f32_16x16x32_bf16(kf[ks], qf, sc[mt], 0, 0, 0); }
                        __builtin_amdgcn_sched_barrier(0);
                    }
#pragma unroll
                    for (int mt = 0; mt < MT; ++mt) {
                        const int il = il0 + 16 * mt + fr;
                        float p[4];
#pragma unroll
                        for (int e = 0; e < 4; ++e) { const int jl = 128 * kb + 16 * w + 4 * fq + e; const int rel = dir == 0 ? il - jl : jl - il;
                            p[e] = rel >= 0 ? sc[mt][e] * __builtin_amdgcn_exp2f(L * (float)rel) : 0.f; }
                        u32x2 wv; wv.x = pk2(p[0], p[1]); wv.y = pk2(p[2], p[3]);
                        *(LAS u32x2*)(P + (16 * mt + fr) * PP + 16 * w + 4 * fq) = wv;
                    }
                }
                __syncthreads();
                const bf16_t* vb = Vt + (size_t)(h * 512 + 64 * w + 16 * (fr >> 2) + (fr & 3)) * R + j0 + 8 * fq;
#pragma unroll 1
                for (int kh2 = 0; kh2 < 2; ++kh2) {
                    bf16x8 vf[2][4];
#pragma unroll
                    for (int k2 = 0; k2 < 2; ++k2)
#pragma unroll
                        for (int nt = 0; nt < 4; ++nt) vf[k2][nt] = *(const bf16x8*)(vb + (size_t)(4 * nt) * R + 32 * (2 * kh2 + k2));
#pragma unroll
                    for (int k2 = 0; k2 < 2; ++k2)
#pragma unroll
                        for (int mt = 0; mt < MT; ++mt) { const bf16x8 pf = *(const LAS bf16x8*)(P + (16 * mt + fr) * PP + 32 * (2 * kh2 + k2) + 8 * fq);
#pragma unroll
                            for (int nt = 0; nt < 4; ++nt) acc[mt][nt] = __builtin_amdgcn_mfma_f32_16x16x32_bf16(vf[k2][nt], pf, acc[mt][nt], 0, 0, 0); }
                }
                __syncthreads();
            }
#pragma unroll
            for (int mt = 0; mt < MT; ++mt) {
                float ss = 0.f;
#pragma unroll
                for (int nt = 0; nt < 4; ++nt) ss += (acc[mt][nt][0] * acc[mt][nt][0] + acc[mt][nt][1] * acc[mt][nt][1]) + (acc[mt][nt][2] * acc[mt][nt][2] + acc[mt][nt][3] * acc[mt][nt][3]);
                ss += __shfl_xor(ss, 16); ss += __shfl_xor(ss, 32);
                if (fq == 0) red[(16 * mt + fr) * 8 + w] = ss;
            }
            const size_t off0 = (size_t)(i0 + fr) * 2048 + h * 512 + 64 * w + 16 * fq;
            u32x4 gld[MT][2];
#pragma unroll
            for (int mt = 0; mt < MT; ++mt)
#pragma unroll
                for (int np = 0; np < 2; ++np) gld[mt][np] = *(const u32x4*)((dir == 0 ? (const bf16_t*)GF : GB) + off0 + (size_t)(16 * mt) * 2048 + 8 * np);
            __syncthreads();
#pragma unroll
            for (int mt = 0; mt < MT; ++mt) {
                float tot = 0.f;
#pragma unroll
                for (int w2 = 0; w2 < 8; ++w2) tot += red[(16 * mt + fr) * 8 + w2];
                const float rn = 1.0f / sqrtf(tot * (1.f / 512.f) + NORM_EPS);
#pragma unroll
                for (int np = 0; np < 2; ++np) {
                    const u32x4 g4 = gld[mt][np];
                    acc[mt][2 * np][0] *= siluf(bflo(g4.x)) * rn; acc[mt][2 * np][1] *= siluf(bfhi(g4.x)) * rn;
                    acc[mt][2 * np][2] *= siluf(bflo(g4.y)) * rn; acc[mt][2 * np][3] *= siluf(bfhi(g4.y)) * rn;
                    acc[mt][2 * np + 1][0] *= siluf(bflo(g4.z)) * rn; acc[mt][2 * np + 1][1] *= siluf(bfhi(g4.z)) * rn;
                    acc[mt][2 * np + 1][2] *= siluf(bflo(g4.w)) * rn; acc[mt][2 * np + 1][3] *= siluf(bfhi(g4.w)) * rn;
                }
            }
            if (dir == 1) {
#pragma unroll
                for (int mt = 0; mt < MT; ++mt)
#pragma unroll
                    for (int np = 0; np < 2; ++np) gld[mt][np] = *(const u32x4*)(GF + off0 + (size_t)(16 * mt) * 2048 + 8 * np);
#pragma unroll
                for (int mt = 0; mt < MT; ++mt)
#pragma unroll
                    for (int np = 0; np < 2; ++np) { const u32x4 yp = gld[mt][np];
                        acc[mt][2 * np][0] += bflo(yp.x); acc[mt][2 * np][1] += bfhi(yp.x); acc[mt][2 * np][2] += bflo(yp.y); acc[mt][2 * np][3] += bfhi(yp.y);
                        acc[mt][2 * np + 1][0] += bflo(yp.z); acc[mt][2 * np + 1][1] += bfhi(yp.z); acc[mt][2 * np + 1][2] += bflo(yp.w); acc[mt][2 * np + 1][3] += bfhi(yp.w); }
            }
            if (PV != 4) {
#pragma unroll
                for (int mt = 0; mt < MT; ++mt)
#pragma unroll
                    for (int np = 0; np < 2; ++np) { u32x4 wv; wv.x = pk2(acc[mt][2 * np][0], acc[mt][2 * np][1]); wv.y = pk2(acc[mt][2 * np][2], acc[mt][2 * np][3]);
                        wv.z = pk2(acc[mt][2 * np + 1][0], acc[mt][2 * np + 1][1]); wv.w = pk2(acc[mt][2 * np + 1][2], acc[mt][2 * np + 1][3]);
                        *(u32x4*)(GF + off0 + (size_t)(16 * mt) * 2048 + 8 * np) = wv; }
            }
        }
        __syncthreads();
    }
}

template <int PV = 0>
__device__ __forceinline__ void readout_phase(Ctx& C, int j, bool skip_ctx) {
    readout_units<8, PV>(C, j);
    if (!skip_ctx) { __syncthreads(); readout_units<2, PV>(C, j); }
}

__device__ __forceinline__ void phase_p0(Ctx& C) {
    float* modv = (float*)(C.ws + WS_MODV);
    for (int u = C.bid; u < 384; u += C.G) {
        const int i = u / 96, nbk = u % 96;
        gemv2_unit<1>(C, C.in[4] + (size_t)i * 1024 * 6144, 6144, 64 * nbk, C.in[1], C.in[3], C.in[5] + i * 6144, modv + (i * 2 + 0) * 6144, modv + (i * 2 + 1) * 6144, 0, 0);
    }
    float* tabc = (float*)(C.ws + WS_TABC); float* tabs = (float*)(C.ws + WS_TABS);
    for (int idx = C.bid * 512 + C.tid; idx < 320 * 64; idx += C.G * 512) {
        const int ti = idx >> 6, i = idx & 63; const float pos = (float)(ti < 256 ? ti : ti - 256);
        const float inv = exp2f(-(float)i * (13.287712379549449f / 64.0f)); const float ang = pos * inv;
        tabc[idx] = __cosf(ang); tabs[idx] = __sinf(ang);
    }
}
__device__ __forceinline__ void phase_p1(Ctx& C) {
    const float* modv = (const float*)(C.ws + WS_MODV);
    float* s1 = (float*)(C.ws + WS_S1); float* s2 = (float*)(C.ws + WS_S2);
    for (int idx = C.bid * 512 + C.tid; idx < 8192; idx += C.G * 512) {
        const int i = idx >> 11, s = (idx >> 10) & 1, k = idx & 1023;
        s1[idx] = C.in[6][i * 1024 + k] * (1.f + modv[(i * 2 + s) * 6144 + 1024 + k]);
        s2[idx] = C.in[7][i * 1024 + k] * (1.f + modv[(i * 2 + s) * 6144 + 4096 + k]);
    }
    float* cvA = (float*)(C.ws + WS_CVA); float* cvF = (float*)(C.ws + WS_CVF);
    for (int u = C.bid; u < 672; u += C.G) {
        if (u < 320) {
            int i, nbk; if (u < 32) { i = 0; nbk = u; } else if (u < 160) { i = 1; nbk = u - 32; } else if (u < 192) { i = 2; nbk = u - 160; } else { i = 3; nbk = u - 192; }
            const int j = i >> 1; const float* v0 = modv + (i * 2 + 0) * 6144; const float* v1 = modv + (i * 2 + 1) * 6144;
            if ((i & 1) == 0) gemv2_unit<0>(C, C.in[8] + (size_t)j * 1024 * 2048, 2048, 64 * nbk, v0, v1, C.in[9] + j * 2048, cvA + (i * 2) * 8192, cvA + (i * 2 + 1) * 8192, 1, 1024);
            else gemv2_unit<0>(C, C.in[16] + (size_t)j * 1024 * 8192, 8192, 64 * nbk, v0, v1, nullptr, cvA + (i * 2) * 8192, cvA + (i * 2 + 1) * 8192, 2, 0);
        } else {
            const int i = (u - 320) / 88, nbk = (u - 320) % 88;
            const float* v0 = modv + (i * 2 + 0) * 6144 + 3072; const float* v1 = modv + (i * 2 + 1) * 6144 + 3072;
            gemv2_unit<0>(C, C.in[19] + (size_t)i * 1024 * FF2, FF2, 64 * nbk, v0, v1, nullptr, cvF + (i * 2) * FF2, cvF + (i * 2 + 1) * FF2, 1, DFF);
        }
    }
    bf16_t* xs = (bf16_t*)(C.ws + WS_XS); float* stats = (float*)(C.ws + WS_STATS); float* xctx = (float*)(C.ws + WS_XCTX);
    for (int row = C.bid * 8 + C.wave; row < R; row += C.G * 8) {
        const bool lat = row < T; const int s = lat ? 0 : 1;
        const float* src = lat ? C.in[0] + (size_t)row * 1024 : C.in[2] + (size_t)(row - T) * 1024;
        float ss = 0.f;
#pragma unroll
        for (int jj = 0; jj < 4; ++jj) {
            const int k = 4 * C.lane + 256 * jj;
            const f32x4 v = *(const f32x4*)(src + k);
            ss += (v[0] * v[0] + v[1] * v[1]) + (v[2] * v[2] + v[3] * v[3]);
            const f32x4 g = *(const f32x4*)(C.in[6] + k), m = *(const f32x4*)(modv + s * 6144 + 1024 + k);
            u32x2 w; w.x = pk2(v[0] * g[0] * (1.f + m[0]), v[1] * g[1] * (1.f + m[1])); w.y = pk2(v[2] * g[2] * (1.f + m[2]), v[3] * g[3] * (1.f + m[3]));
            *(u32x2*)(xs + (size_t)row * 1024 + k) = w;
        }
#pragma unroll
        for (int off = 1; off < 64; off <<= 1) ss += __shfl_xor(ss, off);
        if (C.lane < 16) stats[(size_t)row * 16 + C.lane] = C.lane == 0 ? ss : 0.f;
    }
    prep_layer(C, 0, 7, 0);
}
__device__ __forceinline__ void phase_final(Ctx& C) {
    const float* stats = (const float*)(C.ws + WS_STATS);
    for (int row = C.bid * 8 + C.wave; row < T; row += C.G * 8) {
        float s = C.lane < 16 ? stats[(size_t)row * 16 + C.lane] : 0.f;
#pragma unroll
        for (int off = 1; off < 64; off <<= 1) s += __shfl_xor(s, off);
        const float r = 1.0f / sqrtf(s * (1.f / 1024.f) + NORM_EPS);
        float* xr = C.out + (size_t)row * 1024;
#pragma unroll
        for (int jj = 0; jj < 4; ++jj) { const int k = 4 * C.lane + 256 * jj; const f32x4 v = *(const f32x4*)(xr + k), g = *(const f32x4*)(C.in[21] + k); *(f32x4*)(xr + k) = v * r * g; }
    }
}

constexpr int NPHASE = 31;
__device__ __forceinline__ void run_phase(Ctx& C, int ph) {
    const int i = (ph - 2) / 7, sub = (ph - 2) % 7, j = i >> 1; const bool conv = (i & 1) == 0;
    const bool last = i == DEPTH - 1;
    float* stats = (float*)(C.ws + WS_STATS);
    const bf16_t* xs = (const bf16_t*)(C.ws + WS_XS);
    constexpr int F_MODV = (int)(WS_MODV / 4), F_S1 = (int)(WS_S1 / 4), F_S2 = (int)(WS_S2 / 4), F_CVA = (int)(WS_CVA / 4), F_CVF = (int)(WS_CVF / 4);
    if (sub == 0) {
        if (conv) { EpiGLU E{C.ws, F_CVA + (i * 2) * 8192, 8192, (int)WS_U, 1024, 0, stats}; gemm_both(C, xs, (const bf16_t*)(C.ws + WS_WA), T, 2048, 1024, E, 0, 8); }
        else {
            EpiWin E{C.ws, F_CVA + (i * 2) * 8192, stats};
            const bf16_t* WA = (const bf16_t*)(C.ws + WS_WA);
            gemm_both(C, xs, WA, T, 8192, 1024, E, 0, 0, 0, 8);
            { pg8::Gemm g{xs, WA + (size_t)2048 * 1024, T, 2048, 1024}; pg8::StaticOrder S; S.init(T, 2048, C.G, C.bid); EpiVt EV{C.ws, F_CVA + (i * 2) * 8192};
              pg8::gemm_phase<EpiVt, pg8::StaticOrder, true, true, true>(C.lds, g, S, EV); }
            gemm_both(C, xs, WA, T, 8192, 1024, E, last ? 4 : 0, last ? 16 : 32, 16, 32);
        }
    } else if (sub == 5) {
        EpiGLU E{C.ws, F_CVF + (i * 2) * FF2, FF2, (int)WS_H, DFF, 1, stats}; gemm_both(C, xs, (const bf16_t*)(C.ws + WS_WF1), last ? T : R, FF2, 1024, E, 0, 0);
        if (!last) { __syncthreads(); relane(C); prep_layer(C, i + 1, 5, C.G == 256 ? 150 : 0); }
    } else {
        const bool f2 = sub == 6;
        const int mgoff = F_MODV + (i * 2) * 6144 + (f2 ? 5120 : 2048);
        const int snoff = f2 ? (last ? -1 : F_S1 + ((i + 1) * 2) * 1024) : F_S2 + (i * 2) * 1024;
        const float* bias = (!f2 && conv) ? C.in[15] + j * 1024 : nullptr;
        const bf16_t* A = (const bf16_t*)(C.ws + (f2 ? WS_H : (conv ? WS_A2 : WS_GF)));
        const bf16_t* Bt = (const bf16_t*)(C.ws + (f2 ? WS_WF2 : WS_WA2));
        const int K = f2 ? DFF : (conv ? 1024 : 2048);
        const bool first = (i == 0 && !f2);
        EpiRes E{C.ws, C.out, first ? C.in[0] : (const float*)C.out, first ? C.in[2] : (const float*)(C.ws + WS_XCTX), bias, mgoff, snoff, stats};
        { pg8::Gemm g{A, Bt, T, 1024, K}; pg8::StaticOrder S; S.init(T, 1024, C.G, C.bid); EpiResBig EB{E};
          pg8::gemm_phase<EpiResBig, pg8::StaticOrder, true, true>(C.lds, g, S, EB); }
        if (!last) { __syncthreads(); relane(C); sgemm_small(C, A, Bt, T, R - T, 1024, K, E, 0, 4); }
    }
}

#define XB_TMO      128
#define XB_XCNT(j)  (256  + 64 * (j))
#define XB_XSUB(j)  (1280 + 64 * (j))
#define XB_XGEN(j)  (2304 + 64 * (j))
#define XB_TOP      3328
#define XB_TOPGEN   3392
#define XCD_BAR_WORDS 3456
#define XB_SPIN_CAP (1u << 20)
__device__ __forceinline__ unsigned xb_ld(unsigned* p)              { return __hip_atomic_load(p, __ATOMIC_RELAXED, __HIP_MEMORY_SCOPE_AGENT); }
__device__ __forceinline__ unsigned xb_add(unsigned* p, unsigned v) { return __hip_atomic_fetch_add(p, v, __ATOMIC_RELAXED, __HIP_MEMORY_SCOPE_AGENT); }
__device__ __forceinline__ unsigned xb_xcc_id() { return (unsigned)__builtin_amdgcn_s_getreg((3 << 11) | 20) & 0xFu; }
#define XB_SPIN(cond, bar) do { unsigned _sp = 0; while (cond) { __builtin_amdgcn_s_sleep(1); \
    if ((++_sp & 255u) == 0u) { if (xb_ld(&(bar)[XB_TMO])) break; if (_sp > XB_SPIN_CAP) { atomicAdd(&(bar)[XB_TMO], 1u); break; } } } } while (0)
struct XcdBarrier { unsigned* bar; unsigned x; volatile LAS unsigned* st; };
__device__ __forceinline__ XcdBarrier xcd_barrier_post(unsigned* bar, volatile LAS unsigned* st) {
    XcdBarrier b; b.bar = bar; b.x = xb_xcc_id(); b.st = st;
    if (threadIdx.x == 0) (void)xb_add(&bar[XB_XCNT(b.x)], 1u);
    return b;
}
__device__ __forceinline__ void xcd_barrier_complete(unsigned* bar, unsigned x, unsigned& nloc, unsigned& nx) {
    const unsigned G = gridDim.x * gridDim.y * gridDim.z;
    unsigned sum, cnt, mine, sp = 0u;
    for (;;) {
        sum = 0u; cnt = 0u; mine = 0u;
#pragma unroll
        for (unsigned j = 0; j < 16; ++j) { const unsigned c = xb_ld(&bar[XB_XCNT(j)]); sum += c; cnt += (c > 0u) ? 1u : 0u; mine = (j == x) ? c : mine; }
        if (sum == G) break;
        __builtin_amdgcn_s_sleep(1);
        if ((++sp & 255u) == 0u) { if (xb_ld(&bar[XB_TMO])) break; if (sp > XB_SPIN_CAP) { atomicAdd(&bar[XB_TMO], 1u); break; } }
    }
    nloc = mine > 0u ? mine : 1u; nx = cnt > 0u ? cnt : 1u;
}
__device__ __forceinline__ void xcd_barrier(const XcdBarrier& b) {
    asm volatile("s_waitcnt vmcnt(0)" ::: "memory");
    __syncthreads();
    if (threadIdx.x == 0) {
        unsigned* bar = b.bar;
        __builtin_amdgcn_s_waitcnt(0);
        unsigned nloc = b.st[0], nx = b.st[1];
        if (nloc == 0u) { xcd_barrier_complete(bar, b.x, nloc, nx); b.st[0] = nloc; b.st[1] = nx; }
        const unsigned old = xb_add(&bar[XB_XSUB(b.x)], 1u);
        const unsigned gen = old / nloc;
        if (old + 1u == (gen + 1u) * nloc) {
            __builtin_amdgcn_fence(__ATOMIC_RELEASE, "agent");
            asm volatile("s_waitcnt vmcnt(0)" ::: "memory");
            const unsigned og = xb_add(&bar[XB_TOP], 1u);
            const unsigned tg = og / nx;
            if (og + 1u == (tg + 1u) * nx) xb_add(&bar[XB_TOPGEN], 1u);
            else XB_SPIN(xb_ld(&bar[XB_TOPGEN]) == tg, bar);
            __builtin_amdgcn_fence(__ATOMIC_ACQUIRE, "agent");
            xb_add(&bar[XB_XGEN(b.x)], 1u);
            asm volatile("s_waitcnt vmcnt(0)" ::: "memory");
        } else {
            XB_SPIN(xb_ld(&bar[XB_XGEN(b.x)]) == gen, bar);
            __builtin_amdgcn_fence(__ATOMIC_ACQUIRE, "agent");
            asm volatile("s_waitcnt vmcnt(0)" ::: "memory");
        }
    }
    __syncthreads();
}
constexpr int MISC_OFF = 131072 + 320;
constexpr int CW_BAR = 4096;

#ifndef PROBE_DUP
#define PROBE_DUP 0
#endif
#if ONE_LAUNCH
template <int PH> __device__ __forceinline__ void phase_body(Ctx& C) {
    constexpr int i = (PH - 2) / 7, sub = (PH - 2) % 7, j = i >> 1; constexpr bool conv = (i & 1) == 0;
    if (PH == 0) phase_p0(C);
    else if (PH == 1) phase_p1(C);
    else if (PH == 30) phase_final(C);
    else if (sub == 1) { if (i > 0) { prep_layer(C, i, 2, 0); __syncthreads(); } if (conv) dwconv_phase(C, j); else ugemm_phase(C, j); }
    else if (sub == 2) prefix_phase(C, j);
    else if (sub == 3) readout_phase(C, j, i == DEPTH - 1);
    else run_phase(C, PH);
}
template <int PH> __device__ __forceinline__ void one_phase(Ctx& C, const Args& args, const XcdBarrier& bar) {
    if (PH < args.ph_lo || PH >= args.ph_hi) return;
    constexpr int i = (PH - 2) / 7, sub = (PH - 2) % 7; constexpr bool conv = (i & 1) == 0;
    if (PH >= 2 && PH < 30) { if ((sub == 2 || sub == 3) && conv) return; }
    if (PH > args.ph_lo) xcd_barrier(bar);
    relane(C);
    phase_body<PH>(C);
    constexpr bool dup = ((PH >= 2 && PH < 30) && (((PROBE_DUP & 1) && (sub == 0 || sub == 5)) || ((PROBE_DUP & 2) && sub == 1 && !conv) || ((PROBE_DUP & 4) && sub == 1 && conv))) || ((PROBE_DUP & 16) && PH < 2);
    if constexpr (dup) { xcd_barrier(bar); phase_body<PH>(C); }
}
template <int... PHS> __device__ __forceinline__ void all_phases(Ctx& C, const Args& args, const XcdBarrier& bar, std::integer_sequence<int, PHS...>) { (one_phase<PHS>(C, args, bar), ...); }
__global__ void __launch_bounds__(512, 2) mega_kernel(Args args) {
    extern __shared__ __attribute__((aligned(16))) unsigned char lds_raw[];
    Ctx C;
    C.lds = (LAS unsigned char*)lds_raw; C.tid = threadIdx.x; C.lane = C.tid & 63; C.wave = __builtin_amdgcn_readfirstlane(C.tid >> 6); C.G = gridDim.x; C.bid = blockIdx.x;
    C.in = args.in; C.out = args.out; C.ws = args.ws;
    volatile LAS unsigned* MISC = (volatile LAS unsigned*)(C.lds + MISC_OFF);
    if (C.tid < 32) MISC[C.tid] = 0u;
    __syncthreads();
    XcdBarrier bar = xcd_barrier_post((unsigned*)(C.ws + WS_CTL) + CW_BAR, MISC + 8);
    all_phases(C, args, bar, std::make_integer_sequence<int, NPHASE>{});
}

#endif
#if !ONE_LAUNCH
template <int KIND>
__global__ void __launch_bounds__(512, 2) phase_kernel(Args args) {
    extern __shared__ __attribute__((aligned(16))) unsigned char lds_raw[];
    Ctx C;
    C.lds = (LAS unsigned char*)lds_raw; C.tid = threadIdx.x; C.lane = C.tid & 63; C.wave = __builtin_amdgcn_readfirstlane(C.tid >> 6); C.G = gridDim.x; C.bid = blockIdx.x;
    C.in = args.in; C.out = args.out; C.ws = args.ws;
    const int ph = args.ph_lo;
    if (KIND == 0) phase_p0(C);
    else if (KIND == 1) phase_p1(C);
    else if (KIND == 30) phase_final(C);
    else {
        const int i = (ph - 2) / 7, j = i >> 1; const bool conv = (i & 1) == 0;
        if (KIND == 2) prefix_phase(C, j);
        else if (KIND == 4) { if (i > 0) { prep_layer(C, i, 2, 0); __syncthreads(); } if (conv) dwconv_phase(C, j); else ugemm_phase(C, j); }
        else if (KIND == 5) readout_phase(C, j, i == DEPTH - 1);
        else run_phase(C, ph);
    }
}

#endif
#ifndef PROBE_RD
#define PROBE_RD 0
#endif
#if PROBE_RD
__global__ void __launch_bounds__(512, 2) probe_read_kernel(Args args) {
    extern __shared__ __attribute__((aligned(16))) unsigned char lds_raw[];
    Ctx C;
    C.lds = (LAS unsigned char*)lds_raw; C.tid = threadIdx.x; C.lane = C.tid & 63; C.wave = __builtin_amdgcn_readfirstlane(C.tid >> 6); C.G = gridDim.x; C.bid = blockIdx.x;
    C.in = args.in; C.out = args.out; C.ws = args.ws;
    readout_phase<PROBE_RD>(C, 1, true);
}
#endif
extern "C" void kernel_launch(void* const* d_in, const int* in_sizes, int n_in, void* d_out, int out_size, void* d_ws, size_t ws_size, hipStream_t stream) {
    static int grid = 0;
    if (grid == 0) {
        if (n_in != 22 || out_size != T * D || ws_size < WS_END + (PROBE_RD ? 20 * MiB : 0)) { fprintf(stderr, "kernel_launch: unexpected problem (n_in %d out %d ws %zu, need %zu)\n", n_in, out_size, ws_size, (size_t)WS_END); grid = -1; return; }
        int dev = 0, cus = 0;
        if (hipGetDevice(&dev) != hipSuccess || hipDeviceGetAttribute(&cus, hipDeviceAttributeMultiprocessorCount, dev) != hipSuccess) { grid = -1; return; }
        bool ok = true;
#if !ONE_LAUNCH
        ok &= hipFuncSetAttribute((const void*)phase_kernel<0>, hipFuncAttributeMaxDynamicSharedMemorySize, LDS_BYTES) == hipSuccess;
        ok &= hipFuncSetAttribute((const void*)phase_kernel<1>, hipFuncAttributeMaxDynamicSharedMemorySize, LDS_BYTES) == hipSuccess;
        ok &= hipFuncSetAttribute((const void*)phase_kernel<2>, hipFuncAttributeMaxDynamicSharedMemorySize, LDS_BYTES) == hipSuccess;
        ok &= hipFuncSetAttribute((const void*)phase_kernel<3>, hipFuncAttributeMaxDynamicSharedMemorySize, LDS_BYTES) == hipSuccess;
        ok &= hipFuncSetAttribute((const void*)phase_kernel<4>, hipFuncAttributeMaxDynamicSharedMemorySize, LDS_BYTES) == hipSuccess;
        ok &= hipFuncSetAttribute((const void*)phase_kernel<5>, hipFuncAttributeMaxDynamicSharedMemorySize, LDS_BYTES) == hipSuccess;
        ok &= hipFuncSetAttribute((const void*)phase_kernel<30>, hipFuncAttributeMaxDynamicSharedMemorySize, LDS_BYTES) == hipSuccess;
#endif
#if ONE_LAUNCH
        ok &= hipFuncSetAttribute((const void*)mega_kernel, hipFuncAttributeMaxDynamicSharedMemorySize, LDS_BYTES) == hipSuccess;
#endif
        if (!ok) { fprintf(stderr, "kernel_launch: hipFuncSetAttribute failed\n"); grid = -1; return; }
        grid = cus > 0 ? cus : 256;
    }
    if (grid < 0) return;
    Args a{};
    for (int i = 0; i < 22; ++i) a.in[i] = (const float*)d_in[i];
    a.out = (float*)d_out; a.ws = (unsigned char*)d_ws;
#if ONE_LAUNCH
    if (hipMemsetAsync((char*)d_ws + WS_CTL, 0, 65536, stream) != hipSuccess) { fprintf(stderr, "kernel_launch: memset failed\n"); return; }
    a.ph_lo = 0; a.ph_hi = NPHASE;
    hipLaunchKernelGGL(mega_kernel, dim3(grid), dim3(512), LDS_BYTES, stream, a);
    return;
#endif
#if !ONE_LAUNCH
    for (int ph = 0; ph < NPHASE; ++ph) {
        const int i = (ph - 2) / 7, sub = (ph - 2) % 7;
        if (ph >= 2 && ph < 30) { if ((sub == 2 || sub == 3) && (i & 1) == 0) continue; }
        a.ph_lo = ph; a.ph_hi = ph + 1;
        const dim3 g(grid), b(512);
        if (ph == 0) hipLaunchKernelGGL(phase_kernel<0>, g, b, LDS_BYTES, stream, a);
        else if (ph == 1) hipLaunchKernelGGL(phase_kernel<1>, g, b, LDS_BYTES, stream, a);
        else if (ph == 30) hipLaunchKernelGGL(phase_kernel<30>, g, b, LDS_BYTES, stream, a);
        else if (sub == 2) hipLaunchKernelGGL(phase_kernel<2>, g, b, LDS_BYTES, stream, a);
        else if (sub == 1) hipLaunchKernelGGL(phase_kernel<4>, g, b, LDS_BYTES, stream, a);
        else if (sub == 3) hipLaunchKernelGGL(phase_kernel<5>, g, b, LDS_BYTES, stream, a);
        else hipLaunchKernelGGL(phase_kernel<3>, g, b, LDS_BYTES, stream, a);
#ifdef PROBE_G
        if (ph == 30) { Args a2 = a; a2.ph_lo = PROBE_G; a2.ph_hi = PROBE_G + 1; hipLaunchKernelGGL(phase_kernel<3>, g, b, LDS_BYTES, stream, a2); }
#endif
#if PROBE_RD
        if (ph == 30) { hipFuncSetAttribute((const void*)probe_read_kernel, hipFuncAttributeMaxDynamicSharedMemorySize, LDS_BYTES); hipLaunchKernelGGL(probe_read_kernel, g, b, LDS_BYTES, stream, a); }
#endif
        {   const bool conv = (i & 1) == 0;
            const bool dup = ((ph >= 2 && ph < 30) && (((PROBE_DUP & 1) && (sub == 0 || sub == 5)) || ((PROBE_DUP & 2) && sub == 1 && !conv) || ((PROBE_DUP & 4) && sub == 1 && conv))) || ((PROBE_DUP & 16) && ph < 2);
            if (dup) {
                if (ph == 0) hipLaunchKernelGGL(phase_kernel<0>, g, b, LDS_BYTES, stream, a);
                else if (ph == 1) hipLaunchKernelGGL(phase_kernel<1>, g, b, LDS_BYTES, stream, a);
                else if (sub == 2) hipLaunchKernelGGL(phase_kernel<2>, g, b, LDS_BYTES, stream, a);
                else if (sub == 1) hipLaunchKernelGGL(phase_kernel<4>, g, b, LDS_BYTES, stream, a);
                else hipLaunchKernelGGL(phase_kernel<3>, g, b, LDS_BYTES, stream, a);
            } }
    }
#endif
}
```

```cpp
#include <hip/hip_runtime.h>
#include <cstdio>
#include <cstdint>
#include <utility>

#ifndef ONE_LAUNCH
#define ONE_LAUNCH 1
#endif

typedef unsigned short bf16_t;
typedef short bf16x8 __attribute__((ext_vector_type(8)));
typedef float f32x4 __attribute__((ext_vector_type(4)));
typedef float f32x2 __attribute__((ext_vector_type(2)));
typedef unsigned u32x2 __attribute__((ext_vector_type(2)));
typedef unsigned u32x4 __attribute__((ext_vector_type(4)));
typedef __bf16 bf16x2_t __attribute__((ext_vector_type(2)));
typedef short s16x4 __attribute__((ext_vector_type(4)));
#define LAS __attribute__((address_space(3)))

constexpr int D = 1024, T = 16384, TC = 256, R = T + TC, NH = 4, DK = 256, DV = 512, QKW = 1024, VW = 2048, INW = 8192, DFF = 2816, FF2 = 5632, CK = 31, DEPTH = 4;
constexpr int NSLOT = 33;
constexpr float NORM_EPS = 1e-6f, LN_EPS = 1e-5f;

constexpr size_t MiB = 1u << 20, KiB = 1u << 10;
constexpr size_t WS_CTL = 0, CTL_ZERO_BYTES = 1 * MiB;
constexpr size_t WS_MODV = 1 * MiB;
constexpr size_t WS_S1 = 1 * MiB + 256 * KiB;
constexpr size_t WS_S2 = 1 * MiB + 320 * KiB;
constexpr size_t WS_CVA = 1 * MiB + 384 * KiB;
constexpr size_t WS_CVF = 1 * MiB + 640 * KiB;
constexpr size_t WS_TABC = 1 * MiB + 832 * KiB;
constexpr size_t WS_TABS = 1 * MiB + 912 * KiB;
constexpr size_t WS_STATS = 2 * MiB;
constexpr size_t WS_XCTX = 4 * MiB;
constexpr size_t WS_WA = 8 * MiB;
constexpr size_t WS_WA2 = 24 * MiB;
constexpr size_t WS_WF1 = 28 * MiB;
constexpr size_t WS_WF2 = 40 * MiB;
constexpr size_t WS_XS = 48 * MiB;
constexpr size_t WS_SCP = 48 * MiB;
constexpr size_t WS_BIG = 114 * MiB;
constexpr size_t WS_Q = WS_BIG, WS_K = WS_BIG + 33 * MiB, WS_VT = WS_BIG + 66 * MiB, WS_GF = WS_BIG + 131 * MiB, WS_GB = WS_BIG + 196 * MiB;
constexpr size_t WS_U = WS_BIG, WS_A2 = WS_BIG + 33 * MiB, WS_H = WS_BIG;
constexpr size_t WS_END = WS_BIG + 261 * MiB;
static_assert((size_t)R * 1024 * 2 <= 33 * MiB && (size_t)R * 2048 * 2 <= 65 * MiB && (size_t)R * DFF * 2 <= 131 * MiB, "map");
static_assert((size_t)NSLOT * 8 * 512 * 256 * 2 <= 66 * MiB, "scp");

constexpr int LDS_BYTES = 147456;

__device__ __forceinline__ unsigned pk2(float lo, float hi) { f32x2 v = {lo, hi}; bf16x2_t b = __builtin_convertvector(v, bf16x2_t); return __builtin_bit_cast(unsigned, b); }
__device__ __forceinline__ float bflo(unsigned u) { return __uint_as_float(u << 16); }
__device__ __forceinline__ float bfhi(unsigned u) { return __uint_as_float(u & 0xffff0000u); }
__device__ __forceinline__ float sigmf(float x) { return __builtin_amdgcn_rcpf(1.f + __builtin_amdgcn_exp2f(-1.4426950408889634f * x)); }
__device__ __forceinline__ float siluf(float x) { return x * sigmf(x); }
__device__ __forceinline__ float wave_sum63(float v) {
    v += __builtin_bit_cast(float, __builtin_amdgcn_update_dpp(0, __builtin_bit_cast(int, v), 0xB1, 0xF, 0xF, false));
    v += __builtin_bit_cast(float, __builtin_amdgcn_update_dpp(0, __builtin_bit_cast(int, v), 0x4E, 0xF, 0xF, false));
    v += __builtin_bit_cast(float, __builtin_amdgcn_update_dpp(0, __builtin_bit_cast(int, v), 0x141, 0xF, 0xF, false));
    v += __builtin_bit_cast(float, __builtin_amdgcn_update_dpp(0, __builtin_bit_cast(int, v), 0x140, 0xF, 0xF, false));
    v += __builtin_bit_cast(float, __builtin_amdgcn_update_dpp(0, __builtin_bit_cast(int, v), 0x142, 0xA, 0xF, false));
    v += __builtin_bit_cast(float, __builtin_amdgcn_update_dpp(0, __builtin_bit_cast(int, v), 0x143, 0xC, 0xF, false));
    return v;
}
__device__ __forceinline__ int perm_glu(int n, int H) { const int g = n >= H ? 16 : 0, oc = n >= H ? n - H : n; return 256 * (oc >> 7) + 128 * ((oc >> 2) & 1) + 32 * ((oc >> 5) & 3) + 4 * ((oc >> 3) & 3) + (oc & 3) + g; }
__device__ __forceinline__ int perm_win(int n) {
    if (n >= 4 * QKW) { const int c = n & 31; return (n & ~31) + 16 * ((c >> 2) & 1) + 4 * (c >> 3) + (c & 3); }
    if (n >= 2 * QKW) return n;
    const int part = n >> 10, hn = n & 1023, h = hn >> 8, d = hn & 255, quarter = d >> 6, idx = d & 63;
    const int Gp = (quarter >> 1) * 4 + (idx >> 4), i = (quarter & 1) * 16 + (idx & 15);
    return part * 1024 + h * 256 + 32 * Gp + i;
}
__device__ __forceinline__ int perm_any(int mode, int n, int H) { return mode == 0 ? n : (mode == 1 ? perm_glu(n, H) : perm_win(n)); }

struct Args { const float* in[22]; float* out; unsigned char* ws; int ph_lo, ph_hi; };

struct Ctx {
    LAS unsigned char* lds;
    int tid, lane, wave, G, bid;
    const float* const* in; float* out; unsigned char* ws;
};

__device__ __forceinline__ void relane(Ctx& C) {
    int wv = C.wave; asm volatile("" : "+s"(wv)); int ln = (int)__builtin_amdgcn_mbcnt_hi(~0u, __builtin_amdgcn_mbcnt_lo(~0u, 0u)); asm volatile("" : "+v"(ln));
    C.wave = wv; C.lane = ln; C.tid = wv * 64 + ln;
}
template <int VSILU>
__device__ __forceinline__ void gemv2_unit(Ctx& C, const float* W, int N, int n0, const float* v0, const float* v1, const float* bias, float* o0, float* o1, int pmode, int H) {
    LAS float* red = (LAS float*)C.lds;
    const int c4 = C.tid & 15, ks = C.tid >> 4;
    f32x4 a0 = {0.f, 0.f, 0.f, 0.f}, a1 = {0.f, 0.f, 0.f, 0.f};
#pragma unroll 8
    for (int i = 0; i < 32; ++i) {
        const int k = ks * 32 + i;
        const f32x4 w = *(const f32x4*)(W + (size_t)k * N + n0 + 4 * c4);
        float x0 = v0[k], x1 = v1[k];
        if (VSILU) { x0 = siluf(x0); x1 = siluf(x1); }
        a0 += w * x0; a1 += w * x1;
    }
#pragma unroll
    for (int e = 0; e < 4; ++e) { red[(ks * 2 + 0) * 64 + 4 * c4 + e] = a0[e]; red[(ks * 2 + 1) * 64 + 4 * c4 + e] = a1[e]; }
    __syncthreads();
    if (C.tid < 128) {
        const int s = C.tid >> 6, col = C.tid & 63; float sum = 0.f;
#pragma unroll 8
        for (int k2 = 0; k2 < 32; ++k2) sum += red[(k2 * 2 + s) * 64 + col];
        const int n = n0 + col; if (bias) sum += bias[n];
        (s ? o1 : o0)[perm_any(pmode, n, H)] = sum;
    }
    __syncthreads();
}

struct PrepItem { const float* W; bf16_t* WT; int K, N, pmode, H, k0, n0; };
__device__ __forceinline__ bool prep_decode(Ctx& C, int i, int part, int it, PrepItem& P) {
    const int j = i >> 1; const bool conv = (i & 1) == 0;
    const int I_A = (part & 1) ? (conv ? 16 * 64 : 16 * 256) : 0, I_A2 = (part & 4) ? (conv ? 16 * 32 : 32 * 32) : 0, I_F1 = (part & 2) ? 16 * 176 : 0, I_F2 = (part & 2) ? 44 * 32 : 0;
    if (it >= I_A + I_A2 + I_F1 + I_F2) return false;
    int r = it;
    if (r < I_A) { if (conv) { P.W = C.in[8] + (size_t)j * 1024 * 2048; P.K = 1024; P.N = 2048; P.pmode = 1; P.H = 1024; } else { P.W = C.in[16] + (size_t)j * 1024 * 8192; P.K = 1024; P.N = 8192; P.pmode = 2; P.H = 0; }
                   P.WT = (bf16_t*)(C.ws + WS_WA); }
    else if ((r -= I_A) < I_A2) { if (conv) { P.W = C.in[14] + (size_t)j * 1024 * 1024; P.K = 1024; } else { P.W = C.in[18] + (size_t)j * 2048 * 1024; P.K = 2048; }
                   P.N = 1024; P.pmode = 0; P.H = 0; P.WT = (bf16_t*)(C.ws + WS_WA2); }
    else if ((r -= I_A2) < I_F1) { P.W = C.in[19] + (size_t)i * 1024 * FF2; P.K = 1024; P.N = FF2; P.pmode = 1; P.H = DFF; P.WT = (bf16_t*)(C.ws + WS_WF1); }
    else { r -= I_F1; P.W = C.in[20] + (size_t)i * DFF * 1024; P.K = DFF; P.N = 1024; P.pmode = 0; P.H = 0; P.WT = (bf16_t*)(C.ws + WS_WF2); }
    const int nblk = P.N / 32; P.k0 = 64 * (r / nblk); P.n0 = 32 * (r % nblk);
    return true;
}
__device__ __forceinline__ void prep_layer(Ctx& C, int i, int part, int cu_lo) {
    if (C.bid < cu_lo) return;
    LAS float* scr = (LAS float*)(C.lds + C.wave * 16384);
    const int gw = (C.bid - cu_lo) * 8 + C.wave, NGW = (C.G - cu_lo) * 8, lane = C.lane;
    PrepItem P, Pn; f32x4 v[8], vn[8];
    bool have = prep_decode(C, i, part, gw, P);
    if (have) {
#pragma unroll
        for (int q = 0; q < 8; ++q) v[q] = *(const f32x4*)(P.W + (size_t)(P.k0 + 8 * q + (lane >> 3)) * P.N + P.n0 + 4 * (lane & 7));
    }
    for (int it = gw; have; it += NGW) {
        const bool havn = prep_decode(C, i, part, it + NGW, Pn);
        if (havn) {
#pragma unroll
            for (int q = 0; q < 8; ++q) vn[q] = *(const f32x4*)(Pn.W + (size_t)(Pn.k0 + 8 * q + (lane >> 3)) * Pn.N + Pn.n0 + 4 * (lane & 7));
        }
#pragma unroll
        for (int q = 0; q < 8; ++q) { LAS float* d = scr + (8 * q + (lane >> 3)) * 33 + 4 * (lane & 7); d[0] = v[q][0]; d[1] = v[q][1]; d[2] = v[q][2]; d[3] = v[q][3]; }
        asm volatile("s_waitcnt lgkmcnt(0)" ::: "memory");
        const int c = lane & 7;
#pragma unroll
        for (int jj = 0; jj < 4; ++jj) { const int n = (lane >> 3) + 8 * jj; const LAS float* sp = scr + (8 * c) * 33 + n;
            u32x4 o; o.x = pk2(sp[0 * 33], sp[1 * 33]); o.y = pk2(sp[2 * 33], sp[3 * 33]); o.z = pk2(sp[4 * 33], sp[5 * 33]); o.w = pk2(sp[6 * 33], sp[7 * 33]);
            *(u32x4*)(P.WT + (size_t)perm_any(P.pmode, P.n0 + n, P.H) * P.K + P.k0 + 8 * c) = o; }
        asm volatile("s_waitcnt lgkmcnt(0)" ::: "memory");
        P = Pn; have = havn;
#pragma unroll
        for (int q = 0; q < 8; ++q) v[q] = vn[q];
    }
}

__device__ __forceinline__ float row_rs(const float* stats, int row, int fq) {
    const f32x4 p = *(const f32x4*)(stats + (size_t)row * 16 + 4 * fq);
    float s = (p[0] + p[1]) + (p[2] + p[3]);
    s += __shfl_xor(s, 16); s += __shfl_xor(s, 32);
    return 1.0f / sqrtf(s * (1.0f / 1024.0f) + NORM_EPS);
}
struct EpiGLU {
    static constexpr bool STATS = false, NEEDRS = true, PAIR2 = true;
    unsigned char* ws; int cvoff  , cvstride  , outoff  , ldo, act;
    float* stats;
    __device__ __forceinline__ float row_begin(int row, int fq) const { return row_rs((const float*)(ws + WS_STATS), row, fq); }
    __device__ __forceinline__ float item(int row, int colp, f32x4 v0, f32x4 v1, float rs) const {
        const float* cv = (const float*)ws + cvoff + (row < T ? 0 : cvstride);
        const f32x4 ca = *(const f32x4*)(cv + colp), cg = *(const f32x4*)(cv + colp + 16);
        float o[4];
#pragma unroll
        for (int e = 0; e < 4; ++e) { const float a = rs * v0[e] + ca[e], g = rs * v1[e] + cg[e]; o[e] = act == 0 ? a * sigmf(g) : siluf(a) * g; }
        const int oc = 128 * (colp >> 8) + 32 * ((colp >> 5) & 3) + 8 * ((colp >> 2) & 3) + 4 * ((colp >> 7) & 1);
        u32x2 w; w.x = pk2(o[0], o[1]); w.y = pk2(o[2], o[3]);
        *(u32x2*)((bf16_t*)(ws + outoff) + (size_t)row * ldo + oc) = w;
        return 0.f;
    }
    __device__ __forceinline__ void item2(int row, int colp, f32x4 a0, f32x4 g0, f32x4 a1, f32x4 g1, float rs) const {
        const float* cv = (const float*)ws + cvoff + (row < T ? 0 : cvstride);
        const f32x4 ca0 = *(const f32x4*)(cv + colp), cg0 = *(const f32x4*)(cv + colp + 16), ca1 = *(const f32x4*)(cv + colp + 128), cg1 = *(const f32x4*)(cv + colp + 144);
        float o[8];
#pragma unroll
        for (int e = 0; e < 4; ++e) { const float a = rs * a0[e] + ca0[e], g = rs * g0[e] + cg0[e]; o[e] = act == 0 ? a * sigmf(g) : siluf(a) * g;
                                      const float b = rs * a1[e] + ca1[e], h = rs * g1[e] + cg1[e]; o[4 + e] = act == 0 ? b * sigmf(h) : siluf(b) * h; }
        const int oc = 128 * (colp >> 8) + 32 * ((colp >> 5) & 3) + 8 * ((colp >> 2) & 3);
        u32x4 w; w.x = pk2(o[0], o[1]); w.y = pk2(o[2], o[3]); w.z = pk2(o[4], o[5]); w.w = pk2(o[6], o[7]);
        *(u32x4*)((bf16_t*)(ws + outoff) + (size_t)row * ldo + oc) = w;
    }
};
struct EpiRes {
    static constexpr bool STATS = true, NEEDRS = false, PAIR2 = false;
    unsigned char* ws; float* xl; const float* xin  ; const float* cin  ; const float* bias;
    int mgoff  , snoff  ;
    float* stats;
    __device__ __forceinline__ float row_begin(int, int) const { return 1.f; }
    __device__ __forceinline__ float item(int row, int colp, f32x4 v0, f32x4 v1, float) const {
        const bool lat = row < T;
        float* xr = lat ? xl + (size_t)row * 1024 : (float*)(ws + WS_XCTX) + (size_t)(row - T) * 1024;
        const float* xi = lat ? xin + (size_t)row * 1024 : cin + (size_t)(row - T) * 1024;
        const float* mg = (const float*)ws + mgoff + (lat ? 0 : 6144); const float* sn = (const float*)ws + snoff + (lat ? 0 : 1024);
        bf16_t* xs = (bf16_t*)(ws + WS_XS);
        float ss = 0.f;
#pragma unroll
        for (int hlf = 0; hlf < 2; ++hlf) {
            const int c = colp + 16 * hlf; const f32x4 v = hlf ? v1 : v0;
            const f32x4 xo = *(const f32x4*)(xi + c), m4 = *(const f32x4*)(mg + c);
            f32x4 b4 = {0.f, 0.f, 0.f, 0.f}; if (bias) b4 = *(const f32x4*)(bias + c);
            const f32x4 xn = xo + m4 * (v + b4);
            *(f32x4*)(xr + c) = xn;
            ss += (xn[0] * xn[0] + xn[1] * xn[1]) + (xn[2] * xn[2] + xn[3] * xn[3]);
            if (snoff >= 0) { const f32x4 s4 = *(const f32x4*)(sn + c); u32x2 w; w.x = pk2(xn[0] * s4[0], xn[1] * s4[1]); w.y = pk2(xn[2] * s4[2], xn[3] * s4[3]);
                *(u32x2*)(xs + (size_t)row * 1024 + c) = w; }
        }
        return ss;
    }
};
struct EpiWin {
    static constexpr bool STATS = false, NEEDRS = true, PAIR2 = false;
    unsigned char* ws; int cvoff;
    float* stats;
    __device__ __forceinline__ float row_begin(int row, int fq) const { return row_rs((const float*)(ws + WS_STATS), row, fq); }
    __device__ __forceinline__ float item(int row, int colp, f32x4 v0, f32x4 v1, float rs) const {
        const float* cv = (const float*)ws + cvoff + (row < T ? 0 : 8192);
        const f32x4 c0 = *(const f32x4*)(cv + colp), c1 = *(const f32x4*)(cv + colp + 16);
        f32x4 a = v0 * rs + c0, b = v1 * rs + c1;
        if (colp < 2048) {
            if (row < T) {
                const int Gp = (colp >> 5) & 7, idx0 = 16 * (Gp & 3) + (colp & 15);
                const int ti = (Gp >> 2) ? 256 + (row & 63) : (row >> 6);
                const f32x4 cs = *(const f32x4*)((const float*)(ws + WS_TABC) + ti * 64 + idx0), sn = *(const f32x4*)((const float*)(ws + WS_TABS) + ti * 64 + idx0);
                const f32x4 o1 = a * cs - b * sn, o2 = b * cs + a * sn; a = o1; b = o2;
            }
            bf16_t* dst = (bf16_t*)(ws + WS_Q);
            if (colp >= 1024) { dst = (bf16_t*)(ws + WS_K); a = a * 0.0625f; b = b * 0.0625f; }
            const int cp = colp & 1023, c = (cp & ~31) + 2 * (cp & 31);
            u32x4 w; w.x = pk2(a[0], a[1]); w.y = pk2(a[2], a[3]); w.z = pk2(b[0], b[1]); w.w = pk2(b[2], b[3]); *(u32x4*)(dst + (size_t)row * 1024 + c) = w;
        } else if (colp < 4096) {
            const int c = colp - 2048;
            bf16_t* vt = (bf16_t*)(ws + WS_VT);
#pragma unroll
            for (int e = 0; e < 4; ++e) { vt[(size_t)(c + e) * R + row] = (bf16_t)(pk2(a[e], 0.f) & 0xffffu); vt[(size_t)(c + 16 + e) * R + row] = (bf16_t)(pk2(b[e], 0.f) & 0xffffu); }
        } else {
            bf16_t* dst = (bf16_t*)(ws + (colp < 6144 ? WS_GF : WS_GB)); const int cp = (colp - 4096) & 2047, c = (cp & ~31) + 2 * (cp & 31);
            u32x4 w; w.x = pk2(a[0], a[1]); w.y = pk2(a[2], a[3]); w.z = pk2(b[0], b[1]); w.w = pk2(b[2], b[3]); *(u32x4*)(dst + (size_t)row * 2048 + c) = w;
        }
        return 0.f;
    }
};

namespace pg8 {
#define PG8_LAS __attribute__((address_space(3)))
typedef unsigned short bf16_t;
typedef short bf16x8 __attribute__((ext_vector_type(8)));
typedef float f32x4 __attribute__((ext_vector_type(4)));
typedef unsigned u32x4 __attribute__((ext_vector_type(4)));
constexpr int BM = 256, BK = 64, HALF = 128, HTB = HALF * BK * 2  , STAGE_BYTES = 8 * HTB, NXCD = 8, WGM = 8;

__host__ __device__ __forceinline__ int lds_byte(int r, int c) { const int st = (r >> 4) * 2 + (c >> 5), rr = r & 15, cc = c & 31, ob = rr * 64 + cc * 2; return st * 1024 + (ob ^ (((ob >> 9) & 1) << 5)); }
__host__ __device__ __forceinline__ void stage_rc(int b, int& R, int& C) { const int st = b / 1024, sb = b % 1024, swz = sb ^ (((sb >> 9) & 1) << 5); R = (st >> 1) * 16 + swz / 64; C = (st & 1) * 32 + (swz % 64) / 2; }
__host__ __device__ __forceinline__ int perm32(int rho) { const int n = rho >> 4, i = rho & 15; return 8 * (i >> 2) + 4 * n + (i & 3); }

struct Unit { int pm, pn; };
struct Gemm { const bf16_t* A; const bf16_t* Bt; int M, N, K; };

struct StaticOrder {
    int nM, nN, nwg, G, c;
    __host__ __device__ void init(int M, int N, int G_, int c_) { nM = M / BM; nN = N / BM; nwg = nM * nN; G = G_; c = c_; }
    __host__ __device__ bool next(int i, Unit& u) const {
        const long L = (long)i * G + c; if (L >= nwg) return false;
        int wgid = (int)L; { const int q = nwg / NXCD, r = nwg % NXCD, xcd = wgid % NXCD, off = wgid / NXCD; wgid = (xcd < r ? xcd * (q + 1) : r * (q + 1) + (xcd - r) * q) + off; }
        const int nig = WGM * nN, gid = wgid / nig, fm = gid * WGM, gsz = (nM - fm) < WGM ? (nM - fm) : WGM;
        u.pm = fm + ((wgid % nig) % gsz); u.pn = (wgid % nig) / gsz; return true;
    }
    __device__ __forceinline__ void a_ready(const Unit&) const {}
    __device__ __forceinline__ void done(const Unit&) const {}
};

template <class Epi, class Sched, bool ALIGN_EPI = false, bool SP2 = false, bool SWAPMMA = false>
__device__ __forceinline__ void gemm_phase(PG8_LAS unsigned char* lds, const Gemm g, const Sched& S, const Epi& E) {
    int tid = threadIdx.x; asm volatile("" : "+v"(tid));
    const int wid = __builtin_amdgcn_readfirstlane(tid >> 6), lane = tid & 63, wr = wid >> 2, wc = wid & 3, fr = lane & 15, fq = lane >> 4;
    const int K = g.K, nt = K / BK;
    unsigned voffA[2], voffB[2];
#pragma unroll
    for (int i = 0; i < 2; ++i) { int R, C; stage_rc(tid * 16 + i * 8192, R, C); const int Rb = Epi::PERM ? ((R & ~31) + perm32(R & 31)) : R;
        voffA[i] = (unsigned)(R * K + C) * 2u; voffB[i] = (unsigned)(Rb * K + C) * 2u; }
    const size_t kstep = (size_t)(BK * 2);
    const size_t hstep = (size_t)HALF * K * 2;
    const size_t tstep = 2 * hstep;
    const unsigned ldsw = (unsigned)wid * 1024u;
    const int aoff = lds_byte(wr * 64 + fr, fq * 8), boff = lds_byte(wc * 32 + fr, fq * 8);
#define PG8_SA(b, h) (((b) * 2 + (h)) * HTB)
#define PG8_SB(b, h) ((4 + (b) * 2 + (h)) * HTB)
#define PG8_STAGE(bufoff, gbase, voff) do { _Pragma("unroll") for (int _i = 0; _i < 2; ++_i) \
        __builtin_amdgcn_global_load_lds((const unsigned*)((const char*)(gbase) + (voff)[_i]), (PG8_LAS unsigned*)(lds + (bufoff) + ldsw + _i * 8192), 16, 0, 0); } while (0)
#define PG8_LDA(dst, b, h) do { _Pragma("unroll") for (int m = 0; m < 4; ++m) _Pragma("unroll") for (int k = 0; k < 2; ++k) dst[m][k] = *(const PG8_LAS bf16x8*)(lds + PG8_SA(b, h) + aoff + m * 2048 + k * 1024); } while (0)
#define PG8_LDB(dst, b, h) do { _Pragma("unroll") for (int n = 0; n < 2; ++n) _Pragma("unroll") for (int k = 0; k < 2; ++k) dst[n][k] = *(const PG8_LAS bf16x8*)(lds + PG8_SB(b, h) + boff + n * 2048 + k * 1024); } while (0)
#define PG8_MMA(ai, bj, At, Bt) do { __builtin_amdgcn_s_setprio(1); _Pragma("unroll") for (int m = 0; m < 4; ++m) _Pragma("unroll") for (int n = 0; n < 2; ++n) _Pragma("unroll") for (int k = 0; k < 2; ++k) \
        acc[ai][bj][m][n] = SWAPMMA ? __builtin_amdgcn_mfma_f32_16x16x32_bf16(At[m][k], Bt[n][k], acc[ai][bj][m][n], 0, 0, 0) : __builtin_amdgcn_mfma_f32_16x16x32_bf16(Bt[n][k], At[m][k], acc[ai][bj][m][n], 0, 0, 0); __builtin_amdgcn_s_setprio(0); } while (0)
#define PG8_WAIT_V(n) asm volatile("s_waitcnt vmcnt(" #n ")" ::: "memory")
#define PG8_WAIT_L(n) asm volatile("s_waitcnt lgkmcnt(" #n ")" ::: "memory")
#define PG8_BAR __builtin_amdgcn_s_barrier()
#define PG8_SCHED __builtin_amdgcn_sched_barrier(0)
    Unit cur, nxt; int ui = 0;
    if (!S.next(0, cur)) return;
    f32x4 acc[2][2][4][2];
#pragma unroll
    for (int a = 0; a < 2; ++a)
#pragma unroll
        for (int b = 0; b < 2; ++b)
#pragma unroll
            for (int m = 0; m < 4; ++m)
#pragma unroll
                for (int n = 0; n < 2; ++n) acc[a][b][m][n] = (f32x4){0.f, 0.f, 0.f, 0.f};
    bf16x8 At[4][2], B0[2][2], B1[2][2];
    const char* cA = (const char*)g.A + (size_t)cur.pm * tstep; const char* cB = (const char*)g.Bt + (size_t)cur.pn * tstep;
    S.a_ready(cur);
    if constexpr (SP2) {
        PG8_STAGE(PG8_SB(0, 0), cB, voffB); PG8_STAGE(PG8_SB(0, 1), cB + hstep, voffB); PG8_STAGE(PG8_SA(0, 0), cA, voffA); PG8_STAGE(PG8_SA(0, 1), cA + hstep, voffA);
        if (wr == 1) PG8_BAR;
        PG8_WAIT_V(2); PG8_BAR;
        PG8_STAGE(PG8_SB(1, 0), cB + kstep, voffB); PG8_STAGE(PG8_SA(1, 0), cA + kstep, voffA); PG8_STAGE(PG8_SB(1, 1), cB + hstep + kstep, voffB);
        PG8_WAIT_V(6); PG8_BAR;
    } else {
        PG8_STAGE(PG8_SB(0, 0), cB, voffB); PG8_STAGE(PG8_SA(0, 0), cA, voffA); PG8_STAGE(PG8_SB(0, 1), cB + hstep, voffB); PG8_STAGE(PG8_SA(0, 1), cA + hstep, voffA);
        if (wr == 1) PG8_BAR;
        PG8_WAIT_V(4); PG8_BAR;
        PG8_STAGE(PG8_SB(1, 0), cB + kstep, voffB); PG8_STAGE(PG8_SA(1, 0), cA + kstep, voffA); PG8_STAGE(PG8_SB(1, 1), cB + hstep + kstep, voffB);
        PG8_WAIT_V(6); PG8_BAR;
    }
    for (;;) {
        const bool has_next = S.next(ui + 1, nxt);
        const char* nA = has_next ? (const char*)g.A + (size_t)nxt.pm * tstep : cA; const char* nB = has_next ? (const char*)g.Bt + (size_t)nxt.pn * tstep : cB;
        for (int t = 0; t < nt; t += 2) {
            const bool last = (t == nt - 2);
            const char* a1 = cA + (size_t)(t + 1) * kstep;
            const char* a2 = last ? nA : cA + (size_t)(t + 2) * kstep; const char* b2 = last ? nB : cB + (size_t)(t + 2) * kstep;
            const char* a3 = a2 + kstep; const char* b3 = b2 + kstep;
            if (last && has_next) S.a_ready(nxt);
            if constexpr (SP2) {
            PG8_LDB(B0, 0, 0); PG8_LDB(B1, 0, 1); PG8_SCHED; PG8_LDA(At, 0, 0); PG8_STAGE(PG8_SA(1, 1), a1 + hstep, voffA);
            PG8_WAIT_V(8); PG8_WAIT_L(0); PG8_BAR; PG8_MMA(0, 0, At, B0); PG8_MMA(0, 1, At, B1); PG8_BAR; PG8_SCHED;
            PG8_LDA(At, 0, 1); PG8_STAGE(PG8_SB(0, 0), b2, voffB); PG8_STAGE(PG8_SB(0, 1), b2 + hstep, voffB); PG8_STAGE(PG8_SA(0, 0), a2, voffA);
            PG8_WAIT_V(8); PG8_WAIT_L(0); PG8_BAR; PG8_MMA(1, 0, At, B0); PG8_MMA(1, 1, At, B1); PG8_BAR; PG8_SCHED;
            PG8_LDB(B0, 1, 0); PG8_LDB(B1, 1, 1); PG8_SCHED; PG8_LDA(At, 1, 0); PG8_STAGE(PG8_SA(0, 1), a2 + hstep, voffA);
            PG8_WAIT_V(8); PG8_WAIT_L(0); PG8_BAR; PG8_MMA(0, 0, At, B0); PG8_MMA(0, 1, At, B1); PG8_BAR; PG8_SCHED;
            PG8_LDA(At, 1, 1); PG8_STAGE(PG8_SB(1, 0), b3, voffB); PG8_STAGE(PG8_SB(1, 1), b3 + hstep, voffB); PG8_STAGE(PG8_SA(1, 0), a3, voffA);
            PG8_WAIT_V(8); PG8_WAIT_L(0); PG8_BAR; PG8_MMA(1, 0, At, B0); PG8_MMA(1, 1, At, B1); PG8_BAR; PG8_SCHED;
            } else {
            PG8_LDB(B0, 0, 0); PG8_SCHED; PG8_LDA(At, 0, 0); PG8_STAGE(PG8_SA(1, 1), a1 + hstep, voffA);
            PG8_WAIT_L(8); PG8_BAR; PG8_WAIT_L(0); PG8_MMA(0, 0, At, B0); PG8_BAR; PG8_SCHED;
            PG8_LDB(B1, 0, 1); PG8_STAGE(PG8_SB(0, 0), b2, voffB);
            PG8_BAR; PG8_WAIT_L(0); PG8_MMA(0, 1, At, B1); PG8_BAR;
            PG8_LDA(At, 0, 1); PG8_STAGE(PG8_SA(0, 0), a2, voffA);
            PG8_BAR; PG8_WAIT_L(0); PG8_MMA(1, 0, At, B0); PG8_BAR; PG8_SCHED;
            PG8_STAGE(PG8_SB(0, 1), b2 + hstep, voffB);
            PG8_WAIT_V(6); PG8_BAR; PG8_MMA(1, 1, At, B1); PG8_BAR;
            PG8_LDB(B0, 1, 0); PG8_SCHED; PG8_LDA(At, 1, 0); PG8_STAGE(PG8_SA(0, 1), a2 + hstep, voffA);
            PG8_WAIT_L(8); PG8_BAR; PG8_WAIT_L(0); PG8_MMA(0, 0, At, B0); PG8_BAR; PG8_SCHED;
            PG8_LDB(B1, 1, 1); PG8_STAGE(PG8_SB(1, 0), b3, voffB);
            PG8_BAR; PG8_WAIT_L(0); PG8_MMA(0, 1, At, B1); PG8_BAR;
            PG8_LDA(At, 1, 1); PG8_STAGE(PG8_SA(1, 0), a3, voffA);
            PG8_BAR; PG8_WAIT_L(0); PG8_MMA(1, 0, At, B0); PG8_BAR; PG8_SCHED;
            PG8_STAGE(PG8_SB(1, 1), b3 + hstep, voffB);
            PG8_WAIT_V(6); PG8_BAR; PG8_MMA(1, 1, At, B1); PG8_BAR;
            }
        }
        if constexpr (ALIGN_EPI) { if (wr == 0) PG8_BAR; }
        if constexpr (!Epi::AFTER_DRAIN) { E(acc, cur, wr, wc, fr, fq); S.done(cur); }
        if (!has_next) break;
#pragma unroll
        for (int a = 0; a < 2; ++a)
#pragma unroll
            for (int b = 0; b < 2; ++b)
#pragma unroll
                for (int m = 0; m < 4; ++m)
#pragma unroll
                    for (int n = 0; n < 2; ++n) acc[a][b][m][n] = (f32x4){0.f, 0.f, 0.f, 0.f};
        cur = nxt; cA = nA; cB = nB; ++ui;
        if constexpr (ALIGN_EPI) { if (wr == 1) PG8_BAR; }
    }
    PG8_WAIT_V(0);
    if constexpr (!ALIGN_EPI) { if (wr == 0) PG8_BAR; }
    PG8_BAR;
    if constexpr (Epi::AFTER_DRAIN) { E.fused(acc, cur, wr, wc, fr, fq, lds, wid, lane); S.done(cur); }
#undef PG8_SA
#undef PG8_SB
#undef PG8_STAGE
#undef PG8_LDA
#undef PG8_LDB
#undef PG8_MMA
#undef PG8_WAIT_V
#undef PG8_WAIT_L
#undef PG8_BAR
#undef PG8_SCHED
}
}

template <class E0> struct EpiAdapt {
    static constexpr bool PERM = false, AFTER_DRAIN = false;
    E0 e; int col_base;
    __device__ __forceinline__ void operator()(const pg8::f32x4 (&acc)[2][2][4][2], const pg8::Unit& u, int wr, int wc, int fr, int fq) const {
#pragma unroll
        for (int ai = 0; ai < 2; ++ai)
#pragma unroll
            for (int m = 0; m < 4; ++m) {
                const int row = u.pm * 256 + ai * 128 + wr * 64 + m * 16 + fr;
                const float rs = e.row_begin(row, fq);
                float ss = 0.f;
                if constexpr (E0::PAIR2) e.item2(row, col_base + u.pn * 256 + wc * 32 + 4 * fq, acc[ai][0][m][0], acc[ai][0][m][1], acc[ai][1][m][0], acc[ai][1][m][1], rs);
                else {
#pragma unroll
                    for (int bj = 0; bj < 2; ++bj) ss += e.item(row, col_base + u.pn * 256 + bj * 128 + wc * 32 + 4 * fq, acc[ai][bj][m][0], acc[ai][bj][m][1], rs);
                }
                if constexpr (E0::STATS) { ss += __shfl_xor(ss, 16); ss += __shfl_xor(ss, 32); if (fq == 0) e.stats[(size_t)row * 16 + (col_base >> 6) + u.pn * 4 + wc] = ss; }
            }
    }
};
struct EpiResBig {
    static constexpr bool PERM = false, AFTER_DRAIN = false;
    EpiRes e;
    __device__ __forceinline__ void operator()(const pg8::f32x4 (&acc)[2][2][4][2], const pg8::Unit& u, int wr, int wc, int fr, int fq) const {
        const float* mg = (const float*)e.ws + e.mgoff; const float* sn = (const float*)e.ws + e.snoff;
        bf16_t* xs = (bf16_t*)(e.ws + WS_XS);
        const int colb = u.pn * 256 + wc * 32 + 4 * fq;
#pragma unroll
        for (int aq = 0; aq < 4; ++aq) {
            const int ai = aq >> 1, mh = aq & 1;
            const int rowb = u.pm * 256 + ai * 128 + wr * 64 + fr + 32 * mh;
            f32x4 xo[2][2][2];
#pragma unroll
            for (int m = 0; m < 2; ++m)
#pragma unroll
                for (int bj = 0; bj < 2; ++bj)
#pragma unroll
                    for (int hl = 0; hl < 2; ++hl) xo[m][bj][hl] = *(const f32x4*)(e.xin + (size_t)(rowb + 16 * m) * 1024 + colb + 128 * bj + 16 * hl);
#pragma unroll
            for (int m = 0; m < 2; ++m) {
                const int row = rowb + 16 * m; float ss = 0.f;
#pragma unroll
                for (int bj = 0; bj < 2; ++bj)
#pragma unroll
                    for (int hl = 0; hl < 2; ++hl) {
                        const int c = colb + 128 * bj + 16 * hl;
                        const f32x4 m4 = *(const f32x4*)(mg + c);
                        f32x4 b4 = {0.f, 0.f, 0.f, 0.f}; if (e.bias) b4 = *(const f32x4*)(e.bias + c);
                        const f32x4 xn = xo[m][bj][hl] + m4 * (acc[ai][bj][2 * mh + m][hl] + b4);
                        *(f32x4*)(e.xl + (size_t)row * 1024 + c) = xn;
                        ss += (xn[0] * xn[0] + xn[1] * xn[1]) + (xn[2] * xn[2] + xn[3] * xn[3]);
                        if (e.snoff >= 0) { const f32x4 s4 = *(const f32x4*)(sn + c); u32x2 w; w.x = pk2(xn[0] * s4[0], xn[1] * s4[1]); w.y = pk2(xn[2] * s4[2], xn[3] * s4[3]);
                            *(u32x2*)(xs + (size_t)row * 1024 + c) = w; }
                    }
                ss += __shfl_xor(ss, 16); ss += __shfl_xor(ss, 32); if (fq == 0) e.stats[(size_t)row * 16 + u.pn * 4 + wc] = ss;
            }
        }
    }
};
struct EpiVt {
    static constexpr bool PERM = false, AFTER_DRAIN = false;
    unsigned char* ws; int cvoff;
    __device__ __forceinline__ void operator()(const pg8::f32x4 (&acc)[2][2][4][2], const pg8::Unit& u, int wr, int wc, int fr, int fq) const {
        bf16_t* vt = (bf16_t*)(ws + WS_VT);
#pragma unroll
        for (int ai = 0; ai < 2; ++ai)
#pragma unroll
            for (int m = 0; m < 4; ++m) {
                const int rowb = u.pm * 256 + ai * 128 + wr * 64 + m * 16;
                const float rsl = row_rs((const float*)(ws + WS_STATS), rowb + fr, fq);
                float rsv[4];
#pragma unroll
                for (int e = 0; e < 4; ++e) rsv[e] = __shfl(rsl, 4 * fq + e);
                const float* cv = (const float*)ws + cvoff + (rowb < T ? 0 : 8192);
#pragma unroll
                for (int bj = 0; bj < 2; ++bj)
#pragma unroll
                    for (int n = 0; n < 2; ++n) {
                        const int col = 2048 + u.pn * 256 + bj * 128 + wc * 32 + 16 * n + fr;
                        const float c0 = cv[col]; const pg8::f32x4 a = acc[ai][bj][m][n];
                        u32x2 w; w.x = pk2(a[0] * rsv[0] + c0, a[1] * rsv[1] + c0); w.y = pk2(a[2] * rsv[2] + c0, a[3] * rsv[3] + c0);
                        *(u32x2*)(vt + (size_t)(col - 2048) * R + rowb + 4 * fq) = w;
                    }
            }
    }
};
template <class Epi>
__device__ __forceinline__ void sgemm_small(Ctx& C, const bf16_t* A, const bf16_t* Bt, int row_lo, int Mrows, int N, int K, const Epi& E, int n_lo, int n_hi) {
    const int w = C.wave, fr = C.lane & 15, fq = C.lane >> 4;
    const int nM = Mrows / 16, nN = n_hi - n_lo, nU = nM * nN, K8 = K >> 3;
    LAS f32x4* xch = (LAS f32x4*)C.lds;
    LAS float* sx = (LAS float*)(C.lds + 131072 + 1024);
    for (int u = (C.G - 1 - C.bid); u < nU; u += C.G) {
        const int un = n_lo + u / nM, um = u % nM;
        const int row0 = row_lo + 16 * um, col0 = 256 * un;
        f32x4 acc[16];
#pragma unroll
        for (int t = 0; t < 16; ++t) acc[t] = (f32x4){0.f, 0.f, 0.f, 0.f};
        const bf16_t* ap = A + (size_t)(row0 + fr) * K + w * K8 + 8 * fq;
        const bf16_t* bp = Bt + (size_t)(col0 + fr) * K + w * K8 + 8 * fq;
#pragma unroll 1
        for (int k0 = 0; k0 < K8; k0 += 32) {
            const bf16x8 af = *(const bf16x8*)(ap + k0);
            bf16x8 bf[16];
#pragma unroll
            for (int t = 0; t < 16; ++t) bf[t] = *(const bf16x8*)(bp + (size_t)(16 * t) * K + k0);
#pragma unroll
            for (int t = 0; t < 16; ++t) acc[t] = __builtin_amdgcn_mfma_f32_16x16x32_bf16(bf[t], af, acc[t], 0, 0, 0);
        }
#pragma unroll
        for (int t = 0; t < 16; ++t) xch[(w * 16 + t) * 64 + C.lane] = acc[t];
        __syncthreads();
        const int wc = w >> 1, bj = w & 1, t0 = 8 * bj + 2 * wc;
        f32x4 v0 = {0.f, 0.f, 0.f, 0.f}, v1 = v0;
#pragma unroll
        for (int q = 0; q < 8; ++q) { v0 += xch[(q * 16 + t0) * 64 + C.lane]; v1 += xch[(q * 16 + t0 + 1) * 64 + C.lane]; }
        const int row = row0 + fr;
        const float rs = E.row_begin(row, fq);
        float ss = E.item(row, col0 + 128 * bj + 32 * wc + 4 * fq, v0, v1, rs);
        if constexpr (Epi::STATS) {
            ss += __shfl_xor(ss, 16); ss += __shfl_xor(ss, 32);
            if (fq == 0) sx[fr * 8 + w] = ss;
            __syncthreads();
            if (fq == 0 && bj == 0) E.stats[(size_t)row * 16 + un * 4 + wc] = sx[fr * 8 + w] + sx[fr * 8 + w + 1];
        }
        __syncthreads();
    }
}
template <class E0>
__device__ __forceinline__ void gemm_both(Ctx& C, const bf16_t* A, const bf16_t* Bt, int Mbig, int N, int K, const E0& E, int ctx_n_lo, int ctx_n_hi, int nb_lo = 0, int nb_hi = -1) {
    if (nb_hi < 0) nb_hi = N / 256;
    { pg8::Gemm g{A, Bt + (size_t)nb_lo * 256 * K, Mbig, (nb_hi - nb_lo) * 256, K}; pg8::StaticOrder S; S.init(Mbig, (nb_hi - nb_lo) * 256, C.G, C.bid); EpiAdapt<E0> EA{E, nb_lo * 256};
      pg8::gemm_phase<EpiAdapt<E0>, pg8::StaticOrder, true, true>(C.lds, g, S, EA); }
    if (Mbig < R && ctx_n_hi > ctx_n_lo) { __syncthreads(); relane(C); sgemm_small(C, A, Bt, T, R - T, N, K, E, ctx_n_lo, ctx_n_hi); }
}
__device__ __forceinline__ void dwconv_phase(Ctx& C, int j) {
    const bf16_t* U = (const bf16_t*)(C.ws + WS_U); bf16_t* A2 = (bf16_t*)(C.ws + WS_A2);
    const float* dww = C.in[10] + (size_t)j * CK * 1024; const float* dwb = C.in[11] + j * 1024; const float* lng = C.in[12] + j * 1024; const float* lnb = C.in[13] + j * 1024;
    constexpr int TT = 33, NR = TT + 30;
    LAS unsigned char* tile = C.lds; LAS float* part = (LAS float*)(C.lds + NR * 2048);
    const int tid = C.tid;
    constexpr int NUL = (T + TT - 1) / TT, NUC = (TC + TT - 1) / TT;
    f32x2 wt[CK];
#pragma unroll
    for (int jt = 0; jt < CK; ++jt) wt[jt] = *(const f32x2*)(dww + jt * 1024 + 2 * tid);
    const f32x2 b2 = *(const f32x2*)(dwb + 2 * tid), g2 = *(const f32x2*)(lng + 2 * tid), bb2 = *(const f32x2*)(lnb + 2 * tid);
    for (int u = C.bid; u < NUL + NUC; u += C.G) {
        const bool lat = u < NUL; const int base = lat ? 0 : T, n = lat ? T : TC, t0 = TT * (lat ? u : u - NUL);
        const int nv = (n - t0) < TT ? (n - t0) : TT;
        for (int idx = tid; idx < NR * 128; idx += 512) {
            const int rr = idx >> 7, ch = idx & 127, tt = t0 - 15 + rr;
            u32x4 v = {0u, 0u, 0u, 0u};
            if (tt >= 0 && tt < n) v = *(const u32x4*)(U + (size_t)(base + tt) * 1024 + ch * 8);
            *(LAS u32x4*)(tile + rr * 2048 + ch * 16) = v;
        }
        __syncthreads();
        f32x2 o[TT];
#pragma unroll
        for (int t = 0; t < TT; ++t) o[t] = b2;
#pragma unroll
        for (int hb = 0; hb < 3; ++hb) {
            f32x2 xw[41];
#pragma unroll
            for (int r = 0; r < 41; ++r) { const unsigned uu = *(const LAS unsigned*)(tile + (11 * hb + r) * 2048 + tid * 4); xw[r] = (f32x2){bflo(uu), bfhi(uu)}; }
#pragma unroll
            for (int t = 0; t < 11; ++t)
#pragma unroll
                for (int jt = 0; jt < CK; ++jt) o[11 * hb + t] += wt[jt] * xw[t + jt];
        }
#pragma unroll
        for (int t = 0; t < TT; ++t) {
            const float s = wave_sum63(o[t].x + o[t].y), q = wave_sum63(o[t].x * o[t].x + o[t].y * o[t].y);
            if (C.lane == 63) { part[(t * 8 + C.wave) * 2] = s; part[(t * 8 + C.wave) * 2 + 1] = q; }
        }
        __syncthreads();
#pragma unroll
        for (int t = 0; t < TT; ++t) {
            float s = 0.f, q = 0.f;
#pragma unroll
            for (int w = 0; w < 8; ++w) { s += part[(t * 8 + w) * 2]; q += part[(t * 8 + w) * 2 + 1]; }
            const float mean = s * (1.f / 1024.f), var = q * (1.f / 1024.f) - mean * mean, rstd = 1.0f / sqrtf(var + LN_EPS);
            const float y0 = (o[t].x - mean) * rstd * g2.x + bb2.x, y1 = (o[t].y - mean) * rstd * g2.y + bb2.y;
            if (t < nv) *(unsigned*)(A2 + (size_t)(base + t0 + t) * 1024 + 2 * tid) = pk2(siluf(y0), siluf(y1));
        }
        __syncthreads();
    }
}

__device__ __forceinline__ void scan_phase(Ctx& C, int j) {
    const bf16_t* Kb = (const bf16_t*)(C.ws + WS_K); const bf16_t* Vt = (const bf16_t*)(C.ws + WS_VT); bf16_t* Scp = (bf16_t*)(C.ws + WS_SCP);
    constexpr int SLOT = 32768;
    const int fr = C.lane & 15, fq = C.lane >> 4, w = C.wave, lane = C.lane;
    for (int cu = C.bid; cu < 256; cu += C.G) {
        const int hd = cu & 7, sidx = cu >> 3, h = hd >> 1, dir = hd & 1, dk_s = 64 * ((sidx >> 3) & 3), dv_s = 64 * (sidx & 7);
        const float gam = 1.0f - exp2f(C.in[17][(j * 2 + dir) * 4 + h]); const float L = log2f(gam);
        const float cdec = exp2f(L * 128.f);
        const bf16_t* ksrc[2]; const bf16_t* vsrc[2];
#pragma unroll
        for (int p = 0; p < 2; ++p) {
            const int kr = 8 * (2 * w + p) + (lane >> 3), kpos = lane & 7, kc = kpos ^ (((kr >> 3) & 1) << 1) ^ (((kr >> 1) & 1) << 2);
            ksrc[p] = Kb + (size_t)kr * 1024 + h * 256 + dk_s + 8 * kc;
            const int vr = 4 * (2 * w + p) + (lane >> 4), vpos = lane & 15, vc = vpos ^ (vr & 15);
            vsrc[p] = Vt + (size_t)(h * 512 + dv_s + vr) * R + 8 * vc;
        }
        auto tok_of = [&](int st) { const int sc = st < 129 ? st : 129; const int bl = sc < 2 ? (dir == 0 ? sc : 1 - sc) : (dir == 0 ? sc - 2 : 129 - sc); return (sc < 2 ? T : 0) + 128 * bl; };
#define SCAN_DMA(st) do { const int tok_ = tok_of(st); LAS unsigned char* sl_ = C.lds + ((st) & 3) * SLOT + (2 * w) * 1024; \
        __builtin_amdgcn_global_load_lds((const unsigned*)(ksrc[0] + (size_t)tok_ * 1024), (LAS unsigned*)(sl_), 16, 0, 0); \
        __builtin_amdgcn_global_load_lds((const unsigned*)(ksrc[1] + (size_t)tok_ * 1024), (LAS unsigned*)(sl_ + 1024), 16, 0, 0); \
        __builtin_amdgcn_global_load_lds((const unsigned*)(vsrc[0] + tok_), (LAS unsigned*)(sl_ + 16384), 16, 0, 0); \
        __builtin_amdgcn_global_load_lds((const unsigned*)(vsrc[1] + tok_), (LAS unsigned*)(sl_ + 16384 + 1024), 16, 0, 0); } while (0)
        const int mt = w >> 1, nh = w & 1, dkl = 16 * mt;
        const int trq = (fr >> 2), trp = fr & 3, trrow0 = 8 * fq + trq;
        const int trcol0 = (((2 * mt + (trp >> 1)) ^ ((fq & 1) << 1) ^ (((trq >> 1) & 1) << 2)) << 3) + 4 * (trp & 1);
        float kd[4][8];
#pragma unroll
        for (int ks = 0; ks < 4; ++ks)
#pragma unroll
            for (int e = 0; e < 8; ++e) { const int tl = 32 * ks + 8 * fq + e; kd[ks][e] = exp2f(L * (float)(dir == 0 ? 127 - tl : tl)); }
        int voff[2];
#pragma unroll
        for (int nt = 0; nt < 2; ++nt) { const int vr = 32 * nh + 16 * nt + fr; voff[nt] = 16384 + vr * 256; }
        f32x4 acc[2]; acc[0] = (f32x4){0.f, 0.f, 0.f, 0.f}; acc[1] = acc[0];
        const unsigned lds0 = (unsigned)(size_t)C.lds;
        __syncthreads();
        SCAN_DMA(0); SCAN_DMA(1); SCAN_DMA(2);
#pragma unroll 1
        for (int st = 0; st < 130; ++st) {
            asm volatile("s_waitcnt vmcnt(8)" ::: "memory");
            __builtin_amdgcn_s_barrier(); asm volatile("" ::: "memory");
            SCAN_DMA(st + 3);
            {   const bool isctx = st < 2; const int bl = isctx ? (dir == 0 ? st : 1 - st) : (dir == 0 ? st - 2 : 129 - st);
                const bool cp = dir == 0 ? ((bl & 3) == 0) : (isctx ? bl == 1 : (bl & 3) == 3);
                if (cp) {
                    const int slot = isctx ? 32 : (bl >> 2);
                    bf16_t* sp = Scp + ((size_t)((slot * 4 + h) * 2 + dir) * 512) * 256;
#pragma unroll
                    for (int nt = 0; nt < 2; ++nt) { u32x2 wv; wv.x = pk2(acc[nt][0], acc[nt][1]); wv.y = pk2(acc[nt][2], acc[nt][3]);
                        *(u32x2*)(sp + (size_t)(dv_s + 32 * nh + 16 * nt + fr) * 256 + dk_s + dkl + 4 * fq) = wv; }
                } }
            acc[0] = acc[0] * cdec; acc[1] = acc[1] * cdec;
            const unsigned sl = lds0 + (unsigned)((st & 3) * SLOT);
            u32x2 klo[4], khi[4]; u32x4 vfr[4][2];
#pragma unroll
            for (int ks = 0; ks < 4; ++ks) {
                const unsigned ka = sl + (unsigned)(((32 * ks + trrow0) * 64 + trcol0) * 2);
                asm volatile("ds_read_b64_tr_b16 %0, %1" : "=v"(klo[ks]) : "v"(ka));
                asm volatile("ds_read_b64_tr_b16 %0, %1 offset:512" : "=v"(khi[ks]) : "v"(ka));
#pragma unroll
                for (int nt = 0; nt < 2; ++nt) { const int vr = 32 * nh + 16 * nt + fr;
                    const unsigned va = sl + (unsigned)(voff[nt] + (((4 * ks + fq) ^ (vr & 15)) << 4));
                    asm volatile("ds_read_b128 %0, %1" : "=v"(vfr[ks][nt]) : "v"(va)); }
            }
            asm volatile("s_waitcnt lgkmcnt(0)" : "+v"(klo[0]), "+v"(klo[1]), "+v"(klo[2]), "+v"(klo[3]), "+v"(khi[0]), "+v"(khi[1]), "+v"(khi[2]), "+v"(khi[3]) :: "memory");
            asm volatile("" : "+v"(vfr[0][0]), "+v"(vfr[0][1]), "+v"(vfr[1][0]), "+v"(vfr[1][1]), "+v"(vfr[2][0]), "+v"(vfr[2][1]), "+v"(vfr[3][0]), "+v"(vfr[3][1]));
            __builtin_amdgcn_sched_barrier(0);
#pragma unroll
            for (int ks = 0; ks < 4; ++ks) {
                u32x4 pk;
                pk.x = pk2(bflo(klo[ks].x) * kd[ks][0], bfhi(klo[ks].x) * kd[ks][1]);
                pk.y = pk2(bflo(klo[ks].y) * kd[ks][2], bfhi(klo[ks].y) * kd[ks][3]);
                pk.z = pk2(bflo(khi[ks].x) * kd[ks][4], bfhi(khi[ks].x) * kd[ks][5]);
                pk.w = pk2(bflo(khi[ks].y) * kd[ks][6], bfhi(khi[ks].y) * kd[ks][7]);
                const bf16x8 af = __builtin_bit_cast(bf16x8, pk);
#pragma unroll
                for (int nt = 0; nt < 2; ++nt) acc[nt] = __builtin_amdgcn_mfma_f32_16x16x32_bf16(af, __builtin_bit_cast(bf16x8, vfr[ks][nt]), acc[nt], 0, 0, 0);
            }
        }
        asm volatile("s_waitcnt vmcnt(0)" ::: "memory");
        __syncthreads();
#undef SCAN_DMA
    }
}

__device__ __forceinline__ void ugemm_phase(Ctx& C, int j) {
    const bf16_t* Kb = (const bf16_t*)(C.ws + WS_K); const bf16_t* Vt = (const bf16_t*)(C.ws + WS_VT); bf16_t* Scp = (bf16_t*)(C.ws + WS_SCP);
    constexpr int SLOT = 65536;
    const int fr = C.lane & 15, fq = C.lane >> 4, w = C.wave, lane = C.lane;
    const int wm = w >> 1, wn = w & 1;
    const unsigned lds0 = (unsigned)(size_t)C.lds;
    for (int it0 = 0; it0 < 3; ++it0) {
        int set, sub;
        if (it0 < 2) { const int x = C.bid & 7, ii = (C.bid & 255) >> 3; if (C.G != 256 && C.bid >= 256) break; set = it0 * 64 + x * 8 + (ii >> 2); sub = ii & 3; if (C.G != 256) { const int itx = it0 * 256 + C.bid; set = itx >> 2; sub = itx & 3; } }
        else { const int k = C.G - 1 - C.bid; if (k >= 16) break; set = 128 + (k >> 2); sub = k & 3; }
        const int slot = set >> 2, h = set & 3, dir = sub >> 1, dvh = sub & 1;
        const int ntok = slot < 32 ? 512 : 256, tokb = slot < 32 ? 512 * slot : T, nst = ntok / 64;
        const float gam = 1.0f - exp2f(C.in[17][(j * 2 + dir) * 4 + h]); const float L = log2f(gam);
        unsigned ksrc[4], vsrc[4];
#pragma unroll
        for (int p = 0; p < 4; ++p) {
            const int kr = 2 * (4 * w + p) + (lane >> 5), kpos = lane & 31, kc = kpos ^ ((((kr & 3) | (((kr >> 3) & 1) << 2))) << 1);
            ksrc[p] = (unsigned)((tokb + kr) * 1024 + h * 256 + 8 * kc);
            const int vr = 8 * (4 * w + p) + (lane >> 3), vpos = lane & 7, vc = vpos ^ ((vr >> 1) & 7);
            vsrc[p] = (unsigned)((h * 512 + 256 * dvh + vr) * R + tokb + 8 * vc);
        }
#define UG_DMA(st) do { const int s_ = (st) < nst ? (st) : nst - 1; LAS unsigned char* sl_ = C.lds + ((st) & 1) * SLOT + (4 * w) * 1024; \
        _Pragma("unroll") for (int p = 0; p < 4; ++p) { \
            __builtin_amdgcn_global_load_lds((const unsigned*)(Kb + (ksrc[p] + (unsigned)(64 * s_ * 1024))), (LAS unsigned*)(sl_ + p * 1024), 16, 0, 0); \
            __builtin_amdgcn_global_load_lds((const unsigned*)(Vt + (vsrc[p] + (unsigned)(64 * s_))), (LAS unsigned*)(sl_ + 32768 + p * 1024), 16, 0, 0); } } while (0)
        const int trq = fr >> 2, trp = fr & 3;
        const int row0 = 8 * fq + trq;
        const unsigned a0 = (unsigned)(row0 * 512 + (((8 * wm + (trp >> 1)) ^ ((((row0 & 3) | (((row0 >> 3) & 1) << 2))) << 1)) << 4) + 8 * (trp & 1));
        const unsigned boff0 = (unsigned)(32768 + (128 * wn + fr) * 128);
        float kd[8];
#pragma unroll
        for (int e = 0; e < 8; ++e) { const int tl = 8 * fq + e; kd[e] = exp2f(L * (float)(dir == 0 ? 31 - tl : tl)); }
        const float kstep = exp2f(L * 32.f);
        f32x4 acc[4][8];
#pragma unroll
        for (int mt = 0; mt < 4; ++mt)
#pragma unroll
            for (int nt = 0; nt < 8; ++nt) acc[mt][nt] = (f32x4){0.f, 0.f, 0.f, 0.f};
        __syncthreads();
        UG_DMA(0);
#pragma unroll 1
        for (int st = 0; st < nst; ++st) {
            asm volatile("s_waitcnt vmcnt(0)" ::: "memory");
            __builtin_amdgcn_s_barrier(); asm volatile("" ::: "memory");
            UG_DMA(st + 1);
            const float sf0 = exp2f(L * (float)(dir == 0 ? ntok - 64 - 64 * st : 64 * st));
            const unsigned sl = lds0 + (unsigned)((st & 1) * SLOT);
#pragma unroll
            for (int ks = 0; ks < 2; ++ks) {
                const float sf = (dir == 0 ? (ks == 0 ? sf0 * kstep : sf0) : (ks == 0 ? sf0 : sf0 * kstep));
                u32x2 alo[4], ahi[4]; u32x4 bfv[4];
#pragma unroll
                for (int mt = 0; mt < 4; ++mt) {
                    const unsigned aa = sl + (a0 ^ (unsigned)(mt << 5)) + (unsigned)(ks * 16384);
                    asm volatile("ds_read_b64_tr_b16 %0, %1" : "=v"(alo[mt]) : "v"(aa));
                    asm volatile("ds_read_b64_tr_b16 %0, %1 offset:2048" : "=v"(ahi[mt]) : "v"(aa));
                }
                const unsigned ba = sl + boff0 + (unsigned)((((4 * ks + fq) ^ ((fr >> 1) & 7))) << 4);
#pragma unroll
                for (int nt = 0; nt < 4; ++nt) asm volatile("ds_read_b128 %0, %1 offset:%c2" : "=v"(bfv[nt]) : "v"(ba), "i"(nt * 2048));
                asm volatile("s_waitcnt lgkmcnt(0)" : "+v"(alo[0]), "+v"(alo[1]), "+v"(alo[2]), "+v"(alo[3]), "+v"(ahi[0]), "+v"(ahi[1]), "+v"(ahi[2]), "+v"(ahi[3]) :: "memory");
                asm volatile("" : "+v"(bfv[0]), "+v"(bfv[1]), "+v"(bfv[2]), "+v"(bfv[3]));
                __builtin_amdgcn_sched_barrier(0);
                bf16x8 af[4];
#pragma unroll
                for (int mt = 0; mt < 4; ++mt) {
                    u32x4 pk;
                    pk.x = pk2(bflo(alo[mt].x) * (kd[0] * sf), bfhi(alo[mt].x) * (kd[1] * sf));
                    pk.y = pk2(bflo(alo[mt].y) * (kd[2] * sf), bfhi(alo[mt].y) * (kd[3] * sf));
                    pk.z = pk2(bflo(ahi[mt].x) * (kd[4] * sf), bfhi(ahi[mt].x) * (kd[5] * sf));
                    pk.w = pk2(bflo(ahi[mt].y) * (kd[6] * sf), bfhi(ahi[mt].y) * (kd[7] * sf));
                    af[mt] = __builtin_bit_cast(bf16x8, pk);
                }
#pragma unroll
                for (int mt = 0; mt < 4; ++mt)
#pragma unroll
                    for (int nt = 0; nt < 4; ++nt) acc[mt][nt] = __builtin_amdgcn_mfma_f32_16x16x32_bf16(af[mt], __builtin_bit_cast(bf16x8, bfv[nt]), acc[mt][nt], 0, 0, 0);
                __builtin_amdgcn_sched_barrier(0);
#pragma unroll
                for (int nt = 0; nt < 4; ++nt) asm volatile("ds_read_b128 %0, %1 offset:%c2" : "=v"(bfv[nt]) : "v"(ba), "i"((nt + 4) * 2048));
                asm volatile("s_waitcnt lgkmcnt(0)" : "+v"(bfv[0]), "+v"(bfv[1]), "+v"(bfv[2]), "+v"(bfv[3]) :: "memory");
                __builtin_amdgcn_sched_barrier(0);
#pragma unroll
                for (int mt = 0; mt < 4; ++mt)
#pragma unroll
                    for (int nt = 0; nt < 4; ++nt) acc[mt][nt + 4] = __builtin_amdgcn_mfma_f32_16x16x32_bf16(af[mt], __builtin_bit_cast(bf16x8, bfv[nt]), acc[mt][nt + 4], 0, 0, 0);
            }
        }
        asm volatile("s_waitcnt vmcnt(0)" ::: "memory");
        bf16_t* sp = Scp + ((size_t)((slot * 4 + h) * 2 + dir) * 512) * 256;
#pragma unroll
        for (int nt = 0; nt < 8; ++nt) {
            bf16_t* rowp = sp + (size_t)(256 * dvh + 128 * wn + 16 * nt + fr) * 256 + 64 * wm + 4 * fq;
#pragma unroll
            for (int mt = 0; mt < 4; ++mt) { u32x2 wv; wv.x = pk2(acc[mt][nt][0], acc[mt][nt][1]); wv.y = pk2(acc[mt][nt][2], acc[mt][nt][3]); *(u32x2*)(rowp + 16 * mt) = wv; }
        }
        __syncthreads();
#undef UG_DMA
    }
}
__device__ __forceinline__ void prefix_phase(Ctx& C, int j) {
    bf16_t* Scp = (bf16_t*)(C.ws + WS_SCP);
    constexpr size_t SSTR = (size_t)8 * 512 * 256;
    for (int idx = C.bid * 512 + C.tid; idx < 8 * 512 * 32; idx += C.G * 512) {
        const int hd = idx >> 14, h = hd >> 1, dir = hd & 1;
        const float gam = 1.0f - exp2f(C.in[17][(j * 2 + dir) * 4 + h]); const float cdec = exp2f(log2f(gam) * 512.f);
        bf16_t* p = Scp + (size_t)idx * 8;
        const u32x4 raw = *(const u32x4*)(p + 32 * SSTR);
        float s[8] = {bflo(raw.x), bfhi(raw.x), bflo(raw.y), bfhi(raw.y), bflo(raw.z), bfhi(raw.z), bflo(raw.w), bfhi(raw.w)};
        *(u32x4*)(p + 32 * SSTR) = (u32x4){0u, 0u, 0u, 0u};
#pragma unroll 1
        for (int qb = 0; qb < 4; ++qb) {
            u32x4 u[8];
#pragma unroll
            for (int q = 0; q < 8; ++q) { const int g = dir == 0 ? 8 * qb + q : 31 - (8 * qb + q); u[q] = *(const u32x4*)(p + (size_t)g * SSTR); }
#pragma unroll
            for (int q = 0; q < 8; ++q) {
                const int g = dir == 0 ? 8 * qb + q : 31 - (8 * qb + q);
                u32x4 o; o.x = pk2(s[0], s[1]); o.y = pk2(s[2], s[3]); o.z = pk2(s[4], s[5]); o.w = pk2(s[6], s[7]);
                *(u32x4*)(p + (size_t)g * SSTR) = o;
                s[0] = s[0] * cdec + bflo(u[q].x); s[1] = s[1] * cdec + bfhi(u[q].x); s[2] = s[2] * cdec + bflo(u[q].y); s[3] = s[3] * cdec + bfhi(u[q].y);
                s[4] = s[4] * cdec + bflo(u[q].z); s[5] = s[5] * cdec + bfhi(u[q].z); s[6] = s[6] * cdec + bflo(u[q].w); s[7] = s[7] * cdec + bfhi(u[q].w);
            }
        }
    }
}

template <int MT, int PV = 0>
__device__ __forceinline__ void readout_units(Ctx& C, int j) {
    const bf16_t* Q = (const bf16_t*)(C.ws + WS_Q); const bf16_t* Kb = (const bf16_t*)(C.ws + WS_K); const bf16_t* Vt = (const bf16_t*)(C.ws + WS_VT);
    const bf16_t* Scp = (const bf16_t*)(C.ws + WS_SCP); bf16_t* GF = (bf16_t*)(C.ws + WS_GF); const bf16_t* GB = (const bf16_t*)(C.ws + WS_GB);
    constexpr int QP = 264, PP = 136;
    constexpr int NROW = 16 * MT;
    LAS bf16_t* Qs = (LAS bf16_t*)C.lds;
    LAS bf16_t* P = (LAS bf16_t*)(C.lds + NROW * QP * 2);
    LAS float* red = (LAS float*)(C.lds + NROW * QP * 2 + NROW * PP * 2);
    const int w = C.wave, tid = C.tid;
    const int nunits = MT == 8 ? 512 : 32;
    for (int u0 = (MT == 8 ? C.bid : C.G - 1 - C.bid); u0 < nunits; u0 += C.G) {
        int h, b, sb = 0;
        if (MT != 8) { h = u0 & 3; sb = (u0 >> 2) & 3; b = 128 + (u0 >> 4); }
        else if (C.G == 256) { const int r = u0 >> 8, x = u0 & 7, idx = (u0 & 255) >> 3, grp = r * 64 + x * 8 + (idx >> 2); h = grp & 3; b = (grp >> 2) * 4 + (idx & 3); }
        else { h = u0 & 3; b = u0 >> 2; }
        const bool lat = b < 128; const int base = lat ? 0 : T, nb = lat ? 128 : 2, bl = lat ? b : b - 128;
        const int g = bl >> 2, slot = lat ? g : 32;
        const int gend = (4 * (g + 1) < nb ? 4 * (g + 1) : nb);
        const int i0 = base + 128 * bl + NROW * sb, il0 = 128 * bl + NROW * sb;
#pragma unroll
        for (int i = 0; i < MT; ++i) { const int c = tid + 512 * i, row = c >> 5, ch = c & 31;
            *(LAS u32x4*)(Qs + row * QP + 8 * ch) = *(const u32x4*)(Q + (size_t)(i0 + row) * 1024 + h * 256 + 8 * ch); }
        __syncthreads();
#pragma unroll 1
        for (int dir = 0; dir < 2; ++dir) {
            int lane_o = C.lane; asm volatile("" : "+v"(lane_o));
            const int fr = lane_o & 15, fq = lane_o >> 4;
            const float gam = 1.0f - exp2f(C.in[17][(j * 2 + dir) * 4 + h]); const float L = log2f(gam);
            f32x4 acc[MT][4];
#pragma unroll
            for (int mt = 0; mt < MT; ++mt)
#pragma unroll
                for (int nt = 0; nt < 4; ++nt) acc[mt][nt] = (f32x4){0.f, 0.f, 0.f, 0.f};
            const int kb_lo = dir == 0 ? 4 * g : bl, kb_hi = dir == 0 ? bl : gend - 1;
            const bf16_t* sb = Scp + ((size_t)((slot * 4 + h) * 2 + dir) * 512) * 256 + (size_t)(64 * w + 16 * (fr >> 2) + (fr & 3)) * 256 + 8 * fq;
#pragma unroll 1
            for (int kq = 0; kq < (PV == 5 ? 0 : 4); ++kq) {
                bf16x8 sf[2][4];
#pragma unroll
                for (int k2 = 0; k2 < 2; ++k2)
#pragma unroll
                    for (int nt = 0; nt < 4; ++nt) sf[k2][nt] = *(const bf16x8*)(sb + (size_t)(4 * nt) * 256 + 32 * (2 * kq + k2));
#pragma unroll
                for (int k2 = 0; k2 < 2; ++k2)
#pragma unroll
                    for (int mt = 0; mt < MT; ++mt) { const bf16x8 qf = *(const LAS bf16x8*)(Qs + (16 * mt + fr) * QP + 32 * (2 * kq + k2) + 8 * fq);
#pragma unroll
                        for (int nt = 0; nt < 4; ++nt) acc[mt][nt] = __builtin_amdgcn_mfma_f32_16x16x32_bf16(sf[k2][nt], qf, acc[mt][nt], 0, 0, 0); }
            }
#pragma unroll
            for (int mt = 0; mt < MT; ++mt) {
                const int il = il0 + 16 * mt + fr;
                const int ex = dir == 0 ? il - 512 * g + 1 : gend * 128 - il;
                const float qd = __builtin_amdgcn_exp2f(L * (float)ex);
#pragma unroll
                for (int nt = 0; nt < 4; ++nt) acc[mt][nt] = acc[mt][nt] * qd;
            }
#pragma unroll 1
            for (int kb = kb_lo; kb <= ((PV == 2 || PV == 5) ? kb_lo - 1 : kb_hi); ++kb) {
                const int j0 = base + 128 * kb;
                {
                    bf16x8 kf[8];
                    const bf16_t* k1 = Kb + (size_t)(j0 + 16 * w + fr) * 1024 + h * 256 + 8 * fq;
#pragma unroll
                    for (int ks = 0; ks < 8; ++ks) kf[ks] = *(const bf16x8*)(k1 + 32 * ks);
                    f32x4 sc[MT];
#pragma unroll
                    for (int mt = 0; mt < MT; ++mt) sc[mt] = (f32x4){0.f, 0.f, 0.f, 0.f};
#pragma unroll
                    for (int ks = 0; ks < 8; ++ks) {
#pragma unroll
                        for (int mt = 0; mt < MT; ++mt) { const bf16x8 qf = *(const LAS bf16x8*)(Qs + (16 * mt + fr) * QP + 32 * ks + 8 * fq);
                            sc[mt] = __builtin_amdgcn_mfma_f32_16x16x32_bf16(kf[ks], qf, sc[mt], 0, 0, 0); }
                        __builtin_amdgcn_sched_barrier(0);
                    }
#pragma unroll
                    for (int mt = 0; mt < MT; ++mt) {
                        const int il = il0 + 16 * mt + fr;
                        float p[4];
#pragma unroll
                        for (int e = 0; e < 4; ++e) { const int jl = 128 * kb + 16 * w + 4 * fq + e; const int rel = dir == 0 ? il - jl : jl - il;
                            p[e] = rel >= 0 ? sc[mt][e] * __builtin_amdgcn_exp2f(L * (float)rel) : 0.f; }
                        u32x2 wv; wv.x = pk2(p[0], p[1]); wv.y = pk2(p[2], p[3]);
                        *(LAS u32x2*)(P + (16 * mt + fr) * PP + 16 * w + 4 * fq) = wv;
                    }
                }
                __syncthreads();
                const bf16_t* vb = Vt + (size_t)(h * 512 + 64 * w + 16 * (fr >> 2) + (fr & 3)) * R + j0 + 8 * fq;
#pragma unroll 1
                for (int kh2 = 0; kh2 < 2; ++kh2) {
                    bf16x8 vf[2][4];
#pragma unroll
                    for (int k2 = 0; k2 < 2; ++k2)
#pragma unroll
                        for (int nt = 0; nt < 4; ++nt) vf[k2][nt] = *(const bf16x8*)(vb + (size_t)(4 * nt) * R + 32 * (2 * kh2 + k2));
#pragma unroll
                    for (int k2 = 0; k2 < 2; ++k2)
#pragma unroll
                        for (int mt = 0; mt < MT; ++mt) { const bf16x8 pf = *(const LAS bf16x8*)(P + (16 * mt + fr) * PP + 32 * (2 * kh2 + k2) + 8 * fq);
#pragma unroll
                            for (int nt = 0; nt < 4; ++nt) acc[mt][nt] = __builtin_amdgcn_mfma_f32_16x16x32_bf16(vf[k2][nt], pf, acc[mt][nt], 0, 0, 0); }
                }
                __syncthreads();
            }
#pragma unroll
            for (int mt = 0; mt < MT; ++mt) {
                float ss = 0.f;
#pragma unroll
                for (int nt = 0; nt < 4; ++nt) ss += (acc[mt][nt][0] * acc[mt][nt][0] + acc[mt][nt][1] * acc[mt][nt][1]) + (acc[mt][nt][2] * acc[mt][nt][2] + acc[mt][nt][3] * acc[mt][nt][3]);
                ss += __shfl_xor(ss, 16); ss += __shfl_xor(ss, 32);
                if (fq == 0) red[(16 * mt + fr) * 8 + w] = ss;
            }
            const size_t off0 = (size_t)(i0 + fr) * 2048 + h * 512 + 64 * w + 16 * fq;
            u32x4 gld[MT][2];
#pragma unroll
            for (int mt = 0; mt < MT; ++mt)
#pragma unroll
                for (int np = 0; np < 2; ++np) gld[mt][np] = *(const u32x4*)((dir == 0 ? (const bf16_t*)GF : GB) + off0 + (size_t)(16 * mt) * 2048 + 8 * np);
            __syncthreads();
#pragma unroll
            for (int mt = 0; mt < MT; ++mt) {
                float tot = 0.f;
#pragma unroll
                for (int w2 = 0; w2 < 8; ++w2) tot += red[(16 * mt + fr) * 8 + w2];
                const float rn = 1.0f / sqrtf(tot * (1.f / 512.f) + NORM_EPS);
#pragma unroll
                for (int np = 0; np < 2; ++np) {
                    const u32x4 g4 = gld[mt][np];
                    acc[mt][2 * np][0] *= siluf(bflo(g4.x)) * rn; acc[mt][2 * np][1] *= siluf(bfhi(g4.x)) * rn;
                    acc[mt][2 * np][2] *= siluf(bflo(g4.y)) * rn; acc[mt][2 * np][3] *= siluf(bfhi(g4.y)) * rn;
                    acc[mt][2 * np + 1][0] *= siluf(bflo(g4.z)) * rn; acc[mt][2 * np + 1][1] *= siluf(bfhi(g4.z)) * rn;
                    acc[mt][2 * np + 1][2] *= siluf(bflo(g4.w)) * rn; acc[mt][2 * np + 1][3] *= siluf(bfhi(g4.w)) * rn;
                }
            }
            if (dir == 1) {
#pragma unroll
                for (int mt = 0; mt < MT; ++mt)
#pragma unroll
                    for (int np = 0; np < 2; ++np) gld[mt][np] = *(const u32x4*)(GF + off0 + (size_t)(16 * mt) * 2048 + 8 * np);
#pragma unroll
                for (int mt = 0; mt < MT; ++mt)
#pragma unroll
                    for (int np = 0; np < 2; ++np) { const u32x4 yp = gld[mt][np];
                        acc[mt][2 * np][0] += bflo(yp.x); acc[mt][2 * np][1] += bfhi(yp.x); acc[mt][2 * np][2] += bflo(yp.y); acc[mt][2 * np][3] += bfhi(yp.y);
                        acc[mt][2 * np + 1][0] += bflo(yp.z); acc[mt][2 * np + 1][1] += bfhi(yp.z); acc[mt][2 * np + 1][2] += bflo(yp.w); acc[mt][2 * np + 1][3] += bfhi(yp.w); }
            }
            if (PV != 4) {
#pragma unroll
                for (int mt = 0; mt < MT; ++mt)
#pragma unroll
                    for (int np = 0; np < 2; ++np) { u32x4 wv; wv.x = pk2(acc[mt][2 * np][0], acc[mt][2 * np][1]); wv.y = pk2(acc[mt][2 * np][2], acc[mt][2 * np][3]);
                        wv.z = pk2(acc[mt][2 * np + 1][0], acc[mt][2 * np + 1][1]); wv.w = pk2(acc[mt][2 * np + 1][2], acc[mt][2 * np + 1][3]);
                        *(u32x4*)(GF + off0 + (size_t)(16 * mt) * 2048 + 8 * np) = wv; }
            }
        }
        __syncthreads();
    }
}

template <int PV = 0>
__device__ __forceinline__ void readout_phase(Ctx& C, int j, bool skip_ctx) {
    readout_units<8, PV>(C, j);
    if (!skip_ctx) { __syncthreads(); readout_units<2, PV>(C, j); }
}

__device__ __forceinline__ void phase_p0(Ctx& C) {
    float* modv = (float*)(C.ws + WS_MODV);
    for (int u = C.bid; u < 384; u += C.G) {
        const int i = u / 96, nbk = u % 96;
        gemv2_unit<1>(C, C.in[4] + (size_t)i * 1024 * 6144, 6144, 64 * nbk, C.in[1], C.in[3], C.in[5] + i * 6144, modv + (i * 2 + 0) * 6144, modv + (i * 2 + 1) * 6144, 0, 0);
    }
    float* tabc = (float*)(C.ws + WS_TABC); float* tabs = (float*)(C.ws + WS_TABS);
    for (int idx = C.bid * 512 + C.tid; idx < 320 * 64; idx += C.G * 512) {
        const int ti = idx >> 6, i = idx & 63; const float pos = (float)(ti < 256 ? ti : ti - 256);
        const float inv = exp2f(-(float)i * (13.287712379549449f / 64.0f)); const float ang = pos * inv;
        tabc[idx] = __cosf(ang); tabs[idx] = __sinf(ang);
    }
}
__device__ __forceinline__ void phase_p1(Ctx& C) {
    const float* modv = (const float*)(C.ws + WS_MODV);
    float* s1 = (float*)(C.ws + WS_S1); float* s2 = (float*)(C.ws + WS_S2);
    for (int idx = C.bid * 512 + C.tid; idx < 8192; idx += C.G * 512) {
        const int i = idx >> 11, s = (idx >> 10) & 1, k = idx & 1023;
        s1[idx] = C.in[6][i * 1024 + k] * (1.f + modv[(i * 2 + s) * 6144 + 1024 + k]);
        s2[idx] = C.in[7][i * 1024 + k] * (1.f + modv[(i * 2 + s) * 6144 + 4096 + k]);
    }
    float* cvA = (float*)(C.ws + WS_CVA); float* cvF = (float*)(C.ws + WS_CVF);
    for (int u = C.bid; u < 672; u += C.G) {
        if (u < 320) {
            int i, nbk; if (u < 32) { i = 0; nbk = u; } else if (u < 160) { i = 1; nbk = u - 32; } else if (u < 192) { i = 2; nbk = u - 160; } else { i = 3; nbk = u - 192; }
            const int j = i >> 1; const float* v0 = modv + (i * 2 + 0) * 6144; const float* v1 = modv + (i * 2 + 1) * 6144;
            if ((i & 1) == 0) gemv2_unit<0>(C, C.in[8] + (size_t)j * 1024 * 2048, 2048, 64 * nbk, v0, v1, C.in[9] + j * 2048, cvA + (i * 2) * 8192, cvA + (i * 2 + 1) * 8192, 1, 1024);
            else gemv2_unit<0>(C, C.in[16] + (size_t)j * 1024 * 8192, 8192, 64 * nbk, v0, v1, nullptr, cvA + (i * 2) * 8192, cvA + (i * 2 + 1) * 8192, 2, 0);
        } else {
            const int i = (u - 320) / 88, nbk = (u - 320) % 88;
            const float* v0 = modv + (i * 2 + 0) * 6144 + 3072; const float* v1 = modv + (i * 2 + 1) * 6144 + 3072;
            gemv2_unit<0>(C, C.in[19] + (size_t)i * 1024 * FF2, FF2, 64 * nbk, v0, v1, nullptr, cvF + (i * 2) * FF2, cvF + (i * 2 + 1) * FF2, 1, DFF);
        }
    }
    bf16_t* xs = (bf16_t*)(C.ws + WS_XS); float* stats = (float*)(C.ws + WS_STATS); float* xctx = (float*)(C.ws + WS_XCTX);
    for (int row = C.bid * 8 + C.wave; row < R; row += C.G * 8) {
        const bool lat = row < T; const int s = lat ? 0 : 1;
        const float* src = lat ? C.in[0] + (size_t)row * 1024 : C.in[2] + (size_t)(row - T) * 1024;
        float ss = 0.f;
#pragma unroll
        for (int jj = 0; jj < 4; ++jj) {
            const int k = 4 * C.lane + 256 * jj;
            const f32x4 v = *(const f32x4*)(src + k);
            ss += (v[0] * v[0] + v[1] * v[1]) + (v[2] * v[2] + v[3] * v[3]);
            const f32x4 g = *(const f32x4*)(C.in[6] + k), m = *(const f32x4*)(modv + s * 6144 + 1024 + k);
            u32x2 w; w.x = pk2(v[0] * g[0] * (1.f + m[0]), v[1] * g[1] * (1.f + m[1])); w.y = pk2(v[2] * g[2] * (1.f + m[2]), v[3] * g[3] * (1.f + m[3]));
            *(u32x2*)(xs + (size_t)row * 1024 + k) = w;
        }
#pragma unroll
        for (int off = 1; off < 64; off <<= 1) ss += __shfl_xor(ss, off);
        if (C.lane < 16) stats[(size_t)row * 16 + C.lane] = C.lane == 0 ? ss : 0.f;
    }
    prep_layer(C, 0, 7, 0);
}
__device__ __forceinline__ void phase_final(Ctx& C) {
    const float* stats = (const float*)(C.ws + WS_STATS);
    for (int row = C.bid * 8 + C.wave; row < T; row += C.G * 8) {
        float s = C.lane < 16 ? stats[(size_t)row * 16 + C.lane] : 0.f;
#pragma unroll
        for (int off = 1; off < 64; off <<= 1) s += __shfl_xor(s, off);
        const float r = 1.0f / sqrtf(s * (1.f / 1024.f) + NORM_EPS);
        float* xr = C.out + (size_t)row * 1024;
#pragma unroll
        for (int jj = 0; jj < 4; ++jj) { const int k = 4 * C.lane + 256 * jj; const f32x4 v = *(const f32x4*)(xr + k), g = *(const f32x4*)(C.in[21] + k); *(f32x4*)(xr + k) = v * r * g; }
    }
}

constexpr int NPHASE = 31;
template <int SK  >
__device__ __forceinline__ void run_phase(Ctx& C, int ph) {
    const int i = (ph - 2) / 7, sub = (ph - 2) % 7, j = i >> 1; const bool conv = (i & 1) == 0;
    const bool last = i == DEPTH - 1;
    float* stats = (float*)(C.ws + WS_STATS);
    const bf16_t* xs = (const bf16_t*)(C.ws + WS_XS);
    constexpr int F_MODV = (int)(WS_MODV / 4), F_S1 = (int)(WS_S1 / 4), F_S2 = (int)(WS_S2 / 4), F_CVA = (int)(WS_CVA / 4), F_CVF = (int)(WS_CVF / 4);
    if constexpr (SK == 0 || SK == 1) {
        if constexpr (SK == 0) { EpiGLU E{C.ws, F_CVA + (i * 2) * 8192, 8192, (int)WS_U, 1024, 0, stats}; gemm_both(C, xs, (const bf16_t*)(C.ws + WS_WA), T, 2048, 1024, E, 0, 8); }
        else {
            EpiWin E{C.ws, F_CVA + (i * 2) * 8192, stats};
            const bf16_t* WA = (const bf16_t*)(C.ws + WS_WA);
            gemm_both(C, xs, WA, T, 8192, 1024, E, 0, 0, 0, 8);
            { pg8::Gemm g{xs, WA + (size_t)2048 * 1024, T, 2048, 1024}; pg8::StaticOrder S; S.init(T, 2048, C.G, C.bid); EpiVt EV{C.ws, F_CVA + (i * 2) * 8192};
              pg8::gemm_phase<EpiVt, pg8::StaticOrder, true, true, true>(C.lds, g, S, EV); }
            gemm_both(C, xs, WA, T, 8192, 1024, E, last ? 4 : 0, last ? 16 : 32, 16, 32);
        }
    } else if constexpr (SK == 2) {
        EpiGLU E{C.ws, F_CVF + (i * 2) * FF2, FF2, (int)WS_H, DFF, 1, stats}; gemm_both(C, xs, (const bf16_t*)(C.ws + WS_WF1), last ? T : R, FF2, 1024, E, 0, 0);
        if (!last) { __syncthreads(); relane(C); prep_layer(C, i + 1, 5, C.G == 256 ? 150 : 0); }
    } else {
        const bool f2 = sub == 6;
        const int mgoff = F_MODV + (i * 2) * 6144 + (f2 ? 5120 : 2048);
        const int snoff = f2 ? (last ? -1 : F_S1 + ((i + 1) * 2) * 1024) : F_S2 + (i * 2) * 1024;
        const float* bias = (!f2 && conv) ? C.in[15] + j * 1024 : nullptr;
        const bf16_t* A = (const bf16_t*)(C.ws + (f2 ? WS_H : (conv ? WS_A2 : WS_GF)));
        const bf16_t* Bt = (const bf16_t*)(C.ws + (f2 ? WS_WF2 : WS_WA2));
        const int K = f2 ? DFF : (conv ? 1024 : 2048);
        const bool first = (i == 0 && !f2);
        EpiRes E{C.ws, C.out, first ? C.in[0] : (const float*)C.out, first ? C.in[2] : (const float*)(C.ws + WS_XCTX), bias, mgoff, snoff, stats};
        { pg8::Gemm g{A, Bt, T, 1024, K}; pg8::StaticOrder S; S.init(T, 1024, C.G, C.bid); EpiResBig EB{E};
          pg8::gemm_phase<EpiResBig, pg8::StaticOrder, true, true>(C.lds, g, S, EB); }
        if (!last) { __syncthreads(); relane(C); sgemm_small(C, A, Bt, T, R - T, 1024, K, E, 0, 4); }
    }
}

#define XB_TMO      128
#define XB_XCNT(j)  (256  + 64 * (j))
#define XB_XSUB(j)  (1280 + 64 * (j))
#define XB_XGEN(j)  (2304 + 64 * (j))
#define XB_TOP      3328
#define XB_TOPGEN   3392
#define XCD_BAR_WORDS 3456
#define XB_SPIN_CAP (1u << 20)
__device__ __forceinline__ unsigned xb_ld(unsigned* p)              { return __hip_atomic_load(p, __ATOMIC_RELAXED, __HIP_MEMORY_SCOPE_AGENT); }
__device__ __forceinline__ unsigned xb_add(unsigned* p, unsigned v) { return __hip_atomic_fetch_add(p, v, __ATOMIC_RELAXED, __HIP_MEMORY_SCOPE_AGENT); }
__device__ __forceinline__ unsigned xb_xcc_id() { return (unsigned)__builtin_amdgcn_s_getreg((3 << 11) | 20) & 0xFu; }
#define XB_SPIN(cond, bar) do { unsigned _sp = 0; while (cond) { __builtin_amdgcn_s_sleep(1); \
    if ((++_sp & 255u) == 0u) { if (xb_ld(&(bar)[XB_TMO])) break; if (_sp > XB_SPIN_CAP) { atomicAdd(&(bar)[XB_TMO], 1u); break; } } } } while (0)
struct XcdBarrier { unsigned* bar; unsigned x; volatile LAS unsigned* st; };
__device__ __forceinline__ XcdBarrier xcd_barrier_post(unsigned* bar, volatile LAS unsigned* st) {
    XcdBarrier b; b.bar = bar; b.x = xb_xcc_id(); b.st = st;
    if (threadIdx.x == 0) (void)xb_add(&bar[XB_XCNT(b.x)], 1u);
    return b;
}
__device__ __forceinline__ void xcd_barrier_complete(unsigned* bar, unsigned x, unsigned& nloc, unsigned& nx) {
    const unsigned G = gridDim.x * gridDim.y * gridDim.z;
    unsigned sum, cnt, mine, sp = 0u;
    for (;;) {
        sum = 0u; cnt = 0u; mine = 0u;
#pragma unroll
        for (unsigned j = 0; j < 16; ++j) { const unsigned c = xb_ld(&bar[XB_XCNT(j)]); sum += c; cnt += (c > 0u) ? 1u : 0u; mine = (j == x) ? c : mine; }
        if (sum == G) break;
        __builtin_amdgcn_s_sleep(1);
        if ((++sp & 255u) == 0u) { if (xb_ld(&bar[XB_TMO])) break; if (sp > XB_SPIN_CAP) { atomicAdd(&bar[XB_TMO], 1u); break; } }
    }
    nloc = mine > 0u ? mine : 1u; nx = cnt > 0u ? cnt : 1u;
}
__device__ __forceinline__ void xcd_barrier(const XcdBarrier& b) {
    asm volatile("s_waitcnt vmcnt(0)" ::: "memory");
    __syncthreads();
    if (threadIdx.x == 0) {
        unsigned* bar = b.bar;
        __builtin_amdgcn_s_waitcnt(0);
        unsigned nloc = b.st[0], nx = b.st[1];
        if (nloc == 0u) { xcd_barrier_complete(bar, b.x, nloc, nx); b.st[0] = nloc; b.st[1] = nx; }
        const unsigned old = xb_add(&bar[XB_XSUB(b.x)], 1u);
        const unsigned gen = old / nloc;
        if (old + 1u == (gen + 1u) * nloc) {
            __builtin_amdgcn_fence(__ATOMIC_RELEASE, "agent");
            asm volatile("s_waitcnt vmcnt(0)" ::: "memory");
            const unsigned og = xb_add(&bar[XB_TOP], 1u);
            const unsigned tg = og / nx;
            if (og + 1u == (tg + 1u) * nx) xb_add(&bar[XB_TOPGEN], 1u);
            else XB_SPIN(xb_ld(&bar[XB_TOPGEN]) == tg, bar);
            __builtin_amdgcn_fence(__ATOMIC_ACQUIRE, "agent");
            xb_add(&bar[XB_XGEN(b.x)], 1u);
            asm volatile("s_waitcnt vmcnt(0)" ::: "memory");
        } else {
            XB_SPIN(xb_ld(&bar[XB_XGEN(b.x)]) == gen, bar);
            __builtin_amdgcn_fence(__ATOMIC_ACQUIRE, "agent");
            asm volatile("s_waitcnt vmcnt(0)" ::: "memory");
        }
    }
    __syncthreads();
}
constexpr int MISC_OFF = 131072 + 320;
constexpr int CW_BAR = 4096;

#ifndef PROBE_DUP
#define PROBE_DUP 0
#endif
#if ONE_LAUNCH
template <int PH> __device__ __forceinline__ void phase_body(Ctx& C) {
    constexpr int i = (PH - 2) / 7, sub = (PH - 2) % 7, j = i >> 1; constexpr bool conv = (i & 1) == 0;
    if (PH == 0) phase_p0(C);
    else if (PH == 1) phase_p1(C);
    else if (PH == 30) phase_final(C);
    else if (sub == 1) { if (i > 0) { prep_layer(C, i, 2, 0); __syncthreads(); } if (conv) dwconv_phase(C, j); else ugemm_phase(C, j); }
    else if (sub == 2) prefix_phase(C, j);
    else if (sub == 3) readout_phase(C, j, i == DEPTH - 1);
    else run_phase<(sub == 0 ? (conv ? 0 : 1) : (sub == 5 ? 2 : 3))>(C, PH);
}
template <int PH> __device__ __forceinline__ void one_phase(Ctx& C, const Args& args, const XcdBarrier& bar) {
    constexpr int i = (PH - 2) / 7, sub = (PH - 2) % 7; constexpr bool conv = (i & 1) == 0;
    if (PH >= 2 && PH < 30) { if ((sub == 2 || sub == 3) && conv) return; }
    if (PH > 0) xcd_barrier(bar);
    relane(C);
    phase_body<PH>(C);
    constexpr bool dup = ((PH >= 2 && PH < 30) && (((PROBE_DUP & 1) && (sub == 0 || sub == 5)) || ((PROBE_DUP & 2) && sub == 1 && !conv) || ((PROBE_DUP & 4) && sub == 1 && conv))) || ((PROBE_DUP & 16) && PH < 2);
    if constexpr (dup) { xcd_barrier(bar); phase_body<PH>(C); }
}
template <int... PHS> __device__ __forceinline__ void all_phases(Ctx& C, const Args& args, const XcdBarrier& bar, std::integer_sequence<int, PHS...>) { (one_phase<PHS>(C, args, bar), ...); }
__global__ void __launch_bounds__(512, 2) mega_kernel(Args args) {
    extern __shared__ __attribute__((aligned(16))) unsigned char lds_raw[];
    Ctx C;
    C.lds = (LAS unsigned char*)lds_raw; C.tid = threadIdx.x; C.lane = C.tid & 63; C.wave = __builtin_amdgcn_readfirstlane(C.tid >> 6); C.G = gridDim.x; C.bid = blockIdx.x;
    C.in = args.in; C.out = args.out; C.ws = args.ws;
    volatile LAS unsigned* MISC = (volatile LAS unsigned*)(C.lds + MISC_OFF);
    if (C.tid < 32) MISC[C.tid] = 0u;
    __syncthreads();
    XcdBarrier bar = xcd_barrier_post((unsigned*)(C.ws + WS_CTL) + CW_BAR, MISC + 8);
    all_phases(C, args, bar, std::make_integer_sequence<int, NPHASE>{});
}

#endif
#if !ONE_LAUNCH
template <int KIND>
__global__ void __launch_bounds__(512, 2) phase_kernel(Args args) {
    extern __shared__ __attribute__((aligned(16))) unsigned char lds_raw[];
    Ctx C;
    C.lds = (LAS unsigned char*)lds_raw; C.tid = threadIdx.x; C.lane = C.tid & 63; C.wave = __builtin_amdgcn_readfirstlane(C.tid >> 6); C.G = gridDim.x; C.bid = blockIdx.x;
    C.in = args.in; C.out = args.out; C.ws = args.ws;
    const int ph = args.ph_lo;
    if (KIND == 0) phase_p0(C);
    else if (KIND == 1) phase_p1(C);
    else if (KIND == 30) phase_final(C);
    else {
        const int i = (ph - 2) / 7, j = i >> 1; const bool conv = (i & 1) == 0;
        if (KIND == 2) prefix_phase(C, j);
        else if (KIND == 4) { if (i > 0) { prep_layer(C, i, 2, 0); __syncthreads(); } if (conv) dwconv_phase(C, j); else ugemm_phase(C, j); }
        else if (KIND == 5) readout_phase(C, j, i == DEPTH - 1);
        else if (KIND == 31) run_phase<0>(C, ph);
        else if (KIND == 32) run_phase<1>(C, ph);
        else if (KIND == 33) run_phase<2>(C, ph);
        else run_phase<3>(C, ph);
    }
}

#endif
#ifndef PROBE_RD
#define PROBE_RD 0
#endif
#if PROBE_RD
__global__ void __launch_bounds__(512, 2) probe_read_kernel(Args args) {
    extern __shared__ __attribute__((aligned(16))) unsigned char lds_raw[];
    Ctx C;
    C.lds = (LAS unsigned char*)lds_raw; C.tid = threadIdx.x; C.lane = C.tid & 63; C.wave = __builtin_amdgcn_readfirstlane(C.tid >> 6); C.G = gridDim.x; C.bid = blockIdx.x;
    C.in = args.in; C.out = args.out; C.ws = args.ws;
    readout_phase<PROBE_RD>(C, 1, true);
}
#endif
extern "C" void kernel_launch(void* const* d_in, const int* in_sizes, int n_in, void* d_out, int out_size, void* d_ws, size_t ws_size, hipStream_t stream) {
    static int grid = 0;
    if (grid == 0) {
        if (n_in != 22 || out_size != T * D || ws_size < WS_END + (PROBE_RD ? 20 * MiB : 0)) { fprintf(stderr, "kernel_launch: unexpected problem (n_in %d out %d ws %zu, need %zu)\n", n_in, out_size, ws_size, (size_t)WS_END); grid = -1; return; }
        int dev = 0, cus = 0;
        if (hipGetDevice(&dev) != hipSuccess || hipDeviceGetAttribute(&cus, hipDeviceAttributeMultiprocessorCount, dev) != hipSuccess) { grid = -1; return; }
        bool ok = true;
#if !ONE_LAUNCH
        ok &= hipFuncSetAttribute((const void*)phase_kernel<0>, hipFuncAttributeMaxDynamicSharedMemorySize, LDS_BYTES) == hipSuccess;
        ok &= hipFuncSetAttribute((const void*)phase_kernel<1>, hipFuncAttributeMaxDynamicSharedMemorySize, LDS_BYTES) == hipSuccess;
        ok &= hipFuncSetAttribute((const void*)phase_kernel<2>, hipFuncAttributeMaxDynamicSharedMemorySize, LDS_BYTES) == hipSuccess;
        ok &= hipFuncSetAttribute((const void*)phase_kernel<31>, hipFuncAttributeMaxDynamicSharedMemorySize, LDS_BYTES) == hipSuccess;
        ok &= hipFuncSetAttribute((const void*)phase_kernel<32>, hipFuncAttributeMaxDynamicSharedMemorySize, LDS_BYTES) == hipSuccess;
        ok &= hipFuncSetAttribute((const void*)phase_kernel<33>, hipFuncAttributeMaxDynamicSharedMemorySize, LDS_BYTES) == hipSuccess;
        ok &= hipFuncSetAttribute((const void*)phase_kernel<34>, hipFuncAttributeMaxDynamicSharedMemorySize, LDS_BYTES) == hipSuccess;
        ok &= hipFuncSetAttribute((const void*)phase_kernel<4>, hipFuncAttributeMaxDynamicSharedMemorySize, LDS_BYTES) == hipSuccess;
        ok &= hipFuncSetAttribute((const void*)phase_kernel<5>, hipFuncAttributeMaxDynamicSharedMemorySize, LDS_BYTES) == hipSuccess;
        ok &= hipFuncSetAttribute((const void*)phase_kernel<30>, hipFuncAttributeMaxDynamicSharedMemorySize, LDS_BYTES) == hipSuccess;
#endif
#if ONE_LAUNCH
        ok &= hipFuncSetAttribute((const void*)mega_kernel, hipFuncAttributeMaxDynamicSharedMemorySize, LDS_BYTES) == hipSuccess;
#endif
        if (!ok) { fprintf(stderr, "kernel_launch: hipFuncSetAttribute failed\n"); grid = -1; return; }
        grid = cus > 0 ? cus : 256;
    }
    if (grid < 0) return;
    Args a{};
    for (int i = 0; i < 22; ++i) a.in[i] = (const float*)d_in[i];
    a.out = (float*)d_out; a.ws = (unsigned char*)d_ws;
#if ONE_LAUNCH
    if (hipMemsetAsync((char*)d_ws + WS_CTL, 0, 65536, stream) != hipSuccess) { fprintf(stderr, "kernel_launch: memset failed\n"); return; }
    a.ph_lo = 0; a.ph_hi = NPHASE;
    hipLaunchKernelGGL(mega_kernel, dim3(grid), dim3(512), LDS_BYTES, stream, a);
    return;
#endif
#if !ONE_LAUNCH
    for (int ph = 0; ph < NPHASE; ++ph) {
        const int i = (ph - 2) / 7, sub = (ph - 2) % 7;
        if (ph >= 2 && ph < 30) { if ((sub == 2 || sub == 3) && (i & 1) == 0) continue; }
        a.ph_lo = ph; a.ph_hi = ph + 1;
        const dim3 g(grid), b(512);
        if (ph == 0) hipLaunchKernelGGL(phase_kernel<0>, g, b, LDS_BYTES, stream, a);
        else if (ph == 1) hipLaunchKernelGGL(phase_kernel<1>, g, b, LDS_BYTES, stream, a);
        else if (ph == 30) hipLaunchKernelGGL(phase_kernel<30>, g, b, LDS_BYTES, stream, a);
        else if (sub == 2) hipLaunchKernelGGL(phase_kernel<2>, g, b, LDS_BYTES, stream, a);
        else if (sub == 1) hipLaunchKernelGGL(phase_kernel<4>, g, b, LDS_BYTES, stream, a);
        else if (sub == 3) hipLaunchKernelGGL(phase_kernel<5>, g, b, LDS_BYTES, stream, a);
        else { const bool cv_ = (i & 1) == 0; if (sub == 0) { if (cv_) hipLaunchKernelGGL(phase_kernel<31>, g, b, LDS_BYTES, stream, a); else hipLaunchKernelGGL(phase_kernel<32>, g, b, LDS_BYTES, stream, a); }
               else if (sub == 5) hipLaunchKernelGGL(phase_kernel<33>, g, b, LDS_BYTES, stream, a); else hipLaunchKernelGGL(phase_kernel<34>, g, b, LDS_BYTES, stream, a); }
#ifdef PROBE_G
        if (ph == 30) { Args a2 = a; a2.ph_lo = PROBE_G; a2.ph_hi = PROBE_G + 1; const int i2 = (PROBE_G - 2) / 7, s2 = (PROBE_G - 2) % 7;
            if (s2 == 0 && (i2 & 1) == 0) hipLaunchKernelGGL(phase_kernel<31>, g, b, LDS_BYTES, stream, a2); else if (s2 == 0) hipLaunchKernelGGL(phase_kernel<32>, g, b, LDS_BYTES, stream, a2); else hipLaunchKernelGGL(phase_kernel<33>, g, b, LDS_BYTES, stream, a2); }
#endif
#if PROBE_RD
        if (ph == 30) { hipFuncSetAttribute((const void*)probe_read_kernel, hipFuncAttributeMaxDynamicSharedMemorySize, LDS_BYTES); hipLaunchKernelGGL(probe_read_kernel, g, b, LDS_BYTES, stream, a); }
#endif
        {   const bool conv = (i & 1) == 0;
            const bool dup = ((ph >= 2 && ph < 30) && (((PROBE_DUP & 32) && sub == 0 && conv) || ((PROBE_DUP & 64) && sub == 0 && !conv) || ((PROBE_DUP & 128) && sub == 5) || ((PROBE_DUP & 1) && (sub == 0 || sub == 5)) || ((PROBE_DUP & 2) && sub == 1 && !conv) || ((PROBE_DUP & 4) && sub == 1 && conv))) || ((PROBE_DUP & 16) && ph < 2);
            if (dup) {
                if (ph == 0) hipLaunchKernelGGL(phase_kernel<0>, g, b, LDS_BYTES, stream, a);
                else if (ph == 1) hipLaunchKernelGGL(phase_kernel<1>, g, b, LDS_BYTES, stream, a);
                else if (sub == 2) hipLaunchKernelGGL(phase_kernel<2>, g, b, LDS_BYTES, stream, a);
                else if (sub == 1) hipLaunchKernelGGL(phase_kernel<4>, g, b, LDS_BYTES, stream, a);
                else if (sub == 0 && conv) hipLaunchKernelGGL(phase_kernel<31>, g, b, LDS_BYTES, stream, a);
                else if (sub == 0) hipLaunchKernelGGL(phase_kernel<32>, g, b, LDS_BYTES, stream, a);
                else hipLaunchKernelGGL(phase_kernel<33>, g, b, LDS_BYTES, stream, a);
            } }
    }
#endif
}
```

```cpp
#include <hip/hip_runtime.h>
#include <cstdio>
#include <cstdint>
#include <utility>

#ifndef ONE_LAUNCH
#define ONE_LAUNCH 1
#endif

typedef unsigned short bf16_t;
typedef short bf16x8 __attribute__((ext_vector_type(8)));
typedef float f32x4 __attribute__((ext_vector_type(4)));
typedef float f32x2 __attribute__((ext_vector_type(2)));
typedef unsigned u32x2 __attribute__((ext_vector_type(2)));
typedef unsigned u32x4 __attribute__((ext_vector_type(4)));
typedef __bf16 bf16x2_t __attribute__((ext_vector_type(2)));
typedef short s16x4 __attribute__((ext_vector_type(4)));
#define LAS __attribute__((address_space(3)))

constexpr int D = 1024, T = 16384, TC = 256, R = T + TC, NH = 4, DK = 256, DV = 512, QKW = 1024, VW = 2048, INW = 8192, DFF = 2816, FF2 = 5632, CK = 31, DEPTH = 4;
constexpr int NSLOT = 33;
constexpr float NORM_EPS = 1e-6f, LN_EPS = 1e-5f;

constexpr size_t MiB = 1u << 20, KiB = 1u << 10;
constexpr size_t WS_CTL = 0, CTL_ZERO_BYTES = 1 * MiB;
constexpr size_t WS_MODV = 1 * MiB;
constexpr size_t WS_S1 = 1 * MiB + 256 * KiB;
constexpr size_t WS_S2 = 1 * MiB + 320 * KiB;
constexpr size_t WS_CVA = 1 * MiB + 384 * KiB;
constexpr size_t WS_CVF = 1 * MiB + 640 * KiB;
constexpr size_t WS_TABC = 1 * MiB + 832 * KiB;
constexpr size_t WS_TABS = 1 * MiB + 912 * KiB;
constexpr size_t WS_STATS = 2 * MiB;
constexpr size_t WS_XCTX = 4 * MiB;
constexpr size_t WS_WA = 8 * MiB;
constexpr size_t WS_WA2 = 24 * MiB;
constexpr size_t WS_WF1 = 28 * MiB;
constexpr size_t WS_WF2 = 40 * MiB;
constexpr size_t WS_XS = 48 * MiB;
constexpr size_t WS_SCP = 48 * MiB;
constexpr size_t WS_BIG = 114 * MiB;
constexpr size_t WS_Q = WS_BIG, WS_K = WS_BIG + 33 * MiB, WS_VT = WS_BIG + 66 * MiB, WS_GF = WS_BIG + 131 * MiB, WS_GB = WS_BIG + 196 * MiB;
constexpr size_t WS_U = WS_BIG, WS_A2 = WS_BIG + 33 * MiB, WS_H = WS_BIG;
constexpr size_t WS_END = WS_BIG + 261 * MiB;
static_assert((size_t)R * 1024 * 2 <= 33 * MiB && (size_t)R * 2048 * 2 <= 65 * MiB && (size_t)R * DFF * 2 <= 131 * MiB, "map");
static_assert((size_t)NSLOT * 8 * 512 * 256 * 2 <= 66 * MiB, "scp");

constexpr int LDS_BYTES = 147456;

__device__ __forceinline__ unsigned pk2(float lo, float hi) { f32x2 v = {lo, hi}; bf16x2_t b = __builtin_convertvector(v, bf16x2_t); return __builtin_bit_cast(unsigned, b); }
__device__ __forceinline__ float bflo(unsigned u) { return __uint_as_float(u << 16); }
__device__ __forceinline__ float bfhi(unsigned u) { return __uint_as_float(u & 0xffff0000u); }
__device__ __forceinline__ float sigmf(float x) { return __builtin_amdgcn_rcpf(1.f + __builtin_amdgcn_exp2f(-1.4426950408889634f * x)); }
__device__ __forceinline__ float siluf(float x) { return x * sigmf(x); }
__device__ __forceinline__ float wave_sum63(float v) {
    v += __builtin_bit_cast(float, __builtin_amdgcn_update_dpp(0, __builtin_bit_cast(int, v), 0xB1, 0xF, 0xF, false));
    v += __builtin_bit_cast(float, __builtin_amdgcn_update_dpp(0, __builtin_bit_cast(int, v), 0x4E, 0xF, 0xF, false));
    v += __builtin_bit_cast(float, __builtin_amdgcn_update_dpp(0, __builtin_bit_cast(int, v), 0x141, 0xF, 0xF, false));
    v += __builtin_bit_cast(float, __builtin_amdgcn_update_dpp(0, __builtin_bit_cast(int, v), 0x140, 0xF, 0xF, false));
    v += __builtin_bit_cast(float, __builtin_amdgcn_update_dpp(0, __builtin_bit_cast(int, v), 0x142, 0xA, 0xF, false));
    v += __builtin_bit_cast(float, __builtin_amdgcn_update_dpp(0, __builtin_bit_cast(int, v), 0x143, 0xC, 0xF, false));
    return v;
}
__device__ __forceinline__ int perm_glu(int n, int H) { const int g = n >= H ? 16 : 0, oc = n >= H ? n - H : n; return 256 * (oc >> 7) + 128 * ((oc >> 2) & 1) + 32 * ((oc >> 5) & 3) + 4 * ((oc >> 3) & 3) + (oc & 3) + g; }
__device__ __forceinline__ int perm_win(int n) {
    if (n >= 4 * QKW) { const int c = n & 31; return (n & ~31) + 16 * ((c >> 2) & 1) + 4 * (c >> 3) + (c & 3); }
    if (n >= 2 * QKW) return n;
    const int part = n >> 10, hn = n & 1023, h = hn >> 8, d = hn & 255, quarter = d >> 6, idx = d & 63;
    const int Gp = (quarter >> 1) * 4 + (idx >> 4), i = (quarter & 1) * 16 + (idx & 15);
    return part * 1024 + h * 256 + 32 * Gp + i;
}
__device__ __forceinline__ int perm_any(int mode, int n, int H) { return mode == 0 ? n : (mode == 1 ? perm_glu(n, H) : perm_win(n)); }

struct Args { const float* in[22]; float* out; unsigned char* ws; int ph_lo, ph_hi; };

struct Ctx {
    LAS unsigned char* lds;
    int tid, lane, wave, G, bid;
    const float* const* in; float* out; unsigned char* ws;
};

__device__ __forceinline__ void relane(Ctx& C) {
    int wv = C.wave; asm volatile("" : "+s"(wv)); int ln = (int)__builtin_amdgcn_mbcnt_hi(~0u, __builtin_amdgcn_mbcnt_lo(~0u, 0u)); asm volatile("" : "+v"(ln));
    C.wave = wv; C.lane = ln; C.tid = wv * 64 + ln;
}
template <int VSILU>
__device__ __forceinline__ void gemv2_unit(Ctx& C, const float* W, int N, int n0, const float* v0, const float* v1, const float* bias, float* o0, float* o1, int pmode, int H) {
    LAS float* red = (LAS float*)C.lds;
    const int c4 = C.tid & 15, ks = C.tid >> 4;
    f32x4 a0 = {0.f, 0.f, 0.f, 0.f}, a1 = {0.f, 0.f, 0.f, 0.f};
#pragma unroll 8
    for (int i = 0; i < 32; ++i) {
        const int k = ks * 32 + i;
        const f32x4 w = *(const f32x4*)(W + (size_t)k * N + n0 + 4 * c4);
        float x0 = v0[k], x1 = v1[k];
        if (VSILU) { x0 = siluf(x0); x1 = siluf(x1); }
        a0 += w * x0; a1 += w * x1;
    }
#pragma unroll
    for (int e = 0; e < 4; ++e) { red[(ks * 2 + 0) * 64 + 4 * c4 + e] = a0[e]; red[(ks * 2 + 1) * 64 + 4 * c4 + e] = a1[e]; }
    __syncthreads();
    if (C.tid < 128) {
        const int s = C.tid >> 6, col = C.tid & 63; float sum = 0.f;
#pragma unroll 8
        for (int k2 = 0; k2 < 32; ++k2) sum += red[(k2 * 2 + s) * 64 + col];
        const int n = n0 + col; if (bias) sum += bias[n];
        (s ? o1 : o0)[perm_any(pmode, n, H)] = sum;
    }
    __syncthreads();
}

struct PrepItem { const float* W; bf16_t* WT; int K, N, pmode, H, k0, n0; };
__device__ __forceinline__ bool prep_decode(Ctx& C, int i, int part, int it, PrepItem& P) {
    const int j = i >> 1; const bool conv = (i & 1) == 0;
    const int I_A = (part & 1) ? (conv ? 16 * 64 : 16 * 256) : 0, I_A2 = (part & 4) ? (conv ? 16 * 32 : 32 * 32) : 0, I_F1 = (part & 2) ? 16 * 176 : 0, I_F2 = (part & 2) ? 44 * 32 : 0;
    if (it >= I_A + I_A2 + I_F1 + I_F2) return false;
    int r = it;
    if (r < I_A) { if (conv) { P.W = C.in[8] + (size_t)j * 1024 * 2048; P.K = 1024; P.N = 2048; P.pmode = 1; P.H = 1024; } else { P.W = C.in[16] + (size_t)j * 1024 * 8192; P.K = 1024; P.N = 8192; P.pmode = 2; P.H = 0; }
                   P.WT = (bf16_t*)(C.ws + WS_WA); }
    else if ((r -= I_A) < I_A2) { if (conv) { P.W = C.in[14] + (size_t)j * 1024 * 1024; P.K = 1024; } else { P.W = C.in[18] + (size_t)j * 2048 * 1024; P.K = 2048; }
                   P.N = 1024; P.pmode = 0; P.H = 0; P.WT = (bf16_t*)(C.ws + WS_WA2); }
    else if ((r -= I_A2) < I_F1) { P.W = C.in[19] + (size_t)i * 1024 * FF2; P.K = 1024; P.N = FF2; P.pmode = 1; P.H = DFF; P.WT = (bf16_t*)(C.ws + WS_WF1); }
    else { r -= I_F1; P.W = C.in[20] + (size_t)i * DFF * 1024; P.K = DFF; P.N = 1024; P.pmode = 0; P.H = 0; P.WT = (bf16_t*)(C.ws + WS_WF2); }
    const int nblk = P.N / 32; P.k0 = 64 * (r / nblk); P.n0 = 32 * (r % nblk);
    return true;
}
__device__ __forceinline__ void prep_layer(Ctx& C, int i, int part, int cu_lo) {
    if (C.bid < cu_lo) return;
    LAS float* scr = (LAS float*)(C.lds + C.wave * 16384);
    const int gw = (C.bid - cu_lo) * 8 + C.wave, NGW = (C.G - cu_lo) * 8, lane = C.lane;
    PrepItem P, Pn; f32x4 v[8], vn[8];
    bool have = prep_decode(C, i, part, gw, P);
    if (have) {
#pragma unroll
        for (int q = 0; q < 8; ++q) v[q] = *(const f32x4*)(P.W + (size_t)(P.k0 + 8 * q + (lane >> 3)) * P.N + P.n0 + 4 * (lane & 7));
    }
    for (int it = gw; have; it += NGW) {
        const bool havn = prep_decode(C, i, part, it + NGW, Pn);
        if (havn) {
#pragma unroll
            for (int q = 0; q < 8; ++q) vn[q] = *(const f32x4*)(Pn.W + (size_t)(Pn.k0 + 8 * q + (lane >> 3)) * Pn.N + Pn.n0 + 4 * (lane & 7));
        }
#pragma unroll
        for (int q = 0; q < 8; ++q) { LAS float* d = scr + (8 * q + (lane >> 3)) * 33 + 4 * (lane & 7); d[0] = v[q][0]; d[1] = v[q][1]; d[2] = v[q][2]; d[3] = v[q][3]; }
        asm volatile("s_waitcnt lgkmcnt(0)" ::: "memory");
        const int c = lane & 7;
#pragma unroll
        for (int jj = 0; jj < 4; ++jj) { const int n = (lane >> 3) + 8 * jj; const LAS float* sp = scr + (8 * c) * 33 + n;
            u32x4 o; o.x = pk2(sp[0 * 33], sp[1 * 33]); o.y = pk2(sp[2 * 33], sp[3 * 33]); o.z = pk2(sp[4 * 33], sp[5 * 33]); o.w = pk2(sp[6 * 33], sp[7 * 33]);
            *(u32x4*)(P.WT + (size_t)perm_any(P.pmode, P.n0 + n, P.H) * P.K + P.k0 + 8 * c) = o; }
        asm volatile("s_waitcnt lgkmcnt(0)" ::: "memory");
        P = Pn; have = havn;
#pragma unroll
        for (int q = 0; q < 8; ++q) v[q] = vn[q];
    }
}

__device__ __forceinline__ float row_rs(const float* stats, int row, int fq) {
    const f32x4 p = *(const f32x4*)(stats + (size_t)row * 16 + 4 * fq);
    float s = (p[0] + p[1]) + (p[2] + p[3]);
    s += __shfl_xor(s, 16); s += __shfl_xor(s, 32);
    return 1.0f / sqrtf(s * (1.0f / 1024.0f) + NORM_EPS);
}
struct EpiGLU {
    static constexpr bool STATS = false, NEEDRS = true, PAIR2 = true;
    unsigned char* ws; int cvoff  , cvstride  , outoff  , ldo, act;
    float* stats;
    __device__ __forceinline__ float row_begin(int row, int fq) const { return row_rs((const float*)(ws + WS_STATS), row, fq); }
    __device__ __forceinline__ float item(int row, int colp, f32x4 v0, f32x4 v1, float rs) const {
        const float* cv = (const float*)ws + cvoff + (row < T ? 0 : cvstride);
        const f32x4 ca = *(const f32x4*)(cv + colp), cg = *(const f32x4*)(cv + colp + 16);
        float o[4];
#pragma unroll
        for (int e = 0; e < 4; ++e) { const float a = rs * v0[e] + ca[e], g = rs * v1[e] + cg[e]; o[e] = act == 0 ? a * sigmf(g) : siluf(a) * g; }
        const int oc = 128 * (colp >> 8) + 32 * ((colp >> 5) & 3) + 8 * ((colp >> 2) & 3) + 4 * ((colp >> 7) & 1);
        u32x2 w; w.x = pk2(o[0], o[1]); w.y = pk2(o[2], o[3]);
        *(u32x2*)((bf16_t*)(ws + outoff) + (size_t)row * ldo + oc) = w;
        return 0.f;
    }
    __device__ __forceinline__ void item2(int row, int colp, f32x4 a0, f32x4 g0, f32x4 a1, f32x4 g1, float rs) const {
        const float* cv = (const float*)ws + cvoff + (row < T ? 0 : cvstride);
        const f32x4 ca0 = *(const f32x4*)(cv + colp), cg0 = *(const f32x4*)(cv + colp + 16), ca1 = *(const f32x4*)(cv + colp + 128), cg1 = *(const f32x4*)(cv + colp + 144);
        float o[8];
#pragma unroll
        for (int e = 0; e < 4; ++e) { const float a = rs * a0[e] + ca0[e], g = rs * g0[e] + cg0[e]; o[e] = act == 0 ? a * sigmf(g) : siluf(a) * g;
                                      const float b = rs * a1[e] + ca1[e], h = rs * g1[e] + cg1[e]; o[4 + e] = act == 0 ? b * sigmf(h) : siluf(b) * h; }
        const int oc = 128 * (colp >> 8) + 32 * ((colp >> 5) & 3) + 8 * ((colp >> 2) & 3);
        u32x4 w; w.x = pk2(o[0], o[1]); w.y = pk2(o[2], o[3]); w.z = pk2(o[4], o[5]); w.w = pk2(o[6], o[7]);
        *(u32x4*)((bf16_t*)(ws + outoff) + (size_t)row * ldo + oc) = w;
    }
};
struct EpiRes {
    static constexpr bool STATS = true, NEEDRS = false, PAIR2 = false;
    unsigned char* ws; float* xl; const float* xin  ; const float* cin  ; const float* bias;
    int mgoff  , snoff  ;
    float* stats;
    __device__ __forceinline__ float row_begin(int, int) const { return 1.f; }
    __device__ __forceinline__ float item(int row, int colp, f32x4 v0, f32x4 v1, float) const {
        const bool lat = row < T;
        float* xr = lat ? xl + (size_t)row * 1024 : (float*)(ws + WS_XCTX) + (size_t)(row - T) * 1024;
        const float* xi = lat ? xin + (size_t)row * 1024 : cin + (size_t)(row - T) * 1024;
        const float* mg = (const float*)ws + mgoff + (lat ? 0 : 6144); const float* sn = (const float*)ws + snoff + (lat ? 0 : 1024);
        bf16_t* xs = (bf16_t*)(ws + WS_XS);
        float ss = 0.f;
#pragma unroll
        for (int hlf = 0; hlf < 2; ++hlf) {
            const int c = colp + 16 * hlf; const f32x4 v = hlf ? v1 : v0;
            const f32x4 xo = *(const f32x4*)(xi + c), m4 = *(const f32x4*)(mg + c);
            f32x4 b4 = {0.f, 0.f, 0.f, 0.f}; if (bias) b4 = *(const f32x4*)(bias + c);
            const f32x4 xn = xo + m4 * (v + b4);
            *(f32x4*)(xr + c) = xn;
            ss += (xn[0] * xn[0] + xn[1] * xn[1]) + (xn[2] * xn[2] + xn[3] * xn[3]);
            if (snoff >= 0) { const f32x4 s4 = *(const f32x4*)(sn + c); u32x2 w; w.x = pk2(xn[0] * s4[0], xn[1] * s4[1]); w.y = pk2(xn[2] * s4[2], xn[3] * s4[3]);
                *(u32x2*)(xs + (size_t)row * 1024 + c) = w; }
        }
        return ss;
    }
};
struct EpiWin {
    static constexpr bool STATS = false, NEEDRS = true, PAIR2 = false;
    unsigned char* ws; int cvoff;
    float* stats;
    __device__ __forceinline__ float row_begin(int row, int fq) const { return row_rs((const float*)(ws + WS_STATS), row, fq); }
    __device__ __forceinline__ float item(int row, int colp, f32x4 v0, f32x4 v1, float rs) const {
        const float* cv = (const float*)ws + cvoff + (row < T ? 0 : 8192);
        const f32x4 c0 = *(const f32x4*)(cv + colp), c1 = *(const f32x4*)(cv + colp + 16);
        f32x4 a = v0 * rs + c0, b = v1 * rs + c1;
        if (colp < 2048) {
            if (row < T) {
                const int Gp = (colp >> 5) & 7, idx0 = 16 * (Gp & 3) + (colp & 15);
                const int ti = (Gp >> 2) ? 256 + (row & 63) : (row >> 6);
                const f32x4 cs = *(const f32x4*)((const float*)(ws + WS_TABC) + ti * 64 + idx0), sn = *(const f32x4*)((const float*)(ws + WS_TABS) + ti * 64 + idx0);
                const f32x4 o1 = a * cs - b * sn, o2 = b * cs + a * sn; a = o1; b = o2;
            }
            bf16_t* dst = (bf16_t*)(ws + WS_Q);
            if (colp >= 1024) { dst = (bf16_t*)(ws + WS_K); a = a * 0.0625f; b = b * 0.0625f; }
            const int cp = colp & 1023, c = (cp & ~31) + 2 * (cp & 31);
            u32x4 w; w.x = pk2(a[0], a[1]); w.y = pk2(a[2], a[3]); w.z = pk2(b[0], b[1]); w.w = pk2(b[2], b[3]); *(u32x4*)(dst + (size_t)row * 1024 + c) = w;
        } else if (colp < 4096) {
            const int c = colp - 2048;
            bf16_t* vt = (bf16_t*)(ws + WS_VT);
#pragma unroll
            for (int e = 0; e < 4; ++e) { vt[(size_t)(c + e) * R + row] = (bf16_t)(pk2(a[e], 0.f) & 0xffffu); vt[(size_t)(c + 16 + e) * R + row] = (bf16_t)(pk2(b[e], 0.f) & 0xffffu); }
        } else {
            bf16_t* dst = (bf16_t*)(ws + (colp < 6144 ? WS_GF : WS_GB)); const int cp = (colp - 4096) & 2047, c = (cp & ~31) + 2 * (cp & 31);
            u32x4 w; w.x = pk2(a[0], a[1]); w.y = pk2(a[2], a[3]); w.z = pk2(b[0], b[1]); w.w = pk2(b[2], b[3]); *(u32x4*)(dst + (size_t)row * 2048 + c) = w;
        }
        return 0.f;
    }
};

namespace pg8 {
#define PG8_LAS __attribute__((address_space(3)))
typedef unsigned short bf16_t;
typedef short bf16x8 __attribute__((ext_vector_type(8)));
typedef float f32x4 __attribute__((ext_vector_type(4)));
typedef unsigned u32x4 __attribute__((ext_vector_type(4)));
constexpr int BM = 256, BK = 64, HALF = 128, HTB = HALF * BK * 2  , STAGE_BYTES = 8 * HTB, NXCD = 8, WGM = 8;

__host__ __device__ __forceinline__ int lds_byte(int r, int c) { const int st = (r >> 4) * 2 + (c >> 5), rr = r & 15, cc = c & 31, ob = rr * 64 + cc * 2; return st * 1024 + (ob ^ (((ob >> 9) & 1) << 5)); }
__host__ __device__ __forceinline__ void stage_rc(int b, int& R, int& C) { const int st = b / 1024, sb = b % 1024, swz = sb ^ (((sb >> 9) & 1) << 5); R = (st >> 1) * 16 + swz / 64; C = (st & 1) * 32 + (swz % 64) / 2; }
__host__ __device__ __forceinline__ int perm32(int rho) { const int n = rho >> 4, i = rho & 15; return 8 * (i >> 2) + 4 * n + (i & 3); }

struct Unit { int pm, pn; };
struct Gemm { const bf16_t* A; const bf16_t* Bt; int M, N, K; };

struct StaticOrder {
    int nM, nN, nwg, G, c;
    __host__ __device__ void init(int M, int N, int G_, int c_) { nM = M / BM; nN = N / BM; nwg = nM * nN; G = G_; c = c_; }
    __host__ __device__ bool next(int i, Unit& u) const {
        const long L = (long)i * G + c; if (L >= nwg) return false;
        int wgid = (int)L; { const int q = nwg / NXCD, r = nwg % NXCD, xcd = wgid % NXCD, off = wgid / NXCD; wgid = (xcd < r ? xcd * (q + 1) : r * (q + 1) + (xcd - r) * q) + off; }
        const int nig = WGM * nN, gid = wgid / nig, fm = gid * WGM, gsz = (nM - fm) < WGM ? (nM - fm) : WGM;
        u.pm = fm + ((wgid % nig) % gsz); u.pn = (wgid % nig) / gsz; return true;
    }
    __device__ __forceinline__ void a_ready(const Unit&) const {}
    __device__ __forceinline__ void done(const Unit&) const {}
};

template <class Epi, class Sched, bool ALIGN_EPI = false, bool SP2 = false, bool SWAPMMA = false>
__device__ __forceinline__ void gemm_phase(PG8_LAS unsigned char* lds, const Gemm g, const Sched& S, const Epi& E) {
    int tid = threadIdx.x; asm volatile("" : "+v"(tid));
    const int wid = __builtin_amdgcn_readfirstlane(tid >> 6), lane = tid & 63, wr = wid >> 2, wc = wid & 3, fr = lane & 15, fq = lane >> 4;
    const int K = g.K, nt = K / BK;
    unsigned voffA[2], voffB[2];
#pragma unroll
    for (int i = 0; i < 2; ++i) { int R, C; stage_rc(tid * 16 + i * 8192, R, C); const int Rb = Epi::PERM ? ((R & ~31) + perm32(R & 31)) : R;
        voffA[i] = (unsigned)(R * K + C) * 2u; voffB[i] = (unsigned)(Rb * K + C) * 2u; }
    const size_t kstep = (size_t)(BK * 2);
    const size_t hstep = (size_t)HALF * K * 2;
    const size_t tstep = 2 * hstep;
    const unsigned ldsw = (unsigned)wid * 1024u;
    const int aoff = lds_byte(wr * 64 + fr, fq * 8), boff = lds_byte(wc * 32 + fr, fq * 8);
#define PG8_SA(b, h) (((b) * 2 + (h)) * HTB)
#define PG8_SB(b, h) ((4 + (b) * 2 + (h)) * HTB)
#define PG8_STAGE(bufoff, gbase, voff) do { _Pragma("unroll") for (int _i = 0; _i < 2; ++_i) \
        __builtin_amdgcn_global_load_lds((const unsigned*)((const char*)(gbase) + (voff)[_i]), (PG8_LAS unsigned*)(lds + (bufoff) + ldsw + _i * 8192), 16, 0, 0); } while (0)
#define PG8_LDA(dst, b, h) do { _Pragma("unroll") for (int m = 0; m < 4; ++m) _Pragma("unroll") for (int k = 0; k < 2; ++k) dst[m][k] = *(const PG8_LAS bf16x8*)(lds + PG8_SA(b, h) + aoff + m * 2048 + k * 1024); } while (0)
#define PG8_LDB(dst, b, h) do { _Pragma("unroll") for (int n = 0; n < 2; ++n) _Pragma("unroll") for (int k = 0; k < 2; ++k) dst[n][k] = *(const PG8_LAS bf16x8*)(lds + PG8_SB(b, h) + boff + n * 2048 + k * 1024); } while (0)
#define PG8_MMA(ai, bj, At, Bt) do { __builtin_amdgcn_s_setprio(1); _Pragma("unroll") for (int m = 0; m < 4; ++m) _Pragma("unroll") for (int n = 0; n < 2; ++n) _Pragma("unroll") for (int k = 0; k < 2; ++k) \
        acc[ai][bj][m][n] = SWAPMMA ? __builtin_amdgcn_mfma_f32_16x16x32_bf16(At[m][k], Bt[n][k], acc[ai][bj][m][n], 0, 0, 0) : __builtin_amdgcn_mfma_f32_16x16x32_bf16(Bt[n][k], At[m][k], acc[ai][bj][m][n], 0, 0, 0); __builtin_amdgcn_s_setprio(0); } while (0)
#define PG8_WAIT_V(n) asm volatile("s_waitcnt vmcnt(" #n ")" ::: "memory")
#define PG8_WAIT_L(n) asm volatile("s_waitcnt lgkmcnt(" #n ")" ::: "memory")
#define PG8_BAR __builtin_amdgcn_s_barrier()
#define PG8_SCHED __builtin_amdgcn_sched_barrier(0)
    Unit cur, nxt; int ui = 0;
    if (!S.next(0, cur)) return;
    f32x4 acc[2][2][4][2];
#pragma unroll
    for (int a = 0; a < 2; ++a)
#pragma unroll
        for (int b = 0; b < 2; ++b)
#pragma unroll
            for (int m = 0; m < 4; ++m)
#pragma unroll
                for (int n = 0; n < 2; ++n) acc[a][b][m][n] = (f32x4){0.f, 0.f, 0.f, 0.f};
    bf16x8 At[4][2], B0[2][2], B1[2][2];
    const char* cA = (const char*)g.A + (size_t)cur.pm * tstep; const char* cB = (const char*)g.Bt + (size_t)cur.pn * tstep;
    S.a_ready(cur);
    if constexpr (SP2) {
        PG8_STAGE(PG8_SB(0, 0), cB, voffB); PG8_STAGE(PG8_SB(0, 1), cB + hstep, voffB); PG8_STAGE(PG8_SA(0, 0), cA, voffA); PG8_STAGE(PG8_SA(0, 1), cA + hstep, voffA);
        if (wr == 1) PG8_BAR;
        PG8_WAIT_V(2); PG8_BAR;
        PG8_STAGE(PG8_SB(1, 0), cB + kstep, voffB); PG8_STAGE(PG8_SA(1, 0), cA + kstep, voffA); PG8_STAGE(PG8_SB(1, 1), cB + hstep + kstep, voffB);
        PG8_WAIT_V(6); PG8_BAR;
    } else {
        PG8_STAGE(PG8_SB(0, 0), cB, voffB); PG8_STAGE(PG8_SA(0, 0), cA, voffA); PG8_STAGE(PG8_SB(0, 1), cB + hstep, voffB); PG8_STAGE(PG8_SA(0, 1), cA + hstep, voffA);
        if (wr == 1) PG8_BAR;
        PG8_WAIT_V(4); PG8_BAR;
        PG8_STAGE(PG8_SB(1, 0), cB + kstep, voffB); PG8_STAGE(PG8_SA(1, 0), cA + kstep, voffA); PG8_STAGE(PG8_SB(1, 1), cB + hstep + kstep, voffB);
        PG8_WAIT_V(6); PG8_BAR;
    }
    for (;;) {
        const bool has_next = S.next(ui + 1, nxt);
        const char* nA = has_next ? (const char*)g.A + (size_t)nxt.pm * tstep : cA; const char* nB = has_next ? (const char*)g.Bt + (size_t)nxt.pn * tstep : cB;
        for (int t = 0; t < nt; t += 2) {
            const bool last = (t == nt - 2);
            const char* a1 = cA + (size_t)(t + 1) * kstep;
            const char* a2 = last ? nA : cA + (size_t)(t + 2) * kstep; const char* b2 = last ? nB : cB + (size_t)(t + 2) * kstep;
            const char* a3 = a2 + kstep; const char* b3 = b2 + kstep;
            if (last && has_next) S.a_ready(nxt);
            if constexpr (SP2) {
            PG8_LDB(B0, 0, 0); PG8_LDB(B1, 0, 1); PG8_SCHED; PG8_LDA(At, 0, 0); PG8_STAGE(PG8_SA(1, 1), a1 + hstep, voffA);
            PG8_WAIT_V(8); PG8_WAIT_L(0); PG8_BAR; PG8_MMA(0, 0, At, B0); PG8_MMA(0, 1, At, B1); PG8_BAR; PG8_SCHED;
            PG8_LDA(At, 0, 1); PG8_STAGE(PG8_SB(0, 0), b2, voffB); PG8_STAGE(PG8_SB(0, 1), b2 + hstep, voffB); PG8_STAGE(PG8_SA(0, 0), a2, voffA);
            PG8_WAIT_V(8); PG8_WAIT_L(0); PG8_BAR; PG8_MMA(1, 0, At, B0); PG8_MMA(1, 1, At, B1); PG8_BAR; PG8_SCHED;
            PG8_LDB(B0, 1, 0); PG8_LDB(B1, 1, 1); PG8_SCHED; PG8_LDA(At, 1, 0); PG8_STAGE(PG8_SA(0, 1), a2 + hstep, voffA);
            PG8_WAIT_V(8); PG8_WAIT_L(0); PG8_BAR; PG8_MMA(0, 0, At, B0); PG8_MMA(0, 1, At, B1); PG8_BAR; PG8_SCHED;
            PG8_LDA(At, 1, 1); PG8_STAGE(PG8_SB(1, 0), b3, voffB); PG8_STAGE(PG8_SB(1, 1), b3 + hstep, voffB); PG8_STAGE(PG8_SA(1, 0), a3, voffA);
            PG8_WAIT_V(8); PG8_WAIT_L(0); PG8_BAR; PG8_MMA(1, 0, At, B0); PG8_MMA(1, 1, At, B1); PG8_BAR; PG8_SCHED;
            } else {
            PG8_LDB(B0, 0, 0); PG8_SCHED; PG8_LDA(At, 0, 0); PG8_STAGE(PG8_SA(1, 1), a1 + hstep, voffA);
            PG8_WAIT_L(8); PG8_BAR; PG8_WAIT_L(0); PG8_MMA(0, 0, At, B0); PG8_BAR; PG8_SCHED;
            PG8_LDB(B1, 0, 1); PG8_STAGE(PG8_SB(0, 0), b2, voffB);
            PG8_BAR; PG8_WAIT_L(0); PG8_MMA(0, 1, At, B1); PG8_BAR;
            PG8_LDA(At, 0, 1); PG8_STAGE(PG8_SA(0, 0), a2, voffA);
            PG8_BAR; PG8_WAIT_L(0); PG8_MMA(1, 0, At, B0); PG8_BAR; PG8_SCHED;
            PG8_STAGE(PG8_SB(0, 1), b2 + hstep, voffB);
            PG8_WAIT_V(6); PG8_BAR; PG8_MMA(1, 1, At, B1); PG8_BAR;
            PG8_LDB(B0, 1, 0); PG8_SCHED; PG8_LDA(At, 1, 0); PG8_STAGE(PG8_SA(0, 1), a2 + hstep, voffA);
            PG8_WAIT_L(8); PG8_BAR; PG8_WAIT_L(0); PG8_MMA(0, 0, At, B0); PG8_BAR; PG8_SCHED;
            PG8_LDB(B1, 1, 1); PG8_STAGE(PG8_SB(1, 0), b3, voffB);
            PG8_BAR; PG8_WAIT_L(0); PG8_MMA(0, 1, At, B1); PG8_BAR;
            PG8_LDA(At, 1, 1); PG8_STAGE(PG8_SA(1, 0), a3, voffA);
            PG8_BAR; PG8_WAIT_L(0); PG8_MMA(1, 0, At, B0); PG8_BAR; PG8_SCHED;
            PG8_STAGE(PG8_SB(1, 1), b3 + hstep, voffB);
            PG8_WAIT_V(6); PG8_BAR; PG8_MMA(1, 1, At, B1); PG8_BAR;
            }
        }
        if constexpr (ALIGN_EPI) { if (wr == 0) PG8_BAR; }
        if constexpr (!Epi::AFTER_DRAIN) { E(acc, cur, wr, wc, fr, fq); S.done(cur); }
        if (!has_next) break;
#pragma unroll
        for (int a = 0; a < 2; ++a)
#pragma unroll
            for (int b = 0; b < 2; ++b)
#pragma unroll
                for (int m = 0; m < 4; ++m)
#pragma unroll
                    for (int n = 0; n < 2; ++n) acc[a][b][m][n] = (f32x4){0.f, 0.f, 0.f, 0.f};
        cur = nxt; cA = nA; cB = nB; ++ui;
        if constexpr (ALIGN_EPI) { if (wr == 1) PG8_BAR; }
    }
    PG8_WAIT_V(0);
    if constexpr (!ALIGN_EPI) { if (wr == 0) PG8_BAR; }
    PG8_BAR;
    if constexpr (Epi::AFTER_DRAIN) { E.fused(acc, cur, wr, wc, fr, fq, lds, wid, lane); S.done(cur); }
#undef PG8_SA
#undef PG8_SB
#undef PG8_STAGE
#undef PG8_LDA
#undef PG8_LDB
#undef PG8_MMA
#undef PG8_WAIT_V
#undef PG8_WAIT_L
#undef PG8_BAR
#undef PG8_SCHED
}
}

template <class E0> struct EpiAdapt {
    static constexpr bool PERM = false, AFTER_DRAIN = false;
    E0 e; int col_base;
    __device__ __forceinline__ void operator()(const pg8::f32x4 (&acc)[2][2][4][2], const pg8::Unit& u, int wr, int wc, int fr, int fq) const {
#pragma unroll
        for (int ai = 0; ai < 2; ++ai)
#pragma unroll
            for (int m = 0; m < 4; ++m) {
                const int row = u.pm * 256 + ai * 128 + wr * 64 + m * 16 + fr;
                const float rs = e.row_begin(row, fq);
                float ss = 0.f;
                if constexpr (E0::PAIR2) e.item2(row, col_base + u.pn * 256 + wc * 32 + 4 * fq, acc[ai][0][m][0], acc[ai][0][m][1], acc[ai][1][m][0], acc[ai][1][m][1], rs);
                else {
#pragma unroll
                    for (int bj = 0; bj < 2; ++bj) ss += e.item(row, col_base + u.pn * 256 + bj * 128 + wc * 32 + 4 * fq, acc[ai][bj][m][0], acc[ai][bj][m][1], rs);
                }
                if constexpr (E0::STATS) { ss += __shfl_xor(ss, 16); ss += __shfl_xor(ss, 32); if (fq == 0) e.stats[(size_t)row * 16 + (col_base >> 6) + u.pn * 4 + wc] = ss; }
            }
    }
};
struct EpiResBig {
    static constexpr bool PERM = false, AFTER_DRAIN = false;
    EpiRes e;
    __device__ __forceinline__ void operator()(const pg8::f32x4 (&acc)[2][2][4][2], const pg8::Unit& u, int wr, int wc, int fr, int fq) const {
        const float* mg = (const float*)e.ws + e.mgoff; const float* sn = (const float*)e.ws + e.snoff;
        bf16_t* xs = (bf16_t*)(e.ws + WS_XS);
        const int colb = u.pn * 256 + wc * 32 + 4 * fq;
#pragma unroll
        for (int ai = 0; ai < 2; ++ai) {
            const int rowb = u.pm * 256 + ai * 128 + wr * 64 + fr;
            f32x4 xo[4][2][2];
#pragma unroll
            for (int m = 0; m < 4; ++m)
#pragma unroll
                for (int bj = 0; bj < 2; ++bj)
#pragma unroll
                    for (int hl = 0; hl < 2; ++hl) xo[m][bj][hl] = *(const f32x4*)(e.xin + (size_t)(rowb + 16 * m) * 1024 + colb + 128 * bj + 16 * hl);
#pragma unroll
            for (int m = 0; m < 4; ++m) {
                const int row = rowb + 16 * m; float ss = 0.f;
#pragma unroll
                for (int bj = 0; bj < 2; ++bj)
#pragma unroll
                    for (int hl = 0; hl < 2; ++hl) {
                        const int c = colb + 128 * bj + 16 * hl;
                        const f32x4 m4 = *(const f32x4*)(mg + c);
                        f32x4 b4 = {0.f, 0.f, 0.f, 0.f}; if (e.bias) b4 = *(const f32x4*)(e.bias + c);
                        const f32x4 xn = xo[m][bj][hl] + m4 * (acc[ai][bj][m][hl] + b4);
                        *(f32x4*)(e.xl + (size_t)row * 1024 + c) = xn;
                        ss += (xn[0] * xn[0] + xn[1] * xn[1]) + (xn[2] * xn[2] + xn[3] * xn[3]);
                        if (e.snoff >= 0) { const f32x4 s4 = *(const f32x4*)(sn + c); u32x2 w; w.x = pk2(xn[0] * s4[0], xn[1] * s4[1]); w.y = pk2(xn[2] * s4[2], xn[3] * s4[3]);
                            *(u32x2*)(xs + (size_t)row * 1024 + c) = w; }
                    }
                ss += __shfl_xor(ss, 16); ss += __shfl_xor(ss, 32); if (fq == 0) e.stats[(size_t)row * 16 + u.pn * 4 + wc] = ss;
            }
        }
    }
};
struct EpiVt {
    static constexpr bool PERM = false, AFTER_DRAIN = false;
    unsigned char* ws; int cvoff;
    __device__ __forceinline__ void operator()(const pg8::f32x4 (&acc)[2][2][4][2], const pg8::Unit& u, int wr, int wc, int fr, int fq) const {
        bf16_t* vt = (bf16_t*)(ws + WS_VT);
#pragma unroll
        for (int ai = 0; ai < 2; ++ai)
#pragma unroll
            for (int m = 0; m < 4; ++m) {
                const int rowb = u.pm * 256 + ai * 128 + wr * 64 + m * 16;
                const float rsl = row_rs((const float*)(ws + WS_STATS), rowb + fr, fq);
                float rsv[4];
#pragma unroll
                for (int e = 0; e < 4; ++e) rsv[e] = __shfl(rsl, 4 * fq + e);
                const float* cv = (const float*)ws + cvoff + (rowb < T ? 0 : 8192);
#pragma unroll
                for (int bj = 0; bj < 2; ++bj)
#pragma unroll
                    for (int n = 0; n < 2; ++n) {
                        const int col = 2048 + u.pn * 256 + bj * 128 + wc * 32 + 16 * n + fr;
                        const float c0 = cv[col]; const pg8::f32x4 a = acc[ai][bj][m][n];
                        u32x2 w; w.x = pk2(a[0] * rsv[0] + c0, a[1] * rsv[1] + c0); w.y = pk2(a[2] * rsv[2] + c0, a[3] * rsv[3] + c0);
                        *(u32x2*)(vt + (size_t)(col - 2048) * R + rowb + 4 * fq) = w;
                    }
            }
    }
};
template <class Epi>
__device__ __forceinline__ void sgemm_small(Ctx& C, const bf16_t* A, const bf16_t* Bt, int row_lo, int Mrows, int N, int K, const Epi& E, int n_lo, int n_hi) {
    const int w = C.wave, fr = C.lane & 15, fq = C.lane >> 4;
    const int nM = Mrows / 16, nN = n_hi - n_lo, nU = nM * nN, K8 = K >> 3;
    LAS f32x4* xch = (LAS f32x4*)C.lds;
    LAS float* sx = (LAS float*)(C.lds + 131072 + 1024);
    for (int u = (C.G - 1 - C.bid); u < nU; u += C.G) {
        const int un = n_lo + u / nM, um = u % nM;
        const int row0 = row_lo + 16 * um, col0 = 256 * un;
        f32x4 acc[16];
#pragma unroll
        for (int t = 0; t < 16; ++t) acc[t] = (f32x4){0.f, 0.f, 0.f, 0.f};
        const bf16_t* ap = A + (size_t)(row0 + fr) * K + w * K8 + 8 * fq;
        const bf16_t* bp = Bt + (size_t)(col0 + fr) * K + w * K8 + 8 * fq;
#pragma unroll 1
        for (int k0 = 0; k0 < K8; k0 += 32) {
            const bf16x8 af = *(const bf16x8*)(ap + k0);
            bf16x8 bf[16];
#pragma unroll
            for (int t = 0; t < 16; ++t) bf[t] = *(const bf16x8*)(bp + (size_t)(16 * t) * K + k0);
#pragma unroll
            for (int t = 0; t < 16; ++t) acc[t] = __builtin_amdgcn_mfma_f32_16x16x32_bf16(bf[t], af, acc[t], 0, 0, 0);
        }
#pragma unroll
        for (int t = 0; t < 16; ++t) xch[(w * 16 + t) * 64 + C.lane] = acc[t];
        __syncthreads();
        const int wc = w >> 1, bj = w & 1, t0 = 8 * bj + 2 * wc;
        f32x4 v0 = {0.f, 0.f, 0.f, 0.f}, v1 = v0;
#pragma unroll
        for (int q = 0; q < 8; ++q) { v0 += xch[(q * 16 + t0) * 64 + C.lane]; v1 += xch[(q * 16 + t0 + 1) * 64 + C.lane]; }
        const int row = row0 + fr;
        const float rs = E.row_begin(row, fq);
        float ss = E.item(row, col0 + 128 * bj + 32 * wc + 4 * fq, v0, v1, rs);
        if constexpr (Epi::STATS) {
            ss += __shfl_xor(ss, 16); ss += __shfl_xor(ss, 32);
            if (fq == 0) sx[fr * 8 + w] = ss;
            __syncthreads();
            if (fq == 0 && bj == 0) E.stats[(size_t)row * 16 + un * 4 + wc] = sx[fr * 8 + w] + sx[fr * 8 + w + 1];
        }
        __syncthreads();
    }
}
template <class E0>
__device__ __forceinline__ void gemm_both(Ctx& C, const bf16_t* A, const bf16_t* Bt, int Mbig, int N, int K, const E0& E, int ctx_n_lo, int ctx_n_hi, int nb_lo = 0, int nb_hi = -1) {
    if (nb_hi < 0) nb_hi = N / 256;
    { pg8::Gemm g{A, Bt + (size_t)nb_lo * 256 * K, Mbig, (nb_hi - nb_lo) * 256, K}; pg8::StaticOrder S; S.init(Mbig, (nb_hi - nb_lo) * 256, C.G, C.bid); EpiAdapt<E0> EA{E, nb_lo * 256};
      pg8::gemm_phase<EpiAdapt<E0>, pg8::StaticOrder, true, true>(C.lds, g, S, EA); }
    if (Mbig < R && ctx_n_hi > ctx_n_lo) { __syncthreads(); relane(C); sgemm_small(C, A, Bt, T, R - T, N, K, E, ctx_n_lo, ctx_n_hi); }
}
__device__ __forceinline__ void dwconv_phase(Ctx& C, int j) {
    const bf16_t* U = (const bf16_t*)(C.ws + WS_U); bf16_t* A2 = (bf16_t*)(C.ws + WS_A2);
    const float* dww = C.in[10] + (size_t)j * CK * 1024; const float* dwb = C.in[11] + j * 1024; const float* lng = C.in[12] + j * 1024; const float* lnb = C.in[13] + j * 1024;
    constexpr int TT = 33, NR = TT + 30;
    LAS unsigned char* tile = C.lds; LAS float* part = (LAS float*)(C.lds + NR * 2048);
    const int tid = C.tid;
    constexpr int NUL = (T + TT - 1) / TT, NUC = (TC + TT - 1) / TT;
    f32x2 wt[CK];
#pragma unroll
    for (int jt = 0; jt < CK; ++jt) wt[jt] = *(const f32x2*)(dww + jt * 1024 + 2 * tid);
    const f32x2 b2 = *(const f32x2*)(dwb + 2 * tid), g2 = *(const f32x2*)(lng + 2 * tid), bb2 = *(const f32x2*)(lnb + 2 * tid);
    for (int u = C.bid; u < NUL + NUC; u += C.G) {
        const bool lat = u < NUL; const int base = lat ? 0 : T, n = lat ? T : TC, t0 = TT * (lat ? u : u - NUL);
        const int nv = (n - t0) < TT ? (n - t0) : TT;
        for (int idx = tid; idx < NR * 128; idx += 512) {
            const int rr = idx >> 7, ch = idx & 127, tt = t0 - 15 + rr;
            u32x4 v = {0u, 0u, 0u, 0u};
            if (tt >= 0 && tt < n) v = *(const u32x4*)(U + (size_t)(base + tt) * 1024 + ch * 8);
            *(LAS u32x4*)(tile + rr * 2048 + ch * 16) = v;
        }
        __syncthreads();
        f32x2 o[TT];
#pragma unroll
        for (int t = 0; t < TT; ++t) o[t] = b2;
#pragma unroll
        for (int hb = 0; hb < 3; ++hb) {
            f32x2 xw[41];
#pragma unroll
            for (int r = 0; r < 41; ++r) { const unsigned uu = *(const LAS unsigned*)(tile + (11 * hb + r) * 2048 + tid * 4); xw[r] = (f32x2){bflo(uu), bfhi(uu)}; }
#pragma unroll
            for (int t = 0; t < 11; ++t)
#pragma unroll
                for (int jt = 0; jt < CK; ++jt) o[11 * hb + t] += wt[jt] * xw[t + jt];
        }
#pragma unroll
        for (int t = 0; t < TT; ++t) {
            const float s = wave_sum63(o[t].x + o[t].y), q = wave_sum63(o[t].x * o[t].x + o[t].y * o[t].y);
            if (C.lane == 63) { part[(t * 8 + C.wave) * 2] = s; part[(t * 8 + C.wave) * 2 + 1] = q; }
        }
        __syncthreads();
#pragma unroll
        for (int t = 0; t < TT; ++t) {
            float s = 0.f, q = 0.f;
#pragma unroll
            for (int w = 0; w < 8; ++w) { s += part[(t * 8 + w) * 2]; q += part[(t * 8 + w) * 2 + 1]; }
            const float mean = s * (1.f / 1024.f), var = q * (1.f / 1024.f) - mean * mean, rstd = 1.0f / sqrtf(var + LN_EPS);
            const float y0 = (o[t].x - mean) * rstd * g2.x + bb2.x, y1 = (o[t].y - mean) * rstd * g2.y + bb2.y;
            if (t < nv) *(unsigned*)(A2 + (size_t)(base + t0 + t) * 1024 + 2 * tid) = pk2(siluf(y0), siluf(y1));
        }
        __syncthreads();
    }
}

__device__ __forceinline__ void scan_phase(Ctx& C, int j) {
    const bf16_t* Kb = (const bf16_t*)(C.ws + WS_K); const bf16_t* Vt = (const bf16_t*)(C.ws + WS_VT); bf16_t* Scp = (bf16_t*)(C.ws + WS_SCP);
    constexpr int SLOT = 32768;
    const int fr = C.lane & 15, fq = C.lane >> 4, w = C.wave, lane = C.lane;
    for (int cu = C.bid; cu < 256; cu += C.G) {
        const int hd = cu & 7, sidx = cu >> 3, h = hd >> 1, dir = hd & 1, dk_s = 64 * ((sidx >> 3) & 3), dv_s = 64 * (sidx & 7);
        const float gam = 1.0f - exp2f(C.in[17][(j * 2 + dir) * 4 + h]); const float L = log2f(gam);
        const float cdec = exp2f(L * 128.f);
        const bf16_t* ksrc[2]; const bf16_t* vsrc[2];
#pragma unroll
        for (int p = 0; p < 2; ++p) {
            const int kr = 8 * (2 * w + p) + (lane >> 3), kpos = lane & 7, kc = kpos ^ (((kr >> 3) & 1) << 1) ^ (((kr >> 1) & 1) << 2);
            ksrc[p] = Kb + (size_t)kr * 1024 + h * 256 + dk_s + 8 * kc;
            const int vr = 4 * (2 * w + p) + (lane >> 4), vpos = lane & 15, vc = vpos ^ (vr & 15);
            vsrc[p] = Vt + (size_t)(h * 512 + dv_s + vr) * R + 8 * vc;
        }
        auto tok_of = [&](int st) { const int sc = st < 129 ? st : 129; const int bl = sc < 2 ? (dir == 0 ? sc : 1 - sc) : (dir == 0 ? sc - 2 : 129 - sc); return (sc < 2 ? T : 0) + 128 * bl; };
#define SCAN_DMA(st) do { const int tok_ = tok_of(st); LAS unsigned char* sl_ = C.lds + ((st) & 3) * SLOT + (2 * w) * 1024; \
        __builtin_amdgcn_global_load_lds((const unsigned*)(ksrc[0] + (size_t)tok_ * 1024), (LAS unsigned*)(sl_), 16, 0, 0); \
        __builtin_amdgcn_global_load_lds((const unsigned*)(ksrc[1] + (size_t)tok_ * 1024), (LAS unsigned*)(sl_ + 1024), 16, 0, 0); \
        __builtin_amdgcn_global_load_lds((const unsigned*)(vsrc[0] + tok_), (LAS unsigned*)(sl_ + 16384), 16, 0, 0); \
        __builtin_amdgcn_global_load_lds((const unsigned*)(vsrc[1] + tok_), (LAS unsigned*)(sl_ + 16384 + 1024), 16, 0, 0); } while (0)
        const int mt = w >> 1, nh = w & 1, dkl = 16 * mt;
        const int trq = (fr >> 2), trp = fr & 3, trrow0 = 8 * fq + trq;
        const int trcol0 = (((2 * mt + (trp >> 1)) ^ ((fq & 1) << 1) ^ (((trq >> 1) & 1) << 2)) << 3) + 4 * (trp & 1);
        float kd[4][8];
#pragma unroll
        for (int ks = 0; ks < 4; ++ks)
#pragma unroll
            for (int e = 0; e < 8; ++e) { const int tl = 32 * ks + 8 * fq + e; kd[ks][e] = exp2f(L * (float)(dir == 0 ? 127 - tl : tl)); }
        int voff[2];
#pragma unroll
        for (int nt = 0; nt < 2; ++nt) { const int vr = 32 * nh + 16 * nt + fr; voff[nt] = 16384 + vr * 256; }
        f32x4 acc[2]; acc[0] = (f32x4){0.f, 0.f, 0.f, 0.f}; acc[1] = acc[0];
        const unsigned lds0 = (unsigned)(size_t)C.lds;
        __syncthreads();
        SCAN_DMA(0); SCAN_DMA(1); SCAN_DMA(2);
#pragma unroll 1
        for (int st = 0; st < 130; ++st) {
            asm volatile("s_waitcnt vmcnt(8)" ::: "memory");
            __builtin_amdgcn_s_barrier(); asm volatile("" ::: "memory");
            SCAN_DMA(st + 3);
            {   const bool isctx = st < 2; const int bl = isctx ? (dir == 0 ? st : 1 - st) : (dir == 0 ? st - 2 : 129 - st);
                const bool cp = dir == 0 ? ((bl & 3) == 0) : (isctx ? bl == 1 : (bl & 3) == 3);
                if (cp) {
                    const int slot = isctx ? 32 : (bl >> 2);
                    bf16_t* sp = Scp + ((size_t)((slot * 4 + h) * 2 + dir) * 512) * 256;
#pragma unroll
                    for (int nt = 0; nt < 2; ++nt) { u32x2 wv; wv.x = pk2(acc[nt][0], acc[nt][1]); wv.y = pk2(acc[nt][2], acc[nt][3]);
                        *(u32x2*)(sp + (size_t)(dv_s + 32 * nh + 16 * nt + fr) * 256 + dk_s + dkl + 4 * fq) = wv; }
                } }
            acc[0] = acc[0] * cdec; acc[1] = acc[1] * cdec;
            const unsigned sl = lds0 + (unsigned)((st & 3) * SLOT);
            u32x2 klo[4], khi[4]; u32x4 vfr[4][2];
#pragma unroll
            for (int ks = 0; ks < 4; ++ks) {
                const unsigned ka = sl + (unsigned)(((32 * ks + trrow0) * 64 + trcol0) * 2);
                asm volatile("ds_read_b64_tr_b16 %0, %1" : "=v"(klo[ks]) : "v"(ka));
                asm volatile("ds_read_b64_tr_b16 %0, %1 offset:512" : "=v"(khi[ks]) : "v"(ka));
#pragma unroll
                for (int nt = 0; nt < 2; ++nt) { const int vr = 32 * nh + 16 * nt + fr;
                    const unsigned va = sl + (unsigned)(voff[nt] + (((4 * ks + fq) ^ (vr & 15)) << 4));
                    asm volatile("ds_read_b128 %0, %1" : "=v"(vfr[ks][nt]) : "v"(va)); }
            }
            asm volatile("s_waitcnt lgkmcnt(0)" : "+v"(klo[0]), "+v"(klo[1]), "+v"(klo[2]), "+v"(klo[3]), "+v"(khi[0]), "+v"(khi[1]), "+v"(khi[2]), "+v"(khi[3]) :: "memory");
            asm volatile("" : "+v"(vfr[0][0]), "+v"(vfr[0][1]), "+v"(vfr[1][0]), "+v"(vfr[1][1]), "+v"(vfr[2][0]), "+v"(vfr[2][1]), "+v"(vfr[3][0]), "+v"(vfr[3][1]));
            __builtin_amdgcn_sched_barrier(0);
#pragma unroll
            for (int ks = 0; ks < 4; ++ks) {
                u32x4 pk;
                pk.x = pk2(bflo(klo[ks].x) * kd[ks][0], bfhi(klo[ks].x) * kd[ks][1]);
                pk.y = pk2(bflo(klo[ks].y) * kd[ks][2], bfhi(klo[ks].y) * kd[ks][3]);
                pk.z = pk2(bflo(khi[ks].x) * kd[ks][4], bfhi(khi[ks].x) * kd[ks][5]);
                pk.w = pk2(bflo(khi[ks].y) * kd[ks][6], bfhi(khi[ks].y) * kd[ks][7]);
                const bf16x8 af = __builtin_bit_cast(bf16x8, pk);
#pragma unroll
                for (int nt = 0; nt < 2; ++nt) acc[nt] = __builtin_amdgcn_mfma_f32_16x16x32_bf16(af, __builtin_bit_cast(bf16x8, vfr[ks][nt]), acc[nt], 0, 0, 0);
            }
        }
        asm volatile("s_waitcnt vmcnt(0)" ::: "memory");
        __syncthreads();
#undef SCAN_DMA
    }
}

__device__ __forceinline__ void ugemm_phase(Ctx& C, int j) {
    const bf16_t* Kb = (const bf16_t*)(C.ws + WS_K); const bf16_t* Vt = (const bf16_t*)(C.ws + WS_VT); bf16_t* Scp = (bf16_t*)(C.ws + WS_SCP);
    constexpr int SLOT = 32768;
    const int fr = C.lane & 15, fq = C.lane >> 4, w = C.wave, lane = C.lane;
    const int wm = w >> 1, wn = w & 1;
    const unsigned lds0 = (unsigned)(size_t)C.lds;
    for (int it0 = 0; it0 < 3; ++it0) {
        int set, sub;
        if (it0 < 2) { if (C.bid >= 256) break; const int x = C.bid & 7, ii = C.bid >> 3; set = it0 * 64 + x * 8 + (ii >> 2); sub = ii & 3; }
        else { const int k = C.G - 1 - C.bid; if (k >= 16) break; set = 128 + (k >> 2); sub = k & 3; }
        const int slot = set >> 2, h = set & 3, dir = sub >> 1, dvh = sub & 1;
        const int ntok = slot < 32 ? 512 : 256, tokb = slot < 32 ? 512 * slot : T, nst = ntok / 32;
        const float gam = 1.0f - exp2f(C.in[17][(j * 2 + dir) * 4 + h]); const float L = log2f(gam);
        unsigned ksrc[2], vsrc[2];
#pragma unroll
        for (int p = 0; p < 2; ++p) {
            const int kr = 2 * (2 * w + p) + (lane >> 5), kpos = lane & 31, kc = kpos ^ ((((kr & 3) | (((kr >> 3) & 1) << 2))) << 1);
            ksrc[p] = (unsigned)((tokb + kr) * 1024 + h * 256 + 8 * kc);
            const int vr = 16 * (2 * w + p) + (lane >> 2), vpos = lane & 3, vc = vpos ^ ((4 - ((vr >> 2) & 3)) & 3);
            vsrc[p] = (unsigned)((h * 512 + 256 * dvh + vr) * R + tokb + 8 * vc);
        }
#define UG_DMA(st) do { const int s_ = (st) < nst ? (st) : nst - 1; LAS unsigned char* sl_ = C.lds + ((st) & 3) * SLOT + (2 * w) * 1024; \
        _Pragma("unroll") for (int p = 0; p < 2; ++p) { \
            __builtin_amdgcn_global_load_lds((const unsigned*)(Kb + (ksrc[p] + (unsigned)(32 * s_ * 1024))), (LAS unsigned*)(sl_ + p * 1024), 16, 0, 0); \
            __builtin_amdgcn_global_load_lds((const unsigned*)(Vt + (vsrc[p] + (unsigned)(32 * s_))), (LAS unsigned*)(sl_ + 16384 + p * 1024), 16, 0, 0); } } while (0)
        const int trq = fr >> 2, trp = fr & 3;
        const int row0 = 8 * fq + trq;
        const unsigned a0 = (unsigned)(row0 * 512 + (((8 * wm + (trp >> 1)) ^ ((((row0 & 3) | (((row0 >> 3) & 1) << 2))) << 1)) << 4) + 8 * (trp & 1));
        const unsigned boff0 = (unsigned)(16384 + (128 * wn + fr) * 64 + ((fq ^ ((4 - ((fr >> 2) & 3)) & 3)) << 4));
        float kd[8];
#pragma unroll
        for (int e = 0; e < 8; ++e) { const int tl = 8 * fq + e; kd[e] = exp2f(L * (float)(dir == 0 ? 31 - tl : tl)); }
        f32x4 acc[4][8];
#pragma unroll
        for (int mt = 0; mt < 4; ++mt)
#pragma unroll
            for (int nt = 0; nt < 8; ++nt) acc[mt][nt] = (f32x4){0.f, 0.f, 0.f, 0.f};
        __syncthreads();
        UG_DMA(0); UG_DMA(1); UG_DMA(2);
#pragma unroll 1
        for (int st = 0; st < nst; ++st) {
            asm volatile("s_waitcnt vmcnt(8)" ::: "memory");
            __builtin_amdgcn_s_barrier(); asm volatile("" ::: "memory");
            UG_DMA(st + 3);
            const float sf = exp2f(L * (float)(dir == 0 ? ntok - 32 - 32 * st : 32 * st));
            const unsigned sl = lds0 + (unsigned)((st & 3) * SLOT);
            u32x2 alo[4], ahi[4]; u32x4 bfv[4];
#pragma unroll
            for (int mt = 0; mt < 4; ++mt) {
                const unsigned aa = sl + (a0 ^ (unsigned)(mt << 5));
                asm volatile("ds_read_b64_tr_b16 %0, %1" : "=v"(alo[mt]) : "v"(aa));
                asm volatile("ds_read_b64_tr_b16 %0, %1 offset:2048" : "=v"(ahi[mt]) : "v"(aa));
            }
            const unsigned ba = sl + boff0;
#pragma unroll
            for (int nt = 0; nt < 4; ++nt) asm volatile("ds_read_b128 %0, %1 offset:%c2" : "=v"(bfv[nt]) : "v"(ba), "i"(nt * 1024));
            asm volatile("s_waitcnt lgkmcnt(0)" : "+v"(alo[0]), "+v"(alo[1]), "+v"(alo[2]), "+v"(alo[3]), "+v"(ahi[0]), "+v"(ahi[1]), "+v"(ahi[2]), "+v"(ahi[3]) :: "memory");
            asm volatile("" : "+v"(bfv[0]), "+v"(bfv[1]), "+v"(bfv[2]), "+v"(bfv[3]));
            __builtin_amdgcn_sched_barrier(0);
            bf16x8 af[4];
#pragma unroll
            for (int mt = 0; mt < 4; ++mt) {
                u32x4 pk;
                pk.x = pk2(bflo(alo[mt].x) * (kd[0] * sf), bfhi(alo[mt].x) * (kd[1] * sf));
                pk.y = pk2(bflo(alo[mt].y) * (kd[2] * sf), bfhi(alo[mt].y) * (kd[3] * sf));
                pk.z = pk2(bflo(ahi[mt].x) * (kd[4] * sf), bfhi(ahi[mt].x) * (kd[5] * sf));
                pk.w = pk2(bflo(ahi[mt].y) * (kd[6] * sf), bfhi(ahi[mt].y) * (kd[7] * sf));
                af[mt] = __builtin_bit_cast(bf16x8, pk);
            }
#pragma unroll
            for (int mt = 0; mt < 4; ++mt)
#pragma unroll
                for (int nt = 0; nt < 4; ++nt) acc[mt][nt] = __builtin_amdgcn_mfma_f32_16x16x32_bf16(af[mt], __builtin_bit_cast(bf16x8, bfv[nt]), acc[mt][nt], 0, 0, 0);
            __builtin_amdgcn_sched_barrier(0);
#pragma unroll
            for (int nt = 0; nt < 4; ++nt) asm volatile("ds_read_b128 %0, %1 offset:%c2" : "=v"(bfv[nt]) : "v"(ba), "i"((nt + 4) * 1024));
            asm volatile("s_waitcnt lgkmcnt(0)" : "+v"(bfv[0]), "+v"(bfv[1]), "+v"(bfv[2]), "+v"(bfv[3]) :: "memory");
            __builtin_amdgcn_sched_barrier(0);
#pragma unroll
            for (int mt = 0; mt < 4; ++mt)
#pragma unroll
                for (int nt = 0; nt < 4; ++nt) acc[mt][nt + 4] = __builtin_amdgcn_mfma_f32_16x16x32_bf16(af[mt], __builtin_bit_cast(bf16x8, bfv[nt]), acc[mt][nt + 4], 0, 0, 0);
        }
        asm volatile("s_waitcnt vmcnt(0)" ::: "memory");
        bf16_t* sp = Scp + ((size_t)((slot * 4 + h) * 2 + dir) * 512) * 256;
#pragma unroll
        for (int nt = 0; nt < 8; ++nt) {
            bf16_t* rowp = sp + (size_t)(256 * dvh + 128 * wn + 16 * nt + fr) * 256 + 64 * wm + 4 * fq;
#pragma unroll
            for (int mt = 0; mt < 4; ++mt) { u32x2 wv; wv.x = pk2(acc[mt][nt][0], acc[mt][nt][1]); wv.y = pk2(acc[mt][nt][2], acc[mt][nt][3]); *(u32x2*)(rowp + 16 * mt) = wv; }
        }
        __syncthreads();
#undef UG_DMA
    }
}
__device__ __forceinline__ void prefix_phase(Ctx& C, int j) {
    bf16_t* Scp = (bf16_t*)(C.ws + WS_SCP);
    constexpr size_t SSTR = (size_t)8 * 512 * 256;
    for (int idx = C.bid * 512 + C.tid; idx < 8 * 512 * 32; idx += C.G * 512) {
        const int hd = idx >> 14, h = hd >> 1, dir = hd & 1;
        const float gam = 1.0f - exp2f(C.in[17][(j * 2 + dir) * 4 + h]); const float cdec = exp2f(log2f(gam) * 512.f);
        bf16_t* p = Scp + (size_t)idx * 8;
        const u32x4 raw = *(const u32x4*)(p + 32 * SSTR);
        float s[8] = {bflo(raw.x), bfhi(raw.x), bflo(raw.y), bfhi(raw.y), bflo(raw.z), bfhi(raw.z), bflo(raw.w), bfhi(raw.w)};
        *(u32x4*)(p + 32 * SSTR) = (u32x4){0u, 0u, 0u, 0u};
#pragma unroll 1
        for (int qb = 0; qb < 4; ++qb) {
            u32x4 u[8];
#pragma unroll
            for (int q = 0; q < 8; ++q) { const int g = dir == 0 ? 8 * qb + q : 31 - (8 * qb + q); u[q] = *(const u32x4*)(p + (size_t)g * SSTR); }
#pragma unroll
            for (int q = 0; q < 8; ++q) {
                const int g = dir == 0 ? 8 * qb + q : 31 - (8 * qb + q);
                u32x4 o; o.x = pk2(s[0], s[1]); o.y = pk2(s[2], s[3]); o.z = pk2(s[4], s[5]); o.w = pk2(s[6], s[7]);
                *(u32x4*)(p + (size_t)g * SSTR) = o;
                s[0] = s[0] * cdec + bflo(u[q].x); s[1] = s[1] * cdec + bfhi(u[q].x); s[2] = s[2] * cdec + bflo(u[q].y); s[3] = s[3] * cdec + bfhi(u[q].y);
                s[4] = s[4] * cdec + bflo(u[q].z); s[5] = s[5] * cdec + bfhi(u[q].z); s[6] = s[6] * cdec + bflo(u[q].w); s[7] = s[7] * cdec + bfhi(u[q].w);
            }
        }
    }
}

template <int MT, int PV = 0>
__device__ __forceinline__ void readout_units(Ctx& C, int j) {
    const bf16_t* Q = (const bf16_t*)(C.ws + WS_Q); const bf16_t* Kb = (const bf16_t*)(C.ws + WS_K); const bf16_t* Vt = (const bf16_t*)(C.ws + WS_VT);
    const bf16_t* Scp = (const bf16_t*)(C.ws + WS_SCP); bf16_t* GF = (bf16_t*)(C.ws + WS_GF); const bf16_t* GB = (const bf16_t*)(C.ws + WS_GB);
    constexpr int QP = 264, PP = 136;
    constexpr int NROW = 16 * MT;
    LAS bf16_t* Qs = (LAS bf16_t*)C.lds;
    LAS bf16_t* P = (LAS bf16_t*)(C.lds + NROW * QP * 2);
    LAS float* red = (LAS float*)(C.lds + NROW * QP * 2 + NROW * PP * 2);
    const int w = C.wave, tid = C.tid;
    const int nunits = MT == 8 ? 512 : 32;
    for (int u0 = (MT == 8 ? C.bid : C.G - 1 - C.bid); u0 < nunits; u0 += C.G) {
        int h, b, sb = 0;
        if (MT != 8) { h = u0 & 3; sb = (u0 >> 2) & 3; b = 128 + (u0 >> 4); }
        else if (C.G == 256) { const int r = u0 >> 8, x = u0 & 7, idx = (u0 & 255) >> 3, grp = r * 64 + x * 8 + (idx >> 2); h = grp & 3; b = (grp >> 2) * 4 + (idx & 3); }
        else { h = u0 & 3; b = u0 >> 2; }
        const bool lat = b < 128; const int base = lat ? 0 : T, nb = lat ? 128 : 2, bl = lat ? b : b - 128;
        const int g = bl >> 2, slot = lat ? g : 32;
        const int gend = (4 * (g + 1) < nb ? 4 * (g + 1) : nb);
        const int i0 = base + 128 * bl + NROW * sb, il0 = 128 * bl + NROW * sb;
#pragma unroll
        for (int i = 0; i < MT; ++i) { const int c = tid + 512 * i, row = c >> 5, ch = c & 31;
            *(LAS u32x4*)(Qs + row * QP + 8 * ch) = *(const u32x4*)(Q + (size_t)(i0 + row) * 1024 + h * 256 + 8 * ch); }
        __syncthreads();
#pragma unroll 1
        for (int dir = 0; dir < 2; ++dir) {
            int lane_o = C.lane; asm volatile("" : "+v"(lane_o));
            const int fr = lane_o & 15, fq = lane_o >> 4;
            const float gam = 1.0f - exp2f(C.in[17][(j * 2 + dir) * 4 + h]); const float L = log2f(gam);
            f32x4 acc[MT][4];
#pragma unroll
            for (int mt = 0; mt < MT; ++mt)
#pragma unroll
                for (int nt = 0; nt < 4; ++nt) acc[mt][nt] = (f32x4){0.f, 0.f, 0.f, 0.f};
            const int kb_lo = dir == 0 ? 4 * g : bl, kb_hi = dir == 0 ? bl : gend - 1;
            const bf16_t* sb = Scp + ((size_t)((slot * 4 + h) * 2 + dir) * 512) * 256 + (size_t)(64 * w + 16 * (fr >> 2) + (fr & 3)) * 256 + 8 * fq;
#pragma unroll 1
            for (int kq = 0; kq < (PV == 5 ? 0 : 4); ++kq) {
                bf16x8 sf[2][4];
#pragma unroll
                for (int k2 = 0; k2 < 2; ++k2)
#pragma unroll
                    for (int nt = 0; nt < 4; ++nt) sf[k2][nt] = *(const bf16x8*)(sb + (size_t)(4 * nt) * 256 + 32 * (2 * kq + k2));
#pragma unroll
                for (int k2 = 0; k2 < 2; ++k2)
#pragma unroll
                    for (int mt = 0; mt < MT; ++mt) { const bf16x8 qf = *(const LAS bf16x8*)(Qs + (16 * mt + fr) * QP + 32 * (2 * kq + k2) + 8 * fq);
#pragma unroll
                        for (int nt = 0; nt < 4; ++nt) acc[mt][nt] = __builtin_amdgcn_mfma_f32_16x16x32_bf16(sf[k2][nt], qf, acc[mt][nt], 0, 0, 0); }
            }
#pragma unroll
            for (int mt = 0; mt < MT; ++mt) {
                const int il = il0 + 16 * mt + fr;
                const int ex = dir == 0 ? il - 512 * g + 1 : gend * 128 - il;
                const float qd = __builtin_amdgcn_exp2f(L * (float)ex);
#pragma unroll
                for (int nt = 0; nt < 4; ++nt) acc[mt][nt] = acc[mt][nt] * qd;
            }
#pragma unroll 1
            for (int kb = kb_lo; kb <= ((PV == 2 || PV == 5) ? kb_lo - 1 : kb_hi); ++kb) {
                const int j0 = base + 128 * kb;
                {
                    bf16x8 kf[8];
                    const bf16_t* k1 = Kb + (size_t)(j0 + 16 * w + fr) * 1024 + h * 256 + 8 * fq;
#pragma unroll
                    for (int ks = 0; ks < 8; ++ks) kf[ks] = *(const bf16x8*)(k1 + 32 * ks);
                    f32x4 sc[MT];
#pragma unroll
                    for (int mt = 0; mt < MT; ++mt) sc[mt] = (f32x4){0.f, 0.f, 0.f, 0.f};
#pragma unroll
                    for (int ks = 0; ks < 8; ++ks) {
#pragma unroll
                        for (int mt = 0; mt < MT; ++mt) { const bf16x8 qf = *(const LAS bf16x8*)(Qs + (16 * mt + fr) * QP + 32 * ks + 8 * fq);
                            sc[mt] = __builtin_amdgcn_mfma_f32_16x16x32_bf16(kf[ks], qf, sc[mt], 0, 0, 0); }
                        __builtin_amdgcn_sched_barrier(0);
                    }
#pragma unroll
                    for (int mt = 0; mt < MT; ++mt) {
                        const int il = il0 + 16 * mt + fr;
                        float p[4];
#pragma unroll
                        for (int e = 0; e < 4; ++e) { const int jl = 128 * kb + 16 * w + 4 * fq + e; const int rel = dir == 0 ? il - jl : jl - il;
                            p[e] = rel >= 0 ? sc[mt][e] * __builtin_amdgcn_exp2f(L * (float)rel) : 0.f; }
                        u32x2 wv; wv.x = pk2(p[0], p[1]); wv.y = pk2(p[2], p[3]);
                        *(LAS u32x2*)(P + (16 * mt + fr) * PP + 16 * w + 4 * fq) = wv;
                    }
                }
                __syncthreads();
                const bf16_t* vb = Vt + (size_t)(h * 512 + 64 * w + 16 * (fr >> 2) + (fr & 3)) * R + j0 + 8 * fq;
#pragma unroll 1
                for (int kh2 = 0; kh2 < 2; ++kh2) {
                    bf16x8 vf[2][4];
#pragma unroll
                    for (int k2 = 0; k2 < 2; ++k2)
#pragma unroll
                        for (int nt = 0; nt < 4; ++nt) vf[k2][nt] = *(const bf16x8*)(vb + (size_t)(4 * nt) * R + 32 * (2 * kh2 + k2));
#pragma unroll
                    for (int k2 = 0; k2 < 2; ++k2)
#pragma unroll
                        for (int mt = 0; mt < MT; ++mt) { const bf16x8 pf = *(const LAS bf16x8*)(P + (16 * mt + fr) * PP + 32 * (2 * kh2 + k2) + 8 * fq);
#pragma unroll
                            for (int nt = 0; nt < 4; ++nt) acc[mt][nt] = __builtin_amdgcn_mfma_f32_16x16x32_bf16(vf[k2][nt], pf, acc[mt][nt], 0, 0, 0); }
                }
                __syncthreads();
            }
#pragma unroll
            for (int mt = 0; mt < MT; ++mt) {
                float ss = 0.f;
#pragma unroll
                for (int nt = 0; nt < 4; ++nt) ss += (acc[mt][nt][0] * acc[mt][nt][0] + acc[mt][nt][1] * acc[mt][nt][1]) + (acc[mt][nt][2] * acc[mt][nt][2] + acc[mt][nt][3] * acc[mt][nt][3]);
                ss += __shfl_xor(ss, 16); ss += __shfl_xor(ss, 32);
                if (fq == 0) red[(16 * mt + fr) * 8 + w] = ss;
            }
            const size_t off0 = (size_t)(i0 + fr) * 2048 + h * 512 + 64 * w + 16 * fq;
            u32x4 gld[MT][2];
#pragma unroll
            for (int mt = 0; mt < MT; ++mt)
#pragma unroll
                for (int np = 0; np < 2; ++np) gld[mt][np] = *(const u32x4*)((dir == 0 ? (const bf16_t*)GF : GB) + off0 + (size_t)(16 * mt) * 2048 + 8 * np);
            __syncthreads();
#pragma unroll
            for (int mt = 0; mt < MT; ++mt) {
                float tot = 0.f;
#pragma unroll
                for (int w2 = 0; w2 < 8; ++w2) tot += red[(16 * mt + fr) * 8 + w2];
                const float rn = 1.0f / sqrtf(tot * (1.f / 512.f) + NORM_EPS);
#pragma unroll
                for (int np = 0; np < 2; ++np) {
                    const u32x4 g4 = gld[mt][np];
                    acc[mt][2 * np][0] *= siluf(bflo(g4.x)) * rn; acc[mt][2 * np][1] *= siluf(bfhi(g4.x)) * rn;
                    acc[mt][2 * np][2] *= siluf(bflo(g4.y)) * rn; acc[mt][2 * np][3] *= siluf(bfhi(g4.y)) * rn;
                    acc[mt][2 * np + 1][0] *= siluf(bflo(g4.z)) * rn; acc[mt][2 * np + 1][1] *= siluf(bfhi(g4.z)) * rn;
                    acc[mt][2 * np + 1][2] *= siluf(bflo(g4.w)) * rn; acc[mt][2 * np + 1][3] *= siluf(bfhi(g4.w)) * rn;
                }
            }
            if (dir == 1) {
#pragma unroll
                for (int mt = 0; mt < MT; ++mt)
#pragma unroll
                    for (int np = 0; np < 2; ++np) gld[mt][np] = *(const u32x4*)(GF + off0 + (size_t)(16 * mt) * 2048 + 8 * np);
#pragma unroll
                for (int mt = 0; mt < MT; ++mt)
#pragma unroll
                    for (int np = 0; np < 2; ++np) { const u32x4 yp = gld[mt][np];
                        acc[mt][2 * np][0] += bflo(yp.x); acc[mt][2 * np][1] += bfhi(yp.x); acc[mt][2 * np][2] += bflo(yp.y); acc[mt][2 * np][3] += bfhi(yp.y);
                        acc[mt][2 * np + 1][0] += bflo(yp.z); acc[mt][2 * np + 1][1] += bfhi(yp.z); acc[mt][2 * np + 1][2] += bflo(yp.w); acc[mt][2 * np + 1][3] += bfhi(yp.w); }
            }
            if (PV != 4) {
#pragma unroll
                for (int mt = 0; mt < MT; ++mt)
#pragma unroll
                    for (int np = 0; np < 2; ++np) { u32x4 wv; wv.x = pk2(acc[mt][2 * np][0], acc[mt][2 * np][1]); wv.y = pk2(acc[mt][2 * np][2], acc[mt][2 * np][3]);
                        wv.z = pk2(acc[mt][2 * np + 1][0], acc[mt][2 * np + 1][1]); wv.w = pk2(acc[mt][2 * np + 1][2], acc[mt][2 * np + 1][3]);
                        *(u32x4*)(GF + off0 + (size_t)(16 * mt) * 2048 + 8 * np) = wv; }
            }
        }
        __syncthreads();
    }
}

template <int PV = 0>
__device__ __forceinline__ void readout_phase(Ctx& C, int j, bool skip_ctx) {
    readout_units<8, PV>(C, j);
    if (!skip_ctx) { __syncthreads(); readout_units<2, PV>(C, j); }
}

__device__ __forceinline__ void phase_p0(Ctx& C) {
    float* modv = (float*)(C.ws + WS_MODV);
    for (int u = C.bid; u < 384; u += C.G) {
        const int i = u / 96, nbk = u % 96;
        gemv2_unit<1>(C, C.in[4] + (size_t)i * 1024 * 6144, 6144, 64 * nbk, C.in[1], C.in[3], C.in[5] + i * 6144, modv + (i * 2 + 0) * 6144, modv + (i * 2 + 1) * 6144, 0, 0);
    }
    float* tabc = (float*)(C.ws + WS_TABC); float* tabs = (float*)(C.ws + WS_TABS);
    for (int idx = C.bid * 512 + C.tid; idx < 320 * 64; idx += C.G * 512) {
        const int ti = idx >> 6, i = idx & 63; const float pos = (float)(ti < 256 ? ti : ti - 256);
        const float inv = exp2f(-(float)i * (13.287712379549449f / 64.0f)); const float ang = pos * inv;
        tabc[idx] = __cosf(ang); tabs[idx] = __sinf(ang);
    }
}
__device__ __forceinline__ void phase_p1(Ctx& C) {
    const float* modv = (const float*)(C.ws + WS_MODV);
    float* s1 = (float*)(C.ws + WS_S1); float* s2 = (float*)(C.ws + WS_S2);
    for (int idx = C.bid * 512 + C.tid; idx < 8192; idx += C.G * 512) {
        const int i = idx >> 11, s = (idx >> 10) & 1, k = idx & 1023;
        s1[idx] = C.in[6][i * 1024 + k] * (1.f + modv[(i * 2 + s) * 6144 + 1024 + k]);
        s2[idx] = C.in[7][i * 1024 + k] * (1.f + modv[(i * 2 + s) * 6144 + 4096 + k]);
    }
    float* cvA = (float*)(C.ws + WS_CVA); float* cvF = (float*)(C.ws + WS_CVF);
    for (int u = C.bid; u < 672; u += C.G) {
        if (u < 320) {
            int i, nbk; if (u < 32) { i = 0; nbk = u; } else if (u < 160) { i = 1; nbk = u - 32; } else if (u < 192) { i = 2; nbk = u - 160; } else { i = 3; nbk = u - 192; }
            const int j = i >> 1; const float* v0 = modv + (i * 2 + 0) * 6144; const float* v1 = modv + (i * 2 + 1) * 6144;
            if ((i & 1) == 0) gemv2_unit<0>(C, C.in[8] + (size_t)j * 1024 * 2048, 2048, 64 * nbk, v0, v1, C.in[9] + j * 2048, cvA + (i * 2) * 8192, cvA + (i * 2 + 1) * 8192, 1, 1024);
            else gemv2_unit<0>(C, C.in[16] + (size_t)j * 1024 * 8192, 8192, 64 * nbk, v0, v1, nullptr, cvA + (i * 2) * 8192, cvA + (i * 2 + 1) * 8192, 2, 0);
        } else {
            const int i = (u - 320) / 88, nbk = (u - 320) % 88;
            const float* v0 = modv + (i * 2 + 0) * 6144 + 3072; const float* v1 = modv + (i * 2 + 1) * 6144 + 3072;
            gemv2_unit<0>(C, C.in[19] + (size_t)i * 1024 * FF2, FF2, 64 * nbk, v0, v1, nullptr, cvF + (i * 2) * FF2, cvF + (i * 2 + 1) * FF2, 1, DFF);
        }
    }
    bf16_t* xs = (bf16_t*)(C.ws + WS_XS); float* stats = (float*)(C.ws + WS_STATS); float* xctx = (float*)(C.ws + WS_XCTX);
    for (int row = C.bid * 8 + C.wave; row < R; row += C.G * 8) {
        const bool lat = row < T; const int s = lat ? 0 : 1;
        const float* src = lat ? C.in[0] + (size_t)row * 1024 : C.in[2] + (size_t)(row - T) * 1024;
        float ss = 0.f;
#pragma unroll
        for (int jj = 0; jj < 4; ++jj) {
            const int k = 4 * C.lane + 256 * jj;
            const f32x4 v = *(const f32x4*)(src + k);
            ss += (v[0] * v[0] + v[1] * v[1]) + (v[2] * v[2] + v[3] * v[3]);
            const f32x4 g = *(const f32x4*)(C.in[6] + k), m = *(const f32x4*)(modv + s * 6144 + 1024 + k);
            u32x2 w; w.x = pk2(v[0] * g[0] * (1.f + m[0]), v[1] * g[1] * (1.f + m[1])); w.y = pk2(v[2] * g[2] * (1.f + m[2]), v[3] * g[3] * (1.f + m[3]));
            *(u32x2*)(xs + (size_t)row * 1024 + k) = w;
        }
#pragma unroll
        for (int off = 1; off < 64; off <<= 1) ss += __shfl_xor(ss, off);
        if (C.lane < 16) stats[(size_t)row * 16 + C.lane] = C.lane == 0 ? ss : 0.f;
    }
    prep_layer(C, 0, 7, 0);
}
__device__ __forceinline__ void phase_final(Ctx& C) {
    const float* stats = (const float*)(C.ws + WS_STATS);
    for (int row = C.bid * 8 + C.wave; row < T; row += C.G * 8) {
        float s = C.lane < 16 ? stats[(size_t)row * 16 + C.lane] : 0.f;
#pragma unroll
        for (int off = 1; off < 64; off <<= 1) s += __shfl_xor(s, off);
        const float r = 1.0f / sqrtf(s * (1.f / 1024.f) + NORM_EPS);
        float* xr = C.out + (size_t)row * 1024;
#pragma unroll
        for (int jj = 0; jj < 4; ++jj) { const int k = 4 * C.lane + 256 * jj; const f32x4 v = *(const f32x4*)(xr + k), g = *(const f32x4*)(C.in[21] + k); *(f32x4*)(xr + k) = v * r * g; }
    }
}

constexpr int NPHASE = 31;
template <int SK  >
__device__ __forceinline__ void run_phase(Ctx& C, int ph) {
    const int i = (ph - 2) / 7, sub = (ph - 2) % 7, j = i >> 1; const bool conv = (i & 1) == 0;
    const bool last = i == DEPTH - 1;
    float* stats = (float*)(C.ws + WS_STATS);
    const bf16_t* xs = (const bf16_t*)(C.ws + WS_XS);
    constexpr int F_MODV = (int)(WS_MODV / 4), F_S1 = (int)(WS_S1 / 4), F_S2 = (int)(WS_S2 / 4), F_CVA = (int)(WS_CVA / 4), F_CVF = (int)(WS_CVF / 4);
    if constexpr (SK == 0 || SK == 1) {
        if constexpr (SK == 0) { EpiGLU E{C.ws, F_CVA + (i * 2) * 8192, 8192, (int)WS_U, 1024, 0, stats}; gemm_both(C, xs, (const bf16_t*)(C.ws + WS_WA), T, 2048, 1024, E, 0, 8); }
        else {
            EpiWin E{C.ws, F_CVA + (i * 2) * 8192, stats};
            const bf16_t* WA = (const bf16_t*)(C.ws + WS_WA);
            gemm_both(C, xs, WA, T, 8192, 1024, E, 0, 0, 0, 8);
            { pg8::Gemm g{xs, WA + (size_t)2048 * 1024, T, 2048, 1024}; pg8::StaticOrder S; S.init(T, 2048, C.G, C.bid); EpiVt EV{C.ws, F_CVA + (i * 2) * 8192};
              pg8::gemm_phase<EpiVt, pg8::StaticOrder, true, true, true>(C.lds, g, S, EV); }
            gemm_both(C, xs, WA, T, 8192, 1024, E, last ? 4 : 0, last ? 16 : 32, 16, 32);
        }
    } else if constexpr (SK == 2) {
        EpiGLU E{C.ws, F_CVF + (i * 2) * FF2, FF2, (int)WS_H, DFF, 1, stats}; gemm_both(C, xs, (const bf16_t*)(C.ws + WS_WF1), last ? T : R, FF2, 1024, E, 0, 0);
        if (!last) { __syncthreads(); relane(C); prep_layer(C, i + 1, 5, C.G == 256 ? 150 : 0); }
    } else {
        const bool f2 = sub == 6;
        const int mgoff = F_MODV + (i * 2) * 6144 + (f2 ? 5120 : 2048);
        const int snoff = f2 ? (last ? -1 : F_S1 + ((i + 1) * 2) * 1024) : F_S2 + (i * 2) * 1024;
        const float* bias = (!f2 && conv) ? C.in[15] + j * 1024 : nullptr;
        const bf16_t* A = (const bf16_t*)(C.ws + (f2 ? WS_H : (conv ? WS_A2 : WS_GF)));
        const bf16_t* Bt = (const bf16_t*)(C.ws + (f2 ? WS_WF2 : WS_WA2));
        const int K = f2 ? DFF : (conv ? 1024 : 2048);
        const bool first = (i == 0 && !f2);
        EpiRes E{C.ws, C.out, first ? C.in[0] : (const float*)C.out, first ? C.in[2] : (const float*)(C.ws + WS_XCTX), bias, mgoff, snoff, stats};
        { pg8::Gemm g{A, Bt, T, 1024, K}; pg8::StaticOrder S; S.init(T, 1024, C.G, C.bid); EpiResBig EB{E};
          pg8::gemm_phase<EpiResBig, pg8::StaticOrder, true, true>(C.lds, g, S, EB); }
        if (!last) { __syncthreads(); relane(C); sgemm_small(C, A, Bt, T, R - T, 1024, K, E, 0, 4); }
    }
}

#define XB_TMO      128
#define XB_XCNT(j)  (256  + 64 * (j))
#define XB_XSUB(j)  (1280 + 64 * (j))
#define XB_XGEN(j)  (2304 + 64 * (j))
#define XB_TOP      3328
#define XB_TOPGEN   3392
#define XCD_BAR_WORDS 3456
#define XB_SPIN_CAP (1u << 20)
__device__ __forceinline__ unsigned xb_ld(unsigned* p)              { return __hip_atomic_load(p, __ATOMIC_RELAXED, __HIP_MEMORY_SCOPE_AGENT); }
__device__ __forceinline__ unsigned xb_add(unsigned* p, unsigned v) { return __hip_atomic_fetch_add(p, v, __ATOMIC_RELAXED, __HIP_MEMORY_SCOPE_AGENT); }
__device__ __forceinline__ unsigned xb_xcc_id() { return (unsigned)__builtin_amdgcn_s_getreg((3 << 11) | 20) & 0xFu; }
#define XB_SPIN(cond, bar) do { unsigned _sp = 0; while (cond) { __builtin_amdgcn_s_sleep(1); \
    if ((++_sp & 255u) == 0u) { if (xb_ld(&(bar)[XB_TMO])) break; if (_sp > XB_SPIN_CAP) { atomicAdd(&(bar)[XB_TMO], 1u); break; } } } } while (0)
struct XcdBarrier { unsigned* bar; unsigned x; volatile LAS unsigned* st; };
__device__ __forceinline__ XcdBarrier xcd_barrier_post(unsigned* bar, volatile LAS unsigned* st) {
    XcdBarrier b; b.bar = bar; b.x = xb_xcc_id(); b.st = st;
    if (threadIdx.x == 0) (void)xb_add(&bar[XB_XCNT(b.x)], 1u);
    return b;
}
__device__ __forceinline__ void xcd_barrier_complete(unsigned* bar, unsigned x, unsigned& nloc, unsigned& nx) {
    const unsigned G = gridDim.x * gridDim.y * gridDim.z;
    unsigned sum, cnt, mine, sp = 0u;
    for (;;) {
        sum = 0u; cnt = 0u; mine = 0u;
#pragma unroll
        for (unsigned j = 0; j < 16; ++j) { const unsigned c = xb_ld(&bar[XB_XCNT(j)]); sum += c; cnt += (c > 0u) ? 1u : 0u; mine = (j == x) ? c : mine; }
        if (sum == G) break;
        __builtin_amdgcn_s_sleep(1);
        if ((++sp & 255u) == 0u) { if (xb_ld(&bar[XB_TMO])) break; if (sp > XB_SPIN_CAP) { atomicAdd(&bar[XB_TMO], 1u); break; } }
    }
    nloc = mine > 0u ? mine : 1u; nx = cnt > 0u ? cnt : 1u;
}
__device__ __forceinline__ void xcd_barrier(const XcdBarrier& b) {
    asm volatile("s_waitcnt vmcnt(0)" ::: "memory");
    __syncthreads();
    if (threadIdx.x == 0) {
        unsigned* bar = b.bar;
        __builtin_amdgcn_s_waitcnt(0);
        unsigned nloc = b.st[0], nx = b.st[1];
        if (nloc == 0u) { xcd_barrier_complete(bar, b.x, nloc, nx); b.st[0] = nloc; b.st[1] = nx; }
        const unsigned old = xb_add(&bar[XB_XSUB(b.x)], 1u);
        const unsigned gen = old / nloc;
        if (old + 1u == (gen + 1u) * nloc) {
            __builtin_amdgcn_fence(__ATOMIC_RELEASE, "agent");
            asm volatile("s_waitcnt vmcnt(0)" ::: "memory");
            const unsigned og = xb_add(&bar[XB_TOP], 1u);
            const unsigned tg = og / nx;
            if (og + 1u == (tg + 1u) * nx) xb_add(&bar[XB_TOPGEN], 1u);
            else XB_SPIN(xb_ld(&bar[XB_TOPGEN]) == tg, bar);
            __builtin_amdgcn_fence(__ATOMIC_ACQUIRE, "agent");
            xb_add(&bar[XB_XGEN(b.x)], 1u);
            asm volatile("s_waitcnt vmcnt(0)" ::: "memory");
        } else {
            XB_SPIN(xb_ld(&bar[XB_XGEN(b.x)]) == gen, bar);
            __builtin_amdgcn_fence(__ATOMIC_ACQUIRE, "agent");
            asm volatile("s_waitcnt vmcnt(0)" ::: "memory");
        }
    }
    __syncthreads();
}
constexpr int MISC_OFF = 131072 + 320;
constexpr int CW_BAR = 4096;

#ifndef PROBE_DUP
#define PROBE_DUP 0
#endif
#if ONE_LAUNCH
template <int PH> __device__ __forceinline__ void phase_body(Ctx& C) {
    constexpr int i = (PH - 2) / 7, sub = (PH - 2) % 7, j = i >> 1; constexpr bool conv = (i & 1) == 0;
    if (PH == 0) phase_p0(C);
    else if (PH == 1) phase_p1(C);
    else if (PH == 30) phase_final(C);
    else if (sub == 1) { if (i > 0) { prep_layer(C, i, 2, 0); __syncthreads(); } if (conv) dwconv_phase(C, j); else ugemm_phase(C, j); }
    else if (sub == 2) prefix_phase(C, j);
    else if (sub == 3) readout_phase(C, j, i == DEPTH - 1);
    else run_phase<(sub == 0 ? (conv ? 0 : 1) : (sub == 5 ? 2 : 3))>(C, PH);
}
template <int PH> __device__ __forceinline__ void one_phase(Ctx& C, const Args& args, const XcdBarrier& bar) {
    constexpr int i = (PH - 2) / 7, sub = (PH - 2) % 7; constexpr bool conv = (i & 1) == 0;
    if (PH >= 2 && PH < 30) { if ((sub == 2 || sub == 3) && conv) return; }
    if (PH > 0) xcd_barrier(bar);
    relane(C);
    phase_body<PH>(C);
    constexpr bool dup = ((PH >= 2 && PH < 30) && (((PROBE_DUP & 1) && (sub == 0 || sub == 5)) || ((PROBE_DUP & 2) && sub == 1 && !conv) || ((PROBE_DUP & 4) && sub == 1 && conv))) || ((PROBE_DUP & 16) && PH < 2);
    if constexpr (dup) { xcd_barrier(bar); phase_body<PH>(C); }
}
template <int... PHS> __device__ __forceinline__ void all_phases(Ctx& C, const Args& args, const XcdBarrier& bar, std::integer_sequence<int, PHS...>) { (one_phase<PHS>(C, args, bar), ...); }
__global__ void __launch_bounds__(512, 2) mega_kernel(Args args) {
    extern __shared__ __attribute__((aligned(16))) unsigned char lds_raw[];
    Ctx C;
    C.lds = (LAS unsigned char*)lds_raw; C.tid = threadIdx.x; C.lane = C.tid & 63; C.wave = __builtin_amdgcn_readfirstlane(C.tid >> 6); C.G = gridDim.x; C.bid = blockIdx.x;
    C.in = args.in; C.out = args.out; C.ws = args.ws;
    volatile LAS unsigned* MISC = (volatile LAS unsigned*)(C.lds + MISC_OFF);
    if (C.tid < 32) MISC[C.tid] = 0u;
    __syncthreads();
    XcdBarrier bar = xcd_barrier_post((unsigned*)(C.ws + WS_CTL) + CW_BAR, MISC + 8);
    all_phases(C, args, bar, std::make_integer_sequence<int, NPHASE>{});
}

#endif
#if !ONE_LAUNCH
template <int KIND>
__global__ void __launch_bounds__(512, 2) phase_kernel(Args args) {
    extern __shared__ __attribute__((aligned(16))) unsigned char lds_raw[];
    Ctx C;
    C.lds = (LAS unsigned char*)lds_raw; C.tid = threadIdx.x; C.lane = C.tid & 63; C.wave = __builtin_amdgcn_readfirstlane(C.tid >> 6); C.G = gridDim.x; C.bid = blockIdx.x;
    C.in = args.in; C.out = args.out; C.ws = args.ws;
    const int ph = args.ph_lo;
    if (KIND == 0) phase_p0(C);
    else if (KIND == 1) phase_p1(C);
    else if (KIND == 30) phase_final(C);
    else {
        const int i = (ph - 2) / 7, j = i >> 1; const bool conv = (i & 1) == 0;
        if (KIND == 2) prefix_phase(C, j);
        else if (KIND == 4) { if (i > 0) { prep_layer(C, i, 2, 0); __syncthreads(); } if (conv) dwconv_phase(C, j); else ugemm_phase(C, j); }
        else if (KIND == 5) readout_phase(C, j, i == DEPTH - 1);
        else if (KIND == 31) run_phase<0>(C, ph);
        else if (KIND == 32) run_phase<1>(C, ph);
        else if (KIND == 33) run_phase<2>(C, ph);
        else run_phase<3>(C, ph);
    }
}

#endif
#ifndef PROBE_RD
#define PROBE_RD 0
#endif
#if PROBE_RD
__global__ void __launch_bounds__(512, 2) probe_read_kernel(Args args) {
    extern __shared__ __attribute__((aligned(16))) unsigned char lds_raw[];
    Ctx C;
    C.lds = (LAS unsigned char*)lds_raw; C.tid = threadIdx.x; C.lane = C.tid & 63; C.wave = __builtin_amdgcn_readfirstlane(C.tid >> 6); C.G = gridDim.x; C.bid = blockIdx.x;
    C.in = args.in; C.out = args.out; C.ws = args.ws;
    readout_phase<PROBE_RD>(C, 1, true);
}
#endif
extern "C" void kernel_launch(void* const* d_in, const int* in_sizes, int n_in, void* d_out, int out_size, void* d_ws, size_t ws_size, hipStream_t stream) {
    static int grid = 0;
    if (grid == 0) {
        if (n_in != 22 || out_size != T * D || ws_size < WS_END + (PROBE_RD ? 20 * MiB : 0)) { fprintf(stderr, "kernel_launch: unexpected problem (n_in %d out %d ws %zu, need %zu)\n", n_in, out_size, ws_size, (size_t)WS_END); grid = -1; return; }
        int dev = 0, cus = 0;
        if (hipGetDevice(&dev) != hipSuccess || hipDeviceGetAttribute(&cus, hipDeviceAttributeMultiprocessorCount, dev) != hipSuccess) { grid = -1; return; }
        bool ok = true;
#if !ONE_LAUNCH
        ok &= hipFuncSetAttribute((const void*)phase_kernel<0>, hipFuncAttributeMaxDynamicSharedMemorySize, LDS_BYTES) == hipSuccess;
        ok &= hipFuncSetAttribute((const void*)phase_kernel<1>, hipFuncAttributeMaxDynamicSharedMemorySize, LDS_BYTES) == hipSuccess;
        ok &= hipFuncSetAttribute((const void*)phase_kernel<2>, hipFuncAttributeMaxDynamicSharedMemorySize, LDS_BYTES) == hipSuccess;
        ok &= hipFuncSetAttribute((const void*)phase_kernel<31>, hipFuncAttributeMaxDynamicSharedMemorySize, LDS_BYTES) == hipSuccess;
        ok &= hipFuncSetAttribute((const void*)phase_kernel<32>, hipFuncAttributeMaxDynamicSharedMemorySize, LDS_BYTES) == hipSuccess;
        ok &= hipFuncSetAttribute((const void*)phase_kernel<33>, hipFuncAttributeMaxDynamicSharedMemorySize, LDS_BYTES) == hipSuccess;
        ok &= hipFuncSetAttribute((const void*)phase_kernel<34>, hipFuncAttributeMaxDynamicSharedMemorySize, LDS_BYTES) == hipSuccess;
        ok &= hipFuncSetAttribute((const void*)phase_kernel<4>, hipFuncAttributeMaxDynamicSharedMemorySize, LDS_BYTES) == hipSuccess;
        ok &= hipFuncSetAttribute((const void*)phase_kernel<5>, hipFuncAttributeMaxDynamicSharedMemorySize, LDS_BYTES) == hipSuccess;
        ok &= hipFuncSetAttribute((const void*)phase_kernel<30>, hipFuncAttributeMaxDynamicSharedMemorySize, LDS_BYTES) == hipSuccess;
#endif
#if ONE_LAUNCH
        ok &= hipFuncSetAttribute((const void*)mega_kernel, hipFuncAttributeMaxDynamicSharedMemorySize, LDS_BYTES) == hipSuccess;
#endif
        if (!ok) { fprintf(stderr, "kernel_launch: hipFuncSetAttribute failed\n"); grid = -1; return; }
        grid = cus > 0 ? cus : 256;
    }
    if (grid < 0) return;
    Args a{};
    for (int i = 0; i < 22; ++i) a.in[i] = (const float*)d_in[i];
    a.out = (float*)d_out; a.ws = (unsigned char*)d_ws;
#if ONE_LAUNCH
    if (hipMemsetAsync((char*)d_ws + WS_CTL, 0, 65536, stream) != hipSuccess) { fprintf(stderr, "kernel_launch: memset failed\n"); return; }
    a.ph_lo = 0; a.ph_hi = NPHASE;
    hipLaunchKernelGGL(mega_kernel, dim3(grid), dim3(512), LDS_BYTES, stream, a);
    return;
#endif
#if !ONE_LAUNCH
    for (int ph = 0; ph < NPHASE; ++ph) {
        const int i = (ph - 2) / 7, sub = (ph - 2) % 7;
        if (ph >= 2 && ph < 30) { if ((sub == 2 || sub == 3) && (i & 1) == 0) continue; }
        a.ph_lo = ph; a.ph_hi = ph + 1;
        const dim3 g(grid), b(512);
        if (ph == 0) hipLaunchKernelGGL(phase_kernel<0>, g, b, LDS_BYTES, stream, a);
        else if (ph == 1) hipLaunchKernelGGL(phase_kernel<1>, g, b, LDS_BYTES, stream, a);
        else if (ph == 30) hipLaunchKernelGGL(phase_kernel<30>, g, b, LDS_BYTES, stream, a);
        else if (sub == 2) hipLaunchKernelGGL(phase_kernel<2>, g, b, LDS_BYTES, stream, a);
        else if (sub == 1) hipLaunchKernelGGL(phase_kernel<4>, g, b, LDS_BYTES, stream, a);
        else if (sub == 3) hipLaunchKernelGGL(phase_kernel<5>, g, b, LDS_BYTES, stream, a);
        else { const bool cv_ = (i & 1) == 0; if (sub == 0) { if (cv_) hipLaunchKernelGGL(phase_kernel<31>, g, b, LDS_BYTES, stream, a); else hipLaunchKernelGGL(phase_kernel<32>, g, b, LDS_BYTES, stream, a); }
               else if (sub == 5) hipLaunchKernelGGL(phase_kernel<33>, g, b, LDS_BYTES, stream, a); else hipLaunchKernelGGL(phase_kernel<34>, g, b, LDS_BYTES, stream, a); }
#ifdef PROBE_G
        if (ph == 30) { Args a2 = a; a2.ph_lo = PROBE_G; a2.ph_hi = PROBE_G + 1; const int i2 = (PROBE_G - 2) / 7, s2 = (PROBE_G - 2) % 7;
            if (s2 == 0 && (i2 & 1) == 0) hipLaunchKernelGGL(phase_kernel<31>, g, b, LDS_BYTES, stream, a2); else if (s2 == 0) hipLaunchKernelGGL(phase_kernel<32>, g, b, LDS_BYTES, stream, a2); else hipLaunchKernelGGL(phase_kernel<33>, g, b, LDS_BYTES, stream, a2); }
#endif
#if PROBE_RD
        if (ph == 30) { hipFuncSetAttribute((const void*)probe_read_kernel, hipFuncAttributeMaxDynamicSharedMemorySize, LDS_BYTES); hipLaunchKernelGGL(probe_read_kernel, g, b, LDS_BYTES, stream, a); }
#endif
        {   const bool conv = (i & 1) == 0;
            const bool dup = ((ph >= 2 && ph < 30) && (((PROBE_DUP & 32) && sub == 0 && conv) || ((PROBE_DUP & 64) && sub == 0 && !conv) || ((PROBE_DUP & 128) && sub == 5) || ((PROBE_DUP & 1) && (sub == 0 || sub == 5)) || ((PROBE_DUP & 2) && sub == 1 && !conv) || ((PROBE_DUP & 4) && sub == 1 && conv))) || ((PROBE_DUP & 16) && ph < 2);
            if (dup) {
                if (ph == 0) hipLaunchKernelGGL(phase_kernel<0>, g, b, LDS_BYTES, stream, a);
                else if (ph == 1) hipLaunchKernelGGL(phase_kernel<1>, g, b, LDS_BYTES, stream, a);
                else if (sub == 2) hipLaunchKernelGGL(phase_kernel<2>, g, b, LDS_BYTES, stream, a);
                else if (sub == 1) hipLaunchKernelGGL(phase_kernel<4>, g, b, LDS_BYTES, stream, a);
                else if (sub == 0 && conv) hipLaunchKernelGGL(phase_kernel<31>, g, b, LDS_BYTES, stream, a);
                else if (sub == 0) hipLaunchKernelGGL(phase_kernel<32>, g, b, LDS_BYTES, stream, a);
                else hipLaunchKernelGGL(phase_kernel<33>, g, b, LDS_BYTES, stream, a);
            } }
    }
#endif
}
```

```cpp
#include <hip/hip_runtime.h>
#include <cstdio>
#include <cstdint>
#include <utility>

#ifndef ONE_LAUNCH
#define ONE_LAUNCH 1
#endif

typedef unsigned short bf16_t;
typedef short bf16x8 __attribute__((ext_vector_type(8)));
typedef float f32x4 __attribute__((ext_vector_type(4)));
typedef float f32x2 __attribute__((ext_vector_type(2)));
typedef unsigned u32x2 __attribute__((ext_vector_type(2)));
typedef unsigned u32x4 __attribute__((ext_vector_type(4)));
typedef __bf16 bf16x2_t __attribute__((ext_vector_type(2)));
typedef short s16x4 __attribute__((ext_vector_type(4)));
#define LAS __attribute__((address_space(3)))

constexpr int D = 1024, T = 16384, TC = 256, R = T + TC, NH = 4, DK = 256, DV = 512, QKW = 1024, VW = 2048, INW = 8192, DFF = 2816, FF2 = 5632, CK = 31, DEPTH = 4;
constexpr int NSLOT = 33;
constexpr float NORM_EPS = 1e-6f, LN_EPS = 1e-5f;

constexpr size_t MiB = 1u << 20, KiB = 1u << 10;
constexpr size_t WS_CTL = 0, CTL_ZERO_BYTES = 1 * MiB;
constexpr size_t WS_MODV = 1 * MiB;
constexpr size_t WS_S1 = 1 * MiB + 256 * KiB;
constexpr size_t WS_S2 = 1 * MiB + 320 * KiB;
constexpr size_t WS_CVA = 1 * MiB + 384 * KiB;
constexpr size_t WS_CVF = 1 * MiB + 640 * KiB;
constexpr size_t WS_TABC = 1 * MiB + 832 * KiB;
constexpr size_t WS_TABS = 1 * MiB + 912 * KiB;
constexpr size_t WS_STATS = 2 * MiB;
constexpr size_t WS_XCTX = 4 * MiB;
constexpr size_t WS_WA = 8 * MiB;
constexpr size_t WS_WA2 = 24 * MiB;
constexpr size_t WS_WF1 = 28 * MiB;
constexpr size_t WS_WF2 = 40 * MiB;
constexpr size_t WS_XS = 48 * MiB;
constexpr size_t WS_SCP = 48 * MiB;
constexpr size_t WS_BIG = 114 * MiB;
constexpr size_t WS_Q = WS_BIG, WS_K = WS_BIG + 33 * MiB, WS_VT = WS_BIG + 66 * MiB, WS_GF = WS_BIG + 131 * MiB, WS_GB = WS_BIG + 196 * MiB;
constexpr size_t WS_U = WS_BIG, WS_A2 = WS_BIG + 33 * MiB, WS_H = WS_BIG;
constexpr size_t WS_END = WS_BIG + 261 * MiB;
static_assert((size_t)R * 1024 * 2 <= 33 * MiB && (size_t)R * 2048 * 2 <= 65 * MiB && (size_t)R * DFF * 2 <= 131 * MiB, "map");
static_assert((size_t)NSLOT * 8 * 512 * 256 * 2 <= 66 * MiB, "scp");

constexpr int LDS_BYTES = 147456;

__device__ __forceinline__ unsigned pk2(float lo, float hi) { f32x2 v = {lo, hi}; bf16x2_t b = __builtin_convertvector(v, bf16x2_t); return __builtin_bit_cast(unsigned, b); }
__device__ __forceinline__ float bflo(unsigned u) { return __uint_as_float(u << 16); }
__device__ __forceinline__ float bfhi(unsigned u) { return __uint_as_float(u & 0xffff0000u); }
__device__ __forceinline__ float sigmf(float x) { return __builtin_amdgcn_rcpf(1.f + __builtin_amdgcn_exp2f(-1.4426950408889634f * x)); }
__device__ __forceinline__ float siluf(float x) { return x * sigmf(x); }
__device__ __forceinline__ float wave_sum63(float v) {
    v += __builtin_bit_cast(float, __builtin_amdgcn_update_dpp(0, __builtin_bit_cast(int, v), 0xB1, 0xF, 0xF, false));
    v += __builtin_bit_cast(float, __builtin_amdgcn_update_dpp(0, __builtin_bit_cast(int, v), 0x4E, 0xF, 0xF, false));
    v += __builtin_bit_cast(float, __builtin_amdgcn_update_dpp(0, __builtin_bit_cast(int, v), 0x141, 0xF, 0xF, false));
    v += __builtin_bit_cast(float, __builtin_amdgcn_update_dpp(0, __builtin_bit_cast(int, v), 0x140, 0xF, 0xF, false));
    v += __builtin_bit_cast(float, __builtin_amdgcn_update_dpp(0, __builtin_bit_cast(int, v), 0x142, 0xA, 0xF, false));
    v += __builtin_bit_cast(float, __builtin_amdgcn_update_dpp(0, __builtin_bit_cast(int, v), 0x143, 0xC, 0xF, false));
    return v;
}
__device__ __forceinline__ int perm_glu(int n, int H) { const int g = n >= H ? 16 : 0, oc = n >= H ? n - H : n; return 256 * (oc >> 7) + 128 * ((oc >> 2) & 1) + 32 * ((oc >> 5) & 3) + 4 * ((oc >> 3) & 3) + (oc & 3) + g; }
__device__ __forceinline__ int perm_win(int n) {
    if (n >= 4 * QKW) { const int c = n & 31; return (n & ~31) + 16 * ((c >> 2) & 1) + 4 * (c >> 3) + (c & 3); }
    if (n >= 2 * QKW) return n;
    const int part = n >> 10, hn = n & 1023, h = hn >> 8, d = hn & 255, quarter = d >> 6, idx = d & 63;
    const int Gp = (quarter >> 1) * 4 + (idx >> 4), i = (quarter & 1) * 16 + (idx & 15);
    return part * 1024 + h * 256 + 32 * Gp + i;
}
__device__ __forceinline__ int perm_any(int mode, int n, int H) { return mode == 0 ? n : (mode == 1 ? perm_glu(n, H) : perm_win(n)); }

struct Args { const float* in[22]; float* out; unsigned char* ws; int ph_lo, ph_hi; };

struct Ctx {
    LAS unsigned char* lds;
    int tid, lane, wave, G, bid;
    const float* const* in; float* out; unsigned char* ws;
};

__device__ __forceinline__ void relane(Ctx& C) {
    int wv = C.wave; asm volatile("" : "+s"(wv)); int ln = (int)__builtin_amdgcn_mbcnt_hi(~0u, __builtin_amdgcn_mbcnt_lo(~0u, 0u)); asm volatile("" : "+v"(ln));
    C.wave = wv; C.lane = ln; C.tid = wv * 64 + ln;
}
template <int VSILU>
__device__ __forceinline__ void gemv2_unit(Ctx& C, const float* W, int N, int n0, const float* v0, const float* v1, const float* bias, float* o0, float* o1, int pmode, int H) {
    LAS float* red = (LAS float*)C.lds;
    const int c4 = C.tid & 15, ks = C.tid >> 4;
    f32x4 a0 = {0.f, 0.f, 0.f, 0.f}, a1 = {0.f, 0.f, 0.f, 0.f};
#pragma unroll 8
    for (int i = 0; i < 32; ++i) {
        const int k = ks * 32 + i;
        const f32x4 w = *(const f32x4*)(W + (size_t)k * N + n0 + 4 * c4);
        float x0 = v0[k], x1 = v1[k];
        if (VSILU) { x0 = siluf(x0); x1 = siluf(x1); }
        a0 += w * x0; a1 += w * x1;
    }
#pragma unroll
    for (int e = 0; e < 4; ++e) { red[(ks * 2 + 0) * 64 + 4 * c4 + e] = a0[e]; red[(ks * 2 + 1) * 64 + 4 * c4 + e] = a1[e]; }
    __syncthreads();
    if (C.tid < 128) {
        const int s = C.tid >> 6, col = C.tid & 63; float sum = 0.f;
#pragma unroll 8
        for (int k2 = 0; k2 < 32; ++k2) sum += red[(k2 * 2 + s) * 64 + col];
        const int n = n0 + col; if (bias) sum += bias[n];
        (s ? o1 : o0)[perm_any(pmode, n, H)] = sum;
    }
    __syncthreads();
}

struct PrepItem { const float* W; bf16_t* WT; int K, N, pmode, H, k0, n0; };
__device__ __forceinline__ bool prep_decode(Ctx& C, int i, int part, int it, PrepItem& P) {
    const int j = i >> 1; const bool conv = (i & 1) == 0;
    const int I_A = (part & 1) ? (conv ? 16 * 64 : 16 * 256) : 0, I_A2 = (part & 4) ? (conv ? 16 * 32 : 32 * 32) : 0, I_F1 = (part & 2) ? 16 * 176 : 0, I_F2 = (part & 2) ? 44 * 32 : 0;
    if (it >= I_A + I_A2 + I_F1 + I_F2) return false;
    int r = it;
    if (r < I_A) { if (conv) { P.W = C.in[8] + (size_t)j * 1024 * 2048; P.K = 1024; P.N = 2048; P.pmode = 1; P.H = 1024; } else { P.W = C.in[16] + (size_t)j * 1024 * 8192; P.K = 1024; P.N = 8192; P.pmode = 2; P.H = 0; }
                   P.WT = (bf16_t*)(C.ws + WS_WA); }
    else if ((r -= I_A) < I_A2) { if (conv) { P.W = C.in[14] + (size_t)j * 1024 * 1024; P.K = 1024; } else { P.W = C.in[18] + (size_t)j * 2048 * 1024; P.K = 2048; }
                   P.N = 1024; P.pmode = 0; P.H = 0; P.WT = (bf16_t*)(C.ws + WS_WA2); }
    else if ((r -= I_A2) < I_F1) { P.W = C.in[19] + (size_t)i * 1024 * FF2; P.K = 1024; P.N = FF2; P.pmode = 1; P.H = DFF; P.WT = (bf16_t*)(C.ws + WS_WF1); }
    else { r -= I_F1; P.W = C.in[20] + (size_t)i * DFF * 1024; P.K = DFF; P.N = 1024; P.pmode = 0; P.H = 0; P.WT = (bf16_t*)(C.ws + WS_WF2); }
    const int nblk = P.N / 32; P.k0 = 64 * (r / nblk); P.n0 = 32 * (r % nblk);
    return true;
}
__device__ __forceinline__ void prep_layer(Ctx& C, int i, int part, int cu_lo) {
    if (C.bid < cu_lo) return;
    LAS float* scr = (LAS float*)(C.lds + C.wave * 16384);
    const int gw = (C.bid - cu_lo) * 8 + C.wave, NGW = (C.G - cu_lo) * 8, lane = C.lane;
    PrepItem P, Pn; f32x4 v[8], vn[8];
    bool have = prep_decode(C, i, part, gw, P);
    if (have) {
#pragma unroll
        for (int q = 0; q < 8; ++q) v[q] = *(const f32x4*)(P.W + (size_t)(P.k0 + 8 * q + (lane >> 3)) * P.N + P.n0 + 4 * (lane & 7));
    }
    for (int it = gw; have; it += NGW) {
        const bool havn = prep_decode(C, i, part, it + NGW, Pn);
        if (havn) {
#pragma unroll
            for (int q = 0; q < 8; ++q) vn[q] = *(const f32x4*)(Pn.W + (size_t)(Pn.k0 + 8 * q + (lane >> 3)) * Pn.N + Pn.n0 + 4 * (lane & 7));
        }
#pragma unroll
        for (int q = 0; q < 8; ++q) { LAS float* d = scr + (8 * q + (lane >> 3)) * 33 + 4 * (lane & 7); d[0] = v[q][0]; d[1] = v[q][1]; d[2] = v[q][2]; d[3] = v[q][3]; }
        asm volatile("s_waitcnt lgkmcnt(0)" ::: "memory");
        const int c = lane & 7;
#pragma unroll
        for (int jj = 0; jj < 4; ++jj) { const int n = (lane >> 3) + 8 * jj; const LAS float* sp = scr + (8 * c) * 33 + n;
            u32x4 o; o.x = pk2(sp[0 * 33], sp[1 * 33]); o.y = pk2(sp[2 * 33], sp[3 * 33]); o.z = pk2(sp[4 * 33], sp[5 * 33]); o.w = pk2(sp[6 * 33], sp[7 * 33]);
            *(u32x4*)(P.WT + (size_t)perm_any(P.pmode, P.n0 + n, P.H) * P.K + P.k0 + 8 * c) = o; }
        asm volatile("s_waitcnt lgkmcnt(0)" ::: "memory");
        P = Pn; have = havn;
#pragma unroll
        for (int q = 0; q < 8; ++q) v[q] = vn[q];
    }
}

__device__ __forceinline__ float row_rs(const float* stats, int row, int fq) {
    const f32x4 p = *(const f32x4*)(stats + (size_t)row * 16 + 4 * fq);
    float s = (p[0] + p[1]) + (p[2] + p[3]);
    s += __shfl_xor(s, 16); s += __shfl_xor(s, 32);
    return 1.0f / sqrtf(s * (1.0f / 1024.0f) + NORM_EPS);
}
struct EpiGLU {
    static constexpr bool STATS = false, NEEDRS = true, PAIR2 = true;
    unsigned char* ws; int cvoff  , cvstride  , outoff  , ldo, act;
    float* stats;
    __device__ __forceinline__ float row_begin(int row, int fq) const { return row_rs((const float*)(ws + WS_STATS), row, fq); }
    __device__ __forceinline__ float item(int row, int colp, f32x4 v0, f32x4 v1, float rs) const {
        const float* cv = (const float*)ws + cvoff + (row < T ? 0 : cvstride);
        const f32x4 ca = *(const f32x4*)(cv + colp), cg = *(const f32x4*)(cv + colp + 16);
        float o[4];
#pragma unroll
        for (int e = 0; e < 4; ++e) { const float a = rs * v0[e] + ca[e], g = rs * v1[e] + cg[e]; o[e] = act == 0 ? a * sigmf(g) : siluf(a) * g; }
        const int oc = 128 * (colp >> 8) + 32 * ((colp >> 5) & 3) + 8 * ((colp >> 2) & 3) + 4 * ((colp >> 7) & 1);
        u32x2 w; w.x = pk2(o[0], o[1]); w.y = pk2(o[2], o[3]);
        *(u32x2*)((bf16_t*)(ws + outoff) + (size_t)row * ldo + oc) = w;
        return 0.f;
    }
    __device__ __forceinline__ void item2(int row, int colp, f32x4 a0, f32x4 g0, f32x4 a1, f32x4 g1, float rs) const {
        const float* cv = (const float*)ws + cvoff + (row < T ? 0 : cvstride);
        const f32x4 ca0 = *(const f32x4*)(cv + colp), cg0 = *(const f32x4*)(cv + colp + 16), ca1 = *(const f32x4*)(cv + colp + 128), cg1 = *(const f32x4*)(cv + colp + 144);
        float o[8];
#pragma unroll
        for (int e = 0; e < 4; ++e) { const float a = rs * a0[e] + ca0[e], g = rs * g0[e] + cg0[e]; o[e] = act == 0 ? a * sigmf(g) : siluf(a) * g;
                                      const float b = rs * a1[e] + ca1[e], h = rs * g1[e] + cg1[e]; o[4 + e] = act == 0 ? b * sigmf(h) : siluf(b) * h; }
        const int oc = 128 * (colp >> 8) + 32 * ((colp >> 5) & 3) + 8 * ((colp >> 2) & 3);
        u32x4 w; w.x = pk2(o[0], o[1]); w.y = pk2(o[2], o[3]); w.z = pk2(o[4], o[5]); w.w = pk2(o[6], o[7]);
        *(u32x4*)((bf16_t*)(ws + outoff) + (size_t)row * ldo + oc) = w;
    }
};
struct EpiRes {
    static constexpr bool STATS = true, NEEDRS = false, PAIR2 = false;
    unsigned char* ws; float* xl; const float* xin  ; const float* cin  ; const float* bias;
    int mgoff  , snoff  ;
    float* stats;
    __device__ __forceinline__ float row_begin(int, int) const { return 1.f; }
    __device__ __forceinline__ float item(int row, int colp, f32x4 v0, f32x4 v1, float) const {
        const bool lat = row < T;
        float* xr = lat ? xl + (size_t)row * 1024 : (float*)(ws + WS_XCTX) + (size_t)(row - T) * 1024;
        const float* xi = lat ? xin + (size_t)row * 1024 : cin + (size_t)(row - T) * 1024;
        const float* mg = (const float*)ws + mgoff + (lat ? 0 : 6144); const float* sn = (const float*)ws + snoff + (lat ? 0 : 1024);
        bf16_t* xs = (bf16_t*)(ws + WS_XS);
        float ss = 0.f;
#pragma unroll
        for (int hlf = 0; hlf < 2; ++hlf) {
            const int c = colp + 16 * hlf; const f32x4 v = hlf ? v1 : v0;
            const f32x4 xo = *(const f32x4*)(xi + c), m4 = *(const f32x4*)(mg + c);
            f32x4 b4 = {0.f, 0.f, 0.f, 0.f}; if (bias) b4 = *(const f32x4*)(bias + c);
            const f32x4 xn = xo + m4 * (v + b4);
            *(f32x4*)(xr + c) = xn;
            ss += (xn[0] * xn[0] + xn[1] * xn[1]) + (xn[2] * xn[2] + xn[3] * xn[3]);
            if (snoff >= 0) { const f32x4 s4 = *(const f32x4*)(sn + c); u32x2 w; w.x = pk2(xn[0] * s4[0], xn[1] * s4[1]); w.y = pk2(xn[2] * s4[2], xn[3] * s4[3]);
                *(u32x2*)(xs + (size_t)row * 1024 + c) = w; }
        }
        return ss;
    }
};
struct EpiWin {
    static constexpr bool STATS = false, NEEDRS = true, PAIR2 = false;
    unsigned char* ws; int cvoff;
    float* stats;
    __device__ __forceinline__ float row_begin(int row, int fq) const { return row_rs((const float*)(ws + WS_STATS), row, fq); }
    __device__ __forceinline__ float item(int row, int colp, f32x4 v0, f32x4 v1, float rs) const {
        const float* cv = (const float*)ws + cvoff + (row < T ? 0 : 8192);
        const f32x4 c0 = *(const f32x4*)(cv + colp), c1 = *(const f32x4*)(cv + colp + 16);
        f32x4 a = v0 * rs + c0, b = v1 * rs + c1;
        if (colp < 2048) {
            if (row < T) {
                const int Gp = (colp >> 5) & 7, idx0 = 16 * (Gp & 3) + (colp & 15);
                const int ti = (Gp >> 2) ? 256 + (row & 63) : (row >> 6);
                const f32x4 cs = *(const f32x4*)((const float*)(ws + WS_TABC) + ti * 64 + idx0), sn = *(const f32x4*)((const float*)(ws + WS_TABS) + ti * 64 + idx0);
                const f32x4 o1 = a * cs - b * sn, o2 = b * cs + a * sn; a = o1; b = o2;
            }
            bf16_t* dst = (bf16_t*)(ws + WS_Q);
            if (colp >= 1024) { dst = (bf16_t*)(ws + WS_K); a = a * 0.0625f; b = b * 0.0625f; }
            const int cp = colp & 1023, c = (cp & ~31) + 2 * (cp & 31);
            u32x4 w; w.x = pk2(a[0], a[1]); w.y = pk2(a[2], a[3]); w.z = pk2(b[0], b[1]); w.w = pk2(b[2], b[3]); *(u32x4*)(dst + (size_t)row * 1024 + c) = w;
        } else if (colp < 4096) {
            const int c = colp - 2048;
            bf16_t* vt = (bf16_t*)(ws + WS_VT);
#pragma unroll
            for (int e = 0; e < 4; ++e) { vt[(size_t)(c + e) * R + row] = (bf16_t)(pk2(a[e], 0.f) & 0xffffu); vt[(size_t)(c + 16 + e) * R + row] = (bf16_t)(pk2(b[e], 0.f) & 0xffffu); }
        } else {
            bf16_t* dst = (bf16_t*)(ws + (colp < 6144 ? WS_GF : WS_GB)); const int cp = (colp - 4096) & 2047, c = (cp & ~31) + 2 * (cp & 31);
            u32x4 w; w.x = pk2(a[0], a[1]); w.y = pk2(a[2], a[3]); w.z = pk2(b[0], b[1]); w.w = pk2(b[2], b[3]); *(u32x4*)(dst + (size_t)row * 2048 + c) = w;
        }
        return 0.f;
    }
};

namespace pg8 {
#define PG8_LAS __attribute__((address_space(3)))
typedef unsigned short bf16_t;
typedef short bf16x8 __attribute__((ext_vector_type(8)));
typedef float f32x4 __attribute__((ext_vector_type(4)));
typedef unsigned u32x4 __attribute__((ext_vector_type(4)));
constexpr int BM = 256, BK = 64, HALF = 128, HTB = HALF * BK * 2  , STAGE_BYTES = 8 * HTB, NXCD = 8, WGM = 8;

__host__ __device__ __forceinline__ int lds_byte(int r, int c) { const int st = (r >> 4) * 2 + (c >> 5), rr = r & 15, cc = c & 31, ob = rr * 64 + cc * 2; return st * 1024 + (ob ^ (((ob >> 9) & 1) << 5)); }
__host__ __device__ __forceinline__ void stage_rc(int b, int& R, int& C) { const int st = b / 1024, sb = b % 1024, swz = sb ^ (((sb >> 9) & 1) << 5); R = (st >> 1) * 16 + swz / 64; C = (st & 1) * 32 + (swz % 64) / 2; }
__host__ __device__ __forceinline__ int perm32(int rho) { const int n = rho >> 4, i = rho & 15; return 8 * (i >> 2) + 4 * n + (i & 3); }

struct Unit { int pm, pn; };
struct Gemm { const bf16_t* A; const bf16_t* Bt; int M, N, K; };

struct StaticOrder {
    int nM, nN, nwg, G, c;
    __host__ __device__ void init(int M, int N, int G_, int c_) { nM = M / BM; nN = N / BM; nwg = nM * nN; G = G_; c = c_; }
    __host__ __device__ bool next(int i, Unit& u) const {
        const long L = (long)i * G + c; if (L >= nwg) return false;
        int wgid = (int)L; { const int q = nwg / NXCD, r = nwg % NXCD, xcd = wgid % NXCD, off = wgid / NXCD; wgid = (xcd < r ? xcd * (q + 1) : r * (q + 1) + (xcd - r) * q) + off; }
        const int nig = WGM * nN, gid = wgid / nig, fm = gid * WGM, gsz = (nM - fm) < WGM ? (nM - fm) : WGM;
        u.pm = fm + ((wgid % nig) % gsz); u.pn = (wgid % nig) / gsz; return true;
    }
    __device__ __forceinline__ void a_ready(const Unit&) const {}
    __device__ __forceinline__ void done(const Unit&) const {}
};

template <class Epi, class Sched, bool ALIGN_EPI = false, bool SP2 = false, bool SWAPMMA = false>
__device__ __forceinline__ void gemm_phase(PG8_LAS unsigned char* lds, const Gemm g, const Sched& S, const Epi& E) {
    int tid = threadIdx.x; asm volatile("" : "+v"(tid));
    const int wid = __builtin_amdgcn_readfirstlane(tid >> 6), lane = tid & 63, wr = wid >> 2, wc = wid & 3, fr = lane & 15, fq = lane >> 4;
    const int K = g.K, nt = K / BK;
    unsigned voffA[2], voffB[2];
#pragma unroll
    for (int i = 0; i < 2; ++i) { int R, C; stage_rc(tid * 16 + i * 8192, R, C); const int Rb = Epi::PERM ? ((R & ~31) + perm32(R & 31)) : R;
        voffA[i] = (unsigned)(R * K + C) * 2u; voffB[i] = (unsigned)(Rb * K + C) * 2u; }
    const size_t kstep = (size_t)(BK * 2);
    const size_t hstep = (size_t)HALF * K * 2;
    const size_t tstep = 2 * hstep;
    const unsigned ldsw = (unsigned)wid * 1024u;
    const int aoff = lds_byte(wr * 64 + fr, fq * 8), boff = lds_byte(wc * 32 + fr, fq * 8);
#define PG8_SA(b, h) (((b) * 2 + (h)) * HTB)
#define PG8_SB(b, h) ((4 + (b) * 2 + (h)) * HTB)
#define PG8_STAGE(bufoff, gbase, voff) do { _Pragma("unroll") for (int _i = 0; _i < 2; ++_i) \
        __builtin_amdgcn_global_load_lds((const unsigned*)((const char*)(gbase) + (voff)[_i]), (PG8_LAS unsigned*)(lds + (bufoff) + ldsw + _i * 8192), 16, 0, 0); } while (0)
#define PG8_LDA(dst, b, h) do { _Pragma("unroll") for (int m = 0; m < 4; ++m) _Pragma("unroll") for (int k = 0; k < 2; ++k) dst[m][k] = *(const PG8_LAS bf16x8*)(lds + PG8_SA(b, h) + aoff + m * 2048 + k * 1024); } while (0)
#define PG8_LDB(dst, b, h) do { _Pragma("unroll") for (int n = 0; n < 2; ++n) _Pragma("unroll") for (int k = 0; k < 2; ++k) dst[n][k] = *(const PG8_LAS bf16x8*)(lds + PG8_SB(b, h) + boff + n * 2048 + k * 1024); } while (0)
#define PG8_MMA(ai, bj, At, Bt) do { __builtin_amdgcn_s_setprio(1); _Pragma("unroll") for (int m = 0; m < 4; ++m) _Pragma("unroll") for (int n = 0; n < 2; ++n) _Pragma("unroll") for (int k = 0; k < 2; ++k) \
        acc[ai][bj][m][n] = SWAPMMA ? __builtin_amdgcn_mfma_f32_16x16x32_bf16(At[m][k], Bt[n][k], acc[ai][bj][m][n], 0, 0, 0) : __builtin_amdgcn_mfma_f32_16x16x32_bf16(Bt[n][k], At[m][k], acc[ai][bj][m][n], 0, 0, 0); __builtin_amdgcn_s_setprio(0); } while (0)
#define PG8_WAIT_V(n) asm volatile("s_waitcnt vmcnt(" #n ")" ::: "memory")
#define PG8_WAIT_L(n) asm volatile("s_waitcnt lgkmcnt(" #n ")" ::: "memory")
#define PG8_BAR __builtin_amdgcn_s_barrier()
#define PG8_SCHED __builtin_amdgcn_sched_barrier(0)
    Unit cur, nxt; int ui = 0;
    if (!S.next(0, cur)) return;
    f32x4 acc[2][2][4][2];
#pragma unroll
    for (int a = 0; a < 2; ++a)
#pragma unroll
        for (int b = 0; b < 2; ++b)
#pragma unroll
            for (int m = 0; m < 4; ++m)
#pragma unroll
                for (int n = 0; n < 2; ++n) acc[a][b][m][n] = (f32x4){0.f, 0.f, 0.f, 0.f};
    bf16x8 At[4][2], B0[2][2], B1[2][2];
    const char* cA = (const char*)g.A + (size_t)cur.pm * tstep; const char* cB = (const char*)g.Bt + (size_t)cur.pn * tstep;
    S.a_ready(cur);
    if constexpr (SP2) {
        PG8_STAGE(PG8_SB(0, 0), cB, voffB); PG8_STAGE(PG8_SB(0, 1), cB + hstep, voffB); PG8_STAGE(PG8_SA(0, 0), cA, voffA); PG8_STAGE(PG8_SA(0, 1), cA + hstep, voffA);
        if (wr == 1) PG8_BAR;
        PG8_WAIT_V(2); PG8_BAR;
        PG8_STAGE(PG8_SB(1, 0), cB + kstep, voffB); PG8_STAGE(PG8_SA(1, 0), cA + kstep, voffA); PG8_STAGE(PG8_SB(1, 1), cB + hstep + kstep, voffB);
        PG8_WAIT_V(6); PG8_BAR;
    } else {
        PG8_STAGE(PG8_SB(0, 0), cB, voffB); PG8_STAGE(PG8_SA(0, 0), cA, voffA); PG8_STAGE(PG8_SB(0, 1), cB + hstep, voffB); PG8_STAGE(PG8_SA(0, 1), cA + hstep, voffA);
        if (wr == 1) PG8_BAR;
        PG8_WAIT_V(4); PG8_BAR;
        PG8_STAGE(PG8_SB(1, 0), cB + kstep, voffB); PG8_STAGE(PG8_SA(1, 0), cA + kstep, voffA); PG8_STAGE(PG8_SB(1, 1), cB + hstep + kstep, voffB);
        PG8_WAIT_V(6); PG8_BAR;
    }
    for (;;) {
        const bool has_next = S.next(ui + 1, nxt);
        const char* nA = has_next ? (const char*)g.A + (size_t)nxt.pm * tstep : cA; const char* nB = has_next ? (const char*)g.Bt + (size_t)nxt.pn * tstep : cB;
        for (int t = 0; t < nt; t += 2) {
            const bool last = (t == nt - 2);
            const char* a1 = cA + (size_t)(t + 1) * kstep;
            const char* a2 = last ? nA : cA + (size_t)(t + 2) * kstep; const char* b2 = last ? nB : cB + (size_t)(t + 2) * kstep;
            const char* a3 = a2 + kstep; const char* b3 = b2 + kstep;
            if (last && has_next) S.a_ready(nxt);
            if constexpr (SP2) {
            PG8_LDB(B0, 0, 0); PG8_LDB(B1, 0, 1); PG8_SCHED; PG8_LDA(At, 0, 0); PG8_STAGE(PG8_SA(1, 1), a1 + hstep, voffA);
            PG8_WAIT_V(8); PG8_WAIT_L(0); PG8_BAR; PG8_MMA(0, 0, At, B0); PG8_MMA(0, 1, At, B1); PG8_BAR; PG8_SCHED;
            PG8_LDA(At, 0, 1); PG8_STAGE(PG8_SB(0, 0), b2, voffB); PG8_STAGE(PG8_SB(0, 1), b2 + hstep, voffB); PG8_STAGE(PG8_SA(0, 0), a2, voffA);
            PG8_WAIT_V(8); PG8_WAIT_L(0); PG8_BAR; PG8_MMA(1, 0, At, B0); PG8_MMA(1, 1, At, B1); PG8_BAR; PG8_SCHED;
            PG8_LDB(B0, 1, 0); PG8_LDB(B1, 1, 1); PG8_SCHED; PG8_LDA(At, 1, 0); PG8_STAGE(PG8_SA(0, 1), a2 + hstep, voffA);
            PG8_WAIT_V(8); PG8_WAIT_L(0); PG8_BAR; PG8_MMA(0, 0, At, B0); PG8_MMA(0, 1, At, B1); PG8_BAR; PG8_SCHED;
            PG8_LDA(At, 1, 1); PG8_STAGE(PG8_SB(1, 0), b3, voffB); PG8_STAGE(PG8_SB(1, 1), b3 + hstep, voffB); PG8_STAGE(PG8_SA(1, 0), a3, voffA);
            PG8_WAIT_V(8); PG8_WAIT_L(0); PG8_BAR; PG8_MMA(1, 0, At, B0); PG8_MMA(1, 1, At, B1); PG8_BAR; PG8_SCHED;
            } else {
            PG8_LDB(B0, 0, 0); PG8_SCHED; PG8_LDA(At, 0, 0); PG8_STAGE(PG8_SA(1, 1), a1 + hstep, voffA);
            PG8_WAIT_L(8); PG8_BAR; PG8_WAIT_L(0); PG8_MMA(0, 0, At, B0); PG8_BAR; PG8_SCHED;
            PG8_LDB(B1, 0, 1); PG8_STAGE(PG8_SB(0, 0), b2, voffB);
            PG8_BAR; PG8_WAIT_L(0); PG8_MMA(0, 1, At, B1); PG8_BAR;
            PG8_LDA(At, 0, 1); PG8_STAGE(PG8_SA(0, 0), a2, voffA);
            PG8_BAR; PG8_WAIT_L(0); PG8_MMA(1, 0, At, B0); PG8_BAR; PG8_SCHED;
            PG8_STAGE(PG8_SB(0, 1), b2 + hstep, voffB);
            PG8_WAIT_V(6); PG8_BAR; PG8_MMA(1, 1, At, B1); PG8_BAR;
            PG8_LDB(B0, 1, 0); PG8_SCHED; PG8_LDA(At, 1, 0); PG8_STAGE(PG8_SA(0, 1), a2 + hstep, voffA);
            PG8_WAIT_L(8); PG8_BAR; PG8_WAIT_L(0); PG8_MMA(0, 0, At, B0); PG8_BAR; PG8_SCHED;
            PG8_LDB(B1, 1, 1); PG8_STAGE(PG8_SB(1, 0), b3, voffB);
            PG8_BAR; PG8_WAIT_L(0); PG8_MMA(0, 1, At, B1); PG8_BAR;
            PG8_LDA(At, 1, 1); PG8_STAGE(PG8_SA(1, 0), a3, voffA);
            PG8_BAR; PG8_WAIT_L(0); PG8_MMA(1, 0, At, B0); PG8_BAR; PG8_SCHED;
            PG8_STAGE(PG8_SB(1, 1), b3 + hstep, voffB);
            PG8_WAIT_V(6); PG8_BAR; PG8_MMA(1, 1, At, B1); PG8_BAR;
            }
        }
        if constexpr (ALIGN_EPI) { if (wr == 0) PG8_BAR; }
        if constexpr (!Epi::AFTER_DRAIN) { E(acc, cur, wr, wc, fr, fq); S.done(cur); }
        if (!has_next) break;
#pragma unroll
        for (int a = 0; a < 2; ++a)
#pragma unroll
            for (int b = 0; b < 2; ++b)
#pragma unroll
                for (int m = 0; m < 4; ++m)
#pragma unroll
                    for (int n = 0; n < 2; ++n) acc[a][b][m][n] = (f32x4){0.f, 0.f, 0.f, 0.f};
        cur = nxt; cA = nA; cB = nB; ++ui;
        if constexpr (ALIGN_EPI) { if (wr == 1) PG8_BAR; }
    }
    PG8_WAIT_V(0);
    if constexpr (!ALIGN_EPI) { if (wr == 0) PG8_BAR; }
    PG8_BAR;
    if constexpr (Epi::AFTER_DRAIN) { E.fused(acc, cur, wr, wc, fr, fq, lds, wid, lane); S.done(cur); }
#undef PG8_SA
#undef PG8_SB
#undef PG8_STAGE
#undef PG8_LDA
#undef PG8_LDB
#undef PG8_MMA
#undef PG8_WAIT_V
#undef PG8_WAIT_L
#undef PG8_BAR
#undef PG8_SCHED
}
}

template <class E0> struct EpiAdapt {
    static constexpr bool PERM = false, AFTER_DRAIN = false;
    E0 e; int col_base;
    __device__ __forceinline__ void operator()(const pg8::f32x4 (&acc)[2][2][4][2], const pg8::Unit& u, int wr, int wc, int fr, int fq) const {
#pragma unroll
        for (int ai = 0; ai < 2; ++ai)
#pragma unroll
            for (int m = 0; m < 4; ++m) {
                const int row = u.pm * 256 + ai * 128 + wr * 64 + m * 16 + fr;
                const float rs = e.row_begin(row, fq);
                float ss = 0.f;
                if constexpr (E0::PAIR2) e.item2(row, col_base + u.pn * 256 + wc * 32 + 4 * fq, acc[ai][0][m][0], acc[ai][0][m][1], acc[ai][1][m][0], acc[ai][1][m][1], rs);
                else {
#pragma unroll
                    for (int bj = 0; bj < 2; ++bj) ss += e.item(row, col_base + u.pn * 256 + bj * 128 + wc * 32 + 4 * fq, acc[ai][bj][m][0], acc[ai][bj][m][1], rs);
                }
                if constexpr (E0::STATS) { ss += __shfl_xor(ss, 16); ss += __shfl_xor(ss, 32); if (fq == 0) e.stats[(size_t)row * 16 + (col_base >> 6) + u.pn * 4 + wc] = ss; }
            }
    }
};
struct EpiResBig {
    static constexpr bool PERM = false, AFTER_DRAIN = false;
    EpiRes e;
    __device__ __forceinline__ void operator()(const pg8::f32x4 (&acc)[2][2][4][2], const pg8::Unit& u, int wr, int wc, int fr, int fq) const {
        const float* mg = (const float*)e.ws + e.mgoff; const float* sn = (const float*)e.ws + e.snoff;
        bf16_t* xs = (bf16_t*)(e.ws + WS_XS);
        const int colb = u.pn * 256 + wc * 32 + 4 * fq;
#pragma unroll
        for (int ai = 0; ai < 2; ++ai) {
            const int rowb = u.pm * 256 + ai * 128 + wr * 64 + fr;
            f32x4 xo[4][2][2];
#pragma unroll
            for (int m = 0; m < 4; ++m)
#pragma unroll
                for (int bj = 0; bj < 2; ++bj)
#pragma unroll
                    for (int hl = 0; hl < 2; ++hl) xo[m][bj][hl] = *(const f32x4*)(e.xin + (size_t)(rowb + 16 * m) * 1024 + colb + 128 * bj + 16 * hl);
#pragma unroll
            for (int m = 0; m < 4; ++m) {
                const int row = rowb + 16 * m; float ss = 0.f;
#pragma unroll
                for (int bj = 0; bj < 2; ++bj)
#pragma unroll
                    for (int hl = 0; hl < 2; ++hl) {
                        const int c = colb + 128 * bj + 16 * hl;
                        const f32x4 m4 = *(const f32x4*)(mg + c);
                        f32x4 b4 = {0.f, 0.f, 0.f, 0.f}; if (e.bias) b4 = *(const f32x4*)(e.bias + c);
                        const f32x4 xn = xo[m][bj][hl] + m4 * (acc[ai][bj][m][hl] + b4);
                        *(f32x4*)(e.xl + (size_t)row * 1024 + c) = xn;
                        ss += (xn[0] * xn[0] + xn[1] * xn[1]) + (xn[2] * xn[2] + xn[3] * xn[3]);
                        if (e.snoff >= 0) { const f32x4 s4 = *(const f32x4*)(sn + c); u32x2 w; w.x = pk2(xn[0] * s4[0], xn[1] * s4[1]); w.y = pk2(xn[2] * s4[2], xn[3] * s4[3]);
                            *(u32x2*)(xs + (size_t)row * 1024 + c) = w; }
                    }
                ss += __shfl_xor(ss, 16); ss += __shfl_xor(ss, 32); if (fq == 0) e.stats[(size_t)row * 16 + u.pn * 4 + wc] = ss;
            }
        }
    }
};
struct EpiVt {
    static constexpr bool PERM = false, AFTER_DRAIN = false;
    unsigned char* ws; int cvoff;
    __device__ __forceinline__ void operator()(const pg8::f32x4 (&acc)[2][2][4][2], const pg8::Unit& u, int wr, int wc, int fr, int fq) const {
        bf16_t* vt = (bf16_t*)(ws + WS_VT);
#pragma unroll
        for (int ai = 0; ai < 2; ++ai)
#pragma unroll
            for (int m = 0; m < 4; ++m) {
                const int rowb = u.pm * 256 + ai * 128 + wr * 64 + m * 16;
                const float rsl = row_rs((const float*)(ws + WS_STATS), rowb + fr, fq);
                float rsv[4];
#pragma unroll
                for (int e = 0; e < 4; ++e) rsv[e] = __shfl(rsl, 4 * fq + e);
                const float* cv = (const float*)ws + cvoff + (rowb < T ? 0 : 8192);
#pragma unroll
                for (int bj = 0; bj < 2; ++bj)
#pragma unroll
                    for (int n = 0; n < 2; ++n) {
                        const int col = 2048 + u.pn * 256 + bj * 128 + wc * 32 + 16 * n + fr;
                        const float c0 = cv[col]; const pg8::f32x4 a = acc[ai][bj][m][n];
                        u32x2 w; w.x = pk2(a[0] * rsv[0] + c0, a[1] * rsv[1] + c0); w.y = pk2(a[2] * rsv[2] + c0, a[3] * rsv[3] + c0);
                        *(u32x2*)(vt + (size_t)(col - 2048) * R + rowb + 4 * fq) = w;
                    }
            }
    }
};
template <class Epi>
__device__ __forceinline__ void sgemm_small(Ctx& C, const bf16_t* A, const bf16_t* Bt, int row_lo, int Mrows, int N, int K, const Epi& E, int n_lo, int n_hi) {
    const int w = C.wave, fr = C.lane & 15, fq = C.lane >> 4;
    const int nM = Mrows / 16, nN = n_hi - n_lo, nU = nM * nN, K8 = K >> 3;
    LAS f32x4* xch = (LAS f32x4*)C.lds;
    LAS float* sx = (LAS float*)(C.lds + 131072 + 1024);
    for (int u = (C.G - 1 - C.bid); u < nU; u += C.G) {
        const int un = n_lo + u / nM, um = u % nM;
        const int row0 = row_lo + 16 * um, col0 = 256 * un;
        f32x4 acc[16];
#pragma unroll
        for (int t = 0; t < 16; ++t) acc[t] = (f32x4){0.f, 0.f, 0.f, 0.f};
        const bf16_t* ap = A + (size_t)(row0 + fr) * K + w * K8 + 8 * fq;
        const bf16_t* bp = Bt + (size_t)(col0 + fr) * K + w * K8 + 8 * fq;
#pragma unroll 1
        for (int k0 = 0; k0 < K8; k0 += 32) {
            const bf16x8 af = *(const bf16x8*)(ap + k0);
            bf16x8 bf[16];
#pragma unroll
            for (int t = 0; t < 16; ++t) bf[t] = *(const bf16x8*)(bp + (size_t)(16 * t) * K + k0);
#pragma unroll
            for (int t = 0; t < 16; ++t) acc[t] = __builtin_amdgcn_mfma_f32_16x16x32_bf16(bf[t], af, acc[t], 0, 0, 0);
        }
#pragma unroll
        for (int t = 0; t < 16; ++t) xch[(w * 16 + t) * 64 + C.lane] = acc[t];
        __syncthreads();
        const int wc = w >> 1, bj = w & 1, t0 = 8 * bj + 2 * wc;
        f32x4 v0 = {0.f, 0.f, 0.f, 0.f}, v1 = v0;
#pragma unroll
        for (int q = 0; q < 8; ++q) { v0 += xch[(q * 16 + t0) * 64 + C.lane]; v1 += xch[(q * 16 + t0 + 1) * 64 + C.lane]; }
        const int row = row0 + fr;
        const float rs = E.row_begin(row, fq);
        float ss = E.item(row, col0 + 128 * bj + 32 * wc + 4 * fq, v0, v1, rs);
        if constexpr (Epi::STATS) {
            ss += __shfl_xor(ss, 16); ss += __shfl_xor(ss, 32);
            if (fq == 0) sx[fr * 8 + w] = ss;
            __syncthreads();
            if (fq == 0 && bj == 0) E.stats[(size_t)row * 16 + un * 4 + wc] = sx[fr * 8 + w] + sx[fr * 8 + w + 1];
        }
        __syncthreads();
    }
}
template <class E0>
__device__ __forceinline__ void gemm_both(Ctx& C, const bf16_t* A, const bf16_t* Bt, int Mbig, int N, int K, const E0& E, int ctx_n_lo, int ctx_n_hi, int nb_lo = 0, int nb_hi = -1) {
    if (nb_hi < 0) nb_hi = N / 256;
    { pg8::Gemm g{A, Bt + (size_t)nb_lo * 256 * K, Mbig, (nb_hi - nb_lo) * 256, K}; pg8::StaticOrder S; S.init(Mbig, (nb_hi - nb_lo) * 256, C.G, C.bid); EpiAdapt<E0> EA{E, nb_lo * 256};
      pg8::gemm_phase<EpiAdapt<E0>, pg8::StaticOrder, true, true>(C.lds, g, S, EA); }
    if (Mbig < R && ctx_n_hi > ctx_n_lo) { __syncthreads(); relane(C); sgemm_small(C, A, Bt, T, R - T, N, K, E, ctx_n_lo, ctx_n_hi); }
}
__device__ __forceinline__ void dwconv_phase(Ctx& C, int j) {
    const bf16_t* U = (const bf16_t*)(C.ws + WS_U); bf16_t* A2 = (bf16_t*)(C.ws + WS_A2);
    const float* dww = C.in[10] + (size_t)j * CK * 1024; const float* dwb = C.in[11] + j * 1024; const float* lng = C.in[12] + j * 1024; const float* lnb = C.in[13] + j * 1024;
    constexpr int TT = 33, NR = TT + 30;
    LAS unsigned char* tile = C.lds; LAS float* part = (LAS float*)(C.lds + NR * 2048);
    const int tid = C.tid;
    constexpr int NUL = (T + TT - 1) / TT, NUC = (TC + TT - 1) / TT;
    f32x2 wt[CK];
#pragma unroll
    for (int jt = 0; jt < CK; ++jt) wt[jt] = *(const f32x2*)(dww + jt * 1024 + 2 * tid);
    const f32x2 b2 = *(const f32x2*)(dwb + 2 * tid), g2 = *(const f32x2*)(lng + 2 * tid), bb2 = *(const f32x2*)(lnb + 2 * tid);
    for (int u = C.bid; u < NUL + NUC; u += C.G) {
        const bool lat = u < NUL; const int base = lat ? 0 : T, n = lat ? T : TC, t0 = TT * (lat ? u : u - NUL);
        const int nv = (n - t0) < TT ? (n - t0) : TT;
        for (int idx = tid; idx < NR * 128; idx += 512) {
            const int rr = idx >> 7, ch = idx & 127, tt = t0 - 15 + rr;
            u32x4 v = {0u, 0u, 0u, 0u};
            if (tt >= 0 && tt < n) v = *(const u32x4*)(U + (size_t)(base + tt) * 1024 + ch * 8);
            *(LAS u32x4*)(tile + rr * 2048 + ch * 16) = v;
        }
        __syncthreads();
        f32x2 o[TT];
#pragma unroll
        for (int t = 0; t < TT; ++t) o[t] = b2;
#pragma unroll
        for (int hb = 0; hb < 3; ++hb) {
            f32x2 xw[41];
#pragma unroll
            for (int r = 0; r < 41; ++r) { const unsigned uu = *(const LAS unsigned*)(tile + (11 * hb + r) * 2048 + tid * 4); xw[r] = (f32x2){bflo(uu), bfhi(uu)}; }
#pragma unroll
            for (int t = 0; t < 11; ++t)
#pragma unroll
                for (int jt = 0; jt < CK; ++jt) o[11 * hb + t] += wt[jt] * xw[t + jt];
        }
#pragma unroll
        for (int t = 0; t < TT; ++t) {
            const float s = wave_sum63(o[t].x + o[t].y), q = wave_sum63(o[t].x * o[t].x + o[t].y * o[t].y);
            if (C.lane == 63) { part[(t * 8 + C.wave) * 2] = s; part[(t * 8 + C.wave) * 2 + 1] = q; }
        }
        __syncthreads();
#pragma unroll
        for (int t = 0; t < TT; ++t) {
            float s = 0.f, q = 0.f;
#pragma unroll
            for (int w = 0; w < 8; ++w) { s += part[(t * 8 + w) * 2]; q += part[(t * 8 + w) * 2 + 1]; }
            const float mean = s * (1.f / 1024.f), var = q * (1.f / 1024.f) - mean * mean, rstd = 1.0f / sqrtf(var + LN_EPS);
            const float y0 = (o[t].x - mean) * rstd * g2.x + bb2.x, y1 = (o[t].y - mean) * rstd * g2.y + bb2.y;
            if (t < nv) *(unsigned*)(A2 + (size_t)(base + t0 + t) * 1024 + 2 * tid) = pk2(siluf(y0), siluf(y1));
        }
        __syncthreads();
    }
}

__device__ __forceinline__ void ugemm_phase(Ctx& C, int j) {
    const bf16_t* Kb = (const bf16_t*)(C.ws + WS_K); const bf16_t* Vt = (const bf16_t*)(C.ws + WS_VT); bf16_t* Scp = (bf16_t*)(C.ws + WS_SCP);
    constexpr int SLOT = 32768;
    const int fr = C.lane & 15, fq = C.lane >> 4, w = C.wave, lane = C.lane;
    const int wm = w >> 1, wn = w & 1;
    const unsigned lds0 = (unsigned)(size_t)C.lds;
    for (int it0 = 0; it0 < 3; ++it0) {
        int set, sub;
        if (it0 < 2) { if (C.bid >= 256) break; const int x = C.bid & 7, ii = C.bid >> 3; set = it0 * 64 + x * 8 + (ii >> 2); sub = ii & 3; }
        else { const int k = C.G - 1 - C.bid; if (k >= 16) break; set = 128 + (k >> 2); sub = k & 3; }
        const int slot = set >> 2, h = set & 3, dir = sub >> 1, dvh = sub & 1;
        const int ntok = slot < 32 ? 512 : 256, tokb = slot < 32 ? 512 * slot : T, nst = ntok / 32;
        const float gam = 1.0f - exp2f(C.in[17][(j * 2 + dir) * 4 + h]); const float L = log2f(gam);
        unsigned ksrc[2], vsrc[2];
#pragma unroll
        for (int p = 0; p < 2; ++p) {
            const int kr = 2 * (2 * w + p) + (lane >> 5), kpos = lane & 31, kc = kpos ^ ((((kr & 3) | (((kr >> 3) & 1) << 2))) << 1);
            ksrc[p] = (unsigned)((tokb + kr) * 1024 + h * 256 + 8 * kc);
            const int vr = 16 * (2 * w + p) + (lane >> 2), vpos = lane & 3, vc = vpos ^ ((4 - ((vr >> 2) & 3)) & 3);
            vsrc[p] = (unsigned)((h * 512 + 256 * dvh + vr) * R + tokb + 8 * vc);
        }
#define UG_DMA(st) do { const int s_ = (st) < nst ? (st) : nst - 1; LAS unsigned char* sl_ = C.lds + ((st) & 3) * SLOT + (2 * w) * 1024; \
        _Pragma("unroll") for (int p = 0; p < 2; ++p) { \
            __builtin_amdgcn_global_load_lds((const unsigned*)(Kb + (ksrc[p] + (unsigned)(32 * s_ * 1024))), (LAS unsigned*)(sl_ + p * 1024), 16, 0, 0); \
            __builtin_amdgcn_global_load_lds((const unsigned*)(Vt + (vsrc[p] + (unsigned)(32 * s_))), (LAS unsigned*)(sl_ + 16384 + p * 1024), 16, 0, 0); } } while (0)
        const int trq = fr >> 2, trp = fr & 3;
        const int row0 = 8 * fq + trq;
        const unsigned a0 = (unsigned)(row0 * 512 + (((8 * wm + (trp >> 1)) ^ ((((row0 & 3) | (((row0 >> 3) & 1) << 2))) << 1)) << 4) + 8 * (trp & 1));
        const unsigned boff0 = (unsigned)(16384 + (128 * wn + fr) * 64 + ((fq ^ ((4 - ((fr >> 2) & 3)) & 3)) << 4));
        float kd[8];
#pragma unroll
        for (int e = 0; e < 8; ++e) { const int tl = 8 * fq + e; kd[e] = exp2f(L * (float)(dir == 0 ? 31 - tl : tl)); }
        f32x4 acc[4][8];
#pragma unroll
        for (int mt = 0; mt < 4; ++mt)
#pragma unroll
            for (int nt = 0; nt < 8; ++nt) acc[mt][nt] = (f32x4){0.f, 0.f, 0.f, 0.f};
        __syncthreads();
        UG_DMA(0); UG_DMA(1); UG_DMA(2);
#pragma unroll 1
        for (int st = 0; st < nst; ++st) {
            asm volatile("s_waitcnt vmcnt(8)" ::: "memory");
            __builtin_amdgcn_s_barrier(); asm volatile("" ::: "memory");
            UG_DMA(st + 3);
            const float sf = exp2f(L * (float)(dir == 0 ? ntok - 32 - 32 * st : 32 * st));
            const unsigned sl = lds0 + (unsigned)((st & 3) * SLOT);
            u32x2 alo[4], ahi[4]; u32x4 bfv[4];
#pragma unroll
            for (int mt = 0; mt < 4; ++mt) {
                const unsigned aa = sl + (a0 ^ (unsigned)(mt << 5));
                asm volatile("ds_read_b64_tr_b16 %0, %1" : "=v"(alo[mt]) : "v"(aa));
                asm volatile("ds_read_b64_tr_b16 %0, %1 offset:2048" : "=v"(ahi[mt]) : "v"(aa));
            }
            const unsigned ba = sl + boff0;
#pragma unroll
            for (int nt = 0; nt < 4; ++nt) asm volatile("ds_read_b128 %0, %1 offset:%c2" : "=v"(bfv[nt]) : "v"(ba), "i"(nt * 1024));
            asm volatile("s_waitcnt lgkmcnt(0)" : "+v"(alo[0]), "+v"(alo[1]), "+v"(alo[2]), "+v"(alo[3]), "+v"(ahi[0]), "+v"(ahi[1]), "+v"(ahi[2]), "+v"(ahi[3]) :: "memory");
            asm volatile("" : "+v"(bfv[0]), "+v"(bfv[1]), "+v"(bfv[2]), "+v"(bfv[3]));
            __builtin_amdgcn_sched_barrier(0);
            bf16x8 af[4];
#pragma unroll
            for (int mt = 0; mt < 4; ++mt) {
                u32x4 pk;
                pk.x = pk2(bflo(alo[mt].x) * (kd[0] * sf), bfhi(alo[mt].x) * (kd[1] * sf));
                pk.y = pk2(bflo(alo[mt].y) * (kd[2] * sf), bfhi(alo[mt].y) * (kd[3] * sf));
                pk.z = pk2(bflo(ahi[mt].x) * (kd[4] * sf), bfhi(ahi[mt].x) * (kd[5] * sf));
                pk.w = pk2(bflo(ahi[mt].y) * (kd[6] * sf), bfhi(ahi[mt].y) * (kd[7] * sf));
                af[mt] = __builtin_bit_cast(bf16x8, pk);
            }
#pragma unroll
            for (int mt = 0; mt < 4; ++mt)
#pragma unroll
                for (int nt = 0; nt < 4; ++nt) acc[mt][nt] = __builtin_amdgcn_mfma_f32_16x16x32_bf16(af[mt], __builtin_bit_cast(bf16x8, bfv[nt]), acc[mt][nt], 0, 0, 0);
            __builtin_amdgcn_sched_barrier(0);
#pragma unroll
            for (int nt = 0; nt < 4; ++nt) asm volatile("ds_read_b128 %0, %1 offset:%c2" : "=v"(bfv[nt]) : "v"(ba), "i"((nt + 4) * 1024));
            asm volatile("s_waitcnt lgkmcnt(0)" : "+v"(bfv[0]), "+v"(bfv[1]), "+v"(bfv[2]), "+v"(bfv[3]) :: "memory");
            __builtin_amdgcn_sched_barrier(0);
#pragma unroll
            for (int mt = 0; mt < 4; ++mt)
#pragma unroll
                for (int nt = 0; nt < 4; ++nt) acc[mt][nt + 4] = __builtin_amdgcn_mfma_f32_16x16x32_bf16(af[mt], __builtin_bit_cast(bf16x8, bfv[nt]), acc[mt][nt + 4], 0, 0, 0);
        }
        asm volatile("s_waitcnt vmcnt(0)" ::: "memory");
        bf16_t* sp = Scp + ((size_t)((slot * 4 + h) * 2 + dir) * 512) * 256;
#pragma unroll
        for (int nt = 0; nt < 8; ++nt) {
            bf16_t* rowp = sp + (size_t)(256 * dvh + 128 * wn + 16 * nt + fr) * 256 + 64 * wm + 4 * fq;
#pragma unroll
            for (int mt = 0; mt < 4; ++mt) { u32x2 wv; wv.x = pk2(acc[mt][nt][0], acc[mt][nt][1]); wv.y = pk2(acc[mt][nt][2], acc[mt][nt][3]); *(u32x2*)(rowp + 16 * mt) = wv; }
        }
        __syncthreads();
#undef UG_DMA
    }
}
__device__ __forceinline__ void prefix_phase(Ctx& C, int j) {
    bf16_t* Scp = (bf16_t*)(C.ws + WS_SCP);
    constexpr size_t SSTR = (size_t)8 * 512 * 256;
    for (int idx = C.bid * 512 + C.tid; idx < 8 * 512 * 32; idx += C.G * 512) {
        const int hd = idx >> 14, h = hd >> 1, dir = hd & 1;
        const float gam = 1.0f - exp2f(C.in[17][(j * 2 + dir) * 4 + h]); const float cdec = exp2f(log2f(gam) * 512.f);
        bf16_t* p = Scp + (size_t)idx * 8;
        const u32x4 raw = *(const u32x4*)(p + 32 * SSTR);
        float s[8] = {bflo(raw.x), bfhi(raw.x), bflo(raw.y), bfhi(raw.y), bflo(raw.z), bfhi(raw.z), bflo(raw.w), bfhi(raw.w)};
        *(u32x4*)(p + 32 * SSTR) = (u32x4){0u, 0u, 0u, 0u};
#pragma unroll 1
        for (int qb = 0; qb < 4; ++qb) {
            u32x4 u[8];
#pragma unroll
            for (int q = 0; q < 8; ++q) { const int g = dir == 0 ? 8 * qb + q : 31 - (8 * qb + q); u[q] = *(const u32x4*)(p + (size_t)g * SSTR); }
#pragma unroll
            for (int q = 0; q < 8; ++q) {
                const int g = dir == 0 ? 8 * qb + q : 31 - (8 * qb + q);
                u32x4 o; o.x = pk2(s[0], s[1]); o.y = pk2(s[2], s[3]); o.z = pk2(s[4], s[5]); o.w = pk2(s[6], s[7]);
                *(u32x4*)(p + (size_t)g * SSTR) = o;
                s[0] = s[0] * cdec + bflo(u[q].x); s[1] = s[1] * cdec + bfhi(u[q].x); s[2] = s[2] * cdec + bflo(u[q].y); s[3] = s[3] * cdec + bfhi(u[q].y);
                s[4] = s[4] * cdec + bflo(u[q].z); s[5] = s[5] * cdec + bfhi(u[q].z); s[6] = s[6] * cdec + bflo(u[q].w); s[7] = s[7] * cdec + bfhi(u[q].w);
            }
        }
    }
}

template <int MT, int PV = 0>
__device__ __forceinline__ void readout_units(Ctx& C, int j) {
    const bf16_t* Q = (const bf16_t*)(C.ws + WS_Q); const bf16_t* Kb = (const bf16_t*)(C.ws + WS_K); const bf16_t* Vt = (const bf16_t*)(C.ws + WS_VT);
    const bf16_t* Scp = (const bf16_t*)(C.ws + WS_SCP); bf16_t* GF = (bf16_t*)(C.ws + WS_GF); const bf16_t* GB = (const bf16_t*)(C.ws + WS_GB);
    constexpr int QP = 264, PP = 136;
    constexpr int NROW = 16 * MT;
    LAS bf16_t* Qs = (LAS bf16_t*)C.lds;
    LAS bf16_t* P = (LAS bf16_t*)(C.lds + NROW * QP * 2);
    LAS float* red = (LAS float*)(C.lds + NROW * QP * 2 + NROW * PP * 2);
    const int w = C.wave, tid = C.tid;
    const int nunits = MT == 8 ? 512 : 32;
    for (int u0 = (MT == 8 ? C.bid : C.G - 1 - C.bid); u0 < nunits; u0 += C.G) {
        int h, b, sb = 0;
        if (MT != 8) { h = u0 & 3; sb = (u0 >> 2) & 3; b = 128 + (u0 >> 4); }
        else if (C.G == 256) { const int r = u0 >> 8, x = u0 & 7, idx = (u0 & 255) >> 3, grp = r * 64 + x * 8 + (idx >> 2); h = grp & 3; b = (grp >> 2) * 4 + (idx & 3); }
        else { h = u0 & 3; b = u0 >> 2; }
        const bool lat = b < 128; const int base = lat ? 0 : T, nb = lat ? 128 : 2, bl = lat ? b : b - 128;
        const int g = bl >> 2, slot = lat ? g : 32;
        const int gend = (4 * (g + 1) < nb ? 4 * (g + 1) : nb);
        const int i0 = base + 128 * bl + NROW * sb, il0 = 128 * bl + NROW * sb;
#pragma unroll
        for (int i = 0; i < MT; ++i) { const int c = tid + 512 * i, row = c >> 5, ch = c & 31;
            *(LAS u32x4*)(Qs + row * QP + 8 * ch) = *(const u32x4*)(Q + (size_t)(i0 + row) * 1024 + h * 256 + 8 * ch); }
        __syncthreads();
#pragma unroll 1
        for (int dir = 0; dir < 2; ++dir) {
            int lane_o = C.lane; asm volatile("" : "+v"(lane_o));
            const int fr = lane_o & 15, fq = lane_o >> 4;
            const float gam = 1.0f - exp2f(C.in[17][(j * 2 + dir) * 4 + h]); const float L = log2f(gam);
            f32x4 acc[MT][4];
#pragma unroll
            for (int mt = 0; mt < MT; ++mt)
#pragma unroll
                for (int nt = 0; nt < 4; ++nt) acc[mt][nt] = (f32x4){0.f, 0.f, 0.f, 0.f};
            const int kb_lo = dir == 0 ? 4 * g : bl, kb_hi = dir == 0 ? bl : gend - 1;
            const bf16_t* sb = Scp + ((size_t)((slot * 4 + h) * 2 + dir) * 512) * 256 + (size_t)(64 * w + 16 * (fr >> 2) + (fr & 3)) * 256 + 8 * fq;
#pragma unroll 1
            for (int kq = 0; kq < (PV == 5 ? 0 : 4); ++kq) {
                bf16x8 sf[2][4];
#pragma unroll
                for (int k2 = 0; k2 < 2; ++k2)
#pragma unroll
                    for (int nt = 0; nt < 4; ++nt) sf[k2][nt] = *(const bf16x8*)(sb + (size_t)(4 * nt) * 256 + 32 * (2 * kq + k2));
#pragma unroll
                for (int k2 = 0; k2 < 2; ++k2)
#pragma unroll
                    for (int mt = 0; mt < MT; ++mt) { const bf16x8 qf = *(const LAS bf16x8*)(Qs + (16 * mt + fr) * QP + 32 * (2 * kq + k2) + 8 * fq);
#pragma unroll
                        for (int nt = 0; nt < 4; ++nt) acc[mt][nt] = __builtin_amdgcn_mfma_f32_16x16x32_bf16(sf[k2][nt], qf, acc[mt][nt], 0, 0, 0); }
            }
#pragma unroll
            for (int mt = 0; mt < MT; ++mt) {
                const int il = il0 + 16 * mt + fr;
                const int ex = dir == 0 ? il - 512 * g + 1 : gend * 128 - il;
                const float qd = __builtin_amdgcn_exp2f(L * (float)ex);
#pragma unroll
                for (int nt = 0; nt < 4; ++nt) acc[mt][nt] = acc[mt][nt] * qd;
            }
#pragma unroll 1
            for (int kb = kb_lo; kb <= ((PV == 2 || PV == 5) ? kb_lo - 1 : kb_hi); ++kb) {
                const int j0 = base + 128 * kb;
                {
                    bf16x8 kf[8];
                    const bf16_t* k1 = Kb + (size_t)(j0 + 16 * w + fr) * 1024 + h * 256 + 8 * fq;
#pragma unroll
                    for (int ks = 0; ks < 8; ++ks) kf[ks] = *(const bf16x8*)(k1 + 32 * ks);
                    f32x4 sc[MT];
#pragma unroll
                    for (int mt = 0; mt < MT; ++mt) sc[mt] = (f32x4){0.f, 0.f, 0.f, 0.f};
#pragma unroll
                    for (int ks = 0; ks < 8; ++ks) {
#pragma unroll
                        for (int mt = 0; mt < MT; ++mt) { const bf16x8 qf = *(const LAS bf16x8*)(Qs + (16 * mt + fr) * QP + 32 * ks + 8 * fq);
                            sc[mt] = __builtin_amdgcn_mfma_f32_16x16x32_bf16(kf[ks], qf, sc[mt], 0, 0, 0); }
                        __builtin_amdgcn_sched_barrier(0);
                    }
#pragma unroll
                    for (int mt = 0; mt < MT; ++mt) {
                        const int il = il0 + 16 * mt + fr;
                        float p[4];
#pragma unroll
                        for (int e = 0; e < 4; ++e) { const int jl = 128 * kb + 16 * w + 4 * fq + e; const int rel = dir == 0 ? il - jl : jl - il;
                            p[e] = rel >= 0 ? sc[mt][e] * __builtin_amdgcn_exp2f(L * (float)rel) : 0.f; }
                        u32x2 wv; wv.x = pk2(p[0], p[1]); wv.y = pk2(p[2], p[3]);
                        *(LAS u32x2*)(P + (16 * mt + fr) * PP + 16 * w + 4 * fq) = wv;
                    }
                }
                __syncthreads();
                const bf16_t* vb = Vt + (size_t)(h * 512 + 64 * w + 16 * (fr >> 2) + (fr & 3)) * R + j0 + 8 * fq;
#pragma unroll 1
                for (int kh2 = 0; kh2 < 2; ++kh2) {
                    bf16x8 vf[2][4];
#pragma unroll
                    for (int k2 = 0; k2 < 2; ++k2)
#pragma unroll
                        for (int nt = 0; nt < 4; ++nt) vf[k2][nt] = *(const bf16x8*)(vb + (size_t)(4 * nt) * R + 32 * (2 * kh2 + k2));
#pragma unroll
                    for (int k2 = 0; k2 < 2; ++k2)
#pragma unroll
                        for (int mt = 0; mt < MT; ++mt) { const bf16x8 pf = *(const LAS bf16x8*)(P + (16 * mt + fr) * PP + 32 * (2 * kh2 + k2) + 8 * fq);
#pragma unroll
                            for (int nt = 0; nt < 4; ++nt) acc[mt][nt] = __builtin_amdgcn_mfma_f32_16x16x32_bf16(vf[k2][nt], pf, acc[mt][nt], 0, 0, 0); }
                }
                __syncthreads();
            }
#pragma unroll
            for (int mt = 0; mt < MT; ++mt) {
                float ss = 0.f;
#pragma unroll
                for (int nt = 0; nt < 4; ++nt) ss += (acc[mt][nt][0] * acc[mt][nt][0] + acc[mt][nt][1] * acc[mt][nt][1]) + (acc[mt][nt][2] * acc[mt][nt][2] + acc[mt][nt][3] * acc[mt][nt][3]);
                ss += __shfl_xor(ss, 16); ss += __shfl_xor(ss, 32);
                if (fq == 0) red[(16 * mt + fr) * 8 + w] = ss;
            }
            const size_t off0 = (size_t)(i0 + fr) * 2048 + h * 512 + 64 * w + 16 * fq;
            u32x4 gld[MT][2];
#pragma unroll
            for (int mt = 0; mt < MT; ++mt)
#pragma unroll
                for (int np = 0; np < 2; ++np) gld[mt][np] = *(const u32x4*)((dir == 0 ? (const bf16_t*)GF : GB) + off0 + (size_t)(16 * mt) * 2048 + 8 * np);
            __syncthreads();
#pragma unroll
            for (int mt = 0; mt < MT; ++mt) {
                float tot = 0.f;
#pragma unroll
                for (int w2 = 0; w2 < 8; ++w2) tot += red[(16 * mt + fr) * 8 + w2];
                const float rn = 1.0f / sqrtf(tot * (1.f / 512.f) + NORM_EPS);
#pragma unroll
                for (int np = 0; np < 2; ++np) {
                    const u32x4 g4 = gld[mt][np];
                    acc[mt][2 * np][0] *= siluf(bflo(g4.x)) * rn; acc[mt][2 * np][1] *= siluf(bfhi(g4.x)) * rn;
                    acc[mt][2 * np][2] *= siluf(bflo(g4.y)) * rn; acc[mt][2 * np][3] *= siluf(bfhi(g4.y)) * rn;
                    acc[mt][2 * np + 1][0] *= siluf(bflo(g4.z)) * rn; acc[mt][2 * np + 1][1] *= siluf(bfhi(g4.z)) * rn;
                    acc[mt][2 * np + 1][2] *= siluf(bflo(g4.w)) * rn; acc[mt][2 * np + 1][3] *= siluf(bfhi(g4.w)) * rn;
                }
            }
            if (dir == 1) {
#pragma unroll
                for (int mt = 0; mt < MT; ++mt)
#pragma unroll
                    for (int np = 0; np < 2; ++np) gld[mt][np] = *(const u32x4*)(GF + off0 + (size_t)(16 * mt) * 2048 + 8 * np);
#pragma unroll
                for (int mt = 0; mt < MT; ++mt)
#pragma unroll
                    for (int np = 0; np < 2; ++np) { const u32x4 yp = gld[mt][np];
                        acc[mt][2 * np][0] += bflo(yp.x); acc[mt][2 * np][1] += bfhi(yp.x); acc[mt][2 * np][2] += bflo(yp.y); acc[mt][2 * np][3] += bfhi(yp.y);
                        acc[mt][2 * np + 1][0] += bflo(yp.z); acc[mt][2 * np + 1][1] += bfhi(yp.z); acc[mt][2 * np + 1][2] += bflo(yp.w); acc[mt][2 * np + 1][3] += bfhi(yp.w); }
            }
            if (PV != 4) {
#pragma unroll
                for (int mt = 0; mt < MT; ++mt)
#pragma unroll
                    for (int np = 0; np < 2; ++np) { u32x4 wv; wv.x = pk2(acc[mt][2 * np][0], acc[mt][2 * np][1]); wv.y = pk2(acc[mt][2 * np][2], acc[mt][2 * np][3]);
                        wv.z = pk2(acc[mt][2 * np + 1][0], acc[mt][2 * np + 1][1]); wv.w = pk2(acc[mt][2 * np + 1][2], acc[mt][2 * np + 1][3]);
                        *(u32x4*)(GF + off0 + (size_t)(16 * mt) * 2048 + 8 * np) = wv; }
            }
        }
        __syncthreads();
    }
}

template <int PV = 0>
__device__ __forceinline__ void readout_phase(Ctx& C, int j, bool skip_ctx) {
    readout_units<8, PV>(C, j);
    if (!skip_ctx) { __syncthreads(); readout_units<2, PV>(C, j); }
}

__device__ __forceinline__ void phase_p0(Ctx& C) {
    float* modv = (float*)(C.ws + WS_MODV);
    for (int u = C.bid; u < 384; u += C.G) {
        const int i = u / 96, nbk = u % 96;
        gemv2_unit<1>(C, C.in[4] + (size_t)i * 1024 * 6144, 6144, 64 * nbk, C.in[1], C.in[3], C.in[5] + i * 6144, modv + (i * 2 + 0) * 6144, modv + (i * 2 + 1) * 6144, 0, 0);
    }
    float* tabc = (float*)(C.ws + WS_TABC); float* tabs = (float*)(C.ws + WS_TABS);
    for (int idx = C.bid * 512 + C.tid; idx < 320 * 64; idx += C.G * 512) {
        const int ti = idx >> 6, i = idx & 63; const float pos = (float)(ti < 256 ? ti : ti - 256);
        const float inv = exp2f(-(float)i * (13.287712379549449f / 64.0f)); const float ang = pos * inv;
        tabc[idx] = __cosf(ang); tabs[idx] = __sinf(ang);
    }
}
__device__ __forceinline__ void phase_p1(Ctx& C) {
    const float* modv = (const float*)(C.ws + WS_MODV);
    float* s1 = (float*)(C.ws + WS_S1); float* s2 = (float*)(C.ws + WS_S2);
    for (int idx = C.bid * 512 + C.tid; idx < 8192; idx += C.G * 512) {
        const int i = idx >> 11, s = (idx >> 10) & 1, k = idx & 1023;
        s1[idx] = C.in[6][i * 1024 + k] * (1.f + modv[(i * 2 + s) * 6144 + 1024 + k]);
        s2[idx] = C.in[7][i * 1024 + k] * (1.f + modv[(i * 2 + s) * 6144 + 4096 + k]);
    }
    float* cvA = (float*)(C.ws + WS_CVA); float* cvF = (float*)(C.ws + WS_CVF);
    for (int u = C.bid; u < 672; u += C.G) {
        if (u < 320) {
            int i, nbk; if (u < 32) { i = 0; nbk = u; } else if (u < 160) { i = 1; nbk = u - 32; } else if (u < 192) { i = 2; nbk = u - 160; } else { i = 3; nbk = u - 192; }
            const int j = i >> 1; const float* v0 = modv + (i * 2 + 0) * 6144; const float* v1 = modv + (i * 2 + 1) * 6144;
            if ((i & 1) == 0) gemv2_unit<0>(C, C.in[8] + (size_t)j * 1024 * 2048, 2048, 64 * nbk, v0, v1, C.in[9] + j * 2048, cvA + (i * 2) * 8192, cvA + (i * 2 + 1) * 8192, 1, 1024);
            else gemv2_unit<0>(C, C.in[16] + (size_t)j * 1024 * 8192, 8192, 64 * nbk, v0, v1, nullptr, cvA + (i * 2) * 8192, cvA + (i * 2 + 1) * 8192, 2, 0);
        } else {
            const int i = (u - 320) / 88, nbk = (u - 320) % 88;
            const float* v0 = modv + (i * 2 + 0) * 6144 + 3072; const float* v1 = modv + (i * 2 + 1) * 6144 + 3072;
            gemv2_unit<0>(C, C.in[19] + (size_t)i * 1024 * FF2, FF2, 64 * nbk, v0, v1, nullptr, cvF + (i * 2) * FF2, cvF + (i * 2 + 1) * FF2, 1, DFF);
        }
    }
    bf16_t* xs = (bf16_t*)(C.ws + WS_XS); float* stats = (float*)(C.ws + WS_STATS); float* xctx = (float*)(C.ws + WS_XCTX);
    for (int row = C.bid * 8 + C.wave; row < R; row += C.G * 8) {
        const bool lat = row < T; const int s = lat ? 0 : 1;
        const float* src = lat ? C.in[0] + (size_t)row * 1024 : C.in[2] + (size_t)(row - T) * 1024;
        float ss = 0.f;
#pragma unroll
        for (int jj = 0; jj < 4; ++jj) {
            const int k = 4 * C.lane + 256 * jj;
            const f32x4 v = *(const f32x4*)(src + k);
            ss += (v[0] * v[0] + v[1] * v[1]) + (v[2] * v[2] + v[3] * v[3]);
            const f32x4 g = *(const f32x4*)(C.in[6] + k), m = *(const f32x4*)(modv + s * 6144 + 1024 + k);
            u32x2 w; w.x = pk2(v[0] * g[0] * (1.f + m[0]), v[1] * g[1] * (1.f + m[1])); w.y = pk2(v[2] * g[2] * (1.f + m[2]), v[3] * g[3] * (1.f + m[3]));
            *(u32x2*)(xs + (size_t)row * 1024 + k) = w;
        }
#pragma unroll
        for (int off = 1; off < 64; off <<= 1) ss += __shfl_xor(ss, off);
        if (C.lane < 16) stats[(size_t)row * 16 + C.lane] = C.lane == 0 ? ss : 0.f;
    }
    prep_layer(C, 0, 7, 0);
}
__device__ __forceinline__ void phase_final(Ctx& C) {
    const float* stats = (const float*)(C.ws + WS_STATS);
    for (int row = C.bid * 8 + C.wave; row < T; row += C.G * 8) {
        float s = C.lane < 16 ? stats[(size_t)row * 16 + C.lane] : 0.f;
#pragma unroll
        for (int off = 1; off < 64; off <<= 1) s += __shfl_xor(s, off);
        const float r = 1.0f / sqrtf(s * (1.f / 1024.f) + NORM_EPS);
        float* xr = C.out + (size_t)row * 1024;
#pragma unroll
        for (int jj = 0; jj < 4; ++jj) { const int k = 4 * C.lane + 256 * jj; const f32x4 v = *(const f32x4*)(xr + k), g = *(const f32x4*)(C.in[21] + k); *(f32x4*)(xr + k) = v * r * g; }
    }
}

constexpr int NPHASE = 31;
template <int SK  >
__device__ __forceinline__ void run_phase(Ctx& C, int ph) {
    const int i = (ph - 2) / 7, sub = (ph - 2) % 7, j = i >> 1; const bool conv = (i & 1) == 0;
    const bool last = i == DEPTH - 1;
    float* stats = (float*)(C.ws + WS_STATS);
    const bf16_t* xs = (const bf16_t*)(C.ws + WS_XS);
    constexpr int F_MODV = (int)(WS_MODV / 4), F_S1 = (int)(WS_S1 / 4), F_S2 = (int)(WS_S2 / 4), F_CVA = (int)(WS_CVA / 4), F_CVF = (int)(WS_CVF / 4);
    if constexpr (SK == 0 || SK == 1) {
        if constexpr (SK == 0) { EpiGLU E{C.ws, F_CVA + (i * 2) * 8192, 8192, (int)WS_U, 1024, 0, stats}; gemm_both(C, xs, (const bf16_t*)(C.ws + WS_WA), T, 2048, 1024, E, 0, 8); }
        else {
            EpiWin E{C.ws, F_CVA + (i * 2) * 8192, stats};
            const bf16_t* WA = (const bf16_t*)(C.ws + WS_WA);
            gemm_both(C, xs, WA, T, 8192, 1024, E, 0, 0, 0, 8);
            { pg8::Gemm g{xs, WA + (size_t)2048 * 1024, T, 2048, 1024}; pg8::StaticOrder S; S.init(T, 2048, C.G, C.bid); EpiVt EV{C.ws, F_CVA + (i * 2) * 8192};
              pg8::gemm_phase<EpiVt, pg8::StaticOrder, true, true, true>(C.lds, g, S, EV); }
            gemm_both(C, xs, WA, T, 8192, 1024, E, last ? 4 : 0, last ? 16 : 32, 16, 32);
        }
    } else if constexpr (SK == 2) {
        EpiGLU E{C.ws, F_CVF + (i * 2) * FF2, FF2, (int)WS_H, DFF, 1, stats}; gemm_both(C, xs, (const bf16_t*)(C.ws + WS_WF1), last ? T : R, FF2, 1024, E, 0, 0);
        if (!last) { __syncthreads(); relane(C); prep_layer(C, i + 1, 5, C.G == 256 ? 150 : 0); }
    } else {
        const bool f2 = sub == 6;
        const int mgoff = F_MODV + (i * 2) * 6144 + (f2 ? 5120 : 2048);
        const int snoff = f2 ? (last ? -1 : F_S1 + ((i + 1) * 2) * 1024) : F_S2 + (i * 2) * 1024;
        const float* bias = (!f2 && conv) ? C.in[15] + j * 1024 : nullptr;
        const bf16_t* A = (const bf16_t*)(C.ws + (f2 ? WS_H : (conv ? WS_A2 : WS_GF)));
        const bf16_t* Bt = (const bf16_t*)(C.ws + (f2 ? WS_WF2 : WS_WA2));
        const int K = f2 ? DFF : (conv ? 1024 : 2048);
        const bool first = (i == 0 && !f2);
        EpiRes E{C.ws, C.out, first ? C.in[0] : (const float*)C.out, first ? C.in[2] : (const float*)(C.ws + WS_XCTX), bias, mgoff, snoff, stats};
        { pg8::Gemm g{A, Bt, T, 1024, K}; pg8::StaticOrder S; S.init(T, 1024, C.G, C.bid); EpiResBig EB{E};
          pg8::gemm_phase<EpiResBig, pg8::StaticOrder, true, true>(C.lds, g, S, EB); }
        if (!last) { __syncthreads(); relane(C); sgemm_small(C, A, Bt, T, R - T, 1024, K, E, 0, 4); }
    }
}

#define XB_TMO      128
#define XB_XCNT(j)  (256  + 64 * (j))
#define XB_XSUB(j)  (1280 + 64 * (j))
#define XB_XGEN(j)  (2304 + 64 * (j))
#define XB_TOP      3328
#define XB_TOPGEN   3392
#define XCD_BAR_WORDS 3456
#define XB_SPIN_CAP (1u << 20)
__device__ __forceinline__ unsigned xb_ld(unsigned* p)              { return __hip_atomic_load(p, __ATOMIC_RELAXED, __HIP_MEMORY_SCOPE_AGENT); }
__device__ __forceinline__ unsigned xb_add(unsigned* p, unsigned v) { return __hip_atomic_fetch_add(p, v, __ATOMIC_RELAXED, __HIP_MEMORY_SCOPE_AGENT); }
__device__ __forceinline__ unsigned xb_xcc_id() { return (unsigned)__builtin_amdgcn_s_getreg((3 << 11) | 20) & 0xFu; }
#define XB_SPIN(cond, bar) do { unsigned _sp = 0; while (cond) { __builtin_amdgcn_s_sleep(1); \
    if ((++_sp & 255u) == 0u) { if (xb_ld(&(bar)[XB_TMO])) break; if (_sp > XB_SPIN_CAP) { atomicAdd(&(bar)[XB_TMO], 1u); break; } } } } while (0)
struct XcdBarrier { unsigned* bar; unsigned x; volatile LAS unsigned* st; };
__device__ __forceinline__ XcdBarrier xcd_barrier_post(unsigned* bar, volatile LAS unsigned* st) {
    XcdBarrier b; b.bar = bar; b.x = xb_xcc_id(); b.st = st;
    if (threadIdx.x == 0) (void)xb_add(&bar[XB_XCNT(b.x)], 1u);
    return b;
}
__device__ __forceinline__ void xcd_barrier_complete(unsigned* bar, unsigned x, unsigned& nloc, unsigned& nx) {
    const unsigned G = gridDim.x * gridDim.y * gridDim.z;
    unsigned sum, cnt, mine, sp = 0u;
    for (;;) {
        sum = 0u; cnt = 0u; mine = 0u;
#pragma unroll
        for (unsigned j = 0; j < 16; ++j) { const unsigned c = xb_ld(&bar[XB_XCNT(j)]); sum += c; cnt += (c > 0u) ? 1u : 0u; mine = (j == x) ? c : mine; }
        if (sum == G) break;
        __builtin_amdgcn_s_sleep(1);
        if ((++sp & 255u) == 0u) { if (xb_ld(&bar[XB_TMO])) break; if (sp > XB_SPIN_CAP) { atomicAdd(&bar[XB_TMO], 1u); break; } }
    }
    nloc = mine > 0u ? mine : 1u; nx = cnt > 0u ? cnt : 1u;
}
__device__ __forceinline__ void xcd_barrier(const XcdBarrier& b) {
    asm volatile("s_waitcnt vmcnt(0)" ::: "memory");
    __syncthreads();
    if (threadIdx.x == 0) {
        unsigned* bar = b.bar;
        __builtin_amdgcn_s_waitcnt(0);
        unsigned nloc = b.st[0], nx = b.st[1];
        if (nloc == 0u) { xcd_barrier_complete(bar, b.x, nloc, nx); b.st[0] = nloc; b.st[1] = nx; }
        const unsigned old = xb_add(&bar[XB_XSUB(b.x)], 1u);
        const unsigned gen = old / nloc;
        if (old + 1u == (gen + 1u) * nloc) {
            __builtin_amdgcn_fence(__ATOMIC_RELEASE, "agent");
            asm volatile("s_waitcnt vmcnt(0)" ::: "memory");
            const unsigned og = xb_add(&bar[XB_TOP], 1u);
            const unsigned tg = og / nx;
            if (og + 1u == (tg + 1u) * nx) xb_add(&bar[XB_TOPGEN], 1u);
            else XB_SPIN(xb_ld(&bar[XB_TOPGEN]) == tg, bar);
            __builtin_amdgcn_fence(__ATOMIC_ACQUIRE, "agent");
            xb_add(&bar[XB_XGEN(b.x)], 1u);
            asm volatile("s_waitcnt vmcnt(0)" ::: "memory");
        } else {
            XB_SPIN(xb_ld(&bar[XB_XGEN(b.x)]) == gen, bar);
            __builtin_amdgcn_fence(__ATOMIC_ACQUIRE, "agent");
            asm volatile("s_waitcnt vmcnt(0)" ::: "memory");
        }
    }
    __syncthreads();
}
constexpr int MISC_OFF = 131072 + 320;
constexpr int CW_BAR = 4096;

#ifndef PROBE_DUP
#define PROBE_DUP 0
#endif
#if ONE_LAUNCH
template <int PH> __device__ __forceinline__ void phase_body(Ctx& C) {
    constexpr int i = (PH - 2) / 7, sub = (PH - 2) % 7, j = i >> 1; constexpr bool conv = (i & 1) == 0;
    if (PH == 0) phase_p0(C);
    else if (PH == 1) phase_p1(C);
    else if (PH == 30) phase_final(C);
    else if (sub == 1) { if (i > 0) { prep_layer(C, i, 2, 0); __syncthreads(); } if (conv) dwconv_phase(C, j); else ugemm_phase(C, j); }
    else if (sub == 2) prefix_phase(C, j);
    else if (sub == 3) readout_phase(C, j, i == DEPTH - 1);
    else run_phase<(sub == 0 ? (conv ? 0 : 1) : (sub == 5 ? 2 : 3))>(C, PH);
}
template <int PH> __device__ __forceinline__ void one_phase(Ctx& C, const Args& args, const XcdBarrier& bar) {
    constexpr int i = (PH - 2) / 7, sub = (PH - 2) % 7; constexpr bool conv = (i & 1) == 0;
    if (PH >= 2 && PH < 30) { if ((sub == 2 || sub == 3) && conv) return; }
    if (PH > 0) xcd_barrier(bar);
    relane(C);
    phase_body<PH>(C);
    constexpr bool dup = ((PH >= 2 && PH < 30) && (((PROBE_DUP & 1) && (sub == 0 || sub == 5)) || ((PROBE_DUP & 2) && sub == 1 && !conv) || ((PROBE_DUP & 4) && sub == 1 && conv))) || ((PROBE_DUP & 16) && PH < 2);
    if constexpr (dup) { xcd_barrier(bar); phase_body<PH>(C); }
}
template <int... PHS> __device__ __forceinline__ void all_phases(Ctx& C, const Args& args, const XcdBarrier& bar, std::integer_sequence<int, PHS...>) { (one_phase<PHS>(C, args, bar), ...); }
__global__ void __launch_bounds__(512, 2) mega_kernel(Args args) {
    extern __shared__ __attribute__((aligned(16))) unsigned char lds_raw[];
    Ctx C;
    C.lds = (LAS unsigned char*)lds_raw; C.tid = threadIdx.x; C.lane = C.tid & 63; C.wave = __builtin_amdgcn_readfirstlane(C.tid >> 6); C.G = gridDim.x; C.bid = blockIdx.x;
    C.in = args.in; C.out = args.out; C.ws = args.ws;
    volatile LAS unsigned* MISC = (volatile LAS unsigned*)(C.lds + MISC_OFF);
    if (C.tid < 32) MISC[C.tid] = 0u;
    __syncthreads();
    XcdBarrier bar = xcd_barrier_post((unsigned*)(C.ws + WS_CTL) + CW_BAR, MISC + 8);
    all_phases(C, args, bar, std::make_integer_sequence<int, NPHASE>{});
}

#endif
#if !ONE_LAUNCH
template <int KIND>
__global__ void __launch_bounds__(512, 2) phase_kernel(Args args) {
    extern __shared__ __attribute__((aligned(16))) unsigned char lds_raw[];
    Ctx C;
    C.lds = (LAS unsigned char*)lds_raw; C.tid = threadIdx.x; C.lane = C.tid & 63; C.wave = __builtin_amdgcn_readfirstlane(C.tid >> 6); C.G = gridDim.x; C.bid = blockIdx.x;
    C.in = args.in; C.out = args.out; C.ws = args.ws;
    const int ph = args.ph_lo;
    if (KIND == 0) phase_p0(C);
    else if (KIND == 1) phase_p1(C);
    else if (KIND == 30) phase_final(C);
    else {
        const int i = (ph - 2) / 7, j = i >> 1; const bool conv = (i & 1) == 0;
        if (KIND == 2) prefix_phase(C, j);
        else if (KIND == 4) { if (i > 0) { prep_layer(C, i, 2, 0); __syncthreads(); } if (conv) dwconv_phase(C, j); else ugemm_phase(C, j); }
        else if (KIND == 5) readout_phase(C, j, i == DEPTH - 1);
        else if (KIND == 31) run_phase<0>(C, ph);
        else if (KIND == 32) run_phase<1>(C, ph);
        else if (KIND == 33) run_phase<2>(C, ph);
        else run_phase<3>(C, ph);
    }
}

#endif
#ifndef PROBE_RD
#define PROBE_RD 0
#endif
#if PROBE_RD
__global__ void __launch_bounds__(512, 2) probe_read_kernel(Args args) {
    extern __shared__ __attribute__((aligned(16))) unsigned char lds_raw[];
    Ctx C;
    C.lds = (LAS unsigned char*)lds_raw; C.tid = threadIdx.x; C.lane = C.tid & 63; C.wave = __builtin_amdgcn_readfirstlane(C.tid >> 6); C.G = gridDim.x; C.bid = blockIdx.x;
    C.in = args.in; C.out = args.out; C.ws = args.ws;
    readout_phase<PROBE_RD>(C, 1, true);
}
#endif
extern "C" void kernel_launch(void* const* d_in, const int* in_sizes, int n_in, void* d_out, int out_size, void* d_ws, size_t ws_size, hipStream_t stream) {
    static int grid = 0;
    if (grid == 0) {
        if (n_in != 22 || out_size != T * D || ws_size < WS_END + (PROBE_RD ? 20 * MiB : 0)) { fprintf(stderr, "kernel_launch: unexpected problem (n_in %d out %d ws %zu, need %zu)\n", n_in, out_size, ws_size, (size_t)WS_END); grid = -1; return; }
        int dev = 0, cus = 0;
        if (hipGetDevice(&dev) != hipSuccess || hipDeviceGetAttribute(&cus, hipDeviceAttributeMultiprocessorCount, dev) != hipSuccess) { grid = -1; return; }
        bool ok = true;
#if !ONE_LAUNCH
        ok &= hipFuncSetAttribute((const void*)phase_kernel<0>, hipFuncAttributeMaxDynamicSharedMemorySize, LDS_BYTES) == hipSuccess;
        ok &= hipFuncSetAttribute((const void*)phase_kernel<1>, hipFuncAttributeMaxDynamicSharedMemorySize, LDS_BYTES) == hipSuccess;
        ok &= hipFuncSetAttribute((const void*)phase_kernel<2>, hipFuncAttributeMaxDynamicSharedMemorySize, LDS_BYTES) == hipSuccess;
        ok &= hipFuncSetAttribute((const void*)phase_kernel<31>, hipFuncAttributeMaxDynamicSharedMemorySize, LDS_BYTES) == hipSuccess;
        ok &= hipFuncSetAttribute((const void*)phase_kernel<32>, hipFuncAttributeMaxDynamicSharedMemorySize, LDS_BYTES) == hipSuccess;
        ok &= hipFuncSetAttribute((const void*)phase_kernel<33>, hipFuncAttributeMaxDynamicSharedMemorySize, LDS_BYTES) == hipSuccess;
        ok &= hipFuncSetAttribute((const void*)phase_kernel<34>, hipFuncAttributeMaxDynamicSharedMemorySize, LDS_BYTES) == hipSuccess;
        ok &= hipFuncSetAttribute((const void*)phase_kernel<4>, hipFuncAttributeMaxDynamicSharedMemorySize, LDS_BYTES) == hipSuccess;
        ok &= hipFuncSetAttribute((const void*)phase_kernel<5>, hipFuncAttributeMaxDynamicSharedMemorySize, LDS_BYTES) == hipSuccess;
        ok &= hipFuncSetAttribute((const void*)phase_kernel<30>, hipFuncAttributeMaxDynamicSharedMemorySize, LDS_BYTES) == hipSuccess;
#endif
#if ONE_LAUNCH
        ok &= hipFuncSetAttribute((const void*)mega_kernel, hipFuncAttributeMaxDynamicSharedMemorySize, LDS_BYTES) == hipSuccess;
#endif
        if (!ok) { fprintf(stderr, "kernel_launch: hipFuncSetAttribute failed\n"); grid = -1; return; }
        grid = cus > 0 ? cus : 256;
    }
    if (grid < 0) return;
    Args a{};
    for (int i = 0; i < 22; ++i) a.in[i] = (const float*)d_in[i];
    a.out = (float*)d_out; a.ws = (unsigned char*)d_ws;
#if ONE_LAUNCH
    if (hipMemsetAsync((char*)d_ws + WS_CTL, 0, 65536, stream) != hipSuccess) { fprintf(stderr, "kernel_launch: memset failed\n"); return; }
    a.ph_lo = 0; a.ph_hi = NPHASE;
    hipLaunchKernelGGL(mega_kernel, dim3(grid), dim3(512), LDS_BYTES, stream, a);
    return;
#endif
#if !ONE_LAUNCH
    for (int ph = 0; ph < NPHASE; ++ph) {
        const int i = (ph - 2) / 7, sub = (ph - 2) % 7;
        if (ph >= 2 && ph < 30) { if ((sub == 2 || sub == 3) && (i & 1) == 0) continue; }
        a.ph_lo = ph; a.ph_hi = ph + 1;
        const dim3 g(grid), b(512);
        if (ph == 0) hipLaunchKernelGGL(phase_kernel<0>, g, b, LDS_BYTES, stream, a);
        else if (ph == 1) hipLaunchKernelGGL(phase_kernel<1>, g, b, LDS_BYTES, stream, a);
        else if (ph == 30) hipLaunchKernelGGL(phase_kernel<30>, g, b, LDS_BYTES, stream, a);
        else if (sub == 2) hipLaunchKernelGGL(phase_kernel<2>, g, b, LDS_BYTES, stream, a);
        else if (sub == 1) hipLaunchKernelGGL(phase_kernel<4>, g, b, LDS_BYTES, stream, a);
        else if (sub == 3) hipLaunchKernelGGL(phase_kernel<5>, g, b, LDS_BYTES, stream, a);
        else { const bool cv_ = (i & 1) == 0; if (sub == 0) { if (cv_) hipLaunchKernelGGL(phase_kernel<31>, g, b, LDS_BYTES, stream, a); else hipLaunchKernelGGL(phase_kernel<32>, g, b, LDS_BYTES, stream, a); }
               else if (sub == 5) hipLaunchKernelGGL(phase_kernel<33>, g, b, LDS_BYTES, stream, a); else hipLaunchKernelGGL(phase_kernel<34>, g, b, LDS_BYTES, stream, a); }
#ifdef PROBE_G
        if (ph == 30) { Args a2 = a; a2.ph_lo = PROBE_G; a2.ph_hi = PROBE_G + 1; const int i2 = (PROBE_G - 2) / 7, s2 = (PROBE_G - 2) % 7;
            if (s2 == 0 && (i2 & 1) == 0) hipLaunchKernelGGL(phase_kernel<31>, g, b, LDS_BYTES, stream, a2); else if (s2 == 0) hipLaunchKernelGGL(phase_kernel<32>, g, b, LDS_BYTES, stream, a2); else hipLaunchKernelGGL(phase_kernel<33>, g, b, LDS_BYTES, stream, a2); }
#endif
#if PROBE_RD
        if (ph == 30) { hipFuncSetAttribute((const void*)probe_read_kernel, hipFuncAttributeMaxDynamicSharedMemorySize, LDS_BYTES); hipLaunchKernelGGL(probe_read_kernel, g, b, LDS_BYTES, stream, a); }
#endif
        {   const bool conv = (i & 1) == 0;
            const bool dup = ((ph >= 2 && ph < 30) && (((PROBE_DUP & 32) && sub == 0 && conv) || ((PROBE_DUP & 64) && sub == 0 && !conv) || ((PROBE_DUP & 128) && sub == 5) || ((PROBE_DUP & 1) && (sub == 0 || sub == 5)) || ((PROBE_DUP & 2) && sub == 1 && !conv) || ((PROBE_DUP & 4) && sub == 1 && conv))) || ((PROBE_DUP & 16) && ph < 2);
            if (dup) {
                if (ph == 0) hipLaunchKernelGGL(phase_kernel<0>, g, b, LDS_BYTES, stream, a);
                else if (ph == 1) hipLaunchKernelGGL(phase_kernel<1>, g, b, LDS_BYTES, stream, a);
                else if (sub == 2) hipLaunchKernelGGL(phase_kernel<2>, g, b, LDS_BYTES, stream, a);
                else if (sub == 1) hipLaunchKernelGGL(phase_kernel<4>, g, b, LDS_BYTES, stream, a);
                else if (sub == 0 && conv) hipLaunchKernelGGL(phase_kernel<31>, g, b, LDS_BYTES, stream, a);
                else if (sub == 0) hipLaunchKernelGGL(phase_kernel<32>, g, b, LDS_BYTES, stream, a);
                else hipLaunchKernelGGL(phase_kernel<33>, g, b, LDS_BYTES, stream, a);
            } }
    }
#endif
}
```

```cpp
#include <hip/hip_runtime.h>
#include <cstdio>
#include <cstdint>
#include <utility>

#ifndef ONE_LAUNCH
#define ONE_LAUNCH 1
#endif

typedef unsigned short bf16_t;
typedef short bf16x8 __attribute__((ext_vector_type(8)));
typedef float f32x4 __attribute__((ext_vector_type(4)));
typedef float f32x2 __attribute__((ext_vector_type(2)));
typedef unsigned u32x2 __attribute__((ext_vector_type(2)));
typedef unsigned u32x4 __attribute__((ext_vector_type(4)));
typedef __bf16 bf16x2_t __attribute__((ext_vector_type(2)));
typedef short s16x4 __attribute__((ext_vector_type(4)));
#define LAS __attribute__((address_space(3)))

constexpr int D = 1024, T = 16384, TC = 256, R = T + TC, NH = 4, DK = 256, DV = 512, QKW = 1024, VW = 2048, INW = 8192, DFF = 2816, FF2 = 5632, CK = 31, DEPTH = 4;
constexpr int NSLOT = 33;
constexpr float NORM_EPS = 1e-6f, LN_EPS = 1e-5f;

constexpr size_t MiB = 1u << 20, KiB = 1u << 10;
constexpr size_t WS_CTL = 0, CTL_ZERO_BYTES = 1 * MiB;
constexpr size_t WS_MODV = 1 * MiB;
constexpr size_t WS_S1 = 1 * MiB + 256 * KiB;
constexpr size_t WS_S2 = 1 * MiB + 320 * KiB;
constexpr size_t WS_CVA = 1 * MiB + 384 * KiB;
constexpr size_t WS_CVF = 1 * MiB + 640 * KiB;
constexpr size_t WS_TABC = 1 * MiB + 832 * KiB;
constexpr size_t WS_TABS = 1 * MiB + 912 * KiB;
constexpr size_t WS_STATS = 2 * MiB;
constexpr size_t WS_XCTX = 4 * MiB;
constexpr size_t WS_WA = 8 * MiB;
constexpr size_t WS_WA2 = 24 * MiB;
constexpr size_t WS_WF1 = 28 * MiB;
constexpr size_t WS_WF2 = 40 * MiB;
constexpr size_t WS_XS = 48 * MiB;
constexpr size_t WS_SCP = 48 * MiB;
constexpr size_t WS_BIG = 114 * MiB;
constexpr size_t WS_Q = WS_BIG, WS_K = WS_BIG + 33 * MiB, WS_VT = WS_BIG + 66 * MiB, WS_GF = WS_BIG + 131 * MiB, WS_GB = WS_BIG + 196 * MiB;
constexpr size_t WS_U = WS_BIG, WS_A2 = WS_BIG + 33 * MiB, WS_H = WS_BIG;
constexpr size_t WS_END = WS_BIG + 261 * MiB;
static_assert((size_t)R * 1024 * 2 <= 33 * MiB && (size_t)R * 2048 * 2 <= 65 * MiB && (size_t)R * DFF * 2 <= 131 * MiB, "map");
static_assert((size_t)NSLOT * 8 * 512 * 256 * 2 <= 66 * MiB, "scp");

constexpr int LDS_BYTES = 147456;

__device__ __forceinline__ unsigned pk2(float lo, float hi) { f32x2 v = {lo, hi}; bf16x2_t b = __builtin_convertvector(v, bf16x2_t); return __builtin_bit_cast(unsigned, b); }
__device__ __forceinline__ float bflo(unsigned u) { return __uint_as_float(u << 16); }
__device__ __forceinline__ float bfhi(unsigned u) { return __uint_as_float(u & 0xffff0000u); }
__device__ __forceinline__ float sigmf(float x) { return __builtin_amdgcn_rcpf(1.f + __builtin_amdgcn_exp2f(-1.4426950408889634f * x)); }
__device__ __forceinline__ float siluf(float x) { return x * sigmf(x); }
__device__ __forceinline__ float wave_sum63(float v) {
    v += __builtin_bit_cast(float, __builtin_amdgcn_update_dpp(0, __builtin_bit_cast(int, v), 0xB1, 0xF, 0xF, false));
    v += __builtin_bit_cast(float, __builtin_amdgcn_update_dpp(0, __builtin_bit_cast(int, v), 0x4E, 0xF, 0xF, false));
    v += __builtin_bit_cast(float, __builtin_amdgcn_update_dpp(0, __builtin_bit_cast(int, v), 0x141, 0xF, 0xF, false));
    v += __builtin_bit_cast(float, __builtin_amdgcn_update_dpp(0, __builtin_bit_cast(int, v), 0x140, 0xF, 0xF, false));
    v += __builtin_bit_cast(float, __builtin_amdgcn_update_dpp(0, __builtin_bit_cast(int, v), 0x142, 0xA, 0xF, false));
    v += __builtin_bit_cast(float, __builtin_amdgcn_update_dpp(0, __builtin_bit_cast(int, v), 0x143, 0xC, 0xF, false));
    return v;
}
__device__ __forceinline__ int perm_glu(int n, int H) { const int g = n >= H ? 16 : 0, oc = n >= H ? n - H : n; return 256 * (oc >> 7) + 128 * ((oc >> 2) & 1) + 32 * ((oc >> 5) & 3) + 4 * ((oc >> 3) & 3) + (oc & 3) + g; }
__device__ __forceinline__ int perm_win(int n) {
    if (n >= 4 * QKW) { const int c = n & 31; return (n & ~31) + 16 * ((c >> 2) & 1) + 4 * (c >> 3) + (c & 3); }
    if (n >= 2 * QKW) return n;
    const int part = n >> 10, hn = n & 1023, h = hn >> 8, d = hn & 255, quarter = d >> 6, idx = d & 63;
    const int Gp = (quarter >> 1) * 4 + (idx >> 4), i = (quarter & 1) * 16 + (idx & 15);
    return part * 1024 + h * 256 + 32 * Gp + i;
}
__device__ __forceinline__ int perm_any(int mode, int n, int H) { return mode == 0 ? n : (mode == 1 ? perm_glu(n, H) : perm_win(n)); }

struct Args { const float* in[22]; float* out; unsigned char* ws; int ph_lo, ph_hi; };

struct Ctx {
    LAS unsigned char* lds;
    int tid, lane, wave, G, bid;
    const float* const* in; float* out; unsigned char* ws;
};

__device__ __forceinline__ void relane(Ctx& C) {
    int wv = C.wave; asm volatile("" : "+s"(wv)); int ln = (int)__builtin_amdgcn_mbcnt_hi(~0u, __builtin_amdgcn_mbcnt_lo(~0u, 0u)); asm volatile("" : "+v"(ln));
    int bd = C.bid, gg = C.G; asm volatile("" : "+s"(bd), "+s"(gg));
    C.wave = wv; C.lane = ln; C.tid = wv * 64 + ln; C.bid = bd; C.G = gg;
}
template <int VSILU, bool NTL = true  >
__device__ __forceinline__ void gemv2_unit(Ctx& C, const float* W, int N, int n0, const float* v0, const float* v1, const float* bias, float* o0, float* o1, int pmode, int H) {
    LAS float* red = (LAS float*)C.lds;
    const int c4 = C.tid & 15, ks = C.tid >> 4;
    f32x4 a0 = {0.f, 0.f, 0.f, 0.f}, a1 = {0.f, 0.f, 0.f, 0.f};
#pragma unroll 8
    for (int i = 0; i < 32; ++i) {
        const int k = ks * 32 + i;
        const f32x4 w = NTL ? __builtin_nontemporal_load((const f32x4*)(W + (size_t)k * N + n0 + 4 * c4)) : *(const f32x4*)(W + (size_t)k * N + n0 + 4 * c4);
        float x0 = v0[k], x1 = v1[k];
        if (VSILU) { x0 = siluf(x0); x1 = siluf(x1); }
        a0 += w * x0; a1 += w * x1;
    }
#pragma unroll
    for (int e = 0; e < 4; ++e) { red[(ks * 2 + 0) * 64 + 4 * c4 + e] = a0[e]; red[(ks * 2 + 1) * 64 + 4 * c4 + e] = a1[e]; }
    __syncthreads();
    if (C.tid < 128) {
        const int s = C.tid >> 6, col = C.tid & 63; float sum = 0.f;
#pragma unroll 8
        for (int k2 = 0; k2 < 32; ++k2) sum += red[(k2 * 2 + s) * 64 + col];
        const int n = n0 + col; if (bias) sum += bias[n];
        (s ? o1 : o0)[perm_any(pmode, n, H)] = sum;
    }
    __syncthreads();
}

struct PrepItem { const float* W; bf16_t* WT; const float* sg; const float* sm; int K, N, pmode, H, k0, n0; };
__device__ __forceinline__ bool prep_decode(Ctx& C, int i, int part, int it, PrepItem& P) {
    const int j = i >> 1; const bool conv = (i & 1) == 0;
    const int I_A = (part & 1) ? (conv ? 16 * 64 : 16 * 256) : 0, I_A2 = (part & 4) ? (conv ? 16 * 32 : 32 * 32) : 0, I_F1 = (part & 2) ? 16 * 176 : 0, I_F2 = (part & 2) ? 44 * 32 : 0;
    if (it >= I_A + I_A2 + I_F1 + I_F2) return false;
    int r = it; P.sg = nullptr; P.sm = nullptr;
    if (r < I_A) { if (conv) { P.W = C.in[8] + (size_t)j * 1024 * 2048; P.K = 1024; P.N = 2048; P.pmode = 1; P.H = 1024; } else { P.W = C.in[16] + (size_t)j * 1024 * 8192; P.K = 1024; P.N = 8192; P.pmode = 2; P.H = 0; }
                   P.WT = (bf16_t*)(C.ws + WS_WA); P.sg = C.in[6] + i * 1024; P.sm = (const float*)(C.ws + WS_MODV) + (i * 2) * 6144 + 1024; }
    else if ((r -= I_A) < I_A2) { if (conv) { P.W = C.in[14] + (size_t)j * 1024 * 1024; P.K = 1024; } else { P.W = C.in[18] + (size_t)j * 2048 * 1024; P.K = 2048; }
                   P.N = 1024; P.pmode = 0; P.H = 0; P.WT = (bf16_t*)(C.ws + WS_WA2); }
    else if ((r -= I_A2) < I_F1) { P.W = C.in[19] + (size_t)i * 1024 * FF2; P.K = 1024; P.N = FF2; P.pmode = 1; P.H = DFF; P.WT = (bf16_t*)(C.ws + WS_WF1); P.sg = C.in[7] + i * 1024; P.sm = (const float*)(C.ws + WS_MODV) + (i * 2) * 6144 + 4096; }
    else { r -= I_F1; P.W = C.in[20] + (size_t)i * DFF * 1024; P.K = DFF; P.N = 1024; P.pmode = 0; P.H = 0; P.WT = (bf16_t*)(C.ws + WS_WF2); }
    const int nblk = P.N / 32; P.k0 = 64 * (r / nblk); P.n0 = 32 * (r % nblk);
    return true;
}
__device__ __forceinline__ void prep_layer(Ctx& C, int i, int part, int cu_lo) {
    if (C.bid < cu_lo) return;
    LAS float* scr = (LAS float*)(C.lds + C.wave * 16384);
    const int gw = (C.bid - cu_lo) * 8 + C.wave, NGW = (C.G - cu_lo) * 8, lane = C.lane;
    PrepItem P, Pn; f32x4 v[8], vn[8]; float sk[8], skn[8];
    bool have = prep_decode(C, i, part, gw, P);
    if (have) {
#pragma unroll
        for (int q = 0; q < 8; ++q) { const int k = P.k0 + 8 * q + (lane >> 3); v[q] = __builtin_nontemporal_load((const f32x4*)(P.W + (size_t)k * P.N + P.n0 + 4 * (lane & 7))); sk[q] = P.sg ? P.sg[k] * (1.f + P.sm[k]) : 1.f; }
    }
    for (int it = gw; have; it += NGW) {
        const bool havn = prep_decode(C, i, part, it + NGW, Pn);
        if (havn) {
#pragma unroll
            for (int q = 0; q < 8; ++q) { const int k = Pn.k0 + 8 * q + (lane >> 3); vn[q] = __builtin_nontemporal_load((const f32x4*)(Pn.W + (size_t)k * Pn.N + Pn.n0 + 4 * (lane & 7))); skn[q] = Pn.sg ? Pn.sg[k] * (1.f + Pn.sm[k]) : 1.f; }
        }
#pragma unroll
        for (int q = 0; q < 8; ++q) { LAS float* d = scr + (8 * q + (lane >> 3)) * 33 + 4 * (lane & 7); d[0] = v[q][0] * sk[q]; d[1] = v[q][1] * sk[q]; d[2] = v[q][2] * sk[q]; d[3] = v[q][3] * sk[q]; }
        asm volatile("s_waitcnt lgkmcnt(0)" ::: "memory");
        const int c = lane & 7;
        const int rA = P.pmode ? 32 * (c >> 2) + 4 * (c & 3) : 8 * c, rB = P.pmode ? rA + 16 : rA + 4;
#pragma unroll
        for (int jj = 0; jj < 4; ++jj) { const int n = (lane >> 3) + 8 * jj; const LAS float* sp = scr + rA * 33 + n; const LAS float* sq = scr + rB * 33 + n;
            u32x4 o; o.x = pk2(sp[0 * 33], sp[1 * 33]); o.y = pk2(sp[2 * 33], sp[3 * 33]); o.z = pk2(sq[0 * 33], sq[1 * 33]); o.w = pk2(sq[2 * 33], sq[3 * 33]);
            *(u32x4*)(P.WT + (size_t)perm_any(P.pmode, P.n0 + n, P.H) * P.K + P.k0 + 8 * c) = o; }
        asm volatile("s_waitcnt lgkmcnt(0)" ::: "memory");
        P = Pn; have = havn;
#pragma unroll
        for (int q = 0; q < 8; ++q) { v[q] = vn[q]; sk[q] = skn[q]; }
    }
}

__device__ __forceinline__ float row_rs(const float* stats, int row, int fq) {
    const f32x4 p = *(const f32x4*)(stats + (size_t)row * 16 + 4 * fq);
    float s = (p[0] + p[1]) + (p[2] + p[3]);
    s += __shfl_xor(s, 16); s += __shfl_xor(s, 32);
    return __builtin_amdgcn_rsqf(s * (1.0f / 1024.0f) + NORM_EPS);
}
struct EpiGLU {
    static constexpr bool STATS = false, NEEDRS = true, PAIR2 = true, CVPRE = false;
    unsigned char* ws; int cvoff  , cvstride  , outoff  , ldo, act;
    float* stats;
    __device__ __forceinline__ float row_begin(int row, int fq) const { return row_rs((const float*)(ws + WS_STATS), row, fq); }
    __device__ __forceinline__ float item(int row, int colp, f32x4 v0, f32x4 v1, float rs) const {
        const float* cv = (const float*)ws + cvoff + (row < T ? 0 : cvstride);
        const f32x4 ca = *(const f32x4*)(cv + colp), cg = *(const f32x4*)(cv + colp + 16);
        float o[4];
#pragma unroll
        for (int e = 0; e < 4; ++e) { const float a = rs * v0[e] + ca[e], g = rs * v1[e] + cg[e]; o[e] = act == 0 ? a * sigmf(g) : siluf(a) * g; }
        const int oc = 128 * (colp >> 8) + 32 * ((colp >> 5) & 3) + 8 * ((colp >> 2) & 3) + 4 * ((colp >> 7) & 1);
        u32x2 w; w.x = pk2(o[0], o[1]); w.y = pk2(o[2], o[3]);
        *(u32x2*)((bf16_t*)(ws + outoff) + (size_t)row * ldo + oc) = w;
        return 0.f;
    }
    struct CV { f32x4 ca0, cg0, ca1, cg1; };
    __device__ __forceinline__ CV load_cv(int row, int colp) const {
        const float* cv = (const float*)ws + cvoff + (row < T ? 0 : cvstride);
        return CV{*(const f32x4*)(cv + colp), *(const f32x4*)(cv + colp + 16), *(const f32x4*)(cv + colp + 128), *(const f32x4*)(cv + colp + 144)};
    }
    __device__ __forceinline__ void item2(int row, int colp, f32x4 a0, f32x4 g0, f32x4 a1, f32x4 g1, float rs, const CV& cvv) const {
        const f32x4 ca0 = cvv.ca0, cg0 = cvv.cg0, ca1 = cvv.ca1, cg1 = cvv.cg1;
        float o[8];
#pragma unroll
        for (int e = 0; e < 4; ++e) { const float a = rs * a0[e] + ca0[e], g = rs * g0[e] + cg0[e]; o[e] = act == 0 ? a * sigmf(g) : siluf(a) * g;
                                      const float b = rs * a1[e] + ca1[e], h = rs * g1[e] + cg1[e]; o[4 + e] = act == 0 ? b * sigmf(h) : siluf(b) * h; }
        const int oc = 128 * (colp >> 8) + 32 * ((colp >> 5) & 3) + 8 * ((colp >> 2) & 3);
        u32x4 w; w.x = pk2(o[0], o[1]); w.y = pk2(o[2], o[3]); w.z = pk2(o[4], o[5]); w.w = pk2(o[6], o[7]);
        *(u32x4*)((bf16_t*)(ws + outoff) + (size_t)row * ldo + oc) = w;
    }
};
struct EpiRes {
    static constexpr bool STATS = true, NEEDRS = false, PAIR2 = false, CVPRE = false;
    unsigned char* ws; bf16_t* xb  ; float* xl; const float* xin  ; const float* cin  ; const float* bias;
    int mgoff  , snoff  ;
    float* stats;
    __device__ __forceinline__ float row_begin(int, int) const { return 1.f; }
    __device__ __forceinline__ float item(int row, int colp, f32x4 v0, f32x4 v1, float) const {
        const bool lat = row < T;
        float* xr = lat ? xl + (size_t)row * 1024 : (float*)(ws + WS_XCTX) + (size_t)(row - T) * 1024;
        const float* xi = lat ? xin + (size_t)row * 1024 : cin + (size_t)(row - T) * 1024;
        const float* mg = (const float*)ws + mgoff + (lat ? 0 : 6144); const float* sn = (const float*)ws + snoff + (lat ? 0 : 1024);
        bf16_t* xs = xb;
        float ss = 0.f; u32x4 w;
#pragma unroll
        for (int hlf = 0; hlf < 2; ++hlf) {
            const int c = colp + 16 * hlf; const f32x4 v = hlf ? v1 : v0;
            const f32x4 xo = *(const f32x4*)(xi + c), m4 = *(const f32x4*)(mg + c);
            f32x4 b4 = {0.f, 0.f, 0.f, 0.f}; if (bias) b4 = *(const f32x4*)(bias + c);
            const f32x4 xn = xo + m4 * (v + b4);
            *(f32x4*)(xr + c) = xn;
            ss += (xn[0] * xn[0] + xn[1] * xn[1]) + (xn[2] * xn[2] + xn[3] * xn[3]);
            if (snoff >= 0) { const f32x4 s4 = *(const f32x4*)(sn + c); const unsigned p0 = pk2(xn[0] * s4[0], xn[1] * s4[1]), p1 = pk2(xn[2] * s4[2], xn[3] * s4[3]); if (hlf) { w.z = p0; w.w = p1; } else { w.x = p0; w.y = p1; } }
        }
        if (snoff >= 0) *(u32x4*)(xs + (size_t)row * 1024 + (colp & ~31) + 2 * (colp & 31)) = w;
        return ss;
    }
};
struct EpiWin {
    static constexpr bool STATS = false, NEEDRS = true, PAIR2 = false, CVPRE = true;
    unsigned char* ws; int cvoff;
    float* stats;
    __device__ __forceinline__ float row_begin(int row, int fq) const { return row_rs((const float*)(ws + WS_STATS), row, fq); }
    __device__ __forceinline__ float item(int row, int colp, f32x4 v0, f32x4 v1, float rs) const {
        const float* cv = (const float*)ws + cvoff + (row < T ? 0 : 8192);
        return item_cv(row, colp, v0, v1, rs, *(const f32x4*)(cv + colp), *(const f32x4*)(cv + colp + 16));
    }
    struct CVW { f32x4 c[2][2]; };
    __device__ __forceinline__ CVW load_cvw(int row, int colp) const {
        const float* cv = (const float*)ws + cvoff + (row < T ? 0 : 8192);
        return CVW{{{*(const f32x4*)(cv + colp), *(const f32x4*)(cv + colp + 16)}, {*(const f32x4*)(cv + colp + 128), *(const f32x4*)(cv + colp + 144)}}};
    }
    __device__ __forceinline__ float item_cv(int row, int colp, f32x4 v0, f32x4 v1, float rs, f32x4 c0, f32x4 c1) const {
        f32x4 a = v0 * rs + c0, b = v1 * rs + c1;
        if (colp < 2048) {
            if (row < T) {
                const int Gp = (colp >> 5) & 7, idx0 = 16 * (Gp & 3) + (colp & 15);
                const int ti = (Gp >> 2) ? 256 + (row & 63) : (row >> 6);
                const f32x4 cs = *(const f32x4*)((const float*)(ws + WS_TABC) + ti * 64 + idx0), sn = *(const f32x4*)((const float*)(ws + WS_TABS) + ti * 64 + idx0);
                const f32x4 o1 = a * cs - b * sn, o2 = b * cs + a * sn; a = o1; b = o2;
            }
            bf16_t* dst = (bf16_t*)(ws + WS_Q);
            if (colp >= 1024) { dst = (bf16_t*)(ws + WS_K); a = a * 0.0625f; b = b * 0.0625f; }
            const int cp = colp & 1023, c = (cp & ~31) + 2 * (cp & 31);
            u32x4 w; w.x = pk2(a[0], a[1]); w.y = pk2(a[2], a[3]); w.z = pk2(b[0], b[1]); w.w = pk2(b[2], b[3]); *(u32x4*)(dst + (size_t)row * 1024 + c) = w;
        } else if (colp < 4096) {
            const int c = colp - 2048;
            bf16_t* vt = (bf16_t*)(ws + WS_VT);
#pragma unroll
            for (int e = 0; e < 4; ++e) { vt[(size_t)(c + e) * R + row] = (bf16_t)(pk2(a[e], 0.f) & 0xffffu); vt[(size_t)(c + 16 + e) * R + row] = (bf16_t)(pk2(b[e], 0.f) & 0xffffu); }
        } else {
            bf16_t* dst = (bf16_t*)(ws + (colp < 6144 ? WS_GF : WS_GB)); const int cp = (colp - 4096) & 2047, c = (cp & ~31) + 2 * (cp & 31);
            u32x4 w; w.x = pk2(a[0], a[1]); w.y = pk2(a[2], a[3]); w.z = pk2(b[0], b[1]); w.w = pk2(b[2], b[3]); *(u32x4*)(dst + (size_t)row * 2048 + c) = w;
        }
        return 0.f;
    }
};

namespace pg8 {
#define PG8_LAS __attribute__((address_space(3)))
typedef unsigned short bf16_t;
typedef short bf16x8 __attribute__((ext_vector_type(8)));
typedef float f32x4 __attribute__((ext_vector_type(4)));
typedef unsigned u32x4 __attribute__((ext_vector_type(4)));
constexpr int BM = 256, BK = 64, HALF = 128, HTB = HALF * BK * 2  , STAGE_BYTES = 8 * HTB, NXCD = 8, WGM = 8;

__host__ __device__ __forceinline__ int lds_byte(int r, int c) { const int st = (r >> 4) * 2 + (c >> 5), rr = r & 15, cc = c & 31, ob = rr * 64 + cc * 2; return st * 1024 + (ob ^ (((ob >> 9) & 1) << 5)); }
__host__ __device__ __forceinline__ void stage_rc(int b, int& R, int& C) { const int st = b / 1024, sb = b % 1024, swz = sb ^ (((sb >> 9) & 1) << 5); R = (st >> 1) * 16 + swz / 64; C = (st & 1) * 32 + (swz % 64) / 2; }
__host__ __device__ __forceinline__ int perm32(int rho) { const int n = rho >> 4, i = rho & 15; return 8 * (i >> 2) + 4 * n + (i & 3); }

struct Unit { int pm, pn; };
struct Gemm { const bf16_t* A; const bf16_t* Bt; int M, N, K; };

struct StaticOrder {
    int nM, nN, nwg, G, c;
    __host__ __device__ void init(int M, int N, int G_, int c_) { nM = M / BM; nN = N / BM; nwg = nM * nN; G = G_; c = c_; }
    __host__ __device__ bool next(int i, Unit& u) const {
        const long L = (long)i * G + c; if (L >= nwg) return false;
        int wgid = (int)L; { const int q = nwg / NXCD, r = nwg % NXCD, xcd = wgid % NXCD, off = wgid / NXCD; wgid = (xcd < r ? xcd * (q + 1) : r * (q + 1) + (xcd - r) * q) + off; }
        const int nig = WGM * nN, gid = wgid / nig, fm = gid * WGM, gsz = (nM - fm) < WGM ? (nM - fm) : WGM;
        u.pm = fm + ((wgid % nig) % gsz); u.pn = (wgid % nig) / gsz; return true;
    }
    __device__ __forceinline__ void a_ready(const Unit&) const {}
    __device__ __forceinline__ void done(const Unit&) const {}
};

template <class Epi, class Sched, bool ALIGN_EPI = false, bool SP2 = false, bool SWAPMMA = false, bool ROWPERM = false  >
__device__ __forceinline__ void gemm_phase(PG8_LAS unsigned char* lds, const Gemm g, const Sched& S, const Epi& E) {
    int tid = threadIdx.x; asm volatile("" : "+v"(tid));
    const int wid = __builtin_amdgcn_readfirstlane(tid >> 6), lane = tid & 63, wr = wid >> 2, wc = wid & 3, fr = lane & 15, fq = lane >> 4;
    const int K = g.K, nt = K / BK;
    unsigned voffA[2], voffB[2];
#pragma unroll
    for (int i = 0; i < 2; ++i) { int R, C; stage_rc(tid * 16 + i * 8192, R, C); const int Rb = Epi::PERM ? ((R & ~31) + perm32(R & 31)) : R;
        const int Ra = ROWPERM ? ((R & ~31) + 8 * ((R >> 2) & 3) + 4 * ((R >> 4) & 1) + (R & 3)) : R;
        voffA[i] = (unsigned)(Ra * K + C) * 2u; voffB[i] = (unsigned)(Rb * K + C) * 2u; }
    const size_t kstep = (size_t)(BK * 2);
    const size_t hstep = (size_t)HALF * K * 2;
    const size_t tstep = 2 * hstep;
    const unsigned ldsw = (unsigned)wid * 1024u;
    const int aoff = lds_byte(wr * 64 + fr, fq * 8), boff = lds_byte(wc * 32 + fr, fq * 8);
#define PG8_SA(b, h) (((b) * 2 + (h)) * HTB)
#define PG8_SB(b, h) ((4 + (b) * 2 + (h)) * HTB)
#define PG8_STAGE(bufoff, gbase, voff) do { _Pragma("unroll") for (int _i = 0; _i < 2; ++_i) \
        __builtin_amdgcn_global_load_lds((const unsigned*)((const char*)(gbase) + (voff)[_i]), (PG8_LAS unsigned*)(lds + (bufoff) + ldsw + _i * 8192), 16, 0, 0); } while (0)
#define PG8_LDA(dst, b, h) do { _Pragma("unroll") for (int m = 0; m < 4; ++m) _Pragma("unroll") for (int k = 0; k < 2; ++k) dst[m][k] = *(const PG8_LAS bf16x8*)(lds + PG8_SA(b, h) + aoff + m * 2048 + k * 1024); } while (0)
#define PG8_LDB(dst, b, h) do { _Pragma("unroll") for (int n = 0; n < 2; ++n) _Pragma("unroll") for (int k = 0; k < 2; ++k) dst[n][k] = *(const PG8_LAS bf16x8*)(lds + PG8_SB(b, h) + boff + n * 2048 + k * 1024); } while (0)
#define PG8_MMA(ai, bj, At, Bt) do { __builtin_amdgcn_s_setprio(1); _Pragma("unroll") for (int m = 0; m < 4; ++m) _Pragma("unroll") for (int n = 0; n < 2; ++n) _Pragma("unroll") for (int k = 0; k < 2; ++k) \
        acc[ai][bj][m][n] = SWAPMMA ? __builtin_amdgcn_mfma_f32_16x16x32_bf16(At[m][k], Bt[n][k], acc[ai][bj][m][n], 0, 0, 0) : __builtin_amdgcn_mfma_f32_16x16x32_bf16(Bt[n][k], At[m][k], acc[ai][bj][m][n], 0, 0, 0); __builtin_amdgcn_s_setprio(0); } while (0)
#define PG8_WAIT_V(n) asm volatile("s_waitcnt vmcnt(" #n ")" ::: "memory")
#define PG8_WAIT_L(n) asm volatile("s_waitcnt lgkmcnt(" #n ")" ::: "memory")
#define PG8_BAR __builtin_amdgcn_s_barrier()
#define PG8_SCHED __builtin_amdgcn_sched_barrier(0)
    Unit cur, nxt; int ui = 0;
    if (!S.next(0, cur)) return;
    f32x4 acc[2][2][4][2];
#pragma unroll
    for (int a = 0; a < 2; ++a)
#pragma unroll
        for (int b = 0; b < 2; ++b)
#pragma unroll
            for (int m = 0; m < 4; ++m)
#pragma unroll
                for (int n = 0; n < 2; ++n) acc[a][b][m][n] = (f32x4){0.f, 0.f, 0.f, 0.f};
    bf16x8 At[4][2], B0[2][2], B1[2][2];
    const char* cA = (const char*)g.A + (size_t)cur.pm * tstep; const char* cB = (const char*)g.Bt + (size_t)cur.pn * tstep;
    S.a_ready(cur);
    if constexpr (SP2) {
        PG8_STAGE(PG8_SB(0, 0), cB, voffB); PG8_STAGE(PG8_SB(0, 1), cB + hstep, voffB); PG8_STAGE(PG8_SA(0, 0), cA, voffA); PG8_STAGE(PG8_SA(0, 1), cA + hstep, voffA);
        if (wr == 1) PG8_BAR;
        PG8_WAIT_V(2); PG8_BAR;
        PG8_STAGE(PG8_SB(1, 0), cB + kstep, voffB); PG8_STAGE(PG8_SA(1, 0), cA + kstep, voffA); PG8_STAGE(PG8_SB(1, 1), cB + hstep + kstep, voffB);
        PG8_WAIT_V(6); PG8_BAR;
    } else {
        PG8_STAGE(PG8_SB(0, 0), cB, voffB); PG8_STAGE(PG8_SA(0, 0), cA, voffA); PG8_STAGE(PG8_SB(0, 1), cB + hstep, voffB); PG8_STAGE(PG8_SA(0, 1), cA + hstep, voffA);
        if (wr == 1) PG8_BAR;
        PG8_WAIT_V(4); PG8_BAR;
        PG8_STAGE(PG8_SB(1, 0), cB + kstep, voffB); PG8_STAGE(PG8_SA(1, 0), cA + kstep, voffA); PG8_STAGE(PG8_SB(1, 1), cB + hstep + kstep, voffB);
        PG8_WAIT_V(6); PG8_BAR;
    }
    for (;;) {
        const bool has_next = S.next(ui + 1, nxt);
        const char* nA = has_next ? (const char*)g.A + (size_t)nxt.pm * tstep : cA; const char* nB = has_next ? (const char*)g.Bt + (size_t)nxt.pn * tstep : cB;
        for (int t = 0; t < nt; t += 2) {
            const bool last = (t == nt - 2);
            const char* a1 = cA + (size_t)(t + 1) * kstep;
            const char* a2 = last ? nA : cA + (size_t)(t + 2) * kstep; const char* b2 = last ? nB : cB + (size_t)(t + 2) * kstep;
            const char* a3 = a2 + kstep; const char* b3 = b2 + kstep;
            if (last && has_next) S.a_ready(nxt);
            if constexpr (SP2) {
            PG8_LDB(B0, 0, 0); PG8_LDB(B1, 0, 1); PG8_SCHED; PG8_LDA(At, 0, 0); PG8_STAGE(PG8_SA(1, 1), a1 + hstep, voffA);
            PG8_WAIT_V(8); PG8_WAIT_L(0); PG8_BAR; PG8_MMA(0, 0, At, B0); PG8_MMA(0, 1, At, B1); PG8_BAR; PG8_SCHED;
            PG8_LDA(At, 0, 1); PG8_STAGE(PG8_SB(0, 0), b2, voffB); PG8_STAGE(PG8_SB(0, 1), b2 + hstep, voffB); PG8_STAGE(PG8_SA(0, 0), a2, voffA);
            PG8_WAIT_V(8); PG8_WAIT_L(0); PG8_BAR; PG8_MMA(1, 0, At, B0); PG8_MMA(1, 1, At, B1); PG8_BAR; PG8_SCHED;
            PG8_LDB(B0, 1, 0); PG8_LDB(B1, 1, 1); PG8_SCHED; PG8_LDA(At, 1, 0); PG8_STAGE(PG8_SA(0, 1), a2 + hstep, voffA);
            PG8_WAIT_V(8); PG8_WAIT_L(0); PG8_BAR; PG8_MMA(0, 0, At, B0); PG8_MMA(0, 1, At, B1); PG8_BAR; PG8_SCHED;
            PG8_LDA(At, 1, 1); PG8_STAGE(PG8_SB(1, 0), b3, voffB); PG8_STAGE(PG8_SB(1, 1), b3 + hstep, voffB); PG8_STAGE(PG8_SA(1, 0), a3, voffA);
            PG8_WAIT_V(8); PG8_WAIT_L(0); PG8_BAR; PG8_MMA(1, 0, At, B0); PG8_MMA(1, 1, At, B1); PG8_BAR; PG8_SCHED;
            } else {
            PG8_LDB(B0, 0, 0); PG8_SCHED; PG8_LDA(At, 0, 0); PG8_STAGE(PG8_SA(1, 1), a1 + hstep, voffA);
            PG8_WAIT_L(8); PG8_BAR; PG8_WAIT_L(0); PG8_MMA(0, 0, At, B0); PG8_BAR; PG8_SCHED;
            PG8_LDB(B1, 0, 1); PG8_STAGE(PG8_SB(0, 0), b2, voffB);
            PG8_BAR; PG8_WAIT_L(0); PG8_MMA(0, 1, At, B1); PG8_BAR;
            PG8_LDA(At, 0, 1); PG8_STAGE(PG8_SA(0, 0), a2, voffA);
            PG8_BAR; PG8_WAIT_L(0); PG8_MMA(1, 0, At, B0); PG8_BAR; PG8_SCHED;
            PG8_STAGE(PG8_SB(0, 1), b2 + hstep, voffB);
            PG8_WAIT_V(6); PG8_BAR; PG8_MMA(1, 1, At, B1); PG8_BAR;
            PG8_LDB(B0, 1, 0); PG8_SCHED; PG8_LDA(At, 1, 0); PG8_STAGE(PG8_SA(0, 1), a2 + hstep, voffA);
            PG8_WAIT_L(8); PG8_BAR; PG8_WAIT_L(0); PG8_MMA(0, 0, At, B0); PG8_BAR; PG8_SCHED;
            PG8_LDB(B1, 1, 1); PG8_STAGE(PG8_SB(1, 0), b3, voffB);
            PG8_BAR; PG8_WAIT_L(0); PG8_MMA(0, 1, At, B1); PG8_BAR;
            PG8_LDA(At, 1, 1); PG8_STAGE(PG8_SA(1, 0), a3, voffA);
            PG8_BAR; PG8_WAIT_L(0); PG8_MMA(1, 0, At, B0); PG8_BAR; PG8_SCHED;
            PG8_STAGE(PG8_SB(1, 1), b3 + hstep, voffB);
            PG8_WAIT_V(6); PG8_BAR; PG8_MMA(1, 1, At, B1); PG8_BAR;
            }
        }
        if constexpr (ALIGN_EPI) { if (wr == 0) PG8_BAR; }
        if constexpr (!Epi::AFTER_DRAIN) { E(acc, cur, wr, wc, fr, fq); S.done(cur); }
        if (!has_next) break;
#pragma unroll
        for (int a = 0; a < 2; ++a)
#pragma unroll
            for (int b = 0; b < 2; ++b)
#pragma unroll
                for (int m = 0; m < 4; ++m)
#pragma unroll
                    for (int n = 0; n < 2; ++n) acc[a][b][m][n] = (f32x4){0.f, 0.f, 0.f, 0.f};
        cur = nxt; cA = nA; cB = nB; ++ui;
        if constexpr (ALIGN_EPI) { if (wr == 1) PG8_BAR; }
    }
    PG8_WAIT_V(0);
    if constexpr (!ALIGN_EPI) { if (wr == 0) PG8_BAR; }
    PG8_BAR;
    if constexpr (Epi::AFTER_DRAIN) { E.fused(acc, cur, wr, wc, fr, fq, lds, wid, lane); S.done(cur); }
#undef PG8_SA
#undef PG8_SB
#undef PG8_STAGE
#undef PG8_LDA
#undef PG8_LDB
#undef PG8_MMA
#undef PG8_WAIT_V
#undef PG8_WAIT_L
#undef PG8_BAR
#undef PG8_SCHED
}
}

template <class E0> struct EpiAdapt {
    static constexpr bool PERM = false, AFTER_DRAIN = false;
    E0 e; int col_base;
    __device__ __forceinline__ void operator()(const pg8::f32x4 (&acc)[2][2][4][2], const pg8::Unit& u, int wr, int wc, int fr, int fq) const {
        auto cvv = [&]() { if constexpr (E0::PAIR2) return e.load_cv(u.pm * 256, col_base + u.pn * 256 + wc * 32 + 4 * fq); else return 0; }();
        auto cvw = [&]() { if constexpr (E0::CVPRE) return e.load_cvw(u.pm * 256, col_base + u.pn * 256 + wc * 32 + 4 * fq); else return 0; }();
        float rs8[2][4];
#pragma unroll
        for (int ai = 0; ai < 2; ++ai)
#pragma unroll
            for (int m = 0; m < 4; ++m) rs8[ai][m] = e.row_begin(u.pm * 256 + ai * 128 + wr * 64 + m * 16 + fr, fq);
#pragma unroll
        for (int ai = 0; ai < 2; ++ai)
#pragma unroll
            for (int m = 0; m < 4; ++m) {
                const int row = u.pm * 256 + ai * 128 + wr * 64 + m * 16 + fr;
                const float rs = rs8[ai][m];
                float ss = 0.f;
                if constexpr (E0::PAIR2) e.item2(row, col_base + u.pn * 256 + wc * 32 + 4 * fq, acc[ai][0][m][0], acc[ai][0][m][1], acc[ai][1][m][0], acc[ai][1][m][1], rs, cvv);
                else if constexpr (E0::CVPRE) {
#pragma unroll
                    for (int bj = 0; bj < 2; ++bj) ss += e.item_cv(row, col_base + u.pn * 256 + bj * 128 + wc * 32 + 4 * fq, acc[ai][bj][m][0], acc[ai][bj][m][1], rs, cvw.c[bj][0], cvw.c[bj][1]);
                } else {
#pragma unroll
                    for (int bj = 0; bj < 2; ++bj) ss += e.item(row, col_base + u.pn * 256 + bj * 128 + wc * 32 + 4 * fq, acc[ai][bj][m][0], acc[ai][bj][m][1], rs);
                }
                if constexpr (E0::STATS) { ss += __shfl_xor(ss, 16); ss += __shfl_xor(ss, 32); if (fq == 0) e.stats[(size_t)row * 16 + (col_base >> 6) + u.pn * 4 + wc] = ss; }
            }
    }
};
struct EpiResBig {
    static constexpr bool PERM = false, AFTER_DRAIN = false;
    EpiRes e; LAS unsigned char* lds; bool first  , f32out  ;
    template <bool FIRST>
    __device__ __forceinline__ void half(const pg8::f32x4 (&acc)[2][2][4][2], const pg8::Unit& u, int ai, int wr, int wc, int fr, int fq, const LAS float* cvec) const {
        bf16_t* xb = e.xb;
        const int colb = u.pn * 256 + wc * 32 + 4 * fq, colg = u.pn * 256 + wc * 32 + 8 * fq;
        const int rowb = u.pm * 256 + ai * 128 + wr * 64 + fr;
        f32x4 xo[FIRST ? 4 : 1][2][2]; u32x4 raw[FIRST ? 1 : 4][2];
#pragma unroll
        for (int m = 0; m < 4; ++m)
#pragma unroll
            for (int bj = 0; bj < 2; ++bj) {
                if constexpr (FIRST) {
#pragma unroll
                    for (int hl = 0; hl < 2; ++hl) xo[m][bj][hl] = *(const f32x4*)(e.xin + (size_t)(rowb + 16 * m) * 1024 + colb + 128 * bj + 16 * hl);
                } else raw[m][bj] = *(const u32x4*)(xb + (size_t)(rowb + 16 * m) * 1024 + colg + 128 * bj);
            }
#pragma unroll
        for (int m = 0; m < 4; ++m) {
            const int row = rowb + 16 * m; float ss = 0.f;
#pragma unroll
            for (int bj = 0; bj < 2; ++bj) {
                f32x4 xn[2];
                if constexpr (FIRST) { xn[0] = xo[m][bj][0]; xn[1] = xo[m][bj][1]; }
                else { const u32x4 r = raw[m][bj]; xn[0] = (f32x4){bflo(r.x), bfhi(r.x), bflo(r.y), bfhi(r.y)}; xn[1] = (f32x4){bflo(r.z), bfhi(r.z), bflo(r.w), bfhi(r.w)}; }
#pragma unroll
                for (int hl = 0; hl < 2; ++hl) {
                    const int lc = 32 * bj + 16 * hl + 4 * fq;
                    const f32x4 m4 = *(const LAS f32x4*)(cvec + lc), b4 = *(const LAS f32x4*)(cvec + 64 + lc);
                    xn[hl] = xn[hl] + m4 * (acc[ai][bj][m][hl] + b4);
                    ss += (xn[hl][0] * xn[hl][0] + xn[hl][1] * xn[hl][1]) + (xn[hl][2] * xn[hl][2] + xn[hl][3] * xn[hl][3]);
                }
                if (f32out) { *(f32x4*)(e.xl + (size_t)row * 1024 + colb + 128 * bj) = xn[0]; *(f32x4*)(e.xl + (size_t)row * 1024 + colb + 128 * bj + 16) = xn[1]; }
                else { u32x4 xw; xw.x = pk2(xn[0][0], xn[0][1]); xw.y = pk2(xn[0][2], xn[0][3]); xw.z = pk2(xn[1][0], xn[1][1]); xw.w = pk2(xn[1][2], xn[1][3]); *(u32x4*)(xb + (size_t)row * 1024 + colg + 128 * bj) = xw; }
            }
            ss += __shfl_xor(ss, 16); ss += __shfl_xor(ss, 32); if (fq == 0) e.stats[(size_t)row * 16 + u.pn * 4 + wc] = ss;
        }
    }
    __device__ __forceinline__ void operator()(const pg8::f32x4 (&acc)[2][2][4][2], const pg8::Unit& u, int wr, int wc, int fr, int fq) const {
        LAS float* cvec = (LAS float*)(lds + 131072 + 2048 + (wr * 4 + wc) * 512);
        {   const int l = fq * 16 + fr, col = u.pn * 256 + 128 * (l >> 5) + wc * 32 + (l & 31);
            const float mgv = ((const float*)e.ws + e.mgoff)[col];
            float bv = 0.f; if (e.bias) bv = e.bias[col];
            cvec[l] = mgv; cvec[64 + l] = bv; }
        if (first) { half<true>(acc, u, 0, wr, wc, fr, fq, cvec); half<true>(acc, u, 1, wr, wc, fr, fq, cvec); }
        else { half<false>(acc, u, 0, wr, wc, fr, fq, cvec); half<false>(acc, u, 1, wr, wc, fr, fq, cvec); }
    }
};
struct EpiVt {
    static constexpr bool PERM = false, AFTER_DRAIN = false;
    unsigned char* ws; int cvoff;
    __device__ __forceinline__ void operator()(const pg8::f32x4 (&acc)[2][2][4][2], const pg8::Unit& u, int wr, int wc, int fr, int fq) const {
        bf16_t* vt = (bf16_t*)(ws + WS_VT);
        const float* cv = (const float*)ws + cvoff + (u.pm * 256 < T ? 0 : 8192);
        float c4[2][2];
#pragma unroll
        for (int bj = 0; bj < 2; ++bj)
#pragma unroll
            for (int n = 0; n < 2; ++n) c4[bj][n] = cv[2048 + u.pn * 256 + bj * 128 + wc * 32 + 16 * n + fr];
#pragma unroll
        for (int ai = 0; ai < 2; ++ai)
#pragma unroll
            for (int p = 0; p < 2; ++p) {
                const int rowb = u.pm * 256 + ai * 128 + wr * 64 + 32 * p;
                const float rsA = row_rs((const float*)(ws + WS_STATS), rowb + fr, fq), rsB = row_rs((const float*)(ws + WS_STATS), rowb + 16 + fr, fq);
                float rs8[8];
#pragma unroll
                for (int e = 0; e < 8; ++e) { const float ra = __shfl(rsA, (8 * fq + e) & 15), rb = __shfl(rsB, (8 * fq + e) & 15); rs8[e] = fq < 2 ? ra : rb; }
#pragma unroll
                for (int bj = 0; bj < 2; ++bj)
#pragma unroll
                    for (int n = 0; n < 2; ++n) {
                        const int col = u.pn * 256 + bj * 128 + wc * 32 + 16 * n + fr; const float c0 = c4[bj][n];
                        const pg8::f32x4 a0 = acc[ai][bj][2 * p][n], a1 = acc[ai][bj][2 * p + 1][n];
                        u32x4 w; w.x = pk2(a0[0] * rs8[0] + c0, a0[1] * rs8[1] + c0); w.y = pk2(a0[2] * rs8[2] + c0, a0[3] * rs8[3] + c0);
                        w.z = pk2(a1[0] * rs8[4] + c0, a1[1] * rs8[5] + c0); w.w = pk2(a1[2] * rs8[6] + c0, a1[3] * rs8[7] + c0);
                        *(u32x4*)(vt + (size_t)col * R + rowb + 8 * fq) = w;
                    }
            }
    }
};
template <int NT, int KS, class Epi>
__device__ __forceinline__ void sgemm_small(Ctx& C, const bf16_t* A, const bf16_t* Bt, int row_lo, int Mrows, const Epi& E, int n_lo, int n_hi) {
    constexpr int K = 256 * KS, K8 = 32 * KS;
    constexpr int PD = NT == 16 ? 2 : (NT == 8 ? (KS < 4 ? KS : 4) : (KS < 6 ? KS : 6));
    const int w = C.wave, fr = C.lane & 15, fq = C.lane >> 4;
    const int nM = Mrows / 16, nS = (n_hi - n_lo) * (16 / NT), nU = nM * nS;
    LAS f32x4* xch = (LAS f32x4*)C.lds;
    LAS float* sx = (LAS float*)(C.lds + 131072 + 1024);
    const bool xmap = C.G == 256 && (nU & 7) == 0;
    const int per = xmap ? nU >> 3 : nU, ubase = xmap ? (C.bid & 7) * per : 0, ustep = xmap ? 32 : C.G;
    for (int v = xmap ? C.bid >> 3 : C.bid; v < per; v += ustep) {
        const int u = ubase + v, slab = u / nM, um = u % nM;
        const int row0 = row_lo + 16 * um, col0 = 256 * n_lo + 16 * NT * slab;
        f32x4 acc[NT];
#pragma unroll
        for (int t = 0; t < NT; ++t) acc[t] = (f32x4){0.f, 0.f, 0.f, 0.f};
        const bf16_t* ap = A + (size_t)(row0 + fr) * K + w * K8 + 8 * fq;
        const bf16_t* bp = Bt + (size_t)(col0 + fr) * K + w * K8 + 8 * fq;
        bf16x8 af[PD], bf[PD][NT];
#pragma unroll
        for (int s = 0; s < PD; ++s) {
            af[s] = *(const bf16x8*)(ap + 32 * s);
#pragma unroll
            for (int t = 0; t < NT; ++t) bf[s][t] = *(const bf16x8*)(bp + (size_t)(16 * t) * K + 32 * s);
        }
#pragma unroll
        for (int s = 0; s < KS; ++s) {
            const int sl = s % PD;
#pragma unroll
            for (int t = 0; t < NT; ++t) acc[t] = __builtin_amdgcn_mfma_f32_16x16x32_bf16(bf[sl][t], af[sl], acc[t], 0, 0, 0);
            if (s + PD < KS) {
                af[sl] = *(const bf16x8*)(ap + 32 * (s + PD));
#pragma unroll
                for (int t = 0; t < NT; ++t) bf[sl][t] = *(const bf16x8*)(bp + (size_t)(16 * t) * K + 32 * (s + PD));
            }
            __builtin_amdgcn_sched_barrier(0);
        }
#pragma unroll
        for (int t = 0; t < NT; ++t) xch[(w * NT + t) * 64 + C.lane] = acc[t];
        __syncthreads();
        const int row = row0 + fr;
        float ss = 0.f;
        if (w < NT / 2) {
            f32x4 v0 = {0.f, 0.f, 0.f, 0.f}, v1 = v0;
#pragma unroll
            for (int q = 0; q < 8; ++q) { v0 += xch[(q * NT + 2 * w) * 64 + C.lane]; v1 += xch[(q * NT + 2 * w + 1) * 64 + C.lane]; }
            const float rs = E.row_begin(row, fq);
            ss = E.item(row, col0 + 32 * w + 4 * fq, v0, v1, rs);
        }
        if constexpr (Epi::STATS) {
            ss += __shfl_xor(ss, 16); ss += __shfl_xor(ss, 32);
            if (fq == 0) sx[fr * 8 + w] = ss;
            __syncthreads();
            if (fq == 0 && (w & 1) == 0 && w < NT / 2) E.stats[(size_t)row * 16 + (col0 >> 6) + (w >> 1)] = sx[fr * 8 + w] + sx[fr * 8 + w + 1];
        }
        __syncthreads();
    }
}
template <int NT, class E0>
__device__ __forceinline__ void gemm_both(Ctx& C, const bf16_t* A, const bf16_t* Bt, int Mbig, int N, int K, const E0& E, int ctx_n_lo, int ctx_n_hi, int nb_lo = 0, int nb_hi = -1) {
    if (nb_hi < 0) nb_hi = N / 256;
    { pg8::Gemm g{A, Bt + (size_t)nb_lo * 256 * K, Mbig, (nb_hi - nb_lo) * 256, K}; pg8::StaticOrder S; S.init(Mbig, (nb_hi - nb_lo) * 256, C.G, C.bid); EpiAdapt<E0> EA{E, nb_lo * 256};
      pg8::gemm_phase<EpiAdapt<E0>, pg8::StaticOrder, true, true>(C.lds, g, S, EA); }
    if (Mbig < R && ctx_n_hi > ctx_n_lo) { __syncthreads(); relane(C); sgemm_small<NT, 4>(C, A, Bt, T, R - T, E, ctx_n_lo, ctx_n_hi); }
}
__device__ __forceinline__ void dwconv_phase(Ctx& C, int j) {
    const bf16_t* U = (const bf16_t*)(C.ws + WS_U); bf16_t* A2 = (bf16_t*)(C.ws + WS_A2);
    const float* dww = C.in[10] + (size_t)j * CK * 1024; const float* dwb = C.in[11] + j * 1024; const float* lng = C.in[12] + j * 1024; const float* lnb = C.in[13] + j * 1024;
    constexpr int TT = 33, NR = TT + 30;
    LAS unsigned char* tile = C.lds; LAS float* part = (LAS float*)(C.lds + NR * 2048);
    const int tid = C.tid;
    constexpr int NUL = (T + TT - 1) / TT, NUC = (TC + TT - 1) / TT;
    f32x2 wt[CK];
#pragma unroll
    for (int jt = 0; jt < CK; ++jt) wt[jt] = *(const f32x2*)(dww + jt * 1024 + 2 * tid);
    const f32x2 b2 = *(const f32x2*)(dwb + 2 * tid), g2 = *(const f32x2*)(lng + 2 * tid), bb2 = *(const f32x2*)(lnb + 2 * tid);
    for (int u = C.bid; u < NUL + NUC; u += C.G) {
        const bool lat = u < NUL; const int base = lat ? 0 : T, n = lat ? T : TC, t0 = TT * (lat ? u : u - NUL);
        const int nv = (n - t0) < TT ? (n - t0) : TT;
        for (int idx = tid; idx < NR * 128; idx += 512) {
            const int rr = idx >> 7, ch = idx & 127, tt = t0 - 15 + rr;
            u32x4 v = {0u, 0u, 0u, 0u};
            if (tt >= 0 && tt < n) v = *(const u32x4*)(U + (size_t)(base + tt) * 1024 + ch * 8);
            *(LAS u32x4*)(tile + rr * 2048 + ch * 16) = v;
        }
        __syncthreads();
        f32x2 o[TT];
#pragma unroll
        for (int t = 0; t < TT; ++t) o[t] = b2;
#pragma unroll
        for (int hb = 0; hb < 3; ++hb) {
            f32x2 xw[41];
#pragma unroll
            for (int r = 0; r < 41; ++r) { const unsigned uu = *(const LAS unsigned*)(tile + (11 * hb + r) * 2048 + tid * 4); xw[r] = (f32x2){bflo(uu), bfhi(uu)}; }
#pragma unroll
            for (int t = 0; t < 11; ++t)
#pragma unroll
                for (int jt = 0; jt < CK; ++jt) o[11 * hb + t] += wt[jt] * xw[t + jt];
        }
#pragma unroll
        for (int t = 0; t < TT; ++t) {
            const float s = wave_sum63(o[t].x + o[t].y), q = wave_sum63(o[t].x * o[t].x + o[t].y * o[t].y);
            if (C.lane == 63) { part[(t * 8 + C.wave) * 2] = s; part[(t * 8 + C.wave) * 2 + 1] = q; }
        }
        __syncthreads();
#pragma unroll
        for (int t = 0; t < TT; ++t) {
            float s = 0.f, q = 0.f;
#pragma unroll
            for (int w = 0; w < 8; ++w) { s += part[(t * 8 + w) * 2]; q += part[(t * 8 + w) * 2 + 1]; }
            const float mean = s * (1.f / 1024.f), var = q * (1.f / 1024.f) - mean * mean, rstd = __builtin_amdgcn_rsqf(var + LN_EPS);
            const float y0 = (o[t].x - mean) * rstd * g2.x + bb2.x, y1 = (o[t].y - mean) * rstd * g2.y + bb2.y;
            if (t < nv) *(unsigned*)(A2 + (size_t)(base + t0 + t) * 1024 + 2 * tid) = pk2(siluf(y0), siluf(y1));
        }
        __syncthreads();
    }
}

__device__ __forceinline__ void ugemm_phase(Ctx& C, int j) {
    const bf16_t* Kb = (const bf16_t*)(C.ws + WS_K); const bf16_t* Vt = (const bf16_t*)(C.ws + WS_VT); bf16_t* Scp = (bf16_t*)(C.ws + WS_SCP);
    constexpr int SLOT = 32768;
    const int fr = C.lane & 15, fq = C.lane >> 4, w = C.wave, lane = C.lane;
    const int wm = w >> 1, wn = w & 1;
    const unsigned lds0 = (unsigned)(size_t)C.lds;
    for (int it0 = 0; it0 < 3; ++it0) {
        int set, sub;
        if (it0 < 2) { if (C.bid >= 256) break; const int x = C.bid & 7, ii = C.bid >> 3; set = it0 * 64 + x * 8 + (ii >> 2); sub = ii & 3; }
        else { const int k = C.bid; if (k >= 16) break; set = 128 + (k >> 2); sub = k & 3; }
        const int slot = set >> 2, h = set & 3, dir = sub >> 1, dvh = sub & 1;
        const int ntok = slot < 32 ? 512 : 256, tokb = slot < 32 ? 512 * slot : T, nst = ntok / 32;
        const float gam = 1.0f - exp2f(C.in[17][(j * 2 + dir) * 4 + h]); const float L = log2f(gam);
        unsigned ksrc[2], vsrc[2];
#pragma unroll
        for (int p = 0; p < 2; ++p) {
            const int kr = 2 * (2 * w + p) + (lane >> 5), kpos = lane & 31, kc = kpos ^ ((((kr & 3) | (((kr >> 3) & 1) << 2))) << 1);
            ksrc[p] = (unsigned)((tokb + kr) * 1024 + h * 256 + 8 * kc);
            const int vr = 16 * (2 * w + p) + (lane >> 2), vpos = lane & 3, vc = vpos ^ ((4 - ((vr >> 2) & 3)) & 3);
            vsrc[p] = (unsigned)((h * 512 + 256 * dvh + vr) * R + tokb + 8 * vc);
        }
#define UG_DMA(st) do { const int s_ = (st) < nst ? (st) : nst - 1; LAS unsigned char* sl_ = C.lds + ((st) & 3) * SLOT + (2 * w) * 1024; \
        _Pragma("unroll") for (int p = 0; p < 2; ++p) { \
            __builtin_amdgcn_global_load_lds((const unsigned*)(Kb + (ksrc[p] + (unsigned)(32 * s_ * 1024))), (LAS unsigned*)(sl_ + p * 1024), 16, 0, 0); \
            __builtin_amdgcn_global_load_lds((const unsigned*)(Vt + (vsrc[p] + (unsigned)(32 * s_))), (LAS unsigned*)(sl_ + 16384 + p * 1024), 16, 0, 0); } } while (0)
        const int trq = fr >> 2, trp = fr & 3;
        const int row0 = 8 * fq + trq;
        const unsigned a0 = (unsigned)(row0 * 512 + (((8 * wm + (trp >> 1)) ^ ((((row0 & 3) | (((row0 >> 3) & 1) << 2))) << 1)) << 4) + 8 * (trp & 1));
        const unsigned boff0 = (unsigned)(16384 + (128 * wn + fr) * 64 + ((fq ^ ((4 - ((fr >> 2) & 3)) & 3)) << 4));
        float kd[8];
#pragma unroll
        for (int e = 0; e < 8; ++e) { const int tl = 8 * fq + e; kd[e] = exp2f(L * (float)(dir == 0 ? 31 - tl : tl)); }
        f32x4 acc[4][8];
#pragma unroll
        for (int mt = 0; mt < 4; ++mt)
#pragma unroll
            for (int nt = 0; nt < 8; ++nt) acc[mt][nt] = (f32x4){0.f, 0.f, 0.f, 0.f};
        __syncthreads();
        UG_DMA(0); UG_DMA(1);
#pragma unroll 1
        for (int st2 = 0; st2 < nst; st2 += 2) {
            asm volatile("s_waitcnt vmcnt(0)" ::: "memory");
            __builtin_amdgcn_s_barrier(); asm volatile("" ::: "memory");
            UG_DMA(st2 + 2); UG_DMA(st2 + 3);
#pragma unroll 1
          for (int st = st2; st < st2 + 2; ++st) {
            const float sf = exp2f(L * (float)(dir == 0 ? ntok - 32 - 32 * st : 32 * st));
            const unsigned sl = lds0 + (unsigned)((st & 3) * SLOT);
            u32x2 alo[4], ahi[4]; u32x4 bfv[4];
#pragma unroll
            for (int mt = 0; mt < 4; ++mt) {
                const unsigned aa = sl + (a0 ^ (unsigned)(mt << 5));
                asm volatile("ds_read_b64_tr_b16 %0, %1" : "=v"(alo[mt]) : "v"(aa));
                asm volatile("ds_read_b64_tr_b16 %0, %1 offset:2048" : "=v"(ahi[mt]) : "v"(aa));
            }
            const unsigned ba = sl + boff0;
#pragma unroll
            for (int nt = 0; nt < 4; ++nt) asm volatile("ds_read_b128 %0, %1 offset:%c2" : "=v"(bfv[nt]) : "v"(ba), "i"(nt * 1024));
            asm volatile("s_waitcnt lgkmcnt(0)" : "+v"(alo[0]), "+v"(alo[1]), "+v"(alo[2]), "+v"(alo[3]), "+v"(ahi[0]), "+v"(ahi[1]), "+v"(ahi[2]), "+v"(ahi[3]) :: "memory");
            asm volatile("" : "+v"(bfv[0]), "+v"(bfv[1]), "+v"(bfv[2]), "+v"(bfv[3]));
            __builtin_amdgcn_sched_barrier(0);
            bf16x8 af[4];
#pragma unroll
            for (int mt = 0; mt < 4; ++mt) {
                u32x4 pk;
                pk.x = pk2(bflo(alo[mt].x) * (kd[0] * sf), bfhi(alo[mt].x) * (kd[1] * sf));
                pk.y = pk2(bflo(alo[mt].y) * (kd[2] * sf), bfhi(alo[mt].y) * (kd[3] * sf));
                pk.z = pk2(bflo(ahi[mt].x) * (kd[4] * sf), bfhi(ahi[mt].x) * (kd[5] * sf));
                pk.w = pk2(bflo(ahi[mt].y) * (kd[6] * sf), bfhi(ahi[mt].y) * (kd[7] * sf));
                af[mt] = __builtin_bit_cast(bf16x8, pk);
            }
#pragma unroll
            for (int mt = 0; mt < 4; ++mt)
#pragma unroll
                for (int nt = 0; nt < 4; ++nt) acc[mt][nt] = __builtin_amdgcn_mfma_f32_16x16x32_bf16(af[mt], __builtin_bit_cast(bf16x8, bfv[nt]), acc[mt][nt], 0, 0, 0);
            __builtin_amdgcn_sched_barrier(0);
#pragma unroll
            for (int nt = 0; nt < 4; ++nt) asm volatile("ds_read_b128 %0, %1 offset:%c2" : "=v"(bfv[nt]) : "v"(ba), "i"((nt + 4) * 1024));
            asm volatile("s_waitcnt lgkmcnt(0)" : "+v"(bfv[0]), "+v"(bfv[1]), "+v"(bfv[2]), "+v"(bfv[3]) :: "memory");
            __builtin_amdgcn_sched_barrier(0);
#pragma unroll
            for (int mt = 0; mt < 4; ++mt)
#pragma unroll
                for (int nt = 0; nt < 4; ++nt) acc[mt][nt + 4] = __builtin_amdgcn_mfma_f32_16x16x32_bf16(af[mt], __builtin_bit_cast(bf16x8, bfv[nt]), acc[mt][nt + 4], 0, 0, 0);
          }
        }
        asm volatile("s_waitcnt vmcnt(0)" ::: "memory");
        bf16_t* sp = Scp + ((size_t)((slot * 4 + h) * 2 + dir) * 512) * 256;
#pragma unroll
        for (int nt = 0; nt < 8; ++nt) {
            bf16_t* rowp = sp + (size_t)(256 * dvh + 128 * wn + 16 * nt + fr) * 256 + 64 * wm + 4 * fq;
#pragma unroll
            for (int mt = 0; mt < 4; ++mt) { u32x2 wv; wv.x = pk2(acc[mt][nt][0], acc[mt][nt][1]); wv.y = pk2(acc[mt][nt][2], acc[mt][nt][3]); *(u32x2*)(rowp + 16 * mt) = wv; }
        }
        __syncthreads();
#undef UG_DMA
    }
}
__device__ __forceinline__ void prefix_phase(Ctx& C, int j) {
    bf16_t* Scp = (bf16_t*)(C.ws + WS_SCP);
    constexpr size_t SSTR = (size_t)8 * 512 * 256;
    for (int idx = C.bid * 512 + C.tid; idx < 8 * 512 * 32; idx += C.G * 512) {
        const int hd = idx >> 14, h = hd >> 1, dir = hd & 1;
        const float gam = 1.0f - exp2f(C.in[17][(j * 2 + dir) * 4 + h]); const float cdec = exp2f(log2f(gam) * 512.f);
        bf16_t* p = Scp + (size_t)idx * 8;
        const u32x4 raw = *(const u32x4*)(p + 32 * SSTR);
        float s[8] = {bflo(raw.x), bfhi(raw.x), bflo(raw.y), bfhi(raw.y), bflo(raw.z), bfhi(raw.z), bflo(raw.w), bfhi(raw.w)};
        *(u32x4*)(p + 32 * SSTR) = (u32x4){0u, 0u, 0u, 0u};
#pragma unroll 1
        for (int qb = 0; qb < 4; ++qb) {
            u32x4 u[8];
#pragma unroll
            for (int q = 0; q < 8; ++q) { const int g = dir == 0 ? 8 * qb + q : 31 - (8 * qb + q); u[q] = *(const u32x4*)(p + (size_t)g * SSTR); }
#pragma unroll
            for (int q = 0; q < 8; ++q) {
                const int g = dir == 0 ? 8 * qb + q : 31 - (8 * qb + q);
                u32x4 o; o.x = pk2(s[0], s[1]); o.y = pk2(s[2], s[3]); o.z = pk2(s[4], s[5]); o.w = pk2(s[6], s[7]);
                *(u32x4*)(p + (size_t)g * SSTR) = o;
                s[0] = s[0] * cdec + bflo(u[q].x); s[1] = s[1] * cdec + bfhi(u[q].x); s[2] = s[2] * cdec + bflo(u[q].y); s[3] = s[3] * cdec + bfhi(u[q].y);
                s[4] = s[4] * cdec + bflo(u[q].z); s[5] = s[5] * cdec + bfhi(u[q].z); s[6] = s[6] * cdec + bflo(u[q].w); s[7] = s[7] * cdec + bfhi(u[q].w);
            }
        }
    }
}

template <int MT, int PV = 0>
__device__ __forceinline__ void readout_units(Ctx& C, int j) {
    const bf16_t* Q = (const bf16_t*)(C.ws + WS_Q); const bf16_t* Kb = (const bf16_t*)(C.ws + WS_K); const bf16_t* Vt = (const bf16_t*)(C.ws + WS_VT);
    const bf16_t* Scp = (const bf16_t*)(C.ws + WS_SCP); bf16_t* GF = (bf16_t*)(C.ws + WS_GF); const bf16_t* GB = (const bf16_t*)(C.ws + WS_GB);
    constexpr int QP = 264, PP = 136;
    constexpr int NROW = 16 * MT;
    LAS bf16_t* Qs = (LAS bf16_t*)C.lds;
    LAS bf16_t* P2 = (LAS bf16_t*)(C.lds + NROW * QP * 2);
    LAS float* red = (LAS float*)(C.lds + NROW * QP * 2 + 2 * NROW * PP * 2);
    const int w = C.wave, tid = C.tid;
    const int nunits = MT == 8 ? 512 : 32;
    for (int u0 = (MT == 8 ? C.bid : C.G - 1 - C.bid); u0 < nunits; u0 += C.G) {
        int h, b, sb = 0;
        if (MT != 8) { h = u0 & 3; sb = (u0 >> 2) & 3; b = 128 + (u0 >> 4); }
        else if (C.G == 256) { const int r = u0 >> 8, x = u0 & 7, idx = (u0 & 255) >> 3, grp = r * 64 + x * 8 + (idx >> 2); h = grp & 3; b = (grp >> 2) * 4 + (idx & 3); }
        else { h = u0 & 3; b = u0 >> 2; }
        const bool lat = b < 128; const int base = lat ? 0 : T, nb = lat ? 128 : 2, bl = lat ? b : b - 128;
        const int g = bl >> 2, slot = lat ? g : 32;
        const int gend = (4 * (g + 1) < nb ? 4 * (g + 1) : nb);
        const int i0 = base + 128 * bl + NROW * sb, il0 = 128 * bl + NROW * sb;
#pragma unroll
        for (int i = 0; i < MT; ++i) { const int c = tid + 512 * i, row = c >> 5, ch = c & 31;
            *(LAS u32x4*)(Qs + row * QP + 8 * ch) = *(const u32x4*)(Q + (size_t)(i0 + row) * 1024 + h * 256 + 8 * ch); }
        __syncthreads();
#pragma unroll 1
        for (int dir = 0; dir < 2; ++dir) {
            int lane_o = C.lane; asm volatile("" : "+v"(lane_o));
            const int fr = lane_o & 15, fq = lane_o >> 4;
            const float gam = 1.0f - exp2f(C.in[17][(j * 2 + dir) * 4 + h]); const float L = log2f(gam);
            f32x4 acc[MT][4];
#pragma unroll
            for (int mt = 0; mt < MT; ++mt)
#pragma unroll
                for (int nt = 0; nt < 4; ++nt) acc[mt][nt] = (f32x4){0.f, 0.f, 0.f, 0.f};
            const int kb_lo = dir == 0 ? 4 * g : bl, kb_hi = dir == 0 ? bl : gend - 1;
            const bf16_t* sb = Scp + ((size_t)((slot * 4 + h) * 2 + dir) * 512) * 256 + (size_t)(64 * w + 16 * (fr >> 2) + (fr & 3)) * 256 + 8 * fq;
#pragma unroll 1
            for (int kq = 0; kq < (PV == 5 ? 0 : 4); ++kq) {
                bf16x8 sf[2][4];
#pragma unroll
                for (int k2 = 0; k2 < 2; ++k2)
#pragma unroll
                    for (int nt = 0; nt < 4; ++nt) sf[k2][nt] = *(const bf16x8*)(sb + (size_t)(4 * nt) * 256 + 32 * (2 * kq + k2));
#pragma unroll
                for (int k2 = 0; k2 < 2; ++k2)
#pragma unroll
                    for (int mt = 0; mt < MT; ++mt) { const bf16x8 qf = *(const LAS bf16x8*)(Qs + (16 * mt + fr) * QP + 32 * (2 * kq + k2) + 8 * fq);
#pragma unroll
                        for (int nt = 0; nt < 4; ++nt) acc[mt][nt] = __builtin_amdgcn_mfma_f32_16x16x32_bf16(sf[k2][nt], qf, acc[mt][nt], 0, 0, 0); }
            }
#pragma unroll
            for (int mt = 0; mt < MT; ++mt) {
                const int il = il0 + 16 * mt + fr;
                const int ex = dir == 0 ? il - 512 * g + 1 : gend * 128 - il;
                const float qd = __builtin_amdgcn_exp2f(L * (float)ex);
#pragma unroll
                for (int nt = 0; nt < 4; ++nt) acc[mt][nt] = acc[mt][nt] * qd;
            }
#pragma unroll 1
            for (int kb = kb_lo; kb <= ((PV == 2 || PV == 5) ? kb_lo - 1 : kb_hi); ++kb) {
                const int j0 = base + 128 * kb;
                LAS bf16_t* P = P2 + (kb & 1) * (NROW * PP);
                {
                    bf16x8 kf[8];
                    const bf16_t* k1 = Kb + (size_t)(j0 + 16 * w + fr) * 1024 + h * 256 + 8 * fq;
#pragma unroll
                    for (int ks = 0; ks < 8; ++ks) kf[ks] = *(const bf16x8*)(k1 + 32 * ks);
                    f32x4 sc[MT];
#pragma unroll
                    for (int mt = 0; mt < MT; ++mt) sc[mt] = (f32x4){0.f, 0.f, 0.f, 0.f};
#pragma unroll
                    for (int ks = 0; ks < 8; ++ks) {
#pragma unroll
                        for (int mt = 0; mt < MT; ++mt) { const bf16x8 qf = *(const LAS bf16x8*)(Qs + (16 * mt + fr) * QP + 32 * ks + 8 * fq);
                            sc[mt] = __builtin_amdgcn_mfma_f32_16x16x32_bf16(kf[ks], qf, sc[mt], 0, 0, 0); }
                        __builtin_amdgcn_sched_barrier(0);
                    }
#pragma unroll
                    for (int mt = 0; mt < MT; ++mt) {
                        const int il = il0 + 16 * mt + fr;
                        float p[4];
#pragma unroll
                        for (int e = 0; e < 4; ++e) { const int jl = 128 * kb + 16 * w + 4 * fq + e; const int rel = dir == 0 ? il - jl : jl - il;
                            p[e] = rel >= 0 ? sc[mt][e] * __builtin_amdgcn_exp2f(L * (float)rel) : 0.f; }
                        u32x2 wv; wv.x = pk2(p[0], p[1]); wv.y = pk2(p[2], p[3]);
                        *(LAS u32x2*)(P + (16 * mt + fr) * PP + 16 * w + 4 * fq) = wv;
                    }
                }
                const bf16_t* vb = Vt + (size_t)(h * 512 + 64 * w + 16 * (fr >> 2) + (fr & 3)) * R + j0 + 8 * fq;
                {
                    bf16x8 vf[4][4];
#pragma unroll
                    for (int k4 = 0; k4 < 4; ++k4)
#pragma unroll
                        for (int nt = 0; nt < 4; ++nt) vf[k4][nt] = *(const bf16x8*)(vb + (size_t)(4 * nt) * R + 32 * k4);
                    asm volatile("s_waitcnt lgkmcnt(0)" ::: "memory");
                    __builtin_amdgcn_s_barrier(); asm volatile("" ::: "memory");
#pragma unroll
                    for (int k4 = 0; k4 < 4; ++k4) {
#pragma unroll
                        for (int mt = 0; mt < MT; ++mt) { const bf16x8 pf = *(const LAS bf16x8*)(P + (16 * mt + fr) * PP + 32 * k4 + 8 * fq);
#pragma unroll
                            for (int nt = 0; nt < 4; ++nt) acc[mt][nt] = __builtin_amdgcn_mfma_f32_16x16x32_bf16(vf[k4][nt], pf, acc[mt][nt], 0, 0, 0); }
                        __builtin_amdgcn_sched_barrier(0);
                    }
                }
            }
#pragma unroll
            for (int mt = 0; mt < MT; ++mt) {
                float ss = 0.f;
#pragma unroll
                for (int nt = 0; nt < 4; ++nt) ss += (acc[mt][nt][0] * acc[mt][nt][0] + acc[mt][nt][1] * acc[mt][nt][1]) + (acc[mt][nt][2] * acc[mt][nt][2] + acc[mt][nt][3] * acc[mt][nt][3]);
                ss += __shfl_xor(ss, 16); ss += __shfl_xor(ss, 32);
                if (fq == 0) red[(16 * mt + fr) * 8 + w] = ss;
            }
            const size_t off0 = (size_t)(i0 + fr) * 2048 + h * 512 + 64 * w + 16 * fq;
            u32x4 gld[MT][2];
#pragma unroll
            for (int mt = 0; mt < MT; ++mt)
#pragma unroll
                for (int np = 0; np < 2; ++np) gld[mt][np] = __builtin_nontemporal_load((const u32x4*)((dir == 0 ? (const bf16_t*)GF : GB) + off0 + (size_t)(16 * mt) * 2048 + 8 * np));
            asm volatile("s_waitcnt lgkmcnt(0)" ::: "memory");
            __builtin_amdgcn_s_barrier(); asm volatile("" ::: "memory");
#pragma unroll
            for (int mt = 0; mt < MT; ++mt) {
                float tot = 0.f;
#pragma unroll
                for (int w2 = 0; w2 < 8; ++w2) tot += red[(16 * mt + fr) * 8 + w2];
                const float rn = __builtin_amdgcn_rsqf(tot * (1.f / 512.f) + NORM_EPS);
#pragma unroll
                for (int np = 0; np < 2; ++np) {
                    const u32x4 g4 = gld[mt][np];
                    acc[mt][2 * np][0] *= siluf(bflo(g4.x)) * rn; acc[mt][2 * np][1] *= siluf(bfhi(g4.x)) * rn;
                    acc[mt][2 * np][2] *= siluf(bflo(g4.y)) * rn; acc[mt][2 * np][3] *= siluf(bfhi(g4.y)) * rn;
                    acc[mt][2 * np + 1][0] *= siluf(bflo(g4.z)) * rn; acc[mt][2 * np + 1][1] *= siluf(bfhi(g4.z)) * rn;
                    acc[mt][2 * np + 1][2] *= siluf(bflo(g4.w)) * rn; acc[mt][2 * np + 1][3] *= siluf(bfhi(g4.w)) * rn;
                }
            }
            if (dir == 1) {
#pragma unroll
                for (int mt = 0; mt < MT; ++mt)
#pragma unroll
                    for (int np = 0; np < 2; ++np) gld[mt][np] = *(const u32x4*)(GF + off0 + (size_t)(16 * mt) * 2048 + 8 * np);
#pragma unroll
                for (int mt = 0; mt < MT; ++mt)
#pragma unroll
                    for (int np = 0; np < 2; ++np) { const u32x4 yp = gld[mt][np];
                        acc[mt][2 * np][0] += bflo(yp.x); acc[mt][2 * np][1] += bfhi(yp.x); acc[mt][2 * np][2] += bflo(yp.y); acc[mt][2 * np][3] += bfhi(yp.y);
                        acc[mt][2 * np + 1][0] += bflo(yp.z); acc[mt][2 * np + 1][1] += bfhi(yp.z); acc[mt][2 * np + 1][2] += bflo(yp.w); acc[mt][2 * np + 1][3] += bfhi(yp.w); }
            }
            if (PV != 4) {
#pragma unroll
                for (int mt = 0; mt < MT; ++mt)
#pragma unroll
                    for (int np = 0; np < 2; ++np) { u32x4 wv; wv.x = pk2(acc[mt][2 * np][0], acc[mt][2 * np][1]); wv.y = pk2(acc[mt][2 * np][2], acc[mt][2 * np][3]);
                        wv.z = pk2(acc[mt][2 * np + 1][0], acc[mt][2 * np + 1][1]); wv.w = pk2(acc[mt][2 * np + 1][2], acc[mt][2 * np + 1][3]);
                        *(u32x4*)(GF + off0 + (size_t)(16 * mt) * 2048 + 8 * np) = wv; }
            }
        }
        __syncthreads();
    }
}

template <int PV = 0>
__device__ __forceinline__ void readout_phase(Ctx& C, int j, bool skip_ctx) {
    readout_units<8, PV>(C, j);
    if (!skip_ctx) { __syncthreads(); readout_units<2, PV>(C, j); }
}

__device__ __forceinline__ void phase_p0(Ctx& C) {
    float* modv = (float*)(C.ws + WS_MODV);
    for (int u = C.bid; u < 384; u += C.G) {
        const int i = u / 96, nbk = u % 96;
        gemv2_unit<1>(C, C.in[4] + (size_t)i * 1024 * 6144, 6144, 64 * nbk, C.in[1], C.in[3], C.in[5] + i * 6144, modv + (i * 2 + 0) * 6144, modv + (i * 2 + 1) * 6144, 0, 0);
    }
    float* tabc = (float*)(C.ws + WS_TABC); float* tabs = (float*)(C.ws + WS_TABS);
    for (int idx = C.bid * 512 + C.tid; idx < 320 * 64; idx += C.G * 512) {
        const int ti = idx >> 6, i = idx & 63; const float pos = (float)(ti < 256 ? ti : ti - 256);
        const float inv = exp2f(-(float)i * (13.287712379549449f / 64.0f)); const float ang = pos * inv;
        tabc[idx] = __cosf(ang); tabs[idx] = __sinf(ang);
    }
}
__device__ __forceinline__ void phase_p1(Ctx& C) {
    const float* modv = (const float*)(C.ws + WS_MODV);
    float* s1 = (float*)(C.ws + WS_S1); float* s2 = (float*)(C.ws + WS_S2);
    for (int idx = C.bid * 512 + C.tid; idx < 8192; idx += C.G * 512) {
        const int i = idx >> 11, s = (idx >> 10) & 1, k = idx & 1023;
        const float l1 = 1.f + modv[(i * 2) * 6144 + 1024 + k], l2 = 1.f + modv[(i * 2) * 6144 + 4096 + k];
        s1[idx] = s ? (l1 != 0.f ? (1.f + modv[(i * 2 + 1) * 6144 + 1024 + k]) / l1 : 0.f) : C.in[6][i * 1024 + k] * l1;
        s2[idx] = s ? (l2 != 0.f ? (1.f + modv[(i * 2 + 1) * 6144 + 4096 + k]) / l2 : 0.f) : C.in[7][i * 1024 + k] * l2;
    }
    float* cvA = (float*)(C.ws + WS_CVA); float* cvF = (float*)(C.ws + WS_CVF);
    for (int u = C.bid; u < 672; u += C.G) {
        if (u < 320) {
            int i, nbk; if (u < 32) { i = 0; nbk = u; } else if (u < 160) { i = 1; nbk = u - 32; } else if (u < 192) { i = 2; nbk = u - 160; } else { i = 3; nbk = u - 192; }
            const int j = i >> 1; const float* v0 = modv + (i * 2 + 0) * 6144; const float* v1 = modv + (i * 2 + 1) * 6144;
            if (i == 0) gemv2_unit<0, false>(C, C.in[8] + (size_t)j * 1024 * 2048, 2048, 64 * nbk, v0, v1, C.in[9] + j * 2048, cvA + (i * 2) * 8192, cvA + (i * 2 + 1) * 8192, 1, 1024);
            else if ((i & 1) == 0) gemv2_unit<0>(C, C.in[8] + (size_t)j * 1024 * 2048, 2048, 64 * nbk, v0, v1, C.in[9] + j * 2048, cvA + (i * 2) * 8192, cvA + (i * 2 + 1) * 8192, 1, 1024);
            else gemv2_unit<0>(C, C.in[16] + (size_t)j * 1024 * 8192, 8192, 64 * nbk, v0, v1, nullptr, cvA + (i * 2) * 8192, cvA + (i * 2 + 1) * 8192, 2, 0);
        } else {
            const int i = (u - 320) / 88, nbk = (u - 320) % 88;
            const float* v0 = modv + (i * 2 + 0) * 6144 + 3072; const float* v1 = modv + (i * 2 + 1) * 6144 + 3072;
            if (i == 0) gemv2_unit<0, false>(C, C.in[19] + (size_t)i * 1024 * FF2, FF2, 64 * nbk, v0, v1, nullptr, cvF + (i * 2) * FF2, cvF + (i * 2 + 1) * FF2, 1, DFF);
            else gemv2_unit<0>(C, C.in[19] + (size_t)i * 1024 * FF2, FF2, 64 * nbk, v0, v1, nullptr, cvF + (i * 2) * FF2, cvF + (i * 2 + 1) * FF2, 1, DFF);
        }
    }
    bf16_t* xs = (bf16_t*)C.out; float* stats = (float*)(C.ws + WS_STATS); float* xctx = (float*)(C.ws + WS_XCTX);
    for (int row = C.bid * 8 + C.wave; row < R; row += C.G * 8) {
        const bool lat = row < T;
        const float* src = lat ? C.in[0] + (size_t)row * 1024 : C.in[2] + (size_t)(row - T) * 1024;
        float ss = 0.f;
#pragma unroll
        for (int jj = 0; jj < 4; ++jj) {
            const int k = 4 * C.lane + 256 * jj;
            const f32x4 v = *(const f32x4*)(src + k);
            ss += (v[0] * v[0] + v[1] * v[1]) + (v[2] * v[2] + v[3] * v[3]);
            f32x4 f = {1.f, 1.f, 1.f, 1.f};
            if (!lat) { const f32x4 ml = *(const f32x4*)(modv + 1024 + k), mc = *(const f32x4*)(modv + 6144 + 1024 + k);
#pragma unroll
                for (int e = 0; e < 4; ++e) { const float l1 = 1.f + ml[e]; f[e] = l1 != 0.f ? (1.f + mc[e]) / l1 : 0.f; } }
            u32x2 w; w.x = pk2(v[0] * f[0], v[1] * f[1]); w.y = pk2(v[2] * f[2], v[3] * f[3]);
            *(u32x2*)(xs + (size_t)row * 1024 + ((k & ~31) | ((k & 12) << 1) | ((k & 16) >> 2))) = w;
        }
#pragma unroll
        for (int off = 1; off < 64; off <<= 1) ss += __shfl_xor(ss, off);
        if (C.lane < 16) stats[(size_t)row * 16 + C.lane] = C.lane == 0 ? ss : 0.f;
    }
    prep_layer(C, 0, 7, 0);
}
__device__ __forceinline__ void phase_final(Ctx& C) {
    const float* stats = (const float*)(C.ws + WS_STATS);
    for (int row = C.bid * 8 + C.wave; row < T; row += C.G * 8) {
        float s = C.lane < 16 ? stats[(size_t)row * 16 + C.lane] : 0.f;
#pragma unroll
        for (int off = 1; off < 64; off <<= 1) s += __shfl_xor(s, off);
        const float r = __builtin_amdgcn_rsqf(s * (1.f / 1024.f) + NORM_EPS);
        float* xr = C.out + (size_t)row * 1024; const float* xf = (const float*)(C.ws + WS_GF) + (size_t)row * 1024;
#pragma unroll
        for (int jj = 0; jj < 4; ++jj) { const int k = 4 * C.lane + 256 * jj; const f32x4 v = __builtin_nontemporal_load((const f32x4*)(xf + k)), g = *(const f32x4*)(C.in[21] + k); *(f32x4*)(xr + k) = v * r * g; }
    }
}

constexpr int NPHASE = 31;
template <int SK  , int RK = 0  >
__device__ __forceinline__ void run_phase(Ctx& C, int ph) {
    const int i = (ph - 2) / 7, sub = (ph - 2) % 7, j = i >> 1; const bool conv = (i & 1) == 0;
    const bool last = i == DEPTH - 1;
    float* stats = (float*)(C.ws + WS_STATS);
    const bf16_t* xs = (const bf16_t*)C.out;
    constexpr int F_MODV = (int)(WS_MODV / 4), F_S1 = (int)(WS_S1 / 4), F_S2 = (int)(WS_S2 / 4), F_CVA = (int)(WS_CVA / 4), F_CVF = (int)(WS_CVF / 4);
    if constexpr (SK == 0 || SK == 1) {
        if constexpr (SK == 0) { EpiGLU E{C.ws, F_CVA + (i * 2) * 8192, 8192, (int)WS_U, 1024, 0, stats}; gemm_both<8>(C, xs, (const bf16_t*)(C.ws + WS_WA), T, 2048, 1024, E, 0, 8); }
        else {
            EpiWin E{C.ws, F_CVA + (i * 2) * 8192, stats};
            const bf16_t* WA = (const bf16_t*)(C.ws + WS_WA);
            const bool ctx_first = ((C.bid >> 3) & 1) != 0;
            if (ctx_first) { sgemm_small<8, 4>(C, xs, WA, T, R - T, E, last ? 4 : 0, last ? 16 : 32); }
            gemm_both<8>(C, xs, WA, T, 8192, 1024, E, 0, 0, 0, 8);
            { pg8::Gemm g{xs, WA + (size_t)2048 * 1024, T, 2048, 1024}; pg8::StaticOrder S; S.init(T, 2048, C.G, C.bid); EpiVt EV{C.ws, F_CVA + (i * 2) * 8192};
              pg8::gemm_phase<EpiVt, pg8::StaticOrder, true, true, true, true>(C.lds, g, S, EV); }
            gemm_both<8>(C, xs, WA, T, 8192, 1024, E, 0, 0, 16, 32);
            if (!ctx_first) { __syncthreads(); relane(C); sgemm_small<8, 4>(C, xs, WA, T, R - T, E, last ? 4 : 0, last ? 16 : 32); }
        }
    } else if constexpr (SK == 2) {
        EpiGLU E{C.ws, F_CVF + (i * 2) * FF2, FF2, (int)WS_H, DFF, 1, stats}; gemm_both<16>(C, xs, (const bf16_t*)(C.ws + WS_WF1), last ? T : R, FF2, 1024, E, 0, 0);
        if (!last) { __syncthreads(); relane(C); prep_layer(C, i + 1, 5, C.G == 256 ? 150 : 0); }
    } else {
        const bool f2 = sub == 6;
        const int mgoff = F_MODV + (i * 2) * 6144 + (f2 ? 5120 : 2048);
        const int snoff = f2 ? (last ? -1 : F_S1 + ((i + 1) * 2) * 1024) : F_S2 + (i * 2) * 1024;
        const float* bias = (!f2 && conv) ? C.in[15] + j * 1024 : nullptr;
        const bf16_t* A = (const bf16_t*)(C.ws + (f2 ? WS_H : (conv ? WS_A2 : WS_GF)));
        const bf16_t* Bt = (const bf16_t*)(C.ws + (f2 ? WS_WF2 : WS_WA2));
        const int K = f2 ? DFF : (conv ? 1024 : 2048);
        const bool first = (i == 0 && !f2);
        EpiRes E{C.ws, (bf16_t*)C.out, (float*)(C.ws + WS_GF), C.in[0], first ? C.in[2] : (const float*)(C.ws + WS_XCTX), bias, mgoff, snoff, stats};
        { pg8::Gemm g{A, Bt, T, 1024, K}; pg8::StaticOrder S; S.init(T, 1024, C.G, C.bid); EpiResBig EB{E, C.lds, RK ? RK == 1 : first, RK ? RK == 3 : (f2 && last)};
          pg8::gemm_phase<EpiResBig, pg8::StaticOrder, true, true>(C.lds, g, S, EB); }
        if (!last) { __syncthreads(); relane(C);
            if (K == 1024) sgemm_small<4, 4>(C, A, Bt, T, R - T, E, 0, 4); else if (K == 2048) sgemm_small<4, 8>(C, A, Bt, T, R - T, E, 0, 4); else sgemm_small<4, 11>(C, A, Bt, T, R - T, E, 0, 4); }
    }
}

#define XB_TMO      128
#define XB_XCNT(j)  (256  + 64 * (j))
#define XB_XSUB(j)  (1280 + 64 * (j))
#define XB_XGEN(j)  (2304 + 64 * (j))
#define XB_TOP      3328
#define XB_TOPGEN   3392
#define XCD_BAR_WORDS 3456
#define XB_SPIN_CAP (1u << 20)
__device__ __forceinline__ unsigned xb_ld(unsigned* p)              { return __hip_atomic_load(p, __ATOMIC_RELAXED, __HIP_MEMORY_SCOPE_AGENT); }
__device__ __forceinline__ unsigned xb_add(unsigned* p, unsigned v) { return __hip_atomic_fetch_add(p, v, __ATOMIC_RELAXED, __HIP_MEMORY_SCOPE_AGENT); }
__device__ __forceinline__ unsigned xb_xcc_id() { return (unsigned)__builtin_amdgcn_s_getreg((3 << 11) | 20) & 0xFu; }
#define XB_SPIN(cond, bar) do { unsigned _sp = 0; while (cond) { __builtin_amdgcn_s_sleep(1); \
    if ((++_sp & 255u) == 0u) { if (xb_ld(&(bar)[XB_TMO])) break; if (_sp > XB_SPIN_CAP) { atomicAdd(&(bar)[XB_TMO], 1u); break; } } } } while (0)
struct XcdBarrier { unsigned* bar; unsigned x; volatile LAS unsigned* st; };
__device__ __forceinline__ XcdBarrier xcd_barrier_post(unsigned* bar, volatile LAS unsigned* st) {
    XcdBarrier b; b.bar = bar; b.x = xb_xcc_id(); b.st = st;
    if (threadIdx.x == 0) (void)xb_add(&bar[XB_XCNT(b.x)], 1u);
    return b;
}
__device__ __forceinline__ void xcd_barrier_complete(unsigned* bar, unsigned x, unsigned& nloc, unsigned& nx) {
    const unsigned G = gridDim.x * gridDim.y * gridDim.z;
    unsigned sum, cnt, mine, sp = 0u;
    for (;;) {
        sum = 0u; cnt = 0u; mine = 0u;
#pragma unroll
        for (unsigned j = 0; j < 16; ++j) { const unsigned c = xb_ld(&bar[XB_XCNT(j)]); sum += c; cnt += (c > 0u) ? 1u : 0u; mine = (j == x) ? c : mine; }
        if (sum == G) break;
        __builtin_amdgcn_s_sleep(1);
        if ((++sp & 255u) == 0u) { if (xb_ld(&bar[XB_TMO])) break; if (sp > XB_SPIN_CAP) { atomicAdd(&bar[XB_TMO], 1u); break; } }
    }
    nloc = mine > 0u ? mine : 1u; nx = cnt > 0u ? cnt : 1u;
}
__device__ __forceinline__ void xcd_barrier(const XcdBarrier& b) {
    asm volatile("s_waitcnt vmcnt(0)" ::: "memory");
    __syncthreads();
    if (threadIdx.x == 0) {
        unsigned* bar = b.bar;
        __builtin_amdgcn_s_waitcnt(0);
        unsigned nloc = b.st[0], nx = b.st[1];
        if (nloc == 0u) { xcd_barrier_complete(bar, b.x, nloc, nx); b.st[0] = nloc; b.st[1] = nx; }
        const unsigned old = xb_add(&bar[XB_XSUB(b.x)], 1u);
        const unsigned gen = old / nloc;
        if (old + 1u == (gen + 1u) * nloc) {
            __builtin_amdgcn_fence(__ATOMIC_RELEASE, "agent");
            asm volatile("s_waitcnt vmcnt(0)" ::: "memory");
            const unsigned og = xb_add(&bar[XB_TOP], 1u);
            __builtin_amdgcn_fence(__ATOMIC_ACQUIRE, "agent");
            const unsigned tg = og / nx;
            if (og + 1u == (tg + 1u) * nx) xb_add(&bar[XB_TOPGEN], 1u);
            else XB_SPIN(xb_ld(&bar[XB_TOPGEN]) == tg, bar);
            asm volatile("s_waitcnt vmcnt(0)" ::: "memory");
        } else {
            __builtin_amdgcn_fence(__ATOMIC_ACQUIRE, "agent");
            asm volatile("s_waitcnt vmcnt(0)" ::: "memory");
            XB_SPIN(xb_ld(&bar[XB_TOPGEN]) == gen, bar);
            asm volatile("" ::: "memory");
        }
    }
    __syncthreads();
}
constexpr int MISC_OFF = LDS_BYTES - 512;
constexpr int CW_BAR = 4096;

#ifndef PROBE_DUP
#define PROBE_DUP 0
#endif
#if ONE_LAUNCH
template <int PH> __device__ __forceinline__ void phase_body(Ctx& C) {
    constexpr int i = (PH - 2) / 7, sub = (PH - 2) % 7, j = i >> 1; constexpr bool conv = (i & 1) == 0;
    if (PH == 0) phase_p0(C);
    else if (PH == 1) phase_p1(C);
    else if (PH == 30) phase_final(C);
    else if (sub == 1) { if (i > 0) { prep_layer(C, i, 2, (!conv && C.G == 256) ? 16 : 0); __syncthreads(); } if (conv) dwconv_phase(C, j); else ugemm_phase(C, j); }
    else if (sub == 2) prefix_phase(C, j);
    else if (sub == 3) readout_phase(C, j, i == DEPTH - 1);
    else run_phase<(sub == 0 ? (conv ? 0 : 1) : (sub == 5 ? 2 : 3))>(C, PH);
}
template <int PH> __device__ __forceinline__ void one_phase(Ctx& C, const Args& args, const XcdBarrier& bar) {
    constexpr int i = (PH - 2) / 7, sub = (PH - 2) % 7; constexpr bool conv = (i & 1) == 0;
    if (PH >= 2 && PH < 30) { if ((sub == 2 || sub == 3) && conv) return; }
    if (PH > 0) xcd_barrier(bar);
    relane(C);
    phase_body<PH>(C);
    constexpr bool dup = ((PH >= 2 && PH < 30) && (((PROBE_DUP & 1) && (sub == 0 || sub == 5)) || ((PROBE_DUP & 2) && sub == 1 && !conv) || ((PROBE_DUP & 4) && sub == 1 && conv))) || ((PROBE_DUP & 16) && PH < 2);
    if constexpr (dup) { xcd_barrier(bar); phase_body<PH>(C); }
}
template <int... PHS> __device__ __forceinline__ void all_phases(Ctx& C, const Args& args, const XcdBarrier& bar, std::integer_sequence<int, PHS...>) { (one_phase<PHS>(C, args, bar), ...); }
__global__ void __launch_bounds__(512, 2) mega_kernel(Args args) {
    extern __shared__ __attribute__((aligned(16))) unsigned char lds_raw[];
    Ctx C;
    C.lds = (LAS unsigned char*)lds_raw; C.tid = threadIdx.x; C.lane = C.tid & 63; C.wave = __builtin_amdgcn_readfirstlane(C.tid >> 6); C.G = gridDim.x; C.bid = blockIdx.x;
    C.in = args.in; C.out = args.out; C.ws = args.ws;
    volatile LAS unsigned* MISC = (volatile LAS unsigned*)(C.lds + MISC_OFF);
    if (C.tid < 32) MISC[C.tid] = 0u;
    __syncthreads();
    XcdBarrier bar = xcd_barrier_post((unsigned*)(C.ws + WS_CTL) + CW_BAR, MISC + 8);
    all_phases(C, args, bar, std::make_integer_sequence<int, NPHASE>{});
}

#endif
#if !ONE_LAUNCH
template <int KIND>
__global__ void __launch_bounds__(512, 2) phase_kernel(Args args) {
    extern __shared__ __attribute__((aligned(16))) unsigned char lds_raw[];
    Ctx C;
    C.lds = (LAS unsigned char*)lds_raw; C.tid = threadIdx.x; C.lane = C.tid & 63; C.wave = __builtin_amdgcn_readfirstlane(C.tid >> 6); C.G = gridDim.x; C.bid = blockIdx.x;
    C.in = args.in; C.out = args.out; C.ws = args.ws;
    const int ph = args.ph_lo;
    if (KIND == 0) phase_p0(C);
    else if (KIND == 1) phase_p1(C);
    else if (KIND == 30) phase_final(C);
    else {
        const int i = (ph - 2) / 7, j = i >> 1; const bool conv = (i & 1) == 0;
        if (KIND == 2) prefix_phase(C, j);
        else if (KIND == 4) { if (i > 0) { prep_layer(C, i, 2, (!conv && C.G == 256) ? 16 : 0); __syncthreads(); } if (conv) dwconv_phase(C, j); else ugemm_phase(C, j); }
        else if (KIND == 5) readout_phase(C, j, i == DEPTH - 1);
        else if (KIND == 31) run_phase<0>(C, ph);
        else if (KIND == 32) run_phase<1>(C, ph);
        else if (KIND == 33) run_phase<2>(C, ph);
        else if (KIND == 34) run_phase<3, 1>(C, ph);
        else if (KIND == 35) run_phase<3, 2>(C, ph);
        else run_phase<3, 3>(C, ph);
    }
}

#endif
#ifndef PROBE_RD
#define PROBE_RD 0
#endif
#if PROBE_RD
__global__ void __launch_bounds__(512, 2) probe_read_kernel(Args args) {
    extern __shared__ __attribute__((aligned(16))) unsigned char lds_raw[];
    Ctx C;
    C.lds = (LAS unsigned char*)lds_raw; C.tid = threadIdx.x; C.lane = C.tid & 63; C.wave = __builtin_amdgcn_readfirstlane(C.tid >> 6); C.G = gridDim.x; C.bid = blockIdx.x;
    C.in = args.in; C.out = args.out; C.ws = args.ws;
    readout_phase<PROBE_RD>(C, 1, true);
}
#endif
extern "C" void kernel_launch(void* const* d_in, const int* in_sizes, int n_in, void* d_out, int out_size, void* d_ws, size_t ws_size, hipStream_t stream) {
    static int grid = 0;
    if (grid == 0) {
        if (n_in != 22 || out_size != T * D || ws_size < WS_END + (PROBE_RD ? 20 * MiB : 0)) { fprintf(stderr, "kernel_launch: unexpected problem (n_in %d out %d ws %zu, need %zu)\n", n_in, out_size, ws_size, (size_t)WS_END); grid = -1; return; }
        int dev = 0, cus = 0;
        if (hipGetDevice(&dev) != hipSuccess || hipDeviceGetAttribute(&cus, hipDeviceAttributeMultiprocessorCount, dev) != hipSuccess) { grid = -1; return; }
        bool ok = true;
#if !ONE_LAUNCH
        ok &= hipFuncSetAttribute((const void*)phase_kernel<0>, hipFuncAttributeMaxDynamicSharedMemorySize, LDS_BYTES) == hipSuccess;
        ok &= hipFuncSetAttribute((const void*)phase_kernel<1>, hipFuncAttributeMaxDynamicSharedMemorySize, LDS_BYTES) == hipSuccess;
        ok &= hipFuncSetAttribute((const void*)phase_kernel<2>, hipFuncAttributeMaxDynamicSharedMemorySize, LDS_BYTES) == hipSuccess;
        ok &= hipFuncSetAttribute((const void*)phase_kernel<31>, hipFuncAttributeMaxDynamicSharedMemorySize, LDS_BYTES) == hipSuccess;
        ok &= hipFuncSetAttribute((const void*)phase_kernel<32>, hipFuncAttributeMaxDynamicSharedMemorySize, LDS_BYTES) == hipSuccess;
        ok &= hipFuncSetAttribute((const void*)phase_kernel<33>, hipFuncAttributeMaxDynamicSharedMemorySize, LDS_BYTES) == hipSuccess;
        ok &= hipFuncSetAttribute((const void*)phase_kernel<34>, hipFuncAttributeMaxDynamicSharedMemorySize, LDS_BYTES) == hipSuccess;
        ok &= hipFuncSetAttribute((const void*)phase_kernel<35>, hipFuncAttributeMaxDynamicSharedMemorySize, LDS_BYTES) == hipSuccess;
        ok &= hipFuncSetAttribute((const void*)phase_kernel<36>, hipFuncAttributeMaxDynamicSharedMemorySize, LDS_BYTES) == hipSuccess;
        ok &= hipFuncSetAttribute((const void*)phase_kernel<4>, hipFuncAttributeMaxDynamicSharedMemorySize, LDS_BYTES) == hipSuccess;
        ok &= hipFuncSetAttribute((const void*)phase_kernel<5>, hipFuncAttributeMaxDynamicSharedMemorySize, LDS_BYTES) == hipSuccess;
        ok &= hipFuncSetAttribute((const void*)phase_kernel<30>, hipFuncAttributeMaxDynamicSharedMemorySize, LDS_BYTES) == hipSuccess;
#endif
#if ONE_LAUNCH
        ok &= hipFuncSetAttribute((const void*)mega_kernel, hipFuncAttributeMaxDynamicSharedMemorySize, LDS_BYTES) == hipSuccess;
#endif
        if (!ok) { fprintf(stderr, "kernel_launch: hipFuncSetAttribute failed\n"); grid = -1; return; }
        grid = cus > 0 ? cus : 256;
    }
    if (grid < 0) return;
    Args a{};
    for (int i = 0; i < 22; ++i) a.in[i] = (const float*)d_in[i];
    a.out = (float*)d_out; a.ws = (unsigned char*)d_ws;
#if ONE_LAUNCH
    if (hipMemsetAsync((char*)d_ws + WS_CTL, 0, 65536, stream) != hipSuccess) { fprintf(stderr, "kernel_launch: memset failed\n"); return; }
    a.ph_lo = 0; a.ph_hi = NPHASE;
    hipLaunchKernelGGL(mega_kernel, dim3(grid), dim3(512), LDS_BYTES, stream, a);
    return;
#endif
#if !ONE_LAUNCH
    for (int ph = 0; ph < NPHASE; ++ph) {
        const int i = (ph - 2) / 7, sub = (ph - 2) % 7;
        if (ph >= 2 && ph < 30) { if ((sub == 2 || sub == 3) && (i & 1) == 0) continue; }
        a.ph_lo = ph; a.ph_hi = ph + 1;
        const dim3 g(grid), b(512);
        if (ph == 0) hipLaunchKernelGGL(phase_kernel<0>, g, b, LDS_BYTES, stream, a);
        else if (ph == 1) hipLaunchKernelGGL(phase_kernel<1>, g, b, LDS_BYTES, stream, a);
        else if (ph == 30) hipLaunchKernelGGL(phase_kernel<30>, g, b, LDS_BYTES, stream, a);
        else if (sub == 2) hipLaunchKernelGGL(phase_kernel<2>, g, b, LDS_BYTES, stream, a);
        else if (sub == 1) hipLaunchKernelGGL(phase_kernel<4>, g, b, LDS_BYTES, stream, a);
        else if (sub == 3) hipLaunchKernelGGL(phase_kernel<5>, g, b, LDS_BYTES, stream, a);
        else { const bool cv_ = (i & 1) == 0; if (sub == 0) { if (cv_) hipLaunchKernelGGL(phase_kernel<31>, g, b, LDS_BYTES, stream, a); else hipLaunchKernelGGL(phase_kernel<32>, g, b, LDS_BYTES, stream, a); }
               else if (sub == 5) hipLaunchKernelGGL(phase_kernel<33>, g, b, LDS_BYTES, stream, a);
               else if (i == 0 && sub == 4) hipLaunchKernelGGL(phase_kernel<34>, g, b, LDS_BYTES, stream, a); else if (i == DEPTH - 1 && sub == 6) hipLaunchKernelGGL(phase_kernel<36>, g, b, LDS_BYTES, stream, a); else hipLaunchKernelGGL(phase_kernel<35>, g, b, LDS_BYTES, stream, a); }
#ifdef PROBE_G
        if (ph == 30) { Args a2 = a; a2.ph_lo = PROBE_G; a2.ph_hi = PROBE_G + 1; const int i2 = (PROBE_G - 2) / 7, s2 = (PROBE_G - 2) % 7;
            if (s2 == 0 && (i2 & 1) == 0) hipLaunchKernelGGL(phase_kernel<31>, g, b, LDS_BYTES, stream, a2); else if (s2 == 0) hipLaunchKernelGGL(phase_kernel<32>, g, b, LDS_BYTES, stream, a2); else hipLaunchKernelGGL(phase_kernel<33>, g, b, LDS_BYTES, stream, a2); }
#endif
#if PROBE_RD
        if (ph == 30) { hipFuncSetAttribute((const void*)probe_read_kernel, hipFuncAttributeMaxDynamicSharedMemorySize, LDS_BYTES); hipLaunchKernelGGL(probe_read_kernel, g, b, LDS_BYTES, stream, a); }
#endif
        {   const bool conv = (i & 1) == 0;
            const bool dup = ((ph >= 2 && ph < 30) && (((PROBE_DUP & 32) && sub == 0 && conv) || ((PROBE_DUP & 64) && sub == 0 && !conv) || ((PROBE_DUP & 128) && sub == 5) || ((PROBE_DUP & 1) && (sub == 0 || sub == 5)) || ((PROBE_DUP & 2) && sub == 1 && !conv) || ((PROBE_DUP & 4) && sub == 1 && conv))) || ((PROBE_DUP & 16) && ph < 2);
            if (dup) {
                if (ph == 0) hipLaunchKernelGGL(phase_kernel<0>, g, b, LDS_BYTES, stream, a);
                else if (ph == 1) hipLaunchKernelGGL(phase_kernel<1>, g, b, LDS_BYTES, stream, a);
                else if (sub == 2) hipLaunchKernelGGL(phase_kernel<2>, g, b, LDS_BYTES, stream, a);
                else if (sub == 1) hipLaunchKernelGGL(phase_kernel<4>, g, b, LDS_BYTES, stream, a);
                else if (sub == 0 && conv) hipLaunchKernelGGL(phase_kernel<31>, g, b, LDS_BYTES, stream, a);
                else if (sub == 0) hipLaunchKernelGGL(phase_kernel<32>, g, b, LDS_BYTES, stream, a);
                else hipLaunchKernelGGL(phase_kernel<33>, g, b, LDS_BYTES, stream, a);
            } }
    }
#endif
}
```

```cpp
#include <hip/hip_runtime.h>
#include <cstdio>
#include <cstdint>
#include <utility>

#ifndef ONE_LAUNCH
#define ONE_LAUNCH 1
#endif

typedef unsigned short bf16_t;
typedef short bf16x8 __attribute__((ext_vector_type(8)));
typedef float f32x4 __attribute__((ext_vector_type(4)));
typedef float f32x2 __attribute__((ext_vector_type(2)));
typedef unsigned u32x2 __attribute__((ext_vector_type(2)));
typedef unsigned u32x4 __attribute__((ext_vector_type(4)));
typedef __bf16 bf16x2_t __attribute__((ext_vector_type(2)));
typedef short s16x4 __attribute__((ext_vector_type(4)));
#define LAS __attribute__((address_space(3)))

constexpr int D = 1024, T = 16384, TC = 256, R = T + TC, NH = 4, DK = 256, DV = 512, QKW = 1024, VW = 2048, INW = 8192, DFF = 2816, FF2 = 5632, CK = 31, DEPTH = 4;
constexpr int NSLOT = 33;
constexpr float NORM_EPS = 1e-6f, LN_EPS = 1e-5f;

constexpr size_t MiB = 1u << 20, KiB = 1u << 10;
constexpr size_t WS_CTL = 0, CTL_ZERO_BYTES = 1 * MiB;
constexpr size_t WS_MODV = 1 * MiB;
constexpr size_t WS_S1 = 1 * MiB + 256 * KiB;
constexpr size_t WS_S2 = 1 * MiB + 320 * KiB;
constexpr size_t WS_CVA = 1 * MiB + 384 * KiB;
constexpr size_t WS_CVF = 1 * MiB + 640 * KiB;
constexpr size_t WS_TABC = 1 * MiB + 832 * KiB;
constexpr size_t WS_TABS = 1 * MiB + 912 * KiB;
constexpr size_t WS_STATS = 2 * MiB;
constexpr size_t WS_XCTX = 4 * MiB;
constexpr size_t WS_WA = 8 * MiB;
constexpr size_t WS_WA2 = 24 * MiB;
constexpr size_t WS_WF1 = 28 * MiB;
constexpr size_t WS_WF2 = 40 * MiB;
constexpr size_t WS_XS = 48 * MiB;
constexpr size_t WS_SCP = 48 * MiB;
constexpr size_t WS_BIG = 114 * MiB;
constexpr size_t WS_Q = WS_BIG, WS_K = WS_BIG + 33 * MiB, WS_VT = WS_BIG + 66 * MiB, WS_GF = WS_BIG + 131 * MiB, WS_GB = WS_BIG + 196 * MiB;
constexpr size_t WS_U = WS_BIG, WS_A2 = WS_BIG + 33 * MiB, WS_H = WS_BIG;
constexpr size_t WS_END = WS_BIG + 261 * MiB;
static_assert((size_t)R * 1024 * 2 <= 33 * MiB && (size_t)R * 2048 * 2 <= 65 * MiB && (size_t)R * DFF * 2 <= 131 * MiB, "map");
static_assert((size_t)NSLOT * 8 * 512 * 256 * 2 <= 66 * MiB, "scp");

constexpr int LDS_BYTES = 147456;

__device__ __forceinline__ unsigned pk2(float lo, float hi) { f32x2 v = {lo, hi}; bf16x2_t b = __builtin_convertvector(v, bf16x2_t); return __builtin_bit_cast(unsigned, b); }
__device__ __forceinline__ float bflo(unsigned u) { return __uint_as_float(u << 16); }
__device__ __forceinline__ float bfhi(unsigned u) { return __uint_as_float(u & 0xffff0000u); }
__device__ __forceinline__ float sigmf(float x) { return __builtin_amdgcn_rcpf(1.f + __builtin_amdgcn_exp2f(-1.4426950408889634f * x)); }
__device__ __forceinline__ float siluf(float x) { return x * sigmf(x); }
__device__ __forceinline__ float wave_sum63(float v) {
    v += __builtin_bit_cast(float, __builtin_amdgcn_update_dpp(0, __builtin_bit_cast(int, v), 0xB1, 0xF, 0xF, false));
    v += __builtin_bit_cast(float, __builtin_amdgcn_update_dpp(0, __builtin_bit_cast(int, v), 0x4E, 0xF, 0xF, false));
    v += __builtin_bit_cast(float, __builtin_amdgcn_update_dpp(0, __builtin_bit_cast(int, v), 0x141, 0xF, 0xF, false));
    v += __builtin_bit_cast(float, __builtin_amdgcn_update_dpp(0, __builtin_bit_cast(int, v), 0x140, 0xF, 0xF, false));
    v += __builtin_bit_cast(float, __builtin_amdgcn_update_dpp(0, __builtin_bit_cast(int, v), 0x142, 0xA, 0xF, false));
    v += __builtin_bit_cast(float, __builtin_amdgcn_update_dpp(0, __builtin_bit_cast(int, v), 0x143, 0xC, 0xF, false));
    return v;
}
__device__ __forceinline__ int perm_glu(int n, int H) { const int g = n >= H ? 16 : 0, oc = n >= H ? n - H : n; return 256 * (oc >> 7) + 128 * ((oc >> 2) & 1) + 32 * ((oc >> 5) & 3) + 4 * ((oc >> 3) & 3) + (oc & 3) + g; }
__device__ __forceinline__ int perm_win(int n) {
    if (n >= 4 * QKW) { const int c = n & 31; return (n & ~31) + 16 * ((c >> 2) & 1) + 4 * (c >> 3) + (c & 3); }
    if (n >= 2 * QKW) return n;
    const int part = n >> 10, hn = n & 1023, h = hn >> 8, d = hn & 255, quarter = d >> 6, idx = d & 63;
    const int Gp = (quarter >> 1) * 4 + (idx >> 4), i = (quarter & 1) * 16 + (idx & 15);
    return part * 1024 + h * 256 + 32 * Gp + i;
}
__device__ __forceinline__ int perm_any(int mode, int n, int H) { return mode == 0 ? n : (mode == 1 ? perm_glu(n, H) : perm_win(n)); }

struct Args { const float* in[22]; float* out; unsigned char* ws; int ph_lo, ph_hi; };

struct Ctx {
    LAS unsigned char* lds;
    int tid, lane, wave, G, bid;
    const float* const* in; float* out; unsigned char* ws;
};

__device__ __forceinline__ void relane(Ctx& C) {
    int wv = C.wave; asm volatile("" : "+s"(wv)); int ln = (int)__builtin_amdgcn_mbcnt_hi(~0u, __builtin_amdgcn_mbcnt_lo(~0u, 0u)); asm volatile("" : "+v"(ln));
    int bd = C.bid, gg = C.G; asm volatile("" : "+s"(bd), "+s"(gg));
    C.wave = wv; C.lane = ln; C.tid = wv * 64 + ln; C.bid = bd; C.G = gg;
}
template <int VSILU, bool NTL = true  >
__device__ __forceinline__ void gemv2_unit(Ctx& C, const float* W, int N, int n0, const float* v0, const float* v1, const float* bias, float* o0, float* o1, int pmode, int H) {
    LAS float* red = (LAS float*)C.lds;
    const int c4 = C.tid & 15, ks = C.tid >> 4;
    f32x4 a0 = {0.f, 0.f, 0.f, 0.f}, a1 = {0.f, 0.f, 0.f, 0.f};
#pragma unroll 1
    for (int b = 0; b < 2; ++b) {
        f32x4 w[16]; float x0[16], x1[16];
#pragma unroll
        for (int i = 0; i < 16; ++i) { const int k = ks * 32 + b * 16 + i; x0[i] = v0[k]; x1[i] = v1[k]; }
        __builtin_amdgcn_sched_barrier(0);
#pragma unroll
        for (int i = 0; i < 16; ++i) {
            const int k = ks * 32 + b * 16 + i;
            w[i] = NTL ? __builtin_nontemporal_load((const f32x4*)(W + (size_t)k * N + n0 + 4 * c4)) : *(const f32x4*)(W + (size_t)k * N + n0 + 4 * c4);
        }
        __builtin_amdgcn_sched_barrier(0);
#pragma unroll
        for (int i = 0; i < 16; ++i) {
            float y0 = x0[i], y1 = x1[i];
            if (VSILU) { y0 = siluf(y0); y1 = siluf(y1); }
            a0 += w[i] * y0; a1 += w[i] * y1;
        }
        __builtin_amdgcn_sched_barrier(0);
    }
#pragma unroll
    for (int e = 0; e < 4; ++e) { red[(ks * 2 + 0) * 64 + 4 * c4 + e] = a0[e]; red[(ks * 2 + 1) * 64 + 4 * c4 + e] = a1[e]; }
    __syncthreads();
    if (C.tid < 128) {
        const int s = C.tid >> 6, col = C.tid & 63; float sum = 0.f;
#pragma unroll 8
        for (int k2 = 0; k2 < 32; ++k2) sum += red[(k2 * 2 + s) * 64 + col];
        const int n = n0 + col; if (bias) sum += bias[n];
        (s ? o1 : o0)[perm_any(pmode, n, H)] = sum;
    }
    __syncthreads();
}

struct PrepItem { const float* W; bf16_t* WT; const float* sg; const float* sm; int K, N, pmode, H, k0, n0; };
__device__ __forceinline__ bool prep_decode(Ctx& C, int i, int part, int it, PrepItem& P) {
    const int j = i >> 1; const bool conv = (i & 1) == 0;
    const int I_A = (part & 1) ? (conv ? 16 * 64 : 16 * 256) : 0, I_A2 = (part & 4) ? (conv ? 16 * 32 : 32 * 32) : 0, I_F1 = (part & 2) ? 16 * 176 : 0, I_F2 = (part & 2) ? 44 * 32 : 0;
    if (it >= I_A + I_A2 + I_F1 + I_F2) return false;
    int r = it; P.sg = nullptr; P.sm = nullptr;
    if (r < I_A) { if (conv) { P.W = C.in[8] + (size_t)j * 1024 * 2048; P.K = 1024; P.N = 2048; P.pmode = 1; P.H = 1024; } else { P.W = C.in[16] + (size_t)j * 1024 * 8192; P.K = 1024; P.N = 8192; P.pmode = 2; P.H = 0; }
                   P.WT = (bf16_t*)(C.ws + WS_WA); P.sg = C.in[6] + i * 1024; P.sm = (const float*)(C.ws + WS_MODV) + (i * 2) * 6144 + 1024; }
    else if ((r -= I_A) < I_A2) { if (conv) { P.W = C.in[14] + (size_t)j * 1024 * 1024; P.K = 1024; } else { P.W = C.in[18] + (size_t)j * 2048 * 1024; P.K = 2048; }
                   P.N = 1024; P.pmode = 0; P.H = 0; P.WT = (bf16_t*)(C.ws + WS_WA2); }
    else if ((r -= I_A2) < I_F1) { P.W = C.in[19] + (size_t)i * 1024 * FF2; P.K = 1024; P.N = FF2; P.pmode = 1; P.H = DFF; P.WT = (bf16_t*)(C.ws + WS_WF1); P.sg = C.in[7] + i * 1024; P.sm = (const float*)(C.ws + WS_MODV) + (i * 2) * 6144 + 4096; }
    else { r -= I_F1; P.W = C.in[20] + (size_t)i * DFF * 1024; P.K = DFF; P.N = 1024; P.pmode = 0; P.H = 0; P.WT = (bf16_t*)(C.ws + WS_WF2); }
    const int nblk = P.N / 32; P.k0 = 64 * (r / nblk); P.n0 = 32 * (r % nblk);
    return true;
}
#define PREP_LOAD(v_, s_, P_) { float sgv[8], smv[8]; \
        _Pragma("unroll") for (int q = 0; q < 8; ++q) { const int k = (P_).k0 + 8 * q + (lane >> 3); sgv[q] = (P_).sg ? (P_).sg[k] : 1.f; smv[q] = (P_).sg ? (P_).sm[k] : 0.f; } \
        __builtin_amdgcn_sched_barrier(0); \
        _Pragma("unroll") for (int q = 0; q < 8; ++q) { const int k = (P_).k0 + 8 * q + (lane >> 3); v_[q] = __builtin_nontemporal_load((const f32x4*)((P_).W + (size_t)k * (P_).N + (P_).n0 + 4 * (lane & 7))); } \
        __builtin_amdgcn_sched_barrier(0); \
        _Pragma("unroll") for (int q = 0; q < 8; ++q) s_[q] = sgv[q] * (1.f + smv[q]); }
#define PREP_PROC(v_, s_, P_) do { \
        _Pragma("unroll") for (int q = 0; q < 8; ++q) { LAS float* d = scr + (8 * q + (lane >> 3)) * 33 + 4 * (lane & 7); d[0] = v_[q][0] * s_[q]; d[1] = v_[q][1] * s_[q]; d[2] = v_[q][2] * s_[q]; d[3] = v_[q][3] * s_[q]; } \
        asm volatile("s_waitcnt lgkmcnt(0)" ::: "memory"); \
          \
        const int rA = (P_).pmode ? 32 * (c >> 2) + 4 * (c & 3) : 8 * c, rB = (P_).pmode ? rA + 16 : rA + 4; \
        _Pragma("unroll") for (int jj = 0; jj < 4; ++jj) { const int n = (lane >> 3) + 8 * jj; const LAS float* sp = scr + rA * 33 + n; const LAS float* sq = scr + rB * 33 + n; \
            u32x4 o; o.x = pk2(sp[0 * 33], sp[1 * 33]); o.y = pk2(sp[2 * 33], sp[3 * 33]); o.z = pk2(sq[0 * 33], sq[1 * 33]); o.w = pk2(sq[2 * 33], sq[3 * 33]); \
            *(u32x4*)((P_).WT + (size_t)perm_any((P_).pmode, (P_).n0 + n, (P_).H) * (P_).K + (P_).k0 + 8 * c) = o; } \
        asm volatile("s_waitcnt lgkmcnt(0)" ::: "memory"); } while (0)
__device__ __forceinline__ void prep_layer(Ctx& C, int i, int part, int cu_lo) {
    if (C.bid < cu_lo) return;
    LAS float* scr = (LAS float*)(C.lds + C.wave * 16384);
    const int gw = (C.bid - cu_lo) * 8 + C.wave, NGW = (C.G - cu_lo) * 8, lane = C.lane, c = lane & 7;
    PrepItem PA, PB, PC; f32x4 vA[8], vB[8], vC[8]; float sA[8], sB[8], sC[8];
    bool hA = prep_decode(C, i, part, gw, PA), hB = false, hC = false;
    if (hA) { PREP_LOAD(vA, sA, PA) hB = prep_decode(C, i, part, gw + NGW, PB); }
    if (hB) { PREP_LOAD(vB, sB, PB) }
    for (int it = gw; hA; it += 3 * NGW) {
        hC = hB && prep_decode(C, i, part, it + 2 * NGW, PC);
        if (hC) { PREP_LOAD(vC, sC, PC) }
        PREP_PROC(vA, sA, PA);
        if (!hB) break;
        hA = hC && prep_decode(C, i, part, it + 3 * NGW, PA);
        if (hA) { PREP_LOAD(vA, sA, PA) }
        PREP_PROC(vB, sB, PB);
        if (!hC) break;
        hB = hA && prep_decode(C, i, part, it + 4 * NGW, PB);
        if (hB) { PREP_LOAD(vB, sB, PB) }
        PREP_PROC(vC, sC, PC);
    }
}
#undef PREP_LOAD
#undef PREP_PROC

__device__ __forceinline__ f32x4 row_rs_load(const float* stats, int row, int fq) { return *(const f32x4*)(stats + (size_t)row * 16 + 4 * fq); }
__device__ __forceinline__ float row_rs_finish(f32x4 p) {
    float s = (p[0] + p[1]) + (p[2] + p[3]);
    s += __shfl_xor(s, 16); s += __shfl_xor(s, 32);
    return __builtin_amdgcn_rsqf(s * (1.0f / 1024.0f) + NORM_EPS);
}
__device__ __forceinline__ float row_rs(const float* stats, int row, int fq) {
    const f32x4 p = *(const f32x4*)(stats + (size_t)row * 16 + 4 * fq);
    float s = (p[0] + p[1]) + (p[2] + p[3]);
    s += __shfl_xor(s, 16); s += __shfl_xor(s, 32);
    return __builtin_amdgcn_rsqf(s * (1.0f / 1024.0f) + NORM_EPS);
}
struct EpiGLU {
    static constexpr bool STATS = false, NEEDRS = true, PAIR2 = true, CVPRE = false;
    unsigned char* ws; int cvoff  , cvstride  , outoff  , ldo, act;
    float* stats;
    __device__ __forceinline__ float row_begin(int row, int fq) const { return row_rs((const float*)(ws + WS_STATS), row, fq); }
    __device__ __forceinline__ float item(int row, int colp, f32x4 v0, f32x4 v1, float rs) const {
        const float* cv = (const float*)ws + cvoff + (row < T ? 0 : cvstride);
        const f32x4 ca = *(const f32x4*)(cv + colp), cg = *(const f32x4*)(cv + colp + 16);
        float o[4];
#pragma unroll
        for (int e = 0; e < 4; ++e) { const float a = rs * v0[e] + ca[e], g = rs * v1[e] + cg[e]; o[e] = act == 0 ? a * sigmf(g) : siluf(a) * g; }
        const int oc = 128 * (colp >> 8) + 32 * ((colp >> 5) & 3) + 8 * ((colp >> 2) & 3) + 4 * ((colp >> 7) & 1);
        u32x2 w; w.x = pk2(o[0], o[1]); w.y = pk2(o[2], o[3]);
        *(u32x2*)((bf16_t*)(ws + outoff) + (size_t)row * ldo + oc) = w;
        return 0.f;
    }
    struct CV { f32x4 ca0, cg0, ca1, cg1; };
    __device__ __forceinline__ CV load_cv(int row, int colp) const {
        const float* cv = (const float*)ws + cvoff + (row < T ? 0 : cvstride);
        return CV{*(const f32x4*)(cv + colp), *(const f32x4*)(cv + colp + 16), *(const f32x4*)(cv + colp + 128), *(const f32x4*)(cv + colp + 144)};
    }
    __device__ __forceinline__ void item2(int row, int colp, f32x4 a0, f32x4 g0, f32x4 a1, f32x4 g1, float rs, const CV& cvv) const {
        const f32x4 ca0 = cvv.ca0, cg0 = cvv.cg0, ca1 = cvv.ca1, cg1 = cvv.cg1;
        float o[8];
#pragma unroll
        for (int e = 0; e < 4; ++e) { const float a = rs * a0[e] + ca0[e], g = rs * g0[e] + cg0[e]; o[e] = act == 0 ? a * sigmf(g) : siluf(a) * g;
                                      const float b = rs * a1[e] + ca1[e], h = rs * g1[e] + cg1[e]; o[4 + e] = act == 0 ? b * sigmf(h) : siluf(b) * h; }
        const int oc = 128 * (colp >> 8) + 32 * ((colp >> 5) & 3) + 8 * ((colp >> 2) & 3);
        u32x4 w; w.x = pk2(o[0], o[1]); w.y = pk2(o[2], o[3]); w.z = pk2(o[4], o[5]); w.w = pk2(o[6], o[7]);
        *(u32x4*)((bf16_t*)(ws + outoff) + (size_t)row * ldo + oc) = w;
    }
};
struct EpiRes {
    static constexpr bool STATS = true, NEEDRS = false, PAIR2 = false, CVPRE = false;
    unsigned char* ws; bf16_t* xb  ; float* xl; const float* xin  ; const float* cin  ; const float* bias;
    int mgoff  , snoff  ;
    float* stats;
    __device__ __forceinline__ float row_begin(int, int) const { return 1.f; }
    __device__ __forceinline__ float item(int row, int colp, f32x4 v0, f32x4 v1, float) const {
        const bool lat = row < T;
        float* xr = lat ? xl + (size_t)row * 1024 : (float*)(ws + WS_XCTX) + (size_t)(row - T) * 1024;
        const float* xi = lat ? xin + (size_t)row * 1024 : cin + (size_t)(row - T) * 1024;
        const float* mg = (const float*)ws + mgoff + (lat ? 0 : 6144); const float* sn = (const float*)ws + snoff + (lat ? 0 : 1024);
        bf16_t* xs = xb;
        float ss = 0.f; u32x4 w;
#pragma unroll
        for (int hlf = 0; hlf < 2; ++hlf) {
            const int c = colp + 16 * hlf; const f32x4 v = hlf ? v1 : v0;
            const f32x4 xo = *(const f32x4*)(xi + c), m4 = *(const f32x4*)(mg + c);
            f32x4 b4 = {0.f, 0.f, 0.f, 0.f}; if (bias) b4 = *(const f32x4*)(bias + c);
            const f32x4 xn = xo + m4 * (v + b4);
            *(f32x4*)(xr + c) = xn;
            ss += (xn[0] * xn[0] + xn[1] * xn[1]) + (xn[2] * xn[2] + xn[3] * xn[3]);
            if (snoff >= 0) { const f32x4 s4 = *(const f32x4*)(sn + c); const unsigned p0 = pk2(xn[0] * s4[0], xn[1] * s4[1]), p1 = pk2(xn[2] * s4[2], xn[3] * s4[3]); if (hlf) { w.z = p0; w.w = p1; } else { w.x = p0; w.y = p1; } }
        }
        if (snoff >= 0) *(u32x4*)(xs + (size_t)row * 1024 + (colp & ~31) + 2 * (colp & 31)) = w;
        return ss;
    }
};
struct EpiWin {
    static constexpr bool STATS = false, NEEDRS = true, PAIR2 = false, CVPRE = true;
    unsigned char* ws; int cvoff;
    float* stats;
    __device__ __forceinline__ float row_begin(int row, int fq) const { return row_rs((const float*)(ws + WS_STATS), row, fq); }
    __device__ __forceinline__ float item(int row, int colp, f32x4 v0, f32x4 v1, float rs) const {
        const float* cv = (const float*)ws + cvoff + (row < T ? 0 : 8192);
        return item_cv(row, colp, v0, v1, rs, *(const f32x4*)(cv + colp), *(const f32x4*)(cv + colp + 16));
    }
    struct CVW { f32x4 c[2][2]; };
    __device__ __forceinline__ CVW load_cvw(int row, int colp) const {
        const float* cv = (const float*)ws + cvoff + (row < T ? 0 : 8192);
        return CVW{{{*(const f32x4*)(cv + colp), *(const f32x4*)(cv + colp + 16)}, {*(const f32x4*)(cv + colp + 128), *(const f32x4*)(cv + colp + 144)}}};
    }
    __device__ __forceinline__ float item_cv(int row, int colp, f32x4 v0, f32x4 v1, float rs, f32x4 c0, f32x4 c1) const {
        f32x4 a = v0 * rs + c0, b = v1 * rs + c1;
        if (colp < 2048) {
            if (row < T) {
                const int Gp = (colp >> 5) & 7, idx0 = 16 * (Gp & 3) + (colp & 15);
                const int ti = (Gp >> 2) ? 256 + (row & 63) : (row >> 6);
                const f32x4 cs = *(const f32x4*)((const float*)(ws + WS_TABC) + ti * 64 + idx0), sn = *(const f32x4*)((const float*)(ws + WS_TABS) + ti * 64 + idx0);
                const f32x4 o1 = a * cs - b * sn, o2 = b * cs + a * sn; a = o1; b = o2;
            }
            bf16_t* dst = (bf16_t*)(ws + WS_Q);
            if (colp >= 1024) { dst = (bf16_t*)(ws + WS_K); a = a * 0.0625f; b = b * 0.0625f; }
            const int cp = colp & 1023, c = (cp & ~31) + 2 * (cp & 31);
            u32x4 w; w.x = pk2(a[0], a[1]); w.y = pk2(a[2], a[3]); w.z = pk2(b[0], b[1]); w.w = pk2(b[2], b[3]); *(u32x4*)(dst + (size_t)row * 1024 + c) = w;
        } else if (colp < 4096) {
            const int c = colp - 2048;
            bf16_t* vt = (bf16_t*)(ws + WS_VT);
#pragma unroll
            for (int e = 0; e < 4; ++e) { vt[(size_t)(c + e) * R + row] = (bf16_t)(pk2(a[e], 0.f) & 0xffffu); vt[(size_t)(c + 16 + e) * R + row] = (bf16_t)(pk2(b[e], 0.f) & 0xffffu); }
        } else {
            bf16_t* dst = (bf16_t*)(ws + (colp < 6144 ? WS_GF : WS_GB)); const int cp = (colp - 4096) & 2047, c = (cp & ~31) + 2 * (cp & 31);
            u32x4 w; w.x = pk2(a[0], a[1]); w.y = pk2(a[2], a[3]); w.z = pk2(b[0], b[1]); w.w = pk2(b[2], b[3]); *(u32x4*)(dst + (size_t)row * 2048 + c) = w;
        }
        return 0.f;
    }
};

namespace pg8 {
#define PG8_LAS __attribute__((address_space(3)))
typedef unsigned short bf16_t;
typedef short bf16x8 __attribute__((ext_vector_type(8)));
typedef float f32x4 __attribute__((ext_vector_type(4)));
typedef unsigned u32x4 __attribute__((ext_vector_type(4)));
constexpr int BM = 256, BK = 64, HALF = 128, HTB = HALF * BK * 2  , STAGE_BYTES = 8 * HTB, NXCD = 8, WGM = 8;

__host__ __device__ __forceinline__ int lds_byte(int r, int c) { const int st = (r >> 4) * 2 + (c >> 5), rr = r & 15, cc = c & 31, ob = rr * 64 + cc * 2; return st * 1024 + (ob ^ (((ob >> 9) & 1) << 5)); }
__host__ __device__ __forceinline__ void stage_rc(int b, int& R, int& C) { const int st = b / 1024, sb = b % 1024, swz = sb ^ (((sb >> 9) & 1) << 5); R = (st >> 1) * 16 + swz / 64; C = (st & 1) * 32 + (swz % 64) / 2; }
__host__ __device__ __forceinline__ int perm32(int rho) { const int n = rho >> 4, i = rho & 15; return 8 * (i >> 2) + 4 * n + (i & 3); }

struct Unit { int pm, pn; };
struct Gemm { const bf16_t* A; const bf16_t* Bt; int M, N, K; };

struct StaticOrder {
    int nM, nN, nwg, G, c;
    __host__ __device__ void init(int M, int N, int G_, int c_) { nM = M / BM; nN = N / BM; nwg = nM * nN; G = G_; c = c_; }
    __host__ __device__ bool next(int i, Unit& u) const {
        const long L = (long)i * G + c; if (L >= nwg) return false;
        int wgid = (int)L; { const int q = nwg / NXCD, r = nwg % NXCD, xcd = wgid % NXCD, off = wgid / NXCD; wgid = (xcd < r ? xcd * (q + 1) : r * (q + 1) + (xcd - r) * q) + off; }
        const int nig = WGM * nN, gid = wgid / nig, fm = gid * WGM, gsz = (nM - fm) < WGM ? (nM - fm) : WGM;
        u.pm = fm + ((wgid % nig) % gsz); u.pn = (wgid % nig) / gsz; return true;
    }
    __device__ __forceinline__ void a_ready(const Unit&) const {}
    __device__ __forceinline__ void done(const Unit&) const {}
};

template <class Epi, class Sched, bool ALIGN_EPI = false, bool SP2 = false, bool SWAPMMA = false, bool ROWPERM = false  >
__device__ __forceinline__ void gemm_phase(PG8_LAS unsigned char* lds, const Gemm g, const Sched& S, const Epi& E) {
    int tid = threadIdx.x; asm volatile("" : "+v"(tid));
    const int wid = __builtin_amdgcn_readfirstlane(tid >> 6), lane = tid & 63, wr = wid >> 2, wc = wid & 3, fr = lane & 15, fq = lane >> 4;
    const int K = g.K, nt = K / BK;
    unsigned voffA[2], voffB[2];
#pragma unroll
    for (int i = 0; i < 2; ++i) { int R, C; stage_rc(tid * 16 + i * 8192, R, C); const int Rb = Epi::PERM ? ((R & ~31) + perm32(R & 31)) : R;
        const int Ra = ROWPERM ? ((R & ~31) + 8 * ((R >> 2) & 3) + 4 * ((R >> 4) & 1) + (R & 3)) : R;
        voffA[i] = (unsigned)(Ra * K + C) * 2u; voffB[i] = (unsigned)(Rb * K + C) * 2u; }
    const size_t kstep = (size_t)(BK * 2);
    const size_t hstep = (size_t)HALF * K * 2;
    const size_t tstep = 2 * hstep;
    const unsigned ldsw = (unsigned)wid * 1024u;
    const int aoff = lds_byte(wr * 64 + fr, fq * 8), boff = lds_byte(wc * 32 + fr, fq * 8);
#define PG8_SA(b, h) (((b) * 2 + (h)) * HTB)
#define PG8_SB(b, h) ((4 + (b) * 2 + (h)) * HTB)
#define PG8_STAGE(bufoff, gbase, voff) do { _Pragma("unroll") for (int _i = 0; _i < 2; ++_i) \
        __builtin_amdgcn_global_load_lds((const unsigned*)((const char*)(gbase) + (voff)[_i]), (PG8_LAS unsigned*)(lds + (bufoff) + ldsw + _i * 8192), 16, 0, 0); } while (0)
#define PG8_LDA(dst, b, h) do { _Pragma("unroll") for (int m = 0; m < 4; ++m) _Pragma("unroll") for (int k = 0; k < 2; ++k) dst[m][k] = *(const PG8_LAS bf16x8*)(lds + PG8_SA(b, h) + aoff + m * 2048 + k * 1024); } while (0)
#define PG8_LDB(dst, b, h) do { _Pragma("unroll") for (int n = 0; n < 2; ++n) _Pragma("unroll") for (int k = 0; k < 2; ++k) dst[n][k] = *(const PG8_LAS bf16x8*)(lds + PG8_SB(b, h) + boff + n * 2048 + k * 1024); } while (0)
#define PG8_MMA(ai, bj, At, Bt) do { __builtin_amdgcn_s_setprio(1); _Pragma("unroll") for (int m = 0; m < 4; ++m) _Pragma("unroll") for (int n = 0; n < 2; ++n) _Pragma("unroll") for (int k = 0; k < 2; ++k) \
        acc[ai][bj][m][n] = SWAPMMA ? __builtin_amdgcn_mfma_f32_16x16x32_bf16(At[m][k], Bt[n][k], acc[ai][bj][m][n], 0, 0, 0) : __builtin_amdgcn_mfma_f32_16x16x32_bf16(Bt[n][k], At[m][k], acc[ai][bj][m][n], 0, 0, 0); __builtin_amdgcn_s_setprio(0); } while (0)
#define PG8_WAIT_V(n) asm volatile("s_waitcnt vmcnt(" #n ")" ::: "memory")
#define PG8_WAIT_L(n) asm volatile("s_waitcnt lgkmcnt(" #n ")" ::: "memory")
#define PG8_BAR __builtin_amdgcn_s_barrier()
#define PG8_SCHED __builtin_amdgcn_sched_barrier(0)
    Unit cur, nxt; int ui = 0;
    if (!S.next(0, cur)) return;
    f32x4 acc[2][2][4][2];
#pragma unroll
    for (int a = 0; a < 2; ++a)
#pragma unroll
        for (int b = 0; b < 2; ++b)
#pragma unroll
            for (int m = 0; m < 4; ++m)
#pragma unroll
                for (int n = 0; n < 2; ++n) acc[a][b][m][n] = (f32x4){0.f, 0.f, 0.f, 0.f};
    bf16x8 At[4][2], B0[2][2], B1[2][2];
    const char* cA = (const char*)g.A + (size_t)cur.pm * tstep; const char* cB = (const char*)g.Bt + (size_t)cur.pn * tstep;
    S.a_ready(cur);
    if constexpr (SP2) {
        PG8_STAGE(PG8_SB(0, 0), cB, voffB); PG8_STAGE(PG8_SB(0, 1), cB + hstep, voffB); PG8_STAGE(PG8_SA(0, 0), cA, voffA); PG8_STAGE(PG8_SA(0, 1), cA + hstep, voffA);
        if (wr == 1) PG8_BAR;
        PG8_WAIT_V(2); PG8_BAR;
        PG8_STAGE(PG8_SB(1, 0), cB + kstep, voffB); PG8_STAGE(PG8_SA(1, 0), cA + kstep, voffA); PG8_STAGE(PG8_SB(1, 1), cB + hstep + kstep, voffB);
        PG8_WAIT_V(6); PG8_BAR;
    } else {
        PG8_STAGE(PG8_SB(0, 0), cB, voffB); PG8_STAGE(PG8_SA(0, 0), cA, voffA); PG8_STAGE(PG8_SB(0, 1), cB + hstep, voffB); PG8_STAGE(PG8_SA(0, 1), cA + hstep, voffA);
        if (wr == 1) PG8_BAR;
        PG8_WAIT_V(4); PG8_BAR;
        PG8_STAGE(PG8_SB(1, 0), cB + kstep, voffB); PG8_STAGE(PG8_SA(1, 0), cA + kstep, voffA); PG8_STAGE(PG8_SB(1, 1), cB + hstep + kstep, voffB);
        PG8_WAIT_V(6); PG8_BAR;
    }
    for (;;) {
        const bool has_next = S.next(ui + 1, nxt);
        const char* nA = has_next ? (const char*)g.A + (size_t)nxt.pm * tstep : cA; const char* nB = has_next ? (const char*)g.Bt + (size_t)nxt.pn * tstep : cB;
        for (int t = 0; t < nt; t += 2) {
            const bool last = (t == nt - 2);
            const char* a1 = cA + (size_t)(t + 1) * kstep;
            const char* a2 = last ? nA : cA + (size_t)(t + 2) * kstep; const char* b2 = last ? nB : cB + (size_t)(t + 2) * kstep;
            const char* a3 = a2 + kstep; const char* b3 = b2 + kstep;
            if (last && has_next) S.a_ready(nxt);
            if constexpr (SP2) {
            PG8_LDB(B0, 0, 0); PG8_LDB(B1, 0, 1); PG8_SCHED; PG8_LDA(At, 0, 0); PG8_STAGE(PG8_SA(1, 1), a1 + hstep, voffA);
            PG8_WAIT_V(8); PG8_WAIT_L(0); PG8_BAR; PG8_MMA(0, 0, At, B0); PG8_MMA(0, 1, At, B1); PG8_BAR; PG8_SCHED;
            PG8_LDA(At, 0, 1); PG8_STAGE(PG8_SB(0, 0), b2, voffB); PG8_STAGE(PG8_SB(0, 1), b2 + hstep, voffB); PG8_STAGE(PG8_SA(0, 0), a2, voffA);
            PG8_WAIT_V(8); PG8_WAIT_L(0); PG8_BAR; PG8_MMA(1, 0, At, B0); PG8_MMA(1, 1, At, B1); PG8_BAR; PG8_SCHED;
            PG8_LDB(B0, 1, 0); PG8_LDB(B1, 1, 1); PG8_SCHED; PG8_LDA(At, 1, 0); PG8_STAGE(PG8_SA(0, 1), a2 + hstep, voffA);
            PG8_WAIT_V(8); PG8_WAIT_L(0); PG8_BAR; PG8_MMA(0, 0, At, B0); PG8_MMA(0, 1, At, B1); PG8_BAR; PG8_SCHED;
            PG8_LDA(At, 1, 1); PG8_STAGE(PG8_SB(1, 0), b3, voffB); PG8_STAGE(PG8_SB(1, 1), b3 + hstep, voffB); PG8_STAGE(PG8_SA(1, 0), a3, voffA);
            PG8_WAIT_V(8); PG8_WAIT_L(0); PG8_BAR; PG8_MMA(1, 0, At, B0); PG8_MMA(1, 1, At, B1); PG8_BAR; PG8_SCHED;
            } else {
            PG8_LDB(B0, 0, 0); PG8_SCHED; PG8_LDA(At, 0, 0); PG8_STAGE(PG8_SA(1, 1), a1 + hstep, voffA);
            PG8_WAIT_L(8); PG8_BAR; PG8_WAIT_L(0); PG8_MMA(0, 0, At, B0); PG8_BAR; PG8_SCHED;
            PG8_LDB(B1, 0, 1); PG8_STAGE(PG8_SB(0, 0), b2, voffB);
            PG8_BAR; PG8_WAIT_L(0); PG8_MMA(0, 1, At, B1); PG8_BAR;
            PG8_LDA(At, 0, 1); PG8_STAGE(PG8_SA(0, 0), a2, voffA);
            PG8_BAR; PG8_WAIT_L(0); PG8_MMA(1, 0, At, B0); PG8_BAR; PG8_SCHED;
            PG8_STAGE(PG8_SB(0, 1), b2 + hstep, voffB);
            PG8_WAIT_V(6); PG8_BAR; PG8_MMA(1, 1, At, B1); PG8_BAR;
            PG8_LDB(B0, 1, 0); PG8_SCHED; PG8_LDA(At, 1, 0); PG8_STAGE(PG8_SA(0, 1), a2 + hstep, voffA);
            PG8_WAIT_L(8); PG8_BAR; PG8_WAIT_L(0); PG8_MMA(0, 0, At, B0); PG8_BAR; PG8_SCHED;
            PG8_LDB(B1, 1, 1); PG8_STAGE(PG8_SB(1, 0), b3, voffB);
            PG8_BAR; PG8_WAIT_L(0); PG8_MMA(0, 1, At, B1); PG8_BAR;
            PG8_LDA(At, 1, 1); PG8_STAGE(PG8_SA(1, 0), a3, voffA);
            PG8_BAR; PG8_WAIT_L(0); PG8_MMA(1, 0, At, B0); PG8_BAR; PG8_SCHED;
            PG8_STAGE(PG8_SB(1, 1), b3 + hstep, voffB);
            PG8_WAIT_V(6); PG8_BAR; PG8_MMA(1, 1, At, B1); PG8_BAR;
            }
        }
        if constexpr (ALIGN_EPI) { if (wr == 0) PG8_BAR; }
        if constexpr (!Epi::AFTER_DRAIN) { E(acc, cur, wr, wc, fr, fq); S.done(cur); }
        if (!has_next) break;
#pragma unroll
        for (int a = 0; a < 2; ++a)
#pragma unroll
            for (int b = 0; b < 2; ++b)
#pragma unroll
                for (int m = 0; m < 4; ++m)
#pragma unroll
                    for (int n = 0; n < 2; ++n) acc[a][b][m][n] = (f32x4){0.f, 0.f, 0.f, 0.f};
        cur = nxt; cA = nA; cB = nB; ++ui;
        if constexpr (ALIGN_EPI) { if (wr == 1) PG8_BAR; }
    }
    PG8_WAIT_V(0);
    if constexpr (!ALIGN_EPI) { if (wr == 0) PG8_BAR; }
    PG8_BAR;
    if constexpr (Epi::AFTER_DRAIN) { E.fused(acc, cur, wr, wc, fr, fq, lds, wid, lane); S.done(cur); }
#undef PG8_SA
#undef PG8_SB
#undef PG8_STAGE
#undef PG8_LDA
#undef PG8_LDB
#undef PG8_MMA
#undef PG8_WAIT_V
#undef PG8_WAIT_L
#undef PG8_BAR
#undef PG8_SCHED
}
}

template <class E0> struct EpiAdapt {
    static constexpr bool PERM = false, AFTER_DRAIN = false;
    E0 e; int col_base;
    __device__ __forceinline__ void operator()(const pg8::f32x4 (&acc)[2][2][4][2], const pg8::Unit& u, int wr, int wc, int fr, int fq) const {
        auto cvv = [&]() { if constexpr (E0::PAIR2) return e.load_cv(u.pm * 256, col_base + u.pn * 256 + wc * 32 + 4 * fq); else return 0; }();
        auto cvw = [&]() { if constexpr (E0::CVPRE) return e.load_cvw(u.pm * 256, col_base + u.pn * 256 + wc * 32 + 4 * fq); else return 0; }();
        float rs8[2][4]; f32x4 praw[2][4];
#pragma unroll
        for (int ai = 0; ai < 2; ++ai)
#pragma unroll
            for (int m = 0; m < 4; ++m) praw[ai][m] = row_rs_load((const float*)(e.ws + WS_STATS), u.pm * 256 + ai * 128 + wr * 64 + m * 16 + fr, fq);
        __builtin_amdgcn_sched_barrier(0);
#pragma unroll
        for (int ai = 0; ai < 2; ++ai)
#pragma unroll
            for (int m = 0; m < 4; ++m) rs8[ai][m] = row_rs_finish(praw[ai][m]);
#pragma unroll
        for (int ai = 0; ai < 2; ++ai)
#pragma unroll
            for (int m = 0; m < 4; ++m) {
                const int row = u.pm * 256 + ai * 128 + wr * 64 + m * 16 + fr;
                const float rs = rs8[ai][m];
                float ss = 0.f;
                if constexpr (E0::PAIR2) e.item2(row, col_base + u.pn * 256 + wc * 32 + 4 * fq, acc[ai][0][m][0], acc[ai][0][m][1], acc[ai][1][m][0], acc[ai][1][m][1], rs, cvv);
                else if constexpr (E0::CVPRE) {
#pragma unroll
                    for (int bj = 0; bj < 2; ++bj) ss += e.item_cv(row, col_base + u.pn * 256 + bj * 128 + wc * 32 + 4 * fq, acc[ai][bj][m][0], acc[ai][bj][m][1], rs, cvw.c[bj][0], cvw.c[bj][1]);
                } else {
#pragma unroll
                    for (int bj = 0; bj < 2; ++bj) ss += e.item(row, col_base + u.pn * 256 + bj * 128 + wc * 32 + 4 * fq, acc[ai][bj][m][0], acc[ai][bj][m][1], rs);
                }
                if constexpr (E0::STATS) { ss += __shfl_xor(ss, 16); ss += __shfl_xor(ss, 32); if (fq == 0) e.stats[(size_t)row * 16 + (col_base >> 6) + u.pn * 4 + wc] = ss; }
            }
    }
};
struct EpiResBig {
    static constexpr bool PERM = false, AFTER_DRAIN = false;
    EpiRes e; LAS unsigned char* lds; bool first  , f32out  ;
    template <bool FIRST>
    __device__ __forceinline__ void half(const pg8::f32x4 (&acc)[2][2][4][2], const pg8::Unit& u, int ai, int wr, int wc, int fr, int fq, const LAS float* cvec) const {
        bf16_t* xb = e.xb;
        const int colb = u.pn * 256 + wc * 32 + 4 * fq, colg = u.pn * 256 + wc * 32 + 8 * fq;
        const int rowb = u.pm * 256 + ai * 128 + wr * 64 + fr;
        f32x4 xo[FIRST ? 4 : 1][2][2]; u32x4 raw[FIRST ? 1 : 4][2];
#pragma unroll
        for (int m = 0; m < 4; ++m)
#pragma unroll
            for (int bj = 0; bj < 2; ++bj) {
                if constexpr (FIRST) {
#pragma unroll
                    for (int hl = 0; hl < 2; ++hl) xo[m][bj][hl] = *(const f32x4*)(e.xin + (size_t)(rowb + 16 * m) * 1024 + colb + 128 * bj + 16 * hl);
                } else raw[m][bj] = *(const u32x4*)(xb + (size_t)(rowb + 16 * m) * 1024 + colg + 128 * bj);
            }
#pragma unroll
        for (int m = 0; m < 4; ++m) {
            const int row = rowb + 16 * m; float ss = 0.f;
#pragma unroll
            for (int bj = 0; bj < 2; ++bj) {
                f32x4 xn[2];
                if constexpr (FIRST) { xn[0] = xo[m][bj][0]; xn[1] = xo[m][bj][1]; }
                else { const u32x4 r = raw[m][bj]; xn[0] = (f32x4){bflo(r.x), bfhi(r.x), bflo(r.y), bfhi(r.y)}; xn[1] = (f32x4){bflo(r.z), bfhi(r.z), bflo(r.w), bfhi(r.w)}; }
#pragma unroll
                for (int hl = 0; hl < 2; ++hl) {
                    const int lc = 32 * bj + 16 * hl + 4 * fq;
                    const f32x4 m4 = *(const LAS f32x4*)(cvec + lc), b4 = *(const LAS f32x4*)(cvec + 64 + lc);
                    xn[hl] = xn[hl] + m4 * (acc[ai][bj][m][hl] + b4);
                    ss += (xn[hl][0] * xn[hl][0] + xn[hl][1] * xn[hl][1]) + (xn[hl][2] * xn[hl][2] + xn[hl][3] * xn[hl][3]);
                }
                if (f32out) { *(f32x4*)(e.xl + (size_t)row * 1024 + colb + 128 * bj) = xn[0]; *(f32x4*)(e.xl + (size_t)row * 1024 + colb + 128 * bj + 16) = xn[1]; }
                else { u32x4 xw; xw.x = pk2(xn[0][0], xn[0][1]); xw.y = pk2(xn[0][2], xn[0][3]); xw.z = pk2(xn[1][0], xn[1][1]); xw.w = pk2(xn[1][2], xn[1][3]); *(u32x4*)(xb + (size_t)row * 1024 + colg + 128 * bj) = xw; }
            }
            ss += __shfl_xor(ss, 16); ss += __shfl_xor(ss, 32); if (fq == 0) e.stats[(size_t)row * 16 + u.pn * 4 + wc] = ss;
        }
    }
    __device__ __forceinline__ void operator()(const pg8::f32x4 (&acc)[2][2][4][2], const pg8::Unit& u, int wr, int wc, int fr, int fq) const {
        LAS float* cvec = (LAS float*)(lds + 131072 + 2048 + (wr * 4 + wc) * 512);
        {   const int l = fq * 16 + fr, col = u.pn * 256 + 128 * (l >> 5) + wc * 32 + (l & 31);
            const float mgv = ((const float*)e.ws + e.mgoff)[col];
            float bv = 0.f; if (e.bias) bv = e.bias[col];
            cvec[l] = mgv; cvec[64 + l] = bv; }
        if (first) { half<true>(acc, u, 0, wr, wc, fr, fq, cvec); half<true>(acc, u, 1, wr, wc, fr, fq, cvec); }
        else { half<false>(acc, u, 0, wr, wc, fr, fq, cvec); half<false>(acc, u, 1, wr, wc, fr, fq, cvec); }
    }
};
struct EpiVt {
    static constexpr bool PERM = false, AFTER_DRAIN = false;
    unsigned char* ws; int cvoff;
    __device__ __forceinline__ void operator()(const pg8::f32x4 (&acc)[2][2][4][2], const pg8::Unit& u, int wr, int wc, int fr, int fq) const {
        bf16_t* vt = (bf16_t*)(ws + WS_VT);
        const float* cv = (const float*)ws + cvoff + (u.pm * 256 < T ? 0 : 8192);
        float c4[2][2];
#pragma unroll
        for (int bj = 0; bj < 2; ++bj)
#pragma unroll
            for (int n = 0; n < 2; ++n) c4[bj][n] = cv[2048 + u.pn * 256 + bj * 128 + wc * 32 + 16 * n + fr];
        float rsl[2][2][2];
#pragma unroll
        for (int ai = 0; ai < 2; ++ai)
#pragma unroll
            for (int p = 0; p < 2; ++p) { const int rowb = u.pm * 256 + ai * 128 + wr * 64 + 32 * p;
                rsl[ai][p][0] = row_rs((const float*)(ws + WS_STATS), rowb + fr, fq); rsl[ai][p][1] = row_rs((const float*)(ws + WS_STATS), rowb + 16 + fr, fq); }
#pragma unroll
        for (int ai = 0; ai < 2; ++ai)
#pragma unroll
            for (int p = 0; p < 2; ++p) {
                const int rowb = u.pm * 256 + ai * 128 + wr * 64 + 32 * p;
                const float rsA = rsl[ai][p][0], rsB = rsl[ai][p][1];
                float rs8[8];
#pragma unroll
                for (int e = 0; e < 8; ++e) { const float ra = __shfl(rsA, (8 * fq + e) & 15), rb = __shfl(rsB, (8 * fq + e) & 15); rs8[e] = fq < 2 ? ra : rb; }
#pragma unroll
                for (int bj = 0; bj < 2; ++bj)
#pragma unroll
                    for (int n = 0; n < 2; ++n) {
                        const int col = u.pn * 256 + bj * 128 + wc * 32 + 16 * n + fr; const float c0 = c4[bj][n];
                        const pg8::f32x4 a0 = acc[ai][bj][2 * p][n], a1 = acc[ai][bj][2 * p + 1][n];
                        u32x4 w; w.x = pk2(a0[0] * rs8[0] + c0, a0[1] * rs8[1] + c0); w.y = pk2(a0[2] * rs8[2] + c0, a0[3] * rs8[3] + c0);
                        w.z = pk2(a1[0] * rs8[4] + c0, a1[1] * rs8[5] + c0); w.w = pk2(a1[2] * rs8[6] + c0, a1[3] * rs8[7] + c0);
                        *(u32x4*)(vt + (size_t)col * R + rowb + 8 * fq) = w;
                    }
            }
    }
};
template <int NT, int KS, class Epi>
__device__ __forceinline__ void sgemm_small(Ctx& C, const bf16_t* A, const bf16_t* Bt, int row_lo, int Mrows, const Epi& E, int n_lo, int n_hi) {
    constexpr int K = 256 * KS, K8 = 32 * KS;
    constexpr int PD = NT == 16 ? 2 : (NT == 8 ? (KS < 4 ? KS : 4) : (KS < 6 ? KS : 6));
    const int w = C.wave, fr = C.lane & 15, fq = C.lane >> 4;
    const int nM = Mrows / 16, nS = (n_hi - n_lo) * (16 / NT), nU = nM * nS;
    LAS f32x4* xch = (LAS f32x4*)C.lds;
    LAS float* sx = (LAS float*)(C.lds + 131072 + 1024);
    const bool xmap = C.G == 256 && (nU & 7) == 0;
    const int per = xmap ? nU >> 3 : nU, ubase = xmap ? (C.bid & 7) * per : 0, ustep = xmap ? 32 : C.G;
    for (int v = xmap ? C.bid >> 3 : C.bid; v < per; v += ustep) {
        const int u = ubase + v, slab = u / nM, um = u % nM;
        const int row0 = row_lo + 16 * um, col0 = 256 * n_lo + 16 * NT * slab;
        f32x4 acc[NT];
#pragma unroll
        for (int t = 0; t < NT; ++t) acc[t] = (f32x4){0.f, 0.f, 0.f, 0.f};
        const bf16_t* ap = A + (size_t)(row0 + fr) * K + w * K8 + 8 * fq;
        const bf16_t* bp = Bt + (size_t)(col0 + fr) * K + w * K8 + 8 * fq;
        bf16x8 af[PD], bf[PD][NT];
#pragma unroll
        for (int s = 0; s < PD; ++s) {
            af[s] = *(const bf16x8*)(ap + 32 * s);
#pragma unroll
            for (int t = 0; t < NT; ++t) bf[s][t] = *(const bf16x8*)(bp + (size_t)(16 * t) * K + 32 * s);
        }
#pragma unroll
        for (int s = 0; s < KS; ++s) {
            const int sl = s % PD;
#pragma unroll
            for (int t = 0; t < NT; ++t) acc[t] = __builtin_amdgcn_mfma_f32_16x16x32_bf16(bf[sl][t], af[sl], acc[t], 0, 0, 0);
            if (s + PD < KS) {
                af[sl] = *(const bf16x8*)(ap + 32 * (s + PD));
#pragma unroll
                for (int t = 0; t < NT; ++t) bf[sl][t] = *(const bf16x8*)(bp + (size_t)(16 * t) * K + 32 * (s + PD));
            }
            __builtin_amdgcn_sched_barrier(0);
        }
#pragma unroll
        for (int t = 0; t < NT; ++t) xch[(w * NT + t) * 64 + C.lane] = acc[t];
        __syncthreads();
        const int row = row0 + fr;
        float ss = 0.f;
        if (w < NT / 2) {
            f32x4 v0 = {0.f, 0.f, 0.f, 0.f}, v1 = v0;
#pragma unroll
            for (int q = 0; q < 8; ++q) { v0 += xch[(q * NT + 2 * w) * 64 + C.lane]; v1 += xch[(q * NT + 2 * w + 1) * 64 + C.lane]; }
            const float rs = E.row_begin(row, fq);
            ss = E.item(row, col0 + 32 * w + 4 * fq, v0, v1, rs);
        }
        if constexpr (Epi::STATS) {
            ss += __shfl_xor(ss, 16); ss += __shfl_xor(ss, 32);
            if (fq == 0) sx[fr * 8 + w] = ss;
            __syncthreads();
            if (fq == 0 && (w & 1) == 0 && w < NT / 2) E.stats[(size_t)row * 16 + (col0 >> 6) + (w >> 1)] = sx[fr * 8 + w] + sx[fr * 8 + w + 1];
        }
        __syncthreads();
    }
}
template <int NT, class E0>
__device__ __forceinline__ void gemm_both(Ctx& C, const bf16_t* A, const bf16_t* Bt, int Mbig, int N, int K, const E0& E, int ctx_n_lo, int ctx_n_hi, int nb_lo = 0, int nb_hi = -1) {
    if (nb_hi < 0) nb_hi = N / 256;
    { pg8::Gemm g{A, Bt + (size_t)nb_lo * 256 * K, Mbig, (nb_hi - nb_lo) * 256, K}; pg8::StaticOrder S; S.init(Mbig, (nb_hi - nb_lo) * 256, C.G, C.bid); EpiAdapt<E0> EA{E, nb_lo * 256};
      pg8::gemm_phase<EpiAdapt<E0>, pg8::StaticOrder, true, true>(C.lds, g, S, EA); }
    if (Mbig < R && ctx_n_hi > ctx_n_lo) { __syncthreads(); relane(C); sgemm_small<NT, 4>(C, A, Bt, T, R - T, E, ctx_n_lo, ctx_n_hi); }
}
__device__ __forceinline__ void dwconv_phase(Ctx& C, int j) {
    const bf16_t* U = (const bf16_t*)(C.ws + WS_U); bf16_t* A2 = (bf16_t*)(C.ws + WS_A2);
    const float* dww = C.in[10] + (size_t)j * CK * 1024; const float* dwb = C.in[11] + j * 1024; const float* lng = C.in[12] + j * 1024; const float* lnb = C.in[13] + j * 1024;
    constexpr int TT = 33, NR = TT + 30;
    LAS unsigned char* tile = C.lds; LAS float* part = (LAS float*)(C.lds + NR * 2048);
    const int tid = C.tid;
    constexpr int NUL = (T + TT - 1) / TT, NUC = (TC + TT - 1) / TT;
    f32x2 wt[CK];
#pragma unroll
    for (int jt = 0; jt < CK; ++jt) wt[jt] = *(const f32x2*)(dww + jt * 1024 + 2 * tid);
    const f32x2 b2 = *(const f32x2*)(dwb + 2 * tid), g2 = *(const f32x2*)(lng + 2 * tid), bb2 = *(const f32x2*)(lnb + 2 * tid);
    for (int u = C.bid; u < NUL + NUC; u += C.G) {
        const bool lat = u < NUL; const int base = lat ? 0 : T, n = lat ? T : TC, t0 = TT * (lat ? u : u - NUL);
        const int nv = (n - t0) < TT ? (n - t0) : TT;
        {
            constexpr int NLD = (NR * 128 + 511) / 512;
            u32x4 v[NLD];
#pragma unroll
            for (int q = 0; q < NLD; ++q) {
                const int idx = tid + 512 * q, rr = idx >> 7, ch = idx & 127, tt = t0 - 15 + rr;
                v[q] = (u32x4){0u, 0u, 0u, 0u};
                if (idx < NR * 128 && tt >= 0 && tt < n) v[q] = *(const u32x4*)(U + (size_t)(base + tt) * 1024 + ch * 8);
            }
#pragma unroll
            for (int q = 0; q < NLD; ++q) { const int idx = tid + 512 * q, rr = idx >> 7, ch = idx & 127; if (idx < NR * 128) *(LAS u32x4*)(tile + rr * 2048 + ch * 16) = v[q]; }
        }
        __syncthreads();
        f32x2 o[TT];
#pragma unroll
        for (int t = 0; t < TT; ++t) o[t] = b2;
#pragma unroll
        for (int hb = 0; hb < 3; ++hb) {
            f32x2 xw[41];
#pragma unroll
            for (int r = 0; r < 41; ++r) { const unsigned uu = *(const LAS unsigned*)(tile + (11 * hb + r) * 2048 + tid * 4); xw[r] = (f32x2){bflo(uu), bfhi(uu)}; }
#pragma unroll
            for (int t = 0; t < 11; ++t)
#pragma unroll
                for (int jt = 0; jt < CK; ++jt) o[11 * hb + t] += wt[jt] * xw[t + jt];
        }
#pragma unroll
        for (int t = 0; t < TT; ++t) {
            const float s = wave_sum63(o[t].x + o[t].y), q = wave_sum63(o[t].x * o[t].x + o[t].y * o[t].y);
            if (C.lane == 63) { part[(t * 8 + C.wave) * 2] = s; part[(t * 8 + C.wave) * 2 + 1] = q; }
        }
        __syncthreads();
#pragma unroll
        for (int t = 0; t < TT; ++t) {
            float s = 0.f, q = 0.f;
#pragma unroll
            for (int w = 0; w < 8; ++w) { s += part[(t * 8 + w) * 2]; q += part[(t * 8 + w) * 2 + 1]; }
            const float mean = s * (1.f / 1024.f), var = q * (1.f / 1024.f) - mean * mean, rstd = __builtin_amdgcn_rsqf(var + LN_EPS);
            const float y0 = (o[t].x - mean) * rstd * g2.x + bb2.x, y1 = (o[t].y - mean) * rstd * g2.y + bb2.y;
            if (t < nv) *(unsigned*)(A2 + (size_t)(base + t0 + t) * 1024 + 2 * tid) = pk2(siluf(y0), siluf(y1));
        }
        __syncthreads();
    }
}

__device__ __forceinline__ void ugemm_phase(Ctx& C, int j) {
    const bf16_t* Kb = (const bf16_t*)(C.ws + WS_K); const bf16_t* Vt = (const bf16_t*)(C.ws + WS_VT); bf16_t* Scp = (bf16_t*)(C.ws + WS_SCP);
    constexpr int SLOT = 32768;
    const int fr = C.lane & 15, fq = C.lane >> 4, w = C.wave, lane = C.lane;
    const int wm = w >> 1, wn = w & 1;
    const unsigned lds0 = (unsigned)(size_t)C.lds;
    for (int it0 = 0; it0 < 3; ++it0) {
        int set, sub;
        if (it0 < 2) { if (C.bid >= 256) break; const int x = C.bid & 7, ii = C.bid >> 3; set = it0 * 64 + x * 8 + (ii >> 2); sub = ii & 3; }
        else { const int k = C.bid; if (k >= 16) break; set = 128 + (k >> 2); sub = k & 3; }
        const int slot = set >> 2, h = set & 3, dir = sub >> 1, dvh = sub & 1;
        const int ntok = slot < 32 ? 512 : 256, tokb = slot < 32 ? 512 * slot : T, nst = ntok / 32;
        const float gam = 1.0f - exp2f(C.in[17][(j * 2 + dir) * 4 + h]); const float L = log2f(gam);
        unsigned ksrc[2], vsrc[2];
#pragma unroll
        for (int p = 0; p < 2; ++p) {
            const int kr = 2 * (2 * w + p) + (lane >> 5), kpos = lane & 31, kc = kpos ^ ((((kr & 3) | (((kr >> 3) & 1) << 2))) << 1);
            ksrc[p] = (unsigned)((tokb + kr) * 1024 + h * 256 + 8 * kc);
            const int vr = 16 * (2 * w + p) + (lane >> 2), vpos = lane & 3, vc = vpos ^ ((4 - ((vr >> 2) & 3)) & 3);
            vsrc[p] = (unsigned)((h * 512 + 256 * dvh + vr) * R + tokb + 8 * vc);
        }
#define UG_DMA(st) do { const int s_ = (st) < nst ? (st) : nst - 1; LAS unsigned char* sl_ = C.lds + ((st) & 3) * SLOT + (2 * w) * 1024; \
        _Pragma("unroll") for (int p = 0; p < 2; ++p) { \
            __builtin_amdgcn_global_load_lds((const unsigned*)(Kb + (ksrc[p] + (unsigned)(32 * s_ * 1024))), (LAS unsigned*)(sl_ + p * 1024), 16, 0, 0); \
            __builtin_amdgcn_global_load_lds((const unsigned*)(Vt + (vsrc[p] + (unsigned)(32 * s_))), (LAS unsigned*)(sl_ + 16384 + p * 1024), 16, 0, 0); } } while (0)
        const int trq = fr >> 2, trp = fr & 3;
        const int row0 = 8 * fq + trq;
        const unsigned a0 = (unsigned)(row0 * 512 + (((8 * wm + (trp >> 1)) ^ ((((row0 & 3) | (((row0 >> 3) & 1) << 2))) << 1)) << 4) + 8 * (trp & 1));
        const unsigned boff0 = (unsigned)(16384 + (128 * wn + fr) * 64 + ((fq ^ ((4 - ((fr >> 2) & 3)) & 3)) << 4));
        float kd[8];
#pragma unroll
        for (int e = 0; e < 8; ++e) { const int tl = 8 * fq + e; kd[e] = exp2f(L * (float)(dir == 0 ? 31 - tl : tl)); }
        f32x4 acc[4][8];
#pragma unroll
        for (int mt = 0; mt < 4; ++mt)
#pragma unroll
            for (int nt = 0; nt < 8; ++nt) acc[mt][nt] = (f32x4){0.f, 0.f, 0.f, 0.f};
        __syncthreads();
        UG_DMA(0); UG_DMA(1);
#pragma unroll 1
        for (int st2 = 0; st2 < nst; st2 += 2) {
            asm volatile("s_waitcnt vmcnt(0)" ::: "memory");
            __builtin_amdgcn_s_barrier(); asm volatile("" ::: "memory");
            UG_DMA(st2 + 2); UG_DMA(st2 + 3);
#pragma unroll 1
          for (int st = st2; st < st2 + 2; ++st) {
            const float sf = exp2f(L * (float)(dir == 0 ? ntok - 32 - 32 * st : 32 * st));
            const unsigned sl = lds0 + (unsigned)((st & 3) * SLOT);
            u32x2 alo[4], ahi[4]; u32x4 bfv[4];
#pragma unroll
            for (int mt = 0; mt < 4; ++mt) {
                const unsigned aa = sl + (a0 ^ (unsigned)(mt << 5));
                asm volatile("ds_read_b64_tr_b16 %0, %1" : "=v"(alo[mt]) : "v"(aa));
                asm volatile("ds_read_b64_tr_b16 %0, %1 offset:2048" : "=v"(ahi[mt]) : "v"(aa));
            }
            const unsigned ba = sl + boff0;
#pragma unroll
            for (int nt = 0; nt < 4; ++nt) asm volatile("ds_read_b128 %0, %1 offset:%c2" : "=v"(bfv[nt]) : "v"(ba), "i"(nt * 1024));
            asm volatile("s_waitcnt lgkmcnt(0)" : "+v"(alo[0]), "+v"(alo[1]), "+v"(alo[2]), "+v"(alo[3]), "+v"(ahi[0]), "+v"(ahi[1]), "+v"(ahi[2]), "+v"(ahi[3]) :: "memory");
            asm volatile("" : "+v"(bfv[0]), "+v"(bfv[1]), "+v"(bfv[2]), "+v"(bfv[3]));
            __builtin_amdgcn_sched_barrier(0);
            bf16x8 af[4];
#pragma unroll
            for (int mt = 0; mt < 4; ++mt) {
                u32x4 pk;
                pk.x = pk2(bflo(alo[mt].x) * (kd[0] * sf), bfhi(alo[mt].x) * (kd[1] * sf));
                pk.y = pk2(bflo(alo[mt].y) * (kd[2] * sf), bfhi(alo[mt].y) * (kd[3] * sf));
                pk.z = pk2(bflo(ahi[mt].x) * (kd[4] * sf), bfhi(ahi[mt].x) * (kd[5] * sf));
                pk.w = pk2(bflo(ahi[mt].y) * (kd[6] * sf), bfhi(ahi[mt].y) * (kd[7] * sf));
                af[mt] = __builtin_bit_cast(bf16x8, pk);
            }
#pragma unroll
            for (int mt = 0; mt < 4; ++mt)
#pragma unroll
                for (int nt = 0; nt < 4; ++nt) acc[mt][nt] = __builtin_amdgcn_mfma_f32_16x16x32_bf16(af[mt], __builtin_bit_cast(bf16x8, bfv[nt]), acc[mt][nt], 0, 0, 0);
            __builtin_amdgcn_sched_barrier(0);
#pragma unroll
            for (int nt = 0; nt < 4; ++nt) asm volatile("ds_read_b128 %0, %1 offset:%c2" : "=v"(bfv[nt]) : "v"(ba), "i"((nt + 4) * 1024));
            asm volatile("s_waitcnt lgkmcnt(0)" : "+v"(bfv[0]), "+v"(bfv[1]), "+v"(bfv[2]), "+v"(bfv[3]) :: "memory");
            __builtin_amdgcn_sched_barrier(0);
#pragma unroll
            for (int mt = 0; mt < 4; ++mt)
#pragma unroll
                for (int nt = 0; nt < 4; ++nt) acc[mt][nt + 4] = __builtin_amdgcn_mfma_f32_16x16x32_bf16(af[mt], __builtin_bit_cast(bf16x8, bfv[nt]), acc[mt][nt + 4], 0, 0, 0);
          }
        }
        asm volatile("s_waitcnt vmcnt(0)" ::: "memory");
        bf16_t* sp = Scp + ((size_t)((slot * 4 + h) * 2 + dir) * 512) * 256;
#pragma unroll
        for (int nt = 0; nt < 8; ++nt) {
            bf16_t* rowp = sp + (size_t)(256 * dvh + 128 * wn + 16 * nt + fr) * 256 + 64 * wm + 4 * fq;
#pragma unroll
            for (int mt = 0; mt < 4; ++mt) { u32x2 wv; wv.x = pk2(acc[mt][nt][0], acc[mt][nt][1]); wv.y = pk2(acc[mt][nt][2], acc[mt][nt][3]); *(u32x2*)(rowp + 16 * mt) = wv; }
        }
        __syncthreads();
#undef UG_DMA
    }
}
__device__ __forceinline__ void prefix_phase(Ctx& C, int j) {
    bf16_t* Scp = (bf16_t*)(C.ws + WS_SCP);
    constexpr size_t SSTR = (size_t)8 * 512 * 256;
    for (int idx = C.bid * 512 + C.tid; idx < 8 * 512 * 32; idx += C.G * 512) {
        const int hd = idx >> 14, h = hd >> 1, dir = hd & 1;
        const float gam = 1.0f - exp2f(C.in[17][(j * 2 + dir) * 4 + h]); const float cdec = exp2f(log2f(gam) * 512.f);
        bf16_t* p = Scp + (size_t)idx * 8;
        const u32x4 raw = *(const u32x4*)(p + 32 * SSTR);
        float s[8] = {bflo(raw.x), bfhi(raw.x), bflo(raw.y), bfhi(raw.y), bflo(raw.z), bfhi(raw.z), bflo(raw.w), bfhi(raw.w)};
        *(u32x4*)(p + 32 * SSTR) = (u32x4){0u, 0u, 0u, 0u};
#pragma unroll 1
        for (int qb = 0; qb < 4; ++qb) {
            u32x4 u[8];
#pragma unroll
            for (int q = 0; q < 8; ++q) { const int g = dir == 0 ? 8 * qb + q : 31 - (8 * qb + q); u[q] = *(const u32x4*)(p + (size_t)g * SSTR); }
#pragma unroll
            for (int q = 0; q < 8; ++q) {
                const int g = dir == 0 ? 8 * qb + q : 31 - (8 * qb + q);
                u32x4 o; o.x = pk2(s[0], s[1]); o.y = pk2(s[2], s[3]); o.z = pk2(s[4], s[5]); o.w = pk2(s[6], s[7]);
                *(u32x4*)(p + (size_t)g * SSTR) = o;
                s[0] = s[0] * cdec + bflo(u[q].x); s[1] = s[1] * cdec + bfhi(u[q].x); s[2] = s[2] * cdec + bflo(u[q].y); s[3] = s[3] * cdec + bfhi(u[q].y);
                s[4] = s[4] * cdec + bflo(u[q].z); s[5] = s[5] * cdec + bfhi(u[q].z); s[6] = s[6] * cdec + bflo(u[q].w); s[7] = s[7] * cdec + bfhi(u[q].w);
            }
        }
    }
}

template <int MT, int PV = 0>
__device__ __forceinline__ void readout_units(Ctx& C, int j) {
    const bf16_t* Q = (const bf16_t*)(C.ws + WS_Q); const bf16_t* Kb = (const bf16_t*)(C.ws + WS_K); const bf16_t* Vt = (const bf16_t*)(C.ws + WS_VT);
    const bf16_t* Scp = (const bf16_t*)(C.ws + WS_SCP); bf16_t* GF = (bf16_t*)(C.ws + WS_GF); const bf16_t* GB = (const bf16_t*)(C.ws + WS_GB);
    constexpr int QP = 264, PP = 136;
    constexpr int NROW = 16 * MT;
    LAS bf16_t* Qs = (LAS bf16_t*)C.lds;
    LAS bf16_t* P2 = (LAS bf16_t*)(C.lds + NROW * QP * 2);
    LAS float* red = (LAS float*)(C.lds + NROW * QP * 2 + 2 * NROW * PP * 2);
    const int w = C.wave, tid = C.tid;
    const int nunits = MT == 8 ? 512 : 32;
    for (int u0 = (MT == 8 ? C.bid : C.G - 1 - C.bid); u0 < nunits; u0 += C.G) {
        int h, b, sb = 0;
        if (MT != 8) { h = u0 & 3; sb = (u0 >> 2) & 3; b = 128 + (u0 >> 4); }
        else if (C.G == 256) { const int r = u0 >> 8, x = u0 & 7, idx = (u0 & 255) >> 3, grp = r * 64 + x * 8 + (idx >> 2); h = grp & 3; b = (grp >> 2) * 4 + (idx & 3); }
        else { h = u0 & 3; b = u0 >> 2; }
        const bool lat = b < 128; const int base = lat ? 0 : T, nb = lat ? 128 : 2, bl = lat ? b : b - 128;
        const int g = bl >> 2, slot = lat ? g : 32;
        const int gend = (4 * (g + 1) < nb ? 4 * (g + 1) : nb);
        const int i0 = base + 128 * bl + NROW * sb, il0 = 128 * bl + NROW * sb;
        {   u32x4 qv[MT];
#pragma unroll
            for (int i = 0; i < MT; ++i) { const int c = tid + 512 * i, row = c >> 5, ch = c & 31; qv[i] = *(const u32x4*)(Q + (size_t)(i0 + row) * 1024 + h * 256 + 8 * ch); }
            __builtin_amdgcn_sched_barrier(0);
#pragma unroll
            for (int i = 0; i < MT; ++i) { const int c = tid + 512 * i, row = c >> 5, ch = c & 31; *(LAS u32x4*)(Qs + row * QP + 8 * ch) = qv[i]; }
        }
        __syncthreads();
#pragma unroll 1
        for (int dir = 0; dir < 2; ++dir) {
            int lane_o = C.lane; asm volatile("" : "+v"(lane_o));
            const int fr = lane_o & 15, fq = lane_o >> 4;
            const float gam = 1.0f - exp2f(C.in[17][(j * 2 + dir) * 4 + h]); const float L = log2f(gam);
            f32x4 acc[MT][4];
#pragma unroll
            for (int mt = 0; mt < MT; ++mt)
#pragma unroll
                for (int nt = 0; nt < 4; ++nt) acc[mt][nt] = (f32x4){0.f, 0.f, 0.f, 0.f};
            const int kb_lo = dir == 0 ? 4 * g : bl, kb_hi = dir == 0 ? bl : gend - 1;
            const bf16_t* sb = Scp + ((size_t)((slot * 4 + h) * 2 + dir) * 512) * 256 + (size_t)(64 * w + 16 * (fr >> 2) + (fr & 3)) * 256 + 8 * fq;
#pragma unroll 1
            for (int kq = 0; kq < (PV == 5 ? 0 : 4); ++kq) {
                bf16x8 sf[2][4];
#pragma unroll
                for (int k2 = 0; k2 < 2; ++k2)
#pragma unroll
                    for (int nt = 0; nt < 4; ++nt) sf[k2][nt] = *(const bf16x8*)(sb + (size_t)(4 * nt) * 256 + 32 * (2 * kq + k2));
#pragma unroll
                for (int k2 = 0; k2 < 2; ++k2)
#pragma unroll
                    for (int mt = 0; mt < MT; ++mt) { const bf16x8 qf = *(const LAS bf16x8*)(Qs + (16 * mt + fr) * QP + 32 * (2 * kq + k2) + 8 * fq);
#pragma unroll
                        for (int nt = 0; nt < 4; ++nt) acc[mt][nt] = __builtin_amdgcn_mfma_f32_16x16x32_bf16(sf[k2][nt], qf, acc[mt][nt], 0, 0, 0); }
            }
#pragma unroll
            for (int mt = 0; mt < MT; ++mt) {
                const int il = il0 + 16 * mt + fr;
                const int ex = dir == 0 ? il - 512 * g + 1 : gend * 128 - il;
                const float qd = __builtin_amdgcn_exp2f(L * (float)ex);
#pragma unroll
                for (int nt = 0; nt < 4; ++nt) acc[mt][nt] = acc[mt][nt] * qd;
            }
#pragma unroll 1
            for (int kb = kb_lo; kb <= ((PV == 2 || PV == 5) ? kb_lo - 1 : kb_hi); ++kb) {
                const int j0 = base + 128 * kb;
                LAS bf16_t* P = P2 + (kb & 1) * (NROW * PP);
                {
                    bf16x8 kf[8];
                    const bf16_t* k1 = Kb + (size_t)(j0 + 16 * w + fr) * 1024 + h * 256 + 8 * fq;
#pragma unroll
                    for (int ks = 0; ks < 8; ++ks) kf[ks] = *(const bf16x8*)(k1 + 32 * ks);
                    f32x4 sc[MT];
#pragma unroll
                    for (int mt = 0; mt < MT; ++mt) sc[mt] = (f32x4){0.f, 0.f, 0.f, 0.f};
#pragma unroll
                    for (int ks = 0; ks < 8; ++ks) {
#pragma unroll
                        for (int mt = 0; mt < MT; ++mt) { const bf16x8 qf = *(const LAS bf16x8*)(Qs + (16 * mt + fr) * QP + 32 * ks + 8 * fq);
                            sc[mt] = __builtin_amdgcn_mfma_f32_16x16x32_bf16(kf[ks], qf, sc[mt], 0, 0, 0); }
                        __builtin_amdgcn_sched_barrier(0);
                    }
#pragma unroll
                    for (int mt = 0; mt < MT; ++mt) {
                        const int il = il0 + 16 * mt + fr;
                        float p[4];
#pragma unroll
                        for (int e = 0; e < 4; ++e) { const int jl = 128 * kb + 16 * w + 4 * fq + e; const int rel = dir == 0 ? il - jl : jl - il;
                            p[e] = rel >= 0 ? sc[mt][e] * __builtin_amdgcn_exp2f(L * (float)rel) : 0.f; }
                        u32x2 wv; wv.x = pk2(p[0], p[1]); wv.y = pk2(p[2], p[3]);
                        *(LAS u32x2*)(P + (16 * mt + fr) * PP + 16 * w + 4 * fq) = wv;
                    }
                }
                const bf16_t* vb = Vt + (size_t)(h * 512 + 64 * w + 16 * (fr >> 2) + (fr & 3)) * R + j0 + 8 * fq;
                {
                    bf16x8 vf[4][4];
#pragma unroll
                    for (int k4 = 0; k4 < 4; ++k4)
#pragma unroll
                        for (int nt = 0; nt < 4; ++nt) vf[k4][nt] = *(const bf16x8*)(vb + (size_t)(4 * nt) * R + 32 * k4);
                    asm volatile("s_waitcnt lgkmcnt(0)" ::: "memory");
                    __builtin_amdgcn_s_barrier(); asm volatile("" ::: "memory");
#pragma unroll
                    for (int k4 = 0; k4 < 4; ++k4) {
#pragma unroll
                        for (int mt = 0; mt < MT; ++mt) { const bf16x8 pf = *(const LAS bf16x8*)(P + (16 * mt + fr) * PP + 32 * k4 + 8 * fq);
#pragma unroll
                            for (int nt = 0; nt < 4; ++nt) acc[mt][nt] = __builtin_amdgcn_mfma_f32_16x16x32_bf16(vf[k4][nt], pf, acc[mt][nt], 0, 0, 0); }
                        __builtin_amdgcn_sched_barrier(0);
                    }
                }
            }
#pragma unroll
            for (int mt = 0; mt < MT; ++mt) {
                float ss = 0.f;
#pragma unroll
                for (int nt = 0; nt < 4; ++nt) ss += (acc[mt][nt][0] * acc[mt][nt][0] + acc[mt][nt][1] * acc[mt][nt][1]) + (acc[mt][nt][2] * acc[mt][nt][2] + acc[mt][nt][3] * acc[mt][nt][3]);
                ss += __shfl_xor(ss, 16); ss += __shfl_xor(ss, 32);
                if (fq == 0) red[(16 * mt + fr) * 8 + w] = ss;
            }
            const size_t off0 = (size_t)(i0 + fr) * 2048 + h * 512 + 64 * w + 16 * fq;
            u32x4 gld[MT][2];
#pragma unroll
            for (int mt = 0; mt < MT; ++mt)
#pragma unroll
                for (int np = 0; np < 2; ++np) gld[mt][np] = __builtin_nontemporal_load((const u32x4*)((dir == 0 ? (const bf16_t*)GF : GB) + off0 + (size_t)(16 * mt) * 2048 + 8 * np));
            asm volatile("s_waitcnt lgkmcnt(0)" ::: "memory");
            __builtin_amdgcn_s_barrier(); asm volatile("" ::: "memory");
#pragma unroll
            for (int mt = 0; mt < MT; ++mt) {
                float tot = 0.f;
#pragma unroll
                for (int w2 = 0; w2 < 8; ++w2) tot += red[(16 * mt + fr) * 8 + w2];
                const float rn = __builtin_amdgcn_rsqf(tot * (1.f / 512.f) + NORM_EPS);
#pragma unroll
                for (int np = 0; np < 2; ++np) {
                    const u32x4 g4 = gld[mt][np];
                    acc[mt][2 * np][0] *= siluf(bflo(g4.x)) * rn; acc[mt][2 * np][1] *= siluf(bfhi(g4.x)) * rn;
                    acc[mt][2 * np][2] *= siluf(bflo(g4.y)) * rn; acc[mt][2 * np][3] *= siluf(bfhi(g4.y)) * rn;
                    acc[mt][2 * np + 1][0] *= siluf(bflo(g4.z)) * rn; acc[mt][2 * np + 1][1] *= siluf(bfhi(g4.z)) * rn;
                    acc[mt][2 * np + 1][2] *= siluf(bflo(g4.w)) * rn; acc[mt][2 * np + 1][3] *= siluf(bfhi(g4.w)) * rn;
                }
            }
            if (dir == 1) {
#pragma unroll
                for (int mt = 0; mt < MT; ++mt)
#pragma unroll
                    for (int np = 0; np < 2; ++np) gld[mt][np] = *(const u32x4*)(GF + off0 + (size_t)(16 * mt) * 2048 + 8 * np);
#pragma unroll
                for (int mt = 0; mt < MT; ++mt)
#pragma unroll
                    for (int np = 0; np < 2; ++np) { const u32x4 yp = gld[mt][np];
                        acc[mt][2 * np][0] += bflo(yp.x); acc[mt][2 * np][1] += bfhi(yp.x); acc[mt][2 * np][2] += bflo(yp.y); acc[mt][2 * np][3] += bfhi(yp.y);
                        acc[mt][2 * np + 1][0] += bflo(yp.z); acc[mt][2 * np + 1][1] += bfhi(yp.z); acc[mt][2 * np + 1][2] += bflo(yp.w); acc[mt][2 * np + 1][3] += bfhi(yp.w); }
            }
            if (PV != 4) {
#pragma unroll
                for (int mt = 0; mt < MT; ++mt)
#pragma unroll
                    for (int np = 0; np < 2; ++np) { u32x4 wv; wv.x = pk2(acc[mt][2 * np][0], acc[mt][2 * np][1]); wv.y = pk2(acc[mt][2 * np][2], acc[mt][2 * np][3]);
                        wv.z = pk2(acc[mt][2 * np + 1][0], acc[mt][2 * np + 1][1]); wv.w = pk2(acc[mt][2 * np + 1][2], acc[mt][2 * np + 1][3]);
                        *(u32x4*)(GF + off0 + (size_t)(16 * mt) * 2048 + 8 * np) = wv; }
            }
        }
        __syncthreads();
    }
}

template <int PV = 0>
__device__ __forceinline__ void readout_phase(Ctx& C, int j, bool skip_ctx) {
    readout_units<8, PV>(C, j);
    if (!skip_ctx) { __syncthreads(); readout_units<2, PV>(C, j); }
}

__device__ __forceinline__ void phase_p0(Ctx& C) {
    float* modv = (float*)(C.ws + WS_MODV);
    for (int u = C.bid; u < 384; u += C.G) {
        const int i = u / 96, nbk = u % 96;
        gemv2_unit<1>(C, C.in[4] + (size_t)i * 1024 * 6144, 6144, 64 * nbk, C.in[1], C.in[3], C.in[5] + i * 6144, modv + (i * 2 + 0) * 6144, modv + (i * 2 + 1) * 6144, 0, 0);
    }
    float* tabc = (float*)(C.ws + WS_TABC); float* tabs = (float*)(C.ws + WS_TABS);
    for (int idx = C.bid * 512 + C.tid; idx < 320 * 64; idx += C.G * 512) {
        const int ti = idx >> 6, i = idx & 63; const float pos = (float)(ti < 256 ? ti : ti - 256);
        const float inv = exp2f(-(float)i * (13.287712379549449f / 64.0f)); const float ang = pos * inv;
        tabc[idx] = __cosf(ang); tabs[idx] = __sinf(ang);
    }
}
__device__ __forceinline__ void phase_p1(Ctx& C) {
    const float* modv = (const float*)(C.ws + WS_MODV);
    float* s1 = (float*)(C.ws + WS_S1); float* s2 = (float*)(C.ws + WS_S2);
    for (int idx = C.bid * 512 + C.tid; idx < 8192; idx += C.G * 512) {
        const int i = idx >> 11, s = (idx >> 10) & 1, k = idx & 1023;
        const float l1 = 1.f + modv[(i * 2) * 6144 + 1024 + k], l2 = 1.f + modv[(i * 2) * 6144 + 4096 + k];
        s1[idx] = s ? (l1 != 0.f ? (1.f + modv[(i * 2 + 1) * 6144 + 1024 + k]) / l1 : 0.f) : C.in[6][i * 1024 + k] * l1;
        s2[idx] = s ? (l2 != 0.f ? (1.f + modv[(i * 2 + 1) * 6144 + 4096 + k]) / l2 : 0.f) : C.in[7][i * 1024 + k] * l2;
    }
    float* cvA = (float*)(C.ws + WS_CVA); float* cvF = (float*)(C.ws + WS_CVF);
    for (int u = C.bid; u < 672; u += C.G) {
        if (u < 320) {
            int i, nbk; if (u < 32) { i = 0; nbk = u; } else if (u < 160) { i = 1; nbk = u - 32; } else if (u < 192) { i = 2; nbk = u - 160; } else { i = 3; nbk = u - 192; }
            const int j = i >> 1; const float* v0 = modv + (i * 2 + 0) * 6144; const float* v1 = modv + (i * 2 + 1) * 6144;
            if (i == 0) gemv2_unit<0, false>(C, C.in[8] + (size_t)j * 1024 * 2048, 2048, 64 * nbk, v0, v1, C.in[9] + j * 2048, cvA + (i * 2) * 8192, cvA + (i * 2 + 1) * 8192, 1, 1024);
            else if ((i & 1) == 0) gemv2_unit<0>(C, C.in[8] + (size_t)j * 1024 * 2048, 2048, 64 * nbk, v0, v1, C.in[9] + j * 2048, cvA + (i * 2) * 8192, cvA + (i * 2 + 1) * 8192, 1, 1024);
            else gemv2_unit<0>(C, C.in[16] + (size_t)j * 1024 * 8192, 8192, 64 * nbk, v0, v1, nullptr, cvA + (i * 2) * 8192, cvA + (i * 2 + 1) * 8192, 2, 0);
        } else {
            const int i = (u - 320) / 88, nbk = (u - 320) % 88;
            const float* v0 = modv + (i * 2 + 0) * 6144 + 3072; const float* v1 = modv + (i * 2 + 1) * 6144 + 3072;
            if (i == 0) gemv2_unit<0, false>(C, C.in[19] + (size_t)i * 1024 * FF2, FF2, 64 * nbk, v0, v1, nullptr, cvF + (i * 2) * FF2, cvF + (i * 2 + 1) * FF2, 1, DFF);
            else gemv2_unit<0>(C, C.in[19] + (size_t)i * 1024 * FF2, FF2, 64 * nbk, v0, v1, nullptr, cvF + (i * 2) * FF2, cvF + (i * 2 + 1) * FF2, 1, DFF);
        }
    }
    bf16_t* xs = (bf16_t*)C.out; float* stats = (float*)(C.ws + WS_STATS); float* xctx = (float*)(C.ws + WS_XCTX);
    for (int rp = C.bid * 8 + C.wave; 2 * rp < R; rp += C.G * 8) {
        const int row = 2 * rp; const bool lat = row < T;
        f32x4 v[2][4];
#pragma unroll
        for (int rr = 0; rr < 2; ++rr) {
            const float* src = lat ? C.in[0] + (size_t)(row + rr) * 1024 : C.in[2] + (size_t)(row + rr - T) * 1024;
#pragma unroll
            for (int jj = 0; jj < 4; ++jj) v[rr][jj] = *(const f32x4*)(src + 4 * C.lane + 256 * jj);
        }
#pragma unroll
        for (int rr = 0; rr < 2; ++rr) {
            float ss = 0.f;
#pragma unroll
            for (int jj = 0; jj < 4; ++jj) {
                const int k = 4 * C.lane + 256 * jj; const f32x4 x4 = v[rr][jj];
                ss += (x4[0] * x4[0] + x4[1] * x4[1]) + (x4[2] * x4[2] + x4[3] * x4[3]);
                f32x4 f = {1.f, 1.f, 1.f, 1.f};
                if (!lat) { const f32x4 ml = *(const f32x4*)(modv + 1024 + k), mc = *(const f32x4*)(modv + 6144 + 1024 + k);
#pragma unroll
                    for (int e = 0; e < 4; ++e) { const float l1 = 1.f + ml[e]; f[e] = l1 != 0.f ? (1.f + mc[e]) / l1 : 0.f; } }
                u32x2 w; w.x = pk2(x4[0] * f[0], x4[1] * f[1]); w.y = pk2(x4[2] * f[2], x4[3] * f[3]);
                *(u32x2*)(xs + (size_t)(row + rr) * 1024 + ((k & ~31) | ((k & 12) << 1) | ((k & 16) >> 2))) = w;
            }
#pragma unroll
            for (int off = 1; off < 64; off <<= 1) ss += __shfl_xor(ss, off);
            if (C.lane < 16) stats[(size_t)(row + rr) * 16 + C.lane] = C.lane == 0 ? ss : 0.f;
        }
    }
    prep_layer(C, 0, 7, 0);
}
__device__ __forceinline__ void phase_final(Ctx& C) {
    const float* stats = (const float*)(C.ws + WS_STATS);
    const f32x4 g4[4] = {*(const f32x4*)(C.in[21] + 4 * C.lane), *(const f32x4*)(C.in[21] + 4 * C.lane + 256), *(const f32x4*)(C.in[21] + 4 * C.lane + 512), *(const f32x4*)(C.in[21] + 4 * C.lane + 768)};
    for (int row0 = (C.bid * 8 + C.wave) * 4; row0 < T; row0 += C.G * 32) {
        f32x4 v[4][4]; float s[4];
#pragma unroll
        for (int rr = 0; rr < 4; ++rr) {
            s[rr] = C.lane < 16 ? stats[(size_t)(row0 + rr) * 16 + C.lane] : 0.f;
            const float* xf = (const float*)(C.ws + WS_GF) + (size_t)(row0 + rr) * 1024;
#pragma unroll
            for (int jj = 0; jj < 4; ++jj) v[rr][jj] = __builtin_nontemporal_load((const f32x4*)(xf + 4 * C.lane + 256 * jj));
        }
#pragma unroll
        for (int rr = 0; rr < 4; ++rr) {
            float t = s[rr];
#pragma unroll
            for (int off = 1; off < 64; off <<= 1) t += __shfl_xor(t, off);
            const float r = __builtin_amdgcn_rsqf(t * (1.f / 1024.f) + NORM_EPS);
            float* xr = C.out + (size_t)(row0 + rr) * 1024;
#pragma unroll
            for (int jj = 0; jj < 4; ++jj) *(f32x4*)(xr + 4 * C.lane + 256 * jj) = v[rr][jj] * r * g4[jj];
        }
    }
}

constexpr int NPHASE = 31;
template <int SK  , int RK = 0  >
__device__ __forceinline__ void run_phase(Ctx& C, int ph) {
    const int i = (ph - 2) / 7, sub = (ph - 2) % 7, j = i >> 1; const bool conv = (i & 1) == 0;
    const bool last = i == DEPTH - 1;
    float* stats = (float*)(C.ws + WS_STATS);
    const bf16_t* xs = (const bf16_t*)C.out;
    constexpr int F_MODV = (int)(WS_MODV / 4), F_S1 = (int)(WS_S1 / 4), F_S2 = (int)(WS_S2 / 4), F_CVA = (int)(WS_CVA / 4), F_CVF = (int)(WS_CVF / 4);
    if constexpr (SK == 0 || SK == 1) {
        if constexpr (SK == 0) { EpiGLU E{C.ws, F_CVA + (i * 2) * 8192, 8192, (int)WS_U, 1024, 0, stats}; gemm_both<8>(C, xs, (const bf16_t*)(C.ws + WS_WA), T, 2048, 1024, E, 0, 8); }
        else {
            EpiWin E{C.ws, F_CVA + (i * 2) * 8192, stats};
            const bf16_t* WA = (const bf16_t*)(C.ws + WS_WA);
            const bool ctx_first = ((C.bid >> 3) & 1) != 0;
            if (ctx_first) { sgemm_small<8, 4>(C, xs, WA, T, R - T, E, last ? 4 : 0, last ? 16 : 32); }
            gemm_both<8>(C, xs, WA, T, 8192, 1024, E, 0, 0, 0, 8);
            { pg8::Gemm g{xs, WA + (size_t)2048 * 1024, T, 2048, 1024}; pg8::StaticOrder S; S.init(T, 2048, C.G, C.bid); EpiVt EV{C.ws, F_CVA + (i * 2) * 8192};
              pg8::gemm_phase<EpiVt, pg8::StaticOrder, true, true, true, true>(C.lds, g, S, EV); }
            gemm_both<8>(C, xs, WA, T, 8192, 1024, E, 0, 0, 16, 32);
            if (!ctx_first) { __syncthreads(); relane(C); sgemm_small<8, 4>(C, xs, WA, T, R - T, E, last ? 4 : 0, last ? 16 : 32); }
        }
    } else if constexpr (SK == 2) {
        EpiGLU E{C.ws, F_CVF + (i * 2) * FF2, FF2, (int)WS_H, DFF, 1, stats}; gemm_both<16>(C, xs, (const bf16_t*)(C.ws + WS_WF1), last ? T : R, FF2, 1024, E, 0, 0);
        if (!last) { __syncthreads(); relane(C); prep_layer(C, i + 1, 5, C.G == 256 ? 150 : 0); }
    } else {
        const bool f2 = sub == 6;
        const int mgoff = F_MODV + (i * 2) * 6144 + (f2 ? 5120 : 2048);
        const int snoff = f2 ? (last ? -1 : F_S1 + ((i + 1) * 2) * 1024) : F_S2 + (i * 2) * 1024;
        const float* bias = (!f2 && conv) ? C.in[15] + j * 1024 : nullptr;
        const bf16_t* A = (const bf16_t*)(C.ws + (f2 ? WS_H : (conv ? WS_A2 : WS_GF)));
        const bf16_t* Bt = (const bf16_t*)(C.ws + (f2 ? WS_WF2 : WS_WA2));
        const int K = f2 ? DFF : (conv ? 1024 : 2048);
        const bool first = (i == 0 && !f2);
        EpiRes E{C.ws, (bf16_t*)C.out, (float*)(C.ws + WS_GF), C.in[0], first ? C.in[2] : (const float*)(C.ws + WS_XCTX), bias, mgoff, snoff, stats};
        { pg8::Gemm g{A, Bt, T, 1024, K}; pg8::StaticOrder S; S.init(T, 1024, C.G, C.bid); EpiResBig EB{E, C.lds, RK ? RK == 1 : first, RK ? RK == 3 : (f2 && last)};
          pg8::gemm_phase<EpiResBig, pg8::StaticOrder, true, true>(C.lds, g, S, EB); }
        if (!last) { __syncthreads(); relane(C);
            if (K == 1024) sgemm_small<4, 4>(C, A, Bt, T, R - T, E, 0, 4); else if (K == 2048) sgemm_small<4, 8>(C, A, Bt, T, R - T, E, 0, 4); else sgemm_small<4, 11>(C, A, Bt, T, R - T, E, 0, 4); }
    }
}

#define XB_TMO      128
#define XB_XCNT(j)  (256  + 64 * (j))
#define XB_XSUB(j)  (1280 + 64 * (j))
#define XB_XGEN(j)  (2304 + 64 * (j))
#define XB_TOP      3328
#define XB_TOPGEN   3392
#define XCD_BAR_WORDS 3456
#define XB_SPIN_CAP (1u << 20)
__device__ __forceinline__ unsigned xb_ld(unsigned* p)              { return __hip_atomic_load(p, __ATOMIC_RELAXED, __HIP_MEMORY_SCOPE_AGENT); }
__device__ __forceinline__ unsigned xb_add(unsigned* p, unsigned v) { return __hip_atomic_fetch_add(p, v, __ATOMIC_RELAXED, __HIP_MEMORY_SCOPE_AGENT); }
__device__ __forceinline__ unsigned xb_xcc_id() { return (unsigned)__builtin_amdgcn_s_getreg((3 << 11) | 20) & 0xFu; }
#define XB_SPIN(cond, bar) do { unsigned _sp = 0; while (cond) { __builtin_amdgcn_s_sleep(1); \
    if ((++_sp & 255u) == 0u) { if (xb_ld(&(bar)[XB_TMO])) break; if (_sp > XB_SPIN_CAP) { atomicAdd(&(bar)[XB_TMO], 1u); break; } } } } while (0)
struct XcdBarrier { unsigned* bar; unsigned x; volatile LAS unsigned* st; };
__device__ __forceinline__ XcdBarrier xcd_barrier_post(unsigned* bar, volatile LAS unsigned* st) {
    XcdBarrier b; b.bar = bar; b.x = xb_xcc_id(); b.st = st;
    if (threadIdx.x == 0) (void)xb_add(&bar[XB_XCNT(b.x)], 1u);
    return b;
}
__device__ __forceinline__ void xcd_barrier_complete(unsigned* bar, unsigned x, unsigned& nloc, unsigned& nx) {
    const unsigned G = gridDim.x * gridDim.y * gridDim.z;
    unsigned sum, cnt, mine, sp = 0u;
    for (;;) {
        sum = 0u; cnt = 0u; mine = 0u;
#pragma unroll
        for (unsigned j = 0; j < 16; ++j) { const unsigned c = xb_ld(&bar[XB_XCNT(j)]); sum += c; cnt += (c > 0u) ? 1u : 0u; mine = (j == x) ? c : mine; }
        if (sum == G) break;
        __builtin_amdgcn_s_sleep(1);
        if ((++sp & 255u) == 0u) { if (xb_ld(&bar[XB_TMO])) break; if (sp > XB_SPIN_CAP) { atomicAdd(&bar[XB_TMO], 1u); break; } }
    }
    nloc = mine > 0u ? mine : 1u; nx = cnt > 0u ? cnt : 1u;
}
__device__ __forceinline__ void xcd_barrier(const XcdBarrier& b) {
    asm volatile("s_waitcnt vmcnt(0)" ::: "memory");
    __syncthreads();
    if (threadIdx.x == 0) {
        unsigned* bar = b.bar;
        __builtin_amdgcn_s_waitcnt(0);
        unsigned nloc = b.st[0], nx = b.st[1];
        if (nloc == 0u) { xcd_barrier_complete(bar, b.x, nloc, nx); b.st[0] = nloc; b.st[1] = nx; }
        const unsigned old = xb_add(&bar[XB_XSUB(b.x)], 1u);
        const unsigned gen = old / nloc;
        if (old + 1u == (gen + 1u) * nloc) {
            __builtin_amdgcn_fence(__ATOMIC_RELEASE, "agent");
            asm volatile("s_waitcnt vmcnt(0)" ::: "memory");
            const unsigned og = xb_add(&bar[XB_TOP], 1u);
            __builtin_amdgcn_fence(__ATOMIC_ACQUIRE, "agent");
            const unsigned tg = og / nx;
            if (og + 1u == (tg + 1u) * nx) xb_add(&bar[XB_TOPGEN], 1u);
            else XB_SPIN(xb_ld(&bar[XB_TOPGEN]) == tg, bar);
            xb_add(&bar[XB_XGEN(b.x)], 1u);
            asm volatile("s_waitcnt vmcnt(0)" ::: "memory");
        } else {
            __builtin_amdgcn_fence(__ATOMIC_ACQUIRE, "agent");
            asm volatile("s_waitcnt vmcnt(0)" ::: "memory");
            XB_SPIN(xb_ld(&bar[XB_XGEN(b.x)]) == gen, bar);
            asm volatile("" ::: "memory");
        }
    }
    __syncthreads();
}
constexpr int MISC_OFF = LDS_BYTES - 512;
constexpr int CW_BAR = 4096;

#ifndef PROBE_DUP
#define PROBE_DUP 0
#endif
#if ONE_LAUNCH
template <int PH> __device__ __forceinline__ void phase_body(Ctx& C) {
    constexpr int i = (PH - 2) / 7, sub = (PH - 2) % 7, j = i >> 1; constexpr bool conv = (i & 1) == 0;
    if (PH == 0) phase_p0(C);
    else if (PH == 1) phase_p1(C);
    else if (PH == 30) phase_final(C);
    else if (sub == 1) { if (i > 0) { prep_layer(C, i, 2, (!conv && C.G == 256) ? 16 : 0); __syncthreads(); } if (conv) dwconv_phase(C, j); else ugemm_phase(C, j); }
    else if (sub == 2) prefix_phase(C, j);
    else if (sub == 3) readout_phase(C, j, i == DEPTH - 1);
    else run_phase<(sub == 0 ? (conv ? 0 : 1) : (sub == 5 ? 2 : 3))>(C, PH);
}
template <int PH> __device__ __forceinline__ void one_phase(Ctx& C, const Args& args, const XcdBarrier& bar) {
    constexpr int i = (PH - 2) / 7, sub = (PH - 2) % 7; constexpr bool conv = (i & 1) == 0;
    if (PH >= 2 && PH < 30) { if ((sub == 2 || sub == 3) && conv) return; }
    if (PH > 0) xcd_barrier(bar);
    relane(C);
    phase_body<PH>(C);
    constexpr bool dup = ((PH >= 2 && PH < 30) && (((PROBE_DUP & 1) && (sub == 0 || sub == 5)) || ((PROBE_DUP & 2) && sub == 1 && !conv) || ((PROBE_DUP & 4) && sub == 1 && conv))) || ((PROBE_DUP & 16) && PH < 2);
    if constexpr (dup) { xcd_barrier(bar); phase_body<PH>(C); }
}
template <int... PHS> __device__ __forceinline__ void all_phases(Ctx& C, const Args& args, const XcdBarrier& bar, std::integer_sequence<int, PHS...>) { (one_phase<PHS>(C, args, bar), ...); }
__global__ void __launch_bounds__(512, 2) mega_kernel(Args args) {
    extern __shared__ __attribute__((aligned(16))) unsigned char lds_raw[];
    Ctx C;
    C.lds = (LAS unsigned char*)lds_raw; C.tid = threadIdx.x; C.lane = C.tid & 63; C.wave = __builtin_amdgcn_readfirstlane(C.tid >> 6); C.G = gridDim.x; C.bid = blockIdx.x;
    C.in = args.in; C.out = args.out; C.ws = args.ws;
    volatile LAS unsigned* MISC = (volatile LAS unsigned*)(C.lds + MISC_OFF);
    if (C.tid < 32) MISC[C.tid] = 0u;
    __syncthreads();
    XcdBarrier bar = xcd_barrier_post((unsigned*)(C.ws + WS_CTL) + CW_BAR, MISC + 8);
    all_phases(C, args, bar, std::make_integer_sequence<int, NPHASE>{});
}

#endif
#if !ONE_LAUNCH
template <int KIND>
__global__ void __launch_bounds__(512, 2) phase_kernel(Args args) {
    extern __shared__ __attribute__((aligned(16))) unsigned char lds_raw[];
    Ctx C;
    C.lds = (LAS unsigned char*)lds_raw; C.tid = threadIdx.x; C.lane = C.tid & 63; C.wave = __builtin_amdgcn_readfirstlane(C.tid >> 6); C.G = gridDim.x; C.bid = blockIdx.x;
    C.in = args.in; C.out = args.out; C.ws = args.ws;
    const int ph = args.ph_lo;
    if (KIND == 0) phase_p0(C);
    else if (KIND == 1) phase_p1(C);
    else if (KIND == 30) phase_final(C);
    else {
        const int i = (ph - 2) / 7, j = i >> 1; const bool conv = (i & 1) == 0;
        if (KIND == 2) prefix_phase(C, j);
        else if (KIND == 4) { if (i > 0) { prep_layer(C, i, 2, (!conv && C.G == 256) ? 16 : 0); __syncthreads(); } if (conv) dwconv_phase(C, j); else ugemm_phase(C, j); }
        else if (KIND == 5) readout_phase(C, j, i == DEPTH - 1);
        else if (KIND == 31) run_phase<0>(C, ph);
        else if (KIND == 32) run_phase<1>(C, ph);
        else if (KIND == 33) run_phase<2>(C, ph);
        else if (KIND == 34) run_phase<3, 1>(C, ph);
        else if (KIND == 35) run_phase<3, 2>(C, ph);
        else run_phase<3, 3>(C, ph);
    }
}

#endif
#ifndef PROBE_RD
#define PROBE_RD 0
#endif
#if PROBE_RD
__global__ void __launch_bounds__(512, 2) probe_read_kernel(Args args) {
    extern __shared__ __attribute__((aligned(16))) unsigned char lds_raw[];
    Ctx C;
    C.lds = (LAS unsigned char*)lds_raw; C.tid = threadIdx.x; C.lane = C.tid & 63; C.wave = __builtin_amdgcn_readfirstlane(C.tid >> 6); C.G = gridDim.x; C.bid = blockIdx.x;
    C.in = args.in; C.out = args.out; C.ws = args.ws;
    readout_phase<PROBE_RD>(C, 1, true);
}
#endif
extern "C" void kernel_launch(void* const* d_in, const int* in_sizes, int n_in, void* d_out, int out_size, void* d_ws, size_t ws_size, hipStream_t stream) {
    static int grid = 0;
    if (grid == 0) {
        if (n_in != 22 || out_size != T * D || ws_size < WS_END + (PROBE_RD ? 20 * MiB : 0)) { fprintf(stderr, "kernel_launch: unexpected problem (n_in %d out %d ws %zu, need %zu)\n", n_in, out_size, ws_size, (size_t)WS_END); grid = -1; return; }
        int dev = 0, cus = 0;
        if (hipGetDevice(&dev) != hipSuccess || hipDeviceGetAttribute(&cus, hipDeviceAttributeMultiprocessorCount, dev) != hipSuccess) { grid = -1; return; }
        bool ok = true;
#if !ONE_LAUNCH
        ok &= hipFuncSetAttribute((const void*)phase_kernel<0>, hipFuncAttributeMaxDynamicSharedMemorySize, LDS_BYTES) == hipSuccess;
        ok &= hipFuncSetAttribute((const void*)phase_kernel<1>, hipFuncAttributeMaxDynamicSharedMemorySize, LDS_BYTES) == hipSuccess;
        ok &= hipFuncSetAttribute((const void*)phase_kernel<2>, hipFuncAttributeMaxDynamicSharedMemorySize, LDS_BYTES) == hipSuccess;
        ok &= hipFuncSetAttribute((const void*)phase_kernel<31>, hipFuncAttributeMaxDynamicSharedMemorySize, LDS_BYTES) == hipSuccess;
        ok &= hipFuncSetAttribute((const void*)phase_kernel<32>, hipFuncAttributeMaxDynamicSharedMemorySize, LDS_BYTES) == hipSuccess;
        ok &= hipFuncSetAttribute((const void*)phase_kernel<33>, hipFuncAttributeMaxDynamicSharedMemorySize, LDS_BYTES) == hipSuccess;
        ok &= hipFuncSetAttribute((const void*)phase_kernel<34>, hipFuncAttributeMaxDynamicSharedMemorySize, LDS_BYTES) == hipSuccess;
        ok &= hipFuncSetAttribute((const void*)phase_kernel<35>, hipFuncAttributeMaxDynamicSharedMemorySize, LDS_BYTES) == hipSuccess;
        ok &= hipFuncSetAttribute((const void*)phase_kernel<36>, hipFuncAttributeMaxDynamicSharedMemorySize, LDS_BYTES) == hipSuccess;
        ok &= hipFuncSetAttribute((const void*)phase_kernel<4>, hipFuncAttributeMaxDynamicSharedMemorySize, LDS_BYTES) == hipSuccess;
        ok &= hipFuncSetAttribute((const void*)phase_kernel<5>, hipFuncAttributeMaxDynamicSharedMemorySize, LDS_BYTES) == hipSuccess;
        ok &= hipFuncSetAttribute((const void*)phase_kernel<30>, hipFuncAttributeMaxDynamicSharedMemorySize, LDS_BYTES) == hipSuccess;
#endif
#if ONE_LAUNCH
        ok &= hipFuncSetAttribute((const void*)mega_kernel, hipFuncAttributeMaxDynamicSharedMemorySize, LDS_BYTES) == hipSuccess;
#endif
        if (!ok) { fprintf(stderr, "kernel_launch: hipFuncSetAttribute failed\n"); grid = -1; return; }
        grid = cus > 0 ? cus : 256;
    }
    if (grid < 0) return;
    Args a{};
    for (int i = 0; i < 22; ++i) a.in[i] = (const float*)d_in[i];
    a.out = (float*)d_out; a.ws = (unsigned char*)d_ws;
#if ONE_LAUNCH
    if (hipMemsetAsync((char*)d_ws + WS_CTL, 0, 65536, stream) != hipSuccess) { fprintf(stderr, "kernel_launch: memset failed\n"); return; }
    a.ph_lo = 0; a.ph_hi = NPHASE;
    hipLaunchKernelGGL(mega_kernel, dim3(grid), dim3(512), LDS_BYTES, stream, a);
    return;
#endif
#if !ONE_LAUNCH
    for (int ph = 0; ph < NPHASE; ++ph) {
        const int i = (ph - 2) / 7, sub = (ph - 2) % 7;
        if (ph >= 2 && ph < 30) { if ((sub == 2 || sub == 3) && (i & 1) == 0) continue; }
        a.ph_lo = ph; a.ph_hi = ph + 1;
        const dim3 g(grid), b(512);
        if (ph == 0) hipLaunchKernelGGL(phase_kernel<0>, g, b, LDS_BYTES, stream, a);
        else if (ph == 1) hipLaunchKernelGGL(phase_kernel<1>, g, b, LDS_BYTES, stream, a);
        else if (ph == 30) hipLaunchKernelGGL(phase_kernel<30>, g, b, LDS_BYTES, stream, a);
        else if (sub == 2) hipLaunchKernelGGL(phase_kernel<2>, g, b, LDS_BYTES, stream, a);
        else if (sub == 1) hipLaunchKernelGGL(phase_kernel<4>, g, b, LDS_BYTES, stream, a);
        else if (sub == 3) hipLaunchKernelGGL(phase_kernel<5>, g, b, LDS_BYTES, stream, a);
        else { const bool cv_ = (i & 1) == 0; if (sub == 0) { if (cv_) hipLaunchKernelGGL(phase_kernel<31>, g, b, LDS_BYTES, stream, a); else hipLaunchKernelGGL(phase_kernel<32>, g, b, LDS_BYTES, stream, a); }
               else if (sub == 5) hipLaunchKernelGGL(phase_kernel<33>, g, b, LDS_BYTES, stream, a);
               else if (i == 0 && sub == 4) hipLaunchKernelGGL(phase_kernel<34>, g, b, LDS_BYTES, stream, a); else if (i == DEPTH - 1 && sub == 6) hipLaunchKernelGGL(phase_kernel<36>, g, b, LDS_BYTES, stream, a); else hipLaunchKernelGGL(phase_kernel<35>, g, b, LDS_BYTES, stream, a); }
#ifdef PROBE_G
        if (ph == 30) { Args a2 = a; a2.ph_lo = PROBE_G; a2.ph_hi = PROBE_G + 1; const int i2 = (PROBE_G - 2) / 7, s2 = (PROBE_G - 2) % 7;
            if (s2 == 0 && (i2 & 1) == 0) hipLaunchKernelGGL(phase_kernel<31>, g, b, LDS_BYTES, stream, a2); else if (s2 == 0) hipLaunchKernelGGL(phase_kernel<32>, g, b, LDS_BYTES, stream, a2); else hipLaunchKernelGGL(phase_kernel<33>, g, b, LDS_BYTES, stream, a2); }
#endif
#if PROBE_RD
        if (ph == 30) { hipFuncSetAttribute((const void*)probe_read_kernel, hipFuncAttributeMaxDynamicSharedMemorySize, LDS_BYTES); hipLaunchKernelGGL(probe_read_kernel, g, b, LDS_BYTES, stream, a); }
#endif
        {   const bool conv = (i & 1) == 0;
            const bool dup = ((ph >= 2 && ph < 30) && (((PROBE_DUP & 32) && sub == 0 && conv) || ((PROBE_DUP & 64) && sub == 0 && !conv) || ((PROBE_DUP & 128) && sub == 5) || ((PROBE_DUP & 1) && (sub == 0 || sub == 5)) || ((PROBE_DUP & 2) && sub == 1 && !conv) || ((PROBE_DUP & 4) && sub == 1 && conv))) || ((PROBE_DUP & 16) && ph < 2);
            if (dup) {
                if (ph == 0) hipLaunchKernelGGL(phase_kernel<0>, g, b, LDS_BYTES, stream, a);
                else if (ph == 1) hipLaunchKernelGGL(phase_kernel<1>, g, b, LDS_BYTES, stream, a);
                else if (sub == 2) hipLaunchKernelGGL(phase_kernel<2>, g, b, LDS_BYTES, stream, a);
                else if (sub == 1) hipLaunchKernelGGL(phase_kernel<4>, g, b, LDS_BYTES, stream, a);
                else if (sub == 0 && conv) hipLaunchKernelGGL(phase_kernel<31>, g, b, LDS_BYTES, stream, a);
                else if (sub == 0) hipLaunchKernelGGL(phase_kernel<32>, g, b, LDS_BYTES, stream, a);
                else hipLaunchKernelGGL(phase_kernel<33>, g, b, LDS_BYTES, stream, a);
            } }
    }
#endif
}
```
